# Optimizing an MI355X kernel written in HIP

```python
import math
import jax, jax.numpy as jnp
from jax import lax
import numpy as np

D_MODEL = 1024
BATCH = 32
SEQ = 2048
DEPTH = 4

N_MIXERS = 2
RWKV_HEAD = 64
RWKV_HEADS = D_MODEL // RWKV_HEAD
DECAY_LORA = 64
AAA_LORA = 64
MV_LORA = 32
GATE_LORA = 160
GN_EPS = 64e-5
N_RWKV_BRANCHES = 6
ATT_HEADS = 16
QK_HEAD = 64
V_HEAD = 64
Q_LORA = 256
KV_LORA = 128
IDX_HEADS = 8
IDX_DIM = 64
TOPK_MAX = 256
Q_BLOCK = 128
DSA_IN = Q_LORA + KV_LORA + IDX_DIM + IDX_HEADS
REL_BUCKETS = 32
REL_MAX_DIST = 128
D_FF = 2816
CONV_W = 3
DN_ALPHA = (2 * DEPTH) ** 0.25
DN_BETA = (8 * DEPTH) ** -0.25
LN_EPS = 1e-5

kernel_name = "hybrid_rwkv7_dsa_convffn_deepnorm"


def layer_norm(x, g, b, eps=LN_EPS):
    xf = x.astype(jnp.float32)
    mu = xf.mean(-1, keepdims=True)
    var = jnp.square(xf - mu).mean(-1, keepdims=True)
    return ((xf - mu) * lax.rsqrt(var + eps) * g + b).astype(x.dtype)


def rms_norm(x, g, eps=1e-6):
    xf = x.astype(jnp.float32)
    return (xf * lax.rsqrt(jnp.square(xf).mean(-1, keepdims=True) + eps) * g).astype(x.dtype)


def token_shift(x):
    return jnp.pad(x, ((0, 0), (1, 0), (0, 0)))[:, :-1]


def t5_bucket(dist):
    n = jnp.maximum(dist, 0)
    max_exact = REL_BUCKETS // 2
    nf = jnp.maximum(n, 1).astype(jnp.float32)
    large = max_exact + (jnp.log(nf / max_exact) / math.log(REL_MAX_DIST / max_exact)
                         * (REL_BUCKETS - max_exact)).astype(jnp.int32)
    large = jnp.minimum(large, REL_BUCKETS - 1)
    return jnp.where(n < max_exact, n, large)


def _wkv7_step(state, inp):
    r_t, w_t, k_t, v_t, a_t, b_t = inp
    sa = jnp.einsum('bhvk,bhk->bhv', state, a_t)
    state = (state * w_t[:, :, None, :] + sa[..., None] * b_t[:, :, None, :]
             + v_t[..., None] * k_t[:, :, None, :])
    y = jnp.einsum('bhvk,bhk->bhv', state, r_t)
    return state, y


def rwkv7_time_mix(x, v_first, vres, mix, w_rkv, w0, w1, w2, a0, a1, a2, g1, g2,
                   k_k, k_a, r_k, lnx_g, lnx_b, w_o):
    B, S, D = x.shape
    H, N = RWKV_HEADS, RWKV_HEAD
    f32 = jnp.float32
    xx = token_shift(x) - x
    xm = x[None] + xx[None] * mix[:, None, None, :]
    r, k, v = jnp.einsum('nbsd,nde->nbse', xm[:3], w_rkv)
    xv, xw, xa, xg = xm[2], xm[3], xm[4], xm[5]
    w_log = -jax.nn.softplus(-(w0 + jnp.tanh(xw @ w1) @ w2)) - 0.5
    decay = jnp.exp(-jnp.exp(w_log.astype(f32)))
    if vres is None:
        v_first = v
    else:
        v0, v1, v2 = vres
        v = v + (v_first - v) * jax.nn.sigmoid(v0 + (xv @ v1) @ v2)
    a = jax.nn.sigmoid(a0 + (xa @ a1) @ a2)
    g = jax.nn.sigmoid(xg @ g1) @ g2
    heads = lambda t: t.reshape(B, S, H, N)
    kk = heads(k * k_k).astype(f32)
    kk = kk / jnp.maximum(jnp.sqrt(jnp.sum(kk * kk, -1, keepdims=True)), 1e-12)
    k = k * (1 + (a - 1) * k_a)
    rh, kh, vh, ah = heads(r), heads(k), heads(v), heads(a)
    tm = lambda t: jnp.moveaxis(t.astype(f32), 1, 0)
    xs = (tm(rh), tm(heads(decay)), tm(kh), tm(vh), tm(-kk), tm(kk * ah.astype(f32)))
    state0 = jnp.zeros((B, H, N, N), f32)
    _, y = lax.scan(_wkv7_step, state0, xs)
    y = jnp.moveaxis(y, 0, 1)
    mu = y.mean(-1, keepdims=True)
    var = jnp.square(y - mu).mean(-1, keepdims=True)
    y = ((y - mu) * lax.rsqrt(var + GN_EPS)).reshape(B, S, D) * lnx_g + lnx_b
    bonus = jnp.sum(rh * kh * r_k, -1, keepdims=True) * vh
    y = (y.astype(x.dtype) + bonus.reshape(B, S, D)) * g
    return y @ w_o, v_first


def dsa_attention(x, w_in, q_norm_g, kv_norm_g, w_uq, w_uk, w_uv, w_qidx, kidx_g, kidx_b,
                  rel_bias, w_o):
    B, S, D = x.shape
    H = ATT_HEADS
    topk = min(TOPK_MAX, S // 4)
    h = x @ w_in
    c_q, c_kv, k_idx, w_idx = jnp.split(
        h, [Q_LORA, Q_LORA + KV_LORA, Q_LORA + KV_LORA + IDX_DIM], axis=-1)
    c_q = rms_norm(c_q, q_norm_g)
    c_kv = rms_norm(c_kv, kv_norm_g)
    q = (c_q @ w_uq).reshape(B, S, H, QK_HEAD)
    q_idx = (c_q @ w_qidx).reshape(B, S, IDX_HEADS, IDX_DIM)
    k_idx = layer_norm(k_idx, kidx_g, kidx_b)
    w_idx = w_idx * (IDX_HEADS ** -0.5 * IDX_DIM ** -0.5)
    nb = S // Q_BLOCK
    blk = lambda t: jnp.swapaxes(t.reshape((B, nb, Q_BLOCK) + t.shape[2:]), 0, 1)
    starts = jnp.arange(nb, dtype=jnp.int32) * Q_BLOCK
    key_pos = jnp.arange(S, dtype=jnp.int32)
    qk_scale = QK_HEAD ** -0.5

    def block(args):
        q_b, qi_b, wi_b, t0 = args
        t_pos = t0 + jnp.arange(Q_BLOCK, dtype=jnp.int32)
        s_idx = jnp.einsum('bthd,bsd->bths', qi_b, k_idx)
        score = jnp.einsum('bths,bth->bts', jax.nn.relu(s_idx), wi_b).astype(jnp.float32)
        causal = key_pos[None, :] <= t_pos[:, None]
        score = jnp.where(causal[None], score, -jnp.inf)
        _, sel = lax.top_k(score, topk)
        kv_sel = jax.vmap(lambda c, i: c[i])(c_kv, sel)
        q_abs = jnp.einsum('bthd,hdc->bthc', q_b, w_uk)
        logits = jnp.einsum('bthc,btkc->bhtk', q_abs, kv_sel).astype(jnp.float32) * qk_scale
        dist = t_pos[None, :, None] - sel
        bias = rel_bias[t5_bucket(dist)].astype(jnp.float32)
        logits = logits + jnp.moveaxis(bias, -1, 1)
        logits = jnp.where((dist >= 0)[:, None], logits, -jnp.inf)
        p = jax.nn.softmax(logits, axis=-1).astype(x.dtype)
        o_lat = jnp.einsum('bhtk,btkc->bthc', p, kv_sel)
        o = jnp.einsum('bthc,hcv->bthv', o_lat, w_uv)
        return o.reshape(B, Q_BLOCK, H * V_HEAD)

    o = lax.map(block, (blk(q), blk(q_idx), blk(w_idx), starts))
    o = jnp.swapaxes(o, 0, 1).reshape(B, S, H * V_HEAD)
    return o @ w_o


def conv_ffn(x, w_up, conv_w, conv_b, w_down):
    S = x.shape[1]
    u = x @ w_up
    up = jnp.pad(u, ((0, 0), (CONV_W - 1, 0), (0, 0)))
    u = sum(up[:, j:j + S] * conv_w[j] for j in range(CONV_W)) + conv_b
    gate, val = jnp.split(u, 2, axis=-1)
    return (jax.nn.silu(gate) * val) @ w_down


def setup_inputs(seed: int = 0) -> dict:
    key = jax.random.key(seed)
    ks = iter(jax.random.split(key, 64))
    f32 = jnp.float32
    n = lambda shape, scale: scale * jax.random.normal(next(ks), shape, f32)
    D, H, N = D_MODEL, RWKV_HEADS, RWKV_HEAD
    n_rwkv = (DEPTH + 1) // 2
    n_dsa = DEPTH // 2
    n_vres = max(n_rwkv - 1, 0)
    return {
        "x": n((BATCH, SEQ, D), 1.0),
        "ln_g": 1.0 + n((DEPTH, 2, D), 0.02),
        "ln_b": n((DEPTH, 2, D), 0.02),
        "rwkv_mix": jax.random.uniform(next(ks), (n_rwkv, N_RWKV_BRANCHES, D), f32),
        "rwkv_w_rkv": n((n_rwkv, 3, D, D), D ** -0.5),
        "rwkv_w0": -1.5 + n((n_rwkv, D), 1.0),
        "rwkv_w1": n((n_rwkv, D, DECAY_LORA), D ** -0.5),
        "rwkv_w2": n((n_rwkv, DECAY_LORA, D), 0.5 * DECAY_LORA ** -0.5),
        "rwkv_a0": n((n_rwkv, D), 0.1),
        "rwkv_a1": n((n_rwkv, D, AAA_LORA), D ** -0.5),
        "rwkv_a2": n((n_rwkv, AAA_LORA, D), 0.5 * AAA_LORA ** -0.5),
        "rwkv_v0": n((n_vres, D), 0.1),
        "rwkv_v1": n((n_vres, D, MV_LORA), D ** -0.5),
        "rwkv_v2": n((n_vres, MV_LORA, D), 0.5 * MV_LORA ** -0.5),
        "rwkv_g1": n((n_rwkv, D, GATE_LORA), D ** -0.5),
        "rwkv_g2": n((n_rwkv, GATE_LORA, D), GATE_LORA ** -0.5),
        "rwkv_k_k": 0.85 + n((n_rwkv, D), 0.05),
        "rwkv_k_a": 1.0 + n((n_rwkv, D), 0.05),
        "rwkv_r_k": n((n_rwkv, H, N), 0.1),
        "rwkv_lnx_g": 1.0 + n((n_rwkv, D), 0.02),
        "rwkv_lnx_b": n((n_rwkv, D), 0.02),
        "rwkv_w_o": n((n_rwkv, D, D), DN_BETA * D ** -0.5),
        "dsa_w_in": n((n_dsa, D, DSA_IN), D ** -0.5),
        "dsa_q_norm_g": 1.0 + n((n_dsa, Q_LORA), 0.02),
        "dsa_kv_norm_g": 1.0 + n((n_dsa, KV_LORA), 0.02),
        "dsa_w_uq": n((n_dsa, Q_LORA, ATT_HEADS * QK_HEAD), Q_LORA ** -0.5),
        "dsa_w_uk": n((n_dsa, ATT_HEADS, QK_HEAD, KV_LORA), KV_LORA ** -0.5),
        "dsa_w_uv": n((n_dsa, ATT_HEADS, KV_LORA, V_HEAD), KV_LORA ** -0.5),
        "dsa_w_qidx": n((n_dsa, Q_LORA, IDX_HEADS * IDX_DIM), Q_LORA ** -0.5),
        "dsa_kidx_g": 1.0 + n((n_dsa, IDX_DIM), 0.02),
        "dsa_kidx_b": n((n_dsa, IDX_DIM), 0.02),
        "dsa_w_o": n((n_dsa, ATT_HEADS * V_HEAD, D), DN_BETA * (ATT_HEADS * V_HEAD) ** -0.5),
        "rel_bias": n((REL_BUCKETS, ATT_HEADS), 0.5),
        "ffn_w_up": n((DEPTH, D, 2 * D_FF), D ** -0.5),
        "ffn_conv_w": n((DEPTH, CONV_W, 2 * D_FF), CONV_W ** -0.5),
        "ffn_conv_b": n((DEPTH, 2 * D_FF), 0.02),
        "ffn_w_down": n((DEPTH, D_FF, D), DN_BETA * D_FF ** -0.5),
    }


def reference(x, ln_g, ln_b, rwkv_mix, rwkv_w_rkv, rwkv_w0, rwkv_w1, rwkv_w2, rwkv_a0, rwkv_a1,
              rwkv_a2, rwkv_v0, rwkv_v1, rwkv_v2, rwkv_g1, rwkv_g2, rwkv_k_k, rwkv_k_a, rwkv_r_k,
              rwkv_lnx_g, rwkv_lnx_b, rwkv_w_o, dsa_w_in, dsa_q_norm_g, dsa_kv_norm_g, dsa_w_uq,
              dsa_w_uk, dsa_w_uv, dsa_w_qidx, dsa_kidx_g, dsa_kidx_b, dsa_w_o, rel_bias,
              ffn_w_up, ffn_conv_w, ffn_conv_b, ffn_w_down):
    v_first = None
    for i in range(DEPTH):
        j = i // N_MIXERS
        if i % N_MIXERS == 0:
            vres = None if j == 0 else (rwkv_v0[j - 1], rwkv_v1[j - 1], rwkv_v2[j - 1])
            h, v_first = rwkv7_time_mix(
                x, v_first, vres, rwkv_mix[j], rwkv_w_rkv[j], rwkv_w0[j], rwkv_w1[j], rwkv_w2[j],
                rwkv_a0[j], rwkv_a1[j], rwkv_a2[j], rwkv_g1[j], rwkv_g2[j], rwkv_k_k[j],
                rwkv_k_a[j], rwkv_r_k[j], rwkv_lnx_g[j], rwkv_lnx_b[j], rwkv_w_o[j])
        else:
            h = dsa_attention(
                x, dsa_w_in[j], dsa_q_norm_g[j], dsa_kv_norm_g[j], dsa_w_uq[j], dsa_w_uk[j],
                dsa_w_uv[j], dsa_w_qidx[j], dsa_kidx_g[j], dsa_kidx_b[j], rel_bias, dsa_w_o[j])
        x = layer_norm(DN_ALPHA * x + h, ln_g[i, 0], ln_b[i, 0])
        f = conv_ffn(x, ffn_w_up[i], ffn_conv_w[i], ffn_conv_b[i], ffn_w_down[i])
        x = layer_norm(DN_ALPHA * x + f, ln_g[i, 1], ln_b[i, 1])
    return x
```

```cpp
#include <hip/hip_runtime.h>
#include <hip/hip_cooperative_groups.h>
#include <cstdio>
namespace cg = cooperative_groups;

#ifndef SINGLE_LAUNCH
#define SINGLE_LAUNCH 1
#endif

#define LAS __attribute__((address_space(3)))
typedef _Float16 h16;
typedef _Float16 h16x8 __attribute__((ext_vector_type(8)));
typedef _Float16 h16x4 __attribute__((ext_vector_type(4)));
typedef _Float16 h16x2 __attribute__((ext_vector_type(2)));
typedef float f32x4 __attribute__((ext_vector_type(4)));
typedef float f32x2 __attribute__((ext_vector_type(2)));
typedef unsigned u32x4 __attribute__((ext_vector_type(4)));
typedef unsigned u32x2 __attribute__((ext_vector_type(2)));

constexpr int DM = 1024, SEQ = 2048, NBATCH = 32, MTOK = NBATCH * SEQ;
constexpr int DFF = 2816;
constexpr size_t MiB = (size_t)1 << 20;
constexpr float DN_ALPHA = 1.6817928305074290f;
constexpr int LDS_BYTES = 147456;

constexpr size_t OFF_W = 0;
constexpr size_t OFF_X16 = 118 * MiB;
constexpr size_t OFF_VF = 247 * MiB;
constexpr size_t OFF_R = 375 * MiB;
constexpr size_t WS_NEED = 951 * MiB;
constexpr size_t R_R16 = OFF_R, R_K16 = OFF_R + 128 * MiB, R_V16 = OFF_R + 256 * MiB, R_G16 = OFF_R + 384 * MiB, R_HACT = OFF_R + 512 * MiB;
constexpr size_t F_U16 = OFF_R, F_ACT = OFF_R + 352 * MiB;
constexpr size_t D_HIN = OFF_R, D_O16 = OFF_R, D_QABS = OFF_R + 128 * MiB, D_QIDX = OFF_R + 384 * MiB, D_CQ = OFF_R + 448 * MiB,
                 D_CKV = OFF_R + 480 * MiB, D_CKVT = OFF_R + 496 * MiB, D_KIDX = OFF_R + 512 * MiB, D_WIDX = OFF_R + 520 * MiB, D_MASK = OFF_R + 522 * MiB;

struct Params {
    const float* in[37];
    unsigned char* ws;
    float* out;
    int ph_lo, ph_hi;
    unsigned char prog[64];
};

enum { K_PREP = 0, K_R1, K_R2, K_R3, K_R4, K_LN, K_F1, K_F2, K_F3, K_D1, K_D2, K_D3, K_D4, K_D5, K_D6 };
enum { E_RPROJ = 0, E_LORA2, E_RESID, E_ST16, E_ST32, E_QPROJ };

__device__ __forceinline__ size_t xrow(int row) { return (size_t)(row >> 11) * 2049 + 1 + (row & 2047); }
__device__ __forceinline__ unsigned pk2(float a, float b) { h16x2 h = {(h16)a, (h16)b}; return __builtin_bit_cast(unsigned, h); }
__device__ __forceinline__ u32x4 pack8(f32x4 a, f32x4 b) { u32x4 w; w.x = pk2(a[0], a[1]); w.y = pk2(a[2], a[3]); w.z = pk2(b[0], b[1]); w.w = pk2(b[2], b[3]); return w; }
__device__ __forceinline__ void unpack8(u32x4 w, float* f) {
    h16x8 h = __builtin_bit_cast(h16x8, w);
#pragma unroll
    for (int i = 0; i < 8; ++i) f[i] = (float)h[i];
}
__device__ __forceinline__ float sigmoidf_(float x) { return 1.0f / (1.0f + __expf(-x)); }
__device__ __forceinline__ float wave_sum(float v) {
#pragma unroll
    for (int o = 32; o > 0; o >>= 1) v += __shfl_xor(v, o);
    return v;
}
#define WSYNC() asm volatile("s_waitcnt vmcnt(0) lgkmcnt(0)" ::: "memory")
__device__ __forceinline__ int opaque_tid() { int t = threadIdx.x; asm volatile("" : "+v"(t)); return t; }

namespace pg8 {
constexpr int BM = 256, BK = 64, HALF = 128, HTB = HALF * BK * 2, STAGE_BYTES = 8 * HTB, NXCD = 8, WGM = 8;
__device__ __forceinline__ int lds_byte(int r, int c) { const int st = (r >> 4) * 2 + (c >> 5), rr = r & 15, cc = c & 31, ob = rr * 64 + cc * 2; return st * 1024 + (ob ^ (((ob >> 9) & 1) << 5)); }
__device__ __forceinline__ void stage_rc(int b, int& R, int& C) { const int st = b / 1024, sb = b % 1024, swz = sb ^ (((sb >> 9) & 1) << 5); R = (st >> 1) * 16 + swz / 64; C = (st & 1) * 32 + (swz % 64) / 2; }
__device__ __forceinline__ int perm32(int rho) { const int n = rho >> 4, i = rho & 15; return 8 * (i >> 2) + 4 * n + (i & 3); }
struct Unit { int pm, pn; };
struct Gemm { const h16* A; const h16* Bt; int M, N, K, lda, amode, pm0; };
struct StaticOrder {
    int nM, nN, nwg, G, c;
    __device__ void init(int M, int N, int G_, int c_) { nM = M / BM; nN = N / BM; nwg = nM * nN; G = G_; c = c_; }
    __device__ bool next(int i, Unit& u) const {
        const long L = (long)i * G + c; if (L >= nwg) return false;
        int wgid = (int)L; { const int q = nwg / NXCD, r = nwg % NXCD, xcd = wgid % NXCD, off = wgid / NXCD; wgid = (xcd < r ? xcd * (q + 1) : r * (q + 1) + (xcd - r) * q) + off; }
        const int nig = WGM * nN, gid = wgid / nig, fm = gid * WGM, gsz = (nM - fm) < WGM ? (nM - fm) : WGM;
        u.pm = fm + ((wgid % nig) % gsz); u.pn = (wgid % nig) / gsz; return true;
    }
};

struct Epi {
    int mode, pm0, j;
    unsigned char* ws; float* out; const float* bias0; const float* bias1; const float* bias2;
    __device__ __forceinline__ void operator()(const f32x4 (&acc)[2][2][4][2], const Unit& u, int wr, int wc, int fr, int fq) const {
        const int rowl0 = u.pm * BM + wr * 64 + fr;
        const int colt = u.pn * BM + wc * 32 + 8 * fq;
#pragma unroll
        for (int ai = 0; ai < 2; ++ai)
#pragma unroll
            for (int m = 0; m < 4; ++m) {
                const int rowl = rowl0 + ai * HALF + m * 16;
                const int rowg = rowl + pm0 * BM;
#pragma unroll
                for (int bj = 0; bj < 2; ++bj) {
                    const int col = colt + bj * HALF;
                    f32x4 v0 = acc[ai][bj][m][0], v1 = acc[ai][bj][m][1];
                    if (mode == E_RPROJ) {
                        if (u.pn < 12) {
                            h16* dst = (h16*)(ws + (u.pn < 4 ? R_R16 : (u.pn < 8 ? R_K16 : (j == 0 ? OFF_VF : R_V16))));
                            *(u32x4*)(dst + (size_t)rowg * 1024 + (col & 1023)) = pack8(v0, v1);
                        } else {
                            const int hc = col - 3072;
                            if (hc < 64) {
#pragma unroll
                                for (int jj = 0; jj < 4; ++jj) { v0[jj] = tanhf(v0[jj]); v1[jj] = tanhf(v1[jj]); }
                            } else if (hc >= 160) {
#pragma unroll
                                for (int jj = 0; jj < 4; ++jj) { v0[jj] = sigmoidf_(v0[jj]); v1[jj] = sigmoidf_(v1[jj]); }
                            }
                            *(u32x4*)((h16*)(ws + R_HACT) + (size_t)rowg * 512 + hc) = pack8(v0, v1);
                        }
                    } else if (mode == E_LORA2) {
                        const int grp = u.pn >> 2, c = col & 1023;
                        const size_t off = (size_t)rowg * 1024 + c;
                        if (grp == 0) {
                            const f32x4 ba = *(const f32x4*)(bias0 + c), bb = *(const f32x4*)(bias0 + c + 4);
#pragma unroll
                            for (int jj = 0; jj < 4; ++jj) { v0[jj] = sigmoidf_(v0[jj] + ba[jj]) * 0.6065306597f; v1[jj] = sigmoidf_(v1[jj] + bb[jj]) * 0.6065306597f; }
                            *(u32x4*)((h16*)out + off) = pack8(v0, v1);
                        } else if (grp == 1) {
                            const f32x4 ba = *(const f32x4*)(bias1 + c), bb = *(const f32x4*)(bias1 + c + 4);
#pragma unroll
                            for (int jj = 0; jj < 4; ++jj) { v0[jj] = sigmoidf_(v0[jj] + ba[jj]); v1[jj] = sigmoidf_(v1[jj] + bb[jj]); }
                            *(u32x4*)((h16*)out + (size_t)MTOK * 1024 + off) = pack8(v0, v1);
                        } else if (grp == 2) {
                            *(u32x4*)((h16*)(ws + R_G16) + off) = pack8(v0, v1);
                        } else {
                            const f32x4 ba = *(const f32x4*)(bias2 + c), bb = *(const f32x4*)(bias2 + c + 4);
                            float vv[8], vf8[8];
                            h16* vp = (h16*)(ws + R_V16) + off;
                            unpack8(*(const u32x4*)vp, vv); unpack8(*(const u32x4*)((const h16*)(ws + OFF_VF) + off), vf8);
#pragma unroll
                            for (int jj = 0; jj < 4; ++jj) {
                                v0[jj] = vv[jj] + (vf8[jj] - vv[jj]) * sigmoidf_(v0[jj] + ba[jj]);
                                v1[jj] = vv[4 + jj] + (vf8[4 + jj] - vv[4 + jj]) * sigmoidf_(v1[jj] + bb[jj]);
                            }
                            *(u32x4*)vp = pack8(v0, v1);
                        }
                    } else if (mode == E_RESID) {
                        float xr[8];
                        unpack8(*(const u32x4*)((const h16*)(ws + OFF_X16) + xrow(rowg) * 1024 + col), xr);
                        f32x4 r0, r1;
#pragma unroll
                        for (int jj = 0; jj < 4; ++jj) { r0[jj] = DN_ALPHA * xr[jj] + v0[jj]; r1[jj] = DN_ALPHA * xr[4 + jj] + v1[jj]; }
                        float* dp = out + (size_t)rowg * 1024 + col;
                        *(f32x4*)dp = r0; *(f32x4*)(dp + 4) = r1;
                    } else if (mode == E_ST16) {
                        *(u32x4*)((h16*)(ws + F_U16) + (size_t)rowl * 5632 + col) = pack8(v0, v1);
                    } else if (mode == E_ST32) {
                        float* dp = (float*)(ws + D_HIN) + (size_t)rowg * 512 + col;
                        *(f32x4*)dp = v0; *(f32x4*)(dp + 4) = v1;
                    } else {
                        if (u.pn < 8) *(u32x4*)((h16*)(ws + D_QABS) + (size_t)rowg * 2048 + col) = pack8(v0, v1);
                        else *(u32x4*)((h16*)(ws + D_QIDX) + (size_t)rowg * 512 + (col - 2048)) = pack8(v0, v1);
                    }
                }
            }
    }
};

__device__ __forceinline__ const char* a_tile(const Gemm& g, int pm) {
    if (g.amode == 1) { const int row = (pm + g.pm0) * BM; return (const char*)g.A + xrow(row) * 2048; }
    return (const char*)g.A + (size_t)pm * BM * g.lda * 2;
}

__device__ __forceinline__ void gemm_phase(LAS unsigned char* lds, const Gemm g, const StaticOrder& S, const Epi& E) {
    const int tid = opaque_tid(), wid = __builtin_amdgcn_readfirstlane(tid >> 6), lane = tid & 63, wr = wid >> 2, wc = wid & 3, fr = lane & 15, fq = lane >> 4;
    const int K = g.K, nt = K / BK;
    const bool shiftA = (g.amode == 1);
    unsigned voffA[2], voffB[2];
#pragma unroll
    for (int i = 0; i < 2; ++i) { int R, C; stage_rc(tid * 16 + i * 8192, R, C); const int Rb = (R & ~31) + perm32(R & 31);
        voffA[i] = (unsigned)(R * g.lda + C) * 2u; voffB[i] = (unsigned)(Rb * K + C) * 2u; }
    const size_t kstep = (size_t)(BK * 2);
    const size_t hstepA = (size_t)HALF * g.lda * 2;
    const size_t hstepB = (size_t)HALF * K * 2;
    const size_t tstepB = 2 * hstepB;
    const unsigned ldsw = (unsigned)wid * 1024u;
    const int aoff = lds_byte(wr * 64 + fr, fq * 8), boff = lds_byte(wc * 32 + fr, fq * 8);
#define PG8_KOFF(kt) ((size_t)(kt) * kstep - ((shiftA && (kt) >= 16) ? (size_t)4096 : (size_t)0))
#define PG8_SA(b, h) (((b) * 2 + (h)) * HTB)
#define PG8_SB(b, h) ((4 + (b) * 2 + (h)) * HTB)
#define PG8_STAGE(bufoff, gbase, voff) do { _Pragma("unroll") for (int _i = 0; _i < 2; ++_i) \
        __builtin_amdgcn_global_load_lds((const unsigned*)((const char*)(gbase) + (voff)[_i]), (LAS unsigned*)(lds + (bufoff) + ldsw + _i * 8192), 16, 0, 0); } while (0)
#define PG8_LDA(dst, b, h) do { _Pragma("unroll") for (int m = 0; m < 4; ++m) _Pragma("unroll") for (int k = 0; k < 2; ++k) dst[m][k] = *(const LAS h16x8*)(lds + PG8_SA(b, h) + aoff + m * 2048 + k * 1024); } while (0)
#define PG8_LDB(dst, b, h) do { _Pragma("unroll") for (int n = 0; n < 2; ++n) _Pragma("unroll") for (int k = 0; k < 2; ++k) dst[n][k] = *(const LAS h16x8*)(lds + PG8_SB(b, h) + boff + n * 2048 + k * 1024); } while (0)
#define PG8_MMA(ai, bj, At, Bt) do { __builtin_amdgcn_s_setprio(1); _Pragma("unroll") for (int m = 0; m < 4; ++m) _Pragma("unroll") for (int n = 0; n < 2; ++n) _Pragma("unroll") for (int k = 0; k < 2; ++k) \
        acc[ai][bj][m][n] = __builtin_amdgcn_mfma_f32_16x16x32_f16(Bt[n][k], At[m][k], acc[ai][bj][m][n], 0, 0, 0); __builtin_amdgcn_s_setprio(0); } while (0)
#define PG8_WAIT_V(n) asm volatile("s_waitcnt vmcnt(" #n ")" ::: "memory")
#define PG8_WAIT_L(n) asm volatile("s_waitcnt lgkmcnt(" #n ")" ::: "memory")
#define PG8_BAR __builtin_amdgcn_s_barrier()
#define PG8_SCHED __builtin_amdgcn_sched_barrier(0)
    Unit cur, nxt; int ui = 0;
    if (!S.next(0, cur)) return;
    f32x4 acc[2][2][4][2];
#pragma unroll
    for (int a = 0; a < 2; ++a)
#pragma unroll
        for (int b = 0; b < 2; ++b)
#pragma unroll
            for (int m = 0; m < 4; ++m)
#pragma unroll
                for (int n = 0; n < 2; ++n) acc[a][b][m][n] = (f32x4){0.f, 0.f, 0.f, 0.f};
    h16x8 At[4][2], B0[2][2], B1[2][2];
    const char* cA = a_tile(g, cur.pm); const char* cB = (const char*)g.Bt + (size_t)cur.pn * tstepB;
    PG8_STAGE(PG8_SB(0, 0), cB, voffB); PG8_STAGE(PG8_SA(0, 0), cA, voffA); PG8_STAGE(PG8_SB(0, 1), cB + hstepB, voffB); PG8_STAGE(PG8_SA(0, 1), cA + hstepA, voffA);
    if (wr == 1) PG8_BAR;
    PG8_WAIT_V(4); PG8_BAR;
    PG8_STAGE(PG8_SB(1, 0), cB + kstep, voffB); PG8_STAGE(PG8_SA(1, 0), cA + kstep, voffA); PG8_STAGE(PG8_SB(1, 1), cB + hstepB + kstep, voffB);
    PG8_WAIT_V(6); PG8_BAR;
    for (;;) {
        const bool has_next = S.next(ui + 1, nxt);
        const char* nA = has_next ? a_tile(g, nxt.pm) : cA; const char* nB = has_next ? (const char*)g.Bt + (size_t)nxt.pn * tstepB : cB;
        for (int t = 0; t < nt; t += 2) {
            const bool last = (t == nt - 2);
            const char* a1 = cA + PG8_KOFF(t + 1);
            const char* a2 = last ? nA : cA + PG8_KOFF(t + 2); const char* b2 = last ? nB : cB + (size_t)(t + 2) * kstep;
            const char* a3 = a2 + kstep; const char* b3 = b2 + kstep;
            PG8_LDB(B0, 0, 0); PG8_SCHED; PG8_LDA(At, 0, 0); PG8_STAGE(PG8_SA(1, 1), a1 + hstepA, voffA);
            PG8_WAIT_L(8); PG8_BAR; PG8_WAIT_L(0); PG8_MMA(0, 0, At, B0); PG8_BAR; PG8_SCHED;
            PG8_LDB(B1, 0, 1); PG8_STAGE(PG8_SB(0, 0), b2, voffB);
            PG8_BAR; PG8_WAIT_L(0); PG8_MMA(0, 1, At, B1); PG8_BAR;
            PG8_LDA(At, 0, 1); PG8_STAGE(PG8_SA(0, 0), a2, voffA);
            PG8_BAR; PG8_WAIT_L(0); PG8_MMA(1, 0, At, B0); PG8_BAR; PG8_SCHED;
            PG8_STAGE(PG8_SB(0, 1), b2 + hstepB, voffB);
            PG8_WAIT_V(6); PG8_BAR; PG8_MMA(1, 1, At, B1); PG8_BAR;
            PG8_LDB(B0, 1, 0); PG8_SCHED; PG8_LDA(At, 1, 0); PG8_STAGE(PG8_SA(0, 1), a2 + hstepA, voffA);
            PG8_WAIT_L(8); PG8_BAR; PG8_WAIT_L(0); PG8_MMA(0, 0, At, B0); PG8_BAR; PG8_SCHED;
            PG8_LDB(B1, 1, 1); PG8_STAGE(PG8_SB(1, 0), b3, voffB);
            PG8_BAR; PG8_WAIT_L(0); PG8_MMA(0, 1, At, B1); PG8_BAR;
            PG8_LDA(At, 1, 1); PG8_STAGE(PG8_SA(1, 0), a3, voffA);
            PG8_BAR; PG8_WAIT_L(0); PG8_MMA(1, 0, At, B0); PG8_BAR; PG8_SCHED;
            PG8_STAGE(PG8_SB(1, 1), b3 + hstepB, voffB);
            PG8_WAIT_V(6); PG8_BAR; PG8_MMA(1, 1, At, B1); PG8_BAR;
        }
        E(acc, cur, wr, wc, fr, fq);
        if (!has_next) break;
#pragma unroll
        for (int a = 0; a < 2; ++a)
#pragma unroll
            for (int b = 0; b < 2; ++b)
#pragma unroll
                for (int m = 0; m < 4; ++m)
#pragma unroll
                    for (int n = 0; n < 2; ++n) acc[a][b][m][n] = (f32x4){0.f, 0.f, 0.f, 0.f};
        cur = nxt; cA = nA; cB = nB; ++ui;
    }
    PG8_WAIT_V(0);
    if (wr == 0) PG8_BAR;
    PG8_BAR;
#undef PG8_KOFF
#undef PG8_SA
#undef PG8_SB
#undef PG8_STAGE
#undef PG8_LDA
#undef PG8_LDB
#undef PG8_MMA
#undef PG8_WAIT_V
#undef PG8_WAIT_L
#undef PG8_BAR
#undef PG8_SCHED
}
}

struct TJob { int mode; const float* src; int ld, K, N; h16* dst; int ldd, koff; const float* mix; };

__device__ __forceinline__ TJob get_job(const Params& p, int id) {
    TJob J; J.mode = 0; J.src = nullptr; J.ld = 0; J.K = 0; J.N = 0; J.dst = nullptr; J.ldd = 64; J.koff = 0; J.mix = nullptr;
    h16* W = (h16*)(p.ws + OFF_W);
    if (id < 24) {
        const int j = id / 12, s = id % 12;
        h16* Wbig = W + (size_t)j * (10 * MiB); h16* Wl2 = Wbig + 7 * MiB;
        const float* mix = p.in[3] + j * 6 * 1024;
        J.mode = 1; J.ld = 1024; J.K = 1024; J.ldd = 2048;
        if (s < 3) { J.src = p.in[4] + (size_t)(j * 3 + s) * 1048576; J.N = 1024; J.dst = Wbig + (size_t)s * 1024 * 2048; J.mix = mix + s * 1024; }
        else if (s == 3) { J.src = p.in[6] + (size_t)j * 65536; J.ld = 64; J.N = 64; J.dst = Wbig + (size_t)3072 * 2048; J.mix = mix + 3 * 1024; }
        else if (s == 4) { J.src = p.in[9] + (size_t)j * 65536; J.ld = 64; J.N = 64; J.dst = Wbig + (size_t)3136 * 2048; J.mix = mix + 4 * 1024; }
        else if (s == 5) { J.N = 32; J.dst = Wbig + (size_t)3200 * 2048; if (j == 1) { J.src = p.in[12]; J.ld = 32; J.mix = mix + 2 * 1024; } else { J.mode = 2; } }
        else if (s == 6) { J.src = p.in[14] + (size_t)j * 163840; J.ld = 160; J.N = 160; J.dst = Wbig + (size_t)3232 * 2048; J.mix = mix + 5 * 1024; }
        else if (s == 7) { J.mode = 2; J.N = 192; J.dst = Wbig + (size_t)3392 * 2048; }
        else {
            J.mode = 0; J.ld = 1024; J.N = 1024; J.ldd = 512;
            if (s == 8) { J.src = p.in[7] + (size_t)j * 65536; J.K = 64; J.koff = 0; J.dst = Wl2; }
            else if (s == 9) { J.src = p.in[10] + (size_t)j * 65536; J.K = 64; J.koff = 64; J.dst = Wl2 + (size_t)1024 * 512; }
            else if (s == 10) { J.src = p.in[15] + (size_t)j * 163840; J.K = 160; J.koff = 160; J.dst = Wl2 + (size_t)2048 * 512; }
            else { J.src = p.in[13]; J.K = 32; J.koff = 128; J.dst = Wl2 + (size_t)3072 * 512; if (j == 0) J.N = 0; }
        }
    } else if (id < 26) {
        const int j = id - 24;
        J.src = p.in[21] + (size_t)j * 1048576; J.ld = 1024; J.K = 1024; J.N = 1024; J.dst = W + (size_t)j * (10 * MiB) + 9 * MiB; J.ldd = 1024;
    } else if (id < 34) {
        const int i = (id - 26) >> 1, s = (id - 26) & 1;
        h16* base = W + 20 * MiB + (size_t)i * (17 * MiB / 2);
        if (s == 0) { J.src = p.in[33] + (size_t)i * 1024 * 5632; J.ld = 5632; J.K = 1024; J.N = 5632; J.dst = base; J.ldd = 1024; }
        else { J.src = p.in[36] + (size_t)i * 2816 * 1024; J.ld = 1024; J.K = 2816; J.N = 1024; J.dst = base + (size_t)11 * MiB / 2; J.ldd = 2816; }
    } else {
        const int j = (id - 34) >> 2, s = (id - 34) & 3;
        h16* base = W + 54 * MiB + (size_t)j * (5 * MiB / 2);
        if (s == 0) { J.src = p.in[22] + (size_t)j * 1024 * 456; J.ld = 456; J.K = 1024; J.N = 456; J.dst = base; J.ldd = 1024; }
        else if (s == 1) { J.mode = 2; J.N = 56; J.dst = base + (size_t)456 * 1024; J.ldd = 1024; }
        else if (s == 2) { J.src = p.in[28] + (size_t)j * 256 * 512; J.ld = 512; J.K = 256; J.N = 512; J.dst = base + MiB / 2 + (size_t)2048 * 256; J.ldd = 256; }
        else { J.src = p.in[31] + (size_t)j * 1048576; J.ld = 1024; J.K = 1024; J.N = 1024; J.dst = base + 3 * MiB / 2; J.ldd = 1024; }
    }
    return J;
}
__device__ __forceinline__ h16* w_rwkv_big(unsigned char* ws, int j) { return (h16*)(ws + OFF_W) + (size_t)j * (10 * MiB); }
__device__ __forceinline__ h16* w_rwkv_l2(unsigned char* ws, int j) { return w_rwkv_big(ws, j) + 7 * MiB; }
__device__ __forceinline__ h16* w_rwkv_o(unsigned char* ws, int j) { return w_rwkv_big(ws, j) + 9 * MiB; }
__device__ __forceinline__ h16* w_ffn_up(unsigned char* ws, int i) { return (h16*)(ws + OFF_W) + 20 * MiB + (size_t)i * (17 * MiB / 2); }
__device__ __forceinline__ h16* w_ffn_dn(unsigned char* ws, int i) { return w_ffn_up(ws, i) + (size_t)11 * MiB / 2; }
__device__ __forceinline__ h16* w_dsa_in(unsigned char* ws, int j) { return (h16*)(ws + OFF_W) + 54 * MiB + (size_t)j * (5 * MiB / 2); }
__device__ __forceinline__ h16* w_dsa_q(unsigned char* ws, int j) { return w_dsa_in(ws, j) + MiB / 2; }
__device__ __forceinline__ h16* w_dsa_uvt(unsigned char* ws, int j) { return w_dsa_in(ws, j) + 5 * MiB / 4; }
__device__ __forceinline__ h16* w_dsa_o(unsigned char* ws, int j) { return w_dsa_in(ws, j) + 3 * MiB / 2; }

__device__ __forceinline__ void prep_phase(const Params& p, unsigned char* smem) {
    const int tid = opaque_tid();
    const size_t gtid = (size_t)blockIdx.x * 512 + tid, nth = (size_t)gridDim.x * 512;
    h16* x16 = (h16*)(p.ws + OFF_X16);
    for (size_t idx = gtid; idx < (size_t)MTOK * 128; idx += nth) {
        const int row = (int)(idx >> 7), c8 = (int)(idx & 127) * 8;
        const float* sp = p.in[0] + (size_t)row * 1024 + c8;
        const f32x4 a = *(const f32x4*)sp, b = *(const f32x4*)(sp + 4);
        *(u32x4*)(x16 + xrow(row) * 1024 + c8) = pack8(a, b);
    }
    for (size_t idx = gtid; idx < (size_t)NBATCH * 128; idx += nth) {
        const int b = (int)(idx >> 7), c8 = (int)(idx & 127) * 8;
        *(u32x4*)(x16 + (size_t)b * 2049 * 1024 + c8) = (u32x4){0u, 0u, 0u, 0u};
    }
    for (size_t idx = gtid; idx < (size_t)2 * 2048 * 256; idx += nth) {
        const int j = (int)(idx >> 19), rem = (int)(idx & 524287), n = rem >> 8, q = rem & 255, h = n >> 7, c = n & 127;
        const float* uq = p.in[25] + (size_t)j * 256 * 1024 + (size_t)q * 1024 + h * 64;
        const float* uk = p.in[26] + (size_t)j * 16 * 64 * 128 + (size_t)h * 64 * 128 + c;
        float s = 0.f;
        for (int d = 0; d < 64; ++d) s += uq[d] * uk[d * 128];
        w_dsa_q(p.ws, j)[(size_t)n * 256 + q] = (h16)(s * 0.125f);
    }
    for (size_t idx = gtid; idx < (size_t)2 * 16 * 64 * 128; idx += nth) {
        const int j = (int)(idx >> 17), rem = (int)(idx & 131071), h = rem >> 13, n = (rem >> 7) & 63, k = rem & 127;
        w_dsa_uvt(p.ws, j)[(size_t)(h * 64 + n) * 128 + k] = (h16)p.in[27][(size_t)((j * 16 + h) * 128 + k) * 64 + n];
    }
    float* tile = (float*)smem;
    for (int id = 0; id < 42; ++id) {
        const TJob J = get_job(p, id);
        const int tk = J.ldd >> 6, tn = (J.N + 63) >> 6, ntile = tk * tn;
        for (int tix = blockIdx.x; tix < ntile; tix += gridDim.x) {
            const int k0 = (tix % tk) * 64, n0 = (tix / tk) * 64;
#pragma unroll
            for (int i = 0; i < 8; ++i) {
                const int k = i * 8 + (tid >> 6), n = tid & 63, kk = k0 + k, nn = n0 + n;
                float v = 0.f;
                if (nn < J.N && J.mode != 2) {
                    if (J.mode == 1) { const int ks = kk & 1023; const float mx = J.mix[ks]; v = J.src[(size_t)ks * J.ld + nn] * (kk < 1024 ? 1.0f - mx : mx); }
                    else if (kk >= J.koff && kk < J.koff + J.K) v = J.src[(size_t)(kk - J.koff) * J.ld + nn];
                }
                tile[k * 65 + n] = v;
            }
            __syncthreads();
#pragma unroll
            for (int i = 0; i < 8; ++i) {
                const int n = i * 8 + (tid >> 6), k = tid & 63, nn = n0 + n;
                if (nn < J.N) J.dst[(size_t)nn * J.ldd + k0 + k] = (h16)tile[k * 65 + n];
            }
            __syncthreads();
        }
    }
}

__device__ __forceinline__ void ln_phase(const Params& p, const float* g, const float* b, bool final_out) {
    const int tid = opaque_tid();
    const int lane = tid & 63, wave = tid >> 6;
    float* tb = p.out;
    h16* x16 = (h16*)(p.ws + OFF_X16);
    f32x4 gg[4], bb[4];
#pragma unroll
    for (int i = 0; i < 4; ++i) { gg[i] = *(const f32x4*)(g + i * 256 + lane * 4); bb[i] = *(const f32x4*)(b + i * 256 + lane * 4); }
    for (int row = blockIdx.x * 8 + wave; row < MTOK; row += gridDim.x * 8) {
        float* rp = tb + (size_t)row * 1024;
        f32x4 v[4];
        float s = 0.f;
#pragma unroll
        for (int i = 0; i < 4; ++i) { v[i] = *(const f32x4*)(rp + i * 256 + lane * 4); s += v[i][0] + v[i][1] + v[i][2] + v[i][3]; }
        const float mu = wave_sum(s) * (1.0f / 1024.0f);
        float q = 0.f;
#pragma unroll
        for (int i = 0; i < 4; ++i)
#pragma unroll
            for (int j = 0; j < 4; ++j) { const float d = v[i][j] - mu; q += d * d; }
        const float rstd = rsqrtf(wave_sum(q) * (1.0f / 1024.0f) + 1e-5f);
#pragma unroll
        for (int i = 0; i < 4; ++i) {
            f32x4 y;
#pragma unroll
            for (int j = 0; j < 4; ++j) y[j] = (v[i][j] - mu) * rstd * gg[i][j] + bb[i][j];
            if (final_out) *(f32x4*)(rp + i * 256 + lane * 4) = y;
            else { u32x2 w; w.x = pk2(y[0], y[1]); w.y = pk2(y[2], y[3]); *(u32x2*)(x16 + xrow(row) * 1024 + i * 256 + lane * 4) = w; }
        }
    }
}

__device__ __forceinline__ void conv_phase(const Params& p, int layer) {
    const h16* u = (const h16*)(p.ws + F_U16);
    h16* act = (h16*)(p.ws + F_ACT);
    const float* cw = p.in[34] + (size_t)layer * 3 * 5632;
    const float* cb = p.in[35] + (size_t)layer * 5632;
    const size_t gtid = (size_t)blockIdx.x * 512 + opaque_tid(), nth = (size_t)gridDim.x * 512;
    const size_t ntask = (size_t)2048 * 704;
    for (size_t task = gtid; task < ntask; task += nth) {
        const int cgp = (int)(task % 704), rc = (int)(task / 704), f = cgp * 4, r0 = rc * 16;
        f32x4 wg[3], wv[3];
#pragma unroll
        for (int j = 0; j < 3; ++j) { wg[j] = *(const f32x4*)(cw + j * 5632 + f); wv[j] = *(const f32x4*)(cw + j * 5632 + DFF + f); }
        const f32x4 bg = *(const f32x4*)(cb + f), bv = *(const f32x4*)(cb + DFF + f);
        f32x4 g2 = {0.f, 0.f, 0.f, 0.f}, g1 = g2, v2 = g2, v1 = g2;
        if ((r0 & 2047) != 0) {
            const h16x4 a = *(const h16x4*)(u + (size_t)(r0 - 2) * 5632 + f), b = *(const h16x4*)(u + (size_t)(r0 - 1) * 5632 + f);
            const h16x4 c = *(const h16x4*)(u + (size_t)(r0 - 2) * 5632 + DFF + f), d = *(const h16x4*)(u + (size_t)(r0 - 1) * 5632 + DFF + f);
#pragma unroll
            for (int j = 0; j < 4; ++j) { g2[j] = (float)a[j]; g1[j] = (float)b[j]; v2[j] = (float)c[j]; v1[j] = (float)d[j]; }
        }
        for (int i = 0; i < 16; ++i) {
            const size_t ro = (size_t)(r0 + i) * 5632;
            const h16x4 a = *(const h16x4*)(u + ro + f), c = *(const h16x4*)(u + ro + DFF + f);
            f32x4 g0, v0;
#pragma unroll
            for (int j = 0; j < 4; ++j) { g0[j] = (float)a[j]; v0[j] = (float)c[j]; }
            u32x2 w; float o[4];
#pragma unroll
            for (int j = 0; j < 4; ++j) {
                const float G = wg[0][j] * g2[j] + wg[1][j] * g1[j] + wg[2][j] * g0[j] + bg[j];
                const float V = wv[0][j] * v2[j] + wv[1][j] * v1[j] + wv[2][j] * v0[j] + bv[j];
                o[j] = G * sigmoidf_(G) * V;
            }
            w.x = pk2(o[0], o[1]); w.y = pk2(o[2], o[3]);
            *(u32x2*)(act + (size_t)(r0 + i) * DFF + f) = w;
            g2 = g1; g1 = g0; v2 = v1; v1 = v0;
        }
    }
}

__device__ __forceinline__ void scan_phase(const Params& p, int j, unsigned char* smem) {
    const int tid = opaque_tid();
    const int wave = tid >> 6, lane = tid & 63;
    if (wave >= 2) return;
    float* L = (float*)(smem + wave * 40960);
    float* OPS = L;
    float* VB = L + 5120;
    float* GB = L + 6144;
    float* YB = L + 7168;
    float* BON = L + 8192;
    h16* r16 = (h16*)(p.ws + R_R16);
    const h16* k16 = (const h16*)(p.ws + R_K16);
    const h16* v16 = (j == 0) ? (const h16*)(p.ws + OFF_VF) : (const h16*)(p.ws + R_V16);
    const h16* g16 = (const h16*)(p.ws + R_G16);
    const h16* e16 = (const h16*)p.out;
    const h16* a16 = (const h16*)p.out + (size_t)MTOK * 1024;
    const float* kkw = p.in[16] + j * 1024; const float* kaw = p.in[17] + j * 1024; const float* rkw = p.in[18] + j * 1024;
    const float* lng = p.in[19] + j * 1024; const float* lnb = p.in[20] + j * 1024;
    const int tl = lane >> 2, qr = lane & 3;
    for (int chain = blockIdx.x * 2 + wave; chain < 512; chain += gridDim.x * 2) {
        const int b = chain >> 4, h = chain & 15;
        const int cbase = h * 64 + qr * 16;
        f32x2 S[32];
#pragma unroll
        for (int i = 0; i < 32; ++i) S[i] = (f32x2){0.f, 0.f};
        u32x4 pr[6][2];
        {
            const size_t go = ((size_t)(b * 2048 + tl)) * 1024 + cbase;
#pragma unroll
            for (int x = 0; x < 2; ++x) {
                pr[0][x] = *(const u32x4*)(r16 + go + x * 8); pr[1][x] = *(const u32x4*)(k16 + go + x * 8); pr[2][x] = *(const u32x4*)(v16 + go + x * 8);
                pr[3][x] = *(const u32x4*)(e16 + go + x * 8); pr[4][x] = *(const u32x4*)(a16 + go + x * 8); pr[5][x] = *(const u32x4*)(g16 + go + x * 8);
            }
        }
        for (int ch = 0; ch < 128; ++ch) {
            {
                float kf[16], af[16], tmp[16], c1[16];
                unpack8(pr[1][0], kf); unpack8(pr[1][1], kf + 8);
                unpack8(pr[4][0], af); unpack8(pr[4][1], af + 8);
#pragma unroll
                for (int i = 0; i < 4; ++i) { const f32x4 t4 = *(const f32x4*)(kkw + cbase + i * 4); c1[i * 4] = t4[0]; c1[i * 4 + 1] = t4[1]; c1[i * 4 + 2] = t4[2]; c1[i * 4 + 3] = t4[3]; }
                float ss = 0.f;
#pragma unroll
                for (int i = 0; i < 16; ++i) { tmp[i] = kf[i] * c1[i]; ss += tmp[i] * tmp[i]; }
                ss += __shfl_xor(ss, 1); ss += __shfl_xor(ss, 2);
                const float inv = 1.0f / fmaxf(sqrtf(ss), 1e-12f);
                float* o = OPS + tl * 320 + qr * 16;
#pragma unroll
                for (int i = 0; i < 4; ++i) {
                    f32x4 A4, B4;
#pragma unroll
                    for (int q = 0; q < 4; ++q) { const float kk = tmp[i * 4 + q] * inv; A4[q] = -kk; B4[q] = kk * af[i * 4 + q]; }
                    *(f32x4*)(o + i * 4) = A4; *(f32x4*)(o + 64 + i * 4) = B4;
                }
#pragma unroll
                for (int i = 0; i < 4; ++i) { const f32x4 t4 = *(const f32x4*)(kaw + cbase + i * 4); c1[i * 4] = t4[0]; c1[i * 4 + 1] = t4[1]; c1[i * 4 + 2] = t4[2]; c1[i * 4 + 3] = t4[3]; }
#pragma unroll
                for (int i = 0; i < 16; ++i) kf[i] = kf[i] * (1.0f + (af[i] - 1.0f) * c1[i]);
#pragma unroll
                for (int i = 0; i < 4; ++i) *(f32x4*)(o + 192 + i * 4) = (f32x4){kf[i * 4], kf[i * 4 + 1], kf[i * 4 + 2], kf[i * 4 + 3]};
                unpack8(pr[0][0], af); unpack8(pr[0][1], af + 8);
#pragma unroll
                for (int i = 0; i < 4; ++i) { const f32x4 t4 = *(const f32x4*)(rkw + cbase + i * 4); c1[i * 4] = t4[0]; c1[i * 4 + 1] = t4[1]; c1[i * 4 + 2] = t4[2]; c1[i * 4 + 3] = t4[3]; }
                float bs = 0.f;
#pragma unroll
                for (int i = 0; i < 16; ++i) bs += af[i] * kf[i] * c1[i];
                bs += __shfl_xor(bs, 1); bs += __shfl_xor(bs, 2);
                if (qr == 0) BON[tl] = bs;
#pragma unroll
                for (int i = 0; i < 4; ++i) *(f32x4*)(o + 256 + i * 4) = (f32x4){af[i * 4], af[i * 4 + 1], af[i * 4 + 2], af[i * 4 + 3]};
                unpack8(pr[3][0], af); unpack8(pr[3][1], af + 8);
#pragma unroll
                for (int i = 0; i < 4; ++i) *(f32x4*)(o + 128 + i * 4) = (f32x4){__expf(-af[i * 4]), __expf(-af[i * 4 + 1]), __expf(-af[i * 4 + 2]), __expf(-af[i * 4 + 3])};
                unpack8(pr[2][0], af); unpack8(pr[2][1], af + 8);
#pragma unroll
                for (int i = 0; i < 4; ++i) *(f32x4*)(VB + tl * 64 + qr * 16 + i * 4) = (f32x4){af[i * 4], af[i * 4 + 1], af[i * 4 + 2], af[i * 4 + 3]};
                unpack8(pr[5][0], af); unpack8(pr[5][1], af + 8);
#pragma unroll
                for (int i = 0; i < 4; ++i) *(f32x4*)(GB + tl * 64 + qr * 16 + i * 4) = (f32x4){af[i * 4], af[i * 4 + 1], af[i * 4 + 2], af[i * 4 + 3]};
            }
            if (ch + 1 < 128) {
                const size_t go = ((size_t)(b * 2048 + (ch + 1) * 16 + tl)) * 1024 + cbase;
#pragma unroll
                for (int x = 0; x < 2; ++x) {
                    pr[0][x] = *(const u32x4*)(r16 + go + x * 8); pr[1][x] = *(const u32x4*)(k16 + go + x * 8); pr[2][x] = *(const u32x4*)(v16 + go + x * 8);
                    pr[3][x] = *(const u32x4*)(e16 + go + x * 8); pr[4][x] = *(const u32x4*)(a16 + go + x * 8); pr[5][x] = *(const u32x4*)(g16 + go + x * 8);
                }
            }
            asm volatile("s_waitcnt lgkmcnt(0)" ::: "memory");
            for (int t = 0; t < 16; ++t) {
                const float* op = OPS + t * 320;
                f32x2 s0 = {0.f, 0.f}, s1 = {0.f, 0.f};
#pragma unroll
                for (int k4 = 0; k4 < 16; ++k4) {
                    const f32x4 a4 = *(const f32x4*)(op + k4 * 4);
                    s0 += S[2 * k4] * (f32x2){a4[0], a4[1]}; s1 += S[2 * k4 + 1] * (f32x2){a4[2], a4[3]};
                }
                const float sa = (s0[0] + s0[1]) + (s1[0] + s1[1]);
                const float vv = VB[t * 64 + lane];
                const f32x2 sa2 = {sa, sa}, vv2 = {vv, vv};
#pragma unroll
                for (int k4 = 0; k4 < 16; ++k4) {
                    const f32x4 b4 = *(const f32x4*)(op + 64 + k4 * 4), w4 = *(const f32x4*)(op + 128 + k4 * 4), c4 = *(const f32x4*)(op + 192 + k4 * 4);
                    S[2 * k4] = S[2 * k4] * (f32x2){w4[0], w4[1]} + sa2 * (f32x2){b4[0], b4[1]} + vv2 * (f32x2){c4[0], c4[1]};
                    S[2 * k4 + 1] = S[2 * k4 + 1] * (f32x2){w4[2], w4[3]} + sa2 * (f32x2){b4[2], b4[3]} + vv2 * (f32x2){c4[2], c4[3]};
                }
                f32x2 y0 = {0.f, 0.f}, y1 = {0.f, 0.f};
#pragma unroll
                for (int k4 = 0; k4 < 16; ++k4) {
                    const f32x4 r4 = *(const f32x4*)(op + 256 + k4 * 4);
                    y0 += S[2 * k4] * (f32x2){r4[0], r4[1]}; y1 += S[2 * k4 + 1] * (f32x2){r4[2], r4[3]};
                }
                YB[t * 64 + lane] = (y0[0] + y0[1]) + (y1[0] + y1[1]);
            }
            asm volatile("s_waitcnt lgkmcnt(0)" ::: "memory");
            {
                float y[16];
                float s = 0.f;
#pragma unroll
                for (int i = 0; i < 4; ++i) { const f32x4 t4 = *(const f32x4*)(YB + tl * 64 + qr * 16 + i * 4); y[i * 4] = t4[0]; y[i * 4 + 1] = t4[1]; y[i * 4 + 2] = t4[2]; y[i * 4 + 3] = t4[3]; s += (t4[0] + t4[1]) + (t4[2] + t4[3]); }
                s += __shfl_xor(s, 1); s += __shfl_xor(s, 2);
                const float mu = s * (1.0f / 64.0f);
                float q = 0.f;
#pragma unroll
                for (int i = 0; i < 16; ++i) { const float d = y[i] - mu; q += d * d; }
                q += __shfl_xor(q, 1); q += __shfl_xor(q, 2);
                const float rstd = rsqrtf(q * (1.0f / 64.0f) + 64e-5f);
                const float bon = BON[tl];
                float o16[16];
#pragma unroll
                for (int i = 0; i < 4; ++i) {
                    const f32x4 lg = *(const f32x4*)(lng + cbase + i * 4), lb = *(const f32x4*)(lnb + cbase + i * 4);
                    const f32x4 v4 = *(const f32x4*)(VB + tl * 64 + qr * 16 + i * 4), g4 = *(const f32x4*)(GB + tl * 64 + qr * 16 + i * 4);
#pragma unroll
                    for (int q4 = 0; q4 < 4; ++q4) o16[i * 4 + q4] = ((y[i * 4 + q4] - mu) * rstd * lg[q4] + lb[q4] + bon * v4[q4]) * g4[q4];
                }
                const size_t go = ((size_t)(b * 2048 + ch * 16 + tl)) * 1024 + cbase;
                *(u32x4*)(r16 + go) = pack8((f32x4){o16[0], o16[1], o16[2], o16[3]}, (f32x4){o16[4], o16[5], o16[6], o16[7]});
                *(u32x4*)(r16 + go + 8) = pack8((f32x4){o16[8], o16[9], o16[10], o16[11]}, (f32x4){o16[12], o16[13], o16[14], o16[15]});
            }
            asm volatile("s_waitcnt lgkmcnt(0)" ::: "memory");
        }
    }
}

__device__ __forceinline__ void dsa_norm_phase(const Params& p, int j, unsigned char* smem) {
    const int tid = opaque_tid();
    const int lane = tid & 63, wave = tid >> 6;
    const float* hin = (const float*)(p.ws + D_HIN);
    h16* cq = (h16*)(p.ws + D_CQ); h16* ckv = (h16*)(p.ws + D_CKV); h16* ckvt = (h16*)(p.ws + D_CKVT); h16* kidx = (h16*)(p.ws + D_KIDX);
    float* widx = (float*)(p.ws + D_WIDX);
    const f32x4 gq = *(const f32x4*)(p.in[23] + j * 256 + lane * 4);
    const f32x2 gkv = *(const f32x2*)(p.in[24] + j * 128 + lane * 2);
    const float gi = p.in[29][j * 64 + lane], bi = p.in[30][j * 64 + lane];
    h16* wl = (h16*)(smem + wave * 2048);
    for (int grp = blockIdx.x * 8 + wave; grp < MTOK / 8; grp += gridDim.x * 8) {
        const int r0 = grp * 8;
        for (int i = 0; i < 8; ++i) {
            const int row = r0 + i;
            const float* hp = hin + (size_t)row * 512;
            const f32x4 vq = *(const f32x4*)(hp + lane * 4);
            const f32x2 vk = *(const f32x2*)(hp + 256 + lane * 2);
            const float vi = hp[384 + lane];
            float ssq = wave_sum(vq[0] * vq[0] + vq[1] * vq[1] + vq[2] * vq[2] + vq[3] * vq[3]);
            const float rq = rsqrtf(ssq * (1.0f / 256.0f) + 1e-6f);
            u32x2 w; w.x = pk2(vq[0] * rq * gq[0], vq[1] * rq * gq[1]); w.y = pk2(vq[2] * rq * gq[2], vq[3] * rq * gq[3]);
            *(u32x2*)(cq + (size_t)row * 256 + lane * 4) = w;
            float ssk = wave_sum(vk[0] * vk[0] + vk[1] * vk[1]);
            const float rk = rsqrtf(ssk * (1.0f / 128.0f) + 1e-6f);
            const unsigned wk = pk2(vk[0] * rk * gkv[0], vk[1] * rk * gkv[1]);
            *(unsigned*)(ckv + (size_t)row * 128 + lane * 2) = wk;
            *(unsigned*)(wl + i * 128 + lane * 2) = wk;
            const float mu = wave_sum(vi) * (1.0f / 64.0f);
            const float dv = vi - mu;
            const float var = wave_sum(dv * dv) * (1.0f / 64.0f);
            kidx[(size_t)row * 64 + lane] = (h16)(dv * rsqrtf(var + 1e-5f) * gi + bi);
            if (lane < 8) widx[(size_t)row * 8 + lane] = hp[448 + lane] * 0.044194173824159216f;
        }
        asm volatile("s_waitcnt lgkmcnt(0)" ::: "memory");
        const int b = r0 >> 11, t0 = r0 & 2047;
#pragma unroll
        for (int dd = 0; dd < 2; ++dd) {
            const int d = lane * 2 + dd;
            h16x8 hv;
#pragma unroll
            for (int i = 0; i < 8; ++i) hv[i] = wl[i * 128 + d];
            *(h16x8*)(ckvt + ((size_t)(b * 128 + d)) * 2048 + t0) = hv;
        }
        asm volatile("s_waitcnt lgkmcnt(0)" ::: "memory");
    }
}

constexpr int ROWP = 2052;
__device__ __forceinline__ unsigned fkey(float x) {
    if (x == 0.0f) x = 0.0f;
    const unsigned u = __float_as_uint(x);
    return (u & 0x80000000u) ? ~u : (u | 0x80000000u);
}
__device__ __forceinline__ void dsa_index_phase(const Params& p, unsigned char* smem) {
    const int tid = opaque_tid(), wave = tid >> 6, lane = tid & 63, r = lane & 15, q = lane >> 4;
    float* SC = (float*)smem;
    const h16* qidx = (const h16*)(p.ws + D_QIDX);
    const h16* kidx = (const h16*)(p.ws + D_KIDX);
    const float* widx = (const float*)(p.ws + D_WIDX);
    unsigned* maskb = (unsigned*)(p.ws + D_MASK);
    for (int qt = blockIdx.x; qt < MTOK / 16; qt += gridDim.x) {
        const int row0 = qt * 16, b = row0 >> 11, t0 = row0 & 2047;
        const int nkt = (t0 >> 4) + 1;
        {
            h16x8 qf[8][2]; float wq[8];
#pragma unroll
            for (int h = 0; h < 8; ++h) {
#pragma unroll
                for (int kk = 0; kk < 2; ++kk) qf[h][kk] = *(const h16x8*)(qidx + (size_t)(row0 + r) * 512 + h * 64 + kk * 32 + q * 8);
                wq[h] = widx[(size_t)(row0 + r) * 8 + h];
            }
            for (int kt = wave; kt < nkt; kt += 8) {
                const int s0 = kt * 16;
                const h16* kp = kidx + (size_t)(b * 2048 + s0 + r) * 64 + q * 8;
                const h16x8 k0 = *(const h16x8*)kp, k1 = *(const h16x8*)(kp + 32);
                f32x4 sc = {0.f, 0.f, 0.f, 0.f};
#pragma unroll
                for (int h = 0; h < 8; ++h) {
                    f32x4 acc = {0.f, 0.f, 0.f, 0.f};
                    acc = __builtin_amdgcn_mfma_f32_16x16x32_f16(k0, qf[h][0], acc, 0, 0, 0);
                    acc = __builtin_amdgcn_mfma_f32_16x16x32_f16(k1, qf[h][1], acc, 0, 0, 0);
#pragma unroll
                    for (int jj = 0; jj < 4; ++jj) sc[jj] += fmaxf(acc[jj], 0.f) * wq[h];
                }
                *(f32x4*)(SC + r * ROWP + s0 + q * 4) = sc;
            }
        }
        __syncthreads();
        for (int qq = 0; qq < 2; ++qq) {
            const int ql = wave * 2 + qq, t = t0 + ql;
            const float* srow = SC + ql * ROWP;
            const int ni = (t >> 6) + 1;
            unsigned u[32];
#pragma unroll
            for (int i = 0; i < 32; ++i) {
                u[i] = 0u;
                if (i < ni) { const int s = i * 64 + lane; if (s <= t) u[i] = fkey(srow[s]); }
            }
            unsigned myw = 0u;
            if (t < 256) {
#pragma unroll
                for (int i = 0; i < 32; ++i) { const unsigned long long sm = __ballot(u[i] != 0u); if ((lane >> 1) == i) myw = (lane & 1) ? (unsigned)(sm >> 32) : (unsigned)sm; }
            } else {
                unsigned T = 0u;
                for (int bit = 31; bit >= 0; --bit) {
                    const unsigned cand = T | (1u << bit);
                    int cnt = 0;
#pragma unroll
                    for (int i = 0; i < 32; ++i) if (i < ni) cnt += __popcll(__ballot(u[i] >= cand));
                    if (cnt >= 256) T = cand;
                }
                int cgt = 0;
#pragma unroll
                for (int i = 0; i < 32; ++i) if (i < ni) cgt += __popcll(__ballot(u[i] > T));
                const int need = 256 - cgt;
                int running = 0;
                const unsigned long long lt = (lane == 0) ? 0ull : (~0ull >> (64 - lane));
#pragma unroll
                for (int i = 0; i < 32; ++i) {
                    if (i < ni) {
                        const unsigned long long eq = __ballot(u[i] == T);
                        const int rank = running + __popcll(eq & lt);
                        const unsigned long long sm = __ballot(u[i] > T || (u[i] == T && rank < need));
                        running += __popcll(eq);
                        if ((lane >> 1) == i) myw = (lane & 1) ? (unsigned)(sm >> 32) : (unsigned)sm;
                    }
                }
            }
            maskb[(size_t)(row0 + ql) * 64 + lane] = myw;
        }
        __syncthreads();
    }
}

__device__ __forceinline__ void dsa_attn_phase(const Params& p, int j, unsigned char* smem) {
    const int tid = opaque_tid(), wave = tid >> 6, lane = tid & 63, r = lane & 15, q = lane >> 4;
    float* BL = (float*)smem;
    for (int idx = tid; idx < 16 * 129; idx += 512) {
        const int h = idx / 129, d = idx % 129;
        int bk = d;
        if (d >= 16) { bk = 16 + (int)(logf((float)d * (1.0f / 16.0f)) / 2.0794415416798357f * 16.0f); bk = bk > 31 ? 31 : bk; }
        BL[h * 132 + d] = p.in[32][bk * 16 + h];
    }
    __syncthreads();
    const h16* qabs = (const h16*)(p.ws + D_QABS);
    const h16* ckv = (const h16*)(p.ws + D_CKV);
    const h16* ckvt = (const h16*)(p.ws + D_CKVT);
    const unsigned* maskb = (const unsigned*)(p.ws + D_MASK);
    h16* o16 = (h16*)(p.ws + D_O16);
    const h16* wuvt = w_dsa_uvt(p.ws, j);
    const float NINF = -__builtin_inff();
    for (int qt = blockIdx.x; qt < MTOK / 16; qt += gridDim.x) {
        const int row0 = qt * 16, b = row0 >> 11, t0 = row0 & 2047, nsteps = (t0 + 16 + 31) >> 5, tq = t0 + r;
        h16x8 qf[2][4];
#pragma unroll
        for (int hh = 0; hh < 2; ++hh)
#pragma unroll
            for (int kk = 0; kk < 4; ++kk) qf[hh][kk] = *(const h16x8*)(qabs + (size_t)(row0 + r) * 2048 + (2 * wave + hh) * 128 + kk * 32 + q * 8);
        f32x4 O[2][8];
#pragma unroll
        for (int hh = 0; hh < 2; ++hh)
#pragma unroll
            for (int dt = 0; dt < 8; ++dt) O[hh][dt] = (f32x4){0.f, 0.f, 0.f, 0.f};
        float mrun[2] = {NINF, NINF}, lrun[2] = {0.f, 0.f};
        for (int st = 0; st < nsteps; ++st) {
            const int s0 = st * 32;
            const unsigned mw = maskb[(size_t)(row0 + r) * 64 + st];
            f32x4 sc[2][2];
#pragma unroll
            for (int tt = 0; tt < 2; ++tt) {
                h16x8 kf[4];
#pragma unroll
                for (int kk = 0; kk < 4; ++kk) kf[kk] = *(const h16x8*)(ckv + (size_t)(b * 2048 + s0 + tt * 16 + r) * 128 + kk * 32 + q * 8);
#pragma unroll
                for (int hh = 0; hh < 2; ++hh) {
                    f32x4 acc = {0.f, 0.f, 0.f, 0.f};
#pragma unroll
                    for (int kk = 0; kk < 4; ++kk) acc = __builtin_amdgcn_mfma_f32_16x16x32_f16(kf[kk], qf[hh][kk], acc, 0, 0, 0);
                    sc[hh][tt] = acc;
                }
            }
            h16x8 pf[2]; float alpha[2];
#pragma unroll
            for (int hh = 0; hh < 2; ++hh) {
                const int h = 2 * wave + hh;
                float x[8]; float mx = NINF;
#pragma unroll
                for (int tt = 0; tt < 2; ++tt)
#pragma unroll
                    for (int jj = 0; jj < 4; ++jj) {
                        const int kix = tt * 16 + q * 4 + jj;
                        int dist = tq - (s0 + kix); dist = dist < 0 ? 0 : (dist > 128 ? 128 : dist);
                        const float v = sc[hh][tt][jj] + BL[h * 132 + dist];
                        const float xv = ((mw >> kix) & 1u) ? v : NINF;
                        x[tt * 4 + jj] = xv; mx = fmaxf(mx, xv);
                    }
                mx = fmaxf(mx, __shfl_xor(mx, 16)); mx = fmaxf(mx, __shfl_xor(mx, 32));
                const float mnew = fmaxf(mrun[hh], mx);
                const float mref = (mnew == NINF) ? 0.f : mnew;
                alpha[hh] = __expf(mrun[hh] - mref);
                mrun[hh] = mnew;
                float ps = 0.f;
#pragma unroll
                for (int i = 0; i < 8; ++i) { const float pv = __expf(x[i] - mref); ps += pv; pf[hh][i] = (h16)pv; }
                lrun[hh] = lrun[hh] * alpha[hh] + ps;
            }
#pragma unroll
            for (int dt = 0; dt < 8; ++dt) {
                const h16* vp = ckvt + (size_t)(b * 128 + dt * 16 + r) * 2048 + s0 + q * 4;
                const h16x4 lo = *(const h16x4*)vp, hi = *(const h16x4*)(vp + 16);
                const h16x8 vf = {lo[0], lo[1], lo[2], lo[3], hi[0], hi[1], hi[2], hi[3]};
#pragma unroll
                for (int hh = 0; hh < 2; ++hh) {
                    O[hh][dt] *= alpha[hh];
                    O[hh][dt] = __builtin_amdgcn_mfma_f32_16x16x32_f16(vf, pf[hh], O[hh][dt], 0, 0, 0);
                }
            }
        }
#pragma unroll
        for (int hh = 0; hh < 2; ++hh) {
            const int h = 2 * wave + hh;
            float lt = lrun[hh]; lt += __shfl_xor(lt, 16); lt += __shfl_xor(lt, 32);
            const float inv = 1.0f / lt;
#pragma unroll
            for (int vt = 0; vt < 4; ++vt) {
                f32x4 acc = {0.f, 0.f, 0.f, 0.f};
#pragma unroll
                for (int kk = 0; kk < 4; ++kk) {
                    const h16* ap = wuvt + (size_t)(h * 64 + vt * 16 + r) * 128 + kk * 32 + q * 4;
                    const h16x4 lo = *(const h16x4*)ap, hi = *(const h16x4*)(ap + 16);
                    const h16x8 a8 = {lo[0], lo[1], lo[2], lo[3], hi[0], hi[1], hi[2], hi[3]};
                    h16x8 b8;
#pragma unroll
                    for (int i = 0; i < 4; ++i) { b8[i] = (h16)(O[hh][2 * kk][i] * inv); b8[4 + i] = (h16)(O[hh][2 * kk + 1][i] * inv); }
                    acc = __builtin_amdgcn_mfma_f32_16x16x32_f16(a8, b8, acc, 0, 0, 0);
                }
                u32x2 w; w.x = pk2(acc[0], acc[1]); w.y = pk2(acc[2], acc[3]);
                *(u32x2*)(o16 + (size_t)(row0 + r) * 1024 + h * 64 + vt * 16 + q * 4) = w;
            }
        }
    }
    __syncthreads();
}

__global__ void __launch_bounds__(512) mega_fwd(Params p) {
    extern __shared__ __attribute__((aligned(16))) unsigned char smem[];
    cg::grid_group grid = cg::this_grid();
    unsigned char* ws = p.ws;
    h16* x16 = (h16*)(ws + OFF_X16);
    for (int ph = p.ph_lo; ph < p.ph_hi; ++ph) {
        const unsigned e = p.prog[ph];
        const int kind = e & 15, L = (e >> 4) & 3, sub = (e >> 6) & 1, j = L >> 1;
        const bool isgemm = (kind == K_R1 || kind == K_R2 || kind == K_R4 || kind == K_F1 || kind == K_F3 || kind == K_D1 || kind == K_D3 || kind == K_D6);
        if (isgemm) {
            pg8::Gemm g; pg8::Epi E;
            g.M = MTOK; g.N = 1024; g.K = 1024; g.lda = 1024; g.amode = 0; g.pm0 = 0; g.A = x16; g.Bt = x16;
            E.mode = E_RESID; E.pm0 = 0; E.j = j; E.ws = ws; E.out = p.out; E.bias0 = p.in[5] + j * 1024; E.bias1 = p.in[8] + j * 1024; E.bias2 = p.in[11];
            if (kind == K_R1) {
                g.Bt = w_rwkv_big(ws, j); g.N = 3584; g.K = 2048; g.amode = 1; E.mode = E_RPROJ;
            } else if (kind == K_R2) {
                g.A = (const h16*)(ws + R_HACT); g.Bt = w_rwkv_l2(ws, j); g.N = (j == 0) ? 3072 : 4096; g.K = 512; g.lda = 512; E.mode = E_LORA2;
            } else if (kind == K_R4) {
                g.A = (const h16*)(ws + R_R16); g.Bt = w_rwkv_o(ws, j);
            } else if (kind == K_F1) {
                g.Bt = w_ffn_up(ws, L); g.M = MTOK / 2; g.N = 5632; g.amode = 1; g.pm0 = sub * 128; E.mode = E_ST16;
            } else if (kind == K_F3) {
                g.A = (const h16*)(ws + F_ACT); g.Bt = w_ffn_dn(ws, L); g.M = MTOK / 2; g.K = 2816; g.lda = 2816; E.pm0 = sub * 128;
            } else if (kind == K_D1) {
                g.Bt = w_dsa_in(ws, j); g.N = 512; g.amode = 1; E.mode = E_ST32;
            } else if (kind == K_D3) {
                g.A = (const h16*)(ws + D_CQ); g.Bt = w_dsa_q(ws, j); g.N = 2560; g.K = 256; g.lda = 256; E.mode = E_QPROJ;
            } else {
                g.A = (const h16*)(ws + D_O16); g.Bt = w_dsa_o(ws, j);
            }
            pg8::StaticOrder S; S.init(g.M, g.N, (int)gridDim.x, (int)blockIdx.x);
#ifndef NO_GEMM
            pg8::gemm_phase((LAS unsigned char*)smem, g, S, E);
#endif
        } else if (kind == K_PREP) {
#ifndef NO_PREP
            prep_phase(p, smem);
#endif
        } else if (kind == K_R3) {
#ifndef NO_SCAN
            scan_phase(p, j, smem);
#endif
        } else if (kind == K_LN) {
#ifndef NO_LN
            ln_phase(p, p.in[1] + (L * 2 + sub) * 1024, p.in[2] + (L * 2 + sub) * 1024, L == 3 && sub == 1);
#endif
        } else if (kind == K_F2) {
#ifndef NO_CONV
            conv_phase(p, L);
#endif
        } else if (kind == K_D2) {
#ifndef NO_NORM
            dsa_norm_phase(p, j, smem);
#endif
        } else if (kind == K_D4) {
#ifndef NO_INDEX
            dsa_index_phase(p, smem);
#endif
        } else if (kind == K_D5) {
#ifndef NO_ATTN
            dsa_attn_phase(p, j, smem);
#endif
        }
        if (ph + 1 < p.ph_hi) grid.sync();
    }
}

extern "C" void kernel_launch(void* const* d_in, const int* in_sizes, int n_in, void* d_out, int out_size, void* d_ws, size_t ws_size, hipStream_t stream) {
    static int grid_blocks = 0;
    if (grid_blocks == 0) {
        if (n_in != 37 || ws_size < WS_NEED || out_size != MTOK * DM) { fprintf(stderr, "kernel_launch: unexpected problem (n_in %d ws %zu out %d)\n", n_in, ws_size, out_size); grid_blocks = -1; return; }
        int dev = 0, cus = 0, per_cu = 0;
        hipGetDevice(&dev);
        hipDeviceGetAttribute(&cus, hipDeviceAttributeMultiprocessorCount, dev);
        if (hipFuncSetAttribute((const void*)mega_fwd, hipFuncAttributeMaxDynamicSharedMemorySize, LDS_BYTES) != hipSuccess) { fprintf(stderr, "kernel_launch: hipFuncSetAttribute failed\n"); grid_blocks = -1; return; }
        hipOccupancyMaxActiveBlocksPerMultiprocessor(&per_cu, (const void*)mega_fwd, 512, LDS_BYTES);
        if (per_cu < 1) { fprintf(stderr, "kernel_launch: occupancy query says %d blocks/CU\n", per_cu); per_cu = 1; }
        (void)hipGetLastError();
        grid_blocks = cus * per_cu;
        fprintf(stderr, "kernel_launch: grid %d (cus %d x %d)\n", grid_blocks, cus, per_cu);
    }
    if (grid_blocks < 0) return;
    Params p{};
    for (int i = 0; i < 37; ++i) p.in[i] = (const float*)d_in[i];
    p.ws = (unsigned char*)d_ws; p.out = (float*)d_out;
    int np = 0;
    auto add = [&](int kind, int L, int sub) { p.prog[np++] = (unsigned char)(kind | (L << 4) | (sub << 6)); };
    add(K_PREP, 0, 0);
    for (int L = 0; L < 4; ++L) {
        if ((L & 1) == 0) { add(K_R1, L, 0); add(K_R2, L, 0); add(K_R3, L, 0); add(K_R4, L, 0); }
        else { add(K_D1, L, 0); add(K_D2, L, 0); add(K_D3, L, 0); add(K_D4, L, 0); add(K_D5, L, 0); add(K_D6, L, 0); }
        add(K_LN, L, 0);
        for (int c = 0; c < 2; ++c) { add(K_F1, L, c); add(K_F2, L, c); add(K_F3, L, c); }
        add(K_LN, L, 1);
    }
#if SINGLE_LAUNCH
    p.ph_lo = 0; p.ph_hi = np;
    void* args[] = {&p};
    hipError_t e = hipLaunchCooperativeKernel((const void*)mega_fwd, dim3(grid_blocks), dim3(512), args, LDS_BYTES, stream);
    if (e != hipSuccess) fprintf(stderr, "cooperative launch failed: %s (grid %d)\n", hipGetErrorString(e), grid_blocks);
#else
    for (int ph = 0; ph < np; ++ph) {
        p.ph_lo = ph; p.ph_hi = ph + 1;
        hipLaunchKernelGGL(mega_fwd, dim3(grid_blocks), dim3(512), LDS_BYTES, stream, p);
    }
#endif
}
```

```cpp
#include <hip/hip_runtime.h>
#include <hip/hip_cooperative_groups.h>
#include <cstdio>
namespace cg = cooperative_groups;

#ifndef SINGLE_LAUNCH
#define SINGLE_LAUNCH 1
#endif

#define LAS __attribute__((address_space(3)))
typedef _Float16 h16;
typedef _Float16 h16x8 __attribute__((ext_vector_type(8)));
typedef _Float16 h16x4 __attribute__((ext_vector_type(4)));
typedef _Float16 h16x2 __attribute__((ext_vector_type(2)));
typedef float f32x4 __attribute__((ext_vector_type(4)));
typedef float f32x2 __attribute__((ext_vector_type(2)));
typedef unsigned u32x4 __attribute__((ext_vector_type(4)));
typedef unsigned u32x2 __attribute__((ext_vector_type(2)));

constexpr int DM = 1024, SEQ = 2048, NBATCH = 32, MTOK = NBATCH * SEQ;
constexpr int DFF = 2816;
constexpr size_t MiB = (size_t)1 << 20;
constexpr float DN_ALPHA = 1.6817928305074290f;
constexpr int LDS_BYTES = 147456;

constexpr size_t OFF_W = 0;
constexpr size_t OFF_X16 = 118 * MiB;
constexpr size_t OFF_VF = 247 * MiB;
constexpr size_t OFF_R = 375 * MiB;
constexpr size_t WS_NEED = 951 * MiB;
constexpr size_t R_R16 = OFF_R, R_K16 = OFF_R + 128 * MiB, R_V16 = OFF_R + 256 * MiB, R_G16 = OFF_R + 384 * MiB, R_HACT = OFF_R + 512 * MiB;
constexpr size_t F_U16 = OFF_R, F_ACT = OFF_R + 352 * MiB;
constexpr size_t D_HIN = OFF_R, D_O16 = OFF_R, D_QABS = OFF_R + 128 * MiB, D_QIDX = OFF_R + 384 * MiB, D_CQ = OFF_R + 448 * MiB,
                 D_CKV = OFF_R + 480 * MiB, D_CKVT = OFF_R + 496 * MiB, D_KIDX = OFF_R + 512 * MiB, D_WIDX = OFF_R + 520 * MiB, D_MASK = OFF_R + 522 * MiB;

struct Params {
    const float* in[37];
    unsigned char* ws;
    float* out;
    int ph_lo, ph_hi;
    unsigned char prog[64];
};

enum { K_PREP = 0, K_R1, K_R2, K_R3, K_R4, K_LN, K_F1, K_F2, K_F3, K_D1, K_D2, K_D3, K_D4, K_D5, K_D6 };
enum { E_RPROJ = 0, E_LORA2, E_RESID, E_ST16, E_ST32, E_QPROJ };

__device__ __forceinline__ size_t xrow(int row) { return (size_t)(row >> 11) * 2049 + 1 + (row & 2047); }
__device__ __forceinline__ unsigned pk2(float a, float b) { h16x2 h = {(h16)a, (h16)b}; return __builtin_bit_cast(unsigned, h); }
__device__ __forceinline__ u32x4 pack8(f32x4 a, f32x4 b) { u32x4 w; w.x = pk2(a[0], a[1]); w.y = pk2(a[2], a[3]); w.z = pk2(b[0], b[1]); w.w = pk2(b[2], b[3]); return w; }
__device__ __forceinline__ void unpack8(u32x4 w, float* f) {
    h16x8 h = __builtin_bit_cast(h16x8, w);
#pragma unroll
    for (int i = 0; i < 8; ++i) f[i] = (float)h[i];
}
__device__ __forceinline__ float sigmoidf_(float x) { return 1.0f / (1.0f + __expf(-x)); }
__device__ __forceinline__ float wave_sum(float v) {
#pragma unroll
    for (int o = 32; o > 0; o >>= 1) v += __shfl_xor(v, o);
    return v;
}
#define WSYNC() asm volatile("s_waitcnt vmcnt(0) lgkmcnt(0)" ::: "memory")
__device__ __forceinline__ int opaque_tid() { int t = threadIdx.x; asm volatile("" : "+v"(t)); return t; }

namespace pg8 {
constexpr int BM = 256, BK = 64, HALF = 128, HTB = HALF * BK * 2, STAGE_BYTES = 8 * HTB, NXCD = 8, WGM = 8;
__device__ __forceinline__ int lds_byte(int r, int c) { const int st = (r >> 4) * 2 + (c >> 5), rr = r & 15, cc = c & 31, ob = rr * 64 + cc * 2; return st * 1024 + (ob ^ (((ob >> 9) & 1) << 5)); }
__device__ __forceinline__ void stage_rc(int b, int& R, int& C) { const int st = b / 1024, sb = b % 1024, swz = sb ^ (((sb >> 9) & 1) << 5); R = (st >> 1) * 16 + swz / 64; C = (st & 1) * 32 + (swz % 64) / 2; }
__device__ __forceinline__ int perm32(int rho) { const int n = rho >> 4, i = rho & 15; return 8 * (i >> 2) + 4 * n + (i & 3); }
struct Unit { int pm, pn; };
struct Gemm { const h16* A; const h16* Bt; int M, N, K, lda, amode, pm0; };
struct StaticOrder {
    int nM, nN, nwg, G, c;
    __device__ void init(int M, int N, int G_, int c_) { nM = M / BM; nN = N / BM; nwg = nM * nN; G = G_; c = c_; }
    __device__ bool next(int i, Unit& u) const {
        const long L = (long)i * G + c; if (L >= nwg) return false;
        int wgid = (int)L; { const int q = nwg / NXCD, r = nwg % NXCD, xcd = wgid % NXCD, off = wgid / NXCD; wgid = (xcd < r ? xcd * (q + 1) : r * (q + 1) + (xcd - r) * q) + off; }
        const int nig = WGM * nN, gid = wgid / nig, fm = gid * WGM, gsz = (nM - fm) < WGM ? (nM - fm) : WGM;
        u.pm = fm + ((wgid % nig) % gsz); u.pn = (wgid % nig) / gsz; return true;
    }
};

struct Epi {
    int mode, pm0, j;
    unsigned char* ws; float* out; const float* bias0; const float* bias1; const float* bias2;
    __device__ __forceinline__ void operator()(const f32x4 (&acc)[2][2][4][2], const Unit& u, int wr, int wc, int fr, int fq) const {
        const int rowl0 = u.pm * BM + wr * 64 + fr;
        const int colt = u.pn * BM + wc * 32 + 8 * fq;
#pragma unroll
        for (int ai = 0; ai < 2; ++ai)
#pragma unroll
            for (int m = 0; m < 4; ++m) {
                const int rowl = rowl0 + ai * HALF + m * 16;
                const int rowg = rowl + pm0 * BM;
#pragma unroll
                for (int bj = 0; bj < 2; ++bj) {
                    const int col = colt + bj * HALF;
                    f32x4 v0 = acc[ai][bj][m][0], v1 = acc[ai][bj][m][1];
                    if (mode == E_RPROJ) {
                        if (u.pn < 12) {
                            h16* dst = (h16*)(ws + (u.pn < 4 ? R_R16 : (u.pn < 8 ? R_K16 : (j == 0 ? OFF_VF : R_V16))));
                            *(u32x4*)(dst + (size_t)rowg * 1024 + (col & 1023)) = pack8(v0, v1);
                        } else {
                            const int hc = col - 3072;
                            if (hc < 64) {
#pragma unroll
                                for (int jj = 0; jj < 4; ++jj) { v0[jj] = tanhf(v0[jj]); v1[jj] = tanhf(v1[jj]); }
                            } else if (hc >= 160) {
#pragma unroll
                                for (int jj = 0; jj < 4; ++jj) { v0[jj] = sigmoidf_(v0[jj]); v1[jj] = sigmoidf_(v1[jj]); }
                            }
                            *(u32x4*)((h16*)(ws + R_HACT) + (size_t)rowg * 512 + hc) = pack8(v0, v1);
                        }
                    } else if (mode == E_LORA2) {
                        const int grp = u.pn >> 2, c = col & 1023;
                        const size_t off = (size_t)rowg * 1024 + c;
                        if (grp == 0) {
                            const f32x4 ba = *(const f32x4*)(bias0 + c), bb = *(const f32x4*)(bias0 + c + 4);
#pragma unroll
                            for (int jj = 0; jj < 4; ++jj) { v0[jj] = sigmoidf_(v0[jj] + ba[jj]) * 0.6065306597f; v1[jj] = sigmoidf_(v1[jj] + bb[jj]) * 0.6065306597f; }
                            *(u32x4*)((h16*)out + off) = pack8(v0, v1);
                        } else if (grp == 1) {
                            const f32x4 ba = *(const f32x4*)(bias1 + c), bb = *(const f32x4*)(bias1 + c + 4);
#pragma unroll
                            for (int jj = 0; jj < 4; ++jj) { v0[jj] = sigmoidf_(v0[jj] + ba[jj]); v1[jj] = sigmoidf_(v1[jj] + bb[jj]); }
                            *(u32x4*)((h16*)out + (size_t)MTOK * 1024 + off) = pack8(v0, v1);
                        } else if (grp == 2) {
                            *(u32x4*)((h16*)(ws + R_G16) + off) = pack8(v0, v1);
                        } else {
                            const f32x4 ba = *(const f32x4*)(bias2 + c), bb = *(const f32x4*)(bias2 + c + 4);
                            float vv[8], vf8[8];
                            h16* vp = (h16*)(ws + R_V16) + off;
                            unpack8(*(const u32x4*)vp, vv); unpack8(*(const u32x4*)((const h16*)(ws + OFF_VF) + off), vf8);
#pragma unroll
                            for (int jj = 0; jj < 4; ++jj) {
                                v0[jj] = vv[jj] + (vf8[jj] - vv[jj]) * sigmoidf_(v0[jj] + ba[jj]);
                                v1[jj] = vv[4 + jj] + (vf8[4 + jj] - vv[4 + jj]) * sigmoidf_(v1[jj] + bb[jj]);
                            }
                            *(u32x4*)vp = pack8(v0, v1);
                        }
                    } else if (mode == E_RESID) {
                        float xr[8];
                        unpack8(*(const u32x4*)((const h16*)(ws + OFF_X16) + xrow(rowg) * 1024 + col), xr);
                        f32x4 r0, r1;
#pragma unroll
                        for (int jj = 0; jj < 4; ++jj) { r0[jj] = DN_ALPHA * xr[jj] + v0[jj]; r1[jj] = DN_ALPHA * xr[4 + jj] + v1[jj]; }
                        float* dp = out + (size_t)rowg * 1024 + col;
                        *(f32x4*)dp = r0; *(f32x4*)(dp + 4) = r1;
                    } else if (mode == E_ST16) {
                        *(u32x4*)((h16*)(ws + F_U16) + (size_t)rowl * 5632 + col) = pack8(v0, v1);
                    } else if (mode == E_ST32) {
                        float* dp = (float*)(ws + D_HIN) + (size_t)rowg * 512 + col;
                        *(f32x4*)dp = v0; *(f32x4*)(dp + 4) = v1;
                    } else {
                        if (u.pn < 8) *(u32x4*)((h16*)(ws + D_QABS) + (size_t)rowg * 2048 + col) = pack8(v0, v1);
                        else *(u32x4*)((h16*)(ws + D_QIDX) + (size_t)rowg * 512 + (col - 2048)) = pack8(v0, v1);
                    }
                }
            }
    }
};

__device__ __forceinline__ const char* a_tile(const Gemm& g, int pm) {
    if (g.amode == 1) { const int row = (pm + g.pm0) * BM; return (const char*)g.A + xrow(row) * 2048; }
    return (const char*)g.A + (size_t)pm * BM * g.lda * 2;
}

__device__ __forceinline__ void gemm_phase(LAS unsigned char* lds, const Gemm g, const StaticOrder& S, const Epi& E) {
    const int tid = opaque_tid(), wid = __builtin_amdgcn_readfirstlane(tid >> 6), lane = tid & 63, wr = wid >> 2, wc = wid & 3, fr = lane & 15, fq = lane >> 4;
    const int K = g.K, nt = K / BK;
    const bool shiftA = (g.amode == 1);
    unsigned voffA[2], voffB[2];
#pragma unroll
    for (int i = 0; i < 2; ++i) { int R, C; stage_rc(tid * 16 + i * 8192, R, C); const int Rb = (R & ~31) + perm32(R & 31);
        voffA[i] = (unsigned)(R * g.lda + C) * 2u; voffB[i] = (unsigned)(Rb * K + C) * 2u; }
    const size_t kstep = (size_t)(BK * 2);
    const size_t hstepA = (size_t)HALF * g.lda * 2;
    const size_t hstepB = (size_t)HALF * K * 2;
    const size_t tstepB = 2 * hstepB;
    const unsigned ldsw = (unsigned)wid * 1024u;
    const int aoff = lds_byte(wr * 64 + fr, fq * 8), boff = lds_byte(wc * 32 + fr, fq * 8);
#define PG8_KOFF(kt) ((size_t)(kt) * kstep - ((shiftA && (kt) >= 16) ? (size_t)4096 : (size_t)0))
#define PG8_SA(b, h) (((b) * 2 + (h)) * HTB)
#define PG8_SB(b, h) ((4 + (b) * 2 + (h)) * HTB)
#define PG8_STAGE(bufoff, gbase, voff) do { _Pragma("unroll") for (int _i = 0; _i < 2; ++_i) \
        __builtin_amdgcn_global_load_lds((const unsigned*)((const char*)(gbase) + (voff)[_i]), (LAS unsigned*)(lds + (bufoff) + ldsw + _i * 8192), 16, 0, 0); } while (0)
#define PG8_LDA(dst, b, h) do { _Pragma("unroll") for (int m = 0; m < 4; ++m) _Pragma("unroll") for (int k = 0; k < 2; ++k) dst[m][k] = *(const LAS h16x8*)(lds + PG8_SA(b, h) + aoff + m * 2048 + k * 1024); } while (0)
#define PG8_LDB(dst, b, h) do { _Pragma("unroll") for (int n = 0; n < 2; ++n) _Pragma("unroll") for (int k = 0; k < 2; ++k) dst[n][k] = *(const LAS h16x8*)(lds + PG8_SB(b, h) + boff + n * 2048 + k * 1024); } while (0)
#define PG8_MMA(ai, bj, At, Bt) do { __builtin_amdgcn_s_setprio(1); _Pragma("unroll") for (int m = 0; m < 4; ++m) _Pragma("unroll") for (int n = 0; n < 2; ++n) _Pragma("unroll") for (int k = 0; k < 2; ++k) \
        acc[ai][bj][m][n] = __builtin_amdgcn_mfma_f32_16x16x32_f16(Bt[n][k], At[m][k], acc[ai][bj][m][n], 0, 0, 0); __builtin_amdgcn_s_setprio(0); } while (0)
#define PG8_WAIT_V(n) asm volatile("s_waitcnt vmcnt(" #n ")" ::: "memory")
#define PG8_WAIT_L(n) asm volatile("s_waitcnt lgkmcnt(" #n ")" ::: "memory")
#define PG8_BAR __builtin_amdgcn_s_barrier()
#define PG8_SCHED __builtin_amdgcn_sched_barrier(0)
    Unit cur, nxt; int ui = 0;
    if (!S.next(0, cur)) return;
    f32x4 acc[2][2][4][2];
#pragma unroll
    for (int a = 0; a < 2; ++a)
#pragma unroll
        for (int b = 0; b < 2; ++b)
#pragma unroll
            for (int m = 0; m < 4; ++m)
#pragma unroll
                for (int n = 0; n < 2; ++n) acc[a][b][m][n] = (f32x4){0.f, 0.f, 0.f, 0.f};
    h16x8 At[4][2], B0[2][2], B1[2][2];
    const char* cA = a_tile(g, cur.pm); const char* cB = (const char*)g.Bt + (size_t)cur.pn * tstepB;
    PG8_STAGE(PG8_SB(0, 0), cB, voffB); PG8_STAGE(PG8_SA(0, 0), cA, voffA); PG8_STAGE(PG8_SB(0, 1), cB + hstepB, voffB); PG8_STAGE(PG8_SA(0, 1), cA + hstepA, voffA);
    if (wr == 1) PG8_BAR;
    PG8_WAIT_V(4); PG8_BAR;
    PG8_STAGE(PG8_SB(1, 0), cB + kstep, voffB); PG8_STAGE(PG8_SA(1, 0), cA + kstep, voffA); PG8_STAGE(PG8_SB(1, 1), cB + hstepB + kstep, voffB);
    PG8_WAIT_V(6); PG8_BAR;
    for (;;) {
        const bool has_next = S.next(ui + 1, nxt);
        const char* nA = has_next ? a_tile(g, nxt.pm) : cA; const char* nB = has_next ? (const char*)g.Bt + (size_t)nxt.pn * tstepB : cB;
        for (int t = 0; t < nt; t += 2) {
            const bool last = (t == nt - 2);
            const char* a1 = cA + PG8_KOFF(t + 1);
            const char* a2 = last ? nA : cA + PG8_KOFF(t + 2); const char* b2 = last ? nB : cB + (size_t)(t + 2) * kstep;
            const char* a3 = a2 + kstep; const char* b3 = b2 + kstep;
            PG8_LDB(B0, 0, 0); PG8_SCHED; PG8_LDA(At, 0, 0); PG8_STAGE(PG8_SA(1, 1), a1 + hstepA, voffA);
            PG8_WAIT_L(8); PG8_BAR; PG8_WAIT_L(0); PG8_MMA(0, 0, At, B0); PG8_BAR; PG8_SCHED;
            PG8_LDB(B1, 0, 1); PG8_STAGE(PG8_SB(0, 0), b2, voffB);
            PG8_BAR; PG8_WAIT_L(0); PG8_MMA(0, 1, At, B1); PG8_BAR;
            PG8_LDA(At, 0, 1); PG8_STAGE(PG8_SA(0, 0), a2, voffA);
            PG8_BAR; PG8_WAIT_L(0); PG8_MMA(1, 0, At, B0); PG8_BAR; PG8_SCHED;
            PG8_STAGE(PG8_SB(0, 1), b2 + hstepB, voffB);
            PG8_WAIT_V(6); PG8_BAR; PG8_MMA(1, 1, At, B1); PG8_BAR;
            PG8_LDB(B0, 1, 0); PG8_SCHED; PG8_LDA(At, 1, 0); PG8_STAGE(PG8_SA(0, 1), a2 + hstepA, voffA);
            PG8_WAIT_L(8); PG8_BAR; PG8_WAIT_L(0); PG8_MMA(0, 0, At, B0); PG8_BAR; PG8_SCHED;
            PG8_LDB(B1, 1, 1); PG8_STAGE(PG8_SB(1, 0), b3, voffB);
            PG8_BAR; PG8_WAIT_L(0); PG8_MMA(0, 1, At, B1); PG8_BAR;
            PG8_LDA(At, 1, 1); PG8_STAGE(PG8_SA(1, 0), a3, voffA);
            PG8_BAR; PG8_WAIT_L(0); PG8_MMA(1, 0, At, B0); PG8_BAR; PG8_SCHED;
            PG8_STAGE(PG8_SB(1, 1), b3 + hstepB, voffB);
            PG8_WAIT_V(6); PG8_BAR; PG8_MMA(1, 1, At, B1); PG8_BAR;
        }
        E(acc, cur, wr, wc, fr, fq);
        if (!has_next) break;
#pragma unroll
        for (int a = 0; a < 2; ++a)
#pragma unroll
            for (int b = 0; b < 2; ++b)
#pragma unroll
                for (int m = 0; m < 4; ++m)
#pragma unroll
                    for (int n = 0; n < 2; ++n) acc[a][b][m][n] = (f32x4){0.f, 0.f, 0.f, 0.f};
        cur = nxt; cA = nA; cB = nB; ++ui;
    }
    PG8_WAIT_V(0);
    if (wr == 0) PG8_BAR;
    PG8_BAR;
#undef PG8_KOFF
#undef PG8_SA
#undef PG8_SB
#undef PG8_STAGE
#undef PG8_LDA
#undef PG8_LDB
#undef PG8_MMA
#undef PG8_WAIT_V
#undef PG8_WAIT_L
#undef PG8_BAR
#undef PG8_SCHED
}
}

struct TJob { int mode; const float* src; int ld, K, N; h16* dst; int ldd, koff; const float* mix; };

__device__ __forceinline__ TJob get_job(const Params& p, int id) {
    TJob J; J.mode = 0; J.src = nullptr; J.ld = 0; J.K = 0; J.N = 0; J.dst = nullptr; J.ldd = 64; J.koff = 0; J.mix = nullptr;
    h16* W = (h16*)(p.ws + OFF_W);
    if (id < 24) {
        const int j = id / 12, s = id % 12;
        h16* Wbig = W + (size_t)j * (10 * MiB); h16* Wl2 = Wbig + 7 * MiB;
        const float* mix = p.in[3] + j * 6 * 1024;
        J.mode = 1; J.ld = 1024; J.K = 1024; J.ldd = 2048;
        if (s < 3) { J.src = p.in[4] + (size_t)(j * 3 + s) * 1048576; J.N = 1024; J.dst = Wbig + (size_t)s * 1024 * 2048; J.mix = mix + s * 1024; }
        else if (s == 3) { J.src = p.in[6] + (size_t)j * 65536; J.ld = 64; J.N = 64; J.dst = Wbig + (size_t)3072 * 2048; J.mix = mix + 3 * 1024; }
        else if (s == 4) { J.src = p.in[9] + (size_t)j * 65536; J.ld = 64; J.N = 64; J.dst = Wbig + (size_t)3136 * 2048; J.mix = mix + 4 * 1024; }
        else if (s == 5) { J.N = 32; J.dst = Wbig + (size_t)3200 * 2048; if (j == 1) { J.src = p.in[12]; J.ld = 32; J.mix = mix + 2 * 1024; } else { J.mode = 2; } }
        else if (s == 6) { J.src = p.in[14] + (size_t)j * 163840; J.ld = 160; J.N = 160; J.dst = Wbig + (size_t)3232 * 2048; J.mix = mix + 5 * 1024; }
        else if (s == 7) { J.mode = 2; J.N = 192; J.dst = Wbig + (size_t)3392 * 2048; }
        else {
            J.mode = 0; J.ld = 1024; J.N = 1024; J.ldd = 512;
            if (s == 8) { J.src = p.in[7] + (size_t)j * 65536; J.K = 64; J.koff = 0; J.dst = Wl2; }
            else if (s == 9) { J.src = p.in[10] + (size_t)j * 65536; J.K = 64; J.koff = 64; J.dst = Wl2 + (size_t)1024 * 512; }
            else if (s == 10) { J.src = p.in[15] + (size_t)j * 163840; J.K = 160; J.koff = 160; J.dst = Wl2 + (size_t)2048 * 512; }
            else { J.src = p.in[13]; J.K = 32; J.koff = 128; J.dst = Wl2 + (size_t)3072 * 512; if (j == 0) J.N = 0; }
        }
    } else if (id < 26) {
        const int j = id - 24;
        J.src = p.in[21] + (size_t)j * 1048576; J.ld = 1024; J.K = 1024; J.N = 1024; J.dst = W + (size_t)j * (10 * MiB) + 9 * MiB; J.ldd = 1024;
    } else if (id < 34) {
        const int i = (id - 26) >> 1, s = (id - 26) & 1;
        h16* base = W + 20 * MiB + (size_t)i * (17 * MiB / 2);
        if (s == 0) { J.src = p.in[33] + (size_t)i * 1024 * 5632; J.ld = 5632; J.K = 1024; J.N = 5632; J.dst = base; J.ldd = 1024; }
        else { J.src = p.in[36] + (size_t)i * 2816 * 1024; J.ld = 1024; J.K = 2816; J.N = 1024; J.dst = base + (size_t)11 * MiB / 2; J.ldd = 2816; }
    } else {
        const int j = (id - 34) >> 2, s = (id - 34) & 3;
        h16* base = W + 54 * MiB + (size_t)j * (5 * MiB / 2);
        if (s == 0) { J.src = p.in[22] + (size_t)j * 1024 * 456; J.ld = 456; J.K = 1024; J.N = 456; J.dst = base; J.ldd = 1024; }
        else if (s == 1) { J.mode = 2; J.N = 56; J.dst = base + (size_t)456 * 1024; J.ldd = 1024; }
        else if (s == 2) { J.src = p.in[28] + (size_t)j * 256 * 512; J.ld = 512; J.K = 256; J.N = 512; J.dst = base + MiB / 2 + (size_t)2048 * 256; J.ldd = 256; }
        else { J.src = p.in[31] + (size_t)j * 1048576; J.ld = 1024; J.K = 1024; J.N = 1024; J.dst = base + 3 * MiB / 2; J.ldd = 1024; }
    }
    return J;
}
__device__ __forceinline__ h16* w_rwkv_big(unsigned char* ws, int j) { return (h16*)(ws + OFF_W) + (size_t)j * (10 * MiB); }
__device__ __forceinline__ h16* w_rwkv_l2(unsigned char* ws, int j) { return w_rwkv_big(ws, j) + 7 * MiB; }
__device__ __forceinline__ h16* w_rwkv_o(unsigned char* ws, int j) { return w_rwkv_big(ws, j) + 9 * MiB; }
__device__ __forceinline__ h16* w_ffn_up(unsigned char* ws, int i) { return (h16*)(ws + OFF_W) + 20 * MiB + (size_t)i * (17 * MiB / 2); }
__device__ __forceinline__ h16* w_ffn_dn(unsigned char* ws, int i) { return w_ffn_up(ws, i) + (size_t)11 * MiB / 2; }
__device__ __forceinline__ h16* w_dsa_in(unsigned char* ws, int j) { return (h16*)(ws + OFF_W) + 54 * MiB + (size_t)j * (5 * MiB / 2); }
__device__ __forceinline__ h16* w_dsa_q(unsigned char* ws, int j) { return w_dsa_in(ws, j) + MiB / 2; }
__device__ __forceinline__ h16* w_dsa_uvt(unsigned char* ws, int j) { return w_dsa_in(ws, j) + 5 * MiB / 4; }
__device__ __forceinline__ h16* w_dsa_o(unsigned char* ws, int j) { return w_dsa_in(ws, j) + 3 * MiB / 2; }

__device__ __forceinline__ void prep_phase(const Params& p, unsigned char* smem) {
    const int tid = opaque_tid();
    const size_t gtid = (size_t)blockIdx.x * 512 + tid, nth = (size_t)gridDim.x * 512;
    h16* x16 = (h16*)(p.ws + OFF_X16);
    for (size_t idx = gtid; idx < (size_t)MTOK * 128; idx += nth) {
        const int row = (int)(idx >> 7), c8 = (int)(idx & 127) * 8;
        const float* sp = p.in[0] + (size_t)row * 1024 + c8;
        const f32x4 a = *(const f32x4*)sp, b = *(const f32x4*)(sp + 4);
        *(u32x4*)(x16 + xrow(row) * 1024 + c8) = pack8(a, b);
    }
    for (size_t idx = gtid; idx < (size_t)NBATCH * 128; idx += nth) {
        const int b = (int)(idx >> 7), c8 = (int)(idx & 127) * 8;
        *(u32x4*)(x16 + (size_t)b * 2049 * 1024 + c8) = (u32x4){0u, 0u, 0u, 0u};
    }
    for (size_t idx = gtid; idx < (size_t)2 * 2048 * 256; idx += nth) {
        const int j = (int)(idx >> 19), rem = (int)(idx & 524287), n = rem >> 8, q = rem & 255, h = n >> 7, c = n & 127;
        const float* uq = p.in[25] + (size_t)j * 256 * 1024 + (size_t)q * 1024 + h * 64;
        const float* uk = p.in[26] + (size_t)j * 16 * 64 * 128 + (size_t)h * 64 * 128 + c;
        float s = 0.f;
        for (int d = 0; d < 64; ++d) s += uq[d] * uk[d * 128];
        w_dsa_q(p.ws, j)[(size_t)n * 256 + q] = (h16)(s * 0.125f);
    }
    for (size_t idx = gtid; idx < (size_t)2 * 16 * 64 * 128; idx += nth) {
        const int j = (int)(idx >> 17), rem = (int)(idx & 131071), h = rem >> 13, n = (rem >> 7) & 63, k = rem & 127;
        w_dsa_uvt(p.ws, j)[(size_t)(h * 64 + n) * 128 + k] = (h16)p.in[27][(size_t)((j * 16 + h) * 128 + k) * 64 + n];
    }
    float* tile = (float*)smem;
    for (int id = 0; id < 42; ++id) {
        const TJob J = get_job(p, id);
        const int tk = J.ldd >> 6, tn = (J.N + 63) >> 6, ntile = tk * tn;
        for (int tix = blockIdx.x; tix < ntile; tix += gridDim.x) {
            const int k0 = (tix % tk) * 64, n0 = (tix / tk) * 64;
#pragma unroll
            for (int i = 0; i < 8; ++i) {
                const int k = i * 8 + (tid >> 6), n = tid & 63, kk = k0 + k, nn = n0 + n;
                float v = 0.f;
                if (nn < J.N && J.mode != 2) {
                    if (J.mode == 1) { const int ks = kk & 1023; const float mx = J.mix[ks]; v = J.src[(size_t)ks * J.ld + nn] * (kk < 1024 ? 1.0f - mx : mx); }
                    else if (kk >= J.koff && kk < J.koff + J.K) v = J.src[(size_t)(kk - J.koff) * J.ld + nn];
                }
                tile[k * 65 + n] = v;
            }
            __syncthreads();
#pragma unroll
            for (int i = 0; i < 8; ++i) {
                const int n = i * 8 + (tid >> 6), k = tid & 63, nn = n0 + n;
                if (nn < J.N) J.dst[(size_t)nn * J.ldd + k0 + k] = (h16)tile[k * 65 + n];
            }
            __syncthreads();
        }
    }
}

__device__ __forceinline__ void ln_phase(const Params& p, const float* g, const float* b, bool final_out) {
    const int tid = opaque_tid();
    const int lane = tid & 63, wave = tid >> 6;
    float* tb = p.out;
    h16* x16 = (h16*)(p.ws + OFF_X16);
    f32x4 gg[4], bb[4];
#pragma unroll
    for (int i = 0; i < 4; ++i) { gg[i] = *(const f32x4*)(g + i * 256 + lane * 4); bb[i] = *(const f32x4*)(b + i * 256 + lane * 4); }
    for (int row = blockIdx.x * 8 + wave; row < MTOK; row += gridDim.x * 8) {
        float* rp = tb + (size_t)row * 1024;
        f32x4 v[4];
        float s = 0.f;
#pragma unroll
        for (int i = 0; i < 4; ++i) { v[i] = *(const f32x4*)(rp + i * 256 + lane * 4); s += v[i][0] + v[i][1] + v[i][2] + v[i][3]; }
        const float mu = wave_sum(s) * (1.0f / 1024.0f);
        float q = 0.f;
#pragma unroll
        for (int i = 0; i < 4; ++i)
#pragma unroll
            for (int j = 0; j < 4; ++j) { const float d = v[i][j] - mu; q += d * d; }
        const float rstd = rsqrtf(wave_sum(q) * (1.0f / 1024.0f) + 1e-5f);
#pragma unroll
        for (int i = 0; i < 4; ++i) {
            f32x4 y;
#pragma unroll
            for (int j = 0; j < 4; ++j) y[j] = (v[i][j] - mu) * rstd * gg[i][j] + bb[i][j];
            if (final_out) *(f32x4*)(rp + i * 256 + lane * 4) = y;
            else { u32x2 w; w.x = pk2(y[0], y[1]); w.y = pk2(y[2], y[3]); *(u32x2*)(x16 + xrow(row) * 1024 + i * 256 + lane * 4) = w; }
        }
    }
}

__device__ __forceinline__ void conv_phase(const Params& p, int layer) {
    const h16* u = (const h16*)(p.ws + F_U16);
    h16* act = (h16*)(p.ws + F_ACT);
    const float* cw = p.in[34] + (size_t)layer * 3 * 5632;
    const float* cb = p.in[35] + (size_t)layer * 5632;
    const size_t gtid = (size_t)blockIdx.x * 512 + opaque_tid(), nth = (size_t)gridDim.x * 512;
    const size_t ntask = (size_t)2048 * 704;
    for (size_t task = gtid; task < ntask; task += nth) {
        const int cgp = (int)(task % 704), rc = (int)(task / 704), f = cgp * 4, r0 = rc * 16;
        f32x4 wg[3], wv[3];
#pragma unroll
        for (int j = 0; j < 3; ++j) { wg[j] = *(const f32x4*)(cw + j * 5632 + f); wv[j] = *(const f32x4*)(cw + j * 5632 + DFF + f); }
        const f32x4 bg = *(const f32x4*)(cb + f), bv = *(const f32x4*)(cb + DFF + f);
        f32x4 g2 = {0.f, 0.f, 0.f, 0.f}, g1 = g2, v2 = g2, v1 = g2;
        if ((r0 & 2047) != 0) {
            const h16x4 a = *(const h16x4*)(u + (size_t)(r0 - 2) * 5632 + f), b = *(const h16x4*)(u + (size_t)(r0 - 1) * 5632 + f);
            const h16x4 c = *(const h16x4*)(u + (size_t)(r0 - 2) * 5632 + DFF + f), d = *(const h16x4*)(u + (size_t)(r0 - 1) * 5632 + DFF + f);
#pragma unroll
            for (int j = 0; j < 4; ++j) { g2[j] = (float)a[j]; g1[j] = (float)b[j]; v2[j] = (float)c[j]; v1[j] = (float)d[j]; }
        }
        for (int i = 0; i < 16; ++i) {
            const size_t ro = (size_t)(r0 + i) * 5632;
            const h16x4 a = *(const h16x4*)(u + ro + f), c = *(const h16x4*)(u + ro + DFF + f);
            f32x4 g0, v0;
#pragma unroll
            for (int j = 0; j < 4; ++j) { g0[j] = (float)a[j]; v0[j] = (float)c[j]; }
            u32x2 w; float o[4];
#pragma unroll
            for (int j = 0; j < 4; ++j) {
                const float G = wg[0][j] * g2[j] + wg[1][j] * g1[j] + wg[2][j] * g0[j] + bg[j];
                const float V = wv[0][j] * v2[j] + wv[1][j] * v1[j] + wv[2][j] * v0[j] + bv[j];
                o[j] = G * sigmoidf_(G) * V;
            }
            w.x = pk2(o[0], o[1]); w.y = pk2(o[2], o[3]);
            *(u32x2*)(act + (size_t)(r0 + i) * DFF + f) = w;
            g2 = g1; g1 = g0; v2 = v1; v1 = v0;
        }
    }
}

__device__ __forceinline__ float dppf(float x, const int ctrl_sel) {
    const int v = __builtin_bit_cast(int, x);
    int r;
    if (ctrl_sel == 0) r = __builtin_amdgcn_update_dpp(0, v, 0xB1, 0xF, 0xF, true);
    else if (ctrl_sel == 1) r = __builtin_amdgcn_update_dpp(0, v, 0x4E, 0xF, 0xF, true);
    else if (ctrl_sel == 2) r = __builtin_amdgcn_update_dpp(0, v, 0x141, 0xF, 0xF, true);
    else r = __builtin_amdgcn_update_dpp(0, v, 0x140, 0xF, 0xF, true);
    return __builtin_bit_cast(float, r);
}
__device__ __forceinline__ float red4(float x) { x += dppf(x, 0); x += dppf(x, 1); return x; }
__device__ __forceinline__ float red16(float x) { x += dppf(x, 0); x += dppf(x, 1); x += dppf(x, 2); x += dppf(x, 3); return x; }
__device__ __forceinline__ void unpack4(u32x2 w, float* f) {
    h16x4 h = __builtin_bit_cast(h16x4, w);
#pragma unroll
    for (int i = 0; i < 4; ++i) f[i] = (float)h[i];
}
constexpr int SCAN_BUF = 8256;
__device__ __forceinline__ void scan_phase(const Params& p, int j, unsigned char* smem) {
    const int tid = opaque_tid();
    const int wave = tid >> 6, lane = tid & 63, slot = wave >> 2, w4 = wave & 3;
    float* LB = (float*)smem + slot * (2 * SCAN_BUF);
    h16* r16 = (h16*)(p.ws + R_R16);
    const h16* k16 = (const h16*)(p.ws + R_K16);
    const h16* v16 = (j == 0) ? (const h16*)(p.ws + OFF_VF) : (const h16*)(p.ws + R_V16);
    const h16* g16 = (const h16*)(p.ws + R_G16);
    const h16* e16 = (const h16*)p.out;
    const h16* a16 = (const h16*)p.out + (size_t)MTOK * 1024;
    const int tp = w4 * 4 + (lane >> 4), k4 = (lane & 15) * 4;
    const int vrow = w4 * 16 + (lane >> 2), kq = lane & 3;
    for (int pair = blockIdx.x; pair < 256; pair += gridDim.x) {
        const int chain = pair * 2 + slot, b = chain >> 4, h = chain & 15;
        const int col = h * 64 + k4;
        const f32x4 c_kk = *(const f32x4*)(p.in[16] + j * 1024 + col), c_ka = *(const f32x4*)(p.in[17] + j * 1024 + col), c_rk = *(const f32x4*)(p.in[18] + j * 1024 + col);
        const f32x4 c_lg = *(const f32x4*)(p.in[19] + j * 1024 + col), c_lb = *(const f32x4*)(p.in[20] + j * 1024 + col);
        f32x2 S[8];
#pragma unroll
        for (int i = 0; i < 8; ++i) S[i] = (f32x2){0.f, 0.f};
        u32x2 pr[6];
        {
            const size_t go = ((size_t)(b * 2048 + tp)) * 1024 + col;
            pr[0] = *(const u32x2*)(r16 + go); pr[1] = *(const u32x2*)(k16 + go); pr[2] = *(const u32x2*)(v16 + go);
            pr[3] = *(const u32x2*)(e16 + go); pr[4] = *(const u32x2*)(a16 + go); pr[5] = *(const u32x2*)(g16 + go);
        }
        for (int ch = 0; ch < 128; ++ch) {
            float* BUF = LB + (ch & 1) * SCAN_BUF;
            float* OPS = BUF; float* VB = BUF + 5120; float* GB = BUF + 6144; float* YB = BUF + 7168; float* BON = BUF + 8192;
            {
                float rf[4], kf[4], vf[4], ef[4], af[4], gf[4];
                unpack4(pr[0], rf); unpack4(pr[1], kf); unpack4(pr[2], vf); unpack4(pr[3], ef); unpack4(pr[4], af); unpack4(pr[5], gf);
                float kk[4]; float ss = 0.f;
#pragma unroll
                for (int i = 0; i < 4; ++i) { kk[i] = kf[i] * c_kk[i]; ss += kk[i] * kk[i]; }
                ss = red16(ss);
                const float inv = 1.0f / fmaxf(sqrtf(ss), 1e-12f);
                f32x4 A4, B4, W4, K4, R4; float bs = 0.f;
#pragma unroll
                for (int i = 0; i < 4; ++i) {
                    const float kn = kk[i] * inv;
                    A4[i] = -kn; B4[i] = kn * af[i];
                    W4[i] = __expf(-ef[i]);
                    const float km = kf[i] * (1.0f + (af[i] - 1.0f) * c_ka[i]);
                    K4[i] = km; R4[i] = rf[i];
                    bs += rf[i] * km * c_rk[i];
                }
                bs = red16(bs);
                float* o = OPS + tp * 320 + k4;
                *(f32x4*)(o) = A4; *(f32x4*)(o + 64) = B4; *(f32x4*)(o + 128) = W4; *(f32x4*)(o + 192) = K4; *(f32x4*)(o + 256) = R4;
                *(f32x4*)(VB + tp * 64 + k4) = (f32x4){vf[0], vf[1], vf[2], vf[3]};
                *(f32x4*)(GB + tp * 64 + k4) = (f32x4){gf[0], gf[1], gf[2], gf[3]};
                if ((lane & 15) == 0) BON[tp] = bs;
            }
            if (ch + 1 < 128) {
                const size_t go = ((size_t)(b * 2048 + (ch + 1) * 16 + tp)) * 1024 + col;
                pr[0] = *(const u32x2*)(r16 + go); pr[1] = *(const u32x2*)(k16 + go); pr[2] = *(const u32x2*)(v16 + go);
                pr[3] = *(const u32x2*)(e16 + go); pr[4] = *(const u32x2*)(a16 + go); pr[5] = *(const u32x2*)(g16 + go);
            }
            __syncthreads();
#pragma unroll 2
            for (int t = 0; t < 16; ++t) {
                const float* op = OPS + t * 320 + kq * 16;
                f32x4 A4[4], B4[4], W4[4], K4[4], R4[4];
#pragma unroll
                for (int i = 0; i < 4; ++i) A4[i] = *(const f32x4*)(op + i * 4);
#pragma unroll
                for (int i = 0; i < 4; ++i) { W4[i] = *(const f32x4*)(op + 128 + i * 4); B4[i] = *(const f32x4*)(op + 64 + i * 4); K4[i] = *(const f32x4*)(op + 192 + i * 4); }
#pragma unroll
                for (int i = 0; i < 4; ++i) R4[i] = *(const f32x4*)(op + 256 + i * 4);
                const float vv = VB[t * 64 + vrow];
                f32x2 s0 = {0.f, 0.f}, s1 = {0.f, 0.f};
#pragma unroll
                for (int i = 0; i < 4; ++i) { s0 += S[2 * i] * (f32x2){A4[i][0], A4[i][1]}; s1 += S[2 * i + 1] * (f32x2){A4[i][2], A4[i][3]}; }
                const float sa = red4((s0[0] + s0[1]) + (s1[0] + s1[1]));
                const f32x2 sa2 = {sa, sa}, vv2 = {vv, vv};
#pragma unroll
                for (int i = 0; i < 4; ++i) {
                    S[2 * i] = S[2 * i] * (f32x2){W4[i][0], W4[i][1]} + sa2 * (f32x2){B4[i][0], B4[i][1]} + vv2 * (f32x2){K4[i][0], K4[i][1]};
                    S[2 * i + 1] = S[2 * i + 1] * (f32x2){W4[i][2], W4[i][3]} + sa2 * (f32x2){B4[i][2], B4[i][3]} + vv2 * (f32x2){K4[i][2], K4[i][3]};
                }
                f32x2 y0 = {0.f, 0.f}, y1 = {0.f, 0.f};
#pragma unroll
                for (int i = 0; i < 4; ++i) { y0 += S[2 * i] * (f32x2){R4[i][0], R4[i][1]}; y1 += S[2 * i + 1] * (f32x2){R4[i][2], R4[i][3]}; }
                const float y = red4((y0[0] + y0[1]) + (y1[0] + y1[1]));
                if (kq == 0) YB[t * 64 + vrow] = y;
            }
            __syncthreads();
            {
                const f32x4 y4 = *(const f32x4*)(YB + tp * 64 + k4), v4 = *(const f32x4*)(VB + tp * 64 + k4), g4 = *(const f32x4*)(GB + tp * 64 + k4);
                const float mu = red16((y4[0] + y4[1]) + (y4[2] + y4[3])) * (1.0f / 64.0f);
                float q = 0.f;
#pragma unroll
                for (int i = 0; i < 4; ++i) { const float d = y4[i] - mu; q += d * d; }
                const float rstd = rsqrtf(red16(q) * (1.0f / 64.0f) + 64e-5f);
                const float bon = BON[tp];
                float o[4];
#pragma unroll
                for (int i = 0; i < 4; ++i) o[i] = ((y4[i] - mu) * rstd * c_lg[i] + c_lb[i] + bon * v4[i]) * g4[i];
                u32x2 w; w.x = pk2(o[0], o[1]); w.y = pk2(o[2], o[3]);
                *(u32x2*)(r16 + ((size_t)(b * 2048 + ch * 16 + tp)) * 1024 + col) = w;
            }
        }
        __syncthreads();
    }
}

__device__ __forceinline__ void dsa_norm_phase(const Params& p, int j, unsigned char* smem) {
    const int tid = opaque_tid();
    const int lane = tid & 63, wave = tid >> 6;
    const float* hin = (const float*)(p.ws + D_HIN);
    h16* cq = (h16*)(p.ws + D_CQ); h16* ckv = (h16*)(p.ws + D_CKV); h16* ckvt = (h16*)(p.ws + D_CKVT); h16* kidx = (h16*)(p.ws + D_KIDX);
    float* widx = (float*)(p.ws + D_WIDX);
    const f32x4 gq = *(const f32x4*)(p.in[23] + j * 256 + lane * 4);
    const f32x2 gkv = *(const f32x2*)(p.in[24] + j * 128 + lane * 2);
    const float gi = p.in[29][j * 64 + lane], bi = p.in[30][j * 64 + lane];
    h16* wl = (h16*)(smem + wave * 2048);
    for (int grp = blockIdx.x * 8 + wave; grp < MTOK / 8; grp += gridDim.x * 8) {
        const int r0 = grp * 8;
        for (int i = 0; i < 8; ++i) {
            const int row = r0 + i;
            const float* hp = hin + (size_t)row * 512;
            const f32x4 vq = *(const f32x4*)(hp + lane * 4);
            const f32x2 vk = *(const f32x2*)(hp + 256 + lane * 2);
            const float vi = hp[384 + lane];
            float ssq = wave_sum(vq[0] * vq[0] + vq[1] * vq[1] + vq[2] * vq[2] + vq[3] * vq[3]);
            const float rq = rsqrtf(ssq * (1.0f / 256.0f) + 1e-6f);
            u32x2 w; w.x = pk2(vq[0] * rq * gq[0], vq[1] * rq * gq[1]); w.y = pk2(vq[2] * rq * gq[2], vq[3] * rq * gq[3]);
            *(u32x2*)(cq + (size_t)row * 256 + lane * 4) = w;
            float ssk = wave_sum(vk[0] * vk[0] + vk[1] * vk[1]);
            const float rk = rsqrtf(ssk * (1.0f / 128.0f) + 1e-6f);
            const unsigned wk = pk2(vk[0] * rk * gkv[0], vk[1] * rk * gkv[1]);
            *(unsigned*)(ckv + (size_t)row * 128 + lane * 2) = wk;
            *(unsigned*)(wl + i * 128 + lane * 2) = wk;
            const float mu = wave_sum(vi) * (1.0f / 64.0f);
            const float dv = vi - mu;
            const float var = wave_sum(dv * dv) * (1.0f / 64.0f);
            kidx[(size_t)row * 64 + lane] = (h16)(dv * rsqrtf(var + 1e-5f) * gi + bi);
            if (lane < 8) widx[(size_t)row * 8 + lane] = hp[448 + lane] * 0.044194173824159216f;
        }
        asm volatile("s_waitcnt lgkmcnt(0)" ::: "memory");
        const int b = r0 >> 11, t0 = r0 & 2047;
#pragma unroll
        for (int dd = 0; dd < 2; ++dd) {
            const int d = lane * 2 + dd;
            h16x8 hv;
#pragma unroll
            for (int i = 0; i < 8; ++i) hv[i] = wl[i * 128 + d];
            *(h16x8*)(ckvt + ((size_t)(b * 128 + d)) * 2048 + t0) = hv;
        }
        asm volatile("s_waitcnt lgkmcnt(0)" ::: "memory");
    }
}

constexpr int ROWP = 2052;
__device__ __forceinline__ unsigned fkey(float x) {
    if (x == 0.0f) x = 0.0f;
    const unsigned u = __float_as_uint(x);
    return (u & 0x80000000u) ? ~u : (u | 0x80000000u);
}
__device__ __forceinline__ void dsa_index_phase(const Params& p, unsigned char* smem) {
    const int tid = opaque_tid(), wave = tid >> 6, lane = tid & 63, r = lane & 15, q = lane >> 4;
    float* SC = (float*)smem;
    const h16* qidx = (const h16*)(p.ws + D_QIDX);
    const h16* kidx = (const h16*)(p.ws + D_KIDX);
    const float* widx = (const float*)(p.ws + D_WIDX);
    unsigned* maskb = (unsigned*)(p.ws + D_MASK);
    for (int qt = blockIdx.x; qt < MTOK / 16; qt += gridDim.x) {
        const int row0 = qt * 16, b = row0 >> 11, t0 = row0 & 2047;
        const int nkt = (t0 >> 4) + 1;
        {
            h16x8 qf[8][2]; float wq[8];
#pragma unroll
            for (int h = 0; h < 8; ++h) {
#pragma unroll
                for (int kk = 0; kk < 2; ++kk) qf[h][kk] = *(const h16x8*)(qidx + (size_t)(row0 + r) * 512 + h * 64 + kk * 32 + q * 8);
                wq[h] = widx[(size_t)(row0 + r) * 8 + h];
            }
            for (int kt = wave; kt < nkt; kt += 8) {
                const int s0 = kt * 16;
                const h16* kp = kidx + (size_t)(b * 2048 + s0 + r) * 64 + q * 8;
                const h16x8 k0 = *(const h16x8*)kp, k1 = *(const h16x8*)(kp + 32);
                f32x4 sc = {0.f, 0.f, 0.f, 0.f};
#pragma unroll
                for (int h = 0; h < 8; ++h) {
                    f32x4 acc = {0.f, 0.f, 0.f, 0.f};
                    acc = __builtin_amdgcn_mfma_f32_16x16x32_f16(k0, qf[h][0], acc, 0, 0, 0);
                    acc = __builtin_amdgcn_mfma_f32_16x16x32_f16(k1, qf[h][1], acc, 0, 0, 0);
#pragma unroll
                    for (int jj = 0; jj < 4; ++jj) sc[jj] += fmaxf(acc[jj], 0.f) * wq[h];
                }
                *(f32x4*)(SC + r * ROWP + s0 + q * 4) = sc;
            }
        }
        __syncthreads();
        for (int qq = 0; qq < 2; ++qq) {
            const int ql = wave * 2 + qq, t = t0 + ql;
            const float* srow = SC + ql * ROWP;
            const int ni = (t >> 6) + 1;
            unsigned u[32];
#pragma unroll
            for (int i = 0; i < 32; ++i) {
                u[i] = 0u;
                if (i < ni) { const int s = i * 64 + lane; if (s <= t) u[i] = fkey(srow[s]); }
            }
            unsigned myw = 0u;
            if (t < 256) {
#pragma unroll
                for (int i = 0; i < 32; ++i) { const unsigned long long sm = __ballot(u[i] != 0u); if ((lane >> 1) == i) myw = (lane & 1) ? (unsigned)(sm >> 32) : (unsigned)sm; }
            } else {
                unsigned T = 0u;
                for (int bit = 31; bit >= 0; --bit) {
                    const unsigned cand = T | (1u << bit);
                    int cnt = 0;
#pragma unroll
                    for (int i = 0; i < 32; ++i) if (i < ni) cnt += __popcll(__ballot(u[i] >= cand));
                    if (cnt >= 256) T = cand;
                }
                int cgt = 0;
#pragma unroll
                for (int i = 0; i < 32; ++i) if (i < ni) cgt += __popcll(__ballot(u[i] > T));
                const int need = 256 - cgt;
                int running = 0;
                const unsigned long long lt = (lane == 0) ? 0ull : (~0ull >> (64 - lane));
#pragma unroll
                for (int i = 0; i < 32; ++i) {
                    if (i < ni) {
                        const unsigned long long eq = __ballot(u[i] == T);
                        const int rank = running + __popcll(eq & lt);
                        const unsigned long long sm = __ballot(u[i] > T || (u[i] == T && rank < need));
                        running += __popcll(eq);
                        if ((lane >> 1) == i) myw = (lane & 1) ? (unsigned)(sm >> 32) : (unsigned)sm;
                    }
                }
            }
            maskb[(size_t)(row0 + ql) * 64 + lane] = myw;
        }
        __syncthreads();
    }
}

__device__ __forceinline__ void dsa_attn_phase(const Params& p, int j, unsigned char* smem) {
    const int tid = opaque_tid(), wave = tid >> 6, lane = tid & 63, r = lane & 15, q = lane >> 4;
    float* BL = (float*)smem;
    for (int idx = tid; idx < 16 * 129; idx += 512) {
        const int h = idx / 129, d = idx % 129;
        int bk = d;
        if (d >= 16) { bk = 16 + (int)(logf((float)d * (1.0f / 16.0f)) / 2.0794415416798357f * 16.0f); bk = bk > 31 ? 31 : bk; }
        BL[h * 132 + d] = p.in[32][bk * 16 + h];
    }
    __syncthreads();
    const h16* qabs = (const h16*)(p.ws + D_QABS);
    const h16* ckv = (const h16*)(p.ws + D_CKV);
    const h16* ckvt = (const h16*)(p.ws + D_CKVT);
    const unsigned* maskb = (const unsigned*)(p.ws + D_MASK);
    h16* o16 = (h16*)(p.ws + D_O16);
    const h16* wuvt = w_dsa_uvt(p.ws, j);
    const float NINF = -__builtin_inff();
    for (int qt = blockIdx.x; qt < MTOK / 16; qt += gridDim.x) {
        const int row0 = qt * 16, b = row0 >> 11, t0 = row0 & 2047, nsteps = (t0 + 16 + 31) >> 5, tq = t0 + r;
        h16x8 qf[2][4];
#pragma unroll
        for (int hh = 0; hh < 2; ++hh)
#pragma unroll
            for (int kk = 0; kk < 4; ++kk) qf[hh][kk] = *(const h16x8*)(qabs + (size_t)(row0 + r) * 2048 + (2 * wave + hh) * 128 + kk * 32 + q * 8);
        f32x4 O[2][8];
#pragma unroll
        for (int hh = 0; hh < 2; ++hh)
#pragma unroll
            for (int dt = 0; dt < 8; ++dt) O[hh][dt] = (f32x4){0.f, 0.f, 0.f, 0.f};
        float mrun[2] = {NINF, NINF}, lrun[2] = {0.f, 0.f};
        for (int st = 0; st < nsteps; ++st) {
            const int s0 = st * 32;
            const unsigned mw = maskb[(size_t)(row0 + r) * 64 + st];
            f32x4 sc[2][2];
#pragma unroll
            for (int tt = 0; tt < 2; ++tt) {
                h16x8 kf[4];
#pragma unroll
                for (int kk = 0; kk < 4; ++kk) kf[kk] = *(const h16x8*)(ckv + (size_t)(b * 2048 + s0 + tt * 16 + r) * 128 + kk * 32 + q * 8);
#pragma unroll
                for (int hh = 0; hh < 2; ++hh) {
                    f32x4 acc = {0.f, 0.f, 0.f, 0.f};
#pragma unroll
                    for (int kk = 0; kk < 4; ++kk) acc = __builtin_amdgcn_mfma_f32_16x16x32_f16(kf[kk], qf[hh][kk], acc, 0, 0, 0);
                    sc[hh][tt] = acc;
                }
            }
            h16x8 pf[2]; float alpha[2];
#pragma unroll
            for (int hh = 0; hh < 2; ++hh) {
                const int h = 2 * wave + hh;
                float x[8]; float mx = NINF;
#pragma unroll
                for (int tt = 0; tt < 2; ++tt)
#pragma unroll
                    for (int jj = 0; jj < 4; ++jj) {
                        const int kix = tt * 16 + q * 4 + jj;
                        int dist = tq - (s0 + kix); dist = dist < 0 ? 0 : (dist > 128 ? 128 : dist);
                        const float v = sc[hh][tt][jj] + BL[h * 132 + dist];
                        const float xv = ((mw >> kix) & 1u) ? v : NINF;
                        x[tt * 4 + jj] = xv; mx = fmaxf(mx, xv);
                    }
                mx = fmaxf(mx, __shfl_xor(mx, 16)); mx = fmaxf(mx, __shfl_xor(mx, 32));
                const float mnew = fmaxf(mrun[hh], mx);
                const float mref = (mnew == NINF) ? 0.f : mnew;
                alpha[hh] = __expf(mrun[hh] - mref);
                mrun[hh] = mnew;
                float ps = 0.f;
#pragma unroll
                for (int i = 0; i < 8; ++i) { const float pv = __expf(x[i] - mref); ps += pv; pf[hh][i] = (h16)pv; }
                lrun[hh] = lrun[hh] * alpha[hh] + ps;
            }
#pragma unroll
            for (int dt = 0; dt < 8; ++dt) {
                const h16* vp = ckvt + (size_t)(b * 128 + dt * 16 + r) * 2048 + s0 + q * 4;
                const h16x4 lo = *(const h16x4*)vp, hi = *(const h16x4*)(vp + 16);
                const h16x8 vf = {lo[0], lo[1], lo[2], lo[3], hi[0], hi[1], hi[2], hi[3]};
#pragma unroll
                for (int hh = 0; hh < 2; ++hh) {
                    O[hh][dt] *= alpha[hh];
                    O[hh][dt] = __builtin_amdgcn_mfma_f32_16x16x32_f16(vf, pf[hh], O[hh][dt], 0, 0, 0);
                }
            }
        }
#pragma unroll
        for (int hh = 0; hh < 2; ++hh) {
            const int h = 2 * wave + hh;
            float lt = lrun[hh]; lt += __shfl_xor(lt, 16); lt += __shfl_xor(lt, 32);
            const float inv = 1.0f / lt;
#pragma unroll
            for (int vt = 0; vt < 4; ++vt) {
                f32x4 acc = {0.f, 0.f, 0.f, 0.f};
#pragma unroll
                for (int kk = 0; kk < 4; ++kk) {
                    const h16* ap = wuvt + (size_t)(h * 64 + vt * 16 + r) * 128 + kk * 32 + q * 4;
                    const h16x4 lo = *(const h16x4*)ap, hi = *(const h16x4*)(ap + 16);
                    const h16x8 a8 = {lo[0], lo[1], lo[2], lo[3], hi[0], hi[1], hi[2], hi[3]};
                    h16x8 b8;
#pragma unroll
                    for (int i = 0; i < 4; ++i) { b8[i] = (h16)(O[hh][2 * kk][i] * inv); b8[4 + i] = (h16)(O[hh][2 * kk + 1][i] * inv); }
                    acc = __builtin_amdgcn_mfma_f32_16x16x32_f16(a8, b8, acc, 0, 0, 0);
                }
                u32x2 w; w.x = pk2(acc[0], acc[1]); w.y = pk2(acc[2], acc[3]);
                *(u32x2*)(o16 + (size_t)(row0 + r) * 1024 + h * 64 + vt * 16 + q * 4) = w;
            }
        }
    }
    __syncthreads();
}

__global__ void __launch_bounds__(512) mega_fwd(Params p) {
    extern __shared__ __attribute__((aligned(16))) unsigned char smem[];
    cg::grid_group grid = cg::this_grid();
    unsigned char* ws = p.ws;
    h16* x16 = (h16*)(ws + OFF_X16);
    for (int ph = p.ph_lo; ph < p.ph_hi; ++ph) {
        const unsigned e = p.prog[ph];
        const int kind = e & 15, L = (e >> 4) & 3, sub = (e >> 6) & 1, j = L >> 1;
        const bool isgemm = (kind == K_R1 || kind == K_R2 || kind == K_R4 || kind == K_F1 || kind == K_F3 || kind == K_D1 || kind == K_D3 || kind == K_D6);
        if (isgemm) {
            pg8::Gemm g; pg8::Epi E;
            g.M = MTOK; g.N = 1024; g.K = 1024; g.lda = 1024; g.amode = 0; g.pm0 = 0; g.A = x16; g.Bt = x16;
            E.mode = E_RESID; E.pm0 = 0; E.j = j; E.ws = ws; E.out = p.out; E.bias0 = p.in[5] + j * 1024; E.bias1 = p.in[8] + j * 1024; E.bias2 = p.in[11];
            if (kind == K_R1) {
                g.Bt = w_rwkv_big(ws, j); g.N = 3584; g.K = 2048; g.amode = 1; E.mode = E_RPROJ;
            } else if (kind == K_R2) {
                g.A = (const h16*)(ws + R_HACT); g.Bt = w_rwkv_l2(ws, j); g.N = (j == 0) ? 3072 : 4096; g.K = 512; g.lda = 512; E.mode = E_LORA2;
            } else if (kind == K_R4) {
                g.A = (const h16*)(ws + R_R16); g.Bt = w_rwkv_o(ws, j);
            } else if (kind == K_F1) {
                g.Bt = w_ffn_up(ws, L); g.M = MTOK / 2; g.N = 5632; g.amode = 1; g.pm0 = sub * 128; E.mode = E_ST16;
            } else if (kind == K_F3) {
                g.A = (const h16*)(ws + F_ACT); g.Bt = w_ffn_dn(ws, L); g.M = MTOK / 2; g.K = 2816; g.lda = 2816; E.pm0 = sub * 128;
            } else if (kind == K_D1) {
                g.Bt = w_dsa_in(ws, j); g.N = 512; g.amode = 1; E.mode = E_ST32;
            } else if (kind == K_D3) {
                g.A = (const h16*)(ws + D_CQ); g.Bt = w_dsa_q(ws, j); g.N = 2560; g.K = 256; g.lda = 256; E.mode = E_QPROJ;
            } else {
                g.A = (const h16*)(ws + D_O16); g.Bt = w_dsa_o(ws, j);
            }
            pg8::StaticOrder S; S.init(g.M, g.N, (int)gridDim.x, (int)blockIdx.x);
#ifndef NO_GEMM
            pg8::gemm_phase((LAS unsigned char*)smem, g, S, E);
#endif
        } else if (kind == K_PREP) {
#ifndef NO_PREP
            prep_phase(p, smem);
#endif
        } else if (kind == K_R3) {
#ifndef NO_SCAN
            scan_phase(p, j, smem);
#endif
        } else if (kind == K_LN) {
#ifndef NO_LN
            ln_phase(p, p.in[1] + (L * 2 + sub) * 1024, p.in[2] + (L * 2 + sub) * 1024, L == 3 && sub == 1);
#endif
        } else if (kind == K_F2) {
#ifndef NO_CONV
            conv_phase(p, L);
#endif
        } else if (kind == K_D2) {
#ifndef NO_NORM
            dsa_norm_phase(p, j, smem);
#endif
        } else if (kind == K_D4) {
#ifndef NO_INDEX
            dsa_index_phase(p, smem);
#endif
        } else if (kind == K_D5) {
#ifndef NO_ATTN
            dsa_attn_phase(p, j, smem);
#endif
        }
        if (ph + 1 < p.ph_hi) grid.sync();
    }
}

extern "C" void kernel_launch(void* const* d_in, const int* in_sizes, int n_in, void* d_out, int out_size, void* d_ws, size_t ws_size, hipStream_t stream) {
    static int grid_blocks = 0;
    if (grid_blocks == 0) {
        if (n_in != 37 || ws_size < WS_NEED || out_size != MTOK * DM) { fprintf(stderr, "kernel_launch: unexpected problem (n_in %d ws %zu out %d)\n", n_in, ws_size, out_size); grid_blocks = -1; return; }
        int dev = 0, cus = 0, per_cu = 0;
        hipGetDevice(&dev);
        hipDeviceGetAttribute(&cus, hipDeviceAttributeMultiprocessorCount, dev);
        if (hipFuncSetAttribute((const void*)mega_fwd, hipFuncAttributeMaxDynamicSharedMemorySize, LDS_BYTES) != hipSuccess) { fprintf(stderr, "kernel_launch: hipFuncSetAttribute failed\n"); grid_blocks = -1; return; }
        hipOccupancyMaxActiveBlocksPerMultiprocessor(&per_cu, (const void*)mega_fwd, 512, LDS_BYTES);
        if (per_cu < 1) { fprintf(stderr, "kernel_launch: occupancy query says %d blocks/CU\n", per_cu); per_cu = 1; }
        (void)hipGetLastError();
        grid_blocks = cus * per_cu;
        fprintf(stderr, "kernel_launch: grid %d (cus %d x %d)\n", grid_blocks, cus, per_cu);
    }
    if (grid_blocks < 0) return;
    Params p{};
    for (int i = 0; i < 37; ++i) p.in[i] = (const float*)d_in[i];
    p.ws = (unsigned char*)d_ws; p.out = (float*)d_out;
    int np = 0;
    auto add = [&](int kind, int L, int sub) { p.prog[np++] = (unsigned char)(kind | (L << 4) | (sub << 6)); };
    add(K_PREP, 0, 0);
    for (int L = 0; L < 4; ++L) {
        if ((L & 1) == 0) { add(K_R1, L, 0); add(K_R2, L, 0); add(K_R3, L, 0); add(K_R4, L, 0); }
        else { add(K_D1, L, 0); add(K_D2, L, 0); add(K_D3, L, 0); add(K_D4, L, 0); add(K_D5, L, 0); add(K_D6, L, 0); }
        add(K_LN, L, 0);
        for (int c = 0; c < 2; ++c) { add(K_F1, L, c); add(K_F2, L, c); add(K_F3, L, c); }
        add(K_LN, L, 1);
    }
#if SINGLE_LAUNCH
    p.ph_lo = 0; p.ph_hi = np;
    void* args[] = {&p};
    hipError_t e = hipLaunchCooperativeKernel((const void*)mega_fwd, dim3(grid_blocks), dim3(512), args, LDS_BYTES, stream);
    if (e != hipSuccess) fprintf(stderr, "cooperative launch failed: %s (grid %d)\n", hipGetErrorString(e), grid_blocks);
#else
    for (int ph = 0; ph < np; ++ph) {
        p.ph_lo = ph; p.ph_hi = ph + 1;
        hipLaunchKernelGGL(mega_fwd, dim3(grid_blocks), dim3(512), LDS_BYTES, stream, p);
    }
#endif
}
```

```cpp
#include <hip/hip_runtime.h>
#include <hip/hip_cooperative_groups.h>
#include <cstdio>
namespace cg = cooperative_groups;

#ifndef SINGLE_LAUNCH
#define SINGLE_LAUNCH 1
#endif

#define LAS __attribute__((address_space(3)))
typedef _Float16 h16;
typedef _Float16 h16x8 __attribute__((ext_vector_type(8)));
typedef _Float16 h16x4 __attribute__((ext_vector_type(4)));
typedef _Float16 h16x2 __attribute__((ext_vector_type(2)));
typedef float f32x4 __attribute__((ext_vector_type(4)));
typedef float f32x2 __attribute__((ext_vector_type(2)));
typedef unsigned u32x4 __attribute__((ext_vector_type(4)));
typedef unsigned u32x2 __attribute__((ext_vector_type(2)));

constexpr int DM = 1024, SEQ = 2048, NBATCH = 32, MTOK = NBATCH * SEQ;
constexpr int DFF = 2816;
constexpr size_t MiB = (size_t)1 << 20;
constexpr float DN_ALPHA = 1.6817928305074290f;
constexpr int LDS_BYTES = 147456;

constexpr size_t OFF_W = 0;
constexpr size_t OFF_X16 = 118 * MiB;
constexpr size_t OFF_VF = 247 * MiB;
constexpr size_t OFF_R = 375 * MiB;
constexpr size_t WS_NEED = 951 * MiB;
constexpr size_t R_R16 = OFF_R, R_K16 = OFF_R + 128 * MiB, R_V16 = OFF_R + 256 * MiB, R_G16 = OFF_R + 384 * MiB, R_HACT = OFF_R + 512 * MiB;
constexpr size_t F_U16 = OFF_R, F_ACT = OFF_R + 352 * MiB;
constexpr size_t D_HIN = OFF_R, D_O16 = OFF_R, D_QABS = OFF_R + 128 * MiB, D_QIDX = OFF_R + 384 * MiB, D_CQ = OFF_R + 448 * MiB,
                 D_CKV = OFF_R + 480 * MiB, D_CKVT = OFF_R + 496 * MiB, D_KIDX = OFF_R + 512 * MiB, D_WIDX = OFF_R + 520 * MiB, D_MASK = OFF_R + 522 * MiB;

struct Params {
    const float* in[37];
    unsigned char* ws;
    float* out;
    int ph_lo, ph_hi;
    unsigned char prog[64];
};

enum { K_PREP = 0, K_R1, K_R2, K_R3, K_R4, K_LN, K_F1, K_F2, K_F3, K_D1, K_D2, K_D3, K_D4, K_D5, K_D6 };
enum { E_RPROJ = 0, E_LORA2, E_RESID, E_ST16, E_ST32, E_QPROJ };

__device__ __forceinline__ size_t xrow(int row) { return (size_t)(row >> 11) * 2049 + 1 + (row & 2047); }
__device__ __forceinline__ unsigned pk2(float a, float b) { h16x2 h = {(h16)a, (h16)b}; return __builtin_bit_cast(unsigned, h); }
__device__ __forceinline__ u32x4 pack8(f32x4 a, f32x4 b) { u32x4 w; w.x = pk2(a[0], a[1]); w.y = pk2(a[2], a[3]); w.z = pk2(b[0], b[1]); w.w = pk2(b[2], b[3]); return w; }
__device__ __forceinline__ void unpack8(u32x4 w, float* f) {
    h16x8 h = __builtin_bit_cast(h16x8, w);
#pragma unroll
    for (int i = 0; i < 8; ++i) f[i] = (float)h[i];
}
__device__ __forceinline__ float sigmoidf_(float x) { return 1.0f / (1.0f + __expf(-x)); }
__device__ __forceinline__ float wave_sum(float v) {
#pragma unroll
    for (int o = 32; o > 0; o >>= 1) v += __shfl_xor(v, o);
    return v;
}
#define WSYNC() asm volatile("s_waitcnt vmcnt(0) lgkmcnt(0)" ::: "memory")
__device__ __forceinline__ int opaque_tid() { int t = threadIdx.x; asm volatile("" : "+v"(t)); return t; }

namespace pg8 {
constexpr int BM = 256, BK = 64, HALF = 128, HTB = HALF * BK * 2, STAGE_BYTES = 8 * HTB, NXCD = 8, WGM = 8;
__device__ __forceinline__ int lds_byte(int r, int c) { const int st = (r >> 4) * 2 + (c >> 5), rr = r & 15, cc = c & 31, ob = rr * 64 + cc * 2; return st * 1024 + (ob ^ (((ob >> 9) & 1) << 5)); }
__device__ __forceinline__ void stage_rc(int b, int& R, int& C) { const int st = b / 1024, sb = b % 1024, swz = sb ^ (((sb >> 9) & 1) << 5); R = (st >> 1) * 16 + swz / 64; C = (st & 1) * 32 + (swz % 64) / 2; }
__device__ __forceinline__ int perm32(int rho) { const int n = rho >> 4, i = rho & 15; return 8 * (i >> 2) + 4 * n + (i & 3); }
struct Unit { int pm, pn; };
struct Gemm { const h16* A; const h16* Bt; int M, N, K, lda, amode, pm0; };
struct StaticOrder {
    int nM, nN, nwg, G, c;
    __device__ void init(int M, int N, int G_, int c_) { nM = M / BM; nN = N / BM; nwg = nM * nN; G = G_; c = c_; }
    __device__ bool next(int i, Unit& u) const {
        const long L = (long)i * G + c; if (L >= nwg) return false;
        int wgid = (int)L; { const int q = nwg / NXCD, r = nwg % NXCD, xcd = wgid % NXCD, off = wgid / NXCD; wgid = (xcd < r ? xcd * (q + 1) : r * (q + 1) + (xcd - r) * q) + off; }
        const int nig = WGM * nN, gid = wgid / nig, fm = gid * WGM, gsz = (nM - fm) < WGM ? (nM - fm) : WGM;
        u.pm = fm + ((wgid % nig) % gsz); u.pn = (wgid % nig) / gsz; return true;
    }
};

struct Epi {
    int mode, pm0, j;
    unsigned char* ws; float* out; const float* bias0; const float* bias1; const float* bias2;
    __device__ __forceinline__ void operator()(const f32x4 (&acc)[2][2][4][2], const Unit& u, int wr, int wc, int fr, int fq) const {
        const int rowl0 = u.pm * BM + wr * 64 + fr;
        const int colt = u.pn * BM + wc * 32 + 8 * fq;
#pragma unroll
        for (int ai = 0; ai < 2; ++ai)
#pragma unroll
            for (int m = 0; m < 4; ++m) {
                const int rowl = rowl0 + ai * HALF + m * 16;
                const int rowg = rowl + pm0 * BM;
#pragma unroll
                for (int bj = 0; bj < 2; ++bj) {
                    const int col = colt + bj * HALF;
                    f32x4 v0 = acc[ai][bj][m][0], v1 = acc[ai][bj][m][1];
                    if (mode == E_RPROJ) {
                        if (u.pn < 12) {
                            h16* dst = (h16*)(ws + (u.pn < 4 ? R_R16 : (u.pn < 8 ? R_K16 : (j == 0 ? OFF_VF : R_V16))));
                            *(u32x4*)(dst + (size_t)rowg * 1024 + (col & 1023)) = pack8(v0, v1);
                        } else {
                            const int hc = col - 3072;
                            if (hc < 64) {
#pragma unroll
                                for (int jj = 0; jj < 4; ++jj) { v0[jj] = tanhf(v0[jj]); v1[jj] = tanhf(v1[jj]); }
                            } else if (hc >= 160) {
#pragma unroll
                                for (int jj = 0; jj < 4; ++jj) { v0[jj] = sigmoidf_(v0[jj]); v1[jj] = sigmoidf_(v1[jj]); }
                            }
                            *(u32x4*)((h16*)(ws + R_HACT) + (size_t)rowg * 512 + hc) = pack8(v0, v1);
                        }
                    } else if (mode == E_LORA2) {
                        const int grp = u.pn >> 2, c = col & 1023;
                        const size_t off = (size_t)rowg * 1024 + c;
                        if (grp == 0) {
                            const f32x4 ba = *(const f32x4*)(bias0 + c), bb = *(const f32x4*)(bias0 + c + 4);
#pragma unroll
                            for (int jj = 0; jj < 4; ++jj) { v0[jj] = sigmoidf_(v0[jj] + ba[jj]) * 0.6065306597f; v1[jj] = sigmoidf_(v1[jj] + bb[jj]) * 0.6065306597f; }
                            *(u32x4*)((h16*)out + off) = pack8(v0, v1);
                        } else if (grp == 1) {
                            const f32x4 ba = *(const f32x4*)(bias1 + c), bb = *(const f32x4*)(bias1 + c + 4);
#pragma unroll
                            for (int jj = 0; jj < 4; ++jj) { v0[jj] = sigmoidf_(v0[jj] + ba[jj]); v1[jj] = sigmoidf_(v1[jj] + bb[jj]); }
                            *(u32x4*)((h16*)out + (size_t)MTOK * 1024 + off) = pack8(v0, v1);
                        } else if (grp == 2) {
                            *(u32x4*)((h16*)(ws + R_G16) + off) = pack8(v0, v1);
                        } else {
                            const f32x4 ba = *(const f32x4*)(bias2 + c), bb = *(const f32x4*)(bias2 + c + 4);
                            float vv[8], vf8[8];
                            h16* vp = (h16*)(ws + R_V16) + off;
                            unpack8(*(const u32x4*)vp, vv); unpack8(*(const u32x4*)((const h16*)(ws + OFF_VF) + off), vf8);
#pragma unroll
                            for (int jj = 0; jj < 4; ++jj) {
                                v0[jj] = vv[jj] + (vf8[jj] - vv[jj]) * sigmoidf_(v0[jj] + ba[jj]);
                                v1[jj] = vv[4 + jj] + (vf8[4 + jj] - vv[4 + jj]) * sigmoidf_(v1[jj] + bb[jj]);
                            }
                            *(u32x4*)vp = pack8(v0, v1);
                        }
                    } else if (mode == E_RESID) {
                        float xr[8];
                        unpack8(*(const u32x4*)((const h16*)(ws + OFF_X16) + xrow(rowg) * 1024 + col), xr);
                        f32x4 r0, r1;
#pragma unroll
                        for (int jj = 0; jj < 4; ++jj) { r0[jj] = DN_ALPHA * xr[jj] + v0[jj]; r1[jj] = DN_ALPHA * xr[4 + jj] + v1[jj]; }
                        float* dp = out + (size_t)rowg * 1024 + col;
                        *(f32x4*)dp = r0; *(f32x4*)(dp + 4) = r1;
                    } else if (mode == E_ST16) {
                        *(u32x4*)((h16*)(ws + F_U16) + (size_t)rowl * 5632 + col) = pack8(v0, v1);
                    } else if (mode == E_ST32) {
                        float* dp = (float*)(ws + D_HIN) + (size_t)rowg * 512 + col;
                        *(f32x4*)dp = v0; *(f32x4*)(dp + 4) = v1;
                    } else {
                        if (u.pn < 8) *(u32x4*)((h16*)(ws + D_QABS) + (size_t)rowg * 2048 + col) = pack8(v0, v1);
                        else *(u32x4*)((h16*)(ws + D_QIDX) + (size_t)rowg * 512 + (col - 2048)) = pack8(v0, v1);
                    }
                }
            }
    }
};

__device__ __forceinline__ const char* a_tile(const Gemm& g, int pm) {
    if (g.amode == 1) { const int row = (pm + g.pm0) * BM; return (const char*)g.A + xrow(row) * 2048; }
    return (const char*)g.A + (size_t)pm * BM * g.lda * 2;
}

__device__ __forceinline__ void gemm_phase(LAS unsigned char* lds, const Gemm g, const StaticOrder& S, const Epi& E) {
    const int tid = opaque_tid(), wid = __builtin_amdgcn_readfirstlane(tid >> 6), lane = tid & 63, wr = wid >> 2, wc = wid & 3, fr = lane & 15, fq = lane >> 4;
    const int K = g.K, nt = K / BK;
    const bool shiftA = (g.amode == 1);
    unsigned voffA[2], voffB[2];
#pragma unroll
    for (int i = 0; i < 2; ++i) { int R, C; stage_rc(tid * 16 + i * 8192, R, C); const int Rb = (R & ~31) + perm32(R & 31);
        voffA[i] = (unsigned)(R * g.lda + C) * 2u; voffB[i] = (unsigned)(Rb * K + C) * 2u; }
    const size_t kstep = (size_t)(BK * 2);
    const size_t hstepA = (size_t)HALF * g.lda * 2;
    const size_t hstepB = (size_t)HALF * K * 2;
    const size_t tstepB = 2 * hstepB;
    const unsigned ldsw = (unsigned)wid * 1024u;
    const int aoff = lds_byte(wr * 64 + fr, fq * 8), boff = lds_byte(wc * 32 + fr, fq * 8);
#define PG8_KOFF(kt) ((size_t)(kt) * kstep - ((shiftA && (kt) >= 16) ? (size_t)4096 : (size_t)0))
#define PG8_SA(b, h) (((b) * 2 + (h)) * HTB)
#define PG8_SB(b, h) ((4 + (b) * 2 + (h)) * HTB)
#define PG8_STAGE(bufoff, gbase, voff) do { _Pragma("unroll") for (int _i = 0; _i < 2; ++_i) \
        __builtin_amdgcn_global_load_lds((const unsigned*)((const char*)(gbase) + (voff)[_i]), (LAS unsigned*)(lds + (bufoff) + ldsw + _i * 8192), 16, 0, 0); } while (0)
#define PG8_LDA(dst, b, h) do { _Pragma("unroll") for (int m = 0; m < 4; ++m) _Pragma("unroll") for (int k = 0; k < 2; ++k) dst[m][k] = *(const LAS h16x8*)(lds + PG8_SA(b, h) + aoff + m * 2048 + k * 1024); } while (0)
#define PG8_LDB(dst, b, h) do { _Pragma("unroll") for (int n = 0; n < 2; ++n) _Pragma("unroll") for (int k = 0; k < 2; ++k) dst[n][k] = *(const LAS h16x8*)(lds + PG8_SB(b, h) + boff + n * 2048 + k * 1024); } while (0)
#define PG8_MMA(ai, bj, At, Bt) do { __builtin_amdgcn_s_setprio(1); _Pragma("unroll") for (int m = 0; m < 4; ++m) _Pragma("unroll") for (int n = 0; n < 2; ++n) _Pragma("unroll") for (int k = 0; k < 2; ++k) \
        acc[ai][bj][m][n] = __builtin_amdgcn_mfma_f32_16x16x32_f16(Bt[n][k], At[m][k], acc[ai][bj][m][n], 0, 0, 0); __builtin_amdgcn_s_setprio(0); } while (0)
#define PG8_WAIT_V(n) asm volatile("s_waitcnt vmcnt(" #n ")" ::: "memory")
#define PG8_WAIT_L(n) asm volatile("s_waitcnt lgkmcnt(" #n ")" ::: "memory")
#define PG8_BAR __builtin_amdgcn_s_barrier()
#define PG8_SCHED __builtin_amdgcn_sched_barrier(0)
    Unit cur, nxt; int ui = 0;
    if (!S.next(0, cur)) return;
    f32x4 acc[2][2][4][2];
#pragma unroll
    for (int a = 0; a < 2; ++a)
#pragma unroll
        for (int b = 0; b < 2; ++b)
#pragma unroll
            for (int m = 0; m < 4; ++m)
#pragma unroll
                for (int n = 0; n < 2; ++n) acc[a][b][m][n] = (f32x4){0.f, 0.f, 0.f, 0.f};
    h16x8 At[4][2], B0[2][2], B1[2][2];
    const char* cA = a_tile(g, cur.pm); const char* cB = (const char*)g.Bt + (size_t)cur.pn * tstepB;
    PG8_STAGE(PG8_SB(0, 0), cB, voffB); PG8_STAGE(PG8_SA(0, 0), cA, voffA); PG8_STAGE(PG8_SB(0, 1), cB + hstepB, voffB); PG8_STAGE(PG8_SA(0, 1), cA + hstepA, voffA);
    if (wr == 1) PG8_BAR;
    PG8_WAIT_V(4); PG8_BAR;
    PG8_STAGE(PG8_SB(1, 0), cB + kstep, voffB); PG8_STAGE(PG8_SA(1, 0), cA + kstep, voffA); PG8_STAGE(PG8_SB(1, 1), cB + hstepB + kstep, voffB);
    PG8_WAIT_V(6); PG8_BAR;
    for (;;) {
        const bool has_next = S.next(ui + 1, nxt);
        const char* nA = has_next ? a_tile(g, nxt.pm) : cA; const char* nB = has_next ? (const char*)g.Bt + (size_t)nxt.pn * tstepB : cB;
        for (int t = 0; t < nt; t += 2) {
            const bool last = (t == nt - 2);
            const char* a1 = cA + PG8_KOFF(t + 1);
            const char* a2 = last ? nA : cA + PG8_KOFF(t + 2); const char* b2 = last ? nB : cB + (size_t)(t + 2) * kstep;
            const char* a3 = a2 + kstep; const char* b3 = b2 + kstep;
            PG8_LDB(B0, 0, 0); PG8_SCHED; PG8_LDA(At, 0, 0); PG8_STAGE(PG8_SA(1, 1), a1 + hstepA, voffA);
            PG8_WAIT_L(8); PG8_BAR; PG8_WAIT_L(0); PG8_MMA(0, 0, At, B0); PG8_BAR; PG8_SCHED;
            PG8_LDB(B1, 0, 1); PG8_STAGE(PG8_SB(0, 0), b2, voffB);
            PG8_BAR; PG8_WAIT_L(0); PG8_MMA(0, 1, At, B1); PG8_BAR;
            PG8_LDA(At, 0, 1); PG8_STAGE(PG8_SA(0, 0), a2, voffA);
            PG8_BAR; PG8_WAIT_L(0); PG8_MMA(1, 0, At, B0); PG8_BAR; PG8_SCHED;
            PG8_STAGE(PG8_SB(0, 1), b2 + hstepB, voffB);
            PG8_WAIT_V(6); PG8_BAR; PG8_MMA(1, 1, At, B1); PG8_BAR;
            PG8_LDB(B0, 1, 0); PG8_SCHED; PG8_LDA(At, 1, 0); PG8_STAGE(PG8_SA(0, 1), a2 + hstepA, voffA);
            PG8_WAIT_L(8); PG8_BAR; PG8_WAIT_L(0); PG8_MMA(0, 0, At, B0); PG8_BAR; PG8_SCHED;
            PG8_LDB(B1, 1, 1); PG8_STAGE(PG8_SB(1, 0), b3, voffB);
            PG8_BAR; PG8_WAIT_L(0); PG8_MMA(0, 1, At, B1); PG8_BAR;
            PG8_LDA(At, 1, 1); PG8_STAGE(PG8_SA(1, 0), a3, voffA);
            PG8_BAR; PG8_WAIT_L(0); PG8_MMA(1, 0, At, B0); PG8_BAR; PG8_SCHED;
            PG8_STAGE(PG8_SB(1, 1), b3 + hstepB, voffB);
            PG8_WAIT_V(6); PG8_BAR; PG8_MMA(1, 1, At, B1); PG8_BAR;
        }
        E(acc, cur, wr, wc, fr, fq);
        if (!has_next) break;
#pragma unroll
        for (int a = 0; a < 2; ++a)
#pragma unroll
            for (int b = 0; b < 2; ++b)
#pragma unroll
                for (int m = 0; m < 4; ++m)
#pragma unroll
                    for (int n = 0; n < 2; ++n) acc[a][b][m][n] = (f32x4){0.f, 0.f, 0.f, 0.f};
        cur = nxt; cA = nA; cB = nB; ++ui;
    }
    PG8_WAIT_V(0);
    if (wr == 0) PG8_BAR;
    PG8_BAR;
#undef PG8_KOFF
#undef PG8_SA
#undef PG8_SB
#undef PG8_STAGE
#undef PG8_LDA
#undef PG8_LDB
#undef PG8_MMA
#undef PG8_WAIT_V
#undef PG8_WAIT_L
#undef PG8_BAR
#undef PG8_SCHED
}
}

struct TJob { int mode; const float* src; int ld, K, N; h16* dst; int ldd, koff; const float* mix; };

__device__ __forceinline__ TJob get_job(const Params& p, int id) {
    TJob J; J.mode = 0; J.src = nullptr; J.ld = 0; J.K = 0; J.N = 0; J.dst = nullptr; J.ldd = 64; J.koff = 0; J.mix = nullptr;
    h16* W = (h16*)(p.ws + OFF_W);
    if (id < 24) {
        const int j = id / 12, s = id % 12;
        h16* Wbig = W + (size_t)j * (10 * MiB); h16* Wl2 = Wbig + 7 * MiB;
        const float* mix = p.in[3] + j * 6 * 1024;
        J.mode = 1; J.ld = 1024; J.K = 1024; J.ldd = 2048;
        if (s < 3) { J.src = p.in[4] + (size_t)(j * 3 + s) * 1048576; J.N = 1024; J.dst = Wbig + (size_t)s * 1024 * 2048; J.mix = mix + s * 1024; }
        else if (s == 3) { J.src = p.in[6] + (size_t)j * 65536; J.ld = 64; J.N = 64; J.dst = Wbig + (size_t)3072 * 2048; J.mix = mix + 3 * 1024; }
        else if (s == 4) { J.src = p.in[9] + (size_t)j * 65536; J.ld = 64; J.N = 64; J.dst = Wbig + (size_t)3136 * 2048; J.mix = mix + 4 * 1024; }
        else if (s == 5) { J.N = 32; J.dst = Wbig + (size_t)3200 * 2048; if (j == 1) { J.src = p.in[12]; J.ld = 32; J.mix = mix + 2 * 1024; } else { J.mode = 2; } }
        else if (s == 6) { J.src = p.in[14] + (size_t)j * 163840; J.ld = 160; J.N = 160; J.dst = Wbig + (size_t)3232 * 2048; J.mix = mix + 5 * 1024; }
        else if (s == 7) { J.mode = 2; J.N = 192; J.dst = Wbig + (size_t)3392 * 2048; }
        else {
            J.mode = 0; J.ld = 1024; J.N = 1024; J.ldd = 512;
            if (s == 8) { J.src = p.in[7] + (size_t)j * 65536; J.K = 64; J.koff = 0; J.dst = Wl2; }
            else if (s == 9) { J.src = p.in[10] + (size_t)j * 65536; J.K = 64; J.koff = 64; J.dst = Wl2 + (size_t)1024 * 512; }
            else if (s == 10) { J.src = p.in[15] + (size_t)j * 163840; J.K = 160; J.koff = 160; J.dst = Wl2 + (size_t)2048 * 512; }
            else { J.src = p.in[13]; J.K = 32; J.koff = 128; J.dst = Wl2 + (size_t)3072 * 512; if (j == 0) J.N = 0; }
        }
    } else if (id < 26) {
        const int j = id - 24;
        J.src = p.in[21] + (size_t)j * 1048576; J.ld = 1024; J.K = 1024; J.N = 1024; J.dst = W + (size_t)j * (10 * MiB) + 9 * MiB; J.ldd = 1024;
    } else if (id < 34) {
        const int i = (id - 26) >> 1, s = (id - 26) & 1;
        h16* base = W + 20 * MiB + (size_t)i * (17 * MiB / 2);
        if (s == 0) { J.src = p.in[33] + (size_t)i * 1024 * 5632; J.ld = 5632; J.K = 1024; J.N = 5632; J.dst = base; J.ldd = 1024; }
        else { J.src = p.in[36] + (size_t)i * 2816 * 1024; J.ld = 1024; J.K = 2816; J.N = 1024; J.dst = base + (size_t)11 * MiB / 2; J.ldd = 2816; }
    } else {
        const int j = (id - 34) >> 2, s = (id - 34) & 3;
        h16* base = W + 54 * MiB + (size_t)j * (5 * MiB / 2);
        if (s == 0) { J.src = p.in[22] + (size_t)j * 1024 * 456; J.ld = 456; J.K = 1024; J.N = 456; J.dst = base; J.ldd = 1024; }
        else if (s == 1) { J.mode = 2; J.N = 56; J.dst = base + (size_t)456 * 1024; J.ldd = 1024; }
        else if (s == 2) { J.src = p.in[28] + (size_t)j * 256 * 512; J.ld = 512; J.K = 256; J.N = 512; J.dst = base + MiB / 2 + (size_t)2048 * 256; J.ldd = 256; }
        else { J.src = p.in[31] + (size_t)j * 1048576; J.ld = 1024; J.K = 1024; J.N = 1024; J.dst = base + 3 * MiB / 2; J.ldd = 1024; }
    }
    return J;
}
__device__ __forceinline__ h16* w_rwkv_big(unsigned char* ws, int j) { return (h16*)(ws + OFF_W) + (size_t)j * (10 * MiB); }
__device__ __forceinline__ h16* w_rwkv_l2(unsigned char* ws, int j) { return w_rwkv_big(ws, j) + 7 * MiB; }
__device__ __forceinline__ h16* w_rwkv_o(unsigned char* ws, int j) { return w_rwkv_big(ws, j) + 9 * MiB; }
__device__ __forceinline__ h16* w_ffn_up(unsigned char* ws, int i) { return (h16*)(ws + OFF_W) + 20 * MiB + (size_t)i * (17 * MiB / 2); }
__device__ __forceinline__ h16* w_ffn_dn(unsigned char* ws, int i) { return w_ffn_up(ws, i) + (size_t)11 * MiB / 2; }
__device__ __forceinline__ h16* w_dsa_in(unsigned char* ws, int j) { return (h16*)(ws + OFF_W) + 54 * MiB + (size_t)j * (5 * MiB / 2); }
__device__ __forceinline__ h16* w_dsa_q(unsigned char* ws, int j) { return w_dsa_in(ws, j) + MiB / 2; }
__device__ __forceinline__ h16* w_dsa_uvt(unsigned char* ws, int j) { return w_dsa_in(ws, j) + 5 * MiB / 4; }
__device__ __forceinline__ h16* w_dsa_o(unsigned char* ws, int j) { return w_dsa_in(ws, j) + 3 * MiB / 2; }

__device__ __forceinline__ void prep_phase(const Params& p, unsigned char* smem) {
    const int tid = opaque_tid();
    const size_t gtid = (size_t)blockIdx.x * 512 + tid, nth = (size_t)gridDim.x * 512;
    h16* x16 = (h16*)(p.ws + OFF_X16);
    for (size_t idx = gtid; idx < (size_t)MTOK * 128; idx += nth) {
        const int row = (int)(idx >> 7), c8 = (int)(idx & 127) * 8;
        const float* sp = p.in[0] + (size_t)row * 1024 + c8;
        const f32x4 a = *(const f32x4*)sp, b = *(const f32x4*)(sp + 4);
        *(u32x4*)(x16 + xrow(row) * 1024 + c8) = pack8(a, b);
    }
    for (size_t idx = gtid; idx < (size_t)NBATCH * 128; idx += nth) {
        const int b = (int)(idx >> 7), c8 = (int)(idx & 127) * 8;
        unsigned z = 0u; asm volatile("" : "+v"(z));
        *(u32x4*)(x16 + (size_t)b * 2049 * 1024 + c8) = (u32x4){z, z, z, z};
    }
    for (size_t idx = gtid; idx < (size_t)2 * 2048 * 256; idx += nth) {
        const int j = (int)(idx >> 19), rem = (int)(idx & 524287), n = rem >> 8, q = rem & 255, h = n >> 7, c = n & 127;
        const float* uq = p.in[25] + (size_t)j * 256 * 1024 + (size_t)q * 1024 + h * 64;
        const float* uk = p.in[26] + (size_t)j * 16 * 64 * 128 + (size_t)h * 64 * 128 + c;
        float s = 0.f;
        for (int d = 0; d < 64; ++d) s += uq[d] * uk[d * 128];
        w_dsa_q(p.ws, j)[(size_t)n * 256 + q] = (h16)(s * 0.125f);
    }
    for (size_t idx = gtid; idx < (size_t)2 * 16 * 64 * 128; idx += nth) {
        const int j = (int)(idx >> 17), rem = (int)(idx & 131071), h = rem >> 13, n = (rem >> 7) & 63, k = rem & 127;
        w_dsa_uvt(p.ws, j)[(size_t)(h * 64 + n) * 128 + k] = (h16)p.in[27][(size_t)((j * 16 + h) * 128 + k) * 64 + n];
    }
    float* tile = (float*)smem;
    for (int id = 0; id < 42; ++id) {
        const TJob J = get_job(p, id);
        const int tk = J.ldd >> 6, tn = (J.N + 63) >> 6, ntile = tk * tn;
        for (int tix = blockIdx.x; tix < ntile; tix += gridDim.x) {
            const int k0 = (tix % tk) * 64, n0 = (tix / tk) * 64;
#pragma unroll
            for (int i = 0; i < 8; ++i) {
                const int k = i * 8 + (tid >> 6), n = tid & 63, kk = k0 + k, nn = n0 + n;
                float v = 0.f;
                if (nn < J.N && J.mode != 2) {
                    if (J.mode == 1) { const int ks = kk & 1023; const float mx = J.mix[ks]; v = J.src[(size_t)ks * J.ld + nn] * (kk < 1024 ? 1.0f - mx : mx); }
                    else if (kk >= J.koff && kk < J.koff + J.K) v = J.src[(size_t)(kk - J.koff) * J.ld + nn];
                }
                tile[k * 65 + n] = v;
            }
            __syncthreads();
#pragma unroll
            for (int i = 0; i < 8; ++i) {
                const int n = i * 8 + (tid >> 6), k = tid & 63, nn = n0 + n;
                if (nn < J.N) J.dst[(size_t)nn * J.ldd + k0 + k] = (h16)tile[k * 65 + n];
            }
            __syncthreads();
        }
    }
}

__device__ __forceinline__ void ln_phase(const Params& p, const float* g, const float* b, bool final_out) {
    const int tid = opaque_tid();
    const int lane = tid & 63, wave = tid >> 6;
    float* tb = p.out;
    h16* x16 = (h16*)(p.ws + OFF_X16);
    f32x4 gg[4], bb[4];
#pragma unroll
    for (int i = 0; i < 4; ++i) { gg[i] = *(const f32x4*)(g + i * 256 + lane * 4); bb[i] = *(const f32x4*)(b + i * 256 + lane * 4); }
    for (int row = blockIdx.x * 8 + wave; row < MTOK; row += gridDim.x * 8) {
        float* rp = tb + (size_t)row * 1024;
        f32x4 v[4];
        float s = 0.f;
#pragma unroll
        for (int i = 0; i < 4; ++i) { v[i] = *(const f32x4*)(rp + i * 256 + lane * 4); s += v[i][0] + v[i][1] + v[i][2] + v[i][3]; }
        const float mu = wave_sum(s) * (1.0f / 1024.0f);
        float q = 0.f;
#pragma unroll
        for (int i = 0; i < 4; ++i)
#pragma unroll
            for (int j = 0; j < 4; ++j) { const float d = v[i][j] - mu; q += d * d; }
        const float rstd = rsqrtf(wave_sum(q) * (1.0f / 1024.0f) + 1e-5f);
#pragma unroll
        for (int i = 0; i < 4; ++i) {
            f32x4 y;
#pragma unroll
            for (int j = 0; j < 4; ++j) y[j] = (v[i][j] - mu) * rstd * gg[i][j] + bb[i][j];
            if (final_out) *(f32x4*)(rp + i * 256 + lane * 4) = y;
            else { u32x2 w; w.x = pk2(y[0], y[1]); w.y = pk2(y[2], y[3]); *(u32x2*)(x16 + xrow(row) * 1024 + i * 256 + lane * 4) = w; }
        }
    }
}

__device__ __forceinline__ void conv_phase(const Params& p, int layer) {
    const h16* u = (const h16*)(p.ws + F_U16);
    h16* act = (h16*)(p.ws + F_ACT);
    const float* cw = p.in[34] + (size_t)layer * 3 * 5632;
    const float* cb = p.in[35] + (size_t)layer * 5632;
    const size_t gtid = (size_t)blockIdx.x * 512 + opaque_tid(), nth = (size_t)gridDim.x * 512;
    const size_t ntask = (size_t)2048 * 704;
    for (size_t task = gtid; task < ntask; task += nth) {
        const int cgp = (int)(task % 704), rc = (int)(task / 704), f = cgp * 4, r0 = rc * 16;
        f32x4 wg[3], wv[3];
#pragma unroll
        for (int j = 0; j < 3; ++j) { wg[j] = *(const f32x4*)(cw + j * 5632 + f); wv[j] = *(const f32x4*)(cw + j * 5632 + DFF + f); }
        const f32x4 bg = *(const f32x4*)(cb + f), bv = *(const f32x4*)(cb + DFF + f);
        f32x4 g2 = {0.f, 0.f, 0.f, 0.f}, g1 = g2, v2 = g2, v1 = g2;
        if ((r0 & 2047) != 0) {
            const h16x4 a = *(const h16x4*)(u + (size_t)(r0 - 2) * 5632 + f), b = *(const h16x4*)(u + (size_t)(r0 - 1) * 5632 + f);
            const h16x4 c = *(const h16x4*)(u + (size_t)(r0 - 2) * 5632 + DFF + f), d = *(const h16x4*)(u + (size_t)(r0 - 1) * 5632 + DFF + f);
#pragma unroll
            for (int j = 0; j < 4; ++j) { g2[j] = (float)a[j]; g1[j] = (float)b[j]; v2[j] = (float)c[j]; v1[j] = (float)d[j]; }
        }
        for (int i = 0; i < 16; ++i) {
            const size_t ro = (size_t)(r0 + i) * 5632;
            const h16x4 a = *(const h16x4*)(u + ro + f), c = *(const h16x4*)(u + ro + DFF + f);
            f32x4 g0, v0;
#pragma unroll
            for (int j = 0; j < 4; ++j) { g0[j] = (float)a[j]; v0[j] = (float)c[j]; }
            u32x2 w; float o[4];
#pragma unroll
            for (int j = 0; j < 4; ++j) {
                const float G = wg[0][j] * g2[j] + wg[1][j] * g1[j] + wg[2][j] * g0[j] + bg[j];
                const float V = wv[0][j] * v2[j] + wv[1][j] * v1[j] + wv[2][j] * v0[j] + bv[j];
                o[j] = G * sigmoidf_(G) * V;
            }
            w.x = pk2(o[0], o[1]); w.y = pk2(o[2], o[3]);
            *(u32x2*)(act + (size_t)(r0 + i) * DFF + f) = w;
            g2 = g1; g1 = g0; v2 = v1; v1 = v0;
        }
    }
}

__device__ __forceinline__ float dppf(float x, const int ctrl_sel) {
    const int v = __builtin_bit_cast(int, x);
    int r;
    if (ctrl_sel == 0) r = __builtin_amdgcn_update_dpp(0, v, 0xB1, 0xF, 0xF, true);
    else if (ctrl_sel == 1) r = __builtin_amdgcn_update_dpp(0, v, 0x4E, 0xF, 0xF, true);
    else if (ctrl_sel == 2) r = __builtin_amdgcn_update_dpp(0, v, 0x141, 0xF, 0xF, true);
    else r = __builtin_amdgcn_update_dpp(0, v, 0x140, 0xF, 0xF, true);
    return __builtin_bit_cast(float, r);
}
__device__ __forceinline__ float red4(float x) { x += dppf(x, 0); x += dppf(x, 1); return x; }
__device__ __forceinline__ float red16(float x) { x += dppf(x, 0); x += dppf(x, 1); x += dppf(x, 2); x += dppf(x, 3); return x; }
__device__ __forceinline__ void unpack4(u32x2 w, float* f) {
    h16x4 h = __builtin_bit_cast(h16x4, w);
#pragma unroll
    for (int i = 0; i < 4; ++i) f[i] = (float)h[i];
}
constexpr int SCAN_BUF = 8256;
__device__ __forceinline__ void scan_phase(const Params& p, int j, unsigned char* smem) {
    const int tid = opaque_tid();
    const int wave = tid >> 6, lane = tid & 63, slot = wave >> 2, w4 = wave & 3;
    float* LB = (float*)smem + slot * (2 * SCAN_BUF);
    h16* r16 = (h16*)(p.ws + R_R16);
    const h16* k16 = (const h16*)(p.ws + R_K16);
    const h16* v16 = (j == 0) ? (const h16*)(p.ws + OFF_VF) : (const h16*)(p.ws + R_V16);
    const h16* g16 = (const h16*)(p.ws + R_G16);
    const h16* e16 = (const h16*)p.out;
    const h16* a16 = (const h16*)p.out + (size_t)MTOK * 1024;
    const int tp = w4 * 4 + (lane >> 4), k4 = (lane & 15) * 4;
    const int vrow = w4 * 16 + (lane >> 2), kq = lane & 3;
    for (int pair = blockIdx.x; pair < 256; pair += gridDim.x) {
        const int chain = pair * 2 + slot, b = chain >> 4, h = chain & 15;
        const int col = h * 64 + k4;
        const f32x4 c_kk = *(const f32x4*)(p.in[16] + j * 1024 + col), c_ka = *(const f32x4*)(p.in[17] + j * 1024 + col), c_rk = *(const f32x4*)(p.in[18] + j * 1024 + col);
        const f32x4 c_lg = *(const f32x4*)(p.in[19] + j * 1024 + col), c_lb = *(const f32x4*)(p.in[20] + j * 1024 + col);
        f32x2 S[8];
#pragma unroll
        for (int i = 0; i < 8; ++i) S[i] = (f32x2){0.f, 0.f};
        u32x2 pr[6];
        {
            const size_t go = ((size_t)(b * 2048 + tp)) * 1024 + col;
            pr[0] = *(const u32x2*)(r16 + go); pr[1] = *(const u32x2*)(k16 + go); pr[2] = *(const u32x2*)(v16 + go);
            pr[3] = *(const u32x2*)(e16 + go); pr[4] = *(const u32x2*)(a16 + go); pr[5] = *(const u32x2*)(g16 + go);
        }
        for (int ch = 0; ch < 128; ++ch) {
            float* BUF = LB + (ch & 1) * SCAN_BUF;
            float* OPS = BUF; float* VB = BUF + 5120; float* GB = BUF + 6144; float* YB = BUF + 7168; float* BON = BUF + 8192;
            {
                float rf[4], kf[4], vf[4], ef[4], af[4], gf[4];
                unpack4(pr[0], rf); unpack4(pr[1], kf); unpack4(pr[2], vf); unpack4(pr[3], ef); unpack4(pr[4], af); unpack4(pr[5], gf);
                float kk[4]; float ss = 0.f;
#pragma unroll
                for (int i = 0; i < 4; ++i) { kk[i] = kf[i] * c_kk[i]; ss += kk[i] * kk[i]; }
                ss = red16(ss);
                const float inv = 1.0f / fmaxf(sqrtf(ss), 1e-12f);
                f32x4 A4, B4, W4, K4, R4; float bs = 0.f;
#pragma unroll
                for (int i = 0; i < 4; ++i) {
                    const float kn = kk[i] * inv;
                    A4[i] = -kn; B4[i] = kn * af[i];
                    W4[i] = __expf(-ef[i]);
                    const float km = kf[i] * (1.0f + (af[i] - 1.0f) * c_ka[i]);
                    K4[i] = km; R4[i] = rf[i];
                    bs += rf[i] * km * c_rk[i];
                }
                bs = red16(bs);
                float* o = OPS + tp * 320 + k4;
                *(f32x4*)(o) = A4; *(f32x4*)(o + 64) = B4; *(f32x4*)(o + 128) = W4; *(f32x4*)(o + 192) = K4; *(f32x4*)(o + 256) = R4;
                *(f32x4*)(VB + tp * 64 + k4) = (f32x4){vf[0], vf[1], vf[2], vf[3]};
                *(f32x4*)(GB + tp * 64 + k4) = (f32x4){gf[0], gf[1], gf[2], gf[3]};
                if ((lane & 15) == 0) BON[tp] = bs;
            }
            if (ch + 1 < 128) {
                const size_t go = ((size_t)(b * 2048 + (ch + 1) * 16 + tp)) * 1024 + col;
                pr[0] = *(const u32x2*)(r16 + go); pr[1] = *(const u32x2*)(k16 + go); pr[2] = *(const u32x2*)(v16 + go);
                pr[3] = *(const u32x2*)(e16 + go); pr[4] = *(const u32x2*)(a16 + go); pr[5] = *(const u32x2*)(g16 + go);
            }
            __syncthreads();
#pragma unroll 2
            for (int t = 0; t < 16; ++t) {
                const float* op = OPS + t * 320 + kq * 16;
                f32x4 A4[4], B4[4], W4[4], K4[4], R4[4];
#pragma unroll
                for (int i = 0; i < 4; ++i) A4[i] = *(const f32x4*)(op + i * 4);
#pragma unroll
                for (int i = 0; i < 4; ++i) { W4[i] = *(const f32x4*)(op + 128 + i * 4); B4[i] = *(const f32x4*)(op + 64 + i * 4); K4[i] = *(const f32x4*)(op + 192 + i * 4); }
#pragma unroll
                for (int i = 0; i < 4; ++i) R4[i] = *(const f32x4*)(op + 256 + i * 4);
                const float vv = VB[t * 64 + vrow];
                f32x2 s0 = {0.f, 0.f}, s1 = {0.f, 0.f};
#pragma unroll
                for (int i = 0; i < 4; ++i) { s0 += S[2 * i] * (f32x2){A4[i][0], A4[i][1]}; s1 += S[2 * i + 1] * (f32x2){A4[i][2], A4[i][3]}; }
                const float sa = red4((s0[0] + s0[1]) + (s1[0] + s1[1]));
                const f32x2 sa2 = {sa, sa}, vv2 = {vv, vv};
#pragma unroll
                for (int i = 0; i < 4; ++i) {
                    S[2 * i] = S[2 * i] * (f32x2){W4[i][0], W4[i][1]} + sa2 * (f32x2){B4[i][0], B4[i][1]} + vv2 * (f32x2){K4[i][0], K4[i][1]};
                    S[2 * i + 1] = S[2 * i + 1] * (f32x2){W4[i][2], W4[i][3]} + sa2 * (f32x2){B4[i][2], B4[i][3]} + vv2 * (f32x2){K4[i][2], K4[i][3]};
                }
                f32x2 y0 = {0.f, 0.f}, y1 = {0.f, 0.f};
#pragma unroll
                for (int i = 0; i < 4; ++i) { y0 += S[2 * i] * (f32x2){R4[i][0], R4[i][1]}; y1 += S[2 * i + 1] * (f32x2){R4[i][2], R4[i][3]}; }
                const float y = red4((y0[0] + y0[1]) + (y1[0] + y1[1]));
                if (kq == 0) YB[t * 64 + vrow] = y;
            }
            __syncthreads();
            {
                const f32x4 y4 = *(const f32x4*)(YB + tp * 64 + k4), v4 = *(const f32x4*)(VB + tp * 64 + k4), g4 = *(const f32x4*)(GB + tp * 64 + k4);
                const float mu = red16((y4[0] + y4[1]) + (y4[2] + y4[3])) * (1.0f / 64.0f);
                float q = 0.f;
#pragma unroll
                for (int i = 0; i < 4; ++i) { const float d = y4[i] - mu; q += d * d; }
                const float rstd = rsqrtf(red16(q) * (1.0f / 64.0f) + 64e-5f);
                const float bon = BON[tp];
                float o[4];
#pragma unroll
                for (int i = 0; i < 4; ++i) o[i] = ((y4[i] - mu) * rstd * c_lg[i] + c_lb[i] + bon * v4[i]) * g4[i];
                u32x2 w; w.x = pk2(o[0], o[1]); w.y = pk2(o[2], o[3]);
                *(u32x2*)(r16 + ((size_t)(b * 2048 + ch * 16 + tp)) * 1024 + col) = w;
            }
        }
        __syncthreads();
    }
}

__device__ __forceinline__ void dsa_norm_phase(const Params& p, int j, unsigned char* smem) {
    const int tid = opaque_tid();
    const int lane = tid & 63, wave = tid >> 6;
    const float* hin = (const float*)(p.ws + D_HIN);
    h16* cq = (h16*)(p.ws + D_CQ); h16* ckv = (h16*)(p.ws + D_CKV); h16* ckvt = (h16*)(p.ws + D_CKVT); h16* kidx = (h16*)(p.ws + D_KIDX);
    float* widx = (float*)(p.ws + D_WIDX);
    const f32x4 gq = *(const f32x4*)(p.in[23] + j * 256 + lane * 4);
    const f32x2 gkv = *(const f32x2*)(p.in[24] + j * 128 + lane * 2);
    const float gi = p.in[29][j * 64 + lane], bi = p.in[30][j * 64 + lane];
    h16* wl = (h16*)(smem + wave * 2048);
    for (int grp = blockIdx.x * 8 + wave; grp < MTOK / 8; grp += gridDim.x * 8) {
        const int r0 = grp * 8;
        for (int i = 0; i < 8; ++i) {
            const int row = r0 + i;
            const float* hp = hin + (size_t)row * 512;
            const f32x4 vq = *(const f32x4*)(hp + lane * 4);
            const f32x2 vk = *(const f32x2*)(hp + 256 + lane * 2);
            const float vi = hp[384 + lane];
            float ssq = wave_sum(vq[0] * vq[0] + vq[1] * vq[1] + vq[2] * vq[2] + vq[3] * vq[3]);
            const float rq = rsqrtf(ssq * (1.0f / 256.0f) + 1e-6f);
            u32x2 w; w.x = pk2(vq[0] * rq * gq[0], vq[1] * rq * gq[1]); w.y = pk2(vq[2] * rq * gq[2], vq[3] * rq * gq[3]);
            *(u32x2*)(cq + (size_t)row * 256 + lane * 4) = w;
            float ssk = wave_sum(vk[0] * vk[0] + vk[1] * vk[1]);
            const float rk = rsqrtf(ssk * (1.0f / 128.0f) + 1e-6f);
            const unsigned wk = pk2(vk[0] * rk * gkv[0], vk[1] * rk * gkv[1]);
            *(unsigned*)(ckv + (size_t)row * 128 + lane * 2) = wk;
            *(unsigned*)(wl + i * 128 + lane * 2) = wk;
            const float mu = wave_sum(vi) * (1.0f / 64.0f);
            const float dv = vi - mu;
            const float var = wave_sum(dv * dv) * (1.0f / 64.0f);
            kidx[(size_t)row * 64 + lane] = (h16)(dv * rsqrtf(var + 1e-5f) * gi + bi);
            if (lane < 8) widx[(size_t)row * 8 + lane] = hp[448 + lane] * 0.044194173824159216f;
        }
        asm volatile("s_waitcnt lgkmcnt(0)" ::: "memory");
        const int b = r0 >> 11, t0 = r0 & 2047;
#pragma unroll
        for (int dd = 0; dd < 2; ++dd) {
            const int d = lane * 2 + dd;
            h16x8 hv;
#pragma unroll
            for (int i = 0; i < 8; ++i) hv[i] = wl[i * 128 + d];
            *(h16x8*)(ckvt + ((size_t)(b * 128 + d)) * 2048 + t0) = hv;
        }
        asm volatile("s_waitcnt lgkmcnt(0)" ::: "memory");
    }
}

constexpr int ROWP = 2052;
__device__ __forceinline__ unsigned fkey(float x) {
    if (x == 0.0f) x = 0.0f;
    const unsigned u = __float_as_uint(x);
    return (u & 0x80000000u) ? ~u : (u | 0x80000000u);
}
__device__ __forceinline__ void dsa_index_phase(const Params& p, unsigned char* smem) {
    const int tid = opaque_tid(), wave = tid >> 6, lane = tid & 63, r = lane & 15, q = lane >> 4;
    float* SC = (float*)smem;
    const h16* qidx = (const h16*)(p.ws + D_QIDX);
    const h16* kidx = (const h16*)(p.ws + D_KIDX);
    const float* widx = (const float*)(p.ws + D_WIDX);
    unsigned* maskb = (unsigned*)(p.ws + D_MASK);
    for (int qt = blockIdx.x; qt < MTOK / 16; qt += gridDim.x) {
        const int row0 = qt * 16, b = row0 >> 11, t0 = row0 & 2047;
        const int nkt = (t0 >> 4) + 1;
        {
            h16x8 qf[8][2]; float wq[8];
#pragma unroll
            for (int h = 0; h < 8; ++h) {
#pragma unroll
                for (int kk = 0; kk < 2; ++kk) qf[h][kk] = *(const h16x8*)(qidx + (size_t)(row0 + r) * 512 + h * 64 + kk * 32 + q * 8);
                wq[h] = widx[(size_t)(row0 + r) * 8 + h];
            }
            for (int kt = wave; kt < nkt; kt += 8) {
                const int s0 = kt * 16;
                const h16* kp = kidx + (size_t)(b * 2048 + s0 + r) * 64 + q * 8;
                const h16x8 k0 = *(const h16x8*)kp, k1 = *(const h16x8*)(kp + 32);
                f32x4 sc = {0.f, 0.f, 0.f, 0.f};
#pragma unroll
                for (int h = 0; h < 8; ++h) {
                    f32x4 acc = {0.f, 0.f, 0.f, 0.f};
                    acc = __builtin_amdgcn_mfma_f32_16x16x32_f16(k0, qf[h][0], acc, 0, 0, 0);
                    acc = __builtin_amdgcn_mfma_f32_16x16x32_f16(k1, qf[h][1], acc, 0, 0, 0);
#pragma unroll
                    for (int jj = 0; jj < 4; ++jj) sc[jj] += fmaxf(acc[jj], 0.f) * wq[h];
                }
                *(f32x4*)(SC + r * ROWP + s0 + q * 4) = sc;
            }
        }
        __syncthreads();
        for (int qq = 0; qq < 2; ++qq) {
            const int ql = wave * 2 + qq, t = t0 + ql;
            const float* srow = SC + ql * ROWP;
            const int ni = (t >> 6) + 1;
            unsigned u[32];
#pragma unroll
            for (int i = 0; i < 32; ++i) {
                u[i] = 0u;
                if (i < ni) { const int s = i * 64 + lane; if (s <= t) u[i] = fkey(srow[s]); }
            }
            unsigned myw = 0u;
            if (t < 256) {
#pragma unroll
                for (int i = 0; i < 32; ++i) { const unsigned long long sm = __ballot(u[i] != 0u); if ((lane >> 1) == i) myw = (lane & 1) ? (unsigned)(sm >> 32) : (unsigned)sm; }
            } else {
                unsigned T = 0u;
                for (int bit = 31; bit >= 0; --bit) {
                    const unsigned cand = T | (1u << bit);
                    int cnt = 0;
#pragma unroll
                    for (int i = 0; i < 32; ++i) if (i < ni) cnt += __popcll(__ballot(u[i] >= cand));
                    if (cnt >= 256) T = cand;
                }
                int cgt = 0;
#pragma unroll
                for (int i = 0; i < 32; ++i) if (i < ni) cgt += __popcll(__ballot(u[i] > T));
                const int need = 256 - cgt;
                int running = 0;
                const unsigned long long lt = (lane == 0) ? 0ull : (~0ull >> (64 - lane));
#pragma unroll
                for (int i = 0; i < 32; ++i) {
                    if (i < ni) {
                        const unsigned long long eq = __ballot(u[i] == T);
                        const int rank = running + __popcll(eq & lt);
                        const unsigned long long sm = __ballot(u[i] > T || (u[i] == T && rank < need));
                        running += __popcll(eq);
                        if ((lane >> 1) == i) myw = (lane & 1) ? (unsigned)(sm >> 32) : (unsigned)sm;
                    }
                }
            }
            maskb[(size_t)(row0 + ql) * 64 + lane] = myw;
        }
        __syncthreads();
    }
}

constexpr int AT_KROW = 272, AT_VROW = 144, AT_KBYTES = 64 * AT_KROW, AT_VBYTES = 128 * AT_VROW, AT_STAGE = AT_KBYTES + AT_VBYTES, AT_BL = 2 * AT_STAGE;
__device__ __forceinline__ void dsa_attn_phase(const Params& p, int j, unsigned char* smem) {
    const int tid = opaque_tid(), wave = tid >> 6, lane = tid & 63, r = lane & 15, q = lane >> 4;
    float* BL = (float*)(smem + AT_BL);
    for (int idx = tid; idx < 16 * 129; idx += 512) {
        const int h = idx / 129, d = idx % 129;
        int bk = d;
        if (d >= 16) { bk = 16 + (int)(logf((float)d * (1.0f / 16.0f)) / 2.0794415416798357f * 16.0f); bk = bk > 31 ? 31 : bk; }
        BL[h * 132 + d] = p.in[32][bk * 16 + h];
    }
    __syncthreads();
    const h16* qabs = (const h16*)(p.ws + D_QABS);
    const h16* ckv = (const h16*)(p.ws + D_CKV);
    const h16* ckvt = (const h16*)(p.ws + D_CKVT);
    const unsigned* maskb = (const unsigned*)(p.ws + D_MASK);
    h16* o16 = (h16*)(p.ws + D_O16);
    const h16* wuvt = w_dsa_uvt(p.ws, j);
    const float NINF = -__builtin_inff();
    const int krow0 = tid >> 4, kcc = tid & 15, vrow0 = tid >> 3, vcc = tid & 7;
    for (int qt = blockIdx.x; qt < MTOK / 16; qt += gridDim.x) {
        const int row0 = qt * 16, b = row0 >> 11, t0 = row0 & 2047, nst = (t0 + 16 + 63) >> 6, tq = t0 + r;
        const h16* kg = ckv + (size_t)(b * 2048) * 128;
        const h16* vg = ckvt + (size_t)(b * 128) * 2048;
        u32x4 sk[2], sv[2];
#pragma unroll
        for (int i = 0; i < 2; ++i) {
            sk[i] = *(const u32x4*)(kg + (size_t)(krow0 + i * 32) * 128 + kcc * 8);
            sv[i] = *(const u32x4*)(vg + (size_t)(vrow0 + i * 64) * 2048 + vcc * 8);
        }
        h16x8 qf[2][4];
#pragma unroll
        for (int hh = 0; hh < 2; ++hh)
#pragma unroll
            for (int kk = 0; kk < 4; ++kk) qf[hh][kk] = *(const h16x8*)(qabs + (size_t)(row0 + r) * 2048 + (2 * wave + hh) * 128 + kk * 32 + q * 8);
        f32x4 O[2][8];
#pragma unroll
        for (int hh = 0; hh < 2; ++hh)
#pragma unroll
            for (int dt = 0; dt < 8; ++dt) O[hh][dt] = (f32x4){0.f, 0.f, 0.f, 0.f};
        float mrun[2] = {NINF, NINF}, lrun[2] = {0.f, 0.f};
#pragma unroll
        for (int i = 0; i < 2; ++i) {
            *(u32x4*)(smem + (krow0 + i * 32) * AT_KROW + kcc * 16) = sk[i];
            *(u32x4*)(smem + AT_KBYTES + (vrow0 + i * 64) * AT_VROW + vcc * 16) = sv[i];
        }
        __syncthreads();
        for (int st = 0; st < nst; ++st) {
            const int s0 = st * 64;
            const unsigned char* Kb = smem + (st & 1) * AT_STAGE;
            const unsigned char* Vb = Kb + AT_KBYTES;
            const u32x2 mw2 = *(const u32x2*)(maskb + (size_t)(row0 + r) * 64 + st * 2);
            if (st + 1 < nst) {
#pragma unroll
                for (int i = 0; i < 2; ++i) {
                    sk[i] = *(const u32x4*)(kg + (size_t)(s0 + 64 + krow0 + i * 32) * 128 + kcc * 8);
                    sv[i] = *(const u32x4*)(vg + (size_t)(vrow0 + i * 64) * 2048 + s0 + 64 + vcc * 8);
                }
            }
#pragma nounroll
            for (int hf = 0; hf < 2; ++hf) {
                const unsigned mw = hf ? mw2.y : mw2.x;
                h16x8 pf[2]; float alpha[2];
#pragma unroll
                for (int hh = 0; hh < 2; ++hh) {
                    const int h = 2 * wave + hh;
                    f32x4 sc[2];
#pragma unroll
                    for (int tt = 0; tt < 2; ++tt) {
                        f32x4 acc = {0.f, 0.f, 0.f, 0.f};
#pragma unroll
                        for (int kk = 0; kk < 4; ++kk) {
                            const h16x8 kf = *(const h16x8*)(Kb + (hf * 32 + tt * 16 + r) * AT_KROW + kk * 64 + q * 16);
                            acc = __builtin_amdgcn_mfma_f32_16x16x32_f16(kf, qf[hh][kk], acc, 0, 0, 0);
                        }
                        sc[tt] = acc;
                    }
                    float x[8]; float mx = NINF;
#pragma unroll
                    for (int tt = 0; tt < 2; ++tt)
#pragma unroll
                        for (int jj = 0; jj < 4; ++jj) {
                            const int kix = tt * 16 + q * 4 + jj;
                            int dist = tq - (s0 + hf * 32 + kix); dist = dist < 0 ? 0 : (dist > 128 ? 128 : dist);
                            const float v = sc[tt][jj] + BL[h * 132 + dist];
                            const float xv = ((mw >> kix) & 1u) ? v : NINF;
                            x[tt * 4 + jj] = xv; mx = fmaxf(mx, xv);
                        }
                    mx = fmaxf(mx, __shfl_xor(mx, 16)); mx = fmaxf(mx, __shfl_xor(mx, 32));
                    const float mnew = fmaxf(mrun[hh], mx);
                    const float mref = (mnew == NINF) ? 0.f : mnew;
                    alpha[hh] = __expf(mrun[hh] - mref);
                    mrun[hh] = mnew;
                    float ps = 0.f;
#pragma unroll
                    for (int i = 0; i < 8; ++i) { const float pv = __expf(x[i] - mref); ps += pv; pf[hh][i] = (h16)pv; }
                    lrun[hh] = lrun[hh] * alpha[hh] + ps;
                    __builtin_amdgcn_sched_barrier(0);
                }
#pragma unroll
                for (int dt = 0; dt < 8; ++dt) {
                    if ((dt & 1) == 0) __builtin_amdgcn_sched_barrier(0);
                    const unsigned char* vp = Vb + (dt * 16 + r) * AT_VROW + (hf * 32 + q * 4) * 2;
                    const h16x4 lo = *(const h16x4*)vp, hi = *(const h16x4*)(vp + 32);
                    const h16x8 vf = {lo[0], lo[1], lo[2], lo[3], hi[0], hi[1], hi[2], hi[3]};
#pragma unroll
                    for (int hh = 0; hh < 2; ++hh) {
                        O[hh][dt] *= alpha[hh];
                        O[hh][dt] = __builtin_amdgcn_mfma_f32_16x16x32_f16(vf, pf[hh], O[hh][dt], 0, 0, 0);
                    }
                }
                __builtin_amdgcn_sched_barrier(0);
            }
            if (st + 1 < nst) {
                unsigned char* Kn = smem + ((st + 1) & 1) * AT_STAGE;
#pragma unroll
                for (int i = 0; i < 2; ++i) {
                    *(u32x4*)(Kn + (krow0 + i * 32) * AT_KROW + kcc * 16) = sk[i];
                    *(u32x4*)(Kn + AT_KBYTES + (vrow0 + i * 64) * AT_VROW + vcc * 16) = sv[i];
                }
            }
            __syncthreads();
        }
#pragma unroll
        for (int hh = 0; hh < 2; ++hh) {
            const int h = 2 * wave + hh;
            float lt = lrun[hh]; lt += __shfl_xor(lt, 16); lt += __shfl_xor(lt, 32);
            const float inv = 1.0f / lt;
#pragma unroll
            for (int vt = 0; vt < 4; ++vt) {
                f32x4 acc = {0.f, 0.f, 0.f, 0.f};
#pragma unroll
                for (int kk = 0; kk < 4; ++kk) {
                    const h16* ap = wuvt + (size_t)(h * 64 + vt * 16 + r) * 128 + kk * 32 + q * 4;
                    const h16x4 lo = *(const h16x4*)ap, hi = *(const h16x4*)(ap + 16);
                    const h16x8 a8 = {lo[0], lo[1], lo[2], lo[3], hi[0], hi[1], hi[2], hi[3]};
                    h16x8 b8;
#pragma unroll
                    for (int i = 0; i < 4; ++i) { b8[i] = (h16)(O[hh][2 * kk][i] * inv); b8[4 + i] = (h16)(O[hh][2 * kk + 1][i] * inv); }
                    acc = __builtin_amdgcn_mfma_f32_16x16x32_f16(a8, b8, acc, 0, 0, 0);
                }
                u32x2 w; w.x = pk2(acc[0], acc[1]); w.y = pk2(acc[2], acc[3]);
                *(u32x2*)(o16 + (size_t)(row0 + r) * 1024 + h * 64 + vt * 16 + q * 4) = w;
            }
        }
    }
    __syncthreads();
}

__global__ void __launch_bounds__(512) mega_fwd(Params p) {
    extern __shared__ __attribute__((aligned(16))) unsigned char smem[];
    cg::grid_group grid = cg::this_grid();
    unsigned char* ws = p.ws;
    h16* x16 = (h16*)(ws + OFF_X16);
    for (int ph = p.ph_lo; ph < p.ph_hi; ++ph) {
        const unsigned e = p.prog[ph];
        const int kind = e & 15, L = (e >> 4) & 3, sub = (e >> 6) & 1, j = L >> 1;
        const int nrep = 1 + (int)(e >> 7);
        for (int rep = 0; rep < nrep; ++rep) {
        if (rep) grid.sync();
        const bool isgemm = (kind == K_R1 || kind == K_R2 || kind == K_R4 || kind == K_F1 || kind == K_F3 || kind == K_D1 || kind == K_D3 || kind == K_D6);
        if (isgemm) {
            pg8::Gemm g; pg8::Epi E;
            g.M = MTOK; g.N = 1024; g.K = 1024; g.lda = 1024; g.amode = 0; g.pm0 = 0; g.A = x16; g.Bt = x16;
            E.mode = E_RESID; E.pm0 = 0; E.j = j; E.ws = ws; E.out = p.out; E.bias0 = p.in[5] + j * 1024; E.bias1 = p.in[8] + j * 1024; E.bias2 = p.in[11];
            if (kind == K_R1) {
                g.Bt = w_rwkv_big(ws, j); g.N = 3584; g.K = 2048; g.amode = 1; E.mode = E_RPROJ;
            } else if (kind == K_R2) {
                g.A = (const h16*)(ws + R_HACT); g.Bt = w_rwkv_l2(ws, j); g.N = (j == 0) ? 3072 : 4096; g.K = 512; g.lda = 512; E.mode = E_LORA2;
            } else if (kind == K_R4) {
                g.A = (const h16*)(ws + R_R16); g.Bt = w_rwkv_o(ws, j);
            } else if (kind == K_F1) {
                g.Bt = w_ffn_up(ws, L); g.M = MTOK / 2; g.N = 5632; g.amode = 1; g.pm0 = sub * 128; E.mode = E_ST16;
            } else if (kind == K_F3) {
                g.A = (const h16*)(ws + F_ACT); g.Bt = w_ffn_dn(ws, L); g.M = MTOK / 2; g.K = 2816; g.lda = 2816; E.pm0 = sub * 128;
            } else if (kind == K_D1) {
                g.Bt = w_dsa_in(ws, j); g.N = 512; g.amode = 1; E.mode = E_ST32;
            } else if (kind == K_D3) {
                g.A = (const h16*)(ws + D_CQ); g.Bt = w_dsa_q(ws, j); g.N = 2560; g.K = 256; g.lda = 256; E.mode = E_QPROJ;
            } else {
                g.A = (const h16*)(ws + D_O16); g.Bt = w_dsa_o(ws, j);
            }
            pg8::StaticOrder S; S.init(g.M, g.N, (int)gridDim.x, (int)blockIdx.x);
#ifndef NO_GEMM
            pg8::gemm_phase((LAS unsigned char*)smem, g, S, E);
#endif
        } else if (kind == K_PREP) {
#ifndef NO_PREP
            prep_phase(p, smem);
#endif
        } else if (kind == K_R3) {
#ifndef NO_SCAN
            scan_phase(p, j, smem);
#endif
        } else if (kind == K_LN) {
#ifndef NO_LN
            ln_phase(p, p.in[1] + (L * 2 + sub) * 1024, p.in[2] + (L * 2 + sub) * 1024, L == 3 && sub == 1);
#endif
        } else if (kind == K_F2) {
#ifndef NO_CONV
            conv_phase(p, L);
#endif
        } else if (kind == K_D2) {
#ifndef NO_NORM
            dsa_norm_phase(p, j, smem);
#endif
        } else if (kind == K_D4) {
#ifndef NO_INDEX
            dsa_index_phase(p, smem);
#endif
        } else if (kind == K_D5) {
#ifndef NO_ATTN
            dsa_attn_phase(p, j, smem);
#endif
        }
        }
        if (ph + 1 < p.ph_hi) grid.sync();
    }
}

extern "C" void kernel_launch(void* const* d_in, const int* in_sizes, int n_in, void* d_out, int out_size, void* d_ws, size_t ws_size, hipStream_t stream) {
    static int grid_blocks = 0;
    if (grid_blocks == 0) {
        if (n_in != 37 || ws_size < WS_NEED || out_size != MTOK * DM) { fprintf(stderr, "kernel_launch: unexpected problem (n_in %d ws %zu out %d)\n", n_in, ws_size, out_size); grid_blocks = -1; return; }
        int dev = 0, cus = 0, per_cu = 0;
        hipGetDevice(&dev);
        hipDeviceGetAttribute(&cus, hipDeviceAttributeMultiprocessorCount, dev);
        if (hipFuncSetAttribute((const void*)mega_fwd, hipFuncAttributeMaxDynamicSharedMemorySize, LDS_BYTES) != hipSuccess) { fprintf(stderr, "kernel_launch: hipFuncSetAttribute failed\n"); grid_blocks = -1; return; }
        hipOccupancyMaxActiveBlocksPerMultiprocessor(&per_cu, (const void*)mega_fwd, 512, LDS_BYTES);
        if (per_cu < 1) { fprintf(stderr, "kernel_launch: occupancy query says %d blocks/CU\n", per_cu); per_cu = 1; }
        (void)hipGetLastError();
        grid_blocks = cus * per_cu;
        fprintf(stderr, "kernel_launch: grid %d (cus %d x %d)\n", grid_blocks, cus, per_cu);
    }
    if (grid_blocks < 0) return;
    Params p{};
    for (int i = 0; i < 37; ++i) p.in[i] = (const float*)d_in[i];
    p.ws = (unsigned char*)d_ws; p.out = (float*)d_out;
    int np = 0;
    constexpr int PROBE_KIND = -1;
    auto add = [&](int kind, int L, int sub) { p.prog[np++] = (unsigned char)(kind | (L << 4) | (sub << 6) | ((kind == PROBE_KIND) ? 128 : 0)); };
    add(K_PREP, 0, 0);
    for (int L = 0; L < 4; ++L) {
        if ((L & 1) == 0) { add(K_R1, L, 0); add(K_R2, L, 0); add(K_R3, L, 0); add(K_R4, L, 0); }
        else { add(K_D1, L, 0); add(K_D2, L, 0); add(K_D3, L, 0); add(K_D4, L, 0); add(K_D5, L, 0); add(K_D6, L, 0); }
        add(K_LN, L, 0);
        for (int c = 0; c < 2; ++c) { add(K_F1, L, c); add(K_F2, L, c); add(K_F3, L, c); }
        add(K_LN, L, 1);
    }
#if SINGLE_LAUNCH
    p.ph_lo = 0; p.ph_hi = np;
    void* args[] = {&p};
    hipError_t e = hipLaunchCooperativeKernel((const void*)mega_fwd, dim3(grid_blocks), dim3(512), args, LDS_BYTES, stream);
    if (e != hipSuccess) fprintf(stderr, "cooperative launch failed: %s (grid %d)\n", hipGetErrorString(e), grid_blocks);
#else
    for (int ph = 0; ph < np; ++ph) {
        p.ph_lo = ph; p.ph_hi = ph + 1;
        hipLaunchKernelGGL(mega_fwd, dim3(grid_blocks), dim3(512), LDS_BYTES, stream, p);
    }
#endif
}
```

```cpp
#include <hip/hip_runtime.h>
#include <hip/hip_cooperative_groups.h>
#include <cstdio>
namespace cg = cooperative_groups;

#ifndef SINGLE_LAUNCH
#define SINGLE_LAUNCH 1
#endif

#define LAS __attribute__((address_space(3)))
typedef _Float16 h16;
typedef _Float16 h16x8 __attribute__((ext_vector_type(8)));
typedef _Float16 h16x4 __attribute__((ext_vector_type(4)));
typedef _Float16 h16x2 __attribute__((ext_vector_type(2)));
typedef float f32x4 __attribute__((ext_vector_type(4)));
typedef float f32x2 __attribute__((ext_vector_type(2)));
typedef unsigned u32x4 __attribute__((ext_vector_type(4)));
typedef unsigned u32x2 __attribute__((ext_vector_type(2)));

constexpr int DM = 1024, SEQ = 2048, NBATCH = 32, MTOK = NBATCH * SEQ;
constexpr int DFF = 2816;
constexpr size_t MiB = (size_t)1 << 20;
constexpr float DN_ALPHA = 1.6817928305074290f;
constexpr int LDS_BYTES = 147456;

constexpr size_t OFF_W = 0;
constexpr size_t OFF_X16 = 118 * MiB;
constexpr size_t OFF_VF = 247 * MiB;
constexpr size_t OFF_R = 375 * MiB;
constexpr size_t WS_NEED = 951 * MiB;
constexpr size_t R_R16 = OFF_R, R_K16 = OFF_R + 128 * MiB, R_V16 = OFF_R + 256 * MiB, R_G16 = OFF_R + 384 * MiB, R_HACT = OFF_R + 512 * MiB;
constexpr size_t F_U16 = OFF_R, F_ACT = OFF_R + 352 * MiB;
constexpr size_t D_HIN = OFF_R, D_O16 = OFF_R, D_QABS = OFF_R + 128 * MiB, D_QIDX = OFF_R + 384 * MiB, D_CQ = OFF_R + 448 * MiB,
                 D_CKV = OFF_R + 480 * MiB, D_CKVT = OFF_R + 496 * MiB, D_KIDX = OFF_R + 512 * MiB, D_WIDX = OFF_R + 520 * MiB, D_MASK = OFF_R + 522 * MiB;

struct Params {
    const float* in[37];
    unsigned char* ws;
    float* out;
    int ph_lo, ph_hi;
    unsigned char prog[64];
};

enum { K_PREP = 0, K_R1, K_R2, K_R3, K_R4, K_LN, K_F1, K_F2, K_F3, K_D1, K_D2, K_D3, K_D4, K_D5, K_D6 };
enum { E_RPROJ = 0, E_LORA2, E_RESID, E_ST16, E_ST32, E_QPROJ };

__device__ __forceinline__ size_t xrow(int row) { return (size_t)(row >> 11) * 2049 + 1 + (row & 2047); }
__device__ __forceinline__ unsigned pk2(float a, float b) { h16x2 h = {(h16)a, (h16)b}; return __builtin_bit_cast(unsigned, h); }
__device__ __forceinline__ u32x4 pack8(f32x4 a, f32x4 b) { u32x4 w; w.x = pk2(a[0], a[1]); w.y = pk2(a[2], a[3]); w.z = pk2(b[0], b[1]); w.w = pk2(b[2], b[3]); return w; }
__device__ __forceinline__ void unpack8(u32x4 w, float* f) {
    h16x8 h = __builtin_bit_cast(h16x8, w);
#pragma unroll
    for (int i = 0; i < 8; ++i) f[i] = (float)h[i];
}
__device__ __forceinline__ float sigmoidf_(float x) { return 1.0f / (1.0f + __expf(-x)); }
__device__ __forceinline__ float wave_sum(float v) {
#pragma unroll
    for (int o = 32; o > 0; o >>= 1) v += __shfl_xor(v, o);
    return v;
}
#define WSYNC() asm volatile("s_waitcnt vmcnt(0) lgkmcnt(0)" ::: "memory")
__device__ __forceinline__ int opaque_tid() { int t = threadIdx.x; asm volatile("" : "+v"(t)); return t; }

namespace pg8 {
constexpr int BM = 256, BK = 64, HALF = 128, HTB = HALF * BK * 2, STAGE_BYTES = 8 * HTB, NXCD = 8, WGM = 8;
__device__ __forceinline__ int lds_byte(int r, int c) { const int st = (r >> 4) * 2 + (c >> 5), rr = r & 15, cc = c & 31, ob = rr * 64 + cc * 2; return st * 1024 + (ob ^ (((ob >> 9) & 1) << 5)); }
__device__ __forceinline__ void stage_rc(int b, int& R, int& C) { const int st = b / 1024, sb = b % 1024, swz = sb ^ (((sb >> 9) & 1) << 5); R = (st >> 1) * 16 + swz / 64; C = (st & 1) * 32 + (swz % 64) / 2; }
__device__ __forceinline__ int perm32(int rho) { const int n = rho >> 4, i = rho & 15; return 8 * (i >> 2) + 4 * n + (i & 3); }
struct Unit { int pm, pn; };
struct Gemm { const h16* A; const h16* Bt; int M, N, K, lda, amode, pm0; };
struct StaticOrder {
    int nM, nN, nwg, G, c;
    __device__ void init(int M, int N, int G_, int c_) { nM = M / BM; nN = N / BM; nwg = nM * nN; G = G_; c = c_; }
    __device__ bool next(int i, Unit& u) const {
        const long L = (long)i * G + c; if (L >= nwg) return false;
        int wgid = (int)L; { const int q = nwg / NXCD, r = nwg % NXCD, xcd = wgid % NXCD, off = wgid / NXCD; wgid = (xcd < r ? xcd * (q + 1) : r * (q + 1) + (xcd - r) * q) + off; }
        const int nig = WGM * nN, gid = wgid / nig, fm = gid * WGM, gsz = (nM - fm) < WGM ? (nM - fm) : WGM;
        u.pm = fm + ((wgid % nig) % gsz); u.pn = (wgid % nig) / gsz; return true;
    }
};

struct Epi {
    int mode, pm0, j;
    unsigned char* ws; float* out; const float* bias0; const float* bias1; const float* bias2;
    __device__ __forceinline__ void operator()(const f32x4 (&acc)[2][2][4][2], const Unit& u, int wr, int wc, int fr, int fq) const {
        const int rowl0 = u.pm * BM + wr * 64 + fr;
        const int colt = u.pn * BM + wc * 32 + 8 * fq;
#pragma unroll
        for (int ai = 0; ai < 2; ++ai)
#pragma unroll
            for (int m = 0; m < 4; ++m) {
                const int rowl = rowl0 + ai * HALF + m * 16;
                const int rowg = rowl + pm0 * BM;
#pragma unroll
                for (int bj = 0; bj < 2; ++bj) {
                    const int col = colt + bj * HALF;
                    f32x4 v0 = acc[ai][bj][m][0], v1 = acc[ai][bj][m][1];
                    if (mode == E_RPROJ) {
                        if (u.pn < 12) {
                            h16* dst = (h16*)(ws + (u.pn < 4 ? R_R16 : (u.pn < 8 ? R_K16 : (j == 0 ? OFF_VF : R_V16))));
                            *(u32x4*)(dst + (size_t)rowg * 1024 + (col & 1023)) = pack8(v0, v1);
                        } else {
                            const int hc = col - 3072;
                            if (hc < 64) {
#pragma unroll
                                for (int jj = 0; jj < 4; ++jj) { v0[jj] = tanhf(v0[jj]); v1[jj] = tanhf(v1[jj]); }
                            } else if (hc >= 160) {
#pragma unroll
                                for (int jj = 0; jj < 4; ++jj) { v0[jj] = sigmoidf_(v0[jj]); v1[jj] = sigmoidf_(v1[jj]); }
                            }
                            *(u32x4*)((h16*)(ws + R_HACT) + (size_t)rowg * 512 + hc) = pack8(v0, v1);
                        }
                    } else if (mode == E_LORA2) {
                        const int grp = u.pn >> 2, c = col & 1023;
                        const size_t off = (size_t)rowg * 1024 + c;
                        if (grp == 0) {
                            const f32x4 ba = *(const f32x4*)(bias0 + c), bb = *(const f32x4*)(bias0 + c + 4);
#pragma unroll
                            for (int jj = 0; jj < 4; ++jj) { v0[jj] = sigmoidf_(v0[jj] + ba[jj]) * 0.6065306597f; v1[jj] = sigmoidf_(v1[jj] + bb[jj]) * 0.6065306597f; }
                            *(u32x4*)((h16*)out + off) = pack8(v0, v1);
                        } else if (grp == 1) {
                            const f32x4 ba = *(const f32x4*)(bias1 + c), bb = *(const f32x4*)(bias1 + c + 4);
#pragma unroll
                            for (int jj = 0; jj < 4; ++jj) { v0[jj] = sigmoidf_(v0[jj] + ba[jj]); v1[jj] = sigmoidf_(v1[jj] + bb[jj]); }
                            *(u32x4*)((h16*)out + (size_t)MTOK * 1024 + off) = pack8(v0, v1);
                        } else if (grp == 2) {
                            *(u32x4*)((h16*)(ws + R_G16) + off) = pack8(v0, v1);
                        } else {
                            const f32x4 ba = *(const f32x4*)(bias2 + c), bb = *(const f32x4*)(bias2 + c + 4);
                            float vv[8], vf8[8];
                            h16* vp = (h16*)(ws + R_V16) + off;
                            unpack8(*(const u32x4*)vp, vv); unpack8(*(const u32x4*)((const h16*)(ws + OFF_VF) + off), vf8);
#pragma unroll
                            for (int jj = 0; jj < 4; ++jj) {
                                v0[jj] = vv[jj] + (vf8[jj] - vv[jj]) * sigmoidf_(v0[jj] + ba[jj]);
                                v1[jj] = vv[4 + jj] + (vf8[4 + jj] - vv[4 + jj]) * sigmoidf_(v1[jj] + bb[jj]);
                            }
                            *(u32x4*)vp = pack8(v0, v1);
                        }
                    } else if (mode == E_RESID) {
                        float xr[8];
                        unpack8(*(const u32x4*)((const h16*)(ws + OFF_X16) + xrow(rowg) * 1024 + col), xr);
                        f32x4 r0, r1;
#pragma unroll
                        for (int jj = 0; jj < 4; ++jj) { r0[jj] = DN_ALPHA * xr[jj] + v0[jj]; r1[jj] = DN_ALPHA * xr[4 + jj] + v1[jj]; }
                        float* dp = out + (size_t)rowg * 1024 + col;
                        *(f32x4*)dp = r0; *(f32x4*)(dp + 4) = r1;
                    } else if (mode == E_ST16) {
                        *(u32x4*)((h16*)(ws + F_U16) + (size_t)rowl * 5632 + col) = pack8(v0, v1);
                    } else if (mode == E_ST32) {
                        float* dp = (float*)(ws + D_HIN) + (size_t)rowg * 512 + col;
                        *(f32x4*)dp = v0; *(f32x4*)(dp + 4) = v1;
                    } else {
                        if (u.pn < 8) *(u32x4*)((h16*)(ws + D_QABS) + (size_t)rowg * 2048 + col) = pack8(v0, v1);
                        else *(u32x4*)((h16*)(ws + D_QIDX) + (size_t)rowg * 512 + (col - 2048)) = pack8(v0, v1);
                    }
                }
            }
    }
};

__device__ __forceinline__ const char* a_tile(const Gemm& g, int pm) {
    if (g.amode == 1) { const int row = (pm + g.pm0) * BM; return (const char*)g.A + xrow(row) * 2048; }
    return (const char*)g.A + (size_t)pm * BM * g.lda * 2;
}

__device__ __forceinline__ void gemm_phase(LAS unsigned char* lds, const Gemm g, const StaticOrder& S, const Epi& E) {
    const int tid = opaque_tid(), wid = __builtin_amdgcn_readfirstlane(tid >> 6), lane = tid & 63, wr = wid >> 2, wc = wid & 3, fr = lane & 15, fq = lane >> 4;
    const int K = g.K, nt = K / BK;
    const bool shiftA = (g.amode == 1);
    unsigned voffA[2], voffB[2];
#pragma unroll
    for (int i = 0; i < 2; ++i) { int R, C; stage_rc(tid * 16 + i * 8192, R, C); const int Rb = (R & ~31) + perm32(R & 31);
        voffA[i] = (unsigned)(R * g.lda + C) * 2u; voffB[i] = (unsigned)(Rb * K + C) * 2u; }
    const size_t kstep = (size_t)(BK * 2);
    const size_t hstepA = (size_t)HALF * g.lda * 2;
    const size_t hstepB = (size_t)HALF * K * 2;
    const size_t tstepB = 2 * hstepB;
    const unsigned ldsw = (unsigned)wid * 1024u;
    const int aoff = lds_byte(wr * 64 + fr, fq * 8), boff = lds_byte(wc * 32 + fr, fq * 8);
#define PG8_KOFF(kt) ((size_t)(kt) * kstep - ((shiftA && (kt) >= 16) ? (size_t)4096 : (size_t)0))
#define PG8_SA(b, h) (((b) * 2 + (h)) * HTB)
#define PG8_SB(b, h) ((4 + (b) * 2 + (h)) * HTB)
#define PG8_STAGE(bufoff, gbase, voff) do { _Pragma("unroll") for (int _i = 0; _i < 2; ++_i) \
        __builtin_amdgcn_global_load_lds((const unsigned*)((const char*)(gbase) + (voff)[_i]), (LAS unsigned*)(lds + (bufoff) + ldsw + _i * 8192), 16, 0, 0); } while (0)
#define PG8_LDA(dst, b, h) do { _Pragma("unroll") for (int m = 0; m < 4; ++m) _Pragma("unroll") for (int k = 0; k < 2; ++k) dst[m][k] = *(const LAS h16x8*)(lds + PG8_SA(b, h) + aoff + m * 2048 + k * 1024); } while (0)
#define PG8_LDB(dst, b, h) do { _Pragma("unroll") for (int n = 0; n < 2; ++n) _Pragma("unroll") for (int k = 0; k < 2; ++k) dst[n][k] = *(const LAS h16x8*)(lds + PG8_SB(b, h) + boff + n * 2048 + k * 1024); } while (0)
#define PG8_MMA(ai, bj, At, Bt) do { __builtin_amdgcn_s_setprio(1); _Pragma("unroll") for (int m = 0; m < 4; ++m) _Pragma("unroll") for (int n = 0; n < 2; ++n) _Pragma("unroll") for (int k = 0; k < 2; ++k) \
        acc[ai][bj][m][n] = __builtin_amdgcn_mfma_f32_16x16x32_f16(Bt[n][k], At[m][k], acc[ai][bj][m][n], 0, 0, 0); __builtin_amdgcn_s_setprio(0); } while (0)
#define PG8_WAIT_V(n) asm volatile("s_waitcnt vmcnt(" #n ")" ::: "memory")
#define PG8_WAIT_L(n) asm volatile("s_waitcnt lgkmcnt(" #n ")" ::: "memory")
#define PG8_BAR __builtin_amdgcn_s_barrier()
#define PG8_SCHED __builtin_amdgcn_sched_barrier(0)
    Unit cur, nxt; int ui = 0;
    if (!S.next(0, cur)) return;
    f32x4 acc[2][2][4][2];
#pragma unroll
    for (int a = 0; a < 2; ++a)
#pragma unroll
        for (int b = 0; b < 2; ++b)
#pragma unroll
            for (int m = 0; m < 4; ++m)
#pragma unroll
                for (int n = 0; n < 2; ++n) acc[a][b][m][n] = (f32x4){0.f, 0.f, 0.f, 0.f};
    h16x8 At[4][2], B0[2][2], B1[2][2];
    const char* cA = a_tile(g, cur.pm); const char* cB = (const char*)g.Bt + (size_t)cur.pn * tstepB;
    PG8_STAGE(PG8_SB(0, 0), cB, voffB); PG8_STAGE(PG8_SA(0, 0), cA, voffA); PG8_STAGE(PG8_SB(0, 1), cB + hstepB, voffB); PG8_STAGE(PG8_SA(0, 1), cA + hstepA, voffA);
    if (wr == 1) PG8_BAR;
    PG8_WAIT_V(4); PG8_BAR;
    PG8_STAGE(PG8_SB(1, 0), cB + kstep, voffB); PG8_STAGE(PG8_SA(1, 0), cA + kstep, voffA); PG8_STAGE(PG8_SB(1, 1), cB + hstepB + kstep, voffB);
    PG8_WAIT_V(6); PG8_BAR;
    for (;;) {
        const bool has_next = S.next(ui + 1, nxt);
        const char* nA = has_next ? a_tile(g, nxt.pm) : cA; const char* nB = has_next ? (const char*)g.Bt + (size_t)nxt.pn * tstepB : cB;
        for (int t = 0; t < nt; t += 2) {
            const bool last = (t == nt - 2);
            const char* a1 = cA + PG8_KOFF(t + 1);
            const char* a2 = last ? nA : cA + PG8_KOFF(t + 2); const char* b2 = last ? nB : cB + (size_t)(t + 2) * kstep;
            const char* a3 = a2 + kstep; const char* b3 = b2 + kstep;
            PG8_LDB(B0, 0, 0); PG8_SCHED; PG8_LDA(At, 0, 0); PG8_STAGE(PG8_SA(1, 1), a1 + hstepA, voffA);
            PG8_WAIT_L(8); PG8_BAR; PG8_WAIT_L(0); PG8_MMA(0, 0, At, B0); PG8_BAR; PG8_SCHED;
            PG8_LDB(B1, 0, 1); PG8_STAGE(PG8_SB(0, 0), b2, voffB);
            PG8_BAR; PG8_WAIT_L(0); PG8_MMA(0, 1, At, B1); PG8_BAR;
            PG8_LDA(At, 0, 1); PG8_STAGE(PG8_SA(0, 0), a2, voffA);
            PG8_BAR; PG8_WAIT_L(0); PG8_MMA(1, 0, At, B0); PG8_BAR; PG8_SCHED;
            PG8_STAGE(PG8_SB(0, 1), b2 + hstepB, voffB);
            PG8_WAIT_V(6); PG8_BAR; PG8_MMA(1, 1, At, B1); PG8_BAR;
            PG8_LDB(B0, 1, 0); PG8_SCHED; PG8_LDA(At, 1, 0); PG8_STAGE(PG8_SA(0, 1), a2 + hstepA, voffA);
            PG8_WAIT_L(8); PG8_BAR; PG8_WAIT_L(0); PG8_MMA(0, 0, At, B0); PG8_BAR; PG8_SCHED;
            PG8_LDB(B1, 1, 1); PG8_STAGE(PG8_SB(1, 0), b3, voffB);
            PG8_BAR; PG8_WAIT_L(0); PG8_MMA(0, 1, At, B1); PG8_BAR;
            PG8_LDA(At, 1, 1); PG8_STAGE(PG8_SA(1, 0), a3, voffA);
            PG8_BAR; PG8_WAIT_L(0); PG8_MMA(1, 0, At, B0); PG8_BAR; PG8_SCHED;
            PG8_STAGE(PG8_SB(1, 1), b3 + hstepB, voffB);
            PG8_WAIT_V(6); PG8_BAR; PG8_MMA(1, 1, At, B1); PG8_BAR;
        }
        E(acc, cur, wr, wc, fr, fq);
        if (!has_next) break;
#pragma unroll
        for (int a = 0; a < 2; ++a)
#pragma unroll
            for (int b = 0; b < 2; ++b)
#pragma unroll
                for (int m = 0; m < 4; ++m)
#pragma unroll
                    for (int n = 0; n < 2; ++n) acc[a][b][m][n] = (f32x4){0.f, 0.f, 0.f, 0.f};
        cur = nxt; cA = nA; cB = nB; ++ui;
    }
    PG8_WAIT_V(0);
    if (wr == 0) PG8_BAR;
    PG8_BAR;
#undef PG8_KOFF
#undef PG8_SA
#undef PG8_SB
#undef PG8_STAGE
#undef PG8_LDA
#undef PG8_LDB
#undef PG8_MMA
#undef PG8_WAIT_V
#undef PG8_WAIT_L
#undef PG8_BAR
#undef PG8_SCHED
}
}

struct TJob { int mode; const float* src; int ld, K, N; h16* dst; int ldd, koff; const float* mix; };

__device__ __forceinline__ TJob get_job(const Params& p, int id) {
    TJob J; J.mode = 0; J.src = nullptr; J.ld = 0; J.K = 0; J.N = 0; J.dst = nullptr; J.ldd = 64; J.koff = 0; J.mix = nullptr;
    h16* W = (h16*)(p.ws + OFF_W);
    if (id < 24) {
        const int j = id / 12, s = id % 12;
        h16* Wbig = W + (size_t)j * (10 * MiB); h16* Wl2 = Wbig + 7 * MiB;
        const float* mix = p.in[3] + j * 6 * 1024;
        J.mode = 1; J.ld = 1024; J.K = 1024; J.ldd = 2048;
        if (s < 3) { J.src = p.in[4] + (size_t)(j * 3 + s) * 1048576; J.N = 1024; J.dst = Wbig + (size_t)s * 1024 * 2048; J.mix = mix + s * 1024; }
        else if (s == 3) { J.src = p.in[6] + (size_t)j * 65536; J.ld = 64; J.N = 64; J.dst = Wbig + (size_t)3072 * 2048; J.mix = mix + 3 * 1024; }
        else if (s == 4) { J.src = p.in[9] + (size_t)j * 65536; J.ld = 64; J.N = 64; J.dst = Wbig + (size_t)3136 * 2048; J.mix = mix + 4 * 1024; }
        else if (s == 5) { J.N = 32; J.dst = Wbig + (size_t)3200 * 2048; if (j == 1) { J.src = p.in[12]; J.ld = 32; J.mix = mix + 2 * 1024; } else { J.mode = 2; } }
        else if (s == 6) { J.src = p.in[14] + (size_t)j * 163840; J.ld = 160; J.N = 160; J.dst = Wbig + (size_t)3232 * 2048; J.mix = mix + 5 * 1024; }
        else if (s == 7) { J.mode = 2; J.N = 192; J.dst = Wbig + (size_t)3392 * 2048; }
        else {
            J.mode = 0; J.ld = 1024; J.N = 1024; J.ldd = 512;
            if (s == 8) { J.src = p.in[7] + (size_t)j * 65536; J.K = 64; J.koff = 0; J.dst = Wl2; }
            else if (s == 9) { J.src = p.in[10] + (size_t)j * 65536; J.K = 64; J.koff = 64; J.dst = Wl2 + (size_t)1024 * 512; }
            else if (s == 10) { J.src = p.in[15] + (size_t)j * 163840; J.K = 160; J.koff = 160; J.dst = Wl2 + (size_t)2048 * 512; }
            else { J.src = p.in[13]; J.K = 32; J.koff = 128; J.dst = Wl2 + (size_t)3072 * 512; if (j == 0) J.N = 0; }
        }
    } else if (id < 26) {
        const int j = id - 24;
        J.src = p.in[21] + (size_t)j * 1048576; J.ld = 1024; J.K = 1024; J.N = 1024; J.dst = W + (size_t)j * (10 * MiB) + 9 * MiB; J.ldd = 1024;
    } else if (id < 34) {
        const int i = (id - 26) >> 1, s = (id - 26) & 1;
        h16* base = W + 20 * MiB + (size_t)i * (17 * MiB / 2);
        if (s == 0) { J.src = p.in[33] + (size_t)i * 1024 * 5632; J.ld = 5632; J.K = 1024; J.N = 5632; J.dst = base; J.ldd = 1024; }
        else { J.src = p.in[36] + (size_t)i * 2816 * 1024; J.ld = 1024; J.K = 2816; J.N = 1024; J.dst = base + (size_t)11 * MiB / 2; J.ldd = 2816; }
    } else {
        const int j = (id - 34) >> 2, s = (id - 34) & 3;
        h16* base = W + 54 * MiB + (size_t)j * (5 * MiB / 2);
        if (s == 0) { J.src = p.in[22] + (size_t)j * 1024 * 456; J.ld = 456; J.K = 1024; J.N = 456; J.dst = base; J.ldd = 1024; }
        else if (s == 1) { J.mode = 2; J.N = 56; J.dst = base + (size_t)456 * 1024; J.ldd = 1024; }
        else if (s == 2) { J.src = p.in[28] + (size_t)j * 256 * 512; J.ld = 512; J.K = 256; J.N = 512; J.dst = base + MiB / 2 + (size_t)2048 * 256; J.ldd = 256; }
        else { J.src = p.in[31] + (size_t)j * 1048576; J.ld = 1024; J.K = 1024; J.N = 1024; J.dst = base + 3 * MiB / 2; J.ldd = 1024; }
    }
    return J;
}
__device__ __forceinline__ h16* w_rwkv_big(unsigned char* ws, int j) { return (h16*)(ws + OFF_W) + (size_t)j * (10 * MiB); }
__device__ __forceinline__ h16* w_rwkv_l2(unsigned char* ws, int j) { return w_rwkv_big(ws, j) + 7 * MiB; }
__device__ __forceinline__ h16* w_rwkv_o(unsigned char* ws, int j) { return w_rwkv_big(ws, j) + 9 * MiB; }
__device__ __forceinline__ h16* w_ffn_up(unsigned char* ws, int i) { return (h16*)(ws + OFF_W) + 20 * MiB + (size_t)i * (17 * MiB / 2); }
__device__ __forceinline__ h16* w_ffn_dn(unsigned char* ws, int i) { return w_ffn_up(ws, i) + (size_t)11 * MiB / 2; }
__device__ __forceinline__ h16* w_dsa_in(unsigned char* ws, int j) { return (h16*)(ws + OFF_W) + 54 * MiB + (size_t)j * (5 * MiB / 2); }
__device__ __forceinline__ h16* w_dsa_q(unsigned char* ws, int j) { return w_dsa_in(ws, j) + MiB / 2; }
__device__ __forceinline__ h16* w_dsa_uvt(unsigned char* ws, int j) { return w_dsa_in(ws, j) + 5 * MiB / 4; }
__device__ __forceinline__ h16* w_dsa_o(unsigned char* ws, int j) { return w_dsa_in(ws, j) + 3 * MiB / 2; }

__device__ __forceinline__ void prep_phase(const Params& p, unsigned char* smem) {
    const int tid = opaque_tid();
    const size_t gtid = (size_t)blockIdx.x * 512 + tid, nth = (size_t)gridDim.x * 512;
    h16* x16 = (h16*)(p.ws + OFF_X16);
    for (size_t idx = gtid; idx < (size_t)MTOK * 128; idx += nth) {
        const int row = (int)(idx >> 7), c8 = (int)(idx & 127) * 8;
        const float* sp = p.in[0] + (size_t)row * 1024 + c8;
        const f32x4 a = *(const f32x4*)sp, b = *(const f32x4*)(sp + 4);
        *(u32x4*)(x16 + xrow(row) * 1024 + c8) = pack8(a, b);
    }
    for (size_t idx = gtid; idx < (size_t)NBATCH * 128; idx += nth) {
        const int b = (int)(idx >> 7), c8 = (int)(idx & 127) * 8;
        unsigned z = 0u; asm volatile("" : "+v"(z));
        *(u32x4*)(x16 + (size_t)b * 2049 * 1024 + c8) = (u32x4){z, z, z, z};
    }
    for (size_t idx = gtid; idx < (size_t)2 * 2048 * 256; idx += nth) {
        const int j = (int)(idx >> 19), rem = (int)(idx & 524287), n = rem >> 8, q = rem & 255, h = n >> 7, c = n & 127;
        const float* uq = p.in[25] + (size_t)j * 256 * 1024 + (size_t)q * 1024 + h * 64;
        const float* uk = p.in[26] + (size_t)j * 16 * 64 * 128 + (size_t)h * 64 * 128 + c;
        float s = 0.f;
        for (int d = 0; d < 64; ++d) s += uq[d] * uk[d * 128];
        w_dsa_q(p.ws, j)[(size_t)n * 256 + q] = (h16)(s * 0.125f);
    }
    for (size_t idx = gtid; idx < (size_t)2 * 16 * 64 * 128; idx += nth) {
        const int j = (int)(idx >> 17), rem = (int)(idx & 131071), h = rem >> 13, n = (rem >> 7) & 63, k = rem & 127;
        w_dsa_uvt(p.ws, j)[(size_t)(h * 64 + n) * 128 + k] = (h16)p.in[27][(size_t)((j * 16 + h) * 128 + k) * 64 + n];
    }
    float* tile = (float*)smem;
    for (int id = 0; id < 42; ++id) {
        const TJob J = get_job(p, id);
        const int tk = J.ldd >> 6, tn = (J.N + 63) >> 6, ntile = tk * tn;
        for (int tix = blockIdx.x; tix < ntile; tix += gridDim.x) {
            const int k0 = (tix % tk) * 64, n0 = (tix / tk) * 64;
#pragma unroll
            for (int i = 0; i < 8; ++i) {
                const int k = i * 8 + (tid >> 6), n = tid & 63, kk = k0 + k, nn = n0 + n;
                float v = 0.f;
                if (nn < J.N && J.mode != 2) {
                    if (J.mode == 1) { const int ks = kk & 1023; const float mx = J.mix[ks]; v = J.src[(size_t)ks * J.ld + nn] * (kk < 1024 ? 1.0f - mx : mx); }
                    else if (kk >= J.koff && kk < J.koff + J.K) v = J.src[(size_t)(kk - J.koff) * J.ld + nn];
                }
                tile[k * 65 + n] = v;
            }
            __syncthreads();
#pragma unroll
            for (int i = 0; i < 8; ++i) {
                const int n = i * 8 + (tid >> 6), k = tid & 63, nn = n0 + n;
                if (nn < J.N) J.dst[(size_t)nn * J.ldd + k0 + k] = (h16)tile[k * 65 + n];
            }
            __syncthreads();
        }
    }
}

__device__ __forceinline__ void ln_phase(const Params& p, const float* g, const float* b, bool final_out) {
    const int tid = opaque_tid();
    const int lane = tid & 63, wave = tid >> 6;
    float* tb = p.out;
    h16* x16 = (h16*)(p.ws + OFF_X16);
    f32x4 gg[4], bb[4];
#pragma unroll
    for (int i = 0; i < 4; ++i) { gg[i] = *(const f32x4*)(g + i * 256 + lane * 4); bb[i] = *(const f32x4*)(b + i * 256 + lane * 4); }
    for (int row = blockIdx.x * 8 + wave; row < MTOK; row += gridDim.x * 8) {
        float* rp = tb + (size_t)row * 1024;
        f32x4 v[4];
        float s = 0.f;
#pragma unroll
        for (int i = 0; i < 4; ++i) { v[i] = *(const f32x4*)(rp + i * 256 + lane * 4); s += v[i][0] + v[i][1] + v[i][2] + v[i][3]; }
        const float mu = wave_sum(s) * (1.0f / 1024.0f);
        float q = 0.f;
#pragma unroll
        for (int i = 0; i < 4; ++i)
#pragma unroll
            for (int j = 0; j < 4; ++j) { const float d = v[i][j] - mu; q += d * d; }
        const float rstd = rsqrtf(wave_sum(q) * (1.0f / 1024.0f) + 1e-5f);
#pragma unroll
        for (int i = 0; i < 4; ++i) {
            f32x4 y;
#pragma unroll
            for (int j = 0; j < 4; ++j) y[j] = (v[i][j] - mu) * rstd * gg[i][j] + bb[i][j];
            if (final_out) *(f32x4*)(rp + i * 256 + lane * 4) = y;
            else { u32x2 w; w.x = pk2(y[0], y[1]); w.y = pk2(y[2], y[3]); *(u32x2*)(x16 + xrow(row) * 1024 + i * 256 + lane * 4) = w; }
        }
    }
}

__device__ __forceinline__ void conv_phase(const Params& p, int layer) {
    const h16* u = (const h16*)(p.ws + F_U16);
    h16* act = (h16*)(p.ws + F_ACT);
    const float* cw = p.in[34] + (size_t)layer * 3 * 5632;
    const float* cb = p.in[35] + (size_t)layer * 5632;
    const size_t gtid = (size_t)blockIdx.x * 512 + opaque_tid(), nth = (size_t)gridDim.x * 512;
    const size_t ntask = (size_t)2048 * 704;
    for (size_t task = gtid; task < ntask; task += nth) {
        const int cgp = (int)(task % 704), rc = (int)(task / 704), f = cgp * 4, r0 = rc * 16;
        f32x4 wg[3], wv[3];
#pragma unroll
        for (int j = 0; j < 3; ++j) { wg[j] = *(const f32x4*)(cw + j * 5632 + f); wv[j] = *(const f32x4*)(cw + j * 5632 + DFF + f); }
        const f32x4 bg = *(const f32x4*)(cb + f), bv = *(const f32x4*)(cb + DFF + f);
        f32x4 g2 = {0.f, 0.f, 0.f, 0.f}, g1 = g2, v2 = g2, v1 = g2;
        if ((r0 & 2047) != 0) {
            const h16x4 a = *(const h16x4*)(u + (size_t)(r0 - 2) * 5632 + f), b = *(const h16x4*)(u + (size_t)(r0 - 1) * 5632 + f);
            const h16x4 c = *(const h16x4*)(u + (size_t)(r0 - 2) * 5632 + DFF + f), d = *(const h16x4*)(u + (size_t)(r0 - 1) * 5632 + DFF + f);
#pragma unroll
            for (int j = 0; j < 4; ++j) { g2[j] = (float)a[j]; g1[j] = (float)b[j]; v2[j] = (float)c[j]; v1[j] = (float)d[j]; }
        }
        for (int i = 0; i < 16; ++i) {
            const size_t ro = (size_t)(r0 + i) * 5632;
            const h16x4 a = *(const h16x4*)(u + ro + f), c = *(const h16x4*)(u + ro + DFF + f);
            f32x4 g0, v0;
#pragma unroll
            for (int j = 0; j < 4; ++j) { g0[j] = (float)a[j]; v0[j] = (float)c[j]; }
            u32x2 w; float o[4];
#pragma unroll
            for (int j = 0; j < 4; ++j) {
                const float G = wg[0][j] * g2[j] + wg[1][j] * g1[j] + wg[2][j] * g0[j] + bg[j];
                const float V = wv[0][j] * v2[j] + wv[1][j] * v1[j] + wv[2][j] * v0[j] + bv[j];
                o[j] = G * sigmoidf_(G) * V;
            }
            w.x = pk2(o[0], o[1]); w.y = pk2(o[2], o[3]);
            *(u32x2*)(act + (size_t)(r0 + i) * DFF + f) = w;
            g2 = g1; g1 = g0; v2 = v1; v1 = v0;
        }
    }
}

__device__ __forceinline__ float dppf(float x, const int ctrl_sel) {
    const int v = __builtin_bit_cast(int, x);
    int r;
    if (ctrl_sel == 0) r = __builtin_amdgcn_update_dpp(0, v, 0xB1, 0xF, 0xF, true);
    else if (ctrl_sel == 1) r = __builtin_amdgcn_update_dpp(0, v, 0x4E, 0xF, 0xF, true);
    else if (ctrl_sel == 2) r = __builtin_amdgcn_update_dpp(0, v, 0x141, 0xF, 0xF, true);
    else r = __builtin_amdgcn_update_dpp(0, v, 0x140, 0xF, 0xF, true);
    return __builtin_bit_cast(float, r);
}
__device__ __forceinline__ float red4(float x) { x += dppf(x, 0); x += dppf(x, 1); return x; }
__device__ __forceinline__ float red16(float x) { x += dppf(x, 0); x += dppf(x, 1); x += dppf(x, 2); x += dppf(x, 3); return x; }
__device__ __forceinline__ void unpack4(u32x2 w, float* f) {
    h16x4 h = __builtin_bit_cast(h16x4, w);
#pragma unroll
    for (int i = 0; i < 4; ++i) f[i] = (float)h[i];
}
constexpr int SCAN_BUF = 8256;
__device__ __forceinline__ void scan_phase(const Params& p, int j, unsigned char* smem) {
    const int tid = opaque_tid();
    const int wave = tid >> 6, lane = tid & 63, slot = wave >> 2, w4 = wave & 3;
    float* LB = (float*)smem + slot * (2 * SCAN_BUF);
    h16* r16 = (h16*)(p.ws + R_R16);
    const h16* k16 = (const h16*)(p.ws + R_K16);
    const h16* v16 = (j == 0) ? (const h16*)(p.ws + OFF_VF) : (const h16*)(p.ws + R_V16);
    const h16* g16 = (const h16*)(p.ws + R_G16);
    const h16* e16 = (const h16*)p.out;
    const h16* a16 = (const h16*)p.out + (size_t)MTOK * 1024;
    const int tp = w4 * 4 + (lane >> 4), k4 = (lane & 15) * 4;
    const int vrow = w4 * 16 + (lane >> 2), kq = lane & 3;
    for (int pair = blockIdx.x; pair < 256; pair += gridDim.x) {
        const int chain = pair * 2 + slot, b = chain >> 4, h = chain & 15;
        const int col = h * 64 + k4;
        const f32x4 c_kk = *(const f32x4*)(p.in[16] + j * 1024 + col), c_ka = *(const f32x4*)(p.in[17] + j * 1024 + col), c_rk = *(const f32x4*)(p.in[18] + j * 1024 + col);
        const f32x4 c_lg = *(const f32x4*)(p.in[19] + j * 1024 + col), c_lb = *(const f32x4*)(p.in[20] + j * 1024 + col);
        f32x2 S[8];
#pragma unroll
        for (int i = 0; i < 8; ++i) S[i] = (f32x2){0.f, 0.f};
        u32x2 pr[6];
        {
            const size_t go = ((size_t)(b * 2048 + tp)) * 1024 + col;
            pr[0] = *(const u32x2*)(r16 + go); pr[1] = *(const u32x2*)(k16 + go); pr[2] = *(const u32x2*)(v16 + go);
            pr[3] = *(const u32x2*)(e16 + go); pr[4] = *(const u32x2*)(a16 + go); pr[5] = *(const u32x2*)(g16 + go);
        }
        for (int ch = 0; ch < 128; ++ch) {
            float* BUF = LB + (ch & 1) * SCAN_BUF;
            float* OPS = BUF; float* VB = BUF + 5120; float* GB = BUF + 6144; float* YB = BUF + 7168; float* BON = BUF + 8192;
            {
                float rf[4], kf[4], vf[4], ef[4], af[4], gf[4];
                unpack4(pr[0], rf); unpack4(pr[1], kf); unpack4(pr[2], vf); unpack4(pr[3], ef); unpack4(pr[4], af); unpack4(pr[5], gf);
                float kk[4]; float ss = 0.f;
#pragma unroll
                for (int i = 0; i < 4; ++i) { kk[i] = kf[i] * c_kk[i]; ss += kk[i] * kk[i]; }
                ss = red16(ss);
                const float inv = 1.0f / fmaxf(sqrtf(ss), 1e-12f);
                f32x4 A4, B4, W4, K4, R4; float bs = 0.f;
#pragma unroll
                for (int i = 0; i < 4; ++i) {
                    const float kn = kk[i] * inv;
                    A4[i] = -kn; B4[i] = kn * af[i];
                    W4[i] = __expf(-ef[i]);
                    const float km = kf[i] * (1.0f + (af[i] - 1.0f) * c_ka[i]);
                    K4[i] = km; R4[i] = rf[i];
                    bs += rf[i] * km * c_rk[i];
                }
                bs = red16(bs);
                float* o = OPS + tp * 320 + k4;
                *(f32x4*)(o) = A4; *(f32x4*)(o + 64) = B4; *(f32x4*)(o + 128) = W4; *(f32x4*)(o + 192) = K4; *(f32x4*)(o + 256) = R4;
                *(f32x4*)(VB + tp * 64 + k4) = (f32x4){vf[0], vf[1], vf[2], vf[3]};
                *(f32x4*)(GB + tp * 64 + k4) = (f32x4){gf[0], gf[1], gf[2], gf[3]};
                if ((lane & 15) == 0) BON[tp] = bs;
            }
            if (ch + 1 < 128) {
                const size_t go = ((size_t)(b * 2048 + (ch + 1) * 16 + tp)) * 1024 + col;
                pr[0] = *(const u32x2*)(r16 + go); pr[1] = *(const u32x2*)(k16 + go); pr[2] = *(const u32x2*)(v16 + go);
                pr[3] = *(const u32x2*)(e16 + go); pr[4] = *(const u32x2*)(a16 + go); pr[5] = *(const u32x2*)(g16 + go);
            }
            __syncthreads();
#pragma unroll 2
            for (int t = 0; t < 16; ++t) {
                const float* op = OPS + t * 320 + kq * 16;
                f32x4 A4[4], B4[4], W4[4], K4[4], R4[4];
#pragma unroll
                for (int i = 0; i < 4; ++i) A4[i] = *(const f32x4*)(op + i * 4);
#pragma unroll
                for (int i = 0; i < 4; ++i) { W4[i] = *(const f32x4*)(op + 128 + i * 4); B4[i] = *(const f32x4*)(op + 64 + i * 4); K4[i] = *(const f32x4*)(op + 192 + i * 4); }
#pragma unroll
                for (int i = 0; i < 4; ++i) R4[i] = *(const f32x4*)(op + 256 + i * 4);
                const float vv = VB[t * 64 + vrow];
                f32x2 s0 = {0.f, 0.f}, s1 = {0.f, 0.f};
#pragma unroll
                for (int i = 0; i < 4; ++i) { s0 += S[2 * i] * (f32x2){A4[i][0], A4[i][1]}; s1 += S[2 * i + 1] * (f32x2){A4[i][2], A4[i][3]}; }
                const float sa = red4((s0[0] + s0[1]) + (s1[0] + s1[1]));
                const f32x2 sa2 = {sa, sa}, vv2 = {vv, vv};
#pragma unroll
                for (int i = 0; i < 4; ++i) {
                    S[2 * i] = S[2 * i] * (f32x2){W4[i][0], W4[i][1]} + sa2 * (f32x2){B4[i][0], B4[i][1]} + vv2 * (f32x2){K4[i][0], K4[i][1]};
                    S[2 * i + 1] = S[2 * i + 1] * (f32x2){W4[i][2], W4[i][3]} + sa2 * (f32x2){B4[i][2], B4[i][3]} + vv2 * (f32x2){K4[i][2], K4[i][3]};
                }
                f32x2 y0 = {0.f, 0.f}, y1 = {0.f, 0.f};
#pragma unroll
                for (int i = 0; i < 4; ++i) { y0 += S[2 * i] * (f32x2){R4[i][0], R4[i][1]}; y1 += S[2 * i + 1] * (f32x2){R4[i][2], R4[i][3]}; }
                const float y = red4((y0[0] + y0[1]) + (y1[0] + y1[1]));
                if (kq == 0) YB[t * 64 + vrow] = y;
            }
            __syncthreads();
            {
                const f32x4 y4 = *(const f32x4*)(YB + tp * 64 + k4), v4 = *(const f32x4*)(VB + tp * 64 + k4), g4 = *(const f32x4*)(GB + tp * 64 + k4);
                const float mu = red16((y4[0] + y4[1]) + (y4[2] + y4[3])) * (1.0f / 64.0f);
                float q = 0.f;
#pragma unroll
                for (int i = 0; i < 4; ++i) { const float d = y4[i] - mu; q += d * d; }
                const float rstd = rsqrtf(red16(q) * (1.0f / 64.0f) + 64e-5f);
                const float bon = BON[tp];
                float o[4];
#pragma unroll
                for (int i = 0; i < 4; ++i) o[i] = ((y4[i] - mu) * rstd * c_lg[i] + c_lb[i] + bon * v4[i]) * g4[i];
                u32x2 w; w.x = pk2(o[0], o[1]); w.y = pk2(o[2], o[3]);
                *(u32x2*)(r16 + ((size_t)(b * 2048 + ch * 16 + tp)) * 1024 + col) = w;
            }
        }
        __syncthreads();
    }
}

__device__ __forceinline__ void dsa_norm_phase(const Params& p, int j, unsigned char* smem) {
    const int tid = opaque_tid();
    const int lane = tid & 63, wave = tid >> 6;
    const float* hin = (const float*)(p.ws + D_HIN);
    h16* cq = (h16*)(p.ws + D_CQ); h16* ckv = (h16*)(p.ws + D_CKV); h16* ckvt = (h16*)(p.ws + D_CKVT); h16* kidx = (h16*)(p.ws + D_KIDX);
    float* widx = (float*)(p.ws + D_WIDX);
    const f32x4 gq = *(const f32x4*)(p.in[23] + j * 256 + lane * 4);
    const f32x2 gkv = *(const f32x2*)(p.in[24] + j * 128 + lane * 2);
    const float gi = p.in[29][j * 64 + lane], bi = p.in[30][j * 64 + lane];
    h16* wl = (h16*)(smem + wave * 2048);
    for (int grp = blockIdx.x * 8 + wave; grp < MTOK / 8; grp += gridDim.x * 8) {
        const int r0 = grp * 8;
        for (int i = 0; i < 8; ++i) {
            const int row = r0 + i;
            const float* hp = hin + (size_t)row * 512;
            const f32x4 vq = *(const f32x4*)(hp + lane * 4);
            const f32x2 vk = *(const f32x2*)(hp + 256 + lane * 2);
            const float vi = hp[384 + lane];
            float ssq = wave_sum(vq[0] * vq[0] + vq[1] * vq[1] + vq[2] * vq[2] + vq[3] * vq[3]);
            const float rq = rsqrtf(ssq * (1.0f / 256.0f) + 1e-6f);
            u32x2 w; w.x = pk2(vq[0] * rq * gq[0], vq[1] * rq * gq[1]); w.y = pk2(vq[2] * rq * gq[2], vq[3] * rq * gq[3]);
            *(u32x2*)(cq + (size_t)row * 256 + lane * 4) = w;
            float ssk = wave_sum(vk[0] * vk[0] + vk[1] * vk[1]);
            const float rk = rsqrtf(ssk * (1.0f / 128.0f) + 1e-6f);
            const unsigned wk = pk2(vk[0] * rk * gkv[0], vk[1] * rk * gkv[1]);
            *(unsigned*)(ckv + (size_t)row * 128 + lane * 2) = wk;
            *(unsigned*)(wl + i * 128 + lane * 2) = wk;
            const float mu = wave_sum(vi) * (1.0f / 64.0f);
            const float dv = vi - mu;
            const float var = wave_sum(dv * dv) * (1.0f / 64.0f);
            kidx[(size_t)row * 64 + lane] = (h16)(dv * rsqrtf(var + 1e-5f) * gi + bi);
            if (lane < 8) widx[(size_t)row * 8 + lane] = hp[448 + lane] * 0.044194173824159216f;
        }
        asm volatile("s_waitcnt lgkmcnt(0)" ::: "memory");
        const int b = r0 >> 11, t0 = r0 & 2047;
#pragma unroll
        for (int dd = 0; dd < 2; ++dd) {
            const int d = lane * 2 + dd;
            h16x8 hv;
#pragma unroll
            for (int i = 0; i < 8; ++i) hv[i] = wl[i * 128 + d];
            *(h16x8*)(ckvt + ((size_t)(b * 128 + d)) * 2048 + t0) = hv;
        }
        asm volatile("s_waitcnt lgkmcnt(0)" ::: "memory");
    }
}

constexpr int ROWP = 2052;
__device__ __forceinline__ unsigned fkey(float x) {
    if (x == 0.0f) x = 0.0f;
    const unsigned u = __float_as_uint(x);
    return (u & 0x80000000u) ? ~u : (u | 0x80000000u);
}
__device__ __forceinline__ void dsa_index_phase(const Params& p, unsigned char* smem) {
    const int tid = opaque_tid(), wave = tid >> 6, lane = tid & 63, r = lane & 15, q = lane >> 4;
    float* SC = (float*)smem;
    const h16* qidx = (const h16*)(p.ws + D_QIDX);
    const h16* kidx = (const h16*)(p.ws + D_KIDX);
    const float* widx = (const float*)(p.ws + D_WIDX);
    unsigned* maskb = (unsigned*)(p.ws + D_MASK);
    for (int qi = blockIdx.x, it = 0; qi < MTOK / 16; qi += gridDim.x, ++it) {
        const int qt = (it & 1) ? ((qi & ~127) | (127 - (qi & 127))) : qi;
        const int row0 = qt * 16, b = row0 >> 11, t0 = row0 & 2047;
        const int nkt = (t0 >> 4) + 1;
        {
            h16x8 qf[8][2]; float wq[8];
#pragma unroll
            for (int h = 0; h < 8; ++h) {
#pragma unroll
                for (int kk = 0; kk < 2; ++kk) qf[h][kk] = *(const h16x8*)(qidx + (size_t)(row0 + r) * 512 + h * 64 + kk * 32 + q * 8);
                wq[h] = widx[(size_t)(row0 + r) * 8 + h];
            }
            for (int kt = wave; kt < nkt; kt += 8) {
                const int s0 = kt * 16;
                const h16* kp = kidx + (size_t)(b * 2048 + s0 + r) * 64 + q * 8;
                const h16x8 k0 = *(const h16x8*)kp, k1 = *(const h16x8*)(kp + 32);
                f32x4 sc = {0.f, 0.f, 0.f, 0.f};
#pragma unroll
                for (int h = 0; h < 8; ++h) {
                    f32x4 acc = {0.f, 0.f, 0.f, 0.f};
                    acc = __builtin_amdgcn_mfma_f32_16x16x32_f16(k0, qf[h][0], acc, 0, 0, 0);
                    acc = __builtin_amdgcn_mfma_f32_16x16x32_f16(k1, qf[h][1], acc, 0, 0, 0);
#pragma unroll
                    for (int jj = 0; jj < 4; ++jj) sc[jj] += fmaxf(acc[jj], 0.f) * wq[h];
                }
                *(f32x4*)(SC + r * ROWP + s0 + q * 4) = sc;
            }
        }
        __syncthreads();
        for (int qq = 0; qq < 2; ++qq) {
            const int ql = wave * 2 + qq, t = t0 + ql;
            const float* srow = SC + ql * ROWP;
            const int ni = (t >> 6) + 1;
            unsigned u[32];
#pragma unroll
            for (int i = 0; i < 32; ++i) {
                u[i] = 0u;
                if (i < ni) { const int s = i * 64 + lane; if (s <= t) u[i] = fkey(srow[s]); }
            }
            unsigned myw = 0u;
            if (t < 256) {
#pragma unroll
                for (int i = 0; i < 32; ++i) { const unsigned long long sm = __ballot(u[i] != 0u); if ((lane >> 1) == i) myw = (lane & 1) ? (unsigned)(sm >> 32) : (unsigned)sm; }
            } else {
                unsigned T = 0u;
                for (int bit = 31; bit >= 0; --bit) {
                    const unsigned cand = T | (1u << bit);
                    int cnt = 0;
#pragma unroll
                    for (int i = 0; i < 32; ++i) if (i < ni) cnt += __popcll(__ballot(u[i] >= cand));
                    if (cnt >= 256) T = cand;
                }
                int cgt = 0;
#pragma unroll
                for (int i = 0; i < 32; ++i) if (i < ni) cgt += __popcll(__ballot(u[i] > T));
                const int need = 256 - cgt;
                int running = 0;
                const unsigned long long lt = (lane == 0) ? 0ull : (~0ull >> (64 - lane));
#pragma unroll
                for (int i = 0; i < 32; ++i) {
                    if (i < ni) {
                        const unsigned long long eq = __ballot(u[i] == T);
                        const int rank = running + __popcll(eq & lt);
                        const unsigned long long sm = __ballot(u[i] > T || (u[i] == T && rank < need));
                        running += __popcll(eq);
                        if ((lane >> 1) == i) myw = (lane & 1) ? (unsigned)(sm >> 32) : (unsigned)sm;
                    }
                }
            }
            maskb[(size_t)(row0 + ql) * 64 + lane] = myw;
        }
        __syncthreads();
    }
}

constexpr int AT_KROW = 272, AT_VROW = 144, AT_KBYTES = 64 * AT_KROW, AT_VBYTES = 128 * AT_VROW, AT_STAGE = AT_KBYTES + AT_VBYTES, AT_BL = 2 * AT_STAGE;
__device__ __forceinline__ void dsa_attn_phase(const Params& p, int j, unsigned char* smem) {
    const int tid = opaque_tid(), wave = tid >> 6, lane = tid & 63, r = lane & 15, q = lane >> 4;
    float* BL = (float*)(smem + AT_BL);
    for (int idx = tid; idx < 16 * 129; idx += 512) {
        const int h = idx / 129, d = idx % 129;
        int bk = d;
        if (d >= 16) { bk = 16 + (int)(logf((float)d * (1.0f / 16.0f)) / 2.0794415416798357f * 16.0f); bk = bk > 31 ? 31 : bk; }
        BL[h * 132 + d] = p.in[32][bk * 16 + h];
    }
    __syncthreads();
    const h16* qabs = (const h16*)(p.ws + D_QABS);
    const h16* ckv = (const h16*)(p.ws + D_CKV);
    const h16* ckvt = (const h16*)(p.ws + D_CKVT);
    const unsigned* maskb = (const unsigned*)(p.ws + D_MASK);
    h16* o16 = (h16*)(p.ws + D_O16);
    const h16* wuvt = w_dsa_uvt(p.ws, j);
    const float NINF = -__builtin_inff();
    const int krow0 = tid >> 4, kcc = tid & 15, vrow0 = tid >> 3, vcc = tid & 7;
    for (int qi = blockIdx.x, it = 0; qi < MTOK / 16; qi += gridDim.x, ++it) {
        const int qt = (it & 1) ? ((qi & ~127) | (127 - (qi & 127))) : qi;
        const int row0 = qt * 16, b = row0 >> 11, t0 = row0 & 2047, nst = (t0 + 16 + 63) >> 6, tq = t0 + r;
        const h16* kg = ckv + (size_t)(b * 2048) * 128;
        const h16* vg = ckvt + (size_t)(b * 128) * 2048;
        u32x4 sk[2], sv[2];
#pragma unroll
        for (int i = 0; i < 2; ++i) {
            sk[i] = *(const u32x4*)(kg + (size_t)(krow0 + i * 32) * 128 + kcc * 8);
            sv[i] = *(const u32x4*)(vg + (size_t)(vrow0 + i * 64) * 2048 + vcc * 8);
        }
        h16x8 qf[2][4];
#pragma unroll
        for (int hh = 0; hh < 2; ++hh)
#pragma unroll
            for (int kk = 0; kk < 4; ++kk) qf[hh][kk] = *(const h16x8*)(qabs + (size_t)(row0 + r) * 2048 + (2 * wave + hh) * 128 + kk * 32 + q * 8);
        f32x4 O[2][8];
#pragma unroll
        for (int hh = 0; hh < 2; ++hh)
#pragma unroll
            for (int dt = 0; dt < 8; ++dt) O[hh][dt] = (f32x4){0.f, 0.f, 0.f, 0.f};
        float mrun[2] = {NINF, NINF}, lrun[2] = {0.f, 0.f};
#pragma unroll
        for (int i = 0; i < 2; ++i) {
            *(u32x4*)(smem + (krow0 + i * 32) * AT_KROW + kcc * 16) = sk[i];
            *(u32x4*)(smem + AT_KBYTES + (vrow0 + i * 64) * AT_VROW + vcc * 16) = sv[i];
        }
        __syncthreads();
        for (int st = 0; st < nst; ++st) {
            const int s0 = st * 64;
            const unsigned char* Kb = smem + (st & 1) * AT_STAGE;
            const unsigned char* Vb = Kb + AT_KBYTES;
            const u32x2 mw2 = *(const u32x2*)(maskb + (size_t)(row0 + r) * 64 + st * 2);
            if (st + 1 < nst) {
#pragma unroll
                for (int i = 0; i < 2; ++i) {
                    sk[i] = *(const u32x4*)(kg + (size_t)(s0 + 64 + krow0 + i * 32) * 128 + kcc * 8);
                    sv[i] = *(const u32x4*)(vg + (size_t)(vrow0 + i * 64) * 2048 + s0 + 64 + vcc * 8);
                }
            }
#pragma nounroll
            for (int hf = 0; hf < 2; ++hf) {
                const unsigned mw = hf ? mw2.y : mw2.x;
                h16x8 pf[2]; float alpha[2];
#pragma unroll
                for (int hh = 0; hh < 2; ++hh) {
                    const int h = 2 * wave + hh;
                    f32x4 sc[2];
#pragma unroll
                    for (int tt = 0; tt < 2; ++tt) {
                        f32x4 acc = {0.f, 0.f, 0.f, 0.f};
#pragma unroll
                        for (int kk = 0; kk < 4; ++kk) {
                            const h16x8 kf = *(const h16x8*)(Kb + (hf * 32 + tt * 16 + r) * AT_KROW + kk * 64 + q * 16);
                            acc = __builtin_amdgcn_mfma_f32_16x16x32_f16(kf, qf[hh][kk], acc, 0, 0, 0);
                        }
                        sc[tt] = acc;
                    }
                    float x[8]; float mx = NINF;
#pragma unroll
                    for (int tt = 0; tt < 2; ++tt)
#pragma unroll
                        for (int jj = 0; jj < 4; ++jj) {
                            const int kix = tt * 16 + q * 4 + jj;
                            int dist = tq - (s0 + hf * 32 + kix); dist = dist < 0 ? 0 : (dist > 128 ? 128 : dist);
                            const float v = sc[tt][jj] + BL[h * 132 + dist];
                            const float xv = ((mw >> kix) & 1u) ? v : NINF;
                            x[tt * 4 + jj] = xv; mx = fmaxf(mx, xv);
                        }
                    mx = fmaxf(mx, __shfl_xor(mx, 16)); mx = fmaxf(mx, __shfl_xor(mx, 32));
                    const float mnew = fmaxf(mrun[hh], mx);
                    const float mref = (mnew == NINF) ? 0.f : mnew;
                    alpha[hh] = __expf(mrun[hh] - mref);
                    mrun[hh] = mnew;
                    float ps = 0.f;
#pragma unroll
                    for (int i = 0; i < 8; ++i) { const float pv = __expf(x[i] - mref); ps += pv; pf[hh][i] = (h16)pv; }
                    lrun[hh] = lrun[hh] * alpha[hh] + ps;
                    __builtin_amdgcn_sched_barrier(0);
                }
#pragma unroll
                for (int dt = 0; dt < 8; ++dt) {
                    if ((dt & 1) == 0) __builtin_amdgcn_sched_barrier(0);
                    const unsigned char* vp = Vb + (dt * 16 + r) * AT_VROW + (hf * 32 + q * 4) * 2;
                    const h16x4 lo = *(const h16x4*)vp, hi = *(const h16x4*)(vp + 32);
                    const h16x8 vf = {lo[0], lo[1], lo[2], lo[3], hi[0], hi[1], hi[2], hi[3]};
#pragma unroll
                    for (int hh = 0; hh < 2; ++hh) {
                        O[hh][dt] *= alpha[hh];
                        O[hh][dt] = __builtin_amdgcn_mfma_f32_16x16x32_f16(vf, pf[hh], O[hh][dt], 0, 0, 0);
                    }
                }
                __builtin_amdgcn_sched_barrier(0);
            }
            if (st + 1 < nst) {
                unsigned char* Kn = smem + ((st + 1) & 1) * AT_STAGE;
#pragma unroll
                for (int i = 0; i < 2; ++i) {
                    *(u32x4*)(Kn + (krow0 + i * 32) * AT_KROW + kcc * 16) = sk[i];
                    *(u32x4*)(Kn + AT_KBYTES + (vrow0 + i * 64) * AT_VROW + vcc * 16) = sv[i];
                }
            }
            __syncthreads();
        }
#pragma unroll
        for (int hh = 0; hh < 2; ++hh) {
            const int h = 2 * wave + hh;
            float lt = lrun[hh]; lt += __shfl_xor(lt, 16); lt += __shfl_xor(lt, 32);
            const float inv = 1.0f / lt;
#pragma unroll
            for (int vt = 0; vt < 4; ++vt) {
                f32x4 acc = {0.f, 0.f, 0.f, 0.f};
#pragma unroll
                for (int kk = 0; kk < 4; ++kk) {
                    const h16* ap = wuvt + (size_t)(h * 64 + vt * 16 + r) * 128 + kk * 32 + q * 4;
                    const h16x4 lo = *(const h16x4*)ap, hi = *(const h16x4*)(ap + 16);
                    const h16x8 a8 = {lo[0], lo[1], lo[2], lo[3], hi[0], hi[1], hi[2], hi[3]};
                    h16x8 b8;
#pragma unroll
                    for (int i = 0; i < 4; ++i) { b8[i] = (h16)(O[hh][2 * kk][i] * inv); b8[4 + i] = (h16)(O[hh][2 * kk + 1][i] * inv); }
                    acc = __builtin_amdgcn_mfma_f32_16x16x32_f16(a8, b8, acc, 0, 0, 0);
                }
                u32x2 w; w.x = pk2(acc[0], acc[1]); w.y = pk2(acc[2], acc[3]);
                *(u32x2*)(o16 + (size_t)(row0 + r) * 1024 + h * 64 + vt * 16 + q * 4) = w;
            }
        }
    }
    __syncthreads();
}

__global__ void __launch_bounds__(512) mega_fwd(Params p) {
    extern __shared__ __attribute__((aligned(16))) unsigned char smem[];
    cg::grid_group grid = cg::this_grid();
    unsigned char* ws = p.ws;
    h16* x16 = (h16*)(ws + OFF_X16);
    for (int ph = p.ph_lo; ph < p.ph_hi; ++ph) {
        const unsigned e = p.prog[ph];
        const int kind = e & 15, L = (e >> 4) & 3, sub = (e >> 6) & 1, j = L >> 1;
        const int nrep = 1 + (int)(e >> 7);
        for (int rep = 0; rep < nrep; ++rep) {
        if (rep) grid.sync();
        const bool isgemm = (kind == K_R1 || kind == K_R2 || kind == K_R4 || kind == K_F1 || kind == K_F3 || kind == K_D1 || kind == K_D3 || kind == K_D6);
        if (isgemm) {
            pg8::Gemm g; pg8::Epi E;
            g.M = MTOK; g.N = 1024; g.K = 1024; g.lda = 1024; g.amode = 0; g.pm0 = 0; g.A = x16; g.Bt = x16;
            E.mode = E_RESID; E.pm0 = 0; E.j = j; E.ws = ws; E.out = p.out; E.bias0 = p.in[5] + j * 1024; E.bias1 = p.in[8] + j * 1024; E.bias2 = p.in[11];
            if (kind == K_R1) {
                g.Bt = w_rwkv_big(ws, j); g.N = 3584; g.K = 2048; g.amode = 1; E.mode = E_RPROJ;
            } else if (kind == K_R2) {
                g.A = (const h16*)(ws + R_HACT); g.Bt = w_rwkv_l2(ws, j); g.N = (j == 0) ? 3072 : 4096; g.K = 512; g.lda = 512; E.mode = E_LORA2;
            } else if (kind == K_R4) {
                g.A = (const h16*)(ws + R_R16); g.Bt = w_rwkv_o(ws, j);
            } else if (kind == K_F1) {
                g.Bt = w_ffn_up(ws, L); g.M = MTOK / 2; g.N = 5632; g.amode = 1; g.pm0 = sub * 128; E.mode = E_ST16;
            } else if (kind == K_F3) {
                g.A = (const h16*)(ws + F_ACT); g.Bt = w_ffn_dn(ws, L); g.M = MTOK / 2; g.K = 2816; g.lda = 2816; E.pm0 = sub * 128;
            } else if (kind == K_D1) {
                g.Bt = w_dsa_in(ws, j); g.N = 512; g.amode = 1; E.mode = E_ST32;
            } else if (kind == K_D3) {
                g.A = (const h16*)(ws + D_CQ); g.Bt = w_dsa_q(ws, j); g.N = 2560; g.K = 256; g.lda = 256; E.mode = E_QPROJ;
            } else {
                g.A = (const h16*)(ws + D_O16); g.Bt = w_dsa_o(ws, j);
            }
            pg8::StaticOrder S; S.init(g.M, g.N, (int)gridDim.x, (int)blockIdx.x);
#ifndef NO_GEMM
            pg8::gemm_phase((LAS unsigned char*)smem, g, S, E);
#endif
        } else if (kind == K_PREP) {
#ifndef NO_PREP
            prep_phase(p, smem);
#endif
        } else if (kind == K_R3) {
#ifndef NO_SCAN
            scan_phase(p, j, smem);
#endif
        } else if (kind == K_LN) {
#ifndef NO_LN
            ln_phase(p, p.in[1] + (L * 2 + sub) * 1024, p.in[2] + (L * 2 + sub) * 1024, L == 3 && sub == 1);
#endif
        } else if (kind == K_F2) {
#ifndef NO_CONV
            conv_phase(p, L);
#endif
        } else if (kind == K_D2) {
#ifndef NO_NORM
            dsa_norm_phase(p, j, smem);
#endif
        } else if (kind == K_D4) {
#ifndef NO_INDEX
            dsa_index_phase(p, smem);
#endif
        } else if (kind == K_D5) {
#ifndef NO_ATTN
            dsa_attn_phase(p, j, smem);
#endif
        }
        }
        if (ph + 1 < p.ph_hi) grid.sync();
    }
}

extern "C" void kernel_launch(void* const* d_in, const int* in_sizes, int n_in, void* d_out, int out_size, void* d_ws, size_t ws_size, hipStream_t stream) {
    static int grid_blocks = 0;
    if (grid_blocks == 0) {
        if (n_in != 37 || ws_size < WS_NEED || out_size != MTOK * DM) { fprintf(stderr, "kernel_launch: unexpected problem (n_in %d ws %zu out %d)\n", n_in, ws_size, out_size); grid_blocks = -1; return; }
        int dev = 0, cus = 0, per_cu = 0;
        hipGetDevice(&dev);
        hipDeviceGetAttribute(&cus, hipDeviceAttributeMultiprocessorCount, dev);
        if (hipFuncSetAttribute((const void*)mega_fwd, hipFuncAttributeMaxDynamicSharedMemorySize, LDS_BYTES) != hipSuccess) { fprintf(stderr, "kernel_launch: hipFuncSetAttribute failed\n"); grid_blocks = -1; return; }
        hipOccupancyMaxActiveBlocksPerMultiprocessor(&per_cu, (const void*)mega_fwd, 512, LDS_BYTES);
        if (per_cu < 1) { fprintf(stderr, "kernel_launch: occupancy query says %d blocks/CU\n", per_cu); per_cu = 1; }
        (void)hipGetLastError();
        grid_blocks = cus * per_cu;
        fprintf(stderr, "kernel_launch: grid %d (cus %d x %d)\n", grid_blocks, cus, per_cu);
    }
    if (grid_blocks < 0) return;
    Params p{};
    for (int i = 0; i < 37; ++i) p.in[i] = (const float*)d_in[i];
    p.ws = (unsigned char*)d_ws; p.out = (float*)d_out;
    int np = 0;
    constexpr unsigned PROBE_MASK = 0u;
    auto add = [&](int kind, int L, int sub) { p.prog[np++] = (unsigned char)(kind | (L << 4) | (sub << 6) | ((((PROBE_MASK >> kind) & 1u) && !(kind == K_LN && L == 3 && sub == 1)) ? 128 : 0)); };
    add(K_PREP, 0, 0);
    for (int L = 0; L < 4; ++L) {
        if ((L & 1) == 0) { add(K_R1, L, 0); add(K_R2, L, 0); add(K_R3, L, 0); add(K_R4, L, 0); }
        else { add(K_D1, L, 0); add(K_D2, L, 0); add(K_D3, L, 0); add(K_D4, L, 0); add(K_D5, L, 0); add(K_D6, L, 0); }
        add(K_LN, L, 0);
        for (int c = 0; c < 2; ++c) { add(K_F1, L, c); add(K_F2, L, c); add(K_F3, L, c); }
        add(K_LN, L, 1);
    }
#if SINGLE_LAUNCH
    p.ph_lo = 0; p.ph_hi = np;
    void* args[] = {&p};
    hipError_t e = hipLaunchCooperativeKernel((const void*)mega_fwd, dim3(grid_blocks), dim3(512), args, LDS_BYTES, stream);
    if (e != hipSuccess) fprintf(stderr, "cooperative launch failed: %s (grid %d)\n", hipGetErrorString(e), grid_blocks);
#else
    for (int ph = 0; ph < np; ++ph) {
        p.ph_lo = ph; p.ph_hi = ph + 1;
        hipLaunchKernelGGL(mega_fwd, dim3(grid_blocks), dim3(512), LDS_BYTES, stream, p);
    }
#endif
}
```

```cpp
#include <hip/hip_runtime.h>
#include <hip/hip_cooperative_groups.h>
#include <cstdio>
namespace cg = cooperative_groups;

#ifndef SINGLE_LAUNCH
#define SINGLE_LAUNCH 1
#endif

#define LAS __attribute__((address_space(3)))
typedef _Float16 h16;
typedef _Float16 h16x8 __attribute__((ext_vector_type(8)));
typedef _Float16 h16x4 __attribute__((ext_vector_type(4)));
typedef _Float16 h16x2 __attribute__((ext_vector_type(2)));
typedef float f32x4 __attribute__((ext_vector_type(4)));
typedef float f32x2 __attribute__((ext_vector_type(2)));
typedef unsigned u32x4 __attribute__((ext_vector_type(4)));
typedef unsigned u32x2 __attribute__((ext_vector_type(2)));

constexpr int DM = 1024, SEQ = 2048, NBATCH = 32, MTOK = NBATCH * SEQ;
constexpr int DFF = 2816;
constexpr size_t MiB = (size_t)1 << 20;
constexpr float DN_ALPHA = 1.6817928305074290f;
constexpr int LDS_BYTES = 147456;

constexpr size_t OFF_W = 0;
constexpr size_t OFF_X16 = 118 * MiB;
constexpr size_t OFF_VF = 247 * MiB;
constexpr size_t OFF_R = 375 * MiB;
constexpr size_t WS_NEED = 951 * MiB;
constexpr size_t R_R16 = OFF_R, R_K16 = OFF_R + 128 * MiB, R_V16 = OFF_R + 256 * MiB, R_G16 = OFF_R + 384 * MiB, R_HACT = OFF_R + 512 * MiB;
constexpr size_t F_U16 = OFF_R, F_ACT = OFF_R + 352 * MiB;
constexpr size_t D_HIN = OFF_R, D_O16 = OFF_R, D_QABS = OFF_R + 128 * MiB, D_QIDX = OFF_R + 384 * MiB, D_CQ = OFF_R + 448 * MiB,
                 D_CKV = OFF_R + 480 * MiB, D_CKVT = OFF_R + 496 * MiB, D_KIDX = OFF_R + 512 * MiB, D_WIDX = OFF_R + 520 * MiB, D_MASK = OFF_R + 522 * MiB;

struct Params {
    const float* in[37];
    unsigned char* ws;
    float* out;
    int ph_lo, ph_hi;
    unsigned char prog[64];
};

enum { K_PREP = 0, K_R1, K_R2, K_R3, K_R4, K_LN, K_F1, K_F2, K_F3, K_D1, K_D2, K_D3, K_D4, K_D5, K_D6 };
enum { E_RPROJ = 0, E_LORA2, E_RESID, E_ST16, E_ST32, E_QPROJ };

__device__ __forceinline__ size_t xrow(int row) { return (size_t)(row >> 11) * 2049 + 1 + (row & 2047); }
__device__ __forceinline__ unsigned pk2(float a, float b) { h16x2 h = {(h16)a, (h16)b}; return __builtin_bit_cast(unsigned, h); }
__device__ __forceinline__ u32x4 pack8(f32x4 a, f32x4 b) { u32x4 w; w.x = pk2(a[0], a[1]); w.y = pk2(a[2], a[3]); w.z = pk2(b[0], b[1]); w.w = pk2(b[2], b[3]); return w; }
__device__ __forceinline__ void unpack8(u32x4 w, float* f) {
    h16x8 h = __builtin_bit_cast(h16x8, w);
#pragma unroll
    for (int i = 0; i < 8; ++i) f[i] = (float)h[i];
}
__device__ __forceinline__ float sigmoidf_(float x) { return 1.0f / (1.0f + __expf(-x)); }
__device__ __forceinline__ float wave_sum(float v) {
#pragma unroll
    for (int o = 32; o > 0; o >>= 1) v += __shfl_xor(v, o);
    return v;
}
#define WSYNC() asm volatile("s_waitcnt vmcnt(0) lgkmcnt(0)" ::: "memory")
__device__ __forceinline__ int opaque_tid() { int t = threadIdx.x; asm volatile("" : "+v"(t)); return t; }

namespace pg8 {
constexpr int BM = 256, BK = 64, HALF = 128, HTB = HALF * BK * 2, STAGE_BYTES = 8 * HTB, NXCD = 8, WGM = 8;
__device__ __forceinline__ int lds_byte(int r, int c) { const int st = (r >> 4) * 2 + (c >> 5), rr = r & 15, cc = c & 31, ob = rr * 64 + cc * 2; return st * 1024 + (ob ^ (((ob >> 9) & 1) << 5)); }
__device__ __forceinline__ void stage_rc(int b, int& R, int& C) { const int st = b / 1024, sb = b % 1024, swz = sb ^ (((sb >> 9) & 1) << 5); R = (st >> 1) * 16 + swz / 64; C = (st & 1) * 32 + (swz % 64) / 2; }
__device__ __forceinline__ int perm32(int rho) { const int n = rho >> 4, i = rho & 15; return 8 * (i >> 2) + 4 * n + (i & 3); }
struct Unit { int pm, pn; };
struct Gemm { const h16* A; const h16* Bt; int M, N, K, lda, amode, pm0; };
struct StaticOrder {
    int nM, nN, nwg, G, c;
    __device__ void init(int M, int N, int G_, int c_) { nM = M / BM; nN = N / BM; nwg = nM * nN; G = G_; c = c_; }
    __device__ bool next(int i, Unit& u) const {
        const long L = (long)i * G + c; if (L >= nwg) return false;
        int wgid = (int)L; { const int q = nwg / NXCD, r = nwg % NXCD, xcd = wgid % NXCD, off = wgid / NXCD; wgid = (xcd < r ? xcd * (q + 1) : r * (q + 1) + (xcd - r) * q) + off; }
        const int nig = WGM * nN, gid = wgid / nig, fm = gid * WGM, gsz = (nM - fm) < WGM ? (nM - fm) : WGM;
        u.pm = fm + ((wgid % nig) % gsz); u.pn = (wgid % nig) / gsz; return true;
    }
};

struct Epi {
    int mode, pm0, j;
    unsigned char* ws; float* out; const float* bias0; const float* bias1; const float* bias2;
    __device__ __forceinline__ void operator()(const f32x4 (&acc)[2][2][4][2], const Unit& u, int wr, int wc, int fr, int fq) const {
        const int rowl0 = u.pm * BM + wr * 64 + fr;
        const int colt = u.pn * BM + wc * 32 + 8 * fq;
#pragma unroll
        for (int ai = 0; ai < 2; ++ai)
#pragma unroll
            for (int m = 0; m < 4; ++m) {
                const int rowl = rowl0 + ai * HALF + m * 16;
                const int rowg = rowl + pm0 * BM;
#pragma unroll
                for (int bj = 0; bj < 2; ++bj) {
                    const int col = colt + bj * HALF;
                    f32x4 v0 = acc[ai][bj][m][0], v1 = acc[ai][bj][m][1];
                    if (mode == E_RPROJ) {
                        if (u.pn < 12) {
                            h16* dst = (h16*)(ws + (u.pn < 4 ? R_R16 : (u.pn < 8 ? R_K16 : (j == 0 ? OFF_VF : R_V16))));
                            *(u32x4*)(dst + (size_t)rowg * 1024 + (col & 1023)) = pack8(v0, v1);
                        } else {
                            const int hc = col - 3072;
                            if (hc < 64) {
#pragma unroll
                                for (int jj = 0; jj < 4; ++jj) { v0[jj] = tanhf(v0[jj]); v1[jj] = tanhf(v1[jj]); }
                            } else if (hc >= 160) {
#pragma unroll
                                for (int jj = 0; jj < 4; ++jj) { v0[jj] = sigmoidf_(v0[jj]); v1[jj] = sigmoidf_(v1[jj]); }
                            }
                            *(u32x4*)((h16*)(ws + R_HACT) + (size_t)rowg * 512 + hc) = pack8(v0, v1);
                        }
                    } else if (mode == E_LORA2) {
                        const int grp = u.pn >> 2, c = col & 1023;
                        const size_t off = (size_t)rowg * 1024 + c;
                        if (grp == 0) {
                            const f32x4 ba = *(const f32x4*)(bias0 + c), bb = *(const f32x4*)(bias0 + c + 4);
#pragma unroll
                            for (int jj = 0; jj < 4; ++jj) { v0[jj] = sigmoidf_(v0[jj] + ba[jj]) * 0.6065306597f; v1[jj] = sigmoidf_(v1[jj] + bb[jj]) * 0.6065306597f; }
                            *(u32x4*)((h16*)out + off) = pack8(v0, v1);
                        } else if (grp == 1) {
                            const f32x4 ba = *(const f32x4*)(bias1 + c), bb = *(const f32x4*)(bias1 + c + 4);
#pragma unroll
                            for (int jj = 0; jj < 4; ++jj) { v0[jj] = sigmoidf_(v0[jj] + ba[jj]); v1[jj] = sigmoidf_(v1[jj] + bb[jj]); }
                            *(u32x4*)((h16*)out + (size_t)MTOK * 1024 + off) = pack8(v0, v1);
                        } else if (grp == 2) {
                            *(u32x4*)((h16*)(ws + R_G16) + off) = pack8(v0, v1);
                        } else {
                            const f32x4 ba = *(const f32x4*)(bias2 + c), bb = *(const f32x4*)(bias2 + c + 4);
                            float vv[8], vf8[8];
                            h16* vp = (h16*)(ws + R_V16) + off;
                            unpack8(*(const u32x4*)vp, vv); unpack8(*(const u32x4*)((const h16*)(ws + OFF_VF) + off), vf8);
#pragma unroll
                            for (int jj = 0; jj < 4; ++jj) {
                                v0[jj] = vv[jj] + (vf8[jj] - vv[jj]) * sigmoidf_(v0[jj] + ba[jj]);
                                v1[jj] = vv[4 + jj] + (vf8[4 + jj] - vv[4 + jj]) * sigmoidf_(v1[jj] + bb[jj]);
                            }
                            *(u32x4*)vp = pack8(v0, v1);
                        }
                    } else if (mode == E_RESID) {
                        float xr[8];
                        unpack8(*(const u32x4*)((const h16*)(ws + OFF_X16) + xrow(rowg) * 1024 + col), xr);
                        f32x4 r0, r1;
#pragma unroll
                        for (int jj = 0; jj < 4; ++jj) { r0[jj] = DN_ALPHA * xr[jj] + v0[jj]; r1[jj] = DN_ALPHA * xr[4 + jj] + v1[jj]; }
                        float* dp = out + (size_t)rowg * 1024 + col;
                        *(f32x4*)dp = r0; *(f32x4*)(dp + 4) = r1;
                    } else if (mode == E_ST16) {
                        *(u32x4*)((h16*)(ws + F_U16) + (size_t)rowl * 5632 + col) = pack8(v0, v1);
                    } else if (mode == E_ST32) {
                        float* dp = (float*)(ws + D_HIN) + (size_t)rowg * 512 + col;
                        *(f32x4*)dp = v0; *(f32x4*)(dp + 4) = v1;
                    } else {
                        if (u.pn < 8) *(u32x4*)((h16*)(ws + D_QABS) + (size_t)rowg * 2048 + col) = pack8(v0, v1);
                        else *(u32x4*)((h16*)(ws + D_QIDX) + (size_t)rowg * 512 + (col - 2048)) = pack8(v0, v1);
                    }
                }
            }
    }
};

__device__ __forceinline__ const char* a_tile(const Gemm& g, int pm) {
    if (g.amode == 1) { const int row = (pm + g.pm0) * BM; return (const char*)g.A + xrow(row) * 2048; }
    return (const char*)g.A + (size_t)pm * BM * g.lda * 2;
}

__device__ __forceinline__ void gemm_phase(LAS unsigned char* lds, const Gemm g, const StaticOrder& S, const Epi& E) {
    const int tid = opaque_tid(), wid = __builtin_amdgcn_readfirstlane(tid >> 6), lane = tid & 63, wr = wid >> 2, wc = wid & 3, fr = lane & 15, fq = lane >> 4;
    const int K = g.K, nt = K / BK;
    const bool shiftA = (g.amode == 1);
    unsigned voffA[2], voffB[2];
#pragma unroll
    for (int i = 0; i < 2; ++i) { int R, C; stage_rc(tid * 16 + i * 8192, R, C); const int Rb = (R & ~31) + perm32(R & 31);
        voffA[i] = (unsigned)(R * g.lda + C) * 2u; voffB[i] = (unsigned)(Rb * K + C) * 2u; }
    const size_t kstep = (size_t)(BK * 2);
    const size_t hstepA = (size_t)HALF * g.lda * 2;
    const size_t hstepB = (size_t)HALF * K * 2;
    const size_t tstepB = 2 * hstepB;
    const unsigned ldsw = (unsigned)wid * 1024u;
    const int aoff = lds_byte(wr * 64 + fr, fq * 8), boff = lds_byte(wc * 32 + fr, fq * 8);
#define PG8_KOFF(kt) ((size_t)(kt) * kstep - ((shiftA && (kt) >= 16) ? (size_t)4096 : (size_t)0))
#define PG8_SA(b, h) (((b) * 2 + (h)) * HTB)
#define PG8_SB(b, h) ((4 + (b) * 2 + (h)) * HTB)
#define PG8_STAGE(bufoff, gbase, voff) do { _Pragma("unroll") for (int _i = 0; _i < 2; ++_i) \
        __builtin_amdgcn_global_load_lds((const unsigned*)((const char*)(gbase) + (voff)[_i]), (LAS unsigned*)(lds + (bufoff) + ldsw + _i * 8192), 16, 0, 0); } while (0)
#define PG8_LDA(dst, b, h) do { _Pragma("unroll") for (int m = 0; m < 4; ++m) _Pragma("unroll") for (int k = 0; k < 2; ++k) dst[m][k] = *(const LAS h16x8*)(lds + PG8_SA(b, h) + aoff + m * 2048 + k * 1024); } while (0)
#define PG8_LDB(dst, b, h) do { _Pragma("unroll") for (int n = 0; n < 2; ++n) _Pragma("unroll") for (int k = 0; k < 2; ++k) dst[n][k] = *(const LAS h16x8*)(lds + PG8_SB(b, h) + boff + n * 2048 + k * 1024); } while (0)
#define PG8_MMA(ai, bj, At, Bt) do { __builtin_amdgcn_s_setprio(1); _Pragma("unroll") for (int m = 0; m < 4; ++m) _Pragma("unroll") for (int n = 0; n < 2; ++n) _Pragma("unroll") for (int k = 0; k < 2; ++k) \
        acc[ai][bj][m][n] = __builtin_amdgcn_mfma_f32_16x16x32_f16(Bt[n][k], At[m][k], acc[ai][bj][m][n], 0, 0, 0); __builtin_amdgcn_s_setprio(0); } while (0)
#define PG8_WAIT_V(n) asm volatile("s_waitcnt vmcnt(" #n ")" ::: "memory")
#define PG8_WAIT_L(n) asm volatile("s_waitcnt lgkmcnt(" #n ")" ::: "memory")
#define PG8_BAR __builtin_amdgcn_s_barrier()
#define PG8_SCHED __builtin_amdgcn_sched_barrier(0)
    Unit cur, nxt; int ui = 0;
    if (!S.next(0, cur)) return;
    f32x4 acc[2][2][4][2];
#pragma unroll
    for (int a = 0; a < 2; ++a)
#pragma unroll
        for (int b = 0; b < 2; ++b)
#pragma unroll
            for (int m = 0; m < 4; ++m)
#pragma unroll
                for (int n = 0; n < 2; ++n) acc[a][b][m][n] = (f32x4){0.f, 0.f, 0.f, 0.f};
    h16x8 At[4][2], B0[2][2], B1[2][2];
    const char* cA = a_tile(g, cur.pm); const char* cB = (const char*)g.Bt + (size_t)cur.pn * tstepB;
    PG8_STAGE(PG8_SB(0, 0), cB, voffB); PG8_STAGE(PG8_SA(0, 0), cA, voffA); PG8_STAGE(PG8_SB(0, 1), cB + hstepB, voffB); PG8_STAGE(PG8_SA(0, 1), cA + hstepA, voffA);
    if (wr == 1) PG8_BAR;
    PG8_WAIT_V(4); PG8_BAR;
    PG8_STAGE(PG8_SB(1, 0), cB + kstep, voffB); PG8_STAGE(PG8_SA(1, 0), cA + kstep, voffA); PG8_STAGE(PG8_SB(1, 1), cB + hstepB + kstep, voffB);
    PG8_WAIT_V(6); PG8_BAR;
    for (;;) {
        const bool has_next = S.next(ui + 1, nxt);
        const char* nA = has_next ? a_tile(g, nxt.pm) : cA; const char* nB = has_next ? (const char*)g.Bt + (size_t)nxt.pn * tstepB : cB;
        for (int t = 0; t < nt; t += 2) {
            const bool last = (t == nt - 2);
            const char* a1 = cA + PG8_KOFF(t + 1);
            const char* a2 = last ? nA : cA + PG8_KOFF(t + 2); const char* b2 = last ? nB : cB + (size_t)(t + 2) * kstep;
            const char* a3 = a2 + kstep; const char* b3 = b2 + kstep;
            PG8_LDB(B0, 0, 0); PG8_SCHED; PG8_LDA(At, 0, 0); PG8_STAGE(PG8_SA(1, 1), a1 + hstepA, voffA);
            PG8_WAIT_L(8); PG8_BAR; PG8_WAIT_L(0); PG8_MMA(0, 0, At, B0); PG8_BAR; PG8_SCHED;
            PG8_LDB(B1, 0, 1); PG8_STAGE(PG8_SB(0, 0), b2, voffB);
            PG8_BAR; PG8_WAIT_L(0); PG8_MMA(0, 1, At, B1); PG8_BAR;
            PG8_LDA(At, 0, 1); PG8_STAGE(PG8_SA(0, 0), a2, voffA);
            PG8_BAR; PG8_WAIT_L(0); PG8_MMA(1, 0, At, B0); PG8_BAR; PG8_SCHED;
            PG8_STAGE(PG8_SB(0, 1), b2 + hstepB, voffB);
            PG8_WAIT_V(6); PG8_BAR; PG8_MMA(1, 1, At, B1); PG8_BAR;
            PG8_LDB(B0, 1, 0); PG8_SCHED; PG8_LDA(At, 1, 0); PG8_STAGE(PG8_SA(0, 1), a2 + hstepA, voffA);
            PG8_WAIT_L(8); PG8_BAR; PG8_WAIT_L(0); PG8_MMA(0, 0, At, B0); PG8_BAR; PG8_SCHED;
            PG8_LDB(B1, 1, 1); PG8_STAGE(PG8_SB(1, 0), b3, voffB);
            PG8_BAR; PG8_WAIT_L(0); PG8_MMA(0, 1, At, B1); PG8_BAR;
            PG8_LDA(At, 1, 1); PG8_STAGE(PG8_SA(1, 0), a3, voffA);
            PG8_BAR; PG8_WAIT_L(0); PG8_MMA(1, 0, At, B0); PG8_BAR; PG8_SCHED;
            PG8_STAGE(PG8_SB(1, 1), b3 + hstepB, voffB);
            PG8_WAIT_V(6); PG8_BAR; PG8_MMA(1, 1, At, B1); PG8_BAR;
        }
        E(acc, cur, wr, wc, fr, fq);
        if (!has_next) break;
#pragma unroll
        for (int a = 0; a < 2; ++a)
#pragma unroll
            for (int b = 0; b < 2; ++b)
#pragma unroll
                for (int m = 0; m < 4; ++m)
#pragma unroll
                    for (int n = 0; n < 2; ++n) acc[a][b][m][n] = (f32x4){0.f, 0.f, 0.f, 0.f};
        cur = nxt; cA = nA; cB = nB; ++ui;
    }
    PG8_WAIT_V(0);
    if (wr == 0) PG8_BAR;
    PG8_BAR;
#undef PG8_KOFF
#undef PG8_SA
#undef PG8_SB
#undef PG8_STAGE
#undef PG8_LDA
#undef PG8_LDB
#undef PG8_MMA
#undef PG8_WAIT_V
#undef PG8_WAIT_L
#undef PG8_BAR
#undef PG8_SCHED
}
}

struct TJob { int mode; const float* src; int ld, K, N; h16* dst; int ldd, koff; const float* mix; };

__device__ __forceinline__ TJob get_job(const Params& p, int id) {
    TJob J; J.mode = 0; J.src = nullptr; J.ld = 0; J.K = 0; J.N = 0; J.dst = nullptr; J.ldd = 64; J.koff = 0; J.mix = nullptr;
    h16* W = (h16*)(p.ws + OFF_W);
    if (id < 24) {
        const int j = id / 12, s = id % 12;
        h16* Wbig = W + (size_t)j * (10 * MiB); h16* Wl2 = Wbig + 7 * MiB;
        const float* mix = p.in[3] + j * 6 * 1024;
        J.mode = 1; J.ld = 1024; J.K = 1024; J.ldd = 2048;
        if (s < 3) { J.src = p.in[4] + (size_t)(j * 3 + s) * 1048576; J.N = 1024; J.dst = Wbig + (size_t)s * 1024 * 2048; J.mix = mix + s * 1024; }
        else if (s == 3) { J.src = p.in[6] + (size_t)j * 65536; J.ld = 64; J.N = 64; J.dst = Wbig + (size_t)3072 * 2048; J.mix = mix + 3 * 1024; }
        else if (s == 4) { J.src = p.in[9] + (size_t)j * 65536; J.ld = 64; J.N = 64; J.dst = Wbig + (size_t)3136 * 2048; J.mix = mix + 4 * 1024; }
        else if (s == 5) { J.N = 32; J.dst = Wbig + (size_t)3200 * 2048; if (j == 1) { J.src = p.in[12]; J.ld = 32; J.mix = mix + 2 * 1024; } else { J.mode = 2; } }
        else if (s == 6) { J.src = p.in[14] + (size_t)j * 163840; J.ld = 160; J.N = 160; J.dst = Wbig + (size_t)3232 * 2048; J.mix = mix + 5 * 1024; }
        else if (s == 7) { J.mode = 2; J.N = 192; J.dst = Wbig + (size_t)3392 * 2048; }
        else {
            J.mode = 0; J.ld = 1024; J.N = 1024; J.ldd = 512;
            if (s == 8) { J.src = p.in[7] + (size_t)j * 65536; J.K = 64; J.koff = 0; J.dst = Wl2; }
            else if (s == 9) { J.src = p.in[10] + (size_t)j * 65536; J.K = 64; J.koff = 64; J.dst = Wl2 + (size_t)1024 * 512; }
            else if (s == 10) { J.src = p.in[15] + (size_t)j * 163840; J.K = 160; J.koff = 160; J.dst = Wl2 + (size_t)2048 * 512; }
            else { J.src = p.in[13]; J.K = 32; J.koff = 128; J.dst = Wl2 + (size_t)3072 * 512; if (j == 0) J.N = 0; }
        }
    } else if (id < 26) {
        const int j = id - 24;
        J.src = p.in[21] + (size_t)j * 1048576; J.ld = 1024; J.K = 1024; J.N = 1024; J.dst = W + (size_t)j * (10 * MiB) + 9 * MiB; J.ldd = 1024;
    } else if (id < 34) {
        const int i = (id - 26) >> 1, s = (id - 26) & 1;
        h16* base = W + 20 * MiB + (size_t)i * (17 * MiB / 2);
        if (s == 0) { J.src = p.in[33] + (size_t)i * 1024 * 5632; J.ld = 5632; J.K = 1024; J.N = 5632; J.dst = base; J.ldd = 1024; }
        else { J.src = p.in[36] + (size_t)i * 2816 * 1024; J.ld = 1024; J.K = 2816; J.N = 1024; J.dst = base + (size_t)11 * MiB / 2; J.ldd = 2816; }
    } else {
        const int j = (id - 34) >> 2, s = (id - 34) & 3;
        h16* base = W + 54 * MiB + (size_t)j * (5 * MiB / 2);
        if (s == 0) { J.src = p.in[22] + (size_t)j * 1024 * 456; J.ld = 456; J.K = 1024; J.N = 456; J.dst = base; J.ldd = 1024; }
        else if (s == 1) { J.mode = 2; J.N = 56; J.dst = base + (size_t)456 * 1024; J.ldd = 1024; }
        else if (s == 2) { J.src = p.in[28] + (size_t)j * 256 * 512; J.ld = 512; J.K = 256; J.N = 512; J.dst = base + MiB / 2 + (size_t)2048 * 256; J.ldd = 256; }
        else { J.src = p.in[31] + (size_t)j * 1048576; J.ld = 1024; J.K = 1024; J.N = 1024; J.dst = base + 3 * MiB / 2; J.ldd = 1024; }
    }
    return J;
}
__device__ __forceinline__ h16* w_rwkv_big(unsigned char* ws, int j) { return (h16*)(ws + OFF_W) + (size_t)j * (10 * MiB); }
__device__ __forceinline__ h16* w_rwkv_l2(unsigned char* ws, int j) { return w_rwkv_big(ws, j) + 7 * MiB; }
__device__ __forceinline__ h16* w_rwkv_o(unsigned char* ws, int j) { return w_rwkv_big(ws, j) + 9 * MiB; }
__device__ __forceinline__ h16* w_ffn_up(unsigned char* ws, int i) { return (h16*)(ws + OFF_W) + 20 * MiB + (size_t)i * (17 * MiB / 2); }
__device__ __forceinline__ h16* w_ffn_dn(unsigned char* ws, int i) { return w_ffn_up(ws, i) + (size_t)11 * MiB / 2; }
__device__ __forceinline__ h16* w_dsa_in(unsigned char* ws, int j) { return (h16*)(ws + OFF_W) + 54 * MiB + (size_t)j * (5 * MiB / 2); }
__device__ __forceinline__ h16* w_dsa_q(unsigned char* ws, int j) { return w_dsa_in(ws, j) + MiB / 2; }
__device__ __forceinline__ h16* w_dsa_uvt(unsigned char* ws, int j) { return w_dsa_in(ws, j) + 5 * MiB / 4; }
__device__ __forceinline__ h16* w_dsa_o(unsigned char* ws, int j) { return w_dsa_in(ws, j) + 3 * MiB / 2; }

__device__ __forceinline__ void prep_phase(const Params& p, unsigned char* smem) {
    const int tid = opaque_tid();
    const size_t gtid = (size_t)blockIdx.x * 512 + tid, nth = (size_t)gridDim.x * 512;
    h16* x16 = (h16*)(p.ws + OFF_X16);
    for (size_t idx = gtid; idx < (size_t)MTOK * 128; idx += nth) {
        const int row = (int)(idx >> 7), c8 = (int)(idx & 127) * 8;
        const float* sp = p.in[0] + (size_t)row * 1024 + c8;
        const f32x4 a = *(const f32x4*)sp, b = *(const f32x4*)(sp + 4);
        *(u32x4*)(x16 + xrow(row) * 1024 + c8) = pack8(a, b);
    }
    for (size_t idx = gtid; idx < (size_t)NBATCH * 128; idx += nth) {
        const int b = (int)(idx >> 7), c8 = (int)(idx & 127) * 8;
        unsigned z = 0u; asm volatile("" : "+v"(z));
        *(u32x4*)(x16 + (size_t)b * 2049 * 1024 + c8) = (u32x4){z, z, z, z};
    }
    for (size_t idx = gtid; idx < (size_t)2 * 2048 * 256; idx += nth) {
        const int j = (int)(idx >> 19), rem = (int)(idx & 524287), n = rem >> 8, q = rem & 255, h = n >> 7, c = n & 127;
        const float* uq = p.in[25] + (size_t)j * 256 * 1024 + (size_t)q * 1024 + h * 64;
        const float* uk = p.in[26] + (size_t)j * 16 * 64 * 128 + (size_t)h * 64 * 128 + c;
        float s = 0.f;
        for (int d = 0; d < 64; ++d) s += uq[d] * uk[d * 128];
        w_dsa_q(p.ws, j)[(size_t)n * 256 + q] = (h16)(s * 0.125f);
    }
    for (size_t idx = gtid; idx < (size_t)2 * 16 * 64 * 128; idx += nth) {
        const int j = (int)(idx >> 17), rem = (int)(idx & 131071), h = rem >> 13, n = (rem >> 7) & 63, k = rem & 127;
        w_dsa_uvt(p.ws, j)[(size_t)(h * 64 + n) * 128 + k] = (h16)p.in[27][(size_t)((j * 16 + h) * 128 + k) * 64 + n];
    }
    float* tile = (float*)smem;
    for (int id = 0; id < 42; ++id) {
        const TJob J = get_job(p, id);
        const int tk = J.ldd >> 6, tn = (J.N + 63) >> 6, ntile = tk * tn;
        for (int tix = blockIdx.x; tix < ntile; tix += gridDim.x) {
            const int k0 = (tix % tk) * 64, n0 = (tix / tk) * 64;
#pragma unroll
            for (int i = 0; i < 8; ++i) {
                const int k = i * 8 + (tid >> 6), n = tid & 63, kk = k0 + k, nn = n0 + n;
                float v = 0.f;
                if (nn < J.N && J.mode != 2) {
                    if (J.mode == 1) { const int ks = kk & 1023; const float mx = J.mix[ks]; v = J.src[(size_t)ks * J.ld + nn] * (kk < 1024 ? 1.0f - mx : mx); }
                    else if (kk >= J.koff && kk < J.koff + J.K) v = J.src[(size_t)(kk - J.koff) * J.ld + nn];
                }
                tile[k * 65 + n] = v;
            }
            __syncthreads();
#pragma unroll
            for (int i = 0; i < 8; ++i) {
                const int n = i * 8 + (tid >> 6), k = tid & 63, nn = n0 + n;
                if (nn < J.N) J.dst[(size_t)nn * J.ldd + k0 + k] = (h16)tile[k * 65 + n];
            }
            __syncthreads();
        }
    }
}

__device__ __forceinline__ void wave_sum4(float (&v)[4]) {
#pragma unroll
    for (int o = 32; o > 0; o >>= 1) {
        float t[4];
#pragma unroll
        for (int k = 0; k < 4; ++k) t[k] = __shfl_xor(v[k], o);
#pragma unroll
        for (int k = 0; k < 4; ++k) v[k] += t[k];
    }
}
__device__ __forceinline__ void ln_phase(const Params& p, const float* g, const float* b, bool final_out) {
    const int tid = opaque_tid();
    const int lane = tid & 63, wave = tid >> 6;
    float* tb = p.out;
    h16* x16 = (h16*)(p.ws + OFF_X16);
    f32x4 gg[4], bb[4];
#pragma unroll
    for (int i = 0; i < 4; ++i) { gg[i] = *(const f32x4*)(g + i * 256 + lane * 4); bb[i] = *(const f32x4*)(b + i * 256 + lane * 4); }
    for (int rowb = (blockIdx.x * 8 + wave) * 4; rowb < MTOK; rowb += gridDim.x * 32) {
        f32x4 v[4][4];
        float s[4];
#pragma unroll
        for (int k = 0; k < 4; ++k) {
            const float* rp = tb + (size_t)(rowb + k) * 1024;
            s[k] = 0.f;
#pragma unroll
            for (int i = 0; i < 4; ++i) { v[k][i] = *(const f32x4*)(rp + i * 256 + lane * 4); s[k] += (v[k][i][0] + v[k][i][1]) + (v[k][i][2] + v[k][i][3]); }
        }
        wave_sum4(s);
        float q[4];
#pragma unroll
        for (int k = 0; k < 4; ++k) {
            s[k] *= (1.0f / 1024.0f); q[k] = 0.f;
#pragma unroll
            for (int i = 0; i < 4; ++i)
#pragma unroll
                for (int jj = 0; jj < 4; ++jj) { const float d = v[k][i][jj] - s[k]; q[k] += d * d; }
        }
        wave_sum4(q);
#pragma unroll
        for (int k = 0; k < 4; ++k) {
            const float rstd = rsqrtf(q[k] * (1.0f / 1024.0f) + 1e-5f);
            const int row = rowb + k;
#pragma unroll
            for (int i = 0; i < 4; ++i) {
                f32x4 y;
#pragma unroll
                for (int jj = 0; jj < 4; ++jj) y[jj] = (v[k][i][jj] - s[k]) * rstd * gg[i][jj] + bb[i][jj];
                if (final_out) *(f32x4*)(tb + (size_t)row * 1024 + i * 256 + lane * 4) = y;
                else { u32x2 w; w.x = pk2(y[0], y[1]); w.y = pk2(y[2], y[3]); *(u32x2*)(x16 + xrow(row) * 1024 + i * 256 + lane * 4) = w; }
            }
        }
    }
}

__device__ __forceinline__ void conv_phase(const Params& p, int layer) {
    const h16* u = (const h16*)(p.ws + F_U16);
    h16* act = (h16*)(p.ws + F_ACT);
    const float* cw = p.in[34] + (size_t)layer * 3 * 5632;
    const float* cb = p.in[35] + (size_t)layer * 5632;
    const size_t gtid = (size_t)blockIdx.x * 512 + opaque_tid(), nth = (size_t)gridDim.x * 512;
    const size_t ntask = (size_t)2048 * 352;
    for (size_t task = gtid; task < ntask; task += nth) {
        const int cgp = (int)(task % 352), rc = (int)(task / 352), f = cgp * 8, r0 = rc * 16;
        float wg[3][8], wv[3][8], bg[8], bv[8];
#pragma unroll
        for (int jj = 0; jj < 3; ++jj)
#pragma unroll
            for (int hlf = 0; hlf < 2; ++hlf) {
                const f32x4 a = *(const f32x4*)(cw + jj * 5632 + f + hlf * 4), c = *(const f32x4*)(cw + jj * 5632 + DFF + f + hlf * 4);
#pragma unroll
                for (int e = 0; e < 4; ++e) { wg[jj][hlf * 4 + e] = a[e]; wv[jj][hlf * 4 + e] = c[e]; }
            }
#pragma unroll
        for (int hlf = 0; hlf < 2; ++hlf) {
            const f32x4 a = *(const f32x4*)(cb + f + hlf * 4), c = *(const f32x4*)(cb + DFF + f + hlf * 4);
#pragma unroll
            for (int e = 0; e < 4; ++e) { bg[hlf * 4 + e] = a[e]; bv[hlf * 4 + e] = c[e]; }
        }
        float g2[8], g1[8], v2[8], v1[8];
#pragma unroll
        for (int e = 0; e < 8; ++e) { g2[e] = 0.f; g1[e] = 0.f; v2[e] = 0.f; v1[e] = 0.f; }
        if ((r0 & 2047) != 0) {
            unpack8(*(const u32x4*)(u + (size_t)(r0 - 2) * 5632 + f), g2); unpack8(*(const u32x4*)(u + (size_t)(r0 - 1) * 5632 + f), g1);
            unpack8(*(const u32x4*)(u + (size_t)(r0 - 2) * 5632 + DFF + f), v2); unpack8(*(const u32x4*)(u + (size_t)(r0 - 1) * 5632 + DFF + f), v1);
        }
#pragma unroll 1
        for (int i0 = 0; i0 < 16; i0 += 4) {
            u32x4 lg[4], lv[4];
#pragma unroll
            for (int i = 0; i < 4; ++i) { const size_t ro = (size_t)(r0 + i0 + i) * 5632; lg[i] = *(const u32x4*)(u + ro + f); lv[i] = *(const u32x4*)(u + ro + DFF + f); }
#pragma unroll
            for (int i = 0; i < 4; ++i) {
                float g0[8], v0[8], o[8];
                unpack8(lg[i], g0); unpack8(lv[i], v0);
#pragma unroll
                for (int e = 0; e < 8; ++e) {
                    const float G = wg[0][e] * g2[e] + wg[1][e] * g1[e] + wg[2][e] * g0[e] + bg[e];
                    const float V = wv[0][e] * v2[e] + wv[1][e] * v1[e] + wv[2][e] * v0[e] + bv[e];
                    o[e] = G * sigmoidf_(G) * V;
                    g2[e] = g1[e]; g1[e] = g0[e]; v2[e] = v1[e]; v1[e] = v0[e];
                }
                *(u32x4*)(act + (size_t)(r0 + i0 + i) * DFF + f) = pack8((f32x4){o[0], o[1], o[2], o[3]}, (f32x4){o[4], o[5], o[6], o[7]});
            }
        }
    }
}

__device__ __forceinline__ float dppf(float x, const int ctrl_sel) {
    const int v = __builtin_bit_cast(int, x);
    int r;
    if (ctrl_sel == 0) r = __builtin_amdgcn_update_dpp(0, v, 0xB1, 0xF, 0xF, true);
    else if (ctrl_sel == 1) r = __builtin_amdgcn_update_dpp(0, v, 0x4E, 0xF, 0xF, true);
    else if (ctrl_sel == 2) r = __builtin_amdgcn_update_dpp(0, v, 0x141, 0xF, 0xF, true);
    else r = __builtin_amdgcn_update_dpp(0, v, 0x140, 0xF, 0xF, true);
    return __builtin_bit_cast(float, r);
}
__device__ __forceinline__ float red4(float x) { x += dppf(x, 0); x += dppf(x, 1); return x; }
__device__ __forceinline__ float red16(float x) { x += dppf(x, 0); x += dppf(x, 1); x += dppf(x, 2); x += dppf(x, 3); return x; }
__device__ __forceinline__ void unpack4(u32x2 w, float* f) {
    h16x4 h = __builtin_bit_cast(h16x4, w);
#pragma unroll
    for (int i = 0; i < 4; ++i) f[i] = (float)h[i];
}
constexpr int SCAN_BUF = 8256;
__device__ __forceinline__ void scan_phase(const Params& p, int j, unsigned char* smem) {
    const int tid = opaque_tid();
    const int wave = tid >> 6, lane = tid & 63, slot = wave >> 2, w4 = wave & 3;
    float* LB = (float*)smem + slot * (2 * SCAN_BUF);
    h16* r16 = (h16*)(p.ws + R_R16);
    const h16* k16 = (const h16*)(p.ws + R_K16);
    const h16* v16 = (j == 0) ? (const h16*)(p.ws + OFF_VF) : (const h16*)(p.ws + R_V16);
    const h16* g16 = (const h16*)(p.ws + R_G16);
    const h16* e16 = (const h16*)p.out;
    const h16* a16 = (const h16*)p.out + (size_t)MTOK * 1024;
    const int tp = w4 * 4 + (lane >> 4), k4 = (lane & 15) * 4;
    const int vrow = w4 * 16 + (lane >> 2), kq = lane & 3;
    for (int pair = blockIdx.x; pair < 256; pair += gridDim.x) {
        const int chain = pair * 2 + slot, b = chain >> 4, h = chain & 15;
        const int col = h * 64 + k4;
        const f32x4 c_kk = *(const f32x4*)(p.in[16] + j * 1024 + col), c_ka = *(const f32x4*)(p.in[17] + j * 1024 + col), c_rk = *(const f32x4*)(p.in[18] + j * 1024 + col);
        const f32x4 c_lg = *(const f32x4*)(p.in[19] + j * 1024 + col), c_lb = *(const f32x4*)(p.in[20] + j * 1024 + col);
        f32x2 S[8];
#pragma unroll
        for (int i = 0; i < 8; ++i) S[i] = (f32x2){0.f, 0.f};
        u32x2 pr[6];
        {
            const size_t go = ((size_t)(b * 2048 + tp)) * 1024 + col;
            pr[0] = *(const u32x2*)(r16 + go); pr[1] = *(const u32x2*)(k16 + go); pr[2] = *(const u32x2*)(v16 + go);
            pr[3] = *(const u32x2*)(e16 + go); pr[4] = *(const u32x2*)(a16 + go); pr[5] = *(const u32x2*)(g16 + go);
        }
        for (int ch = 0; ch < 128; ++ch) {
            float* BUF = LB + (ch & 1) * SCAN_BUF;
            float* OPS = BUF; float* VB = BUF + 5120; float* GB = BUF + 6144; float* YB = BUF + 7168; float* BON = BUF + 8192;
            {
                float rf[4], kf[4], vf[4], ef[4], af[4], gf[4];
                unpack4(pr[0], rf); unpack4(pr[1], kf); unpack4(pr[2], vf); unpack4(pr[3], ef); unpack4(pr[4], af); unpack4(pr[5], gf);
                float kk[4]; float ss = 0.f;
#pragma unroll
                for (int i = 0; i < 4; ++i) { kk[i] = kf[i] * c_kk[i]; ss += kk[i] * kk[i]; }
                ss = red16(ss);
                const float inv = 1.0f / fmaxf(sqrtf(ss), 1e-12f);
                f32x4 A4, B4, W4, K4, R4; float bs = 0.f;
#pragma unroll
                for (int i = 0; i < 4; ++i) {
                    const float kn = kk[i] * inv;
                    A4[i] = -kn; B4[i] = kn * af[i];
                    W4[i] = __expf(-ef[i]);
                    const float km = kf[i] * (1.0f + (af[i] - 1.0f) * c_ka[i]);
                    K4[i] = km; R4[i] = rf[i];
                    bs += rf[i] * km * c_rk[i];
                }
                bs = red16(bs);
                float* o = OPS + tp * 320 + k4;
                *(f32x4*)(o) = A4; *(f32x4*)(o + 64) = B4; *(f32x4*)(o + 128) = W4; *(f32x4*)(o + 192) = K4; *(f32x4*)(o + 256) = R4;
                *(f32x4*)(VB + tp * 64 + k4) = (f32x4){vf[0], vf[1], vf[2], vf[3]};
                *(f32x4*)(GB + tp * 64 + k4) = (f32x4){gf[0], gf[1], gf[2], gf[3]};
                if ((lane & 15) == 0) BON[tp] = bs;
            }
            if (ch + 1 < 128) {
                const size_t go = ((size_t)(b * 2048 + (ch + 1) * 16 + tp)) * 1024 + col;
                pr[0] = *(const u32x2*)(r16 + go); pr[1] = *(const u32x2*)(k16 + go); pr[2] = *(const u32x2*)(v16 + go);
                pr[3] = *(const u32x2*)(e16 + go); pr[4] = *(const u32x2*)(a16 + go); pr[5] = *(const u32x2*)(g16 + go);
            }
            __syncthreads();
#pragma unroll 2
            for (int t = 0; t < 16; ++t) {
                const float* op = OPS + t * 320 + kq * 16;
                f32x4 A4[4], B4[4], W4[4], K4[4], R4[4];
#pragma unroll
                for (int i = 0; i < 4; ++i) A4[i] = *(const f32x4*)(op + i * 4);
#pragma unroll
                for (int i = 0; i < 4; ++i) { W4[i] = *(const f32x4*)(op + 128 + i * 4); B4[i] = *(const f32x4*)(op + 64 + i * 4); K4[i] = *(const f32x4*)(op + 192 + i * 4); }
#pragma unroll
                for (int i = 0; i < 4; ++i) R4[i] = *(const f32x4*)(op + 256 + i * 4);
                const float vv = VB[t * 64 + vrow];
                f32x2 s0 = {0.f, 0.f}, s1 = {0.f, 0.f};
#pragma unroll
                for (int i = 0; i < 4; ++i) { s0 += S[2 * i] * (f32x2){A4[i][0], A4[i][1]}; s1 += S[2 * i + 1] * (f32x2){A4[i][2], A4[i][3]}; }
                const float sa = red4((s0[0] + s0[1]) + (s1[0] + s1[1]));
                const f32x2 sa2 = {sa, sa}, vv2 = {vv, vv};
#pragma unroll
                for (int i = 0; i < 4; ++i) {
                    S[2 * i] = S[2 * i] * (f32x2){W4[i][0], W4[i][1]} + sa2 * (f32x2){B4[i][0], B4[i][1]} + vv2 * (f32x2){K4[i][0], K4[i][1]};
                    S[2 * i + 1] = S[2 * i + 1] * (f32x2){W4[i][2], W4[i][3]} + sa2 * (f32x2){B4[i][2], B4[i][3]} + vv2 * (f32x2){K4[i][2], K4[i][3]};
                }
                f32x2 y0 = {0.f, 0.f}, y1 = {0.f, 0.f};
#pragma unroll
                for (int i = 0; i < 4; ++i) { y0 += S[2 * i] * (f32x2){R4[i][0], R4[i][1]}; y1 += S[2 * i + 1] * (f32x2){R4[i][2], R4[i][3]}; }
                const float y = red4((y0[0] + y0[1]) + (y1[0] + y1[1]));
                if (kq == 0) YB[t * 64 + vrow] = y;
            }
            __syncthreads();
            {
                const f32x4 y4 = *(const f32x4*)(YB + tp * 64 + k4), v4 = *(const f32x4*)(VB + tp * 64 + k4), g4 = *(const f32x4*)(GB + tp * 64 + k4);
                const float mu = red16((y4[0] + y4[1]) + (y4[2] + y4[3])) * (1.0f / 64.0f);
                float q = 0.f;
#pragma unroll
                for (int i = 0; i < 4; ++i) { const float d = y4[i] - mu; q += d * d; }
                const float rstd = rsqrtf(red16(q) * (1.0f / 64.0f) + 64e-5f);
                const float bon = BON[tp];
                float o[4];
#pragma unroll
                for (int i = 0; i < 4; ++i) o[i] = ((y4[i] - mu) * rstd * c_lg[i] + c_lb[i] + bon * v4[i]) * g4[i];
                u32x2 w; w.x = pk2(o[0], o[1]); w.y = pk2(o[2], o[3]);
                *(u32x2*)(r16 + ((size_t)(b * 2048 + ch * 16 + tp)) * 1024 + col) = w;
            }
        }
        __syncthreads();
    }
}

__device__ __forceinline__ void dsa_norm_phase(const Params& p, int j, unsigned char* smem) {
    const int tid = opaque_tid();
    const int lane = tid & 63, wave = tid >> 6;
    const float* hin = (const float*)(p.ws + D_HIN);
    h16* cq = (h16*)(p.ws + D_CQ); h16* ckv = (h16*)(p.ws + D_CKV); h16* ckvt = (h16*)(p.ws + D_CKVT); h16* kidx = (h16*)(p.ws + D_KIDX);
    float* widx = (float*)(p.ws + D_WIDX);
    const f32x4 gq = *(const f32x4*)(p.in[23] + j * 256 + lane * 4);
    const f32x2 gkv = *(const f32x2*)(p.in[24] + j * 128 + lane * 2);
    const float gi = p.in[29][j * 64 + lane], bi = p.in[30][j * 64 + lane];
    h16* wl = (h16*)(smem + wave * 2048);
    for (int grp = blockIdx.x * 8 + wave; grp < MTOK / 8; grp += gridDim.x * 8) {
        const int r0 = grp * 8;
        for (int i = 0; i < 8; ++i) {
            const int row = r0 + i;
            const float* hp = hin + (size_t)row * 512;
            const f32x4 vq = *(const f32x4*)(hp + lane * 4);
            const f32x2 vk = *(const f32x2*)(hp + 256 + lane * 2);
            const float vi = hp[384 + lane];
            float ssq = wave_sum(vq[0] * vq[0] + vq[1] * vq[1] + vq[2] * vq[2] + vq[3] * vq[3]);
            const float rq = rsqrtf(ssq * (1.0f / 256.0f) + 1e-6f);
            u32x2 w; w.x = pk2(vq[0] * rq * gq[0], vq[1] * rq * gq[1]); w.y = pk2(vq[2] * rq * gq[2], vq[3] * rq * gq[3]);
            *(u32x2*)(cq + (size_t)row * 256 + lane * 4) = w;
            float ssk = wave_sum(vk[0] * vk[0] + vk[1] * vk[1]);
            const float rk = rsqrtf(ssk * (1.0f / 128.0f) + 1e-6f);
            const unsigned wk = pk2(vk[0] * rk * gkv[0], vk[1] * rk * gkv[1]);
            *(unsigned*)(ckv + (size_t)row * 128 + lane * 2) = wk;
            *(unsigned*)(wl + i * 128 + lane * 2) = wk;
            const float mu = wave_sum(vi) * (1.0f / 64.0f);
            const float dv = vi - mu;
            const float var = wave_sum(dv * dv) * (1.0f / 64.0f);
            kidx[(size_t)row * 64 + lane] = (h16)(dv * rsqrtf(var + 1e-5f) * gi + bi);
            if (lane < 8) widx[(size_t)row * 8 + lane] = hp[448 + lane] * 0.044194173824159216f;
        }
        asm volatile("s_waitcnt lgkmcnt(0)" ::: "memory");
        const int b = r0 >> 11, t0 = r0 & 2047;
#pragma unroll
        for (int dd = 0; dd < 2; ++dd) {
            const int d = lane * 2 + dd;
            h16x8 hv;
#pragma unroll
            for (int i = 0; i < 8; ++i) hv[i] = wl[i * 128 + d];
            *(h16x8*)(ckvt + ((size_t)(b * 128 + d)) * 2048 + t0) = hv;
        }
        asm volatile("s_waitcnt lgkmcnt(0)" ::: "memory");
    }
}

constexpr int ROWP = 2052;
__device__ __forceinline__ unsigned fkey(float x) {
    if (x == 0.0f) x = 0.0f;
    const unsigned u = __float_as_uint(x);
    return (u & 0x80000000u) ? ~u : (u | 0x80000000u);
}
__device__ __forceinline__ void dsa_index_phase(const Params& p, unsigned char* smem) {
    const int tid = opaque_tid(), wave = tid >> 6, lane = tid & 63, r = lane & 15, q = lane >> 4;
    float* SC = (float*)smem;
    const h16* qidx = (const h16*)(p.ws + D_QIDX);
    const h16* kidx = (const h16*)(p.ws + D_KIDX);
    const float* widx = (const float*)(p.ws + D_WIDX);
    unsigned* maskb = (unsigned*)(p.ws + D_MASK);
    for (int qi = blockIdx.x, it = 0; qi < MTOK / 16; qi += gridDim.x, ++it) {
        const int qt = (it & 1) ? ((qi & ~127) | (127 - (qi & 127))) : qi;
        const int row0 = qt * 16, b = row0 >> 11, t0 = row0 & 2047;
        const int nkt = (t0 >> 4) + 1;
        {
            h16x8 qf[8][2]; float wq[8];
#pragma unroll
            for (int h = 0; h < 8; ++h) {
#pragma unroll
                for (int kk = 0; kk < 2; ++kk) qf[h][kk] = *(const h16x8*)(qidx + (size_t)(row0 + r) * 512 + h * 64 + kk * 32 + q * 8);
                wq[h] = widx[(size_t)(row0 + r) * 8 + h];
            }
            for (int kt = wave; kt < nkt; kt += 8) {
                const int s0 = kt * 16;
                const h16* kp = kidx + (size_t)(b * 2048 + s0 + r) * 64 + q * 8;
                const h16x8 k0 = *(const h16x8*)kp, k1 = *(const h16x8*)(kp + 32);
                f32x4 sc = {0.f, 0.f, 0.f, 0.f};
#pragma unroll
                for (int h = 0; h < 8; ++h) {
                    f32x4 acc = {0.f, 0.f, 0.f, 0.f};
                    acc = __builtin_amdgcn_mfma_f32_16x16x32_f16(k0, qf[h][0], acc, 0, 0, 0);
                    acc = __builtin_amdgcn_mfma_f32_16x16x32_f16(k1, qf[h][1], acc, 0, 0, 0);
#pragma unroll
                    for (int jj = 0; jj < 4; ++jj) sc[jj] += fmaxf(acc[jj], 0.f) * wq[h];
                }
                *(f32x4*)(SC + r * ROWP + s0 + q * 4) = sc;
            }
        }
        __syncthreads();
        for (int qq = 0; qq < 2; ++qq) {
            const int ql = wave * 2 + qq, t = t0 + ql;
            const float* srow = SC + ql * ROWP;
            const int ni = (t >> 6) + 1;
            unsigned u[32];
#pragma unroll
            for (int i = 0; i < 32; ++i) {
                u[i] = 0u;
                if (i < ni) { const int s = i * 64 + lane; if (s <= t) u[i] = fkey(srow[s]); }
            }
            unsigned myw = 0u;
            if (t < 256) {
#pragma unroll
                for (int i = 0; i < 32; ++i) { const unsigned long long sm = __ballot(u[i] != 0u); if ((lane >> 1) == i) myw = (lane & 1) ? (unsigned)(sm >> 32) : (unsigned)sm; }
            } else {
                unsigned T = 0u;
                for (int bit = 31; bit >= 0; --bit) {
                    const unsigned cand = T | (1u << bit);
                    int cnt = 0;
#pragma unroll
                    for (int i = 0; i < 32; ++i) if (i < ni) cnt += __popcll(__ballot(u[i] >= cand));
                    if (cnt >= 256) T = cand;
                }
                int cgt = 0;
#pragma unroll
                for (int i = 0; i < 32; ++i) if (i < ni) cgt += __popcll(__ballot(u[i] > T));
                const int need = 256 - cgt;
                int running = 0;
                const unsigned long long lt = (lane == 0) ? 0ull : (~0ull >> (64 - lane));
#pragma unroll
                for (int i = 0; i < 32; ++i) {
                    if (i < ni) {
                        const unsigned long long eq = __ballot(u[i] == T);
                        const int rank = running + __popcll(eq & lt);
                        const unsigned long long sm = __ballot(u[i] > T || (u[i] == T && rank < need));
                        running += __popcll(eq);
                        if ((lane >> 1) == i) myw = (lane & 1) ? (unsigned)(sm >> 32) : (unsigned)sm;
                    }
                }
            }
            maskb[(size_t)(row0 + ql) * 64 + lane] = myw;
        }
        __syncthreads();
    }
}

constexpr int AT_KROW = 272, AT_VROW = 144, AT_KBYTES = 64 * AT_KROW, AT_VBYTES = 128 * AT_VROW, AT_STAGE = AT_KBYTES + AT_VBYTES, AT_BL = 2 * AT_STAGE;
__device__ __forceinline__ void dsa_attn_phase(const Params& p, int j, unsigned char* smem) {
    const int tid = opaque_tid(), wave = tid >> 6, lane = tid & 63, r = lane & 15, q = lane >> 4;
    float* BL = (float*)(smem + AT_BL);
    for (int idx = tid; idx < 16 * 129; idx += 512) {
        const int h = idx / 129, d = idx % 129;
        int bk = d;
        if (d >= 16) { bk = 16 + (int)(logf((float)d * (1.0f / 16.0f)) / 2.0794415416798357f * 16.0f); bk = bk > 31 ? 31 : bk; }
        BL[h * 132 + d] = p.in[32][bk * 16 + h];
    }
    __syncthreads();
    const h16* qabs = (const h16*)(p.ws + D_QABS);
    const h16* ckv = (const h16*)(p.ws + D_CKV);
    const h16* ckvt = (const h16*)(p.ws + D_CKVT);
    const unsigned* maskb = (const unsigned*)(p.ws + D_MASK);
    h16* o16 = (h16*)(p.ws + D_O16);
    const h16* wuvt = w_dsa_uvt(p.ws, j);
    const float NINF = -__builtin_inff();
    const int krow0 = tid >> 4, kcc = tid & 15, vrow0 = tid >> 3, vcc = tid & 7;
    for (int qi = blockIdx.x, it = 0; qi < MTOK / 16; qi += gridDim.x, ++it) {
        const int qt = (it & 1) ? ((qi & ~127) | (127 - (qi & 127))) : qi;
        const int row0 = qt * 16, b = row0 >> 11, t0 = row0 & 2047, nst = (t0 + 16 + 63) >> 6, tq = t0 + r;
        const h16* kg = ckv + (size_t)(b * 2048) * 128;
        const h16* vg = ckvt + (size_t)(b * 128) * 2048;
        u32x4 sk[2], sv[2];
#pragma unroll
        for (int i = 0; i < 2; ++i) {
            sk[i] = *(const u32x4*)(kg + (size_t)(krow0 + i * 32) * 128 + kcc * 8);
            sv[i] = *(const u32x4*)(vg + (size_t)(vrow0 + i * 64) * 2048 + vcc * 8);
        }
        h16x8 qf[2][4];
#pragma unroll
        for (int hh = 0; hh < 2; ++hh)
#pragma unroll
            for (int kk = 0; kk < 4; ++kk) qf[hh][kk] = *(const h16x8*)(qabs + (size_t)(row0 + r) * 2048 + (2 * wave + hh) * 128 + kk * 32 + q * 8);
        f32x4 O[2][8];
#pragma unroll
        for (int hh = 0; hh < 2; ++hh)
#pragma unroll
            for (int dt = 0; dt < 8; ++dt) O[hh][dt] = (f32x4){0.f, 0.f, 0.f, 0.f};
        float mrun[2] = {NINF, NINF}, lrun[2] = {0.f, 0.f};
#pragma unroll
        for (int i = 0; i < 2; ++i) {
            *(u32x4*)(smem + (krow0 + i * 32) * AT_KROW + kcc * 16) = sk[i];
            *(u32x4*)(smem + AT_KBYTES + (vrow0 + i * 64) * AT_VROW + vcc * 16) = sv[i];
        }
        __syncthreads();
        for (int st = 0; st < nst; ++st) {
            const int s0 = st * 64;
            const unsigned char* Kb = smem + (st & 1) * AT_STAGE;
            const unsigned char* Vb = Kb + AT_KBYTES;
            const u32x2 mw2 = *(const u32x2*)(maskb + (size_t)(row0 + r) * 64 + st * 2);
            if (st + 1 < nst) {
#pragma unroll
                for (int i = 0; i < 2; ++i) {
                    sk[i] = *(const u32x4*)(kg + (size_t)(s0 + 64 + krow0 + i * 32) * 128 + kcc * 8);
                    sv[i] = *(const u32x4*)(vg + (size_t)(vrow0 + i * 64) * 2048 + s0 + 64 + vcc * 8);
                }
            }
#pragma nounroll
            for (int hf = 0; hf < 2; ++hf) {
                const unsigned mw = hf ? mw2.y : mw2.x;
                h16x8 pf[2]; float alpha[2];
#pragma unroll
                for (int hh = 0; hh < 2; ++hh) {
                    const int h = 2 * wave + hh;
                    f32x4 sc[2];
#pragma unroll
                    for (int tt = 0; tt < 2; ++tt) {
                        f32x4 acc = {0.f, 0.f, 0.f, 0.f};
#pragma unroll
                        for (int kk = 0; kk < 4; ++kk) {
                            const h16x8 kf = *(const h16x8*)(Kb + (hf * 32 + tt * 16 + r) * AT_KROW + kk * 64 + q * 16);
                            acc = __builtin_amdgcn_mfma_f32_16x16x32_f16(kf, qf[hh][kk], acc, 0, 0, 0);
                        }
                        sc[tt] = acc;
                    }
                    float x[8]; float mx = NINF;
#pragma unroll
                    for (int tt = 0; tt < 2; ++tt)
#pragma unroll
                        for (int jj = 0; jj < 4; ++jj) {
                            const int kix = tt * 16 + q * 4 + jj;
                            int dist = tq - (s0 + hf * 32 + kix); dist = dist < 0 ? 0 : (dist > 128 ? 128 : dist);
                            const float v = sc[tt][jj] + BL[h * 132 + dist];
                            const float xv = ((mw >> kix) & 1u) ? v : NINF;
                            x[tt * 4 + jj] = xv; mx = fmaxf(mx, xv);
                        }
                    mx = fmaxf(mx, __shfl_xor(mx, 16)); mx = fmaxf(mx, __shfl_xor(mx, 32));
                    const float mnew = fmaxf(mrun[hh], mx);
                    const float mref = (mnew == NINF) ? 0.f : mnew;
                    alpha[hh] = __expf(mrun[hh] - mref);
                    mrun[hh] = mnew;
                    float ps = 0.f;
#pragma unroll
                    for (int i = 0; i < 8; ++i) { const float pv = __expf(x[i] - mref); ps += pv; pf[hh][i] = (h16)pv; }
                    lrun[hh] = lrun[hh] * alpha[hh] + ps;
                    __builtin_amdgcn_sched_barrier(0);
                }
#pragma unroll
                for (int dt = 0; dt < 8; ++dt) {
                    if ((dt & 1) == 0) __builtin_amdgcn_sched_barrier(0);
                    const unsigned char* vp = Vb + (dt * 16 + r) * AT_VROW + (hf * 32 + q * 4) * 2;
                    const h16x4 lo = *(const h16x4*)vp, hi = *(const h16x4*)(vp + 32);
                    const h16x8 vf = {lo[0], lo[1], lo[2], lo[3], hi[0], hi[1], hi[2], hi[3]};
#pragma unroll
                    for (int hh = 0; hh < 2; ++hh) {
                        O[hh][dt] *= alpha[hh];
                        O[hh][dt] = __builtin_amdgcn_mfma_f32_16x16x32_f16(vf, pf[hh], O[hh][dt], 0, 0, 0);
                    }
                }
                __builtin_amdgcn_sched_barrier(0);
            }
            if (st + 1 < nst) {
                unsigned char* Kn = smem + ((st + 1) & 1) * AT_STAGE;
#pragma unroll
                for (int i = 0; i < 2; ++i) {
                    *(u32x4*)(Kn + (krow0 + i * 32) * AT_KROW + kcc * 16) = sk[i];
                    *(u32x4*)(Kn + AT_KBYTES + (vrow0 + i * 64) * AT_VROW + vcc * 16) = sv[i];
                }
            }
            __syncthreads();
        }
#pragma unroll
        for (int hh = 0; hh < 2; ++hh) {
            const int h = 2 * wave + hh;
            float lt = lrun[hh]; lt += __shfl_xor(lt, 16); lt += __shfl_xor(lt, 32);
            const float inv = 1.0f / lt;
#pragma unroll
            for (int vt = 0; vt < 4; ++vt) {
                f32x4 acc = {0.f, 0.f, 0.f, 0.f};
#pragma unroll
                for (int kk = 0; kk < 4; ++kk) {
                    const h16* ap = wuvt + (size_t)(h * 64 + vt * 16 + r) * 128 + kk * 32 + q * 4;
                    const h16x4 lo = *(const h16x4*)ap, hi = *(const h16x4*)(ap + 16);
                    const h16x8 a8 = {lo[0], lo[1], lo[2], lo[3], hi[0], hi[1], hi[2], hi[3]};
                    h16x8 b8;
#pragma unroll
                    for (int i = 0; i < 4; ++i) { b8[i] = (h16)(O[hh][2 * kk][i] * inv); b8[4 + i] = (h16)(O[hh][2 * kk + 1][i] * inv); }
                    acc = __builtin_amdgcn_mfma_f32_16x16x32_f16(a8, b8, acc, 0, 0, 0);
                }
                u32x2 w; w.x = pk2(acc[0], acc[1]); w.y = pk2(acc[2], acc[3]);
                *(u32x2*)(o16 + (size_t)(row0 + r) * 1024 + h * 64 + vt * 16 + q * 4) = w;
            }
        }
    }
    __syncthreads();
}

__global__ void __launch_bounds__(512) mega_fwd(Params p) {
    extern __shared__ __attribute__((aligned(16))) unsigned char smem[];
    cg::grid_group grid = cg::this_grid();
    unsigned char* ws = p.ws;
    h16* x16 = (h16*)(ws + OFF_X16);
    for (int ph = p.ph_lo; ph < p.ph_hi; ++ph) {
        const unsigned e = p.prog[ph];
        const int kind = e & 15, L = (e >> 4) & 3, sub = (e >> 6) & 1, j = L >> 1;
        const int nrep = 1 + (int)(e >> 7);
        for (int rep = 0; rep < nrep; ++rep) {
        if (rep) grid.sync();
        const bool isgemm = (kind == K_R1 || kind == K_R2 || kind == K_R4 || kind == K_F1 || kind == K_F3 || kind == K_D1 || kind == K_D3 || kind == K_D6);
        if (isgemm) {
            pg8::Gemm g; pg8::Epi E;
            g.M = MTOK; g.N = 1024; g.K = 1024; g.lda = 1024; g.amode = 0; g.pm0 = 0; g.A = x16; g.Bt = x16;
            E.mode = E_RESID; E.pm0 = 0; E.j = j; E.ws = ws; E.out = p.out; E.bias0 = p.in[5] + j * 1024; E.bias1 = p.in[8] + j * 1024; E.bias2 = p.in[11];
            if (kind == K_R1) {
                g.Bt = w_rwkv_big(ws, j); g.N = 3584; g.K = 2048; g.amode = 1; E.mode = E_RPROJ;
            } else if (kind == K_R2) {
                g.A = (const h16*)(ws + R_HACT); g.Bt = w_rwkv_l2(ws, j); g.N = (j == 0) ? 3072 : 4096; g.K = 512; g.lda = 512; E.mode = E_LORA2;
            } else if (kind == K_R4) {
                g.A = (const h16*)(ws + R_R16); g.Bt = w_rwkv_o(ws, j);
            } else if (kind == K_F1) {
                g.Bt = w_ffn_up(ws, L); g.M = MTOK / 2; g.N = 5632; g.amode = 1; g.pm0 = sub * 128; E.mode = E_ST16;
            } else if (kind == K_F3) {
                g.A = (const h16*)(ws + F_ACT); g.Bt = w_ffn_dn(ws, L); g.M = MTOK / 2; g.K = 2816; g.lda = 2816; E.pm0 = sub * 128;
            } else if (kind == K_D1) {
                g.Bt = w_dsa_in(ws, j); g.N = 512; g.amode = 1; E.mode = E_ST32;
            } else if (kind == K_D3) {
                g.A = (const h16*)(ws + D_CQ); g.Bt = w_dsa_q(ws, j); g.N = 2560; g.K = 256; g.lda = 256; E.mode = E_QPROJ;
            } else {
                g.A = (const h16*)(ws + D_O16); g.Bt = w_dsa_o(ws, j);
            }
            pg8::StaticOrder S; S.init(g.M, g.N, (int)gridDim.x, (int)blockIdx.x);
#ifndef NO_GEMM
            pg8::gemm_phase((LAS unsigned char*)smem, g, S, E);
#endif
        } else if (kind == K_PREP) {
#ifndef NO_PREP
            prep_phase(p, smem);
#endif
        } else if (kind == K_R3) {
#ifndef NO_SCAN
            scan_phase(p, j, smem);
#endif
        } else if (kind == K_LN) {
#ifndef NO_LN
            ln_phase(p, p.in[1] + (L * 2 + sub) * 1024, p.in[2] + (L * 2 + sub) * 1024, L == 3 && sub == 1);
#endif
        } else if (kind == K_F2) {
#ifndef NO_CONV
            conv_phase(p, L);
#endif
        } else if (kind == K_D2) {
#ifndef NO_NORM
            dsa_norm_phase(p, j, smem);
#endif
        } else if (kind == K_D4) {
#ifndef NO_INDEX
            dsa_index_phase(p, smem);
#endif
        } else if (kind == K_D5) {
#ifndef NO_ATTN
            dsa_attn_phase(p, j, smem);
#endif
        }
        }
        if (ph + 1 < p.ph_hi) grid.sync();
    }
}

extern "C" void kernel_launch(void* const* d_in, const int* in_sizes, int n_in, void* d_out, int out_size, void* d_ws, size_t ws_size, hipStream_t stream) {
    static int grid_blocks = 0;
    if (grid_blocks == 0) {
        if (n_in != 37 || ws_size < WS_NEED || out_size != MTOK * DM) { fprintf(stderr, "kernel_launch: unexpected problem (n_in %d ws %zu out %d)\n", n_in, ws_size, out_size); grid_blocks = -1; return; }
        int dev = 0, cus = 0, per_cu = 0;
        hipGetDevice(&dev);
        hipDeviceGetAttribute(&cus, hipDeviceAttributeMultiprocessorCount, dev);
        if (hipFuncSetAttribute((const void*)mega_fwd, hipFuncAttributeMaxDynamicSharedMemorySize, LDS_BYTES) != hipSuccess) { fprintf(stderr, "kernel_launch: hipFuncSetAttribute failed\n"); grid_blocks = -1; return; }
        hipOccupancyMaxActiveBlocksPerMultiprocessor(&per_cu, (const void*)mega_fwd, 512, LDS_BYTES);
        if (per_cu < 1) { fprintf(stderr, "kernel_launch: occupancy query says %d blocks/CU\n", per_cu); per_cu = 1; }
        (void)hipGetLastError();
        grid_blocks = cus * per_cu;
        fprintf(stderr, "kernel_launch: grid %d (cus %d x %d)\n", grid_blocks, cus, per_cu);
    }
    if (grid_blocks < 0) return;
    Params p{};
    for (int i = 0; i < 37; ++i) p.in[i] = (const float*)d_in[i];
    p.ws = (unsigned char*)d_ws; p.out = (float*)d_out;
    int np = 0;
    constexpr unsigned PROBE_MASK = 0u;
    auto add = [&](int kind, int L, int sub) { p.prog[np++] = (unsigned char)(kind | (L << 4) | (sub << 6) | ((((PROBE_MASK >> kind) & 1u) && !(kind == K_LN && L == 3 && sub == 1)) ? 128 : 0)); };
    add(K_PREP, 0, 0);
    for (int L = 0; L < 4; ++L) {
        if ((L & 1) == 0) { add(K_R1, L, 0); add(K_R2, L, 0); add(K_R3, L, 0); add(K_R4, L, 0); }
        else { add(K_D1, L, 0); add(K_D2, L, 0); add(K_D3, L, 0); add(K_D4, L, 0); add(K_D5, L, 0); add(K_D6, L, 0); }
        add(K_LN, L, 0);
        for (int c = 0; c < 2; ++c) { add(K_F1, L, c); add(K_F2, L, c); add(K_F3, L, c); }
        add(K_LN, L, 1);
    }
#if SINGLE_LAUNCH
    p.ph_lo = 0; p.ph_hi = np;
    void* args[] = {&p};
    hipError_t e = hipLaunchCooperativeKernel((const void*)mega_fwd, dim3(grid_blocks), dim3(512), args, LDS_BYTES, stream);
    if (e != hipSuccess) fprintf(stderr, "cooperative launch failed: %s (grid %d)\n", hipGetErrorString(e), grid_blocks);
#else
    for (int ph = 0; ph < np; ++ph) {
        p.ph_lo = ph; p.ph_hi = ph + 1;
        hipLaunchKernelGGL(mega_fwd, dim3(grid_blocks), dim3(512), LDS_BYTES, stream, p);
    }
#endif
}
```

```cpp
#include <hip/hip_runtime.h>
#include <hip/hip_cooperative_groups.h>
#include <cstdio>
namespace cg = cooperative_groups;

constexpr int EXTRA_SYNC = 0;
#ifndef SINGLE_LAUNCH
#define SINGLE_LAUNCH 1
#endif

#define LAS __attribute__((address_space(3)))
typedef _Float16 h16;
typedef _Float16 h16x8 __attribute__((ext_vector_type(8)));
typedef _Float16 h16x4 __attribute__((ext_vector_type(4)));
typedef _Float16 h16x2 __attribute__((ext_vector_type(2)));
typedef float f32x4 __attribute__((ext_vector_type(4)));
typedef float f32x2 __attribute__((ext_vector_type(2)));
typedef unsigned u32x4 __attribute__((ext_vector_type(4)));
typedef unsigned u32x2 __attribute__((ext_vector_type(2)));

constexpr int DM = 1024, SEQ = 2048, NBATCH = 32, MTOK = NBATCH * SEQ;
constexpr int DFF = 2816;
constexpr size_t MiB = (size_t)1 << 20;
constexpr float DN_ALPHA = 1.6817928305074290f;
constexpr int LDS_BYTES = 147456;

constexpr size_t OFF_W = 0;
constexpr size_t OFF_X16 = 118 * MiB;
constexpr size_t OFF_VF = 247 * MiB;
constexpr size_t OFF_R = 375 * MiB;
constexpr size_t WS_NEED = 952 * MiB;
constexpr size_t R_R16 = OFF_R, R_K16 = OFF_R + 128 * MiB, R_V16 = OFF_R + 256 * MiB, R_G16 = OFF_R + 384 * MiB, R_HACT = OFF_R + 512 * MiB;
constexpr size_t F_U16 = OFF_R, F_ACT = OFF_R + 352 * MiB;
constexpr size_t D_HIN = OFF_R, D_O16 = OFF_R, D_QABS = OFF_R + 128 * MiB, D_QIDX = OFF_R + 384 * MiB, D_CQ = OFF_R + 448 * MiB,
                 D_CKV = OFF_R + 480 * MiB, D_CKVT = OFF_R + 496 * MiB, D_KIDX = OFF_R + 512 * MiB, D_WIDX = OFF_R + 520 * MiB, D_MASK = OFF_R + 522 * MiB;

struct Params {
    const float* in[37];
    unsigned char* ws;
    float* out;
    int ph_lo, ph_hi;
    unsigned char prog[64];
};

enum { K_PREP = 0, K_R1, K_R2, K_R3, K_R4, K_LN, K_F1, K_F2, K_F3, K_D1, K_D2, K_D3, K_D4, K_D5, K_D6 };
enum { E_RPROJ = 0, E_LORA2, E_RESID, E_ST16, E_ST32, E_QPROJ };

__device__ __forceinline__ size_t xrow(int row) { return (size_t)(row >> 11) * 2049 + 1 + (row & 2047); }
__device__ __forceinline__ unsigned pk2(float a, float b) { h16x2 h = {(h16)a, (h16)b}; return __builtin_bit_cast(unsigned, h); }
__device__ __forceinline__ u32x4 pack8(f32x4 a, f32x4 b) { u32x4 w; w.x = pk2(a[0], a[1]); w.y = pk2(a[2], a[3]); w.z = pk2(b[0], b[1]); w.w = pk2(b[2], b[3]); return w; }
__device__ __forceinline__ void unpack8(u32x4 w, float* f) {
    h16x8 h = __builtin_bit_cast(h16x8, w);
#pragma unroll
    for (int i = 0; i < 8; ++i) f[i] = (float)h[i];
}
__device__ __forceinline__ float sigmoidf_(float x) { return 1.0f / (1.0f + __expf(-x)); }
__device__ __forceinline__ float wave_sum(float v) {
#pragma unroll
    for (int o = 32; o > 0; o >>= 1) v += __shfl_xor(v, o);
    return v;
}
#define WSYNC() asm volatile("s_waitcnt vmcnt(0) lgkmcnt(0)" ::: "memory")
__device__ __forceinline__ int opaque_tid() { int t = threadIdx.x; asm volatile("" : "+v"(t)); return t; }

namespace pg8 {
constexpr int BM = 256, BK = 64, HALF = 128, HTB = HALF * BK * 2, STAGE_BYTES = 8 * HTB, NXCD = 8, WGM = 8;
__device__ __forceinline__ int lds_byte(int r, int c) { const int st = (r >> 4) * 2 + (c >> 5), rr = r & 15, cc = c & 31, ob = rr * 64 + cc * 2; return st * 1024 + (ob ^ (((ob >> 9) & 1) << 5)); }
__device__ __forceinline__ void stage_rc(int b, int& R, int& C) { const int st = b / 1024, sb = b % 1024, swz = sb ^ (((sb >> 9) & 1) << 5); R = (st >> 1) * 16 + swz / 64; C = (st & 1) * 32 + (swz % 64) / 2; }
__device__ __forceinline__ int perm32(int rho) { const int n = rho >> 4, i = rho & 15; return 8 * (i >> 2) + 4 * n + (i & 3); }
struct Unit { int pm, pn; };
struct Gemm { const h16* A; const h16* Bt; int M, N, K, lda, amode, pm0; };
struct StaticOrder {
    int nM, nN, nwg, G, c;
    __device__ void init(int M, int N, int G_, int c_) { nM = M / BM; nN = N / BM; nwg = nM * nN; G = G_; c = c_; }
    __device__ bool next(int i, Unit& u) const {
        const long L = (long)i * G + c; if (L >= nwg) return false;
        int wgid = (int)L; { const int q = nwg / NXCD, r = nwg % NXCD, xcd = wgid % NXCD, off = wgid / NXCD; wgid = (xcd < r ? xcd * (q + 1) : r * (q + 1) + (xcd - r) * q) + off; }
        const int nig = WGM * nN, gid = wgid / nig, fm = gid * WGM, gsz = (nM - fm) < WGM ? (nM - fm) : WGM;
        u.pm = fm + ((wgid % nig) % gsz); u.pn = (wgid % nig) / gsz; return true;
    }
};

struct Epi {
    int mode, pm0, j;
    unsigned char* ws; float* out; const float* bias0; const float* bias1; const float* bias2;
    __device__ __forceinline__ void operator()(const f32x4 (&acc)[2][2][4][2], const Unit& u, int wr, int wc, int fr, int fq) const {
        const int rowl0 = u.pm * BM + wr * 64 + fr;
        const int colt = u.pn * BM + wc * 32 + 8 * fq;
#pragma unroll
        for (int ai = 0; ai < 2; ++ai)
#pragma unroll
            for (int m = 0; m < 4; ++m) {
                const int rowl = rowl0 + ai * HALF + m * 16;
                const int rowg = rowl + pm0 * BM;
#pragma unroll
                for (int bj = 0; bj < 2; ++bj) {
                    const int col = colt + bj * HALF;
                    f32x4 v0 = acc[ai][bj][m][0], v1 = acc[ai][bj][m][1];
                    if (mode == E_RPROJ) {
                        if (u.pn < 12) {
                            h16* dst = (h16*)(ws + (u.pn < 4 ? R_R16 : (u.pn < 8 ? R_K16 : (j == 0 ? OFF_VF : R_V16))));
                            *(u32x4*)(dst + (size_t)rowg * 1024 + (col & 1023)) = pack8(v0, v1);
                        } else {
                            const int hc = col - 3072;
                            if (hc < 64) {
#pragma unroll
                                for (int jj = 0; jj < 4; ++jj) { v0[jj] = tanhf(v0[jj]); v1[jj] = tanhf(v1[jj]); }
                            } else if (hc >= 160) {
#pragma unroll
                                for (int jj = 0; jj < 4; ++jj) { v0[jj] = sigmoidf_(v0[jj]); v1[jj] = sigmoidf_(v1[jj]); }
                            }
                            *(u32x4*)((h16*)(ws + R_HACT) + (size_t)rowg * 512 + hc) = pack8(v0, v1);
                        }
                    } else if (mode == E_LORA2) {
                        const int grp = u.pn >> 2, c = col & 1023;
                        const size_t off = (size_t)rowg * 1024 + c;
                        if (grp == 0) {
                            const f32x4 ba = *(const f32x4*)(bias0 + c), bb = *(const f32x4*)(bias0 + c + 4);
#pragma unroll
                            for (int jj = 0; jj < 4; ++jj) { v0[jj] = sigmoidf_(v0[jj] + ba[jj]) * 0.6065306597f; v1[jj] = sigmoidf_(v1[jj] + bb[jj]) * 0.6065306597f; }
                            *(u32x4*)((h16*)out + off) = pack8(v0, v1);
                        } else if (grp == 1) {
                            const f32x4 ba = *(const f32x4*)(bias1 + c), bb = *(const f32x4*)(bias1 + c + 4);
#pragma unroll
                            for (int jj = 0; jj < 4; ++jj) { v0[jj] = sigmoidf_(v0[jj] + ba[jj]); v1[jj] = sigmoidf_(v1[jj] + bb[jj]); }
                            *(u32x4*)((h16*)out + (size_t)MTOK * 1024 + off) = pack8(v0, v1);
                        } else if (grp == 2) {
                            *(u32x4*)((h16*)(ws + R_G16) + off) = pack8(v0, v1);
                        } else {
                            const f32x4 ba = *(const f32x4*)(bias2 + c), bb = *(const f32x4*)(bias2 + c + 4);
                            float vv[8], vf8[8];
                            h16* vp = (h16*)(ws + R_V16) + off;
                            unpack8(*(const u32x4*)vp, vv); unpack8(*(const u32x4*)((const h16*)(ws + OFF_VF) + off), vf8);
#pragma unroll
                            for (int jj = 0; jj < 4; ++jj) {
                                v0[jj] = vv[jj] + (vf8[jj] - vv[jj]) * sigmoidf_(v0[jj] + ba[jj]);
                                v1[jj] = vv[4 + jj] + (vf8[4 + jj] - vv[4 + jj]) * sigmoidf_(v1[jj] + bb[jj]);
                            }
                            *(u32x4*)vp = pack8(v0, v1);
                        }
                    } else if (mode == E_RESID) {
                        float xr[8];
                        unpack8(*(const u32x4*)((const h16*)(ws + OFF_X16) + xrow(rowg) * 1024 + col), xr);
                        f32x4 r0, r1;
#pragma unroll
                        for (int jj = 0; jj < 4; ++jj) { r0[jj] = DN_ALPHA * xr[jj] + v0[jj]; r1[jj] = DN_ALPHA * xr[4 + jj] + v1[jj]; }
                        float* dp = out + (size_t)rowg * 1024 + col;
                        *(f32x4*)dp = r0; *(f32x4*)(dp + 4) = r1;
                    } else if (mode == E_ST16) {
                        *(u32x4*)((h16*)(ws + F_U16) + (size_t)rowl * 5632 + col) = pack8(v0, v1);
                    } else if (mode == E_ST32) {
                        float* dp = (float*)(ws + D_HIN) + (size_t)rowg * 512 + col;
                        *(f32x4*)dp = v0; *(f32x4*)(dp + 4) = v1;
                    } else {
                        if (u.pn < 8) *(u32x4*)((h16*)(ws + D_QABS) + (size_t)rowg * 2048 + col) = pack8(v0, v1);
                        else *(u32x4*)((h16*)(ws + D_QIDX) + (size_t)rowg * 512 + (col - 2048)) = pack8(v0, v1);
                    }
                }
            }
    }
};

__device__ __forceinline__ const char* a_tile(const Gemm& g, int pm) {
    if (g.amode == 1) { const int row = (pm + g.pm0) * BM; return (const char*)g.A + xrow(row) * 2048; }
    return (const char*)g.A + (size_t)pm * BM * g.lda * 2;
}

__device__ __forceinline__ void gemm_phase(LAS unsigned char* lds, const Gemm g, const StaticOrder& S, const Epi& E) {
    const int tid = opaque_tid(), wid = __builtin_amdgcn_readfirstlane(tid >> 6), lane = tid & 63, wr = wid >> 2, wc = wid & 3, fr = lane & 15, fq = lane >> 4;
    const int K = g.K, nt = K / BK;
    const bool shiftA = (g.amode == 1);
    unsigned voffA[2], voffB[2];
#pragma unroll
    for (int i = 0; i < 2; ++i) { int R, C; stage_rc(tid * 16 + i * 8192, R, C); const int Rb = (R & ~31) + perm32(R & 31);
        voffA[i] = (unsigned)(R * g.lda + C) * 2u; voffB[i] = (unsigned)(Rb * K + C) * 2u; }
    const size_t kstep = (size_t)(BK * 2);
    const size_t hstepA = (size_t)HALF * g.lda * 2;
    const size_t hstepB = (size_t)HALF * K * 2;
    const size_t tstepB = 2 * hstepB;
    const unsigned ldsw = (unsigned)wid * 1024u;
    const int aoff = lds_byte(wr * 64 + fr, fq * 8), boff = lds_byte(wc * 32 + fr, fq * 8);
#define PG8_KOFF(kt) ((size_t)(kt) * kstep - ((shiftA && (kt) >= 16) ? (size_t)4096 : (size_t)0))
#define PG8_SA(b, h) (((b) * 2 + (h)) * HTB)
#define PG8_SB(b, h) ((4 + (b) * 2 + (h)) * HTB)
#define PG8_STAGE(bufoff, gbase, voff) do { _Pragma("unroll") for (int _i = 0; _i < 2; ++_i) \
        __builtin_amdgcn_global_load_lds((const unsigned*)((const char*)(gbase) + (voff)[_i]), (LAS unsigned*)(lds + (bufoff) + ldsw + _i * 8192), 16, 0, 0); } while (0)
#define PG8_LDA(dst, b, h) do { _Pragma("unroll") for (int m = 0; m < 4; ++m) _Pragma("unroll") for (int k = 0; k < 2; ++k) dst[m][k] = *(const LAS h16x8*)(lds + PG8_SA(b, h) + aoff + m * 2048 + k * 1024); } while (0)
#define PG8_LDB(dst, b, h) do { _Pragma("unroll") for (int n = 0; n < 2; ++n) _Pragma("unroll") for (int k = 0; k < 2; ++k) dst[n][k] = *(const LAS h16x8*)(lds + PG8_SB(b, h) + boff + n * 2048 + k * 1024); } while (0)
#define PG8_MMA(ai, bj, At, Bt) do { __builtin_amdgcn_s_setprio(1); _Pragma("unroll") for (int m = 0; m < 4; ++m) _Pragma("unroll") for (int n = 0; n < 2; ++n) _Pragma("unroll") for (int k = 0; k < 2; ++k) \
        acc[ai][bj][m][n] = __builtin_amdgcn_mfma_f32_16x16x32_f16(Bt[n][k], At[m][k], acc[ai][bj][m][n], 0, 0, 0); __builtin_amdgcn_s_setprio(0); } while (0)
#define PG8_WAIT_V(n) asm volatile("s_waitcnt vmcnt(" #n ")" ::: "memory")
#define PG8_WAIT_L(n) asm volatile("s_waitcnt lgkmcnt(" #n ")" ::: "memory")
#define PG8_BAR __builtin_amdgcn_s_barrier()
#define PG8_SCHED __builtin_amdgcn_sched_barrier(0)
    Unit cur, nxt; int ui = 0;
    if (!S.next(0, cur)) return;
    f32x4 acc[2][2][4][2];
#pragma unroll
    for (int a = 0; a < 2; ++a)
#pragma unroll
        for (int b = 0; b < 2; ++b)
#pragma unroll
            for (int m = 0; m < 4; ++m)
#pragma unroll
                for (int n = 0; n < 2; ++n) acc[a][b][m][n] = (f32x4){0.f, 0.f, 0.f, 0.f};
    h16x8 At[4][2], B0[2][2], B1[2][2];
    const char* cA = a_tile(g, cur.pm); const char* cB = (const char*)g.Bt + (size_t)cur.pn * tstepB;
    PG8_STAGE(PG8_SB(0, 0), cB, voffB); PG8_STAGE(PG8_SA(0, 0), cA, voffA); PG8_STAGE(PG8_SB(0, 1), cB + hstepB, voffB); PG8_STAGE(PG8_SA(0, 1), cA + hstepA, voffA);
    if (wr == 1) PG8_BAR;
    PG8_WAIT_V(4); PG8_BAR;
    PG8_STAGE(PG8_SB(1, 0), cB + kstep, voffB); PG8_STAGE(PG8_SA(1, 0), cA + kstep, voffA); PG8_STAGE(PG8_SB(1, 1), cB + hstepB + kstep, voffB);
    PG8_WAIT_V(6); PG8_BAR;
    for (;;) {
        const bool has_next = S.next(ui + 1, nxt);
        const char* nA = has_next ? a_tile(g, nxt.pm) : cA; const char* nB = has_next ? (const char*)g.Bt + (size_t)nxt.pn * tstepB : cB;
        for (int t = 0; t < nt; t += 2) {
            const bool last = (t == nt - 2);
            const char* a1 = cA + PG8_KOFF(t + 1);
            const char* a2 = last ? nA : cA + PG8_KOFF(t + 2); const char* b2 = last ? nB : cB + (size_t)(t + 2) * kstep;
            const char* a3 = a2 + kstep; const char* b3 = b2 + kstep;
            PG8_LDB(B0, 0, 0); PG8_SCHED; PG8_LDA(At, 0, 0); PG8_STAGE(PG8_SA(1, 1), a1 + hstepA, voffA);
            PG8_WAIT_L(8); PG8_BAR; PG8_WAIT_L(0); PG8_MMA(0, 0, At, B0); PG8_BAR; PG8_SCHED;
            PG8_LDB(B1, 0, 1); PG8_STAGE(PG8_SB(0, 0), b2, voffB);
            PG8_BAR; PG8_WAIT_L(0); PG8_MMA(0, 1, At, B1); PG8_BAR;
            PG8_LDA(At, 0, 1); PG8_STAGE(PG8_SA(0, 0), a2, voffA);
            PG8_BAR; PG8_WAIT_L(0); PG8_MMA(1, 0, At, B0); PG8_BAR; PG8_SCHED;
            PG8_STAGE(PG8_SB(0, 1), b2 + hstepB, voffB);
            PG8_WAIT_V(6); PG8_BAR; PG8_MMA(1, 1, At, B1); PG8_BAR;
            PG8_LDB(B0, 1, 0); PG8_SCHED; PG8_LDA(At, 1, 0); PG8_STAGE(PG8_SA(0, 1), a2 + hstepA, voffA);
            PG8_WAIT_L(8); PG8_BAR; PG8_WAIT_L(0); PG8_MMA(0, 0, At, B0); PG8_BAR; PG8_SCHED;
            PG8_LDB(B1, 1, 1); PG8_STAGE(PG8_SB(1, 0), b3, voffB);
            PG8_BAR; PG8_WAIT_L(0); PG8_MMA(0, 1, At, B1); PG8_BAR;
            PG8_LDA(At, 1, 1); PG8_STAGE(PG8_SA(1, 0), a3, voffA);
            PG8_BAR; PG8_WAIT_L(0); PG8_MMA(1, 0, At, B0); PG8_BAR; PG8_SCHED;
            PG8_STAGE(PG8_SB(1, 1), b3 + hstepB, voffB);
            PG8_WAIT_V(6); PG8_BAR; PG8_MMA(1, 1, At, B1); PG8_BAR;
        }
        E(acc, cur, wr, wc, fr, fq);
        if (!has_next) break;
#pragma unroll
        for (int a = 0; a < 2; ++a)
#pragma unroll
            for (int b = 0; b < 2; ++b)
#pragma unroll
                for (int m = 0; m < 4; ++m)
#pragma unroll
                    for (int n = 0; n < 2; ++n) acc[a][b][m][n] = (f32x4){0.f, 0.f, 0.f, 0.f};
        cur = nxt; cA = nA; cB = nB; ++ui;
    }
    PG8_WAIT_V(0);
    if (wr == 0) PG8_BAR;
    PG8_BAR;
#undef PG8_KOFF
#undef PG8_SA
#undef PG8_SB
#undef PG8_STAGE
#undef PG8_LDA
#undef PG8_LDB
#undef PG8_MMA
#undef PG8_WAIT_V
#undef PG8_WAIT_L
#undef PG8_BAR
#undef PG8_SCHED
}
}

struct TJob { int mode; const float* src; int ld, K, N; h16* dst; int ldd, koff; const float* mix; };

__device__ __forceinline__ TJob get_job(const Params& p, int id) {
    TJob J; J.mode = 0; J.src = nullptr; J.ld = 0; J.K = 0; J.N = 0; J.dst = nullptr; J.ldd = 64; J.koff = 0; J.mix = nullptr;
    h16* W = (h16*)(p.ws + OFF_W);
    if (id < 24) {
        const int j = id / 12, s = id % 12;
        h16* Wbig = W + (size_t)j * (10 * MiB); h16* Wl2 = Wbig + 7 * MiB;
        const float* mix = p.in[3] + j * 6 * 1024;
        J.mode = 1; J.ld = 1024; J.K = 1024; J.ldd = 2048;
        if (s < 3) { J.src = p.in[4] + (size_t)(j * 3 + s) * 1048576; J.N = 1024; J.dst = Wbig + (size_t)s * 1024 * 2048; J.mix = mix + s * 1024; }
        else if (s == 3) { J.src = p.in[6] + (size_t)j * 65536; J.ld = 64; J.N = 64; J.dst = Wbig + (size_t)3072 * 2048; J.mix = mix + 3 * 1024; }
        else if (s == 4) { J.src = p.in[9] + (size_t)j * 65536; J.ld = 64; J.N = 64; J.dst = Wbig + (size_t)3136 * 2048; J.mix = mix + 4 * 1024; }
        else if (s == 5) { J.N = 32; J.dst = Wbig + (size_t)3200 * 2048; if (j == 1) { J.src = p.in[12]; J.ld = 32; J.mix = mix + 2 * 1024; } else { J.mode = 2; } }
        else if (s == 6) { J.src = p.in[14] + (size_t)j * 163840; J.ld = 160; J.N = 160; J.dst = Wbig + (size_t)3232 * 2048; J.mix = mix + 5 * 1024; }
        else if (s == 7) { J.mode = 2; J.N = 192; J.dst = Wbig + (size_t)3392 * 2048; }
        else {
            J.mode = 0; J.ld = 1024; J.N = 1024; J.ldd = 512;
            if (s == 8) { J.src = p.in[7] + (size_t)j * 65536; J.K = 64; J.koff = 0; J.dst = Wl2; }
            else if (s == 9) { J.src = p.in[10] + (size_t)j * 65536; J.K = 64; J.koff = 64; J.dst = Wl2 + (size_t)1024 * 512; }
            else if (s == 10) { J.src = p.in[15] + (size_t)j * 163840; J.K = 160; J.koff = 160; J.dst = Wl2 + (size_t)2048 * 512; }
            else { J.src = p.in[13]; J.K = 32; J.koff = 128; J.dst = Wl2 + (size_t)3072 * 512; if (j == 0) J.N = 0; }
        }
    } else if (id < 26) {
        const int j = id - 24;
        J.src = p.in[21] + (size_t)j * 1048576; J.ld = 1024; J.K = 1024; J.N = 1024; J.dst = W + (size_t)j * (10 * MiB) + 9 * MiB; J.ldd = 1024;
    } else if (id < 34) {
        const int i = (id - 26) >> 1, s = (id - 26) & 1;
        h16* base = W + 20 * MiB + (size_t)i * (17 * MiB / 2);
        if (s == 0) { J.src = p.in[33] + (size_t)i * 1024 * 5632; J.ld = 5632; J.K = 1024; J.N = 5632; J.dst = base; J.ldd = 1024; }
        else { J.src = p.in[36] + (size_t)i * 2816 * 1024; J.ld = 1024; J.K = 2816; J.N = 1024; J.dst = base + (size_t)11 * MiB / 2; J.ldd = 2816; }
    } else {
        const int j = (id - 34) >> 2, s = (id - 34) & 3;
        h16* base = W + 54 * MiB + (size_t)j * (5 * MiB / 2);
        if (s == 0) { J.src = p.in[22] + (size_t)j * 1024 * 456; J.ld = 456; J.K = 1024; J.N = 456; J.dst = base; J.ldd = 1024; }
        else if (s == 1) { J.mode = 2; J.N = 56; J.dst = base + (size_t)456 * 1024; J.ldd = 1024; }
        else if (s == 2) { J.src = p.in[28] + (size_t)j * 256 * 512; J.ld = 512; J.K = 256; J.N = 512; J.dst = base + MiB / 2 + (size_t)2048 * 256; J.ldd = 256; }
        else { J.src = p.in[31] + (size_t)j * 1048576; J.ld = 1024; J.K = 1024; J.N = 1024; J.dst = base + 3 * MiB / 2; J.ldd = 1024; }
    }
    return J;
}
__device__ __forceinline__ h16* w_rwkv_big(unsigned char* ws, int j) { return (h16*)(ws + OFF_W) + (size_t)j * (10 * MiB); }
__device__ __forceinline__ h16* w_rwkv_l2(unsigned char* ws, int j) { return w_rwkv_big(ws, j) + 7 * MiB; }
__device__ __forceinline__ h16* w_rwkv_o(unsigned char* ws, int j) { return w_rwkv_big(ws, j) + 9 * MiB; }
__device__ __forceinline__ h16* w_ffn_up(unsigned char* ws, int i) { return (h16*)(ws + OFF_W) + 20 * MiB + (size_t)i * (17 * MiB / 2); }
__device__ __forceinline__ h16* w_ffn_dn(unsigned char* ws, int i) { return w_ffn_up(ws, i) + (size_t)11 * MiB / 2; }
__device__ __forceinline__ h16* w_dsa_in(unsigned char* ws, int j) { return (h16*)(ws + OFF_W) + 54 * MiB + (size_t)j * (5 * MiB / 2); }
__device__ __forceinline__ h16* w_dsa_q(unsigned char* ws, int j) { return w_dsa_in(ws, j) + MiB / 2; }
__device__ __forceinline__ h16* w_dsa_uvt(unsigned char* ws, int j) { return w_dsa_in(ws, j) + 5 * MiB / 4; }
__device__ __forceinline__ h16* w_dsa_o(unsigned char* ws, int j) { return w_dsa_in(ws, j) + 3 * MiB / 2; }

__device__ __forceinline__ void prep_phase(const Params& p, unsigned char* smem) {
    const int tid = opaque_tid();
    const size_t gtid = (size_t)blockIdx.x * 512 + tid, nth = (size_t)gridDim.x * 512;
    h16* x16 = (h16*)(p.ws + OFF_X16);
    for (size_t idx = gtid; idx < (size_t)MTOK * 128; idx += nth) {
        const int row = (int)(idx >> 7), c8 = (int)(idx & 127) * 8;
        const float* sp = p.in[0] + (size_t)row * 1024 + c8;
        const f32x4 a = *(const f32x4*)sp, b = *(const f32x4*)(sp + 4);
        *(u32x4*)(x16 + xrow(row) * 1024 + c8) = pack8(a, b);
    }
    for (size_t idx = gtid; idx < (size_t)NBATCH * 128; idx += nth) {
        const int b = (int)(idx >> 7), c8 = (int)(idx & 127) * 8;
        unsigned z = 0u; asm volatile("" : "+v"(z));
        *(u32x4*)(x16 + (size_t)b * 2049 * 1024 + c8) = (u32x4){z, z, z, z};
    }
    for (size_t idx = gtid; idx < (size_t)2 * 2048 * 256; idx += nth) {
        const int j = (int)(idx >> 19), rem = (int)(idx & 524287), n = rem >> 8, q = rem & 255, h = n >> 7, c = n & 127;
        const float* uq = p.in[25] + (size_t)j * 256 * 1024 + (size_t)q * 1024 + h * 64;
        const float* uk = p.in[26] + (size_t)j * 16 * 64 * 128 + (size_t)h * 64 * 128 + c;
        float s = 0.f;
        for (int d = 0; d < 64; ++d) s += uq[d] * uk[d * 128];
        w_dsa_q(p.ws, j)[(size_t)n * 256 + q] = (h16)(s * 0.125f);
    }
    for (size_t idx = gtid; idx < (size_t)2 * 16 * 64 * 128; idx += nth) {
        const int j = (int)(idx >> 17), rem = (int)(idx & 131071), h = rem >> 13, n = (rem >> 7) & 63, k = rem & 127;
        w_dsa_uvt(p.ws, j)[(size_t)(h * 64 + n) * 128 + k] = (h16)p.in[27][(size_t)((j * 16 + h) * 128 + k) * 64 + n];
    }
    float* tile = (float*)smem;
    for (int id = 0; id < 42; ++id) {
        const TJob J = get_job(p, id);
        const int tk = J.ldd >> 6, tn = (J.N + 63) >> 6, ntile = tk * tn;
        for (int tix = blockIdx.x; tix < ntile; tix += gridDim.x) {
            const int k0 = (tix % tk) * 64, n0 = (tix / tk) * 64;
#pragma unroll
            for (int i = 0; i < 8; ++i) {
                const int k = i * 8 + (tid >> 6), n = tid & 63, kk = k0 + k, nn = n0 + n;
                float v = 0.f;
                if (nn < J.N && J.mode != 2) {
                    if (J.mode == 1) { const int ks = kk & 1023; const float mx = J.mix[ks]; v = J.src[(size_t)ks * J.ld + nn] * (kk < 1024 ? 1.0f - mx : mx); }
                    else if (kk >= J.koff && kk < J.koff + J.K) v = J.src[(size_t)(kk - J.koff) * J.ld + nn];
                }
                tile[k * 65 + n] = v;
            }
            __syncthreads();
#pragma unroll
            for (int i = 0; i < 8; ++i) {
                const int n = i * 8 + (tid >> 6), k = tid & 63, nn = n0 + n;
                if (nn < J.N) J.dst[(size_t)nn * J.ldd + k0 + k] = (h16)tile[k * 65 + n];
            }
            __syncthreads();
        }
    }
}

__device__ __forceinline__ void wave_sum4(float (&v)[4]) {
#pragma unroll
    for (int o = 32; o > 0; o >>= 1) {
        float t[4];
#pragma unroll
        for (int k = 0; k < 4; ++k) t[k] = __shfl_xor(v[k], o);
#pragma unroll
        for (int k = 0; k < 4; ++k) v[k] += t[k];
    }
}
__device__ __forceinline__ void ln_phase(const Params& p, const float* g, const float* b, bool final_out) {
    const int tid = opaque_tid();
    const int lane = tid & 63, wave = tid >> 6;
    float* tb = p.out;
    h16* x16 = (h16*)(p.ws + OFF_X16);
    f32x4 gg[4], bb[4];
#pragma unroll
    for (int i = 0; i < 4; ++i) { gg[i] = *(const f32x4*)(g + i * 256 + lane * 4); bb[i] = *(const f32x4*)(b + i * 256 + lane * 4); }
    for (int rowb = (blockIdx.x * 8 + wave) * 4; rowb < MTOK; rowb += gridDim.x * 32) {
        f32x4 v[4][4];
        float s[4];
#pragma unroll
        for (int k = 0; k < 4; ++k) {
            const float* rp = tb + (size_t)(rowb + k) * 1024;
            s[k] = 0.f;
#pragma unroll
            for (int i = 0; i < 4; ++i) { v[k][i] = *(const f32x4*)(rp + i * 256 + lane * 4); s[k] += (v[k][i][0] + v[k][i][1]) + (v[k][i][2] + v[k][i][3]); }
        }
        wave_sum4(s);
        float q[4];
#pragma unroll
        for (int k = 0; k < 4; ++k) {
            s[k] *= (1.0f / 1024.0f); q[k] = 0.f;
#pragma unroll
            for (int i = 0; i < 4; ++i)
#pragma unroll
                for (int jj = 0; jj < 4; ++jj) { const float d = v[k][i][jj] - s[k]; q[k] += d * d; }
        }
        wave_sum4(q);
#pragma unroll
        for (int k = 0; k < 4; ++k) {
            const float rstd = rsqrtf(q[k] * (1.0f / 1024.0f) + 1e-5f);
            const int row = rowb + k;
#pragma unroll
            for (int i = 0; i < 4; ++i) {
                f32x4 y;
#pragma unroll
                for (int jj = 0; jj < 4; ++jj) y[jj] = (v[k][i][jj] - s[k]) * rstd * gg[i][jj] + bb[i][jj];
                if (final_out) *(f32x4*)(tb + (size_t)row * 1024 + i * 256 + lane * 4) = y;
                else { u32x2 w; w.x = pk2(y[0], y[1]); w.y = pk2(y[2], y[3]); *(u32x2*)(x16 + xrow(row) * 1024 + i * 256 + lane * 4) = w; }
            }
        }
    }
}

__device__ __forceinline__ void conv_phase(const Params& p, int layer) {
    const h16* u = (const h16*)(p.ws + F_U16);
    h16* act = (h16*)(p.ws + F_ACT);
    const float* cw = p.in[34] + (size_t)layer * 3 * 5632;
    const float* cb = p.in[35] + (size_t)layer * 5632;
    const size_t gtid = (size_t)blockIdx.x * 512 + opaque_tid(), nth = (size_t)gridDim.x * 512;
    const size_t ntask = (size_t)2048 * 352;
    for (size_t task = gtid; task < ntask; task += nth) {
        const int cgp = (int)(task % 352), rc = (int)(task / 352), f = cgp * 8, r0 = rc * 16;
        float wg[3][8], wv[3][8], bg[8], bv[8];
#pragma unroll
        for (int jj = 0; jj < 3; ++jj)
#pragma unroll
            for (int hlf = 0; hlf < 2; ++hlf) {
                const f32x4 a = *(const f32x4*)(cw + jj * 5632 + f + hlf * 4), c = *(const f32x4*)(cw + jj * 5632 + DFF + f + hlf * 4);
#pragma unroll
                for (int e = 0; e < 4; ++e) { wg[jj][hlf * 4 + e] = a[e]; wv[jj][hlf * 4 + e] = c[e]; }
            }
#pragma unroll
        for (int hlf = 0; hlf < 2; ++hlf) {
            const f32x4 a = *(const f32x4*)(cb + f + hlf * 4), c = *(const f32x4*)(cb + DFF + f + hlf * 4);
#pragma unroll
            for (int e = 0; e < 4; ++e) { bg[hlf * 4 + e] = a[e]; bv[hlf * 4 + e] = c[e]; }
        }
        float g2[8], g1[8], v2[8], v1[8];
#pragma unroll
        for (int e = 0; e < 8; ++e) { g2[e] = 0.f; g1[e] = 0.f; v2[e] = 0.f; v1[e] = 0.f; }
        if ((r0 & 2047) != 0) {
            unpack8(*(const u32x4*)(u + (size_t)(r0 - 2) * 5632 + f), g2); unpack8(*(const u32x4*)(u + (size_t)(r0 - 1) * 5632 + f), g1);
            unpack8(*(const u32x4*)(u + (size_t)(r0 - 2) * 5632 + DFF + f), v2); unpack8(*(const u32x4*)(u + (size_t)(r0 - 1) * 5632 + DFF + f), v1);
        }
#pragma unroll 1
        for (int i0 = 0; i0 < 16; i0 += 4) {
            u32x4 lg[4], lv[4];
#pragma unroll
            for (int i = 0; i < 4; ++i) { const size_t ro = (size_t)(r0 + i0 + i) * 5632; lg[i] = *(const u32x4*)(u + ro + f); lv[i] = *(const u32x4*)(u + ro + DFF + f); }
#pragma unroll
            for (int i = 0; i < 4; ++i) {
                float g0[8], v0[8], o[8];
                unpack8(lg[i], g0); unpack8(lv[i], v0);
#pragma unroll
                for (int e = 0; e < 8; ++e) {
                    const float G = wg[0][e] * g2[e] + wg[1][e] * g1[e] + wg[2][e] * g0[e] + bg[e];
                    const float V = wv[0][e] * v2[e] + wv[1][e] * v1[e] + wv[2][e] * v0[e] + bv[e];
                    o[e] = G * sigmoidf_(G) * V;
                    g2[e] = g1[e]; g1[e] = g0[e]; v2[e] = v1[e]; v1[e] = v0[e];
                }
                *(u32x4*)(act + (size_t)(r0 + i0 + i) * DFF + f) = pack8((f32x4){o[0], o[1], o[2], o[3]}, (f32x4){o[4], o[5], o[6], o[7]});
            }
        }
    }
}

__device__ __forceinline__ float dppf(float x, const int ctrl_sel) {
    const int v = __builtin_bit_cast(int, x);
    int r;
    if (ctrl_sel == 0) r = __builtin_amdgcn_update_dpp(0, v, 0xB1, 0xF, 0xF, true);
    else if (ctrl_sel == 1) r = __builtin_amdgcn_update_dpp(0, v, 0x4E, 0xF, 0xF, true);
    else if (ctrl_sel == 2) r = __builtin_amdgcn_update_dpp(0, v, 0x141, 0xF, 0xF, true);
    else r = __builtin_amdgcn_update_dpp(0, v, 0x140, 0xF, 0xF, true);
    return __builtin_bit_cast(float, r);
}
__device__ __forceinline__ float red4(float x) { x += dppf(x, 0); x += dppf(x, 1); return x; }
__device__ __forceinline__ float red16(float x) { x += dppf(x, 0); x += dppf(x, 1); x += dppf(x, 2); x += dppf(x, 3); return x; }
__device__ __forceinline__ void unpack4(u32x2 w, float* f) {
    h16x4 h = __builtin_bit_cast(h16x4, w);
#pragma unroll
    for (int i = 0; i < 4; ++i) f[i] = (float)h[i];
}
constexpr int SCAN_BUF = 8256;
__device__ __forceinline__ void scan_phase(const Params& p, int j, unsigned char* smem) {
    const int tid = opaque_tid();
    const int wave = tid >> 6, lane = tid & 63, slot = wave >> 2, w4 = wave & 3;
    float* LB = (float*)smem + slot * (2 * SCAN_BUF);
    h16* r16 = (h16*)(p.ws + R_R16);
    const h16* k16 = (const h16*)(p.ws + R_K16);
    const h16* v16 = (j == 0) ? (const h16*)(p.ws + OFF_VF) : (const h16*)(p.ws + R_V16);
    const h16* g16 = (const h16*)(p.ws + R_G16);
    const h16* e16 = (const h16*)p.out;
    const h16* a16 = (const h16*)p.out + (size_t)MTOK * 1024;
    const int tp = w4 * 4 + (lane >> 4), k4 = (lane & 15) * 4;
    const int vrow = w4 * 16 + (lane >> 2), kq = lane & 3;
    for (int pair = blockIdx.x; pair < 256; pair += gridDim.x) {
        const int chain = pair * 2 + slot, b = chain >> 4, h = chain & 15;
        const int col = h * 64 + k4;
        const f32x4 c_kk = *(const f32x4*)(p.in[16] + j * 1024 + col), c_ka = *(const f32x4*)(p.in[17] + j * 1024 + col), c_rk = *(const f32x4*)(p.in[18] + j * 1024 + col);
        const f32x4 c_lg = *(const f32x4*)(p.in[19] + j * 1024 + col), c_lb = *(const f32x4*)(p.in[20] + j * 1024 + col);
        f32x2 S[8];
#pragma unroll
        for (int i = 0; i < 8; ++i) S[i] = (f32x2){0.f, 0.f};
        u32x2 pr[6];
        {
            const size_t go = ((size_t)(b * 2048 + tp)) * 1024 + col;
            pr[0] = *(const u32x2*)(r16 + go); pr[1] = *(const u32x2*)(k16 + go); pr[2] = *(const u32x2*)(v16 + go);
            pr[3] = *(const u32x2*)(e16 + go); pr[4] = *(const u32x2*)(a16 + go); pr[5] = *(const u32x2*)(g16 + go);
        }
        for (int ch = 0; ch < 128; ++ch) {
            float* BUF = LB + (ch & 1) * SCAN_BUF;
            float* OPS = BUF; float* VB = BUF + 5120; float* GB = BUF + 6144; float* YB = BUF + 7168; float* BON = BUF + 8192;
            {
                float rf[4], kf[4], vf[4], ef[4], af[4], gf[4];
                unpack4(pr[0], rf); unpack4(pr[1], kf); unpack4(pr[2], vf); unpack4(pr[3], ef); unpack4(pr[4], af); unpack4(pr[5], gf);
                float kk[4]; float ss = 0.f;
#pragma unroll
                for (int i = 0; i < 4; ++i) { kk[i] = kf[i] * c_kk[i]; ss += kk[i] * kk[i]; }
                ss = red16(ss);
                const float inv = 1.0f / fmaxf(sqrtf(ss), 1e-12f);
                f32x4 A4, B4, W4, K4, R4; float bs = 0.f;
#pragma unroll
                for (int i = 0; i < 4; ++i) {
                    const float kn = kk[i] * inv;
                    A4[i] = -kn; B4[i] = kn * af[i];
                    W4[i] = __expf(-ef[i]);
                    const float km = kf[i] * (1.0f + (af[i] - 1.0f) * c_ka[i]);
                    K4[i] = km; R4[i] = rf[i];
                    bs += rf[i] * km * c_rk[i];
                }
                bs = red16(bs);
                float* o = OPS + tp * 320 + k4;
                *(f32x4*)(o) = A4; *(f32x4*)(o + 64) = B4; *(f32x4*)(o + 128) = W4; *(f32x4*)(o + 192) = K4; *(f32x4*)(o + 256) = R4;
                *(f32x4*)(VB + tp * 64 + k4) = (f32x4){vf[0], vf[1], vf[2], vf[3]};
                *(f32x4*)(GB + tp * 64 + k4) = (f32x4){gf[0], gf[1], gf[2], gf[3]};
                if ((lane & 15) == 0) BON[tp] = bs;
            }
            if (ch + 1 < 128) {
                const size_t go = ((size_t)(b * 2048 + (ch + 1) * 16 + tp)) * 1024 + col;
                pr[0] = *(const u32x2*)(r16 + go); pr[1] = *(const u32x2*)(k16 + go); pr[2] = *(const u32x2*)(v16 + go);
                pr[3] = *(const u32x2*)(e16 + go); pr[4] = *(const u32x2*)(a16 + go); pr[5] = *(const u32x2*)(g16 + go);
            }
            __syncthreads();
#pragma unroll 2
            for (int t = 0; t < 16; ++t) {
                const float* op = OPS + t * 320 + kq * 16;
                f32x4 A4[4], B4[4], W4[4], K4[4], R4[4];
#pragma unroll
                for (int i = 0; i < 4; ++i) A4[i] = *(const f32x4*)(op + i * 4);
#pragma unroll
                for (int i = 0; i < 4; ++i) { W4[i] = *(const f32x4*)(op + 128 + i * 4); B4[i] = *(const f32x4*)(op + 64 + i * 4); K4[i] = *(const f32x4*)(op + 192 + i * 4); }
#pragma unroll
                for (int i = 0; i < 4; ++i) R4[i] = *(const f32x4*)(op + 256 + i * 4);
                const float vv = VB[t * 64 + vrow];
                f32x2 s0 = {0.f, 0.f}, s1 = {0.f, 0.f};
#pragma unroll
                for (int i = 0; i < 4; ++i) { s0 += S[2 * i] * (f32x2){A4[i][0], A4[i][1]}; s1 += S[2 * i + 1] * (f32x2){A4[i][2], A4[i][3]}; }
                const float sa = red4((s0[0] + s0[1]) + (s1[0] + s1[1]));
                const f32x2 sa2 = {sa, sa}, vv2 = {vv, vv};
#pragma unroll
                for (int i = 0; i < 4; ++i) {
                    S[2 * i] = S[2 * i] * (f32x2){W4[i][0], W4[i][1]} + sa2 * (f32x2){B4[i][0], B4[i][1]} + vv2 * (f32x2){K4[i][0], K4[i][1]};
                    S[2 * i + 1] = S[2 * i + 1] * (f32x2){W4[i][2], W4[i][3]} + sa2 * (f32x2){B4[i][2], B4[i][3]} + vv2 * (f32x2){K4[i][2], K4[i][3]};
                }
                f32x2 y0 = {0.f, 0.f}, y1 = {0.f, 0.f};
#pragma unroll
                for (int i = 0; i < 4; ++i) { y0 += S[2 * i] * (f32x2){R4[i][0], R4[i][1]}; y1 += S[2 * i + 1] * (f32x2){R4[i][2], R4[i][3]}; }
                const float y = red4((y0[0] + y0[1]) + (y1[0] + y1[1]));
                if (kq == 0) YB[t * 64 + vrow] = y;
            }
            __syncthreads();
            {
                const f32x4 y4 = *(const f32x4*)(YB + tp * 64 + k4), v4 = *(const f32x4*)(VB + tp * 64 + k4), g4 = *(const f32x4*)(GB + tp * 64 + k4);
                const float mu = red16((y4[0] + y4[1]) + (y4[2] + y4[3])) * (1.0f / 64.0f);
                float q = 0.f;
#pragma unroll
                for (int i = 0; i < 4; ++i) { const float d = y4[i] - mu; q += d * d; }
                const float rstd = rsqrtf(red16(q) * (1.0f / 64.0f) + 64e-5f);
                const float bon = BON[tp];
                float o[4];
#pragma unroll
                for (int i = 0; i < 4; ++i) o[i] = ((y4[i] - mu) * rstd * c_lg[i] + c_lb[i] + bon * v4[i]) * g4[i];
                u32x2 w; w.x = pk2(o[0], o[1]); w.y = pk2(o[2], o[3]);
                *(u32x2*)(r16 + ((size_t)(b * 2048 + ch * 16 + tp)) * 1024 + col) = w;
            }
        }
        __syncthreads();
    }
}

__device__ __forceinline__ void dsa_norm_phase(const Params& p, int j, unsigned char* smem) {
    const int tid = opaque_tid();
    const int lane = tid & 63, wave = tid >> 6;
    const float* hin = (const float*)(p.ws + D_HIN);
    h16* cq = (h16*)(p.ws + D_CQ); h16* ckv = (h16*)(p.ws + D_CKV); h16* ckvt = (h16*)(p.ws + D_CKVT); h16* kidx = (h16*)(p.ws + D_KIDX);
    float* widx = (float*)(p.ws + D_WIDX);
    const f32x4 gq = *(const f32x4*)(p.in[23] + j * 256 + lane * 4);
    const f32x2 gkv = *(const f32x2*)(p.in[24] + j * 128 + lane * 2);
    const float gi = p.in[29][j * 64 + lane], bi = p.in[30][j * 64 + lane];
    h16* wl = (h16*)(smem + wave * 2048);
    for (int grp = blockIdx.x * 8 + wave; grp < MTOK / 8; grp += gridDim.x * 8) {
        const int r0 = grp * 8;
        for (int i = 0; i < 8; ++i) {
            const int row = r0 + i;
            const float* hp = hin + (size_t)row * 512;
            const f32x4 vq = *(const f32x4*)(hp + lane * 4);
            const f32x2 vk = *(const f32x2*)(hp + 256 + lane * 2);
            const float vi = hp[384 + lane];
            float ssq = wave_sum(vq[0] * vq[0] + vq[1] * vq[1] + vq[2] * vq[2] + vq[3] * vq[3]);
            const float rq = rsqrtf(ssq * (1.0f / 256.0f) + 1e-6f);
            u32x2 w; w.x = pk2(vq[0] * rq * gq[0], vq[1] * rq * gq[1]); w.y = pk2(vq[2] * rq * gq[2], vq[3] * rq * gq[3]);
            *(u32x2*)(cq + (size_t)row * 256 + lane * 4) = w;
            float ssk = wave_sum(vk[0] * vk[0] + vk[1] * vk[1]);
            const float rk = rsqrtf(ssk * (1.0f / 128.0f) + 1e-6f);
            const unsigned wk = pk2(vk[0] * rk * gkv[0], vk[1] * rk * gkv[1]);
            *(unsigned*)(ckv + (size_t)row * 128 + lane * 2) = wk;
            *(unsigned*)(wl + i * 128 + lane * 2) = wk;
            const float mu = wave_sum(vi) * (1.0f / 64.0f);
            const float dv = vi - mu;
            const float var = wave_sum(dv * dv) * (1.0f / 64.0f);
            kidx[(size_t)row * 64 + lane] = (h16)(dv * rsqrtf(var + 1e-5f) * gi + bi);
            if (lane < 8) widx[(size_t)row * 8 + lane] = hp[448 + lane] * 0.044194173824159216f;
        }
        asm volatile("s_waitcnt lgkmcnt(0)" ::: "memory");
        const int b = r0 >> 11, t0 = r0 & 2047;
#pragma unroll
        for (int dd = 0; dd < 2; ++dd) {
            const int d = lane * 2 + dd;
            h16x8 hv;
#pragma unroll
            for (int i = 0; i < 8; ++i) hv[i] = wl[i * 128 + d];
            *(h16x8*)(ckvt + ((size_t)(b * 128 + d)) * 2048 + t0) = hv;
        }
        asm volatile("s_waitcnt lgkmcnt(0)" ::: "memory");
    }
}

constexpr int ROWP = 2052;
__device__ __forceinline__ unsigned fkey(float x) {
    if (x == 0.0f) x = 0.0f;
    const unsigned u = __float_as_uint(x);
    return (u & 0x80000000u) ? ~u : (u | 0x80000000u);
}
__device__ __forceinline__ void dsa_index_phase(const Params& p, unsigned char* smem) {
    const int tid = opaque_tid(), wave = tid >> 6, lane = tid & 63, r = lane & 15, q = lane >> 4;
    float* SC = (float*)smem;
    const h16* qidx = (const h16*)(p.ws + D_QIDX);
    const h16* kidx = (const h16*)(p.ws + D_KIDX);
    const float* widx = (const float*)(p.ws + D_WIDX);
    unsigned* maskb = (unsigned*)(p.ws + D_MASK);
    for (int qi = blockIdx.x, it = 0; qi < MTOK / 16; qi += gridDim.x, ++it) {
        const int qt = (it & 1) ? ((qi & ~127) | (127 - (qi & 127))) : qi;
        const int row0 = qt * 16, b = row0 >> 11, t0 = row0 & 2047;
        const int nkt = (t0 >> 4) + 1;
        {
            h16x8 qf[8][2]; float wq[8];
#pragma unroll
            for (int h = 0; h < 8; ++h) {
#pragma unroll
                for (int kk = 0; kk < 2; ++kk) qf[h][kk] = *(const h16x8*)(qidx + (size_t)(row0 + r) * 512 + h * 64 + kk * 32 + q * 8);
                wq[h] = widx[(size_t)(row0 + r) * 8 + h];
            }
            for (int kt = wave; kt < nkt; kt += 8) {
                const int s0 = kt * 16;
                const h16* kp = kidx + (size_t)(b * 2048 + s0 + r) * 64 + q * 8;
                const h16x8 k0 = *(const h16x8*)kp, k1 = *(const h16x8*)(kp + 32);
                f32x4 sc = {0.f, 0.f, 0.f, 0.f};
#pragma unroll
                for (int h = 0; h < 8; ++h) {
                    f32x4 acc = {0.f, 0.f, 0.f, 0.f};
                    acc = __builtin_amdgcn_mfma_f32_16x16x32_f16(k0, qf[h][0], acc, 0, 0, 0);
                    acc = __builtin_amdgcn_mfma_f32_16x16x32_f16(k1, qf[h][1], acc, 0, 0, 0);
#pragma unroll
                    for (int jj = 0; jj < 4; ++jj) sc[jj] += fmaxf(acc[jj], 0.f) * wq[h];
                }
                *(f32x4*)(SC + r * ROWP + s0 + q * 4) = sc;
            }
        }
        __syncthreads();
        for (int qq = 0; qq < 2; ++qq) {
            const int ql = wave * 2 + qq, t = t0 + ql;
            const float* srow = SC + ql * ROWP;
            const int ni = (t >> 6) + 1;
            unsigned u[32];
#pragma unroll
            for (int i = 0; i < 32; ++i) {
                u[i] = 0u;
                if (i < ni) { const int s = i * 64 + lane; if (s <= t) u[i] = fkey(srow[s]); }
            }
            unsigned myw = 0u;
            if (t < 256) {
#pragma unroll
                for (int i = 0; i < 32; ++i) { const unsigned long long sm = __ballot(u[i] != 0u); if ((lane >> 1) == i) myw = (lane & 1) ? (unsigned)(sm >> 32) : (unsigned)sm; }
            } else {
                unsigned T = 0u;
                for (int bit = 31; bit >= 0; --bit) {
                    const unsigned cand = T | (1u << bit);
                    int cnt = 0;
#pragma unroll
                    for (int i = 0; i < 32; ++i) if (i < ni) cnt += __popcll(__ballot(u[i] >= cand));
                    if (cnt >= 256) T = cand;
                }
                int cgt = 0;
#pragma unroll
                for (int i = 0; i < 32; ++i) if (i < ni) cgt += __popcll(__ballot(u[i] > T));
                const int need = 256 - cgt;
                int running = 0;
                const unsigned long long lt = (lane == 0) ? 0ull : (~0ull >> (64 - lane));
#pragma unroll
                for (int i = 0; i < 32; ++i) {
                    if (i < ni) {
                        const unsigned long long eq = __ballot(u[i] == T);
                        const int rank = running + __popcll(eq & lt);
                        const unsigned long long sm = __ballot(u[i] > T || (u[i] == T && rank < need));
                        running += __popcll(eq);
                        if ((lane >> 1) == i) myw = (lane & 1) ? (unsigned)(sm >> 32) : (unsigned)sm;
                    }
                }
            }
            maskb[(size_t)(row0 + ql) * 64 + lane] = myw;
        }
        __syncthreads();
    }
}

constexpr int AT_KROW = 272, AT_VROW = 144, AT_KBYTES = 64 * AT_KROW, AT_VBYTES = 128 * AT_VROW, AT_STAGE = AT_KBYTES + AT_VBYTES, AT_BL = 2 * AT_STAGE;
__device__ __forceinline__ void dsa_attn_phase(const Params& p, int j, unsigned char* smem) {
    const int tid = opaque_tid(), wave = tid >> 6, lane = tid & 63, r = lane & 15, q = lane >> 4;
    float* BL = (float*)(smem + AT_BL);
    for (int idx = tid; idx < 16 * 129; idx += 512) {
        const int h = idx / 129, d = idx % 129;
        int bk = d;
        if (d >= 16) { bk = 16 + (int)(logf((float)d * (1.0f / 16.0f)) / 2.0794415416798357f * 16.0f); bk = bk > 31 ? 31 : bk; }
        BL[h * 132 + d] = p.in[32][bk * 16 + h];
    }
    __syncthreads();
    const h16* qabs = (const h16*)(p.ws + D_QABS);
    const h16* ckv = (const h16*)(p.ws + D_CKV);
    const h16* ckvt = (const h16*)(p.ws + D_CKVT);
    const unsigned* maskb = (const unsigned*)(p.ws + D_MASK);
    h16* o16 = (h16*)(p.ws + D_O16);
    const h16* wuvt = w_dsa_uvt(p.ws, j);
    const float NINF = -__builtin_inff();
    const int krow0 = tid >> 4, kcc = tid & 15, vrow0 = tid >> 3, vcc = tid & 7;
    for (int qi = blockIdx.x, it = 0; qi < MTOK / 16; qi += gridDim.x, ++it) {
        const int qt = (it & 1) ? ((qi & ~127) | (127 - (qi & 127))) : qi;
        const int row0 = qt * 16, b = row0 >> 11, t0 = row0 & 2047, nst = (t0 + 16 + 63) >> 6, tq = t0 + r;
        const h16* kg = ckv + (size_t)(b * 2048) * 128;
        const h16* vg = ckvt + (size_t)(b * 128) * 2048;
        u32x4 sk[2], sv[2];
#pragma unroll
        for (int i = 0; i < 2; ++i) {
            sk[i] = *(const u32x4*)(kg + (size_t)(krow0 + i * 32) * 128 + kcc * 8);
            sv[i] = *(const u32x4*)(vg + (size_t)(vrow0 + i * 64) * 2048 + vcc * 8);
        }
        h16x8 qf[2][4];
#pragma unroll
        for (int hh = 0; hh < 2; ++hh)
#pragma unroll
            for (int kk = 0; kk < 4; ++kk) qf[hh][kk] = *(const h16x8*)(qabs + (size_t)(row0 + r) * 2048 + (2 * wave + hh) * 128 + kk * 32 + q * 8);
        f32x4 O[2][8];
#pragma unroll
        for (int hh = 0; hh < 2; ++hh)
#pragma unroll
            for (int dt = 0; dt < 8; ++dt) O[hh][dt] = (f32x4){0.f, 0.f, 0.f, 0.f};
        float mrun[2] = {NINF, NINF}, lrun[2] = {0.f, 0.f};
#pragma unroll
        for (int i = 0; i < 2; ++i) {
            *(u32x4*)(smem + (krow0 + i * 32) * AT_KROW + kcc * 16) = sk[i];
            *(u32x4*)(smem + AT_KBYTES + (vrow0 + i * 64) * AT_VROW + vcc * 16) = sv[i];
        }
        __syncthreads();
        for (int st = 0; st < nst; ++st) {
            const int s0 = st * 64;
            const unsigned char* Kb = smem + (st & 1) * AT_STAGE;
            const unsigned char* Vb = Kb + AT_KBYTES;
            const u32x2 mw2 = *(const u32x2*)(maskb + (size_t)(row0 + r) * 64 + st * 2);
            if (st + 1 < nst) {
#pragma unroll
                for (int i = 0; i < 2; ++i) {
                    sk[i] = *(const u32x4*)(kg + (size_t)(s0 + 64 + krow0 + i * 32) * 128 + kcc * 8);
                    sv[i] = *(const u32x4*)(vg + (size_t)(vrow0 + i * 64) * 2048 + s0 + 64 + vcc * 8);
                }
            }
#pragma nounroll
            for (int hf = 0; hf < 2; ++hf) {
                const unsigned mw = hf ? mw2.y : mw2.x;
                h16x8 pf[2]; float alpha[2];
#pragma unroll
                for (int hh = 0; hh < 2; ++hh) {
                    const int h = 2 * wave + hh;
                    f32x4 sc[2];
#pragma unroll
                    for (int tt = 0; tt < 2; ++tt) {
                        f32x4 acc = {0.f, 0.f, 0.f, 0.f};
#pragma unroll
                        for (int kk = 0; kk < 4; ++kk) {
                            const h16x8 kf = *(const h16x8*)(Kb + (hf * 32 + tt * 16 + r) * AT_KROW + kk * 64 + q * 16);
                            acc = __builtin_amdgcn_mfma_f32_16x16x32_f16(kf, qf[hh][kk], acc, 0, 0, 0);
                        }
                        sc[tt] = acc;
                    }
                    float x[8]; float mx = NINF;
#pragma unroll
                    for (int tt = 0; tt < 2; ++tt)
#pragma unroll
                        for (int jj = 0; jj < 4; ++jj) {
                            const int kix = tt * 16 + q * 4 + jj;
                            int dist = tq - (s0 + hf * 32 + kix); dist = dist < 0 ? 0 : (dist > 128 ? 128 : dist);
                            const float v = sc[tt][jj] + BL[h * 132 + dist];
                            const float xv = ((mw >> kix) & 1u) ? v : NINF;
                            x[tt * 4 + jj] = xv; mx = fmaxf(mx, xv);
                        }
                    mx = fmaxf(mx, __shfl_xor(mx, 16)); mx = fmaxf(mx, __shfl_xor(mx, 32));
                    const float mnew = fmaxf(mrun[hh], mx);
                    const float mref = (mnew == NINF) ? 0.f : mnew;
                    alpha[hh] = __expf(mrun[hh] - mref);
                    mrun[hh] = mnew;
                    float ps = 0.f;
#pragma unroll
                    for (int i = 0; i < 8; ++i) { const float pv = __expf(x[i] - mref); ps += pv; pf[hh][i] = (h16)pv; }
                    lrun[hh] = lrun[hh] * alpha[hh] + ps;
                    __builtin_amdgcn_sched_barrier(0);
                }
#pragma unroll
                for (int dt = 0; dt < 8; ++dt) {
                    if ((dt & 1) == 0) __builtin_amdgcn_sched_barrier(0);
                    const unsigned char* vp = Vb + (dt * 16 + r) * AT_VROW + (hf * 32 + q * 4) * 2;
                    const h16x4 lo = *(const h16x4*)vp, hi = *(const h16x4*)(vp + 32);
                    const h16x8 vf = {lo[0], lo[1], lo[2], lo[3], hi[0], hi[1], hi[2], hi[3]};
#pragma unroll
                    for (int hh = 0; hh < 2; ++hh) {
                        O[hh][dt] *= alpha[hh];
                        O[hh][dt] = __builtin_amdgcn_mfma_f32_16x16x32_f16(vf, pf[hh], O[hh][dt], 0, 0, 0);
                    }
                }
                __builtin_amdgcn_sched_barrier(0);
            }
            if (st + 1 < nst) {
                unsigned char* Kn = smem + ((st + 1) & 1) * AT_STAGE;
#pragma unroll
                for (int i = 0; i < 2; ++i) {
                    *(u32x4*)(Kn + (krow0 + i * 32) * AT_KROW + kcc * 16) = sk[i];
                    *(u32x4*)(Kn + AT_KBYTES + (vrow0 + i * 64) * AT_VROW + vcc * 16) = sv[i];
                }
            }
            __syncthreads();
        }
#pragma unroll
        for (int hh = 0; hh < 2; ++hh) {
            const int h = 2 * wave + hh;
            float lt = lrun[hh]; lt += __shfl_xor(lt, 16); lt += __shfl_xor(lt, 32);
            const float inv = 1.0f / lt;
#pragma unroll
            for (int vt = 0; vt < 4; ++vt) {
                f32x4 acc = {0.f, 0.f, 0.f, 0.f};
#pragma unroll
                for (int kk = 0; kk < 4; ++kk) {
                    const h16* ap = wuvt + (size_t)(h * 64 + vt * 16 + r) * 128 + kk * 32 + q * 4;
                    const h16x4 lo = *(const h16x4*)ap, hi = *(const h16x4*)(ap + 16);
                    const h16x8 a8 = {lo[0], lo[1], lo[2], lo[3], hi[0], hi[1], hi[2], hi[3]};
                    h16x8 b8;
#pragma unroll
                    for (int i = 0; i < 4; ++i) { b8[i] = (h16)(O[hh][2 * kk][i] * inv); b8[4 + i] = (h16)(O[hh][2 * kk + 1][i] * inv); }
                    acc = __builtin_amdgcn_mfma_f32_16x16x32_f16(a8, b8, acc, 0, 0, 0);
                }
                u32x2 w; w.x = pk2(acc[0], acc[1]); w.y = pk2(acc[2], acc[3]);
                *(u32x2*)(o16 + (size_t)(row0 + r) * 1024 + h * 64 + vt * 16 + q * 4) = w;
            }
        }
    }
    __syncthreads();
}

constexpr size_t OFF_BAR = 951 * MiB;
__device__ __forceinline__ void grid_bar(unsigned* ctr, unsigned& target, unsigned nblk) {
    asm volatile("s_waitcnt vmcnt(0) lgkmcnt(0)" ::: "memory");
    __syncthreads();
    target += nblk;
    if (threadIdx.x == 0) {
        __builtin_amdgcn_fence(__ATOMIC_RELEASE, "agent");
        asm volatile("s_waitcnt vmcnt(0)" ::: "memory");
        __hip_atomic_fetch_add(ctr, 1u, __ATOMIC_RELAXED, __HIP_MEMORY_SCOPE_AGENT);
        while (__hip_atomic_load(ctr, __ATOMIC_RELAXED, __HIP_MEMORY_SCOPE_AGENT) < target) __builtin_amdgcn_s_sleep(1);
        __builtin_amdgcn_fence(__ATOMIC_ACQUIRE, "agent");
        asm volatile("s_waitcnt vmcnt(0)" ::: "memory");
    }
    __syncthreads();
}

__global__ void __launch_bounds__(512) mega_fwd(Params p) {
    extern __shared__ __attribute__((aligned(16))) unsigned char smem[];
    cg::grid_group grid = cg::this_grid();
    unsigned char* ws = p.ws;
    h16* x16 = (h16*)(ws + OFF_X16);
    unsigned* barctr = (unsigned*)(ws + OFF_BAR);
    unsigned bar_target = 0u;
    for (int ph = p.ph_lo; ph < p.ph_hi; ++ph) {
        const unsigned e = p.prog[ph];
        const int kind = e & 15, L = (e >> 4) & 3, sub = (e >> 6) & 1, j = L >> 1;
        const int nrep = 1 + (int)(e >> 7);
        for (int rep = 0; rep < nrep; ++rep) {
        if (rep) grid_bar(barctr, bar_target, gridDim.x);
        const bool isgemm = (kind == K_R1 || kind == K_R2 || kind == K_R4 || kind == K_F1 || kind == K_F3 || kind == K_D1 || kind == K_D3 || kind == K_D6);
        if (isgemm) {
            pg8::Gemm g; pg8::Epi E;
            g.M = MTOK; g.N = 1024; g.K = 1024; g.lda = 1024; g.amode = 0; g.pm0 = 0; g.A = x16; g.Bt = x16;
            E.mode = E_RESID; E.pm0 = 0; E.j = j; E.ws = ws; E.out = p.out; E.bias0 = p.in[5] + j * 1024; E.bias1 = p.in[8] + j * 1024; E.bias2 = p.in[11];
            if (kind == K_R1) {
                g.Bt = w_rwkv_big(ws, j); g.N = 3584; g.K = 2048; g.amode = 1; E.mode = E_RPROJ;
            } else if (kind == K_R2) {
                g.A = (const h16*)(ws + R_HACT); g.Bt = w_rwkv_l2(ws, j); g.N = (j == 0) ? 3072 : 4096; g.K = 512; g.lda = 512; E.mode = E_LORA2;
            } else if (kind == K_R4) {
                g.A = (const h16*)(ws + R_R16); g.Bt = w_rwkv_o(ws, j);
            } else if (kind == K_F1) {
                g.Bt = w_ffn_up(ws, L); g.M = MTOK / 2; g.N = 5632; g.amode = 1; g.pm0 = sub * 128; E.mode = E_ST16;
            } else if (kind == K_F3) {
                g.A = (const h16*)(ws + F_ACT); g.Bt = w_ffn_dn(ws, L); g.M = MTOK / 2; g.K = 2816; g.lda = 2816; E.pm0 = sub * 128;
            } else if (kind == K_D1) {
                g.Bt = w_dsa_in(ws, j); g.N = 512; g.amode = 1; E.mode = E_ST32;
            } else if (kind == K_D3) {
                g.A = (const h16*)(ws + D_CQ); g.Bt = w_dsa_q(ws, j); g.N = 2560; g.K = 256; g.lda = 256; E.mode = E_QPROJ;
            } else {
                g.A = (const h16*)(ws + D_O16); g.Bt = w_dsa_o(ws, j);
            }
            pg8::StaticOrder S; S.init(g.M, g.N, (int)gridDim.x, (int)blockIdx.x);
#ifndef NO_GEMM
            pg8::gemm_phase((LAS unsigned char*)smem, g, S, E);
#endif
        } else if (kind == K_PREP) {
#ifndef NO_PREP
            prep_phase(p, smem);
#endif
        } else if (kind == K_R3) {
#ifndef NO_SCAN
            scan_phase(p, j, smem);
#endif
        } else if (kind == K_LN) {
#ifndef NO_LN
            ln_phase(p, p.in[1] + (L * 2 + sub) * 1024, p.in[2] + (L * 2 + sub) * 1024, L == 3 && sub == 1);
#endif
        } else if (kind == K_F2) {
#ifndef NO_CONV
            conv_phase(p, L);
#endif
        } else if (kind == K_D2) {
#ifndef NO_NORM
            dsa_norm_phase(p, j, smem);
#endif
        } else if (kind == K_D4) {
#ifndef NO_INDEX
            dsa_index_phase(p, smem);
#endif
        } else if (kind == K_D5) {
#ifndef NO_ATTN
            dsa_attn_phase(p, j, smem);
#endif
        }
        }
        if (ph + 1 < p.ph_hi) { if (ph == p.ph_lo) grid.sync(); else grid_bar(barctr, bar_target, gridDim.x); for (int xs = 0; xs < EXTRA_SYNC; ++xs) grid_bar(barctr, bar_target, gridDim.x); }
    }
}

extern "C" void kernel_launch(void* const* d_in, const int* in_sizes, int n_in, void* d_out, int out_size, void* d_ws, size_t ws_size, hipStream_t stream) {
    static int grid_blocks = 0;
    if (grid_blocks == 0) {
        if (n_in != 37 || ws_size < WS_NEED || out_size != MTOK * DM) { fprintf(stderr, "kernel_launch: unexpected problem (n_in %d ws %zu out %d)\n", n_in, ws_size, out_size); grid_blocks = -1; return; }
        int dev = 0, cus = 0, per_cu = 0;
        hipGetDevice(&dev);
        hipDeviceGetAttribute(&cus, hipDeviceAttributeMultiprocessorCount, dev);
        if (hipFuncSetAttribute((const void*)mega_fwd, hipFuncAttributeMaxDynamicSharedMemorySize, LDS_BYTES) != hipSuccess) { fprintf(stderr, "kernel_launch: hipFuncSetAttribute failed\n"); grid_blocks = -1; return; }
        hipOccupancyMaxActiveBlocksPerMultiprocessor(&per_cu, (const void*)mega_fwd, 512, LDS_BYTES);
        if (per_cu < 1) { fprintf(stderr, "kernel_launch: occupancy query says %d blocks/CU\n", per_cu); per_cu = 1; }
        (void)hipGetLastError();
        grid_blocks = cus * per_cu;
        fprintf(stderr, "kernel_launch: grid %d (cus %d x %d)\n", grid_blocks, cus, per_cu);
    }
    if (grid_blocks < 0) return;
    Params p{};
    for (int i = 0; i < 37; ++i) p.in[i] = (const float*)d_in[i];
    p.ws = (unsigned char*)d_ws; p.out = (float*)d_out;
    int np = 0;
    constexpr unsigned PROBE_MASK = 0u;
    auto add = [&](int kind, int L, int sub) { p.prog[np++] = (unsigned char)(kind | (L << 4) | (sub << 6) | ((((PROBE_MASK >> kind) & 1u) && !(kind == K_LN && L == 3 && sub == 1)) ? 128 : 0)); };
    add(K_PREP, 0, 0);
    for (int L = 0; L < 4; ++L) {
        if ((L & 1) == 0) { add(K_R1, L, 0); add(K_R2, L, 0); add(K_R3, L, 0); add(K_R4, L, 0); }
        else { add(K_D1, L, 0); add(K_D2, L, 0); add(K_D3, L, 0); add(K_D4, L, 0); add(K_D5, L, 0); add(K_D6, L, 0); }
        add(K_LN, L, 0);
        for (int c = 0; c < 2; ++c) { add(K_F1, L, c); add(K_F2, L, c); add(K_F3, L, c); }
        add(K_LN, L, 1);
    }
#if SINGLE_LAUNCH
    if (hipMemsetAsync((unsigned char*)d_ws + OFF_BAR, 0, 256, stream) != hipSuccess) { fprintf(stderr, "kernel_launch: memset failed\n"); return; }
    p.ph_lo = 0; p.ph_hi = np;
    void* args[] = {&p};
    hipError_t e = hipLaunchCooperativeKernel((const void*)mega_fwd, dim3(grid_blocks), dim3(512), args, LDS_BYTES, stream);
    if (e != hipSuccess) fprintf(stderr, "cooperative launch failed: %s (grid %d)\n", hipGetErrorString(e), grid_blocks);
#else
    for (int ph = 0; ph < np; ++ph) {
        p.ph_lo = ph; p.ph_hi = ph + 1;
        hipLaunchKernelGGL(mega_fwd, dim3(grid_blocks), dim3(512), LDS_BYTES, stream, p);
    }
#endif
}
```

```cpp
#include <hip/hip_runtime.h>
#include <hip/hip_cooperative_groups.h>
#include <cstdio>
namespace cg = cooperative_groups;

constexpr int EXTRA_SYNC = 0;
#ifndef SINGLE_LAUNCH
#define SINGLE_LAUNCH 1
#endif

#define LAS __attribute__((address_space(3)))
typedef _Float16 h16;
typedef _Float16 h16x8 __attribute__((ext_vector_type(8)));
typedef _Float16 h16x4 __attribute__((ext_vector_type(4)));
typedef _Float16 h16x2 __attribute__((ext_vector_type(2)));
typedef float f32x4 __attribute__((ext_vector_type(4)));
typedef float f32x2 __attribute__((ext_vector_type(2)));
typedef unsigned u32x4 __attribute__((ext_vector_type(4)));
typedef unsigned u32x2 __attribute__((ext_vector_type(2)));

constexpr int DM = 1024, SEQ = 2048, NBATCH = 32, MTOK = NBATCH * SEQ;
constexpr int DFF = 2816;
constexpr size_t MiB = (size_t)1 << 20;
constexpr float DN_ALPHA = 1.6817928305074290f;
constexpr int LDS_BYTES = 147456;

constexpr size_t OFF_W = 0;
constexpr size_t OFF_X16 = 118 * MiB;
constexpr size_t OFF_VF = 247 * MiB;
constexpr size_t OFF_R = 375 * MiB;
constexpr size_t WS_NEED = 952 * MiB;
constexpr size_t R_R16 = OFF_R, R_K16 = OFF_R + 128 * MiB, R_V16 = OFF_R + 256 * MiB, R_G16 = OFF_R + 384 * MiB, R_HACT = OFF_R + 512 * MiB;
constexpr size_t F_U16 = OFF_R, F_ACT = OFF_R + 352 * MiB;
constexpr size_t D_HIN = OFF_R, D_O16 = OFF_R, D_QABS = OFF_R + 128 * MiB, D_QIDX = OFF_R + 384 * MiB, D_CQ = OFF_R + 448 * MiB,
                 D_CKV = OFF_R + 480 * MiB, D_CKVT = OFF_R + 496 * MiB, D_KIDX = OFF_R + 512 * MiB, D_WIDX = OFF_R + 520 * MiB, D_MASK = OFF_R + 522 * MiB;

struct Params {
    const float* in[37];
    unsigned char* ws;
    float* out;
    int ph_lo, ph_hi;
    unsigned char prog[64];
};

enum { K_PREP = 0, K_R1, K_R2, K_R3, K_R4, K_LN, K_F1, K_F2, K_F3, K_D1, K_D2, K_D3, K_D4, K_D5, K_D6 };
enum { E_RPROJ = 0, E_LORA2, E_RESID, E_ST16, E_ST32, E_QPROJ };

__device__ __forceinline__ size_t xrow(int row) { return (size_t)(row >> 11) * 2049 + 1 + (row & 2047); }
__device__ __forceinline__ unsigned pk2(float a, float b) { h16x2 h = {(h16)a, (h16)b}; return __builtin_bit_cast(unsigned, h); }
__device__ __forceinline__ u32x4 pack8(f32x4 a, f32x4 b) { u32x4 w; w.x = pk2(a[0], a[1]); w.y = pk2(a[2], a[3]); w.z = pk2(b[0], b[1]); w.w = pk2(b[2], b[3]); return w; }
__device__ __forceinline__ void unpack8(u32x4 w, float* f) {
    h16x8 h = __builtin_bit_cast(h16x8, w);
#pragma unroll
    for (int i = 0; i < 8; ++i) f[i] = (float)h[i];
}
__device__ __forceinline__ float sigmoidf_(float x) { return 1.0f / (1.0f + __expf(-x)); }
__device__ __forceinline__ float wave_sum(float v) {
#pragma unroll
    for (int o = 32; o > 0; o >>= 1) v += __shfl_xor(v, o);
    return v;
}
#define WSYNC() asm volatile("s_waitcnt vmcnt(0) lgkmcnt(0)" ::: "memory")
__device__ __forceinline__ int opaque_tid() { int t = threadIdx.x; asm volatile("" : "+v"(t)); return t; }

namespace pg8 {
constexpr int BM = 256, BK = 64, HALF = 128, HTB = HALF * BK * 2, STAGE_BYTES = 8 * HTB, NXCD = 8, WGM = 8;
__device__ __forceinline__ int lds_byte(int r, int c) { const int st = (r >> 4) * 2 + (c >> 5), rr = r & 15, cc = c & 31, ob = rr * 64 + cc * 2; return st * 1024 + (ob ^ (((ob >> 9) & 1) << 5)); }
__device__ __forceinline__ void stage_rc(int b, int& R, int& C) { const int st = b / 1024, sb = b % 1024, swz = sb ^ (((sb >> 9) & 1) << 5); R = (st >> 1) * 16 + swz / 64; C = (st & 1) * 32 + (swz % 64) / 2; }
__device__ __forceinline__ int perm32(int rho) { const int n = rho >> 4, i = rho & 15; return 8 * (i >> 2) + 4 * n + (i & 3); }
struct Unit { int pm, pn; };
struct Gemm { const h16* A; const h16* Bt; int M, N, K, lda, amode, pm0; };
struct StaticOrder {
    int nM, nN, nwg, G, c;
    __device__ void init(int M, int N, int G_, int c_) { nM = M / BM; nN = N / BM; nwg = nM * nN; G = G_; c = c_; }
    __device__ bool next(int i, Unit& u) const {
        const long L = (long)i * G + c; if (L >= nwg) return false;
        int wgid = (int)L; { const int q = nwg / NXCD, r = nwg % NXCD, xcd = wgid % NXCD, off = wgid / NXCD; wgid = (xcd < r ? xcd * (q + 1) : r * (q + 1) + (xcd - r) * q) + off; }
        const int nig = WGM * nN, gid = wgid / nig, fm = gid * WGM, gsz = (nM - fm) < WGM ? (nM - fm) : WGM;
        u.pm = fm + ((wgid % nig) % gsz); u.pn = (wgid % nig) / gsz; return true;
    }
};

struct Epi {
    int mode, pm0, j;
    unsigned char* ws; float* out; const float* bias0; const float* bias1; const float* bias2;
    __device__ __forceinline__ void operator()(const f32x4 (&acc)[2][2][4][2], const Unit& u, int wr, int wc, int fr, int fq) const {
        const int rowl0 = u.pm * BM + wr * 64 + fr;
        const int colt = u.pn * BM + wc * 32 + 8 * fq;
#pragma unroll
        for (int ai = 0; ai < 2; ++ai)
#pragma unroll
            for (int m = 0; m < 4; ++m) {
                const int rowl = rowl0 + ai * HALF + m * 16;
                const int rowg = rowl + pm0 * BM;
#pragma unroll
                for (int bj = 0; bj < 2; ++bj) {
                    const int col = colt + bj * HALF;
                    f32x4 v0 = acc[ai][bj][m][0], v1 = acc[ai][bj][m][1];
                    if (mode == E_RPROJ) {
                        if (u.pn < 12) {
                            h16* dst = (h16*)(ws + (u.pn < 4 ? R_R16 : (u.pn < 8 ? R_K16 : (j == 0 ? OFF_VF : R_V16))));
                            *(u32x4*)(dst + (size_t)rowg * 1024 + (col & 1023)) = pack8(v0, v1);
                        } else {
                            const int hc = col - 3072;
                            if (hc < 64) {
#pragma unroll
                                for (int jj = 0; jj < 4; ++jj) { v0[jj] = tanhf(v0[jj]); v1[jj] = tanhf(v1[jj]); }
                            } else if (hc >= 160) {
#pragma unroll
                                for (int jj = 0; jj < 4; ++jj) { v0[jj] = sigmoidf_(v0[jj]); v1[jj] = sigmoidf_(v1[jj]); }
                            }
                            *(u32x4*)((h16*)(ws + R_HACT) + (size_t)rowg * 512 + hc) = pack8(v0, v1);
                        }
                    } else if (mode == E_LORA2) {
                        const int grp = u.pn >> 2, c = col & 1023;
                        const size_t off = (size_t)rowg * 1024 + c;
                        if (grp == 0) {
                            const f32x4 ba = *(const f32x4*)(bias0 + c), bb = *(const f32x4*)(bias0 + c + 4);
#pragma unroll
                            for (int jj = 0; jj < 4; ++jj) { v0[jj] = sigmoidf_(v0[jj] + ba[jj]) * 0.6065306597f; v1[jj] = sigmoidf_(v1[jj] + bb[jj]) * 0.6065306597f; }
                            *(u32x4*)((h16*)out + off) = pack8(v0, v1);
                        } else if (grp == 1) {
                            const f32x4 ba = *(const f32x4*)(bias1 + c), bb = *(const f32x4*)(bias1 + c + 4);
#pragma unroll
                            for (int jj = 0; jj < 4; ++jj) { v0[jj] = sigmoidf_(v0[jj] + ba[jj]); v1[jj] = sigmoidf_(v1[jj] + bb[jj]); }
                            *(u32x4*)((h16*)out + (size_t)MTOK * 1024 + off) = pack8(v0, v1);
                        } else if (grp == 2) {
                            *(u32x4*)((h16*)(ws + R_G16) + off) = pack8(v0, v1);
                        } else {
                            const f32x4 ba = *(const f32x4*)(bias2 + c), bb = *(const f32x4*)(bias2 + c + 4);
                            float vv[8], vf8[8];
                            h16* vp = (h16*)(ws + R_V16) + off;
                            unpack8(*(const u32x4*)vp, vv); unpack8(*(const u32x4*)((const h16*)(ws + OFF_VF) + off), vf8);
#pragma unroll
                            for (int jj = 0; jj < 4; ++jj) {
                                v0[jj] = vv[jj] + (vf8[jj] - vv[jj]) * sigmoidf_(v0[jj] + ba[jj]);
                                v1[jj] = vv[4 + jj] + (vf8[4 + jj] - vv[4 + jj]) * sigmoidf_(v1[jj] + bb[jj]);
                            }
                            *(u32x4*)vp = pack8(v0, v1);
                        }
                    } else if (mode == E_RESID) {
                        float xr[8];
                        unpack8(*(const u32x4*)((const h16*)(ws + OFF_X16) + xrow(rowg) * 1024 + col), xr);
                        f32x4 r0, r1;
#pragma unroll
                        for (int jj = 0; jj < 4; ++jj) { r0[jj] = DN_ALPHA * xr[jj] + v0[jj]; r1[jj] = DN_ALPHA * xr[4 + jj] + v1[jj]; }
                        float* dp = out + (size_t)rowg * 1024 + col;
                        *(f32x4*)dp = r0; *(f32x4*)(dp + 4) = r1;
                    } else if (mode == E_ST16) {
                        *(u32x4*)((h16*)(ws + F_U16) + (size_t)rowl * 5632 + col) = pack8(v0, v1);
                    } else if (mode == E_ST32) {
                        float* dp = (float*)(ws + D_HIN) + (size_t)rowg * 512 + col;
                        *(f32x4*)dp = v0; *(f32x4*)(dp + 4) = v1;
                    } else {
                        if (u.pn < 8) *(u32x4*)((h16*)(ws + D_QABS) + (size_t)rowg * 2048 + col) = pack8(v0, v1);
                        else *(u32x4*)((h16*)(ws + D_QIDX) + (size_t)rowg * 512 + (col - 2048)) = pack8(v0, v1);
                    }
                }
            }
    }
};

__device__ __forceinline__ const char* a_tile(const Gemm& g, int pm) {
    if (g.amode == 1) { const int row = (pm + g.pm0) * BM; return (const char*)g.A + xrow(row) * 2048; }
    return (const char*)g.A + (size_t)pm * BM * g.lda * 2;
}

__device__ __forceinline__ void gemm_phase(LAS unsigned char* lds, const Gemm g, const StaticOrder& S, const Epi& E) {
    const int tid = opaque_tid(), wid = __builtin_amdgcn_readfirstlane(tid >> 6), lane = tid & 63, wr = wid >> 2, wc = wid & 3, fr = lane & 15, fq = lane >> 4;
    const int K = g.K, nt = K / BK;
    const bool shiftA = (g.amode == 1);
    unsigned voffA[2], voffB[2];
#pragma unroll
    for (int i = 0; i < 2; ++i) { int R, C; stage_rc(tid * 16 + i * 8192, R, C); const int Rb = (R & ~31) + perm32(R & 31);
        voffA[i] = (unsigned)(R * g.lda + C) * 2u; voffB[i] = (unsigned)(Rb * K + C) * 2u; }
    const size_t kstep = (size_t)(BK * 2);
    const size_t hstepA = (size_t)HALF * g.lda * 2;
    const size_t hstepB = (size_t)HALF * K * 2;
    const size_t tstepB = 2 * hstepB;
    const unsigned ldsw = (unsigned)wid * 1024u;
    const int aoff = lds_byte(wr * 64 + fr, fq * 8), boff = lds_byte(wc * 32 + fr, fq * 8);
#define PG8_KOFF(kt) ((size_t)(kt) * kstep - ((shiftA && (kt) >= 16) ? (size_t)4096 : (size_t)0))
#define PG8_SA(b, h) (((b) * 2 + (h)) * HTB)
#define PG8_SB(b, h) ((4 + (b) * 2 + (h)) * HTB)
#define PG8_STAGE(bufoff, gbase, voff) do { _Pragma("unroll") for (int _i = 0; _i < 2; ++_i) \
        __builtin_amdgcn_global_load_lds((const unsigned*)((const char*)(gbase) + (voff)[_i]), (LAS unsigned*)(lds + (bufoff) + ldsw + _i * 8192), 16, 0, 0); } while (0)
#define PG8_LDA(dst, b, h) do { _Pragma("unroll") for (int m = 0; m < 4; ++m) _Pragma("unroll") for (int k = 0; k < 2; ++k) dst[m][k] = *(const LAS h16x8*)(lds + PG8_SA(b, h) + aoff + m * 2048 + k * 1024); } while (0)
#define PG8_LDB(dst, b, h) do { _Pragma("unroll") for (int n = 0; n < 2; ++n) _Pragma("unroll") for (int k = 0; k < 2; ++k) dst[n][k] = *(const LAS h16x8*)(lds + PG8_SB(b, h) + boff + n * 2048 + k * 1024); } while (0)
#define PG8_MMA(ai, bj, At, Bt) do { __builtin_amdgcn_s_setprio(1); _Pragma("unroll") for (int m = 0; m < 4; ++m) _Pragma("unroll") for (int n = 0; n < 2; ++n) _Pragma("unroll") for (int k = 0; k < 2; ++k) \
        acc[ai][bj][m][n] = __builtin_amdgcn_mfma_f32_16x16x32_f16(Bt[n][k], At[m][k], acc[ai][bj][m][n], 0, 0, 0); __builtin_amdgcn_s_setprio(0); } while (0)
#define PG8_WAIT_V(n) asm volatile("s_waitcnt vmcnt(" #n ")" ::: "memory")
#define PG8_WAIT_L(n) asm volatile("s_waitcnt lgkmcnt(" #n ")" ::: "memory")
#define PG8_BAR __builtin_amdgcn_s_barrier()
#define PG8_SCHED __builtin_amdgcn_sched_barrier(0)
    Unit cur, nxt; int ui = 0;
    if (!S.next(0, cur)) return;
    f32x4 acc[2][2][4][2];
#pragma unroll
    for (int a = 0; a < 2; ++a)
#pragma unroll
        for (int b = 0; b < 2; ++b)
#pragma unroll
            for (int m = 0; m < 4; ++m)
#pragma unroll
                for (int n = 0; n < 2; ++n) acc[a][b][m][n] = (f32x4){0.f, 0.f, 0.f, 0.f};
    h16x8 At[4][2], B0[2][2], B1[2][2];
    const char* cA = a_tile(g, cur.pm); const char* cB = (const char*)g.Bt + (size_t)cur.pn * tstepB;
    PG8_STAGE(PG8_SB(0, 0), cB, voffB); PG8_STAGE(PG8_SA(0, 0), cA, voffA); PG8_STAGE(PG8_SB(0, 1), cB + hstepB, voffB); PG8_STAGE(PG8_SA(0, 1), cA + hstepA, voffA);
    if (wr == 1) PG8_BAR;
    PG8_WAIT_V(4); PG8_BAR;
    PG8_STAGE(PG8_SB(1, 0), cB + kstep, voffB); PG8_STAGE(PG8_SA(1, 0), cA + kstep, voffA); PG8_STAGE(PG8_SB(1, 1), cB + hstepB + kstep, voffB);
    PG8_WAIT_V(6); PG8_BAR;
    for (;;) {
        const bool has_next = S.next(ui + 1, nxt);
        const char* nA = has_next ? a_tile(g, nxt.pm) : cA; const char* nB = has_next ? (const char*)g.Bt + (size_t)nxt.pn * tstepB : cB;
        for (int t = 0; t < nt; t += 2) {
            const bool last = (t == nt - 2);
            const char* a1 = cA + PG8_KOFF(t + 1);
            const char* a2 = last ? nA : cA + PG8_KOFF(t + 2); const char* b2 = last ? nB : cB + (size_t)(t + 2) * kstep;
            const char* a3 = a2 + kstep; const char* b3 = b2 + kstep;
            PG8_LDB(B0, 0, 0); PG8_SCHED; PG8_LDA(At, 0, 0); PG8_STAGE(PG8_SA(1, 1), a1 + hstepA, voffA);
            PG8_WAIT_L(8); PG8_BAR; PG8_WAIT_L(0); PG8_MMA(0, 0, At, B0); PG8_BAR; PG8_SCHED;
            PG8_LDB(B1, 0, 1); PG8_STAGE(PG8_SB(0, 0), b2, voffB);
            PG8_BAR; PG8_WAIT_L(0); PG8_MMA(0, 1, At, B1); PG8_BAR;
            PG8_LDA(At, 0, 1); PG8_STAGE(PG8_SA(0, 0), a2, voffA);
            PG8_BAR; PG8_WAIT_L(0); PG8_MMA(1, 0, At, B0); PG8_BAR; PG8_SCHED;
            PG8_STAGE(PG8_SB(0, 1), b2 + hstepB, voffB);
            PG8_WAIT_V(6); PG8_BAR; PG8_MMA(1, 1, At, B1); PG8_BAR;
            PG8_LDB(B0, 1, 0); PG8_SCHED; PG8_LDA(At, 1, 0); PG8_STAGE(PG8_SA(0, 1), a2 + hstepA, voffA);
            PG8_WAIT_L(8); PG8_BAR; PG8_WAIT_L(0); PG8_MMA(0, 0, At, B0); PG8_BAR; PG8_SCHED;
            PG8_LDB(B1, 1, 1); PG8_STAGE(PG8_SB(1, 0), b3, voffB);
            PG8_BAR; PG8_WAIT_L(0); PG8_MMA(0, 1, At, B1); PG8_BAR;
            PG8_LDA(At, 1, 1); PG8_STAGE(PG8_SA(1, 0), a3, voffA);
            PG8_BAR; PG8_WAIT_L(0); PG8_MMA(1, 0, At, B0); PG8_BAR; PG8_SCHED;
            PG8_STAGE(PG8_SB(1, 1), b3 + hstepB, voffB);
            PG8_WAIT_V(6); PG8_BAR; PG8_MMA(1, 1, At, B1); PG8_BAR;
        }
        E(acc, cur, wr, wc, fr, fq);
        if (!has_next) break;
#pragma unroll
        for (int a = 0; a < 2; ++a)
#pragma unroll
            for (int b = 0; b < 2; ++b)
#pragma unroll
                for (int m = 0; m < 4; ++m)
#pragma unroll
                    for (int n = 0; n < 2; ++n) acc[a][b][m][n] = (f32x4){0.f, 0.f, 0.f, 0.f};
        cur = nxt; cA = nA; cB = nB; ++ui;
    }
    PG8_WAIT_V(0);
    if (wr == 0) PG8_BAR;
    PG8_BAR;
#undef PG8_KOFF
#undef PG8_SA
#undef PG8_SB
#undef PG8_STAGE
#undef PG8_LDA
#undef PG8_LDB
#undef PG8_MMA
#undef PG8_WAIT_V
#undef PG8_WAIT_L
#undef PG8_BAR
#undef PG8_SCHED
}
}

struct TJob { int mode; const float* src; int ld, K, N; h16* dst; int ldd, koff; const float* mix; };

__device__ __forceinline__ TJob get_job(const Params& p, int id) {
    TJob J; J.mode = 0; J.src = nullptr; J.ld = 0; J.K = 0; J.N = 0; J.dst = nullptr; J.ldd = 64; J.koff = 0; J.mix = nullptr;
    h16* W = (h16*)(p.ws + OFF_W);
    if (id < 24) {
        const int j = id / 12, s = id % 12;
        h16* Wbig = W + (size_t)j * (10 * MiB); h16* Wl2 = Wbig + 7 * MiB;
        const float* mix = p.in[3] + j * 6 * 1024;
        J.mode = 1; J.ld = 1024; J.K = 1024; J.ldd = 2048;
        if (s < 3) { J.src = p.in[4] + (size_t)(j * 3 + s) * 1048576; J.N = 1024; J.dst = Wbig + (size_t)s * 1024 * 2048; J.mix = mix + s * 1024; }
        else if (s == 3) { J.src = p.in[6] + (size_t)j * 65536; J.ld = 64; J.N = 64; J.dst = Wbig + (size_t)3072 * 2048; J.mix = mix + 3 * 1024; }
        else if (s == 4) { J.src = p.in[9] + (size_t)j * 65536; J.ld = 64; J.N = 64; J.dst = Wbig + (size_t)3136 * 2048; J.mix = mix + 4 * 1024; }
        else if (s == 5) { J.N = 32; J.dst = Wbig + (size_t)3200 * 2048; if (j == 1) { J.src = p.in[12]; J.ld = 32; J.mix = mix + 2 * 1024; } else { J.mode = 2; } }
        else if (s == 6) { J.src = p.in[14] + (size_t)j * 163840; J.ld = 160; J.N = 160; J.dst = Wbig + (size_t)3232 * 2048; J.mix = mix + 5 * 1024; }
        else if (s == 7) { J.mode = 2; J.N = 192; J.dst = Wbig + (size_t)3392 * 2048; }
        else {
            J.mode = 0; J.ld = 1024; J.N = 1024; J.ldd = 512;
            if (s == 8) { J.src = p.in[7] + (size_t)j * 65536; J.K = 64; J.koff = 0; J.dst = Wl2; }
            else if (s == 9) { J.src = p.in[10] + (size_t)j * 65536; J.K = 64; J.koff = 64; J.dst = Wl2 + (size_t)1024 * 512; }
            else if (s == 10) { J.src = p.in[15] + (size_t)j * 163840; J.K = 160; J.koff = 160; J.dst = Wl2 + (size_t)2048 * 512; }
            else { J.src = p.in[13]; J.K = 32; J.koff = 128; J.dst = Wl2 + (size_t)3072 * 512; if (j == 0) J.N = 0; }
        }
    } else if (id < 26) {
        const int j = id - 24;
        J.src = p.in[21] + (size_t)j * 1048576; J.ld = 1024; J.K = 1024; J.N = 1024; J.dst = W + (size_t)j * (10 * MiB) + 9 * MiB; J.ldd = 1024;
    } else if (id < 34) {
        const int i = (id - 26) >> 1, s = (id - 26) & 1;
        h16* base = W + 20 * MiB + (size_t)i * (17 * MiB / 2);
        if (s == 0) { J.src = p.in[33] + (size_t)i * 1024 * 5632; J.ld = 5632; J.K = 1024; J.N = 5632; J.dst = base; J.ldd = 1024; }
        else { J.src = p.in[36] + (size_t)i * 2816 * 1024; J.ld = 1024; J.K = 2816; J.N = 1024; J.dst = base + (size_t)11 * MiB / 2; J.ldd = 2816; }
    } else {
        const int j = (id - 34) >> 2, s = (id - 34) & 3;
        h16* base = W + 54 * MiB + (size_t)j * (5 * MiB / 2);
        if (s == 0) { J.src = p.in[22] + (size_t)j * 1024 * 456; J.ld = 456; J.K = 1024; J.N = 456; J.dst = base; J.ldd = 1024; }
        else if (s == 1) { J.mode = 2; J.N = 56; J.dst = base + (size_t)456 * 1024; J.ldd = 1024; }
        else if (s == 2) { J.src = p.in[28] + (size_t)j * 256 * 512; J.ld = 512; J.K = 256; J.N = 512; J.dst = base + MiB / 2 + (size_t)2048 * 256; J.ldd = 256; }
        else { J.src = p.in[31] + (size_t)j * 1048576; J.ld = 1024; J.K = 1024; J.N = 1024; J.dst = base + 3 * MiB / 2; J.ldd = 1024; }
    }
    return J;
}
__device__ __forceinline__ h16* w_rwkv_big(unsigned char* ws, int j) { return (h16*)(ws + OFF_W) + (size_t)j * (10 * MiB); }
__device__ __forceinline__ h16* w_rwkv_l2(unsigned char* ws, int j) { return w_rwkv_big(ws, j) + 7 * MiB; }
__device__ __forceinline__ h16* w_rwkv_o(unsigned char* ws, int j) { return w_rwkv_big(ws, j) + 9 * MiB; }
__device__ __forceinline__ h16* w_ffn_up(unsigned char* ws, int i) { return (h16*)(ws + OFF_W) + 20 * MiB + (size_t)i * (17 * MiB / 2); }
__device__ __forceinline__ h16* w_ffn_dn(unsigned char* ws, int i) { return w_ffn_up(ws, i) + (size_t)11 * MiB / 2; }
__device__ __forceinline__ h16* w_dsa_in(unsigned char* ws, int j) { return (h16*)(ws + OFF_W) + 54 * MiB + (size_t)j * (5 * MiB / 2); }
__device__ __forceinline__ h16* w_dsa_q(unsigned char* ws, int j) { return w_dsa_in(ws, j) + MiB / 2; }
__device__ __forceinline__ h16* w_dsa_uvt(unsigned char* ws, int j) { return w_dsa_in(ws, j) + 5 * MiB / 4; }
__device__ __forceinline__ h16* w_dsa_o(unsigned char* ws, int j) { return w_dsa_in(ws, j) + 3 * MiB / 2; }

__device__ __forceinline__ void prep_phase(const Params& p, unsigned char* smem) {
    const int tid = opaque_tid();
    const size_t gtid = (size_t)blockIdx.x * 512 + tid, nth = (size_t)gridDim.x * 512;
    h16* x16 = (h16*)(p.ws + OFF_X16);
    for (size_t idx = gtid; idx < (size_t)MTOK * 128; idx += nth) {
        const int row = (int)(idx >> 7), c8 = (int)(idx & 127) * 8;
        const float* sp = p.in[0] + (size_t)row * 1024 + c8;
        const f32x4 a = *(const f32x4*)sp, b = *(const f32x4*)(sp + 4);
        *(u32x4*)(x16 + xrow(row) * 1024 + c8) = pack8(a, b);
    }
    for (size_t idx = gtid; idx < (size_t)NBATCH * 128; idx += nth) {
        const int b = (int)(idx >> 7), c8 = (int)(idx & 127) * 8;
        unsigned z = 0u; asm volatile("" : "+v"(z));
        *(u32x4*)(x16 + (size_t)b * 2049 * 1024 + c8) = (u32x4){z, z, z, z};
    }
    for (size_t idx = gtid; idx < (size_t)2 * 2048 * 256; idx += nth) {
        const int j = (int)(idx >> 19), rem = (int)(idx & 524287), n = rem >> 8, q = rem & 255, h = n >> 7, c = n & 127;
        const float* uq = p.in[25] + (size_t)j * 256 * 1024 + (size_t)q * 1024 + h * 64;
        const float* uk = p.in[26] + (size_t)j * 16 * 64 * 128 + (size_t)h * 64 * 128 + c;
        float s = 0.f;
        for (int d = 0; d < 64; ++d) s += uq[d] * uk[d * 128];
        w_dsa_q(p.ws, j)[(size_t)n * 256 + q] = (h16)(s * 0.125f);
    }
    for (size_t idx = gtid; idx < (size_t)2 * 16 * 64 * 128; idx += nth) {
        const int j = (int)(idx >> 17), rem = (int)(idx & 131071), h = rem >> 13, n = (rem >> 7) & 63, k = rem & 127;
        w_dsa_uvt(p.ws, j)[(size_t)(h * 64 + n) * 128 + k] = (h16)p.in[27][(size_t)((j * 16 + h) * 128 + k) * 64 + n];
    }
    float* tile = (float*)smem;
    for (int id = 0; id < 42; ++id) {
        const TJob J = get_job(p, id);
        const int tk = J.ldd >> 6, tn = (J.N + 63) >> 6, ntile = tk * tn;
        for (int tix = blockIdx.x; tix < ntile; tix += gridDim.x) {
            const int k0 = (tix % tk) * 64, n0 = (tix / tk) * 64;
#pragma unroll
            for (int i = 0; i < 8; ++i) {
                const int k = i * 8 + (tid >> 6), n = tid & 63, kk = k0 + k, nn = n0 + n;
                float v = 0.f;
                if (nn < J.N && J.mode != 2) {
                    if (J.mode == 1) { const int ks = kk & 1023; const float mx = J.mix[ks]; v = J.src[(size_t)ks * J.ld + nn] * (kk < 1024 ? 1.0f - mx : mx); }
                    else if (kk >= J.koff && kk < J.koff + J.K) v = J.src[(size_t)(kk - J.koff) * J.ld + nn];
                }
                tile[k * 65 + n] = v;
            }
            __syncthreads();
#pragma unroll
            for (int i = 0; i < 8; ++i) {
                const int n = i * 8 + (tid >> 6), k = tid & 63, nn = n0 + n;
                if (nn < J.N) J.dst[(size_t)nn * J.ldd + k0 + k] = (h16)tile[k * 65 + n];
            }
            __syncthreads();
        }
    }
}

__device__ __forceinline__ void wave_sum4(float (&v)[4]) {
#pragma unroll
    for (int o = 32; o > 0; o >>= 1) {
        float t[4];
#pragma unroll
        for (int k = 0; k < 4; ++k) t[k] = __shfl_xor(v[k], o);
#pragma unroll
        for (int k = 0; k < 4; ++k) v[k] += t[k];
    }
}
__device__ __forceinline__ void ln_phase(const Params& p, const float* g, const float* b, bool final_out) {
    const int tid = opaque_tid();
    const int lane = tid & 63, wave = tid >> 6;
    float* tb = p.out;
    h16* x16 = (h16*)(p.ws + OFF_X16);
    f32x4 gg[4], bb[4];
#pragma unroll
    for (int i = 0; i < 4; ++i) { gg[i] = *(const f32x4*)(g + i * 256 + lane * 4); bb[i] = *(const f32x4*)(b + i * 256 + lane * 4); }
    for (int rowb = (blockIdx.x * 8 + wave) * 4; rowb < MTOK; rowb += gridDim.x * 32) {
        f32x4 v[4][4];
        float s[4];
#pragma unroll
        for (int k = 0; k < 4; ++k) {
            const float* rp = tb + (size_t)(rowb + k) * 1024;
            s[k] = 0.f;
#pragma unroll
            for (int i = 0; i < 4; ++i) { v[k][i] = *(const f32x4*)(rp + i * 256 + lane * 4); s[k] += (v[k][i][0] + v[k][i][1]) + (v[k][i][2] + v[k][i][3]); }
        }
        wave_sum4(s);
        float q[4];
#pragma unroll
        for (int k = 0; k < 4; ++k) {
            s[k] *= (1.0f / 1024.0f); q[k] = 0.f;
#pragma unroll
            for (int i = 0; i < 4; ++i)
#pragma unroll
                for (int jj = 0; jj < 4; ++jj) { const float d = v[k][i][jj] - s[k]; q[k] += d * d; }
        }
        wave_sum4(q);
#pragma unroll
        for (int k = 0; k < 4; ++k) {
            const float rstd = rsqrtf(q[k] * (1.0f / 1024.0f) + 1e-5f);
            const int row = rowb + k;
#pragma unroll
            for (int i = 0; i < 4; ++i) {
                f32x4 y;
#pragma unroll
                for (int jj = 0; jj < 4; ++jj) y[jj] = (v[k][i][jj] - s[k]) * rstd * gg[i][jj] + bb[i][jj];
                if (final_out) *(f32x4*)(tb + (size_t)row * 1024 + i * 256 + lane * 4) = y;
                else { u32x2 w; w.x = pk2(y[0], y[1]); w.y = pk2(y[2], y[3]); *(u32x2*)(x16 + xrow(row) * 1024 + i * 256 + lane * 4) = w; }
            }
        }
    }
}

__device__ __forceinline__ void conv_phase(const Params& p, int layer) {
    const h16* u = (const h16*)(p.ws + F_U16);
    h16* act = (h16*)(p.ws + F_ACT);
    const float* cw = p.in[34] + (size_t)layer * 3 * 5632;
    const float* cb = p.in[35] + (size_t)layer * 5632;
    const size_t gtid = (size_t)blockIdx.x * 512 + opaque_tid(), nth = (size_t)gridDim.x * 512;
    const size_t ntask = (size_t)2048 * 352;
    for (size_t task = gtid; task < ntask; task += nth) {
        const int cgp = (int)(task % 352), rc = (int)(task / 352), f = cgp * 8, r0 = rc * 16;
        float wg[3][8], wv[3][8], bg[8], bv[8];
#pragma unroll
        for (int jj = 0; jj < 3; ++jj)
#pragma unroll
            for (int hlf = 0; hlf < 2; ++hlf) {
                const f32x4 a = *(const f32x4*)(cw + jj * 5632 + f + hlf * 4), c = *(const f32x4*)(cw + jj * 5632 + DFF + f + hlf * 4);
#pragma unroll
                for (int e = 0; e < 4; ++e) { wg[jj][hlf * 4 + e] = a[e]; wv[jj][hlf * 4 + e] = c[e]; }
            }
#pragma unroll
        for (int hlf = 0; hlf < 2; ++hlf) {
            const f32x4 a = *(const f32x4*)(cb + f + hlf * 4), c = *(const f32x4*)(cb + DFF + f + hlf * 4);
#pragma unroll
            for (int e = 0; e < 4; ++e) { bg[hlf * 4 + e] = a[e]; bv[hlf * 4 + e] = c[e]; }
        }
        float g2[8], g1[8], v2[8], v1[8];
#pragma unroll
        for (int e = 0; e < 8; ++e) { g2[e] = 0.f; g1[e] = 0.f; v2[e] = 0.f; v1[e] = 0.f; }
        if ((r0 & 2047) != 0) {
            unpack8(*(const u32x4*)(u + (size_t)(r0 - 2) * 5632 + f), g2); unpack8(*(const u32x4*)(u + (size_t)(r0 - 1) * 5632 + f), g1);
            unpack8(*(const u32x4*)(u + (size_t)(r0 - 2) * 5632 + DFF + f), v2); unpack8(*(const u32x4*)(u + (size_t)(r0 - 1) * 5632 + DFF + f), v1);
        }
#pragma unroll 1
        for (int i0 = 0; i0 < 16; i0 += 4) {
            u32x4 lg[4], lv[4];
#pragma unroll
            for (int i = 0; i < 4; ++i) { const size_t ro = (size_t)(r0 + i0 + i) * 5632; lg[i] = *(const u32x4*)(u + ro + f); lv[i] = *(const u32x4*)(u + ro + DFF + f); }
#pragma unroll
            for (int i = 0; i < 4; ++i) {
                float g0[8], v0[8], o[8];
                unpack8(lg[i], g0); unpack8(lv[i], v0);
#pragma unroll
                for (int e = 0; e < 8; ++e) {
                    const float G = wg[0][e] * g2[e] + wg[1][e] * g1[e] + wg[2][e] * g0[e] + bg[e];
                    const float V = wv[0][e] * v2[e] + wv[1][e] * v1[e] + wv[2][e] * v0[e] + bv[e];
                    o[e] = G * sigmoidf_(G) * V;
                    g2[e] = g1[e]; g1[e] = g0[e]; v2[e] = v1[e]; v1[e] = v0[e];
                }
                *(u32x4*)(act + (size_t)(r0 + i0 + i) * DFF + f) = pack8((f32x4){o[0], o[1], o[2], o[3]}, (f32x4){o[4], o[5], o[6], o[7]});
            }
        }
    }
}

__device__ __forceinline__ float dppf(float x, const int ctrl_sel) {
    const int v = __builtin_bit_cast(int, x);
    int r;
    if (ctrl_sel == 0) r = __builtin_amdgcn_update_dpp(0, v, 0xB1, 0xF, 0xF, true);
    else if (ctrl_sel == 1) r = __builtin_amdgcn_update_dpp(0, v, 0x4E, 0xF, 0xF, true);
    else if (ctrl_sel == 2) r = __builtin_amdgcn_update_dpp(0, v, 0x141, 0xF, 0xF, true);
    else r = __builtin_amdgcn_update_dpp(0, v, 0x140, 0xF, 0xF, true);
    return __builtin_bit_cast(float, r);
}
__device__ __forceinline__ float red4(float x) { x += dppf(x, 0); x += dppf(x, 1); return x; }
__device__ __forceinline__ float red16(float x) { x += dppf(x, 0); x += dppf(x, 1); x += dppf(x, 2); x += dppf(x, 3); return x; }
__device__ __forceinline__ void unpack4(u32x2 w, float* f) {
    h16x4 h = __builtin_bit_cast(h16x4, w);
#pragma unroll
    for (int i = 0; i < 4; ++i) f[i] = (float)h[i];
}
constexpr int SCAN_BUF = 8256;
__device__ __forceinline__ void scan_phase(const Params& p, int j, unsigned char* smem) {
    const int tid = opaque_tid();
    const int wave = tid >> 6, lane = tid & 63, slot = wave >> 2, w4 = wave & 3;
    float* LB = (float*)smem + slot * (2 * SCAN_BUF);
    h16* r16 = (h16*)(p.ws + R_R16);
    const h16* k16 = (const h16*)(p.ws + R_K16);
    const h16* v16 = (j == 0) ? (const h16*)(p.ws + OFF_VF) : (const h16*)(p.ws + R_V16);
    const h16* g16 = (const h16*)(p.ws + R_G16);
    const h16* e16 = (const h16*)p.out;
    const h16* a16 = (const h16*)p.out + (size_t)MTOK * 1024;
    const int tp = w4 * 4 + (lane >> 4), k4 = (lane & 15) * 4;
    const int vrow = w4 * 16 + (lane >> 2), kq = lane & 3;
    for (int pair = blockIdx.x; pair < 256; pair += gridDim.x) {
        const int chain = pair * 2 + slot, b = chain >> 4, h = chain & 15;
        const int col = h * 64 + k4;
        const f32x4 c_kk = *(const f32x4*)(p.in[16] + j * 1024 + col), c_ka = *(const f32x4*)(p.in[17] + j * 1024 + col), c_rk = *(const f32x4*)(p.in[18] + j * 1024 + col);
        const f32x4 c_lg = *(const f32x4*)(p.in[19] + j * 1024 + col), c_lb = *(const f32x4*)(p.in[20] + j * 1024 + col);
        f32x2 S[8];
#pragma unroll
        for (int i = 0; i < 8; ++i) S[i] = (f32x2){0.f, 0.f};
        u32x2 pr[6];
        {
            const size_t go = ((size_t)(b * 2048 + tp)) * 1024 + col;
            pr[0] = *(const u32x2*)(r16 + go); pr[1] = *(const u32x2*)(k16 + go); pr[2] = *(const u32x2*)(v16 + go);
            pr[3] = *(const u32x2*)(e16 + go); pr[4] = *(const u32x2*)(a16 + go); pr[5] = *(const u32x2*)(g16 + go);
        }
        for (int ch = 0; ch < 128; ++ch) {
            float* BUF = LB + (ch & 1) * SCAN_BUF;
            float* OPS = BUF; float* VB = BUF + 5120; float* GB = BUF + 6144; float* YB = BUF + 7168; float* BON = BUF + 8192;
            {
                float rf[4], kf[4], vf[4], ef[4], af[4], gf[4];
                unpack4(pr[0], rf); unpack4(pr[1], kf); unpack4(pr[2], vf); unpack4(pr[3], ef); unpack4(pr[4], af); unpack4(pr[5], gf);
                float kk[4]; float ss = 0.f;
#pragma unroll
                for (int i = 0; i < 4; ++i) { kk[i] = kf[i] * c_kk[i]; ss += kk[i] * kk[i]; }
                ss = red16(ss);
                const float inv = 1.0f / fmaxf(sqrtf(ss), 1e-12f);
                f32x4 A4, B4, W4, K4, R4; float bs = 0.f;
#pragma unroll
                for (int i = 0; i < 4; ++i) {
                    const float kn = kk[i] * inv;
                    A4[i] = -kn; B4[i] = kn * af[i];
                    W4[i] = __expf(-ef[i]);
                    const float km = kf[i] * (1.0f + (af[i] - 1.0f) * c_ka[i]);
                    K4[i] = km; R4[i] = rf[i];
                    bs += rf[i] * km * c_rk[i];
                }
                bs = red16(bs);
                float* o = OPS + tp * 320 + k4;
                *(f32x4*)(o) = A4; *(f32x4*)(o + 64) = B4; *(f32x4*)(o + 128) = W4; *(f32x4*)(o + 192) = K4; *(f32x4*)(o + 256) = R4;
                *(f32x4*)(VB + tp * 64 + k4) = (f32x4){vf[0], vf[1], vf[2], vf[3]};
                *(f32x4*)(GB + tp * 64 + k4) = (f32x4){gf[0], gf[1], gf[2], gf[3]};
                if ((lane & 15) == 0) BON[tp] = bs;
            }
            if (ch + 1 < 128) {
                const size_t go = ((size_t)(b * 2048 + (ch + 1) * 16 + tp)) * 1024 + col;
                pr[0] = *(const u32x2*)(r16 + go); pr[1] = *(const u32x2*)(k16 + go); pr[2] = *(const u32x2*)(v16 + go);
                pr[3] = *(const u32x2*)(e16 + go); pr[4] = *(const u32x2*)(a16 + go); pr[5] = *(const u32x2*)(g16 + go);
            }
            __syncthreads();
#pragma unroll 2
            for (int t = 0; t < 16; ++t) {
                const float* op = OPS + t * 320 + kq * 16;
                f32x4 A4[4], B4[4], W4[4], K4[4], R4[4];
#pragma unroll
                for (int i = 0; i < 4; ++i) A4[i] = *(const f32x4*)(op + i * 4);
#pragma unroll
                for (int i = 0; i < 4; ++i) { W4[i] = *(const f32x4*)(op + 128 + i * 4); B4[i] = *(const f32x4*)(op + 64 + i * 4); K4[i] = *(const f32x4*)(op + 192 + i * 4); }
#pragma unroll
                for (int i = 0; i < 4; ++i) R4[i] = *(const f32x4*)(op + 256 + i * 4);
                const float vv = VB[t * 64 + vrow];
                f32x2 s0 = {0.f, 0.f}, s1 = {0.f, 0.f};
#pragma unroll
                for (int i = 0; i < 4; ++i) { s0 += S[2 * i] * (f32x2){A4[i][0], A4[i][1]}; s1 += S[2 * i + 1] * (f32x2){A4[i][2], A4[i][3]}; }
                const float sa = red4((s0[0] + s0[1]) + (s1[0] + s1[1]));
                const f32x2 sa2 = {sa, sa}, vv2 = {vv, vv};
#pragma unroll
                for (int i = 0; i < 4; ++i) {
                    S[2 * i] = S[2 * i] * (f32x2){W4[i][0], W4[i][1]} + sa2 * (f32x2){B4[i][0], B4[i][1]} + vv2 * (f32x2){K4[i][0], K4[i][1]};
                    S[2 * i + 1] = S[2 * i + 1] * (f32x2){W4[i][2], W4[i][3]} + sa2 * (f32x2){B4[i][2], B4[i][3]} + vv2 * (f32x2){K4[i][2], K4[i][3]};
                }
                f32x2 y0 = {0.f, 0.f}, y1 = {0.f, 0.f};
#pragma unroll
                for (int i = 0; i < 4; ++i) { y0 += S[2 * i] * (f32x2){R4[i][0], R4[i][1]}; y1 += S[2 * i + 1] * (f32x2){R4[i][2], R4[i][3]}; }
                const float y = red4((y0[0] + y0[1]) + (y1[0] + y1[1]));
                if (kq == 0) YB[t * 64 + vrow] = y;
            }
            __syncthreads();
            {
                const f32x4 y4 = *(const f32x4*)(YB + tp * 64 + k4), v4 = *(const f32x4*)(VB + tp * 64 + k4), g4 = *(const f32x4*)(GB + tp * 64 + k4);
                const float mu = red16((y4[0] + y4[1]) + (y4[2] + y4[3])) * (1.0f / 64.0f);
                float q = 0.f;
#pragma unroll
                for (int i = 0; i < 4; ++i) { const float d = y4[i] - mu; q += d * d; }
                const float rstd = rsqrtf(red16(q) * (1.0f / 64.0f) + 64e-5f);
                const float bon = BON[tp];
                float o[4];
#pragma unroll
                for (int i = 0; i < 4; ++i) o[i] = ((y4[i] - mu) * rstd * c_lg[i] + c_lb[i] + bon * v4[i]) * g4[i];
                u32x2 w; w.x = pk2(o[0], o[1]); w.y = pk2(o[2], o[3]);
                *(u32x2*)(r16 + ((size_t)(b * 2048 + ch * 16 + tp)) * 1024 + col) = w;
            }
        }
        __syncthreads();
    }
}

__device__ __forceinline__ void dsa_norm_phase(const Params& p, int j, unsigned char* smem) {
    const int tid = opaque_tid();
    const int lane = tid & 63, wave = tid >> 6;
    const float* hin = (const float*)(p.ws + D_HIN);
    h16* cq = (h16*)(p.ws + D_CQ); h16* ckv = (h16*)(p.ws + D_CKV); h16* ckvt = (h16*)(p.ws + D_CKVT); h16* kidx = (h16*)(p.ws + D_KIDX);
    float* widx = (float*)(p.ws + D_WIDX);
    const f32x4 gq = *(const f32x4*)(p.in[23] + j * 256 + lane * 4);
    const f32x2 gkv = *(const f32x2*)(p.in[24] + j * 128 + lane * 2);
    const float gi = p.in[29][j * 64 + lane], bi = p.in[30][j * 64 + lane];
    h16* wl = (h16*)(smem + wave * 2048);
    for (int grp = blockIdx.x * 8 + wave; grp < MTOK / 8; grp += gridDim.x * 8) {
        const int r0 = grp * 8;
        for (int i = 0; i < 8; ++i) {
            const int row = r0 + i;
            const float* hp = hin + (size_t)row * 512;
            const f32x4 vq = *(const f32x4*)(hp + lane * 4);
            const f32x2 vk = *(const f32x2*)(hp + 256 + lane * 2);
            const float vi = hp[384 + lane];
            float ssq = wave_sum(vq[0] * vq[0] + vq[1] * vq[1] + vq[2] * vq[2] + vq[3] * vq[3]);
            const float rq = rsqrtf(ssq * (1.0f / 256.0f) + 1e-6f);
            u32x2 w; w.x = pk2(vq[0] * rq * gq[0], vq[1] * rq * gq[1]); w.y = pk2(vq[2] * rq * gq[2], vq[3] * rq * gq[3]);
            *(u32x2*)(cq + (size_t)row * 256 + lane * 4) = w;
            float ssk = wave_sum(vk[0] * vk[0] + vk[1] * vk[1]);
            const float rk = rsqrtf(ssk * (1.0f / 128.0f) + 1e-6f);
            const unsigned wk = pk2(vk[0] * rk * gkv[0], vk[1] * rk * gkv[1]);
            *(unsigned*)(ckv + (size_t)row * 128 + lane * 2) = wk;
            *(unsigned*)(wl + i * 128 + lane * 2) = wk;
            const float mu = wave_sum(vi) * (1.0f / 64.0f);
            const float dv = vi - mu;
            const float var = wave_sum(dv * dv) * (1.0f / 64.0f);
            kidx[(size_t)row * 64 + lane] = (h16)(dv * rsqrtf(var + 1e-5f) * gi + bi);
            if (lane < 8) widx[(size_t)row * 8 + lane] = hp[448 + lane] * 0.044194173824159216f;
        }
        asm volatile("s_waitcnt lgkmcnt(0)" ::: "memory");
        const int b = r0 >> 11, t0 = r0 & 2047;
#pragma unroll
        for (int dd = 0; dd < 2; ++dd) {
            const int d = lane * 2 + dd;
            h16x8 hv;
#pragma unroll
            for (int i = 0; i < 8; ++i) hv[i] = wl[i * 128 + d];
            *(h16x8*)(ckvt + ((size_t)(b * 128 + d)) * 2048 + t0) = hv;
        }
        asm volatile("s_waitcnt lgkmcnt(0)" ::: "memory");
    }
}

constexpr int ROWP = 2052;
__device__ __forceinline__ unsigned fkey(float x) {
    if (x == 0.0f) x = 0.0f;
    const unsigned u = __float_as_uint(x);
    return (u & 0x80000000u) ? ~u : (u | 0x80000000u);
}
__device__ __forceinline__ void dsa_index_phase(const Params& p, unsigned char* smem) {
    const int tid = opaque_tid(), wave = tid >> 6, lane = tid & 63, r = lane & 15, q = lane >> 4;
    float* SC = (float*)smem;
    const h16* qidx = (const h16*)(p.ws + D_QIDX);
    const h16* kidx = (const h16*)(p.ws + D_KIDX);
    const float* widx = (const float*)(p.ws + D_WIDX);
    unsigned* maskb = (unsigned*)(p.ws + D_MASK);
    for (int qi = blockIdx.x, it = 0; qi < MTOK / 16; qi += gridDim.x, ++it) {
        const int qt = (it & 1) ? ((qi & ~127) | (127 - (qi & 127))) : qi;
        const int row0 = qt * 16, b = row0 >> 11, t0 = row0 & 2047;
        const int nkt = (t0 >> 4) + 1;
        {
            h16x8 qf[8][2]; float wq[8];
#pragma unroll
            for (int h = 0; h < 8; ++h) {
#pragma unroll
                for (int kk = 0; kk < 2; ++kk) qf[h][kk] = *(const h16x8*)(qidx + (size_t)(row0 + r) * 512 + h * 64 + kk * 32 + q * 8);
                wq[h] = widx[(size_t)(row0 + r) * 8 + h];
            }
            for (int kt = wave; kt < nkt; kt += 8) {
                const int s0 = kt * 16;
                const h16* kp = kidx + (size_t)(b * 2048 + s0 + r) * 64 + q * 8;
                const h16x8 k0 = *(const h16x8*)kp, k1 = *(const h16x8*)(kp + 32);
                f32x4 sc = {0.f, 0.f, 0.f, 0.f};
#pragma unroll
                for (int h = 0; h < 8; ++h) {
                    f32x4 acc = {0.f, 0.f, 0.f, 0.f};
                    acc = __builtin_amdgcn_mfma_f32_16x16x32_f16(k0, qf[h][0], acc, 0, 0, 0);
                    acc = __builtin_amdgcn_mfma_f32_16x16x32_f16(k1, qf[h][1], acc, 0, 0, 0);
#pragma unroll
                    for (int jj = 0; jj < 4; ++jj) sc[jj] += fmaxf(acc[jj], 0.f) * wq[h];
                }
                *(f32x4*)(SC + r * ROWP + s0 + q * 4) = sc;
            }
        }
        __syncthreads();
        for (int qq = 0; qq < 2; ++qq) {
            const int ql = wave * 2 + qq, t = t0 + ql;
            const float* srow = SC + ql * ROWP;
            const int ni = (t >> 6) + 1;
            unsigned u[32];
#pragma unroll
            for (int i = 0; i < 32; ++i) {
                u[i] = 0u;
                if (i < ni) { const int s = i * 64 + lane; if (s <= t) u[i] = fkey(srow[s]); }
            }
            unsigned myw = 0u;
            if (t < 256) {
#pragma unroll
                for (int i = 0; i < 32; ++i) { const unsigned long long sm = __ballot(u[i] != 0u); if ((lane >> 1) == i) myw = (lane & 1) ? (unsigned)(sm >> 32) : (unsigned)sm; }
            } else {
                unsigned T = 0u;
                for (int bit = 31; bit >= 0; --bit) {
                    const unsigned cand = T | (1u << bit);
                    int c0 = 0, c1 = 0;
                    if (ni <= 16) {
#pragma unroll
                        for (int i = 0; i < 16; i += 2) { c0 += (u[i] >= cand) ? 1 : 0; c1 += (u[i + 1] >= cand) ? 1 : 0; }
                    } else {
#pragma unroll
                        for (int i = 0; i < 32; i += 2) { c0 += (u[i] >= cand) ? 1 : 0; c1 += (u[i + 1] >= cand) ? 1 : 0; }
                    }
                    int c = c0 + c1;
                    c += __builtin_amdgcn_update_dpp(0, c, 0xB1, 0xF, 0xF, true);
                    c += __builtin_amdgcn_update_dpp(0, c, 0x4E, 0xF, 0xF, true);
                    c += __builtin_amdgcn_update_dpp(0, c, 0x141, 0xF, 0xF, true);
                    c += __builtin_amdgcn_update_dpp(0, c, 0x140, 0xF, 0xF, true);
                    const int cnt = __builtin_amdgcn_readlane(c, 0) + __builtin_amdgcn_readlane(c, 16) + __builtin_amdgcn_readlane(c, 32) + __builtin_amdgcn_readlane(c, 48);
                    if (cnt >= 256) T = cand;
                }
                int cgt = 0;
#pragma unroll
                for (int i = 0; i < 32; ++i) if (i < ni) cgt += __popcll(__ballot(u[i] > T));
                const int need = 256 - cgt;
                int running = 0;
                const unsigned long long lt = (lane == 0) ? 0ull : (~0ull >> (64 - lane));
#pragma unroll
                for (int i = 0; i < 32; ++i) {
                    if (i < ni) {
                        const unsigned long long eq = __ballot(u[i] == T);
                        const int rank = running + __popcll(eq & lt);
                        const unsigned long long sm = __ballot(u[i] > T || (u[i] == T && rank < need));
                        running += __popcll(eq);
                        if ((lane >> 1) == i) myw = (lane & 1) ? (unsigned)(sm >> 32) : (unsigned)sm;
                    }
                }
            }
            maskb[(size_t)(row0 + ql) * 64 + lane] = myw;
        }
        __syncthreads();
    }
}

constexpr int AT_KROW = 272, AT_VROW = 144, AT_KBYTES = 64 * AT_KROW, AT_VBYTES = 128 * AT_VROW, AT_STAGE = AT_KBYTES + AT_VBYTES, AT_BL = 2 * AT_STAGE;
__device__ __forceinline__ void dsa_attn_phase(const Params& p, int j, unsigned char* smem) {
    const int tid = opaque_tid(), wave = tid >> 6, lane = tid & 63, r = lane & 15, q = lane >> 4;
    float* BL = (float*)(smem + AT_BL);
    for (int idx = tid; idx < 16 * 129; idx += 512) {
        const int h = idx / 129, d = idx % 129;
        int bk = d;
        if (d >= 16) { bk = 16 + (int)(logf((float)d * (1.0f / 16.0f)) / 2.0794415416798357f * 16.0f); bk = bk > 31 ? 31 : bk; }
        BL[h * 132 + d] = p.in[32][bk * 16 + h];
    }
    __syncthreads();
    const h16* qabs = (const h16*)(p.ws + D_QABS);
    const h16* ckv = (const h16*)(p.ws + D_CKV);
    const h16* ckvt = (const h16*)(p.ws + D_CKVT);
    const unsigned* maskb = (const unsigned*)(p.ws + D_MASK);
    h16* o16 = (h16*)(p.ws + D_O16);
    const h16* wuvt = w_dsa_uvt(p.ws, j);
    const float NINF = -__builtin_inff();
    const int krow0 = tid >> 4, kcc = tid & 15, vrow0 = tid >> 3, vcc = tid & 7;
    for (int qi = blockIdx.x, it = 0; qi < MTOK / 16; qi += gridDim.x, ++it) {
        const int qt = (it & 1) ? ((qi & ~127) | (127 - (qi & 127))) : qi;
        const int row0 = qt * 16, b = row0 >> 11, t0 = row0 & 2047, nst = (t0 + 16 + 63) >> 6, tq = t0 + r;
        const h16* kg = ckv + (size_t)(b * 2048) * 128;
        const h16* vg = ckvt + (size_t)(b * 128) * 2048;
        u32x4 sk[2], sv[2];
#pragma unroll
        for (int i = 0; i < 2; ++i) {
            sk[i] = *(const u32x4*)(kg + (size_t)(krow0 + i * 32) * 128 + kcc * 8);
            sv[i] = *(const u32x4*)(vg + (size_t)(vrow0 + i * 64) * 2048 + vcc * 8);
        }
        h16x8 qf[2][4];
#pragma unroll
        for (int hh = 0; hh < 2; ++hh)
#pragma unroll
            for (int kk = 0; kk < 4; ++kk) qf[hh][kk] = *(const h16x8*)(qabs + (size_t)(row0 + r) * 2048 + (2 * wave + hh) * 128 + kk * 32 + q * 8);
        f32x4 O[2][8];
#pragma unroll
        for (int hh = 0; hh < 2; ++hh)
#pragma unroll
            for (int dt = 0; dt < 8; ++dt) O[hh][dt] = (f32x4){0.f, 0.f, 0.f, 0.f};
        float mrun[2] = {NINF, NINF}, lrun[2] = {0.f, 0.f};
#pragma unroll
        for (int i = 0; i < 2; ++i) {
            *(u32x4*)(smem + (krow0 + i * 32) * AT_KROW + kcc * 16) = sk[i];
            *(u32x4*)(smem + AT_KBYTES + (vrow0 + i * 64) * AT_VROW + vcc * 16) = sv[i];
        }
        __syncthreads();
        for (int st = 0; st < nst; ++st) {
            const int s0 = st * 64;
            const unsigned char* Kb = smem + (st & 1) * AT_STAGE;
            const unsigned char* Vb = Kb + AT_KBYTES;
            const u32x2 mw2 = *(const u32x2*)(maskb + (size_t)(row0 + r) * 64 + st * 2);
            if (st + 1 < nst) {
#pragma unroll
                for (int i = 0; i < 2; ++i) {
                    sk[i] = *(const u32x4*)(kg + (size_t)(s0 + 64 + krow0 + i * 32) * 128 + kcc * 8);
                    sv[i] = *(const u32x4*)(vg + (size_t)(vrow0 + i * 64) * 2048 + s0 + 64 + vcc * 8);
                }
            }
#pragma nounroll
            for (int hf = 0; hf < 2; ++hf) {
                const unsigned mw = hf ? mw2.y : mw2.x;
                h16x8 pf[2]; float alpha[2];
#pragma unroll
                for (int hh = 0; hh < 2; ++hh) {
                    const int h = 2 * wave + hh;
                    f32x4 sc[2];
#pragma unroll
                    for (int tt = 0; tt < 2; ++tt) {
                        f32x4 acc = {0.f, 0.f, 0.f, 0.f};
#pragma unroll
                        for (int kk = 0; kk < 4; ++kk) {
                            const h16x8 kf = *(const h16x8*)(Kb + (hf * 32 + tt * 16 + r) * AT_KROW + kk * 64 + q * 16);
                            acc = __builtin_amdgcn_mfma_f32_16x16x32_f16(kf, qf[hh][kk], acc, 0, 0, 0);
                        }
                        sc[tt] = acc;
                    }
                    float x[8]; float mx = NINF;
#pragma unroll
                    for (int tt = 0; tt < 2; ++tt)
#pragma unroll
                        for (int jj = 0; jj < 4; ++jj) {
                            const int kix = tt * 16 + q * 4 + jj;
                            int dist = tq - (s0 + hf * 32 + kix); dist = dist < 0 ? 0 : (dist > 128 ? 128 : dist);
                            const float v = sc[tt][jj] + BL[h * 132 + dist];
                            const float xv = ((mw >> kix) & 1u) ? v : NINF;
                            x[tt * 4 + jj] = xv; mx = fmaxf(mx, xv);
                        }
                    mx = fmaxf(mx, __shfl_xor(mx, 16)); mx = fmaxf(mx, __shfl_xor(mx, 32));
                    const float mnew = fmaxf(mrun[hh], mx);
                    const float mref = (mnew == NINF) ? 0.f : mnew;
                    alpha[hh] = __expf(mrun[hh] - mref);
                    mrun[hh] = mnew;
                    float ps = 0.f;
#pragma unroll
                    for (int i = 0; i < 8; ++i) { const float pv = __expf(x[i] - mref); ps += pv; pf[hh][i] = (h16)pv; }
                    lrun[hh] = lrun[hh] * alpha[hh] + ps;
                    __builtin_amdgcn_sched_barrier(0);
                }
#pragma unroll
                for (int dt = 0; dt < 8; ++dt) {
                    if ((dt & 1) == 0) __builtin_amdgcn_sched_barrier(0);
                    const unsigned char* vp = Vb + (dt * 16 + r) * AT_VROW + (hf * 32 + q * 4) * 2;
                    const h16x4 lo = *(const h16x4*)vp, hi = *(const h16x4*)(vp + 32);
                    const h16x8 vf = {lo[0], lo[1], lo[2], lo[3], hi[0], hi[1], hi[2], hi[3]};
#pragma unroll
                    for (int hh = 0; hh < 2; ++hh) {
                        O[hh][dt] *= alpha[hh];
                        O[hh][dt] = __builtin_amdgcn_mfma_f32_16x16x32_f16(vf, pf[hh], O[hh][dt], 0, 0, 0);
                    }
                }
                __builtin_amdgcn_sched_barrier(0);
            }
            if (st + 1 < nst) {
                unsigned char* Kn = smem + ((st + 1) & 1) * AT_STAGE;
#pragma unroll
                for (int i = 0; i < 2; ++i) {
                    *(u32x4*)(Kn + (krow0 + i * 32) * AT_KROW + kcc * 16) = sk[i];
                    *(u32x4*)(Kn + AT_KBYTES + (vrow0 + i * 64) * AT_VROW + vcc * 16) = sv[i];
                }
            }
            __syncthreads();
        }
#pragma unroll
        for (int hh = 0; hh < 2; ++hh) {
            const int h = 2 * wave + hh;
            float lt = lrun[hh]; lt += __shfl_xor(lt, 16); lt += __shfl_xor(lt, 32);
            const float inv = 1.0f / lt;
#pragma unroll
            for (int vt = 0; vt < 4; ++vt) {
                f32x4 acc = {0.f, 0.f, 0.f, 0.f};
#pragma unroll
                for (int kk = 0; kk < 4; ++kk) {
                    const h16* ap = wuvt + (size_t)(h * 64 + vt * 16 + r) * 128 + kk * 32 + q * 4;
                    const h16x4 lo = *(const h16x4*)ap, hi = *(const h16x4*)(ap + 16);
                    const h16x8 a8 = {lo[0], lo[1], lo[2], lo[3], hi[0], hi[1], hi[2], hi[3]};
                    h16x8 b8;
#pragma unroll
                    for (int i = 0; i < 4; ++i) { b8[i] = (h16)(O[hh][2 * kk][i] * inv); b8[4 + i] = (h16)(O[hh][2 * kk + 1][i] * inv); }
                    acc = __builtin_amdgcn_mfma_f32_16x16x32_f16(a8, b8, acc, 0, 0, 0);
                }
                u32x2 w; w.x = pk2(acc[0], acc[1]); w.y = pk2(acc[2], acc[3]);
                *(u32x2*)(o16 + (size_t)(row0 + r) * 1024 + h * 64 + vt * 16 + q * 4) = w;
            }
        }
    }
    __syncthreads();
}

constexpr size_t OFF_BAR = 951 * MiB;
__device__ __forceinline__ void grid_bar(unsigned* ctr, unsigned& target, unsigned nblk) {
    asm volatile("s_waitcnt vmcnt(0) lgkmcnt(0)" ::: "memory");
    __syncthreads();
    target += nblk;
    if (threadIdx.x == 0) {
        __builtin_amdgcn_fence(__ATOMIC_RELEASE, "agent");
        asm volatile("s_waitcnt vmcnt(0)" ::: "memory");
        __hip_atomic_fetch_add(ctr, 1u, __ATOMIC_RELAXED, __HIP_MEMORY_SCOPE_AGENT);
        while (__hip_atomic_load(ctr, __ATOMIC_RELAXED, __HIP_MEMORY_SCOPE_AGENT) < target) __builtin_amdgcn_s_sleep(1);
        __builtin_amdgcn_fence(__ATOMIC_ACQUIRE, "agent");
        asm volatile("s_waitcnt vmcnt(0)" ::: "memory");
    }
    __syncthreads();
}

__global__ void __launch_bounds__(512) mega_fwd(Params p) {
    extern __shared__ __attribute__((aligned(16))) unsigned char smem[];
    cg::grid_group grid = cg::this_grid();
    unsigned char* ws = p.ws;
    h16* x16 = (h16*)(ws + OFF_X16);
    unsigned* barctr = (unsigned*)(ws + OFF_BAR);
    unsigned bar_target = 0u;
    for (int ph = p.ph_lo; ph < p.ph_hi; ++ph) {
        const unsigned e = p.prog[ph];
        const int kind = e & 15, L = (e >> 4) & 3, sub = (e >> 6) & 1, j = L >> 1;
        const int nrep = 1 + (int)(e >> 7);
        for (int rep = 0; rep < nrep; ++rep) {
        if (rep) grid_bar(barctr, bar_target, gridDim.x);
        const bool isgemm = (kind == K_R1 || kind == K_R2 || kind == K_R4 || kind == K_F1 || kind == K_F3 || kind == K_D1 || kind == K_D3 || kind == K_D6);
        if (isgemm) {
            pg8::Gemm g; pg8::Epi E;
            g.M = MTOK; g.N = 1024; g.K = 1024; g.lda = 1024; g.amode = 0; g.pm0 = 0; g.A = x16; g.Bt = x16;
            E.mode = E_RESID; E.pm0 = 0; E.j = j; E.ws = ws; E.out = p.out; E.bias0 = p.in[5] + j * 1024; E.bias1 = p.in[8] + j * 1024; E.bias2 = p.in[11];
            if (kind == K_R1) {
                g.Bt = w_rwkv_big(ws, j); g.N = 3584; g.K = 2048; g.amode = 1; E.mode = E_RPROJ;
            } else if (kind == K_R2) {
                g.A = (const h16*)(ws + R_HACT); g.Bt = w_rwkv_l2(ws, j); g.N = (j == 0) ? 3072 : 4096; g.K = 512; g.lda = 512; E.mode = E_LORA2;
            } else if (kind == K_R4) {
                g.A = (const h16*)(ws + R_R16); g.Bt = w_rwkv_o(ws, j);
            } else if (kind == K_F1) {
                g.Bt = w_ffn_up(ws, L); g.M = MTOK / 2; g.N = 5632; g.amode = 1; g.pm0 = sub * 128; E.mode = E_ST16;
            } else if (kind == K_F3) {
                g.A = (const h16*)(ws + F_ACT); g.Bt = w_ffn_dn(ws, L); g.M = MTOK / 2; g.K = 2816; g.lda = 2816; E.pm0 = sub * 128;
            } else if (kind == K_D1) {
                g.Bt = w_dsa_in(ws, j); g.N = 512; g.amode = 1; E.mode = E_ST32;
            } else if (kind == K_D3) {
                g.A = (const h16*)(ws + D_CQ); g.Bt = w_dsa_q(ws, j); g.N = 2560; g.K = 256; g.lda = 256; E.mode = E_QPROJ;
            } else {
                g.A = (const h16*)(ws + D_O16); g.Bt = w_dsa_o(ws, j);
            }
            pg8::StaticOrder S; S.init(g.M, g.N, (int)gridDim.x, (int)blockIdx.x);
#ifndef NO_GEMM
            pg8::gemm_phase((LAS unsigned char*)smem, g, S, E);
#endif
        } else if (kind == K_PREP) {
#ifndef NO_PREP
            prep_phase(p, smem);
#endif
        } else if (kind == K_R3) {
#ifndef NO_SCAN
            scan_phase(p, j, smem);
#endif
        } else if (kind == K_LN) {
#ifndef NO_LN
            ln_phase(p, p.in[1] + (L * 2 + sub) * 1024, p.in[2] + (L * 2 + sub) * 1024, L == 3 && sub == 1);
#endif
        } else if (kind == K_F2) {
#ifndef NO_CONV
            conv_phase(p, L);
#endif
        } else if (kind == K_D2) {
#ifndef NO_NORM
            dsa_norm_phase(p, j, smem);
#endif
        } else if (kind == K_D4) {
#ifndef NO_INDEX
            dsa_index_phase(p, smem);
#endif
        } else if (kind == K_D5) {
#ifndef NO_ATTN
            dsa_attn_phase(p, j, smem);
#endif
        }
        }
        if (ph + 1 < p.ph_hi) { if (ph == p.ph_lo) grid.sync(); else grid_bar(barctr, bar_target, gridDim.x); for (int xs = 0; xs < EXTRA_SYNC; ++xs) grid_bar(barctr, bar_target, gridDim.x); }
    }
}

extern "C" void kernel_launch(void* const* d_in, const int* in_sizes, int n_in, void* d_out, int out_size, void* d_ws, size_t ws_size, hipStream_t stream) {
    static int grid_blocks = 0;
    if (grid_blocks == 0) {
        if (n_in != 37 || ws_size < WS_NEED || out_size != MTOK * DM) { fprintf(stderr, "kernel_launch: unexpected problem (n_in %d ws %zu out %d)\n", n_in, ws_size, out_size); grid_blocks = -1; return; }
        int dev = 0, cus = 0, per_cu = 0;
        hipGetDevice(&dev);
        hipDeviceGetAttribute(&cus, hipDeviceAttributeMultiprocessorCount, dev);
        if (hipFuncSetAttribute((const void*)mega_fwd, hipFuncAttributeMaxDynamicSharedMemorySize, LDS_BYTES) != hipSuccess) { fprintf(stderr, "kernel_launch: hipFuncSetAttribute failed\n"); grid_blocks = -1; return; }
        hipOccupancyMaxActiveBlocksPerMultiprocessor(&per_cu, (const void*)mega_fwd, 512, LDS_BYTES);
        if (per_cu < 1) { fprintf(stderr, "kernel_launch: occupancy query says %d blocks/CU\n", per_cu); per_cu = 1; }
        (void)hipGetLastError();
        grid_blocks = cus * per_cu;
        fprintf(stderr, "kernel_launch: grid %d (cus %d x %d)\n", grid_blocks, cus, per_cu);
    }
    if (grid_blocks < 0) return;
    Params p{};
    for (int i = 0; i < 37; ++i) p.in[i] = (const float*)d_in[i];
    p.ws = (unsigned char*)d_ws; p.out = (float*)d_out;
    int np = 0;
    constexpr unsigned PROBE_MASK = 0u;
    auto add = [&](int kind, int L, int sub) { p.prog[np++] = (unsigned char)(kind | (L << 4) | (sub << 6) | ((((PROBE_MASK >> kind) & 1u) && !(kind == K_LN && L == 3 && sub == 1)) ? 128 : 0)); };
    add(K_PREP, 0, 0);
    for (int L = 0; L < 4; ++L) {
        if ((L & 1) == 0) { add(K_R1, L, 0); add(K_R2, L, 0); add(K_R3, L, 0); add(K_R4, L, 0); }
        else { add(K_D1, L, 0); add(K_D2, L, 0); add(K_D3, L, 0); add(K_D4, L, 0); add(K_D5, L, 0); add(K_D6, L, 0); }
        add(K_LN, L, 0);
        for (int c = 0; c < 2; ++c) { add(K_F1, L, c); add(K_F2, L, c); add(K_F3, L, c); }
        add(K_LN, L, 1);
    }
#if SINGLE_LAUNCH
    if (hipMemsetAsync((unsigned char*)d_ws + OFF_BAR, 0, 256, stream) != hipSuccess) { fprintf(stderr, "kernel_launch: memset failed\n"); return; }
    p.ph_lo = 0; p.ph_hi = np;
    void* args[] = {&p};
    hipError_t e = hipLaunchCooperativeKernel((const void*)mega_fwd, dim3(grid_blocks), dim3(512), args, LDS_BYTES, stream);
    if (e != hipSuccess) fprintf(stderr, "cooperative launch failed: %s (grid %d)\n", hipGetErrorString(e), grid_blocks);
#else
    for (int ph = 0; ph < np; ++ph) {
        p.ph_lo = ph; p.ph_hi = ph + 1;
        hipLaunchKernelGGL(mega_fwd, dim3(grid_blocks), dim3(512), LDS_BYTES, stream, p);
    }
#endif
}
```

```cpp
#include <hip/hip_runtime.h>
#include <hip/hip_cooperative_groups.h>
#include <cstdio>
namespace cg = cooperative_groups;

constexpr int EXTRA_SYNC = 0;
#ifndef SINGLE_LAUNCH
#define SINGLE_LAUNCH 1
#endif

#define LAS __attribute__((address_space(3)))
typedef _Float16 h16;
typedef _Float16 h16x8 __attribute__((ext_vector_type(8)));
typedef _Float16 h16x4 __attribute__((ext_vector_type(4)));
typedef _Float16 h16x2 __attribute__((ext_vector_type(2)));
typedef float f32x4 __attribute__((ext_vector_type(4)));
typedef float f32x2 __attribute__((ext_vector_type(2)));
typedef unsigned u32x4 __attribute__((ext_vector_type(4)));
typedef unsigned u32x2 __attribute__((ext_vector_type(2)));

constexpr int DM = 1024, SEQ = 2048, NBATCH = 32, MTOK = NBATCH * SEQ;
constexpr int DFF = 2816;
constexpr size_t MiB = (size_t)1 << 20;
constexpr float DN_ALPHA = 1.6817928305074290f;
constexpr int LDS_BYTES = 147456;

constexpr size_t OFF_W = 0;
constexpr size_t OFF_X16 = 118 * MiB;
constexpr size_t OFF_VF = 247 * MiB;
constexpr size_t OFF_R = 375 * MiB;
constexpr size_t WS_NEED = 952 * MiB;
constexpr size_t R_R16 = OFF_R, R_K16 = OFF_R + 128 * MiB, R_V16 = OFF_R + 256 * MiB, R_G16 = OFF_R + 384 * MiB, R_HACT = OFF_R + 512 * MiB;
constexpr size_t F_U16 = OFF_R, F_ACT = OFF_R + 352 * MiB;
constexpr size_t D_HIN = OFF_R, D_O16 = OFF_R, D_QABS = OFF_R + 128 * MiB, D_QIDX = OFF_R + 384 * MiB, D_CQ = OFF_R + 448 * MiB,
                 D_CKV = OFF_R + 480 * MiB, D_CKVT = OFF_R + 496 * MiB, D_KIDX = OFF_R + 512 * MiB, D_WIDX = OFF_R + 520 * MiB, D_MASK = OFF_R + 522 * MiB;

struct Params {
    const float* in[37];
    unsigned char* ws;
    float* out;
    int ph_lo, ph_hi;
    unsigned char prog[64];
};

enum { K_PREP = 0, K_R1, K_R2, K_R3, K_R4, K_LN, K_F1, K_F2, K_F3, K_D1, K_D2, K_D3, K_D4, K_D5, K_D6 };
enum { E_RPROJ = 0, E_LORA2, E_RESID, E_ST16, E_ST32, E_QPROJ };

__device__ __forceinline__ size_t xrow(int row) { return (size_t)(row >> 11) * 2049 + 1 + (row & 2047); }
__device__ __forceinline__ unsigned pk2(float a, float b) { h16x2 h = {(h16)a, (h16)b}; return __builtin_bit_cast(unsigned, h); }
__device__ __forceinline__ u32x4 pack8(f32x4 a, f32x4 b) { u32x4 w; w.x = pk2(a[0], a[1]); w.y = pk2(a[2], a[3]); w.z = pk2(b[0], b[1]); w.w = pk2(b[2], b[3]); return w; }
__device__ __forceinline__ void unpack8(u32x4 w, float* f) {
    h16x8 h = __builtin_bit_cast(h16x8, w);
#pragma unroll
    for (int i = 0; i < 8; ++i) f[i] = (float)h[i];
}
__device__ __forceinline__ float sigmoidf_(float x) { return 1.0f / (1.0f + __expf(-x)); }
__device__ __forceinline__ float wave_sum(float v) {
#pragma unroll
    for (int o = 32; o > 0; o >>= 1) v += __shfl_xor(v, o);
    return v;
}
#define WSYNC() asm volatile("s_waitcnt vmcnt(0) lgkmcnt(0)" ::: "memory")
__device__ __forceinline__ int opaque_tid() { int t = threadIdx.x; asm volatile("" : "+v"(t)); return t; }

namespace pg8 {
constexpr int BM = 256, BK = 64, HALF = 128, HTB = HALF * BK * 2, STAGE_BYTES = 8 * HTB, NXCD = 8, WGM = 8;
__device__ __forceinline__ int lds_byte(int r, int c) { const int st = (r >> 4) * 2 + (c >> 5), rr = r & 15, cc = c & 31, ob = rr * 64 + cc * 2; return st * 1024 + (ob ^ (((ob >> 9) & 1) << 5)); }
__device__ __forceinline__ void stage_rc(int b, int& R, int& C) { const int st = b / 1024, sb = b % 1024, swz = sb ^ (((sb >> 9) & 1) << 5); R = (st >> 1) * 16 + swz / 64; C = (st & 1) * 32 + (swz % 64) / 2; }
__device__ __forceinline__ int perm32(int rho) { const int n = rho >> 4, i = rho & 15; return 8 * (i >> 2) + 4 * n + (i & 3); }
struct Unit { int pm, pn; };
struct Gemm { const h16* A; const h16* Bt; int M, N, K, lda, amode, pm0; };
struct StaticOrder {
    int nM, nN, nwg, G, c;
    __device__ void init(int M, int N, int G_, int c_) { nM = M / BM; nN = N / BM; nwg = nM * nN; G = G_; c = c_; }
    __device__ bool next(int i, Unit& u) const {
        const long L = (long)i * G + c; if (L >= nwg) return false;
        int wgid = (int)L; { const int q = nwg / NXCD, r = nwg % NXCD, xcd = wgid % NXCD, off = wgid / NXCD; wgid = (xcd < r ? xcd * (q + 1) : r * (q + 1) + (xcd - r) * q) + off; }
        const int nig = WGM * nN, gid = wgid / nig, fm = gid * WGM, gsz = (nM - fm) < WGM ? (nM - fm) : WGM;
        u.pm = fm + ((wgid % nig) % gsz); u.pn = (wgid % nig) / gsz; return true;
    }
};

struct Epi {
    int mode, pm0, j;
    unsigned char* ws; float* out; const float* bias0; const float* bias1; const float* bias2;
    __device__ __forceinline__ void operator()(const f32x4 (&acc)[2][2][4][2], const Unit& u, int wr, int wc, int fr, int fq) const {
        const int rowl0 = u.pm * BM + wr * 64 + fr;
        const int colt = u.pn * BM + wc * 32 + 8 * fq;
#pragma unroll
        for (int ai = 0; ai < 2; ++ai)
#pragma unroll
            for (int m = 0; m < 4; ++m) {
                const int rowl = rowl0 + ai * HALF + m * 16;
                const int rowg = rowl + pm0 * BM;
#pragma unroll
                for (int bj = 0; bj < 2; ++bj) {
                    const int col = colt + bj * HALF;
                    f32x4 v0 = acc[ai][bj][m][0], v1 = acc[ai][bj][m][1];
                    if (mode == E_RPROJ) {
                        if (u.pn < 12) {
                            h16* dst = (h16*)(ws + (u.pn < 4 ? R_R16 : (u.pn < 8 ? R_K16 : (j == 0 ? OFF_VF : R_V16))));
                            *(u32x4*)(dst + (size_t)rowg * 1024 + (col & 1023)) = pack8(v0, v1);
                        } else {
                            const int hc = col - 3072;
                            if (hc < 64) {
#pragma unroll
                                for (int jj = 0; jj < 4; ++jj) { v0[jj] = tanhf(v0[jj]); v1[jj] = tanhf(v1[jj]); }
                            } else if (hc >= 160) {
#pragma unroll
                                for (int jj = 0; jj < 4; ++jj) { v0[jj] = sigmoidf_(v0[jj]); v1[jj] = sigmoidf_(v1[jj]); }
                            }
                            *(u32x4*)((h16*)(ws + R_HACT) + (size_t)rowg * 512 + hc) = pack8(v0, v1);
                        }
                    } else if (mode == E_LORA2) {
                        const int grp = u.pn >> 2, c = col & 1023;
                        const size_t off = (size_t)rowg * 1024 + c;
                        if (grp == 0) {
                            const f32x4 ba = *(const f32x4*)(bias0 + c), bb = *(const f32x4*)(bias0 + c + 4);
#pragma unroll
                            for (int jj = 0; jj < 4; ++jj) { v0[jj] = sigmoidf_(v0[jj] + ba[jj]) * 0.6065306597f; v1[jj] = sigmoidf_(v1[jj] + bb[jj]) * 0.6065306597f; }
                            *(u32x4*)((h16*)out + off) = pack8(v0, v1);
                        } else if (grp == 1) {
                            const f32x4 ba = *(const f32x4*)(bias1 + c), bb = *(const f32x4*)(bias1 + c + 4);
#pragma unroll
                            for (int jj = 0; jj < 4; ++jj) { v0[jj] = sigmoidf_(v0[jj] + ba[jj]); v1[jj] = sigmoidf_(v1[jj] + bb[jj]); }
                            *(u32x4*)((h16*)out + (size_t)MTOK * 1024 + off) = pack8(v0, v1);
                        } else if (grp == 2) {
                            *(u32x4*)((h16*)(ws + R_G16) + off) = pack8(v0, v1);
                        } else {
                            const f32x4 ba = *(const f32x4*)(bias2 + c), bb = *(const f32x4*)(bias2 + c + 4);
                            float vv[8], vf8[8];
                            h16* vp = (h16*)(ws + R_V16) + off;
                            unpack8(*(const u32x4*)vp, vv); unpack8(*(const u32x4*)((const h16*)(ws + OFF_VF) + off), vf8);
#pragma unroll
                            for (int jj = 0; jj < 4; ++jj) {
                                v0[jj] = vv[jj] + (vf8[jj] - vv[jj]) * sigmoidf_(v0[jj] + ba[jj]);
                                v1[jj] = vv[4 + jj] + (vf8[4 + jj] - vv[4 + jj]) * sigmoidf_(v1[jj] + bb[jj]);
                            }
                            *(u32x4*)vp = pack8(v0, v1);
                        }
                    } else if (mode == E_RESID) {
                        float xr[8];
                        unpack8(*(const u32x4*)((const h16*)(ws + OFF_X16) + xrow(rowg) * 1024 + col), xr);
                        f32x4 r0, r1;
#pragma unroll
                        for (int jj = 0; jj < 4; ++jj) { r0[jj] = DN_ALPHA * xr[jj] + v0[jj]; r1[jj] = DN_ALPHA * xr[4 + jj] + v1[jj]; }
                        float* dp = out + (size_t)rowg * 1024 + col;
                        *(f32x4*)dp = r0; *(f32x4*)(dp + 4) = r1;
                    } else if (mode == E_ST16) {
                        *(u32x4*)((h16*)(ws + F_U16) + (size_t)rowl * 5632 + col) = pack8(v0, v1);
                    } else if (mode == E_ST32) {
                        float* dp = (float*)(ws + D_HIN) + (size_t)rowg * 512 + col;
                        *(f32x4*)dp = v0; *(f32x4*)(dp + 4) = v1;
                    } else {
                        if (u.pn < 8) *(u32x4*)((h16*)(ws + D_QABS) + (size_t)rowg * 2048 + col) = pack8(v0, v1);
                        else *(u32x4*)((h16*)(ws + D_QIDX) + (size_t)rowg * 512 + (col - 2048)) = pack8(v0, v1);
                    }
                }
            }
    }
};

__device__ __forceinline__ const char* a_tile(const Gemm& g, int pm) {
    if (g.amode == 1) { const int row = (pm + g.pm0) * BM; return (const char*)g.A + xrow(row) * 2048; }
    return (const char*)g.A + (size_t)pm * BM * g.lda * 2;
}

__device__ __forceinline__ void gemm_phase(LAS unsigned char* lds, const Gemm g, const StaticOrder& S, const Epi& E) {
    const int tid = opaque_tid(), wid = __builtin_amdgcn_readfirstlane(tid >> 6), lane = tid & 63, wr = wid >> 2, wc = wid & 3, fr = lane & 15, fq = lane >> 4;
    const int K = g.K, nt = K / BK;
    const bool shiftA = (g.amode == 1);
    unsigned voffA[2], voffB[2];
#pragma unroll
    for (int i = 0; i < 2; ++i) { int R, C; stage_rc(tid * 16 + i * 8192, R, C); const int Rb = (R & ~31) + perm32(R & 31);
        voffA[i] = (unsigned)(R * g.lda + C) * 2u; voffB[i] = (unsigned)(Rb * K + C) * 2u; }
    const size_t kstep = (size_t)(BK * 2);
    const size_t hstepA = (size_t)HALF * g.lda * 2;
    const size_t hstepB = (size_t)HALF * K * 2;
    const size_t tstepB = 2 * hstepB;
    const unsigned ldsw = (unsigned)wid * 1024u;
    const int aoff = lds_byte(wr * 64 + fr, fq * 8), boff = lds_byte(wc * 32 + fr, fq * 8);
#define PG8_KOFF(kt) ((size_t)(kt) * kstep - ((shiftA && (kt) >= 16) ? (size_t)4096 : (size_t)0))
#define PG8_SA(b, h) (((b) * 2 + (h)) * HTB)
#define PG8_SB(b, h) ((4 + (b) * 2 + (h)) * HTB)
#define PG8_STAGE(bufoff, gbase, voff) do { _Pragma("unroll") for (int _i = 0; _i < 2; ++_i) \
        __builtin_amdgcn_global_load_lds((const unsigned*)((const char*)(gbase) + (voff)[_i]), (LAS unsigned*)(lds + (bufoff) + ldsw + _i * 8192), 16, 0, 0); } while (0)
#define PG8_LDA(dst, b, h) do { _Pragma("unroll") for (int m = 0; m < 4; ++m) _Pragma("unroll") for (int k = 0; k < 2; ++k) dst[m][k] = *(const LAS h16x8*)(lds + PG8_SA(b, h) + aoff + m * 2048 + k * 1024); } while (0)
#define PG8_LDB(dst, b, h) do { _Pragma("unroll") for (int n = 0; n < 2; ++n) _Pragma("unroll") for (int k = 0; k < 2; ++k) dst[n][k] = *(const LAS h16x8*)(lds + PG8_SB(b, h) + boff + n * 2048 + k * 1024); } while (0)
#define PG8_MMA(ai, bj, At, Bt) do { __builtin_amdgcn_s_setprio(1); _Pragma("unroll") for (int m = 0; m < 4; ++m) _Pragma("unroll") for (int n = 0; n < 2; ++n) _Pragma("unroll") for (int k = 0; k < 2; ++k) \
        acc[ai][bj][m][n] = __builtin_amdgcn_mfma_f32_16x16x32_f16(Bt[n][k], At[m][k], acc[ai][bj][m][n], 0, 0, 0); __builtin_amdgcn_s_setprio(0); } while (0)
#define PG8_WAIT_V(n) asm volatile("s_waitcnt vmcnt(" #n ")" ::: "memory")
#define PG8_WAIT_L(n) asm volatile("s_waitcnt lgkmcnt(" #n ")" ::: "memory")
#define PG8_BAR __builtin_amdgcn_s_barrier()
#define PG8_SCHED __builtin_amdgcn_sched_barrier(0)
    Unit cur, nxt; int ui = 0;
    if (!S.next(0, cur)) return;
    f32x4 acc[2][2][4][2];
#pragma unroll
    for (int a = 0; a < 2; ++a)
#pragma unroll
        for (int b = 0; b < 2; ++b)
#pragma unroll
            for (int m = 0; m < 4; ++m)
#pragma unroll
                for (int n = 0; n < 2; ++n) acc[a][b][m][n] = (f32x4){0.f, 0.f, 0.f, 0.f};
    h16x8 At[4][2], B0[2][2], B1[2][2];
    const char* cA = a_tile(g, cur.pm); const char* cB = (const char*)g.Bt + (size_t)cur.pn * tstepB;
    PG8_STAGE(PG8_SB(0, 0), cB, voffB); PG8_STAGE(PG8_SA(0, 0), cA, voffA); PG8_STAGE(PG8_SB(0, 1), cB + hstepB, voffB); PG8_STAGE(PG8_SA(0, 1), cA + hstepA, voffA);
    if (wr == 1) PG8_BAR;
    PG8_WAIT_V(4); PG8_BAR;
    PG8_STAGE(PG8_SB(1, 0), cB + kstep, voffB); PG8_STAGE(PG8_SA(1, 0), cA + kstep, voffA); PG8_STAGE(PG8_SB(1, 1), cB + hstepB + kstep, voffB);
    PG8_WAIT_V(6); PG8_BAR;
    for (;;) {
        const bool has_next = S.next(ui + 1, nxt);
        const char* nA = has_next ? a_tile(g, nxt.pm) : cA; const char* nB = has_next ? (const char*)g.Bt + (size_t)nxt.pn * tstepB : cB;
        for (int t = 0; t < nt; t += 2) {
            const bool last = (t == nt - 2);
            const char* a1 = cA + PG8_KOFF(t + 1);
            const char* a2 = last ? nA : cA + PG8_KOFF(t + 2); const char* b2 = last ? nB : cB + (size_t)(t + 2) * kstep;
            const char* a3 = a2 + kstep; const char* b3 = b2 + kstep;
            PG8_LDB(B0, 0, 0); PG8_SCHED; PG8_LDA(At, 0, 0); PG8_STAGE(PG8_SA(1, 1), a1 + hstepA, voffA);
            PG8_WAIT_L(8); PG8_BAR; PG8_WAIT_L(0); PG8_MMA(0, 0, At, B0); PG8_BAR; PG8_SCHED;
            PG8_LDB(B1, 0, 1); PG8_STAGE(PG8_SB(0, 0), b2, voffB);
            PG8_BAR; PG8_WAIT_L(0); PG8_MMA(0, 1, At, B1); PG8_BAR;
            PG8_LDA(At, 0, 1); PG8_STAGE(PG8_SA(0, 0), a2, voffA);
            PG8_BAR; PG8_WAIT_L(0); PG8_MMA(1, 0, At, B0); PG8_BAR; PG8_SCHED;
            PG8_STAGE(PG8_SB(0, 1), b2 + hstepB, voffB);
            PG8_WAIT_V(6); PG8_BAR; PG8_MMA(1, 1, At, B1); PG8_BAR;
            PG8_LDB(B0, 1, 0); PG8_SCHED; PG8_LDA(At, 1, 0); PG8_STAGE(PG8_SA(0, 1), a2 + hstepA, voffA);
            PG8_WAIT_L(8); PG8_BAR; PG8_WAIT_L(0); PG8_MMA(0, 0, At, B0); PG8_BAR; PG8_SCHED;
            PG8_LDB(B1, 1, 1); PG8_STAGE(PG8_SB(1, 0), b3, voffB);
            PG8_BAR; PG8_WAIT_L(0); PG8_MMA(0, 1, At, B1); PG8_BAR;
            PG8_LDA(At, 1, 1); PG8_STAGE(PG8_SA(1, 0), a3, voffA);
            PG8_BAR; PG8_WAIT_L(0); PG8_MMA(1, 0, At, B0); PG8_BAR; PG8_SCHED;
            PG8_STAGE(PG8_SB(1, 1), b3 + hstepB, voffB);
            PG8_WAIT_V(6); PG8_BAR; PG8_MMA(1, 1, At, B1); PG8_BAR;
        }
        E(acc, cur, wr, wc, fr, fq);
        if (!has_next) break;
#pragma unroll
        for (int a = 0; a < 2; ++a)
#pragma unroll
            for (int b = 0; b < 2; ++b)
#pragma unroll
                for (int m = 0; m < 4; ++m)
#pragma unroll
                    for (int n = 0; n < 2; ++n) acc[a][b][m][n] = (f32x4){0.f, 0.f, 0.f, 0.f};
        cur = nxt; cA = nA; cB = nB; ++ui;
    }
    PG8_WAIT_V(0);
    if (wr == 0) PG8_BAR;
    PG8_BAR;
#undef PG8_KOFF
#undef PG8_SA
#undef PG8_SB
#undef PG8_STAGE
#undef PG8_LDA
#undef PG8_LDB
#undef PG8_MMA
#undef PG8_WAIT_V
#undef PG8_WAIT_L
#undef PG8_BAR
#undef PG8_SCHED
}
}

struct TJob { int mode; const float* src; int ld, K, N; h16* dst; int ldd, koff; const float* mix; };

__device__ __forceinline__ TJob get_job(const Params& p, int id) {
    TJob J; J.mode = 0; J.src = nullptr; J.ld = 0; J.K = 0; J.N = 0; J.dst = nullptr; J.ldd = 64; J.koff = 0; J.mix = nullptr;
    h16* W = (h16*)(p.ws + OFF_W);
    if (id < 24) {
        const int j = id / 12, s = id % 12;
        h16* Wbig = W + (size_t)j * (10 * MiB); h16* Wl2 = Wbig + 7 * MiB;
        const float* mix = p.in[3] + j * 6 * 1024;
        J.mode = 1; J.ld = 1024; J.K = 1024; J.ldd = 2048;
        if (s < 3) { J.src = p.in[4] + (size_t)(j * 3 + s) * 1048576; J.N = 1024; J.dst = Wbig + (size_t)s * 1024 * 2048; J.mix = mix + s * 1024; }
        else if (s == 3) { J.src = p.in[6] + (size_t)j * 65536; J.ld = 64; J.N = 64; J.dst = Wbig + (size_t)3072 * 2048; J.mix = mix + 3 * 1024; }
        else if (s == 4) { J.src = p.in[9] + (size_t)j * 65536; J.ld = 64; J.N = 64; J.dst = Wbig + (size_t)3136 * 2048; J.mix = mix + 4 * 1024; }
        else if (s == 5) { J.N = 32; J.dst = Wbig + (size_t)3200 * 2048; if (j == 1) { J.src = p.in[12]; J.ld = 32; J.mix = mix + 2 * 1024; } else { J.mode = 2; } }
        else if (s == 6) { J.src = p.in[14] + (size_t)j * 163840; J.ld = 160; J.N = 160; J.dst = Wbig + (size_t)3232 * 2048; J.mix = mix + 5 * 1024; }
        else if (s == 7) { J.mode = 2; J.N = 192; J.dst = Wbig + (size_t)3392 * 2048; }
        else {
            J.mode = 0; J.ld = 1024; J.N = 1024; J.ldd = 512;
            if (s == 8) { J.src = p.in[7] + (size_t)j * 65536; J.K = 64; J.koff = 0; J.dst = Wl2; }
            else if (s == 9) { J.src = p.in[10] + (size_t)j * 65536; J.K = 64; J.koff = 64; J.dst = Wl2 + (size_t)1024 * 512; }
            else if (s == 10) { J.src = p.in[15] + (size_t)j * 163840; J.K = 160; J.koff = 160; J.dst = Wl2 + (size_t)2048 * 512; }
            else { J.src = p.in[13]; J.K = 32; J.koff = 128; J.dst = Wl2 + (size_t)3072 * 512; if (j == 0) J.N = 0; }
        }
    } else if (id < 26) {
        const int j = id - 24;
        J.src = p.in[21] + (size_t)j * 1048576; J.ld = 1024; J.K = 1024; J.N = 1024; J.dst = W + (size_t)j * (10 * MiB) + 9 * MiB; J.ldd = 1024;
    } else if (id < 34) {
        const int i = (id - 26) >> 1, s = (id - 26) & 1;
        h16* base = W + 20 * MiB + (size_t)i * (17 * MiB / 2);
        if (s == 0) { J.src = p.in[33] + (size_t)i * 1024 * 5632; J.ld = 5632; J.K = 1024; J.N = 5632; J.dst = base; J.ldd = 1024; }
        else { J.src = p.in[36] + (size_t)i * 2816 * 1024; J.ld = 1024; J.K = 2816; J.N = 1024; J.dst = base + (size_t)11 * MiB / 2; J.ldd = 2816; }
    } else {
        const int j = (id - 34) >> 2, s = (id - 34) & 3;
        h16* base = W + 54 * MiB + (size_t)j * (5 * MiB / 2);
        if (s == 0) { J.src = p.in[22] + (size_t)j * 1024 * 456; J.ld = 456; J.K = 1024; J.N = 456; J.dst = base; J.ldd = 1024; }
        else if (s == 1) { J.mode = 2; J.N = 56; J.dst = base + (size_t)456 * 1024; J.ldd = 1024; }
        else if (s == 2) { J.src = p.in[28] + (size_t)j * 256 * 512; J.ld = 512; J.K = 256; J.N = 512; J.dst = base + MiB / 2 + (size_t)2048 * 256; J.ldd = 256; }
        else { J.src = p.in[31] + (size_t)j * 1048576; J.ld = 1024; J.K = 1024; J.N = 1024; J.dst = base + 3 * MiB / 2; J.ldd = 1024; }
    }
    return J;
}
__device__ __forceinline__ h16* w_rwkv_big(unsigned char* ws, int j) { return (h16*)(ws + OFF_W) + (size_t)j * (10 * MiB); }
__device__ __forceinline__ h16* w_rwkv_l2(unsigned char* ws, int j) { return w_rwkv_big(ws, j) + 7 * MiB; }
__device__ __forceinline__ h16* w_rwkv_o(unsigned char* ws, int j) { return w_rwkv_big(ws, j) + 9 * MiB; }
__device__ __forceinline__ h16* w_ffn_up(unsigned char* ws, int i) { return (h16*)(ws + OFF_W) + 20 * MiB + (size_t)i * (17 * MiB / 2); }
__device__ __forceinline__ h16* w_ffn_dn(unsigned char* ws, int i) { return w_ffn_up(ws, i) + (size_t)11 * MiB / 2; }
__device__ __forceinline__ h16* w_dsa_in(unsigned char* ws, int j) { return (h16*)(ws + OFF_W) + 54 * MiB + (size_t)j * (5 * MiB / 2); }
__device__ __forceinline__ h16* w_dsa_q(unsigned char* ws, int j) { return w_dsa_in(ws, j) + MiB / 2; }
__device__ __forceinline__ h16* w_dsa_uvt(unsigned char* ws, int j) { return w_dsa_in(ws, j) + 5 * MiB / 4; }
__device__ __forceinline__ h16* w_dsa_o(unsigned char* ws, int j) { return w_dsa_in(ws, j) + 3 * MiB / 2; }

__device__ __forceinline__ void prep_phase(const Params& p, unsigned char* smem) {
    const int tid = opaque_tid();
    const size_t gtid = (size_t)blockIdx.x * 512 + tid, nth = (size_t)gridDim.x * 512;
    h16* x16 = (h16*)(p.ws + OFF_X16);
    for (size_t idx = gtid; idx < (size_t)MTOK * 128; idx += nth) {
        const int row = (int)(idx >> 7), c8 = (int)(idx & 127) * 8;
        const float* sp = p.in[0] + (size_t)row * 1024 + c8;
        const f32x4 a = *(const f32x4*)sp, b = *(const f32x4*)(sp + 4);
        *(u32x4*)(x16 + xrow(row) * 1024 + c8) = pack8(a, b);
    }
    for (size_t idx = gtid; idx < (size_t)NBATCH * 128; idx += nth) {
        const int b = (int)(idx >> 7), c8 = (int)(idx & 127) * 8;
        unsigned z = 0u; asm volatile("" : "+v"(z));
        *(u32x4*)(x16 + (size_t)b * 2049 * 1024 + c8) = (u32x4){z, z, z, z};
    }
    for (size_t idx = gtid; idx < (size_t)2 * 2048 * 256; idx += nth) {
        const int j = (int)(idx >> 19), rem = (int)(idx & 524287), n = rem >> 8, q = rem & 255, h = n >> 7, c = n & 127;
        const float* uq = p.in[25] + (size_t)j * 256 * 1024 + (size_t)q * 1024 + h * 64;
        const float* uk = p.in[26] + (size_t)j * 16 * 64 * 128 + (size_t)h * 64 * 128 + c;
        float s = 0.f;
        for (int d = 0; d < 64; ++d) s += uq[d] * uk[d * 128];
        w_dsa_q(p.ws, j)[(size_t)n * 256 + q] = (h16)(s * 0.18033688011112042f);
    }
    for (size_t idx = gtid; idx < (size_t)2 * 16 * 64 * 128; idx += nth) {
        const int j = (int)(idx >> 17), rem = (int)(idx & 131071), h = rem >> 13, n = (rem >> 7) & 63, k = rem & 127;
        w_dsa_uvt(p.ws, j)[(size_t)(h * 64 + n) * 128 + k] = (h16)p.in[27][(size_t)((j * 16 + h) * 128 + k) * 64 + n];
    }
    float* tile = (float*)smem;
    for (int id = 0; id < 42; ++id) {
        const TJob J = get_job(p, id);
        const int tk = J.ldd >> 6, tn = (J.N + 63) >> 6, ntile = tk * tn;
        for (int tix = blockIdx.x; tix < ntile; tix += gridDim.x) {
            const int k0 = (tix % tk) * 64, n0 = (tix / tk) * 64;
#pragma unroll
            for (int i = 0; i < 8; ++i) {
                const int k = i * 8 + (tid >> 6), n = tid & 63, kk = k0 + k, nn = n0 + n;
                float v = 0.f;
                if (nn < J.N && J.mode != 2) {
                    if (J.mode == 1) { const int ks = kk & 1023; const float mx = J.mix[ks]; v = J.src[(size_t)ks * J.ld + nn] * (kk < 1024 ? 1.0f - mx : mx); }
                    else if (kk >= J.koff && kk < J.koff + J.K) v = J.src[(size_t)(kk - J.koff) * J.ld + nn];
                }
                tile[k * 65 + n] = v;
            }
            __syncthreads();
#pragma unroll
            for (int i = 0; i < 8; ++i) {
                const int n = i * 8 + (tid >> 6), k = tid & 63, nn = n0 + n;
                if (nn < J.N) J.dst[(size_t)nn * J.ldd + k0 + k] = (h16)tile[k * 65 + n];
            }
            __syncthreads();
        }
    }
}

__device__ __forceinline__ void wave_sum4(float (&v)[4]) {
#pragma unroll
    for (int o = 32; o > 0; o >>= 1) {
        float t[4];
#pragma unroll
        for (int k = 0; k < 4; ++k) t[k] = __shfl_xor(v[k], o);
#pragma unroll
        for (int k = 0; k < 4; ++k) v[k] += t[k];
    }
}
__device__ __forceinline__ void ln_phase(const Params& p, const float* g, const float* b, bool final_out) {
    const int tid = opaque_tid();
    const int lane = tid & 63, wave = tid >> 6;
    float* tb = p.out;
    h16* x16 = (h16*)(p.ws + OFF_X16);
    f32x4 gg[4], bb[4];
#pragma unroll
    for (int i = 0; i < 4; ++i) { gg[i] = *(const f32x4*)(g + i * 256 + lane * 4); bb[i] = *(const f32x4*)(b + i * 256 + lane * 4); }
    for (int rowb = (blockIdx.x * 8 + wave) * 4; rowb < MTOK; rowb += gridDim.x * 32) {
        f32x4 v[4][4];
        float s[4];
#pragma unroll
        for (int k = 0; k < 4; ++k) {
            const float* rp = tb + (size_t)(rowb + k) * 1024;
            s[k] = 0.f;
#pragma unroll
            for (int i = 0; i < 4; ++i) { v[k][i] = *(const f32x4*)(rp + i * 256 + lane * 4); s[k] += (v[k][i][0] + v[k][i][1]) + (v[k][i][2] + v[k][i][3]); }
        }
        wave_sum4(s);
        float q[4];
#pragma unroll
        for (int k = 0; k < 4; ++k) {
            s[k] *= (1.0f / 1024.0f); q[k] = 0.f;
#pragma unroll
            for (int i = 0; i < 4; ++i)
#pragma unroll
                for (int jj = 0; jj < 4; ++jj) { const float d = v[k][i][jj] - s[k]; q[k] += d * d; }
        }
        wave_sum4(q);
#pragma unroll
        for (int k = 0; k < 4; ++k) {
            const float rstd = rsqrtf(q[k] * (1.0f / 1024.0f) + 1e-5f);
            const int row = rowb + k;
#pragma unroll
            for (int i = 0; i < 4; ++i) {
                f32x4 y;
#pragma unroll
                for (int jj = 0; jj < 4; ++jj) y[jj] = (v[k][i][jj] - s[k]) * rstd * gg[i][jj] + bb[i][jj];
                if (final_out) *(f32x4*)(tb + (size_t)row * 1024 + i * 256 + lane * 4) = y;
                else { u32x2 w; w.x = pk2(y[0], y[1]); w.y = pk2(y[2], y[3]); *(u32x2*)(x16 + xrow(row) * 1024 + i * 256 + lane * 4) = w; }
            }
        }
    }
}

__device__ __forceinline__ void conv_phase(const Params& p, int layer) {
    const h16* u = (const h16*)(p.ws + F_U16);
    h16* act = (h16*)(p.ws + F_ACT);
    const float* cw = p.in[34] + (size_t)layer * 3 * 5632;
    const float* cb = p.in[35] + (size_t)layer * 5632;
    const size_t gtid = (size_t)blockIdx.x * 512 + opaque_tid(), nth = (size_t)gridDim.x * 512;
    const size_t ntask = (size_t)2048 * 352;
    for (size_t task = gtid; task < ntask; task += nth) {
        const int cgp = (int)(task % 352), rc = (int)(task / 352), f = cgp * 8, r0 = rc * 16;
        float wg[3][8], wv[3][8], bg[8], bv[8];
#pragma unroll
        for (int jj = 0; jj < 3; ++jj)
#pragma unroll
            for (int hlf = 0; hlf < 2; ++hlf) {
                const f32x4 a = *(const f32x4*)(cw + jj * 5632 + f + hlf * 4), c = *(const f32x4*)(cw + jj * 5632 + DFF + f + hlf * 4);
#pragma unroll
                for (int e = 0; e < 4; ++e) { wg[jj][hlf * 4 + e] = a[e]; wv[jj][hlf * 4 + e] = c[e]; }
            }
#pragma unroll
        for (int hlf = 0; hlf < 2; ++hlf) {
            const f32x4 a = *(const f32x4*)(cb + f + hlf * 4), c = *(const f32x4*)(cb + DFF + f + hlf * 4);
#pragma unroll
            for (int e = 0; e < 4; ++e) { bg[hlf * 4 + e] = a[e]; bv[hlf * 4 + e] = c[e]; }
        }
        float g2[8], g1[8], v2[8], v1[8];
#pragma unroll
        for (int e = 0; e < 8; ++e) { g2[e] = 0.f; g1[e] = 0.f; v2[e] = 0.f; v1[e] = 0.f; }
        if ((r0 & 2047) != 0) {
            unpack8(*(const u32x4*)(u + (size_t)(r0 - 2) * 5632 + f), g2); unpack8(*(const u32x4*)(u + (size_t)(r0 - 1) * 5632 + f), g1);
            unpack8(*(const u32x4*)(u + (size_t)(r0 - 2) * 5632 + DFF + f), v2); unpack8(*(const u32x4*)(u + (size_t)(r0 - 1) * 5632 + DFF + f), v1);
        }
#pragma unroll 1
        for (int i0 = 0; i0 < 16; i0 += 4) {
            u32x4 lg[4], lv[4];
#pragma unroll
            for (int i = 0; i < 4; ++i) { const size_t ro = (size_t)(r0 + i0 + i) * 5632; lg[i] = *(const u32x4*)(u + ro + f); lv[i] = *(const u32x4*)(u + ro + DFF + f); }
#pragma unroll
            for (int i = 0; i < 4; ++i) {
                float g0[8], v0[8], o[8];
                unpack8(lg[i], g0); unpack8(lv[i], v0);
#pragma unroll
                for (int e = 0; e < 8; ++e) {
                    const float G = wg[0][e] * g2[e] + wg[1][e] * g1[e] + wg[2][e] * g0[e] + bg[e];
                    const float V = wv[0][e] * v2[e] + wv[1][e] * v1[e] + wv[2][e] * v0[e] + bv[e];
                    o[e] = G * sigmoidf_(G) * V;
                    g2[e] = g1[e]; g1[e] = g0[e]; v2[e] = v1[e]; v1[e] = v0[e];
                }
                *(u32x4*)(act + (size_t)(r0 + i0 + i) * DFF + f) = pack8((f32x4){o[0], o[1], o[2], o[3]}, (f32x4){o[4], o[5], o[6], o[7]});
            }
        }
    }
}

__device__ __forceinline__ float dppf(float x, const int ctrl_sel) {
    const int v = __builtin_bit_cast(int, x);
    int r;
    if (ctrl_sel == 0) r = __builtin_amdgcn_update_dpp(0, v, 0xB1, 0xF, 0xF, true);
    else if (ctrl_sel == 1) r = __builtin_amdgcn_update_dpp(0, v, 0x4E, 0xF, 0xF, true);
    else if (ctrl_sel == 2) r = __builtin_amdgcn_update_dpp(0, v, 0x141, 0xF, 0xF, true);
    else r = __builtin_amdgcn_update_dpp(0, v, 0x140, 0xF, 0xF, true);
    return __builtin_bit_cast(float, r);
}
__device__ __forceinline__ float red4(float x) { x += dppf(x, 0); x += dppf(x, 1); return x; }
__device__ __forceinline__ float red16(float x) { x += dppf(x, 0); x += dppf(x, 1); x += dppf(x, 2); x += dppf(x, 3); return x; }
__device__ __forceinline__ void unpack4(u32x2 w, float* f) {
    h16x4 h = __builtin_bit_cast(h16x4, w);
#pragma unroll
    for (int i = 0; i < 4; ++i) f[i] = (float)h[i];
}
constexpr int SCAN_BUF = 8256;
__device__ __forceinline__ void scan_phase(const Params& p, int j, unsigned char* smem) {
    const int tid = opaque_tid();
    const int wave = tid >> 6, lane = tid & 63, slot = wave >> 2, w4 = wave & 3;
    float* LB = (float*)smem + slot * (2 * SCAN_BUF);
    h16* r16 = (h16*)(p.ws + R_R16);
    const h16* k16 = (const h16*)(p.ws + R_K16);
    const h16* v16 = (j == 0) ? (const h16*)(p.ws + OFF_VF) : (const h16*)(p.ws + R_V16);
    const h16* g16 = (const h16*)(p.ws + R_G16);
    const h16* e16 = (const h16*)p.out;
    const h16* a16 = (const h16*)p.out + (size_t)MTOK * 1024;
    const int tp = w4 * 4 + (lane >> 4), k4 = (lane & 15) * 4;
    const int vrow = w4 * 16 + (lane >> 2), kq = lane & 3;
    for (int pair = blockIdx.x; pair < 256; pair += gridDim.x) {
        const int chain = pair * 2 + slot, b = chain >> 4, h = chain & 15;
        const int col = h * 64 + k4;
        const f32x4 c_kk = *(const f32x4*)(p.in[16] + j * 1024 + col), c_ka = *(const f32x4*)(p.in[17] + j * 1024 + col), c_rk = *(const f32x4*)(p.in[18] + j * 1024 + col);
        const f32x4 c_lg = *(const f32x4*)(p.in[19] + j * 1024 + col), c_lb = *(const f32x4*)(p.in[20] + j * 1024 + col);
        f32x2 S[8];
#pragma unroll
        for (int i = 0; i < 8; ++i) S[i] = (f32x2){0.f, 0.f};
        u32x2 pr[6];
        {
            const size_t go = ((size_t)(b * 2048 + tp)) * 1024 + col;
            pr[0] = *(const u32x2*)(r16 + go); pr[1] = *(const u32x2*)(k16 + go); pr[2] = *(const u32x2*)(v16 + go);
            pr[3] = *(const u32x2*)(e16 + go); pr[4] = *(const u32x2*)(a16 + go); pr[5] = *(const u32x2*)(g16 + go);
        }
        for (int ch = 0; ch < 128; ++ch) {
            float* BUF = LB + (ch & 1) * SCAN_BUF;
            float* OPS = BUF; float* VB = BUF + 5120; float* GB = BUF + 6144; float* YB = BUF + 7168; float* BON = BUF + 8192;
            {
                float rf[4], kf[4], vf[4], ef[4], af[4], gf[4];
                unpack4(pr[0], rf); unpack4(pr[1], kf); unpack4(pr[2], vf); unpack4(pr[3], ef); unpack4(pr[4], af); unpack4(pr[5], gf);
                float kk[4]; float ss = 0.f;
#pragma unroll
                for (int i = 0; i < 4; ++i) { kk[i] = kf[i] * c_kk[i]; ss += kk[i] * kk[i]; }
                ss = red16(ss);
                const float inv = 1.0f / fmaxf(sqrtf(ss), 1e-12f);
                f32x4 A4, B4, W4, K4, R4; float bs = 0.f;
#pragma unroll
                for (int i = 0; i < 4; ++i) {
                    const float kn = kk[i] * inv;
                    A4[i] = -kn; B4[i] = kn * af[i];
                    W4[i] = __expf(-ef[i]);
                    const float km = kf[i] * (1.0f + (af[i] - 1.0f) * c_ka[i]);
                    K4[i] = km; R4[i] = rf[i];
                    bs += rf[i] * km * c_rk[i];
                }
                bs = red16(bs);
                float* o = OPS + tp * 320 + k4;
                *(f32x4*)(o) = A4; *(f32x4*)(o + 64) = B4; *(f32x4*)(o + 128) = W4; *(f32x4*)(o + 192) = K4; *(f32x4*)(o + 256) = R4;
                *(f32x4*)(VB + tp * 64 + k4) = (f32x4){vf[0], vf[1], vf[2], vf[3]};
                *(f32x4*)(GB + tp * 64 + k4) = (f32x4){gf[0], gf[1], gf[2], gf[3]};
                if ((lane & 15) == 0) BON[tp] = bs;
            }
            if (ch + 1 < 128) {
                const size_t go = ((size_t)(b * 2048 + (ch + 1) * 16 + tp)) * 1024 + col;
                pr[0] = *(const u32x2*)(r16 + go); pr[1] = *(const u32x2*)(k16 + go); pr[2] = *(const u32x2*)(v16 + go);
                pr[3] = *(const u32x2*)(e16 + go); pr[4] = *(const u32x2*)(a16 + go); pr[5] = *(const u32x2*)(g16 + go);
            }
            __syncthreads();
#pragma unroll 2
            for (int t = 0; t < 16; ++t) {
                const float* op = OPS + t * 320 + kq * 16;
                f32x4 A4[4], B4[4], W4[4], K4[4], R4[4];
#pragma unroll
                for (int i = 0; i < 4; ++i) A4[i] = *(const f32x4*)(op + i * 4);
#pragma unroll
                for (int i = 0; i < 4; ++i) { W4[i] = *(const f32x4*)(op + 128 + i * 4); B4[i] = *(const f32x4*)(op + 64 + i * 4); K4[i] = *(const f32x4*)(op + 192 + i * 4); }
#pragma unroll
                for (int i = 0; i < 4; ++i) R4[i] = *(const f32x4*)(op + 256 + i * 4);
                const float vv = VB[t * 64 + vrow];
                f32x2 s0 = {0.f, 0.f}, s1 = {0.f, 0.f};
#pragma unroll
                for (int i = 0; i < 4; ++i) { s0 += S[2 * i] * (f32x2){A4[i][0], A4[i][1]}; s1 += S[2 * i + 1] * (f32x2){A4[i][2], A4[i][3]}; }
                const float sa = red4((s0[0] + s0[1]) + (s1[0] + s1[1]));
                const f32x2 sa2 = {sa, sa}, vv2 = {vv, vv};
#pragma unroll
                for (int i = 0; i < 4; ++i) {
                    S[2 * i] = S[2 * i] * (f32x2){W4[i][0], W4[i][1]} + sa2 * (f32x2){B4[i][0], B4[i][1]} + vv2 * (f32x2){K4[i][0], K4[i][1]};
                    S[2 * i + 1] = S[2 * i + 1] * (f32x2){W4[i][2], W4[i][3]} + sa2 * (f32x2){B4[i][2], B4[i][3]} + vv2 * (f32x2){K4[i][2], K4[i][3]};
                }
                f32x2 y0 = {0.f, 0.f}, y1 = {0.f, 0.f};
#pragma unroll
                for (int i = 0; i < 4; ++i) { y0 += S[2 * i] * (f32x2){R4[i][0], R4[i][1]}; y1 += S[2 * i + 1] * (f32x2){R4[i][2], R4[i][3]}; }
                const float y = red4((y0[0] + y0[1]) + (y1[0] + y1[1]));
                if (kq == 0) YB[t * 64 + vrow] = y;
            }
            __syncthreads();
            {
                const f32x4 y4 = *(const f32x4*)(YB + tp * 64 + k4), v4 = *(const f32x4*)(VB + tp * 64 + k4), g4 = *(const f32x4*)(GB + tp * 64 + k4);
                const float mu = red16((y4[0] + y4[1]) + (y4[2] + y4[3])) * (1.0f / 64.0f);
                float q = 0.f;
#pragma unroll
                for (int i = 0; i < 4; ++i) { const float d = y4[i] - mu; q += d * d; }
                const float rstd = rsqrtf(red16(q) * (1.0f / 64.0f) + 64e-5f);
                const float bon = BON[tp];
                float o[4];
#pragma unroll
                for (int i = 0; i < 4; ++i) o[i] = ((y4[i] - mu) * rstd * c_lg[i] + c_lb[i] + bon * v4[i]) * g4[i];
                u32x2 w; w.x = pk2(o[0], o[1]); w.y = pk2(o[2], o[3]);
                *(u32x2*)(r16 + ((size_t)(b * 2048 + ch * 16 + tp)) * 1024 + col) = w;
            }
        }
        __syncthreads();
    }
}

__device__ __forceinline__ void dsa_norm_phase(const Params& p, int j, unsigned char* smem) {
    const int tid = opaque_tid();
    const int lane = tid & 63, wave = tid >> 6;
    const float* hin = (const float*)(p.ws + D_HIN);
    h16* cq = (h16*)(p.ws + D_CQ); h16* ckv = (h16*)(p.ws + D_CKV); h16* ckvt = (h16*)(p.ws + D_CKVT); h16* kidx = (h16*)(p.ws + D_KIDX);
    float* widx = (float*)(p.ws + D_WIDX);
    const f32x4 gq = *(const f32x4*)(p.in[23] + j * 256 + lane * 4);
    const f32x2 gkv = *(const f32x2*)(p.in[24] + j * 128 + lane * 2);
    const float gi = p.in[29][j * 64 + lane], bi = p.in[30][j * 64 + lane];
    h16* wl = (h16*)(smem + wave * 2048);
    for (int grp = blockIdx.x * 8 + wave; grp < MTOK / 8; grp += gridDim.x * 8) {
        const int r0 = grp * 8;
        for (int i = 0; i < 8; ++i) {
            const int row = r0 + i;
            const float* hp = hin + (size_t)row * 512;
            const f32x4 vq = *(const f32x4*)(hp + lane * 4);
            const f32x2 vk = *(const f32x2*)(hp + 256 + lane * 2);
            const float vi = hp[384 + lane];
            float ssq = wave_sum(vq[0] * vq[0] + vq[1] * vq[1] + vq[2] * vq[2] + vq[3] * vq[3]);
            const float rq = rsqrtf(ssq * (1.0f / 256.0f) + 1e-6f);
            u32x2 w; w.x = pk2(vq[0] * rq * gq[0], vq[1] * rq * gq[1]); w.y = pk2(vq[2] * rq * gq[2], vq[3] * rq * gq[3]);
            *(u32x2*)(cq + (size_t)row * 256 + lane * 4) = w;
            float ssk = wave_sum(vk[0] * vk[0] + vk[1] * vk[1]);
            const float rk = rsqrtf(ssk * (1.0f / 128.0f) + 1e-6f);
            const unsigned wk = pk2(vk[0] * rk * gkv[0], vk[1] * rk * gkv[1]);
            *(unsigned*)(ckv + (size_t)row * 128 + lane * 2) = wk;
            *(unsigned*)(wl + i * 128 + lane * 2) = wk;
            const float mu = wave_sum(vi) * (1.0f / 64.0f);
            const float dv = vi - mu;
            const float var = wave_sum(dv * dv) * (1.0f / 64.0f);
            kidx[(size_t)row * 64 + lane] = (h16)(dv * rsqrtf(var + 1e-5f) * gi + bi);
            if (lane < 8) widx[(size_t)row * 8 + lane] = hp[448 + lane] * 0.044194173824159216f;
        }
        asm volatile("s_waitcnt lgkmcnt(0)" ::: "memory");
        const int b = r0 >> 11, t0 = r0 & 2047;
#pragma unroll
        for (int dd = 0; dd < 2; ++dd) {
            const int d = lane * 2 + dd;
            h16x8 hv;
#pragma unroll
            for (int i = 0; i < 8; ++i) hv[i] = wl[i * 128 + d];
            *(h16x8*)(ckvt + ((size_t)(b * 128 + d)) * 2048 + t0) = hv;
        }
        asm volatile("s_waitcnt lgkmcnt(0)" ::: "memory");
    }
}

constexpr int ROWP = 2052;
__device__ __forceinline__ unsigned fkey(float x) {
    if (x == 0.0f) x = 0.0f;
    const unsigned u = __float_as_uint(x);
    return (u & 0x80000000u) ? ~u : (u | 0x80000000u);
}
__device__ __forceinline__ void dsa_index_phase(const Params& p, unsigned char* smem) {
    const int tid = opaque_tid(), wave = tid >> 6, lane = tid & 63, r = lane & 15, q = lane >> 4;
    float* SC = (float*)smem;
    const h16* qidx = (const h16*)(p.ws + D_QIDX);
    const h16* kidx = (const h16*)(p.ws + D_KIDX);
    const float* widx = (const float*)(p.ws + D_WIDX);
    unsigned* maskb = (unsigned*)(p.ws + D_MASK);
    for (int qi = blockIdx.x, it = 0; qi < MTOK / 16; qi += gridDim.x, ++it) {
        const int qt = (it & 1) ? ((qi & ~127) | (127 - (qi & 127))) : qi;
        const int row0 = qt * 16, b = row0 >> 11, t0 = row0 & 2047;
        const int nkt = (t0 >> 4) + 1;
        {
            h16x8 qf[8][2]; float wq[8];
#pragma unroll
            for (int h = 0; h < 8; ++h) {
#pragma unroll
                for (int kk = 0; kk < 2; ++kk) qf[h][kk] = *(const h16x8*)(qidx + (size_t)(row0 + r) * 512 + h * 64 + kk * 32 + q * 8);
                wq[h] = widx[(size_t)(row0 + r) * 8 + h];
            }
            for (int kt = wave; kt < nkt; kt += 16) {
                const bool two = (kt + 8 < nkt);
                const int s0 = kt * 16, s1 = two ? s0 + 128 : s0;
                const h16* kp = kidx + (size_t)(b * 2048 + s0 + r) * 64 + q * 8;
                const h16* kp1 = kidx + (size_t)(b * 2048 + s1 + r) * 64 + q * 8;
                const h16x8 k0 = *(const h16x8*)kp, k1 = *(const h16x8*)(kp + 32), k2 = *(const h16x8*)kp1, k3 = *(const h16x8*)(kp1 + 32);
                f32x4 sc = {0.f, 0.f, 0.f, 0.f}, sd = {0.f, 0.f, 0.f, 0.f};
#pragma unroll
                for (int h = 0; h < 8; ++h) {
                    f32x4 acc = {0.f, 0.f, 0.f, 0.f}, acd = {0.f, 0.f, 0.f, 0.f};
                    acc = __builtin_amdgcn_mfma_f32_16x16x32_f16(k0, qf[h][0], acc, 0, 0, 0);
                    acd = __builtin_amdgcn_mfma_f32_16x16x32_f16(k2, qf[h][0], acd, 0, 0, 0);
                    acc = __builtin_amdgcn_mfma_f32_16x16x32_f16(k1, qf[h][1], acc, 0, 0, 0);
                    acd = __builtin_amdgcn_mfma_f32_16x16x32_f16(k3, qf[h][1], acd, 0, 0, 0);
#pragma unroll
                    for (int jj = 0; jj < 4; ++jj) { sc[jj] += fmaxf(acc[jj], 0.f) * wq[h]; sd[jj] += fmaxf(acd[jj], 0.f) * wq[h]; }
                }
                *(f32x4*)(SC + r * ROWP + s0 + q * 4) = sc;
                if (two) *(f32x4*)(SC + r * ROWP + s1 + q * 4) = sd;
            }
        }
        __syncthreads();
        for (int qq = 0; qq < 2; ++qq) {
            const int ql = wave * 2 + qq, t = t0 + ql;
            const float* srow = SC + ql * ROWP;
            const int ni = (t >> 6) + 1;
            unsigned u[32];
#pragma unroll
            for (int i = 0; i < 32; ++i) {
                u[i] = 0u;
                if (i < ni) { const int s = i * 64 + lane; if (s <= t) u[i] = fkey(srow[s]); }
            }
            unsigned myw = 0u;
            if (t < 256) {
#pragma unroll
                for (int i = 0; i < 32; ++i) { const unsigned long long sm = __ballot(u[i] != 0u); if ((lane >> 1) == i) myw = (lane & 1) ? (unsigned)(sm >> 32) : (unsigned)sm; }
            } else {
                unsigned T = 0u;
                for (int bit = 31; bit >= 0; --bit) {
                    const unsigned cand = T | (1u << bit);
                    int c0 = 0, c1 = 0;
                    if (ni <= 16) {
#pragma unroll
                        for (int i = 0; i < 16; i += 2) { c0 += (u[i] >= cand) ? 1 : 0; c1 += (u[i + 1] >= cand) ? 1 : 0; }
                    } else {
#pragma unroll
                        for (int i = 0; i < 32; i += 2) { c0 += (u[i] >= cand) ? 1 : 0; c1 += (u[i + 1] >= cand) ? 1 : 0; }
                    }
                    int c = c0 + c1;
                    c += __builtin_amdgcn_update_dpp(0, c, 0xB1, 0xF, 0xF, true);
                    c += __builtin_amdgcn_update_dpp(0, c, 0x4E, 0xF, 0xF, true);
                    c += __builtin_amdgcn_update_dpp(0, c, 0x141, 0xF, 0xF, true);
                    c += __builtin_amdgcn_update_dpp(0, c, 0x140, 0xF, 0xF, true);
                    const int cnt = __builtin_amdgcn_readlane(c, 0) + __builtin_amdgcn_readlane(c, 16) + __builtin_amdgcn_readlane(c, 32) + __builtin_amdgcn_readlane(c, 48);
                    if (cnt >= 256) T = cand;
                }
                int cgt = 0;
#pragma unroll
                for (int i = 0; i < 32; ++i) if (i < ni) cgt += __popcll(__ballot(u[i] > T));
                const int need = 256 - cgt;
                int running = 0;
                const unsigned long long lt = (lane == 0) ? 0ull : (~0ull >> (64 - lane));
#pragma unroll
                for (int i = 0; i < 32; ++i) {
                    if (i < ni) {
                        const unsigned long long eq = __ballot(u[i] == T);
                        const int rank = running + __popcll(eq & lt);
                        const unsigned long long sm = __ballot(u[i] > T || (u[i] == T && rank < need));
                        running += __popcll(eq);
                        if ((lane >> 1) == i) myw = (lane & 1) ? (unsigned)(sm >> 32) : (unsigned)sm;
                    }
                }
            }
            maskb[(size_t)(row0 + ql) * 64 + lane] = myw;
        }
        __syncthreads();
    }
}

constexpr int AT_KROW = 272, AT_VROW = 144, AT_KBYTES = 64 * AT_KROW, AT_VBYTES = 128 * AT_VROW, AT_STAGE = AT_KBYTES + AT_VBYTES, AT_BL = 2 * AT_STAGE, AT_QL = AT_BL + 16 * 132 * 4;
static_assert(AT_QL + 65536 <= LDS_BYTES, "attention LDS");
__device__ __forceinline__ void dsa_attn_phase(const Params& p, int j, unsigned char* smem) {
    const int tid = opaque_tid(), wave = tid >> 6, lane = tid & 63, r = lane & 15, q = lane >> 4;
    float* BL = (float*)(smem + AT_BL);
    for (int idx = tid; idx < 16 * 129; idx += 512) {
        const int h = idx / 129, d = idx % 129;
        int bk = d;
        if (d >= 16) { bk = 16 + (int)(logf((float)d * (1.0f / 16.0f)) / 2.0794415416798357f * 16.0f); bk = bk > 31 ? 31 : bk; }
        BL[h * 132 + d] = p.in[32][bk * 16 + h] * 1.4426950408889634f;
    }
    __syncthreads();
    const h16* qabs = (const h16*)(p.ws + D_QABS);
    const h16* ckv = (const h16*)(p.ws + D_CKV);
    const h16* ckvt = (const h16*)(p.ws + D_CKVT);
    const unsigned* maskb = (const unsigned*)(p.ws + D_MASK);
    h16* o16 = (h16*)(p.ws + D_O16);
    const h16* wuvt = w_dsa_uvt(p.ws, j);
    const float NINF = -__builtin_inff();
    const int krow0 = tid >> 4, kcc = tid & 15, vrow0 = tid >> 3, vcc = tid & 7;
    for (int qi = blockIdx.x, it = 0; qi < MTOK / 16; qi += gridDim.x, ++it) {
        const int qt = (it & 1) ? ((qi & ~127) | (127 - (qi & 127))) : qi;
        const int row0 = qt * 16, b = row0 >> 11, t0 = row0 & 2047, nst = (t0 + 16 + 63) >> 6, tq = t0 + r;
        const h16* kg = ckv + (size_t)(b * 2048) * 128;
        const h16* vg = ckvt + (size_t)(b * 128) * 2048;
        u32x4 sk[2], sv[2];
#pragma unroll
        for (int i = 0; i < 2; ++i) {
            sk[i] = *(const u32x4*)(kg + (size_t)(krow0 + i * 32) * 128 + kcc * 8);
            sv[i] = *(const u32x4*)(vg + (size_t)(vrow0 + i * 64) * 2048 + vcc * 8);
        }
        unsigned char* QL = smem + AT_QL + wave * 8192 + lane * 16;
        {
            h16x8 qtmp[8];
#pragma unroll
            for (int f = 0; f < 8; ++f) qtmp[f] = *(const h16x8*)(qabs + (size_t)(row0 + r) * 2048 + (2 * wave + (f >> 2)) * 128 + (f & 3) * 32 + q * 8);
#pragma unroll
            for (int f = 0; f < 8; ++f) *(h16x8*)(QL + f * 1024) = qtmp[f];
        }
        f32x4 O[2][8];
#pragma unroll
        for (int hh = 0; hh < 2; ++hh)
#pragma unroll
            for (int dt = 0; dt < 8; ++dt) O[hh][dt] = (f32x4){0.f, 0.f, 0.f, 0.f};
        float mrun[2] = {NINF, NINF}, lrun[2] = {0.f, 0.f};
#pragma unroll
        for (int i = 0; i < 2; ++i) {
            *(u32x4*)(smem + (krow0 + i * 32) * AT_KROW + kcc * 16) = sk[i];
            *(u32x4*)(smem + AT_KBYTES + (vrow0 + i * 64) * AT_VROW + vcc * 16) = sv[i];
        }
        u32x2 mwn = *(const u32x2*)(maskb + (size_t)(row0 + r) * 64);
        __syncthreads();
        for (int st = 0; st < nst; ++st) {
            const int s0 = st * 64;
            const unsigned char* Kb = smem + (st & 1) * AT_STAGE;
            const unsigned char* Vb = Kb + AT_KBYTES;
            const u32x2 mw2 = mwn;
            if (st + 1 < nst) mwn = *(const u32x2*)(maskb + (size_t)(row0 + r) * 64 + st * 2 + 2);
            if (st + 1 < nst) {
#pragma unroll
                for (int i = 0; i < 2; ++i) {
                    sk[i] = *(const u32x4*)(kg + (size_t)(s0 + 64 + krow0 + i * 32) * 128 + kcc * 8);
                    sv[i] = *(const u32x4*)(vg + (size_t)(vrow0 + i * 64) * 2048 + s0 + 64 + vcc * 8);
                }
            }
#pragma nounroll
            for (int hf = 0; hf < 2; ++hf) {
                const unsigned mwq = (hf ? mw2.y : mw2.x) >> (q * 4);
                const bool far = (s0 + hf * 32 + 31 + 128 <= t0);
                f32x4 sc[2][2];
                {
                    h16x8 qf[2][4], kf[2][4];
#pragma unroll
                    for (int f = 0; f < 8; ++f) qf[f >> 2][f & 3] = *(const h16x8*)(QL + f * 1024);
#pragma unroll
                    for (int tt = 0; tt < 2; ++tt)
#pragma unroll
                        for (int kk = 0; kk < 4; ++kk) kf[tt][kk] = *(const h16x8*)(Kb + (hf * 32 + tt * 16 + r) * AT_KROW + kk * 64 + q * 16);
                    __builtin_amdgcn_sched_barrier(0);
#pragma unroll
                    for (int tt = 0; tt < 2; ++tt)
#pragma unroll
                        for (int hh = 0; hh < 2; ++hh) {
                            f32x4 acc = {0.f, 0.f, 0.f, 0.f};
#pragma unroll
                            for (int kk = 0; kk < 4; ++kk) acc = __builtin_amdgcn_mfma_f32_16x16x32_f16(kf[tt][kk], qf[hh][kk], acc, 0, 0, 0);
                            sc[hh][tt] = acc;
                        }
                    __builtin_amdgcn_sched_barrier(0);
                }
                h16x4 vlo[8], vhi[8];
#pragma unroll
                for (int dt = 0; dt < 4; ++dt) {
                    const unsigned char* vp = Vb + (dt * 16 + r) * AT_VROW + (hf * 32 + q * 4) * 2;
                    vlo[dt] = *(const h16x4*)vp; vhi[dt] = *(const h16x4*)(vp + 32);
                }
                __builtin_amdgcn_sched_barrier(0);
                h16x8 pf[2]; float alpha[2];
#pragma unroll
                for (int hh = 0; hh < 2; ++hh) {
                    const int h = 2 * wave + hh;
                    float x[8]; float mx = NINF;
                    if (far) {
                        const float cb = BL[h * 132 + 128];
#pragma unroll
                        for (int tt = 0; tt < 2; ++tt)
#pragma unroll
                            for (int jj = 0; jj < 4; ++jj) {
                                const float xv = ((mwq >> (tt * 16 + jj)) & 1u) ? sc[hh][tt][jj] + cb : NINF;
                                x[tt * 4 + jj] = xv; mx = fmaxf(mx, xv);
                            }
                    } else {
#pragma unroll
                        for (int tt = 0; tt < 2; ++tt)
#pragma unroll
                            for (int jj = 0; jj < 4; ++jj) {
                                const int kix = tt * 16 + q * 4 + jj;
                                int dist = tq - (s0 + hf * 32 + kix); dist = dist < 0 ? 0 : (dist > 128 ? 128 : dist);
                                const float v = sc[hh][tt][jj] + BL[h * 132 + dist];
                                const float xv = ((mwq >> (tt * 16 + jj)) & 1u) ? v : NINF;
                                x[tt * 4 + jj] = xv; mx = fmaxf(mx, xv);
                            }
                    }
                    mx = fmaxf(mx, __shfl_xor(mx, 16)); mx = fmaxf(mx, __shfl_xor(mx, 32));
                    const float mnew = fmaxf(mrun[hh], mx);
                    const float mref = (mnew == NINF) ? 0.f : mnew;
                    alpha[hh] = __builtin_amdgcn_exp2f(mrun[hh] - mref);
                    mrun[hh] = mnew;
                    float ps = 0.f;
#pragma unroll
                    for (int i = 0; i < 8; ++i) { const float pv = __builtin_amdgcn_exp2f(x[i] - mref); ps += pv; pf[hh][i] = (h16)pv; }
                    lrun[hh] = lrun[hh] * alpha[hh] + ps;
                }
                __builtin_amdgcn_sched_barrier(0);
#pragma unroll
                for (int dt = 4; dt < 8; ++dt) {
                    const unsigned char* vp = Vb + (dt * 16 + r) * AT_VROW + (hf * 32 + q * 4) * 2;
                    vlo[dt] = *(const h16x4*)vp; vhi[dt] = *(const h16x4*)(vp + 32);
                }
                const bool resc = __ballot(alpha[0] != 1.0f || alpha[1] != 1.0f) != 0ull;
                if (resc) {
#pragma unroll
                    for (int dt = 0; dt < 8; ++dt) { O[0][dt] *= alpha[0]; O[1][dt] *= alpha[1]; }
                }
#pragma unroll
                for (int dt = 0; dt < 8; ++dt) {
                    const h16x8 vf = {vlo[dt][0], vlo[dt][1], vlo[dt][2], vlo[dt][3], vhi[dt][0], vhi[dt][1], vhi[dt][2], vhi[dt][3]};
#pragma unroll
                    for (int hh = 0; hh < 2; ++hh) O[hh][dt] = __builtin_amdgcn_mfma_f32_16x16x32_f16(vf, pf[hh], O[hh][dt], 0, 0, 0);
                }
                __builtin_amdgcn_sched_barrier(0);
            }
            if (st + 1 < nst) {
                unsigned char* Kn = smem + ((st + 1) & 1) * AT_STAGE;
#pragma unroll
                for (int i = 0; i < 2; ++i) {
                    *(u32x4*)(Kn + (krow0 + i * 32) * AT_KROW + kcc * 16) = sk[i];
                    *(u32x4*)(Kn + AT_KBYTES + (vrow0 + i * 64) * AT_VROW + vcc * 16) = sv[i];
                }
            }
            __syncthreads();
        }
#pragma unroll
        for (int hh = 0; hh < 2; ++hh) {
            const int h = 2 * wave + hh;
            float lt = lrun[hh]; lt += __shfl_xor(lt, 16); lt += __shfl_xor(lt, 32);
            const float inv = 1.0f / lt;
            h16x8 b8[4];
#pragma unroll
            for (int kk = 0; kk < 4; ++kk)
#pragma unroll
                for (int i = 0; i < 4; ++i) { b8[kk][i] = (h16)(O[hh][2 * kk][i] * inv); b8[kk][4 + i] = (h16)(O[hh][2 * kk + 1][i] * inv); }
#pragma unroll
            for (int vp2 = 0; vp2 < 2; ++vp2) {
                h16x4 alo[2][4], ahi[2][4];
#pragma unroll
                for (int v2 = 0; v2 < 2; ++v2)
#pragma unroll
                    for (int kk = 0; kk < 4; ++kk) {
                        const h16* ap = wuvt + (size_t)(h * 64 + (vp2 * 2 + v2) * 16 + r) * 128 + kk * 32 + q * 4;
                        alo[v2][kk] = *(const h16x4*)ap; ahi[v2][kk] = *(const h16x4*)(ap + 16);
                    }
                __builtin_amdgcn_sched_barrier(0);
#pragma unroll
                for (int v2 = 0; v2 < 2; ++v2) {
                    const int vt = vp2 * 2 + v2;
                    f32x4 acc = {0.f, 0.f, 0.f, 0.f};
#pragma unroll
                    for (int kk = 0; kk < 4; ++kk) {
                        const h16x8 a8 = {alo[v2][kk][0], alo[v2][kk][1], alo[v2][kk][2], alo[v2][kk][3], ahi[v2][kk][0], ahi[v2][kk][1], ahi[v2][kk][2], ahi[v2][kk][3]};
                        acc = __builtin_amdgcn_mfma_f32_16x16x32_f16(a8, b8[kk], acc, 0, 0, 0);
                    }
                    u32x2 w; w.x = pk2(acc[0], acc[1]); w.y = pk2(acc[2], acc[3]);
                    *(u32x2*)(o16 + (size_t)(row0 + r) * 1024 + h * 64 + vt * 16 + q * 4) = w;
                }
                __builtin_amdgcn_sched_barrier(0);
            }
            __builtin_amdgcn_sched_barrier(0);
        }
    }
    __syncthreads();
}

constexpr size_t OFF_BAR = 951 * MiB;
__device__ __forceinline__ void grid_bar(unsigned* ctr, unsigned& target, unsigned nblk) {
    asm volatile("s_waitcnt vmcnt(0) lgkmcnt(0)" ::: "memory");
    __syncthreads();
    target += nblk;
    if (threadIdx.x == 0) {
        __builtin_amdgcn_fence(__ATOMIC_RELEASE, "agent");
        asm volatile("s_waitcnt vmcnt(0)" ::: "memory");
        __hip_atomic_fetch_add(ctr, 1u, __ATOMIC_RELAXED, __HIP_MEMORY_SCOPE_AGENT);
        while (__hip_atomic_load(ctr, __ATOMIC_RELAXED, __HIP_MEMORY_SCOPE_AGENT) < target) __builtin_amdgcn_s_sleep(1);
        __builtin_amdgcn_fence(__ATOMIC_ACQUIRE, "agent");
        asm volatile("s_waitcnt vmcnt(0)" ::: "memory");
    }
    __syncthreads();
}

__global__ void __launch_bounds__(512) mega_fwd(Params p) {
    extern __shared__ __attribute__((aligned(16))) unsigned char smem[];
    cg::grid_group grid = cg::this_grid();
    unsigned char* ws = p.ws;
    h16* x16 = (h16*)(ws + OFF_X16);
    unsigned* barctr = (unsigned*)(ws + OFF_BAR);
    unsigned bar_target = 0u;
    for (int ph = p.ph_lo; ph < p.ph_hi; ++ph) {
        const unsigned e = p.prog[ph];
        const int kind = e & 15, L = (e >> 4) & 3, sub = (e >> 6) & 1, j = L >> 1;
        const int nrep = 1 + (int)(e >> 7);
        for (int rep = 0; rep < nrep; ++rep) {
        if (rep) grid_bar(barctr, bar_target, gridDim.x);
        const bool isgemm = (kind == K_R1 || kind == K_R2 || kind == K_R4 || kind == K_F1 || kind == K_F3 || kind == K_D1 || kind == K_D3 || kind == K_D6);
        if (isgemm) {
            pg8::Gemm g; pg8::Epi E;
            g.M = MTOK; g.N = 1024; g.K = 1024; g.lda = 1024; g.amode = 0; g.pm0 = 0; g.A = x16; g.Bt = x16;
            E.mode = E_RESID; E.pm0 = 0; E.j = j; E.ws = ws; E.out = p.out; E.bias0 = p.in[5] + j * 1024; E.bias1 = p.in[8] + j * 1024; E.bias2 = p.in[11];
            if (kind == K_R1) {
                g.Bt = w_rwkv_big(ws, j); g.N = 3584; g.K = 2048; g.amode = 1; E.mode = E_RPROJ;
            } else if (kind == K_R2) {
                g.A = (const h16*)(ws + R_HACT); g.Bt = w_rwkv_l2(ws, j); g.N = (j == 0) ? 3072 : 4096; g.K = 512; g.lda = 512; E.mode = E_LORA2;
            } else if (kind == K_R4) {
                g.A = (const h16*)(ws + R_R16); g.Bt = w_rwkv_o(ws, j);
            } else if (kind == K_F1) {
                g.Bt = w_ffn_up(ws, L); g.M = MTOK / 2; g.N = 5632; g.amode = 1; g.pm0 = sub * 128; E.mode = E_ST16;
            } else if (kind == K_F3) {
                g.A = (const h16*)(ws + F_ACT); g.Bt = w_ffn_dn(ws, L); g.M = MTOK / 2; g.K = 2816; g.lda = 2816; E.pm0 = sub * 128;
            } else if (kind == K_D1) {
                g.Bt = w_dsa_in(ws, j); g.N = 512; g.amode = 1; E.mode = E_ST32;
            } else if (kind == K_D3) {
                g.A = (const h16*)(ws + D_CQ); g.Bt = w_dsa_q(ws, j); g.N = 2560; g.K = 256; g.lda = 256; E.mode = E_QPROJ;
            } else {
                g.A = (const h16*)(ws + D_O16); g.Bt = w_dsa_o(ws, j);
            }
            pg8::StaticOrder S; S.init(g.M, g.N, (int)gridDim.x, (int)blockIdx.x);
#ifndef NO_GEMM
            pg8::gemm_phase((LAS unsigned char*)smem, g, S, E);
#endif
        } else if (kind == K_PREP) {
#ifndef NO_PREP
            prep_phase(p, smem);
#endif
        } else if (kind == K_R3) {
#ifndef NO_SCAN
            scan_phase(p, j, smem);
#endif
        } else if (kind == K_LN) {
#ifndef NO_LN
            ln_phase(p, p.in[1] + (L * 2 + sub) * 1024, p.in[2] + (L * 2 + sub) * 1024, L == 3 && sub == 1);
#endif
        } else if (kind == K_F2) {
#ifndef NO_CONV
            conv_phase(p, L);
#endif
        } else if (kind == K_D2) {
#ifndef NO_NORM
            dsa_norm_phase(p, j, smem);
#endif
        } else if (kind == K_D4) {
#ifndef NO_INDEX
            dsa_index_phase(p, smem);
#endif
        } else if (kind == K_D5) {
#ifndef NO_ATTN
            dsa_attn_phase(p, j, smem);
#endif
        }
        }
        if (ph + 1 < p.ph_hi) { if (ph == p.ph_lo) grid.sync(); else grid_bar(barctr, bar_target, gridDim.x); for (int xs = 0; xs < EXTRA_SYNC; ++xs) grid_bar(barctr, bar_target, gridDim.x); }
    }
}

extern "C" void kernel_launch(void* const* d_in, const int* in_sizes, int n_in, void* d_out, int out_size, void* d_ws, size_t ws_size, hipStream_t stream) {
    static int grid_blocks = 0;
    if (grid_blocks == 0) {
        if (n_in != 37 || ws_size < WS_NEED || out_size != MTOK * DM) { fprintf(stderr, "kernel_launch: unexpected problem (n_in %d ws %zu out %d)\n", n_in, ws_size, out_size); grid_blocks = -1; return; }
        int dev = 0, cus = 0, per_cu = 0;
        hipGetDevice(&dev);
        hipDeviceGetAttribute(&cus, hipDeviceAttributeMultiprocessorCount, dev);
        if (hipFuncSetAttribute((const void*)mega_fwd, hipFuncAttributeMaxDynamicSharedMemorySize, LDS_BYTES) != hipSuccess) { fprintf(stderr, "kernel_launch: hipFuncSetAttribute failed\n"); grid_blocks = -1; return; }
        hipOccupancyMaxActiveBlocksPerMultiprocessor(&per_cu, (const void*)mega_fwd, 512, LDS_BYTES);
        if (per_cu < 1) { fprintf(stderr, "kernel_launch: occupancy query says %d blocks/CU\n", per_cu); per_cu = 1; }
        (void)hipGetLastError();
        grid_blocks = cus * per_cu;
        fprintf(stderr, "kernel_launch: grid %d (cus %d x %d)\n", grid_blocks, cus, per_cu);
    }
    if (grid_blocks < 0) return;
    Params p{};
    for (int i = 0; i < 37; ++i) p.in[i] = (const float*)d_in[i];
    p.ws = (unsigned char*)d_ws; p.out = (float*)d_out;
    int np = 0;
    constexpr unsigned PROBE_MASK = 0u;
    auto add = [&](int kind, int L, int sub) { p.prog[np++] = (unsigned char)(kind | (L << 4) | (sub << 6) | ((((PROBE_MASK >> kind) & 1u) && !(kind == K_LN && L == 3 && sub == 1)) ? 128 : 0)); };
    add(K_PREP, 0, 0);
    for (int L = 0; L < 4; ++L) {
        if ((L & 1) == 0) { add(K_R1, L, 0); add(K_R2, L, 0); add(K_R3, L, 0); add(K_R4, L, 0); }
        else { add(K_D1, L, 0); add(K_D2, L, 0); add(K_D3, L, 0); add(K_D4, L, 0); add(K_D5, L, 0); add(K_D6, L, 0); }
        add(K_LN, L, 0);
        for (int c = 0; c < 2; ++c) { add(K_F1, L, c); add(K_F2, L, c); add(K_F3, L, c); }
        add(K_LN, L, 1);
    }
#if SINGLE_LAUNCH
    if (hipMemsetAsync((unsigned char*)d_ws + OFF_BAR, 0, 256, stream) != hipSuccess) { fprintf(stderr, "kernel_launch: memset failed\n"); return; }
    p.ph_lo = 0; p.ph_hi = np;
    void* args[] = {&p};
    hipError_t e = hipLaunchCooperativeKernel((const void*)mega_fwd, dim3(grid_blocks), dim3(512), args, LDS_BYTES, stream);
    if (e != hipSuccess) fprintf(stderr, "cooperative launch failed: %s (grid %d)\n", hipGetErrorString(e), grid_blocks);
#else
    for (int ph = 0; ph < np; ++ph) {
        p.ph_lo = ph; p.ph_hi = ph + 1;
        hipLaunchKernelGGL(mega_fwd, dim3(grid_blocks), dim3(512), LDS_BYTES, stream, p);
    }
#endif
}
```

```cpp
#include <hip/hip_runtime.h>
#include <hip/hip_cooperative_groups.h>
#include <cstdio>
namespace cg = cooperative_groups;

constexpr int EXTRA_SYNC = 0;
#ifndef SINGLE_LAUNCH
#define SINGLE_LAUNCH 1
#endif

#define LAS __attribute__((address_space(3)))
typedef _Float16 h16;
typedef _Float16 h16x8 __attribute__((ext_vector_type(8)));
typedef _Float16 h16x4 __attribute__((ext_vector_type(4)));
typedef _Float16 h16x2 __attribute__((ext_vector_type(2)));
typedef float f32x4 __attribute__((ext_vector_type(4)));
typedef float f32x2 __attribute__((ext_vector_type(2)));
typedef unsigned u32x4 __attribute__((ext_vector_type(4)));
typedef unsigned u32x2 __attribute__((ext_vector_type(2)));

constexpr int DM = 1024, SEQ = 2048, NBATCH = 32, MTOK = NBATCH * SEQ;
constexpr int DFF = 2816;
constexpr size_t MiB = (size_t)1 << 20;
constexpr float DN_ALPHA = 1.6817928305074290f;
constexpr int LDS_BYTES = 147456;

constexpr size_t OFF_W = 0;
constexpr size_t OFF_X16 = 118 * MiB;
constexpr size_t OFF_VF = 247 * MiB;
constexpr size_t OFF_R = 375 * MiB;
constexpr size_t WS_NEED = 952 * MiB;
constexpr size_t R_R16 = OFF_R, R_K16 = OFF_R + 128 * MiB, R_V16 = OFF_R + 256 * MiB, R_G16 = OFF_R + 384 * MiB, R_HACT = OFF_R + 512 * MiB;
constexpr size_t F_U16 = OFF_R, F_ACT = OFF_R + 352 * MiB;
constexpr size_t D_HIN = OFF_R, D_O16 = OFF_R, D_QABS = OFF_R + 128 * MiB, D_QIDX = OFF_R + 384 * MiB, D_CQ = OFF_R + 448 * MiB,
                 D_CKV = OFF_R + 480 * MiB, D_CKVT = OFF_R + 496 * MiB, D_KIDX = OFF_R + 512 * MiB, D_WIDX = OFF_R + 520 * MiB, D_MASK = OFF_R + 522 * MiB;

struct Params {
    const float* in[37];
    unsigned char* ws;
    float* out;
    int ph_lo, ph_hi;
    unsigned char prog[64];
};

enum { K_PREP = 0, K_R1, K_R2, K_R3, K_R4, K_LN, K_F1, K_F2, K_F3, K_D1, K_D2, K_D3, K_D4, K_D5, K_D6, K_R0 };
enum { E_RPROJ = 0, E_LORA2, E_RESID, E_ST16, E_ST32, E_QPROJ };

__device__ __forceinline__ size_t xrow(int row) { return (size_t)(row >> 11) * 2049 + 1 + (row & 2047); }
__device__ __forceinline__ unsigned pk2(float a, float b) { h16x2 h = {(h16)a, (h16)b}; return __builtin_bit_cast(unsigned, h); }
__device__ __forceinline__ u32x4 pack8(f32x4 a, f32x4 b) { u32x4 w; w.x = pk2(a[0], a[1]); w.y = pk2(a[2], a[3]); w.z = pk2(b[0], b[1]); w.w = pk2(b[2], b[3]); return w; }
__device__ __forceinline__ void unpack8(u32x4 w, float* f) {
    h16x8 h = __builtin_bit_cast(h16x8, w);
#pragma unroll
    for (int i = 0; i < 8; ++i) f[i] = (float)h[i];
}
__device__ __forceinline__ float sigmoidf_(float x) { return 1.0f / (1.0f + __expf(-x)); }
__device__ __forceinline__ float wave_sum(float v) {
#pragma unroll
    for (int o = 32; o > 0; o >>= 1) v += __shfl_xor(v, o);
    return v;
}
#define WSYNC() asm volatile("s_waitcnt vmcnt(0) lgkmcnt(0)" ::: "memory")
__device__ __forceinline__ int opaque_tid() { int t = threadIdx.x; asm volatile("" : "+v"(t)); return t; }

namespace pg8 {
constexpr int BM = 256, BK = 64, HALF = 128, HTB = HALF * BK * 2, STAGE_BYTES = 8 * HTB, NXCD = 8, WGM = 8;
__device__ __forceinline__ int lds_byte(int r, int c) { const int st = (r >> 4) * 2 + (c >> 5), rr = r & 15, cc = c & 31, ob = rr * 64 + cc * 2; return st * 1024 + (ob ^ (((ob >> 9) & 1) << 5)); }
__device__ __forceinline__ void stage_rc(int b, int& R, int& C) { const int st = b / 1024, sb = b % 1024, swz = sb ^ (((sb >> 9) & 1) << 5); R = (st >> 1) * 16 + swz / 64; C = (st & 1) * 32 + (swz % 64) / 2; }
__device__ __forceinline__ int perm32(int rho) { const int n = rho >> 4, i = rho & 15; return 8 * (i >> 2) + 4 * n + (i & 3); }
struct Unit { int pm, pn; };
struct Gemm { const h16* A; const h16* A2; const h16* Bt; int M, N, K, lda, amode, pm0; };
struct StaticOrder {
    int nM, nN, nwg, G, c;
    __device__ void init(int M, int N, int G_, int c_) { nM = M / BM; nN = N / BM; nwg = nM * nN; G = G_; c = c_; }
    __device__ bool next(int i, Unit& u) const {
        const long L = (long)i * G + c; if (L >= nwg) return false;
        int wgid = (int)L; { const int q = nwg / NXCD, r = nwg % NXCD, xcd = wgid % NXCD, off = wgid / NXCD; wgid = (xcd < r ? xcd * (q + 1) : r * (q + 1) + (xcd - r) * q) + off; }
        const int nig = WGM * nN, gid = wgid / nig, fm = gid * WGM, gsz = (nM - fm) < WGM ? (nM - fm) : WGM;
        u.pm = fm + ((wgid % nig) % gsz); u.pn = (wgid % nig) / gsz; return true;
    }
};

struct Epi {
    int mode, pm0, j, pnoff;
    unsigned char* ws; float* out; const float* bias0; const float* bias1; const float* bias2;
    __device__ __forceinline__ void operator()(const f32x4 (&acc)[2][2][4][2], const Unit& u, int wr, int wc, int fr, int fq) const {
        const int rowl0 = u.pm * BM + wr * 64 + fr;
        const int colt = u.pn * BM + wc * 32 + 8 * fq;
        if (mode == E_RESID) {
            u32x4 xr[2][4][2];
#pragma unroll
            for (int ai = 0; ai < 2; ++ai)
#pragma unroll
                for (int m = 0; m < 4; ++m) {
                    const int rowg = rowl0 + ai * HALF + m * 16 + pm0 * BM;
                    const h16* xp = (const h16*)(ws + OFF_X16) + xrow(rowg) * 1024 + colt;
#pragma unroll
                    for (int bj = 0; bj < 2; ++bj) xr[ai][m][bj] = *(const u32x4*)(xp + bj * HALF);
                }
#pragma unroll
            for (int ai = 0; ai < 2; ++ai)
#pragma unroll
                for (int m = 0; m < 4; ++m) {
                    const int rowg = rowl0 + ai * HALF + m * 16 + pm0 * BM;
                    float* dp0 = out + (size_t)rowg * 1024 + colt;
#pragma unroll
                    for (int bj = 0; bj < 2; ++bj) {
                        float xf[8]; unpack8(xr[ai][m][bj], xf);
                        const f32x4 v0 = acc[ai][bj][m][0], v1 = acc[ai][bj][m][1];
                        f32x4 r0, r1;
#pragma unroll
                        for (int jj = 0; jj < 4; ++jj) { r0[jj] = DN_ALPHA * xf[jj] + v0[jj]; r1[jj] = DN_ALPHA * xf[4 + jj] + v1[jj]; }
                        float* dp = dp0 + bj * HALF;
                        *(f32x4*)dp = r0; *(f32x4*)(dp + 4) = r1;
                    }
                }
            return;
        }
        if (mode == E_LORA2 && (u.pn >> 2) == 3) {
            const int c0 = colt & 1023;
#pragma unroll
            for (int ai = 0; ai < 2; ++ai) {
                u32x4 lv[4][2], lf[4][2];
#pragma unroll
                for (int m = 0; m < 4; ++m) {
                    const size_t off = (size_t)(rowl0 + ai * HALF + m * 16 + pm0 * BM) * 1024 + c0;
#pragma unroll
                    for (int bj = 0; bj < 2; ++bj) { lv[m][bj] = *(const u32x4*)((const h16*)(ws + R_V16) + off + bj * HALF); lf[m][bj] = *(const u32x4*)((const h16*)(ws + OFF_VF) + off + bj * HALF); }
                }
#pragma unroll
                for (int m = 0; m < 4; ++m) {
                    const size_t off = (size_t)(rowl0 + ai * HALF + m * 16 + pm0 * BM) * 1024 + c0;
#pragma unroll
                    for (int bj = 0; bj < 2; ++bj) {
                        const int c = c0 + bj * HALF;
                        const f32x4 ba = *(const f32x4*)(bias2 + c), bb = *(const f32x4*)(bias2 + c + 4);
                        float vv[8], vf8[8]; unpack8(lv[m][bj], vv); unpack8(lf[m][bj], vf8);
                        f32x4 v0 = acc[ai][bj][m][0], v1 = acc[ai][bj][m][1];
#pragma unroll
                        for (int jj = 0; jj < 4; ++jj) {
                            v0[jj] = vv[jj] + (vf8[jj] - vv[jj]) * sigmoidf_(v0[jj] + ba[jj]);
                            v1[jj] = vv[4 + jj] + (vf8[4 + jj] - vv[4 + jj]) * sigmoidf_(v1[jj] + bb[jj]);
                        }
                        *(u32x4*)((h16*)(ws + R_V16) + off + bj * HALF) = pack8(v0, v1);
                    }
                }
            }
            return;
        }
#pragma unroll
        for (int ai = 0; ai < 2; ++ai)
#pragma unroll
            for (int m = 0; m < 4; ++m) {
                const int rowl = rowl0 + ai * HALF + m * 16;
                const int rowg = rowl + pm0 * BM;
#pragma unroll
                for (int bj = 0; bj < 2; ++bj) {
                    const int col = colt + bj * HALF;
                    f32x4 v0 = acc[ai][bj][m][0], v1 = acc[ai][bj][m][1];
                    if (mode == E_RPROJ) {
                        if (pnoff == 0) {
                            h16* dst = (h16*)(ws + (u.pn < 4 ? R_R16 : (u.pn < 8 ? R_K16 : (j == 0 ? OFF_VF : R_V16))));
                            *(u32x4*)(dst + (size_t)rowg * 1024 + (col & 1023)) = pack8(v0, v1);
                        } else if (col < 384) {
                            const int hc = col;
                            if (hc < 64) {
#pragma unroll
                                for (int jj = 0; jj < 4; ++jj) { v0[jj] = tanhf(v0[jj]); v1[jj] = tanhf(v1[jj]); }
                            } else if (hc >= 160) {
#pragma unroll
                                for (int jj = 0; jj < 4; ++jj) { v0[jj] = sigmoidf_(v0[jj]); v1[jj] = sigmoidf_(v1[jj]); }
                            }
                            *(u32x4*)((h16*)(ws + R_HACT) + (size_t)rowg * 384 + hc) = pack8(v0, v1);
                        }
                    } else if (mode == E_LORA2) {
                        const int grp = u.pn >> 2, c = col & 1023;
                        const size_t off = (size_t)rowg * 1024 + c;
                        if (grp == 0) {
                            const f32x4 ba = *(const f32x4*)(bias0 + c), bb = *(const f32x4*)(bias0 + c + 4);
#pragma unroll
                            for (int jj = 0; jj < 4; ++jj) { v0[jj] = sigmoidf_(v0[jj] + ba[jj]) * 0.6065306597f; v1[jj] = sigmoidf_(v1[jj] + bb[jj]) * 0.6065306597f; }
                            *(u32x4*)((h16*)out + off) = pack8(v0, v1);
                        } else if (grp == 1) {
                            const f32x4 ba = *(const f32x4*)(bias1 + c), bb = *(const f32x4*)(bias1 + c + 4);
#pragma unroll
                            for (int jj = 0; jj < 4; ++jj) { v0[jj] = sigmoidf_(v0[jj] + ba[jj]); v1[jj] = sigmoidf_(v1[jj] + bb[jj]); }
                            *(u32x4*)((h16*)out + (size_t)MTOK * 1024 + off) = pack8(v0, v1);
                        } else {
                            *(u32x4*)((h16*)(ws + R_G16) + off) = pack8(v0, v1);
                        }
                    } else if (mode == E_ST16) {
                        *(u32x4*)((h16*)(ws + F_U16) + (size_t)rowl * 5632 + col) = pack8(v0, v1);
                    } else if (mode == E_ST32) {
                        float* dp = (float*)(ws + D_HIN) + (size_t)rowg * 512 + col;
                        *(f32x4*)dp = v0; *(f32x4*)(dp + 4) = v1;
                    } else {
                        if (u.pn < 8) *(u32x4*)((h16*)(ws + D_QABS) + (size_t)rowg * 2048 + col) = pack8(v0, v1);
                        else *(u32x4*)((h16*)(ws + D_QIDX) + (size_t)rowg * 512 + (col - 2048)) = pack8(v0, v1);
                    }
                }
            }
    }
};

__device__ __forceinline__ const char* a_tile(const Gemm& g, int pm, int pn) {
    if (g.amode == 1) { const int row = (pm + g.pm0) * BM; return (const char*)g.A + xrow(row) * 2048; }
    if (g.amode == 2) {
        const int gq = pn >> 2;
        const char* base = gq == 2 ? (const char*)g.A2 : (const char*)g.A + (size_t)gq * ((size_t)MTOK * 1024 * 2);
        return base + (size_t)pm * BM * 2048;
    }
    return (const char*)g.A + (size_t)pm * BM * g.lda * 2;
}

__device__ __forceinline__ void gemm_phase(LAS unsigned char* lds, const Gemm g, const StaticOrder& S, const Epi& E) {
    const int tid = opaque_tid(), wid = __builtin_amdgcn_readfirstlane(tid >> 6), lane = tid & 63, wr = wid >> 2, wc = wid & 3, fr = lane & 15, fq = lane >> 4;
    const int K = g.K, nt = K / BK;
    const bool shiftA = (g.amode == 1);
    unsigned voffA[2], voffB[2];
#pragma unroll
    for (int i = 0; i < 2; ++i) { int R, C; stage_rc(tid * 16 + i * 8192, R, C); const int Rb = (R & ~31) + perm32(R & 31);
        voffA[i] = (unsigned)(R * g.lda + C) * 2u; voffB[i] = (unsigned)(Rb * K + C) * 2u; }
    const size_t kstep = (size_t)(BK * 2);
    const size_t hstepA = (size_t)HALF * g.lda * 2;
    const size_t hstepB = (size_t)HALF * K * 2;
    const size_t tstepB = 2 * hstepB;
    const unsigned ldsw = (unsigned)wid * 1024u;
    const int aoff = lds_byte(wr * 64 + fr, fq * 8), boff = lds_byte(wc * 32 + fr, fq * 8);
#define PG8_KOFF(kt) ((size_t)(kt) * kstep - ((shiftA && (kt) >= 16) ? (size_t)4096 : (size_t)0))
#define PG8_SA(b, h) (((b) * 2 + (h)) * HTB)
#define PG8_SB(b, h) ((4 + (b) * 2 + (h)) * HTB)
#define PG8_STAGE(bufoff, gbase, voff) do { _Pragma("unroll") for (int _i = 0; _i < 2; ++_i) \
        __builtin_amdgcn_global_load_lds((const unsigned*)((const char*)(gbase) + (voff)[_i]), (LAS unsigned*)(lds + (bufoff) + ldsw + _i * 8192), 16, 0, 0); } while (0)
#define PG8_LDA(dst, b, h) do { _Pragma("unroll") for (int m = 0; m < 4; ++m) _Pragma("unroll") for (int k = 0; k < 2; ++k) dst[m][k] = *(const LAS h16x8*)(lds + PG8_SA(b, h) + aoff + m * 2048 + k * 1024); } while (0)
#define PG8_LDB(dst, b, h) do { _Pragma("unroll") for (int n = 0; n < 2; ++n) _Pragma("unroll") for (int k = 0; k < 2; ++k) dst[n][k] = *(const LAS h16x8*)(lds + PG8_SB(b, h) + boff + n * 2048 + k * 1024); } while (0)
#define PG8_MMA(ai, bj, At, Bt) do { __builtin_amdgcn_s_setprio(1); _Pragma("unroll") for (int m = 0; m < 4; ++m) _Pragma("unroll") for (int n = 0; n < 2; ++n) _Pragma("unroll") for (int k = 0; k < 2; ++k) \
        acc[ai][bj][m][n] = __builtin_amdgcn_mfma_f32_16x16x32_f16(Bt[n][k], At[m][k], acc[ai][bj][m][n], 0, 0, 0); __builtin_amdgcn_s_setprio(0); } while (0)
#define PG8_WAIT_V(n) asm volatile("s_waitcnt vmcnt(" #n ")" ::: "memory")
#define PG8_WAIT_L(n) asm volatile("s_waitcnt lgkmcnt(" #n ")" ::: "memory")
#define PG8_BAR __builtin_amdgcn_s_barrier()
#define PG8_SCHED __builtin_amdgcn_sched_barrier(0)
    Unit cur, nxt; int ui = 0;
    if (!S.next(0, cur)) return;
    f32x4 acc[2][2][4][2];
#pragma unroll
    for (int a = 0; a < 2; ++a)
#pragma unroll
        for (int b = 0; b < 2; ++b)
#pragma unroll
            for (int m = 0; m < 4; ++m)
#pragma unroll
                for (int n = 0; n < 2; ++n) acc[a][b][m][n] = (f32x4){0.f, 0.f, 0.f, 0.f};
    h16x8 At[4][2], B0[2][2], B1[2][2];
    const char* cA = a_tile(g, cur.pm, cur.pn); const char* cB = (const char*)g.Bt + (size_t)cur.pn * tstepB;
    PG8_STAGE(PG8_SB(0, 0), cB, voffB); PG8_STAGE(PG8_SA(0, 0), cA, voffA); PG8_STAGE(PG8_SB(0, 1), cB + hstepB, voffB); PG8_STAGE(PG8_SA(0, 1), cA + hstepA, voffA);
    if (wr == 1) PG8_BAR;
    PG8_WAIT_V(4); PG8_BAR;
    PG8_STAGE(PG8_SB(1, 0), cB + kstep, voffB); PG8_STAGE(PG8_SA(1, 0), cA + kstep, voffA); PG8_STAGE(PG8_SB(1, 1), cB + hstepB + kstep, voffB);
    PG8_WAIT_V(6); PG8_BAR;
    for (;;) {
        const bool has_next = S.next(ui + 1, nxt);
        const char* nA = has_next ? a_tile(g, nxt.pm, nxt.pn) : cA; const char* nB = has_next ? (const char*)g.Bt + (size_t)nxt.pn * tstepB : cB;
        for (int t = 0; t < nt; t += 2) {
            const bool last = (t == nt - 2);
            const char* a1 = cA + PG8_KOFF(t + 1);
            const char* a2 = last ? nA : cA + PG8_KOFF(t + 2); const char* b2 = last ? nB : cB + (size_t)(t + 2) * kstep;
            const char* a3 = a2 + kstep; const char* b3 = b2 + kstep;
            PG8_LDB(B0, 0, 0); PG8_SCHED; PG8_LDA(At, 0, 0); PG8_STAGE(PG8_SA(1, 1), a1 + hstepA, voffA);
            PG8_WAIT_L(8); PG8_BAR; PG8_WAIT_L(0); PG8_MMA(0, 0, At, B0); PG8_BAR; PG8_SCHED;
            PG8_LDB(B1, 0, 1); PG8_STAGE(PG8_SB(0, 0), b2, voffB);
            PG8_BAR; PG8_WAIT_L(0); PG8_MMA(0, 1, At, B1); PG8_BAR;
            PG8_LDA(At, 0, 1); PG8_STAGE(PG8_SA(0, 0), a2, voffA);
            PG8_BAR; PG8_WAIT_L(0); PG8_MMA(1, 0, At, B0); PG8_BAR; PG8_SCHED;
            PG8_STAGE(PG8_SB(0, 1), b2 + hstepB, voffB);
            PG8_WAIT_V(6); PG8_BAR; PG8_MMA(1, 1, At, B1); PG8_BAR;
            PG8_LDB(B0, 1, 0); PG8_SCHED; PG8_LDA(At, 1, 0); PG8_STAGE(PG8_SA(0, 1), a2 + hstepA, voffA);
            PG8_WAIT_L(8); PG8_BAR; PG8_WAIT_L(0); PG8_MMA(0, 0, At, B0); PG8_BAR; PG8_SCHED;
            PG8_LDB(B1, 1, 1); PG8_STAGE(PG8_SB(1, 0), b3, voffB);
            PG8_BAR; PG8_WAIT_L(0); PG8_MMA(0, 1, At, B1); PG8_BAR;
            PG8_LDA(At, 1, 1); PG8_STAGE(PG8_SA(1, 0), a3, voffA);
            PG8_BAR; PG8_WAIT_L(0); PG8_MMA(1, 0, At, B0); PG8_BAR; PG8_SCHED;
            PG8_STAGE(PG8_SB(1, 1), b3 + hstepB, voffB);
            PG8_WAIT_V(6); PG8_BAR; PG8_MMA(1, 1, At, B1); PG8_BAR;
        }
        E(acc, cur, wr, wc, fr, fq);
        if (!has_next) break;
#pragma unroll
        for (int a = 0; a < 2; ++a)
#pragma unroll
            for (int b = 0; b < 2; ++b)
#pragma unroll
                for (int m = 0; m < 4; ++m)
#pragma unroll
                    for (int n = 0; n < 2; ++n) acc[a][b][m][n] = (f32x4){0.f, 0.f, 0.f, 0.f};
        cur = nxt; cA = nA; cB = nB; ++ui;
    }
    PG8_WAIT_V(0);
    if (wr == 0) PG8_BAR;
    PG8_BAR;
#undef PG8_KOFF
#undef PG8_SA
#undef PG8_SB
#undef PG8_STAGE
#undef PG8_LDA
#undef PG8_LDB
#undef PG8_MMA
#undef PG8_WAIT_V
#undef PG8_WAIT_L
#undef PG8_BAR
#undef PG8_SCHED
}
}

struct TJob { int mode; const float* src; int ld, K, N; h16* dst; int ldd, koff; const float* mix; };

__device__ __forceinline__ TJob get_job(const Params& p, int id) {
    TJob J; J.mode = 0; J.src = nullptr; J.ld = 0; J.K = 0; J.N = 0; J.dst = nullptr; J.ldd = 64; J.koff = 0; J.mix = nullptr;
    h16* W = (h16*)(p.ws + OFF_W);
    if (id < 24) {
        const int j = id / 12, s = id % 12;
        h16* Wrkv = W + (size_t)j * (10 * MiB); h16* Wl1 = Wrkv + 3 * MiB; h16* Wl2 = Wrkv + 7 * MiB;
        const float* mix = p.in[3] + j * 6 * 1024;
        if (s < 3) { J.mode = 0; J.src = p.in[4] + (size_t)(j * 3 + s) * 1048576; J.ld = 1024; J.K = 1024; J.N = 1024; J.dst = Wrkv + (size_t)s * 1024 * 1024; J.ldd = 1024; }
        else if (s < 8) {
            J.mode = 1; J.ld = 1024; J.K = 1024; J.ldd = 2048;
            if (s == 3) { J.src = p.in[6] + (size_t)j * 65536; J.ld = 64; J.N = 64; J.dst = Wl1; J.mix = mix + 3 * 1024; }
            else if (s == 4) { J.src = p.in[9] + (size_t)j * 65536; J.ld = 64; J.N = 64; J.dst = Wl1 + (size_t)64 * 2048; J.mix = mix + 4 * 1024; }
            else if (s == 5) { J.N = 32; J.dst = Wl1 + (size_t)128 * 2048; if (j == 1) { J.src = p.in[12]; J.ld = 32; J.mix = mix + 2 * 1024; } else { J.mode = 2; } }
            else if (s == 6) { J.src = p.in[14] + (size_t)j * 163840; J.ld = 160; J.N = 160; J.dst = Wl1 + (size_t)160 * 2048; J.mix = mix + 5 * 1024; }
            else { J.mode = 2; J.N = 192; J.dst = Wl1 + (size_t)320 * 2048; }
        } else {
            J.mode = 0; J.ld = 1024; J.N = 1024; J.ldd = 384;
            if (s == 8) { J.src = p.in[7] + (size_t)j * 65536; J.K = 64; J.koff = 0; J.dst = Wl2; }
            else if (s == 9) { J.src = p.in[10] + (size_t)j * 65536; J.K = 64; J.koff = 64; J.dst = Wl2 + (size_t)1024 * 384; }
            else if (s == 10) { J.src = p.in[15] + (size_t)j * 163840; J.K = 160; J.koff = 160; J.dst = Wl2 + (size_t)2048 * 384; }
            else { J.src = p.in[13]; J.K = 32; J.koff = 128; J.dst = Wl2 + (size_t)3072 * 384; if (j == 0) J.N = 0; }
        }
    } else if (id < 26) {
        const int j = id - 24;
        J.src = p.in[21] + (size_t)j * 1048576; J.ld = 1024; J.K = 1024; J.N = 1024; J.dst = W + (size_t)j * (10 * MiB) + 9 * MiB; J.ldd = 1024;
    } else if (id < 34) {
        const int i = (id - 26) >> 1, s = (id - 26) & 1;
        h16* base = W + 20 * MiB + (size_t)i * (17 * MiB / 2);
        if (s == 0) { J.src = p.in[33] + (size_t)i * 1024 * 5632; J.ld = 5632; J.K = 1024; J.N = 5632; J.dst = base; J.ldd = 1024; }
        else { J.src = p.in[36] + (size_t)i * 2816 * 1024; J.ld = 1024; J.K = 2816; J.N = 1024; J.dst = base + (size_t)11 * MiB / 2; J.ldd = 2816; }
    } else {
        const int j = (id - 34) >> 2, s = (id - 34) & 3;
        h16* base = W + 54 * MiB + (size_t)j * (5 * MiB / 2);
        if (s == 0) { J.src = p.in[22] + (size_t)j * 1024 * 456; J.ld = 456; J.K = 1024; J.N = 456; J.dst = base; J.ldd = 1024; }
        else if (s == 1) { J.mode = 2; J.N = 56; J.dst = base + (size_t)456 * 1024; J.ldd = 1024; }
        else if (s == 2) { J.src = p.in[28] + (size_t)j * 256 * 512; J.ld = 512; J.K = 256; J.N = 512; J.dst = base + MiB / 2 + (size_t)2048 * 256; J.ldd = 256; }
        else { J.src = p.in[31] + (size_t)j * 1048576; J.ld = 1024; J.K = 1024; J.N = 1024; J.dst = base + 3 * MiB / 2; J.ldd = 1024; }
    }
    return J;
}
__device__ __forceinline__ h16* w_rwkv_big(unsigned char* ws, int j) { return (h16*)(ws + OFF_W) + (size_t)j * (10 * MiB); }
__device__ __forceinline__ h16* w_rwkv_l1(unsigned char* ws, int j) { return w_rwkv_big(ws, j) + 3 * MiB; }
__device__ __forceinline__ h16* w_rwkv_l2(unsigned char* ws, int j) { return w_rwkv_big(ws, j) + 7 * MiB; }
__device__ __forceinline__ h16* w_rwkv_o(unsigned char* ws, int j) { return w_rwkv_big(ws, j) + 9 * MiB; }
__device__ __forceinline__ h16* w_ffn_up(unsigned char* ws, int i) { return (h16*)(ws + OFF_W) + 20 * MiB + (size_t)i * (17 * MiB / 2); }
__device__ __forceinline__ h16* w_ffn_dn(unsigned char* ws, int i) { return w_ffn_up(ws, i) + (size_t)11 * MiB / 2; }
__device__ __forceinline__ h16* w_dsa_in(unsigned char* ws, int j) { return (h16*)(ws + OFF_W) + 54 * MiB + (size_t)j * (5 * MiB / 2); }
__device__ __forceinline__ h16* w_dsa_q(unsigned char* ws, int j) { return w_dsa_in(ws, j) + MiB / 2; }
__device__ __forceinline__ h16* w_dsa_uvt(unsigned char* ws, int j) { return w_dsa_in(ws, j) + 5 * MiB / 4; }
__device__ __forceinline__ h16* w_dsa_o(unsigned char* ws, int j) { return w_dsa_in(ws, j) + 3 * MiB / 2; }

__device__ __forceinline__ void prep_phase(const Params& p, unsigned char* smem) {
    const int tid = opaque_tid();
    const size_t gtid = (size_t)blockIdx.x * 512 + tid, nth = (size_t)gridDim.x * 512;
    h16* x16 = (h16*)(p.ws + OFF_X16);
    for (size_t idx = gtid; idx < (size_t)MTOK * 128; idx += nth) {
        const int row = (int)(idx >> 7), c8 = (int)(idx & 127) * 8;
        const float* sp = p.in[0] + (size_t)row * 1024 + c8;
        const f32x4 a = *(const f32x4*)sp, b = *(const f32x4*)(sp + 4);
        *(u32x4*)(x16 + xrow(row) * 1024 + c8) = pack8(a, b);
    }
    for (size_t idx = gtid; idx < (size_t)NBATCH * 128; idx += nth) {
        const int b = (int)(idx >> 7), c8 = (int)(idx & 127) * 8;
        unsigned z = 0u; asm volatile("" : "+v"(z));
        *(u32x4*)(x16 + (size_t)b * 2049 * 1024 + c8) = (u32x4){z, z, z, z};
    }
    for (size_t idx = gtid; idx < (size_t)2 * 2048 * 256; idx += nth) {
        const int j = (int)(idx >> 19), rem = (int)(idx & 524287), n = rem >> 8, q = rem & 255, h = n >> 7, c = n & 127;
        const float* uq = p.in[25] + (size_t)j * 256 * 1024 + (size_t)q * 1024 + h * 64;
        const float* uk = p.in[26] + (size_t)j * 16 * 64 * 128 + (size_t)h * 64 * 128 + c;
        float s = 0.f;
        for (int d = 0; d < 64; ++d) s += uq[d] * uk[d * 128];
        w_dsa_q(p.ws, j)[(size_t)n * 256 + q] = (h16)(s * 0.18033688011112042f);
    }
    for (size_t idx = gtid; idx < (size_t)2 * 16 * 64 * 128; idx += nth) {
        const int j = (int)(idx >> 17), rem = (int)(idx & 131071), h = rem >> 13, n = (rem >> 7) & 63, k = rem & 127;
        w_dsa_uvt(p.ws, j)[(size_t)(h * 64 + n) * 128 + k] = (h16)p.in[27][(size_t)((j * 16 + h) * 128 + k) * 64 + n];
    }
    float* tile = (float*)smem;
    for (int id = 0; id < 42; ++id) {
        const TJob J = get_job(p, id);
        const int tk = J.ldd >> 6, tn = (J.N + 63) >> 6, ntile = tk * tn;
        for (int tix = blockIdx.x; tix < ntile; tix += gridDim.x) {
            const int k0 = (tix % tk) * 64, n0 = (tix / tk) * 64;
#pragma unroll
            for (int i = 0; i < 8; ++i) {
                const int k = i * 8 + (tid >> 6), n = tid & 63, kk = k0 + k, nn = n0 + n;
                float v = 0.f;
                if (nn < J.N && J.mode != 2) {
                    if (J.mode == 1) { const int ks = kk & 1023; const float mx = J.mix[ks]; v = J.src[(size_t)ks * J.ld + nn] * (kk < 1024 ? 1.0f - mx : mx); }
                    else if (kk >= J.koff && kk < J.koff + J.K) v = J.src[(size_t)(kk - J.koff) * J.ld + nn];
                }
                tile[k * 65 + n] = v;
            }
            __syncthreads();
#pragma unroll
            for (int i = 0; i < 8; ++i) {
                const int n = i * 8 + (tid >> 6), k = tid & 63, nn = n0 + n;
                if (nn < J.N) J.dst[(size_t)nn * J.ldd + k0 + k] = (h16)tile[k * 65 + n];
            }
            __syncthreads();
        }
    }
}

__device__ __forceinline__ void wave_sum4(float (&v)[4]) {
#pragma unroll
    for (int o = 32; o > 0; o >>= 1) {
        float t[4];
#pragma unroll
        for (int k = 0; k < 4; ++k) t[k] = __shfl_xor(v[k], o);
#pragma unroll
        for (int k = 0; k < 4; ++k) v[k] += t[k];
    }
}
__device__ __forceinline__ void ln_phase(const Params& p, const float* g, const float* b, bool final_out) {
    const int tid = opaque_tid();
    const int lane = tid & 63, wave = tid >> 6;
    float* tb = p.out;
    h16* x16 = (h16*)(p.ws + OFF_X16);
    f32x4 gg[4], bb[4];
#pragma unroll
    for (int i = 0; i < 4; ++i) { gg[i] = *(const f32x4*)(g + i * 256 + lane * 4); bb[i] = *(const f32x4*)(b + i * 256 + lane * 4); }
    for (int rowb = (blockIdx.x * 8 + wave) * 4; rowb < MTOK; rowb += gridDim.x * 32) {
        f32x4 v[4][4];
        float s[4];
#pragma unroll
        for (int k = 0; k < 4; ++k) {
            const float* rp = tb + (size_t)(rowb + k) * 1024;
            s[k] = 0.f;
#pragma unroll
            for (int i = 0; i < 4; ++i) { v[k][i] = *(const f32x4*)(rp + i * 256 + lane * 4); s[k] += (v[k][i][0] + v[k][i][1]) + (v[k][i][2] + v[k][i][3]); }
        }
        wave_sum4(s);
        float q[4];
#pragma unroll
        for (int k = 0; k < 4; ++k) {
            s[k] *= (1.0f / 1024.0f); q[k] = 0.f;
#pragma unroll
            for (int i = 0; i < 4; ++i)
#pragma unroll
                for (int jj = 0; jj < 4; ++jj) { const float d = v[k][i][jj] - s[k]; q[k] += d * d; }
        }
        wave_sum4(q);
#pragma unroll
        for (int k = 0; k < 4; ++k) {
            const float rstd = rsqrtf(q[k] * (1.0f / 1024.0f) + 1e-5f);
            const int row = rowb + k;
#pragma unroll
            for (int i = 0; i < 4; ++i) {
                f32x4 y;
#pragma unroll
                for (int jj = 0; jj < 4; ++jj) y[jj] = (v[k][i][jj] - s[k]) * rstd * gg[i][jj] + bb[i][jj];
                if (final_out) *(f32x4*)(tb + (size_t)row * 1024 + i * 256 + lane * 4) = y;
                else { u32x2 w; w.x = pk2(y[0], y[1]); w.y = pk2(y[2], y[3]); *(u32x2*)(x16 + xrow(row) * 1024 + i * 256 + lane * 4) = w; }
            }
        }
    }
}

__device__ __forceinline__ void conv_phase(const Params& p, int layer) {
    const h16* u = (const h16*)(p.ws + F_U16);
    h16* act = (h16*)(p.ws + F_ACT);
    const float* cw = p.in[34] + (size_t)layer * 3 * 5632;
    const float* cb = p.in[35] + (size_t)layer * 5632;
    const size_t gtid = (size_t)blockIdx.x * 512 + opaque_tid(), nth = (size_t)gridDim.x * 512;
    const size_t ntask = (size_t)2048 * 352;
    for (size_t task = gtid; task < ntask; task += nth) {
        const int cgp = (int)(task % 352), rc = (int)(task / 352), f = cgp * 8, r0 = rc * 16;
        float wg[3][8], wv[3][8], bg[8], bv[8];
#pragma unroll
        for (int jj = 0; jj < 3; ++jj)
#pragma unroll
            for (int hlf = 0; hlf < 2; ++hlf) {
                const f32x4 a = *(const f32x4*)(cw + jj * 5632 + f + hlf * 4), c = *(const f32x4*)(cw + jj * 5632 + DFF + f + hlf * 4);
#pragma unroll
                for (int e = 0; e < 4; ++e) { wg[jj][hlf * 4 + e] = a[e]; wv[jj][hlf * 4 + e] = c[e]; }
            }
#pragma unroll
        for (int hlf = 0; hlf < 2; ++hlf) {
            const f32x4 a = *(const f32x4*)(cb + f + hlf * 4), c = *(const f32x4*)(cb + DFF + f + hlf * 4);
#pragma unroll
            for (int e = 0; e < 4; ++e) { bg[hlf * 4 + e] = a[e]; bv[hlf * 4 + e] = c[e]; }
        }
        float g2[8], g1[8], v2[8], v1[8];
#pragma unroll
        for (int e = 0; e < 8; ++e) { g2[e] = 0.f; g1[e] = 0.f; v2[e] = 0.f; v1[e] = 0.f; }
        if ((r0 & 2047) != 0) {
            unpack8(*(const u32x4*)(u + (size_t)(r0 - 2) * 5632 + f), g2); unpack8(*(const u32x4*)(u + (size_t)(r0 - 1) * 5632 + f), g1);
            unpack8(*(const u32x4*)(u + (size_t)(r0 - 2) * 5632 + DFF + f), v2); unpack8(*(const u32x4*)(u + (size_t)(r0 - 1) * 5632 + DFF + f), v1);
        }
#pragma unroll 1
        for (int i0 = 0; i0 < 16; i0 += 4) {
            u32x4 lg[4], lv[4];
#pragma unroll
            for (int i = 0; i < 4; ++i) { const size_t ro = (size_t)(r0 + i0 + i) * 5632; lg[i] = *(const u32x4*)(u + ro + f); lv[i] = *(const u32x4*)(u + ro + DFF + f); }
#pragma unroll
            for (int i = 0; i < 4; ++i) {
                float g0[8], v0[8], o[8];
                unpack8(lg[i], g0); unpack8(lv[i], v0);
#pragma unroll
                for (int e = 0; e < 8; ++e) {
                    const float G = wg[0][e] * g2[e] + wg[1][e] * g1[e] + wg[2][e] * g0[e] + bg[e];
                    const float V = wv[0][e] * v2[e] + wv[1][e] * v1[e] + wv[2][e] * v0[e] + bv[e];
                    o[e] = G * sigmoidf_(G) * V;
                    g2[e] = g1[e]; g1[e] = g0[e]; v2[e] = v1[e]; v1[e] = v0[e];
                }
                *(u32x4*)(act + (size_t)(r0 + i0 + i) * DFF + f) = pack8((f32x4){o[0], o[1], o[2], o[3]}, (f32x4){o[4], o[5], o[6], o[7]});
            }
        }
    }
}

__device__ __forceinline__ void mix_phase(const Params& p, int j) {
    const h16* x16 = (const h16*)(p.ws + OFF_X16);
    h16* xr = (h16*)p.out; h16* xk = (h16*)p.out + (size_t)MTOK * 1024; h16* xv = (h16*)(p.ws + R_G16);
    const float* mix = p.in[3] + j * 6 * 1024;
    const size_t gtid = (size_t)blockIdx.x * 512 + opaque_tid(), nth = (size_t)gridDim.x * 512;
    for (size_t idx = gtid; idx < (size_t)MTOK * 128; idx += nth) {
        const int row = (int)(idx >> 7), c8 = (int)(idx & 127) * 8;
        const h16* xp = x16 + xrow(row) * 1024 + c8;
        float xc[8], xq[8];
        unpack8(*(const u32x4*)xp, xc); unpack8(*(const u32x4*)(xp - 1024), xq);
#pragma unroll
        for (int e = 0; e < 8; ++e) xq[e] -= xc[e];
        const size_t o = (size_t)row * 1024 + c8;
#pragma unroll
        for (int bsel = 0; bsel < 3; ++bsel) {
            const f32x4 m0 = *(const f32x4*)(mix + bsel * 1024 + c8), m1 = *(const f32x4*)(mix + bsel * 1024 + c8 + 4);
            f32x4 a, b;
#pragma unroll
            for (int e = 0; e < 4; ++e) { a[e] = xc[e] + xq[e] * m0[e]; b[e] = xc[4 + e] + xq[4 + e] * m1[e]; }
            h16* dst = bsel == 0 ? xr : (bsel == 1 ? xk : xv);
            *(u32x4*)(dst + o) = pack8(a, b);
        }
    }
}

__device__ __forceinline__ float dppf(float x, const int ctrl_sel) {
    const int v = __builtin_bit_cast(int, x);
    int r;
    if (ctrl_sel == 0) r = __builtin_amdgcn_update_dpp(0, v, 0xB1, 0xF, 0xF, true);
    else if (ctrl_sel == 1) r = __builtin_amdgcn_update_dpp(0, v, 0x4E, 0xF, 0xF, true);
    else if (ctrl_sel == 2) r = __builtin_amdgcn_update_dpp(0, v, 0x141, 0xF, 0xF, true);
    else r = __builtin_amdgcn_update_dpp(0, v, 0x140, 0xF, 0xF, true);
    return __builtin_bit_cast(float, r);
}
__device__ __forceinline__ float red4(float x) { x += dppf(x, 0); x += dppf(x, 1); return x; }
__device__ __forceinline__ float red16(float x) { x += dppf(x, 0); x += dppf(x, 1); x += dppf(x, 2); x += dppf(x, 3); return x; }
__device__ __forceinline__ void unpack4(u32x2 w, float* f) {
    h16x4 h = __builtin_bit_cast(h16x4, w);
#pragma unroll
    for (int i = 0; i < 4; ++i) f[i] = (float)h[i];
}
constexpr int SCAN_BUF = 8256;
__device__ __forceinline__ void scan_phase(const Params& p, int j, unsigned char* smem) {
    const int tid = opaque_tid();
    const int wave = tid >> 6, lane = tid & 63, slot = wave >> 2, w4 = wave & 3;
    float* LB = (float*)smem + slot * (2 * SCAN_BUF);
    const h16* r16 = (const h16*)(p.ws + R_R16);
    const h16* k16 = (const h16*)(p.ws + R_K16);
    const h16* v16 = (j == 0) ? (const h16*)(p.ws + OFF_VF) : (const h16*)(p.ws + R_V16);
    const h16* g16 = (const h16*)(p.ws + R_G16);
    const h16* e16 = (const h16*)p.out;
    const h16* a16 = (const h16*)p.out + (size_t)MTOK * 1024;
    h16* y16 = (h16*)(p.ws + (j == 0 ? R_V16 : OFF_VF));
    const int tp = w4 * 4 + (lane >> 4), k4 = (lane & 15) * 4;
    const int vrow = w4 * 16 + (lane >> 2), kq = lane & 3;
    for (int pair = blockIdx.x; pair < 256; pair += gridDim.x) {
        const int chain = pair * 2 + slot, b = chain >> 4, h = chain & 15;
        const int col = h * 64 + k4;
        const f32x4 c_kk = *(const f32x4*)(p.in[16] + j * 1024 + col), c_ka = *(const f32x4*)(p.in[17] + j * 1024 + col), c_rk = *(const f32x4*)(p.in[18] + j * 1024 + col);
        const f32x4 c_lg = *(const f32x4*)(p.in[19] + j * 1024 + col), c_lb = *(const f32x4*)(p.in[20] + j * 1024 + col);
        f32x2 S[8];
#pragma unroll
        for (int i = 0; i < 8; ++i) S[i] = (f32x2){0.f, 0.f};
        u32x2 pr[6];
        {
            const size_t go = ((size_t)(b * 2048 + tp)) * 1024 + col;
            pr[0] = *(const u32x2*)(r16 + go); pr[1] = *(const u32x2*)(k16 + go); pr[2] = *(const u32x2*)(v16 + go);
            pr[3] = *(const u32x2*)(e16 + go); pr[4] = *(const u32x2*)(a16 + go); pr[5] = *(const u32x2*)(g16 + go);
        }
        for (int ch = 0; ch < 128; ++ch) {
            float* BUF = LB + (ch & 1) * SCAN_BUF;
            float* OPS = BUF; float* VB = BUF + 5120; float* GB = BUF + 6144; float* YB = BUF + 7168; float* BON = BUF + 8192;
            {
                float rf[4], kf[4], vf[4], ef[4], af[4], gf[4];
                unpack4(pr[0], rf); unpack4(pr[1], kf); unpack4(pr[2], vf); unpack4(pr[3], ef); unpack4(pr[4], af); unpack4(pr[5], gf);
                float kk[4]; float ss = 0.f;
#pragma unroll
                for (int i = 0; i < 4; ++i) { kk[i] = kf[i] * c_kk[i]; ss += kk[i] * kk[i]; }
                ss = red16(ss);
                const float inv = 1.0f / fmaxf(sqrtf(ss), 1e-12f);
                f32x4 A4, B4, W4, K4, R4; float bs = 0.f;
#pragma unroll
                for (int i = 0; i < 4; ++i) {
                    const float kn = kk[i] * inv;
                    A4[i] = -kn; B4[i] = kn * af[i];
                    W4[i] = __expf(-ef[i]);
                    const float km = kf[i] * (1.0f + (af[i] - 1.0f) * c_ka[i]);
                    K4[i] = km; R4[i] = rf[i];
                    bs += rf[i] * km * c_rk[i];
                }
                bs = red16(bs);
                float* o = OPS + tp * 320 + k4;
                *(f32x4*)(o) = A4; *(f32x4*)(o + 64) = B4; *(f32x4*)(o + 128) = W4; *(f32x4*)(o + 192) = K4; *(f32x4*)(o + 256) = R4;
                *(f32x4*)(VB + tp * 64 + k4) = (f32x4){vf[0], vf[1], vf[2], vf[3]};
                *(f32x4*)(GB + tp * 64 + k4) = (f32x4){gf[0], gf[1], gf[2], gf[3]};
                if ((lane & 15) == 0) BON[tp] = bs;
            }
            if (ch + 1 < 128) {
                const size_t go = ((size_t)(b * 2048 + (ch + 1) * 16 + tp)) * 1024 + col;
                pr[0] = *(const u32x2*)(r16 + go); pr[1] = *(const u32x2*)(k16 + go); pr[2] = *(const u32x2*)(v16 + go);
                pr[3] = *(const u32x2*)(e16 + go); pr[4] = *(const u32x2*)(a16 + go); pr[5] = *(const u32x2*)(g16 + go);
            }
            __syncthreads();
#pragma unroll 2
            for (int t = 0; t < 16; ++t) {
                const float* op = OPS + t * 320 + kq * 16;
                f32x4 A4[4], B4[4], W4[4], K4[4], R4[4];
#pragma unroll
                for (int i = 0; i < 4; ++i) A4[i] = *(const f32x4*)(op + i * 4);
#pragma unroll
                for (int i = 0; i < 4; ++i) { W4[i] = *(const f32x4*)(op + 128 + i * 4); B4[i] = *(const f32x4*)(op + 64 + i * 4); K4[i] = *(const f32x4*)(op + 192 + i * 4); }
#pragma unroll
                for (int i = 0; i < 4; ++i) R4[i] = *(const f32x4*)(op + 256 + i * 4);
                const float vv = VB[t * 64 + vrow];
                f32x2 s0 = {0.f, 0.f}, s1 = {0.f, 0.f};
#pragma unroll
                for (int i = 0; i < 4; ++i) { s0 += S[2 * i] * (f32x2){A4[i][0], A4[i][1]}; s1 += S[2 * i + 1] * (f32x2){A4[i][2], A4[i][3]}; }
                const float sa = red4((s0[0] + s0[1]) + (s1[0] + s1[1]));
                const f32x2 sa2 = {sa, sa}, vv2 = {vv, vv};
#pragma unroll
                for (int i = 0; i < 4; ++i) {
                    S[2 * i] = S[2 * i] * (f32x2){W4[i][0], W4[i][1]} + sa2 * (f32x2){B4[i][0], B4[i][1]} + vv2 * (f32x2){K4[i][0], K4[i][1]};
                    S[2 * i + 1] = S[2 * i + 1] * (f32x2){W4[i][2], W4[i][3]} + sa2 * (f32x2){B4[i][2], B4[i][3]} + vv2 * (f32x2){K4[i][2], K4[i][3]};
                }
                f32x2 y0 = {0.f, 0.f}, y1 = {0.f, 0.f};
#pragma unroll
                for (int i = 0; i < 4; ++i) { y0 += S[2 * i] * (f32x2){R4[i][0], R4[i][1]}; y1 += S[2 * i + 1] * (f32x2){R4[i][2], R4[i][3]}; }
                const float y = red4((y0[0] + y0[1]) + (y1[0] + y1[1]));
                if (kq == 0) YB[t * 64 + vrow] = y;
            }
            __syncthreads();
            {
                const f32x4 y4 = *(const f32x4*)(YB + tp * 64 + k4), v4 = *(const f32x4*)(VB + tp * 64 + k4), g4 = *(const f32x4*)(GB + tp * 64 + k4);
                const float mu = red16((y4[0] + y4[1]) + (y4[2] + y4[3])) * (1.0f / 64.0f);
                float q = 0.f;
#pragma unroll
                for (int i = 0; i < 4; ++i) { const float d = y4[i] - mu; q += d * d; }
                const float rstd = rsqrtf(red16(q) * (1.0f / 64.0f) + 64e-5f);
                const float bon = BON[tp];
                float o[4];
#pragma unroll
                for (int i = 0; i < 4; ++i) o[i] = ((y4[i] - mu) * rstd * c_lg[i] + c_lb[i] + bon * v4[i]) * g4[i];
                u32x2 w; w.x = pk2(o[0], o[1]); w.y = pk2(o[2], o[3]);
                *(u32x2*)(y16 + ((size_t)(b * 2048 + ch * 16 + tp)) * 1024 + col) = w;
            }
        }
        __syncthreads();
    }
}

__device__ __forceinline__ void dsa_norm_phase(const Params& p, int j, unsigned char* smem) {
    const int tid = opaque_tid();
    const int lane = tid & 63, wave = tid >> 6;
    const float* hin = (const float*)(p.ws + D_HIN);
    h16* cq = (h16*)(p.ws + D_CQ); h16* ckv = (h16*)(p.ws + D_CKV); h16* ckvt = (h16*)(p.ws + D_CKVT); h16* kidx = (h16*)(p.ws + D_KIDX);
    float* widx = (float*)(p.ws + D_WIDX);
    const f32x4 gq = *(const f32x4*)(p.in[23] + j * 256 + lane * 4);
    const f32x2 gkv = *(const f32x2*)(p.in[24] + j * 128 + lane * 2);
    const float gi = p.in[29][j * 64 + lane], bi = p.in[30][j * 64 + lane];
    h16* wl = (h16*)(smem + wave * 2048);
    for (int grp = blockIdx.x * 8 + wave; grp < MTOK / 8; grp += gridDim.x * 8) {
        const int r0 = grp * 8;
        for (int i = 0; i < 8; ++i) {
            const int row = r0 + i;
            const float* hp = hin + (size_t)row * 512;
            const f32x4 vq = *(const f32x4*)(hp + lane * 4);
            const f32x2 vk = *(const f32x2*)(hp + 256 + lane * 2);
            const float vi = hp[384 + lane];
            float ssq = wave_sum(vq[0] * vq[0] + vq[1] * vq[1] + vq[2] * vq[2] + vq[3] * vq[3]);
            const float rq = rsqrtf(ssq * (1.0f / 256.0f) + 1e-6f);
            u32x2 w; w.x = pk2(vq[0] * rq * gq[0], vq[1] * rq * gq[1]); w.y = pk2(vq[2] * rq * gq[2], vq[3] * rq * gq[3]);
            *(u32x2*)(cq + (size_t)row * 256 + lane * 4) = w;
            float ssk = wave_sum(vk[0] * vk[0] + vk[1] * vk[1]);
            const float rk = rsqrtf(ssk * (1.0f / 128.0f) + 1e-6f);
            const unsigned wk = pk2(vk[0] * rk * gkv[0], vk[1] * rk * gkv[1]);
            *(unsigned*)(ckv + (size_t)row * 128 + lane * 2) = wk;
            *(unsigned*)(wl + i * 128 + lane * 2) = wk;
            const float mu = wave_sum(vi) * (1.0f / 64.0f);
            const float dv = vi - mu;
            const float var = wave_sum(dv * dv) * (1.0f / 64.0f);
            kidx[(size_t)row * 64 + lane] = (h16)(dv * rsqrtf(var + 1e-5f) * gi + bi);
            if (lane < 8) widx[(size_t)row * 8 + lane] = hp[448 + lane] * 0.044194173824159216f;
        }
        asm volatile("s_waitcnt lgkmcnt(0)" ::: "memory");
        const int b = r0 >> 11, t0 = r0 & 2047;
#pragma unroll
        for (int dd = 0; dd < 2; ++dd) {
            const int d = lane * 2 + dd;
            h16x8 hv;
#pragma unroll
            for (int i = 0; i < 8; ++i) hv[i] = wl[i * 128 + d];
            *(h16x8*)(ckvt + ((size_t)(b * 128 + d)) * 2048 + t0) = hv;
        }
        asm volatile("s_waitcnt lgkmcnt(0)" ::: "memory");
    }
}

constexpr int ROWP = 2052;
__device__ __forceinline__ unsigned fkey(float x) {
    if (x == 0.0f) x = 0.0f;
    const unsigned u = __float_as_uint(x);
    return (u & 0x80000000u) ? ~u : (u | 0x80000000u);
}
__device__ __forceinline__ void dsa_index_phase(const Params& p, unsigned char* smem) {
    const int tid = opaque_tid(), wave = tid >> 6, lane = tid & 63, r = lane & 15, q = lane >> 4;
    float* SC = (float*)smem;
    const h16* qidx = (const h16*)(p.ws + D_QIDX);
    const h16* kidx = (const h16*)(p.ws + D_KIDX);
    const float* widx = (const float*)(p.ws + D_WIDX);
    unsigned* maskb = (unsigned*)(p.ws + D_MASK);
    for (int qi = blockIdx.x, it = 0; qi < MTOK / 16; qi += gridDim.x, ++it) {
        const int qt = (it & 1) ? ((qi & ~127) | (127 - (qi & 127))) : qi;
        const int row0 = qt * 16, b = row0 >> 11, t0 = row0 & 2047;
        const int nkt = (t0 >> 4) + 1;
        {
            h16x8 qf[8][2]; float wq[8];
#pragma unroll
            for (int h = 0; h < 8; ++h) {
#pragma unroll
                for (int kk = 0; kk < 2; ++kk) qf[h][kk] = *(const h16x8*)(qidx + (size_t)(row0 + r) * 512 + h * 64 + kk * 32 + q * 8);
                wq[h] = widx[(size_t)(row0 + r) * 8 + h];
            }
            for (int kt = wave; kt < nkt; kt += 16) {
                const bool two = (kt + 8 < nkt);
                const int s0 = kt * 16, s1 = two ? s0 + 128 : s0;
                const h16* kp = kidx + (size_t)(b * 2048 + s0 + r) * 64 + q * 8;
                const h16* kp1 = kidx + (size_t)(b * 2048 + s1 + r) * 64 + q * 8;
                const h16x8 k0 = *(const h16x8*)kp, k1 = *(const h16x8*)(kp + 32), k2 = *(const h16x8*)kp1, k3 = *(const h16x8*)(kp1 + 32);
                f32x4 sc = {0.f, 0.f, 0.f, 0.f}, sd = {0.f, 0.f, 0.f, 0.f};
#pragma unroll
                for (int h = 0; h < 8; ++h) {
                    f32x4 acc = {0.f, 0.f, 0.f, 0.f}, acd = {0.f, 0.f, 0.f, 0.f};
                    acc = __builtin_amdgcn_mfma_f32_16x16x32_f16(k0, qf[h][0], acc, 0, 0, 0);
                    acd = __builtin_amdgcn_mfma_f32_16x16x32_f16(k2, qf[h][0], acd, 0, 0, 0);
                    acc = __builtin_amdgcn_mfma_f32_16x16x32_f16(k1, qf[h][1], acc, 0, 0, 0);
                    acd = __builtin_amdgcn_mfma_f32_16x16x32_f16(k3, qf[h][1], acd, 0, 0, 0);
#pragma unroll
                    for (int jj = 0; jj < 4; ++jj) { sc[jj] += fmaxf(acc[jj], 0.f) * wq[h]; sd[jj] += fmaxf(acd[jj], 0.f) * wq[h]; }
                }
                *(f32x4*)(SC + r * ROWP + s0 + q * 4) = sc;
                if (two) *(f32x4*)(SC + r * ROWP + s1 + q * 4) = sd;
            }
        }
        __syncthreads();
        for (int qq = 0; qq < 2; ++qq) {
            const int ql = wave * 2 + qq, t = t0 + ql;
            const float* srow = SC + ql * ROWP;
            const int ni = (t >> 6) + 1;
            unsigned u[32];
#pragma unroll
            for (int i = 0; i < 32; ++i) {
                u[i] = 0u;
                if (i < ni) { const int s = i * 64 + lane; if (s <= t) u[i] = fkey(srow[s]); }
            }
            unsigned myw = 0u;
            if (t < 256) {
#pragma unroll
                for (int i = 0; i < 32; ++i) { const unsigned long long sm = __ballot(u[i] != 0u); if ((lane >> 1) == i) myw = (lane & 1) ? (unsigned)(sm >> 32) : (unsigned)sm; }
            } else {
                unsigned T = 0u;
                for (int bit = 31; bit >= 0; --bit) {
                    const unsigned cand = T | (1u << bit);
                    int c0 = 0, c1 = 0;
                    if (ni <= 16) {
#pragma unroll
                        for (int i = 0; i < 16; i += 2) { c0 += (u[i] >= cand) ? 1 : 0; c1 += (u[i + 1] >= cand) ? 1 : 0; }
                    } else {
#pragma unroll
                        for (int i = 0; i < 32; i += 2) { c0 += (u[i] >= cand) ? 1 : 0; c1 += (u[i + 1] >= cand) ? 1 : 0; }
                    }
                    int c = c0 + c1;
                    c += __builtin_amdgcn_update_dpp(0, c, 0xB1, 0xF, 0xF, true);
                    c += __builtin_amdgcn_update_dpp(0, c, 0x4E, 0xF, 0xF, true);
                    c += __builtin_amdgcn_update_dpp(0, c, 0x141, 0xF, 0xF, true);
                    c += __builtin_amdgcn_update_dpp(0, c, 0x140, 0xF, 0xF, true);
                    const int cnt = __builtin_amdgcn_readlane(c, 0) + __builtin_amdgcn_readlane(c, 16) + __builtin_amdgcn_readlane(c, 32) + __builtin_amdgcn_readlane(c, 48);
                    if (cnt >= 256) T = cand;
                }
                int cgt = 0;
#pragma unroll
                for (int i = 0; i < 32; ++i) if (i < ni) cgt += __popcll(__ballot(u[i] > T));
                const int need = 256 - cgt;
                int running = 0;
                const unsigned long long lt = (lane == 0) ? 0ull : (~0ull >> (64 - lane));
#pragma unroll
                for (int i = 0; i < 32; ++i) {
                    if (i < ni) {
                        const unsigned long long eq = __ballot(u[i] == T);
                        const int rank = running + __popcll(eq & lt);
                        const unsigned long long sm = __ballot(u[i] > T || (u[i] == T && rank < need));
                        running += __popcll(eq);
                        if ((lane >> 1) == i) myw = (lane & 1) ? (unsigned)(sm >> 32) : (unsigned)sm;
                    }
                }
            }
            maskb[(size_t)(row0 + ql) * 64 + lane] = myw;
        }
        __syncthreads();
    }
}

constexpr int AT_KROW = 272, AT_VROW = 144, AT_KBYTES = 64 * AT_KROW, AT_VBYTES = 128 * AT_VROW, AT_STAGE = AT_KBYTES + AT_VBYTES, AT_BL = 2 * AT_STAGE, AT_QL = AT_BL + 16 * 132 * 4;
static_assert(AT_QL + 65536 <= LDS_BYTES, "attention LDS");
__device__ __forceinline__ void dsa_attn_phase(const Params& p, int j, unsigned char* smem) {
    const int tid = opaque_tid(), wave = tid >> 6, lane = tid & 63, r = lane & 15, q = lane >> 4;
    float* BL = (float*)(smem + AT_BL);
    for (int idx = tid; idx < 16 * 129; idx += 512) {
        const int h = idx / 129, d = idx % 129;
        int bk = d;
        if (d >= 16) { bk = 16 + (int)(logf((float)d * (1.0f / 16.0f)) / 2.0794415416798357f * 16.0f); bk = bk > 31 ? 31 : bk; }
        BL[h * 132 + d] = p.in[32][bk * 16 + h] * 1.4426950408889634f;
    }
    __syncthreads();
    const h16* qabs = (const h16*)(p.ws + D_QABS);
    const h16* ckv = (const h16*)(p.ws + D_CKV);
    const h16* ckvt = (const h16*)(p.ws + D_CKVT);
    const unsigned* maskb = (const unsigned*)(p.ws + D_MASK);
    h16* o16 = (h16*)(p.ws + D_O16);
    const h16* wuvt = w_dsa_uvt(p.ws, j);
    const float NINF = -__builtin_inff();
    const int krow0 = tid >> 4, kcc = tid & 15, vrow0 = tid >> 3, vcc = tid & 7;
    for (int qi = blockIdx.x, it = 0; qi < MTOK / 16; qi += gridDim.x, ++it) {
        const int qt = (it & 1) ? ((qi & ~127) | (127 - (qi & 127))) : qi;
        const int row0 = qt * 16, b = row0 >> 11, t0 = row0 & 2047, nst = (t0 + 16 + 63) >> 6, tq = t0 + r;
        const h16* kg = ckv + (size_t)(b * 2048) * 128;
        const h16* vg = ckvt + (size_t)(b * 128) * 2048;
        u32x4 sk[2], sv[2];
#pragma unroll
        for (int i = 0; i < 2; ++i) {
            sk[i] = *(const u32x4*)(kg + (size_t)(krow0 + i * 32) * 128 + kcc * 8);
            sv[i] = *(const u32x4*)(vg + (size_t)(vrow0 + i * 64) * 2048 + vcc * 8);
        }
        unsigned char* QL = smem + AT_QL + wave * 8192 + lane * 16;
        {
            h16x8 qtmp[8];
#pragma unroll
            for (int f = 0; f < 8; ++f) qtmp[f] = *(const h16x8*)(qabs + (size_t)(row0 + r) * 2048 + (2 * wave + (f >> 2)) * 128 + (f & 3) * 32 + q * 8);
#pragma unroll
            for (int f = 0; f < 8; ++f) *(h16x8*)(QL + f * 1024) = qtmp[f];
        }
        f32x4 O[2][8];
#pragma unroll
        for (int hh = 0; hh < 2; ++hh)
#pragma unroll
            for (int dt = 0; dt < 8; ++dt) O[hh][dt] = (f32x4){0.f, 0.f, 0.f, 0.f};
        float mrun[2] = {NINF, NINF}, lrun[2] = {0.f, 0.f};
#pragma unroll
        for (int i = 0; i < 2; ++i) {
            *(u32x4*)(smem + (krow0 + i * 32) * AT_KROW + kcc * 16) = sk[i];
            *(u32x4*)(smem + AT_KBYTES + (vrow0 + i * 64) * AT_VROW + vcc * 16) = sv[i];
        }
        u32x2 mwn = *(const u32x2*)(maskb + (size_t)(row0 + r) * 64);
        __syncthreads();
        for (int st = 0; st < nst; ++st) {
            const int s0 = st * 64;
            const unsigned char* Kb = smem + (st & 1) * AT_STAGE;
            const unsigned char* Vb = Kb + AT_KBYTES;
            const u32x2 mw2 = mwn;
            if (st + 1 < nst) mwn = *(const u32x2*)(maskb + (size_t)(row0 + r) * 64 + st * 2 + 2);
            if (st + 1 < nst) {
#pragma unroll
                for (int i = 0; i < 2; ++i) {
                    sk[i] = *(const u32x4*)(kg + (size_t)(s0 + 64 + krow0 + i * 32) * 128 + kcc * 8);
                    sv[i] = *(const u32x4*)(vg + (size_t)(vrow0 + i * 64) * 2048 + s0 + 64 + vcc * 8);
                }
            }
#pragma nounroll
            for (int hf = 0; hf < 2; ++hf) {
                const unsigned mwq = (hf ? mw2.y : mw2.x) >> (q * 4);
                const bool far = (s0 + hf * 32 + 31 + 128 <= t0);
                f32x4 sc[2][2];
                {
                    h16x8 qf[2][4], kf[2][4];
#pragma unroll
                    for (int f = 0; f < 8; ++f) qf[f >> 2][f & 3] = *(const h16x8*)(QL + f * 1024);
#pragma unroll
                    for (int tt = 0; tt < 2; ++tt)
#pragma unroll
                        for (int kk = 0; kk < 4; ++kk) kf[tt][kk] = *(const h16x8*)(Kb + (hf * 32 + tt * 16 + r) * AT_KROW + kk * 64 + q * 16);
                    __builtin_amdgcn_sched_barrier(0);
#pragma unroll
                    for (int tt = 0; tt < 2; ++tt)
#pragma unroll
                        for (int hh = 0; hh < 2; ++hh) {
                            f32x4 acc = {0.f, 0.f, 0.f, 0.f};
#pragma unroll
                            for (int kk = 0; kk < 4; ++kk) acc = __builtin_amdgcn_mfma_f32_16x16x32_f16(kf[tt][kk], qf[hh][kk], acc, 0, 0, 0);
                            sc[hh][tt] = acc;
                        }
                    __builtin_amdgcn_sched_barrier(0);
                }
                h16x4 vlo[8], vhi[8];
#pragma unroll
                for (int dt = 0; dt < 4; ++dt) {
                    const unsigned char* vp = Vb + (dt * 16 + r) * AT_VROW + (hf * 32 + q * 4) * 2;
                    vlo[dt] = *(const h16x4*)vp; vhi[dt] = *(const h16x4*)(vp + 32);
                }
                __builtin_amdgcn_sched_barrier(0);
                h16x8 pf[2]; float alpha[2];
#pragma unroll
                for (int hh = 0; hh < 2; ++hh) {
                    const int h = 2 * wave + hh;
                    float x[8]; float mx = NINF;
                    if (far) {
                        const float cb = BL[h * 132 + 128];
#pragma unroll
                        for (int tt = 0; tt < 2; ++tt)
#pragma unroll
                            for (int jj = 0; jj < 4; ++jj) {
                                const float xv = ((mwq >> (tt * 16 + jj)) & 1u) ? sc[hh][tt][jj] + cb : NINF;
                                x[tt * 4 + jj] = xv; mx = fmaxf(mx, xv);
                            }
                    } else {
#pragma unroll
                        for (int tt = 0; tt < 2; ++tt)
#pragma unroll
                            for (int jj = 0; jj < 4; ++jj) {
                                const int kix = tt * 16 + q * 4 + jj;
                                int dist = tq - (s0 + hf * 32 + kix); dist = dist < 0 ? 0 : (dist > 128 ? 128 : dist);
                                const float v = sc[hh][tt][jj] + BL[h * 132 + dist];
                                const float xv = ((mwq >> (tt * 16 + jj)) & 1u) ? v : NINF;
                                x[tt * 4 + jj] = xv; mx = fmaxf(mx, xv);
                            }
                    }
                    mx = fmaxf(mx, __shfl_xor(mx, 16)); mx = fmaxf(mx, __shfl_xor(mx, 32));
                    const float mnew = fmaxf(mrun[hh], mx);
                    const float mref = (mnew == NINF) ? 0.f : mnew;
                    alpha[hh] = __builtin_amdgcn_exp2f(mrun[hh] - mref);
                    mrun[hh] = mnew;
                    float ps = 0.f;
#pragma unroll
                    for (int i = 0; i < 8; ++i) { const float pv = __builtin_amdgcn_exp2f(x[i] - mref); ps += pv; pf[hh][i] = (h16)pv; }
                    lrun[hh] = lrun[hh] * alpha[hh] + ps;
                }
                __builtin_amdgcn_sched_barrier(0);
#pragma unroll
                for (int dt = 4; dt < 8; ++dt) {
                    const unsigned char* vp = Vb + (dt * 16 + r) * AT_VROW + (hf * 32 + q * 4) * 2;
                    vlo[dt] = *(const h16x4*)vp; vhi[dt] = *(const h16x4*)(vp + 32);
                }
                const bool resc = __ballot(alpha[0] != 1.0f || alpha[1] != 1.0f) != 0ull;
                if (resc) {
#pragma unroll
                    for (int dt = 0; dt < 8; ++dt) { O[0][dt] *= alpha[0]; O[1][dt] *= alpha[1]; }
                }
#pragma unroll
                for (int dt = 0; dt < 8; ++dt) {
                    const h16x8 vf = {vlo[dt][0], vlo[dt][1], vlo[dt][2], vlo[dt][3], vhi[dt][0], vhi[dt][1], vhi[dt][2], vhi[dt][3]};
#pragma unroll
                    for (int hh = 0; hh < 2; ++hh) O[hh][dt] = __builtin_amdgcn_mfma_f32_16x16x32_f16(vf, pf[hh], O[hh][dt], 0, 0, 0);
                }
                __builtin_amdgcn_sched_barrier(0);
            }
            if (st + 1 < nst) {
                unsigned char* Kn = smem + ((st + 1) & 1) * AT_STAGE;
#pragma unroll
                for (int i = 0; i < 2; ++i) {
                    *(u32x4*)(Kn + (krow0 + i * 32) * AT_KROW + kcc * 16) = sk[i];
                    *(u32x4*)(Kn + AT_KBYTES + (vrow0 + i * 64) * AT_VROW + vcc * 16) = sv[i];
                }
            }
            __syncthreads();
        }
#pragma unroll
        for (int hh = 0; hh < 2; ++hh) {
            const int h = 2 * wave + hh;
            float lt = lrun[hh]; lt += __shfl_xor(lt, 16); lt += __shfl_xor(lt, 32);
            const float inv = 1.0f / lt;
            h16x8 b8[4];
#pragma unroll
            for (int kk = 0; kk < 4; ++kk)
#pragma unroll
                for (int i = 0; i < 4; ++i) { b8[kk][i] = (h16)(O[hh][2 * kk][i] * inv); b8[kk][4 + i] = (h16)(O[hh][2 * kk + 1][i] * inv); }
#pragma unroll
            for (int vp2 = 0; vp2 < 2; ++vp2) {
                h16x4 alo[2][4], ahi[2][4];
#pragma unroll
                for (int v2 = 0; v2 < 2; ++v2)
#pragma unroll
                    for (int kk = 0; kk < 4; ++kk) {
                        const h16* ap = wuvt + (size_t)(h * 64 + (vp2 * 2 + v2) * 16 + r) * 128 + kk * 32 + q * 4;
                        alo[v2][kk] = *(const h16x4*)ap; ahi[v2][kk] = *(const h16x4*)(ap + 16);
                    }
                __builtin_amdgcn_sched_barrier(0);
#pragma unroll
                for (int v2 = 0; v2 < 2; ++v2) {
                    const int vt = vp2 * 2 + v2;
                    f32x4 acc = {0.f, 0.f, 0.f, 0.f};
#pragma unroll
                    for (int kk = 0; kk < 4; ++kk) {
                        const h16x8 a8 = {alo[v2][kk][0], alo[v2][kk][1], alo[v2][kk][2], alo[v2][kk][3], ahi[v2][kk][0], ahi[v2][kk][1], ahi[v2][kk][2], ahi[v2][kk][3]};
                        acc = __builtin_amdgcn_mfma_f32_16x16x32_f16(a8, b8[kk], acc, 0, 0, 0);
                    }
                    u32x2 w; w.x = pk2(acc[0], acc[1]); w.y = pk2(acc[2], acc[3]);
                    *(u32x2*)(o16 + (size_t)(row0 + r) * 1024 + h * 64 + vt * 16 + q * 4) = w;
                }
                __builtin_amdgcn_sched_barrier(0);
            }
            __builtin_amdgcn_sched_barrier(0);
        }
    }
    __syncthreads();
}

constexpr size_t OFF_BAR = 951 * MiB;
__device__ __forceinline__ void grid_bar(unsigned* ctr, unsigned& target, unsigned nblk) {
    asm volatile("s_waitcnt vmcnt(0) lgkmcnt(0)" ::: "memory");
    __syncthreads();
    target += nblk;
    if (threadIdx.x == 0) {
        __builtin_amdgcn_fence(__ATOMIC_RELEASE, "agent");
        asm volatile("s_waitcnt vmcnt(0)" ::: "memory");
        __hip_atomic_fetch_add(ctr, 1u, __ATOMIC_RELAXED, __HIP_MEMORY_SCOPE_AGENT);
        while (__hip_atomic_load(ctr, __ATOMIC_RELAXED, __HIP_MEMORY_SCOPE_AGENT) < target) __builtin_amdgcn_s_sleep(1);
        __builtin_amdgcn_fence(__ATOMIC_ACQUIRE, "agent");
        asm volatile("s_waitcnt vmcnt(0)" ::: "memory");
    }
    __syncthreads();
}

__global__ void __launch_bounds__(512) mega_fwd(Params p) {
    extern __shared__ __attribute__((aligned(16))) unsigned char smem[];
    cg::grid_group grid = cg::this_grid();
    unsigned char* ws = p.ws;
    h16* x16 = (h16*)(ws + OFF_X16);
    unsigned* barctr = (unsigned*)(ws + OFF_BAR);
    unsigned bar_target = 0u;
    for (int ph = p.ph_lo; ph < p.ph_hi; ++ph) {
        const unsigned e = p.prog[ph];
        const int kind = e & 15, L = (e >> 4) & 3, sub = (e >> 6) & 1, j = L >> 1;
        const int nrep = 1 + (int)(e >> 7);
        for (int rep = 0; rep < nrep; ++rep) {
        if (rep) grid_bar(barctr, bar_target, gridDim.x);
        const bool isgemm = (kind == K_R1 || kind == K_R2 || kind == K_R4 || kind == K_F1 || kind == K_F3 || kind == K_D1 || kind == K_D3 || kind == K_D6);
        if (isgemm) {
            const int ngemm = (kind == K_R1) ? 2 : 1;
            for (int gi = 0; gi < ngemm; ++gi) {
            pg8::Gemm g; pg8::Epi E;
            g.M = MTOK; g.N = 1024; g.K = 1024; g.lda = 1024; g.amode = 0; g.pm0 = 0; g.A = x16; g.A2 = x16; g.Bt = x16;
            E.mode = E_RESID; E.pm0 = 0; E.j = j; E.pnoff = 0; E.ws = ws; E.out = p.out; E.bias0 = p.in[5] + j * 1024; E.bias1 = p.in[8] + j * 1024; E.bias2 = p.in[11];
            if (kind == K_R1) {
                E.mode = E_RPROJ;
                if (gi == 0) { g.A = (const h16*)p.out; g.A2 = (const h16*)(ws + R_G16); g.Bt = w_rwkv_big(ws, j); g.N = 3072; g.amode = 2; }
                else { g.Bt = w_rwkv_l1(ws, j); g.N = 512; g.K = 2048; g.amode = 1; E.pnoff = 12; }
            } else if (kind == K_R2) {
                g.A = (const h16*)(ws + R_HACT); g.Bt = w_rwkv_l2(ws, j); g.N = (j == 0) ? 3072 : 4096; g.K = 384; g.lda = 384; E.mode = E_LORA2;
            } else if (kind == K_R4) {
                g.A = (const h16*)(ws + (j == 0 ? R_V16 : OFF_VF)); g.Bt = w_rwkv_o(ws, j);
            } else if (kind == K_F1) {
                g.Bt = w_ffn_up(ws, L); g.M = MTOK / 2; g.N = 5632; g.amode = 1; g.pm0 = sub * 128; E.mode = E_ST16;
            } else if (kind == K_F3) {
                g.A = (const h16*)(ws + F_ACT); g.Bt = w_ffn_dn(ws, L); g.M = MTOK / 2; g.K = 2816; g.lda = 2816; E.pm0 = sub * 128;
            } else if (kind == K_D1) {
                g.Bt = w_dsa_in(ws, j); g.N = 512; g.amode = 1; E.mode = E_ST32;
            } else if (kind == K_D3) {
                g.A = (const h16*)(ws + D_CQ); g.Bt = w_dsa_q(ws, j); g.N = 2560; g.K = 256; g.lda = 256; E.mode = E_QPROJ;
            } else {
                g.A = (const h16*)(ws + D_O16); g.Bt = w_dsa_o(ws, j);
            }
            pg8::StaticOrder S; S.init(g.M, g.N, (int)gridDim.x, (int)blockIdx.x);
#ifndef NO_GEMM
            pg8::gemm_phase((LAS unsigned char*)smem, g, S, E);
#endif
            }
        } else if (kind == K_PREP) {
#ifndef NO_PREP
            prep_phase(p, smem);
#endif
        } else if (kind == K_R0) {
            mix_phase(p, j);
        } else if (kind == K_R3) {
#ifndef NO_SCAN
            scan_phase(p, j, smem);
#endif
        } else if (kind == K_LN) {
#ifndef NO_LN
            ln_phase(p, p.in[1] + (L * 2 + sub) * 1024, p.in[2] + (L * 2 + sub) * 1024, L == 3 && sub == 1);
#endif
        } else if (kind == K_F2) {
#ifndef NO_CONV
            conv_phase(p, L);
#endif
        } else if (kind == K_D2) {
#ifndef NO_NORM
            dsa_norm_phase(p, j, smem);
#endif
        } else if (kind == K_D4) {
#ifndef NO_INDEX
            dsa_index_phase(p, smem);
#endif
        } else if (kind == K_D5) {
#ifndef NO_ATTN
            dsa_attn_phase(p, j, smem);
#endif
        }
        }
        if (ph + 1 < p.ph_hi) { if (ph == p.ph_lo) grid.sync(); else grid_bar(barctr, bar_target, gridDim.x); for (int xs = 0; xs < EXTRA_SYNC; ++xs) grid_bar(barctr, bar_target, gridDim.x); }
    }
}

extern "C" void kernel_launch(void* const* d_in, const int* in_sizes, int n_in, void* d_out, int out_size, void* d_ws, size_t ws_size, hipStream_t stream) {
    static int grid_blocks = 0;
    if (grid_blocks == 0) {
        if (n_in != 37 || ws_size < WS_NEED || out_size != MTOK * DM) { fprintf(stderr, "kernel_launch: unexpected problem (n_in %d ws %zu out %d)\n", n_in, ws_size, out_size); grid_blocks = -1; return; }
        int dev = 0, cus = 0, per_cu = 0;
        hipGetDevice(&dev);
        hipDeviceGetAttribute(&cus, hipDeviceAttributeMultiprocessorCount, dev);
        if (hipFuncSetAttribute((const void*)mega_fwd, hipFuncAttributeMaxDynamicSharedMemorySize, LDS_BYTES) != hipSuccess) { fprintf(stderr, "kernel_launch: hipFuncSetAttribute failed\n"); grid_blocks = -1; return; }
        hipOccupancyMaxActiveBlocksPerMultiprocessor(&per_cu, (const void*)mega_fwd, 512, LDS_BYTES);
        if (per_cu < 1) { fprintf(stderr, "kernel_launch: occupancy query says %d blocks/CU\n", per_cu); per_cu = 1; }
        (void)hipGetLastError();
        grid_blocks = cus * per_cu;
        fprintf(stderr, "kernel_launch: grid %d (cus %d x %d)\n", grid_blocks, cus, per_cu);
    }
    if (grid_blocks < 0) return;
    Params p{};
    for (int i = 0; i < 37; ++i) p.in[i] = (const float*)d_in[i];
    p.ws = (unsigned char*)d_ws; p.out = (float*)d_out;
    int np = 0;
    constexpr unsigned PROBE_MASK = 0u;
    auto add = [&](int kind, int L, int sub) { p.prog[np++] = (unsigned char)(kind | (L << 4) | (sub << 6) | ((((PROBE_MASK >> kind) & 1u) && !(kind == K_LN && L == 3 && sub == 1)) ? 128 : 0)); };
    add(K_PREP, 0, 0);
    for (int L = 0; L < 4; ++L) {
        if ((L & 1) == 0) { add(K_R0, L, 0); add(K_R1, L, 0); add(K_R2, L, 0); add(K_R3, L, 0); add(K_R4, L, 0); }
        else { add(K_D1, L, 0); add(K_D2, L, 0); add(K_D3, L, 0); add(K_D4, L, 0); add(K_D5, L, 0); add(K_D6, L, 0); }
        add(K_LN, L, 0);
        for (int c = 0; c < 2; ++c) { add(K_F1, L, c); add(K_F2, L, c); add(K_F3, L, c); }
        add(K_LN, L, 1);
    }
#if SINGLE_LAUNCH
    if (hipMemsetAsync((unsigned char*)d_ws + OFF_BAR, 0, 256, stream) != hipSuccess) { fprintf(stderr, "kernel_launch: memset failed\n"); return; }
    p.ph_lo = 0; p.ph_hi = np;
    void* args[] = {&p};
    hipError_t e = hipLaunchCooperativeKernel((const void*)mega_fwd, dim3(grid_blocks), dim3(512), args, LDS_BYTES, stream);
    if (e != hipSuccess) fprintf(stderr, "cooperative launch failed: %s (grid %d)\n", hipGetErrorString(e), grid_blocks);
#else
    for (int ph = 0; ph < np; ++ph) {
        p.ph_lo = ph; p.ph_hi = ph + 1;
        hipLaunchKernelGGL(mega_fwd, dim3(grid_blocks), dim3(512), LDS_BYTES, stream, p);
    }
#endif
}
```

```cpp
#include <hip/hip_runtime.h>
#include <hip/hip_cooperative_groups.h>
#include <cstdio>
namespace cg = cooperative_groups;

constexpr int EXTRA_SYNC = 0;
#ifndef SINGLE_LAUNCH
#define SINGLE_LAUNCH 1
#endif

#define LAS __attribute__((address_space(3)))
typedef _Float16 h16;
typedef _Float16 h16x8 __attribute__((ext_vector_type(8)));
typedef _Float16 h16x4 __attribute__((ext_vector_type(4)));
typedef _Float16 h16x2 __attribute__((ext_vector_type(2)));
typedef float f32x4 __attribute__((ext_vector_type(4)));
typedef float f32x2 __attribute__((ext_vector_type(2)));
typedef unsigned u32x4 __attribute__((ext_vector_type(4)));
typedef unsigned u32x2 __attribute__((ext_vector_type(2)));

constexpr int DM = 1024, SEQ = 2048, NBATCH = 32, MTOK = NBATCH * SEQ;
constexpr int DFF = 2816;
constexpr size_t MiB = (size_t)1 << 20;
constexpr float DN_ALPHA = 1.6817928305074290f;
constexpr int LDS_BYTES = 147456;

constexpr size_t OFF_W = 0;
constexpr size_t OFF_X16 = 118 * MiB;
constexpr size_t OFF_VF = 247 * MiB;
constexpr size_t OFF_R = 375 * MiB;
constexpr size_t WS_NEED = 952 * MiB;
constexpr size_t R_R16 = OFF_R, R_K16 = OFF_R + 128 * MiB, R_V16 = OFF_R + 256 * MiB, R_G16 = OFF_R + 384 * MiB, R_HACT = OFF_R + 512 * MiB;
constexpr size_t F_U16 = OFF_R, F_ACT = OFF_R + 352 * MiB;
constexpr size_t D_HIN = OFF_R, D_O16 = OFF_R, D_QABS = OFF_R + 128 * MiB, D_QIDX = OFF_R + 384 * MiB, D_CQ = OFF_R + 448 * MiB,
                 D_CKV = OFF_R + 480 * MiB, D_CKVT = OFF_R + 496 * MiB, D_KIDX = OFF_R + 512 * MiB, D_WIDX = OFF_R + 520 * MiB, D_MASK = OFF_R + 522 * MiB;

struct Params {
    const float* in[37];
    unsigned char* ws;
    float* out;
    int ph_lo, ph_hi;
    unsigned char prog[64];
};

enum { K_PREP = 0, K_R1, K_R2, K_R3, K_R4, K_LN, K_F1, K_F2, K_F3, K_D1, K_D2, K_D3, K_D4, K_D5, K_D6, K_R0 };
enum { E_RPROJ = 0, E_LORA2, E_RESID, E_ST16, E_ST32, E_QPROJ };

__device__ __forceinline__ size_t xrow(int row) { return (size_t)(row >> 11) * 2049 + 1 + (row & 2047); }
__device__ __forceinline__ unsigned pk2(float a, float b) { h16x2 h = {(h16)a, (h16)b}; return __builtin_bit_cast(unsigned, h); }
__device__ __forceinline__ u32x4 pack8(f32x4 a, f32x4 b) { u32x4 w; w.x = pk2(a[0], a[1]); w.y = pk2(a[2], a[3]); w.z = pk2(b[0], b[1]); w.w = pk2(b[2], b[3]); return w; }
__device__ __forceinline__ void unpack8(u32x4 w, float* f) {
    h16x8 h = __builtin_bit_cast(h16x8, w);
#pragma unroll
    for (int i = 0; i < 8; ++i) f[i] = (float)h[i];
}
__device__ __forceinline__ float sigmoidf_(float x) { return 1.0f / (1.0f + __expf(-x)); }
__device__ __forceinline__ float wave_sum(float v) {
#pragma unroll
    for (int o = 32; o > 0; o >>= 1) v += __shfl_xor(v, o);
    return v;
}
#define WSYNC() asm volatile("s_waitcnt vmcnt(0) lgkmcnt(0)" ::: "memory")
__device__ __forceinline__ int opaque_tid() { int t = threadIdx.x; asm volatile("" : "+v"(t)); return t; }

namespace pg8 {
constexpr int BM = 256, BK = 64, HALF = 128, HTB = HALF * BK * 2, STAGE_BYTES = 8 * HTB, NXCD = 8, WGM = 8;
__device__ __forceinline__ int lds_byte(int r, int c) { const int st = (r >> 4) * 2 + (c >> 5), rr = r & 15, cc = c & 31, ob = rr * 64 + cc * 2; return st * 1024 + (ob ^ (((ob >> 9) & 1) << 5)); }
__device__ __forceinline__ void stage_rc(int b, int& R, int& C) { const int st = b / 1024, sb = b % 1024, swz = sb ^ (((sb >> 9) & 1) << 5); R = (st >> 1) * 16 + swz / 64; C = (st & 1) * 32 + (swz % 64) / 2; }
__device__ __forceinline__ int perm32(int rho) { const int n = rho >> 4, i = rho & 15; return 8 * (i >> 2) + 4 * n + (i & 3); }
struct Unit { int pm, pn; };
struct Gemm { const h16* A; const h16* A2; const h16* Bt; int M, N, K, lda, amode, pm0; };
struct StaticOrder {
    int nM, nN, nwg, G, c;
    __device__ void init(int M, int N, int G_, int c_) { nM = M / BM; nN = N / BM; nwg = nM * nN; G = G_; c = c_; }
    __device__ bool next(int i, Unit& u) const {
        const long L = (long)i * G + c; if (L >= nwg) return false;
        int wgid = (int)L; { const int q = nwg / NXCD, r = nwg % NXCD, xcd = wgid % NXCD, off = wgid / NXCD; wgid = (xcd < r ? xcd * (q + 1) : r * (q + 1) + (xcd - r) * q) + off; }
        const int nig = WGM * nN, gid = wgid / nig, fm = gid * WGM, gsz = (nM - fm) < WGM ? (nM - fm) : WGM;
        u.pm = fm + ((wgid % nig) % gsz); u.pn = (wgid % nig) / gsz; return true;
    }
};

struct Epi {
    int mode, pm0, j, pnoff, fin;
    unsigned char* ws; float* out; const float* bias0; const float* bias1; const float* bias2;
    __device__ __forceinline__ void operator()(const f32x4 (&acc)[2][2][4][2], const Unit& u, int wr, int wc, int fr, int fq) const {
        const int rowl0 = u.pm * BM + wr * 64 + fr;
        const int colt = u.pn * BM + wc * 32 + 8 * fq;
        if (mode == E_RESID) {
            u32x4 xr[2][4][2];
#pragma unroll
            for (int ai = 0; ai < 2; ++ai)
#pragma unroll
                for (int m = 0; m < 4; ++m) {
                    const int rowg = rowl0 + ai * HALF + m * 16 + pm0 * BM;
                    const h16* xp = (const h16*)(ws + OFF_X16) + xrow(rowg) * 1024 + colt;
#pragma unroll
                    for (int bj = 0; bj < 2; ++bj) xr[ai][m][bj] = *(const u32x4*)(xp + bj * HALF);
                }
#pragma unroll
            for (int ai = 0; ai < 2; ++ai)
#pragma unroll
                for (int m = 0; m < 4; ++m) {
                    const int rowg = rowl0 + ai * HALF + m * 16 + pm0 * BM;
                    float* dp0 = out + (size_t)rowg * 1024 + colt;
                    h16* hp0 = (h16*)out + (size_t)rowg * 1024 + colt;
#pragma unroll
                    for (int bj = 0; bj < 2; ++bj) {
                        float xf[8]; unpack8(xr[ai][m][bj], xf);
                        const f32x4 v0 = acc[ai][bj][m][0], v1 = acc[ai][bj][m][1];
                        f32x4 r0, r1;
#pragma unroll
                        for (int jj = 0; jj < 4; ++jj) { r0[jj] = DN_ALPHA * xf[jj] + v0[jj]; r1[jj] = DN_ALPHA * xf[4 + jj] + v1[jj]; }
                        if (fin) { float* dp = dp0 + bj * HALF; *(f32x4*)dp = r0; *(f32x4*)(dp + 4) = r1; }
                        else *(u32x4*)(hp0 + bj * HALF) = pack8(r0, r1);
                    }
                }
            return;
        }
        if (mode == E_LORA2 && (u.pn >> 2) == 3) {
            const int c0 = colt & 1023;
#pragma unroll
            for (int ai = 0; ai < 2; ++ai) {
                u32x4 lv[4][2], lf[4][2];
#pragma unroll
                for (int m = 0; m < 4; ++m) {
                    const size_t off = (size_t)(rowl0 + ai * HALF + m * 16 + pm0 * BM) * 1024 + c0;
#pragma unroll
                    for (int bj = 0; bj < 2; ++bj) { lv[m][bj] = *(const u32x4*)((const h16*)(ws + R_V16) + off + bj * HALF); lf[m][bj] = *(const u32x4*)((const h16*)(ws + OFF_VF) + off + bj * HALF); }
                }
#pragma unroll
                for (int m = 0; m < 4; ++m) {
                    const size_t off = (size_t)(rowl0 + ai * HALF + m * 16 + pm0 * BM) * 1024 + c0;
#pragma unroll
                    for (int bj = 0; bj < 2; ++bj) {
                        const int c = c0 + bj * HALF;
                        const f32x4 ba = *(const f32x4*)(bias2 + c), bb = *(const f32x4*)(bias2 + c + 4);
                        float vv[8], vf8[8]; unpack8(lv[m][bj], vv); unpack8(lf[m][bj], vf8);
                        f32x4 v0 = acc[ai][bj][m][0], v1 = acc[ai][bj][m][1];
#pragma unroll
                        for (int jj = 0; jj < 4; ++jj) {
                            v0[jj] = vv[jj] + (vf8[jj] - vv[jj]) * sigmoidf_(v0[jj] + ba[jj]);
                            v1[jj] = vv[4 + jj] + (vf8[4 + jj] - vv[4 + jj]) * sigmoidf_(v1[jj] + bb[jj]);
                        }
                        *(u32x4*)((h16*)(ws + R_V16) + off + bj * HALF) = pack8(v0, v1);
                    }
                }
            }
            return;
        }
#pragma unroll
        for (int ai = 0; ai < 2; ++ai)
#pragma unroll
            for (int m = 0; m < 4; ++m) {
                const int rowl = rowl0 + ai * HALF + m * 16;
                const int rowg = rowl + pm0 * BM;
#pragma unroll
                for (int bj = 0; bj < 2; ++bj) {
                    const int col = colt + bj * HALF;
                    f32x4 v0 = acc[ai][bj][m][0], v1 = acc[ai][bj][m][1];
                    if (mode == E_RPROJ) {
                        if (pnoff == 0) {
                            h16* dst = (h16*)(ws + (u.pn < 4 ? R_R16 : (u.pn < 8 ? R_K16 : (j == 0 ? OFF_VF : R_V16))));
                            *(u32x4*)(dst + (size_t)rowg * 1024 + (col & 1023)) = pack8(v0, v1);
                        } else if (col < 384) {
                            const int hc = col;
                            if (hc < 64) {
#pragma unroll
                                for (int jj = 0; jj < 4; ++jj) { v0[jj] = tanhf(v0[jj]); v1[jj] = tanhf(v1[jj]); }
                            } else if (hc >= 160) {
#pragma unroll
                                for (int jj = 0; jj < 4; ++jj) { v0[jj] = sigmoidf_(v0[jj]); v1[jj] = sigmoidf_(v1[jj]); }
                            }
                            *(u32x4*)((h16*)(ws + R_HACT) + (size_t)rowg * 384 + hc) = pack8(v0, v1);
                        }
                    } else if (mode == E_LORA2) {
                        const int grp = u.pn >> 2, c = col & 1023;
                        const size_t off = (size_t)rowg * 1024 + c;
                        if (grp == 0) {
                            const f32x4 ba = *(const f32x4*)(bias0 + c), bb = *(const f32x4*)(bias0 + c + 4);
#pragma unroll
                            for (int jj = 0; jj < 4; ++jj) { v0[jj] = sigmoidf_(v0[jj] + ba[jj]) * 0.6065306597f; v1[jj] = sigmoidf_(v1[jj] + bb[jj]) * 0.6065306597f; }
                            *(u32x4*)((h16*)out + off) = pack8(v0, v1);
                        } else if (grp == 1) {
                            const f32x4 ba = *(const f32x4*)(bias1 + c), bb = *(const f32x4*)(bias1 + c + 4);
#pragma unroll
                            for (int jj = 0; jj < 4; ++jj) { v0[jj] = sigmoidf_(v0[jj] + ba[jj]); v1[jj] = sigmoidf_(v1[jj] + bb[jj]); }
                            *(u32x4*)((h16*)out + (size_t)MTOK * 1024 + off) = pack8(v0, v1);
                        } else {
                            *(u32x4*)((h16*)(ws + R_G16) + off) = pack8(v0, v1);
                        }
                    } else if (mode == E_ST16) {
                        *(u32x4*)((h16*)(ws + F_U16) + (size_t)rowl * 5632 + col) = pack8(v0, v1);
                    } else if (mode == E_ST32) {
                        float* dp = (float*)(ws + D_HIN) + (size_t)rowg * 512 + col;
                        *(f32x4*)dp = v0; *(f32x4*)(dp + 4) = v1;
                    } else {
                        if (u.pn < 8) *(u32x4*)((h16*)(ws + D_QABS) + (size_t)rowg * 2048 + col) = pack8(v0, v1);
                        else *(u32x4*)((h16*)(ws + D_QIDX) + (size_t)rowg * 512 + (col - 2048)) = pack8(v0, v1);
                    }
                }
            }
    }
};

__device__ __forceinline__ const char* a_tile(const Gemm& g, int pm, int pn) {
    if (g.amode == 1) { const int row = (pm + g.pm0) * BM; return (const char*)g.A + xrow(row) * 2048; }
    if (g.amode == 2) {
        const int gq = pn >> 2;
        const char* base = gq == 2 ? (const char*)g.A2 : (const char*)g.A + (size_t)gq * ((size_t)MTOK * 1024 * 2);
        return base + (size_t)pm * BM * 2048;
    }
    return (const char*)g.A + (size_t)pm * BM * g.lda * 2;
}

__device__ __forceinline__ void gemm_phase(LAS unsigned char* lds, const Gemm g, const StaticOrder& S, const Epi& E) {
    const int tid = opaque_tid(), wid = __builtin_amdgcn_readfirstlane(tid >> 6), lane = tid & 63, wr = wid >> 2, wc = wid & 3, fr = lane & 15, fq = lane >> 4;
    const int K = g.K, nt = K / BK;
    const bool shiftA = (g.amode == 1);
    unsigned voffA[2], voffB[2];
#pragma unroll
    for (int i = 0; i < 2; ++i) { int R, C; stage_rc(tid * 16 + i * 8192, R, C); const int Rb = (R & ~31) + perm32(R & 31);
        voffA[i] = (unsigned)(R * g.lda + C) * 2u; voffB[i] = (unsigned)(Rb * K + C) * 2u; }
    const size_t kstep = (size_t)(BK * 2);
    const size_t hstepA = (size_t)HALF * g.lda * 2;
    const size_t hstepB = (size_t)HALF * K * 2;
    const size_t tstepB = 2 * hstepB;
    const unsigned ldsw = (unsigned)wid * 1024u;
    const int aoff = lds_byte(wr * 64 + fr, fq * 8), boff = lds_byte(wc * 32 + fr, fq * 8);
#define PG8_KOFF(kt) ((size_t)(kt) * kstep - ((shiftA && (kt) >= 16) ? (size_t)4096 : (size_t)0))
#define PG8_SA(b, h) (((b) * 2 + (h)) * HTB)
#define PG8_SB(b, h) ((4 + (b) * 2 + (h)) * HTB)
#define PG8_STAGE(bufoff, gbase, voff) do { _Pragma("unroll") for (int _i = 0; _i < 2; ++_i) \
        __builtin_amdgcn_global_load_lds((const unsigned*)((const char*)(gbase) + (voff)[_i]), (LAS unsigned*)(lds + (bufoff) + ldsw + _i * 8192), 16, 0, 0); } while (0)
#define PG8_LDA(dst, b, h) do { _Pragma("unroll") for (int m = 0; m < 4; ++m) _Pragma("unroll") for (int k = 0; k < 2; ++k) dst[m][k] = *(const LAS h16x8*)(lds + PG8_SA(b, h) + aoff + m * 2048 + k * 1024); } while (0)
#define PG8_LDB(dst, b, h) do { _Pragma("unroll") for (int n = 0; n < 2; ++n) _Pragma("unroll") for (int k = 0; k < 2; ++k) dst[n][k] = *(const LAS h16x8*)(lds + PG8_SB(b, h) + boff + n * 2048 + k * 1024); } while (0)
#define PG8_MMA(ai, bj, At, Bt) do { __builtin_amdgcn_s_setprio(1); _Pragma("unroll") for (int m = 0; m < 4; ++m) _Pragma("unroll") for (int n = 0; n < 2; ++n) _Pragma("unroll") for (int k = 0; k < 2; ++k) \
        acc[ai][bj][m][n] = __builtin_amdgcn_mfma_f32_16x16x32_f16(Bt[n][k], At[m][k], acc[ai][bj][m][n], 0, 0, 0); __builtin_amdgcn_s_setprio(0); } while (0)
#define PG8_WAIT_V(n) asm volatile("s_waitcnt vmcnt(" #n ")" ::: "memory")
#define PG8_WAIT_L(n) asm volatile("s_waitcnt lgkmcnt(" #n ")" ::: "memory")
#define PG8_BAR __builtin_amdgcn_s_barrier()
#define PG8_SCHED __builtin_amdgcn_sched_barrier(0)
    Unit cur, nxt; int ui = 0;
    if (!S.next(0, cur)) return;
    f32x4 acc[2][2][4][2];
#pragma unroll
    for (int a = 0; a < 2; ++a)
#pragma unroll
        for (int b = 0; b < 2; ++b)
#pragma unroll
            for (int m = 0; m < 4; ++m)
#pragma unroll
                for (int n = 0; n < 2; ++n) acc[a][b][m][n] = (f32x4){0.f, 0.f, 0.f, 0.f};
    h16x8 At[4][2], B0[2][2], B1[2][2];
    const char* cA = a_tile(g, cur.pm, cur.pn); const char* cB = (const char*)g.Bt + (size_t)cur.pn * tstepB;
    PG8_STAGE(PG8_SB(0, 0), cB, voffB); PG8_STAGE(PG8_SA(0, 0), cA, voffA); PG8_STAGE(PG8_SB(0, 1), cB + hstepB, voffB); PG8_STAGE(PG8_SA(0, 1), cA + hstepA, voffA);
    if (wr == 1) PG8_BAR;
    PG8_WAIT_V(4); PG8_BAR;
    PG8_STAGE(PG8_SB(1, 0), cB + kstep, voffB); PG8_STAGE(PG8_SA(1, 0), cA + kstep, voffA); PG8_STAGE(PG8_SB(1, 1), cB + hstepB + kstep, voffB);
    PG8_WAIT_V(6); PG8_BAR;
    for (;;) {
        const bool has_next = S.next(ui + 1, nxt);
        const char* nA = has_next ? a_tile(g, nxt.pm, nxt.pn) : cA; const char* nB = has_next ? (const char*)g.Bt + (size_t)nxt.pn * tstepB : cB;
        for (int t = 0; t < nt; t += 2) {
            const bool last = (t == nt - 2);
            const char* a1 = cA + PG8_KOFF(t + 1);
            const char* a2 = last ? nA : cA + PG8_KOFF(t + 2); const char* b2 = last ? nB : cB + (size_t)(t + 2) * kstep;
            const char* a3 = a2 + kstep; const char* b3 = b2 + kstep;
            PG8_LDB(B0, 0, 0); PG8_SCHED; PG8_LDA(At, 0, 0); PG8_STAGE(PG8_SA(1, 1), a1 + hstepA, voffA);
            PG8_WAIT_L(8); PG8_BAR; PG8_WAIT_L(0); PG8_MMA(0, 0, At, B0); PG8_BAR; PG8_SCHED;
            PG8_LDB(B1, 0, 1); PG8_STAGE(PG8_SB(0, 0), b2, voffB);
            PG8_BAR; PG8_WAIT_L(0); PG8_MMA(0, 1, At, B1); PG8_BAR;
            PG8_LDA(At, 0, 1); PG8_STAGE(PG8_SA(0, 0), a2, voffA);
            PG8_BAR; PG8_WAIT_L(0); PG8_MMA(1, 0, At, B0); PG8_BAR; PG8_SCHED;
            PG8_STAGE(PG8_SB(0, 1), b2 + hstepB, voffB);
            PG8_WAIT_V(6); PG8_BAR; PG8_MMA(1, 1, At, B1); PG8_BAR;
            PG8_LDB(B0, 1, 0); PG8_SCHED; PG8_LDA(At, 1, 0); PG8_STAGE(PG8_SA(0, 1), a2 + hstepA, voffA);
            PG8_WAIT_L(8); PG8_BAR; PG8_WAIT_L(0); PG8_MMA(0, 0, At, B0); PG8_BAR; PG8_SCHED;
            PG8_LDB(B1, 1, 1); PG8_STAGE(PG8_SB(1, 0), b3, voffB);
            PG8_BAR; PG8_WAIT_L(0); PG8_MMA(0, 1, At, B1); PG8_BAR;
            PG8_LDA(At, 1, 1); PG8_STAGE(PG8_SA(1, 0), a3, voffA);
            PG8_BAR; PG8_WAIT_L(0); PG8_MMA(1, 0, At, B0); PG8_BAR; PG8_SCHED;
            PG8_STAGE(PG8_SB(1, 1), b3 + hstepB, voffB);
            PG8_WAIT_V(6); PG8_BAR; PG8_MMA(1, 1, At, B1); PG8_BAR;
        }
        E(acc, cur, wr, wc, fr, fq);
        if (!has_next) break;
#pragma unroll
        for (int a = 0; a < 2; ++a)
#pragma unroll
            for (int b = 0; b < 2; ++b)
#pragma unroll
                for (int m = 0; m < 4; ++m)
#pragma unroll
                    for (int n = 0; n < 2; ++n) acc[a][b][m][n] = (f32x4){0.f, 0.f, 0.f, 0.f};
        cur = nxt; cA = nA; cB = nB; ++ui;
    }
    PG8_WAIT_V(0);
    if (wr == 0) PG8_BAR;
    PG8_BAR;
#undef PG8_KOFF
#undef PG8_SA
#undef PG8_SB
#undef PG8_STAGE
#undef PG8_LDA
#undef PG8_LDB
#undef PG8_MMA
#undef PG8_WAIT_V
#undef PG8_WAIT_L
#undef PG8_BAR
#undef PG8_SCHED
}
}

struct TJob { int mode; const float* src; int ld, K, N; h16* dst; int ldd, koff; const float* mix; };

__device__ __forceinline__ TJob get_job(const Params& p, int id) {
    TJob J; J.mode = 0; J.src = nullptr; J.ld = 0; J.K = 0; J.N = 0; J.dst = nullptr; J.ldd = 64; J.koff = 0; J.mix = nullptr;
    h16* W = (h16*)(p.ws + OFF_W);
    if (id < 24) {
        const int j = id / 12, s = id % 12;
        h16* Wrkv = W + (size_t)j * (10 * MiB); h16* Wl1 = Wrkv + 3 * MiB; h16* Wl2 = Wrkv + 7 * MiB;
        const float* mix = p.in[3] + j * 6 * 1024;
        if (s < 3) { J.mode = 0; J.src = p.in[4] + (size_t)(j * 3 + s) * 1048576; J.ld = 1024; J.K = 1024; J.N = 1024; J.dst = Wrkv + (size_t)s * 1024 * 1024; J.ldd = 1024; }
        else if (s < 8) {
            J.mode = 1; J.ld = 1024; J.K = 1024; J.ldd = 2048;
            if (s == 3) { J.src = p.in[6] + (size_t)j * 65536; J.ld = 64; J.N = 64; J.dst = Wl1; J.mix = mix + 3 * 1024; }
            else if (s == 4) { J.src = p.in[9] + (size_t)j * 65536; J.ld = 64; J.N = 64; J.dst = Wl1 + (size_t)64 * 2048; J.mix = mix + 4 * 1024; }
            else if (s == 5) { J.N = 32; J.dst = Wl1 + (size_t)128 * 2048; if (j == 1) { J.src = p.in[12]; J.ld = 32; J.mix = mix + 2 * 1024; } else { J.mode = 2; } }
            else if (s == 6) { J.src = p.in[14] + (size_t)j * 163840; J.ld = 160; J.N = 160; J.dst = Wl1 + (size_t)160 * 2048; J.mix = mix + 5 * 1024; }
            else { J.mode = 2; J.N = 192; J.dst = Wl1 + (size_t)320 * 2048; }
        } else {
            J.mode = 0; J.ld = 1024; J.N = 1024; J.ldd = 384;
            if (s == 8) { J.src = p.in[7] + (size_t)j * 65536; J.K = 64; J.koff = 0; J.dst = Wl2; }
            else if (s == 9) { J.src = p.in[10] + (size_t)j * 65536; J.K = 64; J.koff = 64; J.dst = Wl2 + (size_t)1024 * 384; }
            else if (s == 10) { J.src = p.in[15] + (size_t)j * 163840; J.K = 160; J.koff = 160; J.dst = Wl2 + (size_t)2048 * 384; }
            else { J.src = p.in[13]; J.K = 32; J.koff = 128; J.dst = Wl2 + (size_t)3072 * 384; if (j == 0) J.N = 0; }
        }
    } else if (id < 26) {
        const int j = id - 24;
        J.src = p.in[21] + (size_t)j * 1048576; J.ld = 1024; J.K = 1024; J.N = 1024; J.dst = W + (size_t)j * (10 * MiB) + 9 * MiB; J.ldd = 1024;
    } else if (id < 34) {
        const int i = (id - 26) >> 1, s = (id - 26) & 1;
        h16* base = W + 20 * MiB + (size_t)i * (17 * MiB / 2);
        if (s == 0) { J.src = p.in[33] + (size_t)i * 1024 * 5632; J.ld = 5632; J.K = 1024; J.N = 5632; J.dst = base; J.ldd = 1024; }
        else { J.src = p.in[36] + (size_t)i * 2816 * 1024; J.ld = 1024; J.K = 2816; J.N = 1024; J.dst = base + (size_t)11 * MiB / 2; J.ldd = 2816; }
    } else {
        const int j = (id - 34) >> 2, s = (id - 34) & 3;
        h16* base = W + 54 * MiB + (size_t)j * (5 * MiB / 2);
        if (s == 0) { J.src = p.in[22] + (size_t)j * 1024 * 456; J.ld = 456; J.K = 1024; J.N = 456; J.dst = base; J.ldd = 1024; }
        else if (s == 1) { J.mode = 2; J.N = 56; J.dst = base + (size_t)456 * 1024; J.ldd = 1024; }
        else if (s == 2) { J.src = p.in[28] + (size_t)j * 256 * 512; J.ld = 512; J.K = 256; J.N = 512; J.dst = base + MiB / 2 + (size_t)2048 * 256; J.ldd = 256; }
        else { J.src = p.in[31] + (size_t)j * 1048576; J.ld = 1024; J.K = 1024; J.N = 1024; J.dst = base + 3 * MiB / 2; J.ldd = 1024; }
    }
    return J;
}
__device__ __forceinline__ h16* w_rwkv_big(unsigned char* ws, int j) { return (h16*)(ws + OFF_W) + (size_t)j * (10 * MiB); }
__device__ __forceinline__ h16* w_rwkv_l1(unsigned char* ws, int j) { return w_rwkv_big(ws, j) + 3 * MiB; }
__device__ __forceinline__ h16* w_rwkv_l2(unsigned char* ws, int j) { return w_rwkv_big(ws, j) + 7 * MiB; }
__device__ __forceinline__ h16* w_rwkv_o(unsigned char* ws, int j) { return w_rwkv_big(ws, j) + 9 * MiB; }
__device__ __forceinline__ h16* w_ffn_up(unsigned char* ws, int i) { return (h16*)(ws + OFF_W) + 20 * MiB + (size_t)i * (17 * MiB / 2); }
__device__ __forceinline__ h16* w_ffn_dn(unsigned char* ws, int i) { return w_ffn_up(ws, i) + (size_t)11 * MiB / 2; }
__device__ __forceinline__ h16* w_dsa_in(unsigned char* ws, int j) { return (h16*)(ws + OFF_W) + 54 * MiB + (size_t)j * (5 * MiB / 2); }
__device__ __forceinline__ h16* w_dsa_q(unsigned char* ws, int j) { return w_dsa_in(ws, j) + MiB / 2; }
__device__ __forceinline__ h16* w_dsa_uvt(unsigned char* ws, int j) { return w_dsa_in(ws, j) + 5 * MiB / 4; }
__device__ __forceinline__ h16* w_dsa_o(unsigned char* ws, int j) { return w_dsa_in(ws, j) + 3 * MiB / 2; }

__device__ __forceinline__ void prep_phase(const Params& p, unsigned char* smem) {
    const int tid = opaque_tid();
    const size_t gtid = (size_t)blockIdx.x * 512 + tid, nth = (size_t)gridDim.x * 512;
    h16* x16 = (h16*)(p.ws + OFF_X16);
    for (size_t idx = gtid; idx < (size_t)MTOK * 128; idx += nth) {
        const int row = (int)(idx >> 7), c8 = (int)(idx & 127) * 8;
        const float* sp = p.in[0] + (size_t)row * 1024 + c8;
        const f32x4 a = *(const f32x4*)sp, b = *(const f32x4*)(sp + 4);
        *(u32x4*)(x16 + xrow(row) * 1024 + c8) = pack8(a, b);
    }
    for (size_t idx = gtid; idx < (size_t)NBATCH * 128; idx += nth) {
        const int b = (int)(idx >> 7), c8 = (int)(idx & 127) * 8;
        unsigned z = 0u; asm volatile("" : "+v"(z));
        *(u32x4*)(x16 + (size_t)b * 2049 * 1024 + c8) = (u32x4){z, z, z, z};
    }
    for (size_t idx = gtid; idx < (size_t)2 * 2048 * 256; idx += nth) {
        const int j = (int)(idx >> 19), rem = (int)(idx & 524287), n = rem >> 8, q = rem & 255, h = n >> 7, c = n & 127;
        const float* uq = p.in[25] + (size_t)j * 256 * 1024 + (size_t)q * 1024 + h * 64;
        const float* uk = p.in[26] + (size_t)j * 16 * 64 * 128 + (size_t)h * 64 * 128 + c;
        float s = 0.f;
        for (int d = 0; d < 64; ++d) s += uq[d] * uk[d * 128];
        w_dsa_q(p.ws, j)[(size_t)n * 256 + q] = (h16)(s * 0.18033688011112042f);
    }
    for (size_t idx = gtid; idx < (size_t)2 * 16 * 64 * 128; idx += nth) {
        const int j = (int)(idx >> 17), rem = (int)(idx & 131071), h = rem >> 13, n = (rem >> 7) & 63, k = rem & 127;
        w_dsa_uvt(p.ws, j)[(size_t)(h * 64 + n) * 128 + k] = (h16)p.in[27][(size_t)((j * 16 + h) * 128 + k) * 64 + n];
    }
    float* tile = (float*)smem;
    for (int id = 0; id < 42; ++id) {
        const TJob J = get_job(p, id);
        const int tk = J.ldd >> 6, tn = (J.N + 63) >> 6, ntile = tk * tn;
        for (int tix = blockIdx.x; tix < ntile; tix += gridDim.x) {
            const int k0 = (tix % tk) * 64, n0 = (tix / tk) * 64;
#pragma unroll
            for (int i = 0; i < 8; ++i) {
                const int k = i * 8 + (tid >> 6), n = tid & 63, kk = k0 + k, nn = n0 + n;
                float v = 0.f;
                if (nn < J.N && J.mode != 2) {
                    if (J.mode == 1) { const int ks = kk & 1023; const float mx = J.mix[ks]; v = J.src[(size_t)ks * J.ld + nn] * (kk < 1024 ? 1.0f - mx : mx); }
                    else if (kk >= J.koff && kk < J.koff + J.K) v = J.src[(size_t)(kk - J.koff) * J.ld + nn];
                }
                tile[k * 65 + n] = v;
            }
            __syncthreads();
#pragma unroll
            for (int i = 0; i < 8; ++i) {
                const int n = i * 8 + (tid >> 6), k = tid & 63, nn = n0 + n;
                if (nn < J.N) J.dst[(size_t)nn * J.ldd + k0 + k] = (h16)tile[k * 65 + n];
            }
            __syncthreads();
        }
    }
}

__device__ __forceinline__ void wave_sum4(float (&v)[4]) {
#pragma unroll
    for (int o = 32; o > 0; o >>= 1) {
        float t[4];
#pragma unroll
        for (int k = 0; k < 4; ++k) t[k] = __shfl_xor(v[k], o);
#pragma unroll
        for (int k = 0; k < 4; ++k) v[k] += t[k];
    }
}
__device__ __forceinline__ void ln_phase(const Params& p, const float* g, const float* b, bool final_out) {
    const int tid = opaque_tid();
    const int lane = tid & 63, wave = tid >> 6;
    float* tb = p.out;
    h16* x16 = (h16*)(p.ws + OFF_X16);
    f32x4 gg[4], bb[4];
#pragma unroll
    for (int i = 0; i < 4; ++i) { gg[i] = *(const f32x4*)(g + i * 256 + lane * 4); bb[i] = *(const f32x4*)(b + i * 256 + lane * 4); }
    for (int rowb = (blockIdx.x * 8 + wave) * 4; rowb < MTOK; rowb += gridDim.x * 32) {
        f32x4 v[4][4];
        float s[4];
#pragma unroll
        for (int k = 0; k < 4; ++k) {
            s[k] = 0.f;
            if (final_out) {
                const float* rp = tb + (size_t)(rowb + k) * 1024;
#pragma unroll
                for (int i = 0; i < 4; ++i) v[k][i] = *(const f32x4*)(rp + i * 256 + lane * 4);
            } else {
                const h16* hp = (const h16*)tb + (size_t)(rowb + k) * 1024;
#pragma unroll
                for (int i = 0; i < 4; ++i) { const h16x4 hv = *(const h16x4*)(hp + i * 256 + lane * 4); v[k][i] = (f32x4){(float)hv[0], (float)hv[1], (float)hv[2], (float)hv[3]}; }
            }
#pragma unroll
            for (int i = 0; i < 4; ++i) s[k] += (v[k][i][0] + v[k][i][1]) + (v[k][i][2] + v[k][i][3]);
        }
        wave_sum4(s);
        float q[4];
#pragma unroll
        for (int k = 0; k < 4; ++k) {
            s[k] *= (1.0f / 1024.0f); q[k] = 0.f;
#pragma unroll
            for (int i = 0; i < 4; ++i)
#pragma unroll
                for (int jj = 0; jj < 4; ++jj) { const float d = v[k][i][jj] - s[k]; q[k] += d * d; }
        }
        wave_sum4(q);
#pragma unroll
        for (int k = 0; k < 4; ++k) {
            const float rstd = rsqrtf(q[k] * (1.0f / 1024.0f) + 1e-5f);
            const int row = rowb + k;
#pragma unroll
            for (int i = 0; i < 4; ++i) {
                f32x4 y;
#pragma unroll
                for (int jj = 0; jj < 4; ++jj) y[jj] = (v[k][i][jj] - s[k]) * rstd * gg[i][jj] + bb[i][jj];
                if (final_out) *(f32x4*)(tb + (size_t)row * 1024 + i * 256 + lane * 4) = y;
                else { u32x2 w; w.x = pk2(y[0], y[1]); w.y = pk2(y[2], y[3]); *(u32x2*)(x16 + xrow(row) * 1024 + i * 256 + lane * 4) = w; }
            }
        }
    }
}

__device__ __forceinline__ void conv_phase(const Params& p, int layer) {
    const h16* u = (const h16*)(p.ws + F_U16);
    h16* act = (h16*)(p.ws + F_ACT);
    const float* cw = p.in[34] + (size_t)layer * 3 * 5632;
    const float* cb = p.in[35] + (size_t)layer * 5632;
    const size_t gtid = (size_t)blockIdx.x * 512 + opaque_tid(), nth = (size_t)gridDim.x * 512;
    const size_t ntask = (size_t)2048 * 352;
    for (size_t task = gtid; task < ntask; task += nth) {
        const int cgp = (int)(task % 352), rc = (int)(task / 352), f = cgp * 8, r0 = rc * 16;
        float wg[3][8], wv[3][8], bg[8], bv[8];
#pragma unroll
        for (int jj = 0; jj < 3; ++jj)
#pragma unroll
            for (int hlf = 0; hlf < 2; ++hlf) {
                const f32x4 a = *(const f32x4*)(cw + jj * 5632 + f + hlf * 4), c = *(const f32x4*)(cw + jj * 5632 + DFF + f + hlf * 4);
#pragma unroll
                for (int e = 0; e < 4; ++e) { wg[jj][hlf * 4 + e] = a[e]; wv[jj][hlf * 4 + e] = c[e]; }
            }
#pragma unroll
        for (int hlf = 0; hlf < 2; ++hlf) {
            const f32x4 a = *(const f32x4*)(cb + f + hlf * 4), c = *(const f32x4*)(cb + DFF + f + hlf * 4);
#pragma unroll
            for (int e = 0; e < 4; ++e) { bg[hlf * 4 + e] = a[e]; bv[hlf * 4 + e] = c[e]; }
        }
        float g2[8], g1[8], v2[8], v1[8];
#pragma unroll
        for (int e = 0; e < 8; ++e) { g2[e] = 0.f; g1[e] = 0.f; v2[e] = 0.f; v1[e] = 0.f; }
        if ((r0 & 2047) != 0) {
            unpack8(*(const u32x4*)(u + (size_t)(r0 - 2) * 5632 + f), g2); unpack8(*(const u32x4*)(u + (size_t)(r0 - 1) * 5632 + f), g1);
            unpack8(*(const u32x4*)(u + (size_t)(r0 - 2) * 5632 + DFF + f), v2); unpack8(*(const u32x4*)(u + (size_t)(r0 - 1) * 5632 + DFF + f), v1);
        }
#pragma unroll 1
        for (int i0 = 0; i0 < 16; i0 += 4) {
            u32x4 lg[4], lv[4];
#pragma unroll
            for (int i = 0; i < 4; ++i) { const size_t ro = (size_t)(r0 + i0 + i) * 5632; lg[i] = *(const u32x4*)(u + ro + f); lv[i] = *(const u32x4*)(u + ro + DFF + f); }
#pragma unroll
            for (int i = 0; i < 4; ++i) {
                float g0[8], v0[8], o[8];
                unpack8(lg[i], g0); unpack8(lv[i], v0);
#pragma unroll
                for (int e = 0; e < 8; ++e) {
                    const float G = wg[0][e] * g2[e] + wg[1][e] * g1[e] + wg[2][e] * g0[e] + bg[e];
                    const float V = wv[0][e] * v2[e] + wv[1][e] * v1[e] + wv[2][e] * v0[e] + bv[e];
                    o[e] = G * sigmoidf_(G) * V;
                    g2[e] = g1[e]; g1[e] = g0[e]; v2[e] = v1[e]; v1[e] = v0[e];
                }
                *(u32x4*)(act + (size_t)(r0 + i0 + i) * DFF + f) = pack8((f32x4){o[0], o[1], o[2], o[3]}, (f32x4){o[4], o[5], o[6], o[7]});
            }
        }
    }
}

__device__ __forceinline__ void mix_phase(const Params& p, int j) {
    const h16* x16 = (const h16*)(p.ws + OFF_X16);
    h16* xr = (h16*)p.out; h16* xk = (h16*)p.out + (size_t)MTOK * 1024; h16* xv = (h16*)(p.ws + R_G16);
    const float* mix = p.in[3] + j * 6 * 1024;
    const size_t gtid = (size_t)blockIdx.x * 512 + opaque_tid(), nth = (size_t)gridDim.x * 512;
    for (size_t idx = gtid; idx < (size_t)MTOK * 128; idx += nth) {
        const int row = (int)(idx >> 7), c8 = (int)(idx & 127) * 8;
        const h16* xp = x16 + xrow(row) * 1024 + c8;
        float xc[8], xq[8];
        unpack8(*(const u32x4*)xp, xc); unpack8(*(const u32x4*)(xp - 1024), xq);
#pragma unroll
        for (int e = 0; e < 8; ++e) xq[e] -= xc[e];
        const size_t o = (size_t)row * 1024 + c8;
#pragma unroll
        for (int bsel = 0; bsel < 3; ++bsel) {
            const f32x4 m0 = *(const f32x4*)(mix + bsel * 1024 + c8), m1 = *(const f32x4*)(mix + bsel * 1024 + c8 + 4);
            f32x4 a, b;
#pragma unroll
            for (int e = 0; e < 4; ++e) { a[e] = xc[e] + xq[e] * m0[e]; b[e] = xc[4 + e] + xq[4 + e] * m1[e]; }
            h16* dst = bsel == 0 ? xr : (bsel == 1 ? xk : xv);
            *(u32x4*)(dst + o) = pack8(a, b);
        }
    }
}

__device__ __forceinline__ float dppf(float x, const int ctrl_sel) {
    const int v = __builtin_bit_cast(int, x);
    int r;
    if (ctrl_sel == 0) r = __builtin_amdgcn_update_dpp(0, v, 0xB1, 0xF, 0xF, true);
    else if (ctrl_sel == 1) r = __builtin_amdgcn_update_dpp(0, v, 0x4E, 0xF, 0xF, true);
    else if (ctrl_sel == 2) r = __builtin_amdgcn_update_dpp(0, v, 0x141, 0xF, 0xF, true);
    else r = __builtin_amdgcn_update_dpp(0, v, 0x140, 0xF, 0xF, true);
    return __builtin_bit_cast(float, r);
}
__device__ __forceinline__ float red4(float x) { x += dppf(x, 0); x += dppf(x, 1); return x; }
__device__ __forceinline__ float red16(float x) { x += dppf(x, 0); x += dppf(x, 1); x += dppf(x, 2); x += dppf(x, 3); return x; }
__device__ __forceinline__ void unpack4(u32x2 w, float* f) {
    h16x4 h = __builtin_bit_cast(h16x4, w);
#pragma unroll
    for (int i = 0; i < 4; ++i) f[i] = (float)h[i];
}
constexpr int SCAN_BUF = 8256;
__device__ __forceinline__ void scan_phase(const Params& p, int j, unsigned char* smem) {
    const int tid = opaque_tid();
    const int wave = tid >> 6, lane = tid & 63, slot = wave >> 2, w4 = wave & 3;
    float* LB = (float*)smem + slot * (2 * SCAN_BUF);
    const h16* r16 = (const h16*)(p.ws + R_R16);
    const h16* k16 = (const h16*)(p.ws + R_K16);
    const h16* v16 = (j == 0) ? (const h16*)(p.ws + OFF_VF) : (const h16*)(p.ws + R_V16);
    const h16* g16 = (const h16*)(p.ws + R_G16);
    const h16* e16 = (const h16*)p.out;
    const h16* a16 = (const h16*)p.out + (size_t)MTOK * 1024;
    h16* y16 = (h16*)(p.ws + (j == 0 ? R_V16 : OFF_VF));
    const int tp = w4 * 4 + (lane >> 4), k4 = (lane & 15) * 4;
    const int vrow = w4 * 16 + (lane >> 2), kq = lane & 3;
    for (int pair = blockIdx.x; pair < 256; pair += gridDim.x) {
        const int chain = pair * 2 + slot, b = chain >> 4, h = chain & 15;
        const int col = h * 64 + k4;
        const f32x4 c_kk = *(const f32x4*)(p.in[16] + j * 1024 + col), c_ka = *(const f32x4*)(p.in[17] + j * 1024 + col), c_rk = *(const f32x4*)(p.in[18] + j * 1024 + col);
        const f32x4 c_lg = *(const f32x4*)(p.in[19] + j * 1024 + col), c_lb = *(const f32x4*)(p.in[20] + j * 1024 + col);
        f32x2 S[8];
#pragma unroll
        for (int i = 0; i < 8; ++i) S[i] = (f32x2){0.f, 0.f};
        u32x2 pr[6];
        {
            const size_t go = ((size_t)(b * 2048 + tp)) * 1024 + col;
            pr[0] = *(const u32x2*)(r16 + go); pr[1] = *(const u32x2*)(k16 + go); pr[2] = *(const u32x2*)(v16 + go);
            pr[3] = *(const u32x2*)(e16 + go); pr[4] = *(const u32x2*)(a16 + go); pr[5] = *(const u32x2*)(g16 + go);
        }
        for (int ch = 0; ch < 128; ++ch) {
            float* BUF = LB + (ch & 1) * SCAN_BUF;
            float* OPS = BUF; float* VB = BUF + 5120; float* GB = BUF + 6144; float* YB = BUF + 7168; float* BON = BUF + 8192;
            {
                float rf[4], kf[4], vf[4], ef[4], af[4], gf[4];
                unpack4(pr[0], rf); unpack4(pr[1], kf); unpack4(pr[2], vf); unpack4(pr[3], ef); unpack4(pr[4], af); unpack4(pr[5], gf);
                float kk[4]; float ss = 0.f;
#pragma unroll
                for (int i = 0; i < 4; ++i) { kk[i] = kf[i] * c_kk[i]; ss += kk[i] * kk[i]; }
                ss = red16(ss);
                const float inv = 1.0f / fmaxf(sqrtf(ss), 1e-12f);
                f32x4 A4, B4, W4, K4, R4; float bs = 0.f;
#pragma unroll
                for (int i = 0; i < 4; ++i) {
                    const float kn = kk[i] * inv;
                    A4[i] = -kn; B4[i] = kn * af[i];
                    W4[i] = __expf(-ef[i]);
                    const float km = kf[i] * (1.0f + (af[i] - 1.0f) * c_ka[i]);
                    K4[i] = km; R4[i] = rf[i];
                    bs += rf[i] * km * c_rk[i];
                }
                bs = red16(bs);
                float* o = OPS + tp * 320 + k4;
                *(f32x4*)(o) = A4; *(f32x4*)(o + 64) = B4; *(f32x4*)(o + 128) = W4; *(f32x4*)(o + 192) = K4; *(f32x4*)(o + 256) = R4;
                *(f32x4*)(VB + tp * 64 + k4) = (f32x4){vf[0], vf[1], vf[2], vf[3]};
                *(f32x4*)(GB + tp * 64 + k4) = (f32x4){gf[0], gf[1], gf[2], gf[3]};
                if ((lane & 15) == 0) BON[tp] = bs;
            }
            if (ch + 1 < 128) {
                const size_t go = ((size_t)(b * 2048 + (ch + 1) * 16 + tp)) * 1024 + col;
                pr[0] = *(const u32x2*)(r16 + go); pr[1] = *(const u32x2*)(k16 + go); pr[2] = *(const u32x2*)(v16 + go);
                pr[3] = *(const u32x2*)(e16 + go); pr[4] = *(const u32x2*)(a16 + go); pr[5] = *(const u32x2*)(g16 + go);
            }
            __syncthreads();
#pragma unroll 2
            for (int t = 0; t < 16; ++t) {
                const float* op = OPS + t * 320 + kq * 16;
                f32x4 A4[4], B4[4], W4[4], K4[4], R4[4];
#pragma unroll
                for (int i = 0; i < 4; ++i) A4[i] = *(const f32x4*)(op + i * 4);
#pragma unroll
                for (int i = 0; i < 4; ++i) { W4[i] = *(const f32x4*)(op + 128 + i * 4); B4[i] = *(const f32x4*)(op + 64 + i * 4); K4[i] = *(const f32x4*)(op + 192 + i * 4); }
#pragma unroll
                for (int i = 0; i < 4; ++i) R4[i] = *(const f32x4*)(op + 256 + i * 4);
                const float vv = VB[t * 64 + vrow];
                f32x2 s0 = {0.f, 0.f}, s1 = {0.f, 0.f};
#pragma unroll
                for (int i = 0; i < 4; ++i) { s0 += S[2 * i] * (f32x2){A4[i][0], A4[i][1]}; s1 += S[2 * i + 1] * (f32x2){A4[i][2], A4[i][3]}; }
                const float sa = red4((s0[0] + s0[1]) + (s1[0] + s1[1]));
                const f32x2 sa2 = {sa, sa}, vv2 = {vv, vv};
#pragma unroll
                for (int i = 0; i < 4; ++i) {
                    S[2 * i] = S[2 * i] * (f32x2){W4[i][0], W4[i][1]} + sa2 * (f32x2){B4[i][0], B4[i][1]} + vv2 * (f32x2){K4[i][0], K4[i][1]};
                    S[2 * i + 1] = S[2 * i + 1] * (f32x2){W4[i][2], W4[i][3]} + sa2 * (f32x2){B4[i][2], B4[i][3]} + vv2 * (f32x2){K4[i][2], K4[i][3]};
                }
                f32x2 y0 = {0.f, 0.f}, y1 = {0.f, 0.f};
#pragma unroll
                for (int i = 0; i < 4; ++i) { y0 += S[2 * i] * (f32x2){R4[i][0], R4[i][1]}; y1 += S[2 * i + 1] * (f32x2){R4[i][2], R4[i][3]}; }
                const float y = red4((y0[0] + y0[1]) + (y1[0] + y1[1]));
                if (kq == 0) YB[t * 64 + vrow] = y;
            }
            __syncthreads();
            {
                const f32x4 y4 = *(const f32x4*)(YB + tp * 64 + k4), v4 = *(const f32x4*)(VB + tp * 64 + k4), g4 = *(const f32x4*)(GB + tp * 64 + k4);
                const float mu = red16((y4[0] + y4[1]) + (y4[2] + y4[3])) * (1.0f / 64.0f);
                float q = 0.f;
#pragma unroll
                for (int i = 0; i < 4; ++i) { const float d = y4[i] - mu; q += d * d; }
                const float rstd = rsqrtf(red16(q) * (1.0f / 64.0f) + 64e-5f);
                const float bon = BON[tp];
                float o[4];
#pragma unroll
                for (int i = 0; i < 4; ++i) o[i] = ((y4[i] - mu) * rstd * c_lg[i] + c_lb[i] + bon * v4[i]) * g4[i];
                u32x2 w; w.x = pk2(o[0], o[1]); w.y = pk2(o[2], o[3]);
                *(u32x2*)(y16 + ((size_t)(b * 2048 + ch * 16 + tp)) * 1024 + col) = w;
            }
        }
        __syncthreads();
    }
}

__device__ __forceinline__ void dsa_norm_phase(const Params& p, int j, unsigned char* smem) {
    const int tid = opaque_tid();
    const int lane = tid & 63, wave = tid >> 6;
    const float* hin = (const float*)(p.ws + D_HIN);
    h16* cq = (h16*)(p.ws + D_CQ); h16* ckv = (h16*)(p.ws + D_CKV); h16* ckvt = (h16*)(p.ws + D_CKVT); h16* kidx = (h16*)(p.ws + D_KIDX);
    float* widx = (float*)(p.ws + D_WIDX);
    const f32x4 gq = *(const f32x4*)(p.in[23] + j * 256 + lane * 4);
    const f32x2 gkv = *(const f32x2*)(p.in[24] + j * 128 + lane * 2);
    const float gi = p.in[29][j * 64 + lane], bi = p.in[30][j * 64 + lane];
    h16* wl = (h16*)(smem + wave * 2048);
    for (int grp = blockIdx.x * 8 + wave; grp < MTOK / 8; grp += gridDim.x * 8) {
        const int r0 = grp * 8;
        for (int i = 0; i < 8; ++i) {
            const int row = r0 + i;
            const float* hp = hin + (size_t)row * 512;
            const f32x4 vq = *(const f32x4*)(hp + lane * 4);
            const f32x2 vk = *(const f32x2*)(hp + 256 + lane * 2);
            const float vi = hp[384 + lane];
            float ssq = wave_sum(vq[0] * vq[0] + vq[1] * vq[1] + vq[2] * vq[2] + vq[3] * vq[3]);
            const float rq = rsqrtf(ssq * (1.0f / 256.0f) + 1e-6f);
            u32x2 w; w.x = pk2(vq[0] * rq * gq[0], vq[1] * rq * gq[1]); w.y = pk2(vq[2] * rq * gq[2], vq[3] * rq * gq[3]);
            *(u32x2*)(cq + (size_t)row * 256 + lane * 4) = w;
            float ssk = wave_sum(vk[0] * vk[0] + vk[1] * vk[1]);
            const float rk = rsqrtf(ssk * (1.0f / 128.0f) + 1e-6f);
            const unsigned wk = pk2(vk[0] * rk * gkv[0], vk[1] * rk * gkv[1]);
            *(unsigned*)(ckv + (size_t)row * 128 + lane * 2) = wk;
            *(unsigned*)(wl + i * 128 + lane * 2) = wk;
            const float mu = wave_sum(vi) * (1.0f / 64.0f);
            const float dv = vi - mu;
            const float var = wave_sum(dv * dv) * (1.0f / 64.0f);
            kidx[(size_t)row * 64 + lane] = (h16)(dv * rsqrtf(var + 1e-5f) * gi + bi);
            if (lane < 8) widx[(size_t)row * 8 + lane] = hp[448 + lane] * 0.044194173824159216f;
        }
        asm volatile("s_waitcnt lgkmcnt(0)" ::: "memory");
        const int b = r0 >> 11, t0 = r0 & 2047;
#pragma unroll
        for (int dd = 0; dd < 2; ++dd) {
            const int d = lane * 2 + dd;
            h16x8 hv;
#pragma unroll
            for (int i = 0; i < 8; ++i) hv[i] = wl[i * 128 + d];
            *(h16x8*)(ckvt + ((size_t)(b * 128 + d)) * 2048 + t0) = hv;
        }
        asm volatile("s_waitcnt lgkmcnt(0)" ::: "memory");
    }
}

constexpr int ROWP = 2052;
__device__ __forceinline__ unsigned fkey(float x) {
    if (x == 0.0f) x = 0.0f;
    const unsigned u = __float_as_uint(x);
    return (u & 0x80000000u) ? ~u : (u | 0x80000000u);
}
__device__ __forceinline__ void dsa_index_phase(const Params& p, unsigned char* smem) {
    const int tid = opaque_tid(), wave = tid >> 6, lane = tid & 63, r = lane & 15, q = lane >> 4;
    float* SC = (float*)smem;
    const h16* qidx = (const h16*)(p.ws + D_QIDX);
    const h16* kidx = (const h16*)(p.ws + D_KIDX);
    const float* widx = (const float*)(p.ws + D_WIDX);
    unsigned* maskb = (unsigned*)(p.ws + D_MASK);
    for (int qi = blockIdx.x, it = 0; qi < MTOK / 16; qi += gridDim.x, ++it) {
        const int qt = (it & 1) ? ((qi & ~127) | (127 - (qi & 127))) : qi;
        const int row0 = qt * 16, b = row0 >> 11, t0 = row0 & 2047;
        const int nkt = (t0 >> 4) + 1;
        {
            h16x8 qf[8][2]; float wq[8];
#pragma unroll
            for (int h = 0; h < 8; ++h) {
#pragma unroll
                for (int kk = 0; kk < 2; ++kk) qf[h][kk] = *(const h16x8*)(qidx + (size_t)(row0 + r) * 512 + h * 64 + kk * 32 + q * 8);
                wq[h] = widx[(size_t)(row0 + r) * 8 + h];
            }
            for (int kt = wave; kt < nkt; kt += 16) {
                const bool two = (kt + 8 < nkt);
                const int s0 = kt * 16, s1 = two ? s0 + 128 : s0;
                const h16* kp = kidx + (size_t)(b * 2048 + s0 + r) * 64 + q * 8;
                const h16* kp1 = kidx + (size_t)(b * 2048 + s1 + r) * 64 + q * 8;
                const h16x8 k0 = *(const h16x8*)kp, k1 = *(const h16x8*)(kp + 32), k2 = *(const h16x8*)kp1, k3 = *(const h16x8*)(kp1 + 32);
                f32x4 sc = {0.f, 0.f, 0.f, 0.f}, sd = {0.f, 0.f, 0.f, 0.f};
#pragma unroll
                for (int h = 0; h < 8; ++h) {
                    f32x4 acc = {0.f, 0.f, 0.f, 0.f}, acd = {0.f, 0.f, 0.f, 0.f};
                    acc = __builtin_amdgcn_mfma_f32_16x16x32_f16(k0, qf[h][0], acc, 0, 0, 0);
                    acd = __builtin_amdgcn_mfma_f32_16x16x32_f16(k2, qf[h][0], acd, 0, 0, 0);
                    acc = __builtin_amdgcn_mfma_f32_16x16x32_f16(k1, qf[h][1], acc, 0, 0, 0);
                    acd = __builtin_amdgcn_mfma_f32_16x16x32_f16(k3, qf[h][1], acd, 0, 0, 0);
#pragma unroll
                    for (int jj = 0; jj < 4; ++jj) { sc[jj] += fmaxf(acc[jj], 0.f) * wq[h]; sd[jj] += fmaxf(acd[jj], 0.f) * wq[h]; }
                }
                *(f32x4*)(SC + r * ROWP + s0 + q * 4) = sc;
                if (two) *(f32x4*)(SC + r * ROWP + s1 + q * 4) = sd;
            }
        }
        __syncthreads();
        for (int qq = 0; qq < 2; ++qq) {
            const int ql = wave * 2 + qq, t = t0 + ql;
            const float* srow = SC + ql * ROWP;
            const int ni = (t >> 6) + 1;
            unsigned u[32];
#pragma unroll
            for (int i = 0; i < 32; ++i) {
                u[i] = 0u;
                if (i < ni) { const int s = i * 64 + lane; if (s <= t) u[i] = fkey(srow[s]); }
            }
            unsigned myw = 0u;
            if (t < 256) {
#pragma unroll
                for (int i = 0; i < 32; ++i) { const unsigned long long sm = __ballot(u[i] != 0u); if ((lane >> 1) == i) myw = (lane & 1) ? (unsigned)(sm >> 32) : (unsigned)sm; }
            } else {
                unsigned T = 0u;
                for (int bit = 31; bit >= 0; --bit) {
                    const unsigned cand = T | (1u << bit);
                    int c0 = 0, c1 = 0;
                    if (ni <= 16) {
#pragma unroll
                        for (int i = 0; i < 16; i += 2) { c0 += (u[i] >= cand) ? 1 : 0; c1 += (u[i + 1] >= cand) ? 1 : 0; }
                    } else {
#pragma unroll
                        for (int i = 0; i < 32; i += 2) { c0 += (u[i] >= cand) ? 1 : 0; c1 += (u[i + 1] >= cand) ? 1 : 0; }
                    }
                    int c = c0 + c1;
                    c += __builtin_amdgcn_update_dpp(0, c, 0xB1, 0xF, 0xF, true);
                    c += __builtin_amdgcn_update_dpp(0, c, 0x4E, 0xF, 0xF, true);
                    c += __builtin_amdgcn_update_dpp(0, c, 0x141, 0xF, 0xF, true);
                    c += __builtin_amdgcn_update_dpp(0, c, 0x140, 0xF, 0xF, true);
                    const int cnt = __builtin_amdgcn_readlane(c, 0) + __builtin_amdgcn_readlane(c, 16) + __builtin_amdgcn_readlane(c, 32) + __builtin_amdgcn_readlane(c, 48);
                    if (cnt >= 256) T = cand;
                }
                int cgt = 0;
#pragma unroll
                for (int i = 0; i < 32; ++i) if (i < ni) cgt += __popcll(__ballot(u[i] > T));
                const int need = 256 - cgt;
                int running = 0;
                const unsigned long long lt = (lane == 0) ? 0ull : (~0ull >> (64 - lane));
#pragma unroll
                for (int i = 0; i < 32; ++i) {
                    if (i < ni) {
                        const unsigned long long eq = __ballot(u[i] == T);
                        const int rank = running + __popcll(eq & lt);
                        const unsigned long long sm = __ballot(u[i] > T || (u[i] == T && rank < need));
                        running += __popcll(eq);
                        if ((lane >> 1) == i) myw = (lane & 1) ? (unsigned)(sm >> 32) : (unsigned)sm;
                    }
                }
            }
            maskb[(size_t)(row0 + ql) * 64 + lane] = myw;
        }
        __syncthreads();
    }
}

__device__ __forceinline__ float xmax_16_32(float x) {
    const unsigned u = __builtin_bit_cast(unsigned, x);
    auto r = __builtin_amdgcn_permlane16_swap(u, u, false, false);
    float m = fmaxf(__builtin_bit_cast(float, (unsigned)r[0]), __builtin_bit_cast(float, (unsigned)r[1]));
    const unsigned u2 = __builtin_bit_cast(unsigned, m);
    auto r2 = __builtin_amdgcn_permlane32_swap(u2, u2, false, false);
    return fmaxf(__builtin_bit_cast(float, (unsigned)r2[0]), __builtin_bit_cast(float, (unsigned)r2[1]));
}
__device__ __forceinline__ float xsum_16_32(float x) {
    const unsigned u = __builtin_bit_cast(unsigned, x);
    auto r = __builtin_amdgcn_permlane16_swap(u, u, false, false);
    float m = __builtin_bit_cast(float, (unsigned)r[0]) + __builtin_bit_cast(float, (unsigned)r[1]);
    const unsigned u2 = __builtin_bit_cast(unsigned, m);
    auto r2 = __builtin_amdgcn_permlane32_swap(u2, u2, false, false);
    return __builtin_bit_cast(float, (unsigned)r2[0]) + __builtin_bit_cast(float, (unsigned)r2[1]);
}
constexpr int AT_KROW = 272, AT_VROW = 144, AT_KBYTES = 64 * AT_KROW, AT_VBYTES = 128 * AT_VROW, AT_STAGE = AT_KBYTES + AT_VBYTES, AT_BL = 2 * AT_STAGE, AT_QL = AT_BL + 16 * 132 * 4;
static_assert(AT_QL + 65536 <= LDS_BYTES, "attention LDS");
__device__ __forceinline__ void dsa_attn_phase(const Params& p, int j, unsigned char* smem) {
    const int tid = opaque_tid(), wave = tid >> 6, lane = tid & 63, r = lane & 15, q = lane >> 4;
    float* BL = (float*)(smem + AT_BL);
    for (int idx = tid; idx < 16 * 129; idx += 512) {
        const int h = idx / 129, d = idx % 129;
        int bk = d;
        if (d >= 16) { bk = 16 + (int)(logf((float)d * (1.0f / 16.0f)) / 2.0794415416798357f * 16.0f); bk = bk > 31 ? 31 : bk; }
        BL[h * 132 + d] = p.in[32][bk * 16 + h] * 1.4426950408889634f;
    }
    __syncthreads();
    const h16* qabs = (const h16*)(p.ws + D_QABS);
    const h16* ckv = (const h16*)(p.ws + D_CKV);
    const h16* ckvt = (const h16*)(p.ws + D_CKVT);
    const unsigned* maskb = (const unsigned*)(p.ws + D_MASK);
    h16* o16 = (h16*)(p.ws + D_O16);
    const h16* wuvt = w_dsa_uvt(p.ws, j);
    const float NINF = -__builtin_inff();
    const int krow0 = tid >> 4, kcc = tid & 15, vrow0 = tid >> 3, vcc = tid & 7;
    for (int qi = blockIdx.x, it = 0; qi < MTOK / 16; qi += gridDim.x, ++it) {
        const int qt = (it & 1) ? ((qi & ~127) | (127 - (qi & 127))) : qi;
        const int row0 = qt * 16, b = row0 >> 11, t0 = row0 & 2047, nst = (t0 + 16 + 63) >> 6, tq = t0 + r;
        const h16* kg = ckv + (size_t)(b * 2048) * 128;
        const h16* vg = ckvt + (size_t)(b * 128) * 2048;
        u32x4 sk[2], sv[2];
#pragma unroll
        for (int i = 0; i < 2; ++i) {
            sk[i] = *(const u32x4*)(kg + (size_t)(krow0 + i * 32) * 128 + kcc * 8);
            sv[i] = *(const u32x4*)(vg + (size_t)(vrow0 + i * 64) * 2048 + vcc * 8);
        }
        unsigned char* QL = smem + AT_QL + wave * 8192 + lane * 16;
        {
            h16x8 qtmp[8];
#pragma unroll
            for (int f = 0; f < 8; ++f) qtmp[f] = *(const h16x8*)(qabs + (size_t)(row0 + r) * 2048 + (2 * wave + (f >> 2)) * 128 + (f & 3) * 32 + q * 8);
#pragma unroll
            for (int f = 0; f < 8; ++f) *(h16x8*)(QL + f * 1024) = qtmp[f];
        }
        f32x4 O[2][8];
#pragma unroll
        for (int hh = 0; hh < 2; ++hh)
#pragma unroll
            for (int dt = 0; dt < 8; ++dt) O[hh][dt] = (f32x4){0.f, 0.f, 0.f, 0.f};
        float mrun[2] = {NINF, NINF}, lrun[2] = {0.f, 0.f};
#pragma unroll
        for (int i = 0; i < 2; ++i) {
            *(u32x4*)(smem + (krow0 + i * 32) * AT_KROW + kcc * 16) = sk[i];
            *(u32x4*)(smem + AT_KBYTES + (vrow0 + i * 64) * AT_VROW + vcc * 16) = sv[i];
        }
        u32x2 mwn = *(const u32x2*)(maskb + (size_t)(row0 + r) * 64);
        __syncthreads();
        for (int st = 0; st < nst; ++st) {
            const int s0 = st * 64;
            const unsigned char* Kb = smem + (st & 1) * AT_STAGE;
            const unsigned char* Vb = Kb + AT_KBYTES;
            const u32x2 mw2 = mwn;
            if (st + 1 < nst) mwn = *(const u32x2*)(maskb + (size_t)(row0 + r) * 64 + st * 2 + 2);
            if (st + 1 < nst) {
#pragma unroll
                for (int i = 0; i < 2; ++i) {
                    sk[i] = *(const u32x4*)(kg + (size_t)(s0 + 64 + krow0 + i * 32) * 128 + kcc * 8);
                    sv[i] = *(const u32x4*)(vg + (size_t)(vrow0 + i * 64) * 2048 + s0 + 64 + vcc * 8);
                }
            }
#pragma nounroll
            for (int hf = 0; hf < 2; ++hf) {
                const unsigned mwq = (hf ? mw2.y : mw2.x) >> (q * 4);
                const bool far = (s0 + hf * 32 + 31 + 128 <= t0);
                f32x4 sc[2][2];
                {
                    h16x8 qf[2][4], kf[2][4];
#pragma unroll
                    for (int f = 0; f < 8; ++f) qf[f >> 2][f & 3] = *(const h16x8*)(QL + f * 1024);
#pragma unroll
                    for (int tt = 0; tt < 2; ++tt)
#pragma unroll
                        for (int kk = 0; kk < 4; ++kk) kf[tt][kk] = *(const h16x8*)(Kb + (hf * 32 + tt * 16 + r) * AT_KROW + kk * 64 + q * 16);
                    __builtin_amdgcn_sched_barrier(0);
#pragma unroll
                    for (int tt = 0; tt < 2; ++tt)
#pragma unroll
                        for (int hh = 0; hh < 2; ++hh) {
                            f32x4 acc = {0.f, 0.f, 0.f, 0.f};
#pragma unroll
                            for (int kk = 0; kk < 4; ++kk) acc = __builtin_amdgcn_mfma_f32_16x16x32_f16(kf[tt][kk], qf[hh][kk], acc, 0, 0, 0);
                            sc[hh][tt] = acc;
                        }
                    __builtin_amdgcn_sched_barrier(0);
                }
                h16x4 vlo[8], vhi[8];
#pragma unroll
                for (int dt = 0; dt < 4; ++dt) {
                    const unsigned char* vp = Vb + (dt * 16 + r) * AT_VROW + (hf * 32 + q * 4) * 2;
                    vlo[dt] = *(const h16x4*)vp; vhi[dt] = *(const h16x4*)(vp + 32);
                }
                __builtin_amdgcn_sched_barrier(0);
                h16x8 pf[2]; float alpha[2];
#pragma unroll
                for (int hh = 0; hh < 2; ++hh) {
                    const int h = 2 * wave + hh;
                    float x[8]; float mx = NINF;
                    if (far) {
                        const float cb = BL[h * 132 + 128];
#pragma unroll
                        for (int tt = 0; tt < 2; ++tt)
#pragma unroll
                            for (int jj = 0; jj < 4; ++jj) {
                                const float xv = ((mwq >> (tt * 16 + jj)) & 1u) ? sc[hh][tt][jj] + cb : NINF;
                                x[tt * 4 + jj] = xv; mx = fmaxf(mx, xv);
                            }
                    } else {
#pragma unroll
                        for (int tt = 0; tt < 2; ++tt)
#pragma unroll
                            for (int jj = 0; jj < 4; ++jj) {
                                const int kix = tt * 16 + q * 4 + jj;
                                int dist = tq - (s0 + hf * 32 + kix); dist = dist < 0 ? 0 : (dist > 128 ? 128 : dist);
                                const float v = sc[hh][tt][jj] + BL[h * 132 + dist];
                                const float xv = ((mwq >> (tt * 16 + jj)) & 1u) ? v : NINF;
                                x[tt * 4 + jj] = xv; mx = fmaxf(mx, xv);
                            }
                    }
                    mx = xmax_16_32(mx);
                    const float mnew = fmaxf(mrun[hh], mx);
                    const float mref = (mnew == NINF) ? 0.f : mnew;
                    alpha[hh] = __builtin_amdgcn_exp2f(mrun[hh] - mref);
                    mrun[hh] = mnew;
                    float ps = 0.f;
#pragma unroll
                    for (int i = 0; i < 8; ++i) { const float pv = __builtin_amdgcn_exp2f(x[i] - mref); ps += pv; pf[hh][i] = (h16)pv; }
                    lrun[hh] = lrun[hh] * alpha[hh] + ps;
                }
                __builtin_amdgcn_sched_barrier(0);
#pragma unroll
                for (int dt = 4; dt < 8; ++dt) {
                    const unsigned char* vp = Vb + (dt * 16 + r) * AT_VROW + (hf * 32 + q * 4) * 2;
                    vlo[dt] = *(const h16x4*)vp; vhi[dt] = *(const h16x4*)(vp + 32);
                }
                const bool resc = __ballot(alpha[0] != 1.0f || alpha[1] != 1.0f) != 0ull;
                if (resc) {
#pragma unroll
                    for (int dt = 0; dt < 8; ++dt) { O[0][dt] *= alpha[0]; O[1][dt] *= alpha[1]; }
                }
#pragma unroll
                for (int dt = 0; dt < 8; ++dt) {
                    const h16x8 vf = {vlo[dt][0], vlo[dt][1], vlo[dt][2], vlo[dt][3], vhi[dt][0], vhi[dt][1], vhi[dt][2], vhi[dt][3]};
#pragma unroll
                    for (int hh = 0; hh < 2; ++hh) O[hh][dt] = __builtin_amdgcn_mfma_f32_16x16x32_f16(vf, pf[hh], O[hh][dt], 0, 0, 0);
                }
                __builtin_amdgcn_sched_barrier(0);
            }
            if (st + 1 < nst) {
                unsigned char* Kn = smem + ((st + 1) & 1) * AT_STAGE;
#pragma unroll
                for (int i = 0; i < 2; ++i) {
                    *(u32x4*)(Kn + (krow0 + i * 32) * AT_KROW + kcc * 16) = sk[i];
                    *(u32x4*)(Kn + AT_KBYTES + (vrow0 + i * 64) * AT_VROW + vcc * 16) = sv[i];
                }
            }
            __syncthreads();
        }
#pragma unroll
        for (int hh = 0; hh < 2; ++hh) {
            const int h = 2 * wave + hh;
            const float lt = xsum_16_32(lrun[hh]);
            const float inv = 1.0f / lt;
            h16x8 b8[4];
#pragma unroll
            for (int kk = 0; kk < 4; ++kk)
#pragma unroll
                for (int i = 0; i < 4; ++i) { b8[kk][i] = (h16)(O[hh][2 * kk][i] * inv); b8[kk][4 + i] = (h16)(O[hh][2 * kk + 1][i] * inv); }
#pragma unroll
            for (int vp2 = 0; vp2 < 2; ++vp2) {
                h16x4 alo[2][4], ahi[2][4];
#pragma unroll
                for (int v2 = 0; v2 < 2; ++v2)
#pragma unroll
                    for (int kk = 0; kk < 4; ++kk) {
                        const h16* ap = wuvt + (size_t)(h * 64 + (vp2 * 2 + v2) * 16 + r) * 128 + kk * 32 + q * 4;
                        alo[v2][kk] = *(const h16x4*)ap; ahi[v2][kk] = *(const h16x4*)(ap + 16);
                    }
                __builtin_amdgcn_sched_barrier(0);
#pragma unroll
                for (int v2 = 0; v2 < 2; ++v2) {
                    const int vt = vp2 * 2 + v2;
                    f32x4 acc = {0.f, 0.f, 0.f, 0.f};
#pragma unroll
                    for (int kk = 0; kk < 4; ++kk) {
                        const h16x8 a8 = {alo[v2][kk][0], alo[v2][kk][1], alo[v2][kk][2], alo[v2][kk][3], ahi[v2][kk][0], ahi[v2][kk][1], ahi[v2][kk][2], ahi[v2][kk][3]};
                        acc = __builtin_amdgcn_mfma_f32_16x16x32_f16(a8, b8[kk], acc, 0, 0, 0);
                    }
                    u32x2 w; w.x = pk2(acc[0], acc[1]); w.y = pk2(acc[2], acc[3]);
                    *(u32x2*)(o16 + (size_t)(row0 + r) * 1024 + h * 64 + vt * 16 + q * 4) = w;
                }
                __builtin_amdgcn_sched_barrier(0);
            }
            __builtin_amdgcn_sched_barrier(0);
        }
    }
    __syncthreads();
}

constexpr size_t OFF_BAR = 951 * MiB;
__device__ __forceinline__ void grid_bar(unsigned* ctr, unsigned& target, unsigned nblk) {
    asm volatile("s_waitcnt vmcnt(0) lgkmcnt(0)" ::: "memory");
    __syncthreads();
    target += nblk;
    if (threadIdx.x == 0) {
        __builtin_amdgcn_fence(__ATOMIC_RELEASE, "agent");
        asm volatile("s_waitcnt vmcnt(0)" ::: "memory");
        __hip_atomic_fetch_add(ctr, 1u, __ATOMIC_RELAXED, __HIP_MEMORY_SCOPE_AGENT);
        while (__hip_atomic_load(ctr, __ATOMIC_RELAXED, __HIP_MEMORY_SCOPE_AGENT) < target) __builtin_amdgcn_s_sleep(1);
        __builtin_amdgcn_fence(__ATOMIC_ACQUIRE, "agent");
        asm volatile("s_waitcnt vmcnt(0)" ::: "memory");
    }
    __syncthreads();
}

__global__ void __launch_bounds__(512) mega_fwd(Params p) {
    extern __shared__ __attribute__((aligned(16))) unsigned char smem[];
    cg::grid_group grid = cg::this_grid();
    unsigned char* ws = p.ws;
    h16* x16 = (h16*)(ws + OFF_X16);
    unsigned* barctr = (unsigned*)(ws + OFF_BAR);
    unsigned bar_target = 0u;
    for (int ph = p.ph_lo; ph < p.ph_hi; ++ph) {
        const unsigned e = p.prog[ph];
        const int kind = e & 15, L = (e >> 4) & 3, sub = (e >> 6) & 1, j = L >> 1;
        const int nrep = 1 + (int)(e >> 7);
        for (int rep = 0; rep < nrep; ++rep) {
        if (rep) grid_bar(barctr, bar_target, gridDim.x);
        const bool isgemm = (kind == K_R1 || kind == K_R2 || kind == K_R4 || kind == K_F1 || kind == K_F3 || kind == K_D1 || kind == K_D3 || kind == K_D6);
        if (isgemm) {
            const int ngemm = (kind == K_R1) ? 2 : 1;
            for (int gi = 0; gi < ngemm; ++gi) {
            pg8::Gemm g; pg8::Epi E;
            g.M = MTOK; g.N = 1024; g.K = 1024; g.lda = 1024; g.amode = 0; g.pm0 = 0; g.A = x16; g.A2 = x16; g.Bt = x16;
            E.mode = E_RESID; E.pm0 = 0; E.j = j; E.pnoff = 0; E.fin = (L == 3 && kind == K_F3) ? 1 : 0; E.ws = ws; E.out = p.out; E.bias0 = p.in[5] + j * 1024; E.bias1 = p.in[8] + j * 1024; E.bias2 = p.in[11];
            if (kind == K_R1) {
                E.mode = E_RPROJ;
                if (gi == 0) { g.A = (const h16*)p.out; g.A2 = (const h16*)(ws + R_G16); g.Bt = w_rwkv_big(ws, j); g.N = 3072; g.amode = 2; }
                else { g.Bt = w_rwkv_l1(ws, j); g.N = 512; g.K = 2048; g.amode = 1; E.pnoff = 12; }
            } else if (kind == K_R2) {
                g.A = (const h16*)(ws + R_HACT); g.Bt = w_rwkv_l2(ws, j); g.N = (j == 0) ? 3072 : 4096; g.K = 384; g.lda = 384; E.mode = E_LORA2;
            } else if (kind == K_R4) {
                g.A = (const h16*)(ws + (j == 0 ? R_V16 : OFF_VF)); g.Bt = w_rwkv_o(ws, j);
            } else if (kind == K_F1) {
                g.Bt = w_ffn_up(ws, L); g.M = MTOK / 2; g.N = 5632; g.amode = 1; g.pm0 = sub * 128; E.mode = E_ST16;
            } else if (kind == K_F3) {
                g.A = (const h16*)(ws + F_ACT); g.Bt = w_ffn_dn(ws, L); g.M = MTOK / 2; g.K = 2816; g.lda = 2816; E.pm0 = sub * 128;
            } else if (kind == K_D1) {
                g.Bt = w_dsa_in(ws, j); g.N = 512; g.amode = 1; E.mode = E_ST32;
            } else if (kind == K_D3) {
                g.A = (const h16*)(ws + D_CQ); g.Bt = w_dsa_q(ws, j); g.N = 2560; g.K = 256; g.lda = 256; E.mode = E_QPROJ;
            } else {
                g.A = (const h16*)(ws + D_O16); g.Bt = w_dsa_o(ws, j);
            }
            pg8::StaticOrder S; S.init(g.M, g.N, (int)gridDim.x, (int)blockIdx.x);
#ifndef NO_GEMM
            pg8::gemm_phase((LAS unsigned char*)smem, g, S, E);
#endif
            }
        } else if (kind == K_PREP) {
#ifndef NO_PREP
            prep_phase(p, smem);
#endif
        } else if (kind == K_R0) {
            mix_phase(p, j);
        } else if (kind == K_R3) {
#ifndef NO_SCAN
            scan_phase(p, j, smem);
#endif
        } else if (kind == K_LN) {
#ifndef NO_LN
            ln_phase(p, p.in[1] + (L * 2 + sub) * 1024, p.in[2] + (L * 2 + sub) * 1024, L == 3 && sub == 1);
#endif
        } else if (kind == K_F2) {
#ifndef NO_CONV
            conv_phase(p, L);
#endif
        } else if (kind == K_D2) {
#ifndef NO_NORM
            dsa_norm_phase(p, j, smem);
#endif
        } else if (kind == K_D4) {
#ifndef NO_INDEX
            dsa_index_phase(p, smem);
#endif
        } else if (kind == K_D5) {
#ifndef NO_ATTN
            dsa_attn_phase(p, j, smem);
#endif
        }
        }
        if (ph + 1 < p.ph_hi) { if (ph == p.ph_lo) grid.sync(); else grid_bar(barctr, bar_target, gridDim.x); for (int xs = 0; xs < EXTRA_SYNC; ++xs) grid_bar(barctr, bar_target, gridDim.x); }
    }
}

extern "C" void kernel_launch(void* const* d_in, const int* in_sizes, int n_in, void* d_out, int out_size, void* d_ws, size_t ws_size, hipStream_t stream) {
    static int grid_blocks = 0;
    if (grid_blocks == 0) {
        if (n_in != 37 || ws_size < WS_NEED || out_size != MTOK * DM) { fprintf(stderr, "kernel_launch: unexpected problem (n_in %d ws %zu out %d)\n", n_in, ws_size, out_size); grid_blocks = -1; return; }
        int dev = 0, cus = 0, per_cu = 0;
        hipGetDevice(&dev);
        hipDeviceGetAttribute(&cus, hipDeviceAttributeMultiprocessorCount, dev);
        if (hipFuncSetAttribute((const void*)mega_fwd, hipFuncAttributeMaxDynamicSharedMemorySize, LDS_BYTES) != hipSuccess) { fprintf(stderr, "kernel_launch: hipFuncSetAttribute failed\n"); grid_blocks = -1; return; }
        hipOccupancyMaxActiveBlocksPerMultiprocessor(&per_cu, (const void*)mega_fwd, 512, LDS_BYTES);
        if (per_cu < 1) { fprintf(stderr, "kernel_launch: occupancy query says %d blocks/CU\n", per_cu); per_cu = 1; }
        (void)hipGetLastError();
        grid_blocks = cus * per_cu;
        fprintf(stderr, "kernel_launch: grid %d (cus %d x %d)\n", grid_blocks, cus, per_cu);
    }
    if (grid_blocks < 0) return;
    Params p{};
    for (int i = 0; i < 37; ++i) p.in[i] = (const float*)d_in[i];
    p.ws = (unsigned char*)d_ws; p.out = (float*)d_out;
    int np = 0;
    constexpr unsigned PROBE_MASK = 0u;
    auto add = [&](int kind, int L, int sub) { p.prog[np++] = (unsigned char)(kind | (L << 4) | (sub << 6) | ((((PROBE_MASK >> kind) & 1u) && !(kind == K_LN && L == 3 && sub == 1)) ? 128 : 0)); };
    add(K_PREP, 0, 0);
    for (int L = 0; L < 4; ++L) {
        if ((L & 1) == 0) { add(K_R0, L, 0); add(K_R1, L, 0); add(K_R2, L, 0); add(K_R3, L, 0); add(K_R4, L, 0); }
        else { add(K_D1, L, 0); add(K_D2, L, 0); add(K_D3, L, 0); add(K_D4, L, 0); add(K_D5, L, 0); add(K_D6, L, 0); }
        add(K_LN, L, 0);
        for (int c = 0; c < 2; ++c) { add(K_F1, L, c); add(K_F2, L, c); add(K_F3, L, c); }
        add(K_LN, L, 1);
    }
#if SINGLE_LAUNCH
    if (hipMemsetAsync((unsigned char*)d_ws + OFF_BAR, 0, 256, stream) != hipSuccess) { fprintf(stderr, "kernel_launch: memset failed\n"); return; }
    p.ph_lo = 0; p.ph_hi = np;
    void* args[] = {&p};
    hipError_t e = hipLaunchCooperativeKernel((const void*)mega_fwd, dim3(grid_blocks), dim3(512), args, LDS_BYTES, stream);
    if (e != hipSuccess) fprintf(stderr, "cooperative launch failed: %s (grid %d)\n", hipGetErrorString(e), grid_blocks);
#else
    for (int ph = 0; ph < np; ++ph) {
        p.ph_lo = ph; p.ph_hi = ph + 1;
        hipLaunchKernelGGL(mega_fwd, dim3(grid_blocks), dim3(512), LDS_BYTES, stream, p);
    }
#endif
}
```

```cpp
#include <hip/hip_runtime.h>
#include <hip/hip_cooperative_groups.h>
#include <cstdio>
namespace cg = cooperative_groups;

constexpr int EXTRA_SYNC = 0;
#ifndef SINGLE_LAUNCH
#define SINGLE_LAUNCH 1
#endif

#define LAS __attribute__((address_space(3)))
typedef _Float16 h16;
typedef _Float16 h16x8 __attribute__((ext_vector_type(8)));
typedef _Float16 h16x4 __attribute__((ext_vector_type(4)));
typedef _Float16 h16x2 __attribute__((ext_vector_type(2)));
typedef float f32x4 __attribute__((ext_vector_type(4)));
typedef float f32x2 __attribute__((ext_vector_type(2)));
typedef unsigned u32x4 __attribute__((ext_vector_type(4)));
typedef unsigned u32x2 __attribute__((ext_vector_type(2)));

constexpr int DM = 1024, SEQ = 2048, NBATCH = 32, MTOK = NBATCH * SEQ;
constexpr int DFF = 2816;
constexpr size_t MiB = (size_t)1 << 20;
constexpr float DN_ALPHA = 1.6817928305074290f;
constexpr int LDS_BYTES = 147456;

constexpr size_t OFF_W = 0;
constexpr size_t OFF_X16 = 118 * MiB;
constexpr size_t OFF_VF = 247 * MiB;
constexpr size_t OFF_R = 375 * MiB;
constexpr size_t WS_NEED = 960 * MiB;
constexpr size_t OFF_WOV = 952 * MiB;
constexpr size_t R_R16 = OFF_R, R_K16 = OFF_R + 128 * MiB, R_V16 = OFF_R + 256 * MiB, R_G16 = OFF_R + 384 * MiB, R_HACT = OFF_R + 512 * MiB;
constexpr size_t F_U16 = OFF_R, F_ACT = OFF_R + 352 * MiB;
constexpr size_t D_HIN = OFF_R, D_O16 = OFF_R, D_QABS = OFF_R + 128 * MiB, D_QIDX = OFF_R + 384 * MiB, D_CQ = OFF_R + 448 * MiB,
                 D_CKV = OFF_R + 480 * MiB, D_CKVT = OFF_R + 496 * MiB, D_KIDX = OFF_R + 512 * MiB, D_WIDX = OFF_R + 520 * MiB, D_MASK = OFF_R + 522 * MiB;

struct Params {
    const float* in[37];
    unsigned char* ws;
    float* out;
    int ph_lo, ph_hi;
    unsigned char prog[64];
};

enum { K_PREP = 0, K_R1, K_R2, K_R3, K_R4, K_LN, K_F1, K_F2, K_F3, K_D1, K_D2, K_D3, K_D4, K_D5, K_D6, K_R0 };
enum { E_RPROJ = 0, E_LORA2, E_RESID, E_ST16, E_ST32, E_QPROJ };

__device__ __forceinline__ size_t xrow(int row) { return (size_t)(row >> 11) * 2049 + 1 + (row & 2047); }
__device__ __forceinline__ unsigned pk2(float a, float b) { h16x2 h = {(h16)a, (h16)b}; return __builtin_bit_cast(unsigned, h); }
__device__ __forceinline__ u32x4 pack8(f32x4 a, f32x4 b) { u32x4 w; w.x = pk2(a[0], a[1]); w.y = pk2(a[2], a[3]); w.z = pk2(b[0], b[1]); w.w = pk2(b[2], b[3]); return w; }
__device__ __forceinline__ void unpack8(u32x4 w, float* f) {
    h16x8 h = __builtin_bit_cast(h16x8, w);
#pragma unroll
    for (int i = 0; i < 8; ++i) f[i] = (float)h[i];
}
__device__ __forceinline__ float sigmoidf_(float x) { return 1.0f / (1.0f + __expf(-x)); }
__device__ __forceinline__ float wave_sum(float v) {
#pragma unroll
    for (int o = 32; o > 0; o >>= 1) v += __shfl_xor(v, o);
    return v;
}
#define WSYNC() asm volatile("s_waitcnt vmcnt(0) lgkmcnt(0)" ::: "memory")
__device__ __forceinline__ int opaque_tid() { int t = threadIdx.x; asm volatile("" : "+v"(t)); return t; }

namespace pg8 {
constexpr int BM = 256, BK = 64, HALF = 128, HTB = HALF * BK * 2, STAGE_BYTES = 8 * HTB, NXCD = 8, WGM = 8;
__device__ __forceinline__ int lds_byte(int r, int c) { const int st = (r >> 4) * 2 + (c >> 5), rr = r & 15, cc = c & 31, ob = rr * 64 + cc * 2; return st * 1024 + (ob ^ (((ob >> 9) & 1) << 5)); }
__device__ __forceinline__ void stage_rc(int b, int& R, int& C) { const int st = b / 1024, sb = b % 1024, swz = sb ^ (((sb >> 9) & 1) << 5); R = (st >> 1) * 16 + swz / 64; C = (st & 1) * 32 + (swz % 64) / 2; }
__device__ __forceinline__ int perm32(int rho) { const int n = rho >> 4, i = rho & 15; return 8 * (i >> 2) + 4 * n + (i & 3); }
struct Unit { int pm, pn; };
struct Gemm { const h16* A; const h16* A2; const h16* Bt; int M, N, K, lda, amode, pm0; };
struct StaticOrder {
    int nM, nN, nwg, G, c;
    __device__ void init(int M, int N, int G_, int c_) { nM = M / BM; nN = N / BM; nwg = nM * nN; G = G_; c = c_; }
    __device__ bool next(int i, Unit& u) const {
        const long L = (long)i * G + c; if (L >= nwg) return false;
        int wgid = (int)L; { const int q = nwg / NXCD, r = nwg % NXCD, xcd = wgid % NXCD, off = wgid / NXCD; wgid = (xcd < r ? xcd * (q + 1) : r * (q + 1) + (xcd - r) * q) + off; }
        const int nig = WGM * nN, gid = wgid / nig, fm = gid * WGM, gsz = (nM - fm) < WGM ? (nM - fm) : WGM;
        u.pm = fm + ((wgid % nig) % gsz); u.pn = (wgid % nig) / gsz; return true;
    }
};

struct Epi {
    int mode, pm0, j, pnoff, fin;
    unsigned char* ws; float* out; const float* bias0; const float* bias1; const float* bias2;
    __device__ __forceinline__ void operator()(const f32x4 (&acc)[2][2][4][2], const Unit& u, int wr, int wc, int fr, int fq) const {
        const int rowl0 = u.pm * BM + wr * 64 + fr;
        const int colt = u.pn * BM + wc * 32 + 8 * fq;
        if (mode == E_RESID) {
            u32x4 xr[2][4][2];
#pragma unroll
            for (int ai = 0; ai < 2; ++ai)
#pragma unroll
                for (int m = 0; m < 4; ++m) {
                    const int rowg = rowl0 + ai * HALF + m * 16 + pm0 * BM;
                    const h16* xp = (const h16*)(ws + OFF_X16) + xrow(rowg) * 1024 + colt;
#pragma unroll
                    for (int bj = 0; bj < 2; ++bj) xr[ai][m][bj] = *(const u32x4*)(xp + bj * HALF);
                }
#pragma unroll
            for (int ai = 0; ai < 2; ++ai)
#pragma unroll
                for (int m = 0; m < 4; ++m) {
                    const int rowg = rowl0 + ai * HALF + m * 16 + pm0 * BM;
                    float* dp0 = out + (size_t)rowg * 1024 + colt;
                    h16* hp0 = (h16*)out + (size_t)rowg * 1024 + colt;
#pragma unroll
                    for (int bj = 0; bj < 2; ++bj) {
                        float xf[8]; unpack8(xr[ai][m][bj], xf);
                        const f32x4 v0 = acc[ai][bj][m][0], v1 = acc[ai][bj][m][1];
                        f32x4 r0, r1;
#pragma unroll
                        for (int jj = 0; jj < 4; ++jj) { r0[jj] = DN_ALPHA * xf[jj] + v0[jj]; r1[jj] = DN_ALPHA * xf[4 + jj] + v1[jj]; }
                        if (fin) { float* dp = dp0 + bj * HALF; *(f32x4*)dp = r0; *(f32x4*)(dp + 4) = r1; }
                        else *(u32x4*)(hp0 + bj * HALF) = pack8(r0, r1);
                    }
                }
            return;
        }
        if (mode == E_LORA2 && (u.pn >> 2) == 3) {
            const int c0 = colt & 1023;
#pragma unroll
            for (int ai = 0; ai < 2; ++ai) {
                u32x4 lv[4][2], lf[4][2];
#pragma unroll
                for (int m = 0; m < 4; ++m) {
                    const size_t off = (size_t)(rowl0 + ai * HALF + m * 16 + pm0 * BM) * 1024 + c0;
#pragma unroll
                    for (int bj = 0; bj < 2; ++bj) { lv[m][bj] = *(const u32x4*)((const h16*)(ws + R_V16) + off + bj * HALF); lf[m][bj] = *(const u32x4*)((const h16*)(ws + OFF_VF) + off + bj * HALF); }
                }
#pragma unroll
                for (int m = 0; m < 4; ++m) {
                    const size_t off = (size_t)(rowl0 + ai * HALF + m * 16 + pm0 * BM) * 1024 + c0;
#pragma unroll
                    for (int bj = 0; bj < 2; ++bj) {
                        const int c = c0 + bj * HALF;
                        const f32x4 ba = *(const f32x4*)(bias2 + c), bb = *(const f32x4*)(bias2 + c + 4);
                        float vv[8], vf8[8]; unpack8(lv[m][bj], vv); unpack8(lf[m][bj], vf8);
                        f32x4 v0 = acc[ai][bj][m][0], v1 = acc[ai][bj][m][1];
#pragma unroll
                        for (int jj = 0; jj < 4; ++jj) {
                            v0[jj] = vv[jj] + (vf8[jj] - vv[jj]) * sigmoidf_(v0[jj] + ba[jj]);
                            v1[jj] = vv[4 + jj] + (vf8[4 + jj] - vv[4 + jj]) * sigmoidf_(v1[jj] + bb[jj]);
                        }
                        *(u32x4*)((h16*)(ws + R_V16) + off + bj * HALF) = pack8(v0, v1);
                    }
                }
            }
            return;
        }
#pragma unroll
        for (int ai = 0; ai < 2; ++ai)
#pragma unroll
            for (int m = 0; m < 4; ++m) {
                const int rowl = rowl0 + ai * HALF + m * 16;
                const int rowg = rowl + pm0 * BM;
#pragma unroll
                for (int bj = 0; bj < 2; ++bj) {
                    const int col = colt + bj * HALF;
                    f32x4 v0 = acc[ai][bj][m][0], v1 = acc[ai][bj][m][1];
                    if (mode == E_RPROJ) {
                        if (pnoff == 0) {
                            h16* dst = (h16*)(ws + (u.pn < 4 ? R_R16 : (u.pn < 8 ? R_K16 : (j == 0 ? OFF_VF : R_V16))));
                            *(u32x4*)(dst + (size_t)rowg * 1024 + (col & 1023)) = pack8(v0, v1);
                        } else if (col < 384) {
                            const int hc = col;
                            if (hc < 64) {
#pragma unroll
                                for (int jj = 0; jj < 4; ++jj) { v0[jj] = tanhf(v0[jj]); v1[jj] = tanhf(v1[jj]); }
                            } else if (hc >= 160) {
#pragma unroll
                                for (int jj = 0; jj < 4; ++jj) { v0[jj] = sigmoidf_(v0[jj]); v1[jj] = sigmoidf_(v1[jj]); }
                            }
                            *(u32x4*)((h16*)(ws + R_HACT) + (size_t)rowg * 384 + hc) = pack8(v0, v1);
                        }
                    } else if (mode == E_LORA2) {
                        const int grp = u.pn >> 2, c = col & 1023;
                        const size_t off = (size_t)rowg * 1024 + c;
                        if (grp == 0) {
                            const f32x4 ba = *(const f32x4*)(bias0 + c), bb = *(const f32x4*)(bias0 + c + 4);
#pragma unroll
                            for (int jj = 0; jj < 4; ++jj) { v0[jj] = sigmoidf_(v0[jj] + ba[jj]) * 0.6065306597f; v1[jj] = sigmoidf_(v1[jj] + bb[jj]) * 0.6065306597f; }
                            *(u32x4*)((h16*)out + off) = pack8(v0, v1);
                        } else if (grp == 1) {
                            const f32x4 ba = *(const f32x4*)(bias1 + c), bb = *(const f32x4*)(bias1 + c + 4);
#pragma unroll
                            for (int jj = 0; jj < 4; ++jj) { v0[jj] = sigmoidf_(v0[jj] + ba[jj]); v1[jj] = sigmoidf_(v1[jj] + bb[jj]); }
                            *(u32x4*)((h16*)out + (size_t)MTOK * 1024 + off) = pack8(v0, v1);
                        } else {
                            *(u32x4*)((h16*)(ws + R_G16) + off) = pack8(v0, v1);
                        }
                    } else if (mode == E_ST16) {
                        *(u32x4*)((h16*)(ws + F_U16) + (size_t)rowl * 5632 + col) = pack8(v0, v1);
                    } else if (mode == E_ST32) {
                        float* dp = (float*)(ws + D_HIN) + (size_t)rowg * 512 + col;
                        *(f32x4*)dp = v0; *(f32x4*)(dp + 4) = v1;
                    } else {
                        if (u.pn < 8) *(u32x4*)((h16*)(ws + D_QABS) + (size_t)rowg * 2048 + col) = pack8(v0, v1);
                        else *(u32x4*)((h16*)(ws + D_QIDX) + (size_t)rowg * 512 + (col - 2048)) = pack8(v0, v1);
                    }
                }
            }
    }
};

__device__ __forceinline__ const char* a_tile(const Gemm& g, int pm, int pn) {
    if (g.amode == 1) { const int row = (pm + g.pm0) * BM; return (const char*)g.A + xrow(row) * 2048; }
    if (g.amode == 2) {
        const int gq = pn >> 2;
        const char* base = gq == 2 ? (const char*)g.A2 : (const char*)g.A + (size_t)gq * ((size_t)MTOK * 1024 * 2);
        return base + (size_t)pm * BM * 2048;
    }
    if (g.amode == 3) return (pm < 128 ? (const char*)g.A + (size_t)pm * BM * 4096 : (const char*)g.A2 + (size_t)(pm - 128) * BM * 4096);
    return (const char*)g.A + (size_t)pm * BM * g.lda * 2;
}

__device__ __forceinline__ void gemm_phase(LAS unsigned char* lds, const Gemm g, const StaticOrder& S, const Epi& E) {
    const int tid = opaque_tid(), wid = __builtin_amdgcn_readfirstlane(tid >> 6), lane = tid & 63, wr = wid >> 2, wc = wid & 3, fr = lane & 15, fq = lane >> 4;
    const int K = g.K, nt = K / BK;
    const bool shiftA = (g.amode == 1);
    unsigned voffA[2], voffB[2];
#pragma unroll
    for (int i = 0; i < 2; ++i) { int R, C; stage_rc(tid * 16 + i * 8192, R, C); const int Rb = (R & ~31) + perm32(R & 31);
        voffA[i] = (unsigned)(R * g.lda + C) * 2u; voffB[i] = (unsigned)(Rb * K + C) * 2u; }
    const size_t kstep = (size_t)(BK * 2);
    const size_t hstepA = (size_t)HALF * g.lda * 2;
    const size_t hstepB = (size_t)HALF * K * 2;
    const size_t tstepB = 2 * hstepB;
    const unsigned ldsw = (unsigned)wid * 1024u;
    const int aoff = lds_byte(wr * 64 + fr, fq * 8), boff = lds_byte(wc * 32 + fr, fq * 8);
#define PG8_KOFF(kt) ((size_t)(kt) * kstep - ((shiftA && (kt) >= 16) ? (size_t)4096 : (size_t)0))
#define PG8_SA(b, h) (((b) * 2 + (h)) * HTB)
#define PG8_SB(b, h) ((4 + (b) * 2 + (h)) * HTB)
#define PG8_STAGE(bufoff, gbase, voff) do { _Pragma("unroll") for (int _i = 0; _i < 2; ++_i) \
        __builtin_amdgcn_global_load_lds((const unsigned*)((const char*)(gbase) + (voff)[_i]), (LAS unsigned*)(lds + (bufoff) + ldsw + _i * 8192), 16, 0, 0); } while (0)
#define PG8_LDA(dst, b, h) do { _Pragma("unroll") for (int m = 0; m < 4; ++m) _Pragma("unroll") for (int k = 0; k < 2; ++k) dst[m][k] = *(const LAS h16x8*)(lds + PG8_SA(b, h) + aoff + m * 2048 + k * 1024); } while (0)
#define PG8_LDB(dst, b, h) do { _Pragma("unroll") for (int n = 0; n < 2; ++n) _Pragma("unroll") for (int k = 0; k < 2; ++k) dst[n][k] = *(const LAS h16x8*)(lds + PG8_SB(b, h) + boff + n * 2048 + k * 1024); } while (0)
#define PG8_MMA(ai, bj, At, Bt) do { __builtin_amdgcn_s_setprio(1); _Pragma("unroll") for (int m = 0; m < 4; ++m) _Pragma("unroll") for (int n = 0; n < 2; ++n) _Pragma("unroll") for (int k = 0; k < 2; ++k) \
        acc[ai][bj][m][n] = __builtin_amdgcn_mfma_f32_16x16x32_f16(Bt[n][k], At[m][k], acc[ai][bj][m][n], 0, 0, 0); __builtin_amdgcn_s_setprio(0); } while (0)
#define PG8_WAIT_V(n) asm volatile("s_waitcnt vmcnt(" #n ")" ::: "memory")
#define PG8_WAIT_L(n) asm volatile("s_waitcnt lgkmcnt(" #n ")" ::: "memory")
#define PG8_BAR __builtin_amdgcn_s_barrier()
#define PG8_SCHED __builtin_amdgcn_sched_barrier(0)
    Unit cur, nxt; int ui = 0;
    if (!S.next(0, cur)) return;
    f32x4 acc[2][2][4][2];
#pragma unroll
    for (int a = 0; a < 2; ++a)
#pragma unroll
        for (int b = 0; b < 2; ++b)
#pragma unroll
            for (int m = 0; m < 4; ++m)
#pragma unroll
                for (int n = 0; n < 2; ++n) acc[a][b][m][n] = (f32x4){0.f, 0.f, 0.f, 0.f};
    h16x8 At[4][2], B0[2][2], B1[2][2];
    const char* cA = a_tile(g, cur.pm, cur.pn); const char* cB = (const char*)g.Bt + (size_t)cur.pn * tstepB;
    PG8_STAGE(PG8_SB(0, 0), cB, voffB); PG8_STAGE(PG8_SA(0, 0), cA, voffA); PG8_STAGE(PG8_SB(0, 1), cB + hstepB, voffB); PG8_STAGE(PG8_SA(0, 1), cA + hstepA, voffA);
    if (wr == 1) PG8_BAR;
    PG8_WAIT_V(4); PG8_BAR;
    PG8_STAGE(PG8_SB(1, 0), cB + kstep, voffB); PG8_STAGE(PG8_SA(1, 0), cA + kstep, voffA); PG8_STAGE(PG8_SB(1, 1), cB + hstepB + kstep, voffB);
    PG8_WAIT_V(6); PG8_BAR;
    for (;;) {
        const bool has_next = S.next(ui + 1, nxt);
        const char* nA = has_next ? a_tile(g, nxt.pm, nxt.pn) : cA; const char* nB = has_next ? (const char*)g.Bt + (size_t)nxt.pn * tstepB : cB;
        for (int t = 0; t < nt; t += 2) {
            const bool last = (t == nt - 2);
            const char* a1 = cA + PG8_KOFF(t + 1);
            const char* a2 = last ? nA : cA + PG8_KOFF(t + 2); const char* b2 = last ? nB : cB + (size_t)(t + 2) * kstep;
            const char* a3 = a2 + kstep; const char* b3 = b2 + kstep;
            PG8_LDB(B0, 0, 0); PG8_SCHED; PG8_LDA(At, 0, 0); PG8_STAGE(PG8_SA(1, 1), a1 + hstepA, voffA);
            PG8_WAIT_L(8); PG8_BAR; PG8_WAIT_L(0); PG8_MMA(0, 0, At, B0); PG8_BAR; PG8_SCHED;
            PG8_LDB(B1, 0, 1); PG8_STAGE(PG8_SB(0, 0), b2, voffB);
            PG8_BAR; PG8_WAIT_L(0); PG8_MMA(0, 1, At, B1); PG8_BAR;
            PG8_LDA(At, 0, 1); PG8_STAGE(PG8_SA(0, 0), a2, voffA);
            PG8_BAR; PG8_WAIT_L(0); PG8_MMA(1, 0, At, B0); PG8_BAR; PG8_SCHED;
            PG8_STAGE(PG8_SB(0, 1), b2 + hstepB, voffB);
            PG8_WAIT_V(6); PG8_BAR; PG8_MMA(1, 1, At, B1); PG8_BAR;
            PG8_LDB(B0, 1, 0); PG8_SCHED; PG8_LDA(At, 1, 0); PG8_STAGE(PG8_SA(0, 1), a2 + hstepA, voffA);
            PG8_WAIT_L(8); PG8_BAR; PG8_WAIT_L(0); PG8_MMA(0, 0, At, B0); PG8_BAR; PG8_SCHED;
            PG8_LDB(B1, 1, 1); PG8_STAGE(PG8_SB(1, 0), b3, voffB);
            PG8_BAR; PG8_WAIT_L(0); PG8_MMA(0, 1, At, B1); PG8_BAR;
            PG8_LDA(At, 1, 1); PG8_STAGE(PG8_SA(1, 0), a3, voffA);
            PG8_BAR; PG8_WAIT_L(0); PG8_MMA(1, 0, At, B0); PG8_BAR; PG8_SCHED;
            PG8_STAGE(PG8_SB(1, 1), b3 + hstepB, voffB);
            PG8_WAIT_V(6); PG8_BAR; PG8_MMA(1, 1, At, B1); PG8_BAR;
        }
        E(acc, cur, wr, wc, fr, fq);
        if (!has_next) break;
#pragma unroll
        for (int a = 0; a < 2; ++a)
#pragma unroll
            for (int b = 0; b < 2; ++b)
#pragma unroll
                for (int m = 0; m < 4; ++m)
#pragma unroll
                    for (int n = 0; n < 2; ++n) acc[a][b][m][n] = (f32x4){0.f, 0.f, 0.f, 0.f};
        cur = nxt; cA = nA; cB = nB; ++ui;
    }
    PG8_WAIT_V(0);
    if (wr == 0) PG8_BAR;
    PG8_BAR;
#undef PG8_KOFF
#undef PG8_SA
#undef PG8_SB
#undef PG8_STAGE
#undef PG8_LDA
#undef PG8_LDB
#undef PG8_MMA
#undef PG8_WAIT_V
#undef PG8_WAIT_L
#undef PG8_BAR
#undef PG8_SCHED
}
}

struct TJob { int mode; const float* src; int ld, K, N; h16* dst; int ldd, koff; const float* mix; };

__device__ __forceinline__ TJob get_job(const Params& p, int id) {
    TJob J; J.mode = 0; J.src = nullptr; J.ld = 0; J.K = 0; J.N = 0; J.dst = nullptr; J.ldd = 64; J.koff = 0; J.mix = nullptr;
    h16* W = (h16*)(p.ws + OFF_W);
    if (id < 24) {
        const int j = id / 12, s = id % 12;
        h16* Wrkv = W + (size_t)j * (10 * MiB); h16* Wl1 = Wrkv + 3 * MiB; h16* Wl2 = Wrkv + 7 * MiB;
        const float* mix = p.in[3] + j * 6 * 1024;
        if (s < 3) { J.mode = 0; J.src = p.in[4] + (size_t)(j * 3 + s) * 1048576; J.ld = 1024; J.K = 1024; J.N = 1024; J.dst = Wrkv + (size_t)s * 1024 * 1024; J.ldd = 1024; }
        else if (s < 8) {
            J.mode = 1; J.ld = 1024; J.K = 1024; J.ldd = 2048;
            if (s == 3) { J.src = p.in[6] + (size_t)j * 65536; J.ld = 64; J.N = 64; J.dst = Wl1; J.mix = mix + 3 * 1024; }
            else if (s == 4) { J.src = p.in[9] + (size_t)j * 65536; J.ld = 64; J.N = 64; J.dst = Wl1 + (size_t)64 * 2048; J.mix = mix + 4 * 1024; }
            else if (s == 5) { J.N = 32; J.dst = Wl1 + (size_t)128 * 2048; if (j == 1) { J.src = p.in[12]; J.ld = 32; J.mix = mix + 2 * 1024; } else { J.mode = 2; } }
            else if (s == 6) { J.src = p.in[14] + (size_t)j * 163840; J.ld = 160; J.N = 160; J.dst = Wl1 + (size_t)160 * 2048; J.mix = mix + 5 * 1024; }
            else { J.mode = 2; J.N = 192; J.dst = Wl1 + (size_t)320 * 2048; }
        } else {
            J.mode = 0; J.ld = 1024; J.N = 1024; J.ldd = 384;
            if (s == 8) { J.src = p.in[7] + (size_t)j * 65536; J.K = 64; J.koff = 0; J.dst = Wl2; }
            else if (s == 9) { J.src = p.in[10] + (size_t)j * 65536; J.K = 64; J.koff = 64; J.dst = Wl2 + (size_t)1024 * 384; }
            else if (s == 10) { J.src = p.in[15] + (size_t)j * 163840; J.K = 160; J.koff = 160; J.dst = Wl2 + (size_t)2048 * 384; }
            else { J.src = p.in[13]; J.K = 32; J.koff = 128; J.dst = Wl2 + (size_t)3072 * 384; if (j == 0) J.N = 0; }
        }
    } else if (id < 26) {
        const int j = id - 24;
        J.src = p.in[21] + (size_t)j * 1048576; J.ld = 1024; J.K = 1024; J.N = 1024; J.dst = W + (size_t)j * (10 * MiB) + 9 * MiB; J.ldd = 1024;
    } else if (id < 34) {
        const int i = (id - 26) >> 1, s = (id - 26) & 1;
        h16* base = W + 20 * MiB + (size_t)i * (17 * MiB / 2);
        if (s == 0) { J.src = p.in[33] + (size_t)i * 1024 * 5632; J.ld = 5632; J.K = 1024; J.N = 5632; J.dst = base; J.ldd = 1024; }
        else { J.src = p.in[36] + (size_t)i * 2816 * 1024; J.ld = 1024; J.K = 2816; J.N = 1024; J.dst = base + (size_t)11 * MiB / 2; J.ldd = 2816; }
    } else {
        const int j = (id - 34) >> 2, s = (id - 34) & 3;
        h16* base = W + 54 * MiB + (size_t)j * (5 * MiB / 2);
        if (s == 0) { J.src = p.in[22] + (size_t)j * 1024 * 456; J.ld = 456; J.K = 1024; J.N = 456; J.dst = base; J.ldd = 1024; }
        else if (s == 1) { J.mode = 2; J.N = 56; J.dst = base + (size_t)456 * 1024; J.ldd = 1024; }
        else if (s == 2) { J.src = p.in[28] + (size_t)j * 256 * 512; J.ld = 512; J.K = 256; J.N = 512; J.dst = base + MiB / 2 + (size_t)2048 * 256; J.ldd = 256; }
        else { J.src = p.in[31] + (size_t)j * 1048576; J.ld = 1024; J.K = 1024; J.N = 1024; J.dst = base + 3 * MiB / 2; J.ldd = 1024; }
    }
    return J;
}
__device__ __forceinline__ h16* w_rwkv_big(unsigned char* ws, int j) { return (h16*)(ws + OFF_W) + (size_t)j * (10 * MiB); }
__device__ __forceinline__ h16* w_rwkv_l1(unsigned char* ws, int j) { return w_rwkv_big(ws, j) + 3 * MiB; }
__device__ __forceinline__ h16* w_rwkv_l2(unsigned char* ws, int j) { return w_rwkv_big(ws, j) + 7 * MiB; }
__device__ __forceinline__ h16* w_rwkv_o(unsigned char* ws, int j) { return w_rwkv_big(ws, j) + 9 * MiB; }
__device__ __forceinline__ h16* w_ffn_up(unsigned char* ws, int i) { return (h16*)(ws + OFF_W) + 20 * MiB + (size_t)i * (17 * MiB / 2); }
__device__ __forceinline__ h16* w_ffn_dn(unsigned char* ws, int i) { return w_ffn_up(ws, i) + (size_t)11 * MiB / 2; }
__device__ __forceinline__ h16* w_dsa_in(unsigned char* ws, int j) { return (h16*)(ws + OFF_W) + 54 * MiB + (size_t)j * (5 * MiB / 2); }
__device__ __forceinline__ h16* w_dsa_q(unsigned char* ws, int j) { return w_dsa_in(ws, j) + MiB / 2; }
__device__ __forceinline__ h16* w_dsa_uvt(unsigned char* ws, int j) { return w_dsa_in(ws, j) + 5 * MiB / 4; }
__device__ __forceinline__ h16* w_dsa_o(unsigned char* ws, int j) { return w_dsa_in(ws, j) + 3 * MiB / 2; }

__device__ __forceinline__ void prep_phase(const Params& p, unsigned char* smem) {
    const int tid = opaque_tid();
    const size_t gtid = (size_t)blockIdx.x * 512 + tid, nth = (size_t)gridDim.x * 512;
    h16* x16 = (h16*)(p.ws + OFF_X16);
    for (size_t idx = gtid; idx < (size_t)MTOK * 128; idx += nth) {
        const int row = (int)(idx >> 7), c8 = (int)(idx & 127) * 8;
        const float* sp = p.in[0] + (size_t)row * 1024 + c8;
        const f32x4 a = *(const f32x4*)sp, b = *(const f32x4*)(sp + 4);
        *(u32x4*)(x16 + xrow(row) * 1024 + c8) = pack8(a, b);
    }
    for (size_t idx = gtid; idx < (size_t)NBATCH * 128; idx += nth) {
        const int b = (int)(idx >> 7), c8 = (int)(idx & 127) * 8;
        unsigned z = 0u; asm volatile("" : "+v"(z));
        *(u32x4*)(x16 + (size_t)b * 2049 * 1024 + c8) = (u32x4){z, z, z, z};
    }
    for (size_t idx = gtid; idx < (size_t)2 * 2048 * 256; idx += nth) {
        const int j = (int)(idx >> 19), rem = (int)(idx & 524287), n = rem >> 8, q = rem & 255, h = n >> 7, c = n & 127;
        const float* uq = p.in[25] + (size_t)j * 256 * 1024 + (size_t)q * 1024 + h * 64;
        const float* uk = p.in[26] + (size_t)j * 16 * 64 * 128 + (size_t)h * 64 * 128 + c;
        float s = 0.f;
        for (int d = 0; d < 64; ++d) s += uq[d] * uk[d * 128];
        w_dsa_q(p.ws, j)[(size_t)n * 256 + q] = (h16)(s * 0.18033688011112042f);
    }
    for (size_t idx = gtid; idx < (size_t)2 * 2048 * 1024; idx += nth) {
        const int j = (int)(idx >> 21), rem = (int)(idx & 2097151), k = rem >> 10, n = rem & 1023, h = k >> 7, c = k & 127;
        const float* uv = p.in[27] + (size_t)((j * 16 + h) * 128 + c) * 64;
        const float* wo = p.in[31] + (size_t)j * 1048576 + (size_t)(h * 64) * 1024 + n;
        float acc = 0.f;
#pragma unroll 8
        for (int v = 0; v < 64; ++v) acc += uv[v] * wo[(size_t)v * 1024];
        ((h16*)(p.ws + OFF_WOV))[(size_t)j * 2097152 + (size_t)n * 2048 + k] = (h16)acc;
    }
    float* tile = (float*)smem;
    for (int id = 0; id < 42; ++id) {
        const TJob J = get_job(p, id);
        const int tk = J.ldd >> 6, tn = (J.N + 63) >> 6, ntile = tk * tn;
        for (int tix = blockIdx.x; tix < ntile; tix += gridDim.x) {
            const int k0 = (tix % tk) * 64, n0 = (tix / tk) * 64;
#pragma unroll
            for (int i = 0; i < 8; ++i) {
                const int k = i * 8 + (tid >> 6), n = tid & 63, kk = k0 + k, nn = n0 + n;
                float v = 0.f;
                if (nn < J.N && J.mode != 2) {
                    if (J.mode == 1) { const int ks = kk & 1023; const float mx = J.mix[ks]; v = J.src[(size_t)ks * J.ld + nn] * (kk < 1024 ? 1.0f - mx : mx); }
                    else if (kk >= J.koff && kk < J.koff + J.K) v = J.src[(size_t)(kk - J.koff) * J.ld + nn];
                }
                tile[k * 65 + n] = v;
            }
            __syncthreads();
#pragma unroll
            for (int i = 0; i < 8; ++i) {
                const int n = i * 8 + (tid >> 6), k = tid & 63, nn = n0 + n;
                if (nn < J.N) J.dst[(size_t)nn * J.ldd + k0 + k] = (h16)tile[k * 65 + n];
            }
            __syncthreads();
        }
    }
}

__device__ __forceinline__ void wave_sum4(float (&v)[4]) {
#pragma unroll
    for (int o = 32; o > 0; o >>= 1) {
        float t[4];
#pragma unroll
        for (int k = 0; k < 4; ++k) t[k] = __shfl_xor(v[k], o);
#pragma unroll
        for (int k = 0; k < 4; ++k) v[k] += t[k];
    }
}
__device__ __forceinline__ void ln_phase(const Params& p, const float* g, const float* b, bool final_out) {
    const int tid = opaque_tid();
    const int lane = tid & 63, wave = tid >> 6;
    float* tb = p.out;
    h16* x16 = (h16*)(p.ws + OFF_X16);
    f32x4 gg[4], bb[4];
#pragma unroll
    for (int i = 0; i < 4; ++i) { gg[i] = *(const f32x4*)(g + i * 256 + lane * 4); bb[i] = *(const f32x4*)(b + i * 256 + lane * 4); }
    for (int rowb = (blockIdx.x * 8 + wave) * 4; rowb < MTOK; rowb += gridDim.x * 32) {
        f32x4 v[4][4];
        float s[4];
#pragma unroll
        for (int k = 0; k < 4; ++k) {
            s[k] = 0.f;
            if (final_out) {
                const float* rp = tb + (size_t)(rowb + k) * 1024;
#pragma unroll
                for (int i = 0; i < 4; ++i) v[k][i] = *(const f32x4*)(rp + i * 256 + lane * 4);
            } else {
                const h16* hp = (const h16*)tb + (size_t)(rowb + k) * 1024;
#pragma unroll
                for (int i = 0; i < 4; ++i) { const h16x4 hv = *(const h16x4*)(hp + i * 256 + lane * 4); v[k][i] = (f32x4){(float)hv[0], (float)hv[1], (float)hv[2], (float)hv[3]}; }
            }
#pragma unroll
            for (int i = 0; i < 4; ++i) s[k] += (v[k][i][0] + v[k][i][1]) + (v[k][i][2] + v[k][i][3]);
        }
        wave_sum4(s);
        float q[4];
#pragma unroll
        for (int k = 0; k < 4; ++k) {
            s[k] *= (1.0f / 1024.0f); q[k] = 0.f;
#pragma unroll
            for (int i = 0; i < 4; ++i)
#pragma unroll
                for (int jj = 0; jj < 4; ++jj) { const float d = v[k][i][jj] - s[k]; q[k] += d * d; }
        }
        wave_sum4(q);
#pragma unroll
        for (int k = 0; k < 4; ++k) {
            const float rstd = rsqrtf(q[k] * (1.0f / 1024.0f) + 1e-5f);
            const int row = rowb + k;
#pragma unroll
            for (int i = 0; i < 4; ++i) {
                f32x4 y;
#pragma unroll
                for (int jj = 0; jj < 4; ++jj) y[jj] = (v[k][i][jj] - s[k]) * rstd * gg[i][jj] + bb[i][jj];
                if (final_out) *(f32x4*)(tb + (size_t)row * 1024 + i * 256 + lane * 4) = y;
                else { u32x2 w; w.x = pk2(y[0], y[1]); w.y = pk2(y[2], y[3]); *(u32x2*)(x16 + xrow(row) * 1024 + i * 256 + lane * 4) = w; }
            }
        }
    }
}

__device__ __forceinline__ void conv_phase(const Params& p, int layer) {
    const h16* u = (const h16*)(p.ws + F_U16);
    h16* act = (h16*)(p.ws + F_ACT);
    const float* cw = p.in[34] + (size_t)layer * 3 * 5632;
    const float* cb = p.in[35] + (size_t)layer * 5632;
    const size_t gtid = (size_t)blockIdx.x * 512 + opaque_tid(), nth = (size_t)gridDim.x * 512;
    const size_t ntask = (size_t)2048 * 352;
    for (size_t task = gtid; task < ntask; task += nth) {
        const int cgp = (int)(task % 352), rc = (int)(task / 352), f = cgp * 8, r0 = rc * 16;
        float wg[3][8], wv[3][8], bg[8], bv[8];
#pragma unroll
        for (int jj = 0; jj < 3; ++jj)
#pragma unroll
            for (int hlf = 0; hlf < 2; ++hlf) {
                const f32x4 a = *(const f32x4*)(cw + jj * 5632 + f + hlf * 4), c = *(const f32x4*)(cw + jj * 5632 + DFF + f + hlf * 4);
#pragma unroll
                for (int e = 0; e < 4; ++e) { wg[jj][hlf * 4 + e] = a[e]; wv[jj][hlf * 4 + e] = c[e]; }
            }
#pragma unroll
        for (int hlf = 0; hlf < 2; ++hlf) {
            const f32x4 a = *(const f32x4*)(cb + f + hlf * 4), c = *(const f32x4*)(cb + DFF + f + hlf * 4);
#pragma unroll
            for (int e = 0; e < 4; ++e) { bg[hlf * 4 + e] = a[e]; bv[hlf * 4 + e] = c[e]; }
        }
        float g2[8], g1[8], v2[8], v1[8];
#pragma unroll
        for (int e = 0; e < 8; ++e) { g2[e] = 0.f; g1[e] = 0.f; v2[e] = 0.f; v1[e] = 0.f; }
        if ((r0 & 2047) != 0) {
            unpack8(*(const u32x4*)(u + (size_t)(r0 - 2) * 5632 + f), g2); unpack8(*(const u32x4*)(u + (size_t)(r0 - 1) * 5632 + f), g1);
            unpack8(*(const u32x4*)(u + (size_t)(r0 - 2) * 5632 + DFF + f), v2); unpack8(*(const u32x4*)(u + (size_t)(r0 - 1) * 5632 + DFF + f), v1);
        }
#pragma unroll 1
        for (int i0 = 0; i0 < 16; i0 += 4) {
            u32x4 lg[4], lv[4];
#pragma unroll
            for (int i = 0; i < 4; ++i) { const size_t ro = (size_t)(r0 + i0 + i) * 5632; lg[i] = *(const u32x4*)(u + ro + f); lv[i] = *(const u32x4*)(u + ro + DFF + f); }
#pragma unroll
            for (int i = 0; i < 4; ++i) {
                float g0[8], v0[8], o[8];
                unpack8(lg[i], g0); unpack8(lv[i], v0);
#pragma unroll
                for (int e = 0; e < 8; ++e) {
                    const float G = wg[0][e] * g2[e] + wg[1][e] * g1[e] + wg[2][e] * g0[e] + bg[e];
                    const float V = wv[0][e] * v2[e] + wv[1][e] * v1[e] + wv[2][e] * v0[e] + bv[e];
                    o[e] = G * sigmoidf_(G) * V;
                    g2[e] = g1[e]; g1[e] = g0[e]; v2[e] = v1[e]; v1[e] = v0[e];
                }
                *(u32x4*)(act + (size_t)(r0 + i0 + i) * DFF + f) = pack8((f32x4){o[0], o[1], o[2], o[3]}, (f32x4){o[4], o[5], o[6], o[7]});
            }
        }
    }
}

__device__ __forceinline__ void mix_phase(const Params& p, int j) {
    const h16* x16 = (const h16*)(p.ws + OFF_X16);
    h16* xr = (h16*)p.out; h16* xk = (h16*)p.out + (size_t)MTOK * 1024; h16* xv = (h16*)(p.ws + R_G16);
    const float* mix = p.in[3] + j * 6 * 1024;
    const size_t gtid = (size_t)blockIdx.x * 512 + opaque_tid(), nth = (size_t)gridDim.x * 512;
    for (size_t idx = gtid; idx < (size_t)MTOK * 128; idx += nth) {
        const int row = (int)(idx >> 7), c8 = (int)(idx & 127) * 8;
        const h16* xp = x16 + xrow(row) * 1024 + c8;
        float xc[8], xq[8];
        unpack8(*(const u32x4*)xp, xc); unpack8(*(const u32x4*)(xp - 1024), xq);
#pragma unroll
        for (int e = 0; e < 8; ++e) xq[e] -= xc[e];
        const size_t o = (size_t)row * 1024 + c8;
#pragma unroll
        for (int bsel = 0; bsel < 3; ++bsel) {
            const f32x4 m0 = *(const f32x4*)(mix + bsel * 1024 + c8), m1 = *(const f32x4*)(mix + bsel * 1024 + c8 + 4);
            f32x4 a, b;
#pragma unroll
            for (int e = 0; e < 4; ++e) { a[e] = xc[e] + xq[e] * m0[e]; b[e] = xc[4 + e] + xq[4 + e] * m1[e]; }
            h16* dst = bsel == 0 ? xr : (bsel == 1 ? xk : xv);
            *(u32x4*)(dst + o) = pack8(a, b);
        }
    }
}

__device__ __forceinline__ float dppf(float x, const int ctrl_sel) {
    const int v = __builtin_bit_cast(int, x);
    int r;
    if (ctrl_sel == 0) r = __builtin_amdgcn_update_dpp(0, v, 0xB1, 0xF, 0xF, true);
    else if (ctrl_sel == 1) r = __builtin_amdgcn_update_dpp(0, v, 0x4E, 0xF, 0xF, true);
    else if (ctrl_sel == 2) r = __builtin_amdgcn_update_dpp(0, v, 0x141, 0xF, 0xF, true);
    else r = __builtin_amdgcn_update_dpp(0, v, 0x140, 0xF, 0xF, true);
    return __builtin_bit_cast(float, r);
}
__device__ __forceinline__ float red4(float x) { x += dppf(x, 0); x += dppf(x, 1); return x; }
__device__ __forceinline__ float red16(float x) { x += dppf(x, 0); x += dppf(x, 1); x += dppf(x, 2); x += dppf(x, 3); return x; }
__device__ __forceinline__ void unpack4(u32x2 w, float* f) {
    h16x4 h = __builtin_bit_cast(h16x4, w);
#pragma unroll
    for (int i = 0; i < 4; ++i) f[i] = (float)h[i];
}
constexpr int SCAN_BUF = 8256;
__device__ __forceinline__ void scan_phase(const Params& p, int j, unsigned char* smem) {
    const int tid = opaque_tid();
    const int wave = tid >> 6, lane = tid & 63, slot = wave >> 2, w4 = wave & 3;
    float* LB = (float*)smem + slot * (2 * SCAN_BUF);
    const h16* r16 = (const h16*)(p.ws + R_R16);
    const h16* k16 = (const h16*)(p.ws + R_K16);
    const h16* v16 = (j == 0) ? (const h16*)(p.ws + OFF_VF) : (const h16*)(p.ws + R_V16);
    const h16* g16 = (const h16*)(p.ws + R_G16);
    const h16* e16 = (const h16*)p.out;
    const h16* a16 = (const h16*)p.out + (size_t)MTOK * 1024;
    h16* y16 = (h16*)(p.ws + (j == 0 ? R_V16 : OFF_VF));
    const int tp = w4 * 4 + (lane >> 4), k4 = (lane & 15) * 4;
    const int vrow = w4 * 16 + (lane >> 2), kq = lane & 3;
    for (int pair = blockIdx.x; pair < 256; pair += gridDim.x) {
        const int chain = pair * 2 + slot, b = chain >> 4, h = chain & 15;
        const int col = h * 64 + k4;
        const f32x4 c_kk = *(const f32x4*)(p.in[16] + j * 1024 + col), c_ka = *(const f32x4*)(p.in[17] + j * 1024 + col), c_rk = *(const f32x4*)(p.in[18] + j * 1024 + col);
        const f32x4 c_lg = *(const f32x4*)(p.in[19] + j * 1024 + col), c_lb = *(const f32x4*)(p.in[20] + j * 1024 + col);
        f32x2 S[8];
#pragma unroll
        for (int i = 0; i < 8; ++i) S[i] = (f32x2){0.f, 0.f};
        u32x2 pr[6];
        {
            const size_t go = ((size_t)(b * 2048 + tp)) * 1024 + col;
            pr[0] = *(const u32x2*)(r16 + go); pr[1] = *(const u32x2*)(k16 + go); pr[2] = *(const u32x2*)(v16 + go);
            pr[3] = *(const u32x2*)(e16 + go); pr[4] = *(const u32x2*)(a16 + go); pr[5] = *(const u32x2*)(g16 + go);
        }
        for (int ch = 0; ch < 128; ++ch) {
            float* BUF = LB + (ch & 1) * SCAN_BUF;
            float* OPS = BUF; float* VB = BUF + 5120; float* GB = BUF + 6144; float* YB = BUF + 7168; float* BON = BUF + 8192;
            {
                float rf[4], kf[4], vf[4], ef[4], af[4], gf[4];
                unpack4(pr[0], rf); unpack4(pr[1], kf); unpack4(pr[2], vf); unpack4(pr[3], ef); unpack4(pr[4], af); unpack4(pr[5], gf);
                float kk[4]; float ss = 0.f;
#pragma unroll
                for (int i = 0; i < 4; ++i) { kk[i] = kf[i] * c_kk[i]; ss += kk[i] * kk[i]; }
                ss = red16(ss);
                const float inv = 1.0f / fmaxf(sqrtf(ss), 1e-12f);
                f32x4 A4, B4, W4, K4, R4; float bs = 0.f;
#pragma unroll
                for (int i = 0; i < 4; ++i) {
                    const float kn = kk[i] * inv;
                    A4[i] = -kn; B4[i] = kn * af[i];
                    W4[i] = __expf(-ef[i]);
                    const float km = kf[i] * (1.0f + (af[i] - 1.0f) * c_ka[i]);
                    K4[i] = km; R4[i] = rf[i];
                    bs += rf[i] * km * c_rk[i];
                }
                bs = red16(bs);
                float* o = OPS + tp * 320 + k4;
                *(f32x4*)(o) = A4; *(f32x4*)(o + 64) = B4; *(f32x4*)(o + 128) = W4; *(f32x4*)(o + 192) = K4; *(f32x4*)(o + 256) = R4;
                *(f32x4*)(VB + tp * 64 + k4) = (f32x4){vf[0], vf[1], vf[2], vf[3]};
                *(f32x4*)(GB + tp * 64 + k4) = (f32x4){gf[0], gf[1], gf[2], gf[3]};
                if ((lane & 15) == 0) BON[tp] = bs;
            }
            if (ch + 1 < 128) {
                const size_t go = ((size_t)(b * 2048 + (ch + 1) * 16 + tp)) * 1024 + col;
                pr[0] = *(const u32x2*)(r16 + go); pr[1] = *(const u32x2*)(k16 + go); pr[2] = *(const u32x2*)(v16 + go);
                pr[3] = *(const u32x2*)(e16 + go); pr[4] = *(const u32x2*)(a16 + go); pr[5] = *(const u32x2*)(g16 + go);
            }
            __syncthreads();
#pragma unroll 2
            for (int t = 0; t < 16; ++t) {
                const float* op = OPS + t * 320 + kq * 16;
                f32x4 A4[4], B4[4], W4[4], K4[4], R4[4];
#pragma unroll
                for (int i = 0; i < 4; ++i) A4[i] = *(const f32x4*)(op + i * 4);
#pragma unroll
                for (int i = 0; i < 4; ++i) { W4[i] = *(const f32x4*)(op + 128 + i * 4); B4[i] = *(const f32x4*)(op + 64 + i * 4); K4[i] = *(const f32x4*)(op + 192 + i * 4); }
#pragma unroll
                for (int i = 0; i < 4; ++i) R4[i] = *(const f32x4*)(op + 256 + i * 4);
                const float vv = VB[t * 64 + vrow];
                f32x2 s0 = {0.f, 0.f}, s1 = {0.f, 0.f};
#pragma unroll
                for (int i = 0; i < 4; ++i) { s0 += S[2 * i] * (f32x2){A4[i][0], A4[i][1]}; s1 += S[2 * i + 1] * (f32x2){A4[i][2], A4[i][3]}; }
                const float sa = red4((s0[0] + s0[1]) + (s1[0] + s1[1]));
                const f32x2 sa2 = {sa, sa}, vv2 = {vv, vv};
#pragma unroll
                for (int i = 0; i < 4; ++i) {
                    S[2 * i] = S[2 * i] * (f32x2){W4[i][0], W4[i][1]} + sa2 * (f32x2){B4[i][0], B4[i][1]} + vv2 * (f32x2){K4[i][0], K4[i][1]};
                    S[2 * i + 1] = S[2 * i + 1] * (f32x2){W4[i][2], W4[i][3]} + sa2 * (f32x2){B4[i][2], B4[i][3]} + vv2 * (f32x2){K4[i][2], K4[i][3]};
                }
                f32x2 y0 = {0.f, 0.f}, y1 = {0.f, 0.f};
#pragma unroll
                for (int i = 0; i < 4; ++i) { y0 += S[2 * i] * (f32x2){R4[i][0], R4[i][1]}; y1 += S[2 * i + 1] * (f32x2){R4[i][2], R4[i][3]}; }
                const float y = red4((y0[0] + y0[1]) + (y1[0] + y1[1]));
                if (kq == 0) YB[t * 64 + vrow] = y;
            }
            __syncthreads();
            {
                const f32x4 y4 = *(const f32x4*)(YB + tp * 64 + k4), v4 = *(const f32x4*)(VB + tp * 64 + k4), g4 = *(const f32x4*)(GB + tp * 64 + k4);
                const float mu = red16((y4[0] + y4[1]) + (y4[2] + y4[3])) * (1.0f / 64.0f);
                float q = 0.f;
#pragma unroll
                for (int i = 0; i < 4; ++i) { const float d = y4[i] - mu; q += d * d; }
                const float rstd = rsqrtf(red16(q) * (1.0f / 64.0f) + 64e-5f);
                const float bon = BON[tp];
                float o[4];
#pragma unroll
                for (int i = 0; i < 4; ++i) o[i] = ((y4[i] - mu) * rstd * c_lg[i] + c_lb[i] + bon * v4[i]) * g4[i];
                u32x2 w; w.x = pk2(o[0], o[1]); w.y = pk2(o[2], o[3]);
                *(u32x2*)(y16 + ((size_t)(b * 2048 + ch * 16 + tp)) * 1024 + col) = w;
            }
        }
        __syncthreads();
    }
}

__device__ __forceinline__ void dsa_norm_phase(const Params& p, int j, unsigned char* smem) {
    const int tid = opaque_tid();
    const int lane = tid & 63, wave = tid >> 6;
    const float* hin = (const float*)(p.ws + D_HIN);
    h16* cq = (h16*)(p.ws + D_CQ); h16* ckv = (h16*)(p.ws + D_CKV); h16* ckvt = (h16*)(p.ws + D_CKVT); h16* kidx = (h16*)(p.ws + D_KIDX);
    float* widx = (float*)(p.ws + D_WIDX);
    const f32x4 gq = *(const f32x4*)(p.in[23] + j * 256 + lane * 4);
    const f32x2 gkv = *(const f32x2*)(p.in[24] + j * 128 + lane * 2);
    const float gi = p.in[29][j * 64 + lane], bi = p.in[30][j * 64 + lane];
    h16* wl = (h16*)(smem + wave * 2048);
    for (int grp = blockIdx.x * 8 + wave; grp < MTOK / 8; grp += gridDim.x * 8) {
        const int r0 = grp * 8;
        for (int i = 0; i < 8; ++i) {
            const int row = r0 + i;
            const float* hp = hin + (size_t)row * 512;
            const f32x4 vq = *(const f32x4*)(hp + lane * 4);
            const f32x2 vk = *(const f32x2*)(hp + 256 + lane * 2);
            const float vi = hp[384 + lane];
            float ssq = wave_sum(vq[0] * vq[0] + vq[1] * vq[1] + vq[2] * vq[2] + vq[3] * vq[3]);
            const float rq = rsqrtf(ssq * (1.0f / 256.0f) + 1e-6f);
            u32x2 w; w.x = pk2(vq[0] * rq * gq[0], vq[1] * rq * gq[1]); w.y = pk2(vq[2] * rq * gq[2], vq[3] * rq * gq[3]);
            *(u32x2*)(cq + (size_t)row * 256 + lane * 4) = w;
            float ssk = wave_sum(vk[0] * vk[0] + vk[1] * vk[1]);
            const float rk = rsqrtf(ssk * (1.0f / 128.0f) + 1e-6f);
            const unsigned wk = pk2(vk[0] * rk * gkv[0], vk[1] * rk * gkv[1]);
            *(unsigned*)(ckv + (size_t)row * 128 + lane * 2) = wk;
            *(unsigned*)(wl + i * 128 + lane * 2) = wk;
            const float mu = wave_sum(vi) * (1.0f / 64.0f);
            const float dv = vi - mu;
            const float var = wave_sum(dv * dv) * (1.0f / 64.0f);
            kidx[(size_t)row * 64 + lane] = (h16)(dv * rsqrtf(var + 1e-5f) * gi + bi);
            if (lane < 8) widx[(size_t)row * 8 + lane] = hp[448 + lane] * 0.044194173824159216f;
        }
        asm volatile("s_waitcnt lgkmcnt(0)" ::: "memory");
        const int b = r0 >> 11, t0 = r0 & 2047;
#pragma unroll
        for (int dd = 0; dd < 2; ++dd) {
            const int d = lane * 2 + dd;
            h16x8 hv;
#pragma unroll
            for (int i = 0; i < 8; ++i) hv[i] = wl[i * 128 + d];
            *(h16x8*)(ckvt + ((size_t)(b * 128 + d)) * 2048 + t0) = hv;
        }
        asm volatile("s_waitcnt lgkmcnt(0)" ::: "memory");
    }
}

constexpr int ROWP = 2052;
__device__ __forceinline__ unsigned fkey(float x) {
    if (x == 0.0f) x = 0.0f;
    const unsigned u = __float_as_uint(x);
    return (u & 0x80000000u) ? ~u : (u | 0x80000000u);
}
__device__ __forceinline__ void dsa_index_phase(const Params& p, unsigned char* smem) {
    const int tid = opaque_tid(), wave = tid >> 6, lane = tid & 63, r = lane & 15, q = lane >> 4;
    float* SC = (float*)smem;
    const h16* qidx = (const h16*)(p.ws + D_QIDX);
    const h16* kidx = (const h16*)(p.ws + D_KIDX);
    const float* widx = (const float*)(p.ws + D_WIDX);
    unsigned short* selout = (unsigned short*)(p.ws + D_MASK);
    for (int qi = blockIdx.x, it = 0; qi < MTOK / 16; qi += gridDim.x, ++it) {
        const int qt = (it & 1) ? ((qi & ~127) | (127 - (qi & 127))) : qi;
        const int row0 = qt * 16, b = row0 >> 11, t0 = row0 & 2047;
        const int nkt = (t0 >> 4) + 1;
        {
            h16x8 qf[8][2]; float wq[8];
#pragma unroll
            for (int h = 0; h < 8; ++h) {
#pragma unroll
                for (int kk = 0; kk < 2; ++kk) qf[h][kk] = *(const h16x8*)(qidx + (size_t)(row0 + r) * 512 + h * 64 + kk * 32 + q * 8);
                wq[h] = widx[(size_t)(row0 + r) * 8 + h];
            }
            for (int kt = wave; kt < nkt; kt += 16) {
                const bool two = (kt + 8 < nkt);
                const int s0 = kt * 16, s1 = two ? s0 + 128 : s0;
                const h16* kp = kidx + (size_t)(b * 2048 + s0 + r) * 64 + q * 8;
                const h16* kp1 = kidx + (size_t)(b * 2048 + s1 + r) * 64 + q * 8;
                const h16x8 k0 = *(const h16x8*)kp, k1 = *(const h16x8*)(kp + 32), k2 = *(const h16x8*)kp1, k3 = *(const h16x8*)(kp1 + 32);
                f32x4 sc = {0.f, 0.f, 0.f, 0.f}, sd = {0.f, 0.f, 0.f, 0.f};
#pragma unroll
                for (int h = 0; h < 8; ++h) {
                    f32x4 acc = {0.f, 0.f, 0.f, 0.f}, acd = {0.f, 0.f, 0.f, 0.f};
                    acc = __builtin_amdgcn_mfma_f32_16x16x32_f16(k0, qf[h][0], acc, 0, 0, 0);
                    acd = __builtin_amdgcn_mfma_f32_16x16x32_f16(k2, qf[h][0], acd, 0, 0, 0);
                    acc = __builtin_amdgcn_mfma_f32_16x16x32_f16(k1, qf[h][1], acc, 0, 0, 0);
                    acd = __builtin_amdgcn_mfma_f32_16x16x32_f16(k3, qf[h][1], acd, 0, 0, 0);
#pragma unroll
                    for (int jj = 0; jj < 4; ++jj) { sc[jj] += fmaxf(acc[jj], 0.f) * wq[h]; sd[jj] += fmaxf(acd[jj], 0.f) * wq[h]; }
                }
                *(f32x4*)(SC + r * ROWP + s0 + q * 4) = sc;
                if (two) *(f32x4*)(SC + r * ROWP + s1 + q * 4) = sd;
            }
        }
        __syncthreads();
        for (int qq = 0; qq < 2; ++qq) {
            const int ql = wave * 2 + qq, t = t0 + ql;
            const float* srow = SC + ql * ROWP;
            const int ni = (t >> 6) + 1;
            unsigned u[32];
#pragma unroll
            for (int i = 0; i < 32; ++i) {
                u[i] = 0u;
                if (i < ni) { const int s = i * 64 + lane; if (s <= t) u[i] = fkey(srow[s]); }
            }
            unsigned short* selrow = selout + (size_t)(row0 + ql) * 256;
            if (t < 256) {
#pragma unroll
                for (int i = 0; i < 4; ++i) { const int pp = i * 64 + lane; selrow[pp] = (unsigned short)(pp <= t ? pp : 0xFFFF); }
            } else {
                unsigned T = 0u;
                for (int bit = 31; bit >= 0; --bit) {
                    const unsigned cand = T | (1u << bit);
                    int c0 = 0, c1 = 0;
                    if (ni <= 16) {
#pragma unroll
                        for (int i = 0; i < 16; i += 2) { c0 += (u[i] >= cand) ? 1 : 0; c1 += (u[i + 1] >= cand) ? 1 : 0; }
                    } else {
#pragma unroll
                        for (int i = 0; i < 32; i += 2) { c0 += (u[i] >= cand) ? 1 : 0; c1 += (u[i + 1] >= cand) ? 1 : 0; }
                    }
                    int c = c0 + c1;
                    c += __builtin_amdgcn_update_dpp(0, c, 0xB1, 0xF, 0xF, true);
                    c += __builtin_amdgcn_update_dpp(0, c, 0x4E, 0xF, 0xF, true);
                    c += __builtin_amdgcn_update_dpp(0, c, 0x141, 0xF, 0xF, true);
                    c += __builtin_amdgcn_update_dpp(0, c, 0x140, 0xF, 0xF, true);
                    const int cnt = __builtin_amdgcn_readlane(c, 0) + __builtin_amdgcn_readlane(c, 16) + __builtin_amdgcn_readlane(c, 32) + __builtin_amdgcn_readlane(c, 48);
                    if (cnt >= 256) T = cand;
                }
                int cgt = 0;
#pragma unroll
                for (int i = 0; i < 32; ++i) if (i < ni) cgt += __popcll(__ballot(u[i] > T));
                const int need = 256 - cgt;
                int running = 0, outpos = 0;
                const unsigned long long lt = (lane == 0) ? 0ull : (~0ull >> (64 - lane));
#pragma unroll
                for (int i = 0; i < 32; ++i) {
                    if (i < ni) {
                        const unsigned long long eq = __ballot(u[i] == T);
                        const int rank = running + __popcll(eq & lt);
                        const bool sel = u[i] > T || (u[i] == T && rank < need);
                        const unsigned long long sm = __ballot(sel);
                        running += __popcll(eq);
                        if (sel) selrow[outpos + __popcll(sm & lt)] = (unsigned short)(i * 64 + lane);
                        outpos += __popcll(sm);
                    }
                }
            }
        }
        __syncthreads();
    }
}

__device__ __forceinline__ float xmax_16_32(float x) {
    const unsigned u = __builtin_bit_cast(unsigned, x);
    auto r = __builtin_amdgcn_permlane16_swap(u, u, false, false);
    float m = fmaxf(__builtin_bit_cast(float, (unsigned)r[0]), __builtin_bit_cast(float, (unsigned)r[1]));
    const unsigned u2 = __builtin_bit_cast(unsigned, m);
    auto r2 = __builtin_amdgcn_permlane32_swap(u2, u2, false, false);
    return fmaxf(__builtin_bit_cast(float, (unsigned)r2[0]), __builtin_bit_cast(float, (unsigned)r2[1]));
}
__device__ __forceinline__ float xsum_16_32(float x) {
    const unsigned u = __builtin_bit_cast(unsigned, x);
    auto r = __builtin_amdgcn_permlane16_swap(u, u, false, false);
    float m = __builtin_bit_cast(float, (unsigned)r[0]) + __builtin_bit_cast(float, (unsigned)r[1]);
    const unsigned u2 = __builtin_bit_cast(unsigned, m);
    auto r2 = __builtin_amdgcn_permlane32_swap(u2, u2, false, false);
    return __builtin_bit_cast(float, (unsigned)r2[0]) + __builtin_bit_cast(float, (unsigned)r2[1]);
}
typedef __fp16 fp16x4_t __attribute__((__vector_size__(4 * sizeof(__fp16))));
__device__ __forceinline__ unsigned off_b(unsigned row, unsigned ch) { return 256u * row + 16u * (ch ^ (((row & 3) << 2) | ((row >> 2) & 3))); }
constexpr int SA_TILE = 8192, SA_BL = 8 * 2 * SA_TILE;
static_assert(SA_BL + 16 * 132 * 4 <= LDS_BYTES, "sparse attention LDS");
__device__ __forceinline__ void dsa_attn_phase(const Params& p, int j, unsigned char* smem) {
    const int tid = opaque_tid(), wave = tid >> 6, lane = tid & 63, r = lane & 15, q = lane >> 4;
    float* BL = (float*)(smem + SA_BL);
    for (int idx = tid; idx < 16 * 129; idx += 512) {
        const int h = idx / 129, d = idx % 129;
        int bk = d;
        if (d >= 16) { bk = 16 + (int)(logf((float)d * (1.0f / 16.0f)) / 2.0794415416798357f * 16.0f); bk = bk > 31 ? 31 : bk; }
        BL[h * 132 + d] = p.in[32][bk * 16 + h] * 1.4426950408889634f;
    }
    __syncthreads();
    const h16* qabs = (const h16*)(p.ws + D_QABS);
    const h16* ckv = (const h16*)(p.ws + D_CKV);
    const unsigned short* sel = (const unsigned short*)(p.ws + D_MASK);
    h16* olatA = (h16*)(p.ws + D_HIN);
    h16* olatB = (h16*)p.out + (size_t)MTOK * 1024;
    unsigned char* tile0 = smem + wave * (2 * SA_TILE);
    const float NINF = -__builtin_inff();
    unsigned wofs[8], kofs[2][4], vofs[8][2];
#pragma unroll
    for (int i = 0; i < 8; ++i) wofs[i] = off_b(8 * q + i, r);
#pragma unroll
    for (int tt = 0; tt < 2; ++tt)
#pragma unroll
        for (int kk = 0; kk < 4; ++kk) kofs[tt][kk] = off_b(8 * (r >> 2) + 4 * tt + (r & 3), 4 * kk + q);
#pragma unroll
    for (int c = 0; c < 8; ++c)
#pragma unroll
        for (int t2 = 0; t2 < 2; ++t2) vofs[c][t2] = off_b(8 * q + 4 * t2 + (r >> 2), 2 * c + ((lane & 3) >> 1)) + 8 * (lane & 1);
    for (int row = blockIdx.x * 8 + wave; row < MTOK; row += gridDim.x * 8) {
        const int b = row >> 11, t = row & 2047;
        const int nvalid = t + 1 < 256 ? t + 1 : 256, ng = (nvalid + 31) >> 5;
        const h16* kg = ckv + (size_t)(b * 2048) * 128;
        const unsigned short* srow = sel + (size_t)row * 256;
        h16x8 qf[4];
#pragma unroll
        for (int kk = 0; kk < 4; ++kk) qf[kk] = *(const h16x8*)(qabs + (size_t)row * 2048 + r * 128 + kk * 32 + q * 8);
        f32x4 O[8];
#pragma unroll
        for (int dt = 0; dt < 8; ++dt) O[dt] = (f32x4){0.f, 0.f, 0.f, 0.f};
        float mrun = NINF, lrun = 0.f;
        u32x4 selv = *(const u32x4*)(srow + 8 * q);
        u32x4 gr[8];
#pragma unroll
        for (int i = 0; i < 8; ++i) {
            unsigned sidx = (selv[i >> 1] >> ((i & 1) * 16)) & 0xFFFFu; sidx = sidx == 0xFFFFu ? 0u : sidx;
            gr[i] = *(const u32x4*)(kg + (size_t)sidx * 128 + r * 8);
        }
        for (int g = 0; g < ng; ++g) {
            unsigned char* tile = tile0 + (g & 1) * SA_TILE;
            const u32x4 selc = selv;
#pragma unroll
            for (int i = 0; i < 8; ++i) *(u32x4*)(tile + wofs[i]) = gr[i];
            if (g + 1 < ng) {
                selv = *(const u32x4*)(srow + (g + 1) * 32 + 8 * q);
#pragma unroll
                for (int i = 0; i < 8; ++i) {
                    unsigned sidx = (selv[i >> 1] >> ((i & 1) * 16)) & 0xFFFFu; sidx = sidx == 0xFFFFu ? 0u : sidx;
                    gr[i] = *(const u32x4*)(kg + (size_t)sidx * 128 + r * 8);
                }
            }
            asm volatile("s_waitcnt lgkmcnt(0)" ::: "memory");
            f32x4 sc[2];
#pragma unroll
            for (int tt = 0; tt < 2; ++tt) {
                f32x4 acc = {0.f, 0.f, 0.f, 0.f};
#pragma unroll
                for (int kk = 0; kk < 4; ++kk) {
                    const h16x8 kf = *(const h16x8*)(tile + kofs[tt][kk]);
                    acc = __builtin_amdgcn_mfma_f32_16x16x32_f16(kf, qf[kk], acc, 0, 0, 0);
                }
                sc[tt] = acc;
            }
            float x[8]; float mx = NINF;
#pragma unroll
            for (int i = 0; i < 8; ++i) {
                const unsigned sidx = (selc[i >> 1] >> ((i & 1) * 16)) & 0xFFFFu;
                int dist = t - (int)sidx; dist = dist < 0 ? 0 : (dist > 128 ? 128 : dist);
                const float v = sc[i >> 2][i & 3] + BL[r * 132 + dist];
                const float xv = (sidx != 0xFFFFu) ? v : NINF;
                x[i] = xv; mx = fmaxf(mx, xv);
            }
            mx = xmax_16_32(mx);
            const float mnew = fmaxf(mrun, mx);
            const float mref = (mnew == NINF) ? 0.f : mnew;
            const float alpha = __builtin_amdgcn_exp2f(mrun - mref);
            mrun = mnew;
            float ps = 0.f; h16x8 pf;
#pragma unroll
            for (int i = 0; i < 8; ++i) { const float pv = __builtin_amdgcn_exp2f(x[i] - mref); ps += pv; pf[i] = (h16)pv; }
            lrun = lrun * alpha + ps;
#pragma unroll
            for (int dt = 0; dt < 8; ++dt) {
                const fp16x4_t lo = __builtin_amdgcn_ds_read_tr16_b64_v4f16((LAS fp16x4_t*)(tile + vofs[dt][0]));
                const fp16x4_t hi = __builtin_amdgcn_ds_read_tr16_b64_v4f16((LAS fp16x4_t*)(tile + vofs[dt][1]));
                const h16x4 l4 = __builtin_bit_cast(h16x4, lo), h4 = __builtin_bit_cast(h16x4, hi);
                const h16x8 vf = {l4[0], l4[1], l4[2], l4[3], h4[0], h4[1], h4[2], h4[3]};
                O[dt] *= alpha;
                O[dt] = __builtin_amdgcn_mfma_f32_16x16x32_f16(vf, pf, O[dt], 0, 0, 0);
            }
        }
        const float inv = 1.0f / xsum_16_32(lrun);
        h16* op = (row < MTOK / 2 ? olatA + (size_t)row * 2048 : olatB + (size_t)(row - MTOK / 2) * 2048) + r * 128 + q * 4;
#pragma unroll
        for (int dt = 0; dt < 8; ++dt) {
            u32x2 w; w.x = pk2(O[dt][0] * inv, O[dt][1] * inv); w.y = pk2(O[dt][2] * inv, O[dt][3] * inv);
            *(u32x2*)(op + dt * 16) = w;
        }
        asm volatile("s_waitcnt lgkmcnt(0)" ::: "memory");
    }
    __syncthreads();
}

constexpr size_t OFF_BAR = 951 * MiB;
__device__ __forceinline__ void grid_bar(unsigned* ctr, unsigned& target, unsigned nblk) {
    asm volatile("s_waitcnt vmcnt(0) lgkmcnt(0)" ::: "memory");
    __syncthreads();
    target += nblk;
    if (threadIdx.x == 0) {
        __builtin_amdgcn_fence(__ATOMIC_RELEASE, "agent");
        asm volatile("s_waitcnt vmcnt(0)" ::: "memory");
        __hip_atomic_fetch_add(ctr, 1u, __ATOMIC_RELAXED, __HIP_MEMORY_SCOPE_AGENT);
        while (__hip_atomic_load(ctr, __ATOMIC_RELAXED, __HIP_MEMORY_SCOPE_AGENT) < target) __builtin_amdgcn_s_sleep(1);
        __builtin_amdgcn_fence(__ATOMIC_ACQUIRE, "agent");
        asm volatile("s_waitcnt vmcnt(0)" ::: "memory");
    }
    __syncthreads();
}

__global__ void __launch_bounds__(512) mega_fwd(Params p) {
    extern __shared__ __attribute__((aligned(16))) unsigned char smem[];
    cg::grid_group grid = cg::this_grid();
    unsigned char* ws = p.ws;
    h16* x16 = (h16*)(ws + OFF_X16);
    unsigned* barctr = (unsigned*)(ws + OFF_BAR);
    unsigned bar_target = 0u;
    for (int ph = p.ph_lo; ph < p.ph_hi; ++ph) {
        const unsigned e = p.prog[ph];
        const int kind = e & 15, L = (e >> 4) & 3, sub = (e >> 6) & 1, j = L >> 1;
        const int nrep = 1 + (int)(e >> 7);
        for (int rep = 0; rep < nrep; ++rep) {
        if (rep) grid_bar(barctr, bar_target, gridDim.x);
        const bool isgemm = (kind == K_R1 || kind == K_R2 || kind == K_R4 || kind == K_F1 || kind == K_F3 || kind == K_D1 || kind == K_D3 || kind == K_D6);
        if (isgemm) {
            const int ngemm = (kind == K_R1) ? 2 : 1;
            for (int gi = 0; gi < ngemm; ++gi) {
            pg8::Gemm g; pg8::Epi E;
            g.M = MTOK; g.N = 1024; g.K = 1024; g.lda = 1024; g.amode = 0; g.pm0 = 0; g.A = x16; g.A2 = x16; g.Bt = x16;
            E.mode = E_RESID; E.pm0 = 0; E.j = j; E.pnoff = 0; E.fin = (L == 3 && kind == K_F3) ? 1 : 0; E.ws = ws; E.out = p.out; E.bias0 = p.in[5] + j * 1024; E.bias1 = p.in[8] + j * 1024; E.bias2 = p.in[11];
            if (kind == K_R1) {
                E.mode = E_RPROJ;
                if (gi == 0) { g.A = (const h16*)p.out; g.A2 = (const h16*)(ws + R_G16); g.Bt = w_rwkv_big(ws, j); g.N = 3072; g.amode = 2; }
                else { g.Bt = w_rwkv_l1(ws, j); g.N = 512; g.K = 2048; g.amode = 1; E.pnoff = 12; }
            } else if (kind == K_R2) {
                g.A = (const h16*)(ws + R_HACT); g.Bt = w_rwkv_l2(ws, j); g.N = (j == 0) ? 3072 : 4096; g.K = 384; g.lda = 384; E.mode = E_LORA2;
            } else if (kind == K_R4) {
                g.A = (const h16*)(ws + (j == 0 ? R_V16 : OFF_VF)); g.Bt = w_rwkv_o(ws, j);
            } else if (kind == K_F1) {
                g.Bt = w_ffn_up(ws, L); g.M = MTOK / 2; g.N = 5632; g.amode = 1; g.pm0 = sub * 128; E.mode = E_ST16;
            } else if (kind == K_F3) {
                g.A = (const h16*)(ws + F_ACT); g.Bt = w_ffn_dn(ws, L); g.M = MTOK / 2; g.K = 2816; g.lda = 2816; E.pm0 = sub * 128;
            } else if (kind == K_D1) {
                g.Bt = w_dsa_in(ws, j); g.N = 512; g.amode = 1; E.mode = E_ST32;
            } else if (kind == K_D3) {
                g.A = (const h16*)(ws + D_CQ); g.Bt = w_dsa_q(ws, j); g.N = 2560; g.K = 256; g.lda = 256; E.mode = E_QPROJ;
            } else {
                g.A = (const h16*)(ws + D_HIN); g.A2 = (const h16*)p.out + (size_t)MTOK * 1024; g.Bt = (const h16*)(ws + OFF_WOV) + (size_t)j * 2097152; g.K = 2048; g.lda = 2048; g.amode = 3;
            }
            pg8::StaticOrder S; S.init(g.M, g.N, (int)gridDim.x, (int)blockIdx.x);
#ifndef NO_GEMM
            pg8::gemm_phase((LAS unsigned char*)smem, g, S, E);
#endif
            }
        } else if (kind == K_PREP) {
#ifndef NO_PREP
            prep_phase(p, smem);
#endif
        } else if (kind == K_R0) {
            mix_phase(p, j);
        } else if (kind == K_R3) {
#ifndef NO_SCAN
            scan_phase(p, j, smem);
#endif
        } else if (kind == K_LN) {
#ifndef NO_LN
            ln_phase(p, p.in[1] + (L * 2 + sub) * 1024, p.in[2] + (L * 2 + sub) * 1024, L == 3 && sub == 1);
#endif
        } else if (kind == K_F2) {
#ifndef NO_CONV
            conv_phase(p, L);
#endif
        } else if (kind == K_D2) {
#ifndef NO_NORM
            dsa_norm_phase(p, j, smem);
#endif
        } else if (kind == K_D4) {
#ifndef NO_INDEX
            dsa_index_phase(p, smem);
#endif
        } else if (kind == K_D5) {
#ifndef NO_ATTN
            dsa_attn_phase(p, j, smem);
#endif
        }
        }
        if (ph + 1 < p.ph_hi) { if (ph == p.ph_lo) grid.sync(); else grid_bar(barctr, bar_target, gridDim.x); for (int xs = 0; xs < EXTRA_SYNC; ++xs) grid_bar(barctr, bar_target, gridDim.x); }
    }
}

extern "C" void kernel_launch(void* const* d_in, const int* in_sizes, int n_in, void* d_out, int out_size, void* d_ws, size_t ws_size, hipStream_t stream) {
    static int grid_blocks = 0;
    if (grid_blocks == 0) {
        if (n_in != 37 || ws_size < WS_NEED || out_size != MTOK * DM) { fprintf(stderr, "kernel_launch: unexpected problem (n_in %d ws %zu out %d)\n", n_in, ws_size, out_size); grid_blocks = -1; return; }
        int dev = 0, cus = 0, per_cu = 0;
        hipGetDevice(&dev);
        hipDeviceGetAttribute(&cus, hipDeviceAttributeMultiprocessorCount, dev);
        if (hipFuncSetAttribute((const void*)mega_fwd, hipFuncAttributeMaxDynamicSharedMemorySize, LDS_BYTES) != hipSuccess) { fprintf(stderr, "kernel_launch: hipFuncSetAttribute failed\n"); grid_blocks = -1; return; }
        hipOccupancyMaxActiveBlocksPerMultiprocessor(&per_cu, (const void*)mega_fwd, 512, LDS_BYTES);
        if (per_cu < 1) { fprintf(stderr, "kernel_launch: occupancy query says %d blocks/CU\n", per_cu); per_cu = 1; }
        (void)hipGetLastError();
        grid_blocks = cus * per_cu;
        fprintf(stderr, "kernel_launch: grid %d (cus %d x %d)\n", grid_blocks, cus, per_cu);
    }
    if (grid_blocks < 0) return;
    Params p{};
    for (int i = 0; i < 37; ++i) p.in[i] = (const float*)d_in[i];
    p.ws = (unsigned char*)d_ws; p.out = (float*)d_out;
    int np = 0;
    constexpr unsigned PROBE_MASK = 0u;
    auto add = [&](int kind, int L, int sub) { p.prog[np++] = (unsigned char)(kind | (L << 4) | (sub << 6) | ((((PROBE_MASK >> kind) & 1u) && !(kind == K_LN && L == 3 && sub == 1)) ? 128 : 0)); };
    add(K_PREP, 0, 0);
    for (int L = 0; L < 4; ++L) {
        if ((L & 1) == 0) { add(K_R0, L, 0); add(K_R1, L, 0); add(K_R2, L, 0); add(K_R3, L, 0); add(K_R4, L, 0); }
        else { add(K_D1, L, 0); add(K_D2, L, 0); add(K_D3, L, 0); add(K_D4, L, 0); add(K_D5, L, 0); add(K_D6, L, 0); }
        add(K_LN, L, 0);
        for (int c = 0; c < 2; ++c) { add(K_F1, L, c); add(K_F2, L, c); add(K_F3, L, c); }
        add(K_LN, L, 1);
    }
#if SINGLE_LAUNCH
    if (hipMemsetAsync((unsigned char*)d_ws + OFF_BAR, 0, 256, stream) != hipSuccess) { fprintf(stderr, "kernel_launch: memset failed\n"); return; }
    p.ph_lo = 0; p.ph_hi = np;
    void* args[] = {&p};
    hipError_t e = hipLaunchCooperativeKernel((const void*)mega_fwd, dim3(grid_blocks), dim3(512), args, LDS_BYTES, stream);
    if (e != hipSuccess) fprintf(stderr, "cooperative launch failed: %s (grid %d)\n", hipGetErrorString(e), grid_blocks);
#else
    for (int ph = 0; ph < np; ++ph) {
        p.ph_lo = ph; p.ph_hi = ph + 1;
        hipLaunchKernelGGL(mega_fwd, dim3(grid_blocks), dim3(512), LDS_BYTES, stream, p);
    }
#endif
}
```

```cpp
#include <hip/hip_runtime.h>
#include <hip/hip_cooperative_groups.h>
#include <cstdio>
namespace cg = cooperative_groups;

constexpr int EXTRA_SYNC = 0;
#ifndef SINGLE_LAUNCH
#define SINGLE_LAUNCH 1
#endif

#define LAS __attribute__((address_space(3)))
typedef _Float16 h16;
typedef _Float16 h16x8 __attribute__((ext_vector_type(8)));
typedef _Float16 h16x4 __attribute__((ext_vector_type(4)));
typedef _Float16 h16x2 __attribute__((ext_vector_type(2)));
typedef float f32x4 __attribute__((ext_vector_type(4)));
typedef float f32x2 __attribute__((ext_vector_type(2)));
typedef unsigned u32x4 __attribute__((ext_vector_type(4)));
typedef unsigned u32x2 __attribute__((ext_vector_type(2)));

constexpr int DM = 1024, SEQ = 2048, NBATCH = 32, MTOK = NBATCH * SEQ;
constexpr int DFF = 2816;
constexpr size_t MiB = (size_t)1 << 20;
constexpr float DN_ALPHA = 1.6817928305074290f;
constexpr int LDS_BYTES = 147456;

constexpr size_t OFF_W = 0;
constexpr size_t OFF_X16 = 118 * MiB;
constexpr size_t OFF_VF = 247 * MiB;
constexpr size_t OFF_R = 375 * MiB;
constexpr size_t WS_NEED = 960 * MiB;
constexpr size_t OFF_WOV = 952 * MiB;
constexpr size_t R_R16 = OFF_R, R_K16 = OFF_R + 128 * MiB, R_V16 = OFF_R + 256 * MiB, R_G16 = OFF_R + 384 * MiB, R_HACT = OFF_R + 512 * MiB;
constexpr size_t F_U16 = OFF_R, F_ACT = OFF_R + 352 * MiB;
constexpr size_t D_HIN = OFF_R, D_O16 = OFF_R, D_QABS = OFF_R + 128 * MiB, D_QIDX = OFF_R + 384 * MiB, D_CQ = OFF_R + 448 * MiB,
                 D_CKV = OFF_R + 480 * MiB, D_CKVT = OFF_R + 496 * MiB, D_KIDX = OFF_R + 512 * MiB, D_WIDX = OFF_R + 520 * MiB, D_MASK = OFF_R + 522 * MiB;

struct Params {
    const float* in[37];
    unsigned char* ws;
    float* out;
    int ph_lo, ph_hi;
    unsigned char prog[64];
};

enum { K_PREP = 0, K_R1, K_R2, K_R3, K_R4, K_LN, K_F1, K_F2, K_F3, K_D1, K_D2, K_D3, K_D4, K_D5, K_D6, K_R0 };
enum { E_RPROJ = 0, E_LORA2, E_RESID, E_ST16, E_ST32, E_QPROJ };

__device__ __forceinline__ size_t xrow(int row) { return (size_t)(row >> 11) * 2049 + 1 + (row & 2047); }
__device__ __forceinline__ unsigned pk2(float a, float b) { h16x2 h = {(h16)a, (h16)b}; return __builtin_bit_cast(unsigned, h); }
__device__ __forceinline__ u32x4 pack8(f32x4 a, f32x4 b) { u32x4 w; w.x = pk2(a[0], a[1]); w.y = pk2(a[2], a[3]); w.z = pk2(b[0], b[1]); w.w = pk2(b[2], b[3]); return w; }
__device__ __forceinline__ void unpack8(u32x4 w, float* f) {
    h16x8 h = __builtin_bit_cast(h16x8, w);
#pragma unroll
    for (int i = 0; i < 8; ++i) f[i] = (float)h[i];
}
__device__ __forceinline__ float sigmoidf_(float x) { return 1.0f / (1.0f + __expf(-x)); }
__device__ __forceinline__ float wave_sum(float v) {
#pragma unroll
    for (int o = 32; o > 0; o >>= 1) v += __shfl_xor(v, o);
    return v;
}
#define WSYNC() asm volatile("s_waitcnt vmcnt(0) lgkmcnt(0)" ::: "memory")
__device__ __forceinline__ int opaque_tid() { int t = threadIdx.x; asm volatile("" : "+v"(t)); return t; }

namespace pg8 {
constexpr int BM = 256, BK = 64, HALF = 128, HTB = HALF * BK * 2, STAGE_BYTES = 8 * HTB, NXCD = 8, WGM = 8;
__device__ __forceinline__ int lds_byte(int r, int c) { const int st = (r >> 4) * 2 + (c >> 5), rr = r & 15, cc = c & 31, ob = rr * 64 + cc * 2; return st * 1024 + (ob ^ (((ob >> 9) & 1) << 5)); }
__device__ __forceinline__ void stage_rc(int b, int& R, int& C) { const int st = b / 1024, sb = b % 1024, swz = sb ^ (((sb >> 9) & 1) << 5); R = (st >> 1) * 16 + swz / 64; C = (st & 1) * 32 + (swz % 64) / 2; }
__device__ __forceinline__ int perm32(int rho) { const int n = rho >> 4, i = rho & 15; return 8 * (i >> 2) + 4 * n + (i & 3); }
struct Unit { int pm, pn; };
struct Gemm { const h16* A; const h16* A2; const h16* Bt; int M, N, K, lda, amode, pm0; };
struct StaticOrder {
    int nM, nN, nwg, G, c;
    __device__ void init(int M, int N, int G_, int c_) { nM = M / BM; nN = N / BM; nwg = nM * nN; G = G_; c = c_; }
    __device__ bool next(int i, Unit& u) const {
        const long L = (long)i * G + c; if (L >= nwg) return false;
        int wgid = (int)L; { const int q = nwg / NXCD, r = nwg % NXCD, xcd = wgid % NXCD, off = wgid / NXCD; wgid = (xcd < r ? xcd * (q + 1) : r * (q + 1) + (xcd - r) * q) + off; }
        const int nig = WGM * nN, gid = wgid / nig, fm = gid * WGM, gsz = (nM - fm) < WGM ? (nM - fm) : WGM;
        u.pm = fm + ((wgid % nig) % gsz); u.pn = (wgid % nig) / gsz; return true;
    }
};

struct Epi {
    int mode, pm0, j, pnoff, fin;
    unsigned char* ws; float* out; const float* bias0; const float* bias1; const float* bias2;
    __device__ __forceinline__ void operator()(const f32x4 (&acc)[2][2][4][2], const Unit& u, int wr, int wc, int fr, int fq) const {
        const int rowl0 = u.pm * BM + wr * 64 + fr;
        const int colt = u.pn * BM + wc * 32 + 8 * fq;
        if (mode == E_RESID) {
            u32x4 xr[2][4][2];
#pragma unroll
            for (int ai = 0; ai < 2; ++ai)
#pragma unroll
                for (int m = 0; m < 4; ++m) {
                    const int rowg = rowl0 + ai * HALF + m * 16 + pm0 * BM;
                    const h16* xp = (const h16*)(ws + OFF_X16) + xrow(rowg) * 1024 + colt;
#pragma unroll
                    for (int bj = 0; bj < 2; ++bj) xr[ai][m][bj] = *(const u32x4*)(xp + bj * HALF);
                }
#pragma unroll
            for (int ai = 0; ai < 2; ++ai)
#pragma unroll
                for (int m = 0; m < 4; ++m) {
                    const int rowg = rowl0 + ai * HALF + m * 16 + pm0 * BM;
                    float* dp0 = out + (size_t)rowg * 1024 + colt;
                    h16* hp0 = (h16*)out + (size_t)rowg * 1024 + colt;
#pragma unroll
                    for (int bj = 0; bj < 2; ++bj) {
                        float xf[8]; unpack8(xr[ai][m][bj], xf);
                        const f32x4 v0 = acc[ai][bj][m][0], v1 = acc[ai][bj][m][1];
                        f32x4 r0, r1;
#pragma unroll
                        for (int jj = 0; jj < 4; ++jj) { r0[jj] = DN_ALPHA * xf[jj] + v0[jj]; r1[jj] = DN_ALPHA * xf[4 + jj] + v1[jj]; }
                        if (fin) { float* dp = dp0 + bj * HALF; *(f32x4*)dp = r0; *(f32x4*)(dp + 4) = r1; }
                        else *(u32x4*)(hp0 + bj * HALF) = pack8(r0, r1);
                    }
                }
            return;
        }
        if (mode == E_LORA2 && (u.pn >> 2) == 3) {
            const int c0 = colt & 1023;
#pragma unroll
            for (int ai = 0; ai < 2; ++ai) {
                u32x4 lv[4][2], lf[4][2];
#pragma unroll
                for (int m = 0; m < 4; ++m) {
                    const size_t off = (size_t)(rowl0 + ai * HALF + m * 16 + pm0 * BM) * 1024 + c0;
#pragma unroll
                    for (int bj = 0; bj < 2; ++bj) { lv[m][bj] = *(const u32x4*)((const h16*)(ws + R_V16) + off + bj * HALF); lf[m][bj] = *(const u32x4*)((const h16*)(ws + OFF_VF) + off + bj * HALF); }
                }
#pragma unroll
                for (int m = 0; m < 4; ++m) {
                    const size_t off = (size_t)(rowl0 + ai * HALF + m * 16 + pm0 * BM) * 1024 + c0;
#pragma unroll
                    for (int bj = 0; bj < 2; ++bj) {
                        const int c = c0 + bj * HALF;
                        const f32x4 ba = *(const f32x4*)(bias2 + c), bb = *(const f32x4*)(bias2 + c + 4);
                        float vv[8], vf8[8]; unpack8(lv[m][bj], vv); unpack8(lf[m][bj], vf8);
                        f32x4 v0 = acc[ai][bj][m][0], v1 = acc[ai][bj][m][1];
#pragma unroll
                        for (int jj = 0; jj < 4; ++jj) {
                            v0[jj] = vv[jj] + (vf8[jj] - vv[jj]) * sigmoidf_(v0[jj] + ba[jj]);
                            v1[jj] = vv[4 + jj] + (vf8[4 + jj] - vv[4 + jj]) * sigmoidf_(v1[jj] + bb[jj]);
                        }
                        *(u32x4*)((h16*)(ws + R_V16) + off + bj * HALF) = pack8(v0, v1);
                    }
                }
            }
            return;
        }
#pragma unroll
        for (int ai = 0; ai < 2; ++ai)
#pragma unroll
            for (int m = 0; m < 4; ++m) {
                const int rowl = rowl0 + ai * HALF + m * 16;
                const int rowg = rowl + pm0 * BM;
#pragma unroll
                for (int bj = 0; bj < 2; ++bj) {
                    const int col = colt + bj * HALF;
                    f32x4 v0 = acc[ai][bj][m][0], v1 = acc[ai][bj][m][1];
                    if (mode == E_RPROJ) {
                        if (pnoff == 0) {
                            h16* dst = (h16*)(ws + (u.pn < 4 ? R_R16 : (u.pn < 8 ? R_K16 : (j == 0 ? OFF_VF : R_V16))));
                            *(u32x4*)(dst + (size_t)rowg * 1024 + (col & 1023)) = pack8(v0, v1);
                        } else if (col < 384) {
                            const int hc = col;
                            if (hc < 64) {
#pragma unroll
                                for (int jj = 0; jj < 4; ++jj) { v0[jj] = tanhf(v0[jj]); v1[jj] = tanhf(v1[jj]); }
                            } else if (hc >= 160) {
#pragma unroll
                                for (int jj = 0; jj < 4; ++jj) { v0[jj] = sigmoidf_(v0[jj]); v1[jj] = sigmoidf_(v1[jj]); }
                            }
                            *(u32x4*)((h16*)(ws + R_HACT) + (size_t)rowg * 384 + hc) = pack8(v0, v1);
                        }
                    } else if (mode == E_LORA2) {
                        const int grp = u.pn >> 2, c = col & 1023;
                        const size_t off = (size_t)rowg * 1024 + c;
                        if (grp == 0) {
                            const f32x4 ba = *(const f32x4*)(bias0 + c), bb = *(const f32x4*)(bias0 + c + 4);
#pragma unroll
                            for (int jj = 0; jj < 4; ++jj) { v0[jj] = sigmoidf_(v0[jj] + ba[jj]) * 0.6065306597f; v1[jj] = sigmoidf_(v1[jj] + bb[jj]) * 0.6065306597f; }
                            *(u32x4*)((h16*)out + off) = pack8(v0, v1);
                        } else if (grp == 1) {
                            const f32x4 ba = *(const f32x4*)(bias1 + c), bb = *(const f32x4*)(bias1 + c + 4);
#pragma unroll
                            for (int jj = 0; jj < 4; ++jj) { v0[jj] = sigmoidf_(v0[jj] + ba[jj]); v1[jj] = sigmoidf_(v1[jj] + bb[jj]); }
                            *(u32x4*)((h16*)out + (size_t)MTOK * 1024 + off) = pack8(v0, v1);
                        } else {
                            *(u32x4*)((h16*)(ws + R_G16) + off) = pack8(v0, v1);
                        }
                    } else if (mode == E_ST16) {
                        *(u32x4*)((h16*)(ws + F_U16) + (size_t)rowl * 5632 + col) = pack8(v0, v1);
                    } else if (mode == E_ST32) {
                        float* dp = (float*)(ws + D_HIN) + (size_t)rowg * 512 + col;
                        *(f32x4*)dp = v0; *(f32x4*)(dp + 4) = v1;
                    } else {
                        if (u.pn < 8) *(u32x4*)((h16*)(ws + D_QABS) + (size_t)rowg * 2048 + col) = pack8(v0, v1);
                        else *(u32x4*)((h16*)(ws + D_QIDX) + (size_t)rowg * 512 + (col - 2048)) = pack8(v0, v1);
                    }
                }
            }
    }
};

__device__ __forceinline__ const char* a_tile(const Gemm& g, int pm, int pn) {
    if (g.amode == 1) { const int row = (pm + g.pm0) * BM; return (const char*)g.A + xrow(row) * 2048; }
    if (g.amode == 2) {
        const int gq = pn >> 2;
        const char* base = gq == 2 ? (const char*)g.A2 : (const char*)g.A + (size_t)gq * ((size_t)MTOK * 1024 * 2);
        return base + (size_t)pm * BM * 2048;
    }
    if (g.amode == 3) return (pm < 128 ? (const char*)g.A + (size_t)pm * BM * 4096 : (const char*)g.A2 + (size_t)(pm - 128) * BM * 4096);
    return (const char*)g.A + (size_t)pm * BM * g.lda * 2;
}

__device__ __forceinline__ void gemm_phase(LAS unsigned char* lds, const Gemm g, const StaticOrder& S, const Epi& E) {
    const int tid = opaque_tid(), wid = __builtin_amdgcn_readfirstlane(tid >> 6), lane = tid & 63, wr = wid >> 2, wc = wid & 3, fr = lane & 15, fq = lane >> 4;
    const int K = g.K, nt = K / BK;
    const bool shiftA = (g.amode == 1);
    unsigned voffA[2], voffB[2];
#pragma unroll
    for (int i = 0; i < 2; ++i) { int R, C; stage_rc(tid * 16 + i * 8192, R, C); const int Rb = (R & ~31) + perm32(R & 31);
        voffA[i] = (unsigned)(R * g.lda + C) * 2u; voffB[i] = (unsigned)(Rb * K + C) * 2u; }
    const size_t kstep = (size_t)(BK * 2);
    const size_t hstepA = (size_t)HALF * g.lda * 2;
    const size_t hstepB = (size_t)HALF * K * 2;
    const size_t tstepB = 2 * hstepB;
    const unsigned ldsw = (unsigned)wid * 1024u;
    const int aoff = lds_byte(wr * 64 + fr, fq * 8), boff = lds_byte(wc * 32 + fr, fq * 8);
#define PG8_KOFF(kt) ((size_t)(kt) * kstep - ((shiftA && (kt) >= 16) ? (size_t)4096 : (size_t)0))
#define PG8_SA(b, h) (((b) * 2 + (h)) * HTB)
#define PG8_SB(b, h) ((4 + (b) * 2 + (h)) * HTB)
#define PG8_STAGE(bufoff, gbase, voff) do { _Pragma("unroll") for (int _i = 0; _i < 2; ++_i) \
        __builtin_amdgcn_global_load_lds((const unsigned*)((const char*)(gbase) + (voff)[_i]), (LAS unsigned*)(lds + (bufoff) + ldsw + _i * 8192), 16, 0, 0); } while (0)
#define PG8_LDA(dst, b, h) do { _Pragma("unroll") for (int m = 0; m < 4; ++m) _Pragma("unroll") for (int k = 0; k < 2; ++k) dst[m][k] = *(const LAS h16x8*)(lds + PG8_SA(b, h) + aoff + m * 2048 + k * 1024); } while (0)
#define PG8_LDB(dst, b, h) do { _Pragma("unroll") for (int n = 0; n < 2; ++n) _Pragma("unroll") for (int k = 0; k < 2; ++k) dst[n][k] = *(const LAS h16x8*)(lds + PG8_SB(b, h) + boff + n * 2048 + k * 1024); } while (0)
#define PG8_MMA(ai, bj, At, Bt) do { __builtin_amdgcn_s_setprio(1); _Pragma("unroll") for (int m = 0; m < 4; ++m) _Pragma("unroll") for (int n = 0; n < 2; ++n) _Pragma("unroll") for (int k = 0; k < 2; ++k) \
        acc[ai][bj][m][n] = __builtin_amdgcn_mfma_f32_16x16x32_f16(Bt[n][k], At[m][k], acc[ai][bj][m][n], 0, 0, 0); __builtin_amdgcn_s_setprio(0); } while (0)
#define PG8_WAIT_V(n) asm volatile("s_waitcnt vmcnt(" #n ")" ::: "memory")
#define PG8_WAIT_L(n) asm volatile("s_waitcnt lgkmcnt(" #n ")" ::: "memory")
#define PG8_BAR __builtin_amdgcn_s_barrier()
#define PG8_SCHED __builtin_amdgcn_sched_barrier(0)
    Unit cur, nxt; int ui = 0;
    if (!S.next(0, cur)) return;
    f32x4 acc[2][2][4][2];
#pragma unroll
    for (int a = 0; a < 2; ++a)
#pragma unroll
        for (int b = 0; b < 2; ++b)
#pragma unroll
            for (int m = 0; m < 4; ++m)
#pragma unroll
                for (int n = 0; n < 2; ++n) acc[a][b][m][n] = (f32x4){0.f, 0.f, 0.f, 0.f};
    h16x8 At[4][2], B0[2][2], B1[2][2];
    const char* cA = a_tile(g, cur.pm, cur.pn); const char* cB = (const char*)g.Bt + (size_t)cur.pn * tstepB;
    PG8_STAGE(PG8_SB(0, 0), cB, voffB); PG8_STAGE(PG8_SA(0, 0), cA, voffA); PG8_STAGE(PG8_SB(0, 1), cB + hstepB, voffB); PG8_STAGE(PG8_SA(0, 1), cA + hstepA, voffA);
    if (wr == 1) PG8_BAR;
    PG8_WAIT_V(4); PG8_BAR;
    PG8_STAGE(PG8_SB(1, 0), cB + kstep, voffB); PG8_STAGE(PG8_SA(1, 0), cA + kstep, voffA); PG8_STAGE(PG8_SB(1, 1), cB + hstepB + kstep, voffB);
    PG8_WAIT_V(6); PG8_BAR;
    for (;;) {
        const bool has_next = S.next(ui + 1, nxt);
        const char* nA = has_next ? a_tile(g, nxt.pm, nxt.pn) : cA; const char* nB = has_next ? (const char*)g.Bt + (size_t)nxt.pn * tstepB : cB;
        for (int t = 0; t < nt; t += 2) {
            const bool last = (t == nt - 2);
            const char* a1 = cA + PG8_KOFF(t + 1);
            const char* a2 = last ? nA : cA + PG8_KOFF(t + 2); const char* b2 = last ? nB : cB + (size_t)(t + 2) * kstep;
            const char* a3 = a2 + kstep; const char* b3 = b2 + kstep;
            PG8_LDB(B0, 0, 0); PG8_SCHED; PG8_LDA(At, 0, 0); PG8_STAGE(PG8_SA(1, 1), a1 + hstepA, voffA);
            PG8_WAIT_L(8); PG8_BAR; PG8_WAIT_L(0); PG8_MMA(0, 0, At, B0); PG8_BAR; PG8_SCHED;
            PG8_LDB(B1, 0, 1); PG8_STAGE(PG8_SB(0, 0), b2, voffB);
            PG8_BAR; PG8_WAIT_L(0); PG8_MMA(0, 1, At, B1); PG8_BAR;
            PG8_LDA(At, 0, 1); PG8_STAGE(PG8_SA(0, 0), a2, voffA);
            PG8_BAR; PG8_WAIT_L(0); PG8_MMA(1, 0, At, B0); PG8_BAR; PG8_SCHED;
            PG8_STAGE(PG8_SB(0, 1), b2 + hstepB, voffB);
            PG8_WAIT_V(6); PG8_BAR; PG8_MMA(1, 1, At, B1); PG8_BAR;
            PG8_LDB(B0, 1, 0); PG8_SCHED; PG8_LDA(At, 1, 0); PG8_STAGE(PG8_SA(0, 1), a2 + hstepA, voffA);
            PG8_WAIT_L(8); PG8_BAR; PG8_WAIT_L(0); PG8_MMA(0, 0, At, B0); PG8_BAR; PG8_SCHED;
            PG8_LDB(B1, 1, 1); PG8_STAGE(PG8_SB(1, 0), b3, voffB);
            PG8_BAR; PG8_WAIT_L(0); PG8_MMA(0, 1, At, B1); PG8_BAR;
            PG8_LDA(At, 1, 1); PG8_STAGE(PG8_SA(1, 0), a3, voffA);
            PG8_BAR; PG8_WAIT_L(0); PG8_MMA(1, 0, At, B0); PG8_BAR; PG8_SCHED;
            PG8_STAGE(PG8_SB(1, 1), b3 + hstepB, voffB);
            PG8_WAIT_V(6); PG8_BAR; PG8_MMA(1, 1, At, B1); PG8_BAR;
        }
        E(acc, cur, wr, wc, fr, fq);
        if (!has_next) break;
#pragma unroll
        for (int a = 0; a < 2; ++a)
#pragma unroll
            for (int b = 0; b < 2; ++b)
#pragma unroll
                for (int m = 0; m < 4; ++m)
#pragma unroll
                    for (int n = 0; n < 2; ++n) acc[a][b][m][n] = (f32x4){0.f, 0.f, 0.f, 0.f};
        cur = nxt; cA = nA; cB = nB; ++ui;
    }
    PG8_WAIT_V(0);
    if (wr == 0) PG8_BAR;
    PG8_BAR;
#undef PG8_KOFF
#undef PG8_SA
#undef PG8_SB
#undef PG8_STAGE
#undef PG8_LDA
#undef PG8_LDB
#undef PG8_MMA
#undef PG8_WAIT_V
#undef PG8_WAIT_L
#undef PG8_BAR
#undef PG8_SCHED
}
}

struct TJob { int mode; const float* src; int ld, K, N; h16* dst; int ldd, koff; const float* mix; };

__device__ __forceinline__ TJob get_job(const Params& p, int id) {
    TJob J; J.mode = 0; J.src = nullptr; J.ld = 0; J.K = 0; J.N = 0; J.dst = nullptr; J.ldd = 64; J.koff = 0; J.mix = nullptr;
    h16* W = (h16*)(p.ws + OFF_W);
    if (id < 24) {
        const int j = id / 12, s = id % 12;
        h16* Wrkv = W + (size_t)j * (10 * MiB); h16* Wl1 = Wrkv + 3 * MiB; h16* Wl2 = Wrkv + 7 * MiB;
        const float* mix = p.in[3] + j * 6 * 1024;
        if (s < 3) { J.mode = 0; J.src = p.in[4] + (size_t)(j * 3 + s) * 1048576; J.ld = 1024; J.K = 1024; J.N = 1024; J.dst = Wrkv + (size_t)s * 1024 * 1024; J.ldd = 1024; }
        else if (s < 8) {
            J.mode = 1; J.ld = 1024; J.K = 1024; J.ldd = 2048;
            if (s == 3) { J.src = p.in[6] + (size_t)j * 65536; J.ld = 64; J.N = 64; J.dst = Wl1; J.mix = mix + 3 * 1024; }
            else if (s == 4) { J.src = p.in[9] + (size_t)j * 65536; J.ld = 64; J.N = 64; J.dst = Wl1 + (size_t)64 * 2048; J.mix = mix + 4 * 1024; }
            else if (s == 5) { J.N = 32; J.dst = Wl1 + (size_t)128 * 2048; if (j == 1) { J.src = p.in[12]; J.ld = 32; J.mix = mix + 2 * 1024; } else { J.mode = 2; } }
            else if (s == 6) { J.src = p.in[14] + (size_t)j * 163840; J.ld = 160; J.N = 160; J.dst = Wl1 + (size_t)160 * 2048; J.mix = mix + 5 * 1024; }
            else { J.mode = 2; J.N = 192; J.dst = Wl1 + (size_t)320 * 2048; }
        } else {
            J.mode = 0; J.ld = 1024; J.N = 1024; J.ldd = 384;
            if (s == 8) { J.src = p.in[7] + (size_t)j * 65536; J.K = 64; J.koff = 0; J.dst = Wl2; }
            else if (s == 9) { J.src = p.in[10] + (size_t)j * 65536; J.K = 64; J.koff = 64; J.dst = Wl2 + (size_t)1024 * 384; }
            else if (s == 10) { J.src = p.in[15] + (size_t)j * 163840; J.K = 160; J.koff = 160; J.dst = Wl2 + (size_t)2048 * 384; }
            else { J.src = p.in[13]; J.K = 32; J.koff = 128; J.dst = Wl2 + (size_t)3072 * 384; if (j == 0) J.N = 0; }
        }
    } else if (id < 26) {
        const int j = id - 24;
        J.src = p.in[21] + (size_t)j * 1048576; J.ld = 1024; J.K = 1024; J.N = 1024; J.dst = W + (size_t)j * (10 * MiB) + 9 * MiB; J.ldd = 1024;
    } else if (id < 34) {
        const int i = (id - 26) >> 1, s = (id - 26) & 1;
        h16* base = W + 20 * MiB + (size_t)i * (17 * MiB / 2);
        if (s == 0) { J.src = p.in[33] + (size_t)i * 1024 * 5632; J.ld = 5632; J.K = 1024; J.N = 5632; J.dst = base; J.ldd = 1024; }
        else { J.src = p.in[36] + (size_t)i * 2816 * 1024; J.ld = 1024; J.K = 2816; J.N = 1024; J.dst = base + (size_t)11 * MiB / 2; J.ldd = 2816; }
    } else {
        const int j = (id - 34) >> 2, s = (id - 34) & 3;
        h16* base = W + 54 * MiB + (size_t)j * (5 * MiB / 2);
        if (s == 0) { J.src = p.in[22] + (size_t)j * 1024 * 456; J.ld = 456; J.K = 1024; J.N = 456; J.dst = base; J.ldd = 1024; }
        else if (s == 1) { J.mode = 2; J.N = 56; J.dst = base + (size_t)456 * 1024; J.ldd = 1024; }
        else if (s == 2) { J.src = p.in[28] + (size_t)j * 256 * 512; J.ld = 512; J.K = 256; J.N = 512; J.dst = base + MiB / 2 + (size_t)2048 * 256; J.ldd = 256; }
        else { J.src = p.in[31] + (size_t)j * 1048576; J.ld = 1024; J.K = 1024; J.N = 1024; J.dst = base + 3 * MiB / 2; J.ldd = 1024; }
    }
    return J;
}
__device__ __forceinline__ h16* w_rwkv_big(unsigned char* ws, int j) { return (h16*)(ws + OFF_W) + (size_t)j * (10 * MiB); }
__device__ __forceinline__ h16* w_rwkv_l1(unsigned char* ws, int j) { return w_rwkv_big(ws, j) + 3 * MiB; }
__device__ __forceinline__ h16* w_rwkv_l2(unsigned char* ws, int j) { return w_rwkv_big(ws, j) + 7 * MiB; }
__device__ __forceinline__ h16* w_rwkv_o(unsigned char* ws, int j) { return w_rwkv_big(ws, j) + 9 * MiB; }
__device__ __forceinline__ h16* w_ffn_up(unsigned char* ws, int i) { return (h16*)(ws + OFF_W) + 20 * MiB + (size_t)i * (17 * MiB / 2); }
__device__ __forceinline__ h16* w_ffn_dn(unsigned char* ws, int i) { return w_ffn_up(ws, i) + (size_t)11 * MiB / 2; }
__device__ __forceinline__ h16* w_dsa_in(unsigned char* ws, int j) { return (h16*)(ws + OFF_W) + 54 * MiB + (size_t)j * (5 * MiB / 2); }
__device__ __forceinline__ h16* w_dsa_q(unsigned char* ws, int j) { return w_dsa_in(ws, j) + MiB / 2; }
__device__ __forceinline__ h16* w_dsa_uvt(unsigned char* ws, int j) { return w_dsa_in(ws, j) + 5 * MiB / 4; }
__device__ __forceinline__ h16* w_dsa_o(unsigned char* ws, int j) { return w_dsa_in(ws, j) + 3 * MiB / 2; }

__device__ __forceinline__ void prep_phase(const Params& p, unsigned char* smem) {
    const int tid = opaque_tid();
    const size_t gtid = (size_t)blockIdx.x * 512 + tid, nth = (size_t)gridDim.x * 512;
    h16* x16 = (h16*)(p.ws + OFF_X16);
    for (size_t idx = gtid; idx < (size_t)MTOK * 128; idx += nth) {
        const int row = (int)(idx >> 7), c8 = (int)(idx & 127) * 8;
        const float* sp = p.in[0] + (size_t)row * 1024 + c8;
        const f32x4 a = *(const f32x4*)sp, b = *(const f32x4*)(sp + 4);
        *(u32x4*)(x16 + xrow(row) * 1024 + c8) = pack8(a, b);
    }
    for (size_t idx = gtid; idx < (size_t)NBATCH * 128; idx += nth) {
        const int b = (int)(idx >> 7), c8 = (int)(idx & 127) * 8;
        unsigned z = 0u; asm volatile("" : "+v"(z));
        *(u32x4*)(x16 + (size_t)b * 2049 * 1024 + c8) = (u32x4){z, z, z, z};
    }
    for (size_t it = gtid; it < (size_t)2 * 16 * 2048; it += nth) {
        const int j = (int)(it >> 15), rem = (int)(it & 32767), qg = rem >> 11, n = rem & 2047, h = n >> 7, c = n & 127;
        const float* uq = p.in[25] + (size_t)j * 256 * 1024 + (size_t)(qg * 16) * 1024 + h * 64;
        const float* uk = p.in[26] + (size_t)j * 16 * 64 * 128 + (size_t)h * 64 * 128 + c;
        float acc[16];
#pragma unroll
        for (int i = 0; i < 16; ++i) acc[i] = 0.f;
        for (int d = 0; d < 64; ++d) {
            const float kv = uk[d * 128];
#pragma unroll
            for (int i = 0; i < 16; ++i) acc[i] += uq[i * 1024 + d] * kv;
        }
        const float sc = 0.18033688011112042f;
        h16* dst = w_dsa_q(p.ws, j) + (size_t)n * 256 + qg * 16;
        *(u32x4*)dst = pack8((f32x4){acc[0] * sc, acc[1] * sc, acc[2] * sc, acc[3] * sc}, (f32x4){acc[4] * sc, acc[5] * sc, acc[6] * sc, acc[7] * sc});
        *(u32x4*)(dst + 8) = pack8((f32x4){acc[8] * sc, acc[9] * sc, acc[10] * sc, acc[11] * sc}, (f32x4){acc[12] * sc, acc[13] * sc, acc[14] * sc, acc[15] * sc});
    }
    for (size_t it = gtid; it < (size_t)2 * 128 * 1024; it += nth) {
        const int j = (int)(it >> 17), rem = (int)(it & 131071), kg = rem >> 10, n = rem & 1023, h = kg >> 3, c0 = (kg & 7) * 16;
        const float* uv = p.in[27] + (size_t)((j * 16 + h) * 128 + c0) * 64;
        const float* wo = p.in[31] + (size_t)j * 1048576 + (size_t)(h * 64) * 1024 + n;
        float acc[16];
#pragma unroll
        for (int i = 0; i < 16; ++i) acc[i] = 0.f;
        for (int v = 0; v < 64; ++v) {
            const float wv = wo[(size_t)v * 1024];
#pragma unroll
            for (int i = 0; i < 16; ++i) acc[i] += uv[i * 64 + v] * wv;
        }
        h16* dst = (h16*)(p.ws + OFF_WOV) + (size_t)j * 2097152 + (size_t)n * 2048 + h * 128 + c0;
        *(u32x4*)dst = pack8((f32x4){acc[0], acc[1], acc[2], acc[3]}, (f32x4){acc[4], acc[5], acc[6], acc[7]});
        *(u32x4*)(dst + 8) = pack8((f32x4){acc[8], acc[9], acc[10], acc[11]}, (f32x4){acc[12], acc[13], acc[14], acc[15]});
    }
    float* tile = (float*)smem;
    for (int id = 0; id < 42; ++id) {
        const TJob J = get_job(p, id);
        const int tk = J.ldd >> 6, tn = (J.N + 63) >> 6, ntile = tk * tn;
        for (int tix = blockIdx.x; tix < ntile; tix += gridDim.x) {
            const int k0 = (tix % tk) * 64, n0 = (tix / tk) * 64;
#pragma unroll
            for (int i = 0; i < 8; ++i) {
                const int k = i * 8 + (tid >> 6), n = tid & 63, kk = k0 + k, nn = n0 + n;
                float v = 0.f;
                if (nn < J.N && J.mode != 2) {
                    if (J.mode == 1) { const int ks = kk & 1023; const float mx = J.mix[ks]; v = J.src[(size_t)ks * J.ld + nn] * (kk < 1024 ? 1.0f - mx : mx); }
                    else if (kk >= J.koff && kk < J.koff + J.K) v = J.src[(size_t)(kk - J.koff) * J.ld + nn];
                }
                tile[k * 65 + n] = v;
            }
            __syncthreads();
#pragma unroll
            for (int i = 0; i < 8; ++i) {
                const int n = i * 8 + (tid >> 6), k = tid & 63, nn = n0 + n;
                if (nn < J.N) J.dst[(size_t)nn * J.ldd + k0 + k] = (h16)tile[k * 65 + n];
            }
            __syncthreads();
        }
    }
}

__device__ __forceinline__ void wave_sum4(float (&v)[4]) {
#pragma unroll
    for (int o = 32; o > 0; o >>= 1) {
        float t[4];
#pragma unroll
        for (int k = 0; k < 4; ++k) t[k] = __shfl_xor(v[k], o);
#pragma unroll
        for (int k = 0; k < 4; ++k) v[k] += t[k];
    }
}
__device__ __forceinline__ void ln_phase(const Params& p, const float* g, const float* b, bool final_out) {
    const int tid = opaque_tid();
    const int lane = tid & 63, wave = tid >> 6;
    float* tb = p.out;
    h16* x16 = (h16*)(p.ws + OFF_X16);
    f32x4 gg[4], bb[4];
#pragma unroll
    for (int i = 0; i < 4; ++i) { gg[i] = *(const f32x4*)(g + i * 256 + lane * 4); bb[i] = *(const f32x4*)(b + i * 256 + lane * 4); }
    for (int rowb = (blockIdx.x * 8 + wave) * 4; rowb < MTOK; rowb += gridDim.x * 32) {
        f32x4 v[4][4];
        float s[4];
#pragma unroll
        for (int k = 0; k < 4; ++k) {
            s[k] = 0.f;
            if (final_out) {
                const float* rp = tb + (size_t)(rowb + k) * 1024;
#pragma unroll
                for (int i = 0; i < 4; ++i) v[k][i] = *(const f32x4*)(rp + i * 256 + lane * 4);
            } else {
                const h16* hp = (const h16*)tb + (size_t)(rowb + k) * 1024;
#pragma unroll
                for (int i = 0; i < 4; ++i) { const h16x4 hv = *(const h16x4*)(hp + i * 256 + lane * 4); v[k][i] = (f32x4){(float)hv[0], (float)hv[1], (float)hv[2], (float)hv[3]}; }
            }
#pragma unroll
            for (int i = 0; i < 4; ++i) s[k] += (v[k][i][0] + v[k][i][1]) + (v[k][i][2] + v[k][i][3]);
        }
        wave_sum4(s);
        float q[4];
#pragma unroll
        for (int k = 0; k < 4; ++k) {
            s[k] *= (1.0f / 1024.0f); q[k] = 0.f;
#pragma unroll
            for (int i = 0; i < 4; ++i)
#pragma unroll
                for (int jj = 0; jj < 4; ++jj) { const float d = v[k][i][jj] - s[k]; q[k] += d * d; }
        }
        wave_sum4(q);
#pragma unroll
        for (int k = 0; k < 4; ++k) {
            const float rstd = rsqrtf(q[k] * (1.0f / 1024.0f) + 1e-5f);
            const int row = rowb + k;
#pragma unroll
            for (int i = 0; i < 4; ++i) {
                f32x4 y;
#pragma unroll
                for (int jj = 0; jj < 4; ++jj) y[jj] = (v[k][i][jj] - s[k]) * rstd * gg[i][jj] + bb[i][jj];
                if (final_out) *(f32x4*)(tb + (size_t)row * 1024 + i * 256 + lane * 4) = y;
                else { u32x2 w; w.x = pk2(y[0], y[1]); w.y = pk2(y[2], y[3]); *(u32x2*)(x16 + xrow(row) * 1024 + i * 256 + lane * 4) = w; }
            }
        }
    }
}

__device__ __forceinline__ void conv_phase(const Params& p, int layer) {
    const h16* u = (const h16*)(p.ws + F_U16);
    h16* act = (h16*)(p.ws + F_ACT);
    const float* cw = p.in[34] + (size_t)layer * 3 * 5632;
    const float* cb = p.in[35] + (size_t)layer * 5632;
    const size_t gtid = (size_t)blockIdx.x * 512 + opaque_tid(), nth = (size_t)gridDim.x * 512;
    const size_t ntask = (size_t)2048 * 352;
    for (size_t task = gtid; task < ntask; task += nth) {
        const int cgp = (int)(task % 352), rc = (int)(task / 352), f = cgp * 8, r0 = rc * 16;
        float wg[3][8], wv[3][8], bg[8], bv[8];
#pragma unroll
        for (int jj = 0; jj < 3; ++jj)
#pragma unroll
            for (int hlf = 0; hlf < 2; ++hlf) {
                const f32x4 a = *(const f32x4*)(cw + jj * 5632 + f + hlf * 4), c = *(const f32x4*)(cw + jj * 5632 + DFF + f + hlf * 4);
#pragma unroll
                for (int e = 0; e < 4; ++e) { wg[jj][hlf * 4 + e] = a[e]; wv[jj][hlf * 4 + e] = c[e]; }
            }
#pragma unroll
        for (int hlf = 0; hlf < 2; ++hlf) {
            const f32x4 a = *(const f32x4*)(cb + f + hlf * 4), c = *(const f32x4*)(cb + DFF + f + hlf * 4);
#pragma unroll
            for (int e = 0; e < 4; ++e) { bg[hlf * 4 + e] = a[e]; bv[hlf * 4 + e] = c[e]; }
        }
        float g2[8], g1[8], v2[8], v1[8];
#pragma unroll
        for (int e = 0; e < 8; ++e) { g2[e] = 0.f; g1[e] = 0.f; v2[e] = 0.f; v1[e] = 0.f; }
        if ((r0 & 2047) != 0) {
            unpack8(*(const u32x4*)(u + (size_t)(r0 - 2) * 5632 + f), g2); unpack8(*(const u32x4*)(u + (size_t)(r0 - 1) * 5632 + f), g1);
            unpack8(*(const u32x4*)(u + (size_t)(r0 - 2) * 5632 + DFF + f), v2); unpack8(*(const u32x4*)(u + (size_t)(r0 - 1) * 5632 + DFF + f), v1);
        }
#pragma unroll 1
        for (int i0 = 0; i0 < 16; i0 += 4) {
            u32x4 lg[4], lv[4];
#pragma unroll
            for (int i = 0; i < 4; ++i) { const size_t ro = (size_t)(r0 + i0 + i) * 5632; lg[i] = *(const u32x4*)(u + ro + f); lv[i] = *(const u32x4*)(u + ro + DFF + f); }
#pragma unroll
            for (int i = 0; i < 4; ++i) {
                float g0[8], v0[8], o[8];
                unpack8(lg[i], g0); unpack8(lv[i], v0);
#pragma unroll
                for (int e = 0; e < 8; ++e) {
                    const float G = wg[0][e] * g2[e] + wg[1][e] * g1[e] + wg[2][e] * g0[e] + bg[e];
                    const float V = wv[0][e] * v2[e] + wv[1][e] * v1[e] + wv[2][e] * v0[e] + bv[e];
                    o[e] = G * sigmoidf_(G) * V;
                    g2[e] = g1[e]; g1[e] = g0[e]; v2[e] = v1[e]; v1[e] = v0[e];
                }
                *(u32x4*)(act + (size_t)(r0 + i0 + i) * DFF + f) = pack8((f32x4){o[0], o[1], o[2], o[3]}, (f32x4){o[4], o[5], o[6], o[7]});
            }
        }
    }
}

__device__ __forceinline__ void mix_phase(const Params& p, int j) {
    const h16* x16 = (const h16*)(p.ws + OFF_X16);
    h16* xr = (h16*)p.out; h16* xk = (h16*)p.out + (size_t)MTOK * 1024; h16* xv = (h16*)(p.ws + R_G16);
    const float* mix = p.in[3] + j * 6 * 1024;
    const size_t gtid = (size_t)blockIdx.x * 512 + opaque_tid(), nth = (size_t)gridDim.x * 512;
    for (size_t idx = gtid; idx < (size_t)MTOK * 128; idx += nth) {
        const int row = (int)(idx >> 7), c8 = (int)(idx & 127) * 8;
        const h16* xp = x16 + xrow(row) * 1024 + c8;
        float xc[8], xq[8];
        unpack8(*(const u32x4*)xp, xc); unpack8(*(const u32x4*)(xp - 1024), xq);
#pragma unroll
        for (int e = 0; e < 8; ++e) xq[e] -= xc[e];
        const size_t o = (size_t)row * 1024 + c8;
#pragma unroll
        for (int bsel = 0; bsel < 3; ++bsel) {
            const f32x4 m0 = *(const f32x4*)(mix + bsel * 1024 + c8), m1 = *(const f32x4*)(mix + bsel * 1024 + c8 + 4);
            f32x4 a, b;
#pragma unroll
            for (int e = 0; e < 4; ++e) { a[e] = xc[e] + xq[e] * m0[e]; b[e] = xc[4 + e] + xq[4 + e] * m1[e]; }
            h16* dst = bsel == 0 ? xr : (bsel == 1 ? xk : xv);
            *(u32x4*)(dst + o) = pack8(a, b);
        }
    }
}

__device__ __forceinline__ float dppf(float x, const int ctrl_sel) {
    const int v = __builtin_bit_cast(int, x);
    int r;
    if (ctrl_sel == 0) r = __builtin_amdgcn_update_dpp(0, v, 0xB1, 0xF, 0xF, true);
    else if (ctrl_sel == 1) r = __builtin_amdgcn_update_dpp(0, v, 0x4E, 0xF, 0xF, true);
    else if (ctrl_sel == 2) r = __builtin_amdgcn_update_dpp(0, v, 0x141, 0xF, 0xF, true);
    else r = __builtin_amdgcn_update_dpp(0, v, 0x140, 0xF, 0xF, true);
    return __builtin_bit_cast(float, r);
}
__device__ __forceinline__ float red4(float x) { x += dppf(x, 0); x += dppf(x, 1); return x; }
__device__ __forceinline__ float red16(float x) { x += dppf(x, 0); x += dppf(x, 1); x += dppf(x, 2); x += dppf(x, 3); return x; }
__device__ __forceinline__ void unpack4(u32x2 w, float* f) {
    h16x4 h = __builtin_bit_cast(h16x4, w);
#pragma unroll
    for (int i = 0; i < 4; ++i) f[i] = (float)h[i];
}
constexpr int SCAN_BUF = 8256;
__device__ __forceinline__ void scan_phase(const Params& p, int j, unsigned char* smem) {
    const int tid = opaque_tid();
    const int wave = tid >> 6, lane = tid & 63, slot = wave >> 2, w4 = wave & 3;
    float* LB = (float*)smem + slot * (2 * SCAN_BUF);
    const h16* r16 = (const h16*)(p.ws + R_R16);
    const h16* k16 = (const h16*)(p.ws + R_K16);
    const h16* v16 = (j == 0) ? (const h16*)(p.ws + OFF_VF) : (const h16*)(p.ws + R_V16);
    const h16* g16 = (const h16*)(p.ws + R_G16);
    const h16* e16 = (const h16*)p.out;
    const h16* a16 = (const h16*)p.out + (size_t)MTOK * 1024;
    h16* y16 = (h16*)(p.ws + (j == 0 ? R_V16 : OFF_VF));
    const int tp = w4 * 4 + (lane >> 4), k4 = (lane & 15) * 4;
    const int vrow = w4 * 16 + (lane >> 2), kq = lane & 3;
    for (int pair = blockIdx.x; pair < 256; pair += gridDim.x) {
        const int chain = pair * 2 + slot, b = chain >> 4, h = chain & 15;
        const int col = h * 64 + k4;
        const f32x4 c_kk = *(const f32x4*)(p.in[16] + j * 1024 + col), c_ka = *(const f32x4*)(p.in[17] + j * 1024 + col), c_rk = *(const f32x4*)(p.in[18] + j * 1024 + col);
        const f32x4 c_lg = *(const f32x4*)(p.in[19] + j * 1024 + col), c_lb = *(const f32x4*)(p.in[20] + j * 1024 + col);
        f32x2 S[8];
#pragma unroll
        for (int i = 0; i < 8; ++i) S[i] = (f32x2){0.f, 0.f};
        u32x2 pr[6];
        {
            const size_t go = ((size_t)(b * 2048 + tp)) * 1024 + col;
            pr[0] = *(const u32x2*)(r16 + go); pr[1] = *(const u32x2*)(k16 + go); pr[2] = *(const u32x2*)(v16 + go);
            pr[3] = *(const u32x2*)(e16 + go); pr[4] = *(const u32x2*)(a16 + go); pr[5] = *(const u32x2*)(g16 + go);
        }
        for (int ch = 0; ch < 128; ++ch) {
            float* BUF = LB + (ch & 1) * SCAN_BUF;
            float* OPS = BUF; float* VB = BUF + 5120; float* GB = BUF + 6144; float* YB = BUF + 7168; float* BON = BUF + 8192;
            {
                float rf[4], kf[4], vf[4], ef[4], af[4], gf[4];
                unpack4(pr[0], rf); unpack4(pr[1], kf); unpack4(pr[2], vf); unpack4(pr[3], ef); unpack4(pr[4], af); unpack4(pr[5], gf);
                float kk[4]; float ss = 0.f;
#pragma unroll
                for (int i = 0; i < 4; ++i) { kk[i] = kf[i] * c_kk[i]; ss += kk[i] * kk[i]; }
                ss = red16(ss);
                const float inv = 1.0f / fmaxf(sqrtf(ss), 1e-12f);
                f32x4 A4, B4, W4, K4, R4; float bs = 0.f;
#pragma unroll
                for (int i = 0; i < 4; ++i) {
                    const float kn = kk[i] * inv;
                    A4[i] = -kn; B4[i] = kn * af[i];
                    W4[i] = __expf(-ef[i]);
                    const float km = kf[i] * (1.0f + (af[i] - 1.0f) * c_ka[i]);
                    K4[i] = km; R4[i] = rf[i];
                    bs += rf[i] * km * c_rk[i];
                }
                bs = red16(bs);
                float* o = OPS + tp * 320 + k4;
                *(f32x4*)(o) = A4; *(f32x4*)(o + 64) = B4; *(f32x4*)(o + 128) = W4; *(f32x4*)(o + 192) = K4; *(f32x4*)(o + 256) = R4;
                *(f32x4*)(VB + tp * 64 + k4) = (f32x4){vf[0], vf[1], vf[2], vf[3]};
                *(f32x4*)(GB + tp * 64 + k4) = (f32x4){gf[0], gf[1], gf[2], gf[3]};
                if ((lane & 15) == 0) BON[tp] = bs;
            }
            if (ch + 1 < 128) {
                const size_t go = ((size_t)(b * 2048 + (ch + 1) * 16 + tp)) * 1024 + col;
                pr[0] = *(const u32x2*)(r16 + go); pr[1] = *(const u32x2*)(k16 + go); pr[2] = *(const u32x2*)(v16 + go);
                pr[3] = *(const u32x2*)(e16 + go); pr[4] = *(const u32x2*)(a16 + go); pr[5] = *(const u32x2*)(g16 + go);
            }
            __syncthreads();
#pragma unroll 2
            for (int t = 0; t < 16; ++t) {
                const float* op = OPS + t * 320 + kq * 16;
                f32x4 A4[4], B4[4], W4[4], K4[4], R4[4];
#pragma unroll
                for (int i = 0; i < 4; ++i) A4[i] = *(const f32x4*)(op + i * 4);
#pragma unroll
                for (int i = 0; i < 4; ++i) { W4[i] = *(const f32x4*)(op + 128 + i * 4); B4[i] = *(const f32x4*)(op + 64 + i * 4); K4[i] = *(const f32x4*)(op + 192 + i * 4); }
#pragma unroll
                for (int i = 0; i < 4; ++i) R4[i] = *(const f32x4*)(op + 256 + i * 4);
                const float vv = VB[t * 64 + vrow];
                f32x2 s0 = {0.f, 0.f}, s1 = {0.f, 0.f};
#pragma unroll
                for (int i = 0; i < 4; ++i) { s0 += S[2 * i] * (f32x2){A4[i][0], A4[i][1]}; s1 += S[2 * i + 1] * (f32x2){A4[i][2], A4[i][3]}; }
                const float sa = red4((s0[0] + s0[1]) + (s1[0] + s1[1]));
                const f32x2 sa2 = {sa, sa}, vv2 = {vv, vv};
#pragma unroll
                for (int i = 0; i < 4; ++i) {
                    S[2 * i] = S[2 * i] * (f32x2){W4[i][0], W4[i][1]} + sa2 * (f32x2){B4[i][0], B4[i][1]} + vv2 * (f32x2){K4[i][0], K4[i][1]};
                    S[2 * i + 1] = S[2 * i + 1] * (f32x2){W4[i][2], W4[i][3]} + sa2 * (f32x2){B4[i][2], B4[i][3]} + vv2 * (f32x2){K4[i][2], K4[i][3]};
                }
                f32x2 y0 = {0.f, 0.f}, y1 = {0.f, 0.f};
#pragma unroll
                for (int i = 0; i < 4; ++i) { y0 += S[2 * i] * (f32x2){R4[i][0], R4[i][1]}; y1 += S[2 * i + 1] * (f32x2){R4[i][2], R4[i][3]}; }
                const float y = red4((y0[0] + y0[1]) + (y1[0] + y1[1]));
                if (kq == 0) YB[t * 64 + vrow] = y;
            }
            __syncthreads();
            {
                const f32x4 y4 = *(const f32x4*)(YB + tp * 64 + k4), v4 = *(const f32x4*)(VB + tp * 64 + k4), g4 = *(const f32x4*)(GB + tp * 64 + k4);
                const float mu = red16((y4[0] + y4[1]) + (y4[2] + y4[3])) * (1.0f / 64.0f);
                float q = 0.f;
#pragma unroll
                for (int i = 0; i < 4; ++i) { const float d = y4[i] - mu; q += d * d; }
                const float rstd = rsqrtf(red16(q) * (1.0f / 64.0f) + 64e-5f);
                const float bon = BON[tp];
                float o[4];
#pragma unroll
                for (int i = 0; i < 4; ++i) o[i] = ((y4[i] - mu) * rstd * c_lg[i] + c_lb[i] + bon * v4[i]) * g4[i];
                u32x2 w; w.x = pk2(o[0], o[1]); w.y = pk2(o[2], o[3]);
                *(u32x2*)(y16 + ((size_t)(b * 2048 + ch * 16 + tp)) * 1024 + col) = w;
            }
        }
        __syncthreads();
    }
}

__device__ __forceinline__ void dsa_norm_phase(const Params& p, int j, unsigned char* smem) {
    const int tid = opaque_tid();
    const int lane = tid & 63, wave = tid >> 6;
    const float* hin = (const float*)(p.ws + D_HIN);
    h16* cq = (h16*)(p.ws + D_CQ); h16* ckv = (h16*)(p.ws + D_CKV); h16* ckvt = (h16*)(p.ws + D_CKVT); h16* kidx = (h16*)(p.ws + D_KIDX);
    float* widx = (float*)(p.ws + D_WIDX);
    const f32x4 gq = *(const f32x4*)(p.in[23] + j * 256 + lane * 4);
    const f32x2 gkv = *(const f32x2*)(p.in[24] + j * 128 + lane * 2);
    const float gi = p.in[29][j * 64 + lane], bi = p.in[30][j * 64 + lane];
    h16* wl = (h16*)(smem + wave * 2048);
    for (int grp = blockIdx.x * 8 + wave; grp < MTOK / 8; grp += gridDim.x * 8) {
        const int r0 = grp * 8;
        for (int i = 0; i < 8; ++i) {
            const int row = r0 + i;
            const float* hp = hin + (size_t)row * 512;
            const f32x4 vq = *(const f32x4*)(hp + lane * 4);
            const f32x2 vk = *(const f32x2*)(hp + 256 + lane * 2);
            const float vi = hp[384 + lane];
            float ssq = wave_sum(vq[0] * vq[0] + vq[1] * vq[1] + vq[2] * vq[2] + vq[3] * vq[3]);
            const float rq = rsqrtf(ssq * (1.0f / 256.0f) + 1e-6f);
            u32x2 w; w.x = pk2(vq[0] * rq * gq[0], vq[1] * rq * gq[1]); w.y = pk2(vq[2] * rq * gq[2], vq[3] * rq * gq[3]);
            *(u32x2*)(cq + (size_t)row * 256 + lane * 4) = w;
            float ssk = wave_sum(vk[0] * vk[0] + vk[1] * vk[1]);
            const float rk = rsqrtf(ssk * (1.0f / 128.0f) + 1e-6f);
            const unsigned wk = pk2(vk[0] * rk * gkv[0], vk[1] * rk * gkv[1]);
            *(unsigned*)(ckv + (size_t)row * 128 + lane * 2) = wk;
            *(unsigned*)(wl + i * 128 + lane * 2) = wk;
            const float mu = wave_sum(vi) * (1.0f / 64.0f);
            const float dv = vi - mu;
            const float var = wave_sum(dv * dv) * (1.0f / 64.0f);
            kidx[(size_t)row * 64 + lane] = (h16)(dv * rsqrtf(var + 1e-5f) * gi + bi);
            if (lane < 8) widx[(size_t)row * 8 + lane] = hp[448 + lane] * 0.044194173824159216f;
        }
        asm volatile("s_waitcnt lgkmcnt(0)" ::: "memory");
        const int b = r0 >> 11, t0 = r0 & 2047;
#pragma unroll
        for (int dd = 0; dd < 2; ++dd) {
            const int d = lane * 2 + dd;
            h16x8 hv;
#pragma unroll
            for (int i = 0; i < 8; ++i) hv[i] = wl[i * 128 + d];
            *(h16x8*)(ckvt + ((size_t)(b * 128 + d)) * 2048 + t0) = hv;
        }
        asm volatile("s_waitcnt lgkmcnt(0)" ::: "memory");
    }
}

constexpr int ROWP = 2052;
__device__ __forceinline__ unsigned fkey(float x) {
    if (x == 0.0f) x = 0.0f;
    const unsigned u = __float_as_uint(x);
    return (u & 0x80000000u) ? ~u : (u | 0x80000000u);
}
__device__ __forceinline__ void dsa_index_phase(const Params& p, unsigned char* smem) {
    const int tid = opaque_tid(), wave = tid >> 6, lane = tid & 63, r = lane & 15, q = lane >> 4;
    float* SC = (float*)smem;
    const h16* qidx = (const h16*)(p.ws + D_QIDX);
    const h16* kidx = (const h16*)(p.ws + D_KIDX);
    const float* widx = (const float*)(p.ws + D_WIDX);
    unsigned short* selout = (unsigned short*)(p.ws + D_MASK);
    for (int qi = blockIdx.x, it = 0; qi < MTOK / 16; qi += gridDim.x, ++it) {
        const int qt = (it & 1) ? ((qi & ~127) | (127 - (qi & 127))) : qi;
        const int row0 = qt * 16, b = row0 >> 11, t0 = row0 & 2047;
        const int nkt = (t0 >> 4) + 1;
        {
            h16x8 qf[8][2]; float wq[8];
#pragma unroll
            for (int h = 0; h < 8; ++h) {
#pragma unroll
                for (int kk = 0; kk < 2; ++kk) qf[h][kk] = *(const h16x8*)(qidx + (size_t)(row0 + r) * 512 + h * 64 + kk * 32 + q * 8);
                wq[h] = widx[(size_t)(row0 + r) * 8 + h];
            }
            for (int kt = wave; kt < nkt; kt += 16) {
                const bool two = (kt + 8 < nkt);
                const int s0 = kt * 16, s1 = two ? s0 + 128 : s0;
                const h16* kp = kidx + (size_t)(b * 2048 + s0 + r) * 64 + q * 8;
                const h16* kp1 = kidx + (size_t)(b * 2048 + s1 + r) * 64 + q * 8;
                const h16x8 k0 = *(const h16x8*)kp, k1 = *(const h16x8*)(kp + 32), k2 = *(const h16x8*)kp1, k3 = *(const h16x8*)(kp1 + 32);
                f32x4 sc = {0.f, 0.f, 0.f, 0.f}, sd = {0.f, 0.f, 0.f, 0.f};
#pragma unroll
                for (int h = 0; h < 8; ++h) {
                    f32x4 acc = {0.f, 0.f, 0.f, 0.f}, acd = {0.f, 0.f, 0.f, 0.f};
                    acc = __builtin_amdgcn_mfma_f32_16x16x32_f16(k0, qf[h][0], acc, 0, 0, 0);
                    acd = __builtin_amdgcn_mfma_f32_16x16x32_f16(k2, qf[h][0], acd, 0, 0, 0);
                    acc = __builtin_amdgcn_mfma_f32_16x16x32_f16(k1, qf[h][1], acc, 0, 0, 0);
                    acd = __builtin_amdgcn_mfma_f32_16x16x32_f16(k3, qf[h][1], acd, 0, 0, 0);
#pragma unroll
                    for (int jj = 0; jj < 4; ++jj) { sc[jj] += fmaxf(acc[jj], 0.f) * wq[h]; sd[jj] += fmaxf(acd[jj], 0.f) * wq[h]; }
                }
                *(f32x4*)(SC + r * ROWP + s0 + q * 4) = sc;
                if (two) *(f32x4*)(SC + r * ROWP + s1 + q * 4) = sd;
            }
        }
        __syncthreads();
        for (int qq = 0; qq < 2; ++qq) {
            const int ql = wave * 2 + qq, t = t0 + ql;
            const float* srow = SC + ql * ROWP;
            const int ni = (t >> 6) + 1;
            unsigned u[32];
#pragma unroll
            for (int i = 0; i < 32; ++i) {
                u[i] = 0u;
                if (i < ni) { const int s = i * 64 + lane; if (s <= t) u[i] = fkey(srow[s]); }
            }
            unsigned short* selrow = selout + (size_t)(row0 + ql) * 256;
            if (t < 256) {
#pragma unroll
                for (int i = 0; i < 4; ++i) { const int pp = i * 64 + lane; selrow[pp] = (unsigned short)(pp <= t ? pp : 0xFFFF); }
            } else {
                unsigned T = 0u;
                for (int bit = 31; bit >= 0; --bit) {
                    const unsigned cand = T | (1u << bit);
                    int c0 = 0, c1 = 0;
                    if (ni <= 16) {
#pragma unroll
                        for (int i = 0; i < 16; i += 2) { c0 += (u[i] >= cand) ? 1 : 0; c1 += (u[i + 1] >= cand) ? 1 : 0; }
                    } else {
#pragma unroll
                        for (int i = 0; i < 32; i += 2) { c0 += (u[i] >= cand) ? 1 : 0; c1 += (u[i + 1] >= cand) ? 1 : 0; }
                    }
                    int c = c0 + c1;
                    c += __builtin_amdgcn_update_dpp(0, c, 0xB1, 0xF, 0xF, true);
                    c += __builtin_amdgcn_update_dpp(0, c, 0x4E, 0xF, 0xF, true);
                    c += __builtin_amdgcn_update_dpp(0, c, 0x141, 0xF, 0xF, true);
                    c += __builtin_amdgcn_update_dpp(0, c, 0x140, 0xF, 0xF, true);
                    const int cnt = __builtin_amdgcn_readlane(c, 0) + __builtin_amdgcn_readlane(c, 16) + __builtin_amdgcn_readlane(c, 32) + __builtin_amdgcn_readlane(c, 48);
                    if (cnt >= 256) T = cand;
                }
                int cgt = 0;
#pragma unroll
                for (int i = 0; i < 32; ++i) if (i < ni) cgt += __popcll(__ballot(u[i] > T));
                const int need = 256 - cgt;
                int running = 0, outpos = 0;
                const unsigned long long lt = (lane == 0) ? 0ull : (~0ull >> (64 - lane));
#pragma unroll
                for (int i = 0; i < 32; ++i) {
                    if (i < ni) {
                        const unsigned long long eq = __ballot(u[i] == T);
                        const int rank = running + __popcll(eq & lt);
                        const bool sel = u[i] > T || (u[i] == T && rank < need);
                        const unsigned long long sm = __ballot(sel);
                        running += __popcll(eq);
                        if (sel) selrow[outpos + __popcll(sm & lt)] = (unsigned short)(i * 64 + lane);
                        outpos += __popcll(sm);
                    }
                }
            }
        }
        __syncthreads();
    }
}

__device__ __forceinline__ float xmax_16_32(float x) {
    const unsigned u = __builtin_bit_cast(unsigned, x);
    auto r = __builtin_amdgcn_permlane16_swap(u, u, false, false);
    float m = fmaxf(__builtin_bit_cast(float, (unsigned)r[0]), __builtin_bit_cast(float, (unsigned)r[1]));
    const unsigned u2 = __builtin_bit_cast(unsigned, m);
    auto r2 = __builtin_amdgcn_permlane32_swap(u2, u2, false, false);
    return fmaxf(__builtin_bit_cast(float, (unsigned)r2[0]), __builtin_bit_cast(float, (unsigned)r2[1]));
}
__device__ __forceinline__ float xsum_16_32(float x) {
    const unsigned u = __builtin_bit_cast(unsigned, x);
    auto r = __builtin_amdgcn_permlane16_swap(u, u, false, false);
    float m = __builtin_bit_cast(float, (unsigned)r[0]) + __builtin_bit_cast(float, (unsigned)r[1]);
    const unsigned u2 = __builtin_bit_cast(unsigned, m);
    auto r2 = __builtin_amdgcn_permlane32_swap(u2, u2, false, false);
    return __builtin_bit_cast(float, (unsigned)r2[0]) + __builtin_bit_cast(float, (unsigned)r2[1]);
}
typedef __fp16 fp16x4_t __attribute__((__vector_size__(4 * sizeof(__fp16))));
__device__ __forceinline__ unsigned off_b(unsigned row, unsigned ch) { return 256u * row + 16u * (ch ^ (((row & 3) << 2) | ((row >> 2) & 3))); }
constexpr int SA_TILE = 8192, SA_BL = 8 * 2 * SA_TILE;
static_assert(SA_BL + 16 * 132 * 4 <= LDS_BYTES, "sparse attention LDS");
__device__ __forceinline__ void dsa_attn_phase(const Params& p, int j, unsigned char* smem) {
    const int tid = opaque_tid(), wave = tid >> 6, lane = tid & 63, r = lane & 15, q = lane >> 4;
    float* BL = (float*)(smem + SA_BL);
    for (int idx = tid; idx < 16 * 129; idx += 512) {
        const int h = idx / 129, d = idx % 129;
        int bk = d;
        if (d >= 16) { bk = 16 + (int)(logf((float)d * (1.0f / 16.0f)) / 2.0794415416798357f * 16.0f); bk = bk > 31 ? 31 : bk; }
        BL[h * 132 + d] = p.in[32][bk * 16 + h] * 1.4426950408889634f;
    }
    __syncthreads();
    const h16* qabs = (const h16*)(p.ws + D_QABS);
    const h16* ckv = (const h16*)(p.ws + D_CKV);
    const unsigned short* sel = (const unsigned short*)(p.ws + D_MASK);
    h16* olatA = (h16*)(p.ws + D_HIN);
    h16* olatB = (h16*)p.out + (size_t)MTOK * 1024;
    unsigned char* tile0 = smem + wave * (2 * SA_TILE);
    const float NINF = -__builtin_inff();
    unsigned wofs[8], kofs[2][4], vofs[8][2];
#pragma unroll
    for (int i = 0; i < 8; ++i) wofs[i] = off_b(8 * q + i, r);
#pragma unroll
    for (int tt = 0; tt < 2; ++tt)
#pragma unroll
        for (int kk = 0; kk < 4; ++kk) kofs[tt][kk] = off_b(8 * (r >> 2) + 4 * tt + (r & 3), 4 * kk + q);
#pragma unroll
    for (int c = 0; c < 8; ++c)
#pragma unroll
        for (int t2 = 0; t2 < 2; ++t2) vofs[c][t2] = off_b(8 * q + 4 * t2 + (r >> 2), 2 * c + ((lane & 3) >> 1)) + 8 * (lane & 1);
    for (int row = blockIdx.x * 8 + wave; row < MTOK; row += gridDim.x * 8) {
        const int b = row >> 11, t = row & 2047;
        const int nvalid = t + 1 < 256 ? t + 1 : 256, ng = (nvalid + 31) >> 5;
        const h16* kg = ckv + (size_t)(b * 2048) * 128;
        const unsigned short* srow = sel + (size_t)row * 256;
        h16x8 qf[4];
#pragma unroll
        for (int kk = 0; kk < 4; ++kk) qf[kk] = *(const h16x8*)(qabs + (size_t)row * 2048 + r * 128 + kk * 32 + q * 8);
        f32x4 O[8];
#pragma unroll
        for (int dt = 0; dt < 8; ++dt) O[dt] = (f32x4){0.f, 0.f, 0.f, 0.f};
        float mrun = NINF, lrun = 0.f;
        u32x4 selv = *(const u32x4*)(srow + 8 * q);
        u32x4 gr[8];
#pragma unroll
        for (int i = 0; i < 8; ++i) {
            unsigned sidx = (selv[i >> 1] >> ((i & 1) * 16)) & 0xFFFFu; sidx = sidx == 0xFFFFu ? 0u : sidx;
            gr[i] = *(const u32x4*)(kg + (size_t)sidx * 128 + r * 8);
        }
        for (int g = 0; g < ng; ++g) {
            unsigned char* tile = tile0 + (g & 1) * SA_TILE;
            const u32x4 selc = selv;
#pragma unroll
            for (int i = 0; i < 8; ++i) *(u32x4*)(tile + wofs[i]) = gr[i];
            if (g + 1 < ng) {
                selv = *(const u32x4*)(srow + (g + 1) * 32 + 8 * q);
#pragma unroll
                for (int i = 0; i < 8; ++i) {
                    unsigned sidx = (selv[i >> 1] >> ((i & 1) * 16)) & 0xFFFFu; sidx = sidx == 0xFFFFu ? 0u : sidx;
                    gr[i] = *(const u32x4*)(kg + (size_t)sidx * 128 + r * 8);
                }
            }
            asm volatile("s_waitcnt lgkmcnt(0)" ::: "memory");
            f32x4 sc[2];
#pragma unroll
            for (int tt = 0; tt < 2; ++tt) {
                f32x4 acc = {0.f, 0.f, 0.f, 0.f};
#pragma unroll
                for (int kk = 0; kk < 4; ++kk) {
                    const h16x8 kf = *(const h16x8*)(tile + kofs[tt][kk]);
                    acc = __builtin_amdgcn_mfma_f32_16x16x32_f16(kf, qf[kk], acc, 0, 0, 0);
                }
                sc[tt] = acc;
            }
            float x[8]; float mx = NINF;
#pragma unroll
            for (int i = 0; i < 8; ++i) {
                const unsigned sidx = (selc[i >> 1] >> ((i & 1) * 16)) & 0xFFFFu;
                int dist = t - (int)sidx; dist = dist < 0 ? 0 : (dist > 128 ? 128 : dist);
                const float v = sc[i >> 2][i & 3] + BL[r * 132 + dist];
                const float xv = (sidx != 0xFFFFu) ? v : NINF;
                x[i] = xv; mx = fmaxf(mx, xv);
            }
            mx = xmax_16_32(mx);
            const float mnew = fmaxf(mrun, mx);
            const float mref = (mnew == NINF) ? 0.f : mnew;
            const float alpha = __builtin_amdgcn_exp2f(mrun - mref);
            mrun = mnew;
            float ps = 0.f; h16x8 pf;
#pragma unroll
            for (int i = 0; i < 8; ++i) { const float pv = __builtin_amdgcn_exp2f(x[i] - mref); ps += pv; pf[i] = (h16)pv; }
            lrun = lrun * alpha + ps;
#pragma unroll
            for (int dt = 0; dt < 8; ++dt) {
                const fp16x4_t lo = __builtin_amdgcn_ds_read_tr16_b64_v4f16((LAS fp16x4_t*)(tile + vofs[dt][0]));
                const fp16x4_t hi = __builtin_amdgcn_ds_read_tr16_b64_v4f16((LAS fp16x4_t*)(tile + vofs[dt][1]));
                const h16x4 l4 = __builtin_bit_cast(h16x4, lo), h4 = __builtin_bit_cast(h16x4, hi);
                const h16x8 vf = {l4[0], l4[1], l4[2], l4[3], h4[0], h4[1], h4[2], h4[3]};
                O[dt] *= alpha;
                O[dt] = __builtin_amdgcn_mfma_f32_16x16x32_f16(vf, pf, O[dt], 0, 0, 0);
            }
        }
        const float inv = 1.0f / xsum_16_32(lrun);
        h16* op = (row < MTOK / 2 ? olatA + (size_t)row * 2048 : olatB + (size_t)(row - MTOK / 2) * 2048) + r * 128 + q * 4;
#pragma unroll
        for (int dt = 0; dt < 8; ++dt) {
            u32x2 w; w.x = pk2(O[dt][0] * inv, O[dt][1] * inv); w.y = pk2(O[dt][2] * inv, O[dt][3] * inv);
            *(u32x2*)(op + dt * 16) = w;
        }
        asm volatile("s_waitcnt lgkmcnt(0)" ::: "memory");
    }
    __syncthreads();
}

constexpr size_t OFF_BAR = 951 * MiB;
__device__ __forceinline__ void grid_bar(unsigned* ctr, unsigned& target, unsigned nblk) {
    asm volatile("s_waitcnt vmcnt(0) lgkmcnt(0)" ::: "memory");
    __syncthreads();
    target += nblk;
    if (threadIdx.x == 0) {
        __builtin_amdgcn_fence(__ATOMIC_RELEASE, "agent");
        asm volatile("s_waitcnt vmcnt(0)" ::: "memory");
        __hip_atomic_fetch_add(ctr, 1u, __ATOMIC_RELAXED, __HIP_MEMORY_SCOPE_AGENT);
        while (__hip_atomic_load(ctr, __ATOMIC_RELAXED, __HIP_MEMORY_SCOPE_AGENT) < target) __builtin_amdgcn_s_sleep(1);
        __builtin_amdgcn_fence(__ATOMIC_ACQUIRE, "agent");
        asm volatile("s_waitcnt vmcnt(0)" ::: "memory");
    }
    __syncthreads();
}

__global__ void __launch_bounds__(512) mega_fwd(Params p) {
    extern __shared__ __attribute__((aligned(16))) unsigned char smem[];
    cg::grid_group grid = cg::this_grid();
    unsigned char* ws = p.ws;
    h16* x16 = (h16*)(ws + OFF_X16);
    unsigned* barctr = (unsigned*)(ws + OFF_BAR);
    unsigned bar_target = 0u;
    for (int ph = p.ph_lo; ph < p.ph_hi; ++ph) {
        const unsigned e = p.prog[ph];
        const int kind = e & 15, L = (e >> 4) & 3, sub = (e >> 6) & 1, j = L >> 1;
        const int nrep = 1 + (int)(e >> 7);
        for (int rep = 0; rep < nrep; ++rep) {
        if (rep) grid_bar(barctr, bar_target, gridDim.x);
        const bool isgemm = (kind == K_R1 || kind == K_R2 || kind == K_R4 || kind == K_F1 || kind == K_F3 || kind == K_D1 || kind == K_D3 || kind == K_D6);
        if (isgemm) {
            const int ngemm = (kind == K_R1) ? 2 : 1;
            for (int gi = 0; gi < ngemm; ++gi) {
            pg8::Gemm g; pg8::Epi E;
            g.M = MTOK; g.N = 1024; g.K = 1024; g.lda = 1024; g.amode = 0; g.pm0 = 0; g.A = x16; g.A2 = x16; g.Bt = x16;
            E.mode = E_RESID; E.pm0 = 0; E.j = j; E.pnoff = 0; E.fin = (L == 3 && kind == K_F3) ? 1 : 0; E.ws = ws; E.out = p.out; E.bias0 = p.in[5] + j * 1024; E.bias1 = p.in[8] + j * 1024; E.bias2 = p.in[11];
            if (kind == K_R1) {
                E.mode = E_RPROJ;
                if (gi == 0) { g.A = (const h16*)p.out; g.A2 = (const h16*)(ws + R_G16); g.Bt = w_rwkv_big(ws, j); g.N = 3072; g.amode = 2; }
                else { g.Bt = w_rwkv_l1(ws, j); g.N = 512; g.K = 2048; g.amode = 1; E.pnoff = 12; }
            } else if (kind == K_R2) {
                g.A = (const h16*)(ws + R_HACT); g.Bt = w_rwkv_l2(ws, j); g.N = (j == 0) ? 3072 : 4096; g.K = 384; g.lda = 384; E.mode = E_LORA2;
            } else if (kind == K_R4) {
                g.A = (const h16*)(ws + (j == 0 ? R_V16 : OFF_VF)); g.Bt = w_rwkv_o(ws, j);
            } else if (kind == K_F1) {
                g.Bt = w_ffn_up(ws, L); g.M = MTOK / 2; g.N = 5632; g.amode = 1; g.pm0 = sub * 128; E.mode = E_ST16;
            } else if (kind == K_F3) {
                g.A = (const h16*)(ws + F_ACT); g.Bt = w_ffn_dn(ws, L); g.M = MTOK / 2; g.K = 2816; g.lda = 2816; E.pm0 = sub * 128;
            } else if (kind == K_D1) {
                g.Bt = w_dsa_in(ws, j); g.N = 512; g.amode = 1; E.mode = E_ST32;
            } else if (kind == K_D3) {
                g.A = (const h16*)(ws + D_CQ); g.Bt = w_dsa_q(ws, j); g.N = 2560; g.K = 256; g.lda = 256; E.mode = E_QPROJ;
            } else {
                g.A = (const h16*)(ws + D_HIN); g.A2 = (const h16*)p.out + (size_t)MTOK * 1024; g.Bt = (const h16*)(ws + OFF_WOV) + (size_t)j * 2097152; g.K = 2048; g.lda = 2048; g.amode = 3;
            }
            pg8::StaticOrder S; S.init(g.M, g.N, (int)gridDim.x, (int)blockIdx.x);
#ifndef NO_GEMM
            pg8::gemm_phase((LAS unsigned char*)smem, g, S, E);
#endif
            }
        } else if (kind == K_PREP) {
#ifndef NO_PREP
            prep_phase(p, smem);
#endif
        } else if (kind == K_R0) {
            mix_phase(p, j);
        } else if (kind == K_R3) {
#ifndef NO_SCAN
            scan_phase(p, j, smem);
#endif
        } else if (kind == K_LN) {
#ifndef NO_LN
            ln_phase(p, p.in[1] + (L * 2 + sub) * 1024, p.in[2] + (L * 2 + sub) * 1024, L == 3 && sub == 1);
#endif
        } else if (kind == K_F2) {
#ifndef NO_CONV
            conv_phase(p, L);
#endif
        } else if (kind == K_D2) {
#ifndef NO_NORM
            dsa_norm_phase(p, j, smem);
#endif
        } else if (kind == K_D4) {
#ifndef NO_INDEX
            dsa_index_phase(p, smem);
#endif
        } else if (kind == K_D5) {
#ifndef NO_ATTN
            dsa_attn_phase(p, j, smem);
#endif
        }
        }
        if (ph + 1 < p.ph_hi) { if (ph == p.ph_lo) grid.sync(); else grid_bar(barctr, bar_target, gridDim.x); for (int xs = 0; xs < EXTRA_SYNC; ++xs) grid_bar(barctr, bar_target, gridDim.x); }
    }
}

extern "C" void kernel_launch(void* const* d_in, const int* in_sizes, int n_in, void* d_out, int out_size, void* d_ws, size_t ws_size, hipStream_t stream) {
    static int grid_blocks = 0;
    if (grid_blocks == 0) {
        if (n_in != 37 || ws_size < WS_NEED || out_size != MTOK * DM) { fprintf(stderr, "kernel_launch: unexpected problem (n_in %d ws %zu out %d)\n", n_in, ws_size, out_size); grid_blocks = -1; return; }
        int dev = 0, cus = 0, per_cu = 0;
        hipGetDevice(&dev);
        hipDeviceGetAttribute(&cus, hipDeviceAttributeMultiprocessorCount, dev);
        if (hipFuncSetAttribute((const void*)mega_fwd, hipFuncAttributeMaxDynamicSharedMemorySize, LDS_BYTES) != hipSuccess) { fprintf(stderr, "kernel_launch: hipFuncSetAttribute failed\n"); grid_blocks = -1; return; }
        hipOccupancyMaxActiveBlocksPerMultiprocessor(&per_cu, (const void*)mega_fwd, 512, LDS_BYTES);
        if (per_cu < 1) { fprintf(stderr, "kernel_launch: occupancy query says %d blocks/CU\n", per_cu); per_cu = 1; }
        (void)hipGetLastError();
        grid_blocks = cus * per_cu;
        fprintf(stderr, "kernel_launch: grid %d (cus %d x %d)\n", grid_blocks, cus, per_cu);
    }
    if (grid_blocks < 0) return;
    Params p{};
    for (int i = 0; i < 37; ++i) p.in[i] = (const float*)d_in[i];
    p.ws = (unsigned char*)d_ws; p.out = (float*)d_out;
    int np = 0;
    constexpr unsigned PROBE_MASK = 0u;
    auto add = [&](int kind, int L, int sub) { p.prog[np++] = (unsigned char)(kind | (L << 4) | (sub << 6) | ((((PROBE_MASK >> kind) & 1u) && !(kind == K_LN && L == 3 && sub == 1)) ? 128 : 0)); };
    add(K_PREP, 0, 0);
    for (int L = 0; L < 4; ++L) {
        if ((L & 1) == 0) { add(K_R0, L, 0); add(K_R1, L, 0); add(K_R2, L, 0); add(K_R3, L, 0); add(K_R4, L, 0); }
        else { add(K_D1, L, 0); add(K_D2, L, 0); add(K_D3, L, 0); add(K_D4, L, 0); add(K_D5, L, 0); add(K_D6, L, 0); }
        add(K_LN, L, 0);
        for (int c = 0; c < 2; ++c) { add(K_F1, L, c); add(K_F2, L, c); add(K_F3, L, c); }
        add(K_LN, L, 1);
    }
#if SINGLE_LAUNCH
    if (hipMemsetAsync((unsigned char*)d_ws + OFF_BAR, 0, 256, stream) != hipSuccess) { fprintf(stderr, "kernel_launch: memset failed\n"); return; }
    p.ph_lo = 0; p.ph_hi = np;
    void* args[] = {&p};
    hipError_t e = hipLaunchCooperativeKernel((const void*)mega_fwd, dim3(grid_blocks), dim3(512), args, LDS_BYTES, stream);
    if (e != hipSuccess) fprintf(stderr, "cooperative launch failed: %s (grid %d)\n", hipGetErrorString(e), grid_blocks);
#else
    for (int ph = 0; ph < np; ++ph) {
        p.ph_lo = ph; p.ph_hi = ph + 1;
        hipLaunchKernelGGL(mega_fwd, dim3(grid_blocks), dim3(512), LDS_BYTES, stream, p);
    }
#endif
}
```

```cpp
#include <hip/hip_runtime.h>
#include <hip/hip_cooperative_groups.h>
#include <cstdio>
namespace cg = cooperative_groups;

constexpr int EXTRA_SYNC = 0;
#ifndef SINGLE_LAUNCH
#define SINGLE_LAUNCH 1
#endif

#define LAS __attribute__((address_space(3)))
typedef _Float16 h16;
typedef _Float16 h16x8 __attribute__((ext_vector_type(8)));
typedef _Float16 h16x4 __attribute__((ext_vector_type(4)));
typedef _Float16 h16x2 __attribute__((ext_vector_type(2)));
typedef float f32x4 __attribute__((ext_vector_type(4)));
typedef float f32x2 __attribute__((ext_vector_type(2)));
typedef unsigned u32x4 __attribute__((ext_vector_type(4)));
typedef unsigned u32x2 __attribute__((ext_vector_type(2)));

constexpr int DM = 1024, SEQ = 2048, NBATCH = 32, MTOK = NBATCH * SEQ;
constexpr int DFF = 2816;
constexpr size_t MiB = (size_t)1 << 20;
constexpr float DN_ALPHA = 1.6817928305074290f;
constexpr int LDS_BYTES = 147456;

constexpr size_t OFF_W = 0;
constexpr size_t OFF_X16 = 118 * MiB;
constexpr size_t OFF_VF = 247 * MiB;
constexpr size_t OFF_R = 375 * MiB;
constexpr size_t WS_NEED = 960 * MiB;
constexpr size_t OFF_WOV = 952 * MiB;
constexpr size_t R_R16 = OFF_R, R_K16 = OFF_R + 128 * MiB, R_V16 = OFF_R + 256 * MiB, R_G16 = OFF_R + 384 * MiB, R_HACT = OFF_R + 512 * MiB;
constexpr size_t F_U16 = OFF_R, F_ACT = OFF_R + 352 * MiB;
constexpr size_t D_HIN = OFF_R, D_O16 = OFF_R, D_QABS = OFF_R + 128 * MiB, D_QIDX = OFF_R + 384 * MiB, D_CQ = OFF_R + 448 * MiB,
                 D_CKV = OFF_R + 480 * MiB, D_CKVT = OFF_R + 496 * MiB, D_KIDX = OFF_R + 512 * MiB, D_WIDX = OFF_R + 520 * MiB, D_MASK = OFF_R + 522 * MiB;

struct Params {
    const float* in[37];
    unsigned char* ws;
    float* out;
    int ph_lo, ph_hi;
    unsigned char prog[64];
};

enum { K_PREP = 0, K_R1, K_R2, K_R3, K_R4, K_LN, K_F1, K_F2, K_F3, K_D1, K_D2, K_D3, K_D4, K_D5, K_D6, K_R0 };
enum { E_RPROJ = 0, E_LORA2, E_RESID, E_ST16, E_ST32, E_QPROJ };

__device__ __forceinline__ size_t xrow(int row) { return (size_t)(row >> 11) * 2049 + 1 + (row & 2047); }
__device__ __forceinline__ unsigned pk2(float a, float b) { h16x2 h = {(h16)a, (h16)b}; return __builtin_bit_cast(unsigned, h); }
__device__ __forceinline__ u32x4 pack8(f32x4 a, f32x4 b) { u32x4 w; w.x = pk2(a[0], a[1]); w.y = pk2(a[2], a[3]); w.z = pk2(b[0], b[1]); w.w = pk2(b[2], b[3]); return w; }
__device__ __forceinline__ void unpack8(u32x4 w, float* f) {
    h16x8 h = __builtin_bit_cast(h16x8, w);
#pragma unroll
    for (int i = 0; i < 8; ++i) f[i] = (float)h[i];
}
__device__ __forceinline__ float sigmoidf_(float x) { return 1.0f / (1.0f + __expf(-x)); }
__device__ __forceinline__ float wave_sum(float v) {
#pragma unroll
    for (int o = 32; o > 0; o >>= 1) v += __shfl_xor(v, o);
    return v;
}
#define WSYNC() asm volatile("s_waitcnt vmcnt(0) lgkmcnt(0)" ::: "memory")
__device__ __forceinline__ int opaque_tid() { int t = threadIdx.x; asm volatile("" : "+v"(t)); return t; }

namespace pg8 {
constexpr int BM = 256, BK = 64, HALF = 128, HTB = HALF * BK * 2, STAGE_BYTES = 8 * HTB, NXCD = 8, WGM = 8;
__device__ __forceinline__ int lds_byte(int r, int c) { const int st = (r >> 4) * 2 + (c >> 5), rr = r & 15, cc = c & 31, ob = rr * 64 + cc * 2; return st * 1024 + (ob ^ (((ob >> 9) & 1) << 5)); }
__device__ __forceinline__ void stage_rc(int b, int& R, int& C) { const int st = b / 1024, sb = b % 1024, swz = sb ^ (((sb >> 9) & 1) << 5); R = (st >> 1) * 16 + swz / 64; C = (st & 1) * 32 + (swz % 64) / 2; }
__device__ __forceinline__ int perm32(int rho) { const int n = rho >> 4, i = rho & 15; return 8 * (i >> 2) + 4 * n + (i & 3); }
struct Unit { int pm, pn; };
struct Gemm { const h16* A; const h16* A2; const h16* Bt; int M, N, K, lda, amode, pm0; };
struct StaticOrder {
    int nM, nN, nwg, G, c;
    __device__ void init(int M, int N, int G_, int c_) { nM = M / BM; nN = N / BM; nwg = nM * nN; G = G_; c = c_; }
    __device__ bool next(int i, Unit& u) const {
        const long L = (long)i * G + c; if (L >= nwg) return false;
        int wgid = (int)L; { const int q = nwg / NXCD, r = nwg % NXCD, xcd = wgid % NXCD, off = wgid / NXCD; wgid = (xcd < r ? xcd * (q + 1) : r * (q + 1) + (xcd - r) * q) + off; }
        const int nig = WGM * nN, gid = wgid / nig, fm = gid * WGM, gsz = (nM - fm) < WGM ? (nM - fm) : WGM;
        u.pm = fm + ((wgid % nig) % gsz); u.pn = (wgid % nig) / gsz; return true;
    }
};

struct Epi {
    int mode, pm0, j, pnoff, fin;
    unsigned char* ws; float* out; const float* bias0; const float* bias1; const float* bias2;
    __device__ __forceinline__ void operator()(const f32x4 (&acc)[2][2][4][2], const Unit& u, int wr, int wc, int fr, int fq) const {
        const int rowl0 = u.pm * BM + wr * 64 + fr;
        const int colt = u.pn * BM + wc * 32 + 8 * fq;
        if (mode == E_RESID) {
            u32x4 xr[2][4][2];
#pragma unroll
            for (int ai = 0; ai < 2; ++ai)
#pragma unroll
                for (int m = 0; m < 4; ++m) {
                    const int rowg = rowl0 + ai * HALF + m * 16 + pm0 * BM;
                    const h16* xp = (const h16*)(ws + OFF_X16) + xrow(rowg) * 1024 + colt;
#pragma unroll
                    for (int bj = 0; bj < 2; ++bj) xr[ai][m][bj] = *(const u32x4*)(xp + bj * HALF);
                }
#pragma unroll
            for (int ai = 0; ai < 2; ++ai)
#pragma unroll
                for (int m = 0; m < 4; ++m) {
                    const int rowg = rowl0 + ai * HALF + m * 16 + pm0 * BM;
                    float* dp0 = out + (size_t)rowg * 1024 + colt;
                    h16* hp0 = (h16*)out + (size_t)rowg * 1024 + colt;
#pragma unroll
                    for (int bj = 0; bj < 2; ++bj) {
                        float xf[8]; unpack8(xr[ai][m][bj], xf);
                        const f32x4 v0 = acc[ai][bj][m][0], v1 = acc[ai][bj][m][1];
                        f32x4 r0, r1;
#pragma unroll
                        for (int jj = 0; jj < 4; ++jj) { r0[jj] = DN_ALPHA * xf[jj] + v0[jj]; r1[jj] = DN_ALPHA * xf[4 + jj] + v1[jj]; }
                        if (fin) { float* dp = dp0 + bj * HALF; *(f32x4*)dp = r0; *(f32x4*)(dp + 4) = r1; }
                        else *(u32x4*)(hp0 + bj * HALF) = pack8(r0, r1);
                    }
                }
            return;
        }
        if (mode == E_LORA2 && (u.pn >> 2) == 3) {
            const int c0 = colt & 1023;
#pragma unroll
            for (int ai = 0; ai < 2; ++ai) {
                u32x4 lv[4][2], lf[4][2];
#pragma unroll
                for (int m = 0; m < 4; ++m) {
                    const size_t off = (size_t)(rowl0 + ai * HALF + m * 16 + pm0 * BM) * 1024 + c0;
#pragma unroll
                    for (int bj = 0; bj < 2; ++bj) { lv[m][bj] = *(const u32x4*)((const h16*)(ws + R_V16) + off + bj * HALF); lf[m][bj] = *(const u32x4*)((const h16*)(ws + OFF_VF) + off + bj * HALF); }
                }
#pragma unroll
                for (int m = 0; m < 4; ++m) {
                    const size_t off = (size_t)(rowl0 + ai * HALF + m * 16 + pm0 * BM) * 1024 + c0;
#pragma unroll
                    for (int bj = 0; bj < 2; ++bj) {
                        const int c = c0 + bj * HALF;
                        const f32x4 ba = *(const f32x4*)(bias2 + c), bb = *(const f32x4*)(bias2 + c + 4);
                        float vv[8], vf8[8]; unpack8(lv[m][bj], vv); unpack8(lf[m][bj], vf8);
                        f32x4 v0 = acc[ai][bj][m][0], v1 = acc[ai][bj][m][1];
#pragma unroll
                        for (int jj = 0; jj < 4; ++jj) {
                            v0[jj] = vv[jj] + (vf8[jj] - vv[jj]) * sigmoidf_(v0[jj] + ba[jj]);
                            v1[jj] = vv[4 + jj] + (vf8[4 + jj] - vv[4 + jj]) * sigmoidf_(v1[jj] + bb[jj]);
                        }
                        *(u32x4*)((h16*)(ws + R_V16) + off + bj * HALF) = pack8(v0, v1);
                    }
                }
            }
            return;
        }
#pragma unroll
        for (int ai = 0; ai < 2; ++ai)
#pragma unroll
            for (int m = 0; m < 4; ++m) {
                const int rowl = rowl0 + ai * HALF + m * 16;
                const int rowg = rowl + pm0 * BM;
#pragma unroll
                for (int bj = 0; bj < 2; ++bj) {
                    const int col = colt + bj * HALF;
                    f32x4 v0 = acc[ai][bj][m][0], v1 = acc[ai][bj][m][1];
                    if (mode == E_RPROJ) {
                        if (pnoff == 0) {
                            h16* dst = (h16*)(ws + (u.pn < 4 ? R_R16 : (u.pn < 8 ? R_K16 : (j == 0 ? OFF_VF : R_V16))));
                            *(u32x4*)(dst + (size_t)rowg * 1024 + (col & 1023)) = pack8(v0, v1);
                        } else if (col < 384) {
                            const int hc = col;
                            if (hc < 64) {
#pragma unroll
                                for (int jj = 0; jj < 4; ++jj) { v0[jj] = tanhf(v0[jj]); v1[jj] = tanhf(v1[jj]); }
                            } else if (hc >= 160) {
#pragma unroll
                                for (int jj = 0; jj < 4; ++jj) { v0[jj] = sigmoidf_(v0[jj]); v1[jj] = sigmoidf_(v1[jj]); }
                            }
                            *(u32x4*)((h16*)(ws + R_HACT) + (size_t)rowg * 384 + hc) = pack8(v0, v1);
                        }
                    } else if (mode == E_LORA2) {
                        const int grp = u.pn >> 2, c = col & 1023;
                        const size_t off = (size_t)rowg * 1024 + c;
                        if (grp == 0) {
                            const f32x4 ba = *(const f32x4*)(bias0 + c), bb = *(const f32x4*)(bias0 + c + 4);
#pragma unroll
                            for (int jj = 0; jj < 4; ++jj) { v0[jj] = sigmoidf_(v0[jj] + ba[jj]) * 0.6065306597f; v1[jj] = sigmoidf_(v1[jj] + bb[jj]) * 0.6065306597f; }
                            *(u32x4*)((h16*)out + off) = pack8(v0, v1);
                        } else if (grp == 1) {
                            const f32x4 ba = *(const f32x4*)(bias1 + c), bb = *(const f32x4*)(bias1 + c + 4);
#pragma unroll
                            for (int jj = 0; jj < 4; ++jj) { v0[jj] = sigmoidf_(v0[jj] + ba[jj]); v1[jj] = sigmoidf_(v1[jj] + bb[jj]); }
                            *(u32x4*)((h16*)out + (size_t)MTOK * 1024 + off) = pack8(v0, v1);
                        } else {
                            *(u32x4*)((h16*)(ws + R_G16) + off) = pack8(v0, v1);
                        }
                    } else if (mode == E_ST16) {
                        *(u32x4*)((h16*)(ws + F_U16) + (size_t)rowl * 5632 + col) = pack8(v0, v1);
                    } else if (mode == E_ST32) {
                        float* dp = (float*)(ws + D_HIN) + (size_t)rowg * 512 + col;
                        *(f32x4*)dp = v0; *(f32x4*)(dp + 4) = v1;
                    } else {
                        if (u.pn < 8) *(u32x4*)((h16*)(ws + D_QABS) + (size_t)rowg * 2048 + col) = pack8(v0, v1);
                        else *(u32x4*)((h16*)(ws + D_QIDX) + (size_t)rowg * 512 + (col - 2048)) = pack8(v0, v1);
                    }
                }
            }
    }
};

__device__ __forceinline__ const char* a_tile(const Gemm& g, int pm, int pn) {
    if (g.amode == 1) { const int row = (pm + g.pm0) * BM; return (const char*)g.A + xrow(row) * 2048; }
    if (g.amode == 2) {
        const int gq = pn >> 2;
        const char* base = gq == 2 ? (const char*)g.A2 : (const char*)g.A + (size_t)gq * ((size_t)MTOK * 1024 * 2);
        return base + (size_t)pm * BM * 2048;
    }
    if (g.amode == 3) return (pm < 128 ? (const char*)g.A + (size_t)pm * BM * 4096 : (const char*)g.A2 + (size_t)(pm - 128) * BM * 4096);
    return (const char*)g.A + (size_t)pm * BM * g.lda * 2;
}

__device__ __forceinline__ void gemm_phase(LAS unsigned char* lds, const Gemm g, const StaticOrder& S, const Epi& E) {
    const int tid = opaque_tid(), wid = __builtin_amdgcn_readfirstlane(tid >> 6), lane = tid & 63, wr = wid >> 2, wc = wid & 3, fr = lane & 15, fq = lane >> 4;
    const int K = g.K, nt = K / BK;
    const bool shiftA = (g.amode == 1);
    unsigned voffA[2], voffB[2];
#pragma unroll
    for (int i = 0; i < 2; ++i) { int R, C; stage_rc(tid * 16 + i * 8192, R, C); const int Rb = (R & ~31) + perm32(R & 31);
        voffA[i] = (unsigned)(R * g.lda + C) * 2u; voffB[i] = (unsigned)(Rb * K + C) * 2u; }
    const size_t kstep = (size_t)(BK * 2);
    const size_t hstepA = (size_t)HALF * g.lda * 2;
    const size_t hstepB = (size_t)HALF * K * 2;
    const size_t tstepB = 2 * hstepB;
    const unsigned ldsw = (unsigned)wid * 1024u;
    const int aoff = lds_byte(wr * 64 + fr, fq * 8), boff = lds_byte(wc * 32 + fr, fq * 8);
#define PG8_KOFF(kt) ((size_t)(kt) * kstep - ((shiftA && (kt) >= 16) ? (size_t)4096 : (size_t)0))
#define PG8_SA(b, h) (((b) * 2 + (h)) * HTB)
#define PG8_SB(b, h) ((4 + (b) * 2 + (h)) * HTB)
#define PG8_STAGE(bufoff, gbase, voff) do { _Pragma("unroll") for (int _i = 0; _i < 2; ++_i) \
        __builtin_amdgcn_global_load_lds((const unsigned*)((const char*)(gbase) + (voff)[_i]), (LAS unsigned*)(lds + (bufoff) + ldsw + _i * 8192), 16, 0, 0); } while (0)
#define PG8_LDA(dst, b, h) do { _Pragma("unroll") for (int m = 0; m < 4; ++m) _Pragma("unroll") for (int k = 0; k < 2; ++k) dst[m][k] = *(const LAS h16x8*)(lds + PG8_SA(b, h) + aoff + m * 2048 + k * 1024); } while (0)
#define PG8_LDB(dst, b, h) do { _Pragma("unroll") for (int n = 0; n < 2; ++n) _Pragma("unroll") for (int k = 0; k < 2; ++k) dst[n][k] = *(const LAS h16x8*)(lds + PG8_SB(b, h) + boff + n * 2048 + k * 1024); } while (0)
#define PG8_MMA(ai, bj, At, Bt) do { __builtin_amdgcn_s_setprio(1); _Pragma("unroll") for (int m = 0; m < 4; ++m) _Pragma("unroll") for (int n = 0; n < 2; ++n) _Pragma("unroll") for (int k = 0; k < 2; ++k) \
        acc[ai][bj][m][n] = __builtin_amdgcn_mfma_f32_16x16x32_f16(Bt[n][k], At[m][k], acc[ai][bj][m][n], 0, 0, 0); __builtin_amdgcn_s_setprio(0); } while (0)
#define PG8_WAIT_V(n) asm volatile("s_waitcnt vmcnt(" #n ")" ::: "memory")
#define PG8_WAIT_L(n) asm volatile("s_waitcnt lgkmcnt(" #n ")" ::: "memory")
#define PG8_BAR __builtin_amdgcn_s_barrier()
#define PG8_SCHED __builtin_amdgcn_sched_barrier(0)
    Unit cur, nxt; int ui = 0;
    if (!S.next(0, cur)) return;
    f32x4 acc[2][2][4][2];
#pragma unroll
    for (int a = 0; a < 2; ++a)
#pragma unroll
        for (int b = 0; b < 2; ++b)
#pragma unroll
            for (int m = 0; m < 4; ++m)
#pragma unroll
                for (int n = 0; n < 2; ++n) acc[a][b][m][n] = (f32x4){0.f, 0.f, 0.f, 0.f};
    h16x8 At[4][2], B0[2][2], B1[2][2];
    const char* cA = a_tile(g, cur.pm, cur.pn); const char* cB = (const char*)g.Bt + (size_t)cur.pn * tstepB;
    PG8_STAGE(PG8_SB(0, 0), cB, voffB); PG8_STAGE(PG8_SA(0, 0), cA, voffA); PG8_STAGE(PG8_SB(0, 1), cB + hstepB, voffB); PG8_STAGE(PG8_SA(0, 1), cA + hstepA, voffA);
    if (wr == 1) PG8_BAR;
    PG8_WAIT_V(4); PG8_BAR;
    PG8_STAGE(PG8_SB(1, 0), cB + kstep, voffB); PG8_STAGE(PG8_SA(1, 0), cA + kstep, voffA); PG8_STAGE(PG8_SB(1, 1), cB + hstepB + kstep, voffB);
    PG8_WAIT_V(6); PG8_BAR;
    for (;;) {
        const bool has_next = S.next(ui + 1, nxt);
        const char* nA = has_next ? a_tile(g, nxt.pm, nxt.pn) : cA; const char* nB = has_next ? (const char*)g.Bt + (size_t)nxt.pn * tstepB : cB;
        for (int t = 0; t < nt; t += 2) {
            const bool last = (t == nt - 2);
            const char* a1 = cA + PG8_KOFF(t + 1);
            const char* a2 = last ? nA : cA + PG8_KOFF(t + 2); const char* b2 = last ? nB : cB + (size_t)(t + 2) * kstep;
            const char* a3 = a2 + kstep; const char* b3 = b2 + kstep;
            PG8_LDB(B0, 0, 0); PG8_SCHED; PG8_LDA(At, 0, 0); PG8_STAGE(PG8_SA(1, 1), a1 + hstepA, voffA);
            PG8_WAIT_L(8); PG8_BAR; PG8_WAIT_L(0); PG8_MMA(0, 0, At, B0); PG8_BAR; PG8_SCHED;
            PG8_LDB(B1, 0, 1); PG8_STAGE(PG8_SB(0, 0), b2, voffB);
            PG8_BAR; PG8_WAIT_L(0); PG8_MMA(0, 1, At, B1); PG8_BAR;
            PG8_LDA(At, 0, 1); PG8_STAGE(PG8_SA(0, 0), a2, voffA);
            PG8_BAR; PG8_WAIT_L(0); PG8_MMA(1, 0, At, B0); PG8_BAR; PG8_SCHED;
            PG8_STAGE(PG8_SB(0, 1), b2 + hstepB, voffB);
            PG8_WAIT_V(6); PG8_BAR; PG8_MMA(1, 1, At, B1); PG8_BAR;
            PG8_LDB(B0, 1, 0); PG8_SCHED; PG8_LDA(At, 1, 0); PG8_STAGE(PG8_SA(0, 1), a2 + hstepA, voffA);
            PG8_WAIT_L(8); PG8_BAR; PG8_WAIT_L(0); PG8_MMA(0, 0, At, B0); PG8_BAR; PG8_SCHED;
            PG8_LDB(B1, 1, 1); PG8_STAGE(PG8_SB(1, 0), b3, voffB);
            PG8_BAR; PG8_WAIT_L(0); PG8_MMA(0, 1, At, B1); PG8_BAR;
            PG8_LDA(At, 1, 1); PG8_STAGE(PG8_SA(1, 0), a3, voffA);
            PG8_BAR; PG8_WAIT_L(0); PG8_MMA(1, 0, At, B0); PG8_BAR; PG8_SCHED;
            PG8_STAGE(PG8_SB(1, 1), b3 + hstepB, voffB);
            PG8_WAIT_V(6); PG8_BAR; PG8_MMA(1, 1, At, B1); PG8_BAR;
        }
        E(acc, cur, wr, wc, fr, fq);
        if (!has_next) break;
#pragma unroll
        for (int a = 0; a < 2; ++a)
#pragma unroll
            for (int b = 0; b < 2; ++b)
#pragma unroll
                for (int m = 0; m < 4; ++m)
#pragma unroll
                    for (int n = 0; n < 2; ++n) acc[a][b][m][n] = (f32x4){0.f, 0.f, 0.f, 0.f};
        cur = nxt; cA = nA; cB = nB; ++ui;
    }
    PG8_WAIT_V(0);
    if (wr == 0) PG8_BAR;
    PG8_BAR;
#undef PG8_KOFF
#undef PG8_SA
#undef PG8_SB
#undef PG8_STAGE
#undef PG8_LDA
#undef PG8_LDB
#undef PG8_MMA
#undef PG8_WAIT_V
#undef PG8_WAIT_L
#undef PG8_BAR
#undef PG8_SCHED
}
}

struct TJob { int mode; const float* src; int ld, K, N; h16* dst; int ldd, koff; const float* mix; };

__device__ __forceinline__ TJob get_job(const Params& p, int id) {
    TJob J; J.mode = 0; J.src = nullptr; J.ld = 0; J.K = 0; J.N = 0; J.dst = nullptr; J.ldd = 64; J.koff = 0; J.mix = nullptr;
    h16* W = (h16*)(p.ws + OFF_W);
    if (id < 24) {
        const int j = id / 12, s = id % 12;
        h16* Wrkv = W + (size_t)j * (10 * MiB); h16* Wl1 = Wrkv + 3 * MiB; h16* Wl2 = Wrkv + 7 * MiB;
        const float* mix = p.in[3] + j * 6 * 1024;
        if (s < 3) { J.mode = 0; J.src = p.in[4] + (size_t)(j * 3 + s) * 1048576; J.ld = 1024; J.K = 1024; J.N = 1024; J.dst = Wrkv + (size_t)s * 1024 * 1024; J.ldd = 1024; }
        else if (s < 8) {
            J.mode = 1; J.ld = 1024; J.K = 1024; J.ldd = 2048;
            if (s == 3) { J.src = p.in[6] + (size_t)j * 65536; J.ld = 64; J.N = 64; J.dst = Wl1; J.mix = mix + 3 * 1024; }
            else if (s == 4) { J.src = p.in[9] + (size_t)j * 65536; J.ld = 64; J.N = 64; J.dst = Wl1 + (size_t)64 * 2048; J.mix = mix + 4 * 1024; }
            else if (s == 5) { J.N = 32; J.dst = Wl1 + (size_t)128 * 2048; if (j == 1) { J.src = p.in[12]; J.ld = 32; J.mix = mix + 2 * 1024; } else { J.mode = 2; } }
            else if (s == 6) { J.src = p.in[14] + (size_t)j * 163840; J.ld = 160; J.N = 160; J.dst = Wl1 + (size_t)160 * 2048; J.mix = mix + 5 * 1024; }
            else { J.mode = 2; J.N = 192; J.dst = Wl1 + (size_t)320 * 2048; }
        } else {
            J.mode = 0; J.ld = 1024; J.N = 1024; J.ldd = 384;
            if (s == 8) { J.src = p.in[7] + (size_t)j * 65536; J.K = 64; J.koff = 0; J.dst = Wl2; }
            else if (s == 9) { J.src = p.in[10] + (size_t)j * 65536; J.K = 64; J.koff = 64; J.dst = Wl2 + (size_t)1024 * 384; }
            else if (s == 10) { J.src = p.in[15] + (size_t)j * 163840; J.K = 160; J.koff = 160; J.dst = Wl2 + (size_t)2048 * 384; }
            else { J.src = p.in[13]; J.K = 32; J.koff = 128; J.dst = Wl2 + (size_t)3072 * 384; if (j == 0) J.N = 0; }
        }
    } else if (id < 26) {
        const int j = id - 24;
        J.src = p.in[21] + (size_t)j * 1048576; J.ld = 1024; J.K = 1024; J.N = 1024; J.dst = W + (size_t)j * (10 * MiB) + 9 * MiB; J.ldd = 1024;
    } else if (id < 34) {
        const int i = (id - 26) >> 1, s = (id - 26) & 1;
        h16* base = W + 20 * MiB + (size_t)i * (17 * MiB / 2);
        if (s == 0) { J.src = p.in[33] + (size_t)i * 1024 * 5632; J.ld = 5632; J.K = 1024; J.N = 5632; J.dst = base; J.ldd = 1024; }
        else { J.src = p.in[36] + (size_t)i * 2816 * 1024; J.ld = 1024; J.K = 2816; J.N = 1024; J.dst = base + (size_t)11 * MiB / 2; J.ldd = 2816; }
    } else {
        const int j = (id - 34) >> 2, s = (id - 34) & 3;
        h16* base = W + 54 * MiB + (size_t)j * (5 * MiB / 2);
        if (s == 0) { J.src = p.in[22] + (size_t)j * 1024 * 456; J.ld = 456; J.K = 1024; J.N = 456; J.dst = base; J.ldd = 1024; }
        else if (s == 1) { J.mode = 2; J.N = 56; J.dst = base + (size_t)456 * 1024; J.ldd = 1024; }
        else if (s == 2) { J.src = p.in[28] + (size_t)j * 256 * 512; J.ld = 512; J.K = 256; J.N = 512; J.dst = base + MiB / 2 + (size_t)2048 * 256; J.ldd = 256; }
        else { J.src = p.in[31] + (size_t)j * 1048576; J.ld = 1024; J.K = 1024; J.N = 1024; J.dst = base + 3 * MiB / 2; J.ldd = 1024; }
    }
    return J;
}
__device__ __forceinline__ h16* w_rwkv_big(unsigned char* ws, int j) { return (h16*)(ws + OFF_W) + (size_t)j * (10 * MiB); }
__device__ __forceinline__ h16* w_rwkv_l1(unsigned char* ws, int j) { return w_rwkv_big(ws, j) + 3 * MiB; }
__device__ __forceinline__ h16* w_rwkv_l2(unsigned char* ws, int j) { return w_rwkv_big(ws, j) + 7 * MiB; }
__device__ __forceinline__ h16* w_rwkv_o(unsigned char* ws, int j) { return w_rwkv_big(ws, j) + 9 * MiB; }
__device__ __forceinline__ h16* w_ffn_up(unsigned char* ws, int i) { return (h16*)(ws + OFF_W) + 20 * MiB + (size_t)i * (17 * MiB / 2); }
__device__ __forceinline__ h16* w_ffn_dn(unsigned char* ws, int i) { return w_ffn_up(ws, i) + (size_t)11 * MiB / 2; }
__device__ __forceinline__ h16* w_dsa_in(unsigned char* ws, int j) { return (h16*)(ws + OFF_W) + 54 * MiB + (size_t)j * (5 * MiB / 2); }
__device__ __forceinline__ h16* w_dsa_q(unsigned char* ws, int j) { return w_dsa_in(ws, j) + MiB / 2; }
__device__ __forceinline__ h16* w_dsa_uvt(unsigned char* ws, int j) { return w_dsa_in(ws, j) + 5 * MiB / 4; }
__device__ __forceinline__ h16* w_dsa_o(unsigned char* ws, int j) { return w_dsa_in(ws, j) + 3 * MiB / 2; }

__device__ __forceinline__ void prep_phase(const Params& p, unsigned char* smem) {
    const int tid = opaque_tid();
    const size_t gtid = (size_t)blockIdx.x * 512 + tid, nth = (size_t)gridDim.x * 512;
    h16* x16 = (h16*)(p.ws + OFF_X16);
    for (size_t idx = gtid; idx < (size_t)MTOK * 128; idx += nth) {
        const int row = (int)(idx >> 7), c8 = (int)(idx & 127) * 8;
        const float* sp = p.in[0] + (size_t)row * 1024 + c8;
        const f32x4 a = *(const f32x4*)sp, b = *(const f32x4*)(sp + 4);
        *(u32x4*)(x16 + xrow(row) * 1024 + c8) = pack8(a, b);
    }
    for (size_t idx = gtid; idx < (size_t)NBATCH * 128; idx += nth) {
        const int b = (int)(idx >> 7), c8 = (int)(idx & 127) * 8;
        unsigned z = 0u; asm volatile("" : "+v"(z));
        *(u32x4*)(x16 + (size_t)b * 2049 * 1024 + c8) = (u32x4){z, z, z, z};
    }
    for (size_t it = gtid; it < (size_t)2 * 16 * 2048; it += nth) {
        const int j = (int)(it >> 15), rem = (int)(it & 32767), qg = rem >> 11, n = rem & 2047, h = n >> 7, c = n & 127;
        const float* uq = p.in[25] + (size_t)j * 256 * 1024 + (size_t)(qg * 16) * 1024 + h * 64;
        const float* uk = p.in[26] + (size_t)j * 16 * 64 * 128 + (size_t)h * 64 * 128 + c;
        float acc[16];
#pragma unroll
        for (int i = 0; i < 16; ++i) acc[i] = 0.f;
        for (int d = 0; d < 64; ++d) {
            const float kv = uk[d * 128];
#pragma unroll
            for (int i = 0; i < 16; ++i) acc[i] += uq[i * 1024 + d] * kv;
        }
        const float sc = 0.18033688011112042f;
        h16* dst = w_dsa_q(p.ws, j) + (size_t)n * 256 + qg * 16;
        *(u32x4*)dst = pack8((f32x4){acc[0] * sc, acc[1] * sc, acc[2] * sc, acc[3] * sc}, (f32x4){acc[4] * sc, acc[5] * sc, acc[6] * sc, acc[7] * sc});
        *(u32x4*)(dst + 8) = pack8((f32x4){acc[8] * sc, acc[9] * sc, acc[10] * sc, acc[11] * sc}, (f32x4){acc[12] * sc, acc[13] * sc, acc[14] * sc, acc[15] * sc});
    }
    for (size_t it = gtid; it < (size_t)2 * 128 * 1024; it += nth) {
        const int j = (int)(it >> 17), rem = (int)(it & 131071), kg = rem >> 10, n = rem & 1023, h = kg >> 3, c0 = (kg & 7) * 16;
        const float* uv = p.in[27] + (size_t)((j * 16 + h) * 128 + c0) * 64;
        const float* wo = p.in[31] + (size_t)j * 1048576 + (size_t)(h * 64) * 1024 + n;
        float acc[16];
#pragma unroll
        for (int i = 0; i < 16; ++i) acc[i] = 0.f;
        for (int v = 0; v < 64; ++v) {
            const float wv = wo[(size_t)v * 1024];
#pragma unroll
            for (int i = 0; i < 16; ++i) acc[i] += uv[i * 64 + v] * wv;
        }
        h16* dst = (h16*)(p.ws + OFF_WOV) + (size_t)j * 2097152 + (size_t)n * 2048 + h * 128 + c0;
        *(u32x4*)dst = pack8((f32x4){acc[0], acc[1], acc[2], acc[3]}, (f32x4){acc[4], acc[5], acc[6], acc[7]});
        *(u32x4*)(dst + 8) = pack8((f32x4){acc[8], acc[9], acc[10], acc[11]}, (f32x4){acc[12], acc[13], acc[14], acc[15]});
    }
    float* tile = (float*)smem;
    for (int id = 0; id < 42; ++id) {
        const TJob J = get_job(p, id);
        const int tk = J.ldd >> 6, tn = (J.N + 63) >> 6, ntile = tk * tn;
        for (int tix = blockIdx.x; tix < ntile; tix += gridDim.x) {
            const int k0 = (tix % tk) * 64, n0 = (tix / tk) * 64;
#pragma unroll
            for (int i = 0; i < 8; ++i) {
                const int k = i * 8 + (tid >> 6), n = tid & 63, kk = k0 + k, nn = n0 + n;
                float v = 0.f;
                if (nn < J.N && J.mode != 2) {
                    if (J.mode == 1) { const int ks = kk & 1023; const float mx = J.mix[ks]; v = J.src[(size_t)ks * J.ld + nn] * (kk < 1024 ? 1.0f - mx : mx); }
                    else if (kk >= J.koff && kk < J.koff + J.K) v = J.src[(size_t)(kk - J.koff) * J.ld + nn];
                }
                tile[k * 65 + n] = v;
            }
            __syncthreads();
#pragma unroll
            for (int i = 0; i < 8; ++i) {
                const int n = i * 8 + (tid >> 6), k = tid & 63, nn = n0 + n;
                if (nn < J.N) J.dst[(size_t)nn * J.ldd + k0 + k] = (h16)tile[k * 65 + n];
            }
            __syncthreads();
        }
    }
}

__device__ __forceinline__ void wave_sum4(float (&v)[4]) {
#pragma unroll
    for (int o = 32; o > 0; o >>= 1) {
        float t[4];
#pragma unroll
        for (int k = 0; k < 4; ++k) t[k] = __shfl_xor(v[k], o);
#pragma unroll
        for (int k = 0; k < 4; ++k) v[k] += t[k];
    }
}
__device__ __forceinline__ void ln_phase(const Params& p, const float* g, const float* b, bool final_out) {
    const int tid = opaque_tid();
    const int lane = tid & 63, wave = tid >> 6;
    float* tb = p.out;
    h16* x16 = (h16*)(p.ws + OFF_X16);
    f32x4 gg[4], bb[4];
#pragma unroll
    for (int i = 0; i < 4; ++i) { gg[i] = *(const f32x4*)(g + i * 256 + lane * 4); bb[i] = *(const f32x4*)(b + i * 256 + lane * 4); }
    for (int rowb = (blockIdx.x * 8 + wave) * 4; rowb < MTOK; rowb += gridDim.x * 32) {
        f32x4 v[4][4];
        float s[4];
#pragma unroll
        for (int k = 0; k < 4; ++k) {
            s[k] = 0.f;
            if (final_out) {
                const float* rp = tb + (size_t)(rowb + k) * 1024;
#pragma unroll
                for (int i = 0; i < 4; ++i) v[k][i] = *(const f32x4*)(rp + i * 256 + lane * 4);
            } else {
                const h16* hp = (const h16*)tb + (size_t)(rowb + k) * 1024;
#pragma unroll
                for (int i = 0; i < 4; ++i) { const h16x4 hv = *(const h16x4*)(hp + i * 256 + lane * 4); v[k][i] = (f32x4){(float)hv[0], (float)hv[1], (float)hv[2], (float)hv[3]}; }
            }
#pragma unroll
            for (int i = 0; i < 4; ++i) s[k] += (v[k][i][0] + v[k][i][1]) + (v[k][i][2] + v[k][i][3]);
        }
        wave_sum4(s);
        float q[4];
#pragma unroll
        for (int k = 0; k < 4; ++k) {
            s[k] *= (1.0f / 1024.0f); q[k] = 0.f;
#pragma unroll
            for (int i = 0; i < 4; ++i)
#pragma unroll
                for (int jj = 0; jj < 4; ++jj) { const float d = v[k][i][jj] - s[k]; q[k] += d * d; }
        }
        wave_sum4(q);
#pragma unroll
        for (int k = 0; k < 4; ++k) {
            const float rstd = rsqrtf(q[k] * (1.0f / 1024.0f) + 1e-5f);
            const int row = rowb + k;
#pragma unroll
            for (int i = 0; i < 4; ++i) {
                f32x4 y;
#pragma unroll
                for (int jj = 0; jj < 4; ++jj) y[jj] = (v[k][i][jj] - s[k]) * rstd * gg[i][jj] + bb[i][jj];
                if (final_out) *(f32x4*)(tb + (size_t)row * 1024 + i * 256 + lane * 4) = y;
                else { u32x2 w; w.x = pk2(y[0], y[1]); w.y = pk2(y[2], y[3]); *(u32x2*)(x16 + xrow(row) * 1024 + i * 256 + lane * 4) = w; }
            }
        }
    }
}

__device__ __forceinline__ void conv_phase(const Params& p, int layer) {
    const h16* u = (const h16*)(p.ws + F_U16);
    h16* act = (h16*)(p.ws + F_ACT);
    const float* cw = p.in[34] + (size_t)layer * 3 * 5632;
    const float* cb = p.in[35] + (size_t)layer * 5632;
    const size_t gtid = (size_t)blockIdx.x * 512 + opaque_tid(), nth = (size_t)gridDim.x * 512;
    const size_t ntask = (size_t)2048 * 352;
    for (size_t task = gtid; task < ntask; task += nth) {
        const int cgp = (int)(task % 352), rc = (int)(task / 352), f = cgp * 8, r0 = rc * 16;
        float wg[3][8], wv[3][8], bg[8], bv[8];
#pragma unroll
        for (int jj = 0; jj < 3; ++jj)
#pragma unroll
            for (int hlf = 0; hlf < 2; ++hlf) {
                const f32x4 a = *(const f32x4*)(cw + jj * 5632 + f + hlf * 4), c = *(const f32x4*)(cw + jj * 5632 + DFF + f + hlf * 4);
#pragma unroll
                for (int e = 0; e < 4; ++e) { wg[jj][hlf * 4 + e] = a[e]; wv[jj][hlf * 4 + e] = c[e]; }
            }
#pragma unroll
        for (int hlf = 0; hlf < 2; ++hlf) {
            const f32x4 a = *(const f32x4*)(cb + f + hlf * 4), c = *(const f32x4*)(cb + DFF + f + hlf * 4);
#pragma unroll
            for (int e = 0; e < 4; ++e) { bg[hlf * 4 + e] = a[e]; bv[hlf * 4 + e] = c[e]; }
        }
        float g2[8], g1[8], v2[8], v1[8];
#pragma unroll
        for (int e = 0; e < 8; ++e) { g2[e] = 0.f; g1[e] = 0.f; v2[e] = 0.f; v1[e] = 0.f; }
        if ((r0 & 2047) != 0) {
            unpack8(*(const u32x4*)(u + (size_t)(r0 - 2) * 5632 + f), g2); unpack8(*(const u32x4*)(u + (size_t)(r0 - 1) * 5632 + f), g1);
            unpack8(*(const u32x4*)(u + (size_t)(r0 - 2) * 5632 + DFF + f), v2); unpack8(*(const u32x4*)(u + (size_t)(r0 - 1) * 5632 + DFF + f), v1);
        }
#pragma unroll 1
        for (int i0 = 0; i0 < 16; i0 += 4) {
            u32x4 lg[4], lv[4];
#pragma unroll
            for (int i = 0; i < 4; ++i) { const size_t ro = (size_t)(r0 + i0 + i) * 5632; lg[i] = *(const u32x4*)(u + ro + f); lv[i] = *(const u32x4*)(u + ro + DFF + f); }
#pragma unroll
            for (int i = 0; i < 4; ++i) {
                float g0[8], v0[8], o[8];
                unpack8(lg[i], g0); unpack8(lv[i], v0);
#pragma unroll
                for (int e = 0; e < 8; ++e) {
                    const float G = wg[0][e] * g2[e] + wg[1][e] * g1[e] + wg[2][e] * g0[e] + bg[e];
                    const float V = wv[0][e] * v2[e] + wv[1][e] * v1[e] + wv[2][e] * v0[e] + bv[e];
                    o[e] = G * sigmoidf_(G) * V;
                    g2[e] = g1[e]; g1[e] = g0[e]; v2[e] = v1[e]; v1[e] = v0[e];
                }
                *(u32x4*)(act + (size_t)(r0 + i0 + i) * DFF + f) = pack8((f32x4){o[0], o[1], o[2], o[3]}, (f32x4){o[4], o[5], o[6], o[7]});
            }
        }
    }
}

__device__ __forceinline__ void mix_phase(const Params& p, int j) {
    const h16* x16 = (const h16*)(p.ws + OFF_X16);
    h16* xr = (h16*)p.out; h16* xk = (h16*)p.out + (size_t)MTOK * 1024; h16* xv = (h16*)(p.ws + R_G16);
    const float* mix = p.in[3] + j * 6 * 1024;
    const size_t gtid = (size_t)blockIdx.x * 512 + opaque_tid(), nth = (size_t)gridDim.x * 512;
    for (size_t idx = gtid; idx < (size_t)MTOK * 128; idx += nth) {
        const int row = (int)(idx >> 7), c8 = (int)(idx & 127) * 8;
        const h16* xp = x16 + xrow(row) * 1024 + c8;
        float xc[8], xq[8];
        unpack8(*(const u32x4*)xp, xc); unpack8(*(const u32x4*)(xp - 1024), xq);
#pragma unroll
        for (int e = 0; e < 8; ++e) xq[e] -= xc[e];
        const size_t o = (size_t)row * 1024 + c8;
#pragma unroll
        for (int bsel = 0; bsel < 3; ++bsel) {
            const f32x4 m0 = *(const f32x4*)(mix + bsel * 1024 + c8), m1 = *(const f32x4*)(mix + bsel * 1024 + c8 + 4);
            f32x4 a, b;
#pragma unroll
            for (int e = 0; e < 4; ++e) { a[e] = xc[e] + xq[e] * m0[e]; b[e] = xc[4 + e] + xq[4 + e] * m1[e]; }
            h16* dst = bsel == 0 ? xr : (bsel == 1 ? xk : xv);
            *(u32x4*)(dst + o) = pack8(a, b);
        }
    }
}

__device__ __forceinline__ float dppf(float x, const int ctrl_sel) {
    const int v = __builtin_bit_cast(int, x);
    int r;
    if (ctrl_sel == 0) r = __builtin_amdgcn_update_dpp(0, v, 0xB1, 0xF, 0xF, true);
    else if (ctrl_sel == 1) r = __builtin_amdgcn_update_dpp(0, v, 0x4E, 0xF, 0xF, true);
    else if (ctrl_sel == 2) r = __builtin_amdgcn_update_dpp(0, v, 0x141, 0xF, 0xF, true);
    else r = __builtin_amdgcn_update_dpp(0, v, 0x140, 0xF, 0xF, true);
    return __builtin_bit_cast(float, r);
}
__device__ __forceinline__ float red4(float x) { x += dppf(x, 0); x += dppf(x, 1); return x; }
__device__ __forceinline__ float red16(float x) { x += dppf(x, 0); x += dppf(x, 1); x += dppf(x, 2); x += dppf(x, 3); return x; }
__device__ __forceinline__ void unpack4(u32x2 w, float* f) {
    h16x4 h = __builtin_bit_cast(h16x4, w);
#pragma unroll
    for (int i = 0; i < 4; ++i) f[i] = (float)h[i];
}
constexpr int SCAN_BUF = 8256;
__device__ __forceinline__ void scan_phase(const Params& p, int j, unsigned char* smem) {
    const int tid = opaque_tid();
    const int wave = tid >> 6, lane = tid & 63, slot = wave >> 2, w4 = wave & 3;
    float* LB = (float*)smem + slot * (2 * SCAN_BUF);
    const h16* r16 = (const h16*)(p.ws + R_R16);
    const h16* k16 = (const h16*)(p.ws + R_K16);
    const h16* v16 = (j == 0) ? (const h16*)(p.ws + OFF_VF) : (const h16*)(p.ws + R_V16);
    const h16* g16 = (const h16*)(p.ws + R_G16);
    const h16* e16 = (const h16*)p.out;
    const h16* a16 = (const h16*)p.out + (size_t)MTOK * 1024;
    h16* y16 = (h16*)(p.ws + (j == 0 ? R_V16 : OFF_VF));
    const int tp = w4 * 4 + (lane >> 4), k4 = (lane & 15) * 4;
    const int vrow = w4 * 16 + (lane >> 2), kq = lane & 3;
    for (int pair = blockIdx.x; pair < 256; pair += gridDim.x) {
        const int chain = pair * 2 + slot, b = chain >> 4, h = chain & 15;
        const int col = h * 64 + k4;
        const f32x4 c_kk = *(const f32x4*)(p.in[16] + j * 1024 + col), c_ka = *(const f32x4*)(p.in[17] + j * 1024 + col), c_rk = *(const f32x4*)(p.in[18] + j * 1024 + col);
        const f32x4 c_lg = *(const f32x4*)(p.in[19] + j * 1024 + col), c_lb = *(const f32x4*)(p.in[20] + j * 1024 + col);
        f32x2 S[8];
#pragma unroll
        for (int i = 0; i < 8; ++i) S[i] = (f32x2){0.f, 0.f};
        u32x2 pr[6];
        {
            const size_t go = ((size_t)(b * 2048 + tp)) * 1024 + col;
            pr[0] = *(const u32x2*)(r16 + go); pr[1] = *(const u32x2*)(k16 + go); pr[2] = *(const u32x2*)(v16 + go);
            pr[3] = *(const u32x2*)(e16 + go); pr[4] = *(const u32x2*)(a16 + go); pr[5] = *(const u32x2*)(g16 + go);
        }
        for (int ch = 0; ch < 128; ++ch) {
            float* BUF = LB + (ch & 1) * SCAN_BUF;
            float* OPS = BUF; float* VB = BUF + 5120; float* GB = BUF + 6144; float* YB = BUF + 7168; float* BON = BUF + 8192;
            {
                float rf[4], kf[4], vf[4], ef[4], af[4], gf[4];
                unpack4(pr[0], rf); unpack4(pr[1], kf); unpack4(pr[2], vf); unpack4(pr[3], ef); unpack4(pr[4], af); unpack4(pr[5], gf);
                float kk[4]; float ss = 0.f;
#pragma unroll
                for (int i = 0; i < 4; ++i) { kk[i] = kf[i] * c_kk[i]; ss += kk[i] * kk[i]; }
                ss = red16(ss);
                const float inv = 1.0f / fmaxf(sqrtf(ss), 1e-12f);
                f32x4 A4, B4, W4, K4, R4; float bs = 0.f;
#pragma unroll
                for (int i = 0; i < 4; ++i) {
                    const float kn = kk[i] * inv;
                    A4[i] = -kn; B4[i] = kn * af[i];
                    W4[i] = __expf(-ef[i]);
                    const float km = kf[i] * (1.0f + (af[i] - 1.0f) * c_ka[i]);
                    K4[i] = km; R4[i] = rf[i];
                    bs += rf[i] * km * c_rk[i];
                }
                bs = red16(bs);
                float* o = OPS + tp * 320 + k4;
                *(f32x4*)(o) = A4; *(f32x4*)(o + 64) = B4; *(f32x4*)(o + 128) = W4; *(f32x4*)(o + 192) = K4; *(f32x4*)(o + 256) = R4;
                *(f32x4*)(VB + tp * 64 + k4) = (f32x4){vf[0], vf[1], vf[2], vf[3]};
                *(f32x4*)(GB + tp * 64 + k4) = (f32x4){gf[0], gf[1], gf[2], gf[3]};
                if ((lane & 15) == 0) BON[tp] = bs;
            }
            if (ch + 1 < 128) {
                const size_t go = ((size_t)(b * 2048 + (ch + 1) * 16 + tp)) * 1024 + col;
                pr[0] = *(const u32x2*)(r16 + go); pr[1] = *(const u32x2*)(k16 + go); pr[2] = *(const u32x2*)(v16 + go);
                pr[3] = *(const u32x2*)(e16 + go); pr[4] = *(const u32x2*)(a16 + go); pr[5] = *(const u32x2*)(g16 + go);
            }
            __syncthreads();
#pragma unroll 2
            for (int t = 0; t < 16; ++t) {
                const float* op = OPS + t * 320 + kq * 16;
                f32x4 A4[4], B4[4], W4[4], K4[4], R4[4];
#pragma unroll
                for (int i = 0; i < 4; ++i) A4[i] = *(const f32x4*)(op + i * 4);
#pragma unroll
                for (int i = 0; i < 4; ++i) { W4[i] = *(const f32x4*)(op + 128 + i * 4); B4[i] = *(const f32x4*)(op + 64 + i * 4); K4[i] = *(const f32x4*)(op + 192 + i * 4); }
#pragma unroll
                for (int i = 0; i < 4; ++i) R4[i] = *(const f32x4*)(op + 256 + i * 4);
                const float vv = VB[t * 64 + vrow];
                f32x2 s0 = {0.f, 0.f}, s1 = {0.f, 0.f};
#pragma unroll
                for (int i = 0; i < 4; ++i) { s0 += S[2 * i] * (f32x2){A4[i][0], A4[i][1]}; s1 += S[2 * i + 1] * (f32x2){A4[i][2], A4[i][3]}; }
                const float sa = red4((s0[0] + s0[1]) + (s1[0] + s1[1]));
                const f32x2 sa2 = {sa, sa}, vv2 = {vv, vv};
#pragma unroll
                for (int i = 0; i < 4; ++i) {
                    S[2 * i] = S[2 * i] * (f32x2){W4[i][0], W4[i][1]} + sa2 * (f32x2){B4[i][0], B4[i][1]} + vv2 * (f32x2){K4[i][0], K4[i][1]};
                    S[2 * i + 1] = S[2 * i + 1] * (f32x2){W4[i][2], W4[i][3]} + sa2 * (f32x2){B4[i][2], B4[i][3]} + vv2 * (f32x2){K4[i][2], K4[i][3]};
                }
                f32x2 y0 = {0.f, 0.f}, y1 = {0.f, 0.f};
#pragma unroll
                for (int i = 0; i < 4; ++i) { y0 += S[2 * i] * (f32x2){R4[i][0], R4[i][1]}; y1 += S[2 * i + 1] * (f32x2){R4[i][2], R4[i][3]}; }
                const float y = red4((y0[0] + y0[1]) + (y1[0] + y1[1]));
                if (kq == 0) YB[t * 64 + vrow] = y;
            }
            __syncthreads();
            {
                const f32x4 y4 = *(const f32x4*)(YB + tp * 64 + k4), v4 = *(const f32x4*)(VB + tp * 64 + k4), g4 = *(const f32x4*)(GB + tp * 64 + k4);
                const float mu = red16((y4[0] + y4[1]) + (y4[2] + y4[3])) * (1.0f / 64.0f);
                float q = 0.f;
#pragma unroll
                for (int i = 0; i < 4; ++i) { const float d = y4[i] - mu; q += d * d; }
                const float rstd = rsqrtf(red16(q) * (1.0f / 64.0f) + 64e-5f);
                const float bon = BON[tp];
                float o[4];
#pragma unroll
                for (int i = 0; i < 4; ++i) o[i] = ((y4[i] - mu) * rstd * c_lg[i] + c_lb[i] + bon * v4[i]) * g4[i];
                u32x2 w; w.x = pk2(o[0], o[1]); w.y = pk2(o[2], o[3]);
                *(u32x2*)(y16 + ((size_t)(b * 2048 + ch * 16 + tp)) * 1024 + col) = w;
            }
        }
        __syncthreads();
    }
}

__device__ __forceinline__ void dsa_norm_phase(const Params& p, int j, unsigned char* smem) {
    const int tid = opaque_tid();
    const int lane = tid & 63, wave = tid >> 6;
    const float* hin = (const float*)(p.ws + D_HIN);
    h16* cq = (h16*)(p.ws + D_CQ); h16* ckv = (h16*)(p.ws + D_CKV); h16* ckvt = (h16*)(p.ws + D_CKVT); h16* kidx = (h16*)(p.ws + D_KIDX);
    float* widx = (float*)(p.ws + D_WIDX);
    const f32x4 gq = *(const f32x4*)(p.in[23] + j * 256 + lane * 4);
    const f32x2 gkv = *(const f32x2*)(p.in[24] + j * 128 + lane * 2);
    const float gi = p.in[29][j * 64 + lane], bi = p.in[30][j * 64 + lane];
    h16* wl = (h16*)(smem + wave * 2048);
    for (int grp = blockIdx.x * 8 + wave; grp < MTOK / 8; grp += gridDim.x * 8) {
        const int r0 = grp * 8;
        for (int i = 0; i < 8; ++i) {
            const int row = r0 + i;
            const float* hp = hin + (size_t)row * 512;
            const f32x4 vq = *(const f32x4*)(hp + lane * 4);
            const f32x2 vk = *(const f32x2*)(hp + 256 + lane * 2);
            const float vi = hp[384 + lane];
            float ssq = wave_sum(vq[0] * vq[0] + vq[1] * vq[1] + vq[2] * vq[2] + vq[3] * vq[3]);
            const float rq = rsqrtf(ssq * (1.0f / 256.0f) + 1e-6f);
            u32x2 w; w.x = pk2(vq[0] * rq * gq[0], vq[1] * rq * gq[1]); w.y = pk2(vq[2] * rq * gq[2], vq[3] * rq * gq[3]);
            *(u32x2*)(cq + (size_t)row * 256 + lane * 4) = w;
            float ssk = wave_sum(vk[0] * vk[0] + vk[1] * vk[1]);
            const float rk = rsqrtf(ssk * (1.0f / 128.0f) + 1e-6f);
            const unsigned wk = pk2(vk[0] * rk * gkv[0], vk[1] * rk * gkv[1]);
            *(unsigned*)(ckv + (size_t)row * 128 + lane * 2) = wk;
            const float mu = wave_sum(vi) * (1.0f / 64.0f);
            const float dv = vi - mu;
            const float var = wave_sum(dv * dv) * (1.0f / 64.0f);
            kidx[(size_t)row * 64 + lane] = (h16)(dv * rsqrtf(var + 1e-5f) * gi + bi);
            if (lane < 8) widx[(size_t)row * 8 + lane] = hp[448 + lane] * 0.044194173824159216f;
        }
    }
}

constexpr int ROWP = 2052;
__device__ __forceinline__ unsigned fkey(float x) {
    if (x == 0.0f) x = 0.0f;
    const unsigned u = __float_as_uint(x);
    return (u & 0x80000000u) ? ~u : (u | 0x80000000u);
}
__device__ __forceinline__ void dsa_index_phase(const Params& p, unsigned char* smem) {
    const int tid = opaque_tid(), wave = tid >> 6, lane = tid & 63, r = lane & 15, q = lane >> 4;
    float* SC = (float*)smem;
    const h16* qidx = (const h16*)(p.ws + D_QIDX);
    const h16* kidx = (const h16*)(p.ws + D_KIDX);
    const float* widx = (const float*)(p.ws + D_WIDX);
    unsigned short* selout = (unsigned short*)(p.ws + D_MASK);
    for (int qi = blockIdx.x, it = 0; qi < MTOK / 16; qi += gridDim.x, ++it) {
        const int qt = (it & 1) ? ((qi & ~127) | (127 - (qi & 127))) : qi;
        const int row0 = qt * 16, b = row0 >> 11, t0 = row0 & 2047;
        const int nkt = (t0 >> 4) + 1;
        {
            h16x8 qf[8][2]; float wq[8];
#pragma unroll
            for (int h = 0; h < 8; ++h) {
#pragma unroll
                for (int kk = 0; kk < 2; ++kk) qf[h][kk] = *(const h16x8*)(qidx + (size_t)(row0 + r) * 512 + h * 64 + kk * 32 + q * 8);
                wq[h] = widx[(size_t)(row0 + r) * 8 + h];
            }
            for (int kt = wave; kt < nkt; kt += 16) {
                const bool two = (kt + 8 < nkt);
                const int s0 = kt * 16, s1 = two ? s0 + 128 : s0;
                const h16* kp = kidx + (size_t)(b * 2048 + s0 + r) * 64 + q * 8;
                const h16* kp1 = kidx + (size_t)(b * 2048 + s1 + r) * 64 + q * 8;
                const h16x8 k0 = *(const h16x8*)kp, k1 = *(const h16x8*)(kp + 32), k2 = *(const h16x8*)kp1, k3 = *(const h16x8*)(kp1 + 32);
                f32x4 sc = {0.f, 0.f, 0.f, 0.f}, sd = {0.f, 0.f, 0.f, 0.f};
#pragma unroll
                for (int h = 0; h < 8; ++h) {
                    f32x4 acc = {0.f, 0.f, 0.f, 0.f}, acd = {0.f, 0.f, 0.f, 0.f};
                    acc = __builtin_amdgcn_mfma_f32_16x16x32_f16(k0, qf[h][0], acc, 0, 0, 0);
                    acd = __builtin_amdgcn_mfma_f32_16x16x32_f16(k2, qf[h][0], acd, 0, 0, 0);
                    acc = __builtin_amdgcn_mfma_f32_16x16x32_f16(k1, qf[h][1], acc, 0, 0, 0);
                    acd = __builtin_amdgcn_mfma_f32_16x16x32_f16(k3, qf[h][1], acd, 0, 0, 0);
#pragma unroll
                    for (int jj = 0; jj < 4; ++jj) { sc[jj] += fmaxf(acc[jj], 0.f) * wq[h]; sd[jj] += fmaxf(acd[jj], 0.f) * wq[h]; }
                }
                *(f32x4*)(SC + r * ROWP + s0 + q * 4) = sc;
                if (two) *(f32x4*)(SC + r * ROWP + s1 + q * 4) = sd;
            }
        }
        __syncthreads();
        for (int qq = 0; qq < 2; ++qq) {
            const int ql = wave * 2 + qq, t = t0 + ql;
            const float* srow = SC + ql * ROWP;
            const int ni = (t >> 6) + 1;
            unsigned u[32];
#pragma unroll
            for (int i = 0; i < 32; ++i) {
                u[i] = 0u;
                if (i < ni) { const int s = i * 64 + lane; if (s <= t) u[i] = fkey(srow[s]); }
            }
            unsigned short* selrow = selout + (size_t)(row0 + ql) * 256;
            if (t < 256) {
#pragma unroll
                for (int i = 0; i < 4; ++i) { const int pp = i * 64 + lane; selrow[pp] = (unsigned short)(pp <= t ? pp : 0xFFFF); }
            } else {
                unsigned* H = (unsigned*)(smem + 16 * ROWP * 4) + wave * 256;
                unsigned prefix = 0u; int need = 256;
#pragma unroll 1
                for (int pass = 0; pass < 4; ++pass) {
                    const int shift = 24 - 8 * pass;
                    const unsigned hmask = pass == 0 ? 0u : (0xFFFFFFFFu << (shift + 8));
                    *(u32x4*)(H + lane * 4) = (u32x4){0u, 0u, 0u, 0u};
                    asm volatile("s_waitcnt lgkmcnt(0)" ::: "memory");
#pragma unroll
                    for (int i = 0; i < 32; ++i) if (i < ni) { const unsigned uu = u[i]; if (uu != 0u && (uu & hmask) == prefix) atomicAdd(H + ((uu >> shift) & 255u), 1u); }
                    asm volatile("s_waitcnt lgkmcnt(0)" ::: "memory");
                    const u32x4 hv = *(const u32x4*)(H + lane * 4);
                    const int tot = (int)(hv.x + hv.y + hv.z + hv.w);
                    int rs = tot;
                    rs += __builtin_amdgcn_update_dpp(0, rs, 0xB1, 0xF, 0xF, true);
                    rs += __builtin_amdgcn_update_dpp(0, rs, 0x4E, 0xF, 0xF, true);
                    rs += __builtin_amdgcn_update_dpp(0, rs, 0x141, 0xF, 0xF, true);
                    rs += __builtin_amdgcn_update_dpp(0, rs, 0x140, 0xF, 0xF, true);
                    int rowsel = 3, above = 0;
                    {
                        const int r3 = __builtin_amdgcn_readlane(rs, 48), r2 = __builtin_amdgcn_readlane(rs, 32), r1 = __builtin_amdgcn_readlane(rs, 16);
                        if (need > r3) { above = r3; rowsel = 2; if (need > above + r2) { above += r2; rowsel = 1; if (need > above + r1) { above += r1; rowsel = 0; } } }
                    }
                    int lsel = rowsel * 16;
                    for (int k = 15; k >= 0; --k) {
                        const int cl = __builtin_amdgcn_readlane(tot, rowsel * 16 + k);
                        if (need <= above + cl) { lsel = rowsel * 16 + k; break; }
                        above += cl;
                    }
                    const int b3 = __builtin_amdgcn_readlane((int)hv.w, lsel), b2 = __builtin_amdgcn_readlane((int)hv.z, lsel), b1 = __builtin_amdgcn_readlane((int)hv.y, lsel);
                    int bsel = 3;
                    if (need > above + b3) { above += b3; bsel = 2; if (need > above + b2) { above += b2; bsel = 1; if (need > above + b1) { above += b1; bsel = 0; } } }
                    prefix |= (unsigned)(lsel * 4 + bsel) << shift;
                    need -= above;
                }
                const unsigned T = prefix;
                int running = 0, outpos = 0;
                const unsigned long long lt = (lane == 0) ? 0ull : (~0ull >> (64 - lane));
#pragma unroll
                for (int i = 0; i < 32; ++i) {
                    if (i < ni) {
                        const unsigned long long eq = __ballot(u[i] == T);
                        const int rank = running + __popcll(eq & lt);
                        const bool sel = u[i] > T || (u[i] == T && rank < need);
                        const unsigned long long sm = __ballot(sel);
                        running += __popcll(eq);
                        if (sel) selrow[outpos + __popcll(sm & lt)] = (unsigned short)(i * 64 + lane);
                        outpos += __popcll(sm);
                    }
                }
            }
        }
        __syncthreads();
    }
}

__device__ __forceinline__ float xmax_16_32(float x) {
    const unsigned u = __builtin_bit_cast(unsigned, x);
    auto r = __builtin_amdgcn_permlane16_swap(u, u, false, false);
    float m = fmaxf(__builtin_bit_cast(float, (unsigned)r[0]), __builtin_bit_cast(float, (unsigned)r[1]));
    const unsigned u2 = __builtin_bit_cast(unsigned, m);
    auto r2 = __builtin_amdgcn_permlane32_swap(u2, u2, false, false);
    return fmaxf(__builtin_bit_cast(float, (unsigned)r2[0]), __builtin_bit_cast(float, (unsigned)r2[1]));
}
__device__ __forceinline__ float xsum_16_32(float x) {
    const unsigned u = __builtin_bit_cast(unsigned, x);
    auto r = __builtin_amdgcn_permlane16_swap(u, u, false, false);
    float m = __builtin_bit_cast(float, (unsigned)r[0]) + __builtin_bit_cast(float, (unsigned)r[1]);
    const unsigned u2 = __builtin_bit_cast(unsigned, m);
    auto r2 = __builtin_amdgcn_permlane32_swap(u2, u2, false, false);
    return __builtin_bit_cast(float, (unsigned)r2[0]) + __builtin_bit_cast(float, (unsigned)r2[1]);
}
typedef __fp16 fp16x4_t __attribute__((__vector_size__(4 * sizeof(__fp16))));
__device__ __forceinline__ unsigned off_b(unsigned row, unsigned ch) { return 256u * row + 16u * (ch ^ (((row & 3) << 2) | ((row >> 2) & 3))); }
constexpr int SA_TILE = 8192, SA_BL = 8 * 2 * SA_TILE;
static_assert(SA_BL + 16 * 132 * 4 <= LDS_BYTES, "sparse attention LDS");
__device__ __forceinline__ void dsa_attn_phase(const Params& p, int j, unsigned char* smem) {
    const int tid = opaque_tid(), wave = tid >> 6, lane = tid & 63, r = lane & 15, q = lane >> 4;
    float* BL = (float*)(smem + SA_BL);
    for (int idx = tid; idx < 16 * 129; idx += 512) {
        const int h = idx / 129, d = idx % 129;
        int bk = d;
        if (d >= 16) { bk = 16 + (int)(logf((float)d * (1.0f / 16.0f)) / 2.0794415416798357f * 16.0f); bk = bk > 31 ? 31 : bk; }
        BL[h * 132 + d] = p.in[32][bk * 16 + h] * 1.4426950408889634f;
    }
    __syncthreads();
    const h16* qabs = (const h16*)(p.ws + D_QABS);
    const h16* ckv = (const h16*)(p.ws + D_CKV);
    const unsigned short* sel = (const unsigned short*)(p.ws + D_MASK);
    h16* olatA = (h16*)(p.ws + D_HIN);
    h16* olatB = (h16*)p.out + (size_t)MTOK * 1024;
    unsigned char* tile0 = smem + wave * (2 * SA_TILE);
    const float NINF = -__builtin_inff();
    unsigned wofs[8], kofs[2][4], vofs[8][2];
#pragma unroll
    for (int i = 0; i < 8; ++i) wofs[i] = off_b(8 * q + i, r);
#pragma unroll
    for (int tt = 0; tt < 2; ++tt)
#pragma unroll
        for (int kk = 0; kk < 4; ++kk) kofs[tt][kk] = off_b(8 * (r >> 2) + 4 * tt + (r & 3), 4 * kk + q);
#pragma unroll
    for (int c = 0; c < 8; ++c)
#pragma unroll
        for (int t2 = 0; t2 < 2; ++t2) vofs[c][t2] = off_b(8 * q + 4 * t2 + (r >> 2), 2 * c + ((lane & 3) >> 1)) + 8 * (lane & 1);
    for (int row = blockIdx.x * 8 + wave; row < MTOK; row += gridDim.x * 8) {
        const int b = row >> 11, t = row & 2047;
        const int nvalid = t + 1 < 256 ? t + 1 : 256, ng = (nvalid + 31) >> 5;
        const h16* kg = ckv + (size_t)(b * 2048) * 128;
        const unsigned short* srow = sel + (size_t)row * 256;
        h16x8 qf[4];
#pragma unroll
        for (int kk = 0; kk < 4; ++kk) qf[kk] = *(const h16x8*)(qabs + (size_t)row * 2048 + r * 128 + kk * 32 + q * 8);
        f32x4 O[8];
#pragma unroll
        for (int dt = 0; dt < 8; ++dt) O[dt] = (f32x4){0.f, 0.f, 0.f, 0.f};
        float mrun = NINF, lrun = 0.f;
        u32x4 selv = *(const u32x4*)(srow + 8 * q);
        u32x4 gr[8];
#pragma unroll
        for (int i = 0; i < 8; ++i) {
            unsigned sidx = (selv[i >> 1] >> ((i & 1) * 16)) & 0xFFFFu; sidx = sidx == 0xFFFFu ? 0u : sidx;
            gr[i] = *(const u32x4*)(kg + (size_t)sidx * 128 + r * 8);
        }
        for (int g = 0; g < ng; ++g) {
            unsigned char* tile = tile0 + (g & 1) * SA_TILE;
            const u32x4 selc = selv;
#pragma unroll
            for (int i = 0; i < 8; ++i) *(u32x4*)(tile + wofs[i]) = gr[i];
            if (g + 1 < ng) {
                selv = *(const u32x4*)(srow + (g + 1) * 32 + 8 * q);
#pragma unroll
                for (int i = 0; i < 8; ++i) {
                    unsigned sidx = (selv[i >> 1] >> ((i & 1) * 16)) & 0xFFFFu; sidx = sidx == 0xFFFFu ? 0u : sidx;
                    gr[i] = *(const u32x4*)(kg + (size_t)sidx * 128 + r * 8);
                }
            }
            asm volatile("s_waitcnt lgkmcnt(0)" ::: "memory");
            f32x4 sc[2];
#pragma unroll
            for (int tt = 0; tt < 2; ++tt) {
                f32x4 acc = {0.f, 0.f, 0.f, 0.f};
#pragma unroll
                for (int kk = 0; kk < 4; ++kk) {
                    const h16x8 kf = *(const h16x8*)(tile + kofs[tt][kk]);
                    acc = __builtin_amdgcn_mfma_f32_16x16x32_f16(kf, qf[kk], acc, 0, 0, 0);
                }
                sc[tt] = acc;
            }
            float x[8]; float mx = NINF;
#pragma unroll
            for (int i = 0; i < 8; ++i) {
                const unsigned sidx = (selc[i >> 1] >> ((i & 1) * 16)) & 0xFFFFu;
                int dist = t - (int)sidx; dist = dist < 0 ? 0 : (dist > 128 ? 128 : dist);
                const float v = sc[i >> 2][i & 3] + BL[r * 132 + dist];
                const float xv = (sidx != 0xFFFFu) ? v : NINF;
                x[i] = xv; mx = fmaxf(mx, xv);
            }
            mx = xmax_16_32(mx);
            const float mnew = fmaxf(mrun, mx);
            const float mref = (mnew == NINF) ? 0.f : mnew;
            const float alpha = __builtin_amdgcn_exp2f(mrun - mref);
            mrun = mnew;
            float ps = 0.f; h16x8 pf;
#pragma unroll
            for (int i = 0; i < 8; ++i) { const float pv = __builtin_amdgcn_exp2f(x[i] - mref); ps += pv; pf[i] = (h16)pv; }
            lrun = lrun * alpha + ps;
#pragma unroll
            for (int dt = 0; dt < 8; ++dt) {
                const fp16x4_t lo = __builtin_amdgcn_ds_read_tr16_b64_v4f16((LAS fp16x4_t*)(tile + vofs[dt][0]));
                const fp16x4_t hi = __builtin_amdgcn_ds_read_tr16_b64_v4f16((LAS fp16x4_t*)(tile + vofs[dt][1]));
                const h16x4 l4 = __builtin_bit_cast(h16x4, lo), h4 = __builtin_bit_cast(h16x4, hi);
                const h16x8 vf = {l4[0], l4[1], l4[2], l4[3], h4[0], h4[1], h4[2], h4[3]};
                O[dt] *= alpha;
                O[dt] = __builtin_amdgcn_mfma_f32_16x16x32_f16(vf, pf, O[dt], 0, 0, 0);
            }
        }
        const float inv = 1.0f / xsum_16_32(lrun);
        h16* op = (row < MTOK / 2 ? olatA + (size_t)row * 2048 : olatB + (size_t)(row - MTOK / 2) * 2048) + r * 128 + q * 4;
#pragma unroll
        for (int dt = 0; dt < 8; ++dt) {
            u32x2 w; w.x = pk2(O[dt][0] * inv, O[dt][1] * inv); w.y = pk2(O[dt][2] * inv, O[dt][3] * inv);
            *(u32x2*)(op + dt * 16) = w;
        }
        asm volatile("s_waitcnt lgkmcnt(0)" ::: "memory");
    }
    __syncthreads();
}

constexpr size_t OFF_BAR = 951 * MiB;
__device__ __forceinline__ void grid_bar(unsigned* ctr, unsigned& target, unsigned nblk) {
    asm volatile("s_waitcnt vmcnt(0) lgkmcnt(0)" ::: "memory");
    __syncthreads();
    target += nblk;
    if (threadIdx.x == 0) {
        __builtin_amdgcn_fence(__ATOMIC_RELEASE, "agent");
        asm volatile("s_waitcnt vmcnt(0)" ::: "memory");
        __hip_atomic_fetch_add(ctr, 1u, __ATOMIC_RELAXED, __HIP_MEMORY_SCOPE_AGENT);
        while (__hip_atomic_load(ctr, __ATOMIC_RELAXED, __HIP_MEMORY_SCOPE_AGENT) < target) __builtin_amdgcn_s_sleep(1);
        __builtin_amdgcn_fence(__ATOMIC_ACQUIRE, "agent");
        asm volatile("s_waitcnt vmcnt(0)" ::: "memory");
    }
    __syncthreads();
}

__global__ void __launch_bounds__(512) mega_fwd(Params p) {
    extern __shared__ __attribute__((aligned(16))) unsigned char smem[];
    cg::grid_group grid = cg::this_grid();
    unsigned char* ws = p.ws;
    h16* x16 = (h16*)(ws + OFF_X16);
    unsigned* barctr = (unsigned*)(ws + OFF_BAR);
    unsigned bar_target = 0u;
    for (int ph = p.ph_lo; ph < p.ph_hi; ++ph) {
        const unsigned e = p.prog[ph];
        const int kind = e & 15, L = (e >> 4) & 3, sub = (e >> 6) & 1, j = L >> 1;
        const int nrep = 1 + (int)(e >> 7);
        for (int rep = 0; rep < nrep; ++rep) {
        if (rep) grid_bar(barctr, bar_target, gridDim.x);
        const bool isgemm = (kind == K_R1 || kind == K_R2 || kind == K_R4 || kind == K_F1 || kind == K_F3 || kind == K_D1 || kind == K_D3 || kind == K_D6);
        if (isgemm) {
            const int ngemm = (kind == K_R1) ? 2 : 1;
            for (int gi = 0; gi < ngemm; ++gi) {
            pg8::Gemm g; pg8::Epi E;
            g.M = MTOK; g.N = 1024; g.K = 1024; g.lda = 1024; g.amode = 0; g.pm0 = 0; g.A = x16; g.A2 = x16; g.Bt = x16;
            E.mode = E_RESID; E.pm0 = 0; E.j = j; E.pnoff = 0; E.fin = (L == 3 && kind == K_F3) ? 1 : 0; E.ws = ws; E.out = p.out; E.bias0 = p.in[5] + j * 1024; E.bias1 = p.in[8] + j * 1024; E.bias2 = p.in[11];
            if (kind == K_R1) {
                E.mode = E_RPROJ;
                if (gi == 0) { g.A = (const h16*)p.out; g.A2 = (const h16*)(ws + R_G16); g.Bt = w_rwkv_big(ws, j); g.N = 3072; g.amode = 2; }
                else { g.Bt = w_rwkv_l1(ws, j); g.N = 512; g.K = 2048; g.amode = 1; E.pnoff = 12; }
            } else if (kind == K_R2) {
                g.A = (const h16*)(ws + R_HACT); g.Bt = w_rwkv_l2(ws, j); g.N = (j == 0) ? 3072 : 4096; g.K = 384; g.lda = 384; E.mode = E_LORA2;
            } else if (kind == K_R4) {
                g.A = (const h16*)(ws + (j == 0 ? R_V16 : OFF_VF)); g.Bt = w_rwkv_o(ws, j);
            } else if (kind == K_F1) {
                g.Bt = w_ffn_up(ws, L); g.M = MTOK / 2; g.N = 5632; g.amode = 1; g.pm0 = sub * 128; E.mode = E_ST16;
            } else if (kind == K_F3) {
                g.A = (const h16*)(ws + F_ACT); g.Bt = w_ffn_dn(ws, L); g.M = MTOK / 2; g.K = 2816; g.lda = 2816; E.pm0 = sub * 128;
            } else if (kind == K_D1) {
                g.Bt = w_dsa_in(ws, j); g.N = 512; g.amode = 1; E.mode = E_ST32;
            } else if (kind == K_D3) {
                g.A = (const h16*)(ws + D_CQ); g.Bt = w_dsa_q(ws, j); g.N = 2560; g.K = 256; g.lda = 256; E.mode = E_QPROJ;
            } else {
                g.A = (const h16*)(ws + D_HIN); g.A2 = (const h16*)p.out + (size_t)MTOK * 1024; g.Bt = (const h16*)(ws + OFF_WOV) + (size_t)j * 2097152; g.K = 2048; g.lda = 2048; g.amode = 3;
            }
            pg8::StaticOrder S; S.init(g.M, g.N, (int)gridDim.x, (int)blockIdx.x);
#ifndef NO_GEMM
            pg8::gemm_phase((LAS unsigned char*)smem, g, S, E);
#endif
            }
        } else if (kind == K_PREP) {
#ifndef NO_PREP
            prep_phase(p, smem);
#endif
        } else if (kind == K_R0) {
            mix_phase(p, j);
        } else if (kind == K_R3) {
#ifndef NO_SCAN
            scan_phase(p, j, smem);
#endif
        } else if (kind == K_LN) {
#ifndef NO_LN
            ln_phase(p, p.in[1] + (L * 2 + sub) * 1024, p.in[2] + (L * 2 + sub) * 1024, L == 3 && sub == 1);
#endif
        } else if (kind == K_F2) {
#ifndef NO_CONV
            conv_phase(p, L);
#endif
        } else if (kind == K_D2) {
#ifndef NO_NORM
            dsa_norm_phase(p, j, smem);
#endif
        } else if (kind == K_D4) {
#ifndef NO_INDEX
            dsa_index_phase(p, smem);
#endif
        } else if (kind == K_D5) {
#ifndef NO_ATTN
            dsa_attn_phase(p, j, smem);
#endif
        }
        }
        if (ph + 1 < p.ph_hi) { if (ph == p.ph_lo) grid.sync(); else grid_bar(barctr, bar_target, gridDim.x); for (int xs = 0; xs < EXTRA_SYNC; ++xs) grid_bar(barctr, bar_target, gridDim.x); }
    }
}

extern "C" void kernel_launch(void* const* d_in, const int* in_sizes, int n_in, void* d_out, int out_size, void* d_ws, size_t ws_size, hipStream_t stream) {
    static int grid_blocks = 0;
    if (grid_blocks == 0) {
        if (n_in != 37 || ws_size < WS_NEED || out_size != MTOK * DM) { fprintf(stderr, "kernel_launch: unexpected problem (n_in %d ws %zu out %d)\n", n_in, ws_size, out_size); grid_blocks = -1; return; }
        int dev = 0, cus = 0, per_cu = 0;
        hipGetDevice(&dev);
        hipDeviceGetAttribute(&cus, hipDeviceAttributeMultiprocessorCount, dev);
        if (hipFuncSetAttribute((const void*)mega_fwd, hipFuncAttributeMaxDynamicSharedMemorySize, LDS_BYTES) != hipSuccess) { fprintf(stderr, "kernel_launch: hipFuncSetAttribute failed\n"); grid_blocks = -1; return; }
        hipOccupancyMaxActiveBlocksPerMultiprocessor(&per_cu, (const void*)mega_fwd, 512, LDS_BYTES);
        if (per_cu < 1) { fprintf(stderr, "kernel_launch: occupancy query says %d blocks/CU\n", per_cu); per_cu = 1; }
        (void)hipGetLastError();
        grid_blocks = cus * per_cu;
        fprintf(stderr, "kernel_launch: grid %d (cus %d x %d)\n", grid_blocks, cus, per_cu);
    }
    if (grid_blocks < 0) return;
    Params p{};
    for (int i = 0; i < 37; ++i) p.in[i] = (const float*)d_in[i];
    p.ws = (unsigned char*)d_ws; p.out = (float*)d_out;
    int np = 0;
    constexpr unsigned PROBE_MASK = 0u;
    auto add = [&](int kind, int L, int sub) { p.prog[np++] = (unsigned char)(kind | (L << 4) | (sub << 6) | ((((PROBE_MASK >> kind) & 1u) && !(kind == K_LN && L == 3 && sub == 1)) ? 128 : 0)); };
    add(K_PREP, 0, 0);
    for (int L = 0; L < 4; ++L) {
        if ((L & 1) == 0) { add(K_R0, L, 0); add(K_R1, L, 0); add(K_R2, L, 0); add(K_R3, L, 0); add(K_R4, L, 0); }
        else { add(K_D1, L, 0); add(K_D2, L, 0); add(K_D3, L, 0); add(K_D4, L, 0); add(K_D5, L, 0); add(K_D6, L, 0); }
        add(K_LN, L, 0);
        for (int c = 0; c < 2; ++c) { add(K_F1, L, c); add(K_F2, L, c); add(K_F3, L, c); }
        add(K_LN, L, 1);
    }
#if SINGLE_LAUNCH
    if (hipMemsetAsync((unsigned char*)d_ws + OFF_BAR, 0, 256, stream) != hipSuccess) { fprintf(stderr, "kernel_launch: memset failed\n"); return; }
    p.ph_lo = 0; p.ph_hi = np;
    void* args[] = {&p};
    hipError_t e = hipLaunchCooperativeKernel((const void*)mega_fwd, dim3(grid_blocks), dim3(512), args, LDS_BYTES, stream);
    if (e != hipSuccess) fprintf(stderr, "cooperative launch failed: %s (grid %d)\n", hipGetErrorString(e), grid_blocks);
#else
    for (int ph = 0; ph < np; ++ph) {
        p.ph_lo = ph; p.ph_hi = ph + 1;
        hipLaunchKernelGGL(mega_fwd, dim3(grid_blocks), dim3(512), LDS_BYTES, stream, p);
    }
#endif
}
```

```cpp
#include <hip/hip_runtime.h>
#include <hip/hip_cooperative_groups.h>
#include <cstdio>
namespace cg = cooperative_groups;

constexpr int EXTRA_SYNC = 0;
#ifndef SINGLE_LAUNCH
#define SINGLE_LAUNCH 1
#endif

#define LAS __attribute__((address_space(3)))
typedef _Float16 h16;
typedef _Float16 h16x8 __attribute__((ext_vector_type(8)));
typedef _Float16 h16x4 __attribute__((ext_vector_type(4)));
typedef _Float16 h16x2 __attribute__((ext_vector_type(2)));
typedef float f32x4 __attribute__((ext_vector_type(4)));
typedef float f32x2 __attribute__((ext_vector_type(2)));
typedef unsigned u32x4 __attribute__((ext_vector_type(4)));
typedef unsigned u32x2 __attribute__((ext_vector_type(2)));

constexpr int DM = 1024, SEQ = 2048, NBATCH = 32, MTOK = NBATCH * SEQ;
constexpr int DFF = 2816;
constexpr size_t MiB = (size_t)1 << 20;
constexpr float DN_ALPHA = 1.6817928305074290f;
constexpr int LDS_BYTES = 147456;

constexpr size_t OFF_W = 0;
constexpr size_t OFF_X16 = 118 * MiB;
constexpr size_t OFF_VF = 247 * MiB;
constexpr size_t OFF_R = 375 * MiB;
constexpr size_t WS_NEED = 960 * MiB;
constexpr size_t OFF_WOV = 952 * MiB;
constexpr size_t R_R16 = OFF_R, R_K16 = OFF_R + 128 * MiB, R_V16 = OFF_R + 256 * MiB, R_G16 = OFF_R + 384 * MiB, R_HACT = OFF_R + 512 * MiB;
constexpr size_t F_U16 = OFF_R, F_ACT = OFF_R + 352 * MiB;
constexpr size_t D_HIN = OFF_R, D_O16 = OFF_R, D_QABS = OFF_R + 128 * MiB, D_QIDX = OFF_R + 384 * MiB, D_CQ = OFF_R + 448 * MiB,
                 D_CKV = OFF_R + 480 * MiB, D_CKVT = OFF_R + 496 * MiB, D_KIDX = OFF_R + 512 * MiB, D_WIDX = OFF_R + 520 * MiB, D_MASK = OFF_R + 522 * MiB;

struct Params {
    const float* in[37];
    unsigned char* ws;
    float* out;
    int ph_lo, ph_hi;
    unsigned char prog[64];
};

enum { K_PREP = 0, K_R1, K_R2, K_R3, K_R4, K_LN, K_F1, K_F2, K_F3, K_D1, K_D2, K_D3, K_D4, K_D5, K_D6, K_R0 };
enum { E_RPROJ = 0, E_LORA2, E_RESID, E_ST16, E_ST32, E_QPROJ };

__device__ __forceinline__ size_t xrow(int row) { return (size_t)(row >> 11) * 2049 + 1 + (row & 2047); }
__device__ __forceinline__ unsigned pk2(float a, float b) { h16x2 h = {(h16)a, (h16)b}; return __builtin_bit_cast(unsigned, h); }
__device__ __forceinline__ u32x4 pack8(f32x4 a, f32x4 b) { u32x4 w; w.x = pk2(a[0], a[1]); w.y = pk2(a[2], a[3]); w.z = pk2(b[0], b[1]); w.w = pk2(b[2], b[3]); return w; }
__device__ __forceinline__ void unpack8(u32x4 w, float* f) {
    h16x8 h = __builtin_bit_cast(h16x8, w);
#pragma unroll
    for (int i = 0; i < 8; ++i) f[i] = (float)h[i];
}
__device__ __forceinline__ float sigmoidf_(float x) { return 1.0f / (1.0f + __expf(-x)); }
__device__ __forceinline__ float wave_sum(float v) {
#pragma unroll
    for (int o = 32; o > 0; o >>= 1) v += __shfl_xor(v, o);
    return v;
}
#define WSYNC() asm volatile("s_waitcnt vmcnt(0) lgkmcnt(0)" ::: "memory")
__device__ __forceinline__ int opaque_tid() { int t = threadIdx.x; asm volatile("" : "+v"(t)); return t; }

namespace pg8 {
constexpr int BM = 256, BK = 64, HALF = 128, HTB = HALF * BK * 2, STAGE_BYTES = 8 * HTB, NXCD = 8, WGM = 8;
__device__ __forceinline__ int lds_byte(int r, int c) { const int st = (r >> 4) * 2 + (c >> 5), rr = r & 15, cc = c & 31, ob = rr * 64 + cc * 2; return st * 1024 + (ob ^ (((ob >> 9) & 1) << 5)); }
__device__ __forceinline__ void stage_rc(int b, int& R, int& C) { const int st = b / 1024, sb = b % 1024, swz = sb ^ (((sb >> 9) & 1) << 5); R = (st >> 1) * 16 + swz / 64; C = (st & 1) * 32 + (swz % 64) / 2; }
__device__ __forceinline__ int perm32(int rho) { const int n = rho >> 4, i = rho & 15; return 8 * (i >> 2) + 4 * n + (i & 3); }
struct Unit { int pm, pn; };
struct Gemm { const h16* A; const h16* A2; const h16* Bt; int M, N, K, lda, amode, pm0; };
struct StaticOrder {
    int nM, nN, nwg, G, c;
    __device__ void init(int M, int N, int G_, int c_) { nM = M / BM; nN = N / BM; nwg = nM * nN; G = G_; c = c_; }
    __device__ bool next(int i, Unit& u) const {
        const long L = (long)i * G + c; if (L >= nwg) return false;
        int wgid = (int)L; { const int q = nwg / NXCD, r = nwg % NXCD, xcd = wgid % NXCD, off = wgid / NXCD; wgid = (xcd < r ? xcd * (q + 1) : r * (q + 1) + (xcd - r) * q) + off; }
        const int nig = WGM * nN, gid = wgid / nig, fm = gid * WGM, gsz = (nM - fm) < WGM ? (nM - fm) : WGM;
        u.pm = fm + ((wgid % nig) % gsz); u.pn = (wgid % nig) / gsz; return true;
    }
};

struct Epi {
    int mode, pm0, j, pnoff, fin;
    unsigned char* ws; float* out; const float* bias0; const float* bias1; const float* bias2;
    __device__ __forceinline__ void operator()(const f32x4 (&acc)[2][2][4][2], const Unit& u, int wr, int wc, int fr, int fq) const {
        const int rowl0 = u.pm * BM + wr * 64 + fr;
        const int colt = u.pn * BM + wc * 32 + 8 * fq;
        if (mode == E_RESID) {
            u32x4 xr[2][4][2];
#pragma unroll
            for (int ai = 0; ai < 2; ++ai)
#pragma unroll
                for (int m = 0; m < 4; ++m) {
                    const int rowg = rowl0 + ai * HALF + m * 16 + pm0 * BM;
                    const h16* xp = (const h16*)(ws + OFF_X16) + xrow(rowg) * 1024 + colt;
#pragma unroll
                    for (int bj = 0; bj < 2; ++bj) xr[ai][m][bj] = *(const u32x4*)(xp + bj * HALF);
                }
#pragma unroll
            for (int ai = 0; ai < 2; ++ai)
#pragma unroll
                for (int m = 0; m < 4; ++m) {
                    const int rowg = rowl0 + ai * HALF + m * 16 + pm0 * BM;
                    float* dp0 = out + (size_t)rowg * 1024 + colt;
                    h16* hp0 = (h16*)out + (size_t)rowg * 1024 + colt;
#pragma unroll
                    for (int bj = 0; bj < 2; ++bj) {
                        float xf[8]; unpack8(xr[ai][m][bj], xf);
                        const f32x4 v0 = acc[ai][bj][m][0], v1 = acc[ai][bj][m][1];
                        f32x4 r0, r1;
#pragma unroll
                        for (int jj = 0; jj < 4; ++jj) { r0[jj] = DN_ALPHA * xf[jj] + v0[jj]; r1[jj] = DN_ALPHA * xf[4 + jj] + v1[jj]; }
                        if (fin) { float* dp = dp0 + bj * HALF; *(f32x4*)dp = r0; *(f32x4*)(dp + 4) = r1; }
                        else *(u32x4*)(hp0 + bj * HALF) = pack8(r0, r1);
                    }
                }
            return;
        }
        if (mode == E_LORA2 && (u.pn >> 2) == 3) {
            const int c0 = colt & 1023;
#pragma unroll
            for (int ai = 0; ai < 2; ++ai) {
                u32x4 lv[4][2], lf[4][2];
#pragma unroll
                for (int m = 0; m < 4; ++m) {
                    const size_t off = (size_t)(rowl0 + ai * HALF + m * 16 + pm0 * BM) * 1024 + c0;
#pragma unroll
                    for (int bj = 0; bj < 2; ++bj) { lv[m][bj] = *(const u32x4*)((const h16*)(ws + R_V16) + off + bj * HALF); lf[m][bj] = *(const u32x4*)((const h16*)(ws + OFF_VF) + off + bj * HALF); }
                }
#pragma unroll
                for (int m = 0; m < 4; ++m) {
                    const size_t off = (size_t)(rowl0 + ai * HALF + m * 16 + pm0 * BM) * 1024 + c0;
#pragma unroll
                    for (int bj = 0; bj < 2; ++bj) {
                        const int c = c0 + bj * HALF;
                        const f32x4 ba = *(const f32x4*)(bias2 + c), bb = *(const f32x4*)(bias2 + c + 4);
                        float vv[8], vf8[8]; unpack8(lv[m][bj], vv); unpack8(lf[m][bj], vf8);
                        f32x4 v0 = acc[ai][bj][m][0], v1 = acc[ai][bj][m][1];
#pragma unroll
                        for (int jj = 0; jj < 4; ++jj) {
                            v0[jj] = vv[jj] + (vf8[jj] - vv[jj]) * sigmoidf_(v0[jj] + ba[jj]);
                            v1[jj] = vv[4 + jj] + (vf8[4 + jj] - vv[4 + jj]) * sigmoidf_(v1[jj] + bb[jj]);
                        }
                        *(u32x4*)((h16*)(ws + R_V16) + off + bj * HALF) = pack8(v0, v1);
                    }
                }
            }
            return;
        }
#pragma unroll
        for (int ai = 0; ai < 2; ++ai)
#pragma unroll
            for (int m = 0; m < 4; ++m) {
                const int rowl = rowl0 + ai * HALF + m * 16;
                const int rowg = rowl + pm0 * BM;
#pragma unroll
                for (int bj = 0; bj < 2; ++bj) {
                    const int col = colt + bj * HALF;
                    f32x4 v0 = acc[ai][bj][m][0], v1 = acc[ai][bj][m][1];
                    if (mode == E_RPROJ) {
                        if (pnoff == 0) {
                            h16* dst = (h16*)(ws + (u.pn < 4 ? R_R16 : (u.pn < 8 ? R_K16 : (j == 0 ? OFF_VF : R_V16))));
                            *(u32x4*)(dst + (size_t)rowg * 1024 + (col & 1023)) = pack8(v0, v1);
                        } else if (col < 384) {
                            const int hc = col;
                            if (hc < 64) {
#pragma unroll
                                for (int jj = 0; jj < 4; ++jj) { v0[jj] = tanhf(v0[jj]); v1[jj] = tanhf(v1[jj]); }
                            } else if (hc >= 160) {
#pragma unroll
                                for (int jj = 0; jj < 4; ++jj) { v0[jj] = sigmoidf_(v0[jj]); v1[jj] = sigmoidf_(v1[jj]); }
                            }
                            *(u32x4*)((h16*)(ws + R_HACT) + (size_t)rowg * 384 + hc) = pack8(v0, v1);
                        }
                    } else if (mode == E_LORA2) {
                        const int grp = u.pn >> 2, c = col & 1023;
                        const size_t off = (size_t)rowg * 1024 + c;
                        if (grp == 0) {
                            const f32x4 ba = *(const f32x4*)(bias0 + c), bb = *(const f32x4*)(bias0 + c + 4);
#pragma unroll
                            for (int jj = 0; jj < 4; ++jj) { v0[jj] = sigmoidf_(v0[jj] + ba[jj]) * 0.6065306597f; v1[jj] = sigmoidf_(v1[jj] + bb[jj]) * 0.6065306597f; }
                            *(u32x4*)((h16*)out + off) = pack8(v0, v1);
                        } else if (grp == 1) {
                            const f32x4 ba = *(const f32x4*)(bias1 + c), bb = *(const f32x4*)(bias1 + c + 4);
#pragma unroll
                            for (int jj = 0; jj < 4; ++jj) { v0[jj] = sigmoidf_(v0[jj] + ba[jj]); v1[jj] = sigmoidf_(v1[jj] + bb[jj]); }
                            *(u32x4*)((h16*)out + (size_t)MTOK * 1024 + off) = pack8(v0, v1);
                        } else {
                            *(u32x4*)((h16*)(ws + R_G16) + off) = pack8(v0, v1);
                        }
                    } else if (mode == E_ST16) {
                        *(u32x4*)((h16*)(ws + F_U16) + (size_t)rowl * 5632 + col) = pack8(v0, v1);
                    } else if (mode == E_ST32) {
                        float* dp = (float*)(ws + D_HIN) + (size_t)rowg * 512 + col;
                        *(f32x4*)dp = v0; *(f32x4*)(dp + 4) = v1;
                    } else {
                        if (u.pn < 8) *(u32x4*)((h16*)(ws + D_QABS) + (size_t)rowg * 2048 + col) = pack8(v0, v1);
                        else *(u32x4*)((h16*)(ws + D_QIDX) + (size_t)rowg * 512 + (col - 2048)) = pack8(v0, v1);
                    }
                }
            }
    }
};

__device__ __forceinline__ const char* a_tile(const Gemm& g, int pm, int pn) {
    if (g.amode == 1) { const int row = (pm + g.pm0) * BM; return (const char*)g.A + xrow(row) * 2048; }
    if (g.amode == 2) {
        const int gq = pn >> 2;
        const char* base = gq == 2 ? (const char*)g.A2 : (const char*)g.A + (size_t)gq * ((size_t)MTOK * 1024 * 2);
        return base + (size_t)pm * BM * 2048;
    }
    if (g.amode == 3) return (pm < 128 ? (const char*)g.A + (size_t)pm * BM * 4096 : (const char*)g.A2 + (size_t)(pm - 128) * BM * 4096);
    return (const char*)g.A + (size_t)pm * BM * g.lda * 2;
}

__device__ __forceinline__ void gemm_phase(LAS unsigned char* lds, const Gemm g, const StaticOrder& S, const Epi& E) {
    const int tid = opaque_tid(), wid = __builtin_amdgcn_readfirstlane(tid >> 6), lane = tid & 63, wr = wid >> 2, wc = wid & 3, fr = lane & 15, fq = lane >> 4;
    const int K = g.K, nt = K / BK;
    const bool shiftA = (g.amode == 1);
    unsigned voffA[2], voffB[2];
#pragma unroll
    for (int i = 0; i < 2; ++i) { int R, C; stage_rc(tid * 16 + i * 8192, R, C); const int Rb = (R & ~31) + perm32(R & 31);
        voffA[i] = (unsigned)(R * g.lda + C) * 2u; voffB[i] = (unsigned)(Rb * K + C) * 2u; }
    const size_t kstep = (size_t)(BK * 2);
    const size_t hstepA = (size_t)HALF * g.lda * 2;
    const size_t hstepB = (size_t)HALF * K * 2;
    const size_t tstepB = 2 * hstepB;
    const unsigned ldsw = (unsigned)wid * 1024u;
    const int aoff = lds_byte(wr * 64 + fr, fq * 8), boff = lds_byte(wc * 32 + fr, fq * 8);
#define PG8_KOFF(kt) ((size_t)(kt) * kstep - ((shiftA && (kt) >= 16) ? (size_t)4096 : (size_t)0))
#define PG8_SA(b, h) (((b) * 2 + (h)) * HTB)
#define PG8_SB(b, h) ((4 + (b) * 2 + (h)) * HTB)
#define PG8_STAGE(bufoff, gbase, voff) do { _Pragma("unroll") for (int _i = 0; _i < 2; ++_i) \
        __builtin_amdgcn_global_load_lds((const unsigned*)((const char*)(gbase) + (voff)[_i]), (LAS unsigned*)(lds + (bufoff) + ldsw + _i * 8192), 16, 0, 0); } while (0)
#define PG8_LDA(dst, b, h) do { _Pragma("unroll") for (int m = 0; m < 4; ++m) _Pragma("unroll") for (int k = 0; k < 2; ++k) dst[m][k] = *(const LAS h16x8*)(lds + PG8_SA(b, h) + aoff + m * 2048 + k * 1024); } while (0)
#define PG8_LDB(dst, b, h) do { _Pragma("unroll") for (int n = 0; n < 2; ++n) _Pragma("unroll") for (int k = 0; k < 2; ++k) dst[n][k] = *(const LAS h16x8*)(lds + PG8_SB(b, h) + boff + n * 2048 + k * 1024); } while (0)
#define PG8_MMA(ai, bj, At, Bt) do { __builtin_amdgcn_s_setprio(1); _Pragma("unroll") for (int m = 0; m < 4; ++m) _Pragma("unroll") for (int n = 0; n < 2; ++n) _Pragma("unroll") for (int k = 0; k < 2; ++k) \
        acc[ai][bj][m][n] = __builtin_amdgcn_mfma_f32_16x16x32_f16(Bt[n][k], At[m][k], acc[ai][bj][m][n], 0, 0, 0); __builtin_amdgcn_s_setprio(0); } while (0)
#define PG8_WAIT_V(n) asm volatile("s_waitcnt vmcnt(" #n ")" ::: "memory")
#define PG8_WAIT_L(n) asm volatile("s_waitcnt lgkmcnt(" #n ")" ::: "memory")
#define PG8_BAR __builtin_amdgcn_s_barrier()
#define PG8_SCHED __builtin_amdgcn_sched_barrier(0)
    Unit cur, nxt; int ui = 0;
    if (!S.next(0, cur)) return;
    f32x4 acc[2][2][4][2];
#pragma unroll
    for (int a = 0; a < 2; ++a)
#pragma unroll
        for (int b = 0; b < 2; ++b)
#pragma unroll
            for (int m = 0; m < 4; ++m)
#pragma unroll
                for (int n = 0; n < 2; ++n) acc[a][b][m][n] = (f32x4){0.f, 0.f, 0.f, 0.f};
    h16x8 At[4][2], B0[2][2], B1[2][2];
    const char* cA = a_tile(g, cur.pm, cur.pn); const char* cB = (const char*)g.Bt + (size_t)cur.pn * tstepB;
    PG8_STAGE(PG8_SB(0, 0), cB, voffB); PG8_STAGE(PG8_SA(0, 0), cA, voffA); PG8_STAGE(PG8_SB(0, 1), cB + hstepB, voffB); PG8_STAGE(PG8_SA(0, 1), cA + hstepA, voffA);
    if (wr == 1) PG8_BAR;
    PG8_WAIT_V(4); PG8_BAR;
    PG8_STAGE(PG8_SB(1, 0), cB + kstep, voffB); PG8_STAGE(PG8_SA(1, 0), cA + kstep, voffA); PG8_STAGE(PG8_SB(1, 1), cB + hstepB + kstep, voffB);
    PG8_WAIT_V(6); PG8_BAR;
    for (;;) {
        const bool has_next = S.next(ui + 1, nxt);
        const char* nA = has_next ? a_tile(g, nxt.pm, nxt.pn) : cA; const char* nB = has_next ? (const char*)g.Bt + (size_t)nxt.pn * tstepB : cB;
        for (int t = 0; t < nt; t += 2) {
            const bool last = (t == nt - 2);
            const char* a1 = cA + PG8_KOFF(t + 1);
            const char* a2 = last ? nA : cA + PG8_KOFF(t + 2); const char* b2 = last ? nB : cB + (size_t)(t + 2) * kstep;
            const char* a3 = a2 + kstep; const char* b3 = b2 + kstep;
            PG8_LDB(B0, 0, 0); PG8_SCHED; PG8_LDA(At, 0, 0); PG8_STAGE(PG8_SA(1, 1), a1 + hstepA, voffA);
            PG8_WAIT_L(8); PG8_BAR; PG8_WAIT_L(0); PG8_MMA(0, 0, At, B0); PG8_BAR; PG8_SCHED;
            PG8_LDB(B1, 0, 1); PG8_STAGE(PG8_SB(0, 0), b2, voffB);
            PG8_BAR; PG8_WAIT_L(0); PG8_MMA(0, 1, At, B1); PG8_BAR;
            PG8_LDA(At, 0, 1); PG8_STAGE(PG8_SA(0, 0), a2, voffA);
            PG8_BAR; PG8_WAIT_L(0); PG8_MMA(1, 0, At, B0); PG8_BAR; PG8_SCHED;
            PG8_STAGE(PG8_SB(0, 1), b2 + hstepB, voffB);
            PG8_WAIT_V(6); PG8_BAR; PG8_MMA(1, 1, At, B1); PG8_BAR;
            PG8_LDB(B0, 1, 0); PG8_SCHED; PG8_LDA(At, 1, 0); PG8_STAGE(PG8_SA(0, 1), a2 + hstepA, voffA);
            PG8_WAIT_L(8); PG8_BAR; PG8_WAIT_L(0); PG8_MMA(0, 0, At, B0); PG8_BAR; PG8_SCHED;
            PG8_LDB(B1, 1, 1); PG8_STAGE(PG8_SB(1, 0), b3, voffB);
            PG8_BAR; PG8_WAIT_L(0); PG8_MMA(0, 1, At, B1); PG8_BAR;
            PG8_LDA(At, 1, 1); PG8_STAGE(PG8_SA(1, 0), a3, voffA);
            PG8_BAR; PG8_WAIT_L(0); PG8_MMA(1, 0, At, B0); PG8_BAR; PG8_SCHED;
            PG8_STAGE(PG8_SB(1, 1), b3 + hstepB, voffB);
            PG8_WAIT_V(6); PG8_BAR; PG8_MMA(1, 1, At, B1); PG8_BAR;
        }
        E(acc, cur, wr, wc, fr, fq);
        if (!has_next) break;
#pragma unroll
        for (int a = 0; a < 2; ++a)
#pragma unroll
            for (int b = 0; b < 2; ++b)
#pragma unroll
                for (int m = 0; m < 4; ++m)
#pragma unroll
                    for (int n = 0; n < 2; ++n) acc[a][b][m][n] = (f32x4){0.f, 0.f, 0.f, 0.f};
        cur = nxt; cA = nA; cB = nB; ++ui;
    }
    PG8_WAIT_V(0);
    if (wr == 0) PG8_BAR;
    PG8_BAR;
#undef PG8_KOFF
#undef PG8_SA
#undef PG8_SB
#undef PG8_STAGE
#undef PG8_LDA
#undef PG8_LDB
#undef PG8_MMA
#undef PG8_WAIT_V
#undef PG8_WAIT_L
#undef PG8_BAR
#undef PG8_SCHED
}
}

struct TJob { int mode; const float* src; int ld, K, N; h16* dst; int ldd, koff; const float* mix; };

__device__ __forceinline__ TJob get_job(const Params& p, int id) {
    TJob J; J.mode = 0; J.src = nullptr; J.ld = 0; J.K = 0; J.N = 0; J.dst = nullptr; J.ldd = 64; J.koff = 0; J.mix = nullptr;
    h16* W = (h16*)(p.ws + OFF_W);
    if (id < 24) {
        const int j = id / 12, s = id % 12;
        h16* Wrkv = W + (size_t)j * (10 * MiB); h16* Wl1 = Wrkv + 3 * MiB; h16* Wl2 = Wrkv + 7 * MiB;
        const float* mix = p.in[3] + j * 6 * 1024;
        if (s < 3) { J.mode = 0; J.src = p.in[4] + (size_t)(j * 3 + s) * 1048576; J.ld = 1024; J.K = 1024; J.N = 1024; J.dst = Wrkv + (size_t)s * 1024 * 1024; J.ldd = 1024; }
        else if (s < 8) {
            J.mode = 1; J.ld = 1024; J.K = 1024; J.ldd = 2048;
            if (s == 3) { J.src = p.in[6] + (size_t)j * 65536; J.ld = 64; J.N = 64; J.dst = Wl1; J.mix = mix + 3 * 1024; }
            else if (s == 4) { J.src = p.in[9] + (size_t)j * 65536; J.ld = 64; J.N = 64; J.dst = Wl1 + (size_t)64 * 2048; J.mix = mix + 4 * 1024; }
            else if (s == 5) { J.N = 32; J.dst = Wl1 + (size_t)128 * 2048; if (j == 1) { J.src = p.in[12]; J.ld = 32; J.mix = mix + 2 * 1024; } else { J.mode = 2; } }
            else if (s == 6) { J.src = p.in[14] + (size_t)j * 163840; J.ld = 160; J.N = 160; J.dst = Wl1 + (size_t)160 * 2048; J.mix = mix + 5 * 1024; }
            else { J.mode = 2; J.N = 192; J.dst = Wl1 + (size_t)320 * 2048; }
        } else {
            J.mode = 0; J.ld = 1024; J.N = 1024; J.ldd = 384;
            if (s == 8) { J.src = p.in[7] + (size_t)j * 65536; J.K = 64; J.koff = 0; J.dst = Wl2; }
            else if (s == 9) { J.src = p.in[10] + (size_t)j * 65536; J.K = 64; J.koff = 64; J.dst = Wl2 + (size_t)1024 * 384; }
            else if (s == 10) { J.src = p.in[15] + (size_t)j * 163840; J.K = 160; J.koff = 160; J.dst = Wl2 + (size_t)2048 * 384; }
            else { J.src = p.in[13]; J.K = 32; J.koff = 128; J.dst = Wl2 + (size_t)3072 * 384; if (j == 0) J.N = 0; }
        }
    } else if (id < 26) {
        const int j = id - 24;
        J.src = p.in[21] + (size_t)j * 1048576; J.ld = 1024; J.K = 1024; J.N = 1024; J.dst = W + (size_t)j * (10 * MiB) + 9 * MiB; J.ldd = 1024;
    } else if (id < 34) {
        const int i = (id - 26) >> 1, s = (id - 26) & 1;
        h16* base = W + 20 * MiB + (size_t)i * (17 * MiB / 2);
        if (s == 0) { J.src = p.in[33] + (size_t)i * 1024 * 5632; J.ld = 5632; J.K = 1024; J.N = 5632; J.dst = base; J.ldd = 1024; }
        else { J.src = p.in[36] + (size_t)i * 2816 * 1024; J.ld = 1024; J.K = 2816; J.N = 1024; J.dst = base + (size_t)11 * MiB / 2; J.ldd = 2816; }
    } else {
        const int j = (id - 34) >> 2, s = (id - 34) & 3;
        h16* base = W + 54 * MiB + (size_t)j * (5 * MiB / 2);
        if (s == 0) { J.src = p.in[22] + (size_t)j * 1024 * 456; J.ld = 456; J.K = 1024; J.N = 456; J.dst = base; J.ldd = 1024; }
        else if (s == 1) { J.mode = 2; J.N = 56; J.dst = base + (size_t)456 * 1024; J.ldd = 1024; }
        else if (s == 2) { J.src = p.in[28] + (size_t)j * 256 * 512; J.ld = 512; J.K = 256; J.N = 512; J.dst = base + MiB / 2 + (size_t)2048 * 256; J.ldd = 256; }
        else { J.src = p.in[31] + (size_t)j * 1048576; J.ld = 1024; J.K = 1024; J.N = 1024; J.dst = base + 3 * MiB / 2; J.ldd = 1024; }
    }
    return J;
}
__device__ __forceinline__ h16* w_rwkv_big(unsigned char* ws, int j) { return (h16*)(ws + OFF_W) + (size_t)j * (10 * MiB); }
__device__ __forceinline__ h16* w_rwkv_l1(unsigned char* ws, int j) { return w_rwkv_big(ws, j) + 3 * MiB; }
__device__ __forceinline__ h16* w_rwkv_l2(unsigned char* ws, int j) { return w_rwkv_big(ws, j) + 7 * MiB; }
__device__ __forceinline__ h16* w_rwkv_o(unsigned char* ws, int j) { return w_rwkv_big(ws, j) + 9 * MiB; }
__device__ __forceinline__ h16* w_ffn_up(unsigned char* ws, int i) { return (h16*)(ws + OFF_W) + 20 * MiB + (size_t)i * (17 * MiB / 2); }
__device__ __forceinline__ h16* w_ffn_dn(unsigned char* ws, int i) { return w_ffn_up(ws, i) + (size_t)11 * MiB / 2; }
__device__ __forceinline__ h16* w_dsa_in(unsigned char* ws, int j) { return (h16*)(ws + OFF_W) + 54 * MiB + (size_t)j * (5 * MiB / 2); }
__device__ __forceinline__ h16* w_dsa_q(unsigned char* ws, int j) { return w_dsa_in(ws, j) + MiB / 2; }
__device__ __forceinline__ h16* w_dsa_uvt(unsigned char* ws, int j) { return w_dsa_in(ws, j) + 5 * MiB / 4; }
__device__ __forceinline__ h16* w_dsa_o(unsigned char* ws, int j) { return w_dsa_in(ws, j) + 3 * MiB / 2; }

__device__ __forceinline__ void prep_phase(const Params& p, unsigned char* smem) {
    const int tid = opaque_tid();
    const size_t gtid = (size_t)blockIdx.x * 512 + tid, nth = (size_t)gridDim.x * 512;
    h16* x16 = (h16*)(p.ws + OFF_X16);
    for (size_t idx = gtid; idx < (size_t)MTOK * 128; idx += nth) {
        const int row = (int)(idx >> 7), c8 = (int)(idx & 127) * 8;
        const float* sp = p.in[0] + (size_t)row * 1024 + c8;
        const f32x4 a = *(const f32x4*)sp, b = *(const f32x4*)(sp + 4);
        *(u32x4*)(x16 + xrow(row) * 1024 + c8) = pack8(a, b);
    }
    for (size_t idx = gtid; idx < (size_t)NBATCH * 128; idx += nth) {
        const int b = (int)(idx >> 7), c8 = (int)(idx & 127) * 8;
        unsigned z = 0u; asm volatile("" : "+v"(z));
        *(u32x4*)(x16 + (size_t)b * 2049 * 1024 + c8) = (u32x4){z, z, z, z};
    }
    for (size_t it = gtid; it < (size_t)2 * 16 * 2048; it += nth) {
        const int j = (int)(it >> 15), rem = (int)(it & 32767), qg = rem >> 11, n = rem & 2047, h = n >> 7, c = n & 127;
        const float* uq = p.in[25] + (size_t)j * 256 * 1024 + (size_t)(qg * 16) * 1024 + h * 64;
        const float* uk = p.in[26] + (size_t)j * 16 * 64 * 128 + (size_t)h * 64 * 128 + c;
        float acc[16];
#pragma unroll
        for (int i = 0; i < 16; ++i) acc[i] = 0.f;
        for (int d = 0; d < 64; ++d) {
            const float kv = uk[d * 128];
#pragma unroll
            for (int i = 0; i < 16; ++i) acc[i] += uq[i * 1024 + d] * kv;
        }
        const float sc = 0.18033688011112042f;
        h16* dst = w_dsa_q(p.ws, j) + (size_t)n * 256 + qg * 16;
        *(u32x4*)dst = pack8((f32x4){acc[0] * sc, acc[1] * sc, acc[2] * sc, acc[3] * sc}, (f32x4){acc[4] * sc, acc[5] * sc, acc[6] * sc, acc[7] * sc});
        *(u32x4*)(dst + 8) = pack8((f32x4){acc[8] * sc, acc[9] * sc, acc[10] * sc, acc[11] * sc}, (f32x4){acc[12] * sc, acc[13] * sc, acc[14] * sc, acc[15] * sc});
    }
    for (size_t it = gtid; it < (size_t)2 * 128 * 1024; it += nth) {
        const int j = (int)(it >> 17), rem = (int)(it & 131071), kg = rem >> 10, n = rem & 1023, h = kg >> 3, c0 = (kg & 7) * 16;
        const float* uv = p.in[27] + (size_t)((j * 16 + h) * 128 + c0) * 64;
        const float* wo = p.in[31] + (size_t)j * 1048576 + (size_t)(h * 64) * 1024 + n;
        float acc[16];
#pragma unroll
        for (int i = 0; i < 16; ++i) acc[i] = 0.f;
        for (int v = 0; v < 64; ++v) {
            const float wv = wo[(size_t)v * 1024];
#pragma unroll
            for (int i = 0; i < 16; ++i) acc[i] += uv[i * 64 + v] * wv;
        }
        h16* dst = (h16*)(p.ws + OFF_WOV) + (size_t)j * 2097152 + (size_t)n * 2048 + h * 128 + c0;
        *(u32x4*)dst = pack8((f32x4){acc[0], acc[1], acc[2], acc[3]}, (f32x4){acc[4], acc[5], acc[6], acc[7]});
        *(u32x4*)(dst + 8) = pack8((f32x4){acc[8], acc[9], acc[10], acc[11]}, (f32x4){acc[12], acc[13], acc[14], acc[15]});
    }
    float* tile = (float*)smem;
    for (int id = 0; id < 42; ++id) {
        const TJob J = get_job(p, id);
        const int tk = J.ldd >> 6, tn = (J.N + 63) >> 6, ntile = tk * tn;
        for (int tix = blockIdx.x; tix < ntile; tix += gridDim.x) {
            const int k0 = (tix % tk) * 64, n0 = (tix / tk) * 64;
#pragma unroll
            for (int i = 0; i < 8; ++i) {
                const int k = i * 8 + (tid >> 6), n = tid & 63, kk = k0 + k, nn = n0 + n;
                float v = 0.f;
                if (nn < J.N && J.mode != 2) {
                    if (J.mode == 1) { const int ks = kk & 1023; const float mx = J.mix[ks]; v = J.src[(size_t)ks * J.ld + nn] * (kk < 1024 ? 1.0f - mx : mx); }
                    else if (kk >= J.koff && kk < J.koff + J.K) v = J.src[(size_t)(kk - J.koff) * J.ld + nn];
                }
                tile[k * 65 + n] = v;
            }
            __syncthreads();
#pragma unroll
            for (int i = 0; i < 8; ++i) {
                const int n = i * 8 + (tid >> 6), k = tid & 63, nn = n0 + n;
                if (nn < J.N) J.dst[(size_t)nn * J.ldd + k0 + k] = (h16)tile[k * 65 + n];
            }
            __syncthreads();
        }
    }
}

__device__ __forceinline__ void wave_sum4(float (&v)[4]) {
#pragma unroll
    for (int o = 32; o > 0; o >>= 1) {
        float t[4];
#pragma unroll
        for (int k = 0; k < 4; ++k) t[k] = __shfl_xor(v[k], o);
#pragma unroll
        for (int k = 0; k < 4; ++k) v[k] += t[k];
    }
}
__device__ __forceinline__ void ln_phase(const Params& p, const float* g, const float* b, bool final_out) {
    const int tid = opaque_tid();
    const int lane = tid & 63, wave = tid >> 6;
    float* tb = p.out;
    h16* x16 = (h16*)(p.ws + OFF_X16);
    f32x4 gg[4], bb[4];
#pragma unroll
    for (int i = 0; i < 4; ++i) { gg[i] = *(const f32x4*)(g + i * 256 + lane * 4); bb[i] = *(const f32x4*)(b + i * 256 + lane * 4); }
    for (int rowb = (blockIdx.x * 8 + wave) * 4; rowb < MTOK; rowb += gridDim.x * 32) {
        f32x4 v[4][4];
        float s[4];
#pragma unroll
        for (int k = 0; k < 4; ++k) {
            s[k] = 0.f;
            if (final_out) {
                const float* rp = tb + (size_t)(rowb + k) * 1024;
#pragma unroll
                for (int i = 0; i < 4; ++i) v[k][i] = *(const f32x4*)(rp + i * 256 + lane * 4);
            } else {
                const h16* hp = (const h16*)tb + (size_t)(rowb + k) * 1024;
#pragma unroll
                for (int i = 0; i < 4; ++i) { const h16x4 hv = *(const h16x4*)(hp + i * 256 + lane * 4); v[k][i] = (f32x4){(float)hv[0], (float)hv[1], (float)hv[2], (float)hv[3]}; }
            }
#pragma unroll
            for (int i = 0; i < 4; ++i) s[k] += (v[k][i][0] + v[k][i][1]) + (v[k][i][2] + v[k][i][3]);
        }
        wave_sum4(s);
        float q[4];
#pragma unroll
        for (int k = 0; k < 4; ++k) {
            s[k] *= (1.0f / 1024.0f); q[k] = 0.f;
#pragma unroll
            for (int i = 0; i < 4; ++i)
#pragma unroll
                for (int jj = 0; jj < 4; ++jj) { const float d = v[k][i][jj] - s[k]; q[k] += d * d; }
        }
        wave_sum4(q);
#pragma unroll
        for (int k = 0; k < 4; ++k) {
            const float rstd = rsqrtf(q[k] * (1.0f / 1024.0f) + 1e-5f);
            const int row = rowb + k;
#pragma unroll
            for (int i = 0; i < 4; ++i) {
                f32x4 y;
#pragma unroll
                for (int jj = 0; jj < 4; ++jj) y[jj] = (v[k][i][jj] - s[k]) * rstd * gg[i][jj] + bb[i][jj];
                if (final_out) *(f32x4*)(tb + (size_t)row * 1024 + i * 256 + lane * 4) = y;
                else { u32x2 w; w.x = pk2(y[0], y[1]); w.y = pk2(y[2], y[3]); *(u32x2*)(x16 + xrow(row) * 1024 + i * 256 + lane * 4) = w; }
            }
        }
    }
}

__device__ __forceinline__ void conv_phase(const Params& p, int layer) {
    const h16* u = (const h16*)(p.ws + F_U16);
    h16* act = (h16*)(p.ws + F_ACT);
    const float* cw = p.in[34] + (size_t)layer * 3 * 5632;
    const float* cb = p.in[35] + (size_t)layer * 5632;
    const size_t gtid = (size_t)blockIdx.x * 512 + opaque_tid(), nth = (size_t)gridDim.x * 512;
    const size_t ntask = (size_t)2048 * 352;
    for (size_t task = gtid; task < ntask; task += nth) {
        const int cgp = (int)(task % 352), rc = (int)(task / 352), f = cgp * 8, r0 = rc * 16;
        float wg[3][8], wv[3][8], bg[8], bv[8];
#pragma unroll
        for (int jj = 0; jj < 3; ++jj)
#pragma unroll
            for (int hlf = 0; hlf < 2; ++hlf) {
                const f32x4 a = *(const f32x4*)(cw + jj * 5632 + f + hlf * 4), c = *(const f32x4*)(cw + jj * 5632 + DFF + f + hlf * 4);
#pragma unroll
                for (int e = 0; e < 4; ++e) { wg[jj][hlf * 4 + e] = a[e]; wv[jj][hlf * 4 + e] = c[e]; }
            }
#pragma unroll
        for (int hlf = 0; hlf < 2; ++hlf) {
            const f32x4 a = *(const f32x4*)(cb + f + hlf * 4), c = *(const f32x4*)(cb + DFF + f + hlf * 4);
#pragma unroll
            for (int e = 0; e < 4; ++e) { bg[hlf * 4 + e] = a[e]; bv[hlf * 4 + e] = c[e]; }
        }
        float g2[8], g1[8], v2[8], v1[8];
#pragma unroll
        for (int e = 0; e < 8; ++e) { g2[e] = 0.f; g1[e] = 0.f; v2[e] = 0.f; v1[e] = 0.f; }
        if ((r0 & 2047) != 0) {
            unpack8(*(const u32x4*)(u + (size_t)(r0 - 2) * 5632 + f), g2); unpack8(*(const u32x4*)(u + (size_t)(r0 - 1) * 5632 + f), g1);
            unpack8(*(const u32x4*)(u + (size_t)(r0 - 2) * 5632 + DFF + f), v2); unpack8(*(const u32x4*)(u + (size_t)(r0 - 1) * 5632 + DFF + f), v1);
        }
#pragma unroll 1
        for (int i0 = 0; i0 < 16; i0 += 4) {
            u32x4 lg[4], lv[4];
#pragma unroll
            for (int i = 0; i < 4; ++i) { const size_t ro = (size_t)(r0 + i0 + i) * 5632; lg[i] = *(const u32x4*)(u + ro + f); lv[i] = *(const u32x4*)(u + ro + DFF + f); }
#pragma unroll
            for (int i = 0; i < 4; ++i) {
                float g0[8], v0[8], o[8];
                unpack8(lg[i], g0); unpack8(lv[i], v0);
#pragma unroll
                for (int e = 0; e < 8; ++e) {
                    const float G = wg[0][e] * g2[e] + wg[1][e] * g1[e] + wg[2][e] * g0[e] + bg[e];
                    const float V = wv[0][e] * v2[e] + wv[1][e] * v1[e] + wv[2][e] * v0[e] + bv[e];
                    o[e] = G * sigmoidf_(G) * V;
                    g2[e] = g1[e]; g1[e] = g0[e]; v2[e] = v1[e]; v1[e] = v0[e];
                }
                *(u32x4*)(act + (size_t)(r0 + i0 + i) * DFF + f) = pack8((f32x4){o[0], o[1], o[2], o[3]}, (f32x4){o[4], o[5], o[6], o[7]});
            }
        }
    }
}

__device__ __forceinline__ void mix_phase(const Params& p, int j) {
    const h16* x16 = (const h16*)(p.ws + OFF_X16);
    h16* xr = (h16*)p.out; h16* xk = (h16*)p.out + (size_t)MTOK * 1024; h16* xv = (h16*)(p.ws + R_G16);
    const float* mix = p.in[3] + j * 6 * 1024;
    const size_t gtid = (size_t)blockIdx.x * 512 + opaque_tid(), nth = (size_t)gridDim.x * 512;
    for (size_t idx = gtid; idx < (size_t)MTOK * 128; idx += nth) {
        const int row = (int)(idx >> 7), c8 = (int)(idx & 127) * 8;
        const h16* xp = x16 + xrow(row) * 1024 + c8;
        float xc[8], xq[8];
        unpack8(*(const u32x4*)xp, xc); unpack8(*(const u32x4*)(xp - 1024), xq);
#pragma unroll
        for (int e = 0; e < 8; ++e) xq[e] -= xc[e];
        const size_t o = (size_t)row * 1024 + c8;
#pragma unroll
        for (int bsel = 0; bsel < 3; ++bsel) {
            const f32x4 m0 = *(const f32x4*)(mix + bsel * 1024 + c8), m1 = *(const f32x4*)(mix + bsel * 1024 + c8 + 4);
            f32x4 a, b;
#pragma unroll
            for (int e = 0; e < 4; ++e) { a[e] = xc[e] + xq[e] * m0[e]; b[e] = xc[4 + e] + xq[4 + e] * m1[e]; }
            h16* dst = bsel == 0 ? xr : (bsel == 1 ? xk : xv);
            *(u32x4*)(dst + o) = pack8(a, b);
        }
    }
}

__device__ __forceinline__ float dppf(float x, const int ctrl_sel) {
    const int v = __builtin_bit_cast(int, x);
    int r;
    if (ctrl_sel == 0) r = __builtin_amdgcn_update_dpp(0, v, 0xB1, 0xF, 0xF, true);
    else if (ctrl_sel == 1) r = __builtin_amdgcn_update_dpp(0, v, 0x4E, 0xF, 0xF, true);
    else if (ctrl_sel == 2) r = __builtin_amdgcn_update_dpp(0, v, 0x141, 0xF, 0xF, true);
    else r = __builtin_amdgcn_update_dpp(0, v, 0x140, 0xF, 0xF, true);
    return __builtin_bit_cast(float, r);
}
__device__ __forceinline__ float red4(float x) { x += dppf(x, 0); x += dppf(x, 1); return x; }
__device__ __forceinline__ float red16(float x) { x += dppf(x, 0); x += dppf(x, 1); x += dppf(x, 2); x += dppf(x, 3); return x; }
__device__ __forceinline__ void unpack4(u32x2 w, float* f) {
    h16x4 h = __builtin_bit_cast(h16x4, w);
#pragma unroll
    for (int i = 0; i < 4; ++i) f[i] = (float)h[i];
}
constexpr int SCAN_BUF = 8256;
__device__ __forceinline__ void scan_phase(const Params& p, int j, unsigned char* smem) {
    const int tid = opaque_tid();
    const int wave = tid >> 6, lane = tid & 63, slot = wave >> 2, w4 = wave & 3;
    float* LB = (float*)smem + slot * (2 * SCAN_BUF);
    const h16* r16 = (const h16*)(p.ws + R_R16);
    const h16* k16 = (const h16*)(p.ws + R_K16);
    const h16* v16 = (j == 0) ? (const h16*)(p.ws + OFF_VF) : (const h16*)(p.ws + R_V16);
    const h16* g16 = (const h16*)(p.ws + R_G16);
    const h16* e16 = (const h16*)p.out;
    const h16* a16 = (const h16*)p.out + (size_t)MTOK * 1024;
    h16* y16 = (h16*)(p.ws + (j == 0 ? R_V16 : OFF_VF));
    const int tp = w4 * 4 + (lane >> 4), k4 = (lane & 15) * 4;
    const int vrow = w4 * 16 + (lane >> 2), kq = lane & 3;
    for (int pair = blockIdx.x; pair < 256; pair += gridDim.x) {
        const int chain = pair * 2 + slot, b = chain >> 4, h = chain & 15;
        const int col = h * 64 + k4;
        const f32x4 c_kk = *(const f32x4*)(p.in[16] + j * 1024 + col), c_ka = *(const f32x4*)(p.in[17] + j * 1024 + col), c_rk = *(const f32x4*)(p.in[18] + j * 1024 + col);
        const f32x4 c_lg = *(const f32x4*)(p.in[19] + j * 1024 + col), c_lb = *(const f32x4*)(p.in[20] + j * 1024 + col);
        f32x2 S[8];
#pragma unroll
        for (int i = 0; i < 8; ++i) S[i] = (f32x2){0.f, 0.f};
        u32x2 pr[6];
        {
            const size_t go = ((size_t)(b * 2048 + tp)) * 1024 + col;
            pr[0] = *(const u32x2*)(r16 + go); pr[1] = *(const u32x2*)(k16 + go); pr[2] = *(const u32x2*)(v16 + go);
            pr[3] = *(const u32x2*)(e16 + go); pr[4] = *(const u32x2*)(a16 + go); pr[5] = *(const u32x2*)(g16 + go);
        }
        for (int ch = 0; ch < 128; ++ch) {
            float* BUF = LB + (ch & 1) * SCAN_BUF;
            float* OPS = BUF; float* VB = BUF + 5120; float* GB = BUF + 6144; float* YB = BUF + 7168; float* BON = BUF + 8192;
            {
                float rf[4], kf[4], vf[4], ef[4], af[4], gf[4];
                unpack4(pr[0], rf); unpack4(pr[1], kf); unpack4(pr[2], vf); unpack4(pr[3], ef); unpack4(pr[4], af); unpack4(pr[5], gf);
                float kk[4]; float ss = 0.f;
#pragma unroll
                for (int i = 0; i < 4; ++i) { kk[i] = kf[i] * c_kk[i]; ss += kk[i] * kk[i]; }
                ss = red16(ss);
                const float inv = 1.0f / fmaxf(sqrtf(ss), 1e-12f);
                f32x4 A4, B4, W4, K4, R4; float bs = 0.f;
#pragma unroll
                for (int i = 0; i < 4; ++i) {
                    const float kn = kk[i] * inv;
                    A4[i] = -kn; B4[i] = kn * af[i];
                    W4[i] = __expf(-ef[i]);
                    const float km = kf[i] * (1.0f + (af[i] - 1.0f) * c_ka[i]);
                    K4[i] = km; R4[i] = rf[i];
                    bs += rf[i] * km * c_rk[i];
                }
                bs = red16(bs);
                float* o = OPS + tp * 320 + k4;
                *(f32x4*)(o) = A4; *(f32x4*)(o + 64) = B4; *(f32x4*)(o + 128) = W4; *(f32x4*)(o + 192) = K4; *(f32x4*)(o + 256) = R4;
                *(f32x4*)(VB + tp * 64 + k4) = (f32x4){vf[0], vf[1], vf[2], vf[3]};
                *(f32x4*)(GB + tp * 64 + k4) = (f32x4){gf[0], gf[1], gf[2], gf[3]};
                if ((lane & 15) == 0) BON[tp] = bs;
            }
            if (ch + 1 < 128) {
                const size_t go = ((size_t)(b * 2048 + (ch + 1) * 16 + tp)) * 1024 + col;
                pr[0] = *(const u32x2*)(r16 + go); pr[1] = *(const u32x2*)(k16 + go); pr[2] = *(const u32x2*)(v16 + go);
                pr[3] = *(const u32x2*)(e16 + go); pr[4] = *(const u32x2*)(a16 + go); pr[5] = *(const u32x2*)(g16 + go);
            }
            __syncthreads();
#pragma unroll 2
            for (int t = 0; t < 16; ++t) {
                const float* op = OPS + t * 320 + kq * 16;
                f32x4 A4[4], B4[4], W4[4], K4[4], R4[4];
#pragma unroll
                for (int i = 0; i < 4; ++i) A4[i] = *(const f32x4*)(op + i * 4);
#pragma unroll
                for (int i = 0; i < 4; ++i) { W4[i] = *(const f32x4*)(op + 128 + i * 4); B4[i] = *(const f32x4*)(op + 64 + i * 4); K4[i] = *(const f32x4*)(op + 192 + i * 4); }
#pragma unroll
                for (int i = 0; i < 4; ++i) R4[i] = *(const f32x4*)(op + 256 + i * 4);
                const float vv = VB[t * 64 + vrow];
                f32x2 s0 = {0.f, 0.f}, s1 = {0.f, 0.f};
#pragma unroll
                for (int i = 0; i < 4; ++i) { s0 += S[2 * i] * (f32x2){A4[i][0], A4[i][1]}; s1 += S[2 * i + 1] * (f32x2){A4[i][2], A4[i][3]}; }
                const float sa = red4((s0[0] + s0[1]) + (s1[0] + s1[1]));
                const f32x2 sa2 = {sa, sa}, vv2 = {vv, vv};
#pragma unroll
                for (int i = 0; i < 4; ++i) {
                    S[2 * i] = S[2 * i] * (f32x2){W4[i][0], W4[i][1]} + sa2 * (f32x2){B4[i][0], B4[i][1]} + vv2 * (f32x2){K4[i][0], K4[i][1]};
                    S[2 * i + 1] = S[2 * i + 1] * (f32x2){W4[i][2], W4[i][3]} + sa2 * (f32x2){B4[i][2], B4[i][3]} + vv2 * (f32x2){K4[i][2], K4[i][3]};
                }
                f32x2 y0 = {0.f, 0.f}, y1 = {0.f, 0.f};
#pragma unroll
                for (int i = 0; i < 4; ++i) { y0 += S[2 * i] * (f32x2){R4[i][0], R4[i][1]}; y1 += S[2 * i + 1] * (f32x2){R4[i][2], R4[i][3]}; }
                const float y = red4((y0[0] + y0[1]) + (y1[0] + y1[1]));
                if (kq == 0) YB[t * 64 + vrow] = y;
            }
            __syncthreads();
            {
                const f32x4 y4 = *(const f32x4*)(YB + tp * 64 + k4), v4 = *(const f32x4*)(VB + tp * 64 + k4), g4 = *(const f32x4*)(GB + tp * 64 + k4);
                const float mu = red16((y4[0] + y4[1]) + (y4[2] + y4[3])) * (1.0f / 64.0f);
                float q = 0.f;
#pragma unroll
                for (int i = 0; i < 4; ++i) { const float d = y4[i] - mu; q += d * d; }
                const float rstd = rsqrtf(red16(q) * (1.0f / 64.0f) + 64e-5f);
                const float bon = BON[tp];
                float o[4];
#pragma unroll
                for (int i = 0; i < 4; ++i) o[i] = ((y4[i] - mu) * rstd * c_lg[i] + c_lb[i] + bon * v4[i]) * g4[i];
                u32x2 w; w.x = pk2(o[0], o[1]); w.y = pk2(o[2], o[3]);
                *(u32x2*)(y16 + ((size_t)(b * 2048 + ch * 16 + tp)) * 1024 + col) = w;
            }
        }
        __syncthreads();
    }
}

__device__ __forceinline__ void dsa_norm_phase(const Params& p, int j, unsigned char* smem) {
    const int tid = opaque_tid();
    const int lane = tid & 63, wave = tid >> 6;
    const float* hin = (const float*)(p.ws + D_HIN);
    h16* cq = (h16*)(p.ws + D_CQ); h16* ckv = (h16*)(p.ws + D_CKV); h16* ckvt = (h16*)(p.ws + D_CKVT); h16* kidx = (h16*)(p.ws + D_KIDX);
    float* widx = (float*)(p.ws + D_WIDX);
    const f32x4 gq = *(const f32x4*)(p.in[23] + j * 256 + lane * 4);
    const f32x2 gkv = *(const f32x2*)(p.in[24] + j * 128 + lane * 2);
    const float gi = p.in[29][j * 64 + lane], bi = p.in[30][j * 64 + lane];
    h16* wl = (h16*)(smem + wave * 2048);
    for (int grp = blockIdx.x * 8 + wave; grp < MTOK / 8; grp += gridDim.x * 8) {
        const int r0 = grp * 8;
        for (int i = 0; i < 8; ++i) {
            const int row = r0 + i;
            const float* hp = hin + (size_t)row * 512;
            const f32x4 vq = *(const f32x4*)(hp + lane * 4);
            const f32x2 vk = *(const f32x2*)(hp + 256 + lane * 2);
            const float vi = hp[384 + lane];
            float ssq = wave_sum(vq[0] * vq[0] + vq[1] * vq[1] + vq[2] * vq[2] + vq[3] * vq[3]);
            const float rq = rsqrtf(ssq * (1.0f / 256.0f) + 1e-6f);
            u32x2 w; w.x = pk2(vq[0] * rq * gq[0], vq[1] * rq * gq[1]); w.y = pk2(vq[2] * rq * gq[2], vq[3] * rq * gq[3]);
            *(u32x2*)(cq + (size_t)row * 256 + lane * 4) = w;
            float ssk = wave_sum(vk[0] * vk[0] + vk[1] * vk[1]);
            const float rk = rsqrtf(ssk * (1.0f / 128.0f) + 1e-6f);
            const unsigned wk = pk2(vk[0] * rk * gkv[0], vk[1] * rk * gkv[1]);
            *(unsigned*)(ckv + (size_t)row * 128 + lane * 2) = wk;
            const float mu = wave_sum(vi) * (1.0f / 64.0f);
            const float dv = vi - mu;
            const float var = wave_sum(dv * dv) * (1.0f / 64.0f);
            kidx[(size_t)row * 64 + lane] = (h16)(dv * rsqrtf(var + 1e-5f) * gi + bi);
            if (lane < 8) widx[(size_t)row * 8 + lane] = hp[448 + lane] * 0.044194173824159216f;
        }
    }
}

constexpr int ROWP = 2052;
__device__ __forceinline__ unsigned fkey(float x) {
    if (x == 0.0f) x = 0.0f;
    const unsigned u = __float_as_uint(x);
    return (u & 0x80000000u) ? ~u : (u | 0x80000000u);
}
__device__ __forceinline__ void dsa_index_phase(const Params& p, unsigned char* smem) {
    const int tid = opaque_tid(), wave = tid >> 6, lane = tid & 63, r = lane & 15, q = lane >> 4;
    float* SC = (float*)smem;
    const h16* qidx = (const h16*)(p.ws + D_QIDX);
    const h16* kidx = (const h16*)(p.ws + D_KIDX);
    const float* widx = (const float*)(p.ws + D_WIDX);
    unsigned short* selout = (unsigned short*)(p.ws + D_MASK);
    for (int qi = blockIdx.x, it = 0; qi < MTOK / 16; qi += gridDim.x, ++it) {
        const int qt = (it & 1) ? ((qi & ~127) | (127 - (qi & 127))) : qi;
        const int row0 = qt * 16, b = row0 >> 11, t0 = row0 & 2047;
        const int nkt = (t0 >> 4) + 1;
        {
            h16x8 qf[8][2]; float wq[8];
#pragma unroll
            for (int h = 0; h < 8; ++h) {
#pragma unroll
                for (int kk = 0; kk < 2; ++kk) qf[h][kk] = *(const h16x8*)(qidx + (size_t)(row0 + r) * 512 + h * 64 + kk * 32 + q * 8);
                wq[h] = widx[(size_t)(row0 + r) * 8 + h];
            }
            for (int kt = wave; kt < nkt; kt += 16) {
                const bool two = (kt + 8 < nkt);
                const int s0 = kt * 16, s1 = two ? s0 + 128 : s0;
                const h16* kp = kidx + (size_t)(b * 2048 + s0 + r) * 64 + q * 8;
                const h16* kp1 = kidx + (size_t)(b * 2048 + s1 + r) * 64 + q * 8;
                const h16x8 k0 = *(const h16x8*)kp, k1 = *(const h16x8*)(kp + 32), k2 = *(const h16x8*)kp1, k3 = *(const h16x8*)(kp1 + 32);
                f32x4 sc = {0.f, 0.f, 0.f, 0.f}, sd = {0.f, 0.f, 0.f, 0.f};
#pragma unroll
                for (int h = 0; h < 8; ++h) {
                    f32x4 acc = {0.f, 0.f, 0.f, 0.f}, acd = {0.f, 0.f, 0.f, 0.f};
                    acc = __builtin_amdgcn_mfma_f32_16x16x32_f16(k0, qf[h][0], acc, 0, 0, 0);
                    acd = __builtin_amdgcn_mfma_f32_16x16x32_f16(k2, qf[h][0], acd, 0, 0, 0);
                    acc = __builtin_amdgcn_mfma_f32_16x16x32_f16(k1, qf[h][1], acc, 0, 0, 0);
                    acd = __builtin_amdgcn_mfma_f32_16x16x32_f16(k3, qf[h][1], acd, 0, 0, 0);
#pragma unroll
                    for (int jj = 0; jj < 4; ++jj) { sc[jj] += fmaxf(acc[jj], 0.f) * wq[h]; sd[jj] += fmaxf(acd[jj], 0.f) * wq[h]; }
                }
                *(f32x4*)(SC + r * ROWP + s0 + q * 4) = sc;
                if (two) *(f32x4*)(SC + r * ROWP + s1 + q * 4) = sd;
            }
        }
        __syncthreads();
        for (int qq = 0; qq < 2; ++qq) {
            const int ql = wave * 2 + qq, t = t0 + ql;
            const float* srow = SC + ql * ROWP;
            const int ni = (t >> 6) + 1;
            unsigned u[32];
#pragma unroll
            for (int i = 0; i < 32; ++i) {
                u[i] = 0u;
                if (i < ni) { const int s = i * 64 + lane; if (s <= t) u[i] = fkey(srow[s]); }
            }
            unsigned short* selrow = selout + (size_t)(row0 + ql) * 256;
            if (t < 256) {
#pragma unroll
                for (int i = 0; i < 4; ++i) { const int pp = i * 64 + lane; selrow[pp] = (unsigned short)(pp <= t ? pp : 0xFFFF); }
            } else {
                unsigned* H = (unsigned*)(smem + 16 * ROWP * 4) + wave * 256;
                unsigned prefix = 0u; int need = 256;
#pragma unroll 1
                for (int pass = 0; pass < 4; ++pass) {
                    const int shift = 24 - 8 * pass;
                    const unsigned hmask = pass == 0 ? 0u : (0xFFFFFFFFu << (shift + 8));
                    *(u32x4*)(H + lane * 4) = (u32x4){0u, 0u, 0u, 0u};
                    asm volatile("s_waitcnt lgkmcnt(0)" ::: "memory");
#pragma unroll
                    for (int i = 0; i < 32; ++i) if (i < ni) { const unsigned uu = u[i]; if (uu != 0u && (uu & hmask) == prefix) atomicAdd(H + ((uu >> shift) & 255u), 1u); }
                    asm volatile("s_waitcnt lgkmcnt(0)" ::: "memory");
                    const u32x4 hv = *(const u32x4*)(H + lane * 4);
                    const int tot = (int)(hv.x + hv.y + hv.z + hv.w);
                    int rs = tot;
                    rs += __builtin_amdgcn_update_dpp(0, rs, 0xB1, 0xF, 0xF, true);
                    rs += __builtin_amdgcn_update_dpp(0, rs, 0x4E, 0xF, 0xF, true);
                    rs += __builtin_amdgcn_update_dpp(0, rs, 0x141, 0xF, 0xF, true);
                    rs += __builtin_amdgcn_update_dpp(0, rs, 0x140, 0xF, 0xF, true);
                    int rowsel = 3, above = 0;
                    {
                        const int r3 = __builtin_amdgcn_readlane(rs, 48), r2 = __builtin_amdgcn_readlane(rs, 32), r1 = __builtin_amdgcn_readlane(rs, 16);
                        if (need > r3) { above = r3; rowsel = 2; if (need > above + r2) { above += r2; rowsel = 1; if (need > above + r1) { above += r1; rowsel = 0; } } }
                    }
                    int lsel = rowsel * 16;
                    for (int k = 15; k >= 0; --k) {
                        const int cl = __builtin_amdgcn_readlane(tot, rowsel * 16 + k);
                        if (need <= above + cl) { lsel = rowsel * 16 + k; break; }
                        above += cl;
                    }
                    const int b3 = __builtin_amdgcn_readlane((int)hv.w, lsel), b2 = __builtin_amdgcn_readlane((int)hv.z, lsel), b1 = __builtin_amdgcn_readlane((int)hv.y, lsel);
                    int bsel = 3;
                    if (need > above + b3) { above += b3; bsel = 2; if (need > above + b2) { above += b2; bsel = 1; if (need > above + b1) { above += b1; bsel = 0; } } }
                    prefix |= (unsigned)(lsel * 4 + bsel) << shift;
                    need -= above;
                }
                const unsigned T = prefix;
                int running = 0, outpos = 0;
                const unsigned long long lt = (lane == 0) ? 0ull : (~0ull >> (64 - lane));
#pragma unroll
                for (int i = 0; i < 32; ++i) {
                    if (i < ni) {
                        const unsigned long long eq = __ballot(u[i] == T);
                        const int rank = running + __popcll(eq & lt);
                        const bool sel = u[i] > T || (u[i] == T && rank < need);
                        const unsigned long long sm = __ballot(sel);
                        running += __popcll(eq);
                        if (sel) selrow[outpos + __popcll(sm & lt)] = (unsigned short)(i * 64 + lane);
                        outpos += __popcll(sm);
                    }
                }
            }
        }
        __syncthreads();
    }
}

__device__ __forceinline__ float xmax_16_32(float x) {
    const unsigned u = __builtin_bit_cast(unsigned, x);
    auto r = __builtin_amdgcn_permlane16_swap(u, u, false, false);
    float m = fmaxf(__builtin_bit_cast(float, (unsigned)r[0]), __builtin_bit_cast(float, (unsigned)r[1]));
    const unsigned u2 = __builtin_bit_cast(unsigned, m);
    auto r2 = __builtin_amdgcn_permlane32_swap(u2, u2, false, false);
    return fmaxf(__builtin_bit_cast(float, (unsigned)r2[0]), __builtin_bit_cast(float, (unsigned)r2[1]));
}
__device__ __forceinline__ float xsum_16_32(float x) {
    const unsigned u = __builtin_bit_cast(unsigned, x);
    auto r = __builtin_amdgcn_permlane16_swap(u, u, false, false);
    float m = __builtin_bit_cast(float, (unsigned)r[0]) + __builtin_bit_cast(float, (unsigned)r[1]);
    const unsigned u2 = __builtin_bit_cast(unsigned, m);
    auto r2 = __builtin_amdgcn_permlane32_swap(u2, u2, false, false);
    return __builtin_bit_cast(float, (unsigned)r2[0]) + __builtin_bit_cast(float, (unsigned)r2[1]);
}
typedef __fp16 fp16x4_t __attribute__((__vector_size__(4 * sizeof(__fp16))));
__device__ __forceinline__ unsigned off_b(unsigned row, unsigned ch) { return 256u * row + 16u * (ch ^ (((row & 3) << 2) | ((row >> 2) & 3))); }
constexpr int SA_TILE = 8192, SA_BL = 8 * 2 * SA_TILE;
static_assert(SA_BL + 16 * 132 * 4 <= LDS_BYTES, "sparse attention LDS");
__device__ __forceinline__ void dsa_attn_phase(const Params& p, int j, unsigned char* smem) {
    const int tid = opaque_tid(), wave = tid >> 6, lane = tid & 63, r = lane & 15, q = lane >> 4;
    float* BL = (float*)(smem + SA_BL);
    for (int idx = tid; idx < 16 * 129; idx += 512) {
        const int h = idx / 129, d = idx % 129;
        int bk = d;
        if (d >= 16) { bk = 16 + (int)(logf((float)d * (1.0f / 16.0f)) / 2.0794415416798357f * 16.0f); bk = bk > 31 ? 31 : bk; }
        BL[h * 132 + d] = p.in[32][bk * 16 + h] * 1.4426950408889634f;
    }
    __syncthreads();
    const h16* qabs = (const h16*)(p.ws + D_QABS);
    const h16* ckv = (const h16*)(p.ws + D_CKV);
    const unsigned short* sel = (const unsigned short*)(p.ws + D_MASK);
    h16* olatA = (h16*)(p.ws + D_HIN);
    h16* olatB = (h16*)p.out + (size_t)MTOK * 1024;
    unsigned char* tile0 = smem + wave * (2 * SA_TILE);
    const float NINF = -__builtin_inff();
    unsigned wofs[8], kofs[2][4], vofs[8][2];
#pragma unroll
    for (int i = 0; i < 8; ++i) wofs[i] = off_b(8 * q + i, r);
#pragma unroll
    for (int tt = 0; tt < 2; ++tt)
#pragma unroll
        for (int kk = 0; kk < 4; ++kk) kofs[tt][kk] = off_b(8 * (r >> 2) + 4 * tt + (r & 3), 4 * kk + q);
#pragma unroll
    for (int c = 0; c < 8; ++c)
#pragma unroll
        for (int t2 = 0; t2 < 2; ++t2) vofs[c][t2] = off_b(8 * q + 4 * t2 + (r >> 2), 2 * c + ((lane & 3) >> 1)) + 8 * (lane & 1);
    for (int row = blockIdx.x * 8 + wave; row < MTOK; row += gridDim.x * 8) {
        const int b = row >> 11, t = row & 2047;
        const int nvalid = t + 1 < 256 ? t + 1 : 256, ng = (nvalid + 31) >> 5;
        const h16* kg = ckv + (size_t)(b * 2048) * 128;
        const unsigned short* srow = sel + (size_t)row * 256;
        h16x8 qf[4];
#pragma unroll
        for (int kk = 0; kk < 4; ++kk) qf[kk] = *(const h16x8*)(qabs + (size_t)row * 2048 + r * 128 + kk * 32 + q * 8);
        f32x4 O[8];
#pragma unroll
        for (int dt = 0; dt < 8; ++dt) O[dt] = (f32x4){0.f, 0.f, 0.f, 0.f};
        float mrun = NINF, lrun = 0.f;
        u32x4 selv = *(const u32x4*)(srow + 8 * q);
        u32x4 gr[8];
#pragma unroll
        for (int i = 0; i < 8; ++i) {
            unsigned sidx = (selv[i >> 1] >> ((i & 1) * 16)) & 0xFFFFu; sidx = sidx == 0xFFFFu ? 0u : sidx;
            gr[i] = *(const u32x4*)(kg + (size_t)sidx * 128 + r * 8);
        }
        for (int g = 0; g < ng; ++g) {
            unsigned char* tile = tile0 + (g & 1) * SA_TILE;
            const u32x4 selc = selv;
#pragma unroll
            for (int i = 0; i < 8; ++i) *(u32x4*)(tile + wofs[i]) = gr[i];
            if (g + 1 < ng) {
                selv = *(const u32x4*)(srow + (g + 1) * 32 + 8 * q);
#pragma unroll
                for (int i = 0; i < 8; ++i) {
                    unsigned sidx = (selv[i >> 1] >> ((i & 1) * 16)) & 0xFFFFu; sidx = sidx == 0xFFFFu ? 0u : sidx;
                    gr[i] = *(const u32x4*)(kg + (size_t)sidx * 128 + r * 8);
                }
            }
            asm volatile("s_waitcnt lgkmcnt(0)" ::: "memory");
            f32x4 sc[2];
#pragma unroll
            for (int tt = 0; tt < 2; ++tt) {
                f32x4 acc = {0.f, 0.f, 0.f, 0.f};
#pragma unroll
                for (int kk = 0; kk < 4; ++kk) {
                    const h16x8 kf = *(const h16x8*)(tile + kofs[tt][kk]);
                    acc = __builtin_amdgcn_mfma_f32_16x16x32_f16(kf, qf[kk], acc, 0, 0, 0);
                }
                sc[tt] = acc;
            }
            float x[8]; float mx = NINF;
#pragma unroll
            for (int i = 0; i < 8; ++i) {
                const unsigned sidx = (selc[i >> 1] >> ((i & 1) * 16)) & 0xFFFFu;
                int dist = t - (int)sidx; dist = dist < 0 ? 0 : (dist > 128 ? 128 : dist);
                const float v = sc[i >> 2][i & 3] + BL[r * 132 + dist];
                const float xv = (sidx != 0xFFFFu) ? v : NINF;
                x[i] = xv; mx = fmaxf(mx, xv);
            }
            mx = xmax_16_32(mx);
            const float mnew = fmaxf(mrun, mx);
            const float mref = (mnew == NINF) ? 0.f : mnew;
            const float alpha = __builtin_amdgcn_exp2f(mrun - mref);
            mrun = mnew;
            float ps = 0.f; h16x8 pf;
#pragma unroll
            for (int i = 0; i < 8; ++i) { const float pv = __builtin_amdgcn_exp2f(x[i] - mref); ps += pv; pf[i] = (h16)pv; }
            lrun = lrun * alpha + ps;
#pragma unroll
            for (int dt = 0; dt < 8; ++dt) {
                const fp16x4_t lo = __builtin_amdgcn_ds_read_tr16_b64_v4f16((LAS fp16x4_t*)(tile + vofs[dt][0]));
                const fp16x4_t hi = __builtin_amdgcn_ds_read_tr16_b64_v4f16((LAS fp16x4_t*)(tile + vofs[dt][1]));
                const h16x4 l4 = __builtin_bit_cast(h16x4, lo), h4 = __builtin_bit_cast(h16x4, hi);
                const h16x8 vf = {l4[0], l4[1], l4[2], l4[3], h4[0], h4[1], h4[2], h4[3]};
                O[dt] *= alpha;
                O[dt] = __builtin_amdgcn_mfma_f32_16x16x32_f16(vf, pf, O[dt], 0, 0, 0);
            }
        }
        const float inv = 1.0f / xsum_16_32(lrun);
        h16* op = (row < MTOK / 2 ? olatA + (size_t)row * 2048 : olatB + (size_t)(row - MTOK / 2) * 2048) + r * 128 + q * 4;
#pragma unroll
        for (int dt = 0; dt < 8; ++dt) {
            u32x2 w; w.x = pk2(O[dt][0] * inv, O[dt][1] * inv); w.y = pk2(O[dt][2] * inv, O[dt][3] * inv);
            *(u32x2*)(op + dt * 16) = w;
        }
        asm volatile("s_waitcnt lgkmcnt(0)" ::: "memory");
    }
    __syncthreads();
}

constexpr size_t OFF_BAR = 951 * MiB;
#define XB_TMO      128
#define XB_XCNT(j)  (256  + 64 * (j))
#define XB_XSUB(j)  (1280 + 64 * (j))
#define XB_XGEN(j)  (2304 + 64 * (j))
#define XB_TOP      3328
#define XB_TOPGEN   3392
#define XCD_BAR_WORDS 3456
#define XB_SPIN_CAP (1u << 22)
__device__ __forceinline__ unsigned xb_ld(unsigned* p)              { return __hip_atomic_load(p, __ATOMIC_RELAXED, __HIP_MEMORY_SCOPE_AGENT); }
__device__ __forceinline__ unsigned xb_add(unsigned* p, unsigned v) { return __hip_atomic_fetch_add(p, v, __ATOMIC_RELAXED, __HIP_MEMORY_SCOPE_AGENT); }
__device__ __forceinline__ unsigned xb_xcc_id() { return (unsigned)__builtin_amdgcn_s_getreg((3 << 11) | 20) & 0xFu; }
#define XB_SPIN(cond, bar) do { unsigned _sp = 0; while (cond) { __builtin_amdgcn_s_sleep(1); \
    if ((++_sp & 255u) == 0u) { if (xb_ld(&(bar)[XB_TMO])) break; if (_sp > XB_SPIN_CAP) { atomicAdd(&(bar)[XB_TMO], 1u); break; } } } } while (0)
struct XcdBarrier { unsigned* bar; unsigned x; volatile LAS unsigned* st; };
__device__ __forceinline__ XcdBarrier xcd_barrier_post(unsigned* bar, volatile LAS unsigned* st) {
    XcdBarrier b; b.bar = bar; b.x = xb_xcc_id(); b.st = st;
    if (threadIdx.x == 0) (void)xb_add(&bar[XB_XCNT(b.x)], 1u);
    return b;
}
__device__ __forceinline__ void xcd_barrier_complete(unsigned* bar, unsigned x, unsigned& nloc, unsigned& nx) {
    const unsigned G = gridDim.x * gridDim.y * gridDim.z;
    unsigned sum, cnt, mine, sp = 0u;
    for (;;) {
        sum = 0u; cnt = 0u; mine = 0u;
#pragma unroll
        for (unsigned jx = 0; jx < 16; ++jx) { const unsigned c = xb_ld(&bar[XB_XCNT(jx)]); sum += c; cnt += (c > 0u) ? 1u : 0u; mine = (jx == x) ? c : mine; }
        if (sum == G) break;
        __builtin_amdgcn_s_sleep(1);
        if ((++sp & 255u) == 0u) { if (xb_ld(&bar[XB_TMO])) break; if (sp > XB_SPIN_CAP) { atomicAdd(&bar[XB_TMO], 1u); break; } }
    }
    nloc = mine > 0u ? mine : 1u; nx = cnt > 0u ? cnt : 1u;
}
__device__ __forceinline__ void xcd_barrier(const XcdBarrier& b) {
    asm volatile("s_waitcnt vmcnt(0)" ::: "memory");
    __syncthreads();
    if (threadIdx.x == 0) {
        unsigned* bar = b.bar;
        __builtin_amdgcn_s_waitcnt(0);
        unsigned nloc = b.st[0], nx = b.st[1];
        if (nloc == 0u) { xcd_barrier_complete(bar, b.x, nloc, nx); b.st[0] = nloc; b.st[1] = nx; }
        const unsigned old = xb_add(&bar[XB_XSUB(b.x)], 1u);
        const unsigned gen = old / nloc;
        if (old + 1u == (gen + 1u) * nloc) {
            __builtin_amdgcn_fence(__ATOMIC_RELEASE, "agent");
            asm volatile("s_waitcnt vmcnt(0)" ::: "memory");
            const unsigned og = xb_add(&bar[XB_TOP], 1u);
            const unsigned tg = og / nx;
            if (og + 1u == (tg + 1u) * nx) xb_add(&bar[XB_TOPGEN], 1u);
            else XB_SPIN(xb_ld(&bar[XB_TOPGEN]) == tg, bar);
            __builtin_amdgcn_fence(__ATOMIC_ACQUIRE, "agent");
            xb_add(&bar[XB_XGEN(b.x)], 1u);
            asm volatile("s_waitcnt vmcnt(0)" ::: "memory");
        } else {
            XB_SPIN(xb_ld(&bar[XB_XGEN(b.x)]) == gen, bar);
            __builtin_amdgcn_fence(__ATOMIC_ACQUIRE, "agent");
            asm volatile("s_waitcnt vmcnt(0)" ::: "memory");
        }
    }
    __syncthreads();
}

__global__ void __launch_bounds__(512) mega_fwd(Params p) {
    extern __shared__ __attribute__((aligned(16))) unsigned char smem[];
    cg::grid_group grid = cg::this_grid();
    unsigned char* ws = p.ws;
    h16* x16 = (h16*)(ws + OFF_X16);
    volatile LAS unsigned* xbst = (volatile LAS unsigned*)(smem + LDS_BYTES - 16);
    if (threadIdx.x == 0) { xbst[0] = 0u; xbst[1] = 0u; }
    __syncthreads();
    const XcdBarrier xbar = xcd_barrier_post((unsigned*)(ws + OFF_BAR), xbst);
    for (int ph = p.ph_lo; ph < p.ph_hi; ++ph) {
        const unsigned e = p.prog[ph];
        const int kind = e & 15, L = (e >> 4) & 3, sub = (e >> 6) & 1, j = L >> 1;
        const int nrep = 1 + (int)(e >> 7);
        for (int rep = 0; rep < nrep; ++rep) {
        if (rep) xcd_barrier(xbar);
        const bool isgemm = (kind == K_R1 || kind == K_R2 || kind == K_R4 || kind == K_F1 || kind == K_F3 || kind == K_D1 || kind == K_D3 || kind == K_D6);
        if (isgemm) {
            const int ngemm = (kind == K_R1) ? 2 : 1;
            for (int gi = 0; gi < ngemm; ++gi) {
            pg8::Gemm g; pg8::Epi E;
            g.M = MTOK; g.N = 1024; g.K = 1024; g.lda = 1024; g.amode = 0; g.pm0 = 0; g.A = x16; g.A2 = x16; g.Bt = x16;
            E.mode = E_RESID; E.pm0 = 0; E.j = j; E.pnoff = 0; E.fin = (L == 3 && kind == K_F3) ? 1 : 0; E.ws = ws; E.out = p.out; E.bias0 = p.in[5] + j * 1024; E.bias1 = p.in[8] + j * 1024; E.bias2 = p.in[11];
            if (kind == K_R1) {
                E.mode = E_RPROJ;
                if (gi == 0) { g.A = (const h16*)p.out; g.A2 = (const h16*)(ws + R_G16); g.Bt = w_rwkv_big(ws, j); g.N = 3072; g.amode = 2; }
                else { g.Bt = w_rwkv_l1(ws, j); g.N = 512; g.K = 2048; g.amode = 1; E.pnoff = 12; }
            } else if (kind == K_R2) {
                g.A = (const h16*)(ws + R_HACT); g.Bt = w_rwkv_l2(ws, j); g.N = (j == 0) ? 3072 : 4096; g.K = 384; g.lda = 384; E.mode = E_LORA2;
            } else if (kind == K_R4) {
                g.A = (const h16*)(ws + (j == 0 ? R_V16 : OFF_VF)); g.Bt = w_rwkv_o(ws, j);
            } else if (kind == K_F1) {
                g.Bt = w_ffn_up(ws, L); g.M = MTOK / 2; g.N = 5632; g.amode = 1; g.pm0 = sub * 128; E.mode = E_ST16;
            } else if (kind == K_F3) {
                g.A = (const h16*)(ws + F_ACT); g.Bt = w_ffn_dn(ws, L); g.M = MTOK / 2; g.K = 2816; g.lda = 2816; E.pm0 = sub * 128;
            } else if (kind == K_D1) {
                g.Bt = w_dsa_in(ws, j); g.N = 512; g.amode = 1; E.mode = E_ST32;
            } else if (kind == K_D3) {
                g.A = (const h16*)(ws + D_CQ); g.Bt = w_dsa_q(ws, j); g.N = 2560; g.K = 256; g.lda = 256; E.mode = E_QPROJ;
            } else {
                g.A = (const h16*)(ws + D_HIN); g.A2 = (const h16*)p.out + (size_t)MTOK * 1024; g.Bt = (const h16*)(ws + OFF_WOV) + (size_t)j * 2097152; g.K = 2048; g.lda = 2048; g.amode = 3;
            }
            pg8::StaticOrder S; S.init(g.M, g.N, (int)gridDim.x, (int)blockIdx.x);
#ifndef NO_GEMM
            pg8::gemm_phase((LAS unsigned char*)smem, g, S, E);
#endif
            }
        } else if (kind == K_PREP) {
#ifndef NO_PREP
            prep_phase(p, smem);
#endif
        } else if (kind == K_R0) {
            mix_phase(p, j);
        } else if (kind == K_R3) {
#ifndef NO_SCAN
            scan_phase(p, j, smem);
#endif
        } else if (kind == K_LN) {
#ifndef NO_LN
            ln_phase(p, p.in[1] + (L * 2 + sub) * 1024, p.in[2] + (L * 2 + sub) * 1024, L == 3 && sub == 1);
#endif
        } else if (kind == K_F2) {
#ifndef NO_CONV
            conv_phase(p, L);
#endif
        } else if (kind == K_D2) {
#ifndef NO_NORM
            dsa_norm_phase(p, j, smem);
#endif
        } else if (kind == K_D4) {
#ifndef NO_INDEX
            dsa_index_phase(p, smem);
#endif
        } else if (kind == K_D5) {
#ifndef NO_ATTN
            dsa_attn_phase(p, j, smem);
#endif
        }
        }
        if (ph + 1 < p.ph_hi) { if (ph == p.ph_lo) grid.sync(); else xcd_barrier(xbar); for (int xs = 0; xs < EXTRA_SYNC; ++xs) xcd_barrier(xbar); }
    }
}

extern "C" void kernel_launch(void* const* d_in, const int* in_sizes, int n_in, void* d_out, int out_size, void* d_ws, size_t ws_size, hipStream_t stream) {
    static int grid_blocks = 0;
    if (grid_blocks == 0) {
        if (n_in != 37 || ws_size < WS_NEED || out_size != MTOK * DM) { fprintf(stderr, "kernel_launch: unexpected problem (n_in %d ws %zu out %d)\n", n_in, ws_size, out_size); grid_blocks = -1; return; }
        int dev = 0, cus = 0, per_cu = 0;
        hipGetDevice(&dev);
        hipDeviceGetAttribute(&cus, hipDeviceAttributeMultiprocessorCount, dev);
        if (hipFuncSetAttribute((const void*)mega_fwd, hipFuncAttributeMaxDynamicSharedMemorySize, LDS_BYTES) != hipSuccess) { fprintf(stderr, "kernel_launch: hipFuncSetAttribute failed\n"); grid_blocks = -1; return; }
        hipOccupancyMaxActiveBlocksPerMultiprocessor(&per_cu, (const void*)mega_fwd, 512, LDS_BYTES);
        if (per_cu < 1) { fprintf(stderr, "kernel_launch: occupancy query says %d blocks/CU\n", per_cu); per_cu = 1; }
        (void)hipGetLastError();
        grid_blocks = cus * per_cu;
        fprintf(stderr, "kernel_launch: grid %d (cus %d x %d)\n", grid_blocks, cus, per_cu);
    }
    if (grid_blocks < 0) return;
    Params p{};
    for (int i = 0; i < 37; ++i) p.in[i] = (const float*)d_in[i];
    p.ws = (unsigned char*)d_ws; p.out = (float*)d_out;
    int np = 0;
    constexpr unsigned PROBE_MASK = 0u;
    auto add = [&](int kind, int L, int sub) { p.prog[np++] = (unsigned char)(kind | (L << 4) | (sub << 6) | ((((PROBE_MASK >> kind) & 1u) && !(kind == K_LN && L == 3 && sub == 1)) ? 128 : 0)); };
    add(K_PREP, 0, 0);
    for (int L = 0; L < 4; ++L) {
        if ((L & 1) == 0) { add(K_R0, L, 0); add(K_R1, L, 0); add(K_R2, L, 0); add(K_R3, L, 0); add(K_R4, L, 0); }
        else { add(K_D1, L, 0); add(K_D2, L, 0); add(K_D3, L, 0); add(K_D4, L, 0); add(K_D5, L, 0); add(K_D6, L, 0); }
        add(K_LN, L, 0);
        for (int c = 0; c < 2; ++c) { add(K_F1, L, c); add(K_F2, L, c); add(K_F3, L, c); }
        add(K_LN, L, 1);
    }
#if SINGLE_LAUNCH
    if (hipMemsetAsync((unsigned char*)d_ws + OFF_BAR, 0, XCD_BAR_WORDS * 4, stream) != hipSuccess) { fprintf(stderr, "kernel_launch: memset failed\n"); return; }
    p.ph_lo = 0; p.ph_hi = np;
    void* args[] = {&p};
    hipError_t e = hipLaunchCooperativeKernel((const void*)mega_fwd, dim3(grid_blocks), dim3(512), args, LDS_BYTES, stream);
    if (e != hipSuccess) fprintf(stderr, "cooperative launch failed: %s (grid %d)\n", hipGetErrorString(e), grid_blocks);
#else
    for (int ph = 0; ph < np; ++ph) {
        p.ph_lo = ph; p.ph_hi = ph + 1;
        hipLaunchKernelGGL(mega_fwd, dim3(grid_blocks), dim3(512), LDS_BYTES, stream, p);
    }
#endif
}
```

```cpp
#include <hip/hip_runtime.h>
#include <hip/hip_cooperative_groups.h>
#include <cstdio>
namespace cg = cooperative_groups;

constexpr int EXTRA_SYNC = 0;
#ifndef SINGLE_LAUNCH
#define SINGLE_LAUNCH 1
#endif

#define LAS __attribute__((address_space(3)))
typedef _Float16 h16;
typedef _Float16 h16x8 __attribute__((ext_vector_type(8)));
typedef _Float16 h16x4 __attribute__((ext_vector_type(4)));
typedef _Float16 h16x2 __attribute__((ext_vector_type(2)));
typedef float f32x4 __attribute__((ext_vector_type(4)));
typedef float f32x2 __attribute__((ext_vector_type(2)));
typedef unsigned u32x4 __attribute__((ext_vector_type(4)));
typedef unsigned u32x2 __attribute__((ext_vector_type(2)));

constexpr int DM = 1024, SEQ = 2048, NBATCH = 32, MTOK = NBATCH * SEQ;
constexpr int DFF = 2816;
constexpr size_t MiB = (size_t)1 << 20;
constexpr float DN_ALPHA = 1.6817928305074290f;
constexpr int LDS_BYTES = 147456;

constexpr size_t OFF_W = 0;
constexpr size_t OFF_X16 = 118 * MiB;
constexpr size_t OFF_VF = 247 * MiB;
constexpr size_t OFF_R = 375 * MiB;
constexpr size_t WS_NEED = 960 * MiB;
constexpr size_t OFF_WOV = 952 * MiB;
constexpr size_t R_R16 = OFF_R, R_K16 = OFF_R + 128 * MiB, R_V16 = OFF_R + 256 * MiB, R_G16 = OFF_R + 384 * MiB, R_HACT = OFF_R + 512 * MiB;
constexpr size_t F_U16 = OFF_R, F_ACT = OFF_R + 352 * MiB;
constexpr size_t D_HIN = OFF_R, D_O16 = OFF_R, D_QABS = OFF_R + 128 * MiB, D_QIDX = OFF_R + 384 * MiB, D_CQ = OFF_R + 448 * MiB,
                 D_CKV = OFF_R + 480 * MiB, D_CKVT = OFF_R + 496 * MiB, D_KIDX = OFF_R + 512 * MiB, D_WIDX = OFF_R + 520 * MiB, D_MASK = OFF_R + 522 * MiB;

struct Params {
    const float* in[37];
    unsigned char* ws;
    float* out;
    int ph_lo, ph_hi;
    unsigned char prog[64];
};

enum { K_PREP = 0, K_R1, K_R2, K_R3, K_R4, K_LN, K_F1, K_F2, K_F3, K_D1, K_D2, K_D3, K_D4, K_D5, K_D6, K_R0 };
enum { E_RPROJ = 0, E_LORA2, E_RESID, E_ST16, E_ST32, E_QPROJ };

__device__ __forceinline__ size_t xrow(int row) { return (size_t)(row >> 11) * 2049 + 1 + (row & 2047); }
__device__ __forceinline__ unsigned pk2(float a, float b) { h16x2 h = {(h16)a, (h16)b}; return __builtin_bit_cast(unsigned, h); }
__device__ __forceinline__ u32x4 pack8(f32x4 a, f32x4 b) { u32x4 w; w.x = pk2(a[0], a[1]); w.y = pk2(a[2], a[3]); w.z = pk2(b[0], b[1]); w.w = pk2(b[2], b[3]); return w; }
__device__ __forceinline__ void unpack8(u32x4 w, float* f) {
    h16x8 h = __builtin_bit_cast(h16x8, w);
#pragma unroll
    for (int i = 0; i < 8; ++i) f[i] = (float)h[i];
}
__device__ __forceinline__ float sigmoidf_(float x) { return 1.0f / (1.0f + __expf(-x)); }
__device__ __forceinline__ float wave_sum(float v) {
#pragma unroll
    for (int o = 32; o > 0; o >>= 1) v += __shfl_xor(v, o);
    return v;
}
#define WSYNC() asm volatile("s_waitcnt vmcnt(0) lgkmcnt(0)" ::: "memory")
__device__ __forceinline__ int opaque_tid() { int t = threadIdx.x; asm volatile("" : "+v"(t)); return t; }

namespace pg8 {
constexpr int BM = 256, BK = 64, HALF = 128, HTB = HALF * BK * 2, STAGE_BYTES = 8 * HTB, NXCD = 8, WGM = 8;
__device__ __forceinline__ int lds_byte(int r, int c) { const int st = (r >> 4) * 2 + (c >> 5), rr = r & 15, cc = c & 31, ob = rr * 64 + cc * 2; return st * 1024 + (ob ^ (((ob >> 9) & 1) << 5)); }
__device__ __forceinline__ void stage_rc(int b, int& R, int& C) { const int st = b / 1024, sb = b % 1024, swz = sb ^ (((sb >> 9) & 1) << 5); R = (st >> 1) * 16 + swz / 64; C = (st & 1) * 32 + (swz % 64) / 2; }
__device__ __forceinline__ int perm32(int rho) { const int n = rho >> 4, i = rho & 15; return 8 * (i >> 2) + 4 * n + (i & 3); }
struct Unit { int pm, pn; };
struct Gemm { const h16* A; const h16* A2; const h16* Bt; int M, N, K, lda, amode, pm0; };
struct StaticOrder {
    int nM, nN, nwg, G, c;
    __device__ void init(int M, int N, int G_, int c_) { nM = M / BM; nN = N / BM; nwg = nM * nN; G = G_; c = c_; }
    __device__ bool next(int i, Unit& u) const {
        const long L = (long)i * G + c; if (L >= nwg) return false;
        int wgid = (int)L; { const int q = nwg / NXCD, r = nwg % NXCD, xcd = wgid % NXCD, off = wgid / NXCD; wgid = (xcd < r ? xcd * (q + 1) : r * (q + 1) + (xcd - r) * q) + off; }
        const int nig = WGM * nN, gid = wgid / nig, fm = gid * WGM, gsz = (nM - fm) < WGM ? (nM - fm) : WGM;
        u.pm = fm + ((wgid % nig) % gsz); u.pn = (wgid % nig) / gsz; return true;
    }
};

struct Epi {
    int mode, pm0, j, pnoff, fin;
    unsigned char* ws; float* out; const float* bias0; const float* bias1; const float* bias2;
    __device__ __forceinline__ void operator()(const f32x4 (&acc)[2][2][4][2], const Unit& u, int wr, int wc, int fr, int fq) const {
        const int rowl0 = u.pm * BM + wr * 64 + fr;
        const int colt = u.pn * BM + wc * 32 + 8 * fq;
        if (mode == E_RESID) {
            u32x4 xr[2][4][2];
#pragma unroll
            for (int ai = 0; ai < 2; ++ai)
#pragma unroll
                for (int m = 0; m < 4; ++m) {
                    const int rowg = rowl0 + ai * HALF + m * 16 + pm0 * BM;
                    const h16* xp = (const h16*)(ws + OFF_X16) + xrow(rowg) * 1024 + colt;
#pragma unroll
                    for (int bj = 0; bj < 2; ++bj) xr[ai][m][bj] = *(const u32x4*)(xp + bj * HALF);
                }
#pragma unroll
            for (int ai = 0; ai < 2; ++ai)
#pragma unroll
                for (int m = 0; m < 4; ++m) {
                    const int rowg = rowl0 + ai * HALF + m * 16 + pm0 * BM;
                    float* dp0 = out + (size_t)rowg * 1024 + colt;
                    h16* hp0 = (h16*)out + (size_t)rowg * 1024 + colt;
#pragma unroll
                    for (int bj = 0; bj < 2; ++bj) {
                        float xf[8]; unpack8(xr[ai][m][bj], xf);
                        const f32x4 v0 = acc[ai][bj][m][0], v1 = acc[ai][bj][m][1];
                        f32x4 r0, r1;
#pragma unroll
                        for (int jj = 0; jj < 4; ++jj) { r0[jj] = DN_ALPHA * xf[jj] + v0[jj]; r1[jj] = DN_ALPHA * xf[4 + jj] + v1[jj]; }
                        if (fin) { float* dp = dp0 + bj * HALF; *(f32x4*)dp = r0; *(f32x4*)(dp + 4) = r1; }
                        else *(u32x4*)(hp0 + bj * HALF) = pack8(r0, r1);
                    }
                }
            return;
        }
        if (mode == E_LORA2 && (u.pn >> 2) == 3) {
            const int c0 = colt & 1023;
#pragma unroll
            for (int ai = 0; ai < 2; ++ai) {
                u32x4 lv[4][2], lf[4][2];
#pragma unroll
                for (int m = 0; m < 4; ++m) {
                    const size_t off = (size_t)(rowl0 + ai * HALF + m * 16 + pm0 * BM) * 1024 + c0;
#pragma unroll
                    for (int bj = 0; bj < 2; ++bj) { lv[m][bj] = *(const u32x4*)((const h16*)(ws + R_V16) + off + bj * HALF); lf[m][bj] = *(const u32x4*)((const h16*)(ws + OFF_VF) + off + bj * HALF); }
                }
#pragma unroll
                for (int m = 0; m < 4; ++m) {
                    const size_t off = (size_t)(rowl0 + ai * HALF + m * 16 + pm0 * BM) * 1024 + c0;
#pragma unroll
                    for (int bj = 0; bj < 2; ++bj) {
                        const int c = c0 + bj * HALF;
                        const f32x4 ba = *(const f32x4*)(bias2 + c), bb = *(const f32x4*)(bias2 + c + 4);
                        float vv[8], vf8[8]; unpack8(lv[m][bj], vv); unpack8(lf[m][bj], vf8);
                        f32x4 v0 = acc[ai][bj][m][0], v1 = acc[ai][bj][m][1];
#pragma unroll
                        for (int jj = 0; jj < 4; ++jj) {
                            v0[jj] = vv[jj] + (vf8[jj] - vv[jj]) * sigmoidf_(v0[jj] + ba[jj]);
                            v1[jj] = vv[4 + jj] + (vf8[4 + jj] - vv[4 + jj]) * sigmoidf_(v1[jj] + bb[jj]);
                        }
                        *(u32x4*)((h16*)(ws + R_V16) + off + bj * HALF) = pack8(v0, v1);
                    }
                }
            }
            return;
        }
#pragma unroll
        for (int ai = 0; ai < 2; ++ai)
#pragma unroll
            for (int m = 0; m < 4; ++m) {
                const int rowl = rowl0 + ai * HALF + m * 16;
                const int rowg = rowl + pm0 * BM;
#pragma unroll
                for (int bj = 0; bj < 2; ++bj) {
                    const int col = colt + bj * HALF;
                    f32x4 v0 = acc[ai][bj][m][0], v1 = acc[ai][bj][m][1];
                    if (mode == E_RPROJ) {
                        if (pnoff == 0) {
                            h16* dst = (h16*)(ws + (u.pn < 4 ? R_R16 : (u.pn < 8 ? R_K16 : (j == 0 ? OFF_VF : R_V16))));
                            *(u32x4*)(dst + (size_t)rowg * 1024 + (col & 1023)) = pack8(v0, v1);
                        } else if (col < 384) {
                            const int hc = col;
                            if (hc < 64) {
#pragma unroll
                                for (int jj = 0; jj < 4; ++jj) { v0[jj] = tanhf(v0[jj]); v1[jj] = tanhf(v1[jj]); }
                            } else if (hc >= 160) {
#pragma unroll
                                for (int jj = 0; jj < 4; ++jj) { v0[jj] = sigmoidf_(v0[jj]); v1[jj] = sigmoidf_(v1[jj]); }
                            }
                            *(u32x4*)((h16*)(ws + R_HACT) + (size_t)rowg * 384 + hc) = pack8(v0, v1);
                        }
                    } else if (mode == E_LORA2) {
                        const int grp = u.pn >> 2, c = col & 1023;
                        const size_t off = (size_t)rowg * 1024 + c;
                        if (grp == 0) {
                            const f32x4 ba = *(const f32x4*)(bias0 + c), bb = *(const f32x4*)(bias0 + c + 4);
#pragma unroll
                            for (int jj = 0; jj < 4; ++jj) { v0[jj] = sigmoidf_(v0[jj] + ba[jj]) * 0.6065306597f; v1[jj] = sigmoidf_(v1[jj] + bb[jj]) * 0.6065306597f; }
                            *(u32x4*)((h16*)out + off) = pack8(v0, v1);
                        } else if (grp == 1) {
                            const f32x4 ba = *(const f32x4*)(bias1 + c), bb = *(const f32x4*)(bias1 + c + 4);
#pragma unroll
                            for (int jj = 0; jj < 4; ++jj) { v0[jj] = sigmoidf_(v0[jj] + ba[jj]); v1[jj] = sigmoidf_(v1[jj] + bb[jj]); }
                            *(u32x4*)((h16*)out + (size_t)MTOK * 1024 + off) = pack8(v0, v1);
                        } else {
                            *(u32x4*)((h16*)(ws + R_G16) + off) = pack8(v0, v1);
                        }
                    } else if (mode == E_ST16) {
                        *(u32x4*)((h16*)(ws + F_U16) + (size_t)rowl * 5632 + col) = pack8(v0, v1);
                    } else if (mode == E_ST32) {
                        float* dp = (float*)(ws + D_HIN) + (size_t)rowg * 512 + col;
                        *(f32x4*)dp = v0; *(f32x4*)(dp + 4) = v1;
                    } else {
                        if (u.pn < 8) *(u32x4*)((h16*)(ws + D_QABS) + (size_t)rowg * 2048 + col) = pack8(v0, v1);
                        else *(u32x4*)((h16*)(ws + D_QIDX) + (size_t)rowg * 512 + (col - 2048)) = pack8(v0, v1);
                    }
                }
            }
    }
};

__device__ __forceinline__ const char* a_tile(const Gemm& g, int pm, int pn) {
    if (g.amode == 1) { const int row = (pm + g.pm0) * BM; return (const char*)g.A + xrow(row) * 2048; }
    if (g.amode == 2) {
        const int gq = pn >> 2;
        const char* base = gq == 2 ? (const char*)g.A2 : (const char*)g.A + (size_t)gq * ((size_t)MTOK * 1024 * 2);
        return base + (size_t)pm * BM * 2048;
    }
    if (g.amode == 3) return (pm < 128 ? (const char*)g.A + (size_t)pm * BM * 4096 : (const char*)g.A2 + (size_t)(pm - 128) * BM * 4096);
    return (const char*)g.A + (size_t)pm * BM * g.lda * 2;
}

__device__ __forceinline__ void gemm_phase(LAS unsigned char* lds, const Gemm g, const StaticOrder& S, const Epi& E) {
    const int tid = opaque_tid(), wid = __builtin_amdgcn_readfirstlane(tid >> 6), lane = tid & 63, wr = wid >> 2, wc = wid & 3, fr = lane & 15, fq = lane >> 4;
    const int K = g.K, nt = K / BK;
    const bool shiftA = (g.amode == 1);
    unsigned voffA[2], voffB[2];
#pragma unroll
    for (int i = 0; i < 2; ++i) { int R, C; stage_rc(tid * 16 + i * 8192, R, C); const int Rb = (R & ~31) + perm32(R & 31);
        voffA[i] = (unsigned)(R * g.lda + C) * 2u; voffB[i] = (unsigned)(Rb * K + C) * 2u; }
    const size_t kstep = (size_t)(BK * 2);
    const size_t hstepA = (size_t)HALF * g.lda * 2;
    const size_t hstepB = (size_t)HALF * K * 2;
    const size_t tstepB = 2 * hstepB;
    const unsigned ldsw = (unsigned)wid * 1024u;
    const int aoff = lds_byte(wr * 64 + fr, fq * 8), boff = lds_byte(wc * 32 + fr, fq * 8);
#define PG8_KOFF(kt) ((size_t)(kt) * kstep - ((shiftA && (kt) >= 16) ? (size_t)4096 : (size_t)0))
#define PG8_SA(b, h) (((b) * 2 + (h)) * HTB)
#define PG8_SB(b, h) ((4 + (b) * 2 + (h)) * HTB)
#define PG8_STAGE(bufoff, gbase, voff) do { _Pragma("unroll") for (int _i = 0; _i < 2; ++_i) \
        __builtin_amdgcn_global_load_lds((const unsigned*)((const char*)(gbase) + (voff)[_i]), (LAS unsigned*)(lds + (bufoff) + ldsw + _i * 8192), 16, 0, 0); } while (0)
#define PG8_LDA(dst, b, h) do { _Pragma("unroll") for (int m = 0; m < 4; ++m) _Pragma("unroll") for (int k = 0; k < 2; ++k) dst[m][k] = *(const LAS h16x8*)(lds + PG8_SA(b, h) + aoff + m * 2048 + k * 1024); } while (0)
#define PG8_LDB(dst, b, h) do { _Pragma("unroll") for (int n = 0; n < 2; ++n) _Pragma("unroll") for (int k = 0; k < 2; ++k) dst[n][k] = *(const LAS h16x8*)(lds + PG8_SB(b, h) + boff + n * 2048 + k * 1024); } while (0)
#define PG8_MMA(ai, bj, At, Bt) do { __builtin_amdgcn_s_setprio(1); _Pragma("unroll") for (int m = 0; m < 4; ++m) _Pragma("unroll") for (int n = 0; n < 2; ++n) _Pragma("unroll") for (int k = 0; k < 2; ++k) \
        acc[ai][bj][m][n] = __builtin_amdgcn_mfma_f32_16x16x32_f16(Bt[n][k], At[m][k], acc[ai][bj][m][n], 0, 0, 0); __builtin_amdgcn_s_setprio(0); } while (0)
#define PG8_WAIT_V(n) asm volatile("s_waitcnt vmcnt(" #n ")" ::: "memory")
#define PG8_WAIT_L(n) asm volatile("s_waitcnt lgkmcnt(" #n ")" ::: "memory")
#define PG8_BAR __builtin_amdgcn_s_barrier()
#define PG8_SCHED __builtin_amdgcn_sched_barrier(0)
    Unit cur, nxt; int ui = 0;
    if (!S.next(0, cur)) return;
    f32x4 acc[2][2][4][2];
#pragma unroll
    for (int a = 0; a < 2; ++a)
#pragma unroll
        for (int b = 0; b < 2; ++b)
#pragma unroll
            for (int m = 0; m < 4; ++m)
#pragma unroll
                for (int n = 0; n < 2; ++n) acc[a][b][m][n] = (f32x4){0.f, 0.f, 0.f, 0.f};
    h16x8 At[4][2], B0[2][2], B1[2][2];
    const char* cA = a_tile(g, cur.pm, cur.pn); const char* cB = (const char*)g.Bt + (size_t)cur.pn * tstepB;
    PG8_STAGE(PG8_SB(0, 0), cB, voffB); PG8_STAGE(PG8_SA(0, 0), cA, voffA); PG8_STAGE(PG8_SB(0, 1), cB + hstepB, voffB); PG8_STAGE(PG8_SA(0, 1), cA + hstepA, voffA);
    if (wr == 1) PG8_BAR;
    PG8_WAIT_V(4); PG8_BAR;
    PG8_STAGE(PG8_SB(1, 0), cB + kstep, voffB); PG8_STAGE(PG8_SA(1, 0), cA + kstep, voffA); PG8_STAGE(PG8_SB(1, 1), cB + hstepB + kstep, voffB);
    PG8_WAIT_V(6); PG8_BAR;
    for (;;) {
        const bool has_next = S.next(ui + 1, nxt);
        const char* nA = has_next ? a_tile(g, nxt.pm, nxt.pn) : cA; const char* nB = has_next ? (const char*)g.Bt + (size_t)nxt.pn * tstepB : cB;
        for (int t = 0; t < nt; t += 2) {
            const bool last = (t == nt - 2);
            const char* a1 = cA + PG8_KOFF(t + 1);
            const char* a2 = last ? nA : cA + PG8_KOFF(t + 2); const char* b2 = last ? nB : cB + (size_t)(t + 2) * kstep;
            const char* a3 = a2 + kstep; const char* b3 = b2 + kstep;
            PG8_LDB(B0, 0, 0); PG8_SCHED; PG8_LDA(At, 0, 0); PG8_STAGE(PG8_SA(1, 1), a1 + hstepA, voffA);
            PG8_WAIT_L(8); PG8_BAR; PG8_WAIT_L(0); PG8_MMA(0, 0, At, B0); PG8_BAR; PG8_SCHED;
            PG8_LDB(B1, 0, 1); PG8_STAGE(PG8_SB(0, 0), b2, voffB);
            PG8_BAR; PG8_WAIT_L(0); PG8_MMA(0, 1, At, B1); PG8_BAR;
            PG8_LDA(At, 0, 1); PG8_STAGE(PG8_SA(0, 0), a2, voffA);
            PG8_BAR; PG8_WAIT_L(0); PG8_MMA(1, 0, At, B0); PG8_BAR; PG8_SCHED;
            PG8_STAGE(PG8_SB(0, 1), b2 + hstepB, voffB);
            PG8_WAIT_V(6); PG8_BAR; PG8_MMA(1, 1, At, B1); PG8_BAR;
            PG8_LDB(B0, 1, 0); PG8_SCHED; PG8_LDA(At, 1, 0); PG8_STAGE(PG8_SA(0, 1), a2 + hstepA, voffA);
            PG8_WAIT_L(8); PG8_BAR; PG8_WAIT_L(0); PG8_MMA(0, 0, At, B0); PG8_BAR; PG8_SCHED;
            PG8_LDB(B1, 1, 1); PG8_STAGE(PG8_SB(1, 0), b3, voffB);
            PG8_BAR; PG8_WAIT_L(0); PG8_MMA(0, 1, At, B1); PG8_BAR;
            PG8_LDA(At, 1, 1); PG8_STAGE(PG8_SA(1, 0), a3, voffA);
            PG8_BAR; PG8_WAIT_L(0); PG8_MMA(1, 0, At, B0); PG8_BAR; PG8_SCHED;
            PG8_STAGE(PG8_SB(1, 1), b3 + hstepB, voffB);
            PG8_WAIT_V(6); PG8_BAR; PG8_MMA(1, 1, At, B1); PG8_BAR;
        }
        E(acc, cur, wr, wc, fr, fq);
        if (!has_next) break;
#pragma unroll
        for (int a = 0; a < 2; ++a)
#pragma unroll
            for (int b = 0; b < 2; ++b)
#pragma unroll
                for (int m = 0; m < 4; ++m)
#pragma unroll
                    for (int n = 0; n < 2; ++n) acc[a][b][m][n] = (f32x4){0.f, 0.f, 0.f, 0.f};
        cur = nxt; cA = nA; cB = nB; ++ui;
    }
    PG8_WAIT_V(0);
    if (wr == 0) PG8_BAR;
    PG8_BAR;
#undef PG8_KOFF
#undef PG8_SA
#undef PG8_SB
#undef PG8_STAGE
#undef PG8_LDA
#undef PG8_LDB
#undef PG8_MMA
#undef PG8_WAIT_V
#undef PG8_WAIT_L
#undef PG8_BAR
#undef PG8_SCHED
}
}

struct TJob { int mode; const float* src; int ld, K, N; h16* dst; int ldd, koff; const float* mix; };

__device__ __forceinline__ TJob get_job(const Params& p, int id) {
    TJob J; J.mode = 0; J.src = nullptr; J.ld = 0; J.K = 0; J.N = 0; J.dst = nullptr; J.ldd = 64; J.koff = 0; J.mix = nullptr;
    h16* W = (h16*)(p.ws + OFF_W);
    if (id < 24) {
        const int j = id / 12, s = id % 12;
        h16* Wrkv = W + (size_t)j * (10 * MiB); h16* Wl1 = Wrkv + 3 * MiB; h16* Wl2 = Wrkv + 7 * MiB;
        const float* mix = p.in[3] + j * 6 * 1024;
        if (s < 3) { J.mode = 0; J.src = p.in[4] + (size_t)(j * 3 + s) * 1048576; J.ld = 1024; J.K = 1024; J.N = 1024; J.dst = Wrkv + (size_t)s * 1024 * 1024; J.ldd = 1024; }
        else if (s < 8) {
            J.mode = 1; J.ld = 1024; J.K = 1024; J.ldd = 2048;
            if (s == 3) { J.src = p.in[6] + (size_t)j * 65536; J.ld = 64; J.N = 64; J.dst = Wl1; J.mix = mix + 3 * 1024; }
            else if (s == 4) { J.src = p.in[9] + (size_t)j * 65536; J.ld = 64; J.N = 64; J.dst = Wl1 + (size_t)64 * 2048; J.mix = mix + 4 * 1024; }
            else if (s == 5) { J.N = 32; J.dst = Wl1 + (size_t)128 * 2048; if (j == 1) { J.src = p.in[12]; J.ld = 32; J.mix = mix + 2 * 1024; } else { J.mode = 2; } }
            else if (s == 6) { J.src = p.in[14] + (size_t)j * 163840; J.ld = 160; J.N = 160; J.dst = Wl1 + (size_t)160 * 2048; J.mix = mix + 5 * 1024; }
            else { J.mode = 2; J.N = 192; J.dst = Wl1 + (size_t)320 * 2048; }
        } else {
            J.mode = 0; J.ld = 1024; J.N = 1024; J.ldd = 384;
            if (s == 8) { J.src = p.in[7] + (size_t)j * 65536; J.K = 64; J.koff = 0; J.dst = Wl2; }
            else if (s == 9) { J.src = p.in[10] + (size_t)j * 65536; J.K = 64; J.koff = 64; J.dst = Wl2 + (size_t)1024 * 384; }
            else if (s == 10) { J.src = p.in[15] + (size_t)j * 163840; J.K = 160; J.koff = 160; J.dst = Wl2 + (size_t)2048 * 384; }
            else { J.src = p.in[13]; J.K = 32; J.koff = 128; J.dst = Wl2 + (size_t)3072 * 384; if (j == 0) J.N = 0; }
        }
    } else if (id < 26) {
        const int j = id - 24;
        J.src = p.in[21] + (size_t)j * 1048576; J.ld = 1024; J.K = 1024; J.N = 1024; J.dst = W + (size_t)j * (10 * MiB) + 9 * MiB; J.ldd = 1024;
    } else if (id < 34) {
        const int i = (id - 26) >> 1, s = (id - 26) & 1;
        h16* base = W + 20 * MiB + (size_t)i * (17 * MiB / 2);
        if (s == 0) { J.src = p.in[33] + (size_t)i * 1024 * 5632; J.ld = 5632; J.K = 1024; J.N = 5632; J.dst = base; J.ldd = 1024; }
        else { J.src = p.in[36] + (size_t)i * 2816 * 1024; J.ld = 1024; J.K = 2816; J.N = 1024; J.dst = base + (size_t)11 * MiB / 2; J.ldd = 2816; }
    } else {
        const int j = (id - 34) >> 2, s = (id - 34) & 3;
        h16* base = W + 54 * MiB + (size_t)j * (5 * MiB / 2);
        if (s == 0) { J.src = p.in[22] + (size_t)j * 1024 * 456; J.ld = 456; J.K = 1024; J.N = 456; J.dst = base; J.ldd = 1024; }
        else if (s == 1) { J.mode = 2; J.N = 56; J.dst = base + (size_t)456 * 1024; J.ldd = 1024; }
        else if (s == 2) { J.src = p.in[28] + (size_t)j * 256 * 512; J.ld = 512; J.K = 256; J.N = 512; J.dst = base + MiB / 2 + (size_t)2048 * 256; J.ldd = 256; }
        else { J.src = p.in[31] + (size_t)j * 1048576; J.ld = 1024; J.K = 1024; J.N = 1024; J.dst = base + 3 * MiB / 2; J.ldd = 1024; }
    }
    return J;
}
__device__ __forceinline__ h16* w_rwkv_big(unsigned char* ws, int j) { return (h16*)(ws + OFF_W) + (size_t)j * (10 * MiB); }
__device__ __forceinline__ h16* w_rwkv_l1(unsigned char* ws, int j) { return w_rwkv_big(ws, j) + 3 * MiB; }
__device__ __forceinline__ h16* w_rwkv_l2(unsigned char* ws, int j) { return w_rwkv_big(ws, j) + 7 * MiB; }
__device__ __forceinline__ h16* w_rwkv_o(unsigned char* ws, int j) { return w_rwkv_big(ws, j) + 9 * MiB; }
__device__ __forceinline__ h16* w_ffn_up(unsigned char* ws, int i) { return (h16*)(ws + OFF_W) + 20 * MiB + (size_t)i * (17 * MiB / 2); }
__device__ __forceinline__ h16* w_ffn_dn(unsigned char* ws, int i) { return w_ffn_up(ws, i) + (size_t)11 * MiB / 2; }
__device__ __forceinline__ h16* w_dsa_in(unsigned char* ws, int j) { return (h16*)(ws + OFF_W) + 54 * MiB + (size_t)j * (5 * MiB / 2); }
__device__ __forceinline__ h16* w_dsa_q(unsigned char* ws, int j) { return w_dsa_in(ws, j) + MiB / 2; }
__device__ __forceinline__ h16* w_dsa_uvt(unsigned char* ws, int j) { return w_dsa_in(ws, j) + 5 * MiB / 4; }
__device__ __forceinline__ h16* w_dsa_o(unsigned char* ws, int j) { return w_dsa_in(ws, j) + 3 * MiB / 2; }

__device__ __forceinline__ void prep_phase(const Params& p, unsigned char* smem) {
    const int tid = opaque_tid();
    const size_t gtid = (size_t)blockIdx.x * 512 + tid, nth = (size_t)gridDim.x * 512;
    h16* x16 = (h16*)(p.ws + OFF_X16);
    for (size_t idx = gtid; idx < (size_t)MTOK * 128; idx += nth) {
        const int row = (int)(idx >> 7), c8 = (int)(idx & 127) * 8;
        const float* sp = p.in[0] + (size_t)row * 1024 + c8;
        const f32x4 a = *(const f32x4*)sp, b = *(const f32x4*)(sp + 4);
        *(u32x4*)(x16 + xrow(row) * 1024 + c8) = pack8(a, b);
    }
    for (size_t idx = gtid; idx < (size_t)NBATCH * 128; idx += nth) {
        const int b = (int)(idx >> 7), c8 = (int)(idx & 127) * 8;
        unsigned z = 0u; asm volatile("" : "+v"(z));
        *(u32x4*)(x16 + (size_t)b * 2049 * 1024 + c8) = (u32x4){z, z, z, z};
    }
    for (size_t it = gtid; it < (size_t)2 * 16 * 2048; it += nth) {
        const int j = (int)(it >> 15), rem = (int)(it & 32767), qg = rem >> 11, n = rem & 2047, h = n >> 7, c = n & 127;
        const float* uq = p.in[25] + (size_t)j * 256 * 1024 + (size_t)(qg * 16) * 1024 + h * 64;
        const float* uk = p.in[26] + (size_t)j * 16 * 64 * 128 + (size_t)h * 64 * 128 + c;
        float acc[16];
#pragma unroll
        for (int i = 0; i < 16; ++i) acc[i] = 0.f;
        for (int d = 0; d < 64; ++d) {
            const float kv = uk[d * 128];
#pragma unroll
            for (int i = 0; i < 16; ++i) acc[i] += uq[i * 1024 + d] * kv;
        }
        const float sc = 0.18033688011112042f;
        h16* dst = w_dsa_q(p.ws, j) + (size_t)n * 256 + qg * 16;
        *(u32x4*)dst = pack8((f32x4){acc[0] * sc, acc[1] * sc, acc[2] * sc, acc[3] * sc}, (f32x4){acc[4] * sc, acc[5] * sc, acc[6] * sc, acc[7] * sc});
        *(u32x4*)(dst + 8) = pack8((f32x4){acc[8] * sc, acc[9] * sc, acc[10] * sc, acc[11] * sc}, (f32x4){acc[12] * sc, acc[13] * sc, acc[14] * sc, acc[15] * sc});
    }
    for (size_t it = gtid; it < (size_t)2 * 128 * 1024; it += nth) {
        const int j = (int)(it >> 17), rem = (int)(it & 131071), kg = rem >> 10, n = rem & 1023, h = kg >> 3, c0 = (kg & 7) * 16;
        const float* uv = p.in[27] + (size_t)((j * 16 + h) * 128 + c0) * 64;
        const float* wo = p.in[31] + (size_t)j * 1048576 + (size_t)(h * 64) * 1024 + n;
        float acc[16];
#pragma unroll
        for (int i = 0; i < 16; ++i) acc[i] = 0.f;
        for (int v = 0; v < 64; ++v) {
            const float wv = wo[(size_t)v * 1024];
#pragma unroll
            for (int i = 0; i < 16; ++i) acc[i] += uv[i * 64 + v] * wv;
        }
        h16* dst = (h16*)(p.ws + OFF_WOV) + (size_t)j * 2097152 + (size_t)n * 2048 + h * 128 + c0;
        *(u32x4*)dst = pack8((f32x4){acc[0], acc[1], acc[2], acc[3]}, (f32x4){acc[4], acc[5], acc[6], acc[7]});
        *(u32x4*)(dst + 8) = pack8((f32x4){acc[8], acc[9], acc[10], acc[11]}, (f32x4){acc[12], acc[13], acc[14], acc[15]});
    }
    float* tile = (float*)smem;
    for (int id = 0; id < 42; ++id) {
        const TJob J = get_job(p, id);
        const int tk = J.ldd >> 6, tn = (J.N + 63) >> 6, ntile = tk * tn;
        for (int tix = blockIdx.x; tix < ntile; tix += gridDim.x) {
            const int k0 = (tix % tk) * 64, n0 = (tix / tk) * 64;
#pragma unroll
            for (int i = 0; i < 8; ++i) {
                const int k = i * 8 + (tid >> 6), n = tid & 63, kk = k0 + k, nn = n0 + n;
                float v = 0.f;
                if (nn < J.N && J.mode != 2) {
                    if (J.mode == 1) { const int ks = kk & 1023; const float mx = J.mix[ks]; v = J.src[(size_t)ks * J.ld + nn] * (kk < 1024 ? 1.0f - mx : mx); }
                    else if (kk >= J.koff && kk < J.koff + J.K) v = J.src[(size_t)(kk - J.koff) * J.ld + nn];
                }
                tile[k * 65 + n] = v;
            }
            __syncthreads();
#pragma unroll
            for (int i = 0; i < 8; ++i) {
                const int n = i * 8 + (tid >> 6), k = tid & 63, nn = n0 + n;
                if (nn < J.N) J.dst[(size_t)nn * J.ldd + k0 + k] = (h16)tile[k * 65 + n];
            }
            __syncthreads();
        }
    }
}

__device__ __forceinline__ void wave_sum4(float (&v)[4]) {
#pragma unroll
    for (int o = 32; o > 0; o >>= 1) {
        float t[4];
#pragma unroll
        for (int k = 0; k < 4; ++k) t[k] = __shfl_xor(v[k], o);
#pragma unroll
        for (int k = 0; k < 4; ++k) v[k] += t[k];
    }
}
__device__ __forceinline__ void ln_phase(const Params& p, const float* g, const float* b, bool final_out) {
    const int tid = opaque_tid();
    const int lane = tid & 63, wave = tid >> 6;
    float* tb = p.out;
    h16* x16 = (h16*)(p.ws + OFF_X16);
    f32x4 gg[4], bb[4];
#pragma unroll
    for (int i = 0; i < 4; ++i) { gg[i] = *(const f32x4*)(g + i * 256 + lane * 4); bb[i] = *(const f32x4*)(b + i * 256 + lane * 4); }
    for (int rowb = (blockIdx.x * 8 + wave) * 4; rowb < MTOK; rowb += gridDim.x * 32) {
        f32x4 v[4][4];
        float s[4];
#pragma unroll
        for (int k = 0; k < 4; ++k) {
            s[k] = 0.f;
            if (final_out) {
                const float* rp = tb + (size_t)(rowb + k) * 1024;
#pragma unroll
                for (int i = 0; i < 4; ++i) v[k][i] = *(const f32x4*)(rp + i * 256 + lane * 4);
            } else {
                const h16* hp = (const h16*)tb + (size_t)(rowb + k) * 1024;
#pragma unroll
                for (int i = 0; i < 4; ++i) { const h16x4 hv = *(const h16x4*)(hp + i * 256 + lane * 4); v[k][i] = (f32x4){(float)hv[0], (float)hv[1], (float)hv[2], (float)hv[3]}; }
            }
#pragma unroll
            for (int i = 0; i < 4; ++i) s[k] += (v[k][i][0] + v[k][i][1]) + (v[k][i][2] + v[k][i][3]);
        }
        wave_sum4(s);
        float q[4];
#pragma unroll
        for (int k = 0; k < 4; ++k) {
            s[k] *= (1.0f / 1024.0f); q[k] = 0.f;
#pragma unroll
            for (int i = 0; i < 4; ++i)
#pragma unroll
                for (int jj = 0; jj < 4; ++jj) { const float d = v[k][i][jj] - s[k]; q[k] += d * d; }
        }
        wave_sum4(q);
#pragma unroll
        for (int k = 0; k < 4; ++k) {
            const float rstd = rsqrtf(q[k] * (1.0f / 1024.0f) + 1e-5f);
            const int row = rowb + k;
#pragma unroll
            for (int i = 0; i < 4; ++i) {
                f32x4 y;
#pragma unroll
                for (int jj = 0; jj < 4; ++jj) y[jj] = (v[k][i][jj] - s[k]) * rstd * gg[i][jj] + bb[i][jj];
                if (final_out) *(f32x4*)(tb + (size_t)row * 1024 + i * 256 + lane * 4) = y;
                else { u32x2 w; w.x = pk2(y[0], y[1]); w.y = pk2(y[2], y[3]); *(u32x2*)(x16 + xrow(row) * 1024 + i * 256 + lane * 4) = w; }
            }
        }
    }
}

__device__ __forceinline__ void conv_phase(const Params& p, int layer) {
    const h16* u = (const h16*)(p.ws + F_U16);
    h16* act = (h16*)(p.ws + F_ACT);
    const float* cw = p.in[34] + (size_t)layer * 3 * 5632;
    const float* cb = p.in[35] + (size_t)layer * 5632;
    const size_t gtid = (size_t)blockIdx.x * 512 + opaque_tid(), nth = (size_t)gridDim.x * 512;
    const size_t ntask = (size_t)2048 * 352;
    for (size_t task = gtid; task < ntask; task += nth) {
        const int cgp = (int)(task % 352), rc = (int)(task / 352), f = cgp * 8, r0 = rc * 16;
        float wg[3][8], wv[3][8], bg[8], bv[8];
#pragma unroll
        for (int jj = 0; jj < 3; ++jj)
#pragma unroll
            for (int hlf = 0; hlf < 2; ++hlf) {
                const f32x4 a = *(const f32x4*)(cw + jj * 5632 + f + hlf * 4), c = *(const f32x4*)(cw + jj * 5632 + DFF + f + hlf * 4);
#pragma unroll
                for (int e = 0; e < 4; ++e) { wg[jj][hlf * 4 + e] = a[e]; wv[jj][hlf * 4 + e] = c[e]; }
            }
#pragma unroll
        for (int hlf = 0; hlf < 2; ++hlf) {
            const f32x4 a = *(const f32x4*)(cb + f + hlf * 4), c = *(const f32x4*)(cb + DFF + f + hlf * 4);
#pragma unroll
            for (int e = 0; e < 4; ++e) { bg[hlf * 4 + e] = a[e]; bv[hlf * 4 + e] = c[e]; }
        }
        float g2[8], g1[8], v2[8], v1[8];
#pragma unroll
        for (int e = 0; e < 8; ++e) { g2[e] = 0.f; g1[e] = 0.f; v2[e] = 0.f; v1[e] = 0.f; }
        if ((r0 & 2047) != 0) {
            unpack8(*(const u32x4*)(u + (size_t)(r0 - 2) * 5632 + f), g2); unpack8(*(const u32x4*)(u + (size_t)(r0 - 1) * 5632 + f), g1);
            unpack8(*(const u32x4*)(u + (size_t)(r0 - 2) * 5632 + DFF + f), v2); unpack8(*(const u32x4*)(u + (size_t)(r0 - 1) * 5632 + DFF + f), v1);
        }
#pragma unroll 1
        for (int i0 = 0; i0 < 16; i0 += 4) {
            u32x4 lg[4], lv[4];
#pragma unroll
            for (int i = 0; i < 4; ++i) { const size_t ro = (size_t)(r0 + i0 + i) * 5632; lg[i] = *(const u32x4*)(u + ro + f); lv[i] = *(const u32x4*)(u + ro + DFF + f); }
#pragma unroll
            for (int i = 0; i < 4; ++i) {
                float g0[8], v0[8], o[8];
                unpack8(lg[i], g0); unpack8(lv[i], v0);
#pragma unroll
                for (int e = 0; e < 8; ++e) {
                    const float G = wg[0][e] * g2[e] + wg[1][e] * g1[e] + wg[2][e] * g0[e] + bg[e];
                    const float V = wv[0][e] * v2[e] + wv[1][e] * v1[e] + wv[2][e] * v0[e] + bv[e];
                    o[e] = G * sigmoidf_(G) * V;
                    g2[e] = g1[e]; g1[e] = g0[e]; v2[e] = v1[e]; v1[e] = v0[e];
                }
                *(u32x4*)(act + (size_t)(r0 + i0 + i) * DFF + f) = pack8((f32x4){o[0], o[1], o[2], o[3]}, (f32x4){o[4], o[5], o[6], o[7]});
            }
        }
    }
}

__device__ __forceinline__ void mix_phase(const Params& p, int j) {
    const h16* x16 = (const h16*)(p.ws + OFF_X16);
    h16* xr = (h16*)p.out; h16* xk = (h16*)p.out + (size_t)MTOK * 1024; h16* xv = (h16*)(p.ws + R_G16);
    const float* mix = p.in[3] + j * 6 * 1024;
    const size_t gtid = (size_t)blockIdx.x * 512 + opaque_tid(), nth = (size_t)gridDim.x * 512;
    for (size_t idx = gtid; idx < (size_t)MTOK * 128; idx += nth) {
        const int row = (int)(idx >> 7), c8 = (int)(idx & 127) * 8;
        const h16* xp = x16 + xrow(row) * 1024 + c8;
        float xc[8], xq[8];
        unpack8(*(const u32x4*)xp, xc); unpack8(*(const u32x4*)(xp - 1024), xq);
#pragma unroll
        for (int e = 0; e < 8; ++e) xq[e] -= xc[e];
        const size_t o = (size_t)row * 1024 + c8;
#pragma unroll
        for (int bsel = 0; bsel < 3; ++bsel) {
            const f32x4 m0 = *(const f32x4*)(mix + bsel * 1024 + c8), m1 = *(const f32x4*)(mix + bsel * 1024 + c8 + 4);
            f32x4 a, b;
#pragma unroll
            for (int e = 0; e < 4; ++e) { a[e] = xc[e] + xq[e] * m0[e]; b[e] = xc[4 + e] + xq[4 + e] * m1[e]; }
            h16* dst = bsel == 0 ? xr : (bsel == 1 ? xk : xv);
            *(u32x4*)(dst + o) = pack8(a, b);
        }
    }
}

__device__ __forceinline__ float dppf(float x, const int ctrl_sel) {
    const int v = __builtin_bit_cast(int, x);
    int r;
    if (ctrl_sel == 0) r = __builtin_amdgcn_update_dpp(0, v, 0xB1, 0xF, 0xF, true);
    else if (ctrl_sel == 1) r = __builtin_amdgcn_update_dpp(0, v, 0x4E, 0xF, 0xF, true);
    else if (ctrl_sel == 2) r = __builtin_amdgcn_update_dpp(0, v, 0x141, 0xF, 0xF, true);
    else r = __builtin_amdgcn_update_dpp(0, v, 0x140, 0xF, 0xF, true);
    return __builtin_bit_cast(float, r);
}
__device__ __forceinline__ float red4(float x) { x += dppf(x, 0); x += dppf(x, 1); return x; }
__device__ __forceinline__ float red16(float x) { x += dppf(x, 0); x += dppf(x, 1); x += dppf(x, 2); x += dppf(x, 3); return x; }
__device__ __forceinline__ void unpack4(u32x2 w, float* f) {
    h16x4 h = __builtin_bit_cast(h16x4, w);
#pragma unroll
    for (int i = 0; i < 4; ++i) f[i] = (float)h[i];
}
constexpr int SCAN_BUF = 8256;
__device__ __forceinline__ void scan_phase(const Params& p, int j, unsigned char* smem) {
    const int tid = opaque_tid();
    const int wave = tid >> 6, lane = tid & 63, slot = wave >> 2, w4 = wave & 3;
    float* LB = (float*)smem + slot * (2 * SCAN_BUF);
    const h16* r16 = (const h16*)(p.ws + R_R16);
    const h16* k16 = (const h16*)(p.ws + R_K16);
    const h16* v16 = (j == 0) ? (const h16*)(p.ws + OFF_VF) : (const h16*)(p.ws + R_V16);
    const h16* g16 = (const h16*)(p.ws + R_G16);
    const h16* e16 = (const h16*)p.out;
    const h16* a16 = (const h16*)p.out + (size_t)MTOK * 1024;
    h16* y16 = (h16*)(p.ws + (j == 0 ? R_V16 : OFF_VF));
    const int tp = w4 * 4 + (lane >> 4), k4 = (lane & 15) * 4;
    const int vrow = w4 * 16 + (lane >> 2), kq = lane & 3;
    for (int pair = blockIdx.x; pair < 256; pair += gridDim.x) {
        const int chain = pair * 2 + slot, b = chain >> 4, h = chain & 15;
        const int col = h * 64 + k4;
        const f32x4 c_kk = *(const f32x4*)(p.in[16] + j * 1024 + col), c_ka = *(const f32x4*)(p.in[17] + j * 1024 + col), c_rk = *(const f32x4*)(p.in[18] + j * 1024 + col);
        const f32x4 c_lg = *(const f32x4*)(p.in[19] + j * 1024 + col), c_lb = *(const f32x4*)(p.in[20] + j * 1024 + col);
        f32x2 S[8];
#pragma unroll
        for (int i = 0; i < 8; ++i) S[i] = (f32x2){0.f, 0.f};
        u32x2 pr[6];
        {
            const size_t go = ((size_t)(b * 2048 + tp)) * 1024 + col;
            pr[0] = *(const u32x2*)(r16 + go); pr[1] = *(const u32x2*)(k16 + go); pr[2] = *(const u32x2*)(v16 + go);
            pr[3] = *(const u32x2*)(e16 + go); pr[4] = *(const u32x2*)(a16 + go); pr[5] = *(const u32x2*)(g16 + go);
        }
        for (int ch = 0; ch < 128; ++ch) {
            float* BUF = LB + (ch & 1) * SCAN_BUF;
            float* OPS = BUF; float* VB = BUF + 5120; float* GB = BUF + 6144; float* YB = BUF + 7168; float* BON = BUF + 8192;
            {
                float rf[4], kf[4], vf[4], ef[4], af[4], gf[4];
                unpack4(pr[0], rf); unpack4(pr[1], kf); unpack4(pr[2], vf); unpack4(pr[3], ef); unpack4(pr[4], af); unpack4(pr[5], gf);
                float kk[4]; float ss = 0.f;
#pragma unroll
                for (int i = 0; i < 4; ++i) { kk[i] = kf[i] * c_kk[i]; ss += kk[i] * kk[i]; }
                ss = red16(ss);
                const float inv = 1.0f / fmaxf(sqrtf(ss), 1e-12f);
                f32x4 A4, B4, W4, K4, R4; float bs = 0.f;
#pragma unroll
                for (int i = 0; i < 4; ++i) {
                    const float kn = kk[i] * inv;
                    A4[i] = -kn; B4[i] = kn * af[i];
                    W4[i] = __expf(-ef[i]);
                    const float km = kf[i] * (1.0f + (af[i] - 1.0f) * c_ka[i]);
                    K4[i] = km; R4[i] = rf[i];
                    bs += rf[i] * km * c_rk[i];
                }
                bs = red16(bs);
                float* o = OPS + tp * 320 + k4;
                *(f32x4*)(o) = A4; *(f32x4*)(o + 64) = B4; *(f32x4*)(o + 128) = W4; *(f32x4*)(o + 192) = K4; *(f32x4*)(o + 256) = R4;
                *(f32x4*)(VB + tp * 64 + k4) = (f32x4){vf[0], vf[1], vf[2], vf[3]};
                *(f32x4*)(GB + tp * 64 + k4) = (f32x4){gf[0], gf[1], gf[2], gf[3]};
                if ((lane & 15) == 0) BON[tp] = bs;
            }
            if (ch + 1 < 128) {
                const size_t go = ((size_t)(b * 2048 + (ch + 1) * 16 + tp)) * 1024 + col;
                pr[0] = *(const u32x2*)(r16 + go); pr[1] = *(const u32x2*)(k16 + go); pr[2] = *(const u32x2*)(v16 + go);
                pr[3] = *(const u32x2*)(e16 + go); pr[4] = *(const u32x2*)(a16 + go); pr[5] = *(const u32x2*)(g16 + go);
            }
            __syncthreads();
#pragma unroll 2
            for (int t = 0; t < 16; ++t) {
                const float* op = OPS + t * 320 + kq * 16;
                f32x4 A4[4], B4[4], W4[4], K4[4], R4[4];
#pragma unroll
                for (int i = 0; i < 4; ++i) A4[i] = *(const f32x4*)(op + i * 4);
#pragma unroll
                for (int i = 0; i < 4; ++i) { W4[i] = *(const f32x4*)(op + 128 + i * 4); B4[i] = *(const f32x4*)(op + 64 + i * 4); K4[i] = *(const f32x4*)(op + 192 + i * 4); }
#pragma unroll
                for (int i = 0; i < 4; ++i) R4[i] = *(const f32x4*)(op + 256 + i * 4);
                const float vv = VB[t * 64 + vrow];
                f32x2 s0 = {0.f, 0.f}, s1 = {0.f, 0.f};
#pragma unroll
                for (int i = 0; i < 4; ++i) { s0 += S[2 * i] * (f32x2){A4[i][0], A4[i][1]}; s1 += S[2 * i + 1] * (f32x2){A4[i][2], A4[i][3]}; }
                const float sa = red4((s0[0] + s0[1]) + (s1[0] + s1[1]));
                const f32x2 sa2 = {sa, sa}, vv2 = {vv, vv};
#pragma unroll
                for (int i = 0; i < 4; ++i) {
                    S[2 * i] = S[2 * i] * (f32x2){W4[i][0], W4[i][1]} + sa2 * (f32x2){B4[i][0], B4[i][1]} + vv2 * (f32x2){K4[i][0], K4[i][1]};
                    S[2 * i + 1] = S[2 * i + 1] * (f32x2){W4[i][2], W4[i][3]} + sa2 * (f32x2){B4[i][2], B4[i][3]} + vv2 * (f32x2){K4[i][2], K4[i][3]};
                }
                f32x2 y0 = {0.f, 0.f}, y1 = {0.f, 0.f};
#pragma unroll
                for (int i = 0; i < 4; ++i) { y0 += S[2 * i] * (f32x2){R4[i][0], R4[i][1]}; y1 += S[2 * i + 1] * (f32x2){R4[i][2], R4[i][3]}; }
                const float y = red4((y0[0] + y0[1]) + (y1[0] + y1[1]));
                if (kq == 0) YB[t * 64 + vrow] = y;
            }
            __syncthreads();
            {
                const f32x4 y4 = *(const f32x4*)(YB + tp * 64 + k4), v4 = *(const f32x4*)(VB + tp * 64 + k4), g4 = *(const f32x4*)(GB + tp * 64 + k4);
                const float mu = red16((y4[0] + y4[1]) + (y4[2] + y4[3])) * (1.0f / 64.0f);
                float q = 0.f;
#pragma unroll
                for (int i = 0; i < 4; ++i) { const float d = y4[i] - mu; q += d * d; }
                const float rstd = rsqrtf(red16(q) * (1.0f / 64.0f) + 64e-5f);
                const float bon = BON[tp];
                float o[4];
#pragma unroll
                for (int i = 0; i < 4; ++i) o[i] = ((y4[i] - mu) * rstd * c_lg[i] + c_lb[i] + bon * v4[i]) * g4[i];
                u32x2 w; w.x = pk2(o[0], o[1]); w.y = pk2(o[2], o[3]);
                *(u32x2*)(y16 + ((size_t)(b * 2048 + ch * 16 + tp)) * 1024 + col) = w;
            }
        }
        __syncthreads();
    }
}

__device__ __forceinline__ void dsa_norm_phase(const Params& p, int j, unsigned char* smem) {
    const int tid = opaque_tid();
    const int lane = tid & 63, wave = tid >> 6;
    const float* hin = (const float*)(p.ws + D_HIN);
    h16* cq = (h16*)(p.ws + D_CQ); h16* ckv = (h16*)(p.ws + D_CKV); h16* ckvt = (h16*)(p.ws + D_CKVT); h16* kidx = (h16*)(p.ws + D_KIDX);
    float* widx = (float*)(p.ws + D_WIDX);
    const f32x4 gq = *(const f32x4*)(p.in[23] + j * 256 + lane * 4);
    const f32x2 gkv = *(const f32x2*)(p.in[24] + j * 128 + lane * 2);
    const float gi = p.in[29][j * 64 + lane], bi = p.in[30][j * 64 + lane];
    h16* wl = (h16*)(smem + wave * 2048);
    for (int grp = blockIdx.x * 8 + wave; grp < MTOK / 8; grp += gridDim.x * 8) {
        const int r0 = grp * 8;
        for (int i = 0; i < 8; ++i) {
            const int row = r0 + i;
            const float* hp = hin + (size_t)row * 512;
            const f32x4 vq = *(const f32x4*)(hp + lane * 4);
            const f32x2 vk = *(const f32x2*)(hp + 256 + lane * 2);
            const float vi = hp[384 + lane];
            float ssq = wave_sum(vq[0] * vq[0] + vq[1] * vq[1] + vq[2] * vq[2] + vq[3] * vq[3]);
            const float rq = rsqrtf(ssq * (1.0f / 256.0f) + 1e-6f);
            u32x2 w; w.x = pk2(vq[0] * rq * gq[0], vq[1] * rq * gq[1]); w.y = pk2(vq[2] * rq * gq[2], vq[3] * rq * gq[3]);
            *(u32x2*)(cq + (size_t)row * 256 + lane * 4) = w;
            float ssk = wave_sum(vk[0] * vk[0] + vk[1] * vk[1]);
            const float rk = rsqrtf(ssk * (1.0f / 128.0f) + 1e-6f);
            const unsigned wk = pk2(vk[0] * rk * gkv[0], vk[1] * rk * gkv[1]);
            *(unsigned*)(ckv + (size_t)row * 128 + lane * 2) = wk;
            const float mu = wave_sum(vi) * (1.0f / 64.0f);
            const float dv = vi - mu;
            const float var = wave_sum(dv * dv) * (1.0f / 64.0f);
            kidx[(size_t)row * 64 + lane] = (h16)(dv * rsqrtf(var + 1e-5f) * gi + bi);
            if (lane < 8) widx[(size_t)row * 8 + lane] = hp[448 + lane] * 0.044194173824159216f;
        }
    }
}

constexpr int ROWP = 2052;
__device__ __forceinline__ unsigned fkey(float x) {
    if (x == 0.0f) x = 0.0f;
    const unsigned u = __float_as_uint(x);
    return (u & 0x80000000u) ? ~u : (u | 0x80000000u);
}
__device__ __forceinline__ void dsa_index_phase(const Params& p, unsigned char* smem) {
    const int tid = opaque_tid(), wave = tid >> 6, lane = tid & 63, r = lane & 15, q = lane >> 4;
    float* SC = (float*)smem;
    const h16* qidx = (const h16*)(p.ws + D_QIDX);
    const h16* kidx = (const h16*)(p.ws + D_KIDX);
    const float* widx = (const float*)(p.ws + D_WIDX);
    unsigned short* selout = (unsigned short*)(p.ws + D_MASK);
    for (int qi = blockIdx.x, it = 0; qi < MTOK / 16; qi += gridDim.x, ++it) {
        const int qt = (it & 1) ? ((qi & ~127) | (127 - (qi & 127))) : qi;
        const int row0 = qt * 16, b = row0 >> 11, t0 = row0 & 2047;
        const int nkt = (t0 >> 4) + 1;
        {
            h16x8 qf[8][2]; float wq[8];
#pragma unroll
            for (int h = 0; h < 8; ++h) {
#pragma unroll
                for (int kk = 0; kk < 2; ++kk) qf[h][kk] = *(const h16x8*)(qidx + (size_t)(row0 + r) * 512 + h * 64 + kk * 32 + q * 8);
                wq[h] = widx[(size_t)(row0 + r) * 8 + h];
            }
            for (int kt = wave; kt < nkt; kt += 16) {
                const bool two = (kt + 8 < nkt);
                const int s0 = kt * 16, s1 = two ? s0 + 128 : s0;
                const h16* kp = kidx + (size_t)(b * 2048 + s0 + r) * 64 + q * 8;
                const h16* kp1 = kidx + (size_t)(b * 2048 + s1 + r) * 64 + q * 8;
                const h16x8 k0 = *(const h16x8*)kp, k1 = *(const h16x8*)(kp + 32), k2 = *(const h16x8*)kp1, k3 = *(const h16x8*)(kp1 + 32);
                f32x4 sc = {0.f, 0.f, 0.f, 0.f}, sd = {0.f, 0.f, 0.f, 0.f};
#pragma unroll
                for (int h = 0; h < 8; ++h) {
                    f32x4 acc = {0.f, 0.f, 0.f, 0.f}, acd = {0.f, 0.f, 0.f, 0.f};
                    acc = __builtin_amdgcn_mfma_f32_16x16x32_f16(k0, qf[h][0], acc, 0, 0, 0);
                    acd = __builtin_amdgcn_mfma_f32_16x16x32_f16(k2, qf[h][0], acd, 0, 0, 0);
                    acc = __builtin_amdgcn_mfma_f32_16x16x32_f16(k1, qf[h][1], acc, 0, 0, 0);
                    acd = __builtin_amdgcn_mfma_f32_16x16x32_f16(k3, qf[h][1], acd, 0, 0, 0);
#pragma unroll
                    for (int jj = 0; jj < 4; ++jj) { sc[jj] += fmaxf(acc[jj], 0.f) * wq[h]; sd[jj] += fmaxf(acd[jj], 0.f) * wq[h]; }
                }
                *(f32x4*)(SC + r * ROWP + s0 + q * 4) = sc;
                if (two) *(f32x4*)(SC + r * ROWP + s1 + q * 4) = sd;
            }
        }
        __syncthreads();
        for (int qq = 0; qq < 2; ++qq) {
            const int ql = wave * 2 + qq, t = t0 + ql;
            const float* srow = SC + ql * ROWP;
            const int ni = (t >> 6) + 1;
            unsigned u[32];
#pragma unroll
            for (int i = 0; i < 32; ++i) {
                u[i] = 0u;
                if (i < ni) { const int s = i * 64 + lane; if (s <= t) u[i] = fkey(srow[s]); }
            }
            unsigned short* selrow = selout + (size_t)(row0 + ql) * 256;
            if (t < 256) {
#pragma unroll
                for (int i = 0; i < 4; ++i) { const int pp = i * 64 + lane; selrow[pp] = (unsigned short)(pp <= t ? pp : 0xFFFF); }
            } else {
                unsigned* H = (unsigned*)(smem + 16 * ROWP * 4) + wave * 256;
                unsigned prefix = 0u; int need = 256;
#pragma unroll 1
                for (int pass = 0; pass < 4; ++pass) {
                    const int shift = 24 - 8 * pass;
                    const unsigned hmask = pass == 0 ? 0u : (0xFFFFFFFFu << (shift + 8));
                    *(u32x4*)(H + lane * 4) = (u32x4){0u, 0u, 0u, 0u};
                    asm volatile("s_waitcnt lgkmcnt(0)" ::: "memory");
#pragma unroll
                    for (int i = 0; i < 32; ++i) if (i < ni) { const unsigned uu = u[i]; if (uu != 0u && (uu & hmask) == prefix) atomicAdd(H + ((uu >> shift) & 255u), 1u); }
                    asm volatile("s_waitcnt lgkmcnt(0)" ::: "memory");
                    const u32x4 hv = *(const u32x4*)(H + lane * 4);
                    const int tot = (int)(hv.x + hv.y + hv.z + hv.w);
                    int rs = tot;
                    rs += __builtin_amdgcn_update_dpp(0, rs, 0xB1, 0xF, 0xF, true);
                    rs += __builtin_amdgcn_update_dpp(0, rs, 0x4E, 0xF, 0xF, true);
                    rs += __builtin_amdgcn_update_dpp(0, rs, 0x141, 0xF, 0xF, true);
                    rs += __builtin_amdgcn_update_dpp(0, rs, 0x140, 0xF, 0xF, true);
                    int rowsel = 3, above = 0;
                    {
                        const int r3 = __builtin_amdgcn_readlane(rs, 48), r2 = __builtin_amdgcn_readlane(rs, 32), r1 = __builtin_amdgcn_readlane(rs, 16);
                        if (need > r3) { above = r3; rowsel = 2; if (need > above + r2) { above += r2; rowsel = 1; if (need > above + r1) { above += r1; rowsel = 0; } } }
                    }
                    int lsel = rowsel * 16;
                    for (int k = 15; k >= 0; --k) {
                        const int cl = __builtin_amdgcn_readlane(tot, rowsel * 16 + k);
                        if (need <= above + cl) { lsel = rowsel * 16 + k; break; }
                        above += cl;
                    }
                    const int b3 = __builtin_amdgcn_readlane((int)hv.w, lsel), b2 = __builtin_amdgcn_readlane((int)hv.z, lsel), b1 = __builtin_amdgcn_readlane((int)hv.y, lsel);
                    int bsel = 3;
                    if (need > above + b3) { above += b3; bsel = 2; if (need > above + b2) { above += b2; bsel = 1; if (need > above + b1) { above += b1; bsel = 0; } } }
                    prefix |= (unsigned)(lsel * 4 + bsel) << shift;
                    need -= above;
                }
                const unsigned T = prefix;
                int running = 0, outpos = 0;
                const unsigned long long lt = (lane == 0) ? 0ull : (~0ull >> (64 - lane));
#pragma unroll
                for (int i = 0; i < 32; ++i) {
                    if (i < ni) {
                        const unsigned long long eq = __ballot(u[i] == T);
                        const int rank = running + __popcll(eq & lt);
                        const bool sel = u[i] > T || (u[i] == T && rank < need);
                        const unsigned long long sm = __ballot(sel);
                        running += __popcll(eq);
                        if (sel) selrow[outpos + __popcll(sm & lt)] = (unsigned short)(i * 64 + lane);
                        outpos += __popcll(sm);
                    }
                }
            }
        }
        __syncthreads();
    }
}

__device__ __forceinline__ float xmax_16_32(float x) {
    const unsigned u = __builtin_bit_cast(unsigned, x);
    auto r = __builtin_amdgcn_permlane16_swap(u, u, false, false);
    float m = fmaxf(__builtin_bit_cast(float, (unsigned)r[0]), __builtin_bit_cast(float, (unsigned)r[1]));
    const unsigned u2 = __builtin_bit_cast(unsigned, m);
    auto r2 = __builtin_amdgcn_permlane32_swap(u2, u2, false, false);
    return fmaxf(__builtin_bit_cast(float, (unsigned)r2[0]), __builtin_bit_cast(float, (unsigned)r2[1]));
}
__device__ __forceinline__ float xsum_16_32(float x) {
    const unsigned u = __builtin_bit_cast(unsigned, x);
    auto r = __builtin_amdgcn_permlane16_swap(u, u, false, false);
    float m = __builtin_bit_cast(float, (unsigned)r[0]) + __builtin_bit_cast(float, (unsigned)r[1]);
    const unsigned u2 = __builtin_bit_cast(unsigned, m);
    auto r2 = __builtin_amdgcn_permlane32_swap(u2, u2, false, false);
    return __builtin_bit_cast(float, (unsigned)r2[0]) + __builtin_bit_cast(float, (unsigned)r2[1]);
}
typedef __fp16 fp16x4_t __attribute__((__vector_size__(4 * sizeof(__fp16))));
__device__ __forceinline__ unsigned off_b(unsigned row, unsigned ch) { return 256u * row + 16u * (ch ^ (((row & 3) << 2) | ((row >> 2) & 3))); }
constexpr int SA_TILE = 8192, SA_BL = 8 * 2 * SA_TILE;
static_assert(SA_BL + 16 * 132 * 4 <= LDS_BYTES, "sparse attention LDS");
__device__ __forceinline__ void dsa_attn_phase(const Params& p, int j, unsigned char* smem) {
    const int tid = opaque_tid(), wave = tid >> 6, lane = tid & 63, r = lane & 15, q = lane >> 4;
    float* BL = (float*)(smem + SA_BL);
    for (int idx = tid; idx < 16 * 129; idx += 512) {
        const int h = idx / 129, d = idx % 129;
        int bk = d;
        if (d >= 16) { bk = 16 + (int)(logf((float)d * (1.0f / 16.0f)) / 2.0794415416798357f * 16.0f); bk = bk > 31 ? 31 : bk; }
        BL[h * 132 + d] = p.in[32][bk * 16 + h] * 1.4426950408889634f;
    }
    __syncthreads();
    const h16* qabs = (const h16*)(p.ws + D_QABS);
    const h16* ckv = (const h16*)(p.ws + D_CKV);
    const unsigned short* sel = (const unsigned short*)(p.ws + D_MASK);
    h16* olatA = (h16*)(p.ws + D_HIN);
    h16* olatB = (h16*)p.out + (size_t)MTOK * 1024;
    unsigned char* tile0 = smem + wave * (2 * SA_TILE);
    const float NINF = -__builtin_inff();
    unsigned wofs[8], kofs[2][4], vofs[8][2];
#pragma unroll
    for (int i = 0; i < 8; ++i) wofs[i] = off_b(8 * q + i, r);
#pragma unroll
    for (int tt = 0; tt < 2; ++tt)
#pragma unroll
        for (int kk = 0; kk < 4; ++kk) kofs[tt][kk] = off_b(8 * (r >> 2) + 4 * tt + (r & 3), 4 * kk + q);
#pragma unroll
    for (int c = 0; c < 8; ++c)
#pragma unroll
        for (int t2 = 0; t2 < 2; ++t2) vofs[c][t2] = off_b(8 * q + 4 * t2 + (r >> 2), 2 * c + ((lane & 3) >> 1)) + 8 * (lane & 1);
    for (int row = blockIdx.x * 8 + wave; row < MTOK; row += gridDim.x * 8) {
        const int b = row >> 11, t = row & 2047;
        const int nvalid = t + 1 < 256 ? t + 1 : 256, ng = (nvalid + 31) >> 5;
        const h16* kg = ckv + (size_t)(b * 2048) * 128;
        const unsigned short* srow = sel + (size_t)row * 256;
        h16x8 qf[4];
#pragma unroll
        for (int kk = 0; kk < 4; ++kk) qf[kk] = *(const h16x8*)(qabs + (size_t)row * 2048 + r * 128 + kk * 32 + q * 8);
        f32x4 O[8];
#pragma unroll
        for (int dt = 0; dt < 8; ++dt) O[dt] = (f32x4){0.f, 0.f, 0.f, 0.f};
        float mrun = NINF, lrun = 0.f;
        u32x4 selA = *(const u32x4*)(srow + 8 * q), selB = selA;
        u32x4 grA[8], grB[8];
#define SA_GATHER(GR, SELV) do { _Pragma("unroll") for (int i = 0; i < 8; ++i) { \
            unsigned sidx = ((SELV)[i >> 1] >> ((i & 1) * 16)) & 0xFFFFu; sidx = sidx == 0xFFFFu ? 0u : sidx; \
            (GR)[i] = *(const u32x4*)(kg + (size_t)sidx * 128 + r * 8); } } while (0)
#define SA_GROUP(GR, SELV, G) do { \
            unsigned char* tile = tile0 + ((G) & 1) * SA_TILE; \
            const u32x4 selc = (SELV); \
            _Pragma("unroll") for (int i = 0; i < 8; ++i) *(u32x4*)(tile + wofs[i]) = (GR)[i]; \
            if ((G) + 2 < ng) { (SELV) = *(const u32x4*)(srow + ((G) + 2) * 32 + 8 * q); SA_GATHER(GR, SELV); } \
            asm volatile("s_waitcnt lgkmcnt(0)" ::: "memory"); \
            f32x4 sc[2]; \
            _Pragma("unroll") for (int tt = 0; tt < 2; ++tt) { \
                f32x4 acc = {0.f, 0.f, 0.f, 0.f}; \
                _Pragma("unroll") for (int kk = 0; kk < 4; ++kk) { \
                    const h16x8 kf = *(const h16x8*)(tile + kofs[tt][kk]); \
                    acc = __builtin_amdgcn_mfma_f32_16x16x32_f16(kf, qf[kk], acc, 0, 0, 0); } \
                sc[tt] = acc; } \
            float x[8]; float mx = NINF; \
            _Pragma("unroll") for (int i = 0; i < 8; ++i) { \
                const unsigned sidx = (selc[i >> 1] >> ((i & 1) * 16)) & 0xFFFFu; \
                int dist = t - (int)sidx; dist = dist < 0 ? 0 : (dist > 128 ? 128 : dist); \
                const float v = sc[i >> 2][i & 3] + BL[r * 132 + dist]; \
                const float xv = (sidx != 0xFFFFu) ? v : NINF; \
                x[i] = xv; mx = fmaxf(mx, xv); } \
            mx = xmax_16_32(mx); \
            const float mnew = fmaxf(mrun, mx); \
            const float mref = (mnew == NINF) ? 0.f : mnew; \
            const float alpha = __builtin_amdgcn_exp2f(mrun - mref); \
            mrun = mnew; \
            float ps = 0.f; h16x8 pf; \
            _Pragma("unroll") for (int i = 0; i < 8; ++i) { const float pv = __builtin_amdgcn_exp2f(x[i] - mref); ps += pv; pf[i] = (h16)pv; } \
            lrun = lrun * alpha + ps; \
            _Pragma("unroll") for (int dt = 0; dt < 8; ++dt) { \
                const fp16x4_t lo = __builtin_amdgcn_ds_read_tr16_b64_v4f16((LAS fp16x4_t*)(tile + vofs[dt][0])); \
                const fp16x4_t hi = __builtin_amdgcn_ds_read_tr16_b64_v4f16((LAS fp16x4_t*)(tile + vofs[dt][1])); \
                const h16x4 l4 = __builtin_bit_cast(h16x4, lo), h4 = __builtin_bit_cast(h16x4, hi); \
                const h16x8 vf = {l4[0], l4[1], l4[2], l4[3], h4[0], h4[1], h4[2], h4[3]}; \
                O[dt] *= alpha; \
                O[dt] = __builtin_amdgcn_mfma_f32_16x16x32_f16(vf, pf, O[dt], 0, 0, 0); } \
        } while (0)
        SA_GATHER(grA, selA);
        if (ng > 1) { selB = *(const u32x4*)(srow + 32 + 8 * q); SA_GATHER(grB, selB); }
        for (int g = 0; g < ng; g += 2) {
            SA_GROUP(grA, selA, g);
            if (g + 1 < ng) SA_GROUP(grB, selB, g + 1);
        }
#undef SA_GATHER
#undef SA_GROUP
        const float inv = 1.0f / xsum_16_32(lrun);
        h16* op = (row < MTOK / 2 ? olatA + (size_t)row * 2048 : olatB + (size_t)(row - MTOK / 2) * 2048) + r * 128 + q * 4;
#pragma unroll
        for (int dt = 0; dt < 8; ++dt) {
            u32x2 w; w.x = pk2(O[dt][0] * inv, O[dt][1] * inv); w.y = pk2(O[dt][2] * inv, O[dt][3] * inv);
            *(u32x2*)(op + dt * 16) = w;
        }
        asm volatile("s_waitcnt lgkmcnt(0)" ::: "memory");
    }
    __syncthreads();
}

constexpr size_t OFF_BAR = 951 * MiB;
#define XB_TMO      128
#define XB_XCNT(j)  (256  + 64 * (j))
#define XB_XSUB(j)  (1280 + 64 * (j))
#define XB_XGEN(j)  (2304 + 64 * (j))
#define XB_TOP      3328
#define XB_TOPGEN   3392
#define XCD_BAR_WORDS 3456
#define XB_SPIN_CAP (1u << 22)
__device__ __forceinline__ unsigned xb_ld(unsigned* p)              { return __hip_atomic_load(p, __ATOMIC_RELAXED, __HIP_MEMORY_SCOPE_AGENT); }
__device__ __forceinline__ unsigned xb_add(unsigned* p, unsigned v) { return __hip_atomic_fetch_add(p, v, __ATOMIC_RELAXED, __HIP_MEMORY_SCOPE_AGENT); }
__device__ __forceinline__ unsigned xb_xcc_id() { return (unsigned)__builtin_amdgcn_s_getreg((3 << 11) | 20) & 0xFu; }
#define XB_SPIN(cond, bar) do { unsigned _sp = 0; while (cond) { __builtin_amdgcn_s_sleep(1); \
    if ((++_sp & 255u) == 0u) { if (xb_ld(&(bar)[XB_TMO])) break; if (_sp > XB_SPIN_CAP) { atomicAdd(&(bar)[XB_TMO], 1u); break; } } } } while (0)
struct XcdBarrier { unsigned* bar; unsigned x; volatile LAS unsigned* st; };
__device__ __forceinline__ XcdBarrier xcd_barrier_post(unsigned* bar, volatile LAS unsigned* st) {
    XcdBarrier b; b.bar = bar; b.x = xb_xcc_id(); b.st = st;
    if (threadIdx.x == 0) (void)xb_add(&bar[XB_XCNT(b.x)], 1u);
    return b;
}
__device__ __forceinline__ void xcd_barrier_complete(unsigned* bar, unsigned x, unsigned& nloc, unsigned& nx) {
    const unsigned G = gridDim.x * gridDim.y * gridDim.z;
    unsigned sum, cnt, mine, sp = 0u;
    for (;;) {
        sum = 0u; cnt = 0u; mine = 0u;
#pragma unroll
        for (unsigned jx = 0; jx < 16; ++jx) { const unsigned c = xb_ld(&bar[XB_XCNT(jx)]); sum += c; cnt += (c > 0u) ? 1u : 0u; mine = (jx == x) ? c : mine; }
        if (sum == G) break;
        __builtin_amdgcn_s_sleep(1);
        if ((++sp & 255u) == 0u) { if (xb_ld(&bar[XB_TMO])) break; if (sp > XB_SPIN_CAP) { atomicAdd(&bar[XB_TMO], 1u); break; } }
    }
    nloc = mine > 0u ? mine : 1u; nx = cnt > 0u ? cnt : 1u;
}
__device__ __forceinline__ void xcd_barrier(const XcdBarrier& b) {
    asm volatile("s_waitcnt vmcnt(0)" ::: "memory");
    __syncthreads();
    if (threadIdx.x == 0) {
        unsigned* bar = b.bar;
        __builtin_amdgcn_s_waitcnt(0);
        unsigned nloc = b.st[0], nx = b.st[1];
        if (nloc == 0u) { xcd_barrier_complete(bar, b.x, nloc, nx); b.st[0] = nloc; b.st[1] = nx; }
        const unsigned old = xb_add(&bar[XB_XSUB(b.x)], 1u);
        const unsigned gen = old / nloc;
        if (old + 1u == (gen + 1u) * nloc) {
            __builtin_amdgcn_fence(__ATOMIC_RELEASE, "agent");
            asm volatile("s_waitcnt vmcnt(0)" ::: "memory");
            const unsigned og = xb_add(&bar[XB_TOP], 1u);
            const unsigned tg = og / nx;
            if (og + 1u == (tg + 1u) * nx) xb_add(&bar[XB_TOPGEN], 1u);
            else XB_SPIN(xb_ld(&bar[XB_TOPGEN]) == tg, bar);
            __builtin_amdgcn_fence(__ATOMIC_ACQUIRE, "agent");
            xb_add(&bar[XB_XGEN(b.x)], 1u);
            asm volatile("s_waitcnt vmcnt(0)" ::: "memory");
        } else {
            XB_SPIN(xb_ld(&bar[XB_XGEN(b.x)]) == gen, bar);
            __builtin_amdgcn_fence(__ATOMIC_ACQUIRE, "agent");
            asm volatile("s_waitcnt vmcnt(0)" ::: "memory");
        }
    }
    __syncthreads();
}

__global__ void __launch_bounds__(512) mega_fwd(Params p) {
    extern __shared__ __attribute__((aligned(16))) unsigned char smem[];
    cg::grid_group grid = cg::this_grid();
    unsigned char* ws = p.ws;
    h16* x16 = (h16*)(ws + OFF_X16);
    volatile LAS unsigned* xbst = (volatile LAS unsigned*)(smem + LDS_BYTES - 16);
    if (threadIdx.x == 0) { xbst[0] = 0u; xbst[1] = 0u; }
    __syncthreads();
    const XcdBarrier xbar = xcd_barrier_post((unsigned*)(ws + OFF_BAR), xbst);
    for (int ph = p.ph_lo; ph < p.ph_hi; ++ph) {
        const unsigned e = p.prog[ph];
        const int kind = e & 15, L = (e >> 4) & 3, sub = (e >> 6) & 1, j = L >> 1;
        const int nrep = 1 + (int)(e >> 7);
        for (int rep = 0; rep < nrep; ++rep) {
        if (rep) xcd_barrier(xbar);
        const bool isgemm = (kind == K_R1 || kind == K_R2 || kind == K_R4 || kind == K_F1 || kind == K_F3 || kind == K_D1 || kind == K_D3 || kind == K_D6);
        if (isgemm) {
            const int ngemm = (kind == K_R1) ? 2 : 1;
            for (int gi = 0; gi < ngemm; ++gi) {
            pg8::Gemm g; pg8::Epi E;
            g.M = MTOK; g.N = 1024; g.K = 1024; g.lda = 1024; g.amode = 0; g.pm0 = 0; g.A = x16; g.A2 = x16; g.Bt = x16;
            E.mode = E_RESID; E.pm0 = 0; E.j = j; E.pnoff = 0; E.fin = (L == 3 && kind == K_F3) ? 1 : 0; E.ws = ws; E.out = p.out; E.bias0 = p.in[5] + j * 1024; E.bias1 = p.in[8] + j * 1024; E.bias2 = p.in[11];
            if (kind == K_R1) {
                E.mode = E_RPROJ;
                if (gi == 0) { g.A = (const h16*)p.out; g.A2 = (const h16*)(ws + R_G16); g.Bt = w_rwkv_big(ws, j); g.N = 3072; g.amode = 2; }
                else { g.Bt = w_rwkv_l1(ws, j); g.N = 512; g.K = 2048; g.amode = 1; E.pnoff = 12; }
            } else if (kind == K_R2) {
                g.A = (const h16*)(ws + R_HACT); g.Bt = w_rwkv_l2(ws, j); g.N = (j == 0) ? 3072 : 4096; g.K = 384; g.lda = 384; E.mode = E_LORA2;
            } else if (kind == K_R4) {
                g.A = (const h16*)(ws + (j == 0 ? R_V16 : OFF_VF)); g.Bt = w_rwkv_o(ws, j);
            } else if (kind == K_F1) {
                g.Bt = w_ffn_up(ws, L); g.M = MTOK / 2; g.N = 5632; g.amode = 1; g.pm0 = sub * 128; E.mode = E_ST16;
            } else if (kind == K_F3) {
                g.A = (const h16*)(ws + F_ACT); g.Bt = w_ffn_dn(ws, L); g.M = MTOK / 2; g.K = 2816; g.lda = 2816; E.pm0 = sub * 128;
            } else if (kind == K_D1) {
                g.Bt = w_dsa_in(ws, j); g.N = 512; g.amode = 1; E.mode = E_ST32;
            } else if (kind == K_D3) {
                g.A = (const h16*)(ws + D_CQ); g.Bt = w_dsa_q(ws, j); g.N = 2560; g.K = 256; g.lda = 256; E.mode = E_QPROJ;
            } else {
                g.A = (const h16*)(ws + D_HIN); g.A2 = (const h16*)p.out + (size_t)MTOK * 1024; g.Bt = (const h16*)(ws + OFF_WOV) + (size_t)j * 2097152; g.K = 2048; g.lda = 2048; g.amode = 3;
            }
            pg8::StaticOrder S; S.init(g.M, g.N, (int)gridDim.x, (int)blockIdx.x);
#ifndef NO_GEMM
            pg8::gemm_phase((LAS unsigned char*)smem, g, S, E);
#endif
            }
        } else if (kind == K_PREP) {
#ifndef NO_PREP
            prep_phase(p, smem);
#endif
        } else if (kind == K_R0) {
            mix_phase(p, j);
        } else if (kind == K_R3) {
#ifndef NO_SCAN
            scan_phase(p, j, smem);
#endif
        } else if (kind == K_LN) {
#ifndef NO_LN
            ln_phase(p, p.in[1] + (L * 2 + sub) * 1024, p.in[2] + (L * 2 + sub) * 1024, L == 3 && sub == 1);
#endif
        } else if (kind == K_F2) {
#ifndef NO_CONV
            conv_phase(p, L);
#endif
        } else if (kind == K_D2) {
#ifndef NO_NORM
            dsa_norm_phase(p, j, smem);
#endif
        } else if (kind == K_D4) {
#ifndef NO_INDEX
            dsa_index_phase(p, smem);
#endif
        } else if (kind == K_D5) {
#ifndef NO_ATTN
            dsa_attn_phase(p, j, smem);
#endif
        }
        }
        if (ph + 1 < p.ph_hi) { if (ph == p.ph_lo) grid.sync(); else xcd_barrier(xbar); for (int xs = 0; xs < EXTRA_SYNC; ++xs) xcd_barrier(xbar); }
    }
}

extern "C" void kernel_launch(void* const* d_in, const int* in_sizes, int n_in, void* d_out, int out_size, void* d_ws, size_t ws_size, hipStream_t stream) {
    static int grid_blocks = 0;
    if (grid_blocks == 0) {
        if (n_in != 37 || ws_size < WS_NEED || out_size != MTOK * DM) { fprintf(stderr, "kernel_launch: unexpected problem (n_in %d ws %zu out %d)\n", n_in, ws_size, out_size); grid_blocks = -1; return; }
        int dev = 0, cus = 0, per_cu = 0;
        hipGetDevice(&dev);
        hipDeviceGetAttribute(&cus, hipDeviceAttributeMultiprocessorCount, dev);
        if (hipFuncSetAttribute((const void*)mega_fwd, hipFuncAttributeMaxDynamicSharedMemorySize, LDS_BYTES) != hipSuccess) { fprintf(stderr, "kernel_launch: hipFuncSetAttribute failed\n"); grid_blocks = -1; return; }
        hipOccupancyMaxActiveBlocksPerMultiprocessor(&per_cu, (const void*)mega_fwd, 512, LDS_BYTES);
        if (per_cu < 1) { fprintf(stderr, "kernel_launch: occupancy query says %d blocks/CU\n", per_cu); per_cu = 1; }
        (void)hipGetLastError();
        grid_blocks = cus * per_cu;
        fprintf(stderr, "kernel_launch: grid %d (cus %d x %d)\n", grid_blocks, cus, per_cu);
    }
    if (grid_blocks < 0) return;
    Params p{};
    for (int i = 0; i < 37; ++i) p.in[i] = (const float*)d_in[i];
    p.ws = (unsigned char*)d_ws; p.out = (float*)d_out;
    int np = 0;
    constexpr unsigned PROBE_MASK = 0u;
    auto add = [&](int kind, int L, int sub) { p.prog[np++] = (unsigned char)(kind | (L << 4) | (sub << 6) | ((((PROBE_MASK >> kind) & 1u) && !(kind == K_LN && L == 3 && sub == 1)) ? 128 : 0)); };
    add(K_PREP, 0, 0);
    for (int L = 0; L < 4; ++L) {
        if ((L & 1) == 0) { add(K_R0, L, 0); add(K_R1, L, 0); add(K_R2, L, 0); add(K_R3, L, 0); add(K_R4, L, 0); }
        else { add(K_D1, L, 0); add(K_D2, L, 0); add(K_D3, L, 0); add(K_D4, L, 0); add(K_D5, L, 0); add(K_D6, L, 0); }
        add(K_LN, L, 0);
        for (int c = 0; c < 2; ++c) { add(K_F1, L, c); add(K_F2, L, c); add(K_F3, L, c); }
        add(K_LN, L, 1);
    }
#if SINGLE_LAUNCH
    if (hipMemsetAsync((unsigned char*)d_ws + OFF_BAR, 0, XCD_BAR_WORDS * 4, stream) != hipSuccess) { fprintf(stderr, "kernel_launch: memset failed\n"); return; }
    p.ph_lo = 0; p.ph_hi = np;
    void* args[] = {&p};
    hipError_t e = hipLaunchCooperativeKernel((const void*)mega_fwd, dim3(grid_blocks), dim3(512), args, LDS_BYTES, stream);
    if (e != hipSuccess) fprintf(stderr, "cooperative launch failed: %s (grid %d)\n", hipGetErrorString(e), grid_blocks);
#else
    for (int ph = 0; ph < np; ++ph) {
        p.ph_lo = ph; p.ph_hi = ph + 1;
        hipLaunchKernelGGL(mega_fwd, dim3(grid_blocks), dim3(512), LDS_BYTES, stream, p);
    }
#endif
}
```

```cpp
#include <hip/hip_runtime.h>
#include <hip/hip_cooperative_groups.h>
#include <cstdio>
namespace cg = cooperative_groups;

constexpr int EXTRA_SYNC = 0;
#ifndef SINGLE_LAUNCH
#define SINGLE_LAUNCH 1
#endif

#define LAS __attribute__((address_space(3)))
typedef _Float16 h16;
typedef _Float16 h16x8 __attribute__((ext_vector_type(8)));
typedef _Float16 h16x4 __attribute__((ext_vector_type(4)));
typedef _Float16 h16x2 __attribute__((ext_vector_type(2)));
typedef float f32x4 __attribute__((ext_vector_type(4)));
typedef float f32x2 __attribute__((ext_vector_type(2)));
typedef unsigned u32x4 __attribute__((ext_vector_type(4)));
typedef unsigned u32x2 __attribute__((ext_vector_type(2)));

constexpr int DM = 1024, SEQ = 2048, NBATCH = 32, MTOK = NBATCH * SEQ;
constexpr int DFF = 2816;
constexpr size_t MiB = (size_t)1 << 20;
constexpr float DN_ALPHA = 1.6817928305074290f;
constexpr int LDS_BYTES = 147456;

constexpr size_t OFF_W = 0;
constexpr size_t OFF_X16 = 118 * MiB;
constexpr size_t OFF_VF = 247 * MiB;
constexpr size_t OFF_R = 375 * MiB;
constexpr size_t WS_NEED = 960 * MiB;
constexpr size_t OFF_WOV = 952 * MiB;
constexpr size_t R_R16 = OFF_R, R_K16 = OFF_R + 128 * MiB, R_V16 = OFF_R + 256 * MiB, R_G16 = OFF_R + 384 * MiB, R_HACT = OFF_R + 512 * MiB;
constexpr size_t F_U16 = OFF_R, F_ACT = OFF_R + 352 * MiB;
constexpr size_t D_HIN = OFF_R, D_O16 = OFF_R, D_QABS = OFF_R + 128 * MiB, D_QIDX = OFF_R + 384 * MiB, D_CQ = OFF_R + 448 * MiB,
                 D_CKV = OFF_R + 480 * MiB, D_CKVT = OFF_R + 496 * MiB, D_KIDX = OFF_R + 512 * MiB, D_WIDX = OFF_R + 520 * MiB, D_MASK = OFF_R + 522 * MiB;

struct Params {
    const float* in[37];
    unsigned char* ws;
    float* out;
    int ph_lo, ph_hi;
    unsigned char prog[64];
};

enum { K_PREP = 0, K_R1, K_R2, K_R3, K_R4, K_LN, K_F1, K_F2, K_F3, K_D1, K_D2, K_D3, K_D4, K_D5, K_D6, K_R0 };
enum { E_RPROJ = 0, E_LORA2, E_RESID, E_ST16, E_ST32, E_QPROJ };

__device__ __forceinline__ size_t xrow(int row) { return (size_t)(row >> 11) * 2049 + 1 + (row & 2047); }
__device__ __forceinline__ unsigned pk2(float a, float b) { h16x2 h = {(h16)a, (h16)b}; return __builtin_bit_cast(unsigned, h); }
__device__ __forceinline__ u32x4 pack8(f32x4 a, f32x4 b) { u32x4 w; w.x = pk2(a[0], a[1]); w.y = pk2(a[2], a[3]); w.z = pk2(b[0], b[1]); w.w = pk2(b[2], b[3]); return w; }
__device__ __forceinline__ void unpack8(u32x4 w, float* f) {
    h16x8 h = __builtin_bit_cast(h16x8, w);
#pragma unroll
    for (int i = 0; i < 8; ++i) f[i] = (float)h[i];
}
__device__ __forceinline__ float sigmoidf_(float x) { return 1.0f / (1.0f + __expf(-x)); }
__device__ __forceinline__ float wave_sum(float v) {
#pragma unroll
    for (int o = 32; o > 0; o >>= 1) v += __shfl_xor(v, o);
    return v;
}
#define WSYNC() asm volatile("s_waitcnt vmcnt(0) lgkmcnt(0)" ::: "memory")
__device__ __forceinline__ int opaque_tid() { int t = threadIdx.x; asm volatile("" : "+v"(t)); return t; }

namespace pg8 {
constexpr int BM = 256, BK = 64, HALF = 128, HTB = HALF * BK * 2, STAGE_BYTES = 8 * HTB, NXCD = 8, WGM = 8;
__device__ __forceinline__ int lds_byte(int r, int c) { const int st = (r >> 4) * 2 + (c >> 5), rr = r & 15, cc = c & 31, ob = rr * 64 + cc * 2; return st * 1024 + (ob ^ (((ob >> 9) & 1) << 5)); }
__device__ __forceinline__ void stage_rc(int b, int& R, int& C) { const int st = b / 1024, sb = b % 1024, swz = sb ^ (((sb >> 9) & 1) << 5); R = (st >> 1) * 16 + swz / 64; C = (st & 1) * 32 + (swz % 64) / 2; }
__device__ __forceinline__ int perm32(int rho) { const int n = rho >> 4, i = rho & 15; return 8 * (i >> 2) + 4 * n + (i & 3); }
struct Unit { int pm, pn; };
struct Gemm { const h16* A; const h16* A2; const h16* Bt; int M, N, K, lda, amode, pm0; };
struct StaticOrder {
    int nM, nN, nwg, G, c;
    __device__ void init(int M, int N, int G_, int c_) { nM = M / BM; nN = N / BM; nwg = nM * nN; G = G_; c = c_; }
    __device__ bool next(int i, Unit& u) const {
        const long L = (long)i * G + c; if (L >= nwg) return false;
        int wgid = (int)L; { const int q = nwg / NXCD, r = nwg % NXCD, xcd = wgid % NXCD, off = wgid / NXCD; wgid = (xcd < r ? xcd * (q + 1) : r * (q + 1) + (xcd - r) * q) + off; }
        const int nig = WGM * nN, gid = wgid / nig, fm = gid * WGM, gsz = (nM - fm) < WGM ? (nM - fm) : WGM;
        u.pm = fm + ((wgid % nig) % gsz); u.pn = (wgid % nig) / gsz; return true;
    }
};

struct Epi {
    int mode, pm0, j, pnoff, fin;
    unsigned char* ws; float* out; const float* bias0; const float* bias1; const float* bias2;
    __device__ __forceinline__ void operator()(const f32x4 (&acc)[2][2][4][2], const Unit& u, int wr, int wc, int fr, int fq) const {
        const int rowl0 = u.pm * BM + wr * 64 + fr;
        const int colt = u.pn * BM + wc * 32 + 8 * fq;
        if (mode == E_RESID) {
            u32x4 xr[2][4][2];
#pragma unroll
            for (int ai = 0; ai < 2; ++ai)
#pragma unroll
                for (int m = 0; m < 4; ++m) {
                    const int rowg = rowl0 + ai * HALF + m * 16 + pm0 * BM;
                    const h16* xp = (const h16*)(ws + OFF_X16) + xrow(rowg) * 1024 + colt;
#pragma unroll
                    for (int bj = 0; bj < 2; ++bj) xr[ai][m][bj] = *(const u32x4*)(xp + bj * HALF);
                }
#pragma unroll
            for (int ai = 0; ai < 2; ++ai)
#pragma unroll
                for (int m = 0; m < 4; ++m) {
                    const int rowg = rowl0 + ai * HALF + m * 16 + pm0 * BM;
                    float* dp0 = out + (size_t)rowg * 1024 + colt;
                    h16* hp0 = (h16*)out + (size_t)rowg * 1024 + colt;
#pragma unroll
                    for (int bj = 0; bj < 2; ++bj) {
                        float xf[8]; unpack8(xr[ai][m][bj], xf);
                        const f32x4 v0 = acc[ai][bj][m][0], v1 = acc[ai][bj][m][1];
                        f32x4 r0, r1;
#pragma unroll
                        for (int jj = 0; jj < 4; ++jj) { r0[jj] = DN_ALPHA * xf[jj] + v0[jj]; r1[jj] = DN_ALPHA * xf[4 + jj] + v1[jj]; }
                        if (fin) { float* dp = dp0 + bj * HALF; *(f32x4*)dp = r0; *(f32x4*)(dp + 4) = r1; }
                        else *(u32x4*)(hp0 + bj * HALF) = pack8(r0, r1);
                    }
                }
            return;
        }
        if (mode == E_LORA2 && (u.pn >> 2) == 3) {
            const int c0 = colt & 1023;
#pragma unroll
            for (int ai = 0; ai < 2; ++ai) {
                u32x4 lv[4][2], lf[4][2];
#pragma unroll
                for (int m = 0; m < 4; ++m) {
                    const size_t off = (size_t)(rowl0 + ai * HALF + m * 16 + pm0 * BM) * 1024 + c0;
#pragma unroll
                    for (int bj = 0; bj < 2; ++bj) { lv[m][bj] = *(const u32x4*)((const h16*)(ws + R_V16) + off + bj * HALF); lf[m][bj] = *(const u32x4*)((const h16*)(ws + OFF_VF) + off + bj * HALF); }
                }
#pragma unroll
                for (int m = 0; m < 4; ++m) {
                    const size_t off = (size_t)(rowl0 + ai * HALF + m * 16 + pm0 * BM) * 1024 + c0;
#pragma unroll
                    for (int bj = 0; bj < 2; ++bj) {
                        const int c = c0 + bj * HALF;
                        const f32x4 ba = *(const f32x4*)(bias2 + c), bb = *(const f32x4*)(bias2 + c + 4);
                        float vv[8], vf8[8]; unpack8(lv[m][bj], vv); unpack8(lf[m][bj], vf8);
                        f32x4 v0 = acc[ai][bj][m][0], v1 = acc[ai][bj][m][1];
#pragma unroll
                        for (int jj = 0; jj < 4; ++jj) {
                            v0[jj] = vv[jj] + (vf8[jj] - vv[jj]) * sigmoidf_(v0[jj] + ba[jj]);
                            v1[jj] = vv[4 + jj] + (vf8[4 + jj] - vv[4 + jj]) * sigmoidf_(v1[jj] + bb[jj]);
                        }
                        *(u32x4*)((h16*)(ws + R_V16) + off + bj * HALF) = pack8(v0, v1);
                    }
                }
            }
            return;
        }
#pragma unroll
        for (int ai = 0; ai < 2; ++ai)
#pragma unroll
            for (int m = 0; m < 4; ++m) {
                const int rowl = rowl0 + ai * HALF + m * 16;
                const int rowg = rowl + pm0 * BM;
#pragma unroll
                for (int bj = 0; bj < 2; ++bj) {
                    const int col = colt + bj * HALF;
                    f32x4 v0 = acc[ai][bj][m][0], v1 = acc[ai][bj][m][1];
                    if (mode == E_RPROJ) {
                        if (pnoff == 0) {
                            h16* dst = (h16*)(ws + (u.pn < 4 ? R_R16 : (u.pn < 8 ? R_K16 : (j == 0 ? OFF_VF : R_V16))));
                            *(u32x4*)(dst + (size_t)rowg * 1024 + (col & 1023)) = pack8(v0, v1);
                        } else if (col < 384) {
                            const int hc = col;
                            if (hc < 64) {
#pragma unroll
                                for (int jj = 0; jj < 4; ++jj) { v0[jj] = tanhf(v0[jj]); v1[jj] = tanhf(v1[jj]); }
                            } else if (hc >= 160) {
#pragma unroll
                                for (int jj = 0; jj < 4; ++jj) { v0[jj] = sigmoidf_(v0[jj]); v1[jj] = sigmoidf_(v1[jj]); }
                            }
                            *(u32x4*)((h16*)(ws + R_HACT) + (size_t)rowg * 384 + hc) = pack8(v0, v1);
                        }
                    } else if (mode == E_LORA2) {
                        const int grp = u.pn >> 2, c = col & 1023;
                        const size_t off = (size_t)rowg * 1024 + c;
                        if (grp == 0) {
                            const f32x4 ba = *(const f32x4*)(bias0 + c), bb = *(const f32x4*)(bias0 + c + 4);
#pragma unroll
                            for (int jj = 0; jj < 4; ++jj) { v0[jj] = sigmoidf_(v0[jj] + ba[jj]) * 0.6065306597f; v1[jj] = sigmoidf_(v1[jj] + bb[jj]) * 0.6065306597f; }
                            *(u32x4*)((h16*)out + off) = pack8(v0, v1);
                        } else if (grp == 1) {
                            const f32x4 ba = *(const f32x4*)(bias1 + c), bb = *(const f32x4*)(bias1 + c + 4);
#pragma unroll
                            for (int jj = 0; jj < 4; ++jj) { v0[jj] = sigmoidf_(v0[jj] + ba[jj]); v1[jj] = sigmoidf_(v1[jj] + bb[jj]); }
                            *(u32x4*)((h16*)out + (size_t)MTOK * 1024 + off) = pack8(v0, v1);
                        } else {
                            *(u32x4*)((h16*)(ws + R_G16) + off) = pack8(v0, v1);
                        }
                    } else if (mode == E_ST16) {
                        *(u32x4*)((h16*)(ws + F_U16) + (size_t)rowl * 5632 + col) = pack8(v0, v1);
                    } else if (mode == E_ST32) {
                        float* dp = (float*)(ws + D_HIN) + (size_t)rowg * 512 + col;
                        *(f32x4*)dp = v0; *(f32x4*)(dp + 4) = v1;
                    } else {
                        if (u.pn < 8) *(u32x4*)((h16*)(ws + D_QABS) + (size_t)rowg * 2048 + col) = pack8(v0, v1);
                        else *(u32x4*)((h16*)(ws + D_QIDX) + (size_t)rowg * 512 + (col - 2048)) = pack8(v0, v1);
                    }
                }
            }
    }
};

__device__ __forceinline__ const char* a_tile(const Gemm& g, int pm, int pn) {
    if (g.amode == 1) { const int row = (pm + g.pm0) * BM; return (const char*)g.A + xrow(row) * 2048; }
    if (g.amode == 2) {
        const int gq = pn >> 2;
        const char* base = gq == 2 ? (const char*)g.A2 : (const char*)g.A + (size_t)gq * ((size_t)MTOK * 1024 * 2);
        return base + (size_t)pm * BM * 2048;
    }
    if (g.amode == 3) return (pm < 128 ? (const char*)g.A + (size_t)pm * BM * 4096 : (const char*)g.A2 + (size_t)(pm - 128) * BM * 4096);
    return (const char*)g.A + (size_t)pm * BM * g.lda * 2;
}

__device__ __forceinline__ void gemm_phase(LAS unsigned char* lds, const Gemm g, const StaticOrder& S, const Epi& E) {
    const int tid = opaque_tid(), wid = __builtin_amdgcn_readfirstlane(tid >> 6), lane = tid & 63, wr = wid >> 2, wc = wid & 3, fr = lane & 15, fq = lane >> 4;
    const int K = g.K, nt = K / BK;
    const bool shiftA = (g.amode == 1);
    unsigned voffA[2], voffB[2];
#pragma unroll
    for (int i = 0; i < 2; ++i) { int R, C; stage_rc(tid * 16 + i * 8192, R, C); const int Rb = (R & ~31) + perm32(R & 31);
        voffA[i] = (unsigned)(R * g.lda + C) * 2u; voffB[i] = (unsigned)(Rb * K + C) * 2u; }
    const size_t kstep = (size_t)(BK * 2);
    const size_t hstepA = (size_t)HALF * g.lda * 2;
    const size_t hstepB = (size_t)HALF * K * 2;
    const size_t tstepB = 2 * hstepB;
    const unsigned ldsw = (unsigned)wid * 1024u;
    const int aoff = lds_byte(wr * 64 + fr, fq * 8), boff = lds_byte(wc * 32 + fr, fq * 8);
#define PG8_KOFF(kt) ((size_t)(kt) * kstep - ((shiftA && (kt) >= 16) ? (size_t)4096 : (size_t)0))
#define PG8_SA(b, h) (((b) * 2 + (h)) * HTB)
#define PG8_SB(b, h) ((4 + (b) * 2 + (h)) * HTB)
#define PG8_STAGE(bufoff, gbase, voff) do { _Pragma("unroll") for (int _i = 0; _i < 2; ++_i) \
        __builtin_amdgcn_global_load_lds((const unsigned*)((const char*)(gbase) + (voff)[_i]), (LAS unsigned*)(lds + (bufoff) + ldsw + _i * 8192), 16, 0, 0); } while (0)
#define PG8_LDA(dst, b, h) do { _Pragma("unroll") for (int m = 0; m < 4; ++m) _Pragma("unroll") for (int k = 0; k < 2; ++k) dst[m][k] = *(const LAS h16x8*)(lds + PG8_SA(b, h) + aoff + m * 2048 + k * 1024); } while (0)
#define PG8_LDB(dst, b, h) do { _Pragma("unroll") for (int n = 0; n < 2; ++n) _Pragma("unroll") for (int k = 0; k < 2; ++k) dst[n][k] = *(const LAS h16x8*)(lds + PG8_SB(b, h) + boff + n * 2048 + k * 1024); } while (0)
#define PG8_MMA(ai, bj, At, Bt) do { __builtin_amdgcn_s_setprio(1); _Pragma("unroll") for (int m = 0; m < 4; ++m) _Pragma("unroll") for (int n = 0; n < 2; ++n) _Pragma("unroll") for (int k = 0; k < 2; ++k) \
        acc[ai][bj][m][n] = __builtin_amdgcn_mfma_f32_16x16x32_f16(Bt[n][k], At[m][k], acc[ai][bj][m][n], 0, 0, 0); __builtin_amdgcn_s_setprio(0); } while (0)
#define PG8_WAIT_V(n) asm volatile("s_waitcnt vmcnt(" #n ")" ::: "memory")
#define PG8_WAIT_L(n) asm volatile("s_waitcnt lgkmcnt(" #n ")" ::: "memory")
#define PG8_BAR __builtin_amdgcn_s_barrier()
#define PG8_SCHED __builtin_amdgcn_sched_barrier(0)
    Unit cur, nxt; int ui = 0;
    if (!S.next(0, cur)) return;
    f32x4 acc[2][2][4][2];
#pragma unroll
    for (int a = 0; a < 2; ++a)
#pragma unroll
        for (int b = 0; b < 2; ++b)
#pragma unroll
            for (int m = 0; m < 4; ++m)
#pragma unroll
                for (int n = 0; n < 2; ++n) acc[a][b][m][n] = (f32x4){0.f, 0.f, 0.f, 0.f};
    h16x8 At[4][2], B0[2][2], B1[2][2];
    const char* cA = a_tile(g, cur.pm, cur.pn); const char* cB = (const char*)g.Bt + (size_t)cur.pn * tstepB;
    PG8_STAGE(PG8_SB(0, 0), cB, voffB); PG8_STAGE(PG8_SA(0, 0), cA, voffA); PG8_STAGE(PG8_SB(0, 1), cB + hstepB, voffB); PG8_STAGE(PG8_SA(0, 1), cA + hstepA, voffA);
    if (wr == 1) PG8_BAR;
    PG8_WAIT_V(4); PG8_BAR;
    PG8_STAGE(PG8_SB(1, 0), cB + kstep, voffB); PG8_STAGE(PG8_SA(1, 0), cA + kstep, voffA); PG8_STAGE(PG8_SB(1, 1), cB + hstepB + kstep, voffB);
    PG8_WAIT_V(6); PG8_BAR;
    for (;;) {
        const bool has_next = S.next(ui + 1, nxt);
        const char* nA = has_next ? a_tile(g, nxt.pm, nxt.pn) : cA; const char* nB = has_next ? (const char*)g.Bt + (size_t)nxt.pn * tstepB : cB;
        for (int t = 0; t < nt; t += 2) {
            const bool last = (t == nt - 2);
            const char* a1 = cA + PG8_KOFF(t + 1);
            const char* a2 = last ? nA : cA + PG8_KOFF(t + 2); const char* b2 = last ? nB : cB + (size_t)(t + 2) * kstep;
            const char* a3 = a2 + kstep; const char* b3 = b2 + kstep;
            PG8_LDB(B0, 0, 0); PG8_SCHED; PG8_LDA(At, 0, 0); PG8_STAGE(PG8_SA(1, 1), a1 + hstepA, voffA);
            PG8_WAIT_L(8); PG8_BAR; PG8_WAIT_L(0); PG8_MMA(0, 0, At, B0); PG8_BAR; PG8_SCHED;
            PG8_LDB(B1, 0, 1); PG8_STAGE(PG8_SB(0, 0), b2, voffB);
            PG8_BAR; PG8_WAIT_L(0); PG8_MMA(0, 1, At, B1); PG8_BAR;
            PG8_LDA(At, 0, 1); PG8_STAGE(PG8_SA(0, 0), a2, voffA);
            PG8_BAR; PG8_WAIT_L(0); PG8_MMA(1, 0, At, B0); PG8_BAR; PG8_SCHED;
            PG8_STAGE(PG8_SB(0, 1), b2 + hstepB, voffB);
            PG8_WAIT_V(6); PG8_BAR; PG8_MMA(1, 1, At, B1); PG8_BAR;
            PG8_LDB(B0, 1, 0); PG8_SCHED; PG8_LDA(At, 1, 0); PG8_STAGE(PG8_SA(0, 1), a2 + hstepA, voffA);
            PG8_WAIT_L(8); PG8_BAR; PG8_WAIT_L(0); PG8_MMA(0, 0, At, B0); PG8_BAR; PG8_SCHED;
            PG8_LDB(B1, 1, 1); PG8_STAGE(PG8_SB(1, 0), b3, voffB);
            PG8_BAR; PG8_WAIT_L(0); PG8_MMA(0, 1, At, B1); PG8_BAR;
            PG8_LDA(At, 1, 1); PG8_STAGE(PG8_SA(1, 0), a3, voffA);
            PG8_BAR; PG8_WAIT_L(0); PG8_MMA(1, 0, At, B0); PG8_BAR; PG8_SCHED;
            PG8_STAGE(PG8_SB(1, 1), b3 + hstepB, voffB);
            PG8_WAIT_V(6); PG8_BAR; PG8_MMA(1, 1, At, B1); PG8_BAR;
        }
        E(acc, cur, wr, wc, fr, fq);
        if (!has_next) break;
#pragma unroll
        for (int a = 0; a < 2; ++a)
#pragma unroll
            for (int b = 0; b < 2; ++b)
#pragma unroll
                for (int m = 0; m < 4; ++m)
#pragma unroll
                    for (int n = 0; n < 2; ++n) acc[a][b][m][n] = (f32x4){0.f, 0.f, 0.f, 0.f};
        cur = nxt; cA = nA; cB = nB; ++ui;
    }
    PG8_WAIT_V(0);
    if (wr == 0) PG8_BAR;
    PG8_BAR;
#undef PG8_KOFF
#undef PG8_SA
#undef PG8_SB
#undef PG8_STAGE
#undef PG8_LDA
#undef PG8_LDB
#undef PG8_MMA
#undef PG8_WAIT_V
#undef PG8_WAIT_L
#undef PG8_BAR
#undef PG8_SCHED
}
}

struct TJob { int mode; const float* src; int ld, K, N; h16* dst; int ldd, koff; const float* mix; };

__device__ __forceinline__ TJob get_job(const Params& p, int id) {
    TJob J; J.mode = 0; J.src = nullptr; J.ld = 0; J.K = 0; J.N = 0; J.dst = nullptr; J.ldd = 64; J.koff = 0; J.mix = nullptr;
    h16* W = (h16*)(p.ws + OFF_W);
    if (id < 24) {
        const int j = id / 12, s = id % 12;
        h16* Wrkv = W + (size_t)j * (10 * MiB); h16* Wl1 = Wrkv + 3 * MiB; h16* Wl2 = Wrkv + 7 * MiB;
        const float* mix = p.in[3] + j * 6 * 1024;
        if (s < 3) { J.mode = 0; J.src = p.in[4] + (size_t)(j * 3 + s) * 1048576; J.ld = 1024; J.K = 1024; J.N = 1024; J.dst = Wrkv + (size_t)s * 1024 * 1024; J.ldd = 1024; }
        else if (s < 8) {
            J.mode = 1; J.ld = 1024; J.K = 1024; J.ldd = 2048;
            if (s == 3) { J.src = p.in[6] + (size_t)j * 65536; J.ld = 64; J.N = 64; J.dst = Wl1; J.mix = mix + 3 * 1024; }
            else if (s == 4) { J.src = p.in[9] + (size_t)j * 65536; J.ld = 64; J.N = 64; J.dst = Wl1 + (size_t)64 * 2048; J.mix = mix + 4 * 1024; }
            else if (s == 5) { J.N = 32; J.dst = Wl1 + (size_t)128 * 2048; if (j == 1) { J.src = p.in[12]; J.ld = 32; J.mix = mix + 2 * 1024; } else { J.mode = 2; } }
            else if (s == 6) { J.src = p.in[14] + (size_t)j * 163840; J.ld = 160; J.N = 160; J.dst = Wl1 + (size_t)160 * 2048; J.mix = mix + 5 * 1024; }
            else { J.mode = 2; J.N = 192; J.dst = Wl1 + (size_t)320 * 2048; }
        } else {
            J.mode = 0; J.ld = 1024; J.N = 1024; J.ldd = 384;
            if (s == 8) { J.src = p.in[7] + (size_t)j * 65536; J.K = 64; J.koff = 0; J.dst = Wl2; }
            else if (s == 9) { J.src = p.in[10] + (size_t)j * 65536; J.K = 64; J.koff = 64; J.dst = Wl2 + (size_t)1024 * 384; }
            else if (s == 10) { J.src = p.in[15] + (size_t)j * 163840; J.K = 160; J.koff = 160; J.dst = Wl2 + (size_t)2048 * 384; }
            else { J.src = p.in[13]; J.K = 32; J.koff = 128; J.dst = Wl2 + (size_t)3072 * 384; if (j == 0) J.N = 0; }
        }
    } else if (id < 26) {
        const int j = id - 24;
        J.src = p.in[21] + (size_t)j * 1048576; J.ld = 1024; J.K = 1024; J.N = 1024; J.dst = W + (size_t)j * (10 * MiB) + 9 * MiB; J.ldd = 1024;
    } else if (id < 34) {
        const int i = (id - 26) >> 1, s = (id - 26) & 1;
        h16* base = W + 20 * MiB + (size_t)i * (17 * MiB / 2);
        if (s == 0) { J.src = p.in[33] + (size_t)i * 1024 * 5632; J.ld = 5632; J.K = 1024; J.N = 5632; J.dst = base; J.ldd = 1024; }
        else { J.src = p.in[36] + (size_t)i * 2816 * 1024; J.ld = 1024; J.K = 2816; J.N = 1024; J.dst = base + (size_t)11 * MiB / 2; J.ldd = 2816; }
    } else {
        const int j = (id - 34) >> 2, s = (id - 34) & 3;
        h16* base = W + 54 * MiB + (size_t)j * (5 * MiB / 2);
        if (s == 0) { J.src = p.in[22] + (size_t)j * 1024 * 456; J.ld = 456; J.K = 1024; J.N = 456; J.dst = base; J.ldd = 1024; }
        else if (s == 1) { J.mode = 2; J.N = 56; J.dst = base + (size_t)456 * 1024; J.ldd = 1024; }
        else if (s == 2) { J.src = p.in[28] + (size_t)j * 256 * 512; J.ld = 512; J.K = 256; J.N = 512; J.dst = base + MiB / 2 + (size_t)2048 * 256; J.ldd = 256; }
        else { J.src = p.in[31] + (size_t)j * 1048576; J.ld = 1024; J.K = 1024; J.N = 1024; J.dst = base + 3 * MiB / 2; J.ldd = 1024; }
    }
    return J;
}
__device__ __forceinline__ h16* w_rwkv_big(unsigned char* ws, int j) { return (h16*)(ws + OFF_W) + (size_t)j * (10 * MiB); }
__device__ __forceinline__ h16* w_rwkv_l1(unsigned char* ws, int j) { return w_rwkv_big(ws, j) + 3 * MiB; }
__device__ __forceinline__ h16* w_rwkv_l2(unsigned char* ws, int j) { return w_rwkv_big(ws, j) + 7 * MiB; }
__device__ __forceinline__ h16* w_rwkv_o(unsigned char* ws, int j) { return w_rwkv_big(ws, j) + 9 * MiB; }
__device__ __forceinline__ h16* w_ffn_up(unsigned char* ws, int i) { return (h16*)(ws + OFF_W) + 20 * MiB + (size_t)i * (17 * MiB / 2); }
__device__ __forceinline__ h16* w_ffn_dn(unsigned char* ws, int i) { return w_ffn_up(ws, i) + (size_t)11 * MiB / 2; }
__device__ __forceinline__ h16* w_dsa_in(unsigned char* ws, int j) { return (h16*)(ws + OFF_W) + 54 * MiB + (size_t)j * (5 * MiB / 2); }
__device__ __forceinline__ h16* w_dsa_q(unsigned char* ws, int j) { return w_dsa_in(ws, j) + MiB / 2; }
__device__ __forceinline__ h16* w_dsa_uvt(unsigned char* ws, int j) { return w_dsa_in(ws, j) + 5 * MiB / 4; }
__device__ __forceinline__ h16* w_dsa_o(unsigned char* ws, int j) { return w_dsa_in(ws, j) + 3 * MiB / 2; }

__device__ __forceinline__ void prep_phase(const Params& p, unsigned char* smem) {
    const int tid = opaque_tid();
    const size_t gtid = (size_t)blockIdx.x * 512 + tid, nth = (size_t)gridDim.x * 512;
    h16* x16 = (h16*)(p.ws + OFF_X16);
    for (size_t idx = gtid; idx < (size_t)MTOK * 128; idx += nth) {
        const int row = (int)(idx >> 7), c8 = (int)(idx & 127) * 8;
        const float* sp = p.in[0] + (size_t)row * 1024 + c8;
        const f32x4 a = *(const f32x4*)sp, b = *(const f32x4*)(sp + 4);
        *(u32x4*)(x16 + xrow(row) * 1024 + c8) = pack8(a, b);
    }
    for (size_t idx = gtid; idx < (size_t)NBATCH * 128; idx += nth) {
        const int b = (int)(idx >> 7), c8 = (int)(idx & 127) * 8;
        unsigned z = 0u; asm volatile("" : "+v"(z));
        *(u32x4*)(x16 + (size_t)b * 2049 * 1024 + c8) = (u32x4){z, z, z, z};
    }
    for (size_t it = gtid; it < (size_t)2 * 16 * 2048; it += nth) {
        const int j = (int)(it >> 15), rem = (int)(it & 32767), qg = rem >> 11, n = rem & 2047, h = n >> 7, c = n & 127;
        const float* uq = p.in[25] + (size_t)j * 256 * 1024 + (size_t)(qg * 16) * 1024 + h * 64;
        const float* uk = p.in[26] + (size_t)j * 16 * 64 * 128 + (size_t)h * 64 * 128 + c;
        float acc[16];
#pragma unroll
        for (int i = 0; i < 16; ++i) acc[i] = 0.f;
        for (int d = 0; d < 64; ++d) {
            const float kv = uk[d * 128];
#pragma unroll
            for (int i = 0; i < 16; ++i) acc[i] += uq[i * 1024 + d] * kv;
        }
        const float sc = 0.18033688011112042f;
        h16* dst = w_dsa_q(p.ws, j) + (size_t)n * 256 + qg * 16;
        *(u32x4*)dst = pack8((f32x4){acc[0] * sc, acc[1] * sc, acc[2] * sc, acc[3] * sc}, (f32x4){acc[4] * sc, acc[5] * sc, acc[6] * sc, acc[7] * sc});
        *(u32x4*)(dst + 8) = pack8((f32x4){acc[8] * sc, acc[9] * sc, acc[10] * sc, acc[11] * sc}, (f32x4){acc[12] * sc, acc[13] * sc, acc[14] * sc, acc[15] * sc});
    }
    for (size_t it = gtid; it < (size_t)2 * 128 * 1024; it += nth) {
        const int j = (int)(it >> 17), rem = (int)(it & 131071), kg = rem >> 10, n = rem & 1023, h = kg >> 3, c0 = (kg & 7) * 16;
        const float* uv = p.in[27] + (size_t)((j * 16 + h) * 128 + c0) * 64;
        const float* wo = p.in[31] + (size_t)j * 1048576 + (size_t)(h * 64) * 1024 + n;
        float acc[16];
#pragma unroll
        for (int i = 0; i < 16; ++i) acc[i] = 0.f;
        for (int v = 0; v < 64; ++v) {
            const float wv = wo[(size_t)v * 1024];
#pragma unroll
            for (int i = 0; i < 16; ++i) acc[i] += uv[i * 64 + v] * wv;
        }
        h16* dst = (h16*)(p.ws + OFF_WOV) + (size_t)j * 2097152 + (size_t)n * 2048 + h * 128 + c0;
        *(u32x4*)dst = pack8((f32x4){acc[0], acc[1], acc[2], acc[3]}, (f32x4){acc[4], acc[5], acc[6], acc[7]});
        *(u32x4*)(dst + 8) = pack8((f32x4){acc[8], acc[9], acc[10], acc[11]}, (f32x4){acc[12], acc[13], acc[14], acc[15]});
    }
    float* tile = (float*)smem;
    for (int id = 0; id < 42; ++id) {
        const TJob J = get_job(p, id);
        const int tk = J.ldd >> 6, tn = (J.N + 63) >> 6, ntile = tk * tn;
        for (int tix = blockIdx.x; tix < ntile; tix += gridDim.x) {
            const int k0 = (tix % tk) * 64, n0 = (tix / tk) * 64;
#pragma unroll
            for (int i = 0; i < 8; ++i) {
                const int k = i * 8 + (tid >> 6), n = tid & 63, kk = k0 + k, nn = n0 + n;
                float v = 0.f;
                if (nn < J.N && J.mode != 2) {
                    if (J.mode == 1) { const int ks = kk & 1023; const float mx = J.mix[ks]; v = J.src[(size_t)ks * J.ld + nn] * (kk < 1024 ? 1.0f - mx : mx); }
                    else if (kk >= J.koff && kk < J.koff + J.K) v = J.src[(size_t)(kk - J.koff) * J.ld + nn];
                }
                tile[k * 65 + n] = v;
            }
            __syncthreads();
#pragma unroll
            for (int i = 0; i < 8; ++i) {
                const int n = i * 8 + (tid >> 6), k = tid & 63, nn = n0 + n;
                if (nn < J.N) J.dst[(size_t)nn * J.ldd + k0 + k] = (h16)tile[k * 65 + n];
            }
            __syncthreads();
        }
    }
}

__device__ __forceinline__ void wave_sum4(float (&v)[4]) {
#pragma unroll
    for (int o = 32; o > 0; o >>= 1) {
        float t[4];
#pragma unroll
        for (int k = 0; k < 4; ++k) t[k] = __shfl_xor(v[k], o);
#pragma unroll
        for (int k = 0; k < 4; ++k) v[k] += t[k];
    }
}
__device__ __forceinline__ void ln_phase(const Params& p, const float* g, const float* b, bool final_out) {
    const int tid = opaque_tid();
    const int lane = tid & 63, wave = tid >> 6;
    float* tb = p.out;
    h16* x16 = (h16*)(p.ws + OFF_X16);
    f32x4 gg[4], bb[4];
#pragma unroll
    for (int i = 0; i < 4; ++i) { gg[i] = *(const f32x4*)(g + i * 256 + lane * 4); bb[i] = *(const f32x4*)(b + i * 256 + lane * 4); }
    for (int rowb = (blockIdx.x * 8 + wave) * 4; rowb < MTOK; rowb += gridDim.x * 32) {
        f32x4 v[4][4];
        float s[4];
#pragma unroll
        for (int k = 0; k < 4; ++k) {
            s[k] = 0.f;
            if (final_out) {
                const float* rp = tb + (size_t)(rowb + k) * 1024;
#pragma unroll
                for (int i = 0; i < 4; ++i) v[k][i] = *(const f32x4*)(rp + i * 256 + lane * 4);
            } else {
                const h16* hp = (const h16*)tb + (size_t)(rowb + k) * 1024;
#pragma unroll
                for (int i = 0; i < 4; ++i) { const h16x4 hv = *(const h16x4*)(hp + i * 256 + lane * 4); v[k][i] = (f32x4){(float)hv[0], (float)hv[1], (float)hv[2], (float)hv[3]}; }
            }
#pragma unroll
            for (int i = 0; i < 4; ++i) s[k] += (v[k][i][0] + v[k][i][1]) + (v[k][i][2] + v[k][i][3]);
        }
        wave_sum4(s);
        float q[4];
#pragma unroll
        for (int k = 0; k < 4; ++k) {
            s[k] *= (1.0f / 1024.0f); q[k] = 0.f;
#pragma unroll
            for (int i = 0; i < 4; ++i)
#pragma unroll
                for (int jj = 0; jj < 4; ++jj) { const float d = v[k][i][jj] - s[k]; q[k] += d * d; }
        }
        wave_sum4(q);
#pragma unroll
        for (int k = 0; k < 4; ++k) {
            const float rstd = rsqrtf(q[k] * (1.0f / 1024.0f) + 1e-5f);
            const int row = rowb + k;
#pragma unroll
            for (int i = 0; i < 4; ++i) {
                f32x4 y;
#pragma unroll
                for (int jj = 0; jj < 4; ++jj) y[jj] = (v[k][i][jj] - s[k]) * rstd * gg[i][jj] + bb[i][jj];
                if (final_out) *(f32x4*)(tb + (size_t)row * 1024 + i * 256 + lane * 4) = y;
                else { u32x2 w; w.x = pk2(y[0], y[1]); w.y = pk2(y[2], y[3]); *(u32x2*)(x16 + xrow(row) * 1024 + i * 256 + lane * 4) = w; }
            }
        }
    }
}

__device__ __forceinline__ void conv_phase(const Params& p, int layer) {
    const h16* u = (const h16*)(p.ws + F_U16);
    h16* act = (h16*)(p.ws + F_ACT);
    const float* cw = p.in[34] + (size_t)layer * 3 * 5632;
    const float* cb = p.in[35] + (size_t)layer * 5632;
    const size_t gtid = (size_t)blockIdx.x * 512 + opaque_tid(), nth = (size_t)gridDim.x * 512;
    const size_t ntask = (size_t)2048 * 352;
    for (size_t task = gtid; task < ntask; task += nth) {
        const int cgp = (int)(task % 352), rc = (int)(task / 352), f = cgp * 8, r0 = rc * 16;
        float wg[3][8], wv[3][8], bg[8], bv[8];
#pragma unroll
        for (int jj = 0; jj < 3; ++jj)
#pragma unroll
            for (int hlf = 0; hlf < 2; ++hlf) {
                const f32x4 a = *(const f32x4*)(cw + jj * 5632 + f + hlf * 4), c = *(const f32x4*)(cw + jj * 5632 + DFF + f + hlf * 4);
#pragma unroll
                for (int e = 0; e < 4; ++e) { wg[jj][hlf * 4 + e] = a[e]; wv[jj][hlf * 4 + e] = c[e]; }
            }
#pragma unroll
        for (int hlf = 0; hlf < 2; ++hlf) {
            const f32x4 a = *(const f32x4*)(cb + f + hlf * 4), c = *(const f32x4*)(cb + DFF + f + hlf * 4);
#pragma unroll
            for (int e = 0; e < 4; ++e) { bg[hlf * 4 + e] = a[e]; bv[hlf * 4 + e] = c[e]; }
        }
        float g2[8], g1[8], v2[8], v1[8];
#pragma unroll
        for (int e = 0; e < 8; ++e) { g2[e] = 0.f; g1[e] = 0.f; v2[e] = 0.f; v1[e] = 0.f; }
        if ((r0 & 2047) != 0) {
            unpack8(*(const u32x4*)(u + (size_t)(r0 - 2) * 5632 + f), g2); unpack8(*(const u32x4*)(u + (size_t)(r0 - 1) * 5632 + f), g1);
            unpack8(*(const u32x4*)(u + (size_t)(r0 - 2) * 5632 + DFF + f), v2); unpack8(*(const u32x4*)(u + (size_t)(r0 - 1) * 5632 + DFF + f), v1);
        }
#pragma unroll 1
        for (int i0 = 0; i0 < 16; i0 += 4) {
            u32x4 lg[4], lv[4];
#pragma unroll
            for (int i = 0; i < 4; ++i) { const size_t ro = (size_t)(r0 + i0 + i) * 5632; lg[i] = *(const u32x4*)(u + ro + f); lv[i] = *(const u32x4*)(u + ro + DFF + f); }
#pragma unroll
            for (int i = 0; i < 4; ++i) {
                float g0[8], v0[8], o[8];
                unpack8(lg[i], g0); unpack8(lv[i], v0);
#pragma unroll
                for (int e = 0; e < 8; ++e) {
                    const float G = wg[0][e] * g2[e] + wg[1][e] * g1[e] + wg[2][e] * g0[e] + bg[e];
                    const float V = wv[0][e] * v2[e] + wv[1][e] * v1[e] + wv[2][e] * v0[e] + bv[e];
                    o[e] = G * sigmoidf_(G) * V;
                    g2[e] = g1[e]; g1[e] = g0[e]; v2[e] = v1[e]; v1[e] = v0[e];
                }
                *(u32x4*)(act + (size_t)(r0 + i0 + i) * DFF + f) = pack8((f32x4){o[0], o[1], o[2], o[3]}, (f32x4){o[4], o[5], o[6], o[7]});
            }
        }
    }
}

__device__ __forceinline__ void mix_phase(const Params& p, int j) {
    const h16* x16 = (const h16*)(p.ws + OFF_X16);
    h16* xr = (h16*)p.out; h16* xk = (h16*)p.out + (size_t)MTOK * 1024; h16* xv = (h16*)(p.ws + R_G16);
    const float* mix = p.in[3] + j * 6 * 1024;
    const size_t gtid = (size_t)blockIdx.x * 512 + opaque_tid(), nth = (size_t)gridDim.x * 512;
    for (size_t idx = gtid; idx < (size_t)MTOK * 128; idx += nth) {
        const int row = (int)(idx >> 7), c8 = (int)(idx & 127) * 8;
        const h16* xp = x16 + xrow(row) * 1024 + c8;
        float xc[8], xq[8];
        unpack8(*(const u32x4*)xp, xc); unpack8(*(const u32x4*)(xp - 1024), xq);
#pragma unroll
        for (int e = 0; e < 8; ++e) xq[e] -= xc[e];
        const size_t o = (size_t)row * 1024 + c8;
#pragma unroll
        for (int bsel = 0; bsel < 3; ++bsel) {
            const f32x4 m0 = *(const f32x4*)(mix + bsel * 1024 + c8), m1 = *(const f32x4*)(mix + bsel * 1024 + c8 + 4);
            f32x4 a, b;
#pragma unroll
            for (int e = 0; e < 4; ++e) { a[e] = xc[e] + xq[e] * m0[e]; b[e] = xc[4 + e] + xq[4 + e] * m1[e]; }
            h16* dst = bsel == 0 ? xr : (bsel == 1 ? xk : xv);
            *(u32x4*)(dst + o) = pack8(a, b);
        }
    }
}

__device__ __forceinline__ float dppf(float x, const int ctrl_sel) {
    const int v = __builtin_bit_cast(int, x);
    int r;
    if (ctrl_sel == 0) r = __builtin_amdgcn_update_dpp(0, v, 0xB1, 0xF, 0xF, true);
    else if (ctrl_sel == 1) r = __builtin_amdgcn_update_dpp(0, v, 0x4E, 0xF, 0xF, true);
    else if (ctrl_sel == 2) r = __builtin_amdgcn_update_dpp(0, v, 0x141, 0xF, 0xF, true);
    else r = __builtin_amdgcn_update_dpp(0, v, 0x140, 0xF, 0xF, true);
    return __builtin_bit_cast(float, r);
}
__device__ __forceinline__ float red4(float x) { x += dppf(x, 0); x += dppf(x, 1); return x; }
__device__ __forceinline__ float red16(float x) { x += dppf(x, 0); x += dppf(x, 1); x += dppf(x, 2); x += dppf(x, 3); return x; }
__device__ __forceinline__ void unpack4(u32x2 w, float* f) {
    h16x4 h = __builtin_bit_cast(h16x4, w);
#pragma unroll
    for (int i = 0; i < 4; ++i) f[i] = (float)h[i];
}
constexpr int SCAN_BUF = 8256;
__device__ __forceinline__ void scan_phase(const Params& p, int j, unsigned char* smem) {
    const int tid = opaque_tid();
    const int wave = tid >> 6, lane = tid & 63, slot = wave >> 2, w4 = wave & 3;
    float* LB = (float*)smem + slot * (2 * SCAN_BUF);
    const h16* r16 = (const h16*)(p.ws + R_R16);
    const h16* k16 = (const h16*)(p.ws + R_K16);
    const h16* v16 = (j == 0) ? (const h16*)(p.ws + OFF_VF) : (const h16*)(p.ws + R_V16);
    const h16* g16 = (const h16*)(p.ws + R_G16);
    const h16* e16 = (const h16*)p.out;
    const h16* a16 = (const h16*)p.out + (size_t)MTOK * 1024;
    h16* y16 = (h16*)(p.ws + (j == 0 ? R_V16 : OFF_VF));
    const int tp = w4 * 4 + (lane >> 4), k4 = (lane & 15) * 4;
    const int vrow = w4 * 16 + (lane >> 2), kq = lane & 3;
    for (int pair = blockIdx.x; pair < 256; pair += gridDim.x) {
        const int chain = pair * 2 + slot, b = chain >> 4, h = chain & 15;
        const int col = h * 64 + k4;
        const f32x4 c_kk = *(const f32x4*)(p.in[16] + j * 1024 + col), c_ka = *(const f32x4*)(p.in[17] + j * 1024 + col), c_rk = *(const f32x4*)(p.in[18] + j * 1024 + col);
        const f32x4 c_lg = *(const f32x4*)(p.in[19] + j * 1024 + col), c_lb = *(const f32x4*)(p.in[20] + j * 1024 + col);
        f32x2 S[8];
#pragma unroll
        for (int i = 0; i < 8; ++i) S[i] = (f32x2){0.f, 0.f};
        u32x2 pr[6];
        {
            const size_t go = ((size_t)(b * 2048 + tp)) * 1024 + col;
            pr[0] = *(const u32x2*)(r16 + go); pr[1] = *(const u32x2*)(k16 + go); pr[2] = *(const u32x2*)(v16 + go);
            pr[3] = *(const u32x2*)(e16 + go); pr[4] = *(const u32x2*)(a16 + go); pr[5] = *(const u32x2*)(g16 + go);
        }
        for (int ch = 0; ch < 128; ++ch) {
            float* BUF = LB + (ch & 1) * SCAN_BUF;
            float* OPS = BUF; float* VB = BUF + 5120; float* GB = BUF + 6144; float* YB = BUF + 7168; float* BON = BUF + 8192;
            {
                float rf[4], kf[4], vf[4], ef[4], af[4], gf[4];
                unpack4(pr[0], rf); unpack4(pr[1], kf); unpack4(pr[2], vf); unpack4(pr[3], ef); unpack4(pr[4], af); unpack4(pr[5], gf);
                float kk[4]; float ss = 0.f;
#pragma unroll
                for (int i = 0; i < 4; ++i) { kk[i] = kf[i] * c_kk[i]; ss += kk[i] * kk[i]; }
                ss = red16(ss);
                const float inv = 1.0f / fmaxf(sqrtf(ss), 1e-12f);
                f32x4 A4, B4, W4, K4, R4; float bs = 0.f;
#pragma unroll
                for (int i = 0; i < 4; ++i) {
                    const float kn = kk[i] * inv;
                    A4[i] = -kn; B4[i] = kn * af[i];
                    W4[i] = __expf(-ef[i]);
                    const float km = kf[i] * (1.0f + (af[i] - 1.0f) * c_ka[i]);
                    K4[i] = km; R4[i] = rf[i];
                    bs += rf[i] * km * c_rk[i];
                }
                bs = red16(bs);
                float* o = OPS + tp * 320 + k4;
                *(f32x4*)(o) = A4; *(f32x4*)(o + 64) = B4; *(f32x4*)(o + 128) = W4; *(f32x4*)(o + 192) = K4; *(f32x4*)(o + 256) = R4;
                *(f32x4*)(VB + tp * 64 + k4) = (f32x4){vf[0], vf[1], vf[2], vf[3]};
                *(f32x4*)(GB + tp * 64 + k4) = (f32x4){gf[0], gf[1], gf[2], gf[3]};
                if ((lane & 15) == 0) BON[tp] = bs;
            }
            if (ch + 1 < 128) {
                const size_t go = ((size_t)(b * 2048 + (ch + 1) * 16 + tp)) * 1024 + col;
                pr[0] = *(const u32x2*)(r16 + go); pr[1] = *(const u32x2*)(k16 + go); pr[2] = *(const u32x2*)(v16 + go);
                pr[3] = *(const u32x2*)(e16 + go); pr[4] = *(const u32x2*)(a16 + go); pr[5] = *(const u32x2*)(g16 + go);
            }
            __syncthreads();
#pragma unroll 2
            for (int t = 0; t < 16; ++t) {
                const float* op = OPS + t * 320 + kq * 16;
                f32x4 A4[4], B4[4], W4[4], K4[4], R4[4];
#pragma unroll
                for (int i = 0; i < 4; ++i) A4[i] = *(const f32x4*)(op + i * 4);
#pragma unroll
                for (int i = 0; i < 4; ++i) { W4[i] = *(const f32x4*)(op + 128 + i * 4); B4[i] = *(const f32x4*)(op + 64 + i * 4); K4[i] = *(const f32x4*)(op + 192 + i * 4); }
#pragma unroll
                for (int i = 0; i < 4; ++i) R4[i] = *(const f32x4*)(op + 256 + i * 4);
                const float vv = VB[t * 64 + vrow];
                f32x2 s0 = {0.f, 0.f}, s1 = {0.f, 0.f};
#pragma unroll
                for (int i = 0; i < 4; ++i) { s0 += S[2 * i] * (f32x2){A4[i][0], A4[i][1]}; s1 += S[2 * i + 1] * (f32x2){A4[i][2], A4[i][3]}; }
                const float sa = red4((s0[0] + s0[1]) + (s1[0] + s1[1]));
                const f32x2 sa2 = {sa, sa}, vv2 = {vv, vv};
#pragma unroll
                for (int i = 0; i < 4; ++i) {
                    S[2 * i] = S[2 * i] * (f32x2){W4[i][0], W4[i][1]} + sa2 * (f32x2){B4[i][0], B4[i][1]} + vv2 * (f32x2){K4[i][0], K4[i][1]};
                    S[2 * i + 1] = S[2 * i + 1] * (f32x2){W4[i][2], W4[i][3]} + sa2 * (f32x2){B4[i][2], B4[i][3]} + vv2 * (f32x2){K4[i][2], K4[i][3]};
                }
                f32x2 y0 = {0.f, 0.f}, y1 = {0.f, 0.f};
#pragma unroll
                for (int i = 0; i < 4; ++i) { y0 += S[2 * i] * (f32x2){R4[i][0], R4[i][1]}; y1 += S[2 * i + 1] * (f32x2){R4[i][2], R4[i][3]}; }
                const float y = red4((y0[0] + y0[1]) + (y1[0] + y1[1]));
                if (kq == 0) YB[t * 64 + vrow] = y;
            }
            __syncthreads();
            {
                const f32x4 y4 = *(const f32x4*)(YB + tp * 64 + k4), v4 = *(const f32x4*)(VB + tp * 64 + k4), g4 = *(const f32x4*)(GB + tp * 64 + k4);
                const float mu = red16((y4[0] + y4[1]) + (y4[2] + y4[3])) * (1.0f / 64.0f);
                float q = 0.f;
#pragma unroll
                for (int i = 0; i < 4; ++i) { const float d = y4[i] - mu; q += d * d; }
                const float rstd = rsqrtf(red16(q) * (1.0f / 64.0f) + 64e-5f);
                const float bon = BON[tp];
                float o[4];
#pragma unroll
                for (int i = 0; i < 4; ++i) o[i] = ((y4[i] - mu) * rstd * c_lg[i] + c_lb[i] + bon * v4[i]) * g4[i];
                u32x2 w; w.x = pk2(o[0], o[1]); w.y = pk2(o[2], o[3]);
                *(u32x2*)(y16 + ((size_t)(b * 2048 + ch * 16 + tp)) * 1024 + col) = w;
            }
        }
        __syncthreads();
    }
}

__device__ __forceinline__ void dsa_norm_phase(const Params& p, int j, unsigned char* smem) {
    const int tid = opaque_tid();
    const int lane = tid & 63, wave = tid >> 6;
    const float* hin = (const float*)(p.ws + D_HIN);
    h16* cq = (h16*)(p.ws + D_CQ); h16* ckv = (h16*)(p.ws + D_CKV); h16* ckvt = (h16*)(p.ws + D_CKVT); h16* kidx = (h16*)(p.ws + D_KIDX);
    float* widx = (float*)(p.ws + D_WIDX);
    const f32x4 gq = *(const f32x4*)(p.in[23] + j * 256 + lane * 4);
    const f32x2 gkv = *(const f32x2*)(p.in[24] + j * 128 + lane * 2);
    const float gi = p.in[29][j * 64 + lane], bi = p.in[30][j * 64 + lane];
    h16* wl = (h16*)(smem + wave * 2048);
    for (int grp = blockIdx.x * 8 + wave; grp < MTOK / 8; grp += gridDim.x * 8) {
        const int r0 = grp * 8;
        for (int i = 0; i < 8; ++i) {
            const int row = r0 + i;
            const float* hp = hin + (size_t)row * 512;
            const f32x4 vq = *(const f32x4*)(hp + lane * 4);
            const f32x2 vk = *(const f32x2*)(hp + 256 + lane * 2);
            const float vi = hp[384 + lane];
            float ssq = wave_sum(vq[0] * vq[0] + vq[1] * vq[1] + vq[2] * vq[2] + vq[3] * vq[3]);
            const float rq = rsqrtf(ssq * (1.0f / 256.0f) + 1e-6f);
            u32x2 w; w.x = pk2(vq[0] * rq * gq[0], vq[1] * rq * gq[1]); w.y = pk2(vq[2] * rq * gq[2], vq[3] * rq * gq[3]);
            *(u32x2*)(cq + (size_t)row * 256 + lane * 4) = w;
            float ssk = wave_sum(vk[0] * vk[0] + vk[1] * vk[1]);
            const float rk = rsqrtf(ssk * (1.0f / 128.0f) + 1e-6f);
            const unsigned wk = pk2(vk[0] * rk * gkv[0], vk[1] * rk * gkv[1]);
            *(unsigned*)(ckv + (size_t)row * 128 + lane * 2) = wk;
            const float mu = wave_sum(vi) * (1.0f / 64.0f);
            const float dv = vi - mu;
            const float var = wave_sum(dv * dv) * (1.0f / 64.0f);
            kidx[(size_t)row * 64 + lane] = (h16)(dv * rsqrtf(var + 1e-5f) * gi + bi);
            if (lane < 8) widx[(size_t)row * 8 + lane] = hp[448 + lane] * 0.044194173824159216f;
        }
    }
}

constexpr int ROWP = 2052;
__device__ __forceinline__ unsigned fkey(float x) {
    if (x == 0.0f) x = 0.0f;
    const unsigned u = __float_as_uint(x);
    return (u & 0x80000000u) ? ~u : (u | 0x80000000u);
}
__device__ __forceinline__ void dsa_index_phase(const Params& p, unsigned char* smem) {
    const int tid = opaque_tid(), wave = tid >> 6, lane = tid & 63, r = lane & 15, q = lane >> 4;
    float* SC = (float*)smem;
    const h16* qidx = (const h16*)(p.ws + D_QIDX);
    const h16* kidx = (const h16*)(p.ws + D_KIDX);
    const float* widx = (const float*)(p.ws + D_WIDX);
    unsigned short* selout = (unsigned short*)(p.ws + D_MASK);
    h16x8 qf[8][2]; float wq[8];
    if ((int)blockIdx.x < MTOK / 16) {
        const int row0 = (int)blockIdx.x * 16;
#pragma unroll
        for (int h = 0; h < 8; ++h) {
#pragma unroll
            for (int kk = 0; kk < 2; ++kk) qf[h][kk] = *(const h16x8*)(qidx + (size_t)(row0 + r) * 512 + h * 64 + kk * 32 + q * 8);
            wq[h] = widx[(size_t)(row0 + r) * 8 + h];
        }
    }
    for (int qi = blockIdx.x, it = 0; qi < MTOK / 16; qi += gridDim.x, ++it) {
        const int qt = (it & 1) ? ((qi & ~127) | (127 - (qi & 127))) : qi;
        const int row0 = qt * 16, b = row0 >> 11, t0 = row0 & 2047;
        const int nkt = (t0 >> 4) + 1;
        {
            h16x8 kn[4];
            if (wave < nkt) {
                const bool two = (wave + 8 < nkt);
                const int s0 = wave * 16, s1 = two ? s0 + 128 : s0;
                const h16* kp = kidx + (size_t)(b * 2048 + s0 + r) * 64 + q * 8;
                const h16* kp1 = kidx + (size_t)(b * 2048 + s1 + r) * 64 + q * 8;
                kn[0] = *(const h16x8*)kp; kn[1] = *(const h16x8*)(kp + 32); kn[2] = *(const h16x8*)kp1; kn[3] = *(const h16x8*)(kp1 + 32);
            }
            for (int kt = wave; kt < nkt; kt += 16) {
                const bool two = (kt + 8 < nkt);
                const int s0 = kt * 16, s1 = two ? s0 + 128 : s0;
                const h16x8 k0 = kn[0], k1 = kn[1], k2 = kn[2], k3 = kn[3];
                if (kt + 16 < nkt) {
                    const bool two2 = (kt + 24 < nkt);
                    const int n0 = (kt + 16) * 16, n1 = two2 ? n0 + 128 : n0;
                    const h16* kp = kidx + (size_t)(b * 2048 + n0 + r) * 64 + q * 8;
                    const h16* kp1 = kidx + (size_t)(b * 2048 + n1 + r) * 64 + q * 8;
                    kn[0] = *(const h16x8*)kp; kn[1] = *(const h16x8*)(kp + 32); kn[2] = *(const h16x8*)kp1; kn[3] = *(const h16x8*)(kp1 + 32);
                }
                f32x4 sc = {0.f, 0.f, 0.f, 0.f}, sd = {0.f, 0.f, 0.f, 0.f};
#pragma unroll
                for (int h = 0; h < 8; ++h) {
                    f32x4 acc = {0.f, 0.f, 0.f, 0.f}, acd = {0.f, 0.f, 0.f, 0.f};
                    acc = __builtin_amdgcn_mfma_f32_16x16x32_f16(k0, qf[h][0], acc, 0, 0, 0);
                    acd = __builtin_amdgcn_mfma_f32_16x16x32_f16(k2, qf[h][0], acd, 0, 0, 0);
                    acc = __builtin_amdgcn_mfma_f32_16x16x32_f16(k1, qf[h][1], acc, 0, 0, 0);
                    acd = __builtin_amdgcn_mfma_f32_16x16x32_f16(k3, qf[h][1], acd, 0, 0, 0);
#pragma unroll
                    for (int jj = 0; jj < 4; ++jj) { sc[jj] += fmaxf(acc[jj], 0.f) * wq[h]; sd[jj] += fmaxf(acd[jj], 0.f) * wq[h]; }
                }
                *(f32x4*)(SC + r * ROWP + s0 + q * 4) = sc;
                if (two) *(f32x4*)(SC + r * ROWP + s1 + q * 4) = sd;
            }
            const int qin = qi + (int)gridDim.x;
            if (qin < MTOK / 16) {
                const int qtn = ((it + 1) & 1) ? ((qin & ~127) | (127 - (qin & 127))) : qin;
                const int rown = qtn * 16;
#pragma unroll
                for (int h = 0; h < 8; ++h) {
#pragma unroll
                    for (int kk = 0; kk < 2; ++kk) qf[h][kk] = *(const h16x8*)(qidx + (size_t)(rown + r) * 512 + h * 64 + kk * 32 + q * 8);
                    wq[h] = widx[(size_t)(rown + r) * 8 + h];
                }
            }
        }
        __syncthreads();
        for (int qq = 0; qq < 2; ++qq) {
            const int ql = wave * 2 + qq, t = t0 + ql;
            const float* srow = SC + ql * ROWP;
            const int ni = (t >> 6) + 1;
            unsigned u[32];
#pragma unroll
            for (int i = 0; i < 32; ++i) {
                u[i] = 0u;
                if (i < ni) { const int s = i * 64 + lane; if (s <= t) u[i] = fkey(srow[s]); }
            }
            unsigned short* selrow = selout + (size_t)(row0 + ql) * 256;
            if (t < 256) {
#pragma unroll
                for (int i = 0; i < 4; ++i) { const int pp = i * 64 + lane; selrow[pp] = (unsigned short)(pp <= t ? pp : 0xFFFF); }
            } else {
                unsigned* H = (unsigned*)(smem + 16 * ROWP * 4) + wave * 256;
                unsigned prefix = 0u; int need = 256;
#pragma unroll 1
                for (int pass = 0; pass < 4; ++pass) {
                    const int shift = 24 - 8 * pass;
                    const unsigned hmask = pass == 0 ? 0u : (0xFFFFFFFFu << (shift + 8));
                    *(u32x4*)(H + lane * 4) = (u32x4){0u, 0u, 0u, 0u};
                    asm volatile("s_waitcnt lgkmcnt(0)" ::: "memory");
#pragma unroll
                    for (int i = 0; i < 32; ++i) if (i < ni) { const unsigned uu = u[i]; if (uu != 0u && (uu & hmask) == prefix) atomicAdd(H + ((uu >> shift) & 255u), 1u); }
                    asm volatile("s_waitcnt lgkmcnt(0)" ::: "memory");
                    const u32x4 hv = *(const u32x4*)(H + lane * 4);
                    const int tot = (int)(hv.x + hv.y + hv.z + hv.w);
                    int rs = tot;
                    rs += __builtin_amdgcn_update_dpp(0, rs, 0xB1, 0xF, 0xF, true);
                    rs += __builtin_amdgcn_update_dpp(0, rs, 0x4E, 0xF, 0xF, true);
                    rs += __builtin_amdgcn_update_dpp(0, rs, 0x141, 0xF, 0xF, true);
                    rs += __builtin_amdgcn_update_dpp(0, rs, 0x140, 0xF, 0xF, true);
                    int rowsel = 3, above = 0;
                    {
                        const int r3 = __builtin_amdgcn_readlane(rs, 48), r2 = __builtin_amdgcn_readlane(rs, 32), r1 = __builtin_amdgcn_readlane(rs, 16);
                        if (need > r3) { above = r3; rowsel = 2; if (need > above + r2) { above += r2; rowsel = 1; if (need > above + r1) { above += r1; rowsel = 0; } } }
                    }
                    int lsel = rowsel * 16;
                    for (int k = 15; k >= 0; --k) {
                        const int cl = __builtin_amdgcn_readlane(tot, rowsel * 16 + k);
                        if (need <= above + cl) { lsel = rowsel * 16 + k; break; }
                        above += cl;
                    }
                    const int b3 = __builtin_amdgcn_readlane((int)hv.w, lsel), b2 = __builtin_amdgcn_readlane((int)hv.z, lsel), b1 = __builtin_amdgcn_readlane((int)hv.y, lsel);
                    int bsel = 3;
                    if (need > above + b3) { above += b3; bsel = 2; if (need > above + b2) { above += b2; bsel = 1; if (need > above + b1) { above += b1; bsel = 0; } } }
                    prefix |= (unsigned)(lsel * 4 + bsel) << shift;
                    need -= above;
                }
                const unsigned T = prefix;
                int running = 0, outpos = 0;
                const unsigned long long lt = (lane == 0) ? 0ull : (~0ull >> (64 - lane));
#pragma unroll
                for (int i = 0; i < 32; ++i) {
                    if (i < ni) {
                        const unsigned long long eq = __ballot(u[i] == T);
                        const int rank = running + __popcll(eq & lt);
                        const bool sel = u[i] > T || (u[i] == T && rank < need);
                        const unsigned long long sm = __ballot(sel);
                        running += __popcll(eq);
                        if (sel) selrow[outpos + __popcll(sm & lt)] = (unsigned short)(i * 64 + lane);
                        outpos += __popcll(sm);
                    }
                }
            }
        }
        __syncthreads();
    }
}

__device__ __forceinline__ float xmax_16_32(float x) {
    const unsigned u = __builtin_bit_cast(unsigned, x);
    auto r = __builtin_amdgcn_permlane16_swap(u, u, false, false);
    float m = fmaxf(__builtin_bit_cast(float, (unsigned)r[0]), __builtin_bit_cast(float, (unsigned)r[1]));
    const unsigned u2 = __builtin_bit_cast(unsigned, m);
    auto r2 = __builtin_amdgcn_permlane32_swap(u2, u2, false, false);
    return fmaxf(__builtin_bit_cast(float, (unsigned)r2[0]), __builtin_bit_cast(float, (unsigned)r2[1]));
}
__device__ __forceinline__ float xsum_16_32(float x) {
    const unsigned u = __builtin_bit_cast(unsigned, x);
    auto r = __builtin_amdgcn_permlane16_swap(u, u, false, false);
    float m = __builtin_bit_cast(float, (unsigned)r[0]) + __builtin_bit_cast(float, (unsigned)r[1]);
    const unsigned u2 = __builtin_bit_cast(unsigned, m);
    auto r2 = __builtin_amdgcn_permlane32_swap(u2, u2, false, false);
    return __builtin_bit_cast(float, (unsigned)r2[0]) + __builtin_bit_cast(float, (unsigned)r2[1]);
}
typedef __fp16 fp16x4_t __attribute__((__vector_size__(4 * sizeof(__fp16))));
__device__ __forceinline__ unsigned off_b(unsigned row, unsigned ch) { return 256u * row + 16u * (ch ^ (((row & 3) << 2) | ((row >> 2) & 3))); }
constexpr int SA_TILE = 8192, SA_BL = 8 * 2 * SA_TILE;
static_assert(SA_BL + 16 * 132 * 4 <= LDS_BYTES, "sparse attention LDS");
__device__ __forceinline__ void dsa_attn_phase(const Params& p, int j, unsigned char* smem) {
    const int tid = opaque_tid(), wave = tid >> 6, lane = tid & 63, r = lane & 15, q = lane >> 4;
    float* BL = (float*)(smem + SA_BL);
    for (int idx = tid; idx < 16 * 129; idx += 512) {
        const int h = idx / 129, d = idx % 129;
        int bk = d;
        if (d >= 16) { bk = 16 + (int)(logf((float)d * (1.0f / 16.0f)) / 2.0794415416798357f * 16.0f); bk = bk > 31 ? 31 : bk; }
        BL[h * 132 + d] = p.in[32][bk * 16 + h] * 1.4426950408889634f;
    }
    __syncthreads();
    const h16* qabs = (const h16*)(p.ws + D_QABS);
    const h16* ckv = (const h16*)(p.ws + D_CKV);
    const unsigned short* sel = (const unsigned short*)(p.ws + D_MASK);
    h16* olatA = (h16*)(p.ws + D_HIN);
    h16* olatB = (h16*)p.out + (size_t)MTOK * 1024;
    unsigned char* tile0 = smem + wave * (2 * SA_TILE);
    const float NINF = -__builtin_inff();
    unsigned wofs[8], kofs[2][4], vofs[8][2];
#pragma unroll
    for (int i = 0; i < 8; ++i) wofs[i] = off_b(8 * q + i, r);
#pragma unroll
    for (int tt = 0; tt < 2; ++tt)
#pragma unroll
        for (int kk = 0; kk < 4; ++kk) kofs[tt][kk] = off_b(8 * (r >> 2) + 4 * tt + (r & 3), 4 * kk + q);
#pragma unroll
    for (int c = 0; c < 8; ++c)
#pragma unroll
        for (int t2 = 0; t2 < 2; ++t2) vofs[c][t2] = off_b(8 * q + 4 * t2 + (r >> 2), 2 * c + ((lane & 3) >> 1)) + 8 * (lane & 1);
    for (int row = blockIdx.x * 8 + wave; row < MTOK; row += gridDim.x * 8) {
        const int b = row >> 11, t = row & 2047;
        const int nvalid = t + 1 < 256 ? t + 1 : 256, ng = (nvalid + 31) >> 5;
        const h16* kg = ckv + (size_t)(b * 2048) * 128;
        const unsigned short* srow = sel + (size_t)row * 256;
        h16x8 qf[4];
#pragma unroll
        for (int kk = 0; kk < 4; ++kk) qf[kk] = *(const h16x8*)(qabs + (size_t)row * 2048 + r * 128 + kk * 32 + q * 8);
        f32x4 O[8];
#pragma unroll
        for (int dt = 0; dt < 8; ++dt) O[dt] = (f32x4){0.f, 0.f, 0.f, 0.f};
        float mrun = NINF, lrun = 0.f;
        u32x4 selA = *(const u32x4*)(srow + 8 * q), selB = selA;
        u32x4 grA[8], grB[8];
#define SA_GATHER(GR, SELV) do { _Pragma("unroll") for (int i = 0; i < 8; ++i) { \
            unsigned sidx = ((SELV)[i >> 1] >> ((i & 1) * 16)) & 0xFFFFu; sidx = sidx == 0xFFFFu ? 0u : sidx; \
            (GR)[i] = *(const u32x4*)(kg + (size_t)sidx * 128 + r * 8); } } while (0)
#define SA_GROUP(GR, SELV, G) do { \
            unsigned char* tile = tile0 + ((G) & 1) * SA_TILE; \
            const u32x4 selc = (SELV); \
            _Pragma("unroll") for (int i = 0; i < 8; ++i) *(u32x4*)(tile + wofs[i]) = (GR)[i]; \
            if ((G) + 2 < ng) { (SELV) = *(const u32x4*)(srow + ((G) + 2) * 32 + 8 * q); SA_GATHER(GR, SELV); } \
            asm volatile("s_waitcnt lgkmcnt(0)" ::: "memory"); \
            f32x4 sc[2]; \
            _Pragma("unroll") for (int tt = 0; tt < 2; ++tt) { \
                f32x4 acc = {0.f, 0.f, 0.f, 0.f}; \
                _Pragma("unroll") for (int kk = 0; kk < 4; ++kk) { \
                    const h16x8 kf = *(const h16x8*)(tile + kofs[tt][kk]); \
                    acc = __builtin_amdgcn_mfma_f32_16x16x32_f16(kf, qf[kk], acc, 0, 0, 0); } \
                sc[tt] = acc; } \
            float x[8]; float mx = NINF; \
            _Pragma("unroll") for (int i = 0; i < 8; ++i) { \
                const unsigned sidx = (selc[i >> 1] >> ((i & 1) * 16)) & 0xFFFFu; \
                int dist = t - (int)sidx; dist = dist < 0 ? 0 : (dist > 128 ? 128 : dist); \
                const float v = sc[i >> 2][i & 3] + BL[r * 132 + dist]; \
                const float xv = (sidx != 0xFFFFu) ? v : NINF; \
                x[i] = xv; mx = fmaxf(mx, xv); } \
            mx = xmax_16_32(mx); \
            const float mnew = fmaxf(mrun, mx); \
            const float mref = (mnew == NINF) ? 0.f : mnew; \
            const float alpha = __builtin_amdgcn_exp2f(mrun - mref); \
            mrun = mnew; \
            float ps = 0.f; h16x8 pf; \
            _Pragma("unroll") for (int i = 0; i < 8; ++i) { const float pv = __builtin_amdgcn_exp2f(x[i] - mref); ps += pv; pf[i] = (h16)pv; } \
            lrun = lrun * alpha + ps; \
            _Pragma("unroll") for (int dt = 0; dt < 8; ++dt) { \
                const fp16x4_t lo = __builtin_amdgcn_ds_read_tr16_b64_v4f16((LAS fp16x4_t*)(tile + vofs[dt][0])); \
                const fp16x4_t hi = __builtin_amdgcn_ds_read_tr16_b64_v4f16((LAS fp16x4_t*)(tile + vofs[dt][1])); \
                const h16x4 l4 = __builtin_bit_cast(h16x4, lo), h4 = __builtin_bit_cast(h16x4, hi); \
                const h16x8 vf = {l4[0], l4[1], l4[2], l4[3], h4[0], h4[1], h4[2], h4[3]}; \
                O[dt] *= alpha; \
                O[dt] = __builtin_amdgcn_mfma_f32_16x16x32_f16(vf, pf, O[dt], 0, 0, 0); } \
        } while (0)
        SA_GATHER(grA, selA);
        if (ng > 1) { selB = *(const u32x4*)(srow + 32 + 8 * q); SA_GATHER(grB, selB); }
        for (int g = 0; g < ng; g += 2) {
            SA_GROUP(grA, selA, g);
            if (g + 1 < ng) SA_GROUP(grB, selB, g + 1);
        }
#undef SA_GATHER
#undef SA_GROUP
        const float inv = 1.0f / xsum_16_32(lrun);
        h16* op = (row < MTOK / 2 ? olatA + (size_t)row * 2048 : olatB + (size_t)(row - MTOK / 2) * 2048) + r * 128 + q * 4;
#pragma unroll
        for (int dt = 0; dt < 8; ++dt) {
            u32x2 w; w.x = pk2(O[dt][0] * inv, O[dt][1] * inv); w.y = pk2(O[dt][2] * inv, O[dt][3] * inv);
            *(u32x2*)(op + dt * 16) = w;
        }
        asm volatile("s_waitcnt lgkmcnt(0)" ::: "memory");
    }
    __syncthreads();
}

constexpr size_t OFF_BAR = 951 * MiB;
#define XB_TMO      128
#define XB_XCNT(j)  (256  + 64 * (j))
#define XB_XSUB(j)  (1280 + 64 * (j))
#define XB_XGEN(j)  (2304 + 64 * (j))
#define XB_TOP      3328
#define XB_TOPGEN   3392
#define XCD_BAR_WORDS 3456
#define XB_SPIN_CAP (1u << 22)
__device__ __forceinline__ unsigned xb_ld(unsigned* p)              { return __hip_atomic_load(p, __ATOMIC_RELAXED, __HIP_MEMORY_SCOPE_AGENT); }
__device__ __forceinline__ unsigned xb_add(unsigned* p, unsigned v) { return __hip_atomic_fetch_add(p, v, __ATOMIC_RELAXED, __HIP_MEMORY_SCOPE_AGENT); }
__device__ __forceinline__ unsigned xb_xcc_id() { return (unsigned)__builtin_amdgcn_s_getreg((3 << 11) | 20) & 0xFu; }
#define XB_SPIN(cond, bar) do { unsigned _sp = 0; while (cond) { __builtin_amdgcn_s_sleep(1); \
    if ((++_sp & 255u) == 0u) { if (xb_ld(&(bar)[XB_TMO])) break; if (_sp > XB_SPIN_CAP) { atomicAdd(&(bar)[XB_TMO], 1u); break; } } } } while (0)
struct XcdBarrier { unsigned* bar; unsigned x; volatile LAS unsigned* st; };
__device__ __forceinline__ XcdBarrier xcd_barrier_post(unsigned* bar, volatile LAS unsigned* st) {
    XcdBarrier b; b.bar = bar; b.x = xb_xcc_id(); b.st = st;
    if (threadIdx.x == 0) (void)xb_add(&bar[XB_XCNT(b.x)], 1u);
    return b;
}
__device__ __forceinline__ void xcd_barrier_complete(unsigned* bar, unsigned x, unsigned& nloc, unsigned& nx) {
    const unsigned G = gridDim.x * gridDim.y * gridDim.z;
    unsigned sum, cnt, mine, sp = 0u;
    for (;;) {
        sum = 0u; cnt = 0u; mine = 0u;
#pragma unroll
        for (unsigned jx = 0; jx < 16; ++jx) { const unsigned c = xb_ld(&bar[XB_XCNT(jx)]); sum += c; cnt += (c > 0u) ? 1u : 0u; mine = (jx == x) ? c : mine; }
        if (sum == G) break;
        __builtin_amdgcn_s_sleep(1);
        if ((++sp & 255u) == 0u) { if (xb_ld(&bar[XB_TMO])) break; if (sp > XB_SPIN_CAP) { atomicAdd(&bar[XB_TMO], 1u); break; } }
    }
    nloc = mine > 0u ? mine : 1u; nx = cnt > 0u ? cnt : 1u;
}
__device__ __forceinline__ void xcd_barrier(const XcdBarrier& b) {
    asm volatile("s_waitcnt vmcnt(0)" ::: "memory");
    __syncthreads();
    if (threadIdx.x == 0) {
        unsigned* bar = b.bar;
        __builtin_amdgcn_s_waitcnt(0);
        unsigned nloc = b.st[0], nx = b.st[1];
        if (nloc == 0u) { xcd_barrier_complete(bar, b.x, nloc, nx); b.st[0] = nloc; b.st[1] = nx; }
        const unsigned old = xb_add(&bar[XB_XSUB(b.x)], 1u);
        const unsigned gen = old / nloc;
        if (old + 1u == (gen + 1u) * nloc) {
            __builtin_amdgcn_fence(__ATOMIC_RELEASE, "agent");
            asm volatile("s_waitcnt vmcnt(0)" ::: "memory");
            const unsigned og = xb_add(&bar[XB_TOP], 1u);
            const unsigned tg = og / nx;
            if (og + 1u == (tg + 1u) * nx) xb_add(&bar[XB_TOPGEN], 1u);
            else XB_SPIN(xb_ld(&bar[XB_TOPGEN]) == tg, bar);
            __builtin_amdgcn_fence(__ATOMIC_ACQUIRE, "agent");
            xb_add(&bar[XB_XGEN(b.x)], 1u);
            asm volatile("s_waitcnt vmcnt(0)" ::: "memory");
        } else {
            XB_SPIN(xb_ld(&bar[XB_XGEN(b.x)]) == gen, bar);
            __builtin_amdgcn_fence(__ATOMIC_ACQUIRE, "agent");
            asm volatile("s_waitcnt vmcnt(0)" ::: "memory");
        }
    }
    __syncthreads();
}

__global__ void __launch_bounds__(512) mega_fwd(Params p) {
    extern __shared__ __attribute__((aligned(16))) unsigned char smem[];
    cg::grid_group grid = cg::this_grid();
    unsigned char* ws = p.ws;
    h16* x16 = (h16*)(ws + OFF_X16);
    volatile LAS unsigned* xbst = (volatile LAS unsigned*)(smem + LDS_BYTES - 16);
    if (threadIdx.x == 0) { xbst[0] = 0u; xbst[1] = 0u; }
    __syncthreads();
    const XcdBarrier xbar = xcd_barrier_post((unsigned*)(ws + OFF_BAR), xbst);
    for (int ph = p.ph_lo; ph < p.ph_hi; ++ph) {
        const unsigned e = p.prog[ph];
        const int kind = e & 15, L = (e >> 4) & 3, sub = (e >> 6) & 1, j = L >> 1;
        const int nrep = 1 + (int)(e >> 7);
        for (int rep = 0; rep < nrep; ++rep) {
        if (rep) xcd_barrier(xbar);
        const bool isgemm = (kind == K_R1 || kind == K_R2 || kind == K_R4 || kind == K_F1 || kind == K_F3 || kind == K_D1 || kind == K_D3 || kind == K_D6);
        if (isgemm) {
            const int ngemm = (kind == K_R1) ? 2 : 1;
            for (int gi = 0; gi < ngemm; ++gi) {
            pg8::Gemm g; pg8::Epi E;
            g.M = MTOK; g.N = 1024; g.K = 1024; g.lda = 1024; g.amode = 0; g.pm0 = 0; g.A = x16; g.A2 = x16; g.Bt = x16;
            E.mode = E_RESID; E.pm0 = 0; E.j = j; E.pnoff = 0; E.fin = (L == 3 && kind == K_F3) ? 1 : 0; E.ws = ws; E.out = p.out; E.bias0 = p.in[5] + j * 1024; E.bias1 = p.in[8] + j * 1024; E.bias2 = p.in[11];
            if (kind == K_R1) {
                E.mode = E_RPROJ;
                if (gi == 0) { g.A = (const h16*)p.out; g.A2 = (const h16*)(ws + R_G16); g.Bt = w_rwkv_big(ws, j); g.N = 3072; g.amode = 2; }
                else { g.Bt = w_rwkv_l1(ws, j); g.N = 512; g.K = 2048; g.amode = 1; E.pnoff = 12; }
            } else if (kind == K_R2) {
                g.A = (const h16*)(ws + R_HACT); g.Bt = w_rwkv_l2(ws, j); g.N = (j == 0) ? 3072 : 4096; g.K = 384; g.lda = 384; E.mode = E_LORA2;
            } else if (kind == K_R4) {
                g.A = (const h16*)(ws + (j == 0 ? R_V16 : OFF_VF)); g.Bt = w_rwkv_o(ws, j);
            } else if (kind == K_F1) {
                g.Bt = w_ffn_up(ws, L); g.M = MTOK / 2; g.N = 5632; g.amode = 1; g.pm0 = sub * 128; E.mode = E_ST16;
            } else if (kind == K_F3) {
                g.A = (const h16*)(ws + F_ACT); g.Bt = w_ffn_dn(ws, L); g.M = MTOK / 2; g.K = 2816; g.lda = 2816; E.pm0 = sub * 128;
            } else if (kind == K_D1) {
                g.Bt = w_dsa_in(ws, j); g.N = 512; g.amode = 1; E.mode = E_ST32;
            } else if (kind == K_D3) {
                g.A = (const h16*)(ws + D_CQ); g.Bt = w_dsa_q(ws, j); g.N = 2560; g.K = 256; g.lda = 256; E.mode = E_QPROJ;
            } else {
                g.A = (const h16*)(ws + D_HIN); g.A2 = (const h16*)p.out + (size_t)MTOK * 1024; g.Bt = (const h16*)(ws + OFF_WOV) + (size_t)j * 2097152; g.K = 2048; g.lda = 2048; g.amode = 3;
            }
            pg8::StaticOrder S; S.init(g.M, g.N, (int)gridDim.x, (int)blockIdx.x);
#ifndef NO_GEMM
            pg8::gemm_phase((LAS unsigned char*)smem, g, S, E);
#endif
            }
        } else if (kind == K_PREP) {
#ifndef NO_PREP
            prep_phase(p, smem);
#endif
        } else if (kind == K_R0) {
            mix_phase(p, j);
        } else if (kind == K_R3) {
#ifndef NO_SCAN
            scan_phase(p, j, smem);
#endif
        } else if (kind == K_LN) {
#ifndef NO_LN
            ln_phase(p, p.in[1] + (L * 2 + sub) * 1024, p.in[2] + (L * 2 + sub) * 1024, L == 3 && sub == 1);
#endif
        } else if (kind == K_F2) {
#ifndef NO_CONV
            conv_phase(p, L);
#endif
        } else if (kind == K_D2) {
#ifndef NO_NORM
            dsa_norm_phase(p, j, smem);
#endif
        } else if (kind == K_D4) {
#ifndef NO_INDEX
            dsa_index_phase(p, smem);
#endif
        } else if (kind == K_D5) {
#ifndef NO_ATTN
            dsa_attn_phase(p, j, smem);
#endif
        }
        }
        if (ph + 1 < p.ph_hi) { if (ph == p.ph_lo) grid.sync(); else xcd_barrier(xbar); for (int xs = 0; xs < EXTRA_SYNC; ++xs) xcd_barrier(xbar); }
    }
}

extern "C" void kernel_launch(void* const* d_in, const int* in_sizes, int n_in, void* d_out, int out_size, void* d_ws, size_t ws_size, hipStream_t stream) {
    static int grid_blocks = 0;
    if (grid_blocks == 0) {
        if (n_in != 37 || ws_size < WS_NEED || out_size != MTOK * DM) { fprintf(stderr, "kernel_launch: unexpected problem (n_in %d ws %zu out %d)\n", n_in, ws_size, out_size); grid_blocks = -1; return; }
        int dev = 0, cus = 0, per_cu = 0;
        hipGetDevice(&dev);
        hipDeviceGetAttribute(&cus, hipDeviceAttributeMultiprocessorCount, dev);
        if (hipFuncSetAttribute((const void*)mega_fwd, hipFuncAttributeMaxDynamicSharedMemorySize, LDS_BYTES) != hipSuccess) { fprintf(stderr, "kernel_launch: hipFuncSetAttribute failed\n"); grid_blocks = -1; return; }
        hipOccupancyMaxActiveBlocksPerMultiprocessor(&per_cu, (const void*)mega_fwd, 512, LDS_BYTES);
        if (per_cu < 1) { fprintf(stderr, "kernel_launch: occupancy query says %d blocks/CU\n", per_cu); per_cu = 1; }
        (void)hipGetLastError();
        grid_blocks = cus * per_cu;
        fprintf(stderr, "kernel_launch: grid %d (cus %d x %d)\n", grid_blocks, cus, per_cu);
    }
    if (grid_blocks < 0) return;
    Params p{};
    for (int i = 0; i < 37; ++i) p.in[i] = (const float*)d_in[i];
    p.ws = (unsigned char*)d_ws; p.out = (float*)d_out;
    int np = 0;
    constexpr unsigned PROBE_MASK = 0u;
    auto add = [&](int kind, int L, int sub) { p.prog[np++] = (unsigned char)(kind | (L << 4) | (sub << 6) | ((((PROBE_MASK >> kind) & 1u) && !(kind == K_LN && L == 3 && sub == 1)) ? 128 : 0)); };
    add(K_PREP, 0, 0);
    for (int L = 0; L < 4; ++L) {
        if ((L & 1) == 0) { add(K_R0, L, 0); add(K_R1, L, 0); add(K_R2, L, 0); add(K_R3, L, 0); add(K_R4, L, 0); }
        else { add(K_D1, L, 0); add(K_D2, L, 0); add(K_D3, L, 0); add(K_D4, L, 0); add(K_D5, L, 0); add(K_D6, L, 0); }
        add(K_LN, L, 0);
        for (int c = 0; c < 2; ++c) { add(K_F1, L, c); add(K_F2, L, c); add(K_F3, L, c); }
        add(K_LN, L, 1);
    }
#if SINGLE_LAUNCH
    if (hipMemsetAsync((unsigned char*)d_ws + OFF_BAR, 0, XCD_BAR_WORDS * 4, stream) != hipSuccess) { fprintf(stderr, "kernel_launch: memset failed\n"); return; }
    p.ph_lo = 0; p.ph_hi = np;
    void* args[] = {&p};
    hipError_t e = hipLaunchCooperativeKernel((const void*)mega_fwd, dim3(grid_blocks), dim3(512), args, LDS_BYTES, stream);
    if (e != hipSuccess) fprintf(stderr, "cooperative launch failed: %s (grid %d)\n", hipGetErrorString(e), grid_blocks);
#else
    for (int ph = 0; ph < np; ++ph) {
        p.ph_lo = ph; p.ph_hi = ph + 1;
        hipLaunchKernelGGL(mega_fwd, dim3(grid_blocks), dim3(512), LDS_BYTES, stream, p);
    }
#endif
}
```

```cpp
#include <hip/hip_runtime.h>
#include <hip/hip_cooperative_groups.h>
#include <cstdio>
namespace cg = cooperative_groups;

constexpr int EXTRA_SYNC = 0;
#ifndef SINGLE_LAUNCH
#define SINGLE_LAUNCH 1
#endif

#define LAS __attribute__((address_space(3)))
typedef _Float16 h16;
typedef _Float16 h16x8 __attribute__((ext_vector_type(8)));
typedef _Float16 h16x4 __attribute__((ext_vector_type(4)));
typedef _Float16 h16x2 __attribute__((ext_vector_type(2)));
typedef float f32x4 __attribute__((ext_vector_type(4)));
typedef float f32x2 __attribute__((ext_vector_type(2)));
typedef unsigned u32x4 __attribute__((ext_vector_type(4)));
typedef unsigned u32x2 __attribute__((ext_vector_type(2)));

constexpr int DM = 1024, SEQ = 2048, NBATCH = 32, MTOK = NBATCH * SEQ;
constexpr int DFF = 2816;
constexpr size_t MiB = (size_t)1 << 20;
constexpr float DN_ALPHA = 1.6817928305074290f;
constexpr int LDS_BYTES = 147456;

constexpr size_t OFF_W = 0;
constexpr size_t OFF_X16 = 118 * MiB;
constexpr size_t OFF_VF = 247 * MiB;
constexpr size_t OFF_R = 375 * MiB;
constexpr size_t WS_NEED = 960 * MiB;
constexpr size_t OFF_WOV = 952 * MiB;
constexpr size_t R_R16 = OFF_R, R_K16 = OFF_R + 128 * MiB, R_V16 = OFF_R + 256 * MiB, R_G16 = OFF_R + 384 * MiB, R_HACT = OFF_R + 512 * MiB;
constexpr size_t F_U16 = OFF_R, F_ACT = OFF_R + 352 * MiB;
constexpr size_t D_HIN = OFF_R, D_O16 = OFF_R, D_QABS = OFF_R + 128 * MiB, D_QIDX = OFF_R + 384 * MiB, D_CQ = OFF_R + 448 * MiB,
                 D_CKV = OFF_R + 480 * MiB, D_CKVT = OFF_R + 496 * MiB, D_KIDX = OFF_R + 512 * MiB, D_WIDX = OFF_R + 520 * MiB, D_MASK = OFF_R + 522 * MiB;

struct Params {
    const float* in[37];
    unsigned char* ws;
    float* out;
    int ph_lo, ph_hi;
    unsigned char prog[64];
};

enum { K_PREP = 0, K_R1, K_R2, K_R3, K_R4, K_LN, K_F1, K_F2, K_F3, K_D1, K_D2, K_D3, K_D4, K_D5, K_D6, K_R0 };
enum { E_RPROJ = 0, E_LORA2, E_RESID, E_ST16, E_ST32, E_QPROJ };

__device__ __forceinline__ size_t xrow(int row) { return (size_t)(row >> 11) * 2049 + 1 + (row & 2047); }
__device__ __forceinline__ unsigned pk2(float a, float b) { h16x2 h = {(h16)a, (h16)b}; return __builtin_bit_cast(unsigned, h); }
__device__ __forceinline__ u32x4 pack8(f32x4 a, f32x4 b) { u32x4 w; w.x = pk2(a[0], a[1]); w.y = pk2(a[2], a[3]); w.z = pk2(b[0], b[1]); w.w = pk2(b[2], b[3]); return w; }
__device__ __forceinline__ void unpack8(u32x4 w, float* f) {
    h16x8 h = __builtin_bit_cast(h16x8, w);
#pragma unroll
    for (int i = 0; i < 8; ++i) f[i] = (float)h[i];
}
__device__ __forceinline__ float sigmoidf_(float x) { return 1.0f / (1.0f + __expf(-x)); }
#define WSYNC() asm volatile("s_waitcnt vmcnt(0) lgkmcnt(0)" ::: "memory")
__device__ __forceinline__ int opaque_tid() { int t = threadIdx.x; asm volatile("" : "+v"(t)); return t; }
__device__ __forceinline__ float dppf(float x, const int ctrl_sel) {
    const int v = __builtin_bit_cast(int, x);
    int r;
    if (ctrl_sel == 0) r = __builtin_amdgcn_update_dpp(0, v, 0xB1, 0xF, 0xF, true);
    else if (ctrl_sel == 1) r = __builtin_amdgcn_update_dpp(0, v, 0x4E, 0xF, 0xF, true);
    else if (ctrl_sel == 2) r = __builtin_amdgcn_update_dpp(0, v, 0x141, 0xF, 0xF, true);
    else r = __builtin_amdgcn_update_dpp(0, v, 0x140, 0xF, 0xF, true);
    return __builtin_bit_cast(float, r);
}
__device__ __forceinline__ float red4(float x) { x += dppf(x, 0); x += dppf(x, 1); return x; }
__device__ __forceinline__ float red16(float x) { x += dppf(x, 0); x += dppf(x, 1); x += dppf(x, 2); x += dppf(x, 3); return x; }
__device__ __forceinline__ float xmax_16_32(float x) {
    const unsigned u = __builtin_bit_cast(unsigned, x);
    auto r = __builtin_amdgcn_permlane16_swap(u, u, false, false);
    float m = fmaxf(__builtin_bit_cast(float, (unsigned)r[0]), __builtin_bit_cast(float, (unsigned)r[1]));
    const unsigned u2 = __builtin_bit_cast(unsigned, m);
    auto r2 = __builtin_amdgcn_permlane32_swap(u2, u2, false, false);
    return fmaxf(__builtin_bit_cast(float, (unsigned)r2[0]), __builtin_bit_cast(float, (unsigned)r2[1]));
}
__device__ __forceinline__ float xsum_16_32(float x) {
    const unsigned u = __builtin_bit_cast(unsigned, x);
    auto r = __builtin_amdgcn_permlane16_swap(u, u, false, false);
    float m = __builtin_bit_cast(float, (unsigned)r[0]) + __builtin_bit_cast(float, (unsigned)r[1]);
    const unsigned u2 = __builtin_bit_cast(unsigned, m);
    auto r2 = __builtin_amdgcn_permlane32_swap(u2, u2, false, false);
    return __builtin_bit_cast(float, (unsigned)r2[0]) + __builtin_bit_cast(float, (unsigned)r2[1]);
}
__device__ __forceinline__ float wave_sum(float v) { return xsum_16_32(red16(v)); }

namespace pg8 {
constexpr int BM = 256, BK = 64, HALF = 128, HTB = HALF * BK * 2, STAGE_BYTES = 8 * HTB, NXCD = 8, WGM = 8;
__device__ __forceinline__ int lds_byte(int r, int c) { const int st = (r >> 4) * 2 + (c >> 5), rr = r & 15, cc = c & 31, ob = rr * 64 + cc * 2; return st * 1024 + (ob ^ (((ob >> 9) & 1) << 5)); }
__device__ __forceinline__ void stage_rc(int b, int& R, int& C) { const int st = b / 1024, sb = b % 1024, swz = sb ^ (((sb >> 9) & 1) << 5); R = (st >> 1) * 16 + swz / 64; C = (st & 1) * 32 + (swz % 64) / 2; }
__device__ __forceinline__ int perm32(int rho) { const int n = rho >> 4, i = rho & 15; return 8 * (i >> 2) + 4 * n + (i & 3); }
struct Unit { int pm, pn; };
struct Gemm { const h16* A; const h16* A2; const h16* Bt; int M, N, K, lda, amode, pm0; };
struct StaticOrder {
    int nM, nN, nwg, G, c;
    __device__ void init(int M, int N, int G_, int c_) { nM = M / BM; nN = N / BM; nwg = nM * nN; G = G_; c = c_; }
    __device__ bool next(int i, Unit& u) const {
        const long L = (long)i * G + c; if (L >= nwg) return false;
        int wgid = (int)L; { const int q = nwg / NXCD, r = nwg % NXCD, xcd = wgid % NXCD, off = wgid / NXCD; wgid = (xcd < r ? xcd * (q + 1) : r * (q + 1) + (xcd - r) * q) + off; }
        const int nig = WGM * nN, gid = wgid / nig, fm = gid * WGM, gsz = (nM - fm) < WGM ? (nM - fm) : WGM;
        u.pm = fm + ((wgid % nig) % gsz); u.pn = (wgid % nig) / gsz; return true;
    }
};

struct Epi {
    int mode, pm0, j, pnoff, fin;
    unsigned char* ws; float* out; const float* bias0; const float* bias1; const float* bias2;
    __device__ __forceinline__ void operator()(const f32x4 (&acc)[2][2][4][2], const Unit& u, int wr, int wc, int fr, int fq) const {
        const int rowl0 = u.pm * BM + wr * 64 + fr;
        const int colt = u.pn * BM + wc * 32 + 8 * fq;
        if (mode == E_RESID) {
            u32x4 xr[2][4][2];
#pragma unroll
            for (int ai = 0; ai < 2; ++ai)
#pragma unroll
                for (int m = 0; m < 4; ++m) {
                    const int rowg = rowl0 + ai * HALF + m * 16 + pm0 * BM;
                    const h16* xp = (const h16*)(ws + OFF_X16) + xrow(rowg) * 1024 + colt;
#pragma unroll
                    for (int bj = 0; bj < 2; ++bj) xr[ai][m][bj] = *(const u32x4*)(xp + bj * HALF);
                }
#pragma unroll
            for (int ai = 0; ai < 2; ++ai)
#pragma unroll
                for (int m = 0; m < 4; ++m) {
                    const int rowg = rowl0 + ai * HALF + m * 16 + pm0 * BM;
                    float* dp0 = out + (size_t)rowg * 1024 + colt;
                    h16* hp0 = (h16*)out + (size_t)rowg * 1024 + colt;
#pragma unroll
                    for (int bj = 0; bj < 2; ++bj) {
                        float xf[8]; unpack8(xr[ai][m][bj], xf);
                        const f32x4 v0 = acc[ai][bj][m][0], v1 = acc[ai][bj][m][1];
                        f32x4 r0, r1;
#pragma unroll
                        for (int jj = 0; jj < 4; ++jj) { r0[jj] = DN_ALPHA * xf[jj] + v0[jj]; r1[jj] = DN_ALPHA * xf[4 + jj] + v1[jj]; }
                        if (fin) { float* dp = dp0 + bj * HALF; *(f32x4*)dp = r0; *(f32x4*)(dp + 4) = r1; }
                        else *(u32x4*)(hp0 + bj * HALF) = pack8(r0, r1);
                    }
                }
            return;
        }
        if (mode == E_LORA2 && (u.pn >> 2) == 3) {
            const int c0 = colt & 1023;
#pragma unroll
            for (int ai = 0; ai < 2; ++ai) {
                u32x4 lv[4][2], lf[4][2];
#pragma unroll
                for (int m = 0; m < 4; ++m) {
                    const size_t off = (size_t)(rowl0 + ai * HALF + m * 16 + pm0 * BM) * 1024 + c0;
#pragma unroll
                    for (int bj = 0; bj < 2; ++bj) { lv[m][bj] = *(const u32x4*)((const h16*)(ws + R_V16) + off + bj * HALF); lf[m][bj] = *(const u32x4*)((const h16*)(ws + OFF_VF) + off + bj * HALF); }
                }
#pragma unroll
                for (int m = 0; m < 4; ++m) {
                    const size_t off = (size_t)(rowl0 + ai * HALF + m * 16 + pm0 * BM) * 1024 + c0;
#pragma unroll
                    for (int bj = 0; bj < 2; ++bj) {
                        const int c = c0 + bj * HALF;
                        const f32x4 ba = *(const f32x4*)(bias2 + c), bb = *(const f32x4*)(bias2 + c + 4);
                        float vv[8], vf8[8]; unpack8(lv[m][bj], vv); unpack8(lf[m][bj], vf8);
                        f32x4 v0 = acc[ai][bj][m][0], v1 = acc[ai][bj][m][1];
#pragma unroll
                        for (int jj = 0; jj < 4; ++jj) {
                            v0[jj] = vv[jj] + (vf8[jj] - vv[jj]) * sigmoidf_(v0[jj] + ba[jj]);
                            v1[jj] = vv[4 + jj] + (vf8[4 + jj] - vv[4 + jj]) * sigmoidf_(v1[jj] + bb[jj]);
                        }
                        *(u32x4*)((h16*)(ws + R_V16) + off + bj * HALF) = pack8(v0, v1);
                    }
                }
            }
            return;
        }
#pragma unroll
        for (int ai = 0; ai < 2; ++ai)
#pragma unroll
            for (int m = 0; m < 4; ++m) {
                const int rowl = rowl0 + ai * HALF + m * 16;
                const int rowg = rowl + pm0 * BM;
#pragma unroll
                for (int bj = 0; bj < 2; ++bj) {
                    const int col = colt + bj * HALF;
                    f32x4 v0 = acc[ai][bj][m][0], v1 = acc[ai][bj][m][1];
                    if (mode == E_RPROJ) {
                        if (pnoff == 0) {
                            h16* dst = (h16*)(ws + (u.pn < 4 ? R_R16 : (u.pn < 8 ? R_K16 : (j == 0 ? OFF_VF : R_V16))));
                            *(u32x4*)(dst + (size_t)rowg * 1024 + (col & 1023)) = pack8(v0, v1);
                        } else if (col < 384) {
                            const int hc = col;
                            if (hc < 64) {
#pragma unroll
                                for (int jj = 0; jj < 4; ++jj) { v0[jj] = tanhf(v0[jj]); v1[jj] = tanhf(v1[jj]); }
                            } else if (hc >= 160) {
#pragma unroll
                                for (int jj = 0; jj < 4; ++jj) { v0[jj] = sigmoidf_(v0[jj]); v1[jj] = sigmoidf_(v1[jj]); }
                            }
                            *(u32x4*)((h16*)(ws + R_HACT) + (size_t)rowg * 384 + hc) = pack8(v0, v1);
                        }
                    } else if (mode == E_LORA2) {
                        const int grp = u.pn >> 2, c = col & 1023;
                        const size_t off = (size_t)rowg * 1024 + c;
                        if (grp == 0) {
                            const f32x4 ba = *(const f32x4*)(bias0 + c), bb = *(const f32x4*)(bias0 + c + 4);
#pragma unroll
                            for (int jj = 0; jj < 4; ++jj) { v0[jj] = sigmoidf_(v0[jj] + ba[jj]) * 0.6065306597f; v1[jj] = sigmoidf_(v1[jj] + bb[jj]) * 0.6065306597f; }
                            *(u32x4*)((h16*)out + off) = pack8(v0, v1);
                        } else if (grp == 1) {
                            const f32x4 ba = *(const f32x4*)(bias1 + c), bb = *(const f32x4*)(bias1 + c + 4);
#pragma unroll
                            for (int jj = 0; jj < 4; ++jj) { v0[jj] = sigmoidf_(v0[jj] + ba[jj]); v1[jj] = sigmoidf_(v1[jj] + bb[jj]); }
                            *(u32x4*)((h16*)out + (size_t)MTOK * 1024 + off) = pack8(v0, v1);
                        } else {
                            *(u32x4*)((h16*)(ws + R_G16) + off) = pack8(v0, v1);
                        }
                    } else if (mode == E_ST16) {
                        *(u32x4*)((h16*)(ws + F_U16) + (size_t)rowl * 5632 + col) = pack8(v0, v1);
                    } else if (mode == E_ST32) {
                        float* dp = (float*)(ws + D_HIN) + (size_t)rowg * 512 + col;
                        *(f32x4*)dp = v0; *(f32x4*)(dp + 4) = v1;
                    } else {
                        if (u.pn < 8) *(u32x4*)((h16*)(ws + D_QABS) + (size_t)rowg * 2048 + col) = pack8(v0, v1);
                        else *(u32x4*)((h16*)(ws + D_QIDX) + (size_t)rowg * 512 + (col - 2048)) = pack8(v0, v1);
                    }
                }
            }
    }
};

__device__ __forceinline__ const char* a_tile(const Gemm& g, int pm, int pn) {
    if (g.amode == 1) { const int row = (pm + g.pm0) * BM; return (const char*)g.A + xrow(row) * 2048; }
    if (g.amode == 2) {
        const int gq = pn >> 2;
        const char* base = gq == 2 ? (const char*)g.A2 : (const char*)g.A + (size_t)gq * ((size_t)MTOK * 1024 * 2);
        return base + (size_t)pm * BM * 2048;
    }
    if (g.amode == 3) return (pm < 128 ? (const char*)g.A + (size_t)pm * BM * 4096 : (const char*)g.A2 + (size_t)(pm - 128) * BM * 4096);
    return (const char*)g.A + (size_t)pm * BM * g.lda * 2;
}

__device__ __forceinline__ void gemm_phase(LAS unsigned char* lds, const Gemm g, const StaticOrder& S, const Epi& E) {
    const int tid = opaque_tid(), wid = __builtin_amdgcn_readfirstlane(tid >> 6), lane = tid & 63, wr = wid >> 2, wc = wid & 3, fr = lane & 15, fq = lane >> 4;
    const int K = g.K, nt = K / BK;
    const bool shiftA = (g.amode == 1);
    unsigned voffA[2], voffB[2];
#pragma unroll
    for (int i = 0; i < 2; ++i) { int R, C; stage_rc(tid * 16 + i * 8192, R, C); const int Rb = (R & ~31) + perm32(R & 31);
        voffA[i] = (unsigned)(R * g.lda + C) * 2u; voffB[i] = (unsigned)(Rb * K + C) * 2u; }
    const size_t kstep = (size_t)(BK * 2);
    const size_t hstepA = (size_t)HALF * g.lda * 2;
    const size_t hstepB = (size_t)HALF * K * 2;
    const size_t tstepB = 2 * hstepB;
    const unsigned ldsw = (unsigned)wid * 1024u;
    const int aoff = lds_byte(wr * 64 + fr, fq * 8), boff = lds_byte(wc * 32 + fr, fq * 8);
#define PG8_KOFF(kt) ((size_t)(kt) * kstep - ((shiftA && (kt) >= 16) ? (size_t)4096 : (size_t)0))
#define PG8_SA(b, h) (((b) * 2 + (h)) * HTB)
#define PG8_SB(b, h) ((4 + (b) * 2 + (h)) * HTB)
#define PG8_STAGE(bufoff, gbase, voff) do { _Pragma("unroll") for (int _i = 0; _i < 2; ++_i) \
        __builtin_amdgcn_global_load_lds((const unsigned*)((const char*)(gbase) + (voff)[_i]), (LAS unsigned*)(lds + (bufoff) + ldsw + _i * 8192), 16, 0, 0); } while (0)
#define PG8_LDA(dst, b, h) do { _Pragma("unroll") for (int m = 0; m < 4; ++m) _Pragma("unroll") for (int k = 0; k < 2; ++k) dst[m][k] = *(const LAS h16x8*)(lds + PG8_SA(b, h) + aoff + m * 2048 + k * 1024); } while (0)
#define PG8_LDB(dst, b, h) do { _Pragma("unroll") for (int n = 0; n < 2; ++n) _Pragma("unroll") for (int k = 0; k < 2; ++k) dst[n][k] = *(const LAS h16x8*)(lds + PG8_SB(b, h) + boff + n * 2048 + k * 1024); } while (0)
#define PG8_MMA(ai, bj, At, Bt) do { __builtin_amdgcn_s_setprio(1); _Pragma("unroll") for (int m = 0; m < 4; ++m) _Pragma("unroll") for (int n = 0; n < 2; ++n) _Pragma("unroll") for (int k = 0; k < 2; ++k) \
        acc[ai][bj][m][n] = __builtin_amdgcn_mfma_f32_16x16x32_f16(Bt[n][k], At[m][k], acc[ai][bj][m][n], 0, 0, 0); __builtin_amdgcn_s_setprio(0); } while (0)
#define PG8_WAIT_V(n) asm volatile("s_waitcnt vmcnt(" #n ")" ::: "memory")
#define PG8_WAIT_L(n) asm volatile("s_waitcnt lgkmcnt(" #n ")" ::: "memory")
#define PG8_BAR __builtin_amdgcn_s_barrier()
#define PG8_SCHED __builtin_amdgcn_sched_barrier(0)
    Unit cur, nxt; int ui = 0;
    if (!S.next(0, cur)) return;
    f32x4 acc[2][2][4][2];
#pragma unroll
    for (int a = 0; a < 2; ++a)
#pragma unroll
        for (int b = 0; b < 2; ++b)
#pragma unroll
            for (int m = 0; m < 4; ++m)
#pragma unroll
                for (int n = 0; n < 2; ++n) acc[a][b][m][n] = (f32x4){0.f, 0.f, 0.f, 0.f};
    h16x8 At[4][2], B0[2][2], B1[2][2];
    const char* cA = a_tile(g, cur.pm, cur.pn); const char* cB = (const char*)g.Bt + (size_t)cur.pn * tstepB;
    PG8_STAGE(PG8_SB(0, 0), cB, voffB); PG8_STAGE(PG8_SA(0, 0), cA, voffA); PG8_STAGE(PG8_SB(0, 1), cB + hstepB, voffB); PG8_STAGE(PG8_SA(0, 1), cA + hstepA, voffA);
    if (wr == 1) PG8_BAR;
    PG8_WAIT_V(4); PG8_BAR;
    PG8_STAGE(PG8_SB(1, 0), cB + kstep, voffB); PG8_STAGE(PG8_SA(1, 0), cA + kstep, voffA); PG8_STAGE(PG8_SB(1, 1), cB + hstepB + kstep, voffB);
    PG8_WAIT_V(6); PG8_BAR;
    for (;;) {
        const bool has_next = S.next(ui + 1, nxt);
        const char* nA = has_next ? a_tile(g, nxt.pm, nxt.pn) : cA; const char* nB = has_next ? (const char*)g.Bt + (size_t)nxt.pn * tstepB : cB;
        for (int t = 0; t < nt; t += 2) {
            const bool last = (t == nt - 2);
            const char* a1 = cA + PG8_KOFF(t + 1);
            const char* a2 = last ? nA : cA + PG8_KOFF(t + 2); const char* b2 = last ? nB : cB + (size_t)(t + 2) * kstep;
            const char* a3 = a2 + kstep; const char* b3 = b2 + kstep;
            PG8_LDB(B0, 0, 0); PG8_SCHED; PG8_LDA(At, 0, 0); PG8_STAGE(PG8_SA(1, 1), a1 + hstepA, voffA);
            PG8_WAIT_L(8); PG8_BAR; PG8_WAIT_L(0); PG8_MMA(0, 0, At, B0); PG8_BAR; PG8_SCHED;
            PG8_LDB(B1, 0, 1); PG8_STAGE(PG8_SB(0, 0), b2, voffB);
            PG8_BAR; PG8_WAIT_L(0); PG8_MMA(0, 1, At, B1); PG8_BAR;
            PG8_LDA(At, 0, 1); PG8_STAGE(PG8_SA(0, 0), a2, voffA);
            PG8_BAR; PG8_WAIT_L(0); PG8_MMA(1, 0, At, B0); PG8_BAR; PG8_SCHED;
            PG8_STAGE(PG8_SB(0, 1), b2 + hstepB, voffB);
            PG8_WAIT_V(6); PG8_BAR; PG8_MMA(1, 1, At, B1); PG8_BAR;
            PG8_LDB(B0, 1, 0); PG8_SCHED; PG8_LDA(At, 1, 0); PG8_STAGE(PG8_SA(0, 1), a2 + hstepA, voffA);
            PG8_WAIT_L(8); PG8_BAR; PG8_WAIT_L(0); PG8_MMA(0, 0, At, B0); PG8_BAR; PG8_SCHED;
            PG8_LDB(B1, 1, 1); PG8_STAGE(PG8_SB(1, 0), b3, voffB);
            PG8_BAR; PG8_WAIT_L(0); PG8_MMA(0, 1, At, B1); PG8_BAR;
            PG8_LDA(At, 1, 1); PG8_STAGE(PG8_SA(1, 0), a3, voffA);
            PG8_BAR; PG8_WAIT_L(0); PG8_MMA(1, 0, At, B0); PG8_BAR; PG8_SCHED;
            PG8_STAGE(PG8_SB(1, 1), b3 + hstepB, voffB);
            PG8_WAIT_V(6); PG8_BAR; PG8_MMA(1, 1, At, B1); PG8_BAR;
        }
        E(acc, cur, wr, wc, fr, fq);
        if (!has_next) break;
#pragma unroll
        for (int a = 0; a < 2; ++a)
#pragma unroll
            for (int b = 0; b < 2; ++b)
#pragma unroll
                for (int m = 0; m < 4; ++m)
#pragma unroll
                    for (int n = 0; n < 2; ++n) acc[a][b][m][n] = (f32x4){0.f, 0.f, 0.f, 0.f};
        cur = nxt; cA = nA; cB = nB; ++ui;
    }
    PG8_WAIT_V(0);
    if (wr == 0) PG8_BAR;
    PG8_BAR;
#undef PG8_KOFF
#undef PG8_SA
#undef PG8_SB
#undef PG8_STAGE
#undef PG8_LDA
#undef PG8_LDB
#undef PG8_MMA
#undef PG8_WAIT_V
#undef PG8_WAIT_L
#undef PG8_BAR
#undef PG8_SCHED
}
}

struct TJob { int mode; const float* src; int ld, K, N; h16* dst; int ldd, koff; const float* mix; };

__device__ __forceinline__ TJob get_job(const Params& p, int id) {
    TJob J; J.mode = 0; J.src = nullptr; J.ld = 0; J.K = 0; J.N = 0; J.dst = nullptr; J.ldd = 64; J.koff = 0; J.mix = nullptr;
    h16* W = (h16*)(p.ws + OFF_W);
    if (id < 24) {
        const int j = id / 12, s = id % 12;
        h16* Wrkv = W + (size_t)j * (10 * MiB); h16* Wl1 = Wrkv + 3 * MiB; h16* Wl2 = Wrkv + 7 * MiB;
        const float* mix = p.in[3] + j * 6 * 1024;
        if (s < 3) { J.mode = 0; J.src = p.in[4] + (size_t)(j * 3 + s) * 1048576; J.ld = 1024; J.K = 1024; J.N = 1024; J.dst = Wrkv + (size_t)s * 1024 * 1024; J.ldd = 1024; }
        else if (s < 8) {
            J.mode = 1; J.ld = 1024; J.K = 1024; J.ldd = 2048;
            if (s == 3) { J.src = p.in[6] + (size_t)j * 65536; J.ld = 64; J.N = 64; J.dst = Wl1; J.mix = mix + 3 * 1024; }
            else if (s == 4) { J.src = p.in[9] + (size_t)j * 65536; J.ld = 64; J.N = 64; J.dst = Wl1 + (size_t)64 * 2048; J.mix = mix + 4 * 1024; }
            else if (s == 5) { J.N = 32; J.dst = Wl1 + (size_t)128 * 2048; if (j == 1) { J.src = p.in[12]; J.ld = 32; J.mix = mix + 2 * 1024; } else { J.mode = 2; } }
            else if (s == 6) { J.src = p.in[14] + (size_t)j * 163840; J.ld = 160; J.N = 160; J.dst = Wl1 + (size_t)160 * 2048; J.mix = mix + 5 * 1024; }
            else { J.mode = 2; J.N = 192; J.dst = Wl1 + (size_t)320 * 2048; }
        } else {
            J.mode = 0; J.ld = 1024; J.N = 1024; J.ldd = 384;
            if (s == 8) { J.src = p.in[7] + (size_t)j * 65536; J.K = 64; J.koff = 0; J.dst = Wl2; }
            else if (s == 9) { J.src = p.in[10] + (size_t)j * 65536; J.K = 64; J.koff = 64; J.dst = Wl2 + (size_t)1024 * 384; }
            else if (s == 10) { J.src = p.in[15] + (size_t)j * 163840; J.K = 160; J.koff = 160; J.dst = Wl2 + (size_t)2048 * 384; }
            else { J.src = p.in[13]; J.K = 32; J.koff = 128; J.dst = Wl2 + (size_t)3072 * 384; if (j == 0) J.N = 0; }
        }
    } else if (id < 26) {
        const int j = id - 24;
        J.src = p.in[21] + (size_t)j * 1048576; J.ld = 1024; J.K = 1024; J.N = 1024; J.dst = W + (size_t)j * (10 * MiB) + 9 * MiB; J.ldd = 1024;
    } else if (id < 34) {
        const int i = (id - 26) >> 1, s = (id - 26) & 1;
        h16* base = W + 20 * MiB + (size_t)i * (17 * MiB / 2);
        if (s == 0) { J.src = p.in[33] + (size_t)i * 1024 * 5632; J.ld = 5632; J.K = 1024; J.N = 5632; J.dst = base; J.ldd = 1024; }
        else { J.src = p.in[36] + (size_t)i * 2816 * 1024; J.ld = 1024; J.K = 2816; J.N = 1024; J.dst = base + (size_t)11 * MiB / 2; J.ldd = 2816; }
    } else {
        const int j = (id - 34) >> 2, s = (id - 34) & 3;
        h16* base = W + 54 * MiB + (size_t)j * (5 * MiB / 2);
        if (s == 0) { J.src = p.in[22] + (size_t)j * 1024 * 456; J.ld = 456; J.K = 1024; J.N = 456; J.dst = base; J.ldd = 1024; }
        else if (s == 1) { J.mode = 2; J.N = 56; J.dst = base + (size_t)456 * 1024; J.ldd = 1024; }
        else if (s == 2) { J.src = p.in[28] + (size_t)j * 256 * 512; J.ld = 512; J.K = 256; J.N = 512; J.dst = base + MiB / 2 + (size_t)2048 * 256; J.ldd = 256; }
        else { J.src = p.in[31] + (size_t)j * 1048576; J.ld = 1024; J.K = 1024; J.N = 1024; J.dst = base + 3 * MiB / 2; J.ldd = 1024; }
    }
    return J;
}
__device__ __forceinline__ h16* w_rwkv_big(unsigned char* ws, int j) { return (h16*)(ws + OFF_W) + (size_t)j * (10 * MiB); }
__device__ __forceinline__ h16* w_rwkv_l1(unsigned char* ws, int j) { return w_rwkv_big(ws, j) + 3 * MiB; }
__device__ __forceinline__ h16* w_rwkv_l2(unsigned char* ws, int j) { return w_rwkv_big(ws, j) + 7 * MiB; }
__device__ __forceinline__ h16* w_rwkv_o(unsigned char* ws, int j) { return w_rwkv_big(ws, j) + 9 * MiB; }
__device__ __forceinline__ h16* w_ffn_up(unsigned char* ws, int i) { return (h16*)(ws + OFF_W) + 20 * MiB + (size_t)i * (17 * MiB / 2); }
__device__ __forceinline__ h16* w_ffn_dn(unsigned char* ws, int i) { return w_ffn_up(ws, i) + (size_t)11 * MiB / 2; }
__device__ __forceinline__ h16* w_dsa_in(unsigned char* ws, int j) { return (h16*)(ws + OFF_W) + 54 * MiB + (size_t)j * (5 * MiB / 2); }
__device__ __forceinline__ h16* w_dsa_q(unsigned char* ws, int j) { return w_dsa_in(ws, j) + MiB / 2; }
__device__ __forceinline__ h16* w_dsa_uvt(unsigned char* ws, int j) { return w_dsa_in(ws, j) + 5 * MiB / 4; }
__device__ __forceinline__ h16* w_dsa_o(unsigned char* ws, int j) { return w_dsa_in(ws, j) + 3 * MiB / 2; }

__device__ __forceinline__ void prep_phase(const Params& p, unsigned char* smem) {
    const int tid = opaque_tid();
    const size_t gtid = (size_t)blockIdx.x * 512 + tid, nth = (size_t)gridDim.x * 512;
    h16* x16 = (h16*)(p.ws + OFF_X16);
    for (size_t idx = gtid; idx < (size_t)MTOK * 128; idx += nth) {
        const int row = (int)(idx >> 7), c8 = (int)(idx & 127) * 8;
        const float* sp = p.in[0] + (size_t)row * 1024 + c8;
        const f32x4 a = *(const f32x4*)sp, b = *(const f32x4*)(sp + 4);
        *(u32x4*)(x16 + xrow(row) * 1024 + c8) = pack8(a, b);
    }
    for (size_t idx = gtid; idx < (size_t)NBATCH * 128; idx += nth) {
        const int b = (int)(idx >> 7), c8 = (int)(idx & 127) * 8;
        unsigned z = 0u; asm volatile("" : "+v"(z));
        *(u32x4*)(x16 + (size_t)b * 2049 * 1024 + c8) = (u32x4){z, z, z, z};
    }
    for (size_t it = gtid; it < (size_t)2 * 16 * 2048; it += nth) {
        const int j = (int)(it >> 15), rem = (int)(it & 32767), qg = rem >> 11, n = rem & 2047, h = n >> 7, c = n & 127;
        const float* uq = p.in[25] + (size_t)j * 256 * 1024 + (size_t)(qg * 16) * 1024 + h * 64;
        const float* uk = p.in[26] + (size_t)j * 16 * 64 * 128 + (size_t)h * 64 * 128 + c;
        float acc[16];
#pragma unroll
        for (int i = 0; i < 16; ++i) acc[i] = 0.f;
        for (int d = 0; d < 64; ++d) {
            const float kv = uk[d * 128];
#pragma unroll
            for (int i = 0; i < 16; ++i) acc[i] += uq[i * 1024 + d] * kv;
        }
        const float sc = 0.18033688011112042f;
        h16* dst = w_dsa_q(p.ws, j) + (size_t)n * 256 + qg * 16;
        *(u32x4*)dst = pack8((f32x4){acc[0] * sc, acc[1] * sc, acc[2] * sc, acc[3] * sc}, (f32x4){acc[4] * sc, acc[5] * sc, acc[6] * sc, acc[7] * sc});
        *(u32x4*)(dst + 8) = pack8((f32x4){acc[8] * sc, acc[9] * sc, acc[10] * sc, acc[11] * sc}, (f32x4){acc[12] * sc, acc[13] * sc, acc[14] * sc, acc[15] * sc});
    }
    for (size_t it = gtid; it < (size_t)2 * 128 * 1024; it += nth) {
        const int j = (int)(it >> 17), rem = (int)(it & 131071), kg = rem >> 10, n = rem & 1023, h = kg >> 3, c0 = (kg & 7) * 16;
        const float* uv = p.in[27] + (size_t)((j * 16 + h) * 128 + c0) * 64;
        const float* wo = p.in[31] + (size_t)j * 1048576 + (size_t)(h * 64) * 1024 + n;
        float acc[16];
#pragma unroll
        for (int i = 0; i < 16; ++i) acc[i] = 0.f;
        for (int v = 0; v < 64; ++v) {
            const float wv = wo[(size_t)v * 1024];
#pragma unroll
            for (int i = 0; i < 16; ++i) acc[i] += uv[i * 64 + v] * wv;
        }
        h16* dst = (h16*)(p.ws + OFF_WOV) + (size_t)j * 2097152 + (size_t)n * 2048 + h * 128 + c0;
        *(u32x4*)dst = pack8((f32x4){acc[0], acc[1], acc[2], acc[3]}, (f32x4){acc[4], acc[5], acc[6], acc[7]});
        *(u32x4*)(dst + 8) = pack8((f32x4){acc[8], acc[9], acc[10], acc[11]}, (f32x4){acc[12], acc[13], acc[14], acc[15]});
    }
    float* tile = (float*)smem;
    for (int id = 0; id < 42; ++id) {
        const TJob J = get_job(p, id);
        const int tk = J.ldd >> 6, tn = (J.N + 63) >> 6, ntile = tk * tn;
        for (int tix = blockIdx.x; tix < ntile; tix += gridDim.x) {
            const int k0 = (tix % tk) * 64, n0 = (tix / tk) * 64;
#pragma unroll
            for (int i = 0; i < 8; ++i) {
                const int k = i * 8 + (tid >> 6), n = tid & 63, kk = k0 + k, nn = n0 + n;
                float v = 0.f;
                if (nn < J.N && J.mode != 2) {
                    if (J.mode == 1) { const int ks = kk & 1023; const float mx = J.mix[ks]; v = J.src[(size_t)ks * J.ld + nn] * (kk < 1024 ? 1.0f - mx : mx); }
                    else if (kk >= J.koff && kk < J.koff + J.K) v = J.src[(size_t)(kk - J.koff) * J.ld + nn];
                }
                tile[k * 65 + n] = v;
            }
            __syncthreads();
#pragma unroll
            for (int i = 0; i < 8; ++i) {
                const int n = i * 8 + (tid >> 6), k = tid & 63, nn = n0 + n;
                if (nn < J.N) J.dst[(size_t)nn * J.ldd + k0 + k] = (h16)tile[k * 65 + n];
            }
            __syncthreads();
        }
    }
}

__device__ __forceinline__ void wave_sum4(float (&v)[4]) {
#pragma unroll
    for (int k = 0; k < 4; ++k) v[k] = wave_sum(v[k]);
}
__device__ __forceinline__ void ln_phase(const Params& p, const float* g, const float* b, bool final_out) {
    const int tid = opaque_tid();
    const int lane = tid & 63, wave = tid >> 6;
    float* tb = p.out;
    h16* x16 = (h16*)(p.ws + OFF_X16);
    f32x4 gg[4], bb[4];
#pragma unroll
    for (int i = 0; i < 4; ++i) { gg[i] = *(const f32x4*)(g + i * 256 + lane * 4); bb[i] = *(const f32x4*)(b + i * 256 + lane * 4); }
    for (int rowb = (blockIdx.x * 8 + wave) * 4; rowb < MTOK; rowb += gridDim.x * 32) {
        f32x4 v[4][4];
        float s[4];
#pragma unroll
        for (int k = 0; k < 4; ++k) {
            s[k] = 0.f;
            if (final_out) {
                const float* rp = tb + (size_t)(rowb + k) * 1024;
#pragma unroll
                for (int i = 0; i < 4; ++i) v[k][i] = *(const f32x4*)(rp + i * 256 + lane * 4);
            } else {
                const h16* hp = (const h16*)tb + (size_t)(rowb + k) * 1024;
#pragma unroll
                for (int i = 0; i < 4; ++i) { const h16x4 hv = *(const h16x4*)(hp + i * 256 + lane * 4); v[k][i] = (f32x4){(float)hv[0], (float)hv[1], (float)hv[2], (float)hv[3]}; }
            }
#pragma unroll
            for (int i = 0; i < 4; ++i) s[k] += (v[k][i][0] + v[k][i][1]) + (v[k][i][2] + v[k][i][3]);
        }
        wave_sum4(s);
        float q[4];
#pragma unroll
        for (int k = 0; k < 4; ++k) {
            s[k] *= (1.0f / 1024.0f); q[k] = 0.f;
#pragma unroll
            for (int i = 0; i < 4; ++i)
#pragma unroll
                for (int jj = 0; jj < 4; ++jj) { const float d = v[k][i][jj] - s[k]; q[k] += d * d; }
        }
        wave_sum4(q);
#pragma unroll
        for (int k = 0; k < 4; ++k) {
            const float rstd = rsqrtf(q[k] * (1.0f / 1024.0f) + 1e-5f);
            const int row = rowb + k;
#pragma unroll
            for (int i = 0; i < 4; ++i) {
                f32x4 y;
#pragma unroll
                for (int jj = 0; jj < 4; ++jj) y[jj] = (v[k][i][jj] - s[k]) * rstd * gg[i][jj] + bb[i][jj];
                if (final_out) *(f32x4*)(tb + (size_t)row * 1024 + i * 256 + lane * 4) = y;
                else { u32x2 w; w.x = pk2(y[0], y[1]); w.y = pk2(y[2], y[3]); *(u32x2*)(x16 + xrow(row) * 1024 + i * 256 + lane * 4) = w; }
            }
        }
    }
}

__device__ __forceinline__ void conv_phase(const Params& p, int layer) {
    const h16* u = (const h16*)(p.ws + F_U16);
    h16* act = (h16*)(p.ws + F_ACT);
    const float* cw = p.in[34] + (size_t)layer * 3 * 5632;
    const float* cb = p.in[35] + (size_t)layer * 5632;
    const size_t gtid = (size_t)blockIdx.x * 512 + opaque_tid(), nth = (size_t)gridDim.x * 512;
    const size_t ntask = (size_t)2048 * 352;
    for (size_t task = gtid; task < ntask; task += nth) {
        const int cgp = (int)(task % 352), rc = (int)(task / 352), f = cgp * 8, r0 = rc * 16;
        float wg[3][8], wv[3][8], bg[8], bv[8];
#pragma unroll
        for (int jj = 0; jj < 3; ++jj)
#pragma unroll
            for (int hlf = 0; hlf < 2; ++hlf) {
                const f32x4 a = *(const f32x4*)(cw + jj * 5632 + f + hlf * 4), c = *(const f32x4*)(cw + jj * 5632 + DFF + f + hlf * 4);
#pragma unroll
                for (int e = 0; e < 4; ++e) { wg[jj][hlf * 4 + e] = a[e]; wv[jj][hlf * 4 + e] = c[e]; }
            }
#pragma unroll
        for (int hlf = 0; hlf < 2; ++hlf) {
            const f32x4 a = *(const f32x4*)(cb + f + hlf * 4), c = *(const f32x4*)(cb + DFF + f + hlf * 4);
#pragma unroll
            for (int e = 0; e < 4; ++e) { bg[hlf * 4 + e] = a[e]; bv[hlf * 4 + e] = c[e]; }
        }
        float g2[8], g1[8], v2[8], v1[8];
#pragma unroll
        for (int e = 0; e < 8; ++e) { g2[e] = 0.f; g1[e] = 0.f; v2[e] = 0.f; v1[e] = 0.f; }
        if ((r0 & 2047) != 0) {
            unpack8(*(const u32x4*)(u + (size_t)(r0 - 2) * 5632 + f), g2); unpack8(*(const u32x4*)(u + (size_t)(r0 - 1) * 5632 + f), g1);
            unpack8(*(const u32x4*)(u + (size_t)(r0 - 2) * 5632 + DFF + f), v2); unpack8(*(const u32x4*)(u + (size_t)(r0 - 1) * 5632 + DFF + f), v1);
        }
#pragma unroll 1
        for (int i0 = 0; i0 < 16; i0 += 4) {
            u32x4 lg[4], lv[4];
#pragma unroll
            for (int i = 0; i < 4; ++i) { const size_t ro = (size_t)(r0 + i0 + i) * 5632; lg[i] = *(const u32x4*)(u + ro + f); lv[i] = *(const u32x4*)(u + ro + DFF + f); }
#pragma unroll
            for (int i = 0; i < 4; ++i) {
                float g0[8], v0[8], o[8];
                unpack8(lg[i], g0); unpack8(lv[i], v0);
#pragma unroll
                for (int e = 0; e < 8; ++e) {
                    const float G = wg[0][e] * g2[e] + wg[1][e] * g1[e] + wg[2][e] * g0[e] + bg[e];
                    const float V = wv[0][e] * v2[e] + wv[1][e] * v1[e] + wv[2][e] * v0[e] + bv[e];
                    o[e] = G * sigmoidf_(G) * V;
                    g2[e] = g1[e]; g1[e] = g0[e]; v2[e] = v1[e]; v1[e] = v0[e];
                }
                *(u32x4*)(act + (size_t)(r0 + i0 + i) * DFF + f) = pack8((f32x4){o[0], o[1], o[2], o[3]}, (f32x4){o[4], o[5], o[6], o[7]});
            }
        }
    }
}

__device__ __forceinline__ void mix_phase(const Params& p, int j) {
    const h16* x16 = (const h16*)(p.ws + OFF_X16);
    h16* xr = (h16*)p.out; h16* xk = (h16*)p.out + (size_t)MTOK * 1024; h16* xv = (h16*)(p.ws + R_G16);
    const float* mix = p.in[3] + j * 6 * 1024;
    const size_t gtid = (size_t)blockIdx.x * 512 + opaque_tid(), nth = (size_t)gridDim.x * 512;
    for (size_t idx = gtid; idx < (size_t)MTOK * 128; idx += nth) {
        const int row = (int)(idx >> 7), c8 = (int)(idx & 127) * 8;
        const h16* xp = x16 + xrow(row) * 1024 + c8;
        float xc[8], xq[8];
        unpack8(*(const u32x4*)xp, xc); unpack8(*(const u32x4*)(xp - 1024), xq);
#pragma unroll
        for (int e = 0; e < 8; ++e) xq[e] -= xc[e];
        const size_t o = (size_t)row * 1024 + c8;
#pragma unroll
        for (int bsel = 0; bsel < 3; ++bsel) {
            const f32x4 m0 = *(const f32x4*)(mix + bsel * 1024 + c8), m1 = *(const f32x4*)(mix + bsel * 1024 + c8 + 4);
            f32x4 a, b;
#pragma unroll
            for (int e = 0; e < 4; ++e) { a[e] = xc[e] + xq[e] * m0[e]; b[e] = xc[4 + e] + xq[4 + e] * m1[e]; }
            h16* dst = bsel == 0 ? xr : (bsel == 1 ? xk : xv);
            *(u32x4*)(dst + o) = pack8(a, b);
        }
    }
}

__device__ __forceinline__ void unpack4(u32x2 w, float* f) {
    h16x4 h = __builtin_bit_cast(h16x4, w);
#pragma unroll
    for (int i = 0; i < 4; ++i) f[i] = (float)h[i];
}
constexpr int SCAN_BUF = 8256;
__device__ __forceinline__ void scan_phase(const Params& p, int j, unsigned char* smem) {
    const int tid = opaque_tid();
    const int wave = tid >> 6, lane = tid & 63, slot = wave >> 2, w4 = wave & 3;
    float* LB = (float*)smem + slot * (2 * SCAN_BUF);
    const h16* r16 = (const h16*)(p.ws + R_R16);
    const h16* k16 = (const h16*)(p.ws + R_K16);
    const h16* v16 = (j == 0) ? (const h16*)(p.ws + OFF_VF) : (const h16*)(p.ws + R_V16);
    const h16* g16 = (const h16*)(p.ws + R_G16);
    const h16* e16 = (const h16*)p.out;
    const h16* a16 = (const h16*)p.out + (size_t)MTOK * 1024;
    h16* y16 = (h16*)(p.ws + (j == 0 ? R_V16 : OFF_VF));
    const int tp = w4 * 4 + (lane >> 4), k4 = (lane & 15) * 4;
    const int vrow = w4 * 16 + (lane >> 2), kq = lane & 3;
    for (int pair = blockIdx.x; pair < 256; pair += gridDim.x) {
        const int chain = pair * 2 + slot, b = chain >> 4, h = chain & 15;
        const int col = h * 64 + k4;
        const f32x4 c_kk = *(const f32x4*)(p.in[16] + j * 1024 + col), c_ka = *(const f32x4*)(p.in[17] + j * 1024 + col), c_rk = *(const f32x4*)(p.in[18] + j * 1024 + col);
        const f32x4 c_lg = *(const f32x4*)(p.in[19] + j * 1024 + col), c_lb = *(const f32x4*)(p.in[20] + j * 1024 + col);
        f32x2 S[8];
#pragma unroll
        for (int i = 0; i < 8; ++i) S[i] = (f32x2){0.f, 0.f};
        u32x2 pr[6];
        {
            const size_t go = ((size_t)(b * 2048 + tp)) * 1024 + col;
            pr[0] = *(const u32x2*)(r16 + go); pr[1] = *(const u32x2*)(k16 + go); pr[2] = *(const u32x2*)(v16 + go);
            pr[3] = *(const u32x2*)(e16 + go); pr[4] = *(const u32x2*)(a16 + go); pr[5] = *(const u32x2*)(g16 + go);
        }
        for (int ch = 0; ch < 128; ++ch) {
            float* BUF = LB + (ch & 1) * SCAN_BUF;
            float* OPS = BUF; float* VB = BUF + 5120; float* GB = BUF + 6144; float* YB = BUF + 7168; float* BON = BUF + 8192;
            {
                float rf[4], kf[4], vf[4], ef[4], af[4], gf[4];
                unpack4(pr[0], rf); unpack4(pr[1], kf); unpack4(pr[2], vf); unpack4(pr[3], ef); unpack4(pr[4], af); unpack4(pr[5], gf);
                float kk[4]; float ss = 0.f;
#pragma unroll
                for (int i = 0; i < 4; ++i) { kk[i] = kf[i] * c_kk[i]; ss += kk[i] * kk[i]; }
                ss = red16(ss);
                const float inv = 1.0f / fmaxf(sqrtf(ss), 1e-12f);
                f32x4 A4, B4, W4, K4, R4; float bs = 0.f;
#pragma unroll
                for (int i = 0; i < 4; ++i) {
                    const float kn = kk[i] * inv;
                    A4[i] = -kn; B4[i] = kn * af[i];
                    W4[i] = __expf(-ef[i]);
                    const float km = kf[i] * (1.0f + (af[i] - 1.0f) * c_ka[i]);
                    K4[i] = km; R4[i] = rf[i];
                    bs += rf[i] * km * c_rk[i];
                }
                bs = red16(bs);
                float* o = OPS + tp * 320 + k4;
                *(f32x4*)(o) = A4; *(f32x4*)(o + 64) = B4; *(f32x4*)(o + 128) = W4; *(f32x4*)(o + 192) = K4; *(f32x4*)(o + 256) = R4;
                *(f32x4*)(VB + tp * 64 + k4) = (f32x4){vf[0], vf[1], vf[2], vf[3]};
                *(f32x4*)(GB + tp * 64 + k4) = (f32x4){gf[0], gf[1], gf[2], gf[3]};
                if ((lane & 15) == 0) BON[tp] = bs;
            }
            if (ch + 1 < 128) {
                const size_t go = ((size_t)(b * 2048 + (ch + 1) * 16 + tp)) * 1024 + col;
                pr[0] = *(const u32x2*)(r16 + go); pr[1] = *(const u32x2*)(k16 + go); pr[2] = *(const u32x2*)(v16 + go);
                pr[3] = *(const u32x2*)(e16 + go); pr[4] = *(const u32x2*)(a16 + go); pr[5] = *(const u32x2*)(g16 + go);
            }
            __syncthreads();
#pragma unroll 2
            for (int t = 0; t < 16; ++t) {
                const float* op = OPS + t * 320 + kq * 16;
                f32x4 A4[4], B4[4], W4[4], K4[4], R4[4];
#pragma unroll
                for (int i = 0; i < 4; ++i) A4[i] = *(const f32x4*)(op + i * 4);
#pragma unroll
                for (int i = 0; i < 4; ++i) { W4[i] = *(const f32x4*)(op + 128 + i * 4); B4[i] = *(const f32x4*)(op + 64 + i * 4); K4[i] = *(const f32x4*)(op + 192 + i * 4); }
#pragma unroll
                for (int i = 0; i < 4; ++i) R4[i] = *(const f32x4*)(op + 256 + i * 4);
                const float vv = VB[t * 64 + vrow];
                f32x2 s0 = {0.f, 0.f}, s1 = {0.f, 0.f};
#pragma unroll
                for (int i = 0; i < 4; ++i) { s0 += S[2 * i] * (f32x2){A4[i][0], A4[i][1]}; s1 += S[2 * i + 1] * (f32x2){A4[i][2], A4[i][3]}; }
                const float sa = red4((s0[0] + s0[1]) + (s1[0] + s1[1]));
                const f32x2 sa2 = {sa, sa}, vv2 = {vv, vv};
#pragma unroll
                for (int i = 0; i < 4; ++i) {
                    S[2 * i] = S[2 * i] * (f32x2){W4[i][0], W4[i][1]} + sa2 * (f32x2){B4[i][0], B4[i][1]} + vv2 * (f32x2){K4[i][0], K4[i][1]};
                    S[2 * i + 1] = S[2 * i + 1] * (f32x2){W4[i][2], W4[i][3]} + sa2 * (f32x2){B4[i][2], B4[i][3]} + vv2 * (f32x2){K4[i][2], K4[i][3]};
                }
                f32x2 y0 = {0.f, 0.f}, y1 = {0.f, 0.f};
#pragma unroll
                for (int i = 0; i < 4; ++i) { y0 += S[2 * i] * (f32x2){R4[i][0], R4[i][1]}; y1 += S[2 * i + 1] * (f32x2){R4[i][2], R4[i][3]}; }
                const float y = red4((y0[0] + y0[1]) + (y1[0] + y1[1]));
                if (kq == 0) YB[t * 64 + vrow] = y;
            }
            __syncthreads();
            {
                const f32x4 y4 = *(const f32x4*)(YB + tp * 64 + k4), v4 = *(const f32x4*)(VB + tp * 64 + k4), g4 = *(const f32x4*)(GB + tp * 64 + k4);
                const float mu = red16((y4[0] + y4[1]) + (y4[2] + y4[3])) * (1.0f / 64.0f);
                float q = 0.f;
#pragma unroll
                for (int i = 0; i < 4; ++i) { const float d = y4[i] - mu; q += d * d; }
                const float rstd = rsqrtf(red16(q) * (1.0f / 64.0f) + 64e-5f);
                const float bon = BON[tp];
                float o[4];
#pragma unroll
                for (int i = 0; i < 4; ++i) o[i] = ((y4[i] - mu) * rstd * c_lg[i] + c_lb[i] + bon * v4[i]) * g4[i];
                u32x2 w; w.x = pk2(o[0], o[1]); w.y = pk2(o[2], o[3]);
                *(u32x2*)(y16 + ((size_t)(b * 2048 + ch * 16 + tp)) * 1024 + col) = w;
            }
        }
        __syncthreads();
    }
}

__device__ __forceinline__ void dsa_norm_phase(const Params& p, int j, unsigned char* smem) {
    const int tid = opaque_tid();
    const int lane = tid & 63, wave = tid >> 6;
    const float* hin = (const float*)(p.ws + D_HIN);
    h16* cq = (h16*)(p.ws + D_CQ); h16* ckv = (h16*)(p.ws + D_CKV); h16* ckvt = (h16*)(p.ws + D_CKVT); h16* kidx = (h16*)(p.ws + D_KIDX);
    float* widx = (float*)(p.ws + D_WIDX);
    const f32x4 gq = *(const f32x4*)(p.in[23] + j * 256 + lane * 4);
    const f32x2 gkv = *(const f32x2*)(p.in[24] + j * 128 + lane * 2);
    const float gi = p.in[29][j * 64 + lane], bi = p.in[30][j * 64 + lane];
    h16* wl = (h16*)(smem + wave * 2048);
    for (int grp = blockIdx.x * 8 + wave; grp < MTOK / 8; grp += gridDim.x * 8) {
        const int r0 = grp * 8;
        for (int i = 0; i < 8; ++i) {
            const int row = r0 + i;
            const float* hp = hin + (size_t)row * 512;
            const f32x4 vq = *(const f32x4*)(hp + lane * 4);
            const f32x2 vk = *(const f32x2*)(hp + 256 + lane * 2);
            const float vi = hp[384 + lane];
            float ssq = wave_sum(vq[0] * vq[0] + vq[1] * vq[1] + vq[2] * vq[2] + vq[3] * vq[3]);
            const float rq = rsqrtf(ssq * (1.0f / 256.0f) + 1e-6f);
            u32x2 w; w.x = pk2(vq[0] * rq * gq[0], vq[1] * rq * gq[1]); w.y = pk2(vq[2] * rq * gq[2], vq[3] * rq * gq[3]);
            *(u32x2*)(cq + (size_t)row * 256 + lane * 4) = w;
            float ssk = wave_sum(vk[0] * vk[0] + vk[1] * vk[1]);
            const float rk = rsqrtf(ssk * (1.0f / 128.0f) + 1e-6f);
            const unsigned wk = pk2(vk[0] * rk * gkv[0], vk[1] * rk * gkv[1]);
            *(unsigned*)(ckv + (size_t)row * 128 + lane * 2) = wk;
            const float mu = wave_sum(vi) * (1.0f / 64.0f);
            const float dv = vi - mu;
            const float var = wave_sum(dv * dv) * (1.0f / 64.0f);
            kidx[(size_t)row * 64 + lane] = (h16)(dv * rsqrtf(var + 1e-5f) * gi + bi);
            if (lane < 8) widx[(size_t)row * 8 + lane] = hp[448 + lane] * 0.044194173824159216f;
        }
    }
}

constexpr int ROWP = 2052;
__device__ __forceinline__ unsigned fkey(float x) {
    if (x == 0.0f) x = 0.0f;
    const unsigned u = __float_as_uint(x);
    return (u & 0x80000000u) ? ~u : (u | 0x80000000u);
}
__device__ __forceinline__ void dsa_index_phase(const Params& p, unsigned char* smem) {
    const int tid = opaque_tid(), wave = tid >> 6, lane = tid & 63, r = lane & 15, q = lane >> 4;
    float* SC = (float*)smem;
    const h16* qidx = (const h16*)(p.ws + D_QIDX);
    const h16* kidx = (const h16*)(p.ws + D_KIDX);
    const float* widx = (const float*)(p.ws + D_WIDX);
    unsigned short* selout = (unsigned short*)(p.ws + D_MASK);
    h16x8 qf[8][2]; float wq[8];
    if ((int)blockIdx.x < MTOK / 16) {
        const int row0 = (int)blockIdx.x * 16;
#pragma unroll
        for (int h = 0; h < 8; ++h) {
#pragma unroll
            for (int kk = 0; kk < 2; ++kk) qf[h][kk] = *(const h16x8*)(qidx + (size_t)(row0 + r) * 512 + h * 64 + kk * 32 + q * 8);
            wq[h] = widx[(size_t)(row0 + r) * 8 + h];
        }
    }
    for (int qi = blockIdx.x, it = 0; qi < MTOK / 16; qi += gridDim.x, ++it) {
        const int qt = (it & 1) ? ((qi & ~127) | (127 - (qi & 127))) : qi;
        const int row0 = qt * 16, b = row0 >> 11, t0 = row0 & 2047;
        const int nkt = (t0 >> 4) + 1;
        {
            h16x8 kn[4];
            if (wave < nkt) {
                const bool two = (wave + 8 < nkt);
                const int s0 = wave * 16, s1 = two ? s0 + 128 : s0;
                const h16* kp = kidx + (size_t)(b * 2048 + s0 + r) * 64 + q * 8;
                const h16* kp1 = kidx + (size_t)(b * 2048 + s1 + r) * 64 + q * 8;
                kn[0] = *(const h16x8*)kp; kn[1] = *(const h16x8*)(kp + 32); kn[2] = *(const h16x8*)kp1; kn[3] = *(const h16x8*)(kp1 + 32);
            }
            for (int kt = wave; kt < nkt; kt += 16) {
                const bool two = (kt + 8 < nkt);
                const int s0 = kt * 16, s1 = two ? s0 + 128 : s0;
                const h16x8 k0 = kn[0], k1 = kn[1], k2 = kn[2], k3 = kn[3];
                if (kt + 16 < nkt) {
                    const bool two2 = (kt + 24 < nkt);
                    const int n0 = (kt + 16) * 16, n1 = two2 ? n0 + 128 : n0;
                    const h16* kp = kidx + (size_t)(b * 2048 + n0 + r) * 64 + q * 8;
                    const h16* kp1 = kidx + (size_t)(b * 2048 + n1 + r) * 64 + q * 8;
                    kn[0] = *(const h16x8*)kp; kn[1] = *(const h16x8*)(kp + 32); kn[2] = *(const h16x8*)kp1; kn[3] = *(const h16x8*)(kp1 + 32);
                }
                f32x4 sc = {0.f, 0.f, 0.f, 0.f}, sd = {0.f, 0.f, 0.f, 0.f};
#pragma unroll
                for (int h = 0; h < 8; ++h) {
                    f32x4 acc = {0.f, 0.f, 0.f, 0.f}, acd = {0.f, 0.f, 0.f, 0.f};
                    acc = __builtin_amdgcn_mfma_f32_16x16x32_f16(k0, qf[h][0], acc, 0, 0, 0);
                    acd = __builtin_amdgcn_mfma_f32_16x16x32_f16(k2, qf[h][0], acd, 0, 0, 0);
                    acc = __builtin_amdgcn_mfma_f32_16x16x32_f16(k1, qf[h][1], acc, 0, 0, 0);
                    acd = __builtin_amdgcn_mfma_f32_16x16x32_f16(k3, qf[h][1], acd, 0, 0, 0);
#pragma unroll
                    for (int jj = 0; jj < 4; ++jj) { sc[jj] += fmaxf(acc[jj], 0.f) * wq[h]; sd[jj] += fmaxf(acd[jj], 0.f) * wq[h]; }
                }
                *(f32x4*)(SC + r * ROWP + s0 + q * 4) = sc;
                if (two) *(f32x4*)(SC + r * ROWP + s1 + q * 4) = sd;
            }
            const int qin = qi + (int)gridDim.x;
            if (qin < MTOK / 16) {
                const int qtn = ((it + 1) & 1) ? ((qin & ~127) | (127 - (qin & 127))) : qin;
                const int rown = qtn * 16;
#pragma unroll
                for (int h = 0; h < 8; ++h) {
#pragma unroll
                    for (int kk = 0; kk < 2; ++kk) qf[h][kk] = *(const h16x8*)(qidx + (size_t)(rown + r) * 512 + h * 64 + kk * 32 + q * 8);
                    wq[h] = widx[(size_t)(rown + r) * 8 + h];
                }
            }
        }
        __syncthreads();
        for (int qq = 0; qq < 2; ++qq) {
            const int ql = wave * 2 + qq, t = t0 + ql;
            const float* srow = SC + ql * ROWP;
            const int ni = (t >> 6) + 1;
            unsigned u[32];
#pragma unroll
            for (int i = 0; i < 32; ++i) {
                u[i] = 0u;
                if (i < ni) { const int s = i * 64 + lane; if (s <= t) u[i] = fkey(srow[s]); }
            }
            unsigned short* selrow = selout + (size_t)(row0 + ql) * 256;
            if (t < 256) {
#pragma unroll
                for (int i = 0; i < 4; ++i) { const int pp = i * 64 + lane; selrow[pp] = (unsigned short)(pp <= t ? pp : 0xFFFF); }
            } else {
                unsigned* H = (unsigned*)(smem + 16 * ROWP * 4) + wave * 256;
                unsigned prefix = 0u; int need = 256;
#pragma unroll 1
                for (int pass = 0; pass < 4; ++pass) {
                    const int shift = 24 - 8 * pass;
                    const unsigned hmask = pass == 0 ? 0u : (0xFFFFFFFFu << (shift + 8));
                    *(u32x4*)(H + lane * 4) = (u32x4){0u, 0u, 0u, 0u};
                    asm volatile("s_waitcnt lgkmcnt(0)" ::: "memory");
#pragma unroll
                    for (int i = 0; i < 32; ++i) if (i < ni) { const unsigned uu = u[i]; if (uu != 0u && (uu & hmask) == prefix) atomicAdd(H + ((uu >> shift) & 255u), 1u); }
                    asm volatile("s_waitcnt lgkmcnt(0)" ::: "memory");
                    const u32x4 hv = *(const u32x4*)(H + lane * 4);
                    const int tot = (int)(hv.x + hv.y + hv.z + hv.w);
                    int rs = tot;
                    rs += __builtin_amdgcn_update_dpp(0, rs, 0xB1, 0xF, 0xF, true);
                    rs += __builtin_amdgcn_update_dpp(0, rs, 0x4E, 0xF, 0xF, true);
                    rs += __builtin_amdgcn_update_dpp(0, rs, 0x141, 0xF, 0xF, true);
                    rs += __builtin_amdgcn_update_dpp(0, rs, 0x140, 0xF, 0xF, true);
                    int rowsel = 3, above = 0;
                    {
                        const int r3 = __builtin_amdgcn_readlane(rs, 48), r2 = __builtin_amdgcn_readlane(rs, 32), r1 = __builtin_amdgcn_readlane(rs, 16);
                        if (need > r3) { above = r3; rowsel = 2; if (need > above + r2) { above += r2; rowsel = 1; if (need > above + r1) { above += r1; rowsel = 0; } } }
                    }
                    int lsel = rowsel * 16;
                    for (int k = 15; k >= 0; --k) {
                        const int cl = __builtin_amdgcn_readlane(tot, rowsel * 16 + k);
                        if (need <= above + cl) { lsel = rowsel * 16 + k; break; }
                        above += cl;
                    }
                    const int b3 = __builtin_amdgcn_readlane((int)hv.w, lsel), b2 = __builtin_amdgcn_readlane((int)hv.z, lsel), b1 = __builtin_amdgcn_readlane((int)hv.y, lsel);
                    int bsel = 3;
                    if (need > above + b3) { above += b3; bsel = 2; if (need > above + b2) { above += b2; bsel = 1; if (need > above + b1) { above += b1; bsel = 0; } } }
                    prefix |= (unsigned)(lsel * 4 + bsel) << shift;
                    need -= above;
                }
                const unsigned T = prefix;
                int running = 0, outpos = 0;
                const unsigned long long lt = (lane == 0) ? 0ull : (~0ull >> (64 - lane));
#pragma unroll
                for (int i = 0; i < 32; ++i) {
                    if (i < ni) {
                        const unsigned long long eq = __ballot(u[i] == T);
                        const int rank = running + __popcll(eq & lt);
                        const bool sel = u[i] > T || (u[i] == T && rank < need);
                        const unsigned long long sm = __ballot(sel);
                        running += __popcll(eq);
                        if (sel) selrow[outpos + __popcll(sm & lt)] = (unsigned short)(i * 64 + lane);
                        outpos += __popcll(sm);
                    }
                }
            }
        }
        __syncthreads();
    }
}

typedef __fp16 fp16x4_t __attribute__((__vector_size__(4 * sizeof(__fp16))));
__device__ __forceinline__ unsigned off_b(unsigned row, unsigned ch) { return 256u * row + 16u * (ch ^ (((row & 3) << 2) | ((row >> 2) & 3))); }
constexpr int SA_TILE = 8192, SA_BL = 8 * 2 * SA_TILE;
static_assert(SA_BL + 16 * 132 * 4 <= LDS_BYTES, "sparse attention LDS");
__device__ __forceinline__ void dsa_attn_phase(const Params& p, int j, unsigned char* smem) {
    const int tid = opaque_tid(), wave = tid >> 6, lane = tid & 63, r = lane & 15, q = lane >> 4;
    float* BL = (float*)(smem + SA_BL);
    for (int idx = tid; idx < 16 * 129; idx += 512) {
        const int h = idx / 129, d = idx % 129;
        int bk = d;
        if (d >= 16) { bk = 16 + (int)(logf((float)d * (1.0f / 16.0f)) / 2.0794415416798357f * 16.0f); bk = bk > 31 ? 31 : bk; }
        BL[h * 132 + d] = p.in[32][bk * 16 + h] * 1.4426950408889634f;
    }
    __syncthreads();
    const h16* qabs = (const h16*)(p.ws + D_QABS);
    const h16* ckv = (const h16*)(p.ws + D_CKV);
    const unsigned short* sel = (const unsigned short*)(p.ws + D_MASK);
    h16* olatA = (h16*)(p.ws + D_HIN);
    h16* olatB = (h16*)p.out + (size_t)MTOK * 1024;
    unsigned char* tile0 = smem + wave * (2 * SA_TILE);
    const float NINF = -__builtin_inff();
    unsigned wofs[8], kofs[2][4], vofs[8][2];
#pragma unroll
    for (int i = 0; i < 8; ++i) wofs[i] = off_b(8 * q + i, r);
#pragma unroll
    for (int tt = 0; tt < 2; ++tt)
#pragma unroll
        for (int kk = 0; kk < 4; ++kk) kofs[tt][kk] = off_b(8 * (r >> 2) + 4 * tt + (r & 3), 4 * kk + q);
#pragma unroll
    for (int c = 0; c < 8; ++c)
#pragma unroll
        for (int t2 = 0; t2 < 2; ++t2) vofs[c][t2] = off_b(8 * q + 4 * t2 + (r >> 2), 2 * c + ((lane & 3) >> 1)) + 8 * (lane & 1);
    for (int row = blockIdx.x * 8 + wave; row < MTOK; row += gridDim.x * 8) {
        const int b = row >> 11, t = row & 2047;
        const int nvalid = t + 1 < 256 ? t + 1 : 256, ng = (nvalid + 31) >> 5;
        const h16* kg = ckv + (size_t)(b * 2048) * 128;
        const unsigned short* srow = sel + (size_t)row * 256;
        h16x8 qf[4];
#pragma unroll
        for (int kk = 0; kk < 4; ++kk) qf[kk] = *(const h16x8*)(qabs + (size_t)row * 2048 + r * 128 + kk * 32 + q * 8);
        f32x4 O[8];
#pragma unroll
        for (int dt = 0; dt < 8; ++dt) O[dt] = (f32x4){0.f, 0.f, 0.f, 0.f};
        float mrun = NINF, lrun = 0.f;
        u32x4 selA = *(const u32x4*)(srow + 8 * q), selB = selA;
        u32x4 grA[8], grB[8];
#define SA_GATHER(GR, SELV) do { _Pragma("unroll") for (int i = 0; i < 8; ++i) { \
            unsigned sidx = ((SELV)[i >> 1] >> ((i & 1) * 16)) & 0xFFFFu; sidx = sidx == 0xFFFFu ? 0u : sidx; \
            (GR)[i] = *(const u32x4*)(kg + (size_t)sidx * 128 + r * 8); } } while (0)
#define SA_GROUP(GR, SELV, G) do { \
            unsigned char* tile = tile0 + ((G) & 1) * SA_TILE; \
            const u32x4 selc = (SELV); \
            _Pragma("unroll") for (int i = 0; i < 8; ++i) *(u32x4*)(tile + wofs[i]) = (GR)[i]; \
            if ((G) + 2 < ng) { (SELV) = *(const u32x4*)(srow + ((G) + 2) * 32 + 8 * q); SA_GATHER(GR, SELV); } \
            asm volatile("s_waitcnt lgkmcnt(0)" ::: "memory"); \
            f32x4 sc[2]; \
            _Pragma("unroll") for (int tt = 0; tt < 2; ++tt) { \
                f32x4 acc = {0.f, 0.f, 0.f, 0.f}; \
                _Pragma("unroll") for (int kk = 0; kk < 4; ++kk) { \
                    const h16x8 kf = *(const h16x8*)(tile + kofs[tt][kk]); \
                    acc = __builtin_amdgcn_mfma_f32_16x16x32_f16(kf, qf[kk], acc, 0, 0, 0); } \
                sc[tt] = acc; } \
            float x[8]; float mx = NINF; \
            _Pragma("unroll") for (int i = 0; i < 8; ++i) { \
                const unsigned sidx = (selc[i >> 1] >> ((i & 1) * 16)) & 0xFFFFu; \
                int dist = t - (int)sidx; dist = dist < 0 ? 0 : (dist > 128 ? 128 : dist); \
                const float v = sc[i >> 2][i & 3] + BL[r * 132 + dist]; \
                const float xv = (sidx != 0xFFFFu) ? v : NINF; \
                x[i] = xv; mx = fmaxf(mx, xv); } \
            mx = xmax_16_32(mx); \
            const float mnew = fmaxf(mrun, mx); \
            const float mref = (mnew == NINF) ? 0.f : mnew; \
            const float alpha = __builtin_amdgcn_exp2f(mrun - mref); \
            mrun = mnew; \
            float ps = 0.f; h16x8 pf; \
            _Pragma("unroll") for (int i = 0; i < 8; ++i) { const float pv = __builtin_amdgcn_exp2f(x[i] - mref); ps += pv; pf[i] = (h16)pv; } \
            lrun = lrun * alpha + ps; \
            _Pragma("unroll") for (int dt = 0; dt < 8; ++dt) { \
                const fp16x4_t lo = __builtin_amdgcn_ds_read_tr16_b64_v4f16((LAS fp16x4_t*)(tile + vofs[dt][0])); \
                const fp16x4_t hi = __builtin_amdgcn_ds_read_tr16_b64_v4f16((LAS fp16x4_t*)(tile + vofs[dt][1])); \
                const h16x4 l4 = __builtin_bit_cast(h16x4, lo), h4 = __builtin_bit_cast(h16x4, hi); \
                const h16x8 vf = {l4[0], l4[1], l4[2], l4[3], h4[0], h4[1], h4[2], h4[3]}; \
                O[dt] *= alpha; \
                O[dt] = __builtin_amdgcn_mfma_f32_16x16x32_f16(vf, pf, O[dt], 0, 0, 0); } \
        } while (0)
        SA_GATHER(grA, selA);
        if (ng > 1) { selB = *(const u32x4*)(srow + 32 + 8 * q); SA_GATHER(grB, selB); }
        for (int g = 0; g < ng; g += 2) {
            SA_GROUP(grA, selA, g);
            if (g + 1 < ng) SA_GROUP(grB, selB, g + 1);
        }
#undef SA_GATHER
#undef SA_GROUP
        const float inv = 1.0f / xsum_16_32(lrun);
        h16* op = (row < MTOK / 2 ? olatA + (size_t)row * 2048 : olatB + (size_t)(row - MTOK / 2) * 2048) + r * 128 + q * 4;
#pragma unroll
        for (int dt = 0; dt < 8; ++dt) {
            u32x2 w; w.x = pk2(O[dt][0] * inv, O[dt][1] * inv); w.y = pk2(O[dt][2] * inv, O[dt][3] * inv);
            *(u32x2*)(op + dt * 16) = w;
        }
        asm volatile("s_waitcnt lgkmcnt(0)" ::: "memory");
    }
    __syncthreads();
}

constexpr size_t OFF_BAR = 951 * MiB;
#define XB_TMO      128
#define XB_XCNT(j)  (256  + 64 * (j))
#define XB_XSUB(j)  (1280 + 64 * (j))
#define XB_XGEN(j)  (2304 + 64 * (j))
#define XB_TOP      3328
#define XB_TOPGEN   3392
#define XCD_BAR_WORDS 3456
#define XB_SPIN_CAP (1u << 22)
__device__ __forceinline__ unsigned xb_ld(unsigned* p)              { return __hip_atomic_load(p, __ATOMIC_RELAXED, __HIP_MEMORY_SCOPE_AGENT); }
__device__ __forceinline__ unsigned xb_add(unsigned* p, unsigned v) { return __hip_atomic_fetch_add(p, v, __ATOMIC_RELAXED, __HIP_MEMORY_SCOPE_AGENT); }
__device__ __forceinline__ unsigned xb_xcc_id() { return (unsigned)__builtin_amdgcn_s_getreg((3 << 11) | 20) & 0xFu; }
#define XB_SPIN(cond, bar) do { unsigned _sp = 0; while (cond) { __builtin_amdgcn_s_sleep(1); \
    if ((++_sp & 255u) == 0u) { if (xb_ld(&(bar)[XB_TMO])) break; if (_sp > XB_SPIN_CAP) { atomicAdd(&(bar)[XB_TMO], 1u); break; } } } } while (0)
struct XcdBarrier { unsigned* bar; unsigned x; volatile LAS unsigned* st; };
__device__ __forceinline__ XcdBarrier xcd_barrier_post(unsigned* bar, volatile LAS unsigned* st) {
    XcdBarrier b; b.bar = bar; b.x = xb_xcc_id(); b.st = st;
    if (threadIdx.x == 0) (void)xb_add(&bar[XB_XCNT(b.x)], 1u);
    return b;
}
__device__ __forceinline__ void xcd_barrier_complete(unsigned* bar, unsigned x, unsigned& nloc, unsigned& nx) {
    const unsigned G = gridDim.x * gridDim.y * gridDim.z;
    unsigned sum, cnt, mine, sp = 0u;
    for (;;) {
        sum = 0u; cnt = 0u; mine = 0u;
#pragma unroll
        for (unsigned jx = 0; jx < 16; ++jx) { const unsigned c = xb_ld(&bar[XB_XCNT(jx)]); sum += c; cnt += (c > 0u) ? 1u : 0u; mine = (jx == x) ? c : mine; }
        if (sum == G) break;
        __builtin_amdgcn_s_sleep(1);
        if ((++sp & 255u) == 0u) { if (xb_ld(&bar[XB_TMO])) break; if (sp > XB_SPIN_CAP) { atomicAdd(&bar[XB_TMO], 1u); break; } }
    }
    nloc = mine > 0u ? mine : 1u; nx = cnt > 0u ? cnt : 1u;
}
__device__ __forceinline__ void xcd_barrier(const XcdBarrier& b) {
    asm volatile("s_waitcnt vmcnt(0)" ::: "memory");
    __syncthreads();
    if (threadIdx.x == 0) {
        unsigned* bar = b.bar;
        __builtin_amdgcn_s_waitcnt(0);
        unsigned nloc = b.st[0], nx = b.st[1];
        if (nloc == 0u) { xcd_barrier_complete(bar, b.x, nloc, nx); b.st[0] = nloc; b.st[1] = nx; }
        const unsigned old = xb_add(&bar[XB_XSUB(b.x)], 1u);
        const unsigned gen = old / nloc;
        if (old + 1u == (gen + 1u) * nloc) {
            __builtin_amdgcn_fence(__ATOMIC_RELEASE, "agent");
            asm volatile("s_waitcnt vmcnt(0)" ::: "memory");
            const unsigned og = xb_add(&bar[XB_TOP], 1u);
            const unsigned tg = og / nx;
            if (og + 1u == (tg + 1u) * nx) xb_add(&bar[XB_TOPGEN], 1u);
            else XB_SPIN(xb_ld(&bar[XB_TOPGEN]) == tg, bar);
            __builtin_amdgcn_fence(__ATOMIC_ACQUIRE, "agent");
            xb_add(&bar[XB_XGEN(b.x)], 1u);
            asm volatile("s_waitcnt vmcnt(0)" ::: "memory");
        } else {
            XB_SPIN(xb_ld(&bar[XB_XGEN(b.x)]) == gen, bar);
            __builtin_amdgcn_fence(__ATOMIC_ACQUIRE, "agent");
            asm volatile("s_waitcnt vmcnt(0)" ::: "memory");
        }
    }
    __syncthreads();
}

__global__ void __launch_bounds__(512) mega_fwd(Params p) {
    extern __shared__ __attribute__((aligned(16))) unsigned char smem[];
    cg::grid_group grid = cg::this_grid();
    unsigned char* ws = p.ws;
    h16* x16 = (h16*)(ws + OFF_X16);
    volatile LAS unsigned* xbst = (volatile LAS unsigned*)(smem + LDS_BYTES - 16);
    if (threadIdx.x == 0) { xbst[0] = 0u; xbst[1] = 0u; }
    __syncthreads();
    const XcdBarrier xbar = xcd_barrier_post((unsigned*)(ws + OFF_BAR), xbst);
    for (int ph = p.ph_lo; ph < p.ph_hi; ++ph) {
        const unsigned e = p.prog[ph];
        const int kind = e & 15, L = (e >> 4) & 3, sub = (e >> 6) & 1, j = L >> 1;
        const int nrep = 1 + (int)(e >> 7);
        for (int rep = 0; rep < nrep; ++rep) {
        if (rep) xcd_barrier(xbar);
        const bool isgemm = (kind == K_R1 || kind == K_R2 || kind == K_R4 || kind == K_F1 || kind == K_F3 || kind == K_D1 || kind == K_D3 || kind == K_D6);
        if (isgemm) {
            const int ngemm = (kind == K_R1) ? 2 : 1;
            for (int gi = 0; gi < ngemm; ++gi) {
            pg8::Gemm g; pg8::Epi E;
            g.M = MTOK; g.N = 1024; g.K = 1024; g.lda = 1024; g.amode = 0; g.pm0 = 0; g.A = x16; g.A2 = x16; g.Bt = x16;
            E.mode = E_RESID; E.pm0 = 0; E.j = j; E.pnoff = 0; E.fin = (L == 3 && kind == K_F3) ? 1 : 0; E.ws = ws; E.out = p.out; E.bias0 = p.in[5] + j * 1024; E.bias1 = p.in[8] + j * 1024; E.bias2 = p.in[11];
            if (kind == K_R1) {
                E.mode = E_RPROJ;
                if (gi == 0) { g.A = (const h16*)p.out; g.A2 = (const h16*)(ws + R_G16); g.Bt = w_rwkv_big(ws, j); g.N = 3072; g.amode = 2; }
                else { g.Bt = w_rwkv_l1(ws, j); g.N = 512; g.K = 2048; g.amode = 1; E.pnoff = 12; }
            } else if (kind == K_R2) {
                g.A = (const h16*)(ws + R_HACT); g.Bt = w_rwkv_l2(ws, j); g.N = (j == 0) ? 3072 : 4096; g.K = 384; g.lda = 384; E.mode = E_LORA2;
            } else if (kind == K_R4) {
                g.A = (const h16*)(ws + (j == 0 ? R_V16 : OFF_VF)); g.Bt = w_rwkv_o(ws, j);
            } else if (kind == K_F1) {
                g.Bt = w_ffn_up(ws, L); g.M = MTOK / 2; g.N = 5632; g.amode = 1; g.pm0 = sub * 128; E.mode = E_ST16;
            } else if (kind == K_F3) {
                g.A = (const h16*)(ws + F_ACT); g.Bt = w_ffn_dn(ws, L); g.M = MTOK / 2; g.K = 2816; g.lda = 2816; E.pm0 = sub * 128;
            } else if (kind == K_D1) {
                g.Bt = w_dsa_in(ws, j); g.N = 512; g.amode = 1; E.mode = E_ST32;
            } else if (kind == K_D3) {
                g.A = (const h16*)(ws + D_CQ); g.Bt = w_dsa_q(ws, j); g.N = 2560; g.K = 256; g.lda = 256; E.mode = E_QPROJ;
            } else {
                g.A = (const h16*)(ws + D_HIN); g.A2 = (const h16*)p.out + (size_t)MTOK * 1024; g.Bt = (const h16*)(ws + OFF_WOV) + (size_t)j * 2097152; g.K = 2048; g.lda = 2048; g.amode = 3;
            }
            pg8::StaticOrder S; S.init(g.M, g.N, (int)gridDim.x, (int)blockIdx.x);
#ifndef NO_GEMM
            pg8::gemm_phase((LAS unsigned char*)smem, g, S, E);
#endif
            }
        } else if (kind == K_PREP) {
#ifndef NO_PREP
            prep_phase(p, smem);
#endif
        } else if (kind == K_R0) {
            mix_phase(p, j);
        } else if (kind == K_R3) {
#ifndef NO_SCAN
            scan_phase(p, j, smem);
#endif
        } else if (kind == K_LN) {
#ifndef NO_LN
            ln_phase(p, p.in[1] + (L * 2 + sub) * 1024, p.in[2] + (L * 2 + sub) * 1024, L == 3 && sub == 1);
#endif
        } else if (kind == K_F2) {
#ifndef NO_CONV
            conv_phase(p, L);
#endif
        } else if (kind == K_D2) {
#ifndef NO_NORM
            dsa_norm_phase(p, j, smem);
#endif
        } else if (kind == K_D4) {
#ifndef NO_INDEX
            dsa_index_phase(p, smem);
#endif
        } else if (kind == K_D5) {
#ifndef NO_ATTN
            dsa_attn_phase(p, j, smem);
#endif
        }
        }
        if (ph + 1 < p.ph_hi) { if (ph == p.ph_lo) grid.sync(); else xcd_barrier(xbar); for (int xs = 0; xs < EXTRA_SYNC; ++xs) xcd_barrier(xbar); }
    }
}

extern "C" void kernel_launch(void* const* d_in, const int* in_sizes, int n_in, void* d_out, int out_size, void* d_ws, size_t ws_size, hipStream_t stream) {
    static int grid_blocks = 0;
    if (grid_blocks == 0) {
        if (n_in != 37 || ws_size < WS_NEED || out_size != MTOK * DM) { fprintf(stderr, "kernel_launch: unexpected problem (n_in %d ws %zu out %d)\n", n_in, ws_size, out_size); grid_blocks = -1; return; }
        int dev = 0, cus = 0, per_cu = 0;
        hipGetDevice(&dev);
        hipDeviceGetAttribute(&cus, hipDeviceAttributeMultiprocessorCount, dev);
        if (hipFuncSetAttribute((const void*)mega_fwd, hipFuncAttributeMaxDynamicSharedMemorySize, LDS_BYTES) != hipSuccess) { fprintf(stderr, "kernel_launch: hipFuncSetAttribute failed\n"); grid_blocks = -1; return; }
        hipOccupancyMaxActiveBlocksPerMultiprocessor(&per_cu, (const void*)mega_fwd, 512, LDS_BYTES);
        if (per_cu < 1) { fprintf(stderr, "kernel_launch: occupancy query says %d blocks/CU\n", per_cu); per_cu = 1; }
        (void)hipGetLastError();
        grid_blocks = cus * per_cu;
        fprintf(stderr, "kernel_launch: grid %d (cus %d x %d)\n", grid_blocks, cus, per_cu);
    }
    if (grid_blocks < 0) return;
    Params p{};
    for (int i = 0; i < 37; ++i) p.in[i] = (const float*)d_in[i];
    p.ws = (unsigned char*)d_ws; p.out = (float*)d_out;
    int np = 0;
    constexpr unsigned PROBE_MASK = 0u;
    auto add = [&](int kind, int L, int sub) { p.prog[np++] = (unsigned char)(kind | (L << 4) | (sub << 6) | ((((PROBE_MASK >> kind) & 1u) && !(kind == K_LN && L == 3 && sub == 1)) ? 128 : 0)); };
    add(K_PREP, 0, 0);
    for (int L = 0; L < 4; ++L) {
        if ((L & 1) == 0) { add(K_R0, L, 0); add(K_R1, L, 0); add(K_R2, L, 0); add(K_R3, L, 0); add(K_R4, L, 0); }
        else { add(K_D1, L, 0); add(K_D2, L, 0); add(K_D3, L, 0); add(K_D4, L, 0); add(K_D5, L, 0); add(K_D6, L, 0); }
        add(K_LN, L, 0);
        for (int c = 0; c < 2; ++c) { add(K_F1, L, c); add(K_F2, L, c); add(K_F3, L, c); }
        add(K_LN, L, 1);
    }
#if SINGLE_LAUNCH
    if (hipMemsetAsync((unsigned char*)d_ws + OFF_BAR, 0, XCD_BAR_WORDS * 4, stream) != hipSuccess) { fprintf(stderr, "kernel_launch: memset failed\n"); return; }
    p.ph_lo = 0; p.ph_hi = np;
    void* args[] = {&p};
    hipError_t e = hipLaunchCooperativeKernel((const void*)mega_fwd, dim3(grid_blocks), dim3(512), args, LDS_BYTES, stream);
    if (e != hipSuccess) fprintf(stderr, "cooperative launch failed: %s (grid %d)\n", hipGetErrorString(e), grid_blocks);
#else
    for (int ph = 0; ph < np; ++ph) {
        p.ph_lo = ph; p.ph_hi = ph + 1;
        hipLaunchKernelGGL(mega_fwd, dim3(grid_blocks), dim3(512), LDS_BYTES, stream, p);
    }
#endif
}
```

```cpp
#include <hip/hip_runtime.h>
#include <hip/hip_cooperative_groups.h>
#include <cstdio>
namespace cg = cooperative_groups;

constexpr int EXTRA_SYNC = 0;
#ifndef SINGLE_LAUNCH
#define SINGLE_LAUNCH 1
#endif

#define LAS __attribute__((address_space(3)))
typedef _Float16 h16;
typedef _Float16 h16x8 __attribute__((ext_vector_type(8)));
typedef _Float16 h16x4 __attribute__((ext_vector_type(4)));
typedef _Float16 h16x2 __attribute__((ext_vector_type(2)));
typedef float f32x4 __attribute__((ext_vector_type(4)));
typedef float f32x2 __attribute__((ext_vector_type(2)));
typedef unsigned u32x4 __attribute__((ext_vector_type(4)));
typedef unsigned u32x2 __attribute__((ext_vector_type(2)));

constexpr int DM = 1024, SEQ = 2048, NBATCH = 32, MTOK = NBATCH * SEQ;
constexpr int DFF = 2816;
constexpr size_t MiB = (size_t)1 << 20;
constexpr float DN_ALPHA = 1.6817928305074290f;
constexpr int LDS_BYTES = 147456;

constexpr size_t OFF_W = 0;
constexpr size_t OFF_X16 = 118 * MiB;
constexpr size_t OFF_VF = 247 * MiB;
constexpr size_t OFF_R = 375 * MiB;
constexpr size_t WS_NEED = 960 * MiB;
constexpr size_t OFF_WOV = 952 * MiB;
constexpr size_t R_R16 = OFF_R, R_K16 = OFF_R + 128 * MiB, R_V16 = OFF_R + 256 * MiB, R_G16 = OFF_R + 384 * MiB, R_HACT = OFF_R + 512 * MiB;
constexpr size_t F_U16 = OFF_R, F_ACT = OFF_R + 352 * MiB;
constexpr size_t D_HIN = OFF_R, D_O16 = OFF_R, D_QABS = OFF_R + 128 * MiB, D_QIDX = OFF_R + 384 * MiB, D_CQ = OFF_R + 448 * MiB,
                 D_CKV = OFF_R + 480 * MiB, D_CKVT = OFF_R + 496 * MiB, D_KIDX = OFF_R + 512 * MiB, D_WIDX = OFF_R + 520 * MiB, D_MASK = OFF_R + 522 * MiB;

struct Params {
    const float* in[37];
    unsigned char* ws;
    float* out;
    int ph_lo, ph_hi;
    unsigned char prog[64];
};

enum { K_PREP = 0, K_R1, K_R2, K_R3, K_R4, K_LN, K_F1, K_F2, K_F3, K_D1, K_D2, K_D3, K_D4, K_D5, K_D6, K_R0 };
enum { E_RPROJ = 0, E_LORA2, E_RESID, E_ST16, E_ST32, E_QPROJ };

__device__ __forceinline__ size_t xrow(int row) { return (size_t)(row >> 11) * 2049 + 1 + (row & 2047); }
__device__ __forceinline__ unsigned pk2(float a, float b) { h16x2 h = {(h16)a, (h16)b}; return __builtin_bit_cast(unsigned, h); }
__device__ __forceinline__ u32x4 pack8(f32x4 a, f32x4 b) { u32x4 w; w.x = pk2(a[0], a[1]); w.y = pk2(a[2], a[3]); w.z = pk2(b[0], b[1]); w.w = pk2(b[2], b[3]); return w; }
__device__ __forceinline__ void unpack8(u32x4 w, float* f) {
    h16x8 h = __builtin_bit_cast(h16x8, w);
#pragma unroll
    for (int i = 0; i < 8; ++i) f[i] = (float)h[i];
}
__device__ __forceinline__ float sigmoidf_(float x) { return __builtin_amdgcn_rcpf(1.0f + __expf(-x)); }
#define WSYNC() asm volatile("s_waitcnt vmcnt(0) lgkmcnt(0)" ::: "memory")
__device__ __forceinline__ int opaque_tid() { int t = threadIdx.x; asm volatile("" : "+v"(t)); return t; }
__device__ __forceinline__ float dppf(float x, const int ctrl_sel) {
    const int v = __builtin_bit_cast(int, x);
    int r;
    if (ctrl_sel == 0) r = __builtin_amdgcn_update_dpp(0, v, 0xB1, 0xF, 0xF, true);
    else if (ctrl_sel == 1) r = __builtin_amdgcn_update_dpp(0, v, 0x4E, 0xF, 0xF, true);
    else if (ctrl_sel == 2) r = __builtin_amdgcn_update_dpp(0, v, 0x141, 0xF, 0xF, true);
    else r = __builtin_amdgcn_update_dpp(0, v, 0x140, 0xF, 0xF, true);
    return __builtin_bit_cast(float, r);
}
__device__ __forceinline__ float red4(float x) { x += dppf(x, 0); x += dppf(x, 1); return x; }
__device__ __forceinline__ float red16(float x) { x += dppf(x, 0); x += dppf(x, 1); x += dppf(x, 2); x += dppf(x, 3); return x; }
__device__ __forceinline__ float xmax_16_32(float x) {
    const unsigned u = __builtin_bit_cast(unsigned, x);
    auto r = __builtin_amdgcn_permlane16_swap(u, u, false, false);
    float m = fmaxf(__builtin_bit_cast(float, (unsigned)r[0]), __builtin_bit_cast(float, (unsigned)r[1]));
    const unsigned u2 = __builtin_bit_cast(unsigned, m);
    auto r2 = __builtin_amdgcn_permlane32_swap(u2, u2, false, false);
    return fmaxf(__builtin_bit_cast(float, (unsigned)r2[0]), __builtin_bit_cast(float, (unsigned)r2[1]));
}
__device__ __forceinline__ float xsum_16_32(float x) {
    const unsigned u = __builtin_bit_cast(unsigned, x);
    auto r = __builtin_amdgcn_permlane16_swap(u, u, false, false);
    float m = __builtin_bit_cast(float, (unsigned)r[0]) + __builtin_bit_cast(float, (unsigned)r[1]);
    const unsigned u2 = __builtin_bit_cast(unsigned, m);
    auto r2 = __builtin_amdgcn_permlane32_swap(u2, u2, false, false);
    return __builtin_bit_cast(float, (unsigned)r2[0]) + __builtin_bit_cast(float, (unsigned)r2[1]);
}
__device__ __forceinline__ float wave_sum(float v) { return xsum_16_32(red16(v)); }

namespace pg8 {
constexpr int BM = 256, BK = 64, HALF = 128, HTB = HALF * BK * 2, STAGE_BYTES = 8 * HTB, NXCD = 8, WGM = 8;
__device__ __forceinline__ int lds_byte(int r, int c) { const int st = (r >> 4) * 2 + (c >> 5), rr = r & 15, cc = c & 31, ob = rr * 64 + cc * 2; return st * 1024 + (ob ^ (((ob >> 9) & 1) << 5)); }
__device__ __forceinline__ void stage_rc(int b, int& R, int& C) { const int st = b / 1024, sb = b % 1024, swz = sb ^ (((sb >> 9) & 1) << 5); R = (st >> 1) * 16 + swz / 64; C = (st & 1) * 32 + (swz % 64) / 2; }
__device__ __forceinline__ int perm32(int rho) { const int n = rho >> 4, i = rho & 15; return 8 * (i >> 2) + 4 * n + (i & 3); }
struct Unit { int pm, pn; };
struct Gemm { const h16* A; const h16* A2; const h16* Bt; int M, N, K, lda, amode, pm0; };
struct StaticOrder {
    int nM, nN, nwg, G, c;
    __device__ void init(int M, int N, int G_, int c_) { nM = M / BM; nN = N / BM; nwg = nM * nN; G = G_; c = c_; }
    __device__ bool next(int i, Unit& u) const {
        const long L = (long)i * G + c; if (L >= nwg) return false;
        int wgid = (int)L; { const int q = nwg / NXCD, r = nwg % NXCD, xcd = wgid % NXCD, off = wgid / NXCD; wgid = (xcd < r ? xcd * (q + 1) : r * (q + 1) + (xcd - r) * q) + off; }
        const int nig = WGM * nN, gid = wgid / nig, fm = gid * WGM, gsz = (nM - fm) < WGM ? (nM - fm) : WGM;
        u.pm = fm + ((wgid % nig) % gsz); u.pn = (wgid % nig) / gsz; return true;
    }
};

struct Epi {
    int mode, pm0, j, pnoff, fin;
    unsigned char* ws; float* out; const float* bias0; const float* bias1; const float* bias2;
    __device__ __forceinline__ void operator()(const f32x4 (&acc)[2][2][4][2], const Unit& u, int wr, int wc, int fr, int fq) const {
        const int rowl0 = u.pm * BM + wr * 64 + fr;
        const int colt = u.pn * BM + wc * 32 + 8 * fq;
        if (mode == E_RESID) {
            u32x4 xr[2][4][2];
#pragma unroll
            for (int ai = 0; ai < 2; ++ai)
#pragma unroll
                for (int m = 0; m < 4; ++m) {
                    const int rowg = rowl0 + ai * HALF + m * 16 + pm0 * BM;
                    const h16* xp = (const h16*)(ws + OFF_X16) + xrow(rowg) * 1024 + colt;
#pragma unroll
                    for (int bj = 0; bj < 2; ++bj) xr[ai][m][bj] = *(const u32x4*)(xp + bj * HALF);
                }
#pragma unroll
            for (int ai = 0; ai < 2; ++ai)
#pragma unroll
                for (int m = 0; m < 4; ++m) {
                    const int rowg = rowl0 + ai * HALF + m * 16 + pm0 * BM;
                    float* dp0 = out + (size_t)rowg * 1024 + colt;
                    h16* hp0 = (h16*)out + (size_t)rowg * 1024 + colt;
#pragma unroll
                    for (int bj = 0; bj < 2; ++bj) {
                        float xf[8]; unpack8(xr[ai][m][bj], xf);
                        const f32x4 v0 = acc[ai][bj][m][0], v1 = acc[ai][bj][m][1];
                        f32x4 r0, r1;
#pragma unroll
                        for (int jj = 0; jj < 4; ++jj) { r0[jj] = DN_ALPHA * xf[jj] + v0[jj]; r1[jj] = DN_ALPHA * xf[4 + jj] + v1[jj]; }
                        if (fin) { float* dp = dp0 + bj * HALF; *(f32x4*)dp = r0; *(f32x4*)(dp + 4) = r1; }
                        else *(u32x4*)(hp0 + bj * HALF) = pack8(r0, r1);
                    }
                }
            return;
        }
        if (mode == E_LORA2 && (u.pn >> 2) == 3) {
            const int c0 = colt & 1023;
#pragma unroll
            for (int ai = 0; ai < 2; ++ai) {
                u32x4 lv[4][2], lf[4][2];
#pragma unroll
                for (int m = 0; m < 4; ++m) {
                    const size_t off = (size_t)(rowl0 + ai * HALF + m * 16 + pm0 * BM) * 1024 + c0;
#pragma unroll
                    for (int bj = 0; bj < 2; ++bj) { lv[m][bj] = *(const u32x4*)((const h16*)(ws + R_V16) + off + bj * HALF); lf[m][bj] = *(const u32x4*)((const h16*)(ws + OFF_VF) + off + bj * HALF); }
                }
#pragma unroll
                for (int m = 0; m < 4; ++m) {
                    const size_t off = (size_t)(rowl0 + ai * HALF + m * 16 + pm0 * BM) * 1024 + c0;
#pragma unroll
                    for (int bj = 0; bj < 2; ++bj) {
                        const int c = c0 + bj * HALF;
                        const f32x4 ba = *(const f32x4*)(bias2 + c), bb = *(const f32x4*)(bias2 + c + 4);
                        float vv[8], vf8[8]; unpack8(lv[m][bj], vv); unpack8(lf[m][bj], vf8);
                        f32x4 v0 = acc[ai][bj][m][0], v1 = acc[ai][bj][m][1];
#pragma unroll
                        for (int jj = 0; jj < 4; ++jj) {
                            v0[jj] = vv[jj] + (vf8[jj] - vv[jj]) * sigmoidf_(v0[jj] + ba[jj]);
                            v1[jj] = vv[4 + jj] + (vf8[4 + jj] - vv[4 + jj]) * sigmoidf_(v1[jj] + bb[jj]);
                        }
                        *(u32x4*)((h16*)(ws + R_V16) + off + bj * HALF) = pack8(v0, v1);
                    }
                }
            }
            return;
        }
#pragma unroll
        for (int ai = 0; ai < 2; ++ai)
#pragma unroll
            for (int m = 0; m < 4; ++m) {
                const int rowl = rowl0 + ai * HALF + m * 16;
                const int rowg = rowl + pm0 * BM;
#pragma unroll
                for (int bj = 0; bj < 2; ++bj) {
                    const int col = colt + bj * HALF;
                    f32x4 v0 = acc[ai][bj][m][0], v1 = acc[ai][bj][m][1];
                    if (mode == E_RPROJ) {
                        if (pnoff == 0) {
                            h16* dst = (h16*)(ws + (u.pn < 4 ? R_R16 : (u.pn < 8 ? R_K16 : (j == 0 ? OFF_VF : R_V16))));
                            *(u32x4*)(dst + (size_t)rowg * 1024 + (col & 1023)) = pack8(v0, v1);
                        } else if (col < 384) {
                            const int hc = col;
                            if (hc < 64) {
#pragma unroll
                                for (int jj = 0; jj < 4; ++jj) { v0[jj] = tanhf(v0[jj]); v1[jj] = tanhf(v1[jj]); }
                            } else if (hc >= 160) {
#pragma unroll
                                for (int jj = 0; jj < 4; ++jj) { v0[jj] = sigmoidf_(v0[jj]); v1[jj] = sigmoidf_(v1[jj]); }
                            }
                            *(u32x4*)((h16*)(ws + R_HACT) + (size_t)rowg * 384 + hc) = pack8(v0, v1);
                        }
                    } else if (mode == E_LORA2) {
                        const int grp = u.pn >> 2, c = col & 1023;
                        const size_t off = (size_t)rowg * 1024 + c;
                        if (grp == 0) {
                            const f32x4 ba = *(const f32x4*)(bias0 + c), bb = *(const f32x4*)(bias0 + c + 4);
#pragma unroll
                            for (int jj = 0; jj < 4; ++jj) { v0[jj] = sigmoidf_(v0[jj] + ba[jj]) * 0.6065306597f; v1[jj] = sigmoidf_(v1[jj] + bb[jj]) * 0.6065306597f; }
                            *(u32x4*)((h16*)out + off) = pack8(v0, v1);
                        } else if (grp == 1) {
                            const f32x4 ba = *(const f32x4*)(bias1 + c), bb = *(const f32x4*)(bias1 + c + 4);
#pragma unroll
                            for (int jj = 0; jj < 4; ++jj) { v0[jj] = sigmoidf_(v0[jj] + ba[jj]); v1[jj] = sigmoidf_(v1[jj] + bb[jj]); }
                            *(u32x4*)((h16*)out + (size_t)MTOK * 1024 + off) = pack8(v0, v1);
                        } else {
                            *(u32x4*)((h16*)(ws + R_G16) + off) = pack8(v0, v1);
                        }
                    } else if (mode == E_ST16) {
                        *(u32x4*)((h16*)(ws + F_U16) + (size_t)rowl * 5632 + col) = pack8(v0, v1);
                    } else if (mode == E_ST32) {
                        float* dp = (float*)(ws + D_HIN) + (size_t)rowg * 512 + col;
                        *(f32x4*)dp = v0; *(f32x4*)(dp + 4) = v1;
                    } else {
                        if (u.pn < 8) *(u32x4*)((h16*)(ws + D_QABS) + (size_t)rowg * 2048 + col) = pack8(v0, v1);
                        else *(u32x4*)((h16*)(ws + D_QIDX) + (size_t)rowg * 512 + (col - 2048)) = pack8(v0, v1);
                    }
                }
            }
    }
};

__device__ __forceinline__ const char* a_tile(const Gemm& g, int pm, int pn) {
    if (g.amode == 1) { const int row = (pm + g.pm0) * BM; return (const char*)g.A + xrow(row) * 2048; }
    if (g.amode == 2) {
        const int gq = pn >> 2;
        const char* base = gq == 2 ? (const char*)g.A2 : (const char*)g.A + (size_t)gq * ((size_t)MTOK * 1024 * 2);
        return base + (size_t)pm * BM * 2048;
    }
    if (g.amode == 3) return (pm < 128 ? (const char*)g.A + (size_t)pm * BM * 4096 : (const char*)g.A2 + (size_t)(pm - 128) * BM * 4096);
    return (const char*)g.A + (size_t)pm * BM * g.lda * 2;
}

__device__ __forceinline__ void gemm_phase(LAS unsigned char* lds, const Gemm g, const StaticOrder& S, const Epi& E) {
    const int tid = opaque_tid(), wid = __builtin_amdgcn_readfirstlane(tid >> 6), lane = tid & 63, wr = wid >> 2, wc = wid & 3, fr = lane & 15, fq = lane >> 4;
    const int K = g.K, nt = K / BK;
    const bool shiftA = (g.amode == 1);
    unsigned voffA[2], voffB[2];
#pragma unroll
    for (int i = 0; i < 2; ++i) { int R, C; stage_rc(tid * 16 + i * 8192, R, C); const int Rb = (R & ~31) + perm32(R & 31);
        voffA[i] = (unsigned)(R * g.lda + C) * 2u; voffB[i] = (unsigned)(Rb * K + C) * 2u; }
    const size_t kstep = (size_t)(BK * 2);
    const size_t hstepA = (size_t)HALF * g.lda * 2;
    const size_t hstepB = (size_t)HALF * K * 2;
    const size_t tstepB = 2 * hstepB;
    const unsigned ldsw = (unsigned)wid * 1024u;
    const int aoff = lds_byte(wr * 64 + fr, fq * 8), boff = lds_byte(wc * 32 + fr, fq * 8);
#define PG8_KOFF(kt) ((size_t)(kt) * kstep - ((shiftA && (kt) >= 16) ? (size_t)4096 : (size_t)0))
#define PG8_SA(b, h) (((b) * 2 + (h)) * HTB)
#define PG8_SB(b, h) ((4 + (b) * 2 + (h)) * HTB)
#define PG8_STAGE(bufoff, gbase, voff) do { _Pragma("unroll") for (int _i = 0; _i < 2; ++_i) \
        __builtin_amdgcn_global_load_lds((const unsigned*)((const char*)(gbase) + (voff)[_i]), (LAS unsigned*)(lds + (bufoff) + ldsw + _i * 8192), 16, 0, 0); } while (0)
#define PG8_LDA(dst, b, h) do { _Pragma("unroll") for (int m = 0; m < 4; ++m) _Pragma("unroll") for (int k = 0; k < 2; ++k) dst[m][k] = *(const LAS h16x8*)(lds + PG8_SA(b, h) + aoff + m * 2048 + k * 1024); } while (0)
#define PG8_LDB(dst, b, h) do { _Pragma("unroll") for (int n = 0; n < 2; ++n) _Pragma("unroll") for (int k = 0; k < 2; ++k) dst[n][k] = *(const LAS h16x8*)(lds + PG8_SB(b, h) + boff + n * 2048 + k * 1024); } while (0)
#define PG8_MMA(ai, bj, At, Bt) do { __builtin_amdgcn_s_setprio(1); _Pragma("unroll") for (int m = 0; m < 4; ++m) _Pragma("unroll") for (int n = 0; n < 2; ++n) _Pragma("unroll") for (int k = 0; k < 2; ++k) \
        acc[ai][bj][m][n] = __builtin_amdgcn_mfma_f32_16x16x32_f16(Bt[n][k], At[m][k], acc[ai][bj][m][n], 0, 0, 0); __builtin_amdgcn_s_setprio(0); } while (0)
#define PG8_WAIT_V(n) asm volatile("s_waitcnt vmcnt(" #n ")" ::: "memory")
#define PG8_WAIT_L(n) asm volatile("s_waitcnt lgkmcnt(" #n ")" ::: "memory")
#define PG8_BAR __builtin_amdgcn_s_barrier()
#define PG8_SCHED __builtin_amdgcn_sched_barrier(0)
    Unit cur, nxt; int ui = 0;
    if (!S.next(0, cur)) return;
    f32x4 acc[2][2][4][2];
#pragma unroll
    for (int a = 0; a < 2; ++a)
#pragma unroll
        for (int b = 0; b < 2; ++b)
#pragma unroll
            for (int m = 0; m < 4; ++m)
#pragma unroll
                for (int n = 0; n < 2; ++n) acc[a][b][m][n] = (f32x4){0.f, 0.f, 0.f, 0.f};
    h16x8 At[4][2], B0[2][2], B1[2][2];
    const char* cA = a_tile(g, cur.pm, cur.pn); const char* cB = (const char*)g.Bt + (size_t)cur.pn * tstepB;
    PG8_STAGE(PG8_SB(0, 0), cB, voffB); PG8_STAGE(PG8_SA(0, 0), cA, voffA); PG8_STAGE(PG8_SB(0, 1), cB + hstepB, voffB); PG8_STAGE(PG8_SA(0, 1), cA + hstepA, voffA);
    if (wr == 1) PG8_BAR;
    PG8_WAIT_V(4); PG8_BAR;
    PG8_STAGE(PG8_SB(1, 0), cB + kstep, voffB); PG8_STAGE(PG8_SA(1, 0), cA + kstep, voffA); PG8_STAGE(PG8_SB(1, 1), cB + hstepB + kstep, voffB);
    PG8_WAIT_V(6); PG8_BAR;
    for (;;) {
        const bool has_next = S.next(ui + 1, nxt);
        const char* nA = has_next ? a_tile(g, nxt.pm, nxt.pn) : cA; const char* nB = has_next ? (const char*)g.Bt + (size_t)nxt.pn * tstepB : cB;
        for (int t = 0; t < nt; t += 2) {
            const bool last = (t == nt - 2);
            const char* a1 = cA + PG8_KOFF(t + 1);
            const char* a2 = last ? nA : cA + PG8_KOFF(t + 2); const char* b2 = last ? nB : cB + (size_t)(t + 2) * kstep;
            const char* a3 = a2 + kstep; const char* b3 = b2 + kstep;
            PG8_LDB(B0, 0, 0); PG8_SCHED; PG8_LDA(At, 0, 0); PG8_STAGE(PG8_SA(1, 1), a1 + hstepA, voffA);
            PG8_WAIT_L(8); PG8_BAR; PG8_WAIT_L(0); PG8_MMA(0, 0, At, B0); PG8_BAR; PG8_SCHED;
            PG8_LDB(B1, 0, 1); PG8_STAGE(PG8_SB(0, 0), b2, voffB);
            PG8_BAR; PG8_WAIT_L(0); PG8_MMA(0, 1, At, B1); PG8_BAR;
            PG8_LDA(At, 0, 1); PG8_STAGE(PG8_SA(0, 0), a2, voffA);
            PG8_BAR; PG8_WAIT_L(0); PG8_MMA(1, 0, At, B0); PG8_BAR; PG8_SCHED;
            PG8_STAGE(PG8_SB(0, 1), b2 + hstepB, voffB);
            PG8_WAIT_V(6); PG8_BAR; PG8_MMA(1, 1, At, B1); PG8_BAR;
            PG8_LDB(B0, 1, 0); PG8_SCHED; PG8_LDA(At, 1, 0); PG8_STAGE(PG8_SA(0, 1), a2 + hstepA, voffA);
            PG8_WAIT_L(8); PG8_BAR; PG8_WAIT_L(0); PG8_MMA(0, 0, At, B0); PG8_BAR; PG8_SCHED;
            PG8_LDB(B1, 1, 1); PG8_STAGE(PG8_SB(1, 0), b3, voffB);
            PG8_BAR; PG8_WAIT_L(0); PG8_MMA(0, 1, At, B1); PG8_BAR;
            PG8_LDA(At, 1, 1); PG8_STAGE(PG8_SA(1, 0), a3, voffA);
            PG8_BAR; PG8_WAIT_L(0); PG8_MMA(1, 0, At, B0); PG8_BAR; PG8_SCHED;
            PG8_STAGE(PG8_SB(1, 1), b3 + hstepB, voffB);
            PG8_WAIT_V(6); PG8_BAR; PG8_MMA(1, 1, At, B1); PG8_BAR;
        }
        E(acc, cur, wr, wc, fr, fq);
        if (!has_next) break;
#pragma unroll
        for (int a = 0; a < 2; ++a)
#pragma unroll
            for (int b = 0; b < 2; ++b)
#pragma unroll
                for (int m = 0; m < 4; ++m)
#pragma unroll
                    for (int n = 0; n < 2; ++n) acc[a][b][m][n] = (f32x4){0.f, 0.f, 0.f, 0.f};
        cur = nxt; cA = nA; cB = nB; ++ui;
    }
    PG8_WAIT_V(0);
    if (wr == 0) PG8_BAR;
    PG8_BAR;
#undef PG8_KOFF
#undef PG8_SA
#undef PG8_SB
#undef PG8_STAGE
#undef PG8_LDA
#undef PG8_LDB
#undef PG8_MMA
#undef PG8_WAIT_V
#undef PG8_WAIT_L
#undef PG8_BAR
#undef PG8_SCHED
}
}

struct TJob { int mode; const float* src; int ld, K, N; h16* dst; int ldd, koff; const float* mix; };

__device__ __forceinline__ TJob get_job(const Params& p, int id) {
    TJob J; J.mode = 0; J.src = nullptr; J.ld = 0; J.K = 0; J.N = 0; J.dst = nullptr; J.ldd = 64; J.koff = 0; J.mix = nullptr;
    h16* W = (h16*)(p.ws + OFF_W);
    if (id < 24) {
        const int j = id / 12, s = id % 12;
        h16* Wrkv = W + (size_t)j * (10 * MiB); h16* Wl1 = Wrkv + 3 * MiB; h16* Wl2 = Wrkv + 7 * MiB;
        const float* mix = p.in[3] + j * 6 * 1024;
        if (s < 3) { J.mode = 0; J.src = p.in[4] + (size_t)(j * 3 + s) * 1048576; J.ld = 1024; J.K = 1024; J.N = 1024; J.dst = Wrkv + (size_t)s * 1024 * 1024; J.ldd = 1024; }
        else if (s < 8) {
            J.mode = 1; J.ld = 1024; J.K = 1024; J.ldd = 2048;
            if (s == 3) { J.src = p.in[6] + (size_t)j * 65536; J.ld = 64; J.N = 64; J.dst = Wl1; J.mix = mix + 3 * 1024; }
            else if (s == 4) { J.src = p.in[9] + (size_t)j * 65536; J.ld = 64; J.N = 64; J.dst = Wl1 + (size_t)64 * 2048; J.mix = mix + 4 * 1024; }
            else if (s == 5) { J.N = 32; J.dst = Wl1 + (size_t)128 * 2048; if (j == 1) { J.src = p.in[12]; J.ld = 32; J.mix = mix + 2 * 1024; } else { J.mode = 2; } }
            else if (s == 6) { J.src = p.in[14] + (size_t)j * 163840; J.ld = 160; J.N = 160; J.dst = Wl1 + (size_t)160 * 2048; J.mix = mix + 5 * 1024; }
            else { J.mode = 2; J.N = 192; J.dst = Wl1 + (size_t)320 * 2048; }
        } else {
            J.mode = 0; J.ld = 1024; J.N = 1024; J.ldd = 384;
            if (s == 8) { J.src = p.in[7] + (size_t)j * 65536; J.K = 64; J.koff = 0; J.dst = Wl2; }
            else if (s == 9) { J.src = p.in[10] + (size_t)j * 65536; J.K = 64; J.koff = 64; J.dst = Wl2 + (size_t)1024 * 384; }
            else if (s == 10) { J.src = p.in[15] + (size_t)j * 163840; J.K = 160; J.koff = 160; J.dst = Wl2 + (size_t)2048 * 384; }
            else { J.src = p.in[13]; J.K = 32; J.koff = 128; J.dst = Wl2 + (size_t)3072 * 384; if (j == 0) J.N = 0; }
        }
    } else if (id < 26) {
        const int j = id - 24;
        J.src = p.in[21] + (size_t)j * 1048576; J.ld = 1024; J.K = 1024; J.N = 1024; J.dst = W + (size_t)j * (10 * MiB) + 9 * MiB; J.ldd = 1024;
    } else if (id < 34) {
        const int i = (id - 26) >> 1, s = (id - 26) & 1;
        h16* base = W + 20 * MiB + (size_t)i * (17 * MiB / 2);
        if (s == 0) { J.src = p.in[33] + (size_t)i * 1024 * 5632; J.ld = 5632; J.K = 1024; J.N = 5632; J.dst = base; J.ldd = 1024; }
        else { J.src = p.in[36] + (size_t)i * 2816 * 1024; J.ld = 1024; J.K = 2816; J.N = 1024; J.dst = base + (size_t)11 * MiB / 2; J.ldd = 2816; }
    } else {
        const int j = (id - 34) >> 2, s = (id - 34) & 3;
        h16* base = W + 54 * MiB + (size_t)j * (5 * MiB / 2);
        if (s == 0) { J.src = p.in[22] + (size_t)j * 1024 * 456; J.ld = 456; J.K = 1024; J.N = 456; J.dst = base; J.ldd = 1024; }
        else if (s == 1) { J.mode = 2; J.N = 56; J.dst = base + (size_t)456 * 1024; J.ldd = 1024; }
        else if (s == 2) { J.src = p.in[28] + (size_t)j * 256 * 512; J.ld = 512; J.K = 256; J.N = 512; J.dst = base + MiB / 2 + (size_t)2048 * 256; J.ldd = 256; }
        else { J.src = p.in[31] + (size_t)j * 1048576; J.ld = 1024; J.K = 1024; J.N = 1024; J.dst = base + 3 * MiB / 2; J.ldd = 1024; }
    }
    return J;
}
__device__ __forceinline__ h16* w_rwkv_big(unsigned char* ws, int j) { return (h16*)(ws + OFF_W) + (size_t)j * (10 * MiB); }
__device__ __forceinline__ h16* w_rwkv_l1(unsigned char* ws, int j) { return w_rwkv_big(ws, j) + 3 * MiB; }
__device__ __forceinline__ h16* w_rwkv_l2(unsigned char* ws, int j) { return w_rwkv_big(ws, j) + 7 * MiB; }
__device__ __forceinline__ h16* w_rwkv_o(unsigned char* ws, int j) { return w_rwkv_big(ws, j) + 9 * MiB; }
__device__ __forceinline__ h16* w_ffn_up(unsigned char* ws, int i) { return (h16*)(ws + OFF_W) + 20 * MiB + (size_t)i * (17 * MiB / 2); }
__device__ __forceinline__ h16* w_ffn_dn(unsigned char* ws, int i) { return w_ffn_up(ws, i) + (size_t)11 * MiB / 2; }
__device__ __forceinline__ h16* w_dsa_in(unsigned char* ws, int j) { return (h16*)(ws + OFF_W) + 54 * MiB + (size_t)j * (5 * MiB / 2); }
__device__ __forceinline__ h16* w_dsa_q(unsigned char* ws, int j) { return w_dsa_in(ws, j) + MiB / 2; }
__device__ __forceinline__ h16* w_dsa_uvt(unsigned char* ws, int j) { return w_dsa_in(ws, j) + 5 * MiB / 4; }
__device__ __forceinline__ h16* w_dsa_o(unsigned char* ws, int j) { return w_dsa_in(ws, j) + 3 * MiB / 2; }

__device__ __forceinline__ void prep_phase(const Params& p, unsigned char* smem) {
    const int tid = opaque_tid();
    const size_t gtid = (size_t)blockIdx.x * 512 + tid, nth = (size_t)gridDim.x * 512;
    h16* x16 = (h16*)(p.ws + OFF_X16);
    for (size_t idx = gtid; idx < (size_t)MTOK * 128; idx += nth) {
        const int row = (int)(idx >> 7), c8 = (int)(idx & 127) * 8;
        const float* sp = p.in[0] + (size_t)row * 1024 + c8;
        const f32x4 a = *(const f32x4*)sp, b = *(const f32x4*)(sp + 4);
        *(u32x4*)(x16 + xrow(row) * 1024 + c8) = pack8(a, b);
    }
    for (size_t idx = gtid; idx < (size_t)NBATCH * 128; idx += nth) {
        const int b = (int)(idx >> 7), c8 = (int)(idx & 127) * 8;
        unsigned z = 0u; asm volatile("" : "+v"(z));
        *(u32x4*)(x16 + (size_t)b * 2049 * 1024 + c8) = (u32x4){z, z, z, z};
    }
    for (size_t it = gtid; it < (size_t)2 * 16 * 2048; it += nth) {
        const int j = (int)(it >> 15), rem = (int)(it & 32767), qg = rem >> 11, n = rem & 2047, h = n >> 7, c = n & 127;
        const float* uq = p.in[25] + (size_t)j * 256 * 1024 + (size_t)(qg * 16) * 1024 + h * 64;
        const float* uk = p.in[26] + (size_t)j * 16 * 64 * 128 + (size_t)h * 64 * 128 + c;
        float acc[16];
#pragma unroll
        for (int i = 0; i < 16; ++i) acc[i] = 0.f;
        for (int d = 0; d < 64; ++d) {
            const float kv = uk[d * 128];
#pragma unroll
            for (int i = 0; i < 16; ++i) acc[i] += uq[i * 1024 + d] * kv;
        }
        const float sc = 0.18033688011112042f;
        h16* dst = w_dsa_q(p.ws, j) + (size_t)n * 256 + qg * 16;
        *(u32x4*)dst = pack8((f32x4){acc[0] * sc, acc[1] * sc, acc[2] * sc, acc[3] * sc}, (f32x4){acc[4] * sc, acc[5] * sc, acc[6] * sc, acc[7] * sc});
        *(u32x4*)(dst + 8) = pack8((f32x4){acc[8] * sc, acc[9] * sc, acc[10] * sc, acc[11] * sc}, (f32x4){acc[12] * sc, acc[13] * sc, acc[14] * sc, acc[15] * sc});
    }
    for (size_t it = gtid; it < (size_t)2 * 128 * 1024; it += nth) {
        const int j = (int)(it >> 17), rem = (int)(it & 131071), kg = rem >> 10, n = rem & 1023, h = kg >> 3, c0 = (kg & 7) * 16;
        const float* uv = p.in[27] + (size_t)((j * 16 + h) * 128 + c0) * 64;
        const float* wo = p.in[31] + (size_t)j * 1048576 + (size_t)(h * 64) * 1024 + n;
        float acc[16];
#pragma unroll
        for (int i = 0; i < 16; ++i) acc[i] = 0.f;
        for (int v = 0; v < 64; ++v) {
            const float wv = wo[(size_t)v * 1024];
#pragma unroll
            for (int i = 0; i < 16; ++i) acc[i] += uv[i * 64 + v] * wv;
        }
        h16* dst = (h16*)(p.ws + OFF_WOV) + (size_t)j * 2097152 + (size_t)n * 2048 + h * 128 + c0;
        *(u32x4*)dst = pack8((f32x4){acc[0], acc[1], acc[2], acc[3]}, (f32x4){acc[4], acc[5], acc[6], acc[7]});
        *(u32x4*)(dst + 8) = pack8((f32x4){acc[8], acc[9], acc[10], acc[11]}, (f32x4){acc[12], acc[13], acc[14], acc[15]});
    }
    float* tile = (float*)smem;
    for (int id = 0; id < 42; ++id) {
        const TJob J = get_job(p, id);
        const int tk = J.ldd >> 6, tn = (J.N + 63) >> 6, ntile = tk * tn;
        for (int tix = blockIdx.x; tix < ntile; tix += gridDim.x) {
            const int k0 = (tix % tk) * 64, n0 = (tix / tk) * 64;
#pragma unroll
            for (int i = 0; i < 8; ++i) {
                const int k = i * 8 + (tid >> 6), n = tid & 63, kk = k0 + k, nn = n0 + n;
                float v = 0.f;
                if (nn < J.N && J.mode != 2) {
                    if (J.mode == 1) { const int ks = kk & 1023; const float mx = J.mix[ks]; v = J.src[(size_t)ks * J.ld + nn] * (kk < 1024 ? 1.0f - mx : mx); }
                    else if (kk >= J.koff && kk < J.koff + J.K) v = J.src[(size_t)(kk - J.koff) * J.ld + nn];
                }
                tile[k * 65 + n] = v;
            }
            __syncthreads();
#pragma unroll
            for (int i = 0; i < 8; ++i) {
                const int n = i * 8 + (tid >> 6), k = tid & 63, nn = n0 + n;
                if (nn < J.N) J.dst[(size_t)nn * J.ldd + k0 + k] = (h16)tile[k * 65 + n];
            }
            __syncthreads();
        }
    }
}

__device__ __forceinline__ void wave_sum4(float (&v)[4]) {
#pragma unroll
    for (int k = 0; k < 4; ++k) v[k] = wave_sum(v[k]);
}
__device__ __forceinline__ void ln_phase(const Params& p, const float* g, const float* b, bool final_out) {
    const int tid = opaque_tid();
    const int lane = tid & 63, wave = tid >> 6;
    float* tb = p.out;
    h16* x16 = (h16*)(p.ws + OFF_X16);
    f32x4 gg[4], bb[4];
#pragma unroll
    for (int i = 0; i < 4; ++i) { gg[i] = *(const f32x4*)(g + i * 256 + lane * 4); bb[i] = *(const f32x4*)(b + i * 256 + lane * 4); }
    for (int rowb = (blockIdx.x * 8 + wave) * 4; rowb < MTOK; rowb += gridDim.x * 32) {
        f32x4 v[4][4];
        float s[4];
#pragma unroll
        for (int k = 0; k < 4; ++k) {
            s[k] = 0.f;
            if (final_out) {
                const float* rp = tb + (size_t)(rowb + k) * 1024;
#pragma unroll
                for (int i = 0; i < 4; ++i) v[k][i] = *(const f32x4*)(rp + i * 256 + lane * 4);
            } else {
                const h16* hp = (const h16*)tb + (size_t)(rowb + k) * 1024;
#pragma unroll
                for (int i = 0; i < 4; ++i) { const h16x4 hv = *(const h16x4*)(hp + i * 256 + lane * 4); v[k][i] = (f32x4){(float)hv[0], (float)hv[1], (float)hv[2], (float)hv[3]}; }
            }
#pragma unroll
            for (int i = 0; i < 4; ++i) s[k] += (v[k][i][0] + v[k][i][1]) + (v[k][i][2] + v[k][i][3]);
        }
        wave_sum4(s);
        float q[4];
#pragma unroll
        for (int k = 0; k < 4; ++k) {
            s[k] *= (1.0f / 1024.0f); q[k] = 0.f;
#pragma unroll
            for (int i = 0; i < 4; ++i)
#pragma unroll
                for (int jj = 0; jj < 4; ++jj) { const float d = v[k][i][jj] - s[k]; q[k] += d * d; }
        }
        wave_sum4(q);
#pragma unroll
        for (int k = 0; k < 4; ++k) {
            const float rstd = rsqrtf(q[k] * (1.0f / 1024.0f) + 1e-5f);
            const int row = rowb + k;
#pragma unroll
            for (int i = 0; i < 4; ++i) {
                f32x4 y;
#pragma unroll
                for (int jj = 0; jj < 4; ++jj) y[jj] = (v[k][i][jj] - s[k]) * rstd * gg[i][jj] + bb[i][jj];
                if (final_out) *(f32x4*)(tb + (size_t)row * 1024 + i * 256 + lane * 4) = y;
                else { u32x2 w; w.x = pk2(y[0], y[1]); w.y = pk2(y[2], y[3]); *(u32x2*)(x16 + xrow(row) * 1024 + i * 256 + lane * 4) = w; }
            }
        }
    }
}

__device__ __forceinline__ void conv_phase(const Params& p, int layer) {
    const h16* u = (const h16*)(p.ws + F_U16);
    h16* act = (h16*)(p.ws + F_ACT);
    const float* cw = p.in[34] + (size_t)layer * 3 * 5632;
    const float* cb = p.in[35] + (size_t)layer * 5632;
    const size_t gtid = (size_t)blockIdx.x * 512 + opaque_tid(), nth = (size_t)gridDim.x * 512;
    const size_t ntask = (size_t)2048 * 352;
    for (size_t task = gtid; task < ntask; task += nth) {
        const int cgp = (int)(task % 352), rc = (int)(task / 352), f = cgp * 8, r0 = rc * 16;
        float wg[3][8], wv[3][8], bg[8], bv[8];
#pragma unroll
        for (int jj = 0; jj < 3; ++jj)
#pragma unroll
            for (int hlf = 0; hlf < 2; ++hlf) {
                const f32x4 a = *(const f32x4*)(cw + jj * 5632 + f + hlf * 4), c = *(const f32x4*)(cw + jj * 5632 + DFF + f + hlf * 4);
#pragma unroll
                for (int e = 0; e < 4; ++e) { wg[jj][hlf * 4 + e] = a[e]; wv[jj][hlf * 4 + e] = c[e]; }
            }
#pragma unroll
        for (int hlf = 0; hlf < 2; ++hlf) {
            const f32x4 a = *(const f32x4*)(cb + f + hlf * 4), c = *(const f32x4*)(cb + DFF + f + hlf * 4);
#pragma unroll
            for (int e = 0; e < 4; ++e) { bg[hlf * 4 + e] = a[e]; bv[hlf * 4 + e] = c[e]; }
        }
        float g2[8], g1[8], v2[8], v1[8];
#pragma unroll
        for (int e = 0; e < 8; ++e) { g2[e] = 0.f; g1[e] = 0.f; v2[e] = 0.f; v1[e] = 0.f; }
        if ((r0 & 2047) != 0) {
            unpack8(*(const u32x4*)(u + (size_t)(r0 - 2) * 5632 + f), g2); unpack8(*(const u32x4*)(u + (size_t)(r0 - 1) * 5632 + f), g1);
            unpack8(*(const u32x4*)(u + (size_t)(r0 - 2) * 5632 + DFF + f), v2); unpack8(*(const u32x4*)(u + (size_t)(r0 - 1) * 5632 + DFF + f), v1);
        }
#pragma unroll 1
        for (int i0 = 0; i0 < 16; i0 += 4) {
            u32x4 lg[4], lv[4];
#pragma unroll
            for (int i = 0; i < 4; ++i) { const size_t ro = (size_t)(r0 + i0 + i) * 5632; lg[i] = *(const u32x4*)(u + ro + f); lv[i] = *(const u32x4*)(u + ro + DFF + f); }
#pragma unroll
            for (int i = 0; i < 4; ++i) {
                float g0[8], v0[8], o[8];
                unpack8(lg[i], g0); unpack8(lv[i], v0);
#pragma unroll
                for (int e = 0; e < 8; ++e) {
                    const float G = wg[0][e] * g2[e] + wg[1][e] * g1[e] + wg[2][e] * g0[e] + bg[e];
                    const float V = wv[0][e] * v2[e] + wv[1][e] * v1[e] + wv[2][e] * v0[e] + bv[e];
                    o[e] = G * sigmoidf_(G) * V;
                    g2[e] = g1[e]; g1[e] = g0[e]; v2[e] = v1[e]; v1[e] = v0[e];
                }
                *(u32x4*)(act + (size_t)(r0 + i0 + i) * DFF + f) = pack8((f32x4){o[0], o[1], o[2], o[3]}, (f32x4){o[4], o[5], o[6], o[7]});
            }
        }
    }
}

__device__ __forceinline__ void mix_phase(const Params& p, int j) {
    const h16* x16 = (const h16*)(p.ws + OFF_X16);
    h16* xr = (h16*)p.out; h16* xk = (h16*)p.out + (size_t)MTOK * 1024; h16* xv = (h16*)(p.ws + R_G16);
    const float* mix = p.in[3] + j * 6 * 1024;
    const size_t gtid = (size_t)blockIdx.x * 512 + opaque_tid(), nth = (size_t)gridDim.x * 512;
    for (size_t idx = gtid; idx < (size_t)MTOK * 128; idx += nth) {
        const int row = (int)(idx >> 7), c8 = (int)(idx & 127) * 8;
        const h16* xp = x16 + xrow(row) * 1024 + c8;
        float xc[8], xq[8];
        unpack8(*(const u32x4*)xp, xc); unpack8(*(const u32x4*)(xp - 1024), xq);
#pragma unroll
        for (int e = 0; e < 8; ++e) xq[e] -= xc[e];
        const size_t o = (size_t)row * 1024 + c8;
#pragma unroll
        for (int bsel = 0; bsel < 3; ++bsel) {
            const f32x4 m0 = *(const f32x4*)(mix + bsel * 1024 + c8), m1 = *(const f32x4*)(mix + bsel * 1024 + c8 + 4);
            f32x4 a, b;
#pragma unroll
            for (int e = 0; e < 4; ++e) { a[e] = xc[e] + xq[e] * m0[e]; b[e] = xc[4 + e] + xq[4 + e] * m1[e]; }
            h16* dst = bsel == 0 ? xr : (bsel == 1 ? xk : xv);
            *(u32x4*)(dst + o) = pack8(a, b);
        }
    }
}

__device__ __forceinline__ void unpack4(u32x2 w, float* f) {
    h16x4 h = __builtin_bit_cast(h16x4, w);
#pragma unroll
    for (int i = 0; i < 4; ++i) f[i] = (float)h[i];
}
constexpr int SCAN_BUF = 8256;
__device__ __forceinline__ void scan_phase(const Params& p, int j, unsigned char* smem) {
    const int tid = opaque_tid();
    const int wave = tid >> 6, lane = tid & 63, slot = wave >> 2, w4 = wave & 3;
    float* LB = (float*)smem + slot * (2 * SCAN_BUF);
    const h16* r16 = (const h16*)(p.ws + R_R16);
    const h16* k16 = (const h16*)(p.ws + R_K16);
    const h16* v16 = (j == 0) ? (const h16*)(p.ws + OFF_VF) : (const h16*)(p.ws + R_V16);
    const h16* g16 = (const h16*)(p.ws + R_G16);
    const h16* e16 = (const h16*)p.out;
    const h16* a16 = (const h16*)p.out + (size_t)MTOK * 1024;
    h16* y16 = (h16*)(p.ws + (j == 0 ? R_V16 : OFF_VF));
    const int tp = w4 * 4 + (lane >> 4), k4 = (lane & 15) * 4;
    const int vrow = w4 * 16 + (lane >> 2), kq = lane & 3;
    for (int pair = blockIdx.x; pair < 256; pair += gridDim.x) {
        const int chain = pair * 2 + slot, b = chain >> 4, h = chain & 15;
        const int col = h * 64 + k4;
        const f32x4 c_kk = *(const f32x4*)(p.in[16] + j * 1024 + col), c_ka = *(const f32x4*)(p.in[17] + j * 1024 + col), c_rk = *(const f32x4*)(p.in[18] + j * 1024 + col);
        const f32x4 c_lg = *(const f32x4*)(p.in[19] + j * 1024 + col), c_lb = *(const f32x4*)(p.in[20] + j * 1024 + col);
        f32x2 S[8];
#pragma unroll
        for (int i = 0; i < 8; ++i) S[i] = (f32x2){0.f, 0.f};
        u32x2 pr[6];
        {
            const size_t go = ((size_t)(b * 2048 + tp)) * 1024 + col;
            pr[0] = *(const u32x2*)(r16 + go); pr[1] = *(const u32x2*)(k16 + go); pr[2] = *(const u32x2*)(v16 + go);
            pr[3] = *(const u32x2*)(e16 + go); pr[4] = *(const u32x2*)(a16 + go); pr[5] = *(const u32x2*)(g16 + go);
        }
        for (int ch = 0; ch < 128; ++ch) {
            float* BUF = LB + (ch & 1) * SCAN_BUF;
            float* OPS = BUF; float* VB = BUF + 5120; float* GB = BUF + 6144; float* YB = BUF + 7168; float* BON = BUF + 8192;
            {
                float rf[4], kf[4], vf[4], ef[4], af[4], gf[4];
                unpack4(pr[0], rf); unpack4(pr[1], kf); unpack4(pr[2], vf); unpack4(pr[3], ef); unpack4(pr[4], af); unpack4(pr[5], gf);
                float kk[4]; float ss = 0.f;
#pragma unroll
                for (int i = 0; i < 4; ++i) { kk[i] = kf[i] * c_kk[i]; ss += kk[i] * kk[i]; }
                ss = red16(ss);
                const float inv = 1.0f / fmaxf(sqrtf(ss), 1e-12f);
                f32x4 A4, B4, W4, K4, R4; float bs = 0.f;
#pragma unroll
                for (int i = 0; i < 4; ++i) {
                    const float kn = kk[i] * inv;
                    A4[i] = -kn; B4[i] = kn * af[i];
                    W4[i] = __expf(-ef[i]);
                    const float km = kf[i] * (1.0f + (af[i] - 1.0f) * c_ka[i]);
                    K4[i] = km; R4[i] = rf[i];
                    bs += rf[i] * km * c_rk[i];
                }
                bs = red16(bs);
                float* o = OPS + tp * 320 + k4;
                *(f32x4*)(o) = A4; *(f32x4*)(o + 64) = B4; *(f32x4*)(o + 128) = W4; *(f32x4*)(o + 192) = K4; *(f32x4*)(o + 256) = R4;
                *(f32x4*)(VB + tp * 64 + k4) = (f32x4){vf[0], vf[1], vf[2], vf[3]};
                *(f32x4*)(GB + tp * 64 + k4) = (f32x4){gf[0], gf[1], gf[2], gf[3]};
                if ((lane & 15) == 0) BON[tp] = bs;
            }
            if (ch + 1 < 128) {
                const size_t go = ((size_t)(b * 2048 + (ch + 1) * 16 + tp)) * 1024 + col;
                pr[0] = *(const u32x2*)(r16 + go); pr[1] = *(const u32x2*)(k16 + go); pr[2] = *(const u32x2*)(v16 + go);
                pr[3] = *(const u32x2*)(e16 + go); pr[4] = *(const u32x2*)(a16 + go); pr[5] = *(const u32x2*)(g16 + go);
            }
            __syncthreads();
#pragma unroll 2
            for (int t = 0; t < 16; ++t) {
                const float* op = OPS + t * 320 + kq * 16;
                f32x4 A4[4], B4[4], W4[4], K4[4], R4[4];
#pragma unroll
                for (int i = 0; i < 4; ++i) A4[i] = *(const f32x4*)(op + i * 4);
#pragma unroll
                for (int i = 0; i < 4; ++i) { W4[i] = *(const f32x4*)(op + 128 + i * 4); B4[i] = *(const f32x4*)(op + 64 + i * 4); K4[i] = *(const f32x4*)(op + 192 + i * 4); }
#pragma unroll
                for (int i = 0; i < 4; ++i) R4[i] = *(const f32x4*)(op + 256 + i * 4);
                const float vv = VB[t * 64 + vrow];
                f32x2 s0 = {0.f, 0.f}, s1 = {0.f, 0.f};
#pragma unroll
                for (int i = 0; i < 4; ++i) { s0 += S[2 * i] * (f32x2){A4[i][0], A4[i][1]}; s1 += S[2 * i + 1] * (f32x2){A4[i][2], A4[i][3]}; }
                const float sa = red4((s0[0] + s0[1]) + (s1[0] + s1[1]));
                const f32x2 sa2 = {sa, sa}, vv2 = {vv, vv};
#pragma unroll
                for (int i = 0; i < 4; ++i) {
                    S[2 * i] = S[2 * i] * (f32x2){W4[i][0], W4[i][1]} + sa2 * (f32x2){B4[i][0], B4[i][1]} + vv2 * (f32x2){K4[i][0], K4[i][1]};
                    S[2 * i + 1] = S[2 * i + 1] * (f32x2){W4[i][2], W4[i][3]} + sa2 * (f32x2){B4[i][2], B4[i][3]} + vv2 * (f32x2){K4[i][2], K4[i][3]};
                }
                f32x2 y0 = {0.f, 0.f}, y1 = {0.f, 0.f};
#pragma unroll
                for (int i = 0; i < 4; ++i) { y0 += S[2 * i] * (f32x2){R4[i][0], R4[i][1]}; y1 += S[2 * i + 1] * (f32x2){R4[i][2], R4[i][3]}; }
                const float y = red4((y0[0] + y0[1]) + (y1[0] + y1[1]));
                if (kq == 0) YB[t * 64 + vrow] = y;
            }
            __syncthreads();
            {
                const f32x4 y4 = *(const f32x4*)(YB + tp * 64 + k4), v4 = *(const f32x4*)(VB + tp * 64 + k4), g4 = *(const f32x4*)(GB + tp * 64 + k4);
                const float mu = red16((y4[0] + y4[1]) + (y4[2] + y4[3])) * (1.0f / 64.0f);
                float q = 0.f;
#pragma unroll
                for (int i = 0; i < 4; ++i) { const float d = y4[i] - mu; q += d * d; }
                const float rstd = rsqrtf(red16(q) * (1.0f / 64.0f) + 64e-5f);
                const float bon = BON[tp];
                float o[4];
#pragma unroll
                for (int i = 0; i < 4; ++i) o[i] = ((y4[i] - mu) * rstd * c_lg[i] + c_lb[i] + bon * v4[i]) * g4[i];
                u32x2 w; w.x = pk2(o[0], o[1]); w.y = pk2(o[2], o[3]);
                *(u32x2*)(y16 + ((size_t)(b * 2048 + ch * 16 + tp)) * 1024 + col) = w;
            }
        }
        __syncthreads();
    }
}

__device__ __forceinline__ void dsa_norm_phase(const Params& p, int j, unsigned char* smem) {
    const int tid = opaque_tid();
    const int lane = tid & 63, wave = tid >> 6;
    const float* hin = (const float*)(p.ws + D_HIN);
    h16* cq = (h16*)(p.ws + D_CQ); h16* ckv = (h16*)(p.ws + D_CKV); h16* ckvt = (h16*)(p.ws + D_CKVT); h16* kidx = (h16*)(p.ws + D_KIDX);
    float* widx = (float*)(p.ws + D_WIDX);
    const f32x4 gq = *(const f32x4*)(p.in[23] + j * 256 + lane * 4);
    const f32x2 gkv = *(const f32x2*)(p.in[24] + j * 128 + lane * 2);
    const float gi = p.in[29][j * 64 + lane], bi = p.in[30][j * 64 + lane];
    h16* wl = (h16*)(smem + wave * 2048);
    for (int grp = blockIdx.x * 8 + wave; grp < MTOK / 8; grp += gridDim.x * 8) {
        const int r0 = grp * 8;
        for (int i = 0; i < 8; ++i) {
            const int row = r0 + i;
            const float* hp = hin + (size_t)row * 512;
            const f32x4 vq = *(const f32x4*)(hp + lane * 4);
            const f32x2 vk = *(const f32x2*)(hp + 256 + lane * 2);
            const float vi = hp[384 + lane];
            float ssq = wave_sum(vq[0] * vq[0] + vq[1] * vq[1] + vq[2] * vq[2] + vq[3] * vq[3]);
            const float rq = rsqrtf(ssq * (1.0f / 256.0f) + 1e-6f);
            u32x2 w; w.x = pk2(vq[0] * rq * gq[0], vq[1] * rq * gq[1]); w.y = pk2(vq[2] * rq * gq[2], vq[3] * rq * gq[3]);
            *(u32x2*)(cq + (size_t)row * 256 + lane * 4) = w;
            float ssk = wave_sum(vk[0] * vk[0] + vk[1] * vk[1]);
            const float rk = rsqrtf(ssk * (1.0f / 128.0f) + 1e-6f);
            const unsigned wk = pk2(vk[0] * rk * gkv[0], vk[1] * rk * gkv[1]);
            *(unsigned*)(ckv + (size_t)row * 128 + lane * 2) = wk;
            const float mu = wave_sum(vi) * (1.0f / 64.0f);
            const float dv = vi - mu;
            const float var = wave_sum(dv * dv) * (1.0f / 64.0f);
            kidx[(size_t)row * 64 + lane] = (h16)(dv * rsqrtf(var + 1e-5f) * gi + bi);
            if (lane < 8) widx[(size_t)row * 8 + lane] = hp[448 + lane] * 0.044194173824159216f;
        }
    }
}

constexpr int ROWP = 2052;
__device__ __forceinline__ unsigned fkey(float x) {
    if (x == 0.0f) x = 0.0f;
    const unsigned u = __float_as_uint(x);
    return (u & 0x80000000u) ? ~u : (u | 0x80000000u);
}
__device__ __forceinline__ void dsa_index_phase(const Params& p, unsigned char* smem) {
    const int tid = opaque_tid(), wave = tid >> 6, lane = tid & 63, r = lane & 15, q = lane >> 4;
    float* SC = (float*)smem;
    const h16* qidx = (const h16*)(p.ws + D_QIDX);
    const h16* kidx = (const h16*)(p.ws + D_KIDX);
    const float* widx = (const float*)(p.ws + D_WIDX);
    unsigned short* selout = (unsigned short*)(p.ws + D_MASK);
    h16x8 qf[8][2]; float wq[8];
    if ((int)blockIdx.x < MTOK / 16) {
        const int row0 = (int)blockIdx.x * 16;
#pragma unroll
        for (int h = 0; h < 8; ++h) {
#pragma unroll
            for (int kk = 0; kk < 2; ++kk) qf[h][kk] = *(const h16x8*)(qidx + (size_t)(row0 + r) * 512 + h * 64 + kk * 32 + q * 8);
            wq[h] = widx[(size_t)(row0 + r) * 8 + h];
        }
    }
    for (int qi = blockIdx.x, it = 0; qi < MTOK / 16; qi += gridDim.x, ++it) {
        const int qt = (it & 1) ? ((qi & ~127) | (127 - (qi & 127))) : qi;
        const int row0 = qt * 16, b = row0 >> 11, t0 = row0 & 2047;
        const int nkt = (t0 >> 4) + 1;
        {
            h16x8 kn[4];
            if (wave < nkt) {
                const bool two = (wave + 8 < nkt);
                const int s0 = wave * 16, s1 = two ? s0 + 128 : s0;
                const h16* kp = kidx + (size_t)(b * 2048 + s0 + r) * 64 + q * 8;
                const h16* kp1 = kidx + (size_t)(b * 2048 + s1 + r) * 64 + q * 8;
                kn[0] = *(const h16x8*)kp; kn[1] = *(const h16x8*)(kp + 32); kn[2] = *(const h16x8*)kp1; kn[3] = *(const h16x8*)(kp1 + 32);
            }
            for (int kt = wave; kt < nkt; kt += 16) {
                const bool two = (kt + 8 < nkt);
                const int s0 = kt * 16, s1 = two ? s0 + 128 : s0;
                const h16x8 k0 = kn[0], k1 = kn[1], k2 = kn[2], k3 = kn[3];
                if (kt + 16 < nkt) {
                    const bool two2 = (kt + 24 < nkt);
                    const int n0 = (kt + 16) * 16, n1 = two2 ? n0 + 128 : n0;
                    const h16* kp = kidx + (size_t)(b * 2048 + n0 + r) * 64 + q * 8;
                    const h16* kp1 = kidx + (size_t)(b * 2048 + n1 + r) * 64 + q * 8;
                    kn[0] = *(const h16x8*)kp; kn[1] = *(const h16x8*)(kp + 32); kn[2] = *(const h16x8*)kp1; kn[3] = *(const h16x8*)(kp1 + 32);
                }
                f32x4 sc = {0.f, 0.f, 0.f, 0.f}, sd = {0.f, 0.f, 0.f, 0.f};
#pragma unroll
                for (int h = 0; h < 8; ++h) {
                    f32x4 acc = {0.f, 0.f, 0.f, 0.f}, acd = {0.f, 0.f, 0.f, 0.f};
                    acc = __builtin_amdgcn_mfma_f32_16x16x32_f16(k0, qf[h][0], acc, 0, 0, 0);
                    acd = __builtin_amdgcn_mfma_f32_16x16x32_f16(k2, qf[h][0], acd, 0, 0, 0);
                    acc = __builtin_amdgcn_mfma_f32_16x16x32_f16(k1, qf[h][1], acc, 0, 0, 0);
                    acd = __builtin_amdgcn_mfma_f32_16x16x32_f16(k3, qf[h][1], acd, 0, 0, 0);
#pragma unroll
                    for (int jj = 0; jj < 4; ++jj) { sc[jj] += fmaxf(acc[jj], 0.f) * wq[h]; sd[jj] += fmaxf(acd[jj], 0.f) * wq[h]; }
                }
                *(f32x4*)(SC + r * ROWP + s0 + q * 4) = sc;
                if (two) *(f32x4*)(SC + r * ROWP + s1 + q * 4) = sd;
            }
            const int qin = qi + (int)gridDim.x;
            if (qin < MTOK / 16) {
                const int qtn = ((it + 1) & 1) ? ((qin & ~127) | (127 - (qin & 127))) : qin;
                const int rown = qtn * 16;
#pragma unroll
                for (int h = 0; h < 8; ++h) {
#pragma unroll
                    for (int kk = 0; kk < 2; ++kk) qf[h][kk] = *(const h16x8*)(qidx + (size_t)(rown + r) * 512 + h * 64 + kk * 32 + q * 8);
                    wq[h] = widx[(size_t)(rown + r) * 8 + h];
                }
            }
        }
        __syncthreads();
        for (int qq = 0; qq < 2; ++qq) {
            const int ql = wave * 2 + qq, t = t0 + ql;
            const float* srow = SC + ql * ROWP;
            const int ni = (t >> 6) + 1;
            unsigned u[32];
#pragma unroll
            for (int i = 0; i < 32; ++i) {
                u[i] = 0u;
                if (i < ni) { const int s = i * 64 + lane; if (s <= t) u[i] = fkey(srow[s]); }
            }
            unsigned short* selrow = selout + (size_t)(row0 + ql) * 256;
            if (t < 256) {
#pragma unroll
                for (int i = 0; i < 4; ++i) { const int pp = i * 64 + lane; selrow[pp] = (unsigned short)(pp <= t ? pp : 0xFFFF); }
            } else {
                unsigned* H = (unsigned*)(smem + 16 * ROWP * 4) + wave * 256;
                unsigned prefix = 0u; int need = 256;
#pragma unroll 1
                for (int pass = 0; pass < 4; ++pass) {
                    const int shift = 24 - 8 * pass;
                    const unsigned hmask = pass == 0 ? 0u : (0xFFFFFFFFu << (shift + 8));
                    *(u32x4*)(H + lane * 4) = (u32x4){0u, 0u, 0u, 0u};
                    asm volatile("s_waitcnt lgkmcnt(0)" ::: "memory");
#pragma unroll
                    for (int i = 0; i < 32; ++i) if (i < ni) { const unsigned uu = u[i]; if (uu != 0u && (uu & hmask) == prefix) atomicAdd(H + ((uu >> shift) & 255u), 1u); }
                    asm volatile("s_waitcnt lgkmcnt(0)" ::: "memory");
                    const u32x4 hv = *(const u32x4*)(H + lane * 4);
                    const int tot = (int)(hv.x + hv.y + hv.z + hv.w);
                    int rs = tot;
                    rs += __builtin_amdgcn_update_dpp(0, rs, 0xB1, 0xF, 0xF, true);
                    rs += __builtin_amdgcn_update_dpp(0, rs, 0x4E, 0xF, 0xF, true);
                    rs += __builtin_amdgcn_update_dpp(0, rs, 0x141, 0xF, 0xF, true);
                    rs += __builtin_amdgcn_update_dpp(0, rs, 0x140, 0xF, 0xF, true);
                    int rowsel = 3, above = 0;
                    {
                        const int r3 = __builtin_amdgcn_readlane(rs, 48), r2 = __builtin_amdgcn_readlane(rs, 32), r1 = __builtin_amdgcn_readlane(rs, 16);
                        if (need > r3) { above = r3; rowsel = 2; if (need > above + r2) { above += r2; rowsel = 1; if (need > above + r1) { above += r1; rowsel = 0; } } }
                    }
                    int lsel = rowsel * 16;
                    for (int k = 15; k >= 0; --k) {
                        const int cl = __builtin_amdgcn_readlane(tot, rowsel * 16 + k);
                        if (need <= above + cl) { lsel = rowsel * 16 + k; break; }
                        above += cl;
                    }
                    const int b3 = __builtin_amdgcn_readlane((int)hv.w, lsel), b2 = __builtin_amdgcn_readlane((int)hv.z, lsel), b1 = __builtin_amdgcn_readlane((int)hv.y, lsel);
                    int bsel = 3;
                    if (need > above + b3) { above += b3; bsel = 2; if (need > above + b2) { above += b2; bsel = 1; if (need > above + b1) { above += b1; bsel = 0; } } }
                    prefix |= (unsigned)(lsel * 4 + bsel) << shift;
                    need -= above;
                }
                const unsigned T = prefix;
                int running = 0, outpos = 0;
                const unsigned long long lt = (lane == 0) ? 0ull : (~0ull >> (64 - lane));
#pragma unroll
                for (int i = 0; i < 32; ++i) {
                    if (i < ni) {
                        const unsigned long long eq = __ballot(u[i] == T);
                        const int rank = running + __popcll(eq & lt);
                        const bool sel = u[i] > T || (u[i] == T && rank < need);
                        const unsigned long long sm = __ballot(sel);
                        running += __popcll(eq);
                        if (sel) selrow[outpos + __popcll(sm & lt)] = (unsigned short)(i * 64 + lane);
                        outpos += __popcll(sm);
                    }
                }
            }
        }
        __syncthreads();
    }
}

typedef __fp16 fp16x4_t __attribute__((__vector_size__(4 * sizeof(__fp16))));
__device__ __forceinline__ unsigned off_b(unsigned row, unsigned ch) { return 256u * row + 16u * (ch ^ (((row & 3) << 2) | ((row >> 2) & 3))); }
constexpr int SA_TILE = 8192, SA_BL = 8 * 2 * SA_TILE;
static_assert(SA_BL + 16 * 132 * 4 <= LDS_BYTES, "sparse attention LDS");
__device__ __forceinline__ void dsa_attn_phase(const Params& p, int j, unsigned char* smem) {
    const int tid = opaque_tid(), wave = tid >> 6, lane = tid & 63, r = lane & 15, q = lane >> 4;
    float* BL = (float*)(smem + SA_BL);
    for (int idx = tid; idx < 16 * 129; idx += 512) {
        const int h = idx / 129, d = idx % 129;
        int bk = d;
        if (d >= 16) { bk = 16 + (int)(logf((float)d * (1.0f / 16.0f)) / 2.0794415416798357f * 16.0f); bk = bk > 31 ? 31 : bk; }
        BL[h * 132 + d] = p.in[32][bk * 16 + h] * 1.4426950408889634f;
    }
    __syncthreads();
    const h16* qabs = (const h16*)(p.ws + D_QABS);
    const h16* ckv = (const h16*)(p.ws + D_CKV);
    const unsigned short* sel = (const unsigned short*)(p.ws + D_MASK);
    h16* olatA = (h16*)(p.ws + D_HIN);
    h16* olatB = (h16*)p.out + (size_t)MTOK * 1024;
    unsigned char* tile0 = smem + wave * (2 * SA_TILE);
    const float NINF = -__builtin_inff();
    unsigned wofs[8], kofs[2][4], vofs[8][2];
#pragma unroll
    for (int i = 0; i < 8; ++i) wofs[i] = off_b(8 * q + i, r);
#pragma unroll
    for (int tt = 0; tt < 2; ++tt)
#pragma unroll
        for (int kk = 0; kk < 4; ++kk) kofs[tt][kk] = off_b(8 * (r >> 2) + 4 * tt + (r & 3), 4 * kk + q);
#pragma unroll
    for (int c = 0; c < 8; ++c)
#pragma unroll
        for (int t2 = 0; t2 < 2; ++t2) vofs[c][t2] = off_b(8 * q + 4 * t2 + (r >> 2), 2 * c + ((lane & 3) >> 1)) + 8 * (lane & 1);
    for (int row = blockIdx.x * 8 + wave; row < MTOK; row += gridDim.x * 8) {
        const int b = row >> 11, t = row & 2047;
        const int nvalid = t + 1 < 256 ? t + 1 : 256, ng = (nvalid + 31) >> 5;
        const h16* kg = ckv + (size_t)(b * 2048) * 128;
        const unsigned short* srow = sel + (size_t)row * 256;
        h16x8 qf[4];
#pragma unroll
        for (int kk = 0; kk < 4; ++kk) qf[kk] = *(const h16x8*)(qabs + (size_t)row * 2048 + r * 128 + kk * 32 + q * 8);
        f32x4 O[8];
#pragma unroll
        for (int dt = 0; dt < 8; ++dt) O[dt] = (f32x4){0.f, 0.f, 0.f, 0.f};
        float mrun = NINF, lrun = 0.f;
        u32x4 selA = *(const u32x4*)(srow + 8 * q), selB = selA;
        u32x4 grA[8], grB[8];
#define SA_GATHER(GR, SELV) do { _Pragma("unroll") for (int i = 0; i < 8; ++i) { \
            unsigned sidx = ((SELV)[i >> 1] >> ((i & 1) * 16)) & 0xFFFFu; sidx = sidx == 0xFFFFu ? 0u : sidx; \
            (GR)[i] = *(const u32x4*)(kg + (size_t)sidx * 128 + r * 8); } } while (0)
#define SA_GROUP(GR, SELV, G) do { \
            unsigned char* tile = tile0 + ((G) & 1) * SA_TILE; \
            const u32x4 selc = (SELV); \
            _Pragma("unroll") for (int i = 0; i < 8; ++i) *(u32x4*)(tile + wofs[i]) = (GR)[i]; \
            if ((G) + 2 < ng) { (SELV) = *(const u32x4*)(srow + ((G) + 2) * 32 + 8 * q); SA_GATHER(GR, SELV); } \
            asm volatile("s_waitcnt lgkmcnt(0)" ::: "memory"); \
            f32x4 sc[2]; \
            _Pragma("unroll") for (int tt = 0; tt < 2; ++tt) { \
                f32x4 acc = {0.f, 0.f, 0.f, 0.f}; \
                _Pragma("unroll") for (int kk = 0; kk < 4; ++kk) { \
                    const h16x8 kf = *(const h16x8*)(tile + kofs[tt][kk]); \
                    acc = __builtin_amdgcn_mfma_f32_16x16x32_f16(kf, qf[kk], acc, 0, 0, 0); } \
                sc[tt] = acc; } \
            float x[8]; float mx = NINF; \
            _Pragma("unroll") for (int i = 0; i < 8; ++i) { \
                const unsigned sidx = (selc[i >> 1] >> ((i & 1) * 16)) & 0xFFFFu; \
                int dist = t - (int)sidx; dist = dist < 0 ? 0 : (dist > 128 ? 128 : dist); \
                const float v = sc[i >> 2][i & 3] + BL[r * 132 + dist]; \
                const float xv = (sidx != 0xFFFFu) ? v : NINF; \
                x[i] = xv; mx = fmaxf(mx, xv); } \
            mx = xmax_16_32(mx); \
            const float mnew = fmaxf(mrun, mx); \
            const float mref = (mnew == NINF) ? 0.f : mnew; \
            const float alpha = __builtin_amdgcn_exp2f(mrun - mref); \
            mrun = mnew; \
            float ps = 0.f; h16x8 pf; \
            _Pragma("unroll") for (int i = 0; i < 8; ++i) { const float pv = __builtin_amdgcn_exp2f(x[i] - mref); ps += pv; pf[i] = (h16)pv; } \
            lrun = lrun * alpha + ps; \
            _Pragma("unroll") for (int dt = 0; dt < 8; ++dt) { \
                const fp16x4_t lo = __builtin_amdgcn_ds_read_tr16_b64_v4f16((LAS fp16x4_t*)(tile + vofs[dt][0])); \
                const fp16x4_t hi = __builtin_amdgcn_ds_read_tr16_b64_v4f16((LAS fp16x4_t*)(tile + vofs[dt][1])); \
                const h16x4 l4 = __builtin_bit_cast(h16x4, lo), h4 = __builtin_bit_cast(h16x4, hi); \
                const h16x8 vf = {l4[0], l4[1], l4[2], l4[3], h4[0], h4[1], h4[2], h4[3]}; \
                O[dt] *= alpha; \
                O[dt] = __builtin_amdgcn_mfma_f32_16x16x32_f16(vf, pf, O[dt], 0, 0, 0); } \
        } while (0)
        SA_GATHER(grA, selA);
        if (ng > 1) { selB = *(const u32x4*)(srow + 32 + 8 * q); SA_GATHER(grB, selB); }
        for (int g = 0; g < ng; g += 2) {
            SA_GROUP(grA, selA, g);
            if (g + 1 < ng) SA_GROUP(grB, selB, g + 1);
        }
#undef SA_GATHER
#undef SA_GROUP
        const float inv = 1.0f / xsum_16_32(lrun);
        h16* op = (row < MTOK / 2 ? olatA + (size_t)row * 2048 : olatB + (size_t)(row - MTOK / 2) * 2048) + r * 128 + q * 4;
#pragma unroll
        for (int dt = 0; dt < 8; ++dt) {
            u32x2 w; w.x = pk2(O[dt][0] * inv, O[dt][1] * inv); w.y = pk2(O[dt][2] * inv, O[dt][3] * inv);
            *(u32x2*)(op + dt * 16) = w;
        }
        asm volatile("s_waitcnt lgkmcnt(0)" ::: "memory");
    }
    __syncthreads();
}

constexpr size_t OFF_BAR = 951 * MiB;
#define XB_TMO      128
#define XB_XCNT(j)  (256  + 64 * (j))
#define XB_XSUB(j)  (1280 + 64 * (j))
#define XB_XGEN(j)  (2304 + 64 * (j))
#define XB_TOP      3328
#define XB_TOPGEN   3392
#define XCD_BAR_WORDS 3456
#define XB_SPIN_CAP (1u << 22)
__device__ __forceinline__ unsigned xb_ld(unsigned* p)              { return __hip_atomic_load(p, __ATOMIC_RELAXED, __HIP_MEMORY_SCOPE_AGENT); }
__device__ __forceinline__ unsigned xb_add(unsigned* p, unsigned v) { return __hip_atomic_fetch_add(p, v, __ATOMIC_RELAXED, __HIP_MEMORY_SCOPE_AGENT); }
__device__ __forceinline__ unsigned xb_xcc_id() { return (unsigned)__builtin_amdgcn_s_getreg((3 << 11) | 20) & 0xFu; }
#define XB_SPIN(cond, bar) do { unsigned _sp = 0; while (cond) { __builtin_amdgcn_s_sleep(1); \
    if ((++_sp & 255u) == 0u) { if (xb_ld(&(bar)[XB_TMO])) break; if (_sp > XB_SPIN_CAP) { atomicAdd(&(bar)[XB_TMO], 1u); break; } } } } while (0)
struct XcdBarrier { unsigned* bar; unsigned x; volatile LAS unsigned* st; };
__device__ __forceinline__ XcdBarrier xcd_barrier_post(unsigned* bar, volatile LAS unsigned* st) {
    XcdBarrier b; b.bar = bar; b.x = xb_xcc_id(); b.st = st;
    if (threadIdx.x == 0) (void)xb_add(&bar[XB_XCNT(b.x)], 1u);
    return b;
}
__device__ __forceinline__ void xcd_barrier_complete(unsigned* bar, unsigned x, unsigned& nloc, unsigned& nx) {
    const unsigned G = gridDim.x * gridDim.y * gridDim.z;
    unsigned sum, cnt, mine, sp = 0u;
    for (;;) {
        sum = 0u; cnt = 0u; mine = 0u;
#pragma unroll
        for (unsigned jx = 0; jx < 16; ++jx) { const unsigned c = xb_ld(&bar[XB_XCNT(jx)]); sum += c; cnt += (c > 0u) ? 1u : 0u; mine = (jx == x) ? c : mine; }
        if (sum == G) break;
        __builtin_amdgcn_s_sleep(1);
        if ((++sp & 255u) == 0u) { if (xb_ld(&bar[XB_TMO])) break; if (sp > XB_SPIN_CAP) { atomicAdd(&bar[XB_TMO], 1u); break; } }
    }
    nloc = mine > 0u ? mine : 1u; nx = cnt > 0u ? cnt : 1u;
}
__device__ __forceinline__ void xcd_barrier(const XcdBarrier& b) {
    asm volatile("s_waitcnt vmcnt(0)" ::: "memory");
    __syncthreads();
    if (threadIdx.x == 0) {
        unsigned* bar = b.bar;
        __builtin_amdgcn_s_waitcnt(0);
        unsigned nloc = b.st[0], nx = b.st[1];
        if (nloc == 0u) { xcd_barrier_complete(bar, b.x, nloc, nx); b.st[0] = nloc; b.st[1] = nx; }
        const unsigned old = xb_add(&bar[XB_XSUB(b.x)], 1u);
        const unsigned gen = old / nloc;
        if (old + 1u == (gen + 1u) * nloc) {
            __builtin_amdgcn_fence(__ATOMIC_RELEASE, "agent");
            asm volatile("s_waitcnt vmcnt(0)" ::: "memory");
            const unsigned og = xb_add(&bar[XB_TOP], 1u);
            const unsigned tg = og / nx;
            if (og + 1u == (tg + 1u) * nx) xb_add(&bar[XB_TOPGEN], 1u);
            else XB_SPIN(xb_ld(&bar[XB_TOPGEN]) == tg, bar);
            __builtin_amdgcn_fence(__ATOMIC_ACQUIRE, "agent");
            xb_add(&bar[XB_XGEN(b.x)], 1u);
            asm volatile("s_waitcnt vmcnt(0)" ::: "memory");
        } else {
            XB_SPIN(xb_ld(&bar[XB_XGEN(b.x)]) == gen, bar);
            __builtin_amdgcn_fence(__ATOMIC_ACQUIRE, "agent");
            asm volatile("s_waitcnt vmcnt(0)" ::: "memory");
        }
    }
    __syncthreads();
}

__global__ void __launch_bounds__(512) mega_fwd(Params p) {
    extern __shared__ __attribute__((aligned(16))) unsigned char smem[];
    cg::grid_group grid = cg::this_grid();
    unsigned char* ws = p.ws;
    h16* x16 = (h16*)(ws + OFF_X16);
    volatile LAS unsigned* xbst = (volatile LAS unsigned*)(smem + LDS_BYTES - 16);
    if (threadIdx.x == 0) { xbst[0] = 0u; xbst[1] = 0u; }
    __syncthreads();
    const XcdBarrier xbar = xcd_barrier_post((unsigned*)(ws + OFF_BAR), xbst);
    for (int ph = p.ph_lo; ph < p.ph_hi; ++ph) {
        const unsigned e = p.prog[ph];
        const int kind = e & 15, L = (e >> 4) & 3, sub = (e >> 6) & 1, j = L >> 1;
        const int nrep = 1 + (int)(e >> 7);
        for (int rep = 0; rep < nrep; ++rep) {
        if (rep) xcd_barrier(xbar);
        const bool isgemm = (kind == K_R1 || kind == K_R2 || kind == K_R4 || kind == K_F1 || kind == K_F3 || kind == K_D1 || kind == K_D3 || kind == K_D6);
        if (isgemm) {
            const int ngemm = (kind == K_R1) ? 2 : 1;
            for (int gi = 0; gi < ngemm; ++gi) {
            pg8::Gemm g; pg8::Epi E;
            g.M = MTOK; g.N = 1024; g.K = 1024; g.lda = 1024; g.amode = 0; g.pm0 = 0; g.A = x16; g.A2 = x16; g.Bt = x16;
            E.mode = E_RESID; E.pm0 = 0; E.j = j; E.pnoff = 0; E.fin = (L == 3 && kind == K_F3) ? 1 : 0; E.ws = ws; E.out = p.out; E.bias0 = p.in[5] + j * 1024; E.bias1 = p.in[8] + j * 1024; E.bias2 = p.in[11];
            if (kind == K_R1) {
                E.mode = E_RPROJ;
                if (gi == 0) { g.A = (const h16*)p.out; g.A2 = (const h16*)(ws + R_G16); g.Bt = w_rwkv_big(ws, j); g.N = 3072; g.amode = 2; }
                else { g.Bt = w_rwkv_l1(ws, j); g.N = 512; g.K = 2048; g.amode = 1; E.pnoff = 12; }
            } else if (kind == K_R2) {
                g.A = (const h16*)(ws + R_HACT); g.Bt = w_rwkv_l2(ws, j); g.N = (j == 0) ? 3072 : 4096; g.K = 384; g.lda = 384; E.mode = E_LORA2;
            } else if (kind == K_R4) {
                g.A = (const h16*)(ws + (j == 0 ? R_V16 : OFF_VF)); g.Bt = w_rwkv_o(ws, j);
            } else if (kind == K_F1) {
                g.Bt = w_ffn_up(ws, L); g.M = MTOK / 2; g.N = 5632; g.amode = 1; g.pm0 = sub * 128; E.mode = E_ST16;
            } else if (kind == K_F3) {
                g.A = (const h16*)(ws + F_ACT); g.Bt = w_ffn_dn(ws, L); g.M = MTOK / 2; g.K = 2816; g.lda = 2816; E.pm0 = sub * 128;
            } else if (kind == K_D1) {
                g.Bt = w_dsa_in(ws, j); g.N = 512; g.amode = 1; E.mode = E_ST32;
            } else if (kind == K_D3) {
                g.A = (const h16*)(ws + D_CQ); g.Bt = w_dsa_q(ws, j); g.N = 2560; g.K = 256; g.lda = 256; E.mode = E_QPROJ;
            } else {
                g.A = (const h16*)(ws + D_HIN); g.A2 = (const h16*)p.out + (size_t)MTOK * 1024; g.Bt = (const h16*)(ws + OFF_WOV) + (size_t)j * 2097152; g.K = 2048; g.lda = 2048; g.amode = 3;
            }
            pg8::StaticOrder S; S.init(g.M, g.N, (int)gridDim.x, (int)blockIdx.x);
#ifndef NO_GEMM
            pg8::gemm_phase((LAS unsigned char*)smem, g, S, E);
#endif
            }
        } else if (kind == K_PREP) {
#ifndef NO_PREP
            prep_phase(p, smem);
#endif
        } else if (kind == K_R0) {
            mix_phase(p, j);
        } else if (kind == K_R3) {
#ifndef NO_SCAN
            scan_phase(p, j, smem);
#endif
        } else if (kind == K_LN) {
#ifndef NO_LN
            ln_phase(p, p.in[1] + (L * 2 + sub) * 1024, p.in[2] + (L * 2 + sub) * 1024, L == 3 && sub == 1);
#endif
        } else if (kind == K_F2) {
#ifndef NO_CONV
            conv_phase(p, L);
#endif
        } else if (kind == K_D2) {
#ifndef NO_NORM
            dsa_norm_phase(p, j, smem);
#endif
        } else if (kind == K_D4) {
#ifndef NO_INDEX
            dsa_index_phase(p, smem);
#endif
        } else if (kind == K_D5) {
#ifndef NO_ATTN
            dsa_attn_phase(p, j, smem);
#endif
        }
        }
        if (ph + 1 < p.ph_hi) { if (ph == p.ph_lo) grid.sync(); else xcd_barrier(xbar); for (int xs = 0; xs < EXTRA_SYNC; ++xs) xcd_barrier(xbar); }
    }
}

extern "C" void kernel_launch(void* const* d_in, const int* in_sizes, int n_in, void* d_out, int out_size, void* d_ws, size_t ws_size, hipStream_t stream) {
    static int grid_blocks = 0;
    if (grid_blocks == 0) {
        if (n_in != 37 || ws_size < WS_NEED || out_size != MTOK * DM) { fprintf(stderr, "kernel_launch: unexpected problem (n_in %d ws %zu out %d)\n", n_in, ws_size, out_size); grid_blocks = -1; return; }
        int dev = 0, cus = 0, per_cu = 0;
        hipGetDevice(&dev);
        hipDeviceGetAttribute(&cus, hipDeviceAttributeMultiprocessorCount, dev);
        if (hipFuncSetAttribute((const void*)mega_fwd, hipFuncAttributeMaxDynamicSharedMemorySize, LDS_BYTES) != hipSuccess) { fprintf(stderr, "kernel_launch: hipFuncSetAttribute failed\n"); grid_blocks = -1; return; }
        hipOccupancyMaxActiveBlocksPerMultiprocessor(&per_cu, (const void*)mega_fwd, 512, LDS_BYTES);
        if (per_cu < 1) { fprintf(stderr, "kernel_launch: occupancy query says %d blocks/CU\n", per_cu); per_cu = 1; }
        (void)hipGetLastError();
        grid_blocks = cus * per_cu;
        fprintf(stderr, "kernel_launch: grid %d (cus %d x %d)\n", grid_blocks, cus, per_cu);
    }
    if (grid_blocks < 0) return;
    Params p{};
    for (int i = 0; i < 37; ++i) p.in[i] = (const float*)d_in[i];
    p.ws = (unsigned char*)d_ws; p.out = (float*)d_out;
    int np = 0;
    constexpr unsigned PROBE_MASK = 0u;
    auto add = [&](int kind, int L, int sub) { p.prog[np++] = (unsigned char)(kind | (L << 4) | (sub << 6) | ((((PROBE_MASK >> kind) & 1u) && !(kind == K_LN && L == 3 && sub == 1)) ? 128 : 0)); };
    add(K_PREP, 0, 0);
    for (int L = 0; L < 4; ++L) {
        if ((L & 1) == 0) { add(K_R0, L, 0); add(K_R1, L, 0); add(K_R2, L, 0); add(K_R3, L, 0); add(K_R4, L, 0); }
        else { add(K_D1, L, 0); add(K_D2, L, 0); add(K_D3, L, 0); add(K_D4, L, 0); add(K_D5, L, 0); add(K_D6, L, 0); }
        add(K_LN, L, 0);
        for (int c = 0; c < 2; ++c) { add(K_F1, L, c); add(K_F2, L, c); add(K_F3, L, c); }
        add(K_LN, L, 1);
    }
#if SINGLE_LAUNCH
    if (hipMemsetAsync((unsigned char*)d_ws + OFF_BAR, 0, XCD_BAR_WORDS * 4, stream) != hipSuccess) { fprintf(stderr, "kernel_launch: memset failed\n"); return; }
    p.ph_lo = 0; p.ph_hi = np;
    void* args[] = {&p};
    hipError_t e = hipLaunchCooperativeKernel((const void*)mega_fwd, dim3(grid_blocks), dim3(512), args, LDS_BYTES, stream);
    if (e != hipSuccess) fprintf(stderr, "cooperative launch failed: %s (grid %d)\n", hipGetErrorString(e), grid_blocks);
#else
    for (int ph = 0; ph < np; ++ph) {
        p.ph_lo = ph; p.ph_hi = ph + 1;
        hipLaunchKernelGGL(mega_fwd, dim3(grid_blocks), dim3(512), LDS_BYTES, stream, p);
    }
#endif
}
```

```cpp
#include <hip/hip_runtime.h>
#include <hip/hip_cooperative_groups.h>
#include <cstdio>
namespace cg = cooperative_groups;

constexpr int EXTRA_SYNC = 0;
#ifndef SINGLE_LAUNCH
#define SINGLE_LAUNCH 1
#endif

#define LAS __attribute__((address_space(3)))
typedef _Float16 h16;
typedef _Float16 h16x8 __attribute__((ext_vector_type(8)));
typedef _Float16 h16x4 __attribute__((ext_vector_type(4)));
typedef _Float16 h16x2 __attribute__((ext_vector_type(2)));
typedef float f32x4 __attribute__((ext_vector_type(4)));
typedef float f32x2 __attribute__((ext_vector_type(2)));
typedef unsigned u32x4 __attribute__((ext_vector_type(4)));
typedef unsigned u32x2 __attribute__((ext_vector_type(2)));

constexpr int DM = 1024, SEQ = 2048, NBATCH = 32, MTOK = NBATCH * SEQ;
constexpr int DFF = 2816;
constexpr size_t MiB = (size_t)1 << 20;
constexpr float DN_ALPHA = 1.6817928305074290f;
constexpr int LDS_BYTES = 147456;

constexpr size_t OFF_W = 0;
constexpr size_t OFF_X16 = 118 * MiB;
constexpr size_t OFF_VF = 247 * MiB;
constexpr size_t OFF_R = 375 * MiB;
constexpr size_t WS_NEED = 960 * MiB;
constexpr size_t OFF_WOV = 952 * MiB;
constexpr size_t R_R16 = OFF_R, R_K16 = OFF_R + 128 * MiB, R_V16 = OFF_R + 256 * MiB, R_G16 = OFF_R + 384 * MiB, R_HACT = OFF_R + 512 * MiB;
constexpr size_t F_U16 = OFF_R, F_ACT = OFF_R + 352 * MiB;
constexpr size_t D_HIN = OFF_R, D_O16 = OFF_R, D_QABS = OFF_R + 128 * MiB, D_QIDX = OFF_R + 384 * MiB, D_CQ = OFF_R + 448 * MiB,
                 D_CKV = OFF_R + 480 * MiB, D_CKVT = OFF_R + 496 * MiB, D_KIDX = OFF_R + 512 * MiB, D_WIDX = OFF_R + 520 * MiB, D_MASK = OFF_R + 522 * MiB;

struct Params {
    const float* in[37];
    unsigned char* ws;
    float* out;
    int ph_lo, ph_hi;
    unsigned char prog[64];
};

enum { K_PREP = 0, K_R1, K_R2, K_R3, K_R4, K_LN, K_F1, K_F2, K_F3, K_D1, K_D2, K_D3, K_D4, K_D5, K_D6, K_R0 };
enum { E_RPROJ = 0, E_LORA2, E_RESID, E_ST16, E_ST32, E_QPROJ };

__device__ __forceinline__ size_t xrow(int row) { return (size_t)(row >> 11) * 2049 + 1 + (row & 2047); }
__device__ __forceinline__ unsigned pk2(float a, float b) { h16x2 h = {(h16)a, (h16)b}; return __builtin_bit_cast(unsigned, h); }
__device__ __forceinline__ u32x4 pack8(f32x4 a, f32x4 b) { u32x4 w; w.x = pk2(a[0], a[1]); w.y = pk2(a[2], a[3]); w.z = pk2(b[0], b[1]); w.w = pk2(b[2], b[3]); return w; }
__device__ __forceinline__ void unpack8(u32x4 w, float* f) {
    h16x8 h = __builtin_bit_cast(h16x8, w);
#pragma unroll
    for (int i = 0; i < 8; ++i) f[i] = (float)h[i];
}
__device__ __forceinline__ float sigmoidf_(float x) { return __builtin_amdgcn_rcpf(1.0f + __expf(-x)); }
#define WSYNC() asm volatile("s_waitcnt vmcnt(0) lgkmcnt(0)" ::: "memory")
__device__ __forceinline__ int opaque_tid() { int t = threadIdx.x; asm volatile("" : "+v"(t)); return t; }
__device__ __forceinline__ float dppf(float x, const int ctrl_sel) {
    const int v = __builtin_bit_cast(int, x);
    int r;
    if (ctrl_sel == 0) r = __builtin_amdgcn_update_dpp(0, v, 0xB1, 0xF, 0xF, true);
    else if (ctrl_sel == 1) r = __builtin_amdgcn_update_dpp(0, v, 0x4E, 0xF, 0xF, true);
    else if (ctrl_sel == 2) r = __builtin_amdgcn_update_dpp(0, v, 0x141, 0xF, 0xF, true);
    else r = __builtin_amdgcn_update_dpp(0, v, 0x140, 0xF, 0xF, true);
    return __builtin_bit_cast(float, r);
}
__device__ __forceinline__ float red4(float x) { x += dppf(x, 0); x += dppf(x, 1); return x; }
__device__ __forceinline__ float red16(float x) { x += dppf(x, 0); x += dppf(x, 1); x += dppf(x, 2); x += dppf(x, 3); return x; }
__device__ __forceinline__ float xmax_16_32(float x) {
    const unsigned u = __builtin_bit_cast(unsigned, x);
    auto r = __builtin_amdgcn_permlane16_swap(u, u, false, false);
    float m = fmaxf(__builtin_bit_cast(float, (unsigned)r[0]), __builtin_bit_cast(float, (unsigned)r[1]));
    const unsigned u2 = __builtin_bit_cast(unsigned, m);
    auto r2 = __builtin_amdgcn_permlane32_swap(u2, u2, false, false);
    return fmaxf(__builtin_bit_cast(float, (unsigned)r2[0]), __builtin_bit_cast(float, (unsigned)r2[1]));
}
__device__ __forceinline__ float xsum_16_32(float x) {
    const unsigned u = __builtin_bit_cast(unsigned, x);
    auto r = __builtin_amdgcn_permlane16_swap(u, u, false, false);
    float m = __builtin_bit_cast(float, (unsigned)r[0]) + __builtin_bit_cast(float, (unsigned)r[1]);
    const unsigned u2 = __builtin_bit_cast(unsigned, m);
    auto r2 = __builtin_amdgcn_permlane32_swap(u2, u2, false, false);
    return __builtin_bit_cast(float, (unsigned)r2[0]) + __builtin_bit_cast(float, (unsigned)r2[1]);
}
__device__ __forceinline__ float wave_sum(float v) { return xsum_16_32(red16(v)); }

namespace pg8 {
constexpr int BM = 256, BK = 64, HALF = 128, HTB = HALF * BK * 2, STAGE_BYTES = 8 * HTB, NXCD = 8, WGM = 8;
__device__ __forceinline__ int lds_byte(int r, int c) { const int st = (r >> 4) * 2 + (c >> 5), rr = r & 15, cc = c & 31, ob = rr * 64 + cc * 2; return st * 1024 + (ob ^ (((ob >> 9) & 1) << 5)); }
__device__ __forceinline__ void stage_rc(int b, int& R, int& C) { const int st = b / 1024, sb = b % 1024, swz = sb ^ (((sb >> 9) & 1) << 5); R = (st >> 1) * 16 + swz / 64; C = (st & 1) * 32 + (swz % 64) / 2; }
__device__ __forceinline__ int perm32(int rho) { const int n = rho >> 4, i = rho & 15; return 8 * (i >> 2) + 4 * n + (i & 3); }
struct Unit { int pm, pn; };
struct Gemm { const h16* A; const h16* A2; const h16* Bt; int M, N, K, lda, amode, pm0; };
struct StaticOrder {
    int nM, nN, nwg, G, c;
    __device__ void init(int M, int N, int G_, int c_) { nM = M / BM; nN = N / BM; nwg = nM * nN; G = G_; c = c_; }
    __device__ bool next(int i, Unit& u) const {
        const long L = (long)i * G + c; if (L >= nwg) return false;
        int wgid = (int)L; { const int q = nwg / NXCD, r = nwg % NXCD, xcd = wgid % NXCD, off = wgid / NXCD; wgid = (xcd < r ? xcd * (q + 1) : r * (q + 1) + (xcd - r) * q) + off; }
        const int nig = WGM * nN, gid = wgid / nig, fm = gid * WGM, gsz = (nM - fm) < WGM ? (nM - fm) : WGM;
        u.pm = fm + ((wgid % nig) % gsz); u.pn = (wgid % nig) / gsz; return true;
    }
};

struct Epi {
    int mode, pm0, j, pnoff, fin;
    unsigned char* ws; float* out; const float* bias0; const float* bias1; const float* bias2;
    __device__ __forceinline__ void operator()(const f32x4 (&acc)[2][2][4][2], const Unit& u, int wr, int wc, int fr, int fq) const {
        const int rowl0 = u.pm * BM + wr * 64 + fr;
        const int colt = u.pn * BM + wc * 32 + 8 * fq;
        if (mode == E_RESID) {
            u32x4 xr[2][4][2];
#pragma unroll
            for (int ai = 0; ai < 2; ++ai)
#pragma unroll
                for (int m = 0; m < 4; ++m) {
                    const int rowg = rowl0 + ai * HALF + m * 16 + pm0 * BM;
                    const h16* xp = (const h16*)(ws + OFF_X16) + xrow(rowg) * 1024 + colt;
#pragma unroll
                    for (int bj = 0; bj < 2; ++bj) xr[ai][m][bj] = *(const u32x4*)(xp + bj * HALF);
                }
#pragma unroll
            for (int ai = 0; ai < 2; ++ai)
#pragma unroll
                for (int m = 0; m < 4; ++m) {
                    const int rowg = rowl0 + ai * HALF + m * 16 + pm0 * BM;
                    float* dp0 = out + (size_t)rowg * 1024 + colt;
                    h16* hp0 = (h16*)out + (size_t)rowg * 1024 + colt;
#pragma unroll
                    for (int bj = 0; bj < 2; ++bj) {
                        float xf[8]; unpack8(xr[ai][m][bj], xf);
                        const f32x4 v0 = acc[ai][bj][m][0], v1 = acc[ai][bj][m][1];
                        f32x4 r0, r1;
#pragma unroll
                        for (int jj = 0; jj < 4; ++jj) { r0[jj] = DN_ALPHA * xf[jj] + v0[jj]; r1[jj] = DN_ALPHA * xf[4 + jj] + v1[jj]; }
                        if (fin) { float* dp = dp0 + bj * HALF; *(f32x4*)dp = r0; *(f32x4*)(dp + 4) = r1; }
                        else *(u32x4*)(hp0 + bj * HALF) = pack8(r0, r1);
                    }
                }
            return;
        }
        if (mode == E_LORA2 && (u.pn >> 2) == 3) {
            const int c0 = colt & 1023;
#pragma unroll
            for (int ai = 0; ai < 2; ++ai) {
                u32x4 lv[4][2], lf[4][2];
#pragma unroll
                for (int m = 0; m < 4; ++m) {
                    const size_t off = (size_t)(rowl0 + ai * HALF + m * 16 + pm0 * BM) * 1024 + c0;
#pragma unroll
                    for (int bj = 0; bj < 2; ++bj) { lv[m][bj] = *(const u32x4*)((const h16*)(ws + R_V16) + off + bj * HALF); lf[m][bj] = *(const u32x4*)((const h16*)(ws + OFF_VF) + off + bj * HALF); }
                }
#pragma unroll
                for (int m = 0; m < 4; ++m) {
                    const size_t off = (size_t)(rowl0 + ai * HALF + m * 16 + pm0 * BM) * 1024 + c0;
#pragma unroll
                    for (int bj = 0; bj < 2; ++bj) {
                        const int c = c0 + bj * HALF;
                        const f32x4 ba = *(const f32x4*)(bias2 + c), bb = *(const f32x4*)(bias2 + c + 4);
                        float vv[8], vf8[8]; unpack8(lv[m][bj], vv); unpack8(lf[m][bj], vf8);
                        f32x4 v0 = acc[ai][bj][m][0], v1 = acc[ai][bj][m][1];
#pragma unroll
                        for (int jj = 0; jj < 4; ++jj) {
                            v0[jj] = vv[jj] + (vf8[jj] - vv[jj]) * sigmoidf_(v0[jj] + ba[jj]);
                            v1[jj] = vv[4 + jj] + (vf8[4 + jj] - vv[4 + jj]) * sigmoidf_(v1[jj] + bb[jj]);
                        }
                        *(u32x4*)((h16*)(ws + R_V16) + off + bj * HALF) = pack8(v0, v1);
                    }
                }
            }
            return;
        }
#pragma unroll
        for (int ai = 0; ai < 2; ++ai)
#pragma unroll
            for (int m = 0; m < 4; ++m) {
                const int rowl = rowl0 + ai * HALF + m * 16;
                const int rowg = rowl + pm0 * BM;
#pragma unroll
                for (int bj = 0; bj < 2; ++bj) {
                    const int col = colt + bj * HALF;
                    f32x4 v0 = acc[ai][bj][m][0], v1 = acc[ai][bj][m][1];
                    if (mode == E_RPROJ) {
                        if (pnoff == 0) {
                            h16* dst = (h16*)(ws + (u.pn < 4 ? R_R16 : (u.pn < 8 ? R_K16 : (j == 0 ? OFF_VF : R_V16))));
                            *(u32x4*)(dst + (size_t)rowg * 1024 + (col & 1023)) = pack8(v0, v1);
                        } else if (col < 384) {
                            const int hc = col;
                            if (hc < 64) {
#pragma unroll
                                for (int jj = 0; jj < 4; ++jj) { v0[jj] = tanhf(v0[jj]); v1[jj] = tanhf(v1[jj]); }
                            } else if (hc >= 160) {
#pragma unroll
                                for (int jj = 0; jj < 4; ++jj) { v0[jj] = sigmoidf_(v0[jj]); v1[jj] = sigmoidf_(v1[jj]); }
                            }
                            *(u32x4*)((h16*)(ws + R_HACT) + (size_t)rowg * 384 + hc) = pack8(v0, v1);
                        }
                    } else if (mode == E_LORA2) {
                        const int grp = u.pn >> 2, c = col & 1023;
                        const size_t off = (size_t)rowg * 1024 + c;
                        if (grp == 0) {
                            const f32x4 ba = *(const f32x4*)(bias0 + c), bb = *(const f32x4*)(bias0 + c + 4);
#pragma unroll
                            for (int jj = 0; jj < 4; ++jj) { v0[jj] = sigmoidf_(v0[jj] + ba[jj]) * 0.6065306597f; v1[jj] = sigmoidf_(v1[jj] + bb[jj]) * 0.6065306597f; }
                            *(u32x4*)((h16*)out + off) = pack8(v0, v1);
                        } else if (grp == 1) {
                            const f32x4 ba = *(const f32x4*)(bias1 + c), bb = *(const f32x4*)(bias1 + c + 4);
#pragma unroll
                            for (int jj = 0; jj < 4; ++jj) { v0[jj] = sigmoidf_(v0[jj] + ba[jj]); v1[jj] = sigmoidf_(v1[jj] + bb[jj]); }
                            *(u32x4*)((h16*)out + (size_t)MTOK * 1024 + off) = pack8(v0, v1);
                        } else {
                            *(u32x4*)((h16*)(ws + R_G16) + off) = pack8(v0, v1);
                        }
                    } else if (mode == E_ST16) {
                        *(u32x4*)((h16*)(ws + F_U16) + (size_t)rowl * 5632 + col) = pack8(v0, v1);
                    } else if (mode == E_ST32) {
                        float* dp = (float*)(ws + D_HIN) + (size_t)rowg * 512 + col;
                        *(f32x4*)dp = v0; *(f32x4*)(dp + 4) = v1;
                    } else {
                        if (u.pn < 8) *(u32x4*)((h16*)(ws + D_QABS) + (size_t)rowg * 2048 + col) = pack8(v0, v1);
                        else *(u32x4*)((h16*)(ws + D_QIDX) + (size_t)rowg * 512 + (col - 2048)) = pack8(v0, v1);
                    }
                }
            }
    }
};

__device__ __forceinline__ const char* a_tile(const Gemm& g, int pm, int pn) {
    if (g.amode == 1) { const int row = (pm + g.pm0) * BM; return (const char*)g.A + xrow(row) * 2048; }
    if (g.amode == 2) {
        const int gq = pn >> 2;
        const char* base = gq == 2 ? (const char*)g.A2 : (const char*)g.A + (size_t)gq * ((size_t)MTOK * 1024 * 2);
        return base + (size_t)pm * BM * 2048;
    }
    if (g.amode == 3) return (pm < 128 ? (const char*)g.A + (size_t)pm * BM * 4096 : (const char*)g.A2 + (size_t)(pm - 128) * BM * 4096);
    return (const char*)g.A + (size_t)pm * BM * g.lda * 2;
}

__device__ __forceinline__ void gemm_phase(LAS unsigned char* lds, const Gemm g, const StaticOrder& S, const Epi& E) {
    const int tid = opaque_tid(), wid = __builtin_amdgcn_readfirstlane(tid >> 6), lane = tid & 63, wr = wid >> 2, wc = wid & 3, fr = lane & 15, fq = lane >> 4;
    const int K = g.K, nt = K / BK;
    const bool shiftA = (g.amode == 1);
    unsigned voffA[2], voffB[2];
#pragma unroll
    for (int i = 0; i < 2; ++i) { int R, C; stage_rc(tid * 16 + i * 8192, R, C); const int Rb = (R & ~31) + perm32(R & 31);
        voffA[i] = (unsigned)(R * g.lda + C) * 2u; voffB[i] = (unsigned)(Rb * K + C) * 2u; }
    const size_t kstep = (size_t)(BK * 2);
    const size_t hstepA = (size_t)HALF * g.lda * 2;
    const size_t hstepB = (size_t)HALF * K * 2;
    const size_t tstepB = 2 * hstepB;
    const unsigned ldsw = (unsigned)wid * 1024u;
    const int aoff = lds_byte(wr * 64 + fr, fq * 8), boff = lds_byte(wc * 32 + fr, fq * 8);
#define PG8_KOFF(kt) ((size_t)(kt) * kstep - ((shiftA && (kt) >= 16) ? (size_t)4096 : (size_t)0))
#define PG8_SA(b, h) (((b) * 2 + (h)) * HTB)
#define PG8_SB(b, h) ((4 + (b) * 2 + (h)) * HTB)
#define PG8_STAGE(bufoff, gbase, voff) do { _Pragma("unroll") for (int _i = 0; _i < 2; ++_i) \
        __builtin_amdgcn_global_load_lds((const unsigned*)((const char*)(gbase) + (voff)[_i]), (LAS unsigned*)(lds + (bufoff) + ldsw + _i * 8192), 16, 0, 0); } while (0)
#define PG8_LDA(dst, b, h) do { _Pragma("unroll") for (int m = 0; m < 4; ++m) _Pragma("unroll") for (int k = 0; k < 2; ++k) dst[m][k] = *(const LAS h16x8*)(lds + PG8_SA(b, h) + aoff + m * 2048 + k * 1024); } while (0)
#define PG8_LDB(dst, b, h) do { _Pragma("unroll") for (int n = 0; n < 2; ++n) _Pragma("unroll") for (int k = 0; k < 2; ++k) dst[n][k] = *(const LAS h16x8*)(lds + PG8_SB(b, h) + boff + n * 2048 + k * 1024); } while (0)
#define PG8_MMA(ai, bj, At, Bt) do { __builtin_amdgcn_s_setprio(1); _Pragma("unroll") for (int m = 0; m < 4; ++m) _Pragma("unroll") for (int n = 0; n < 2; ++n) _Pragma("unroll") for (int k = 0; k < 2; ++k) \
        acc[ai][bj][m][n] = __builtin_amdgcn_mfma_f32_16x16x32_f16(Bt[n][k], At[m][k], acc[ai][bj][m][n], 0, 0, 0); __builtin_amdgcn_s_setprio(0); } while (0)
#define PG8_WAIT_V(n) asm volatile("s_waitcnt vmcnt(" #n ")" ::: "memory")
#define PG8_WAIT_L(n) asm volatile("s_waitcnt lgkmcnt(" #n ")" ::: "memory")
#define PG8_BAR __builtin_amdgcn_s_barrier()
#define PG8_SCHED __builtin_amdgcn_sched_barrier(0)
    Unit cur, nxt; int ui = 0;
    if (!S.next(0, cur)) return;
    f32x4 acc[2][2][4][2];
#pragma unroll
    for (int a = 0; a < 2; ++a)
#pragma unroll
        for (int b = 0; b < 2; ++b)
#pragma unroll
            for (int m = 0; m < 4; ++m)
#pragma unroll
                for (int n = 0; n < 2; ++n) acc[a][b][m][n] = (f32x4){0.f, 0.f, 0.f, 0.f};
    h16x8 At[4][2], B0[2][2], B1[2][2];
    const char* cA = a_tile(g, cur.pm, cur.pn); const char* cB = (const char*)g.Bt + (size_t)cur.pn * tstepB;
    PG8_STAGE(PG8_SB(0, 0), cB, voffB); PG8_STAGE(PG8_SA(0, 0), cA, voffA); PG8_STAGE(PG8_SB(0, 1), cB + hstepB, voffB); PG8_STAGE(PG8_SA(0, 1), cA + hstepA, voffA);
    if (wr == 1) PG8_BAR;
    PG8_WAIT_V(4); PG8_BAR;
    PG8_STAGE(PG8_SB(1, 0), cB + kstep, voffB); PG8_STAGE(PG8_SA(1, 0), cA + kstep, voffA); PG8_STAGE(PG8_SB(1, 1), cB + hstepB + kstep, voffB);
    PG8_WAIT_V(6); PG8_BAR;
    for (;;) {
        const bool has_next = S.next(ui + 1, nxt);
        const char* nA = has_next ? a_tile(g, nxt.pm, nxt.pn) : cA; const char* nB = has_next ? (const char*)g.Bt + (size_t)nxt.pn * tstepB : cB;
        for (int t = 0; t < nt; t += 2) {
            const bool last = (t == nt - 2);
            const char* a1 = cA + PG8_KOFF(t + 1);
            const char* a2 = last ? nA : cA + PG8_KOFF(t + 2); const char* b2 = last ? nB : cB + (size_t)(t + 2) * kstep;
            const char* a3 = a2 + kstep; const char* b3 = b2 + kstep;
            PG8_LDB(B0, 0, 0); PG8_SCHED; PG8_LDA(At, 0, 0); PG8_STAGE(PG8_SA(1, 1), a1 + hstepA, voffA);
            PG8_WAIT_L(8); PG8_BAR; PG8_WAIT_L(0); PG8_MMA(0, 0, At, B0); PG8_BAR; PG8_SCHED;
            PG8_LDB(B1, 0, 1); PG8_STAGE(PG8_SB(0, 0), b2, voffB);
            PG8_BAR; PG8_WAIT_L(0); PG8_MMA(0, 1, At, B1); PG8_BAR;
            PG8_LDA(At, 0, 1); PG8_STAGE(PG8_SA(0, 0), a2, voffA);
            PG8_BAR; PG8_WAIT_L(0); PG8_MMA(1, 0, At, B0); PG8_BAR; PG8_SCHED;
            PG8_STAGE(PG8_SB(0, 1), b2 + hstepB, voffB);
            PG8_WAIT_V(6); PG8_BAR; PG8_MMA(1, 1, At, B1); PG8_BAR;
            PG8_LDB(B0, 1, 0); PG8_SCHED; PG8_LDA(At, 1, 0); PG8_STAGE(PG8_SA(0, 1), a2 + hstepA, voffA);
            PG8_WAIT_L(8); PG8_BAR; PG8_WAIT_L(0); PG8_MMA(0, 0, At, B0); PG8_BAR; PG8_SCHED;
            PG8_LDB(B1, 1, 1); PG8_STAGE(PG8_SB(1, 0), b3, voffB);
            PG8_BAR; PG8_WAIT_L(0); PG8_MMA(0, 1, At, B1); PG8_BAR;
            PG8_LDA(At, 1, 1); PG8_STAGE(PG8_SA(1, 0), a3, voffA);
            PG8_BAR; PG8_WAIT_L(0); PG8_MMA(1, 0, At, B0); PG8_BAR; PG8_SCHED;
            PG8_STAGE(PG8_SB(1, 1), b3 + hstepB, voffB);
            PG8_WAIT_V(6); PG8_BAR; PG8_MMA(1, 1, At, B1); PG8_BAR;
        }
        E(acc, cur, wr, wc, fr, fq);
        if (!has_next) break;
#pragma unroll
        for (int a = 0; a < 2; ++a)
#pragma unroll
            for (int b = 0; b < 2; ++b)
#pragma unroll
                for (int m = 0; m < 4; ++m)
#pragma unroll
                    for (int n = 0; n < 2; ++n) acc[a][b][m][n] = (f32x4){0.f, 0.f, 0.f, 0.f};
        cur = nxt; cA = nA; cB = nB; ++ui;
    }
    PG8_WAIT_V(0);
    if (wr == 0) PG8_BAR;
    PG8_BAR;
#undef PG8_KOFF
#undef PG8_SA
#undef PG8_SB
#undef PG8_STAGE
#undef PG8_LDA
#undef PG8_LDB
#undef PG8_MMA
#undef PG8_WAIT_V
#undef PG8_WAIT_L
#undef PG8_BAR
#undef PG8_SCHED
}
}

struct TJob { int mode; const float* src; int ld, K, N; h16* dst; int ldd, koff; const float* mix; };

__device__ __forceinline__ TJob get_job(const Params& p, int id) {
    TJob J; J.mode = 0; J.src = nullptr; J.ld = 0; J.K = 0; J.N = 0; J.dst = nullptr; J.ldd = 64; J.koff = 0; J.mix = nullptr;
    h16* W = (h16*)(p.ws + OFF_W);
    if (id < 24) {
        const int j = id / 12, s = id % 12;
        h16* Wrkv = W + (size_t)j * (10 * MiB); h16* Wl1 = Wrkv + 3 * MiB; h16* Wl2 = Wrkv + 7 * MiB;
        const float* mix = p.in[3] + j * 6 * 1024;
        if (s < 3) { J.mode = 0; J.src = p.in[4] + (size_t)(j * 3 + s) * 1048576; J.ld = 1024; J.K = 1024; J.N = 1024; J.dst = Wrkv + (size_t)s * 1024 * 1024; J.ldd = 1024; }
        else if (s < 8) {
            J.mode = 1; J.ld = 1024; J.K = 1024; J.ldd = 2048;
            if (s == 3) { J.src = p.in[6] + (size_t)j * 65536; J.ld = 64; J.N = 64; J.dst = Wl1; J.mix = mix + 3 * 1024; }
            else if (s == 4) { J.src = p.in[9] + (size_t)j * 65536; J.ld = 64; J.N = 64; J.dst = Wl1 + (size_t)64 * 2048; J.mix = mix + 4 * 1024; }
            else if (s == 5) { J.N = 32; J.dst = Wl1 + (size_t)128 * 2048; if (j == 1) { J.src = p.in[12]; J.ld = 32; J.mix = mix + 2 * 1024; } else { J.mode = 2; } }
            else if (s == 6) { J.src = p.in[14] + (size_t)j * 163840; J.ld = 160; J.N = 160; J.dst = Wl1 + (size_t)160 * 2048; J.mix = mix + 5 * 1024; }
            else { J.mode = 2; J.N = 192; J.dst = Wl1 + (size_t)320 * 2048; }
        } else {
            J.mode = 0; J.ld = 1024; J.N = 1024; J.ldd = 384;
            if (s == 8) { J.src = p.in[7] + (size_t)j * 65536; J.K = 64; J.koff = 0; J.dst = Wl2; }
            else if (s == 9) { J.src = p.in[10] + (size_t)j * 65536; J.K = 64; J.koff = 64; J.dst = Wl2 + (size_t)1024 * 384; }
            else if (s == 10) { J.src = p.in[15] + (size_t)j * 163840; J.K = 160; J.koff = 160; J.dst = Wl2 + (size_t)2048 * 384; }
            else { J.src = p.in[13]; J.K = 32; J.koff = 128; J.dst = Wl2 + (size_t)3072 * 384; if (j == 0) J.N = 0; }
        }
    } else if (id < 26) {
        const int j = id - 24;
        J.src = p.in[21] + (size_t)j * 1048576; J.ld = 1024; J.K = 1024; J.N = 1024; J.dst = W + (size_t)j * (10 * MiB) + 9 * MiB; J.ldd = 1024;
    } else if (id < 34) {
        const int i = (id - 26) >> 1, s = (id - 26) & 1;
        h16* base = W + 20 * MiB + (size_t)i * (17 * MiB / 2);
        if (s == 0) { J.src = p.in[33] + (size_t)i * 1024 * 5632; J.ld = 5632; J.K = 1024; J.N = 5632; J.dst = base; J.ldd = 1024; }
        else { J.src = p.in[36] + (size_t)i * 2816 * 1024; J.ld = 1024; J.K = 2816; J.N = 1024; J.dst = base + (size_t)11 * MiB / 2; J.ldd = 2816; }
    } else {
        const int j = (id - 34) >> 2, s = (id - 34) & 3;
        h16* base = W + 54 * MiB + (size_t)j * (5 * MiB / 2);
        if (s == 0) { J.src = p.in[22] + (size_t)j * 1024 * 456; J.ld = 456; J.K = 1024; J.N = 456; J.dst = base; J.ldd = 1024; }
        else if (s == 1) { J.mode = 2; J.N = 56; J.dst = base + (size_t)456 * 1024; J.ldd = 1024; }
        else if (s == 2) { J.src = p.in[28] + (size_t)j * 256 * 512; J.ld = 512; J.K = 256; J.N = 512; J.dst = base + MiB / 2 + (size_t)2048 * 256; J.ldd = 256; }
        else { J.src = p.in[31] + (size_t)j * 1048576; J.ld = 1024; J.K = 1024; J.N = 1024; J.dst = base + 3 * MiB / 2; J.ldd = 1024; }
    }
    return J;
}
__device__ __forceinline__ h16* w_rwkv_big(unsigned char* ws, int j) { return (h16*)(ws + OFF_W) + (size_t)j * (10 * MiB); }
__device__ __forceinline__ h16* w_rwkv_l1(unsigned char* ws, int j) { return w_rwkv_big(ws, j) + 3 * MiB; }
__device__ __forceinline__ h16* w_rwkv_l2(unsigned char* ws, int j) { return w_rwkv_big(ws, j) + 7 * MiB; }
__device__ __forceinline__ h16* w_rwkv_o(unsigned char* ws, int j) { return w_rwkv_big(ws, j) + 9 * MiB; }
__device__ __forceinline__ h16* w_ffn_up(unsigned char* ws, int i) { return (h16*)(ws + OFF_W) + 20 * MiB + (size_t)i * (17 * MiB / 2); }
__device__ __forceinline__ h16* w_ffn_dn(unsigned char* ws, int i) { return w_ffn_up(ws, i) + (size_t)11 * MiB / 2; }
__device__ __forceinline__ h16* w_dsa_in(unsigned char* ws, int j) { return (h16*)(ws + OFF_W) + 54 * MiB + (size_t)j * (5 * MiB / 2); }
__device__ __forceinline__ h16* w_dsa_q(unsigned char* ws, int j) { return w_dsa_in(ws, j) + MiB / 2; }
__device__ __forceinline__ h16* w_dsa_uvt(unsigned char* ws, int j) { return w_dsa_in(ws, j) + 5 * MiB / 4; }
__device__ __forceinline__ h16* w_dsa_o(unsigned char* ws, int j) { return w_dsa_in(ws, j) + 3 * MiB / 2; }

__device__ __forceinline__ void prep_phase(const Params& p, unsigned char* smem) {
    const int tid = opaque_tid();
    const size_t gtid = (size_t)blockIdx.x * 512 + tid, nth = (size_t)gridDim.x * 512;
    h16* x16 = (h16*)(p.ws + OFF_X16);
    for (size_t idx = gtid; idx < (size_t)MTOK * 128; idx += nth) {
        const int row = (int)(idx >> 7), c8 = (int)(idx & 127) * 8;
        const float* sp = p.in[0] + (size_t)row * 1024 + c8;
        const f32x4 a = *(const f32x4*)sp, b = *(const f32x4*)(sp + 4);
        *(u32x4*)(x16 + xrow(row) * 1024 + c8) = pack8(a, b);
    }
    for (size_t idx = gtid; idx < (size_t)NBATCH * 128; idx += nth) {
        const int b = (int)(idx >> 7), c8 = (int)(idx & 127) * 8;
        unsigned z = 0u; asm volatile("" : "+v"(z));
        *(u32x4*)(x16 + (size_t)b * 2049 * 1024 + c8) = (u32x4){z, z, z, z};
    }
    for (size_t it = gtid; it < (size_t)2 * 16 * 2048; it += nth) {
        const int j = (int)(it >> 15), rem = (int)(it & 32767), qg = rem >> 11, n = rem & 2047, h = n >> 7, c = n & 127;
        const float* uq = p.in[25] + (size_t)j * 256 * 1024 + (size_t)(qg * 16) * 1024 + h * 64;
        const float* uk = p.in[26] + (size_t)j * 16 * 64 * 128 + (size_t)h * 64 * 128 + c;
        float acc[16];
#pragma unroll
        for (int i = 0; i < 16; ++i) acc[i] = 0.f;
        for (int d = 0; d < 64; ++d) {
            const float kv = uk[d * 128];
#pragma unroll
            for (int i = 0; i < 16; ++i) acc[i] += uq[i * 1024 + d] * kv;
        }
        const float sc = 0.18033688011112042f;
        h16* dst = w_dsa_q(p.ws, j) + (size_t)n * 256 + qg * 16;
        *(u32x4*)dst = pack8((f32x4){acc[0] * sc, acc[1] * sc, acc[2] * sc, acc[3] * sc}, (f32x4){acc[4] * sc, acc[5] * sc, acc[6] * sc, acc[7] * sc});
        *(u32x4*)(dst + 8) = pack8((f32x4){acc[8] * sc, acc[9] * sc, acc[10] * sc, acc[11] * sc}, (f32x4){acc[12] * sc, acc[13] * sc, acc[14] * sc, acc[15] * sc});
    }
    for (size_t it = gtid; it < (size_t)2 * 128 * 1024; it += nth) {
        const int j = (int)(it >> 17), rem = (int)(it & 131071), kg = rem >> 10, n = rem & 1023, h = kg >> 3, c0 = (kg & 7) * 16;
        const float* uv = p.in[27] + (size_t)((j * 16 + h) * 128 + c0) * 64;
        const float* wo = p.in[31] + (size_t)j * 1048576 + (size_t)(h * 64) * 1024 + n;
        float acc[16];
#pragma unroll
        for (int i = 0; i < 16; ++i) acc[i] = 0.f;
        for (int v = 0; v < 64; ++v) {
            const float wv = wo[(size_t)v * 1024];
#pragma unroll
            for (int i = 0; i < 16; ++i) acc[i] += uv[i * 64 + v] * wv;
        }
        h16* dst = (h16*)(p.ws + OFF_WOV) + (size_t)j * 2097152 + (size_t)n * 2048 + h * 128 + c0;
        *(u32x4*)dst = pack8((f32x4){acc[0], acc[1], acc[2], acc[3]}, (f32x4){acc[4], acc[5], acc[6], acc[7]});
        *(u32x4*)(dst + 8) = pack8((f32x4){acc[8], acc[9], acc[10], acc[11]}, (f32x4){acc[12], acc[13], acc[14], acc[15]});
    }
    float* tile = (float*)smem;
    for (int id = 0; id < 42; ++id) {
        const TJob J = get_job(p, id);
        const int tk = J.ldd >> 6, tn = (J.N + 63) >> 6, ntile = tk * tn;
        for (int tix = (int)((blockIdx.x + gridDim.x - (unsigned)(id * 37) % gridDim.x) % gridDim.x); tix < ntile; tix += gridDim.x) {
            const int k0 = (tix % tk) * 64, n0 = (tix / tk) * 64;
#pragma unroll
            for (int i = 0; i < 8; ++i) {
                const int k = i * 8 + (tid >> 6), n = tid & 63, kk = k0 + k, nn = n0 + n;
                float v = 0.f;
                if (nn < J.N && J.mode != 2) {
                    if (J.mode == 1) { const int ks = kk & 1023; const float mx = J.mix[ks]; v = J.src[(size_t)ks * J.ld + nn] * (kk < 1024 ? 1.0f - mx : mx); }
                    else if (kk >= J.koff && kk < J.koff + J.K) v = J.src[(size_t)(kk - J.koff) * J.ld + nn];
                }
                tile[k * 65 + n] = v;
            }
            __syncthreads();
#pragma unroll
            for (int i = 0; i < 8; ++i) {
                const int n = i * 8 + (tid >> 6), k = tid & 63, nn = n0 + n;
                if (nn < J.N) J.dst[(size_t)nn * J.ldd + k0 + k] = (h16)tile[k * 65 + n];
            }
            __syncthreads();
        }
    }
}

__device__ __forceinline__ void wave_sum4(float (&v)[4]) {
#pragma unroll
    for (int k = 0; k < 4; ++k) v[k] = wave_sum(v[k]);
}
__device__ __forceinline__ void ln_phase(const Params& p, const float* g, const float* b, bool final_out) {
    const int tid = opaque_tid();
    const int lane = tid & 63, wave = tid >> 6;
    float* tb = p.out;
    h16* x16 = (h16*)(p.ws + OFF_X16);
    f32x4 gg[4], bb[4];
#pragma unroll
    for (int i = 0; i < 4; ++i) { gg[i] = *(const f32x4*)(g + i * 256 + lane * 4); bb[i] = *(const f32x4*)(b + i * 256 + lane * 4); }
    for (int rowb = (blockIdx.x * 8 + wave) * 4; rowb < MTOK; rowb += gridDim.x * 32) {
        f32x4 v[4][4];
        float s[4];
#pragma unroll
        for (int k = 0; k < 4; ++k) {
            s[k] = 0.f;
            if (final_out) {
                const float* rp = tb + (size_t)(rowb + k) * 1024;
#pragma unroll
                for (int i = 0; i < 4; ++i) v[k][i] = *(const f32x4*)(rp + i * 256 + lane * 4);
            } else {
                const h16* hp = (const h16*)tb + (size_t)(rowb + k) * 1024;
#pragma unroll
                for (int i = 0; i < 4; ++i) { const h16x4 hv = *(const h16x4*)(hp + i * 256 + lane * 4); v[k][i] = (f32x4){(float)hv[0], (float)hv[1], (float)hv[2], (float)hv[3]}; }
            }
#pragma unroll
            for (int i = 0; i < 4; ++i) s[k] += (v[k][i][0] + v[k][i][1]) + (v[k][i][2] + v[k][i][3]);
        }
        wave_sum4(s);
        float q[4];
#pragma unroll
        for (int k = 0; k < 4; ++k) {
            s[k] *= (1.0f / 1024.0f); q[k] = 0.f;
#pragma unroll
            for (int i = 0; i < 4; ++i)
#pragma unroll
                for (int jj = 0; jj < 4; ++jj) { const float d = v[k][i][jj] - s[k]; q[k] += d * d; }
        }
        wave_sum4(q);
#pragma unroll
        for (int k = 0; k < 4; ++k) {
            const float rstd = rsqrtf(q[k] * (1.0f / 1024.0f) + 1e-5f);
            const int row = rowb + k;
#pragma unroll
            for (int i = 0; i < 4; ++i) {
                f32x4 y;
#pragma unroll
                for (int jj = 0; jj < 4; ++jj) y[jj] = (v[k][i][jj] - s[k]) * rstd * gg[i][jj] + bb[i][jj];
                if (final_out) *(f32x4*)(tb + (size_t)row * 1024 + i * 256 + lane * 4) = y;
                else { u32x2 w; w.x = pk2(y[0], y[1]); w.y = pk2(y[2], y[3]); *(u32x2*)(x16 + xrow(row) * 1024 + i * 256 + lane * 4) = w; }
            }
        }
    }
}

__device__ __forceinline__ void conv_phase(const Params& p, int layer) {
    const h16* u = (const h16*)(p.ws + F_U16);
    h16* act = (h16*)(p.ws + F_ACT);
    const float* cw = p.in[34] + (size_t)layer * 3 * 5632;
    const float* cb = p.in[35] + (size_t)layer * 5632;
    const size_t gtid = (size_t)blockIdx.x * 512 + opaque_tid(), nth = (size_t)gridDim.x * 512;
    const size_t ntask = (size_t)2048 * 352;
    for (size_t task = gtid; task < ntask; task += nth) {
        const int cgp = (int)(task % 352), rc = (int)(task / 352), f = cgp * 8, r0 = rc * 16;
        float wg[3][8], wv[3][8], bg[8], bv[8];
#pragma unroll
        for (int jj = 0; jj < 3; ++jj)
#pragma unroll
            for (int hlf = 0; hlf < 2; ++hlf) {
                const f32x4 a = *(const f32x4*)(cw + jj * 5632 + f + hlf * 4), c = *(const f32x4*)(cw + jj * 5632 + DFF + f + hlf * 4);
#pragma unroll
                for (int e = 0; e < 4; ++e) { wg[jj][hlf * 4 + e] = a[e]; wv[jj][hlf * 4 + e] = c[e]; }
            }
#pragma unroll
        for (int hlf = 0; hlf < 2; ++hlf) {
            const f32x4 a = *(const f32x4*)(cb + f + hlf * 4), c = *(const f32x4*)(cb + DFF + f + hlf * 4);
#pragma unroll
            for (int e = 0; e < 4; ++e) { bg[hlf * 4 + e] = a[e]; bv[hlf * 4 + e] = c[e]; }
        }
        float g2[8], g1[8], v2[8], v1[8];
#pragma unroll
        for (int e = 0; e < 8; ++e) { g2[e] = 0.f; g1[e] = 0.f; v2[e] = 0.f; v1[e] = 0.f; }
        if ((r0 & 2047) != 0) {
            unpack8(*(const u32x4*)(u + (size_t)(r0 - 2) * 5632 + f), g2); unpack8(*(const u32x4*)(u + (size_t)(r0 - 1) * 5632 + f), g1);
            unpack8(*(const u32x4*)(u + (size_t)(r0 - 2) * 5632 + DFF + f), v2); unpack8(*(const u32x4*)(u + (size_t)(r0 - 1) * 5632 + DFF + f), v1);
        }
#pragma unroll 1
        for (int i0 = 0; i0 < 16; i0 += 4) {
            u32x4 lg[4], lv[4];
#pragma unroll
            for (int i = 0; i < 4; ++i) { const size_t ro = (size_t)(r0 + i0 + i) * 5632; lg[i] = *(const u32x4*)(u + ro + f); lv[i] = *(const u32x4*)(u + ro + DFF + f); }
#pragma unroll
            for (int i = 0; i < 4; ++i) {
                float g0[8], v0[8], o[8];
                unpack8(lg[i], g0); unpack8(lv[i], v0);
#pragma unroll
                for (int e = 0; e < 8; ++e) {
                    const float G = wg[0][e] * g2[e] + wg[1][e] * g1[e] + wg[2][e] * g0[e] + bg[e];
                    const float V = wv[0][e] * v2[e] + wv[1][e] * v1[e] + wv[2][e] * v0[e] + bv[e];
                    o[e] = G * sigmoidf_(G) * V;
                    g2[e] = g1[e]; g1[e] = g0[e]; v2[e] = v1[e]; v1[e] = v0[e];
                }
                *(u32x4*)(act + (size_t)(r0 + i0 + i) * DFF + f) = pack8((f32x4){o[0], o[1], o[2], o[3]}, (f32x4){o[4], o[5], o[6], o[7]});
            }
        }
    }
}

__device__ __forceinline__ void mix_phase(const Params& p, int j) {
    const h16* x16 = (const h16*)(p.ws + OFF_X16);
    h16* xr = (h16*)p.out; h16* xk = (h16*)p.out + (size_t)MTOK * 1024; h16* xv = (h16*)(p.ws + R_G16);
    const float* mix = p.in[3] + j * 6 * 1024;
    const size_t gtid = (size_t)blockIdx.x * 512 + opaque_tid(), nth = (size_t)gridDim.x * 512;
    for (size_t idx = gtid; idx < (size_t)MTOK * 128; idx += nth) {
        const int row = (int)(idx >> 7), c8 = (int)(idx & 127) * 8;
        const h16* xp = x16 + xrow(row) * 1024 + c8;
        float xc[8], xq[8];
        unpack8(*(const u32x4*)xp, xc); unpack8(*(const u32x4*)(xp - 1024), xq);
#pragma unroll
        for (int e = 0; e < 8; ++e) xq[e] -= xc[e];
        const size_t o = (size_t)row * 1024 + c8;
#pragma unroll
        for (int bsel = 0; bsel < 3; ++bsel) {
            const f32x4 m0 = *(const f32x4*)(mix + bsel * 1024 + c8), m1 = *(const f32x4*)(mix + bsel * 1024 + c8 + 4);
            f32x4 a, b;
#pragma unroll
            for (int e = 0; e < 4; ++e) { a[e] = xc[e] + xq[e] * m0[e]; b[e] = xc[4 + e] + xq[4 + e] * m1[e]; }
            h16* dst = bsel == 0 ? xr : (bsel == 1 ? xk : xv);
            *(u32x4*)(dst + o) = pack8(a, b);
        }
    }
}

__device__ __forceinline__ void unpack4(u32x2 w, float* f) {
    h16x4 h = __builtin_bit_cast(h16x4, w);
#pragma unroll
    for (int i = 0; i < 4; ++i) f[i] = (float)h[i];
}
constexpr int SCAN_BUF = 8256;
__device__ __forceinline__ void scan_phase(const Params& p, int j, unsigned char* smem) {
    const int tid = opaque_tid();
    const int wave = tid >> 6, lane = tid & 63, slot = wave >> 2, w4 = wave & 3;
    float* LB = (float*)smem + slot * (2 * SCAN_BUF);
    const h16* r16 = (const h16*)(p.ws + R_R16);
    const h16* k16 = (const h16*)(p.ws + R_K16);
    const h16* v16 = (j == 0) ? (const h16*)(p.ws + OFF_VF) : (const h16*)(p.ws + R_V16);
    const h16* g16 = (const h16*)(p.ws + R_G16);
    const h16* e16 = (const h16*)p.out;
    const h16* a16 = (const h16*)p.out + (size_t)MTOK * 1024;
    h16* y16 = (h16*)(p.ws + (j == 0 ? R_V16 : OFF_VF));
    const int tp = w4 * 4 + (lane >> 4), k4 = (lane & 15) * 4;
    const int vrow = w4 * 16 + (lane >> 2), kq = lane & 3;
    for (int pair = blockIdx.x; pair < 256; pair += gridDim.x) {
        const int chain = pair * 2 + slot, b = chain >> 4, h = chain & 15;
        const int col = h * 64 + k4;
        const f32x4 c_kk = *(const f32x4*)(p.in[16] + j * 1024 + col), c_ka = *(const f32x4*)(p.in[17] + j * 1024 + col), c_rk = *(const f32x4*)(p.in[18] + j * 1024 + col);
        const f32x4 c_lg = *(const f32x4*)(p.in[19] + j * 1024 + col), c_lb = *(const f32x4*)(p.in[20] + j * 1024 + col);
        f32x2 S[8];
#pragma unroll
        for (int i = 0; i < 8; ++i) S[i] = (f32x2){0.f, 0.f};
        u32x2 pr[6];
        {
            const size_t go = ((size_t)(b * 2048 + tp)) * 1024 + col;
            pr[0] = *(const u32x2*)(r16 + go); pr[1] = *(const u32x2*)(k16 + go); pr[2] = *(const u32x2*)(v16 + go);
            pr[3] = *(const u32x2*)(e16 + go); pr[4] = *(const u32x2*)(a16 + go); pr[5] = *(const u32x2*)(g16 + go);
        }
        for (int ch = 0; ch < 128; ++ch) {
            float* BUF = LB + (ch & 1) * SCAN_BUF;
            float* OPS = BUF; float* VB = BUF + 5120; float* GB = BUF + 6144; float* YB = BUF + 7168; float* BON = BUF + 8192;
            {
                float rf[4], kf[4], vf[4], ef[4], af[4], gf[4];
                unpack4(pr[0], rf); unpack4(pr[1], kf); unpack4(pr[2], vf); unpack4(pr[3], ef); unpack4(pr[4], af); unpack4(pr[5], gf);
                float kk[4]; float ss = 0.f;
#pragma unroll
                for (int i = 0; i < 4; ++i) { kk[i] = kf[i] * c_kk[i]; ss += kk[i] * kk[i]; }
                ss = red16(ss);
                const float inv = 1.0f / fmaxf(sqrtf(ss), 1e-12f);
                f32x4 A4, B4, W4, K4, R4; float bs = 0.f;
#pragma unroll
                for (int i = 0; i < 4; ++i) {
                    const float kn = kk[i] * inv;
                    A4[i] = -kn; B4[i] = kn * af[i];
                    W4[i] = __expf(-ef[i]);
                    const float km = kf[i] * (1.0f + (af[i] - 1.0f) * c_ka[i]);
                    K4[i] = km; R4[i] = rf[i];
                    bs += rf[i] * km * c_rk[i];
                }
                bs = red16(bs);
                float* o = OPS + tp * 320 + k4;
                *(f32x4*)(o) = A4; *(f32x4*)(o + 64) = B4; *(f32x4*)(o + 128) = W4; *(f32x4*)(o + 192) = K4; *(f32x4*)(o + 256) = R4;
                *(f32x4*)(VB + tp * 64 + k4) = (f32x4){vf[0], vf[1], vf[2], vf[3]};
                *(f32x4*)(GB + tp * 64 + k4) = (f32x4){gf[0], gf[1], gf[2], gf[3]};
                if ((lane & 15) == 0) BON[tp] = bs;
            }
            if (ch + 1 < 128) {
                const size_t go = ((size_t)(b * 2048 + (ch + 1) * 16 + tp)) * 1024 + col;
                pr[0] = *(const u32x2*)(r16 + go); pr[1] = *(const u32x2*)(k16 + go); pr[2] = *(const u32x2*)(v16 + go);
                pr[3] = *(const u32x2*)(e16 + go); pr[4] = *(const u32x2*)(a16 + go); pr[5] = *(const u32x2*)(g16 + go);
            }
            __syncthreads();
#pragma unroll 2
            for (int t = 0; t < 16; ++t) {
                const float* op = OPS + t * 320 + kq * 16;
                f32x4 A4[4], B4[4], W4[4], K4[4], R4[4];
#pragma unroll
                for (int i = 0; i < 4; ++i) A4[i] = *(const f32x4*)(op + i * 4);
#pragma unroll
                for (int i = 0; i < 4; ++i) { W4[i] = *(const f32x4*)(op + 128 + i * 4); B4[i] = *(const f32x4*)(op + 64 + i * 4); K4[i] = *(const f32x4*)(op + 192 + i * 4); }
#pragma unroll
                for (int i = 0; i < 4; ++i) R4[i] = *(const f32x4*)(op + 256 + i * 4);
                const float vv = VB[t * 64 + vrow];
                f32x2 s0 = {0.f, 0.f}, s1 = {0.f, 0.f};
#pragma unroll
                for (int i = 0; i < 4; ++i) { s0 += S[2 * i] * (f32x2){A4[i][0], A4[i][1]}; s1 += S[2 * i + 1] * (f32x2){A4[i][2], A4[i][3]}; }
                const float sa = red4((s0[0] + s0[1]) + (s1[0] + s1[1]));
                const f32x2 sa2 = {sa, sa}, vv2 = {vv, vv};
#pragma unroll
                for (int i = 0; i < 4; ++i) {
                    S[2 * i] = S[2 * i] * (f32x2){W4[i][0], W4[i][1]} + sa2 * (f32x2){B4[i][0], B4[i][1]} + vv2 * (f32x2){K4[i][0], K4[i][1]};
                    S[2 * i + 1] = S[2 * i + 1] * (f32x2){W4[i][2], W4[i][3]} + sa2 * (f32x2){B4[i][2], B4[i][3]} + vv2 * (f32x2){K4[i][2], K4[i][3]};
                }
                f32x2 y0 = {0.f, 0.f}, y1 = {0.f, 0.f};
#pragma unroll
                for (int i = 0; i < 4; ++i) { y0 += S[2 * i] * (f32x2){R4[i][0], R4[i][1]}; y1 += S[2 * i + 1] * (f32x2){R4[i][2], R4[i][3]}; }
                const float y = red4((y0[0] + y0[1]) + (y1[0] + y1[1]));
                if (kq == 0) YB[t * 64 + vrow] = y;
            }
            __syncthreads();
            {
                const f32x4 y4 = *(const f32x4*)(YB + tp * 64 + k4), v4 = *(const f32x4*)(VB + tp * 64 + k4), g4 = *(const f32x4*)(GB + tp * 64 + k4);
                const float mu = red16((y4[0] + y4[1]) + (y4[2] + y4[3])) * (1.0f / 64.0f);
                float q = 0.f;
#pragma unroll
                for (int i = 0; i < 4; ++i) { const float d = y4[i] - mu; q += d * d; }
                const float rstd = rsqrtf(red16(q) * (1.0f / 64.0f) + 64e-5f);
                const float bon = BON[tp];
                float o[4];
#pragma unroll
                for (int i = 0; i < 4; ++i) o[i] = ((y4[i] - mu) * rstd * c_lg[i] + c_lb[i] + bon * v4[i]) * g4[i];
                u32x2 w; w.x = pk2(o[0], o[1]); w.y = pk2(o[2], o[3]);
                *(u32x2*)(y16 + ((size_t)(b * 2048 + ch * 16 + tp)) * 1024 + col) = w;
            }
        }
        __syncthreads();
    }
}

__device__ __forceinline__ void dsa_norm_phase(const Params& p, int j, unsigned char* smem) {
    const int tid = opaque_tid();
    const int lane = tid & 63, wave = tid >> 6;
    const float* hin = (const float*)(p.ws + D_HIN);
    h16* cq = (h16*)(p.ws + D_CQ); h16* ckv = (h16*)(p.ws + D_CKV); h16* ckvt = (h16*)(p.ws + D_CKVT); h16* kidx = (h16*)(p.ws + D_KIDX);
    float* widx = (float*)(p.ws + D_WIDX);
    const f32x4 gq = *(const f32x4*)(p.in[23] + j * 256 + lane * 4);
    const f32x2 gkv = *(const f32x2*)(p.in[24] + j * 128 + lane * 2);
    const float gi = p.in[29][j * 64 + lane], bi = p.in[30][j * 64 + lane];
    h16* wl = (h16*)(smem + wave * 2048);
    for (int grp = blockIdx.x * 8 + wave; grp < MTOK / 8; grp += gridDim.x * 8) {
        const int r0 = grp * 8;
        for (int i = 0; i < 8; ++i) {
            const int row = r0 + i;
            const float* hp = hin + (size_t)row * 512;
            const f32x4 vq = *(const f32x4*)(hp + lane * 4);
            const f32x2 vk = *(const f32x2*)(hp + 256 + lane * 2);
            const float vi = hp[384 + lane];
            float ssq = wave_sum(vq[0] * vq[0] + vq[1] * vq[1] + vq[2] * vq[2] + vq[3] * vq[3]);
            const float rq = rsqrtf(ssq * (1.0f / 256.0f) + 1e-6f);
            u32x2 w; w.x = pk2(vq[0] * rq * gq[0], vq[1] * rq * gq[1]); w.y = pk2(vq[2] * rq * gq[2], vq[3] * rq * gq[3]);
            *(u32x2*)(cq + (size_t)row * 256 + lane * 4) = w;
            float ssk = wave_sum(vk[0] * vk[0] + vk[1] * vk[1]);
            const float rk = rsqrtf(ssk * (1.0f / 128.0f) + 1e-6f);
            const unsigned wk = pk2(vk[0] * rk * gkv[0], vk[1] * rk * gkv[1]);
            *(unsigned*)(ckv + (size_t)row * 128 + lane * 2) = wk;
            const float mu = wave_sum(vi) * (1.0f / 64.0f);
            const float dv = vi - mu;
            const float var = wave_sum(dv * dv) * (1.0f / 64.0f);
            kidx[(size_t)row * 64 + lane] = (h16)(dv * rsqrtf(var + 1e-5f) * gi + bi);
            if (lane < 8) widx[(size_t)row * 8 + lane] = hp[448 + lane] * 0.044194173824159216f;
        }
    }
}

constexpr int ROWP = 2052;
__device__ __forceinline__ unsigned fkey(float x) {
    if (x == 0.0f) x = 0.0f;
    const unsigned u = __float_as_uint(x);
    return (u & 0x80000000u) ? ~u : (u | 0x80000000u);
}
__device__ __forceinline__ void dsa_index_phase(const Params& p, unsigned char* smem) {
    const int tid = opaque_tid(), wave = tid >> 6, lane = tid & 63, r = lane & 15, q = lane >> 4;
    float* SC = (float*)smem;
    const h16* qidx = (const h16*)(p.ws + D_QIDX);
    const h16* kidx = (const h16*)(p.ws + D_KIDX);
    const float* widx = (const float*)(p.ws + D_WIDX);
    unsigned short* selout = (unsigned short*)(p.ws + D_MASK);
    h16x8 qf[8][2]; float wq[8];
    if ((int)blockIdx.x < MTOK / 16) {
        const int row0 = (int)blockIdx.x * 16;
#pragma unroll
        for (int h = 0; h < 8; ++h) {
#pragma unroll
            for (int kk = 0; kk < 2; ++kk) qf[h][kk] = *(const h16x8*)(qidx + (size_t)(row0 + r) * 512 + h * 64 + kk * 32 + q * 8);
            wq[h] = widx[(size_t)(row0 + r) * 8 + h];
        }
    }
    for (int qi = blockIdx.x, it = 0; qi < MTOK / 16; qi += gridDim.x, ++it) {
        const int qt = (it & 1) ? ((qi & ~127) | (127 - (qi & 127))) : qi;
        const int row0 = qt * 16, b = row0 >> 11, t0 = row0 & 2047;
        const int nkt = (t0 >> 4) + 1;
        {
            h16x8 kn[4];
            if (wave < nkt) {
                const bool two = (wave + 8 < nkt);
                const int s0 = wave * 16, s1 = two ? s0 + 128 : s0;
                const h16* kp = kidx + (size_t)(b * 2048 + s0 + r) * 64 + q * 8;
                const h16* kp1 = kidx + (size_t)(b * 2048 + s1 + r) * 64 + q * 8;
                kn[0] = *(const h16x8*)kp; kn[1] = *(const h16x8*)(kp + 32); kn[2] = *(const h16x8*)kp1; kn[3] = *(const h16x8*)(kp1 + 32);
            }
            for (int kt = wave; kt < nkt; kt += 16) {
                const bool two = (kt + 8 < nkt);
                const int s0 = kt * 16, s1 = two ? s0 + 128 : s0;
                const h16x8 k0 = kn[0], k1 = kn[1], k2 = kn[2], k3 = kn[3];
                if (kt + 16 < nkt) {
                    const bool two2 = (kt + 24 < nkt);
                    const int n0 = (kt + 16) * 16, n1 = two2 ? n0 + 128 : n0;
                    const h16* kp = kidx + (size_t)(b * 2048 + n0 + r) * 64 + q * 8;
                    const h16* kp1 = kidx + (size_t)(b * 2048 + n1 + r) * 64 + q * 8;
                    kn[0] = *(const h16x8*)kp; kn[1] = *(const h16x8*)(kp + 32); kn[2] = *(const h16x8*)kp1; kn[3] = *(const h16x8*)(kp1 + 32);
                }
                f32x4 sc = {0.f, 0.f, 0.f, 0.f}, sd = {0.f, 0.f, 0.f, 0.f};
#pragma unroll
                for (int h = 0; h < 8; ++h) {
                    f32x4 acc = {0.f, 0.f, 0.f, 0.f}, acd = {0.f, 0.f, 0.f, 0.f};
                    acc = __builtin_amdgcn_mfma_f32_16x16x32_f16(k0, qf[h][0], acc, 0, 0, 0);
                    acd = __builtin_amdgcn_mfma_f32_16x16x32_f16(k2, qf[h][0], acd, 0, 0, 0);
                    acc = __builtin_amdgcn_mfma_f32_16x16x32_f16(k1, qf[h][1], acc, 0, 0, 0);
                    acd = __builtin_amdgcn_mfma_f32_16x16x32_f16(k3, qf[h][1], acd, 0, 0, 0);
#pragma unroll
                    for (int jj = 0; jj < 4; ++jj) { sc[jj] += fmaxf(acc[jj], 0.f) * wq[h]; sd[jj] += fmaxf(acd[jj], 0.f) * wq[h]; }
                }
                *(f32x4*)(SC + r * ROWP + s0 + q * 4) = sc;
                if (two) *(f32x4*)(SC + r * ROWP + s1 + q * 4) = sd;
            }
            const int qin = qi + (int)gridDim.x;
            if (qin < MTOK / 16) {
                const int qtn = ((it + 1) & 1) ? ((qin & ~127) | (127 - (qin & 127))) : qin;
                const int rown = qtn * 16;
#pragma unroll
                for (int h = 0; h < 8; ++h) {
#pragma unroll
                    for (int kk = 0; kk < 2; ++kk) qf[h][kk] = *(const h16x8*)(qidx + (size_t)(rown + r) * 512 + h * 64 + kk * 32 + q * 8);
                    wq[h] = widx[(size_t)(rown + r) * 8 + h];
                }
            }
        }
        __syncthreads();
        for (int qq = 0; qq < 2; ++qq) {
            const int ql = wave * 2 + qq, t = t0 + ql;
            const float* srow = SC + ql * ROWP;
            const int ni = (t >> 6) + 1;
            unsigned u[32];
#pragma unroll
            for (int i = 0; i < 32; ++i) {
                u[i] = 0u;
                if (i < ni) { const int s = i * 64 + lane; if (s <= t) u[i] = fkey(srow[s]); }
            }
            unsigned short* selrow = selout + (size_t)(row0 + ql) * 256;
            if (t < 256) {
#pragma unroll
                for (int i = 0; i < 4; ++i) { const int pp = i * 64 + lane; selrow[pp] = (unsigned short)(pp <= t ? pp : 0xFFFF); }
            } else {
                unsigned* H = (unsigned*)(smem + 16 * ROWP * 4) + wave * 256;
                unsigned prefix = 0u; int need = 256;
#pragma unroll 1
                for (int pass = 0; pass < 4; ++pass) {
                    const int shift = 24 - 8 * pass;
                    const unsigned hmask = pass == 0 ? 0u : (0xFFFFFFFFu << (shift + 8));
                    *(u32x4*)(H + lane * 4) = (u32x4){0u, 0u, 0u, 0u};
                    asm volatile("s_waitcnt lgkmcnt(0)" ::: "memory");
#pragma unroll
                    for (int i = 0; i < 32; ++i) if (i < ni) { const unsigned uu = u[i]; if (uu != 0u && (uu & hmask) == prefix) atomicAdd(H + ((uu >> shift) & 255u), 1u); }
                    asm volatile("s_waitcnt lgkmcnt(0)" ::: "memory");
                    const u32x4 hv = *(const u32x4*)(H + lane * 4);
                    const int tot = (int)(hv.x + hv.y + hv.z + hv.w);
                    int rs = tot;
                    rs += __builtin_amdgcn_update_dpp(0, rs, 0xB1, 0xF, 0xF, true);
                    rs += __builtin_amdgcn_update_dpp(0, rs, 0x4E, 0xF, 0xF, true);
                    rs += __builtin_amdgcn_update_dpp(0, rs, 0x141, 0xF, 0xF, true);
                    rs += __builtin_amdgcn_update_dpp(0, rs, 0x140, 0xF, 0xF, true);
                    int rowsel = 3, above = 0;
                    {
                        const int r3 = __builtin_amdgcn_readlane(rs, 48), r2 = __builtin_amdgcn_readlane(rs, 32), r1 = __builtin_amdgcn_readlane(rs, 16);
                        if (need > r3) { above = r3; rowsel = 2; if (need > above + r2) { above += r2; rowsel = 1; if (need > above + r1) { above += r1; rowsel = 0; } } }
                    }
                    int lsel = rowsel * 16;
                    for (int k = 15; k >= 0; --k) {
                        const int cl = __builtin_amdgcn_readlane(tot, rowsel * 16 + k);
                        if (need <= above + cl) { lsel = rowsel * 16 + k; break; }
                        above += cl;
                    }
                    const int b3 = __builtin_amdgcn_readlane((int)hv.w, lsel), b2 = __builtin_amdgcn_readlane((int)hv.z, lsel), b1 = __builtin_amdgcn_readlane((int)hv.y, lsel);
                    int bsel = 3;
                    if (need > above + b3) { above += b3; bsel = 2; if (need > above + b2) { above += b2; bsel = 1; if (need > above + b1) { above += b1; bsel = 0; } } }
                    prefix |= (unsigned)(lsel * 4 + bsel) << shift;
                    need -= above;
                }
                const unsigned T = prefix;
                int running = 0, outpos = 0;
                const unsigned long long lt = (lane == 0) ? 0ull : (~0ull >> (64 - lane));
#pragma unroll
                for (int i = 0; i < 32; ++i) {
                    if (i < ni) {
                        const unsigned long long eq = __ballot(u[i] == T);
                        const int rank = running + __popcll(eq & lt);
                        const bool sel = u[i] > T || (u[i] == T && rank < need);
                        const unsigned long long sm = __ballot(sel);
                        running += __popcll(eq);
                        if (sel) selrow[outpos + __popcll(sm & lt)] = (unsigned short)(i * 64 + lane);
                        outpos += __popcll(sm);
                    }
                }
            }
        }
        __syncthreads();
    }
}

typedef __fp16 fp16x4_t __attribute__((__vector_size__(4 * sizeof(__fp16))));
__device__ __forceinline__ unsigned off_b(unsigned row, unsigned ch) { return 256u * row + 16u * (ch ^ (((row & 3) << 2) | ((row >> 2) & 3))); }
constexpr int SA_TILE = 8192, SA_BL = 8 * 2 * SA_TILE;
static_assert(SA_BL + 16 * 132 * 4 <= LDS_BYTES, "sparse attention LDS");
__device__ __forceinline__ void dsa_attn_phase(const Params& p, int j, unsigned char* smem) {
    const int tid = opaque_tid(), wave = tid >> 6, lane = tid & 63, r = lane & 15, q = lane >> 4;
    float* BL = (float*)(smem + SA_BL);
    for (int idx = tid; idx < 16 * 129; idx += 512) {
        const int h = idx / 129, d = idx % 129;
        int bk = d;
        if (d >= 16) { bk = 16 + (int)(logf((float)d * (1.0f / 16.0f)) / 2.0794415416798357f * 16.0f); bk = bk > 31 ? 31 : bk; }
        BL[h * 132 + d] = p.in[32][bk * 16 + h] * 1.4426950408889634f;
    }
    __syncthreads();
    const h16* qabs = (const h16*)(p.ws + D_QABS);
    const h16* ckv = (const h16*)(p.ws + D_CKV);
    const unsigned short* sel = (const unsigned short*)(p.ws + D_MASK);
    h16* olatA = (h16*)(p.ws + D_HIN);
    h16* olatB = (h16*)p.out + (size_t)MTOK * 1024;
    unsigned char* tile0 = smem + wave * (2 * SA_TILE);
    const float NINF = -__builtin_inff();
    unsigned wofs[8], kofs[2][4], vofs[8][2];
#pragma unroll
    for (int i = 0; i < 8; ++i) wofs[i] = off_b(8 * q + i, r);
#pragma unroll
    for (int tt = 0; tt < 2; ++tt)
#pragma unroll
        for (int kk = 0; kk < 4; ++kk) kofs[tt][kk] = off_b(8 * (r >> 2) + 4 * tt + (r & 3), 4 * kk + q);
#pragma unroll
    for (int c = 0; c < 8; ++c)
#pragma unroll
        for (int t2 = 0; t2 < 2; ++t2) vofs[c][t2] = off_b(8 * q + 4 * t2 + (r >> 2), 2 * c + ((lane & 3) >> 1)) + 8 * (lane & 1);
    for (int row = blockIdx.x * 8 + wave; row < MTOK; row += gridDim.x * 8) {
        const int b = row >> 11, t = row & 2047;
        const int nvalid = t + 1 < 256 ? t + 1 : 256, ng = (nvalid + 31) >> 5;
        const h16* kg = ckv + (size_t)(b * 2048) * 128;
        const unsigned short* srow = sel + (size_t)row * 256;
        h16x8 qf[4];
#pragma unroll
        for (int kk = 0; kk < 4; ++kk) qf[kk] = *(const h16x8*)(qabs + (size_t)row * 2048 + r * 128 + kk * 32 + q * 8);
        f32x4 O[8];
#pragma unroll
        for (int dt = 0; dt < 8; ++dt) O[dt] = (f32x4){0.f, 0.f, 0.f, 0.f};
        float mrun = NINF, lrun = 0.f;
        u32x4 selA = *(const u32x4*)(srow + 8 * q), selB = selA;
        u32x4 grA[8], grB[8];
#define SA_GATHER(GR, SELV) do { _Pragma("unroll") for (int i = 0; i < 8; ++i) { \
            unsigned sidx = ((SELV)[i >> 1] >> ((i & 1) * 16)) & 0xFFFFu; sidx = sidx == 0xFFFFu ? 0u : sidx; \
            (GR)[i] = *(const u32x4*)(kg + (size_t)sidx * 128 + r * 8); } } while (0)
#define SA_GROUP(GR, SELV, G) do { \
            unsigned char* tile = tile0 + ((G) & 1) * SA_TILE; \
            const u32x4 selc = (SELV); \
            _Pragma("unroll") for (int i = 0; i < 8; ++i) *(u32x4*)(tile + wofs[i]) = (GR)[i]; \
            if ((G) + 2 < ng) { (SELV) = *(const u32x4*)(srow + ((G) + 2) * 32 + 8 * q); SA_GATHER(GR, SELV); } \
            asm volatile("s_waitcnt lgkmcnt(0)" ::: "memory"); \
            f32x4 sc[2]; \
            _Pragma("unroll") for (int tt = 0; tt < 2; ++tt) { \
                f32x4 acc = {0.f, 0.f, 0.f, 0.f}; \
                _Pragma("unroll") for (int kk = 0; kk < 4; ++kk) { \
                    const h16x8 kf = *(const h16x8*)(tile + kofs[tt][kk]); \
                    acc = __builtin_amdgcn_mfma_f32_16x16x32_f16(kf, qf[kk], acc, 0, 0, 0); } \
                sc[tt] = acc; } \
            float x[8]; float mx = NINF; \
            _Pragma("unroll") for (int i = 0; i < 8; ++i) { \
                const unsigned sidx = (selc[i >> 1] >> ((i & 1) * 16)) & 0xFFFFu; \
                int dist = t - (int)sidx; dist = dist < 0 ? 0 : (dist > 128 ? 128 : dist); \
                const float v = sc[i >> 2][i & 3] + BL[r * 132 + dist]; \
                const float xv = (sidx != 0xFFFFu) ? v : NINF; \
                x[i] = xv; mx = fmaxf(mx, xv); } \
            mx = xmax_16_32(mx); \
            const float mnew = fmaxf(mrun, mx); \
            const float mref = (mnew == NINF) ? 0.f : mnew; \
            const float alpha = __builtin_amdgcn_exp2f(mrun - mref); \
            mrun = mnew; \
            float ps = 0.f; h16x8 pf; \
            _Pragma("unroll") for (int i = 0; i < 8; ++i) { const float pv = __builtin_amdgcn_exp2f(x[i] - mref); ps += pv; pf[i] = (h16)pv; } \
            lrun = lrun * alpha + ps; \
            _Pragma("unroll") for (int dt = 0; dt < 8; ++dt) { \
                const fp16x4_t lo = __builtin_amdgcn_ds_read_tr16_b64_v4f16((LAS fp16x4_t*)(tile + vofs[dt][0])); \
                const fp16x4_t hi = __builtin_amdgcn_ds_read_tr16_b64_v4f16((LAS fp16x4_t*)(tile + vofs[dt][1])); \
                const h16x4 l4 = __builtin_bit_cast(h16x4, lo), h4 = __builtin_bit_cast(h16x4, hi); \
                const h16x8 vf = {l4[0], l4[1], l4[2], l4[3], h4[0], h4[1], h4[2], h4[3]}; \
                O[dt] *= alpha; \
                O[dt] = __builtin_amdgcn_mfma_f32_16x16x32_f16(vf, pf, O[dt], 0, 0, 0); } \
        } while (0)
        SA_GATHER(grA, selA);
        if (ng > 1) { selB = *(const u32x4*)(srow + 32 + 8 * q); SA_GATHER(grB, selB); }
        for (int g = 0; g < ng; g += 2) {
            SA_GROUP(grA, selA, g);
            if (g + 1 < ng) SA_GROUP(grB, selB, g + 1);
        }
#undef SA_GATHER
#undef SA_GROUP
        const float inv = 1.0f / xsum_16_32(lrun);
        h16* op = (row < MTOK / 2 ? olatA + (size_t)row * 2048 : olatB + (size_t)(row - MTOK / 2) * 2048) + r * 128 + q * 4;
#pragma unroll
        for (int dt = 0; dt < 8; ++dt) {
            u32x2 w; w.x = pk2(O[dt][0] * inv, O[dt][1] * inv); w.y = pk2(O[dt][2] * inv, O[dt][3] * inv);
            *(u32x2*)(op + dt * 16) = w;
        }
        asm volatile("s_waitcnt lgkmcnt(0)" ::: "memory");
    }
    __syncthreads();
}

constexpr size_t OFF_BAR = 951 * MiB;
#define XB_TMO      128
#define XB_XCNT(j)  (256  + 64 * (j))
#define XB_XSUB(j)  (1280 + 64 * (j))
#define XB_XGEN(j)  (2304 + 64 * (j))
#define XB_TOP      3328
#define XB_TOPGEN   3392
#define XCD_BAR_WORDS 3456
#define XB_SPIN_CAP (1u << 22)
__device__ __forceinline__ unsigned xb_ld(unsigned* p)              { return __hip_atomic_load(p, __ATOMIC_RELAXED, __HIP_MEMORY_SCOPE_AGENT); }
__device__ __forceinline__ unsigned xb_add(unsigned* p, unsigned v) { return __hip_atomic_fetch_add(p, v, __ATOMIC_RELAXED, __HIP_MEMORY_SCOPE_AGENT); }
__device__ __forceinline__ unsigned xb_xcc_id() { return (unsigned)__builtin_amdgcn_s_getreg((3 << 11) | 20) & 0xFu; }
#define XB_SPIN(cond, bar) do { unsigned _sp = 0; while (cond) { __builtin_amdgcn_s_sleep(1); \
    if ((++_sp & 255u) == 0u) { if (xb_ld(&(bar)[XB_TMO])) break; if (_sp > XB_SPIN_CAP) { atomicAdd(&(bar)[XB_TMO], 1u); break; } } } } while (0)
struct XcdBarrier { unsigned* bar; unsigned x; volatile LAS unsigned* st; };
__device__ __forceinline__ XcdBarrier xcd_barrier_post(unsigned* bar, volatile LAS unsigned* st) {
    XcdBarrier b; b.bar = bar; b.x = xb_xcc_id(); b.st = st;
    if (threadIdx.x == 0) (void)xb_add(&bar[XB_XCNT(b.x)], 1u);
    return b;
}
__device__ __forceinline__ void xcd_barrier_complete(unsigned* bar, unsigned x, unsigned& nloc, unsigned& nx) {
    const unsigned G = gridDim.x * gridDim.y * gridDim.z;
    unsigned sum, cnt, mine, sp = 0u;
    for (;;) {
        sum = 0u; cnt = 0u; mine = 0u;
#pragma unroll
        for (unsigned jx = 0; jx < 16; ++jx) { const unsigned c = xb_ld(&bar[XB_XCNT(jx)]); sum += c; cnt += (c > 0u) ? 1u : 0u; mine = (jx == x) ? c : mine; }
        if (sum == G) break;
        __builtin_amdgcn_s_sleep(1);
        if ((++sp & 255u) == 0u) { if (xb_ld(&bar[XB_TMO])) break; if (sp > XB_SPIN_CAP) { atomicAdd(&bar[XB_TMO], 1u); break; } }
    }
    nloc = mine > 0u ? mine : 1u; nx = cnt > 0u ? cnt : 1u;
}
__device__ __forceinline__ void xcd_barrier(const XcdBarrier& b) {
    asm volatile("s_waitcnt vmcnt(0)" ::: "memory");
    __syncthreads();
    if (threadIdx.x == 0) {
        unsigned* bar = b.bar;
        __builtin_amdgcn_s_waitcnt(0);
        unsigned nloc = b.st[0], nx = b.st[1];
        if (nloc == 0u) { xcd_barrier_complete(bar, b.x, nloc, nx); b.st[0] = nloc; b.st[1] = nx; }
        const unsigned old = xb_add(&bar[XB_XSUB(b.x)], 1u);
        const unsigned gen = old / nloc;
        if (old + 1u == (gen + 1u) * nloc) {
            __builtin_amdgcn_fence(__ATOMIC_RELEASE, "agent");
            asm volatile("s_waitcnt vmcnt(0)" ::: "memory");
            const unsigned og = xb_add(&bar[XB_TOP], 1u);
            const unsigned tg = og / nx;
            if (og + 1u == (tg + 1u) * nx) xb_add(&bar[XB_TOPGEN], 1u);
            else XB_SPIN(xb_ld(&bar[XB_TOPGEN]) == tg, bar);
            __builtin_amdgcn_fence(__ATOMIC_ACQUIRE, "agent");
            xb_add(&bar[XB_XGEN(b.x)], 1u);
            asm volatile("s_waitcnt vmcnt(0)" ::: "memory");
        } else {
            XB_SPIN(xb_ld(&bar[XB_XGEN(b.x)]) == gen, bar);
            __builtin_amdgcn_fence(__ATOMIC_ACQUIRE, "agent");
            asm volatile("s_waitcnt vmcnt(0)" ::: "memory");
        }
    }
    __syncthreads();
}

__global__ void __launch_bounds__(512) mega_fwd(Params p) {
    extern __shared__ __attribute__((aligned(16))) unsigned char smem[];
    cg::grid_group grid = cg::this_grid();
    unsigned char* ws = p.ws;
    h16* x16 = (h16*)(ws + OFF_X16);
    volatile LAS unsigned* xbst = (volatile LAS unsigned*)(smem + LDS_BYTES - 16);
    if (threadIdx.x == 0) { xbst[0] = 0u; xbst[1] = 0u; }
    __syncthreads();
    const XcdBarrier xbar = xcd_barrier_post((unsigned*)(ws + OFF_BAR), xbst);
    for (int ph = p.ph_lo; ph < p.ph_hi; ++ph) {
        const unsigned e = p.prog[ph];
        const int kind = e & 15, L = (e >> 4) & 3, sub = (e >> 6) & 1, j = L >> 1;
        const int nrep = 1 + (int)(e >> 7);
        for (int rep = 0; rep < nrep; ++rep) {
        if (rep) xcd_barrier(xbar);
        const bool isgemm = (kind == K_R1 || kind == K_R2 || kind == K_R4 || kind == K_F1 || kind == K_F3 || kind == K_D1 || kind == K_D3 || kind == K_D6);
        if (isgemm) {
            const int ngemm = (kind == K_R1) ? 2 : 1;
            for (int gi = 0; gi < ngemm; ++gi) {
            pg8::Gemm g; pg8::Epi E;
            g.M = MTOK; g.N = 1024; g.K = 1024; g.lda = 1024; g.amode = 0; g.pm0 = 0; g.A = x16; g.A2 = x16; g.Bt = x16;
            E.mode = E_RESID; E.pm0 = 0; E.j = j; E.pnoff = 0; E.fin = (L == 3 && kind == K_F3) ? 1 : 0; E.ws = ws; E.out = p.out; E.bias0 = p.in[5] + j * 1024; E.bias1 = p.in[8] + j * 1024; E.bias2 = p.in[11];
            if (kind == K_R1) {
                E.mode = E_RPROJ;
                if (gi == 0) { g.A = (const h16*)p.out; g.A2 = (const h16*)(ws + R_G16); g.Bt = w_rwkv_big(ws, j); g.N = 3072; g.amode = 2; }
                else { g.Bt = w_rwkv_l1(ws, j); g.N = 512; g.K = 2048; g.amode = 1; E.pnoff = 12; }
            } else if (kind == K_R2) {
                g.A = (const h16*)(ws + R_HACT); g.Bt = w_rwkv_l2(ws, j); g.N = (j == 0) ? 3072 : 4096; g.K = 384; g.lda = 384; E.mode = E_LORA2;
            } else if (kind == K_R4) {
                g.A = (const h16*)(ws + (j == 0 ? R_V16 : OFF_VF)); g.Bt = w_rwkv_o(ws, j);
            } else if (kind == K_F1) {
                g.Bt = w_ffn_up(ws, L); g.M = MTOK / 2; g.N = 5632; g.amode = 1; g.pm0 = sub * 128; E.mode = E_ST16;
            } else if (kind == K_F3) {
                g.A = (const h16*)(ws + F_ACT); g.Bt = w_ffn_dn(ws, L); g.M = MTOK / 2; g.K = 2816; g.lda = 2816; E.pm0 = sub * 128;
            } else if (kind == K_D1) {
                g.Bt = w_dsa_in(ws, j); g.N = 512; g.amode = 1; E.mode = E_ST32;
            } else if (kind == K_D3) {
                g.A = (const h16*)(ws + D_CQ); g.Bt = w_dsa_q(ws, j); g.N = 2560; g.K = 256; g.lda = 256; E.mode = E_QPROJ;
            } else {
                g.A = (const h16*)(ws + D_HIN); g.A2 = (const h16*)p.out + (size_t)MTOK * 1024; g.Bt = (const h16*)(ws + OFF_WOV) + (size_t)j * 2097152; g.K = 2048; g.lda = 2048; g.amode = 3;
            }
            pg8::StaticOrder S; S.init(g.M, g.N, (int)gridDim.x, (int)blockIdx.x);
#ifndef NO_GEMM
            pg8::gemm_phase((LAS unsigned char*)smem, g, S, E);
#endif
            }
        } else if (kind == K_PREP) {
#ifndef NO_PREP
            prep_phase(p, smem);
#endif
        } else if (kind == K_R0) {
            mix_phase(p, j);
        } else if (kind == K_R3) {
#ifndef NO_SCAN
            scan_phase(p, j, smem);
#endif
        } else if (kind == K_LN) {
#ifndef NO_LN
            ln_phase(p, p.in[1] + (L * 2 + sub) * 1024, p.in[2] + (L * 2 + sub) * 1024, L == 3 && sub == 1);
#endif
        } else if (kind == K_F2) {
#ifndef NO_CONV
            conv_phase(p, L);
#endif
        } else if (kind == K_D2) {
#ifndef NO_NORM
            dsa_norm_phase(p, j, smem);
#endif
        } else if (kind == K_D4) {
#ifndef NO_INDEX
            dsa_index_phase(p, smem);
#endif
        } else if (kind == K_D5) {
#ifndef NO_ATTN
            dsa_attn_phase(p, j, smem);
#endif
        }
        }
        if (ph + 1 < p.ph_hi) { if (ph == p.ph_lo) grid.sync(); else xcd_barrier(xbar); for (int xs = 0; xs < EXTRA_SYNC; ++xs) xcd_barrier(xbar); }
    }
}

extern "C" void kernel_launch(void* const* d_in, const int* in_sizes, int n_in, void* d_out, int out_size, void* d_ws, size_t ws_size, hipStream_t stream) {
    static int grid_blocks = 0;
    if (grid_blocks == 0) {
        if (n_in != 37 || ws_size < WS_NEED || out_size != MTOK * DM) { fprintf(stderr, "kernel_launch: unexpected problem (n_in %d ws %zu out %d)\n", n_in, ws_size, out_size); grid_blocks = -1; return; }
        int dev = 0, cus = 0, per_cu = 0;
        hipGetDevice(&dev);
        hipDeviceGetAttribute(&cus, hipDeviceAttributeMultiprocessorCount, dev);
        if (hipFuncSetAttribute((const void*)mega_fwd, hipFuncAttributeMaxDynamicSharedMemorySize, LDS_BYTES) != hipSuccess) { fprintf(stderr, "kernel_launch: hipFuncSetAttribute failed\n"); grid_blocks = -1; return; }
        hipOccupancyMaxActiveBlocksPerMultiprocessor(&per_cu, (const void*)mega_fwd, 512, LDS_BYTES);
        if (per_cu < 1) { fprintf(stderr, "kernel_launch: occupancy query says %d blocks/CU\n", per_cu); per_cu = 1; }
        (void)hipGetLastError();
        grid_blocks = cus * per_cu;
        fprintf(stderr, "kernel_launch: grid %d (cus %d x %d)\n", grid_blocks, cus, per_cu);
    }
    if (grid_blocks < 0) return;
    Params p{};
    for (int i = 0; i < 37; ++i) p.in[i] = (const float*)d_in[i];
    p.ws = (unsigned char*)d_ws; p.out = (float*)d_out;
    int np = 0;
    constexpr unsigned PROBE_MASK = 0u;
    auto add = [&](int kind, int L, int sub) { p.prog[np++] = (unsigned char)(kind | (L << 4) | (sub << 6) | ((((PROBE_MASK >> kind) & 1u) && !(kind == K_LN && L == 3 && sub == 1)) ? 128 : 0)); };
    add(K_PREP, 0, 0);
    for (int L = 0; L < 4; ++L) {
        if ((L & 1) == 0) { add(K_R0, L, 0); add(K_R1, L, 0); add(K_R2, L, 0); add(K_R3, L, 0); add(K_R4, L, 0); }
        else { add(K_D1, L, 0); add(K_D2, L, 0); add(K_D3, L, 0); add(K_D4, L, 0); add(K_D5, L, 0); add(K_D6, L, 0); }
        add(K_LN, L, 0);
        for (int c = 0; c < 2; ++c) { add(K_F1, L, c); add(K_F2, L, c); add(K_F3, L, c); }
        add(K_LN, L, 1);
    }
#if SINGLE_LAUNCH
    if (hipMemsetAsync((unsigned char*)d_ws + OFF_BAR, 0, XCD_BAR_WORDS * 4, stream) != hipSuccess) { fprintf(stderr, "kernel_launch: memset failed\n"); return; }
    p.ph_lo = 0; p.ph_hi = np;
    void* args[] = {&p};
    hipError_t e = hipLaunchCooperativeKernel((const void*)mega_fwd, dim3(grid_blocks), dim3(512), args, LDS_BYTES, stream);
    if (e != hipSuccess) fprintf(stderr, "cooperative launch failed: %s (grid %d)\n", hipGetErrorString(e), grid_blocks);
#else
    for (int ph = 0; ph < np; ++ph) {
        p.ph_lo = ph; p.ph_hi = ph + 1;
        hipLaunchKernelGGL(mega_fwd, dim3(grid_blocks), dim3(512), LDS_BYTES, stream, p);
    }
#endif
}
```

```cpp
#include <hip/hip_runtime.h>
#include <hip/hip_cooperative_groups.h>
#include <cstdio>
namespace cg = cooperative_groups;

constexpr int EXTRA_SYNC = 0;
#ifndef SINGLE_LAUNCH
#define SINGLE_LAUNCH 1
#endif

#define LAS __attribute__((address_space(3)))
typedef _Float16 h16;
typedef _Float16 h16x8 __attribute__((ext_vector_type(8)));
typedef _Float16 h16x4 __attribute__((ext_vector_type(4)));
typedef _Float16 h16x2 __attribute__((ext_vector_type(2)));
typedef float f32x4 __attribute__((ext_vector_type(4)));
typedef float f32x2 __attribute__((ext_vector_type(2)));
typedef unsigned u32x4 __attribute__((ext_vector_type(4)));
typedef unsigned u32x2 __attribute__((ext_vector_type(2)));

constexpr int DM = 1024, SEQ = 2048, NBATCH = 32, MTOK = NBATCH * SEQ;
constexpr int DFF = 2816;
constexpr size_t MiB = (size_t)1 << 20;
constexpr float DN_ALPHA = 1.6817928305074290f;
constexpr int LDS_BYTES = 147456;

constexpr size_t OFF_W = 0;
constexpr size_t OFF_X16 = 118 * MiB;
constexpr size_t OFF_VF = 247 * MiB;
constexpr size_t OFF_R = 375 * MiB;
constexpr size_t WS_NEED = 960 * MiB;
constexpr size_t OFF_WOV = 952 * MiB;
constexpr size_t R_R16 = OFF_R, R_K16 = OFF_R + 128 * MiB, R_V16 = OFF_R + 256 * MiB, R_G16 = OFF_R + 384 * MiB, R_HACT = OFF_R + 512 * MiB;
constexpr size_t F_U16 = OFF_R, F_ACT = OFF_R + 352 * MiB;
constexpr size_t D_HIN = OFF_R, D_O16 = OFF_R, D_QABS = OFF_R + 128 * MiB, D_QIDX = OFF_R + 384 * MiB, D_CQ = OFF_R + 448 * MiB,
                 D_CKV = OFF_R + 480 * MiB, D_CKVT = OFF_R + 496 * MiB, D_KIDX = OFF_R + 512 * MiB, D_WIDX = OFF_R + 520 * MiB, D_MASK = OFF_R + 522 * MiB;

struct Params {
    const float* in[37];
    unsigned char* ws;
    float* out;
    int ph_lo, ph_hi;
    unsigned char prog[64];
};

enum { K_PREP = 0, K_R1, K_R2, K_R3, K_R4, K_LN, K_F1, K_F2, K_F3, K_D1, K_D2, K_D3, K_D4, K_D5, K_D6, K_R0 };
enum { E_RPROJ = 0, E_LORA2, E_RESID, E_ST16, E_ST32, E_QPROJ };

__device__ __forceinline__ size_t xrow(int row) { return (size_t)(row >> 11) * 2049 + 1 + (row & 2047); }
__device__ __forceinline__ unsigned pk2(float a, float b) { h16x2 h = {(h16)a, (h16)b}; return __builtin_bit_cast(unsigned, h); }
__device__ __forceinline__ u32x4 pack8(f32x4 a, f32x4 b) { u32x4 w; w.x = pk2(a[0], a[1]); w.y = pk2(a[2], a[3]); w.z = pk2(b[0], b[1]); w.w = pk2(b[2], b[3]); return w; }
__device__ __forceinline__ void unpack8(u32x4 w, float* f) {
    h16x8 h = __builtin_bit_cast(h16x8, w);
#pragma unroll
    for (int i = 0; i < 8; ++i) f[i] = (float)h[i];
}
__device__ __forceinline__ float sigmoidf_(float x) { return __builtin_amdgcn_rcpf(1.0f + __expf(-x)); }
#define WSYNC() asm volatile("s_waitcnt vmcnt(0) lgkmcnt(0)" ::: "memory")
__device__ __forceinline__ int opaque_tid() { int t = threadIdx.x; asm volatile("" : "+v"(t)); return t; }
__device__ __forceinline__ float dppf(float x, const int ctrl_sel) {
    const int v = __builtin_bit_cast(int, x);
    int r;
    if (ctrl_sel == 0) r = __builtin_amdgcn_update_dpp(0, v, 0xB1, 0xF, 0xF, true);
    else if (ctrl_sel == 1) r = __builtin_amdgcn_update_dpp(0, v, 0x4E, 0xF, 0xF, true);
    else if (ctrl_sel == 2) r = __builtin_amdgcn_update_dpp(0, v, 0x141, 0xF, 0xF, true);
    else r = __builtin_amdgcn_update_dpp(0, v, 0x140, 0xF, 0xF, true);
    return __builtin_bit_cast(float, r);
}
__device__ __forceinline__ float red4(float x) { x += dppf(x, 0); x += dppf(x, 1); return x; }
__device__ __forceinline__ float red16(float x) { x += dppf(x, 0); x += dppf(x, 1); x += dppf(x, 2); x += dppf(x, 3); return x; }
__device__ __forceinline__ float xmax_16_32(float x) {
    const unsigned u = __builtin_bit_cast(unsigned, x);
    auto r = __builtin_amdgcn_permlane16_swap(u, u, false, false);
    float m = fmaxf(__builtin_bit_cast(float, (unsigned)r[0]), __builtin_bit_cast(float, (unsigned)r[1]));
    const unsigned u2 = __builtin_bit_cast(unsigned, m);
    auto r2 = __builtin_amdgcn_permlane32_swap(u2, u2, false, false);
    return fmaxf(__builtin_bit_cast(float, (unsigned)r2[0]), __builtin_bit_cast(float, (unsigned)r2[1]));
}
__device__ __forceinline__ float xsum_16_32(float x) {
    const unsigned u = __builtin_bit_cast(unsigned, x);
    auto r = __builtin_amdgcn_permlane16_swap(u, u, false, false);
    float m = __builtin_bit_cast(float, (unsigned)r[0]) + __builtin_bit_cast(float, (unsigned)r[1]);
    const unsigned u2 = __builtin_bit_cast(unsigned, m);
    auto r2 = __builtin_amdgcn_permlane32_swap(u2, u2, false, false);
    return __builtin_bit_cast(float, (unsigned)r2[0]) + __builtin_bit_cast(float, (unsigned)r2[1]);
}
__device__ __forceinline__ float wave_sum(float v) { return xsum_16_32(red16(v)); }

namespace pg8 {
constexpr int BM = 256, BK = 64, HALF = 128, HTB = HALF * BK * 2, STAGE_BYTES = 8 * HTB, NXCD = 8, WGM = 8;
__device__ __forceinline__ int lds_byte(int r, int c) { const int st = (r >> 4) * 2 + (c >> 5), rr = r & 15, cc = c & 31, ob = rr * 64 + cc * 2; return st * 1024 + (ob ^ (((ob >> 9) & 1) << 5)); }
__device__ __forceinline__ void stage_rc(int b, int& R, int& C) { const int st = b / 1024, sb = b % 1024, swz = sb ^ (((sb >> 9) & 1) << 5); R = (st >> 1) * 16 + swz / 64; C = (st & 1) * 32 + (swz % 64) / 2; }
__device__ __forceinline__ int perm32(int rho) { const int n = rho >> 4, i = rho & 15; return 8 * (i >> 2) + 4 * n + (i & 3); }
struct Unit { int pm, pn; };
struct Gemm { const h16* A; const h16* A2; const h16* Bt; int M, N, K, lda, amode, pm0; };
struct StaticOrder {
    int nM, nN, nwg, G, c;
    __device__ void init(int M, int N, int G_, int c_) { nM = M / BM; nN = N / BM; nwg = nM * nN; G = G_; c = c_; }
    __device__ bool next(int i, Unit& u) const {
        const long L = (long)i * G + c; if (L >= nwg) return false;
        int wgid = (int)L; { const int q = nwg / NXCD, r = nwg % NXCD, xcd = wgid % NXCD, off = wgid / NXCD; wgid = (xcd < r ? xcd * (q + 1) : r * (q + 1) + (xcd - r) * q) + off; }
        const int nig = WGM * nN, gid = wgid / nig, fm = gid * WGM, gsz = (nM - fm) < WGM ? (nM - fm) : WGM;
        u.pm = fm + ((wgid % nig) % gsz); u.pn = (wgid % nig) / gsz; return true;
    }
};

struct Epi {
    int mode, pm0, j, pnoff, fin;
    unsigned char* ws; float* out; const float* bias0; const float* bias1; const float* bias2;
    __device__ __forceinline__ void operator()(const f32x4 (&acc)[2][2][4][2], const Unit& u, int wr, int wc, int fr, int fq) const {
        const int rowl0 = u.pm * BM + wr * 64 + fr;
        const int colt = u.pn * BM + wc * 32 + 8 * fq;
        if (mode == E_RESID) {
            u32x4 xr[2][4][2];
#pragma unroll
            for (int ai = 0; ai < 2; ++ai)
#pragma unroll
                for (int m = 0; m < 4; ++m) {
                    const int rowg = rowl0 + ai * HALF + m * 16 + pm0 * BM;
                    const h16* xp = (const h16*)(ws + OFF_X16) + xrow(rowg) * 1024 + colt;
#pragma unroll
                    for (int bj = 0; bj < 2; ++bj) xr[ai][m][bj] = *(const u32x4*)(xp + bj * HALF);
                }
#pragma unroll
            for (int ai = 0; ai < 2; ++ai)
#pragma unroll
                for (int m = 0; m < 4; ++m) {
                    const int rowg = rowl0 + ai * HALF + m * 16 + pm0 * BM;
                    float* dp0 = out + (size_t)rowg * 1024 + colt;
                    h16* hp0 = (h16*)out + (size_t)rowg * 1024 + colt;
#pragma unroll
                    for (int bj = 0; bj < 2; ++bj) {
                        float xf[8]; unpack8(xr[ai][m][bj], xf);
                        const f32x4 v0 = acc[ai][bj][m][0], v1 = acc[ai][bj][m][1];
                        f32x4 r0, r1;
#pragma unroll
                        for (int jj = 0; jj < 4; ++jj) { r0[jj] = DN_ALPHA * xf[jj] + v0[jj]; r1[jj] = DN_ALPHA * xf[4 + jj] + v1[jj]; }
                        if (fin) { float* dp = dp0 + bj * HALF; *(f32x4*)dp = r0; *(f32x4*)(dp + 4) = r1; }
                        else *(u32x4*)(hp0 + bj * HALF) = pack8(r0, r1);
                    }
                }
            return;
        }
        if (mode == E_LORA2 && (u.pn >> 2) == 3) {
            const int c0 = colt & 1023;
#pragma unroll
            for (int ai = 0; ai < 2; ++ai) {
                u32x4 lv[4][2], lf[4][2];
#pragma unroll
                for (int m = 0; m < 4; ++m) {
                    const size_t off = (size_t)(rowl0 + ai * HALF + m * 16 + pm0 * BM) * 1024 + c0;
#pragma unroll
                    for (int bj = 0; bj < 2; ++bj) { lv[m][bj] = *(const u32x4*)((const h16*)(ws + R_V16) + off + bj * HALF); lf[m][bj] = *(const u32x4*)((const h16*)(ws + OFF_VF) + off + bj * HALF); }
                }
#pragma unroll
                for (int m = 0; m < 4; ++m) {
                    const size_t off = (size_t)(rowl0 + ai * HALF + m * 16 + pm0 * BM) * 1024 + c0;
#pragma unroll
                    for (int bj = 0; bj < 2; ++bj) {
                        const int c = c0 + bj * HALF;
                        const f32x4 ba = *(const f32x4*)(bias2 + c), bb = *(const f32x4*)(bias2 + c + 4);
                        float vv[8], vf8[8]; unpack8(lv[m][bj], vv); unpack8(lf[m][bj], vf8);
                        f32x4 v0 = acc[ai][bj][m][0], v1 = acc[ai][bj][m][1];
#pragma unroll
                        for (int jj = 0; jj < 4; ++jj) {
                            v0[jj] = vv[jj] + (vf8[jj] - vv[jj]) * sigmoidf_(v0[jj] + ba[jj]);
                            v1[jj] = vv[4 + jj] + (vf8[4 + jj] - vv[4 + jj]) * sigmoidf_(v1[jj] + bb[jj]);
                        }
                        *(u32x4*)((h16*)(ws + R_V16) + off + bj * HALF) = pack8(v0, v1);
                    }
                }
            }
            return;
        }
#pragma unroll
        for (int ai = 0; ai < 2; ++ai)
#pragma unroll
            for (int m = 0; m < 4; ++m) {
                const int rowl = rowl0 + ai * HALF + m * 16;
                const int rowg = rowl + pm0 * BM;
#pragma unroll
                for (int bj = 0; bj < 2; ++bj) {
                    const int col = colt + bj * HALF;
                    f32x4 v0 = acc[ai][bj][m][0], v1 = acc[ai][bj][m][1];
                    if (mode == E_RPROJ) {
                        if (pnoff == 0) {
                            h16* dst = (h16*)(ws + (u.pn < 4 ? R_R16 : (u.pn < 8 ? R_K16 : (j == 0 ? OFF_VF : R_V16))));
                            *(u32x4*)(dst + (size_t)rowg * 1024 + (col & 1023)) = pack8(v0, v1);
                        } else if (col < 384) {
                            const int hc = col;
                            if (hc < 64) {
#pragma unroll
                                for (int jj = 0; jj < 4; ++jj) { v0[jj] = tanhf(v0[jj]); v1[jj] = tanhf(v1[jj]); }
                            } else if (hc >= 160) {
#pragma unroll
                                for (int jj = 0; jj < 4; ++jj) { v0[jj] = sigmoidf_(v0[jj]); v1[jj] = sigmoidf_(v1[jj]); }
                            }
                            *(u32x4*)((h16*)(ws + R_HACT) + (size_t)rowg * 384 + hc) = pack8(v0, v1);
                        }
                    } else if (mode == E_LORA2) {
                        const int grp = u.pn >> 2, c = col & 1023;
                        const size_t off = (size_t)rowg * 1024 + c;
                        if (grp == 0) {
                            const f32x4 ba = *(const f32x4*)(bias0 + c), bb = *(const f32x4*)(bias0 + c + 4);
#pragma unroll
                            for (int jj = 0; jj < 4; ++jj) { v0[jj] = sigmoidf_(v0[jj] + ba[jj]) * 0.6065306597f; v1[jj] = sigmoidf_(v1[jj] + bb[jj]) * 0.6065306597f; }
                            *(u32x4*)((h16*)out + off) = pack8(v0, v1);
                        } else if (grp == 1) {
                            const f32x4 ba = *(const f32x4*)(bias1 + c), bb = *(const f32x4*)(bias1 + c + 4);
#pragma unroll
                            for (int jj = 0; jj < 4; ++jj) { v0[jj] = sigmoidf_(v0[jj] + ba[jj]); v1[jj] = sigmoidf_(v1[jj] + bb[jj]); }
                            *(u32x4*)((h16*)out + (size_t)MTOK * 1024 + off) = pack8(v0, v1);
                        } else {
                            *(u32x4*)((h16*)(ws + R_G16) + off) = pack8(v0, v1);
                        }
                    } else if (mode == E_ST16) {
                        *(u32x4*)((h16*)(ws + F_U16) + (size_t)rowl * 5632 + col) = pack8(v0, v1);
                    } else if (mode == E_ST32) {
                        float* dp = (float*)(ws + D_HIN) + (size_t)rowg * 512 + col;
                        *(f32x4*)dp = v0; *(f32x4*)(dp + 4) = v1;
                    } else {
                        if (u.pn < 8) *(u32x4*)((h16*)(ws + D_QABS) + (size_t)rowg * 2048 + col) = pack8(v0, v1);
                        else *(u32x4*)((h16*)(ws + D_QIDX) + (size_t)rowg * 512 + (col - 2048)) = pack8(v0, v1);
                    }
                }
            }
    }
};

__device__ __forceinline__ const char* a_tile(const Gemm& g, int pm, int pn) {
    if (g.amode == 1) { const int row = (pm + g.pm0) * BM; return (const char*)g.A + xrow(row) * 2048; }
    if (g.amode == 2) {
        const int gq = pn >> 2;
        const char* base = gq == 2 ? (const char*)g.A2 : (const char*)g.A + (size_t)gq * ((size_t)MTOK * 1024 * 2);
        return base + (size_t)pm * BM * 2048;
    }
    if (g.amode == 3) return (pm < 128 ? (const char*)g.A + (size_t)pm * BM * 4096 : (const char*)g.A2 + (size_t)(pm - 128) * BM * 4096);
    return (const char*)g.A + (size_t)pm * BM * g.lda * 2;
}

__device__ __forceinline__ void gemm_phase(LAS unsigned char* lds, const Gemm g, const StaticOrder& S, const Epi& E) {
    const int tid = opaque_tid(), wid = __builtin_amdgcn_readfirstlane(tid >> 6), lane = tid & 63, wr = wid >> 2, wc = wid & 3, fr = lane & 15, fq = lane >> 4;
    const int K = g.K, nt = K / BK;
    const bool shiftA = (g.amode == 1);
    unsigned voffA[2], voffB[2];
#pragma unroll
    for (int i = 0; i < 2; ++i) { int R, C; stage_rc(tid * 16 + i * 8192, R, C); const int Rb = (R & ~31) + perm32(R & 31);
        voffA[i] = (unsigned)(R * g.lda + C) * 2u; voffB[i] = (unsigned)(Rb * K + C) * 2u; }
    const size_t kstep = (size_t)(BK * 2);
    const size_t hstepA = (size_t)HALF * g.lda * 2;
    const size_t hstepB = (size_t)HALF * K * 2;
    const size_t tstepB = 2 * hstepB;
    const unsigned ldsw = (unsigned)wid * 1024u;
    const int aoff = lds_byte(wr * 64 + fr, fq * 8), boff = lds_byte(wc * 32 + fr, fq * 8);
#define PG8_KOFF(kt) ((size_t)(kt) * kstep - ((shiftA && (kt) >= 16) ? (size_t)4096 : (size_t)0))
#define PG8_SA(b, h) (((b) * 2 + (h)) * HTB)
#define PG8_SB(b, h) ((4 + (b) * 2 + (h)) * HTB)
#define PG8_STAGE(bufoff, gbase, voff) do { _Pragma("unroll") for (int _i = 0; _i < 2; ++_i) \
        __builtin_amdgcn_global_load_lds((const unsigned*)((const char*)(gbase) + (voff)[_i]), (LAS unsigned*)(lds + (bufoff) + ldsw + _i * 8192), 16, 0, 0); } while (0)
#define PG8_LDA(dst, b, h) do { _Pragma("unroll") for (int m = 0; m < 4; ++m) _Pragma("unroll") for (int k = 0; k < 2; ++k) dst[m][k] = *(const LAS h16x8*)(lds + PG8_SA(b, h) + aoff + m * 2048 + k * 1024); } while (0)
#define PG8_LDB(dst, b, h) do { _Pragma("unroll") for (int n = 0; n < 2; ++n) _Pragma("unroll") for (int k = 0; k < 2; ++k) dst[n][k] = *(const LAS h16x8*)(lds + PG8_SB(b, h) + boff + n * 2048 + k * 1024); } while (0)
#define PG8_MMA(ai, bj, At, Bt) do { __builtin_amdgcn_s_setprio(1); _Pragma("unroll") for (int m = 0; m < 4; ++m) _Pragma("unroll") for (int n = 0; n < 2; ++n) _Pragma("unroll") for (int k = 0; k < 2; ++k) \
        acc[ai][bj][m][n] = __builtin_amdgcn_mfma_f32_16x16x32_f16(Bt[n][k], At[m][k], acc[ai][bj][m][n], 0, 0, 0); __builtin_amdgcn_s_setprio(0); } while (0)
#define PG8_WAIT_V(n) asm volatile("s_waitcnt vmcnt(" #n ")" ::: "memory")
#define PG8_WAIT_L(n) asm volatile("s_waitcnt lgkmcnt(" #n ")" ::: "memory")
#define PG8_BAR __builtin_amdgcn_s_barrier()
#define PG8_SCHED __builtin_amdgcn_sched_barrier(0)
    Unit cur, nxt; int ui = 0;
    if (!S.next(0, cur)) return;
    f32x4 acc[2][2][4][2];
#pragma unroll
    for (int a = 0; a < 2; ++a)
#pragma unroll
        for (int b = 0; b < 2; ++b)
#pragma unroll
            for (int m = 0; m < 4; ++m)
#pragma unroll
                for (int n = 0; n < 2; ++n) acc[a][b][m][n] = (f32x4){0.f, 0.f, 0.f, 0.f};
    h16x8 At[4][2], B0[2][2], B1[2][2];
    const char* cA = a_tile(g, cur.pm, cur.pn); const char* cB = (const char*)g.Bt + (size_t)cur.pn * tstepB;
    PG8_STAGE(PG8_SB(0, 0), cB, voffB); PG8_STAGE(PG8_SA(0, 0), cA, voffA); PG8_STAGE(PG8_SB(0, 1), cB + hstepB, voffB); PG8_STAGE(PG8_SA(0, 1), cA + hstepA, voffA);
    if (wr == 1) PG8_BAR;
    PG8_WAIT_V(4); PG8_BAR;
    PG8_STAGE(PG8_SB(1, 0), cB + kstep, voffB); PG8_STAGE(PG8_SA(1, 0), cA + kstep, voffA); PG8_STAGE(PG8_SB(1, 1), cB + hstepB + kstep, voffB);
    PG8_WAIT_V(6); PG8_BAR;
    for (;;) {
        const bool has_next = S.next(ui + 1, nxt);
        const char* nA = has_next ? a_tile(g, nxt.pm, nxt.pn) : cA; const char* nB = has_next ? (const char*)g.Bt + (size_t)nxt.pn * tstepB : cB;
        for (int t = 0; t < nt; t += 2) {
            const bool last = (t == nt - 2);
            const char* a1 = cA + PG8_KOFF(t + 1);
            const char* a2 = last ? nA : cA + PG8_KOFF(t + 2); const char* b2 = last ? nB : cB + (size_t)(t + 2) * kstep;
            const char* a3 = a2 + kstep; const char* b3 = b2 + kstep;
            PG8_LDB(B0, 0, 0); PG8_SCHED; PG8_LDA(At, 0, 0); PG8_STAGE(PG8_SA(1, 1), a1 + hstepA, voffA);
            PG8_WAIT_L(8); PG8_BAR; PG8_WAIT_L(0); PG8_MMA(0, 0, At, B0); PG8_BAR; PG8_SCHED;
            PG8_LDB(B1, 0, 1); PG8_STAGE(PG8_SB(0, 0), b2, voffB);
            PG8_BAR; PG8_WAIT_L(0); PG8_MMA(0, 1, At, B1); PG8_BAR;
            PG8_LDA(At, 0, 1); PG8_STAGE(PG8_SA(0, 0), a2, voffA);
            PG8_BAR; PG8_WAIT_L(0); PG8_MMA(1, 0, At, B0); PG8_BAR; PG8_SCHED;
            PG8_STAGE(PG8_SB(0, 1), b2 + hstepB, voffB);
            PG8_WAIT_V(6); PG8_BAR; PG8_MMA(1, 1, At, B1); PG8_BAR;
            PG8_LDB(B0, 1, 0); PG8_SCHED; PG8_LDA(At, 1, 0); PG8_STAGE(PG8_SA(0, 1), a2 + hstepA, voffA);
            PG8_WAIT_L(8); PG8_BAR; PG8_WAIT_L(0); PG8_MMA(0, 0, At, B0); PG8_BAR; PG8_SCHED;
            PG8_LDB(B1, 1, 1); PG8_STAGE(PG8_SB(1, 0), b3, voffB);
            PG8_BAR; PG8_WAIT_L(0); PG8_MMA(0, 1, At, B1); PG8_BAR;
            PG8_LDA(At, 1, 1); PG8_STAGE(PG8_SA(1, 0), a3, voffA);
            PG8_BAR; PG8_WAIT_L(0); PG8_MMA(1, 0, At, B0); PG8_BAR; PG8_SCHED;
            PG8_STAGE(PG8_SB(1, 1), b3 + hstepB, voffB);
            PG8_WAIT_V(6); PG8_BAR; PG8_MMA(1, 1, At, B1); PG8_BAR;
        }
        E(acc, cur, wr, wc, fr, fq);
        if (!has_next) break;
#pragma unroll
        for (int a = 0; a < 2; ++a)
#pragma unroll
            for (int b = 0; b < 2; ++b)
#pragma unroll
                for (int m = 0; m < 4; ++m)
#pragma unroll
                    for (int n = 0; n < 2; ++n) acc[a][b][m][n] = (f32x4){0.f, 0.f, 0.f, 0.f};
        cur = nxt; cA = nA; cB = nB; ++ui;
    }
    PG8_WAIT_V(0);
    if (wr == 0) PG8_BAR;
    PG8_BAR;
#undef PG8_KOFF
#undef PG8_SA
#undef PG8_SB
#undef PG8_STAGE
#undef PG8_LDA
#undef PG8_LDB
#undef PG8_MMA
#undef PG8_WAIT_V
#undef PG8_WAIT_L
#undef PG8_BAR
#undef PG8_SCHED
}
}

struct TJob { int mode; const float* src; int ld, K, N; h16* dst; int ldd, koff; const float* mix; };

__device__ __forceinline__ TJob get_job(const Params& p, int id) {
    TJob J; J.mode = 0; J.src = nullptr; J.ld = 0; J.K = 0; J.N = 0; J.dst = nullptr; J.ldd = 64; J.koff = 0; J.mix = nullptr;
    h16* W = (h16*)(p.ws + OFF_W);
    if (id < 24) {
        const int j = id / 12, s = id % 12;
        h16* Wrkv = W + (size_t)j * (10 * MiB); h16* Wl1 = Wrkv + 3 * MiB; h16* Wl2 = Wrkv + 7 * MiB;
        const float* mix = p.in[3] + j * 6 * 1024;
        if (s < 3) { J.mode = 0; J.src = p.in[4] + (size_t)(j * 3 + s) * 1048576; J.ld = 1024; J.K = 1024; J.N = 1024; J.dst = Wrkv + (size_t)s * 1024 * 1024; J.ldd = 1024; }
        else if (s < 8) {
            J.mode = 1; J.ld = 1024; J.K = 1024; J.ldd = 2048;
            if (s == 3) { J.src = p.in[6] + (size_t)j * 65536; J.ld = 64; J.N = 64; J.dst = Wl1; J.mix = mix + 3 * 1024; }
            else if (s == 4) { J.src = p.in[9] + (size_t)j * 65536; J.ld = 64; J.N = 64; J.dst = Wl1 + (size_t)64 * 2048; J.mix = mix + 4 * 1024; }
            else if (s == 5) { J.N = 32; J.dst = Wl1 + (size_t)128 * 2048; if (j == 1) { J.src = p.in[12]; J.ld = 32; J.mix = mix + 2 * 1024; } else { J.mode = 2; } }
            else if (s == 6) { J.src = p.in[14] + (size_t)j * 163840; J.ld = 160; J.N = 160; J.dst = Wl1 + (size_t)160 * 2048; J.mix = mix + 5 * 1024; }
            else { J.mode = 2; J.N = 192; J.dst = Wl1 + (size_t)320 * 2048; }
        } else {
            J.mode = 0; J.ld = 1024; J.N = 1024; J.ldd = 384;
            if (s == 8) { J.src = p.in[7] + (size_t)j * 65536; J.K = 64; J.koff = 0; J.dst = Wl2; }
            else if (s == 9) { J.src = p.in[10] + (size_t)j * 65536; J.K = 64; J.koff = 64; J.dst = Wl2 + (size_t)1024 * 384; }
            else if (s == 10) { J.src = p.in[15] + (size_t)j * 163840; J.K = 160; J.koff = 160; J.dst = Wl2 + (size_t)2048 * 384; }
            else { J.src = p.in[13]; J.K = 32; J.koff = 128; J.dst = Wl2 + (size_t)3072 * 384; if (j == 0) J.N = 0; }
        }
    } else if (id < 26) {
        const int j = id - 24;
        J.src = p.in[21] + (size_t)j * 1048576; J.ld = 1024; J.K = 1024; J.N = 1024; J.dst = W + (size_t)j * (10 * MiB) + 9 * MiB; J.ldd = 1024;
    } else if (id < 34) {
        const int i = (id - 26) >> 1, s = (id - 26) & 1;
        h16* base = W + 20 * MiB + (size_t)i * (17 * MiB / 2);
        if (s == 0) { J.src = p.in[33] + (size_t)i * 1024 * 5632; J.ld = 5632; J.K = 1024; J.N = 5632; J.dst = base; J.ldd = 1024; }
        else { J.src = p.in[36] + (size_t)i * 2816 * 1024; J.ld = 1024; J.K = 2816; J.N = 1024; J.dst = base + (size_t)11 * MiB / 2; J.ldd = 2816; }
    } else {
        const int j = (id - 34) >> 2, s = (id - 34) & 3;
        h16* base = W + 54 * MiB + (size_t)j * (5 * MiB / 2);
        if (s == 0) { J.src = p.in[22] + (size_t)j * 1024 * 456; J.ld = 456; J.K = 1024; J.N = 456; J.dst = base; J.ldd = 1024; }
        else if (s == 1) { J.mode = 2; J.N = 56; J.dst = base + (size_t)456 * 1024; J.ldd = 1024; }
        else if (s == 2) { J.src = p.in[28] + (size_t)j * 256 * 512; J.ld = 512; J.K = 256; J.N = 512; J.dst = base + MiB / 2 + (size_t)2048 * 256; J.ldd = 256; }
        else { J.src = p.in[31] + (size_t)j * 1048576; J.ld = 1024; J.K = 1024; J.N = 1024; J.dst = base + 3 * MiB / 2; J.ldd = 1024; }
    }
    return J;
}
__device__ __forceinline__ h16* w_rwkv_big(unsigned char* ws, int j) { return (h16*)(ws + OFF_W) + (size_t)j * (10 * MiB); }
__device__ __forceinline__ h16* w_rwkv_l1(unsigned char* ws, int j) { return w_rwkv_big(ws, j) + 3 * MiB; }
__device__ __forceinline__ h16* w_rwkv_l2(unsigned char* ws, int j) { return w_rwkv_big(ws, j) + 7 * MiB; }
__device__ __forceinline__ h16* w_rwkv_o(unsigned char* ws, int j) { return w_rwkv_big(ws, j) + 9 * MiB; }
__device__ __forceinline__ h16* w_ffn_up(unsigned char* ws, int i) { return (h16*)(ws + OFF_W) + 20 * MiB + (size_t)i * (17 * MiB / 2); }
__device__ __forceinline__ h16* w_ffn_dn(unsigned char* ws, int i) { return w_ffn_up(ws, i) + (size_t)11 * MiB / 2; }
__device__ __forceinline__ h16* w_dsa_in(unsigned char* ws, int j) { return (h16*)(ws + OFF_W) + 54 * MiB + (size_t)j * (5 * MiB / 2); }
__device__ __forceinline__ h16* w_dsa_q(unsigned char* ws, int j) { return w_dsa_in(ws, j) + MiB / 2; }
__device__ __forceinline__ h16* w_dsa_uvt(unsigned char* ws, int j) { return w_dsa_in(ws, j) + 5 * MiB / 4; }
__device__ __forceinline__ h16* w_dsa_o(unsigned char* ws, int j) { return w_dsa_in(ws, j) + 3 * MiB / 2; }

__device__ __forceinline__ void prep_phase(const Params& p, unsigned char* smem) {
    const int tid = opaque_tid();
    const size_t gtid = (size_t)blockIdx.x * 512 + tid, nth = (size_t)gridDim.x * 512;
    h16* x16 = (h16*)(p.ws + OFF_X16);
    for (size_t idx = gtid; idx < (size_t)MTOK * 128; idx += nth) {
        const int row = (int)(idx >> 7), c8 = (int)(idx & 127) * 8;
        const float* sp = p.in[0] + (size_t)row * 1024 + c8;
        const f32x4 a = *(const f32x4*)sp, b = *(const f32x4*)(sp + 4);
        *(u32x4*)(x16 + xrow(row) * 1024 + c8) = pack8(a, b);
    }
    for (size_t idx = gtid; idx < (size_t)NBATCH * 128; idx += nth) {
        const int b = (int)(idx >> 7), c8 = (int)(idx & 127) * 8;
        unsigned z = 0u; asm volatile("" : "+v"(z));
        *(u32x4*)(x16 + (size_t)b * 2049 * 1024 + c8) = (u32x4){z, z, z, z};
    }
    for (size_t it = gtid; it < (size_t)2 * 16 * 2048; it += nth) {
        const int j = (int)(it >> 15), rem = (int)(it & 32767), qg = rem >> 11, n = rem & 2047, h = n >> 7, c = n & 127;
        const float* uq = p.in[25] + (size_t)j * 256 * 1024 + (size_t)(qg * 16) * 1024 + h * 64;
        const float* uk = p.in[26] + (size_t)j * 16 * 64 * 128 + (size_t)h * 64 * 128 + c;
        float acc[16];
#pragma unroll
        for (int i = 0; i < 16; ++i) acc[i] = 0.f;
        for (int d = 0; d < 64; ++d) {
            const float kv = uk[d * 128];
#pragma unroll
            for (int i = 0; i < 16; ++i) acc[i] += uq[i * 1024 + d] * kv;
        }
        const float sc = 0.18033688011112042f;
        h16* dst = w_dsa_q(p.ws, j) + (size_t)n * 256 + qg * 16;
        *(u32x4*)dst = pack8((f32x4){acc[0] * sc, acc[1] * sc, acc[2] * sc, acc[3] * sc}, (f32x4){acc[4] * sc, acc[5] * sc, acc[6] * sc, acc[7] * sc});
        *(u32x4*)(dst + 8) = pack8((f32x4){acc[8] * sc, acc[9] * sc, acc[10] * sc, acc[11] * sc}, (f32x4){acc[12] * sc, acc[13] * sc, acc[14] * sc, acc[15] * sc});
    }
    for (size_t it = gtid; it < (size_t)2 * 128 * 1024; it += nth) {
        const int j = (int)(it >> 17), rem = (int)(it & 131071), kg = rem >> 10, n = rem & 1023, h = kg >> 3, c0 = (kg & 7) * 16;
        const float* uv = p.in[27] + (size_t)((j * 16 + h) * 128 + c0) * 64;
        const float* wo = p.in[31] + (size_t)j * 1048576 + (size_t)(h * 64) * 1024 + n;
        float acc[16];
#pragma unroll
        for (int i = 0; i < 16; ++i) acc[i] = 0.f;
        for (int v = 0; v < 64; ++v) {
            const float wv = wo[(size_t)v * 1024];
#pragma unroll
            for (int i = 0; i < 16; ++i) acc[i] += uv[i * 64 + v] * wv;
        }
        h16* dst = (h16*)(p.ws + OFF_WOV) + (size_t)j * 2097152 + (size_t)n * 2048 + h * 128 + c0;
        *(u32x4*)dst = pack8((f32x4){acc[0], acc[1], acc[2], acc[3]}, (f32x4){acc[4], acc[5], acc[6], acc[7]});
        *(u32x4*)(dst + 8) = pack8((f32x4){acc[8], acc[9], acc[10], acc[11]}, (f32x4){acc[12], acc[13], acc[14], acc[15]});
    }
    float* tile = (float*)smem;
    for (int id = 0; id < 42; ++id) {
        const TJob J = get_job(p, id);
        const int tk = J.ldd >> 6, tn = (J.N + 63) >> 6, ntile = tk * tn;
        for (int tix = (int)((blockIdx.x + gridDim.x - (unsigned)(id * 37) % gridDim.x) % gridDim.x); tix < ntile; tix += gridDim.x) {
            const int k0 = (tix % tk) * 64, n0 = (tix / tk) * 64;
#pragma unroll
            for (int i = 0; i < 8; ++i) {
                const int k = i * 8 + (tid >> 6), n = tid & 63, kk = k0 + k, nn = n0 + n;
                float v = 0.f;
                if (nn < J.N && J.mode != 2) {
                    if (J.mode == 1) { const int ks = kk & 1023; const float mx = J.mix[ks]; v = J.src[(size_t)ks * J.ld + nn] * (kk < 1024 ? 1.0f - mx : mx); }
                    else if (kk >= J.koff && kk < J.koff + J.K) v = J.src[(size_t)(kk - J.koff) * J.ld + nn];
                }
                tile[k * 65 + n] = v;
            }
            __syncthreads();
#pragma unroll
            for (int i = 0; i < 8; ++i) {
                const int n = i * 8 + (tid >> 6), k = tid & 63, nn = n0 + n;
                if (nn < J.N) J.dst[(size_t)nn * J.ldd + k0 + k] = (h16)tile[k * 65 + n];
            }
            __syncthreads();
        }
    }
}

__device__ __forceinline__ void wave_sum4(float (&v)[4]) {
#pragma unroll
    for (int k = 0; k < 4; ++k) v[k] = wave_sum(v[k]);
}
__device__ __forceinline__ void ln_phase(const Params& p, const float* g, const float* b, bool final_out) {
    const int tid = opaque_tid();
    const int lane = tid & 63, wave = tid >> 6;
    float* tb = p.out;
    h16* x16 = (h16*)(p.ws + OFF_X16);
    if (!final_out) {
        float g0[8], g1[8], b0[8], b1[8];
#pragma unroll
        for (int hlf = 0; hlf < 2; ++hlf) {
            const f32x4 a = *(const f32x4*)(g + lane * 8 + hlf * 4), c = *(const f32x4*)(g + 512 + lane * 8 + hlf * 4);
            const f32x4 d = *(const f32x4*)(b + lane * 8 + hlf * 4), e = *(const f32x4*)(b + 512 + lane * 8 + hlf * 4);
#pragma unroll
            for (int i = 0; i < 4; ++i) { g0[hlf * 4 + i] = a[i]; g1[hlf * 4 + i] = c[i]; b0[hlf * 4 + i] = d[i]; b1[hlf * 4 + i] = e[i]; }
        }
        for (int rowb = (blockIdx.x * 8 + wave) * 8; rowb < MTOK; rowb += gridDim.x * 64) {
            u32x4 va[8], vb[8];
#pragma unroll
            for (int k = 0; k < 8; ++k) {
                const h16* hp = (const h16*)tb + (size_t)(rowb + k) * 1024 + lane * 8;
                va[k] = *(const u32x4*)hp; vb[k] = *(const u32x4*)(hp + 512);
            }
            float mu[8], rs[8];
#pragma unroll
            for (int k = 0; k < 8; ++k) {
                float xa[8], xb[8]; unpack8(va[k], xa); unpack8(vb[k], xb);
                float sk = 0.f;
#pragma unroll
                for (int i = 0; i < 8; ++i) sk += xa[i] + xb[i];
                mu[k] = sk;
            }
#pragma unroll
            for (int k = 0; k < 8; ++k) mu[k] = wave_sum(mu[k]) * (1.0f / 1024.0f);
#pragma unroll
            for (int k = 0; k < 8; ++k) {
                float xa[8], xb[8]; unpack8(va[k], xa); unpack8(vb[k], xb);
                float qk = 0.f;
#pragma unroll
                for (int i = 0; i < 8; ++i) { const float da = xa[i] - mu[k], db = xb[i] - mu[k]; qk += da * da + db * db; }
                rs[k] = qk;
            }
#pragma unroll
            for (int k = 0; k < 8; ++k) rs[k] = rsqrtf(wave_sum(rs[k]) * (1.0f / 1024.0f) + 1e-5f);
#pragma unroll
            for (int k = 0; k < 8; ++k) {
                float xa[8], xb[8]; unpack8(va[k], xa); unpack8(vb[k], xb);
                f32x4 y0, y1, y2, y3;
#pragma unroll
                for (int i = 0; i < 4; ++i) {
                    y0[i] = (xa[i] - mu[k]) * rs[k] * g0[i] + b0[i]; y1[i] = (xa[4 + i] - mu[k]) * rs[k] * g0[4 + i] + b0[4 + i];
                    y2[i] = (xb[i] - mu[k]) * rs[k] * g1[i] + b1[i]; y3[i] = (xb[4 + i] - mu[k]) * rs[k] * g1[4 + i] + b1[4 + i];
                }
                h16* op = x16 + xrow(rowb + k) * 1024 + lane * 8;
                *(u32x4*)op = pack8(y0, y1); *(u32x4*)(op + 512) = pack8(y2, y3);
            }
        }
        return;
    }
    f32x4 gg[4], bb[4];
#pragma unroll
    for (int i = 0; i < 4; ++i) { gg[i] = *(const f32x4*)(g + i * 256 + lane * 4); bb[i] = *(const f32x4*)(b + i * 256 + lane * 4); }
    for (int rowb = (blockIdx.x * 8 + wave) * 4; rowb < MTOK; rowb += gridDim.x * 32) {
        f32x4 v[4][4];
        float s[4];
#pragma unroll
        for (int k = 0; k < 4; ++k) {
            s[k] = 0.f;
            if (final_out) {
                const float* rp = tb + (size_t)(rowb + k) * 1024;
#pragma unroll
                for (int i = 0; i < 4; ++i) v[k][i] = *(const f32x4*)(rp + i * 256 + lane * 4);
            } else {
                const h16* hp = (const h16*)tb + (size_t)(rowb + k) * 1024;
#pragma unroll
                for (int i = 0; i < 4; ++i) { const h16x4 hv = *(const h16x4*)(hp + i * 256 + lane * 4); v[k][i] = (f32x4){(float)hv[0], (float)hv[1], (float)hv[2], (float)hv[3]}; }
            }
#pragma unroll
            for (int i = 0; i < 4; ++i) s[k] += (v[k][i][0] + v[k][i][1]) + (v[k][i][2] + v[k][i][3]);
        }
        wave_sum4(s);
        float q[4];
#pragma unroll
        for (int k = 0; k < 4; ++k) {
            s[k] *= (1.0f / 1024.0f); q[k] = 0.f;
#pragma unroll
            for (int i = 0; i < 4; ++i)
#pragma unroll
                for (int jj = 0; jj < 4; ++jj) { const float d = v[k][i][jj] - s[k]; q[k] += d * d; }
        }
        wave_sum4(q);
#pragma unroll
        for (int k = 0; k < 4; ++k) {
            const float rstd = rsqrtf(q[k] * (1.0f / 1024.0f) + 1e-5f);
            const int row = rowb + k;
#pragma unroll
            for (int i = 0; i < 4; ++i) {
                f32x4 y;
#pragma unroll
                for (int jj = 0; jj < 4; ++jj) y[jj] = (v[k][i][jj] - s[k]) * rstd * gg[i][jj] + bb[i][jj];
                if (final_out) *(f32x4*)(tb + (size_t)row * 1024 + i * 256 + lane * 4) = y;
                else { u32x2 w; w.x = pk2(y[0], y[1]); w.y = pk2(y[2], y[3]); *(u32x2*)(x16 + xrow(row) * 1024 + i * 256 + lane * 4) = w; }
            }
        }
    }
}

__device__ __forceinline__ void conv_phase(const Params& p, int layer) {
    const h16* u = (const h16*)(p.ws + F_U16);
    h16* act = (h16*)(p.ws + F_ACT);
    const float* cw = p.in[34] + (size_t)layer * 3 * 5632;
    const float* cb = p.in[35] + (size_t)layer * 5632;
    const size_t gtid = (size_t)blockIdx.x * 512 + opaque_tid(), nth = (size_t)gridDim.x * 512;
    const size_t ntask = (size_t)2048 * 352;
    for (size_t task = gtid; task < ntask; task += nth) {
        const int cgp = (int)(task % 352), rc = (int)(task / 352), f = cgp * 8, r0 = rc * 16;
        float wg[3][8], wv[3][8], bg[8], bv[8];
#pragma unroll
        for (int jj = 0; jj < 3; ++jj)
#pragma unroll
            for (int hlf = 0; hlf < 2; ++hlf) {
                const f32x4 a = *(const f32x4*)(cw + jj * 5632 + f + hlf * 4), c = *(const f32x4*)(cw + jj * 5632 + DFF + f + hlf * 4);
#pragma unroll
                for (int e = 0; e < 4; ++e) { wg[jj][hlf * 4 + e] = a[e]; wv[jj][hlf * 4 + e] = c[e]; }
            }
#pragma unroll
        for (int hlf = 0; hlf < 2; ++hlf) {
            const f32x4 a = *(const f32x4*)(cb + f + hlf * 4), c = *(const f32x4*)(cb + DFF + f + hlf * 4);
#pragma unroll
            for (int e = 0; e < 4; ++e) { bg[hlf * 4 + e] = a[e]; bv[hlf * 4 + e] = c[e]; }
        }
        float g2[8], g1[8], v2[8], v1[8];
#pragma unroll
        for (int e = 0; e < 8; ++e) { g2[e] = 0.f; g1[e] = 0.f; v2[e] = 0.f; v1[e] = 0.f; }
        if ((r0 & 2047) != 0) {
            unpack8(*(const u32x4*)(u + (size_t)(r0 - 2) * 5632 + f), g2); unpack8(*(const u32x4*)(u + (size_t)(r0 - 1) * 5632 + f), g1);
            unpack8(*(const u32x4*)(u + (size_t)(r0 - 2) * 5632 + DFF + f), v2); unpack8(*(const u32x4*)(u + (size_t)(r0 - 1) * 5632 + DFF + f), v1);
        }
#pragma unroll 1
        for (int i0 = 0; i0 < 16; i0 += 4) {
            u32x4 lg[4], lv[4];
#pragma unroll
            for (int i = 0; i < 4; ++i) { const size_t ro = (size_t)(r0 + i0 + i) * 5632; lg[i] = *(const u32x4*)(u + ro + f); lv[i] = *(const u32x4*)(u + ro + DFF + f); }
#pragma unroll
            for (int i = 0; i < 4; ++i) {
                float g0[8], v0[8], o[8];
                unpack8(lg[i], g0); unpack8(lv[i], v0);
#pragma unroll
                for (int e = 0; e < 8; ++e) {
                    const float G = wg[0][e] * g2[e] + wg[1][e] * g1[e] + wg[2][e] * g0[e] + bg[e];
                    const float V = wv[0][e] * v2[e] + wv[1][e] * v1[e] + wv[2][e] * v0[e] + bv[e];
                    o[e] = G * sigmoidf_(G) * V;
                    g2[e] = g1[e]; g1[e] = g0[e]; v2[e] = v1[e]; v1[e] = v0[e];
                }
                *(u32x4*)(act + (size_t)(r0 + i0 + i) * DFF + f) = pack8((f32x4){o[0], o[1], o[2], o[3]}, (f32x4){o[4], o[5], o[6], o[7]});
            }
        }
    }
}

__device__ __forceinline__ void mix_phase(const Params& p, int j) {
    const h16* x16 = (const h16*)(p.ws + OFF_X16);
    h16* xr = (h16*)p.out; h16* xk = (h16*)p.out + (size_t)MTOK * 1024; h16* xv = (h16*)(p.ws + R_G16);
    const float* mix = p.in[3] + j * 6 * 1024;
    const size_t gtid = (size_t)blockIdx.x * 512 + opaque_tid(), nth = (size_t)gridDim.x * 512;
    for (size_t idx = gtid; idx < (size_t)MTOK * 128; idx += nth) {
        const int row = (int)(idx >> 7), c8 = (int)(idx & 127) * 8;
        const h16* xp = x16 + xrow(row) * 1024 + c8;
        float xc[8], xq[8];
        unpack8(*(const u32x4*)xp, xc); unpack8(*(const u32x4*)(xp - 1024), xq);
#pragma unroll
        for (int e = 0; e < 8; ++e) xq[e] -= xc[e];
        const size_t o = (size_t)row * 1024 + c8;
#pragma unroll
        for (int bsel = 0; bsel < 3; ++bsel) {
            const f32x4 m0 = *(const f32x4*)(mix + bsel * 1024 + c8), m1 = *(const f32x4*)(mix + bsel * 1024 + c8 + 4);
            f32x4 a, b;
#pragma unroll
            for (int e = 0; e < 4; ++e) { a[e] = xc[e] + xq[e] * m0[e]; b[e] = xc[4 + e] + xq[4 + e] * m1[e]; }
            h16* dst = bsel == 0 ? xr : (bsel == 1 ? xk : xv);
            *(u32x4*)(dst + o) = pack8(a, b);
        }
    }
}

__device__ __forceinline__ void unpack4(u32x2 w, float* f) {
    h16x4 h = __builtin_bit_cast(h16x4, w);
#pragma unroll
    for (int i = 0; i < 4; ++i) f[i] = (float)h[i];
}
constexpr int SCAN_BUF = 8256;
__device__ __forceinline__ void scan_phase(const Params& p, int j, unsigned char* smem) {
    const int tid = opaque_tid();
    const int wave = tid >> 6, lane = tid & 63, slot = wave >> 2, w4 = wave & 3;
    float* LB = (float*)smem + slot * (2 * SCAN_BUF);
    const h16* r16 = (const h16*)(p.ws + R_R16);
    const h16* k16 = (const h16*)(p.ws + R_K16);
    const h16* v16 = (j == 0) ? (const h16*)(p.ws + OFF_VF) : (const h16*)(p.ws + R_V16);
    const h16* g16 = (const h16*)(p.ws + R_G16);
    const h16* e16 = (const h16*)p.out;
    const h16* a16 = (const h16*)p.out + (size_t)MTOK * 1024;
    h16* y16 = (h16*)(p.ws + (j == 0 ? R_V16 : OFF_VF));
    const int tp = w4 * 4 + (lane >> 4), k4 = (lane & 15) * 4;
    const int vrow = w4 * 16 + (lane >> 2), kq = lane & 3;
    for (int pair = blockIdx.x; pair < 256; pair += gridDim.x) {
        const int chain = pair * 2 + slot, b = chain >> 4, h = chain & 15;
        const int col = h * 64 + k4;
        const f32x4 c_kk = *(const f32x4*)(p.in[16] + j * 1024 + col), c_ka = *(const f32x4*)(p.in[17] + j * 1024 + col), c_rk = *(const f32x4*)(p.in[18] + j * 1024 + col);
        const f32x4 c_lg = *(const f32x4*)(p.in[19] + j * 1024 + col), c_lb = *(const f32x4*)(p.in[20] + j * 1024 + col);
        f32x2 S[8];
#pragma unroll
        for (int i = 0; i < 8; ++i) S[i] = (f32x2){0.f, 0.f};
        u32x2 pr[6];
        {
            const size_t go = ((size_t)(b * 2048 + tp)) * 1024 + col;
            pr[0] = *(const u32x2*)(r16 + go); pr[1] = *(const u32x2*)(k16 + go); pr[2] = *(const u32x2*)(v16 + go);
            pr[3] = *(const u32x2*)(e16 + go); pr[4] = *(const u32x2*)(a16 + go); pr[5] = *(const u32x2*)(g16 + go);
        }
        for (int ch = 0; ch < 128; ++ch) {
            float* BUF = LB + (ch & 1) * SCAN_BUF;
            float* OPS = BUF; float* VB = BUF + 5120; float* GB = BUF + 6144; float* YB = BUF + 7168; float* BON = BUF + 8192;
            {
                float rf[4], kf[4], vf[4], ef[4], af[4], gf[4];
                unpack4(pr[0], rf); unpack4(pr[1], kf); unpack4(pr[2], vf); unpack4(pr[3], ef); unpack4(pr[4], af); unpack4(pr[5], gf);
                float kk[4]; float ss = 0.f;
#pragma unroll
                for (int i = 0; i < 4; ++i) { kk[i] = kf[i] * c_kk[i]; ss += kk[i] * kk[i]; }
                ss = red16(ss);
                const float inv = 1.0f / fmaxf(sqrtf(ss), 1e-12f);
                f32x4 A4, B4, W4, K4, R4; float bs = 0.f;
#pragma unroll
                for (int i = 0; i < 4; ++i) {
                    const float kn = kk[i] * inv;
                    A4[i] = -kn; B4[i] = kn * af[i];
                    W4[i] = __expf(-ef[i]);
                    const float km = kf[i] * (1.0f + (af[i] - 1.0f) * c_ka[i]);
                    K4[i] = km; R4[i] = rf[i];
                    bs += rf[i] * km * c_rk[i];
                }
                bs = red16(bs);
                float* o = OPS + tp * 320 + k4;
                *(f32x4*)(o) = A4; *(f32x4*)(o + 64) = B4; *(f32x4*)(o + 128) = W4; *(f32x4*)(o + 192) = K4; *(f32x4*)(o + 256) = R4;
                *(f32x4*)(VB + tp * 64 + k4) = (f32x4){vf[0], vf[1], vf[2], vf[3]};
                *(f32x4*)(GB + tp * 64 + k4) = (f32x4){gf[0], gf[1], gf[2], gf[3]};
                if ((lane & 15) == 0) BON[tp] = bs;
            }
            if (ch + 1 < 128) {
                const size_t go = ((size_t)(b * 2048 + (ch + 1) * 16 + tp)) * 1024 + col;
                pr[0] = *(const u32x2*)(r16 + go); pr[1] = *(const u32x2*)(k16 + go); pr[2] = *(const u32x2*)(v16 + go);
                pr[3] = *(const u32x2*)(e16 + go); pr[4] = *(const u32x2*)(a16 + go); pr[5] = *(const u32x2*)(g16 + go);
            }
            __syncthreads();
#pragma unroll 2
            for (int t = 0; t < 16; ++t) {
                const float* op = OPS + t * 320 + kq * 16;
                f32x4 A4[4], B4[4], W4[4], K4[4], R4[4];
#pragma unroll
                for (int i = 0; i < 4; ++i) A4[i] = *(const f32x4*)(op + i * 4);
#pragma unroll
                for (int i = 0; i < 4; ++i) { W4[i] = *(const f32x4*)(op + 128 + i * 4); B4[i] = *(const f32x4*)(op + 64 + i * 4); K4[i] = *(const f32x4*)(op + 192 + i * 4); }
#pragma unroll
                for (int i = 0; i < 4; ++i) R4[i] = *(const f32x4*)(op + 256 + i * 4);
                const float vv = VB[t * 64 + vrow];
                f32x2 s0 = {0.f, 0.f}, s1 = {0.f, 0.f};
#pragma unroll
                for (int i = 0; i < 4; ++i) { s0 += S[2 * i] * (f32x2){A4[i][0], A4[i][1]}; s1 += S[2 * i + 1] * (f32x2){A4[i][2], A4[i][3]}; }
                const float sa = red4((s0[0] + s0[1]) + (s1[0] + s1[1]));
                const f32x2 sa2 = {sa, sa}, vv2 = {vv, vv};
#pragma unroll
                for (int i = 0; i < 4; ++i) {
                    S[2 * i] = S[2 * i] * (f32x2){W4[i][0], W4[i][1]} + sa2 * (f32x2){B4[i][0], B4[i][1]} + vv2 * (f32x2){K4[i][0], K4[i][1]};
                    S[2 * i + 1] = S[2 * i + 1] * (f32x2){W4[i][2], W4[i][3]} + sa2 * (f32x2){B4[i][2], B4[i][3]} + vv2 * (f32x2){K4[i][2], K4[i][3]};
                }
                f32x2 y0 = {0.f, 0.f}, y1 = {0.f, 0.f};
#pragma unroll
                for (int i = 0; i < 4; ++i) { y0 += S[2 * i] * (f32x2){R4[i][0], R4[i][1]}; y1 += S[2 * i + 1] * (f32x2){R4[i][2], R4[i][3]}; }
                const float y = red4((y0[0] + y0[1]) + (y1[0] + y1[1]));
                if (kq == 0) YB[t * 64 + vrow] = y;
            }
            __syncthreads();
            {
                const f32x4 y4 = *(const f32x4*)(YB + tp * 64 + k4), v4 = *(const f32x4*)(VB + tp * 64 + k4), g4 = *(const f32x4*)(GB + tp * 64 + k4);
                const float mu = red16((y4[0] + y4[1]) + (y4[2] + y4[3])) * (1.0f / 64.0f);
                float q = 0.f;
#pragma unroll
                for (int i = 0; i < 4; ++i) { const float d = y4[i] - mu; q += d * d; }
                const float rstd = rsqrtf(red16(q) * (1.0f / 64.0f) + 64e-5f);
                const float bon = BON[tp];
                float o[4];
#pragma unroll
                for (int i = 0; i < 4; ++i) o[i] = ((y4[i] - mu) * rstd * c_lg[i] + c_lb[i] + bon * v4[i]) * g4[i];
                u32x2 w; w.x = pk2(o[0], o[1]); w.y = pk2(o[2], o[3]);
                *(u32x2*)(y16 + ((size_t)(b * 2048 + ch * 16 + tp)) * 1024 + col) = w;
            }
        }
        __syncthreads();
    }
}

__device__ __forceinline__ void dsa_norm_phase(const Params& p, int j, unsigned char* smem) {
    const int tid = opaque_tid();
    const int lane = tid & 63, wave = tid >> 6;
    const float* hin = (const float*)(p.ws + D_HIN);
    h16* cq = (h16*)(p.ws + D_CQ); h16* ckv = (h16*)(p.ws + D_CKV); h16* ckvt = (h16*)(p.ws + D_CKVT); h16* kidx = (h16*)(p.ws + D_KIDX);
    float* widx = (float*)(p.ws + D_WIDX);
    const f32x4 gq = *(const f32x4*)(p.in[23] + j * 256 + lane * 4);
    const f32x2 gkv = *(const f32x2*)(p.in[24] + j * 128 + lane * 2);
    const float gi = p.in[29][j * 64 + lane], bi = p.in[30][j * 64 + lane];
    h16* wl = (h16*)(smem + wave * 2048);
    for (int grp = blockIdx.x * 8 + wave; grp < MTOK / 8; grp += gridDim.x * 8) {
        const int r0 = grp * 8;
        for (int i = 0; i < 8; ++i) {
            const int row = r0 + i;
            const float* hp = hin + (size_t)row * 512;
            const f32x4 vq = *(const f32x4*)(hp + lane * 4);
            const f32x2 vk = *(const f32x2*)(hp + 256 + lane * 2);
            const float vi = hp[384 + lane];
            float ssq = wave_sum(vq[0] * vq[0] + vq[1] * vq[1] + vq[2] * vq[2] + vq[3] * vq[3]);
            const float rq = rsqrtf(ssq * (1.0f / 256.0f) + 1e-6f);
            u32x2 w; w.x = pk2(vq[0] * rq * gq[0], vq[1] * rq * gq[1]); w.y = pk2(vq[2] * rq * gq[2], vq[3] * rq * gq[3]);
            *(u32x2*)(cq + (size_t)row * 256 + lane * 4) = w;
            float ssk = wave_sum(vk[0] * vk[0] + vk[1] * vk[1]);
            const float rk = rsqrtf(ssk * (1.0f / 128.0f) + 1e-6f);
            const unsigned wk = pk2(vk[0] * rk * gkv[0], vk[1] * rk * gkv[1]);
            *(unsigned*)(ckv + (size_t)row * 128 + lane * 2) = wk;
            const float mu = wave_sum(vi) * (1.0f / 64.0f);
            const float dv = vi - mu;
            const float var = wave_sum(dv * dv) * (1.0f / 64.0f);
            kidx[(size_t)row * 64 + lane] = (h16)(dv * rsqrtf(var + 1e-5f) * gi + bi);
            if (lane < 8) widx[(size_t)row * 8 + lane] = hp[448 + lane] * 0.044194173824159216f;
        }
    }
}

constexpr int ROWP = 2052;
__device__ __forceinline__ unsigned fkey(float x) {
    if (x == 0.0f) x = 0.0f;
    const unsigned u = __float_as_uint(x);
    return (u & 0x80000000u) ? ~u : (u | 0x80000000u);
}
__device__ __forceinline__ void dsa_index_phase(const Params& p, unsigned char* smem) {
    const int tid = opaque_tid(), wave = tid >> 6, lane = tid & 63, r = lane & 15, q = lane >> 4;
    float* SC = (float*)smem;
    const h16* qidx = (const h16*)(p.ws + D_QIDX);
    const h16* kidx = (const h16*)(p.ws + D_KIDX);
    const float* widx = (const float*)(p.ws + D_WIDX);
    unsigned short* selout = (unsigned short*)(p.ws + D_MASK);
    h16x8 qf[8][2]; float wq[8];
    if ((int)blockIdx.x < MTOK / 16) {
        const int row0 = (int)blockIdx.x * 16;
#pragma unroll
        for (int h = 0; h < 8; ++h) {
#pragma unroll
            for (int kk = 0; kk < 2; ++kk) qf[h][kk] = *(const h16x8*)(qidx + (size_t)(row0 + r) * 512 + h * 64 + kk * 32 + q * 8);
            wq[h] = widx[(size_t)(row0 + r) * 8 + h];
        }
    }
    for (int qi = blockIdx.x, it = 0; qi < MTOK / 16; qi += gridDim.x, ++it) {
        const int qt = (it & 1) ? ((qi & ~127) | (127 - (qi & 127))) : qi;
        const int row0 = qt * 16, b = row0 >> 11, t0 = row0 & 2047;
        const int nkt = (t0 >> 4) + 1;
        {
            h16x8 kn[4];
            if (wave < nkt) {
                const bool two = (wave + 8 < nkt);
                const int s0 = wave * 16, s1 = two ? s0 + 128 : s0;
                const h16* kp = kidx + (size_t)(b * 2048 + s0 + r) * 64 + q * 8;
                const h16* kp1 = kidx + (size_t)(b * 2048 + s1 + r) * 64 + q * 8;
                kn[0] = *(const h16x8*)kp; kn[1] = *(const h16x8*)(kp + 32); kn[2] = *(const h16x8*)kp1; kn[3] = *(const h16x8*)(kp1 + 32);
            }
            for (int kt = wave; kt < nkt; kt += 16) {
                const bool two = (kt + 8 < nkt);
                const int s0 = kt * 16, s1 = two ? s0 + 128 : s0;
                const h16x8 k0 = kn[0], k1 = kn[1], k2 = kn[2], k3 = kn[3];
                if (kt + 16 < nkt) {
                    const bool two2 = (kt + 24 < nkt);
                    const int n0 = (kt + 16) * 16, n1 = two2 ? n0 + 128 : n0;
                    const h16* kp = kidx + (size_t)(b * 2048 + n0 + r) * 64 + q * 8;
                    const h16* kp1 = kidx + (size_t)(b * 2048 + n1 + r) * 64 + q * 8;
                    kn[0] = *(const h16x8*)kp; kn[1] = *(const h16x8*)(kp + 32); kn[2] = *(const h16x8*)kp1; kn[3] = *(const h16x8*)(kp1 + 32);
                }
                f32x4 sc = {0.f, 0.f, 0.f, 0.f}, sd = {0.f, 0.f, 0.f, 0.f};
#pragma unroll
                for (int h = 0; h < 8; ++h) {
                    f32x4 acc = {0.f, 0.f, 0.f, 0.f}, acd = {0.f, 0.f, 0.f, 0.f};
                    acc = __builtin_amdgcn_mfma_f32_16x16x32_f16(k0, qf[h][0], acc, 0, 0, 0);
                    acd = __builtin_amdgcn_mfma_f32_16x16x32_f16(k2, qf[h][0], acd, 0, 0, 0);
                    acc = __builtin_amdgcn_mfma_f32_16x16x32_f16(k1, qf[h][1], acc, 0, 0, 0);
                    acd = __builtin_amdgcn_mfma_f32_16x16x32_f16(k3, qf[h][1], acd, 0, 0, 0);
#pragma unroll
                    for (int jj = 0; jj < 4; ++jj) { sc[jj] += fmaxf(acc[jj], 0.f) * wq[h]; sd[jj] += fmaxf(acd[jj], 0.f) * wq[h]; }
                }
                *(f32x4*)(SC + r * ROWP + s0 + q * 4) = sc;
                if (two) *(f32x4*)(SC + r * ROWP + s1 + q * 4) = sd;
            }
            const int qin = qi + (int)gridDim.x;
            if (qin < MTOK / 16) {
                const int qtn = ((it + 1) & 1) ? ((qin & ~127) | (127 - (qin & 127))) : qin;
                const int rown = qtn * 16;
#pragma unroll
                for (int h = 0; h < 8; ++h) {
#pragma unroll
                    for (int kk = 0; kk < 2; ++kk) qf[h][kk] = *(const h16x8*)(qidx + (size_t)(rown + r) * 512 + h * 64 + kk * 32 + q * 8);
                    wq[h] = widx[(size_t)(rown + r) * 8 + h];
                }
            }
        }
        __syncthreads();
        for (int qq = 0; qq < 2; ++qq) {
            const int ql = wave * 2 + qq, t = t0 + ql;
            const float* srow = SC + ql * ROWP;
            const int ni = (t >> 6) + 1;
            unsigned u[32];
#pragma unroll
            for (int i = 0; i < 32; ++i) {
                u[i] = 0u;
                if (i < ni) { const int s = i * 64 + lane; if (s <= t) u[i] = fkey(srow[s]); }
            }
            unsigned short* selrow = selout + (size_t)(row0 + ql) * 256;
            if (t < 256) {
#pragma unroll
                for (int i = 0; i < 4; ++i) { const int pp = i * 64 + lane; selrow[pp] = (unsigned short)(pp <= t ? pp : 0xFFFF); }
            } else {
                unsigned* H = (unsigned*)(smem + 16 * ROWP * 4) + wave * 256;
                unsigned prefix = 0u; int need = 256;
#pragma unroll 1
                for (int pass = 0; pass < 4; ++pass) {
                    const int shift = 24 - 8 * pass;
                    const unsigned hmask = pass == 0 ? 0u : (0xFFFFFFFFu << (shift + 8));
                    *(u32x4*)(H + lane * 4) = (u32x4){0u, 0u, 0u, 0u};
                    asm volatile("s_waitcnt lgkmcnt(0)" ::: "memory");
#pragma unroll
                    for (int i = 0; i < 32; ++i) if (i < ni) { const unsigned uu = u[i]; if (uu != 0u && (uu & hmask) == prefix) atomicAdd(H + ((uu >> shift) & 255u), 1u); }
                    asm volatile("s_waitcnt lgkmcnt(0)" ::: "memory");
                    const u32x4 hv = *(const u32x4*)(H + lane * 4);
                    const int tot = (int)(hv.x + hv.y + hv.z + hv.w);
                    int rs = tot;
                    rs += __builtin_amdgcn_update_dpp(0, rs, 0xB1, 0xF, 0xF, true);
                    rs += __builtin_amdgcn_update_dpp(0, rs, 0x4E, 0xF, 0xF, true);
                    rs += __builtin_amdgcn_update_dpp(0, rs, 0x141, 0xF, 0xF, true);
                    rs += __builtin_amdgcn_update_dpp(0, rs, 0x140, 0xF, 0xF, true);
                    int rowsel = 3, above = 0;
                    {
                        const int r3 = __builtin_amdgcn_readlane(rs, 48), r2 = __builtin_amdgcn_readlane(rs, 32), r1 = __builtin_amdgcn_readlane(rs, 16);
                        if (need > r3) { above = r3; rowsel = 2; if (need > above + r2) { above += r2; rowsel = 1; if (need > above + r1) { above += r1; rowsel = 0; } } }
                    }
                    int lsel = rowsel * 16;
                    for (int k = 15; k >= 0; --k) {
                        const int cl = __builtin_amdgcn_readlane(tot, rowsel * 16 + k);
                        if (need <= above + cl) { lsel = rowsel * 16 + k; break; }
                        above += cl;
                    }
                    const int b3 = __builtin_amdgcn_readlane((int)hv.w, lsel), b2 = __builtin_amdgcn_readlane((int)hv.z, lsel), b1 = __builtin_amdgcn_readlane((int)hv.y, lsel);
                    int bsel = 3;
                    if (need > above + b3) { above += b3; bsel = 2; if (need > above + b2) { above += b2; bsel = 1; if (need > above + b1) { above += b1; bsel = 0; } } }
                    prefix |= (unsigned)(lsel * 4 + bsel) << shift;
                    need -= above;
                }
                const unsigned T = prefix;
                int running = 0, outpos = 0;
                const unsigned long long lt = (lane == 0) ? 0ull : (~0ull >> (64 - lane));
#pragma unroll
                for (int i = 0; i < 32; ++i) {
                    if (i < ni) {
                        const unsigned long long eq = __ballot(u[i] == T);
                        const int rank = running + __popcll(eq & lt);
                        const bool sel = u[i] > T || (u[i] == T && rank < need);
                        const unsigned long long sm = __ballot(sel);
                        running += __popcll(eq);
                        if (sel) selrow[outpos + __popcll(sm & lt)] = (unsigned short)(i * 64 + lane);
                        outpos += __popcll(sm);
                    }
                }
            }
        }
        __syncthreads();
    }
}

typedef __fp16 fp16x4_t __attribute__((__vector_size__(4 * sizeof(__fp16))));
__device__ __forceinline__ unsigned off_b(unsigned row, unsigned ch) { return 256u * row + 16u * (ch ^ (((row & 3) << 2) | ((row >> 2) & 3))); }
constexpr int SA_TILE = 8192, SA_BL = 8 * 2 * SA_TILE;
static_assert(SA_BL + 16 * 132 * 4 <= LDS_BYTES, "sparse attention LDS");
__device__ __forceinline__ void dsa_attn_phase(const Params& p, int j, unsigned char* smem) {
    const int tid = opaque_tid(), wave = tid >> 6, lane = tid & 63, r = lane & 15, q = lane >> 4;
    float* BL = (float*)(smem + SA_BL);
    for (int idx = tid; idx < 16 * 129; idx += 512) {
        const int h = idx / 129, d = idx % 129;
        int bk = d;
        if (d >= 16) { bk = 16 + (int)(logf((float)d * (1.0f / 16.0f)) / 2.0794415416798357f * 16.0f); bk = bk > 31 ? 31 : bk; }
        BL[h * 132 + d] = p.in[32][bk * 16 + h] * 1.4426950408889634f;
    }
    __syncthreads();
    const h16* qabs = (const h16*)(p.ws + D_QABS);
    const h16* ckv = (const h16*)(p.ws + D_CKV);
    const unsigned short* sel = (const unsigned short*)(p.ws + D_MASK);
    h16* olatA = (h16*)(p.ws + D_HIN);
    h16* olatB = (h16*)p.out + (size_t)MTOK * 1024;
    unsigned char* tile0 = smem + wave * (2 * SA_TILE);
    const float NINF = -__builtin_inff();
    unsigned wofs[8], kofs[2][4], vofs[8][2];
#pragma unroll
    for (int i = 0; i < 8; ++i) wofs[i] = off_b(8 * q + i, r);
#pragma unroll
    for (int tt = 0; tt < 2; ++tt)
#pragma unroll
        for (int kk = 0; kk < 4; ++kk) kofs[tt][kk] = off_b(8 * (r >> 2) + 4 * tt + (r & 3), 4 * kk + q);
#pragma unroll
    for (int c = 0; c < 8; ++c)
#pragma unroll
        for (int t2 = 0; t2 < 2; ++t2) vofs[c][t2] = off_b(8 * q + 4 * t2 + (r >> 2), 2 * c + ((lane & 3) >> 1)) + 8 * (lane & 1);
    for (int row = blockIdx.x * 8 + wave; row < MTOK; row += gridDim.x * 8) {
        const int b = row >> 11, t = row & 2047;
        const int nvalid = t + 1 < 256 ? t + 1 : 256, ng = (nvalid + 31) >> 5;
        const h16* kg = ckv + (size_t)(b * 2048) * 128;
        const unsigned short* srow = sel + (size_t)row * 256;
        h16x8 qf[4];
#pragma unroll
        for (int kk = 0; kk < 4; ++kk) qf[kk] = *(const h16x8*)(qabs + (size_t)row * 2048 + r * 128 + kk * 32 + q * 8);
        f32x4 O[8];
#pragma unroll
        for (int dt = 0; dt < 8; ++dt) O[dt] = (f32x4){0.f, 0.f, 0.f, 0.f};
        float mrun = NINF, lrun = 0.f;
        u32x4 selA = *(const u32x4*)(srow + 8 * q), selB = selA;
        u32x4 grA[8], grB[8];
#define SA_GATHER(GR, SELV) do { _Pragma("unroll") for (int i = 0; i < 8; ++i) { \
            unsigned sidx = ((SELV)[i >> 1] >> ((i & 1) * 16)) & 0xFFFFu; sidx = sidx == 0xFFFFu ? 0u : sidx; \
            (GR)[i] = *(const u32x4*)(kg + (size_t)sidx * 128 + r * 8); } } while (0)
#define SA_GROUP(GR, SELV, G) do { \
            unsigned char* tile = tile0 + ((G) & 1) * SA_TILE; \
            const u32x4 selc = (SELV); \
            _Pragma("unroll") for (int i = 0; i < 8; ++i) *(u32x4*)(tile + wofs[i]) = (GR)[i]; \
            if ((G) + 2 < ng) { (SELV) = *(const u32x4*)(srow + ((G) + 2) * 32 + 8 * q); SA_GATHER(GR, SELV); } \
            asm volatile("s_waitcnt lgkmcnt(0)" ::: "memory"); \
            f32x4 sc[2]; \
            _Pragma("unroll") for (int tt = 0; tt < 2; ++tt) { \
                f32x4 acc = {0.f, 0.f, 0.f, 0.f}; \
                _Pragma("unroll") for (int kk = 0; kk < 4; ++kk) { \
                    const h16x8 kf = *(const h16x8*)(tile + kofs[tt][kk]); \
                    acc = __builtin_amdgcn_mfma_f32_16x16x32_f16(kf, qf[kk], acc, 0, 0, 0); } \
                sc[tt] = acc; } \
            float x[8]; float mx = NINF; \
            _Pragma("unroll") for (int i = 0; i < 8; ++i) { \
                const unsigned sidx = (selc[i >> 1] >> ((i & 1) * 16)) & 0xFFFFu; \
                int dist = t - (int)sidx; dist = dist < 0 ? 0 : (dist > 128 ? 128 : dist); \
                const float v = sc[i >> 2][i & 3] + BL[r * 132 + dist]; \
                const float xv = (sidx != 0xFFFFu) ? v : NINF; \
                x[i] = xv; mx = fmaxf(mx, xv); } \
            mx = xmax_16_32(mx); \
            const float mnew = fmaxf(mrun, mx); \
            const float mref = (mnew == NINF) ? 0.f : mnew; \
            const float alpha = __builtin_amdgcn_exp2f(mrun - mref); \
            mrun = mnew; \
            float ps = 0.f; h16x8 pf; \
            _Pragma("unroll") for (int i = 0; i < 8; ++i) { const float pv = __builtin_amdgcn_exp2f(x[i] - mref); ps += pv; pf[i] = (h16)pv; } \
            lrun = lrun * alpha + ps; \
            _Pragma("unroll") for (int dt = 0; dt < 8; ++dt) { \
                const fp16x4_t lo = __builtin_amdgcn_ds_read_tr16_b64_v4f16((LAS fp16x4_t*)(tile + vofs[dt][0])); \
                const fp16x4_t hi = __builtin_amdgcn_ds_read_tr16_b64_v4f16((LAS fp16x4_t*)(tile + vofs[dt][1])); \
                const h16x4 l4 = __builtin_bit_cast(h16x4, lo), h4 = __builtin_bit_cast(h16x4, hi); \
                const h16x8 vf = {l4[0], l4[1], l4[2], l4[3], h4[0], h4[1], h4[2], h4[3]}; \
                O[dt] *= alpha; \
                O[dt] = __builtin_amdgcn_mfma_f32_16x16x32_f16(vf, pf, O[dt], 0, 0, 0); } \
        } while (0)
        SA_GATHER(grA, selA);
        if (ng > 1) { selB = *(const u32x4*)(srow + 32 + 8 * q); SA_GATHER(grB, selB); }
        for (int g = 0; g < ng; g += 2) {
            SA_GROUP(grA, selA, g);
            if (g + 1 < ng) SA_GROUP(grB, selB, g + 1);
        }
#undef SA_GATHER
#undef SA_GROUP
        const float inv = 1.0f / xsum_16_32(lrun);
        h16* op = (row < MTOK / 2 ? olatA + (size_t)row * 2048 : olatB + (size_t)(row - MTOK / 2) * 2048) + r * 128 + q * 4;
#pragma unroll
        for (int dt = 0; dt < 8; ++dt) {
            u32x2 w; w.x = pk2(O[dt][0] * inv, O[dt][1] * inv); w.y = pk2(O[dt][2] * inv, O[dt][3] * inv);
            *(u32x2*)(op + dt * 16) = w;
        }
        asm volatile("s_waitcnt lgkmcnt(0)" ::: "memory");
    }
    __syncthreads();
}

constexpr size_t OFF_BAR = 951 * MiB;
#define XB_TMO      128
#define XB_XCNT(j)  (256  + 64 * (j))
#define XB_XSUB(j)  (1280 + 64 * (j))
#define XB_XGEN(j)  (2304 + 64 * (j))
#define XB_TOP      3328
#define XB_TOPGEN   3392
#define XCD_BAR_WORDS 3456
#define XB_SPIN_CAP (1u << 22)
__device__ __forceinline__ unsigned xb_ld(unsigned* p)              { return __hip_atomic_load(p, __ATOMIC_RELAXED, __HIP_MEMORY_SCOPE_AGENT); }
__device__ __forceinline__ unsigned xb_add(unsigned* p, unsigned v) { return __hip_atomic_fetch_add(p, v, __ATOMIC_RELAXED, __HIP_MEMORY_SCOPE_AGENT); }
__device__ __forceinline__ unsigned xb_xcc_id() { return (unsigned)__builtin_amdgcn_s_getreg((3 << 11) | 20) & 0xFu; }
#define XB_SPIN(cond, bar) do { unsigned _sp = 0; while (cond) { __builtin_amdgcn_s_sleep(1); \
    if ((++_sp & 255u) == 0u) { if (xb_ld(&(bar)[XB_TMO])) break; if (_sp > XB_SPIN_CAP) { atomicAdd(&(bar)[XB_TMO], 1u); break; } } } } while (0)
struct XcdBarrier { unsigned* bar; unsigned x; volatile LAS unsigned* st; };
__device__ __forceinline__ XcdBarrier xcd_barrier_post(unsigned* bar, volatile LAS unsigned* st) {
    XcdBarrier b; b.bar = bar; b.x = xb_xcc_id(); b.st = st;
    if (threadIdx.x == 0) (void)xb_add(&bar[XB_XCNT(b.x)], 1u);
    return b;
}
__device__ __forceinline__ void xcd_barrier_complete(unsigned* bar, unsigned x, unsigned& nloc, unsigned& nx) {
    const unsigned G = gridDim.x * gridDim.y * gridDim.z;
    unsigned sum, cnt, mine, sp = 0u;
    for (;;) {
        sum = 0u; cnt = 0u; mine = 0u;
#pragma unroll
        for (unsigned jx = 0; jx < 16; ++jx) { const unsigned c = xb_ld(&bar[XB_XCNT(jx)]); sum += c; cnt += (c > 0u) ? 1u : 0u; mine = (jx == x) ? c : mine; }
        if (sum == G) break;
        __builtin_amdgcn_s_sleep(1);
        if ((++sp & 255u) == 0u) { if (xb_ld(&bar[XB_TMO])) break; if (sp > XB_SPIN_CAP) { atomicAdd(&bar[XB_TMO], 1u); break; } }
    }
    nloc = mine > 0u ? mine : 1u; nx = cnt > 0u ? cnt : 1u;
}
__device__ __forceinline__ void xcd_barrier(const XcdBarrier& b) {
    asm volatile("s_waitcnt vmcnt(0)" ::: "memory");
    __syncthreads();
    if (threadIdx.x == 0) {
        unsigned* bar = b.bar;
        __builtin_amdgcn_s_waitcnt(0);
        unsigned nloc = b.st[0], nx = b.st[1];
        if (nloc == 0u) { xcd_barrier_complete(bar, b.x, nloc, nx); b.st[0] = nloc; b.st[1] = nx; }
        const unsigned old = xb_add(&bar[XB_XSUB(b.x)], 1u);
        const unsigned gen = old / nloc;
        if (old + 1u == (gen + 1u) * nloc) {
            __builtin_amdgcn_fence(__ATOMIC_RELEASE, "agent");
            asm volatile("s_waitcnt vmcnt(0)" ::: "memory");
            const unsigned og = xb_add(&bar[XB_TOP], 1u);
            const unsigned tg = og / nx;
            if (og + 1u == (tg + 1u) * nx) xb_add(&bar[XB_TOPGEN], 1u);
            else XB_SPIN(xb_ld(&bar[XB_TOPGEN]) == tg, bar);
            __builtin_amdgcn_fence(__ATOMIC_ACQUIRE, "agent");
            xb_add(&bar[XB_XGEN(b.x)], 1u);
            asm volatile("s_waitcnt vmcnt(0)" ::: "memory");
        } else {
            XB_SPIN(xb_ld(&bar[XB_XGEN(b.x)]) == gen, bar);
            __builtin_amdgcn_fence(__ATOMIC_ACQUIRE, "agent");
            asm volatile("s_waitcnt vmcnt(0)" ::: "memory");
        }
    }
    __syncthreads();
}

__global__ void __launch_bounds__(512) mega_fwd(Params p) {
    extern __shared__ __attribute__((aligned(16))) unsigned char smem[];
    cg::grid_group grid = cg::this_grid();
    unsigned char* ws = p.ws;
    h16* x16 = (h16*)(ws + OFF_X16);
    volatile LAS unsigned* xbst = (volatile LAS unsigned*)(smem + LDS_BYTES - 16);
    if (threadIdx.x == 0) { xbst[0] = 0u; xbst[1] = 0u; }
    __syncthreads();
    const XcdBarrier xbar = xcd_barrier_post((unsigned*)(ws + OFF_BAR), xbst);
    for (int ph = p.ph_lo; ph < p.ph_hi; ++ph) {
        const unsigned e = p.prog[ph];
        const int kind = e & 15, L = (e >> 4) & 3, sub = (e >> 6) & 1, j = L >> 1;
        const int nrep = 1 + (int)(e >> 7);
        for (int rep = 0; rep < nrep; ++rep) {
        if (rep) xcd_barrier(xbar);
        const bool isgemm = (kind == K_R1 || kind == K_R2 || kind == K_R4 || kind == K_F1 || kind == K_F3 || kind == K_D1 || kind == K_D3 || kind == K_D6);
        if (isgemm) {
            const int ngemm = (kind == K_R1) ? 2 : 1;
            for (int gi = 0; gi < ngemm; ++gi) {
            pg8::Gemm g; pg8::Epi E;
            g.M = MTOK; g.N = 1024; g.K = 1024; g.lda = 1024; g.amode = 0; g.pm0 = 0; g.A = x16; g.A2 = x16; g.Bt = x16;
            E.mode = E_RESID; E.pm0 = 0; E.j = j; E.pnoff = 0; E.fin = (L == 3 && kind == K_F3) ? 1 : 0; E.ws = ws; E.out = p.out; E.bias0 = p.in[5] + j * 1024; E.bias1 = p.in[8] + j * 1024; E.bias2 = p.in[11];
            if (kind == K_R1) {
                E.mode = E_RPROJ;
                if (gi == 0) { g.A = (const h16*)p.out; g.A2 = (const h16*)(ws + R_G16); g.Bt = w_rwkv_big(ws, j); g.N = 3072; g.amode = 2; }
                else { g.Bt = w_rwkv_l1(ws, j); g.N = 512; g.K = 2048; g.amode = 1; E.pnoff = 12; }
            } else if (kind == K_R2) {
                g.A = (const h16*)(ws + R_HACT); g.Bt = w_rwkv_l2(ws, j); g.N = (j == 0) ? 3072 : 4096; g.K = 384; g.lda = 384; E.mode = E_LORA2;
            } else if (kind == K_R4) {
                g.A = (const h16*)(ws + (j == 0 ? R_V16 : OFF_VF)); g.Bt = w_rwkv_o(ws, j);
            } else if (kind == K_F1) {
                g.Bt = w_ffn_up(ws, L); g.M = MTOK / 2; g.N = 5632; g.amode = 1; g.pm0 = sub * 128; E.mode = E_ST16;
            } else if (kind == K_F3) {
                g.A = (const h16*)(ws + F_ACT); g.Bt = w_ffn_dn(ws, L); g.M = MTOK / 2; g.K = 2816; g.lda = 2816; E.pm0 = sub * 128;
            } else if (kind == K_D1) {
                g.Bt = w_dsa_in(ws, j); g.N = 512; g.amode = 1; E.mode = E_ST32;
            } else if (kind == K_D3) {
                g.A = (const h16*)(ws + D_CQ); g.Bt = w_dsa_q(ws, j); g.N = 2560; g.K = 256; g.lda = 256; E.mode = E_QPROJ;
            } else {
                g.A = (const h16*)(ws + D_HIN); g.A2 = (const h16*)p.out + (size_t)MTOK * 1024; g.Bt = (const h16*)(ws + OFF_WOV) + (size_t)j * 2097152; g.K = 2048; g.lda = 2048; g.amode = 3;
            }
            pg8::StaticOrder S; S.init(g.M, g.N, (int)gridDim.x, (int)blockIdx.x);
#ifndef NO_GEMM
            pg8::gemm_phase((LAS unsigned char*)smem, g, S, E);
#endif
            }
        } else if (kind == K_PREP) {
#ifndef NO_PREP
            prep_phase(p, smem);
#endif
        } else if (kind == K_R0) {
            mix_phase(p, j);
        } else if (kind == K_R3) {
#ifndef NO_SCAN
            scan_phase(p, j, smem);
#endif
        } else if (kind == K_LN) {
#ifndef NO_LN
            ln_phase(p, p.in[1] + (L * 2 + sub) * 1024, p.in[2] + (L * 2 + sub) * 1024, L == 3 && sub == 1);
#endif
        } else if (kind == K_F2) {
#ifndef NO_CONV
            conv_phase(p, L);
#endif
        } else if (kind == K_D2) {
#ifndef NO_NORM
            dsa_norm_phase(p, j, smem);
#endif
        } else if (kind == K_D4) {
#ifndef NO_INDEX
            dsa_index_phase(p, smem);
#endif
        } else if (kind == K_D5) {
#ifndef NO_ATTN
            dsa_attn_phase(p, j, smem);
#endif
        }
        }
        if (ph + 1 < p.ph_hi) { if (ph == p.ph_lo) grid.sync(); else xcd_barrier(xbar); for (int xs = 0; xs < EXTRA_SYNC; ++xs) xcd_barrier(xbar); }
    }
}

extern "C" void kernel_launch(void* const* d_in, const int* in_sizes, int n_in, void* d_out, int out_size, void* d_ws, size_t ws_size, hipStream_t stream) {
    static int grid_blocks = 0;
    if (grid_blocks == 0) {
        if (n_in != 37 || ws_size < WS_NEED || out_size != MTOK * DM) { fprintf(stderr, "kernel_launch: unexpected problem (n_in %d ws %zu out %d)\n", n_in, ws_size, out_size); grid_blocks = -1; return; }
        int dev = 0, cus = 0, per_cu = 0;
        hipGetDevice(&dev);
        hipDeviceGetAttribute(&cus, hipDeviceAttributeMultiprocessorCount, dev);
        if (hipFuncSetAttribute((const void*)mega_fwd, hipFuncAttributeMaxDynamicSharedMemorySize, LDS_BYTES) != hipSuccess) { fprintf(stderr, "kernel_launch: hipFuncSetAttribute failed\n"); grid_blocks = -1; return; }
        hipOccupancyMaxActiveBlocksPerMultiprocessor(&per_cu, (const void*)mega_fwd, 512, LDS_BYTES);
        if (per_cu < 1) { fprintf(stderr, "kernel_launch: occupancy query says %d blocks/CU\n", per_cu); per_cu = 1; }
        (void)hipGetLastError();
        grid_blocks = cus * per_cu;
        fprintf(stderr, "kernel_launch: grid %d (cus %d x %d)\n", grid_blocks, cus, per_cu);
    }
    if (grid_blocks < 0) return;
    Params p{};
    for (int i = 0; i < 37; ++i) p.in[i] = (const float*)d_in[i];
    p.ws = (unsigned char*)d_ws; p.out = (float*)d_out;
    int np = 0;
    constexpr unsigned PROBE_MASK = 0u;
    auto add = [&](int kind, int L, int sub) { p.prog[np++] = (unsigned char)(kind | (L << 4) | (sub << 6) | ((((PROBE_MASK >> kind) & 1u) && !(kind == K_LN && L == 3 && sub == 1)) ? 128 : 0)); };
    add(K_PREP, 0, 0);
    for (int L = 0; L < 4; ++L) {
        if ((L & 1) == 0) { add(K_R0, L, 0); add(K_R1, L, 0); add(K_R2, L, 0); add(K_R3, L, 0); add(K_R4, L, 0); }
        else { add(K_D1, L, 0); add(K_D2, L, 0); add(K_D3, L, 0); add(K_D4, L, 0); add(K_D5, L, 0); add(K_D6, L, 0); }
        add(K_LN, L, 0);
        for (int c = 0; c < 2; ++c) { add(K_F1, L, c); add(K_F2, L, c); add(K_F3, L, c); }
        add(K_LN, L, 1);
    }
#if SINGLE_LAUNCH
    if (hipMemsetAsync((unsigned char*)d_ws + OFF_BAR, 0, XCD_BAR_WORDS * 4, stream) != hipSuccess) { fprintf(stderr, "kernel_launch: memset failed\n"); return; }
    p.ph_lo = 0; p.ph_hi = np;
    void* args[] = {&p};
    hipError_t e = hipLaunchCooperativeKernel((const void*)mega_fwd, dim3(grid_blocks), dim3(512), args, LDS_BYTES, stream);
    if (e != hipSuccess) fprintf(stderr, "cooperative launch failed: %s (grid %d)\n", hipGetErrorString(e), grid_blocks);
#else
    for (int ph = 0; ph < np; ++ph) {
        p.ph_lo = ph; p.ph_hi = ph + 1;
        hipLaunchKernelGGL(mega_fwd, dim3(grid_blocks), dim3(512), LDS_BYTES, stream, p);
    }
#endif
}
```

```cpp
#include <hip/hip_runtime.h>
#include <hip/hip_cooperative_groups.h>
#include <cstdio>
namespace cg = cooperative_groups;

constexpr int EXTRA_SYNC = 0;
#ifndef SINGLE_LAUNCH
#define SINGLE_LAUNCH 1
#endif

#define LAS __attribute__((address_space(3)))
typedef _Float16 h16;
typedef _Float16 h16x8 __attribute__((ext_vector_type(8)));
typedef _Float16 h16x4 __attribute__((ext_vector_type(4)));
typedef _Float16 h16x2 __attribute__((ext_vector_type(2)));
typedef float f32x4 __attribute__((ext_vector_type(4)));
typedef float f32x2 __attribute__((ext_vector_type(2)));
typedef unsigned u32x4 __attribute__((ext_vector_type(4)));
typedef unsigned u32x2 __attribute__((ext_vector_type(2)));

constexpr int DM = 1024, SEQ = 2048, NBATCH = 32, MTOK = NBATCH * SEQ;
constexpr int DFF = 2816;
constexpr size_t MiB = (size_t)1 << 20;
constexpr float DN_ALPHA = 1.6817928305074290f;
constexpr int LDS_BYTES = 147456;

constexpr size_t OFF_W = 0;
constexpr size_t OFF_X16 = 118 * MiB;
constexpr size_t OFF_VF = 247 * MiB;
constexpr size_t OFF_R = 375 * MiB;
constexpr size_t WS_NEED = 960 * MiB;
constexpr size_t OFF_WOV = 952 * MiB;
constexpr size_t R_R16 = OFF_R, R_K16 = OFF_R + 128 * MiB, R_V16 = OFF_R + 256 * MiB, R_G16 = OFF_R + 384 * MiB, R_HACT = OFF_R + 512 * MiB;
constexpr size_t F_U16 = OFF_R, F_ACT = OFF_R + 352 * MiB;
constexpr size_t D_HIN = OFF_R, D_O16 = OFF_R, D_QABS = OFF_R + 128 * MiB, D_QIDX = OFF_R + 384 * MiB, D_CQ = OFF_R + 448 * MiB,
                 D_CKV = OFF_R + 480 * MiB, D_CKVT = OFF_R + 496 * MiB, D_KIDX = OFF_R + 512 * MiB, D_WIDX = OFF_R + 520 * MiB, D_MASK = OFF_R + 522 * MiB;

struct Params {
    const float* in[37];
    unsigned char* ws;
    float* out;
    int ph_lo, ph_hi;
    unsigned char prog[64];
};

enum { K_PREP = 0, K_R1, K_R2, K_R3, K_R4, K_LN, K_F1, K_F2, K_F3, K_D1, K_D2, K_D3, K_D4, K_D5, K_D6, K_R0 };
enum { E_RPROJ = 0, E_LORA2, E_RESID, E_ST16, E_ST32, E_QPROJ };

__device__ __forceinline__ size_t xrow(int row) { return (size_t)(row >> 11) * 2049 + 1 + (row & 2047); }
__device__ __forceinline__ unsigned pk2(float a, float b) { h16x2 h = {(h16)a, (h16)b}; return __builtin_bit_cast(unsigned, h); }
__device__ __forceinline__ u32x4 pack8(f32x4 a, f32x4 b) { u32x4 w; w.x = pk2(a[0], a[1]); w.y = pk2(a[2], a[3]); w.z = pk2(b[0], b[1]); w.w = pk2(b[2], b[3]); return w; }
__device__ __forceinline__ void unpack8(u32x4 w, float* f) {
    h16x8 h = __builtin_bit_cast(h16x8, w);
#pragma unroll
    for (int i = 0; i < 8; ++i) f[i] = (float)h[i];
}
__device__ __forceinline__ float sigmoidf_(float x) { return __builtin_amdgcn_rcpf(1.0f + __expf(-x)); }
#define WSYNC() asm volatile("s_waitcnt vmcnt(0) lgkmcnt(0)" ::: "memory")
__device__ __forceinline__ int opaque_tid() { int t = threadIdx.x; asm volatile("" : "+v"(t)); return t; }
__device__ __forceinline__ float dppf(float x, const int ctrl_sel) {
    const int v = __builtin_bit_cast(int, x);
    int r;
    if (ctrl_sel == 0) r = __builtin_amdgcn_update_dpp(0, v, 0xB1, 0xF, 0xF, true);
    else if (ctrl_sel == 1) r = __builtin_amdgcn_update_dpp(0, v, 0x4E, 0xF, 0xF, true);
    else if (ctrl_sel == 2) r = __builtin_amdgcn_update_dpp(0, v, 0x141, 0xF, 0xF, true);
    else r = __builtin_amdgcn_update_dpp(0, v, 0x140, 0xF, 0xF, true);
    return __builtin_bit_cast(float, r);
}
__device__ __forceinline__ float red4(float x) { x += dppf(x, 0); x += dppf(x, 1); return x; }
__device__ __forceinline__ float red16(float x) { x += dppf(x, 0); x += dppf(x, 1); x += dppf(x, 2); x += dppf(x, 3); return x; }
__device__ __forceinline__ float xmax_16_32(float x) {
    const unsigned u = __builtin_bit_cast(unsigned, x);
    auto r = __builtin_amdgcn_permlane16_swap(u, u, false, false);
    float m = fmaxf(__builtin_bit_cast(float, (unsigned)r[0]), __builtin_bit_cast(float, (unsigned)r[1]));
    const unsigned u2 = __builtin_bit_cast(unsigned, m);
    auto r2 = __builtin_amdgcn_permlane32_swap(u2, u2, false, false);
    return fmaxf(__builtin_bit_cast(float, (unsigned)r2[0]), __builtin_bit_cast(float, (unsigned)r2[1]));
}
__device__ __forceinline__ float xsum_16_32(float x) {
    const unsigned u = __builtin_bit_cast(unsigned, x);
    auto r = __builtin_amdgcn_permlane16_swap(u, u, false, false);
    float m = __builtin_bit_cast(float, (unsigned)r[0]) + __builtin_bit_cast(float, (unsigned)r[1]);
    const unsigned u2 = __builtin_bit_cast(unsigned, m);
    auto r2 = __builtin_amdgcn_permlane32_swap(u2, u2, false, false);
    return __builtin_bit_cast(float, (unsigned)r2[0]) + __builtin_bit_cast(float, (unsigned)r2[1]);
}
__device__ __forceinline__ float wave_sum(float v) { return xsum_16_32(red16(v)); }

namespace pg8 {
constexpr int BM = 256, BK = 64, HALF = 128, HTB = HALF * BK * 2, STAGE_BYTES = 8 * HTB, NXCD = 8, WGM = 8;
__device__ __forceinline__ int lds_byte(int r, int c) { const int st = (r >> 4) * 2 + (c >> 5), rr = r & 15, cc = c & 31, ob = rr * 64 + cc * 2; return st * 1024 + (ob ^ (((ob >> 9) & 1) << 5)); }
__device__ __forceinline__ void stage_rc(int b, int& R, int& C) { const int st = b / 1024, sb = b % 1024, swz = sb ^ (((sb >> 9) & 1) << 5); R = (st >> 1) * 16 + swz / 64; C = (st & 1) * 32 + (swz % 64) / 2; }
__device__ __forceinline__ int perm32(int rho) { const int n = rho >> 4, i = rho & 15; return 8 * (i >> 2) + 4 * n + (i & 3); }
struct Unit { int pm, pn; };
struct Gemm { const h16* A; const h16* A2; const h16* Bt; int M, N, K, lda, amode, pm0; };
struct StaticOrder {
    int nM, nN, nwg, G, c;
    __device__ void init(int M, int N, int G_, int c_) { nM = M / BM; nN = N / BM; nwg = nM * nN; G = G_; c = c_; }
    __device__ bool next(int i, Unit& u) const {
        const long L = (long)i * G + c; if (L >= nwg) return false;
        int wgid = (int)L; { const int q = nwg / NXCD, r = nwg % NXCD, xcd = wgid % NXCD, off = wgid / NXCD; wgid = (xcd < r ? xcd * (q + 1) : r * (q + 1) + (xcd - r) * q) + off; }
        const int nig = WGM * nN, gid = wgid / nig, fm = gid * WGM, gsz = (nM - fm) < WGM ? (nM - fm) : WGM;
        u.pm = fm + ((wgid % nig) % gsz); u.pn = (wgid % nig) / gsz; return true;
    }
};

struct Epi {
    int mode, pm0, j, pnoff, fin;
    unsigned char* ws; float* out; const float* bias0; const float* bias1; const float* bias2;
    __device__ __forceinline__ void operator()(const f32x4 (&acc)[2][2][4][2], const Unit& u, int wr, int wc, int fr, int fq) const {
        const int rowl0 = u.pm * BM + wr * 64 + fr;
        const int colt = u.pn * BM + wc * 32 + 8 * fq;
        if (mode == E_RESID) {
            u32x4 xr[2][4][2];
#pragma unroll
            for (int ai = 0; ai < 2; ++ai)
#pragma unroll
                for (int m = 0; m < 4; ++m) {
                    const int rowg = rowl0 + ai * HALF + m * 16 + pm0 * BM;
                    const h16* xp = (const h16*)(ws + OFF_X16) + xrow(rowg) * 1024 + colt;
#pragma unroll
                    for (int bj = 0; bj < 2; ++bj) xr[ai][m][bj] = *(const u32x4*)(xp + bj * HALF);
                }
#pragma unroll
            for (int ai = 0; ai < 2; ++ai)
#pragma unroll
                for (int m = 0; m < 4; ++m) {
                    const int rowg = rowl0 + ai * HALF + m * 16 + pm0 * BM;
                    float* dp0 = out + (size_t)rowg * 1024 + colt;
                    h16* hp0 = (h16*)out + (size_t)rowg * 1024 + colt;
#pragma unroll
                    for (int bj = 0; bj < 2; ++bj) {
                        float xf[8]; unpack8(xr[ai][m][bj], xf);
                        const f32x4 v0 = acc[ai][bj][m][0], v1 = acc[ai][bj][m][1];
                        f32x4 r0, r1;
#pragma unroll
                        for (int jj = 0; jj < 4; ++jj) { r0[jj] = DN_ALPHA * xf[jj] + v0[jj]; r1[jj] = DN_ALPHA * xf[4 + jj] + v1[jj]; }
                        if (fin) { float* dp = dp0 + bj * HALF; *(f32x4*)dp = r0; *(f32x4*)(dp + 4) = r1; }
                        else *(u32x4*)(hp0 + bj * HALF) = pack8(r0, r1);
                    }
                }
            return;
        }
        if (mode == E_LORA2 && (u.pn >> 2) == 3) {
            const int c0 = colt & 1023;
#pragma unroll
            for (int ai = 0; ai < 2; ++ai) {
                u32x4 lv[4][2], lf[4][2];
#pragma unroll
                for (int m = 0; m < 4; ++m) {
                    const size_t off = (size_t)(rowl0 + ai * HALF + m * 16 + pm0 * BM) * 1024 + c0;
#pragma unroll
                    for (int bj = 0; bj < 2; ++bj) { lv[m][bj] = *(const u32x4*)((const h16*)(ws + R_V16) + off + bj * HALF); lf[m][bj] = *(const u32x4*)((const h16*)(ws + OFF_VF) + off + bj * HALF); }
                }
#pragma unroll
                for (int m = 0; m < 4; ++m) {
                    const size_t off = (size_t)(rowl0 + ai * HALF + m * 16 + pm0 * BM) * 1024 + c0;
#pragma unroll
                    for (int bj = 0; bj < 2; ++bj) {
                        const int c = c0 + bj * HALF;
                        const f32x4 ba = *(const f32x4*)(bias2 + c), bb = *(const f32x4*)(bias2 + c + 4);
                        float vv[8], vf8[8]; unpack8(lv[m][bj], vv); unpack8(lf[m][bj], vf8);
                        f32x4 v0 = acc[ai][bj][m][0], v1 = acc[ai][bj][m][1];
#pragma unroll
                        for (int jj = 0; jj < 4; ++jj) {
                            v0[jj] = vv[jj] + (vf8[jj] - vv[jj]) * sigmoidf_(v0[jj] + ba[jj]);
                            v1[jj] = vv[4 + jj] + (vf8[4 + jj] - vv[4 + jj]) * sigmoidf_(v1[jj] + bb[jj]);
                        }
                        *(u32x4*)((h16*)(ws + R_V16) + off + bj * HALF) = pack8(v0, v1);
                    }
                }
            }
            return;
        }
#pragma unroll
        for (int ai = 0; ai < 2; ++ai)
#pragma unroll
            for (int m = 0; m < 4; ++m) {
                const int rowl = rowl0 + ai * HALF + m * 16;
                const int rowg = rowl + pm0 * BM;
#pragma unroll
                for (int bj = 0; bj < 2; ++bj) {
                    const int col = colt + bj * HALF;
                    f32x4 v0 = acc[ai][bj][m][0], v1 = acc[ai][bj][m][1];
                    if (mode == E_RPROJ) {
                        if (pnoff == 0) {
                            h16* dst = (h16*)(ws + (u.pn < 4 ? R_R16 : (u.pn < 8 ? R_K16 : (j == 0 ? OFF_VF : R_V16))));
                            *(u32x4*)(dst + (size_t)rowg * 1024 + (col & 1023)) = pack8(v0, v1);
                        } else if (col < 384) {
                            const int hc = col;
                            if (hc < 64) {
#pragma unroll
                                for (int jj = 0; jj < 4; ++jj) { v0[jj] = tanhf(v0[jj]); v1[jj] = tanhf(v1[jj]); }
                            } else if (hc >= 160) {
#pragma unroll
                                for (int jj = 0; jj < 4; ++jj) { v0[jj] = sigmoidf_(v0[jj]); v1[jj] = sigmoidf_(v1[jj]); }
                            }
                            *(u32x4*)((h16*)(ws + R_HACT) + (size_t)rowg * 384 + hc) = pack8(v0, v1);
                        }
                    } else if (mode == E_LORA2) {
                        const int grp = u.pn >> 2, c = col & 1023;
                        const size_t off = (size_t)rowg * 1024 + c;
                        if (grp == 0) {
                            const f32x4 ba = *(const f32x4*)(bias0 + c), bb = *(const f32x4*)(bias0 + c + 4);
#pragma unroll
                            for (int jj = 0; jj < 4; ++jj) { v0[jj] = sigmoidf_(v0[jj] + ba[jj]) * 0.6065306597f; v1[jj] = sigmoidf_(v1[jj] + bb[jj]) * 0.6065306597f; }
                            *(u32x4*)((h16*)out + off) = pack8(v0, v1);
                        } else if (grp == 1) {
                            const f32x4 ba = *(const f32x4*)(bias1 + c), bb = *(const f32x4*)(bias1 + c + 4);
#pragma unroll
                            for (int jj = 0; jj < 4; ++jj) { v0[jj] = sigmoidf_(v0[jj] + ba[jj]); v1[jj] = sigmoidf_(v1[jj] + bb[jj]); }
                            *(u32x4*)((h16*)out + (size_t)MTOK * 1024 + off) = pack8(v0, v1);
                        } else {
                            *(u32x4*)((h16*)(ws + R_G16) + off) = pack8(v0, v1);
                        }
                    } else if (mode == E_ST16) {
                        __builtin_nontemporal_store(pack8(v0, v1), (u32x4*)((h16*)(ws + F_U16) + (size_t)rowl * 5632 + col));
                    } else if (mode == E_ST32) {
                        float* dp = (float*)(ws + D_HIN) + (size_t)rowg * 512 + col;
                        *(f32x4*)dp = v0; *(f32x4*)(dp + 4) = v1;
                    } else {
                        if (u.pn < 8) *(u32x4*)((h16*)(ws + D_QABS) + (size_t)rowg * 2048 + col) = pack8(v0, v1);
                        else *(u32x4*)((h16*)(ws + D_QIDX) + (size_t)rowg * 512 + (col - 2048)) = pack8(v0, v1);
                    }
                }
            }
    }
};

__device__ __forceinline__ const char* a_tile(const Gemm& g, int pm, int pn) {
    if (g.amode == 1) { const int row = (pm + g.pm0) * BM; return (const char*)g.A + xrow(row) * 2048; }
    if (g.amode == 2) {
        const int gq = pn >> 2;
        const char* base = gq == 2 ? (const char*)g.A2 : (const char*)g.A + (size_t)gq * ((size_t)MTOK * 1024 * 2);
        return base + (size_t)pm * BM * 2048;
    }
    if (g.amode == 3) return (pm < 128 ? (const char*)g.A + (size_t)pm * BM * 4096 : (const char*)g.A2 + (size_t)(pm - 128) * BM * 4096);
    return (const char*)g.A + (size_t)pm * BM * g.lda * 2;
}

__device__ __forceinline__ void gemm_phase(LAS unsigned char* lds, const Gemm g, const StaticOrder& S, const Epi& E) {
    const int tid = opaque_tid(), wid = __builtin_amdgcn_readfirstlane(tid >> 6), lane = tid & 63, wr = wid >> 2, wc = wid & 3, fr = lane & 15, fq = lane >> 4;
    const int K = g.K, nt = K / BK;
    const bool shiftA = (g.amode == 1);
    unsigned voffA[2], voffB[2];
#pragma unroll
    for (int i = 0; i < 2; ++i) { int R, C; stage_rc(tid * 16 + i * 8192, R, C); const int Rb = (R & ~31) + perm32(R & 31);
        voffA[i] = (unsigned)(R * g.lda + C) * 2u; voffB[i] = (unsigned)(Rb * K + C) * 2u; }
    const size_t kstep = (size_t)(BK * 2);
    const size_t hstepA = (size_t)HALF * g.lda * 2;
    const size_t hstepB = (size_t)HALF * K * 2;
    const size_t tstepB = 2 * hstepB;
    const unsigned ldsw = (unsigned)wid * 1024u;
    const int aoff = lds_byte(wr * 64 + fr, fq * 8), boff = lds_byte(wc * 32 + fr, fq * 8);
#define PG8_KOFF(kt) ((size_t)(kt) * kstep - ((shiftA && (kt) >= 16) ? (size_t)4096 : (size_t)0))
#define PG8_SA(b, h) (((b) * 2 + (h)) * HTB)
#define PG8_SB(b, h) ((4 + (b) * 2 + (h)) * HTB)
#define PG8_STAGE(bufoff, gbase, voff) do { _Pragma("unroll") for (int _i = 0; _i < 2; ++_i) \
        __builtin_amdgcn_global_load_lds((const unsigned*)((const char*)(gbase) + (voff)[_i]), (LAS unsigned*)(lds + (bufoff) + ldsw + _i * 8192), 16, 0, 0); } while (0)
#define PG8_LDA(dst, b, h) do { _Pragma("unroll") for (int m = 0; m < 4; ++m) _Pragma("unroll") for (int k = 0; k < 2; ++k) dst[m][k] = *(const LAS h16x8*)(lds + PG8_SA(b, h) + aoff + m * 2048 + k * 1024); } while (0)
#define PG8_LDB(dst, b, h) do { _Pragma("unroll") for (int n = 0; n < 2; ++n) _Pragma("unroll") for (int k = 0; k < 2; ++k) dst[n][k] = *(const LAS h16x8*)(lds + PG8_SB(b, h) + boff + n * 2048 + k * 1024); } while (0)
#define PG8_MMA(ai, bj, At, Bt) do { __builtin_amdgcn_s_setprio(1); _Pragma("unroll") for (int m = 0; m < 4; ++m) _Pragma("unroll") for (int n = 0; n < 2; ++n) _Pragma("unroll") for (int k = 0; k < 2; ++k) \
        acc[ai][bj][m][n] = __builtin_amdgcn_mfma_f32_16x16x32_f16(Bt[n][k], At[m][k], acc[ai][bj][m][n], 0, 0, 0); __builtin_amdgcn_s_setprio(0); } while (0)
#define PG8_WAIT_V(n) asm volatile("s_waitcnt vmcnt(" #n ")" ::: "memory")
#define PG8_WAIT_L(n) asm volatile("s_waitcnt lgkmcnt(" #n ")" ::: "memory")
#define PG8_BAR __builtin_amdgcn_s_barrier()
#define PG8_SCHED __builtin_amdgcn_sched_barrier(0)
    Unit cur, nxt; int ui = 0;
    if (!S.next(0, cur)) return;
    f32x4 acc[2][2][4][2];
#pragma unroll
    for (int a = 0; a < 2; ++a)
#pragma unroll
        for (int b = 0; b < 2; ++b)
#pragma unroll
            for (int m = 0; m < 4; ++m)
#pragma unroll
                for (int n = 0; n < 2; ++n) acc[a][b][m][n] = (f32x4){0.f, 0.f, 0.f, 0.f};
    h16x8 At[4][2], B0[2][2], B1[2][2];
    const char* cA = a_tile(g, cur.pm, cur.pn); const char* cB = (const char*)g.Bt + (size_t)cur.pn * tstepB;
    PG8_STAGE(PG8_SB(0, 0), cB, voffB); PG8_STAGE(PG8_SA(0, 0), cA, voffA); PG8_STAGE(PG8_SB(0, 1), cB + hstepB, voffB); PG8_STAGE(PG8_SA(0, 1), cA + hstepA, voffA);
    if (wr == 1) PG8_BAR;
    PG8_WAIT_V(4); PG8_BAR;
    PG8_STAGE(PG8_SB(1, 0), cB + kstep, voffB); PG8_STAGE(PG8_SA(1, 0), cA + kstep, voffA); PG8_STAGE(PG8_SB(1, 1), cB + hstepB + kstep, voffB);
    PG8_WAIT_V(6); PG8_BAR;
    for (;;) {
        const bool has_next = S.next(ui + 1, nxt);
        const char* nA = has_next ? a_tile(g, nxt.pm, nxt.pn) : cA; const char* nB = has_next ? (const char*)g.Bt + (size_t)nxt.pn * tstepB : cB;
        for (int t = 0; t < nt; t += 2) {
            const bool last = (t == nt - 2);
            const char* a1 = cA + PG8_KOFF(t + 1);
            const char* a2 = last ? nA : cA + PG8_KOFF(t + 2); const char* b2 = last ? nB : cB + (size_t)(t + 2) * kstep;
            const char* a3 = a2 + kstep; const char* b3 = b2 + kstep;
            PG8_LDB(B0, 0, 0); PG8_SCHED; PG8_LDA(At, 0, 0); PG8_STAGE(PG8_SA(1, 1), a1 + hstepA, voffA);
            PG8_WAIT_L(8); PG8_BAR; PG8_WAIT_L(0); PG8_MMA(0, 0, At, B0); PG8_BAR; PG8_SCHED;
            PG8_LDB(B1, 0, 1); PG8_STAGE(PG8_SB(0, 0), b2, voffB);
            PG8_BAR; PG8_WAIT_L(0); PG8_MMA(0, 1, At, B1); PG8_BAR;
            PG8_LDA(At, 0, 1); PG8_STAGE(PG8_SA(0, 0), a2, voffA);
            PG8_BAR; PG8_WAIT_L(0); PG8_MMA(1, 0, At, B0); PG8_BAR; PG8_SCHED;
            PG8_STAGE(PG8_SB(0, 1), b2 + hstepB, voffB);
            PG8_WAIT_V(6); PG8_BAR; PG8_MMA(1, 1, At, B1); PG8_BAR;
            PG8_LDB(B0, 1, 0); PG8_SCHED; PG8_LDA(At, 1, 0); PG8_STAGE(PG8_SA(0, 1), a2 + hstepA, voffA);
            PG8_WAIT_L(8); PG8_BAR; PG8_WAIT_L(0); PG8_MMA(0, 0, At, B0); PG8_BAR; PG8_SCHED;
            PG8_LDB(B1, 1, 1); PG8_STAGE(PG8_SB(1, 0), b3, voffB);
            PG8_BAR; PG8_WAIT_L(0); PG8_MMA(0, 1, At, B1); PG8_BAR;
            PG8_LDA(At, 1, 1); PG8_STAGE(PG8_SA(1, 0), a3, voffA);
            PG8_BAR; PG8_WAIT_L(0); PG8_MMA(1, 0, At, B0); PG8_BAR; PG8_SCHED;
            PG8_STAGE(PG8_SB(1, 1), b3 + hstepB, voffB);
            PG8_WAIT_V(6); PG8_BAR; PG8_MMA(1, 1, At, B1); PG8_BAR;
        }
        E(acc, cur, wr, wc, fr, fq);
        if (!has_next) break;
#pragma unroll
        for (int a = 0; a < 2; ++a)
#pragma unroll
            for (int b = 0; b < 2; ++b)
#pragma unroll
                for (int m = 0; m < 4; ++m)
#pragma unroll
                    for (int n = 0; n < 2; ++n) acc[a][b][m][n] = (f32x4){0.f, 0.f, 0.f, 0.f};
        cur = nxt; cA = nA; cB = nB; ++ui;
    }
    PG8_WAIT_V(0);
    if (wr == 0) PG8_BAR;
    PG8_BAR;
#undef PG8_KOFF
#undef PG8_SA
#undef PG8_SB
#undef PG8_STAGE
#undef PG8_LDA
#undef PG8_LDB
#undef PG8_MMA
#undef PG8_WAIT_V
#undef PG8_WAIT_L
#undef PG8_BAR
#undef PG8_SCHED
}
}

struct TJob { int mode; const float* src; int ld, K, N; h16* dst; int ldd, koff; const float* mix; };

__device__ __forceinline__ TJob get_job(const Params& p, int id) {
    TJob J; J.mode = 0; J.src = nullptr; J.ld = 0; J.K = 0; J.N = 0; J.dst = nullptr; J.ldd = 64; J.koff = 0; J.mix = nullptr;
    h16* W = (h16*)(p.ws + OFF_W);
    if (id < 24) {
        const int j = id / 12, s = id % 12;
        h16* Wrkv = W + (size_t)j * (10 * MiB); h16* Wl1 = Wrkv + 3 * MiB; h16* Wl2 = Wrkv + 7 * MiB;
        const float* mix = p.in[3] + j * 6 * 1024;
        if (s < 3) { J.mode = 0; J.src = p.in[4] + (size_t)(j * 3 + s) * 1048576; J.ld = 1024; J.K = 1024; J.N = 1024; J.dst = Wrkv + (size_t)s * 1024 * 1024; J.ldd = 1024; }
        else if (s < 8) {
            J.mode = 1; J.ld = 1024; J.K = 1024; J.ldd = 2048;
            if (s == 3) { J.src = p.in[6] + (size_t)j * 65536; J.ld = 64; J.N = 64; J.dst = Wl1; J.mix = mix + 3 * 1024; }
            else if (s == 4) { J.src = p.in[9] + (size_t)j * 65536; J.ld = 64; J.N = 64; J.dst = Wl1 + (size_t)64 * 2048; J.mix = mix + 4 * 1024; }
            else if (s == 5) { J.N = 32; J.dst = Wl1 + (size_t)128 * 2048; if (j == 1) { J.src = p.in[12]; J.ld = 32; J.mix = mix + 2 * 1024; } else { J.mode = 2; } }
            else if (s == 6) { J.src = p.in[14] + (size_t)j * 163840; J.ld = 160; J.N = 160; J.dst = Wl1 + (size_t)160 * 2048; J.mix = mix + 5 * 1024; }
            else { J.mode = 2; J.N = 192; J.dst = Wl1 + (size_t)320 * 2048; }
        } else {
            J.mode = 0; J.ld = 1024; J.N = 1024; J.ldd = 384;
            if (s == 8) { J.src = p.in[7] + (size_t)j * 65536; J.K = 64; J.koff = 0; J.dst = Wl2; }
            else if (s == 9) { J.src = p.in[10] + (size_t)j * 65536; J.K = 64; J.koff = 64; J.dst = Wl2 + (size_t)1024 * 384; }
            else if (s == 10) { J.src = p.in[15] + (size_t)j * 163840; J.K = 160; J.koff = 160; J.dst = Wl2 + (size_t)2048 * 384; }
            else { J.src = p.in[13]; J.K = 32; J.koff = 128; J.dst = Wl2 + (size_t)3072 * 384; if (j == 0) J.N = 0; }
        }
    } else if (id < 26) {
        const int j = id - 24;
        J.src = p.in[21] + (size_t)j * 1048576; J.ld = 1024; J.K = 1024; J.N = 1024; J.dst = W + (size_t)j * (10 * MiB) + 9 * MiB; J.ldd = 1024;
    } else if (id < 34) {
        const int i = (id - 26) >> 1, s = (id - 26) & 1;
        h16* base = W + 20 * MiB + (size_t)i * (17 * MiB / 2);
        if (s == 0) { J.src = p.in[33] + (size_t)i * 1024 * 5632; J.ld = 5632; J.K = 1024; J.N = 5632; J.dst = base; J.ldd = 1024; }
        else { J.src = p.in[36] + (size_t)i * 2816 * 1024; J.ld = 1024; J.K = 2816; J.N = 1024; J.dst = base + (size_t)11 * MiB / 2; J.ldd = 2816; }
    } else {
        const int j = (id - 34) >> 2, s = (id - 34) & 3;
        h16* base = W + 54 * MiB + (size_t)j * (5 * MiB / 2);
        if (s == 0) { J.src = p.in[22] + (size_t)j * 1024 * 456; J.ld = 456; J.K = 1024; J.N = 456; J.dst = base; J.ldd = 1024; }
        else if (s == 1) { J.mode = 2; J.N = 56; J.dst = base + (size_t)456 * 1024; J.ldd = 1024; }
        else if (s == 2) { J.src = p.in[28] + (size_t)j * 256 * 512; J.ld = 512; J.K = 256; J.N = 512; J.dst = base + MiB / 2 + (size_t)2048 * 256; J.ldd = 256; }
        else { J.src = p.in[31] + (size_t)j * 1048576; J.ld = 1024; J.K = 1024; J.N = 1024; J.dst = base + 3 * MiB / 2; J.ldd = 1024; }
    }
    return J;
}
__device__ __forceinline__ h16* w_rwkv_big(unsigned char* ws, int j) { return (h16*)(ws + OFF_W) + (size_t)j * (10 * MiB); }
__device__ __forceinline__ h16* w_rwkv_l1(unsigned char* ws, int j) { return w_rwkv_big(ws, j) + 3 * MiB; }
__device__ __forceinline__ h16* w_rwkv_l2(unsigned char* ws, int j) { return w_rwkv_big(ws, j) + 7 * MiB; }
__device__ __forceinline__ h16* w_rwkv_o(unsigned char* ws, int j) { return w_rwkv_big(ws, j) + 9 * MiB; }
__device__ __forceinline__ h16* w_ffn_up(unsigned char* ws, int i) { return (h16*)(ws + OFF_W) + 20 * MiB + (size_t)i * (17 * MiB / 2); }
__device__ __forceinline__ h16* w_ffn_dn(unsigned char* ws, int i) { return w_ffn_up(ws, i) + (size_t)11 * MiB / 2; }
__device__ __forceinline__ h16* w_dsa_in(unsigned char* ws, int j) { return (h16*)(ws + OFF_W) + 54 * MiB + (size_t)j * (5 * MiB / 2); }
__device__ __forceinline__ h16* w_dsa_q(unsigned char* ws, int j) { return w_dsa_in(ws, j) + MiB / 2; }
__device__ __forceinline__ h16* w_dsa_uvt(unsigned char* ws, int j) { return w_dsa_in(ws, j) + 5 * MiB / 4; }
__device__ __forceinline__ h16* w_dsa_o(unsigned char* ws, int j) { return w_dsa_in(ws, j) + 3 * MiB / 2; }

__device__ __forceinline__ void prep_phase(const Params& p, unsigned char* smem) {
    const int tid = opaque_tid();
    const size_t gtid = (size_t)blockIdx.x * 512 + tid, nth = (size_t)gridDim.x * 512;
    h16* x16 = (h16*)(p.ws + OFF_X16);
    for (size_t idx = gtid; idx < (size_t)MTOK * 128; idx += nth) {
        const int row = (int)(idx >> 7), c8 = (int)(idx & 127) * 8;
        const float* sp = p.in[0] + (size_t)row * 1024 + c8;
        const f32x4 a = *(const f32x4*)sp, b = *(const f32x4*)(sp + 4);
        *(u32x4*)(x16 + xrow(row) * 1024 + c8) = pack8(a, b);
    }
    for (size_t idx = gtid; idx < (size_t)NBATCH * 128; idx += nth) {
        const int b = (int)(idx >> 7), c8 = (int)(idx & 127) * 8;
        unsigned z = 0u; asm volatile("" : "+v"(z));
        *(u32x4*)(x16 + (size_t)b * 2049 * 1024 + c8) = (u32x4){z, z, z, z};
    }
    for (size_t it = gtid; it < (size_t)2 * 16 * 2048; it += nth) {
        const int j = (int)(it >> 15), rem = (int)(it & 32767), qg = rem >> 11, n = rem & 2047, h = n >> 7, c = n & 127;
        const float* uq = p.in[25] + (size_t)j * 256 * 1024 + (size_t)(qg * 16) * 1024 + h * 64;
        const float* uk = p.in[26] + (size_t)j * 16 * 64 * 128 + (size_t)h * 64 * 128 + c;
        float acc[16];
#pragma unroll
        for (int i = 0; i < 16; ++i) acc[i] = 0.f;
        for (int d = 0; d < 64; ++d) {
            const float kv = uk[d * 128];
#pragma unroll
            for (int i = 0; i < 16; ++i) acc[i] += uq[i * 1024 + d] * kv;
        }
        const float sc = 0.18033688011112042f;
        h16* dst = w_dsa_q(p.ws, j) + (size_t)n * 256 + qg * 16;
        *(u32x4*)dst = pack8((f32x4){acc[0] * sc, acc[1] * sc, acc[2] * sc, acc[3] * sc}, (f32x4){acc[4] * sc, acc[5] * sc, acc[6] * sc, acc[7] * sc});
        *(u32x4*)(dst + 8) = pack8((f32x4){acc[8] * sc, acc[9] * sc, acc[10] * sc, acc[11] * sc}, (f32x4){acc[12] * sc, acc[13] * sc, acc[14] * sc, acc[15] * sc});
    }
    for (size_t it = gtid; it < (size_t)2 * 128 * 1024; it += nth) {
        const int j = (int)(it >> 17), rem = (int)(it & 131071), kg = rem >> 10, n = rem & 1023, h = kg >> 3, c0 = (kg & 7) * 16;
        const float* uv = p.in[27] + (size_t)((j * 16 + h) * 128 + c0) * 64;
        const float* wo = p.in[31] + (size_t)j * 1048576 + (size_t)(h * 64) * 1024 + n;
        float acc[16];
#pragma unroll
        for (int i = 0; i < 16; ++i) acc[i] = 0.f;
        for (int v = 0; v < 64; ++v) {
            const float wv = wo[(size_t)v * 1024];
#pragma unroll
            for (int i = 0; i < 16; ++i) acc[i] += uv[i * 64 + v] * wv;
        }
        h16* dst = (h16*)(p.ws + OFF_WOV) + (size_t)j * 2097152 + (size_t)n * 2048 + h * 128 + c0;
        *(u32x4*)dst = pack8((f32x4){acc[0], acc[1], acc[2], acc[3]}, (f32x4){acc[4], acc[5], acc[6], acc[7]});
        *(u32x4*)(dst + 8) = pack8((f32x4){acc[8], acc[9], acc[10], acc[11]}, (f32x4){acc[12], acc[13], acc[14], acc[15]});
    }
    float* tile = (float*)smem;
    for (int id = 0; id < 42; ++id) {
        const TJob J = get_job(p, id);
        const int tk = J.ldd >> 6, tn = (J.N + 63) >> 6, ntile = tk * tn;
        for (int tix = (int)((blockIdx.x + gridDim.x - (unsigned)(id * 37) % gridDim.x) % gridDim.x); tix < ntile; tix += gridDim.x) {
            const int k0 = (tix % tk) * 64, n0 = (tix / tk) * 64;
#pragma unroll
            for (int i = 0; i < 8; ++i) {
                const int k = i * 8 + (tid >> 6), n = tid & 63, kk = k0 + k, nn = n0 + n;
                float v = 0.f;
                if (nn < J.N && J.mode != 2) {
                    if (J.mode == 1) { const int ks = kk & 1023; const float mx = J.mix[ks]; v = J.src[(size_t)ks * J.ld + nn] * (kk < 1024 ? 1.0f - mx : mx); }
                    else if (kk >= J.koff && kk < J.koff + J.K) v = J.src[(size_t)(kk - J.koff) * J.ld + nn];
                }
                tile[k * 65 + n] = v;
            }
            __syncthreads();
#pragma unroll
            for (int i = 0; i < 8; ++i) {
                const int n = i * 8 + (tid >> 6), k = tid & 63, nn = n0 + n;
                if (nn < J.N) J.dst[(size_t)nn * J.ldd + k0 + k] = (h16)tile[k * 65 + n];
            }
            __syncthreads();
        }
    }
}

__device__ __forceinline__ void wave_sum4(float (&v)[4]) {
#pragma unroll
    for (int k = 0; k < 4; ++k) v[k] = wave_sum(v[k]);
}
__device__ __forceinline__ void ln_phase(const Params& p, const float* g, const float* b, bool final_out) {
    const int tid = opaque_tid();
    const int lane = tid & 63, wave = tid >> 6;
    float* tb = p.out;
    h16* x16 = (h16*)(p.ws + OFF_X16);
    if (!final_out) {
        float g0[8], g1[8], b0[8], b1[8];
#pragma unroll
        for (int hlf = 0; hlf < 2; ++hlf) {
            const f32x4 a = *(const f32x4*)(g + lane * 8 + hlf * 4), c = *(const f32x4*)(g + 512 + lane * 8 + hlf * 4);
            const f32x4 d = *(const f32x4*)(b + lane * 8 + hlf * 4), e = *(const f32x4*)(b + 512 + lane * 8 + hlf * 4);
#pragma unroll
            for (int i = 0; i < 4; ++i) { g0[hlf * 4 + i] = a[i]; g1[hlf * 4 + i] = c[i]; b0[hlf * 4 + i] = d[i]; b1[hlf * 4 + i] = e[i]; }
        }
        for (int rowb = (blockIdx.x * 8 + wave) * 8; rowb < MTOK; rowb += gridDim.x * 64) {
            u32x4 va[8], vb[8];
#pragma unroll
            for (int k = 0; k < 8; ++k) {
                const h16* hp = (const h16*)tb + (size_t)(rowb + k) * 1024 + lane * 8;
                va[k] = *(const u32x4*)hp; vb[k] = *(const u32x4*)(hp + 512);
            }
            float mu[8], rs[8];
#pragma unroll
            for (int k = 0; k < 8; ++k) {
                float xa[8], xb[8]; unpack8(va[k], xa); unpack8(vb[k], xb);
                float sk = 0.f;
#pragma unroll
                for (int i = 0; i < 8; ++i) sk += xa[i] + xb[i];
                mu[k] = sk;
            }
#pragma unroll
            for (int k = 0; k < 8; ++k) mu[k] = wave_sum(mu[k]) * (1.0f / 1024.0f);
#pragma unroll
            for (int k = 0; k < 8; ++k) {
                float xa[8], xb[8]; unpack8(va[k], xa); unpack8(vb[k], xb);
                float qk = 0.f;
#pragma unroll
                for (int i = 0; i < 8; ++i) { const float da = xa[i] - mu[k], db = xb[i] - mu[k]; qk += da * da + db * db; }
                rs[k] = qk;
            }
#pragma unroll
            for (int k = 0; k < 8; ++k) rs[k] = rsqrtf(wave_sum(rs[k]) * (1.0f / 1024.0f) + 1e-5f);
#pragma unroll
            for (int k = 0; k < 8; ++k) {
                float xa[8], xb[8]; unpack8(va[k], xa); unpack8(vb[k], xb);
                f32x4 y0, y1, y2, y3;
#pragma unroll
                for (int i = 0; i < 4; ++i) {
                    y0[i] = (xa[i] - mu[k]) * rs[k] * g0[i] + b0[i]; y1[i] = (xa[4 + i] - mu[k]) * rs[k] * g0[4 + i] + b0[4 + i];
                    y2[i] = (xb[i] - mu[k]) * rs[k] * g1[i] + b1[i]; y3[i] = (xb[4 + i] - mu[k]) * rs[k] * g1[4 + i] + b1[4 + i];
                }
                h16* op = x16 + xrow(rowb + k) * 1024 + lane * 8;
                *(u32x4*)op = pack8(y0, y1); *(u32x4*)(op + 512) = pack8(y2, y3);
            }
        }
        return;
    }
    f32x4 gg[4], bb[4];
#pragma unroll
    for (int i = 0; i < 4; ++i) { gg[i] = *(const f32x4*)(g + i * 256 + lane * 4); bb[i] = *(const f32x4*)(b + i * 256 + lane * 4); }
    for (int rowb = (blockIdx.x * 8 + wave) * 4; rowb < MTOK; rowb += gridDim.x * 32) {
        f32x4 v[4][4];
        float s[4];
#pragma unroll
        for (int k = 0; k < 4; ++k) {
            s[k] = 0.f;
            if (final_out) {
                const float* rp = tb + (size_t)(rowb + k) * 1024;
#pragma unroll
                for (int i = 0; i < 4; ++i) v[k][i] = *(const f32x4*)(rp + i * 256 + lane * 4);
            } else {
                const h16* hp = (const h16*)tb + (size_t)(rowb + k) * 1024;
#pragma unroll
                for (int i = 0; i < 4; ++i) { const h16x4 hv = *(const h16x4*)(hp + i * 256 + lane * 4); v[k][i] = (f32x4){(float)hv[0], (float)hv[1], (float)hv[2], (float)hv[3]}; }
            }
#pragma unroll
            for (int i = 0; i < 4; ++i) s[k] += (v[k][i][0] + v[k][i][1]) + (v[k][i][2] + v[k][i][3]);
        }
        wave_sum4(s);
        float q[4];
#pragma unroll
        for (int k = 0; k < 4; ++k) {
            s[k] *= (1.0f / 1024.0f); q[k] = 0.f;
#pragma unroll
            for (int i = 0; i < 4; ++i)
#pragma unroll
                for (int jj = 0; jj < 4; ++jj) { const float d = v[k][i][jj] - s[k]; q[k] += d * d; }
        }
        wave_sum4(q);
#pragma unroll
        for (int k = 0; k < 4; ++k) {
            const float rstd = rsqrtf(q[k] * (1.0f / 1024.0f) + 1e-5f);
            const int row = rowb + k;
#pragma unroll
            for (int i = 0; i < 4; ++i) {
                f32x4 y;
#pragma unroll
                for (int jj = 0; jj < 4; ++jj) y[jj] = (v[k][i][jj] - s[k]) * rstd * gg[i][jj] + bb[i][jj];
                if (final_out) *(f32x4*)(tb + (size_t)row * 1024 + i * 256 + lane * 4) = y;
                else { u32x2 w; w.x = pk2(y[0], y[1]); w.y = pk2(y[2], y[3]); *(u32x2*)(x16 + xrow(row) * 1024 + i * 256 + lane * 4) = w; }
            }
        }
    }
}

__device__ __forceinline__ void conv_phase(const Params& p, int layer) {
    const h16* u = (const h16*)(p.ws + F_U16);
    h16* act = (h16*)(p.ws + F_ACT);
    const float* cw = p.in[34] + (size_t)layer * 3 * 5632;
    const float* cb = p.in[35] + (size_t)layer * 5632;
    const size_t gtid = (size_t)blockIdx.x * 512 + opaque_tid(), nth = (size_t)gridDim.x * 512;
    const size_t ntask = (size_t)2048 * 352;
    for (size_t task = gtid; task < ntask; task += nth) {
        const int cgp = (int)(task % 352), rc = (int)(task / 352), f = cgp * 8, r0 = rc * 16;
        float wg[3][8], wv[3][8], bg[8], bv[8];
#pragma unroll
        for (int jj = 0; jj < 3; ++jj)
#pragma unroll
            for (int hlf = 0; hlf < 2; ++hlf) {
                const f32x4 a = *(const f32x4*)(cw + jj * 5632 + f + hlf * 4), c = *(const f32x4*)(cw + jj * 5632 + DFF + f + hlf * 4);
#pragma unroll
                for (int e = 0; e < 4; ++e) { wg[jj][hlf * 4 + e] = a[e]; wv[jj][hlf * 4 + e] = c[e]; }
            }
#pragma unroll
        for (int hlf = 0; hlf < 2; ++hlf) {
            const f32x4 a = *(const f32x4*)(cb + f + hlf * 4), c = *(const f32x4*)(cb + DFF + f + hlf * 4);
#pragma unroll
            for (int e = 0; e < 4; ++e) { bg[hlf * 4 + e] = a[e]; bv[hlf * 4 + e] = c[e]; }
        }
        float g2[8], g1[8], v2[8], v1[8];
#pragma unroll
        for (int e = 0; e < 8; ++e) { g2[e] = 0.f; g1[e] = 0.f; v2[e] = 0.f; v1[e] = 0.f; }
        if ((r0 & 2047) != 0) {
            unpack8(*(const u32x4*)(u + (size_t)(r0 - 2) * 5632 + f), g2); unpack8(*(const u32x4*)(u + (size_t)(r0 - 1) * 5632 + f), g1);
            unpack8(*(const u32x4*)(u + (size_t)(r0 - 2) * 5632 + DFF + f), v2); unpack8(*(const u32x4*)(u + (size_t)(r0 - 1) * 5632 + DFF + f), v1);
        }
#pragma unroll 1
        for (int i0 = 0; i0 < 16; i0 += 4) {
            u32x4 lg[4], lv[4];
#pragma unroll
            for (int i = 0; i < 4; ++i) { const size_t ro = (size_t)(r0 + i0 + i) * 5632; lg[i] = *(const u32x4*)(u + ro + f); lv[i] = *(const u32x4*)(u + ro + DFF + f); }
#pragma unroll
            for (int i = 0; i < 4; ++i) {
                float g0[8], v0[8], o[8];
                unpack8(lg[i], g0); unpack8(lv[i], v0);
#pragma unroll
                for (int e = 0; e < 8; ++e) {
                    const float G = wg[0][e] * g2[e] + wg[1][e] * g1[e] + wg[2][e] * g0[e] + bg[e];
                    const float V = wv[0][e] * v2[e] + wv[1][e] * v1[e] + wv[2][e] * v0[e] + bv[e];
                    o[e] = G * sigmoidf_(G) * V;
                    g2[e] = g1[e]; g1[e] = g0[e]; v2[e] = v1[e]; v1[e] = v0[e];
                }
                __builtin_nontemporal_store(pack8((f32x4){o[0], o[1], o[2], o[3]}, (f32x4){o[4], o[5], o[6], o[7]}), (u32x4*)(act + (size_t)(r0 + i0 + i) * DFF + f));
            }
        }
    }
}

__device__ __forceinline__ void mix_phase(const Params& p, int j) {
    const h16* x16 = (const h16*)(p.ws + OFF_X16);
    h16* xr = (h16*)p.out; h16* xk = (h16*)p.out + (size_t)MTOK * 1024; h16* xv = (h16*)(p.ws + R_G16);
    const float* mix = p.in[3] + j * 6 * 1024;
    const size_t gtid = (size_t)blockIdx.x * 512 + opaque_tid(), nth = (size_t)gridDim.x * 512;
    for (size_t idx = gtid; idx < (size_t)MTOK * 128; idx += nth) {
        const int row = (int)(idx >> 7), c8 = (int)(idx & 127) * 8;
        const h16* xp = x16 + xrow(row) * 1024 + c8;
        float xc[8], xq[8];
        unpack8(*(const u32x4*)xp, xc); unpack8(*(const u32x4*)(xp - 1024), xq);
#pragma unroll
        for (int e = 0; e < 8; ++e) xq[e] -= xc[e];
        const size_t o = (size_t)row * 1024 + c8;
#pragma unroll
        for (int bsel = 0; bsel < 3; ++bsel) {
            const f32x4 m0 = *(const f32x4*)(mix + bsel * 1024 + c8), m1 = *(const f32x4*)(mix + bsel * 1024 + c8 + 4);
            f32x4 a, b;
#pragma unroll
            for (int e = 0; e < 4; ++e) { a[e] = xc[e] + xq[e] * m0[e]; b[e] = xc[4 + e] + xq[4 + e] * m1[e]; }
            h16* dst = bsel == 0 ? xr : (bsel == 1 ? xk : xv);
            __builtin_nontemporal_store(pack8(a, b), (u32x4*)(dst + o));
        }
    }
}

__device__ __forceinline__ void unpack4(u32x2 w, float* f) {
    h16x4 h = __builtin_bit_cast(h16x4, w);
#pragma unroll
    for (int i = 0; i < 4; ++i) f[i] = (float)h[i];
}
constexpr int SCAN_BUF = 8256;
__device__ __forceinline__ void scan_phase(const Params& p, int j, unsigned char* smem) {
    const int tid = opaque_tid();
    const int wave = tid >> 6, lane = tid & 63, slot = wave >> 2, w4 = wave & 3;
    float* LB = (float*)smem + slot * (2 * SCAN_BUF);
    const h16* r16 = (const h16*)(p.ws + R_R16);
    const h16* k16 = (const h16*)(p.ws + R_K16);
    const h16* v16 = (j == 0) ? (const h16*)(p.ws + OFF_VF) : (const h16*)(p.ws + R_V16);
    const h16* g16 = (const h16*)(p.ws + R_G16);
    const h16* e16 = (const h16*)p.out;
    const h16* a16 = (const h16*)p.out + (size_t)MTOK * 1024;
    h16* y16 = (h16*)(p.ws + (j == 0 ? R_V16 : OFF_VF));
    const int tp = w4 * 4 + (lane >> 4), k4 = (lane & 15) * 4;
    const int vrow = w4 * 16 + (lane >> 2), kq = lane & 3;
    for (int pair = blockIdx.x; pair < 256; pair += gridDim.x) {
        const int chain = pair * 2 + slot, b = chain >> 4, h = chain & 15;
        const int col = h * 64 + k4;
        const f32x4 c_kk = *(const f32x4*)(p.in[16] + j * 1024 + col), c_ka = *(const f32x4*)(p.in[17] + j * 1024 + col), c_rk = *(const f32x4*)(p.in[18] + j * 1024 + col);
        const f32x4 c_lg = *(const f32x4*)(p.in[19] + j * 1024 + col), c_lb = *(const f32x4*)(p.in[20] + j * 1024 + col);
        f32x2 S[8];
#pragma unroll
        for (int i = 0; i < 8; ++i) S[i] = (f32x2){0.f, 0.f};
        u32x2 pr[6];
        {
            const size_t go = ((size_t)(b * 2048 + tp)) * 1024 + col;
            pr[0] = *(const u32x2*)(r16 + go); pr[1] = *(const u32x2*)(k16 + go); pr[2] = *(const u32x2*)(v16 + go);
            pr[3] = *(const u32x2*)(e16 + go); pr[4] = *(const u32x2*)(a16 + go); pr[5] = *(const u32x2*)(g16 + go);
        }
        for (int ch = 0; ch < 128; ++ch) {
            float* BUF = LB + (ch & 1) * SCAN_BUF;
            float* OPS = BUF; float* VB = BUF + 5120; float* GB = BUF + 6144; float* YB = BUF + 7168; float* BON = BUF + 8192;
            {
                float rf[4], kf[4], vf[4], ef[4], af[4], gf[4];
                unpack4(pr[0], rf); unpack4(pr[1], kf); unpack4(pr[2], vf); unpack4(pr[3], ef); unpack4(pr[4], af); unpack4(pr[5], gf);
                float kk[4]; float ss = 0.f;
#pragma unroll
                for (int i = 0; i < 4; ++i) { kk[i] = kf[i] * c_kk[i]; ss += kk[i] * kk[i]; }
                ss = red16(ss);
                const float inv = 1.0f / fmaxf(sqrtf(ss), 1e-12f);
                f32x4 A4, B4, W4, K4, R4; float bs = 0.f;
#pragma unroll
                for (int i = 0; i < 4; ++i) {
                    const float kn = kk[i] * inv;
                    A4[i] = -kn; B4[i] = kn * af[i];
                    W4[i] = __expf(-ef[i]);
                    const float km = kf[i] * (1.0f + (af[i] - 1.0f) * c_ka[i]);
                    K4[i] = km; R4[i] = rf[i];
                    bs += rf[i] * km * c_rk[i];
                }
                bs = red16(bs);
                float* o = OPS + tp * 320 + k4;
                *(f32x4*)(o) = A4; *(f32x4*)(o + 64) = B4; *(f32x4*)(o + 128) = W4; *(f32x4*)(o + 192) = K4; *(f32x4*)(o + 256) = R4;
                *(f32x4*)(VB + tp * 64 + k4) = (f32x4){vf[0], vf[1], vf[2], vf[3]};
                *(f32x4*)(GB + tp * 64 + k4) = (f32x4){gf[0], gf[1], gf[2], gf[3]};
                if ((lane & 15) == 0) BON[tp] = bs;
            }
            if (ch + 1 < 128) {
                const size_t go = ((size_t)(b * 2048 + (ch + 1) * 16 + tp)) * 1024 + col;
                pr[0] = *(const u32x2*)(r16 + go); pr[1] = *(const u32x2*)(k16 + go); pr[2] = *(const u32x2*)(v16 + go);
                pr[3] = *(const u32x2*)(e16 + go); pr[4] = *(const u32x2*)(a16 + go); pr[5] = *(const u32x2*)(g16 + go);
            }
            __syncthreads();
#pragma unroll 2
            for (int t = 0; t < 16; ++t) {
                const float* op = OPS + t * 320 + kq * 16;
                f32x4 A4[4], B4[4], W4[4], K4[4], R4[4];
#pragma unroll
                for (int i = 0; i < 4; ++i) A4[i] = *(const f32x4*)(op + i * 4);
#pragma unroll
                for (int i = 0; i < 4; ++i) { W4[i] = *(const f32x4*)(op + 128 + i * 4); B4[i] = *(const f32x4*)(op + 64 + i * 4); K4[i] = *(const f32x4*)(op + 192 + i * 4); }
#pragma unroll
                for (int i = 0; i < 4; ++i) R4[i] = *(const f32x4*)(op + 256 + i * 4);
                const float vv = VB[t * 64 + vrow];
                f32x2 s0 = {0.f, 0.f}, s1 = {0.f, 0.f};
#pragma unroll
                for (int i = 0; i < 4; ++i) { s0 += S[2 * i] * (f32x2){A4[i][0], A4[i][1]}; s1 += S[2 * i + 1] * (f32x2){A4[i][2], A4[i][3]}; }
                const float sa = red4((s0[0] + s0[1]) + (s1[0] + s1[1]));
                const f32x2 sa2 = {sa, sa}, vv2 = {vv, vv};
#pragma unroll
                for (int i = 0; i < 4; ++i) {
                    S[2 * i] = S[2 * i] * (f32x2){W4[i][0], W4[i][1]} + sa2 * (f32x2){B4[i][0], B4[i][1]} + vv2 * (f32x2){K4[i][0], K4[i][1]};
                    S[2 * i + 1] = S[2 * i + 1] * (f32x2){W4[i][2], W4[i][3]} + sa2 * (f32x2){B4[i][2], B4[i][3]} + vv2 * (f32x2){K4[i][2], K4[i][3]};
                }
                f32x2 y0 = {0.f, 0.f}, y1 = {0.f, 0.f};
#pragma unroll
                for (int i = 0; i < 4; ++i) { y0 += S[2 * i] * (f32x2){R4[i][0], R4[i][1]}; y1 += S[2 * i + 1] * (f32x2){R4[i][2], R4[i][3]}; }
                const float y = red4((y0[0] + y0[1]) + (y1[0] + y1[1]));
                if (kq == 0) YB[t * 64 + vrow] = y;
            }
            __syncthreads();
            {
                const f32x4 y4 = *(const f32x4*)(YB + tp * 64 + k4), v4 = *(const f32x4*)(VB + tp * 64 + k4), g4 = *(const f32x4*)(GB + tp * 64 + k4);
                const float mu = red16((y4[0] + y4[1]) + (y4[2] + y4[3])) * (1.0f / 64.0f);
                float q = 0.f;
#pragma unroll
                for (int i = 0; i < 4; ++i) { const float d = y4[i] - mu; q += d * d; }
                const float rstd = rsqrtf(red16(q) * (1.0f / 64.0f) + 64e-5f);
                const float bon = BON[tp];
                float o[4];
#pragma unroll
                for (int i = 0; i < 4; ++i) o[i] = ((y4[i] - mu) * rstd * c_lg[i] + c_lb[i] + bon * v4[i]) * g4[i];
                u32x2 w; w.x = pk2(o[0], o[1]); w.y = pk2(o[2], o[3]);
                *(u32x2*)(y16 + ((size_t)(b * 2048 + ch * 16 + tp)) * 1024 + col) = w;
            }
        }
        __syncthreads();
    }
}

__device__ __forceinline__ void dsa_norm_phase(const Params& p, int j, unsigned char* smem) {
    const int tid = opaque_tid();
    const int lane = tid & 63, wave = tid >> 6;
    const float* hin = (const float*)(p.ws + D_HIN);
    h16* cq = (h16*)(p.ws + D_CQ); h16* ckv = (h16*)(p.ws + D_CKV); h16* ckvt = (h16*)(p.ws + D_CKVT); h16* kidx = (h16*)(p.ws + D_KIDX);
    float* widx = (float*)(p.ws + D_WIDX);
    const f32x4 gq = *(const f32x4*)(p.in[23] + j * 256 + lane * 4);
    const f32x2 gkv = *(const f32x2*)(p.in[24] + j * 128 + lane * 2);
    const float gi = p.in[29][j * 64 + lane], bi = p.in[30][j * 64 + lane];
    h16* wl = (h16*)(smem + wave * 2048);
    for (int grp = blockIdx.x * 8 + wave; grp < MTOK / 8; grp += gridDim.x * 8) {
        const int r0 = grp * 8;
        for (int i = 0; i < 8; ++i) {
            const int row = r0 + i;
            const float* hp = hin + (size_t)row * 512;
            const f32x4 vq = *(const f32x4*)(hp + lane * 4);
            const f32x2 vk = *(const f32x2*)(hp + 256 + lane * 2);
            const float vi = hp[384 + lane];
            float ssq = wave_sum(vq[0] * vq[0] + vq[1] * vq[1] + vq[2] * vq[2] + vq[3] * vq[3]);
            const float rq = rsqrtf(ssq * (1.0f / 256.0f) + 1e-6f);
            u32x2 w; w.x = pk2(vq[0] * rq * gq[0], vq[1] * rq * gq[1]); w.y = pk2(vq[2] * rq * gq[2], vq[3] * rq * gq[3]);
            *(u32x2*)(cq + (size_t)row * 256 + lane * 4) = w;
            float ssk = wave_sum(vk[0] * vk[0] + vk[1] * vk[1]);
            const float rk = rsqrtf(ssk * (1.0f / 128.0f) + 1e-6f);
            const unsigned wk = pk2(vk[0] * rk * gkv[0], vk[1] * rk * gkv[1]);
            *(unsigned*)(ckv + (size_t)row * 128 + lane * 2) = wk;
            const float mu = wave_sum(vi) * (1.0f / 64.0f);
            const float dv = vi - mu;
            const float var = wave_sum(dv * dv) * (1.0f / 64.0f);
            kidx[(size_t)row * 64 + lane] = (h16)(dv * rsqrtf(var + 1e-5f) * gi + bi);
            if (lane < 8) widx[(size_t)row * 8 + lane] = hp[448 + lane] * 0.044194173824159216f;
        }
    }
}

constexpr int ROWP = 2052;
__device__ __forceinline__ unsigned fkey(float x) {
    if (x == 0.0f) x = 0.0f;
    const unsigned u = __float_as_uint(x);
    return (u & 0x80000000u) ? ~u : (u | 0x80000000u);
}
__device__ __forceinline__ void dsa_index_phase(const Params& p, unsigned char* smem) {
    const int tid = opaque_tid(), wave = tid >> 6, lane = tid & 63, r = lane & 15, q = lane >> 4;
    float* SC = (float*)smem;
    const h16* qidx = (const h16*)(p.ws + D_QIDX);
    const h16* kidx = (const h16*)(p.ws + D_KIDX);
    const float* widx = (const float*)(p.ws + D_WIDX);
    unsigned short* selout = (unsigned short*)(p.ws + D_MASK);
    h16x8 qf[8][2]; float wq[8];
    if ((int)blockIdx.x < MTOK / 16) {
        const int row0 = (int)blockIdx.x * 16;
#pragma unroll
        for (int h = 0; h < 8; ++h) {
#pragma unroll
            for (int kk = 0; kk < 2; ++kk) qf[h][kk] = *(const h16x8*)(qidx + (size_t)(row0 + r) * 512 + h * 64 + kk * 32 + q * 8);
            wq[h] = widx[(size_t)(row0 + r) * 8 + h];
        }
    }
    for (int qi = blockIdx.x, it = 0; qi < MTOK / 16; qi += gridDim.x, ++it) {
        const int qt = (it & 1) ? ((qi & ~127) | (127 - (qi & 127))) : qi;
        const int row0 = qt * 16, b = row0 >> 11, t0 = row0 & 2047;
        const int nkt = (t0 >> 4) + 1;
        {
            h16x8 kn[4];
            if (wave < nkt) {
                const bool two = (wave + 8 < nkt);
                const int s0 = wave * 16, s1 = two ? s0 + 128 : s0;
                const h16* kp = kidx + (size_t)(b * 2048 + s0 + r) * 64 + q * 8;
                const h16* kp1 = kidx + (size_t)(b * 2048 + s1 + r) * 64 + q * 8;
                kn[0] = *(const h16x8*)kp; kn[1] = *(const h16x8*)(kp + 32); kn[2] = *(const h16x8*)kp1; kn[3] = *(const h16x8*)(kp1 + 32);
            }
            for (int kt = wave; kt < nkt; kt += 16) {
                const bool two = (kt + 8 < nkt);
                const int s0 = kt * 16, s1 = two ? s0 + 128 : s0;
                const h16x8 k0 = kn[0], k1 = kn[1], k2 = kn[2], k3 = kn[3];
                if (kt + 16 < nkt) {
                    const bool two2 = (kt + 24 < nkt);
                    const int n0 = (kt + 16) * 16, n1 = two2 ? n0 + 128 : n0;
                    const h16* kp = kidx + (size_t)(b * 2048 + n0 + r) * 64 + q * 8;
                    const h16* kp1 = kidx + (size_t)(b * 2048 + n1 + r) * 64 + q * 8;
                    kn[0] = *(const h16x8*)kp; kn[1] = *(const h16x8*)(kp + 32); kn[2] = *(const h16x8*)kp1; kn[3] = *(const h16x8*)(kp1 + 32);
                }
                f32x4 sc = {0.f, 0.f, 0.f, 0.f}, sd = {0.f, 0.f, 0.f, 0.f};
#pragma unroll
                for (int h = 0; h < 8; ++h) {
                    f32x4 acc = {0.f, 0.f, 0.f, 0.f}, acd = {0.f, 0.f, 0.f, 0.f};
                    acc = __builtin_amdgcn_mfma_f32_16x16x32_f16(k0, qf[h][0], acc, 0, 0, 0);
                    acd = __builtin_amdgcn_mfma_f32_16x16x32_f16(k2, qf[h][0], acd, 0, 0, 0);
                    acc = __builtin_amdgcn_mfma_f32_16x16x32_f16(k1, qf[h][1], acc, 0, 0, 0);
                    acd = __builtin_amdgcn_mfma_f32_16x16x32_f16(k3, qf[h][1], acd, 0, 0, 0);
#pragma unroll
                    for (int jj = 0; jj < 4; ++jj) { sc[jj] += fmaxf(acc[jj], 0.f) * wq[h]; sd[jj] += fmaxf(acd[jj], 0.f) * wq[h]; }
                }
                *(f32x4*)(SC + r * ROWP + s0 + q * 4) = sc;
                if (two) *(f32x4*)(SC + r * ROWP + s1 + q * 4) = sd;
            }
            const int qin = qi + (int)gridDim.x;
            if (qin < MTOK / 16) {
                const int qtn = ((it + 1) & 1) ? ((qin & ~127) | (127 - (qin & 127))) : qin;
                const int rown = qtn * 16;
#pragma unroll
                for (int h = 0; h < 8; ++h) {
#pragma unroll
                    for (int kk = 0; kk < 2; ++kk) qf[h][kk] = *(const h16x8*)(qidx + (size_t)(rown + r) * 512 + h * 64 + kk * 32 + q * 8);
                    wq[h] = widx[(size_t)(rown + r) * 8 + h];
                }
            }
        }
        __syncthreads();
        for (int qq = 0; qq < 2; ++qq) {
            const int ql = wave * 2 + qq, t = t0 + ql;
            const float* srow = SC + ql * ROWP;
            const int ni = (t >> 6) + 1;
            unsigned u[32];
#pragma unroll
            for (int i = 0; i < 32; ++i) {
                u[i] = 0u;
                if (i < ni) { const int s = i * 64 + lane; if (s <= t) u[i] = fkey(srow[s]); }
            }
            unsigned short* selrow = selout + (size_t)(row0 + ql) * 256;
            if (t < 256) {
#pragma unroll
                for (int i = 0; i < 4; ++i) { const int pp = i * 64 + lane; selrow[pp] = (unsigned short)(pp <= t ? pp : 0xFFFF); }
            } else {
                unsigned* H = (unsigned*)(smem + 16 * ROWP * 4) + wave * 256;
                unsigned prefix = 0u; int need = 256;
#pragma unroll 1
                for (int pass = 0; pass < 4; ++pass) {
                    const int shift = 24 - 8 * pass;
                    const unsigned hmask = pass == 0 ? 0u : (0xFFFFFFFFu << (shift + 8));
                    *(u32x4*)(H + lane * 4) = (u32x4){0u, 0u, 0u, 0u};
                    asm volatile("s_waitcnt lgkmcnt(0)" ::: "memory");
#pragma unroll
                    for (int i = 0; i < 32; ++i) if (i < ni) { const unsigned uu = u[i]; if (uu != 0u && (uu & hmask) == prefix) atomicAdd(H + ((uu >> shift) & 255u), 1u); }
                    asm volatile("s_waitcnt lgkmcnt(0)" ::: "memory");
                    const u32x4 hv = *(const u32x4*)(H + lane * 4);
                    const int tot = (int)(hv.x + hv.y + hv.z + hv.w);
                    int rs = tot;
                    rs += __builtin_amdgcn_update_dpp(0, rs, 0xB1, 0xF, 0xF, true);
                    rs += __builtin_amdgcn_update_dpp(0, rs, 0x4E, 0xF, 0xF, true);
                    rs += __builtin_amdgcn_update_dpp(0, rs, 0x141, 0xF, 0xF, true);
                    rs += __builtin_amdgcn_update_dpp(0, rs, 0x140, 0xF, 0xF, true);
                    int rowsel = 3, above = 0;
                    {
                        const int r3 = __builtin_amdgcn_readlane(rs, 48), r2 = __builtin_amdgcn_readlane(rs, 32), r1 = __builtin_amdgcn_readlane(rs, 16);
                        if (need > r3) { above = r3; rowsel = 2; if (need > above + r2) { above += r2; rowsel = 1; if (need > above + r1) { above += r1; rowsel = 0; } } }
                    }
                    int lsel = rowsel * 16;
                    for (int k = 15; k >= 0; --k) {
                        const int cl = __builtin_amdgcn_readlane(tot, rowsel * 16 + k);
                        if (need <= above + cl) { lsel = rowsel * 16 + k; break; }
                        above += cl;
                    }
                    const int b3 = __builtin_amdgcn_readlane((int)hv.w, lsel), b2 = __builtin_amdgcn_readlane((int)hv.z, lsel), b1 = __builtin_amdgcn_readlane((int)hv.y, lsel);
                    int bsel = 3;
                    if (need > above + b3) { above += b3; bsel = 2; if (need > above + b2) { above += b2; bsel = 1; if (need > above + b1) { above += b1; bsel = 0; } } }
                    prefix |= (unsigned)(lsel * 4 + bsel) << shift;
                    need -= above;
                }
                const unsigned T = prefix;
                int running = 0, outpos = 0;
                const unsigned long long lt = (lane == 0) ? 0ull : (~0ull >> (64 - lane));
#pragma unroll
                for (int i = 0; i < 32; ++i) {
                    if (i < ni) {
                        const unsigned long long eq = __ballot(u[i] == T);
                        const int rank = running + __popcll(eq & lt);
                        const bool sel = u[i] > T || (u[i] == T && rank < need);
                        const unsigned long long sm = __ballot(sel);
                        running += __popcll(eq);
                        if (sel) selrow[outpos + __popcll(sm & lt)] = (unsigned short)(i * 64 + lane);
                        outpos += __popcll(sm);
                    }
                }
            }
        }
        __syncthreads();
    }
}

typedef __fp16 fp16x4_t __attribute__((__vector_size__(4 * sizeof(__fp16))));
__device__ __forceinline__ unsigned off_b(unsigned row, unsigned ch) { return 256u * row + 16u * (ch ^ (((row & 3) << 2) | ((row >> 2) & 3))); }
constexpr int SA_TILE = 8192, SA_BL = 8 * 2 * SA_TILE;
static_assert(SA_BL + 16 * 132 * 4 <= LDS_BYTES, "sparse attention LDS");
__device__ __forceinline__ void dsa_attn_phase(const Params& p, int j, unsigned char* smem) {
    const int tid = opaque_tid(), wave = tid >> 6, lane = tid & 63, r = lane & 15, q = lane >> 4;
    float* BL = (float*)(smem + SA_BL);
    for (int idx = tid; idx < 16 * 129; idx += 512) {
        const int h = idx / 129, d = idx % 129;
        int bk = d;
        if (d >= 16) { bk = 16 + (int)(logf((float)d * (1.0f / 16.0f)) / 2.0794415416798357f * 16.0f); bk = bk > 31 ? 31 : bk; }
        BL[h * 132 + d] = p.in[32][bk * 16 + h] * 1.4426950408889634f;
    }
    __syncthreads();
    const h16* qabs = (const h16*)(p.ws + D_QABS);
    const h16* ckv = (const h16*)(p.ws + D_CKV);
    const unsigned short* sel = (const unsigned short*)(p.ws + D_MASK);
    h16* olatA = (h16*)(p.ws + D_HIN);
    h16* olatB = (h16*)p.out + (size_t)MTOK * 1024;
    unsigned char* tile0 = smem + wave * (2 * SA_TILE);
    const float NINF = -__builtin_inff();
    unsigned wofs[8], kofs[2][4], vofs[8][2];
#pragma unroll
    for (int i = 0; i < 8; ++i) wofs[i] = off_b(8 * q + i, r);
#pragma unroll
    for (int tt = 0; tt < 2; ++tt)
#pragma unroll
        for (int kk = 0; kk < 4; ++kk) kofs[tt][kk] = off_b(8 * (r >> 2) + 4 * tt + (r & 3), 4 * kk + q);
#pragma unroll
    for (int c = 0; c < 8; ++c)
#pragma unroll
        for (int t2 = 0; t2 < 2; ++t2) vofs[c][t2] = off_b(8 * q + 4 * t2 + (r >> 2), 2 * c + ((lane & 3) >> 1)) + 8 * (lane & 1);
    for (int row = blockIdx.x * 8 + wave; row < MTOK; row += gridDim.x * 8) {
        const int b = row >> 11, t = row & 2047;
        const int nvalid = t + 1 < 256 ? t + 1 : 256, ng = (nvalid + 31) >> 5;
        const h16* kg = ckv + (size_t)(b * 2048) * 128;
        const unsigned short* srow = sel + (size_t)row * 256;
        h16x8 qf[4];
#pragma unroll
        for (int kk = 0; kk < 4; ++kk) qf[kk] = *(const h16x8*)(qabs + (size_t)row * 2048 + r * 128 + kk * 32 + q * 8);
        f32x4 O[8];
#pragma unroll
        for (int dt = 0; dt < 8; ++dt) O[dt] = (f32x4){0.f, 0.f, 0.f, 0.f};
        float mrun = NINF, lrun = 0.f;
        u32x4 selA = *(const u32x4*)(srow + 8 * q), selB = selA;
        u32x4 grA[8], grB[8];
#define SA_GATHER(GR, SELV) do { _Pragma("unroll") for (int i = 0; i < 8; ++i) { \
            unsigned sidx = ((SELV)[i >> 1] >> ((i & 1) * 16)) & 0xFFFFu; sidx = sidx == 0xFFFFu ? 0u : sidx; \
            (GR)[i] = *(const u32x4*)(kg + (size_t)sidx * 128 + r * 8); } } while (0)
#define SA_GROUP(GR, SELV, G) do { \
            unsigned char* tile = tile0 + ((G) & 1) * SA_TILE; \
            const u32x4 selc = (SELV); \
            _Pragma("unroll") for (int i = 0; i < 8; ++i) *(u32x4*)(tile + wofs[i]) = (GR)[i]; \
            if ((G) + 2 < ng) { (SELV) = *(const u32x4*)(srow + ((G) + 2) * 32 + 8 * q); SA_GATHER(GR, SELV); } \
            asm volatile("s_waitcnt lgkmcnt(0)" ::: "memory"); \
            f32x4 sc[2]; \
            _Pragma("unroll") for (int tt = 0; tt < 2; ++tt) { \
                f32x4 acc = {0.f, 0.f, 0.f, 0.f}; \
                _Pragma("unroll") for (int kk = 0; kk < 4; ++kk) { \
                    const h16x8 kf = *(const h16x8*)(tile + kofs[tt][kk]); \
                    acc = __builtin_amdgcn_mfma_f32_16x16x32_f16(kf, qf[kk], acc, 0, 0, 0); } \
                sc[tt] = acc; } \
            float x[8]; float mx = NINF; \
            _Pragma("unroll") for (int i = 0; i < 8; ++i) { \
                const unsigned sidx = (selc[i >> 1] >> ((i & 1) * 16)) & 0xFFFFu; \
                int dist = t - (int)sidx; dist = dist < 0 ? 0 : (dist > 128 ? 128 : dist); \
                const float v = sc[i >> 2][i & 3] + BL[r * 132 + dist]; \
                const float xv = (sidx != 0xFFFFu) ? v : NINF; \
                x[i] = xv; mx = fmaxf(mx, xv); } \
            mx = xmax_16_32(mx); \
            const float mnew = fmaxf(mrun, mx); \
            const float mref = (mnew == NINF) ? 0.f : mnew; \
            const float alpha = __builtin_amdgcn_exp2f(mrun - mref); \
            mrun = mnew; \
            float ps = 0.f; h16x8 pf; \
            _Pragma("unroll") for (int i = 0; i < 8; ++i) { const float pv = __builtin_amdgcn_exp2f(x[i] - mref); ps += pv; pf[i] = (h16)pv; } \
            lrun = lrun * alpha + ps; \
            _Pragma("unroll") for (int dt = 0; dt < 8; ++dt) { \
                const fp16x4_t lo = __builtin_amdgcn_ds_read_tr16_b64_v4f16((LAS fp16x4_t*)(tile + vofs[dt][0])); \
                const fp16x4_t hi = __builtin_amdgcn_ds_read_tr16_b64_v4f16((LAS fp16x4_t*)(tile + vofs[dt][1])); \
                const h16x4 l4 = __builtin_bit_cast(h16x4, lo), h4 = __builtin_bit_cast(h16x4, hi); \
                const h16x8 vf = {l4[0], l4[1], l4[2], l4[3], h4[0], h4[1], h4[2], h4[3]}; \
                O[dt] *= alpha; \
                O[dt] = __builtin_amdgcn_mfma_f32_16x16x32_f16(vf, pf, O[dt], 0, 0, 0); } \
        } while (0)
        SA_GATHER(grA, selA);
        if (ng > 1) { selB = *(const u32x4*)(srow + 32 + 8 * q); SA_GATHER(grB, selB); }
        for (int g = 0; g < ng; g += 2) {
            SA_GROUP(grA, selA, g);
            if (g + 1 < ng) SA_GROUP(grB, selB, g + 1);
        }
#undef SA_GATHER
#undef SA_GROUP
        const float inv = 1.0f / xsum_16_32(lrun);
        h16* op = (row < MTOK / 2 ? olatA + (size_t)row * 2048 : olatB + (size_t)(row - MTOK / 2) * 2048) + r * 128 + q * 4;
#pragma unroll
        for (int dt = 0; dt < 8; ++dt) {
            u32x2 w; w.x = pk2(O[dt][0] * inv, O[dt][1] * inv); w.y = pk2(O[dt][2] * inv, O[dt][3] * inv);
            *(u32x2*)(op + dt * 16) = w;
        }
        asm volatile("s_waitcnt lgkmcnt(0)" ::: "memory");
    }
    __syncthreads();
}

constexpr size_t OFF_BAR = 951 * MiB;
#define XB_TMO      128
#define XB_XCNT(j)  (256  + 64 * (j))
#define XB_XSUB(j)  (1280 + 64 * (j))
#define XB_XGEN(j)  (2304 + 64 * (j))
#define XB_TOP      3328
#define XB_TOPGEN   3392
#define XCD_BAR_WORDS 3456
#define XB_SPIN_CAP (1u << 22)
__device__ __forceinline__ unsigned xb_ld(unsigned* p)              { return __hip_atomic_load(p, __ATOMIC_RELAXED, __HIP_MEMORY_SCOPE_AGENT); }
__device__ __forceinline__ unsigned xb_add(unsigned* p, unsigned v) { return __hip_atomic_fetch_add(p, v, __ATOMIC_RELAXED, __HIP_MEMORY_SCOPE_AGENT); }
__device__ __forceinline__ unsigned xb_xcc_id() { return (unsigned)__builtin_amdgcn_s_getreg((3 << 11) | 20) & 0xFu; }
#define XB_SPIN(cond, bar) do { unsigned _sp = 0; while (cond) { __builtin_amdgcn_s_sleep(1); \
    if ((++_sp & 255u) == 0u) { if (xb_ld(&(bar)[XB_TMO])) break; if (_sp > XB_SPIN_CAP) { atomicAdd(&(bar)[XB_TMO], 1u); break; } } } } while (0)
struct XcdBarrier { unsigned* bar; unsigned x; volatile LAS unsigned* st; };
__device__ __forceinline__ XcdBarrier xcd_barrier_post(unsigned* bar, volatile LAS unsigned* st) {
    XcdBarrier b; b.bar = bar; b.x = xb_xcc_id(); b.st = st;
    if (threadIdx.x == 0) (void)xb_add(&bar[XB_XCNT(b.x)], 1u);
    return b;
}
__device__ __forceinline__ void xcd_barrier_complete(unsigned* bar, unsigned x, unsigned& nloc, unsigned& nx) {
    const unsigned G = gridDim.x * gridDim.y * gridDim.z;
    unsigned sum, cnt, mine, sp = 0u;
    for (;;) {
        sum = 0u; cnt = 0u; mine = 0u;
#pragma unroll
        for (unsigned jx = 0; jx < 16; ++jx) { const unsigned c = xb_ld(&bar[XB_XCNT(jx)]); sum += c; cnt += (c > 0u) ? 1u : 0u; mine = (jx == x) ? c : mine; }
        if (sum == G) break;
        __builtin_amdgcn_s_sleep(1);
        if ((++sp & 255u) == 0u) { if (xb_ld(&bar[XB_TMO])) break; if (sp > XB_SPIN_CAP) { atomicAdd(&bar[XB_TMO], 1u); break; } }
    }
    nloc = mine > 0u ? mine : 1u; nx = cnt > 0u ? cnt : 1u;
}
__device__ __forceinline__ void xcd_barrier(const XcdBarrier& b) {
    asm volatile("s_waitcnt vmcnt(0)" ::: "memory");
    __syncthreads();
    if (threadIdx.x == 0) {
        unsigned* bar = b.bar;
        __builtin_amdgcn_s_waitcnt(0);
        unsigned nloc = b.st[0], nx = b.st[1];
        if (nloc == 0u) { xcd_barrier_complete(bar, b.x, nloc, nx); b.st[0] = nloc; b.st[1] = nx; }
        const unsigned old = xb_add(&bar[XB_XSUB(b.x)], 1u);
        const unsigned gen = old / nloc;
        if (old + 1u == (gen + 1u) * nloc) {
            __builtin_amdgcn_fence(__ATOMIC_RELEASE, "agent");
            asm volatile("s_waitcnt vmcnt(0)" ::: "memory");
            const unsigned og = xb_add(&bar[XB_TOP], 1u);
            const unsigned tg = og / nx;
            if (og + 1u == (tg + 1u) * nx) xb_add(&bar[XB_TOPGEN], 1u);
            else XB_SPIN(xb_ld(&bar[XB_TOPGEN]) == tg, bar);
            __builtin_amdgcn_fence(__ATOMIC_ACQUIRE, "agent");
            xb_add(&bar[XB_XGEN(b.x)], 1u);
            asm volatile("s_waitcnt vmcnt(0)" ::: "memory");
        } else {
            XB_SPIN(xb_ld(&bar[XB_XGEN(b.x)]) == gen, bar);
            __builtin_amdgcn_fence(__ATOMIC_ACQUIRE, "agent");
            asm volatile("s_waitcnt vmcnt(0)" ::: "memory");
        }
    }
    __syncthreads();
}

__global__ void __launch_bounds__(512) mega_fwd(Params p) {
    extern __shared__ __attribute__((aligned(16))) unsigned char smem[];
    cg::grid_group grid = cg::this_grid();
    unsigned char* ws = p.ws;
    h16* x16 = (h16*)(ws + OFF_X16);
    volatile LAS unsigned* xbst = (volatile LAS unsigned*)(smem + LDS_BYTES - 16);
    if (threadIdx.x == 0) { xbst[0] = 0u; xbst[1] = 0u; }
    __syncthreads();
    const XcdBarrier xbar = xcd_barrier_post((unsigned*)(ws + OFF_BAR), xbst);
    for (int ph = p.ph_lo; ph < p.ph_hi; ++ph) {
        const unsigned e = p.prog[ph];
        const int kind = e & 15, L = (e >> 4) & 3, sub = (e >> 6) & 1, j = L >> 1;
        const int nrep = 1 + (int)(e >> 7);
        for (int rep = 0; rep < nrep; ++rep) {
        if (rep) xcd_barrier(xbar);
        const bool isgemm = (kind == K_R1 || kind == K_R2 || kind == K_R4 || kind == K_F1 || kind == K_F3 || kind == K_D1 || kind == K_D3 || kind == K_D6);
        if (isgemm) {
            const int ngemm = (kind == K_R1) ? 2 : 1;
            for (int gi = 0; gi < ngemm; ++gi) {
            pg8::Gemm g; pg8::Epi E;
            g.M = MTOK; g.N = 1024; g.K = 1024; g.lda = 1024; g.amode = 0; g.pm0 = 0; g.A = x16; g.A2 = x16; g.Bt = x16;
            E.mode = E_RESID; E.pm0 = 0; E.j = j; E.pnoff = 0; E.fin = (L == 3 && kind == K_F3) ? 1 : 0; E.ws = ws; E.out = p.out; E.bias0 = p.in[5] + j * 1024; E.bias1 = p.in[8] + j * 1024; E.bias2 = p.in[11];
            if (kind == K_R1) {
                E.mode = E_RPROJ;
                if (gi == 0) { g.A = (const h16*)p.out; g.A2 = (const h16*)(ws + R_G16); g.Bt = w_rwkv_big(ws, j); g.N = 3072; g.amode = 2; }
                else { g.Bt = w_rwkv_l1(ws, j); g.N = 512; g.K = 2048; g.amode = 1; E.pnoff = 12; }
            } else if (kind == K_R2) {
                g.A = (const h16*)(ws + R_HACT); g.Bt = w_rwkv_l2(ws, j); g.N = (j == 0) ? 3072 : 4096; g.K = 384; g.lda = 384; E.mode = E_LORA2;
            } else if (kind == K_R4) {
                g.A = (const h16*)(ws + (j == 0 ? R_V16 : OFF_VF)); g.Bt = w_rwkv_o(ws, j);
            } else if (kind == K_F1) {
                g.Bt = w_ffn_up(ws, L); g.M = MTOK / 2; g.N = 5632; g.amode = 1; g.pm0 = sub * 128; E.mode = E_ST16;
            } else if (kind == K_F3) {
                g.A = (const h16*)(ws + F_ACT); g.Bt = w_ffn_dn(ws, L); g.M = MTOK / 2; g.K = 2816; g.lda = 2816; E.pm0 = sub * 128;
            } else if (kind == K_D1) {
                g.Bt = w_dsa_in(ws, j); g.N = 512; g.amode = 1; E.mode = E_ST32;
            } else if (kind == K_D3) {
                g.A = (const h16*)(ws + D_CQ); g.Bt = w_dsa_q(ws, j); g.N = 2560; g.K = 256; g.lda = 256; E.mode = E_QPROJ;
            } else {
                g.A = (const h16*)(ws + D_HIN); g.A2 = (const h16*)p.out + (size_t)MTOK * 1024; g.Bt = (const h16*)(ws + OFF_WOV) + (size_t)j * 2097152; g.K = 2048; g.lda = 2048; g.amode = 3;
            }
            pg8::StaticOrder S; S.init(g.M, g.N, (int)gridDim.x, (int)blockIdx.x);
#ifndef NO_GEMM
            pg8::gemm_phase((LAS unsigned char*)smem, g, S, E);
#endif
            }
        } else if (kind == K_PREP) {
#ifndef NO_PREP
            prep_phase(p, smem);
#endif
        } else if (kind == K_R0) {
            mix_phase(p, j);
        } else if (kind == K_R3) {
#ifndef NO_SCAN
            scan_phase(p, j, smem);
#endif
        } else if (kind == K_LN) {
#ifndef NO_LN
            ln_phase(p, p.in[1] + (L * 2 + sub) * 1024, p.in[2] + (L * 2 + sub) * 1024, L == 3 && sub == 1);
#endif
        } else if (kind == K_F2) {
#ifndef NO_CONV
            conv_phase(p, L);
#endif
        } else if (kind == K_D2) {
#ifndef NO_NORM
            dsa_norm_phase(p, j, smem);
#endif
        } else if (kind == K_D4) {
#ifndef NO_INDEX
            dsa_index_phase(p, smem);
#endif
        } else if (kind == K_D5) {
#ifndef NO_ATTN
            dsa_attn_phase(p, j, smem);
#endif
        }
        }
        if (ph + 1 < p.ph_hi) { if (ph == p.ph_lo) grid.sync(); else xcd_barrier(xbar); for (int xs = 0; xs < EXTRA_SYNC; ++xs) xcd_barrier(xbar); }
    }
}

extern "C" void kernel_launch(void* const* d_in, const int* in_sizes, int n_in, void* d_out, int out_size, void* d_ws, size_t ws_size, hipStream_t stream) {
    static int grid_blocks = 0;
    if (grid_blocks == 0) {
        if (n_in != 37 || ws_size < WS_NEED || out_size != MTOK * DM) { fprintf(stderr, "kernel_launch: unexpected problem (n_in %d ws %zu out %d)\n", n_in, ws_size, out_size); grid_blocks = -1; return; }
        int dev = 0, cus = 0, per_cu = 0;
        hipGetDevice(&dev);
        hipDeviceGetAttribute(&cus, hipDeviceAttributeMultiprocessorCount, dev);
        if (hipFuncSetAttribute((const void*)mega_fwd, hipFuncAttributeMaxDynamicSharedMemorySize, LDS_BYTES) != hipSuccess) { fprintf(stderr, "kernel_launch: hipFuncSetAttribute failed\n"); grid_blocks = -1; return; }
        hipOccupancyMaxActiveBlocksPerMultiprocessor(&per_cu, (const void*)mega_fwd, 512, LDS_BYTES);
        if (per_cu < 1) { fprintf(stderr, "kernel_launch: occupancy query says %d blocks/CU\n", per_cu); per_cu = 1; }
        (void)hipGetLastError();
        grid_blocks = cus * per_cu;
        fprintf(stderr, "kernel_launch: grid %d (cus %d x %d)\n", grid_blocks, cus, per_cu);
    }
    if (grid_blocks < 0) return;
    Params p{};
    for (int i = 0; i < 37; ++i) p.in[i] = (const float*)d_in[i];
    p.ws = (unsigned char*)d_ws; p.out = (float*)d_out;
    int np = 0;
    constexpr unsigned PROBE_MASK = 0u;
    auto add = [&](int kind, int L, int sub) { p.prog[np++] = (unsigned char)(kind | (L << 4) | (sub << 6) | ((((PROBE_MASK >> kind) & 1u) && !(kind == K_LN && L == 3 && sub == 1)) ? 128 : 0)); };
    add(K_PREP, 0, 0);
    for (int L = 0; L < 4; ++L) {
        if ((L & 1) == 0) { add(K_R0, L, 0); add(K_R1, L, 0); add(K_R2, L, 0); add(K_R3, L, 0); add(K_R4, L, 0); }
        else { add(K_D1, L, 0); add(K_D2, L, 0); add(K_D3, L, 0); add(K_D4, L, 0); add(K_D5, L, 0); add(K_D6, L, 0); }
        add(K_LN, L, 0);
        for (int c = 0; c < 2; ++c) { add(K_F1, L, c); add(K_F2, L, c); add(K_F3, L, c); }
        add(K_LN, L, 1);
    }
#if SINGLE_LAUNCH
    if (hipMemsetAsync((unsigned char*)d_ws + OFF_BAR, 0, XCD_BAR_WORDS * 4, stream) != hipSuccess) { fprintf(stderr, "kernel_launch: memset failed\n"); return; }
    p.ph_lo = 0; p.ph_hi = np;
    void* args[] = {&p};
    hipError_t e = hipLaunchCooperativeKernel((const void*)mega_fwd, dim3(grid_blocks), dim3(512), args, LDS_BYTES, stream);
    if (e != hipSuccess) fprintf(stderr, "cooperative launch failed: %s (grid %d)\n", hipGetErrorString(e), grid_blocks);
#else
    for (int ph = 0; ph < np; ++ph) {
        p.ph_lo = ph; p.ph_hi = ph + 1;
        hipLaunchKernelGGL(mega_fwd, dim3(grid_blocks), dim3(512), LDS_BYTES, stream, p);
    }
#endif
}
```

```cpp
#include <hip/hip_runtime.h>
#include <hip/hip_cooperative_groups.h>
#include <cstdio>
namespace cg = cooperative_groups;

constexpr int EXTRA_SYNC = 0;
#ifndef SINGLE_LAUNCH
#define SINGLE_LAUNCH 1
#endif

#define LAS __attribute__((address_space(3)))
typedef _Float16 h16;
typedef _Float16 h16x8 __attribute__((ext_vector_type(8)));
typedef _Float16 h16x4 __attribute__((ext_vector_type(4)));
typedef _Float16 h16x2 __attribute__((ext_vector_type(2)));
typedef float f32x4 __attribute__((ext_vector_type(4)));
typedef float f32x2 __attribute__((ext_vector_type(2)));
typedef unsigned u32x4 __attribute__((ext_vector_type(4)));
typedef unsigned u32x2 __attribute__((ext_vector_type(2)));

constexpr int DM = 1024, SEQ = 2048, NBATCH = 32, MTOK = NBATCH * SEQ;
constexpr int DFF = 2816;
constexpr size_t MiB = (size_t)1 << 20;
constexpr float DN_ALPHA = 1.6817928305074290f;
constexpr int LDS_BYTES = 147456;

constexpr size_t OFF_W = 0;
constexpr size_t OFF_X16 = 118 * MiB;
constexpr size_t OFF_VF = 247 * MiB;
constexpr size_t OFF_R = 375 * MiB;
constexpr size_t WS_NEED = 960 * MiB;
constexpr size_t OFF_WOV = 952 * MiB;
constexpr size_t R_R16 = OFF_R, R_K16 = OFF_R + 128 * MiB, R_V16 = OFF_R + 256 * MiB, R_G16 = OFF_R + 384 * MiB, R_HACT = OFF_R + 512 * MiB;
constexpr size_t F_U16 = OFF_R, F_ACT = OFF_R + 352 * MiB;
constexpr size_t D_HIN = OFF_R, D_O16 = OFF_R, D_QABS = OFF_R + 128 * MiB, D_QIDX = OFF_R + 384 * MiB, D_CQ = OFF_R + 448 * MiB,
                 D_CKV = OFF_R + 480 * MiB, D_CKVT = OFF_R + 496 * MiB, D_KIDX = OFF_R + 512 * MiB, D_WIDX = OFF_R + 520 * MiB, D_MASK = OFF_R + 522 * MiB;

struct Params {
    const float* in[37];
    unsigned char* ws;
    float* out;
    int ph_lo, ph_hi;
    unsigned char prog[64];
};

enum { K_PREP = 0, K_R1, K_R2, K_R3, K_R4, K_LN, K_F1, K_F2, K_F3, K_D1, K_D2, K_D3, K_D4, K_D5, K_D6, K_R0 };
enum { E_RPROJ = 0, E_LORA2, E_RESID, E_ST16, E_ST32, E_QPROJ };

__device__ __forceinline__ size_t xrow(int row) { return (size_t)(row >> 11) * 2049 + 1 + (row & 2047); }
__device__ __forceinline__ unsigned pk2(float a, float b) { h16x2 h = {(h16)a, (h16)b}; return __builtin_bit_cast(unsigned, h); }
__device__ __forceinline__ u32x4 pack8(f32x4 a, f32x4 b) { u32x4 w; w.x = pk2(a[0], a[1]); w.y = pk2(a[2], a[3]); w.z = pk2(b[0], b[1]); w.w = pk2(b[2], b[3]); return w; }
__device__ __forceinline__ void unpack8(u32x4 w, float* f) {
    h16x8 h = __builtin_bit_cast(h16x8, w);
#pragma unroll
    for (int i = 0; i < 8; ++i) f[i] = (float)h[i];
}
__device__ __forceinline__ float sigmoidf_(float x) { return __builtin_amdgcn_rcpf(1.0f + __expf(-x)); }
#define WSYNC() asm volatile("s_waitcnt vmcnt(0) lgkmcnt(0)" ::: "memory")
__device__ __forceinline__ int opaque_tid() { int t = threadIdx.x; asm volatile("" : "+v"(t)); return t; }
__device__ __forceinline__ float dppf(float x, const int ctrl_sel) {
    const int v = __builtin_bit_cast(int, x);
    int r;
    if (ctrl_sel == 0) r = __builtin_amdgcn_update_dpp(0, v, 0xB1, 0xF, 0xF, true);
    else if (ctrl_sel == 1) r = __builtin_amdgcn_update_dpp(0, v, 0x4E, 0xF, 0xF, true);
    else if (ctrl_sel == 2) r = __builtin_amdgcn_update_dpp(0, v, 0x141, 0xF, 0xF, true);
    else r = __builtin_amdgcn_update_dpp(0, v, 0x140, 0xF, 0xF, true);
    return __builtin_bit_cast(float, r);
}
__device__ __forceinline__ float red4(float x) { x += dppf(x, 0); x += dppf(x, 1); return x; }
__device__ __forceinline__ float red16(float x) { x += dppf(x, 0); x += dppf(x, 1); x += dppf(x, 2); x += dppf(x, 3); return x; }
__device__ __forceinline__ float xmax_16_32(float x) {
    const unsigned u = __builtin_bit_cast(unsigned, x);
    auto r = __builtin_amdgcn_permlane16_swap(u, u, false, false);
    float m = fmaxf(__builtin_bit_cast(float, (unsigned)r[0]), __builtin_bit_cast(float, (unsigned)r[1]));
    const unsigned u2 = __builtin_bit_cast(unsigned, m);
    auto r2 = __builtin_amdgcn_permlane32_swap(u2, u2, false, false);
    return fmaxf(__builtin_bit_cast(float, (unsigned)r2[0]), __builtin_bit_cast(float, (unsigned)r2[1]));
}
__device__ __forceinline__ float xsum_16_32(float x) {
    const unsigned u = __builtin_bit_cast(unsigned, x);
    auto r = __builtin_amdgcn_permlane16_swap(u, u, false, false);
    float m = __builtin_bit_cast(float, (unsigned)r[0]) + __builtin_bit_cast(float, (unsigned)r[1]);
    const unsigned u2 = __builtin_bit_cast(unsigned, m);
    auto r2 = __builtin_amdgcn_permlane32_swap(u2, u2, false, false);
    return __builtin_bit_cast(float, (unsigned)r2[0]) + __builtin_bit_cast(float, (unsigned)r2[1]);
}
__device__ __forceinline__ float wave_sum(float v) { return xsum_16_32(red16(v)); }

namespace pg8 {
constexpr int BM = 256, BK = 64, HALF = 128, HTB = HALF * BK * 2, STAGE_BYTES = 8 * HTB, NXCD = 8, WGM = 8;
__device__ __forceinline__ int lds_byte(int r, int c) { const int st = (r >> 4) * 2 + (c >> 5), rr = r & 15, cc = c & 31, ob = rr * 64 + cc * 2; return st * 1024 + (ob ^ (((ob >> 9) & 1) << 5)); }
__device__ __forceinline__ void stage_rc(int b, int& R, int& C) { const int st = b / 1024, sb = b % 1024, swz = sb ^ (((sb >> 9) & 1) << 5); R = (st >> 1) * 16 + swz / 64; C = (st & 1) * 32 + (swz % 64) / 2; }
__device__ __forceinline__ int perm32(int rho) { const int n = rho >> 4, i = rho & 15; return 8 * (i >> 2) + 4 * n + (i & 3); }
struct Unit { int pm, pn; };
struct Gemm { const h16* A; const h16* A2; const h16* Bt; int M, N, K, lda, amode, pm0; };
struct StaticOrder {
    int nM, nN, nwg, G, c;
    __device__ void init(int M, int N, int G_, int c_) { nM = M / BM; nN = N / BM; nwg = nM * nN; G = G_; c = c_; }
    __device__ bool next(int i, Unit& u) const {
        const long L = (long)i * G + c; if (L >= nwg) return false;
        int wgid = (int)L; { const int q = nwg / NXCD, r = nwg % NXCD, xcd = wgid % NXCD, off = wgid / NXCD; wgid = (xcd < r ? xcd * (q + 1) : r * (q + 1) + (xcd - r) * q) + off; }
        const int nig = WGM * nN, gid = wgid / nig, fm = gid * WGM, gsz = (nM - fm) < WGM ? (nM - fm) : WGM;
        u.pm = fm + ((wgid % nig) % gsz); u.pn = (wgid % nig) / gsz; return true;
    }
};

struct Epi {
    int mode, pm0, j, pnoff, fin;
    unsigned char* ws; float* out; const float* bias0; const float* bias1; const float* bias2;
    __device__ __forceinline__ void operator()(const f32x4 (&acc)[2][2][4][2], const Unit& u, int wr, int wc, int fr, int fq) const {
        const int rowl0 = u.pm * BM + wr * 64 + fr;
        const int colt = u.pn * BM + wc * 32 + 8 * fq;
        if (mode == E_RESID) {
            u32x4 xr[2][4][2];
#pragma unroll
            for (int ai = 0; ai < 2; ++ai)
#pragma unroll
                for (int m = 0; m < 4; ++m) {
                    const int rowg = rowl0 + ai * HALF + m * 16 + pm0 * BM;
                    const h16* xp = (const h16*)(ws + OFF_X16) + xrow(rowg) * 1024 + colt;
#pragma unroll
                    for (int bj = 0; bj < 2; ++bj) xr[ai][m][bj] = *(const u32x4*)(xp + bj * HALF);
                }
#pragma unroll
            for (int ai = 0; ai < 2; ++ai)
#pragma unroll
                for (int m = 0; m < 4; ++m) {
                    const int rowg = rowl0 + ai * HALF + m * 16 + pm0 * BM;
                    float* dp0 = out + (size_t)rowg * 1024 + colt;
                    h16* hp0 = (h16*)out + (size_t)rowg * 1024 + colt;
#pragma unroll
                    for (int bj = 0; bj < 2; ++bj) {
                        float xf[8]; unpack8(xr[ai][m][bj], xf);
                        const f32x4 v0 = acc[ai][bj][m][0], v1 = acc[ai][bj][m][1];
                        f32x4 r0, r1;
#pragma unroll
                        for (int jj = 0; jj < 4; ++jj) { r0[jj] = DN_ALPHA * xf[jj] + v0[jj]; r1[jj] = DN_ALPHA * xf[4 + jj] + v1[jj]; }
                        if (fin) { float* dp = dp0 + bj * HALF; *(f32x4*)dp = r0; *(f32x4*)(dp + 4) = r1; }
                        else *(u32x4*)(hp0 + bj * HALF) = pack8(r0, r1);
                    }
                }
            return;
        }
        if (mode == E_LORA2 && (u.pn >> 2) == 3) {
            const int c0 = colt & 1023;
#pragma unroll
            for (int ai = 0; ai < 2; ++ai) {
                u32x4 lv[4][2], lf[4][2];
#pragma unroll
                for (int m = 0; m < 4; ++m) {
                    const size_t off = (size_t)(rowl0 + ai * HALF + m * 16 + pm0 * BM) * 1024 + c0;
#pragma unroll
                    for (int bj = 0; bj < 2; ++bj) { lv[m][bj] = *(const u32x4*)((const h16*)(ws + R_V16) + off + bj * HALF); lf[m][bj] = *(const u32x4*)((const h16*)(ws + OFF_VF) + off + bj * HALF); }
                }
#pragma unroll
                for (int m = 0; m < 4; ++m) {
                    const size_t off = (size_t)(rowl0 + ai * HALF + m * 16 + pm0 * BM) * 1024 + c0;
#pragma unroll
                    for (int bj = 0; bj < 2; ++bj) {
                        const int c = c0 + bj * HALF;
                        const f32x4 ba = *(const f32x4*)(bias2 + c), bb = *(const f32x4*)(bias2 + c + 4);
                        float vv[8], vf8[8]; unpack8(lv[m][bj], vv); unpack8(lf[m][bj], vf8);
                        f32x4 v0 = acc[ai][bj][m][0], v1 = acc[ai][bj][m][1];
#pragma unroll
                        for (int jj = 0; jj < 4; ++jj) {
                            v0[jj] = vv[jj] + (vf8[jj] - vv[jj]) * sigmoidf_(v0[jj] + ba[jj]);
                            v1[jj] = vv[4 + jj] + (vf8[4 + jj] - vv[4 + jj]) * sigmoidf_(v1[jj] + bb[jj]);
                        }
                        *(u32x4*)((h16*)(ws + R_V16) + off + bj * HALF) = pack8(v0, v1);
                    }
                }
            }
            return;
        }
#pragma unroll
        for (int ai = 0; ai < 2; ++ai)
#pragma unroll
            for (int m = 0; m < 4; ++m) {
                const int rowl = rowl0 + ai * HALF + m * 16;
                const int rowg = rowl + pm0 * BM;
#pragma unroll
                for (int bj = 0; bj < 2; ++bj) {
                    const int col = colt + bj * HALF;
                    f32x4 v0 = acc[ai][bj][m][0], v1 = acc[ai][bj][m][1];
                    if (mode == E_RPROJ) {
                        if (pnoff == 0) {
                            h16* dst = (h16*)(ws + (u.pn < 4 ? R_R16 : (u.pn < 8 ? R_K16 : (j == 0 ? OFF_VF : R_V16))));
                            *(u32x4*)(dst + (size_t)rowg * 1024 + (col & 1023)) = pack8(v0, v1);
                        } else if (col < 384) {
                            const int hc = col;
                            if (hc < 64) {
#pragma unroll
                                for (int jj = 0; jj < 4; ++jj) { v0[jj] = tanhf(v0[jj]); v1[jj] = tanhf(v1[jj]); }
                            } else if (hc >= 160) {
#pragma unroll
                                for (int jj = 0; jj < 4; ++jj) { v0[jj] = sigmoidf_(v0[jj]); v1[jj] = sigmoidf_(v1[jj]); }
                            }
                            *(u32x4*)((h16*)(ws + R_HACT) + (size_t)rowg * 384 + hc) = pack8(v0, v1);
                        }
                    } else if (mode == E_LORA2) {
                        const int grp = u.pn >> 2, c = col & 1023;
                        const size_t off = (size_t)rowg * 1024 + c;
                        if (grp == 0) {
                            const f32x4 ba = *(const f32x4*)(bias0 + c), bb = *(const f32x4*)(bias0 + c + 4);
#pragma unroll
                            for (int jj = 0; jj < 4; ++jj) { v0[jj] = sigmoidf_(v0[jj] + ba[jj]) * 0.6065306597f; v1[jj] = sigmoidf_(v1[jj] + bb[jj]) * 0.6065306597f; }
                            *(u32x4*)((h16*)out + off) = pack8(v0, v1);
                        } else if (grp == 1) {
                            const f32x4 ba = *(const f32x4*)(bias1 + c), bb = *(const f32x4*)(bias1 + c + 4);
#pragma unroll
                            for (int jj = 0; jj < 4; ++jj) { v0[jj] = sigmoidf_(v0[jj] + ba[jj]); v1[jj] = sigmoidf_(v1[jj] + bb[jj]); }
                            *(u32x4*)((h16*)out + (size_t)MTOK * 1024 + off) = pack8(v0, v1);
                        } else {
                            *(u32x4*)((h16*)(ws + R_G16) + off) = pack8(v0, v1);
                        }
                    } else if (mode == E_ST16) {
                        __builtin_nontemporal_store(pack8(v0, v1), (u32x4*)((h16*)(ws + F_U16) + (size_t)rowl * 5632 + col));
                    } else if (mode == E_ST32) {
                        float* dp = (float*)(ws + D_HIN) + (size_t)rowg * 512 + col;
                        *(f32x4*)dp = v0; *(f32x4*)(dp + 4) = v1;
                    } else {
                        if (u.pn < 8) *(u32x4*)((h16*)(ws + D_QABS) + (size_t)rowg * 2048 + col) = pack8(v0, v1);
                        else *(u32x4*)((h16*)(ws + D_QIDX) + (size_t)rowg * 512 + (col - 2048)) = pack8(v0, v1);
                    }
                }
            }
    }
};

__device__ __forceinline__ const char* a_tile(const Gemm& g, int pm, int pn) {
    if (g.amode == 1) { const int row = (pm + g.pm0) * BM; return (const char*)g.A + xrow(row) * 2048; }
    if (g.amode == 2) {
        const int gq = pn >> 2;
        const char* base = gq == 2 ? (const char*)g.A2 : (const char*)g.A + (size_t)gq * ((size_t)MTOK * 1024 * 2);
        return base + (size_t)pm * BM * 2048;
    }
    if (g.amode == 3) return (pm < 128 ? (const char*)g.A + (size_t)pm * BM * 4096 : (const char*)g.A2 + (size_t)(pm - 128) * BM * 4096);
    return (const char*)g.A + (size_t)pm * BM * g.lda * 2;
}

__device__ __forceinline__ void gemm_phase(LAS unsigned char* lds, const Gemm g, const StaticOrder& S, const Epi& E) {
    const int tid = opaque_tid(), wid = __builtin_amdgcn_readfirstlane(tid >> 6), lane = tid & 63, wr = wid >> 2, wc = wid & 3, fr = lane & 15, fq = lane >> 4;
    const int K = g.K, nt = K / BK;
    const bool shiftA = (g.amode == 1);
    unsigned voffA[2], voffB[2];
#pragma unroll
    for (int i = 0; i < 2; ++i) { int R, C; stage_rc(tid * 16 + i * 8192, R, C); const int Rb = (R & ~31) + perm32(R & 31);
        voffA[i] = (unsigned)(R * g.lda + C) * 2u; voffB[i] = (unsigned)(Rb * K + C) * 2u; }
    const size_t kstep = (size_t)(BK * 2);
    const size_t hstepA = (size_t)HALF * g.lda * 2;
    const size_t hstepB = (size_t)HALF * K * 2;
    const size_t tstepB = 2 * hstepB;
    const unsigned ldsw = (unsigned)wid * 1024u;
    const int aoff = lds_byte(wr * 64 + fr, fq * 8), boff = lds_byte(wc * 32 + fr, fq * 8);
#define PG8_KOFF(kt) ((size_t)(kt) * kstep - ((shiftA && (kt) >= 16) ? (size_t)4096 : (size_t)0))
#define PG8_SA(b, h) (((b) * 2 + (h)) * HTB)
#define PG8_SB(b, h) ((4 + (b) * 2 + (h)) * HTB)
#define PG8_STAGE(bufoff, gbase, voff) do { _Pragma("unroll") for (int _i = 0; _i < 2; ++_i) \
        __builtin_amdgcn_global_load_lds((const unsigned*)((const char*)(gbase) + (voff)[_i]), (LAS unsigned*)(lds + (bufoff) + ldsw + _i * 8192), 16, 0, 0); } while (0)
#define PG8_LDA(dst, b, h) do { _Pragma("unroll") for (int m = 0; m < 4; ++m) _Pragma("unroll") for (int k = 0; k < 2; ++k) dst[m][k] = *(const LAS h16x8*)(lds + PG8_SA(b, h) + aoff + m * 2048 + k * 1024); } while (0)
#define PG8_LDB(dst, b, h) do { _Pragma("unroll") for (int n = 0; n < 2; ++n) _Pragma("unroll") for (int k = 0; k < 2; ++k) dst[n][k] = *(const LAS h16x8*)(lds + PG8_SB(b, h) + boff + n * 2048 + k * 1024); } while (0)
#define PG8_MMA(ai, bj, At, Bt) do { __builtin_amdgcn_s_setprio(1); _Pragma("unroll") for (int m = 0; m < 4; ++m) _Pragma("unroll") for (int n = 0; n < 2; ++n) _Pragma("unroll") for (int k = 0; k < 2; ++k) \
        acc[ai][bj][m][n] = __builtin_amdgcn_mfma_f32_16x16x32_f16(Bt[n][k], At[m][k], acc[ai][bj][m][n], 0, 0, 0); __builtin_amdgcn_s_setprio(0); } while (0)
#define PG8_WAIT_V(n) asm volatile("s_waitcnt vmcnt(" #n ")" ::: "memory")
#define PG8_WAIT_L(n) asm volatile("s_waitcnt lgkmcnt(" #n ")" ::: "memory")
#define PG8_BAR __builtin_amdgcn_s_barrier()
#define PG8_SCHED __builtin_amdgcn_sched_barrier(0)
    Unit cur, nxt; int ui = 0;
    if (!S.next(0, cur)) return;
    f32x4 acc[2][2][4][2];
#pragma unroll
    for (int a = 0; a < 2; ++a)
#pragma unroll
        for (int b = 0; b < 2; ++b)
#pragma unroll
            for (int m = 0; m < 4; ++m)
#pragma unroll
                for (int n = 0; n < 2; ++n) acc[a][b][m][n] = (f32x4){0.f, 0.f, 0.f, 0.f};
    h16x8 At[4][2], B0[2][2], B1[2][2];
    const char* cA = a_tile(g, cur.pm, cur.pn); const char* cB = (const char*)g.Bt + (size_t)cur.pn * tstepB;
    PG8_STAGE(PG8_SB(0, 0), cB, voffB); PG8_STAGE(PG8_SA(0, 0), cA, voffA); PG8_STAGE(PG8_SB(0, 1), cB + hstepB, voffB); PG8_STAGE(PG8_SA(0, 1), cA + hstepA, voffA);
    if (wr == 1) PG8_BAR;
    PG8_WAIT_V(4); PG8_BAR;
    PG8_STAGE(PG8_SB(1, 0), cB + kstep, voffB); PG8_STAGE(PG8_SA(1, 0), cA + kstep, voffA); PG8_STAGE(PG8_SB(1, 1), cB + hstepB + kstep, voffB);
    PG8_WAIT_V(6); PG8_BAR;
    for (;;) {
        const bool has_next = S.next(ui + 1, nxt);
        const char* nA = has_next ? a_tile(g, nxt.pm, nxt.pn) : cA; const char* nB = has_next ? (const char*)g.Bt + (size_t)nxt.pn * tstepB : cB;
        for (int t = 0; t < nt; t += 2) {
            const bool last = (t == nt - 2);
            const char* a1 = cA + PG8_KOFF(t + 1);
            const char* a2 = last ? nA : cA + PG8_KOFF(t + 2); const char* b2 = last ? nB : cB + (size_t)(t + 2) * kstep;
            const char* a3 = a2 + kstep; const char* b3 = b2 + kstep;
            PG8_LDB(B0, 0, 0); PG8_SCHED; PG8_LDA(At, 0, 0); PG8_STAGE(PG8_SA(1, 1), a1 + hstepA, voffA);
            PG8_WAIT_L(8); PG8_BAR; PG8_WAIT_L(0); PG8_MMA(0, 0, At, B0); PG8_BAR; PG8_SCHED;
            PG8_LDB(B1, 0, 1); PG8_STAGE(PG8_SB(0, 0), b2, voffB);
            PG8_BAR; PG8_WAIT_L(0); PG8_MMA(0, 1, At, B1); PG8_BAR;
            PG8_LDA(At, 0, 1); PG8_STAGE(PG8_SA(0, 0), a2, voffA);
            PG8_BAR; PG8_WAIT_L(0); PG8_MMA(1, 0, At, B0); PG8_BAR; PG8_SCHED;
            PG8_STAGE(PG8_SB(0, 1), b2 + hstepB, voffB);
            PG8_WAIT_V(6); PG8_BAR; PG8_MMA(1, 1, At, B1); PG8_BAR;
            PG8_LDB(B0, 1, 0); PG8_SCHED; PG8_LDA(At, 1, 0); PG8_STAGE(PG8_SA(0, 1), a2 + hstepA, voffA);
            PG8_WAIT_L(8); PG8_BAR; PG8_WAIT_L(0); PG8_MMA(0, 0, At, B0); PG8_BAR; PG8_SCHED;
            PG8_LDB(B1, 1, 1); PG8_STAGE(PG8_SB(1, 0), b3, voffB);
            PG8_BAR; PG8_WAIT_L(0); PG8_MMA(0, 1, At, B1); PG8_BAR;
            PG8_LDA(At, 1, 1); PG8_STAGE(PG8_SA(1, 0), a3, voffA);
            PG8_BAR; PG8_WAIT_L(0); PG8_MMA(1, 0, At, B0); PG8_BAR; PG8_SCHED;
            PG8_STAGE(PG8_SB(1, 1), b3 + hstepB, voffB);
            PG8_WAIT_V(6); PG8_BAR; PG8_MMA(1, 1, At, B1); PG8_BAR;
        }
        E(acc, cur, wr, wc, fr, fq);
        if (!has_next) break;
#pragma unroll
        for (int a = 0; a < 2; ++a)
#pragma unroll
            for (int b = 0; b < 2; ++b)
#pragma unroll
                for (int m = 0; m < 4; ++m)
#pragma unroll
                    for (int n = 0; n < 2; ++n) acc[a][b][m][n] = (f32x4){0.f, 0.f, 0.f, 0.f};
        cur = nxt; cA = nA; cB = nB; ++ui;
    }
    PG8_WAIT_V(0);
    if (wr == 0) PG8_BAR;
    PG8_BAR;
#undef PG8_KOFF
#undef PG8_SA
#undef PG8_SB
#undef PG8_STAGE
#undef PG8_LDA
#undef PG8_LDB
#undef PG8_MMA
#undef PG8_WAIT_V
#undef PG8_WAIT_L
#undef PG8_BAR
#undef PG8_SCHED
}
}

struct TJob { int mode; const float* src; int ld, K, N; h16* dst; int ldd, koff; const float* mix; };

__device__ __forceinline__ TJob get_job(const Params& p, int id) {
    TJob J; J.mode = 0; J.src = nullptr; J.ld = 0; J.K = 0; J.N = 0; J.dst = nullptr; J.ldd = 64; J.koff = 0; J.mix = nullptr;
    h16* W = (h16*)(p.ws + OFF_W);
    if (id < 24) {
        const int j = id / 12, s = id % 12;
        h16* Wrkv = W + (size_t)j * (10 * MiB); h16* Wl1 = Wrkv + 3 * MiB; h16* Wl2 = Wrkv + 7 * MiB;
        const float* mix = p.in[3] + j * 6 * 1024;
        if (s < 3) { J.mode = 0; J.src = p.in[4] + (size_t)(j * 3 + s) * 1048576; J.ld = 1024; J.K = 1024; J.N = 1024; J.dst = Wrkv + (size_t)s * 1024 * 1024; J.ldd = 1024; }
        else if (s < 8) {
            J.mode = 1; J.ld = 1024; J.K = 1024; J.ldd = 2048;
            if (s == 3) { J.src = p.in[6] + (size_t)j * 65536; J.ld = 64; J.N = 64; J.dst = Wl1; J.mix = mix + 3 * 1024; }
            else if (s == 4) { J.src = p.in[9] + (size_t)j * 65536; J.ld = 64; J.N = 64; J.dst = Wl1 + (size_t)64 * 2048; J.mix = mix + 4 * 1024; }
            else if (s == 5) { J.N = 32; J.dst = Wl1 + (size_t)128 * 2048; if (j == 1) { J.src = p.in[12]; J.ld = 32; J.mix = mix + 2 * 1024; } else { J.mode = 2; } }
            else if (s == 6) { J.src = p.in[14] + (size_t)j * 163840; J.ld = 160; J.N = 160; J.dst = Wl1 + (size_t)160 * 2048; J.mix = mix + 5 * 1024; }
            else { J.mode = 2; J.N = 192; J.dst = Wl1 + (size_t)320 * 2048; }
        } else {
            J.mode = 0; J.ld = 1024; J.N = 1024; J.ldd = 384;
            if (s == 8) { J.src = p.in[7] + (size_t)j * 65536; J.K = 64; J.koff = 0; J.dst = Wl2; }
            else if (s == 9) { J.src = p.in[10] + (size_t)j * 65536; J.K = 64; J.koff = 64; J.dst = Wl2 + (size_t)1024 * 384; }
            else if (s == 10) { J.src = p.in[15] + (size_t)j * 163840; J.K = 160; J.koff = 160; J.dst = Wl2 + (size_t)2048 * 384; }
            else { J.src = p.in[13]; J.K = 32; J.koff = 128; J.dst = Wl2 + (size_t)3072 * 384; if (j == 0) J.N = 0; }
        }
    } else if (id < 26) {
        const int j = id - 24;
        J.src = p.in[21] + (size_t)j * 1048576; J.ld = 1024; J.K = 1024; J.N = 1024; J.dst = W + (size_t)j * (10 * MiB) + 9 * MiB; J.ldd = 1024;
    } else if (id < 34) {
        const int i = (id - 26) >> 1, s = (id - 26) & 1;
        h16* base = W + 20 * MiB + (size_t)i * (17 * MiB / 2);
        if (s == 0) { J.src = p.in[33] + (size_t)i * 1024 * 5632; J.ld = 5632; J.K = 1024; J.N = 5632; J.dst = base; J.ldd = 1024; }
        else { J.src = p.in[36] + (size_t)i * 2816 * 1024; J.ld = 1024; J.K = 2816; J.N = 1024; J.dst = base + (size_t)11 * MiB / 2; J.ldd = 2816; }
    } else {
        const int j = (id - 34) >> 2, s = (id - 34) & 3;
        h16* base = W + 54 * MiB + (size_t)j * (5 * MiB / 2);
        if (s == 0) { J.src = p.in[22] + (size_t)j * 1024 * 456; J.ld = 456; J.K = 1024; J.N = 456; J.dst = base; J.ldd = 1024; }
        else if (s == 1) { J.mode = 2; J.N = 56; J.dst = base + (size_t)456 * 1024; J.ldd = 1024; }
        else if (s == 2) { J.src = p.in[28] + (size_t)j * 256 * 512; J.ld = 512; J.K = 256; J.N = 512; J.dst = base + MiB / 2 + (size_t)2048 * 256; J.ldd = 256; }
        else { J.N = 0; }
    }
    return J;
}
__device__ __forceinline__ h16* w_rwkv_big(unsigned char* ws, int j) { return (h16*)(ws + OFF_W) + (size_t)j * (10 * MiB); }
__device__ __forceinline__ h16* w_rwkv_l1(unsigned char* ws, int j) { return w_rwkv_big(ws, j) + 3 * MiB; }
__device__ __forceinline__ h16* w_rwkv_l2(unsigned char* ws, int j) { return w_rwkv_big(ws, j) + 7 * MiB; }
__device__ __forceinline__ h16* w_rwkv_o(unsigned char* ws, int j) { return w_rwkv_big(ws, j) + 9 * MiB; }
__device__ __forceinline__ h16* w_ffn_up(unsigned char* ws, int i) { return (h16*)(ws + OFF_W) + 20 * MiB + (size_t)i * (17 * MiB / 2); }
__device__ __forceinline__ h16* w_ffn_dn(unsigned char* ws, int i) { return w_ffn_up(ws, i) + (size_t)11 * MiB / 2; }
__device__ __forceinline__ h16* w_dsa_in(unsigned char* ws, int j) { return (h16*)(ws + OFF_W) + 54 * MiB + (size_t)j * (5 * MiB / 2); }
__device__ __forceinline__ h16* w_dsa_q(unsigned char* ws, int j) { return w_dsa_in(ws, j) + MiB / 2; }
__device__ __forceinline__ h16* w_dsa_uvt(unsigned char* ws, int j) { return w_dsa_in(ws, j) + 5 * MiB / 4; }
__device__ __forceinline__ h16* w_dsa_o(unsigned char* ws, int j) { return w_dsa_in(ws, j) + 3 * MiB / 2; }

__device__ __forceinline__ void prep_phase(const Params& p, unsigned char* smem) {
    const int tid = opaque_tid();
    const size_t gtid = (size_t)blockIdx.x * 512 + tid, nth = (size_t)gridDim.x * 512;
    h16* x16 = (h16*)(p.ws + OFF_X16);
    for (size_t idx = gtid; idx < (size_t)MTOK * 128; idx += nth) {
        const int row = (int)(idx >> 7), c8 = (int)(idx & 127) * 8;
        const float* sp = p.in[0] + (size_t)row * 1024 + c8;
        const f32x4 a = *(const f32x4*)sp, b = *(const f32x4*)(sp + 4);
        *(u32x4*)(x16 + xrow(row) * 1024 + c8) = pack8(a, b);
    }
    for (size_t idx = gtid; idx < (size_t)NBATCH * 128; idx += nth) {
        const int b = (int)(idx >> 7), c8 = (int)(idx & 127) * 8;
        unsigned z = 0u; asm volatile("" : "+v"(z));
        *(u32x4*)(x16 + (size_t)b * 2049 * 1024 + c8) = (u32x4){z, z, z, z};
    }
    for (size_t it = gtid; it < (size_t)2 * 16 * 2048; it += nth) {
        const int j = (int)(it >> 15), rem = (int)(it & 32767), qg = rem >> 11, n = rem & 2047, h = n >> 7, c = n & 127;
        const float* uq = p.in[25] + (size_t)j * 256 * 1024 + (size_t)(qg * 16) * 1024 + h * 64;
        const float* uk = p.in[26] + (size_t)j * 16 * 64 * 128 + (size_t)h * 64 * 128 + c;
        float acc[16];
#pragma unroll
        for (int i = 0; i < 16; ++i) acc[i] = 0.f;
        for (int d = 0; d < 64; ++d) {
            const float kv = uk[d * 128];
#pragma unroll
            for (int i = 0; i < 16; ++i) acc[i] += uq[i * 1024 + d] * kv;
        }
        const float sc = 0.18033688011112042f;
        h16* dst = w_dsa_q(p.ws, j) + (size_t)n * 256 + qg * 16;
        *(u32x4*)dst = pack8((f32x4){acc[0] * sc, acc[1] * sc, acc[2] * sc, acc[3] * sc}, (f32x4){acc[4] * sc, acc[5] * sc, acc[6] * sc, acc[7] * sc});
        *(u32x4*)(dst + 8) = pack8((f32x4){acc[8] * sc, acc[9] * sc, acc[10] * sc, acc[11] * sc}, (f32x4){acc[12] * sc, acc[13] * sc, acc[14] * sc, acc[15] * sc});
    }
    for (size_t it = gtid; it < (size_t)2 * 128 * 1024; it += nth) {
        const int j = (int)(it >> 17), rem = (int)(it & 131071), kg = rem >> 10, n = rem & 1023, h = kg >> 3, c0 = (kg & 7) * 16;
        const float* uv = p.in[27] + (size_t)((j * 16 + h) * 128 + c0) * 64;
        const float* wo = p.in[31] + (size_t)j * 1048576 + (size_t)(h * 64) * 1024 + n;
        float acc[16];
#pragma unroll
        for (int i = 0; i < 16; ++i) acc[i] = 0.f;
        for (int v = 0; v < 64; ++v) {
            const float wv = wo[(size_t)v * 1024];
#pragma unroll
            for (int i = 0; i < 16; ++i) acc[i] += uv[i * 64 + v] * wv;
        }
        h16* dst = (h16*)(p.ws + OFF_WOV) + (size_t)j * 2097152 + (size_t)n * 2048 + h * 128 + c0;
        *(u32x4*)dst = pack8((f32x4){acc[0], acc[1], acc[2], acc[3]}, (f32x4){acc[4], acc[5], acc[6], acc[7]});
        *(u32x4*)(dst + 8) = pack8((f32x4){acc[8], acc[9], acc[10], acc[11]}, (f32x4){acc[12], acc[13], acc[14], acc[15]});
    }
    float* tile = (float*)smem;
    for (int id = 0; id < 42; ++id) {
        const TJob J = get_job(p, id);
        const int tk = J.ldd >> 6, tn = (J.N + 63) >> 6, ntile = tk * tn;
        for (int tix = (int)((blockIdx.x + gridDim.x - (unsigned)(id * 37) % gridDim.x) % gridDim.x); tix < ntile; tix += gridDim.x) {
            const int k0 = (tix % tk) * 64, n0 = (tix / tk) * 64;
#pragma unroll
            for (int i = 0; i < 8; ++i) {
                const int k = i * 8 + (tid >> 6), n = tid & 63, kk = k0 + k, nn = n0 + n;
                float v = 0.f;
                if (nn < J.N && J.mode != 2) {
                    if (J.mode == 1) { const int ks = kk & 1023; const float mx = J.mix[ks]; v = J.src[(size_t)ks * J.ld + nn] * (kk < 1024 ? 1.0f - mx : mx); }
                    else if (kk >= J.koff && kk < J.koff + J.K) v = J.src[(size_t)(kk - J.koff) * J.ld + nn];
                }
                tile[k * 65 + n] = v;
            }
            __syncthreads();
#pragma unroll
            for (int i = 0; i < 8; ++i) {
                const int n = i * 8 + (tid >> 6), k = tid & 63, nn = n0 + n;
                if (nn < J.N) J.dst[(size_t)nn * J.ldd + k0 + k] = (h16)tile[k * 65 + n];
            }
            __syncthreads();
        }
    }
}

__device__ __forceinline__ void wave_sum4(float (&v)[4]) {
#pragma unroll
    for (int k = 0; k < 4; ++k) v[k] = wave_sum(v[k]);
}
__device__ __forceinline__ void ln_phase(const Params& p, const float* g, const float* b, bool final_out) {
    const int tid = opaque_tid();
    const int lane = tid & 63, wave = tid >> 6;
    float* tb = p.out;
    h16* x16 = (h16*)(p.ws + OFF_X16);
    if (!final_out) {
        float g0[8], g1[8], b0[8], b1[8];
#pragma unroll
        for (int hlf = 0; hlf < 2; ++hlf) {
            const f32x4 a = *(const f32x4*)(g + lane * 8 + hlf * 4), c = *(const f32x4*)(g + 512 + lane * 8 + hlf * 4);
            const f32x4 d = *(const f32x4*)(b + lane * 8 + hlf * 4), e = *(const f32x4*)(b + 512 + lane * 8 + hlf * 4);
#pragma unroll
            for (int i = 0; i < 4; ++i) { g0[hlf * 4 + i] = a[i]; g1[hlf * 4 + i] = c[i]; b0[hlf * 4 + i] = d[i]; b1[hlf * 4 + i] = e[i]; }
        }
        for (int rowb = (blockIdx.x * 8 + wave) * 8; rowb < MTOK; rowb += gridDim.x * 64) {
            u32x4 va[8], vb[8];
#pragma unroll
            for (int k = 0; k < 8; ++k) {
                const h16* hp = (const h16*)tb + (size_t)(rowb + k) * 1024 + lane * 8;
                va[k] = *(const u32x4*)hp; vb[k] = *(const u32x4*)(hp + 512);
            }
            float mu[8], rs[8];
#pragma unroll
            for (int k = 0; k < 8; ++k) {
                float xa[8], xb[8]; unpack8(va[k], xa); unpack8(vb[k], xb);
                float sk = 0.f;
#pragma unroll
                for (int i = 0; i < 8; ++i) sk += xa[i] + xb[i];
                mu[k] = sk;
            }
#pragma unroll
            for (int k = 0; k < 8; ++k) mu[k] = wave_sum(mu[k]) * (1.0f / 1024.0f);
#pragma unroll
            for (int k = 0; k < 8; ++k) {
                float xa[8], xb[8]; unpack8(va[k], xa); unpack8(vb[k], xb);
                float qk = 0.f;
#pragma unroll
                for (int i = 0; i < 8; ++i) { const float da = xa[i] - mu[k], db = xb[i] - mu[k]; qk += da * da + db * db; }
                rs[k] = qk;
            }
#pragma unroll
            for (int k = 0; k < 8; ++k) rs[k] = rsqrtf(wave_sum(rs[k]) * (1.0f / 1024.0f) + 1e-5f);
#pragma unroll
            for (int k = 0; k < 8; ++k) {
                float xa[8], xb[8]; unpack8(va[k], xa); unpack8(vb[k], xb);
                f32x4 y0, y1, y2, y3;
#pragma unroll
                for (int i = 0; i < 4; ++i) {
                    y0[i] = (xa[i] - mu[k]) * rs[k] * g0[i] + b0[i]; y1[i] = (xa[4 + i] - mu[k]) * rs[k] * g0[4 + i] + b0[4 + i];
                    y2[i] = (xb[i] - mu[k]) * rs[k] * g1[i] + b1[i]; y3[i] = (xb[4 + i] - mu[k]) * rs[k] * g1[4 + i] + b1[4 + i];
                }
                h16* op = x16 + xrow(rowb + k) * 1024 + lane * 8;
                *(u32x4*)op = pack8(y0, y1); *(u32x4*)(op + 512) = pack8(y2, y3);
            }
        }
        return;
    }
    f32x4 gg[4], bb[4];
#pragma unroll
    for (int i = 0; i < 4; ++i) { gg[i] = *(const f32x4*)(g + i * 256 + lane * 4); bb[i] = *(const f32x4*)(b + i * 256 + lane * 4); }
    for (int rowb = (blockIdx.x * 8 + wave) * 4; rowb < MTOK; rowb += gridDim.x * 32) {
        f32x4 v[4][4];
        float s[4];
#pragma unroll
        for (int k = 0; k < 4; ++k) {
            s[k] = 0.f;
            if (final_out) {
                const float* rp = tb + (size_t)(rowb + k) * 1024;
#pragma unroll
                for (int i = 0; i < 4; ++i) v[k][i] = *(const f32x4*)(rp + i * 256 + lane * 4);
            } else {
                const h16* hp = (const h16*)tb + (size_t)(rowb + k) * 1024;
#pragma unroll
                for (int i = 0; i < 4; ++i) { const h16x4 hv = *(const h16x4*)(hp + i * 256 + lane * 4); v[k][i] = (f32x4){(float)hv[0], (float)hv[1], (float)hv[2], (float)hv[3]}; }
            }
#pragma unroll
            for (int i = 0; i < 4; ++i) s[k] += (v[k][i][0] + v[k][i][1]) + (v[k][i][2] + v[k][i][3]);
        }
        wave_sum4(s);
        float q[4];
#pragma unroll
        for (int k = 0; k < 4; ++k) {
            s[k] *= (1.0f / 1024.0f); q[k] = 0.f;
#pragma unroll
            for (int i = 0; i < 4; ++i)
#pragma unroll
                for (int jj = 0; jj < 4; ++jj) { const float d = v[k][i][jj] - s[k]; q[k] += d * d; }
        }
        wave_sum4(q);
#pragma unroll
        for (int k = 0; k < 4; ++k) {
            const float rstd = rsqrtf(q[k] * (1.0f / 1024.0f) + 1e-5f);
            const int row = rowb + k;
#pragma unroll
            for (int i = 0; i < 4; ++i) {
                f32x4 y;
#pragma unroll
                for (int jj = 0; jj < 4; ++jj) y[jj] = (v[k][i][jj] - s[k]) * rstd * gg[i][jj] + bb[i][jj];
                if (final_out) *(f32x4*)(tb + (size_t)row * 1024 + i * 256 + lane * 4) = y;
                else { u32x2 w; w.x = pk2(y[0], y[1]); w.y = pk2(y[2], y[3]); *(u32x2*)(x16 + xrow(row) * 1024 + i * 256 + lane * 4) = w; }
            }
        }
    }
}

__device__ __forceinline__ void conv_phase(const Params& p, int layer) {
    const h16* u = (const h16*)(p.ws + F_U16);
    h16* act = (h16*)(p.ws + F_ACT);
    const float* cw = p.in[34] + (size_t)layer * 3 * 5632;
    const float* cb = p.in[35] + (size_t)layer * 5632;
    const size_t gtid = (size_t)blockIdx.x * 512 + opaque_tid(), nth = (size_t)gridDim.x * 512;
    const size_t ntask = (size_t)2048 * 352;
    for (size_t task = gtid; task < ntask; task += nth) {
        const int cgp = (int)(task % 352), rc = (int)(task / 352), f = cgp * 8, r0 = rc * 16;
        float wg[3][8], wv[3][8], bg[8], bv[8];
#pragma unroll
        for (int jj = 0; jj < 3; ++jj)
#pragma unroll
            for (int hlf = 0; hlf < 2; ++hlf) {
                const f32x4 a = *(const f32x4*)(cw + jj * 5632 + f + hlf * 4), c = *(const f32x4*)(cw + jj * 5632 + DFF + f + hlf * 4);
#pragma unroll
                for (int e = 0; e < 4; ++e) { wg[jj][hlf * 4 + e] = a[e]; wv[jj][hlf * 4 + e] = c[e]; }
            }
#pragma unroll
        for (int hlf = 0; hlf < 2; ++hlf) {
            const f32x4 a = *(const f32x4*)(cb + f + hlf * 4), c = *(const f32x4*)(cb + DFF + f + hlf * 4);
#pragma unroll
            for (int e = 0; e < 4; ++e) { bg[hlf * 4 + e] = a[e]; bv[hlf * 4 + e] = c[e]; }
        }
        float g2[8], g1[8], v2[8], v1[8];
#pragma unroll
        for (int e = 0; e < 8; ++e) { g2[e] = 0.f; g1[e] = 0.f; v2[e] = 0.f; v1[e] = 0.f; }
        if ((r0 & 2047) != 0) {
            unpack8(*(const u32x4*)(u + (size_t)(r0 - 2) * 5632 + f), g2); unpack8(*(const u32x4*)(u + (size_t)(r0 - 1) * 5632 + f), g1);
            unpack8(*(const u32x4*)(u + (size_t)(r0 - 2) * 5632 + DFF + f), v2); unpack8(*(const u32x4*)(u + (size_t)(r0 - 1) * 5632 + DFF + f), v1);
        }
#pragma unroll 1
        for (int i0 = 0; i0 < 16; i0 += 4) {
            u32x4 lg[4], lv[4];
#pragma unroll
            for (int i = 0; i < 4; ++i) { const size_t ro = (size_t)(r0 + i0 + i) * 5632; lg[i] = *(const u32x4*)(u + ro + f); lv[i] = *(const u32x4*)(u + ro + DFF + f); }
#pragma unroll
            for (int i = 0; i < 4; ++i) {
                float g0[8], v0[8], o[8];
                unpack8(lg[i], g0); unpack8(lv[i], v0);
#pragma unroll
                for (int e = 0; e < 8; ++e) {
                    const float G = wg[0][e] * g2[e] + wg[1][e] * g1[e] + wg[2][e] * g0[e] + bg[e];
                    const float V = wv[0][e] * v2[e] + wv[1][e] * v1[e] + wv[2][e] * v0[e] + bv[e];
                    o[e] = G * sigmoidf_(G) * V;
                    g2[e] = g1[e]; g1[e] = g0[e]; v2[e] = v1[e]; v1[e] = v0[e];
                }
                __builtin_nontemporal_store(pack8((f32x4){o[0], o[1], o[2], o[3]}, (f32x4){o[4], o[5], o[6], o[7]}), (u32x4*)(act + (size_t)(r0 + i0 + i) * DFF + f));
            }
        }
    }
}

__device__ __forceinline__ void mix_phase(const Params& p, int j) {
    const h16* x16 = (const h16*)(p.ws + OFF_X16);
    h16* xr = (h16*)p.out; h16* xk = (h16*)p.out + (size_t)MTOK * 1024; h16* xv = (h16*)(p.ws + R_G16);
    const float* mix = p.in[3] + j * 6 * 1024;
    const size_t gtid = (size_t)blockIdx.x * 512 + opaque_tid(), nth = (size_t)gridDim.x * 512;
    for (size_t idx = gtid; idx < (size_t)MTOK * 128; idx += nth) {
        const int row = (int)(idx >> 7), c8 = (int)(idx & 127) * 8;
        const h16* xp = x16 + xrow(row) * 1024 + c8;
        float xc[8], xq[8];
        unpack8(*(const u32x4*)xp, xc); unpack8(*(const u32x4*)(xp - 1024), xq);
#pragma unroll
        for (int e = 0; e < 8; ++e) xq[e] -= xc[e];
        const size_t o = (size_t)row * 1024 + c8;
#pragma unroll
        for (int bsel = 0; bsel < 3; ++bsel) {
            const f32x4 m0 = *(const f32x4*)(mix + bsel * 1024 + c8), m1 = *(const f32x4*)(mix + bsel * 1024 + c8 + 4);
            f32x4 a, b;
#pragma unroll
            for (int e = 0; e < 4; ++e) { a[e] = xc[e] + xq[e] * m0[e]; b[e] = xc[4 + e] + xq[4 + e] * m1[e]; }
            h16* dst = bsel == 0 ? xr : (bsel == 1 ? xk : xv);
            __builtin_nontemporal_store(pack8(a, b), (u32x4*)(dst + o));
        }
    }
}

__device__ __forceinline__ void unpack4(u32x2 w, float* f) {
    h16x4 h = __builtin_bit_cast(h16x4, w);
#pragma unroll
    for (int i = 0; i < 4; ++i) f[i] = (float)h[i];
}
constexpr int SCAN_BUF = 8256;
__device__ __forceinline__ void scan_phase(const Params& p, int j, unsigned char* smem) {
    const int tid = opaque_tid();
    const int wave = tid >> 6, lane = tid & 63, slot = wave >> 2, w4 = wave & 3;
    float* LB = (float*)smem + slot * (2 * SCAN_BUF);
    const h16* r16 = (const h16*)(p.ws + R_R16);
    const h16* k16 = (const h16*)(p.ws + R_K16);
    const h16* v16 = (j == 0) ? (const h16*)(p.ws + OFF_VF) : (const h16*)(p.ws + R_V16);
    const h16* g16 = (const h16*)(p.ws + R_G16);
    const h16* e16 = (const h16*)p.out;
    const h16* a16 = (const h16*)p.out + (size_t)MTOK * 1024;
    h16* y16 = (h16*)(p.ws + (j == 0 ? R_V16 : OFF_VF));
    const int tp = w4 * 4 + (lane >> 4), k4 = (lane & 15) * 4;
    const int vrow = w4 * 16 + (lane >> 2), kq = lane & 3;
    for (int pair = blockIdx.x; pair < 256; pair += gridDim.x) {
        const int chain = pair * 2 + slot, b = chain >> 4, h = chain & 15;
        const int col = h * 64 + k4;
        const f32x4 c_kk = *(const f32x4*)(p.in[16] + j * 1024 + col), c_ka = *(const f32x4*)(p.in[17] + j * 1024 + col), c_rk = *(const f32x4*)(p.in[18] + j * 1024 + col);
        const f32x4 c_lg = *(const f32x4*)(p.in[19] + j * 1024 + col), c_lb = *(const f32x4*)(p.in[20] + j * 1024 + col);
        f32x2 S[8];
#pragma unroll
        for (int i = 0; i < 8; ++i) S[i] = (f32x2){0.f, 0.f};
        u32x2 pr[6];
        {
            const size_t go = ((size_t)(b * 2048 + tp)) * 1024 + col;
            pr[0] = *(const u32x2*)(r16 + go); pr[1] = *(const u32x2*)(k16 + go); pr[2] = *(const u32x2*)(v16 + go);
            pr[3] = *(const u32x2*)(e16 + go); pr[4] = *(const u32x2*)(a16 + go); pr[5] = *(const u32x2*)(g16 + go);
        }
        for (int ch = 0; ch < 128; ++ch) {
            float* BUF = LB + (ch & 1) * SCAN_BUF;
            float* OPS = BUF; float* VB = BUF + 5120; float* GB = BUF + 6144; float* YB = BUF + 7168; float* BON = BUF + 8192;
            {
                float rf[4], kf[4], vf[4], ef[4], af[4], gf[4];
                unpack4(pr[0], rf); unpack4(pr[1], kf); unpack4(pr[2], vf); unpack4(pr[3], ef); unpack4(pr[4], af); unpack4(pr[5], gf);
                float kk[4]; float ss = 0.f;
#pragma unroll
                for (int i = 0; i < 4; ++i) { kk[i] = kf[i] * c_kk[i]; ss += kk[i] * kk[i]; }
                ss = red16(ss);
                const float inv = 1.0f / fmaxf(sqrtf(ss), 1e-12f);
                f32x4 A4, B4, W4, K4, R4; float bs = 0.f;
#pragma unroll
                for (int i = 0; i < 4; ++i) {
                    const float kn = kk[i] * inv;
                    A4[i] = -kn; B4[i] = kn * af[i];
                    W4[i] = __expf(-ef[i]);
                    const float km = kf[i] * (1.0f + (af[i] - 1.0f) * c_ka[i]);
                    K4[i] = km; R4[i] = rf[i];
                    bs += rf[i] * km * c_rk[i];
                }
                bs = red16(bs);
                float* o = OPS + tp * 320 + k4;
                *(f32x4*)(o) = A4; *(f32x4*)(o + 64) = B4; *(f32x4*)(o + 128) = W4; *(f32x4*)(o + 192) = K4; *(f32x4*)(o + 256) = R4;
                *(f32x4*)(VB + tp * 64 + k4) = (f32x4){vf[0], vf[1], vf[2], vf[3]};
                *(f32x4*)(GB + tp * 64 + k4) = (f32x4){gf[0], gf[1], gf[2], gf[3]};
                if ((lane & 15) == 0) BON[tp] = bs;
            }
            if (ch + 1 < 128) {
                const size_t go = ((size_t)(b * 2048 + (ch + 1) * 16 + tp)) * 1024 + col;
                pr[0] = *(const u32x2*)(r16 + go); pr[1] = *(const u32x2*)(k16 + go); pr[2] = *(const u32x2*)(v16 + go);
                pr[3] = *(const u32x2*)(e16 + go); pr[4] = *(const u32x2*)(a16 + go); pr[5] = *(const u32x2*)(g16 + go);
            }
            __syncthreads();
#pragma unroll 2
            for (int t = 0; t < 16; ++t) {
                const float* op = OPS + t * 320 + kq * 16;
                f32x4 A4[4], B4[4], W4[4], K4[4], R4[4];
#pragma unroll
                for (int i = 0; i < 4; ++i) A4[i] = *(const f32x4*)(op + i * 4);
#pragma unroll
                for (int i = 0; i < 4; ++i) { W4[i] = *(const f32x4*)(op + 128 + i * 4); B4[i] = *(const f32x4*)(op + 64 + i * 4); K4[i] = *(const f32x4*)(op + 192 + i * 4); }
#pragma unroll
                for (int i = 0; i < 4; ++i) R4[i] = *(const f32x4*)(op + 256 + i * 4);
                const float vv = VB[t * 64 + vrow];
                f32x2 s0 = {0.f, 0.f}, s1 = {0.f, 0.f};
#pragma unroll
                for (int i = 0; i < 4; ++i) { s0 += S[2 * i] * (f32x2){A4[i][0], A4[i][1]}; s1 += S[2 * i + 1] * (f32x2){A4[i][2], A4[i][3]}; }
                const float sa = red4((s0[0] + s0[1]) + (s1[0] + s1[1]));
                const f32x2 sa2 = {sa, sa}, vv2 = {vv, vv};
#pragma unroll
                for (int i = 0; i < 4; ++i) {
                    S[2 * i] = S[2 * i] * (f32x2){W4[i][0], W4[i][1]} + sa2 * (f32x2){B4[i][0], B4[i][1]} + vv2 * (f32x2){K4[i][0], K4[i][1]};
                    S[2 * i + 1] = S[2 * i + 1] * (f32x2){W4[i][2], W4[i][3]} + sa2 * (f32x2){B4[i][2], B4[i][3]} + vv2 * (f32x2){K4[i][2], K4[i][3]};
                }
                f32x2 y0 = {0.f, 0.f}, y1 = {0.f, 0.f};
#pragma unroll
                for (int i = 0; i < 4; ++i) { y0 += S[2 * i] * (f32x2){R4[i][0], R4[i][1]}; y1 += S[2 * i + 1] * (f32x2){R4[i][2], R4[i][3]}; }
                const float y = red4((y0[0] + y0[1]) + (y1[0] + y1[1]));
                if (kq == 0) YB[t * 64 + vrow] = y;
            }
            __syncthreads();
            {
                const f32x4 y4 = *(const f32x4*)(YB + tp * 64 + k4), v4 = *(const f32x4*)(VB + tp * 64 + k4), g4 = *(const f32x4*)(GB + tp * 64 + k4);
                const float mu = red16((y4[0] + y4[1]) + (y4[2] + y4[3])) * (1.0f / 64.0f);
                float q = 0.f;
#pragma unroll
                for (int i = 0; i < 4; ++i) { const float d = y4[i] - mu; q += d * d; }
                const float rstd = rsqrtf(red16(q) * (1.0f / 64.0f) + 64e-5f);
                const float bon = BON[tp];
                float o[4];
#pragma unroll
                for (int i = 0; i < 4; ++i) o[i] = ((y4[i] - mu) * rstd * c_lg[i] + c_lb[i] + bon * v4[i]) * g4[i];
                u32x2 w; w.x = pk2(o[0], o[1]); w.y = pk2(o[2], o[3]);
                *(u32x2*)(y16 + ((size_t)(b * 2048 + ch * 16 + tp)) * 1024 + col) = w;
            }
        }
        __syncthreads();
    }
}

__device__ __forceinline__ void dsa_norm_phase(const Params& p, int j, unsigned char* smem) {
    const int tid = opaque_tid();
    const int lane = tid & 63, wave = tid >> 6;
    const float* hin = (const float*)(p.ws + D_HIN);
    h16* cq = (h16*)(p.ws + D_CQ); h16* ckv = (h16*)(p.ws + D_CKV); h16* ckvt = (h16*)(p.ws + D_CKVT); h16* kidx = (h16*)(p.ws + D_KIDX);
    float* widx = (float*)(p.ws + D_WIDX);
    const f32x4 gq = *(const f32x4*)(p.in[23] + j * 256 + lane * 4);
    const f32x2 gkv = *(const f32x2*)(p.in[24] + j * 128 + lane * 2);
    const float gi = p.in[29][j * 64 + lane], bi = p.in[30][j * 64 + lane];
    h16* wl = (h16*)(smem + wave * 2048);
    for (int grp = blockIdx.x * 8 + wave; grp < MTOK / 8; grp += gridDim.x * 8) {
        const int r0 = grp * 8;
        for (int i = 0; i < 8; ++i) {
            const int row = r0 + i;
            const float* hp = hin + (size_t)row * 512;
            const f32x4 vq = *(const f32x4*)(hp + lane * 4);
            const f32x2 vk = *(const f32x2*)(hp + 256 + lane * 2);
            const float vi = hp[384 + lane];
            float ssq = wave_sum(vq[0] * vq[0] + vq[1] * vq[1] + vq[2] * vq[2] + vq[3] * vq[3]);
            const float rq = rsqrtf(ssq * (1.0f / 256.0f) + 1e-6f);
            u32x2 w; w.x = pk2(vq[0] * rq * gq[0], vq[1] * rq * gq[1]); w.y = pk2(vq[2] * rq * gq[2], vq[3] * rq * gq[3]);
            *(u32x2*)(cq + (size_t)row * 256 + lane * 4) = w;
            float ssk = wave_sum(vk[0] * vk[0] + vk[1] * vk[1]);
            const float rk = rsqrtf(ssk * (1.0f / 128.0f) + 1e-6f);
            const unsigned wk = pk2(vk[0] * rk * gkv[0], vk[1] * rk * gkv[1]);
            *(unsigned*)(ckv + (size_t)row * 128 + lane * 2) = wk;
            const float mu = wave_sum(vi) * (1.0f / 64.0f);
            const float dv = vi - mu;
            const float var = wave_sum(dv * dv) * (1.0f / 64.0f);
            kidx[(size_t)row * 64 + lane] = (h16)(dv * rsqrtf(var + 1e-5f) * gi + bi);
            if (lane < 8) widx[(size_t)row * 8 + lane] = hp[448 + lane] * 0.044194173824159216f;
        }
    }
}

constexpr int ROWP = 2052;
__device__ __forceinline__ unsigned fkey(float x) {
    if (x == 0.0f) x = 0.0f;
    const unsigned u = __float_as_uint(x);
    return (u & 0x80000000u) ? ~u : (u | 0x80000000u);
}
__device__ __forceinline__ void dsa_index_phase(const Params& p, unsigned char* smem) {
    const int tid = opaque_tid(), wave = tid >> 6, lane = tid & 63, r = lane & 15, q = lane >> 4;
    float* SC = (float*)smem;
    const h16* qidx = (const h16*)(p.ws + D_QIDX);
    const h16* kidx = (const h16*)(p.ws + D_KIDX);
    const float* widx = (const float*)(p.ws + D_WIDX);
    unsigned short* selout = (unsigned short*)(p.ws + D_MASK);
    h16x8 qf[8][2]; float wq[8];
    if ((int)blockIdx.x < MTOK / 16) {
        const int row0 = (int)blockIdx.x * 16;
#pragma unroll
        for (int h = 0; h < 8; ++h) {
#pragma unroll
            for (int kk = 0; kk < 2; ++kk) qf[h][kk] = *(const h16x8*)(qidx + (size_t)(row0 + r) * 512 + h * 64 + kk * 32 + q * 8);
            wq[h] = widx[(size_t)(row0 + r) * 8 + h];
        }
    }
    for (int qi = blockIdx.x, it = 0; qi < MTOK / 16; qi += gridDim.x, ++it) {
        const int qt = (it & 1) ? ((qi & ~127) | (127 - (qi & 127))) : qi;
        const int row0 = qt * 16, b = row0 >> 11, t0 = row0 & 2047;
        const int nkt = (t0 >> 4) + 1;
        {
            h16x8 kn[4];
            if (wave < nkt) {
                const bool two = (wave + 8 < nkt);
                const int s0 = wave * 16, s1 = two ? s0 + 128 : s0;
                const h16* kp = kidx + (size_t)(b * 2048 + s0 + r) * 64 + q * 8;
                const h16* kp1 = kidx + (size_t)(b * 2048 + s1 + r) * 64 + q * 8;
                kn[0] = *(const h16x8*)kp; kn[1] = *(const h16x8*)(kp + 32); kn[2] = *(const h16x8*)kp1; kn[3] = *(const h16x8*)(kp1 + 32);
            }
            for (int kt = wave; kt < nkt; kt += 16) {
                const bool two = (kt + 8 < nkt);
                const int s0 = kt * 16, s1 = two ? s0 + 128 : s0;
                const h16x8 k0 = kn[0], k1 = kn[1], k2 = kn[2], k3 = kn[3];
                if (kt + 16 < nkt) {
                    const bool two2 = (kt + 24 < nkt);
                    const int n0 = (kt + 16) * 16, n1 = two2 ? n0 + 128 : n0;
                    const h16* kp = kidx + (size_t)(b * 2048 + n0 + r) * 64 + q * 8;
                    const h16* kp1 = kidx + (size_t)(b * 2048 + n1 + r) * 64 + q * 8;
                    kn[0] = *(const h16x8*)kp; kn[1] = *(const h16x8*)(kp + 32); kn[2] = *(const h16x8*)kp1; kn[3] = *(const h16x8*)(kp1 + 32);
                }
                f32x4 sc = {0.f, 0.f, 0.f, 0.f}, sd = {0.f, 0.f, 0.f, 0.f};
#pragma unroll
                for (int h = 0; h < 8; ++h) {
                    f32x4 acc = {0.f, 0.f, 0.f, 0.f}, acd = {0.f, 0.f, 0.f, 0.f};
                    acc = __builtin_amdgcn_mfma_f32_16x16x32_f16(k0, qf[h][0], acc, 0, 0, 0);
                    acd = __builtin_amdgcn_mfma_f32_16x16x32_f16(k2, qf[h][0], acd, 0, 0, 0);
                    acc = __builtin_amdgcn_mfma_f32_16x16x32_f16(k1, qf[h][1], acc, 0, 0, 0);
                    acd = __builtin_amdgcn_mfma_f32_16x16x32_f16(k3, qf[h][1], acd, 0, 0, 0);
#pragma unroll
                    for (int jj = 0; jj < 4; ++jj) { sc[jj] += fmaxf(acc[jj], 0.f) * wq[h]; sd[jj] += fmaxf(acd[jj], 0.f) * wq[h]; }
                }
                *(f32x4*)(SC + r * ROWP + s0 + q * 4) = sc;
                if (two) *(f32x4*)(SC + r * ROWP + s1 + q * 4) = sd;
            }
            const int qin = qi + (int)gridDim.x;
            if (qin < MTOK / 16) {
                const int qtn = ((it + 1) & 1) ? ((qin & ~127) | (127 - (qin & 127))) : qin;
                const int rown = qtn * 16;
#pragma unroll
                for (int h = 0; h < 8; ++h) {
#pragma unroll
                    for (int kk = 0; kk < 2; ++kk) qf[h][kk] = *(const h16x8*)(qidx + (size_t)(rown + r) * 512 + h * 64 + kk * 32 + q * 8);
                    wq[h] = widx[(size_t)(rown + r) * 8 + h];
                }
            }
        }
        __syncthreads();
        for (int qq = 0; qq < 2; ++qq) {
            const int ql = wave * 2 + qq, t = t0 + ql;
            const float* srow = SC + ql * ROWP;
            const int ni = (t >> 6) + 1;
            unsigned u[32];
#pragma unroll
            for (int i = 0; i < 32; ++i) {
                u[i] = 0u;
                if (i < ni) { const int s = i * 64 + lane; if (s <= t) u[i] = fkey(srow[s]); }
            }
            unsigned short* selrow = selout + (size_t)(row0 + ql) * 256;
            if (t < 256) {
#pragma unroll
                for (int i = 0; i < 4; ++i) { const int pp = i * 64 + lane; selrow[pp] = (unsigned short)(pp <= t ? pp : 0xFFFF); }
            } else {
                unsigned* H = (unsigned*)(smem + 16 * ROWP * 4) + wave * 256;
                unsigned prefix = 0u; int need = 256;
#pragma unroll 1
                for (int pass = 0; pass < 4; ++pass) {
                    const int shift = 24 - 8 * pass;
                    const unsigned hmask = pass == 0 ? 0u : (0xFFFFFFFFu << (shift + 8));
                    *(u32x4*)(H + lane * 4) = (u32x4){0u, 0u, 0u, 0u};
                    asm volatile("s_waitcnt lgkmcnt(0)" ::: "memory");
#pragma unroll
                    for (int i = 0; i < 32; ++i) if (i < ni) { const unsigned uu = u[i]; if (uu != 0u && (uu & hmask) == prefix) atomicAdd(H + ((uu >> shift) & 255u), 1u); }
                    asm volatile("s_waitcnt lgkmcnt(0)" ::: "memory");
                    const u32x4 hv = *(const u32x4*)(H + lane * 4);
                    const int tot = (int)(hv.x + hv.y + hv.z + hv.w);
                    int rs = tot;
                    rs += __builtin_amdgcn_update_dpp(0, rs, 0xB1, 0xF, 0xF, true);
                    rs += __builtin_amdgcn_update_dpp(0, rs, 0x4E, 0xF, 0xF, true);
                    rs += __builtin_amdgcn_update_dpp(0, rs, 0x141, 0xF, 0xF, true);
                    rs += __builtin_amdgcn_update_dpp(0, rs, 0x140, 0xF, 0xF, true);
                    int rowsel = 3, above = 0;
                    {
                        const int r3 = __builtin_amdgcn_readlane(rs, 48), r2 = __builtin_amdgcn_readlane(rs, 32), r1 = __builtin_amdgcn_readlane(rs, 16);
                        if (need > r3) { above = r3; rowsel = 2; if (need > above + r2) { above += r2; rowsel = 1; if (need > above + r1) { above += r1; rowsel = 0; } } }
                    }
                    int lsel = rowsel * 16;
                    for (int k = 15; k >= 0; --k) {
                        const int cl = __builtin_amdgcn_readlane(tot, rowsel * 16 + k);
                        if (need <= above + cl) { lsel = rowsel * 16 + k; break; }
                        above += cl;
                    }
                    const int b3 = __builtin_amdgcn_readlane((int)hv.w, lsel), b2 = __builtin_amdgcn_readlane((int)hv.z, lsel), b1 = __builtin_amdgcn_readlane((int)hv.y, lsel);
                    int bsel = 3;
                    if (need > above + b3) { above += b3; bsel = 2; if (need > above + b2) { above += b2; bsel = 1; if (need > above + b1) { above += b1; bsel = 0; } } }
                    prefix |= (unsigned)(lsel * 4 + bsel) << shift;
                    need -= above;
                }
                const unsigned T = prefix;
                int running = 0, outpos = 0;
                const unsigned long long lt = (lane == 0) ? 0ull : (~0ull >> (64 - lane));
#pragma unroll
                for (int i = 0; i < 32; ++i) {
                    if (i < ni) {
                        const unsigned long long eq = __ballot(u[i] == T);
                        const int rank = running + __popcll(eq & lt);
                        const bool sel = u[i] > T || (u[i] == T && rank < need);
                        const unsigned long long sm = __ballot(sel);
                        running += __popcll(eq);
                        if (sel) selrow[outpos + __popcll(sm & lt)] = (unsigned short)(i * 64 + lane);
                        outpos += __popcll(sm);
                    }
                }
            }
        }
        __syncthreads();
    }
}

typedef __fp16 fp16x4_t __attribute__((__vector_size__(4 * sizeof(__fp16))));
__device__ __forceinline__ unsigned off_b(unsigned row, unsigned ch) { return 256u * row + 16u * (ch ^ (((row & 3) << 2) | ((row >> 2) & 3))); }
constexpr int SA_TILE = 8192, SA_BL = 8 * 2 * SA_TILE;
static_assert(SA_BL + 16 * 132 * 4 <= LDS_BYTES, "sparse attention LDS");
__device__ __forceinline__ void dsa_attn_phase(const Params& p, int j, unsigned char* smem) {
    const int tid = opaque_tid(), wave = tid >> 6, lane = tid & 63, r = lane & 15, q = lane >> 4;
    float* BL = (float*)(smem + SA_BL);
    for (int idx = tid; idx < 16 * 129; idx += 512) {
        const int h = idx / 129, d = idx % 129;
        int bk = d;
        if (d >= 16) { bk = 16 + (int)(logf((float)d * (1.0f / 16.0f)) / 2.0794415416798357f * 16.0f); bk = bk > 31 ? 31 : bk; }
        BL[h * 132 + d] = p.in[32][bk * 16 + h] * 1.4426950408889634f;
    }
    __syncthreads();
    const h16* qabs = (const h16*)(p.ws + D_QABS);
    const h16* ckv = (const h16*)(p.ws + D_CKV);
    const unsigned short* sel = (const unsigned short*)(p.ws + D_MASK);
    h16* olatA = (h16*)(p.ws + D_HIN);
    h16* olatB = (h16*)p.out + (size_t)MTOK * 1024;
    unsigned char* tile0 = smem + wave * (2 * SA_TILE);
    const float NINF = -__builtin_inff();
    unsigned wofs[8], kofs[2][4], vofs[8][2];
#pragma unroll
    for (int i = 0; i < 8; ++i) wofs[i] = off_b(8 * q + i, r);
#pragma unroll
    for (int tt = 0; tt < 2; ++tt)
#pragma unroll
        for (int kk = 0; kk < 4; ++kk) kofs[tt][kk] = off_b(8 * (r >> 2) + 4 * tt + (r & 3), 4 * kk + q);
#pragma unroll
    for (int c = 0; c < 8; ++c)
#pragma unroll
        for (int t2 = 0; t2 < 2; ++t2) vofs[c][t2] = off_b(8 * q + 4 * t2 + (r >> 2), 2 * c + ((lane & 3) >> 1)) + 8 * (lane & 1);
    for (int row = blockIdx.x * 8 + wave; row < MTOK; row += gridDim.x * 8) {
        const int b = row >> 11, t = row & 2047;
        const int nvalid = t + 1 < 256 ? t + 1 : 256, ng = (nvalid + 31) >> 5;
        const h16* kg = ckv + (size_t)(b * 2048) * 128;
        const unsigned short* srow = sel + (size_t)row * 256;
        h16x8 qf[4];
#pragma unroll
        for (int kk = 0; kk < 4; ++kk) qf[kk] = *(const h16x8*)(qabs + (size_t)row * 2048 + r * 128 + kk * 32 + q * 8);
        f32x4 O[8];
#pragma unroll
        for (int dt = 0; dt < 8; ++dt) O[dt] = (f32x4){0.f, 0.f, 0.f, 0.f};
        float mrun = NINF, lrun = 0.f;
        u32x4 selA = *(const u32x4*)(srow + 8 * q), selB = selA;
        u32x4 grA[8], grB[8];
#define SA_GATHER(GR, SELV) do { _Pragma("unroll") for (int i = 0; i < 8; ++i) { \
            unsigned sidx = ((SELV)[i >> 1] >> ((i & 1) * 16)) & 0xFFFFu; sidx = sidx == 0xFFFFu ? 0u : sidx; \
            (GR)[i] = *(const u32x4*)(kg + (size_t)sidx * 128 + r * 8); } } while (0)
#define SA_GROUP(GR, SELV, G) do { \
            unsigned char* tile = tile0 + ((G) & 1) * SA_TILE; \
            const u32x4 selc = (SELV); \
            _Pragma("unroll") for (int i = 0; i < 8; ++i) *(u32x4*)(tile + wofs[i]) = (GR)[i]; \
            if ((G) + 2 < ng) { (SELV) = *(const u32x4*)(srow + ((G) + 2) * 32 + 8 * q); SA_GATHER(GR, SELV); } \
            asm volatile("s_waitcnt lgkmcnt(0)" ::: "memory"); \
            f32x4 sc[2]; \
            _Pragma("unroll") for (int tt = 0; tt < 2; ++tt) { \
                f32x4 acc = {0.f, 0.f, 0.f, 0.f}; \
                _Pragma("unroll") for (int kk = 0; kk < 4; ++kk) { \
                    const h16x8 kf = *(const h16x8*)(tile + kofs[tt][kk]); \
                    acc = __builtin_amdgcn_mfma_f32_16x16x32_f16(kf, qf[kk], acc, 0, 0, 0); } \
                sc[tt] = acc; } \
            float x[8]; float mx = NINF; \
            _Pragma("unroll") for (int i = 0; i < 8; ++i) { \
                const unsigned sidx = (selc[i >> 1] >> ((i & 1) * 16)) & 0xFFFFu; \
                int dist = t - (int)sidx; dist = dist < 0 ? 0 : (dist > 128 ? 128 : dist); \
                const float v = sc[i >> 2][i & 3] + BL[r * 132 + dist]; \
                const float xv = (sidx != 0xFFFFu) ? v : NINF; \
                x[i] = xv; mx = fmaxf(mx, xv); } \
            mx = xmax_16_32(mx); \
            const float mnew = fmaxf(mrun, mx); \
            const float mref = (mnew == NINF) ? 0.f : mnew; \
            const float alpha = __builtin_amdgcn_exp2f(mrun - mref); \
            mrun = mnew; \
            float ps = 0.f; h16x8 pf; \
            _Pragma("unroll") for (int i = 0; i < 8; ++i) { const float pv = __builtin_amdgcn_exp2f(x[i] - mref); ps += pv; pf[i] = (h16)pv; } \
            lrun = lrun * alpha + ps; \
            _Pragma("unroll") for (int dt = 0; dt < 8; ++dt) { \
                const fp16x4_t lo = __builtin_amdgcn_ds_read_tr16_b64_v4f16((LAS fp16x4_t*)(tile + vofs[dt][0])); \
                const fp16x4_t hi = __builtin_amdgcn_ds_read_tr16_b64_v4f16((LAS fp16x4_t*)(tile + vofs[dt][1])); \
                const h16x4 l4 = __builtin_bit_cast(h16x4, lo), h4 = __builtin_bit_cast(h16x4, hi); \
                const h16x8 vf = {l4[0], l4[1], l4[2], l4[3], h4[0], h4[1], h4[2], h4[3]}; \
                O[dt] *= alpha; \
                O[dt] = __builtin_amdgcn_mfma_f32_16x16x32_f16(vf, pf, O[dt], 0, 0, 0); } \
        } while (0)
        SA_GATHER(grA, selA);
        if (ng > 1) { selB = *(const u32x4*)(srow + 32 + 8 * q); SA_GATHER(grB, selB); }
        for (int g = 0; g < ng; g += 2) {
            SA_GROUP(grA, selA, g);
            if (g + 1 < ng) SA_GROUP(grB, selB, g + 1);
        }
#undef SA_GATHER
#undef SA_GROUP
        const float inv = 1.0f / xsum_16_32(lrun);
        h16* op = (row < MTOK / 2 ? olatA + (size_t)row * 2048 : olatB + (size_t)(row - MTOK / 2) * 2048) + r * 128 + q * 4;
#pragma unroll
        for (int dt = 0; dt < 8; ++dt) {
            u32x2 w; w.x = pk2(O[dt][0] * inv, O[dt][1] * inv); w.y = pk2(O[dt][2] * inv, O[dt][3] * inv);
            *(u32x2*)(op + dt * 16) = w;
        }
        asm volatile("s_waitcnt lgkmcnt(0)" ::: "memory");
    }
    __syncthreads();
}

constexpr size_t OFF_BAR = 951 * MiB;
#define XB_TMO      128
#define XB_XCNT(j)  (256  + 64 * (j))
#define XB_XSUB(j)  (1280 + 64 * (j))
#define XB_XGEN(j)  (2304 + 64 * (j))
#define XB_TOP      3328
#define XB_TOPGEN   3392
#define XCD_BAR_WORDS 3456
#define XB_SPIN_CAP (1u << 22)
__device__ __forceinline__ unsigned xb_ld(unsigned* p)              { return __hip_atomic_load(p, __ATOMIC_RELAXED, __HIP_MEMORY_SCOPE_AGENT); }
__device__ __forceinline__ unsigned xb_add(unsigned* p, unsigned v) { return __hip_atomic_fetch_add(p, v, __ATOMIC_RELAXED, __HIP_MEMORY_SCOPE_AGENT); }
__device__ __forceinline__ unsigned xb_xcc_id() { return (unsigned)__builtin_amdgcn_s_getreg((3 << 11) | 20) & 0xFu; }
#define XB_SPIN(cond, bar) do { unsigned _sp = 0; while (cond) { __builtin_amdgcn_s_sleep(1); \
    if ((++_sp & 255u) == 0u) { if (xb_ld(&(bar)[XB_TMO])) break; if (_sp > XB_SPIN_CAP) { atomicAdd(&(bar)[XB_TMO], 1u); break; } } } } while (0)
struct XcdBarrier { unsigned* bar; unsigned x; volatile LAS unsigned* st; };
__device__ __forceinline__ XcdBarrier xcd_barrier_post(unsigned* bar, volatile LAS unsigned* st) {
    XcdBarrier b; b.bar = bar; b.x = xb_xcc_id(); b.st = st;
    if (threadIdx.x == 0) (void)xb_add(&bar[XB_XCNT(b.x)], 1u);
    return b;
}
__device__ __forceinline__ void xcd_barrier_complete(unsigned* bar, unsigned x, unsigned& nloc, unsigned& nx) {
    const unsigned G = gridDim.x * gridDim.y * gridDim.z;
    unsigned sum, cnt, mine, sp = 0u;
    for (;;) {
        sum = 0u; cnt = 0u; mine = 0u;
#pragma unroll
        for (unsigned jx = 0; jx < 16; ++jx) { const unsigned c = xb_ld(&bar[XB_XCNT(jx)]); sum += c; cnt += (c > 0u) ? 1u : 0u; mine = (jx == x) ? c : mine; }
        if (sum == G) break;
        __builtin_amdgcn_s_sleep(1);
        if ((++sp & 255u) == 0u) { if (xb_ld(&bar[XB_TMO])) break; if (sp > XB_SPIN_CAP) { atomicAdd(&bar[XB_TMO], 1u); break; } }
    }
    nloc = mine > 0u ? mine : 1u; nx = cnt > 0u ? cnt : 1u;
}
__device__ __forceinline__ void xcd_barrier(const XcdBarrier& b) {
    asm volatile("s_waitcnt vmcnt(0)" ::: "memory");
    __syncthreads();
    if (threadIdx.x == 0) {
        unsigned* bar = b.bar;
        __builtin_amdgcn_s_waitcnt(0);
        unsigned nloc = b.st[0], nx = b.st[1];
        if (nloc == 0u) { xcd_barrier_complete(bar, b.x, nloc, nx); b.st[0] = nloc; b.st[1] = nx; }
        const unsigned old = xb_add(&bar[XB_XSUB(b.x)], 1u);
        const unsigned gen = old / nloc;
        if (old + 1u == (gen + 1u) * nloc) {
            __builtin_amdgcn_fence(__ATOMIC_RELEASE, "agent");
            asm volatile("s_waitcnt vmcnt(0)" ::: "memory");
            const unsigned og = xb_add(&bar[XB_TOP], 1u);
            const unsigned tg = og / nx;
            if (og + 1u == (tg + 1u) * nx) xb_add(&bar[XB_TOPGEN], 1u);
            else XB_SPIN(xb_ld(&bar[XB_TOPGEN]) == tg, bar);
            __builtin_amdgcn_fence(__ATOMIC_ACQUIRE, "agent");
            xb_add(&bar[XB_XGEN(b.x)], 1u);
            asm volatile("s_waitcnt vmcnt(0)" ::: "memory");
        } else {
            XB_SPIN(xb_ld(&bar[XB_XGEN(b.x)]) == gen, bar);
            __builtin_amdgcn_fence(__ATOMIC_ACQUIRE, "agent");
            asm volatile("s_waitcnt vmcnt(0)" ::: "memory");
        }
    }
    __syncthreads();
}

__global__ void __launch_bounds__(512) mega_fwd(Params p) {
    extern __shared__ __attribute__((aligned(16))) unsigned char smem[];
    cg::grid_group grid = cg::this_grid();
    unsigned char* ws = p.ws;
    h16* x16 = (h16*)(ws + OFF_X16);
    volatile LAS unsigned* xbst = (volatile LAS unsigned*)(smem + LDS_BYTES - 16);
    if (threadIdx.x == 0) { xbst[0] = 0u; xbst[1] = 0u; }
    __syncthreads();
    const XcdBarrier xbar = xcd_barrier_post((unsigned*)(ws + OFF_BAR), xbst);
    for (int ph = p.ph_lo; ph < p.ph_hi; ++ph) {
        const unsigned e = p.prog[ph];
        const int kind = e & 15, L = (e >> 4) & 3, sub = (e >> 6) & 1, j = L >> 1;
        const int nrep = 1 + (int)(e >> 7);
        for (int rep = 0; rep < nrep; ++rep) {
        if (rep) xcd_barrier(xbar);
        const bool isgemm = (kind == K_R1 || kind == K_R2 || kind == K_R4 || kind == K_F1 || kind == K_F3 || kind == K_D1 || kind == K_D3 || kind == K_D6);
        if (isgemm) {
            const int ngemm = (kind == K_R1) ? 2 : 1;
            for (int gi = 0; gi < ngemm; ++gi) {
            pg8::Gemm g; pg8::Epi E;
            g.M = MTOK; g.N = 1024; g.K = 1024; g.lda = 1024; g.amode = 0; g.pm0 = 0; g.A = x16; g.A2 = x16; g.Bt = x16;
            E.mode = E_RESID; E.pm0 = 0; E.j = j; E.pnoff = 0; E.fin = (L == 3 && kind == K_F3) ? 1 : 0; E.ws = ws; E.out = p.out; E.bias0 = p.in[5] + j * 1024; E.bias1 = p.in[8] + j * 1024; E.bias2 = p.in[11];
            if (kind == K_R1) {
                E.mode = E_RPROJ;
                if (gi == 0) { g.A = (const h16*)p.out; g.A2 = (const h16*)(ws + R_G16); g.Bt = w_rwkv_big(ws, j); g.N = 3072; g.amode = 2; }
                else { g.Bt = w_rwkv_l1(ws, j); g.N = 512; g.K = 2048; g.amode = 1; E.pnoff = 12; }
            } else if (kind == K_R2) {
                g.A = (const h16*)(ws + R_HACT); g.Bt = w_rwkv_l2(ws, j); g.N = (j == 0) ? 3072 : 4096; g.K = 384; g.lda = 384; E.mode = E_LORA2;
            } else if (kind == K_R4) {
                g.A = (const h16*)(ws + (j == 0 ? R_V16 : OFF_VF)); g.Bt = w_rwkv_o(ws, j);
            } else if (kind == K_F1) {
                g.Bt = w_ffn_up(ws, L); g.M = MTOK / 2; g.N = 5632; g.amode = 1; g.pm0 = sub * 128; E.mode = E_ST16;
            } else if (kind == K_F3) {
                g.A = (const h16*)(ws + F_ACT); g.Bt = w_ffn_dn(ws, L); g.M = MTOK / 2; g.K = 2816; g.lda = 2816; E.pm0 = sub * 128;
            } else if (kind == K_D1) {
                g.Bt = w_dsa_in(ws, j); g.N = 512; g.amode = 1; E.mode = E_ST32;
            } else if (kind == K_D3) {
                g.A = (const h16*)(ws + D_CQ); g.Bt = w_dsa_q(ws, j); g.N = 2560; g.K = 256; g.lda = 256; E.mode = E_QPROJ;
            } else {
                g.A = (const h16*)(ws + D_HIN); g.A2 = (const h16*)p.out + (size_t)MTOK * 1024; g.Bt = (const h16*)(ws + OFF_WOV) + (size_t)j * 2097152; g.K = 2048; g.lda = 2048; g.amode = 3;
            }
            pg8::StaticOrder S; S.init(g.M, g.N, (int)gridDim.x, (int)blockIdx.x);
#ifndef NO_GEMM
            pg8::gemm_phase((LAS unsigned char*)smem, g, S, E);
#endif
            }
        } else if (kind == K_PREP) {
#ifndef NO_PREP
            prep_phase(p, smem);
#endif
        } else if (kind == K_R0) {
            mix_phase(p, j);
        } else if (kind == K_R3) {
#ifndef NO_SCAN
            scan_phase(p, j, smem);
#endif
        } else if (kind == K_LN) {
#ifndef NO_LN
            ln_phase(p, p.in[1] + (L * 2 + sub) * 1024, p.in[2] + (L * 2 + sub) * 1024, L == 3 && sub == 1);
#endif
        } else if (kind == K_F2) {
#ifndef NO_CONV
            conv_phase(p, L);
#endif
        } else if (kind == K_D2) {
#ifndef NO_NORM
            dsa_norm_phase(p, j, smem);
#endif
        } else if (kind == K_D4) {
#ifndef NO_INDEX
            dsa_index_phase(p, smem);
#endif
        } else if (kind == K_D5) {
#ifndef NO_ATTN
            dsa_attn_phase(p, j, smem);
#endif
        }
        }
        if (ph + 1 < p.ph_hi) { if (ph == p.ph_lo) grid.sync(); else xcd_barrier(xbar); for (int xs = 0; xs < EXTRA_SYNC; ++xs) xcd_barrier(xbar); }
    }
}

extern "C" void kernel_launch(void* const* d_in, const int* in_sizes, int n_in, void* d_out, int out_size, void* d_ws, size_t ws_size, hipStream_t stream) {
    static int grid_blocks = 0;
    if (grid_blocks == 0) {
        if (n_in != 37 || ws_size < WS_NEED || out_size != MTOK * DM) { fprintf(stderr, "kernel_launch: unexpected problem (n_in %d ws %zu out %d)\n", n_in, ws_size, out_size); grid_blocks = -1; return; }
        int dev = 0, cus = 0, per_cu = 0;
        hipGetDevice(&dev);
        hipDeviceGetAttribute(&cus, hipDeviceAttributeMultiprocessorCount, dev);
        if (hipFuncSetAttribute((const void*)mega_fwd, hipFuncAttributeMaxDynamicSharedMemorySize, LDS_BYTES) != hipSuccess) { fprintf(stderr, "kernel_launch: hipFuncSetAttribute failed\n"); grid_blocks = -1; return; }
        hipOccupancyMaxActiveBlocksPerMultiprocessor(&per_cu, (const void*)mega_fwd, 512, LDS_BYTES);
        if (per_cu < 1) { fprintf(stderr, "kernel_launch: occupancy query says %d blocks/CU\n", per_cu); per_cu = 1; }
        (void)hipGetLastError();
        grid_blocks = cus * per_cu;
        fprintf(stderr, "kernel_launch: grid %d (cus %d x %d)\n", grid_blocks, cus, per_cu);
    }
    if (grid_blocks < 0) return;
    Params p{};
    for (int i = 0; i < 37; ++i) p.in[i] = (const float*)d_in[i];
    p.ws = (unsigned char*)d_ws; p.out = (float*)d_out;
    int np = 0;
    constexpr unsigned PROBE_MASK = 0u;
    auto add = [&](int kind, int L, int sub) { p.prog[np++] = (unsigned char)(kind | (L << 4) | (sub << 6) | ((((PROBE_MASK >> kind) & 1u) && !(kind == K_LN && L == 3 && sub == 1)) ? 128 : 0)); };
    add(K_PREP, 0, 0);
    for (int L = 0; L < 4; ++L) {
        if ((L & 1) == 0) { add(K_R0, L, 0); add(K_R1, L, 0); add(K_R2, L, 0); add(K_R3, L, 0); add(K_R4, L, 0); }
        else { add(K_D1, L, 0); add(K_D2, L, 0); add(K_D3, L, 0); add(K_D4, L, 0); add(K_D5, L, 0); add(K_D6, L, 0); }
        add(K_LN, L, 0);
        for (int c = 0; c < 2; ++c) { add(K_F1, L, c); add(K_F2, L, c); add(K_F3, L, c); }
        add(K_LN, L, 1);
    }
#if SINGLE_LAUNCH
    if (hipMemsetAsync((unsigned char*)d_ws + OFF_BAR, 0, XCD_BAR_WORDS * 4, stream) != hipSuccess) { fprintf(stderr, "kernel_launch: memset failed\n"); return; }
    p.ph_lo = 0; p.ph_hi = np;
    void* args[] = {&p};
    hipError_t e = hipLaunchCooperativeKernel((const void*)mega_fwd, dim3(grid_blocks), dim3(512), args, LDS_BYTES, stream);
    if (e != hipSuccess) fprintf(stderr, "cooperative launch failed: %s (grid %d)\n", hipGetErrorString(e), grid_blocks);
#else
    for (int ph = 0; ph < np; ++ph) {
        p.ph_lo = ph; p.ph_hi = ph + 1;
        hipLaunchKernelGGL(mega_fwd, dim3(grid_blocks), dim3(512), LDS_BYTES, stream, p);
    }
#endif
}
```
